# Optimizing an MI355X kernel written in HIP

```python
import math
import numpy as np
import jax
import jax.numpy as jnp
from jax import lax

D_MODEL = 1024
BATCH = 2
SEQ = 8192
DEPTH = 2

CTX_LEN = 256
GRID_W = 64
N_EVEN = (DEPTH + 1) // 2
N_ODD = DEPTH // 2

SSD_HEADS = 16
SSD_HEAD_DIM = 64
SSD_WIDTH = SSD_HEADS * SSD_HEAD_DIM
SSD_GROUPS = 2
SSD_STATE = 128
SSD_CHUNK = 128
CONV_K = 5
CONV_CH = SSD_WIDTH + 2 * SSD_GROUPS * SSD_STATE

GLA_HEADS = 4
GLA_KEY_DIM = 128
GLA_VAL_DIM = 256
GLA_K = GLA_HEADS * GLA_KEY_DIM
GLA_V = GLA_HEADS * GLA_VAL_DIM
GLA_RANK = 16
GLA_GATE_NORMALIZER = 16.0
GLA_CHUNK = 64

E_SPLITS = (SSD_WIDTH, CONV_CH, 2 * SSD_HEADS, GLA_K, GLA_K, GLA_V, GLA_V, 2 * GLA_RANK)
E_IN = SSD_WIDTH + CONV_CH + 2 * SSD_HEADS + 2 * GLA_K + 2 * GLA_V + 2 * GLA_RANK
E_MIX = SSD_WIDTH + GLA_V

ATT_HEADS = 16
ATT_KV_HEADS = 4
ATT_GROUP = ATT_HEADS // ATT_KV_HEADS
ATT_HEAD_DIM = 128
ATT_W = ATT_HEADS * ATT_HEAD_DIM
ATT_KV_W = ATT_KV_HEADS * ATT_HEAD_DIM
WINDOW = 128
ATT_BLOCK = 128
ROPE_BASE = 10000.0
ROPE_FREQS = ATT_HEAD_DIM // 4
O_IN = 2 * ATT_KV_W + 2 * ATT_W
NORM_EPS = 1e-6

kernel_name = 'hybrid_ssd_gla_swa_ctxprefix'


def rms_norm(t, g):
    tf = t.astype(jnp.float32)
    y = tf * lax.rsqrt(jnp.mean(tf * tf, axis=-1, keepdims=True) + NORM_EPS)
    return (y * g.astype(jnp.float32)).astype(t.dtype)


def split_cols(t, sizes):
    idx = np.cumsum(np.array(sizes))[:-1].tolist()
    return jnp.split(t, idx, axis=-1)


def _flip(t):
    return jnp.flip(t, axis=1)


def adaln(cvec, w, b):
    mod = (jnp.dot(jax.nn.silu(cvec), w) + b)[:, None, :]
    return jnp.split(mod, 3, axis=-1)


def centered_dwconv(t, w, b):
    half = (w.shape[0] - 1) // 2
    out = lax.conv_general_dilated(t, w.astype(t.dtype)[:, None, :], window_strides=(1,), padding=[(half, half)],
                                   dimension_numbers=('NWC', 'WIO', 'NWC'), feature_group_count=t.shape[-1])
    return out + b.astype(t.dtype)


def ssd_scan(xs, dt, a, bm, cm, init):
    bsz, seq, _, hd = xs.shape
    T = SSD_CHUNK
    nc = seq // T
    G, R, N = SSD_GROUPS, SSD_HEADS // SSD_GROUPS, SSD_STATE
    xdt = (xs * dt[..., None]).reshape(bsz, nc, T, G, R, hd)
    cs = jnp.cumsum((dt * a).reshape(bsz, nc, T, G, R), axis=2)
    bm = bm.reshape(bsz, nc, T, G, N)
    cm = cm.reshape(bsz, nc, T, G, N)
    incl = jnp.tril(jnp.ones((T, T), bool))[:, :, None, None]
    seg = jnp.exp(jnp.where(incl, cs[:, :, :, None] - cs[:, :, None, :], -jnp.inf))
    cb = jnp.einsum('bcign,bcjgn->bcijg', cm, bm)
    y_diag = jnp.einsum('bcijg,bcijgr,bcjgrp->bcigrp', cb, seg, xdt)
    u = jnp.einsum('bctgn,bctgr,bctgrp->bcgrpn', bm, jnp.exp(cs[:, :, -1:] - cs), xdt)
    chunk_decay = jnp.exp(cs[:, :, -1])

    def step(state, inp):
        d, uc = inp
        return d[..., None, None] * state + uc, state

    final, starts = lax.scan(step, init, (jnp.moveaxis(chunk_decay, 1, 0), jnp.moveaxis(u, 1, 0)))
    starts = jnp.moveaxis(starts, 0, 1)
    y_off = jnp.einsum('bcign,bcigr,bcgrpn->bcigrp', cm, jnp.exp(cs), starts)
    return (y_diag + y_off).reshape(bsz, seq, SSD_HEADS, hd), final


def ssd_mixer(z, xbc, dt_raw, conv_w, conv_b, dt_bias, a_log, d_skip, norm_g, init):
    bsz, seq, _ = z.shape
    xbc = jax.nn.silu(centered_dwconv(xbc, conv_w, conv_b))
    xs, bm, cm = split_cols(xbc, (SSD_WIDTH, SSD_GROUPS * SSD_STATE, SSD_GROUPS * SSD_STATE))
    xs = xs.reshape(bsz, seq, SSD_HEADS, SSD_HEAD_DIM)
    bm = bm.reshape(bsz, seq, SSD_GROUPS, SSD_STATE)
    cm = cm.reshape(bsz, seq, SSD_GROUPS, SSD_STATE)
    dt = jax.nn.softplus(dt_raw.reshape(bsz, seq, 2, SSD_HEADS) + dt_bias.astype(jnp.float32))
    a = -jnp.exp(a_log.astype(jnp.float32))
    y_f, fin_f = ssd_scan(xs, dt[:, :, 0], a[0], bm, cm, init[0])
    y_b, fin_b = ssd_scan(_flip(xs), _flip(dt[:, :, 1]), a[1], _flip(bm), _flip(cm), init[1])
    y = y_f + _flip(y_b) + d_skip.astype(jnp.float32)[:, None] * xs
    gsz = SSD_WIDTH // SSD_GROUPS
    y = y.reshape(bsz, seq, SSD_GROUPS, gsz) * jax.nn.silu(z).reshape(bsz, seq, SSD_GROUPS, gsz)
    y = rms_norm(y, norm_g.reshape(SSD_GROUPS, gsz))
    return y.reshape(bsz, seq, SSD_WIDTH), (fin_f, fin_b)


def gla_scan(q, k, v, lg, init):
    bsz, seq, nh, dk = q.shape
    dv = v.shape[-1]
    T = GLA_CHUNK
    nc = seq // T
    q = q.reshape(bsz, nc, T, nh, dk) * (dk ** -0.5)
    k = k.reshape(bsz, nc, T, nh, dk)
    v = v.reshape(bsz, nc, T, nh, dv)
    cs = jnp.cumsum(lg.reshape(bsz, nc, T, nh, dk), axis=2)
    q_dec = q * jnp.exp(cs)
    att = jnp.einsum('bcihd,bcjhd->bchij', q_dec, k * jnp.exp(-cs))
    att = jnp.where(jnp.tril(jnp.ones((T, T), bool)), att, 0.0)
    o_intra = jnp.einsum('bchij,bcjhe->bcihe', att, v)
    u = jnp.einsum('bcthd,bcthe->bchde', k * jnp.exp(cs[:, :, -1:] - cs), v)
    chunk_decay = jnp.exp(cs[:, :, -1])

    def step(state, inp):
        d, uc = inp
        return d[..., None] * state + uc, state

    final, starts = lax.scan(step, init, (jnp.moveaxis(chunk_decay, 1, 0), jnp.moveaxis(u, 1, 0)))
    starts = jnp.moveaxis(starts, 0, 1)
    o_inter = jnp.einsum('bcthd,bchde->bcthe', q_dec, starts)
    return (o_intra + o_inter).reshape(bsz, seq, nh, dv), final


def gla_mixer(q, k, v, g, g_lr, gate_w, gate_b, norm_g, init):
    bsz, seq, _ = q.shape
    lr = g_lr.reshape(bsz, seq, 2, GLA_RANK)
    logits = jnp.einsum('bldr,drk->bldk', lr, gate_w.astype(jnp.float32)) + gate_b.astype(jnp.float32)
    lg = (jax.nn.log_sigmoid(logits) / GLA_GATE_NORMALIZER).reshape(bsz, seq, 2, GLA_HEADS, GLA_KEY_DIM)
    qh = q.reshape(bsz, seq, GLA_HEADS, GLA_KEY_DIM)
    kh = k.reshape(bsz, seq, GLA_HEADS, GLA_KEY_DIM)
    vh = v.reshape(bsz, seq, GLA_HEADS, GLA_VAL_DIM)
    o_f, fin_f = gla_scan(qh, kh, vh, lg[:, :, 0], init[0])
    o_b, fin_b = gla_scan(_flip(qh), _flip(kh), _flip(vh), _flip(lg[:, :, 1]), init[1])
    o = rms_norm(o_f + _flip(o_b), norm_g.reshape(GLA_HEADS, GLA_VAL_DIM)).reshape(bsz, seq, GLA_V)
    return o * jax.nn.silu(g), (fin_f, fin_b)


def even_layer(x, xc, c, c_ctx, norm_g, mod_w, mod_b, w_in, conv_w, conv_b, dt_bias, a_log, d_skip,
               ssd_norm, gla_gate_w, gla_gate_b, gla_norm, w_out, update_ctx):
    f32 = jnp.float32

    def branch_inputs(stream, cvec):
        shift, scale, gate = adaln(cvec, mod_w, mod_b)
        h = rms_norm(stream, norm_g) * (1 + scale) + shift
        return [p.astype(f32) for p in split_cols(jnp.dot(h, w_in), E_SPLITS)], gate

    def mixers(parts, ssd_init, gla_init):
        z, xbc, dt_raw, q, k, v, g, g_lr = parts
        y_ssd, ssd_fin = ssd_mixer(z, xbc, dt_raw, conv_w, conv_b, dt_bias, a_log, d_skip, ssd_norm, ssd_init)
        y_gla, gla_fin = gla_mixer(q, k, v, g, g_lr, gla_gate_w, gla_gate_b, gla_norm, gla_init)
        return jnp.concatenate([y_ssd, y_gla], axis=-1), ssd_fin, gla_fin

    bsz = x.shape[0]
    ssd0 = jnp.zeros((bsz, SSD_GROUPS, SSD_HEADS // SSD_GROUPS, SSD_HEAD_DIM, SSD_STATE), f32)
    gla0 = jnp.zeros((bsz, GLA_HEADS, GLA_KEY_DIM, GLA_VAL_DIM), f32)
    ctx_parts, ctx_gate = branch_inputs(xc, c_ctx[None])
    y_c, ssd_fin, gla_fin = mixers(ctx_parts, (ssd0, ssd0), (gla0, gla0))
    lat_parts, lat_gate = branch_inputs(x, c)
    y, _, _ = mixers(lat_parts, ssd_fin, gla_fin)
    x = x + (lat_gate * jnp.dot(y, w_out)).astype(x.dtype)
    if update_ctx:
        xc = xc + (ctx_gate * jnp.dot(y_c, w_out)).astype(xc.dtype)
    return x, xc


def axial_rope_tables(seq):
    rows = seq // GRID_W
    row = jnp.repeat(jnp.arange(rows, dtype=jnp.float32), GRID_W)
    col = jnp.tile(jnp.arange(GRID_W, dtype=jnp.float32), rows)
    inv = 1.0 / (ROPE_BASE ** (jnp.arange(ROPE_FREQS, dtype=jnp.float32) / ROPE_FREQS))
    ang = jnp.stack([row[:, None] * inv, col[:, None] * inv], axis=1)
    return jnp.cos(ang), jnp.sin(ang)


def apply_axial_rope(t, cos, sin):
    bsz, seq, nh, dh = t.shape
    t = t.reshape(bsz, seq, nh, 2, 2, ROPE_FREQS)
    t1, t2 = t[..., 0, :], t[..., 1, :]
    cs = cos[None, :, None]
    sn = sin[None, :, None]
    return jnp.stack([t1 * cs - t2 * sn, t2 * cs + t1 * sn], axis=-2).reshape(bsz, seq, nh, dh)


def _heads(t, n):
    return t.reshape(t.shape[0], t.shape[1], n, ATT_HEAD_DIM)


def band_blocks(t, nb):
    tp = jnp.pad(t, ((0, 0), (ATT_BLOCK, ATT_BLOCK), (0, 0), (0, 0)))
    tp = tp.reshape(t.shape[0], nb + 2, ATT_BLOCK, t.shape[2], t.shape[3])
    return jnp.concatenate([tp[:, :-2], tp[:, 1:-1], tp[:, 2:]], axis=2)


def band_mask(nb, seq):
    qpos = jnp.arange(nb)[:, None] * ATT_BLOCK + jnp.arange(ATT_BLOCK)[None]
    kpos = (jnp.arange(nb)[:, None] - 1) * ATT_BLOCK + jnp.arange(3 * ATT_BLOCK)[None]
    inside = (kpos >= 0) & (kpos < seq)
    return (jnp.abs(qpos[:, :, None] - kpos[:, None, :]) <= WINDOW) & inside[:, None, :]


def attend_with_sink(qb, key_sets, sink):
    scores = []
    for k, _, mask in key_sets:
        spec = 'bnqhgd,bnkhd->bnhgqk' if k.ndim == 5 else 'bnqhgd,bkhd->bnhgqk'
        s = jnp.einsum(spec, qb, k)
        if mask is not None:
            s = jnp.where(mask[None, :, None, None], s, -jnp.inf)
        scores.append(s)
    sink_l = sink.reshape(ATT_KV_HEADS, ATT_GROUP)[None, None, :, :, None, None]
    m = sink_l
    for s in scores:
        m = jnp.maximum(m, jnp.max(s, axis=-1, keepdims=True))
    denom = jnp.exp(sink_l - m)[..., 0]
    out = 0.0
    for s, (_, v, _) in zip(scores, key_sets):
        p = jnp.exp(s - m)
        denom = denom + jnp.sum(p, axis=-1)
        spec = 'bnhgqk,bnkhd->bnqhgd' if v.ndim == 5 else 'bnhgqk,bkhd->bnqhgd'
        out = out + jnp.einsum(spec, p, v)
    return out / jnp.moveaxis(denom, -1, 2)[..., None]


def odd_layer(x, xc, c, c_ctx, norm_g, mod_w, mod_b, w_in, q_norm, k_norm, sink, w_out, update_ctx):
    f32 = jnp.float32
    bsz, seq, _ = x.shape
    n_ctx = xc.shape[1]
    scale = ATT_HEAD_DIM ** -0.5
    sink = sink.astype(f32)
    c_shift, c_scale, c_gate = adaln(c_ctx[None], mod_w, mod_b)
    hc = rms_norm(xc, norm_g) * (1 + c_scale) + c_shift
    k_c, v_c = split_cols(jnp.dot(hc, w_in[:, :2 * ATT_KV_W]), (ATT_KV_W, ATT_KV_W))
    k_c = rms_norm(_heads(k_c, ATT_KV_HEADS), k_norm).astype(f32)
    v_c = _heads(v_c, ATT_KV_HEADS).astype(f32)
    shift, mscale, gate = adaln(c, mod_w, mod_b)
    h = rms_norm(x, norm_g) * (1 + mscale) + shift
    k, v, q, g = split_cols(jnp.dot(h, w_in), (ATT_KV_W, ATT_KV_W, ATT_W, ATT_W))
    cos, sin = axial_rope_tables(seq)
    q = apply_axial_rope(rms_norm(_heads(q, ATT_HEADS), q_norm).astype(f32), cos, sin)
    k = apply_axial_rope(rms_norm(_heads(k, ATT_KV_HEADS), k_norm).astype(f32), cos, sin)
    v = _heads(v, ATT_KV_HEADS).astype(f32)
    nb = seq // ATT_BLOCK
    qb = (q * scale).reshape(bsz, nb, ATT_BLOCK, ATT_KV_HEADS, ATT_GROUP, ATT_HEAD_DIM)
    o = attend_with_sink(qb, [(band_blocks(k, nb), band_blocks(v, nb), band_mask(nb, seq)), (k_c, v_c, None)], sink)
    o = o.reshape(bsz, seq, ATT_W) * jax.nn.silu(g.astype(f32))
    x = x + (gate * jnp.dot(o, w_out)).astype(x.dtype)
    if update_ctx:
        q_c, g_c = split_cols(jnp.dot(hc, w_in[:, 2 * ATT_KV_W:]), (ATT_W, ATT_W))
        q_c = rms_norm(_heads(q_c, ATT_HEADS), q_norm).astype(f32) * scale
        o_c = attend_with_sink(q_c.reshape(bsz, 1, n_ctx, ATT_KV_HEADS, ATT_GROUP, ATT_HEAD_DIM), [(k_c, v_c, None)], sink)
        o_c = o_c.reshape(bsz, n_ctx, ATT_W) * jax.nn.silu(g_c.astype(f32))
        xc = xc + (c_gate * jnp.dot(o_c, w_out)).astype(xc.dtype)
    return x, xc


def setup_inputs(seed: int = 0) -> dict:
    key = jax.random.key(seed)
    keys = list(jax.random.split(key, 32))
    f32 = jnp.float32

    def normal(shape, s):
        return jax.random.normal(keys.pop(), shape, f32) * s

    def gain(shape):
        return 1.0 + normal(shape, 0.02)

    E, O, D = N_EVEN, N_ODD, D_MODEL
    dt0 = jnp.exp(jax.random.uniform(keys.pop(), (E, 2, SSD_HEADS), f32, math.log(1e-3), math.log(1e-1)))
    a_log = jnp.log(jax.random.uniform(keys.pop(), (E, 2, SSD_HEADS), f32, 1.0, 16.0))
    return {
        'x': normal((BATCH, SEQ, D), 1.0),
        'c': normal((BATCH, D), 1.0),
        'ctx': normal((BATCH, CTX_LEN, D), 1.0),
        'c_ctx': normal((D,), 1.0),
        'e_norm': gain((E, D)),
        'e_mod_w': normal((E, D, 3 * D), 0.5 * D ** -0.5),
        'e_mod_b': normal((E, 3 * D), 0.02),
        'e_w_in': normal((E, D, E_IN), D ** -0.5),
        'e_conv_w': normal((E, CONV_K, CONV_CH), CONV_K ** -0.5),
        'e_conv_b': normal((E, CONV_CH), 0.02),
        'e_dt_bias': dt0 + jnp.log(-jnp.expm1(-dt0)),
        'e_a_log': a_log,
        'e_d_skip': gain((E, SSD_HEADS)),
        'e_ssd_norm': gain((E, SSD_WIDTH)),
        'e_gla_gate_w': normal((E, 2, GLA_RANK, GLA_K), GLA_RANK ** -0.5),
        'e_gla_gate_b': normal((E, 2, GLA_K), 0.1),
        'e_gla_norm': gain((E, GLA_V)),
        'e_w_out': normal((E, E_MIX, D), E_MIX ** -0.5),
        'o_norm': gain((O, D)),
        'o_mod_w': normal((O, D, 3 * D), 0.5 * D ** -0.5),
        'o_mod_b': normal((O, 3 * D), 0.02),
        'o_w_in': normal((O, D, O_IN), D ** -0.5),
        'o_q_norm': gain((O, ATT_HEAD_DIM)),
        'o_k_norm': gain((O, ATT_HEAD_DIM)),
        'o_sink': normal((O, ATT_HEADS), 0.5),
        'o_w_out': normal((O, ATT_W, D), ATT_W ** -0.5),
    }


def reference(x, c, ctx, c_ctx, e_norm, e_mod_w, e_mod_b, e_w_in, e_conv_w, e_conv_b, e_dt_bias, e_a_log,
              e_d_skip, e_ssd_norm, e_gla_gate_w, e_gla_gate_b, e_gla_norm, e_w_out, o_norm, o_mod_w, o_mod_b,
              o_w_in, o_q_norm, o_k_norm, o_sink, o_w_out):
    xc = ctx
    for i in range(DEPTH):
        update_ctx = i < DEPTH - 1
        j = i // 2
        if i % 2 == 0:
            x, xc = even_layer(x, xc, c, c_ctx, e_norm[j], e_mod_w[j], e_mod_b[j], e_w_in[j], e_conv_w[j],
                               e_conv_b[j], e_dt_bias[j], e_a_log[j], e_d_skip[j], e_ssd_norm[j],
                               e_gla_gate_w[j], e_gla_gate_b[j], e_gla_norm[j], e_w_out[j], update_ctx)
        else:
            x, xc = odd_layer(x, xc, c, c_ctx, o_norm[j], o_mod_w[j], o_mod_b[j], o_w_in[j], o_q_norm[j],
                              o_k_norm[j], o_sink[j], o_w_out[j], update_ctx)
    return x
```

```cpp
#include <hip/hip_runtime.h>
#include <stdint.h>
#include <math.h>

typedef unsigned short bf16_t;
#define DEV __device__ __forceinline__

DEV float bf2f(bf16_t v) { return __uint_as_float(((unsigned)v) << 16); }
DEV bf16_t f2bf(float f) { unsigned u = __float_as_uint(f); u = (u + 0x7fffu + ((u >> 16) & 1u)) >> 16; return (bf16_t)u; }
DEV float siluf(float x) { return x / (1.f + __expf(-x)); }
DEV float softplusf(float x) { return x > 20.f ? x : log1pf(__expf(x)); }
DEV float logsigmoidf(float x) { return fminf(x, 0.f) - log1pf(__expf(-fabsf(x))); }

constexpr int D = 1024, NB = 2, SEQ = 8192, CTXL = 256;
constexpr int ML = NB * SEQ;
constexpr int MC = NB * CTXL;
constexpr int MA = ML + MC;
constexpr int NCH = MA / 128;
constexpr int E_IN = 5696, O_IN = 5120;
constexpr float EPS = 1e-6f;

constexpr size_t MiB = 1u << 20;
constexpr size_t WS_MOD = 1 * MiB;
constexpr size_t WS_ROPE = 1 * MiB + 128 * 1024;
constexpr size_t WS_SDEC = 1 * MiB + 256 * 1024;
constexpr size_t WS_GDEC = 1 * MiB + 384 * 1024;
constexpr size_t WS_SCR = 2 * MiB;
constexpr size_t WS_CB = 2 * MiB;
constexpr size_t WS_SDT = 20 * MiB;
constexpr size_t WS_SCS = 23 * MiB;
constexpr size_t WS_GCSC = 26 * MiB;
constexpr size_t WS_Y0 = 32 * MiB;
constexpr size_t WS_Q0 = 98 * MiB;
constexpr size_t WS_K0 = WS_Q0 + 16 * MiB + 512 * 1024;
constexpr size_t WS_V0 = 131 * MiB;
constexpr size_t WS_DTLR = 164 * MiB;
constexpr size_t WS_XC1 = 168 * MiB + 512 * 1024;
constexpr size_t WS_XBC = 171 * MiB;
constexpr size_t WS_STATE = 171 * MiB;
constexpr size_t WS_H1 = 32 * MiB;
constexpr size_t WS_K1 = 65 * MiB;
constexpr size_t WS_V1 = 81 * MiB + 512 * 1024;
constexpr size_t WS_Q1 = 98 * MiB;
constexpr size_t WS_G1 = 171 * MiB;

DEV int row_vec(int row) { return row < ML ? (row / SEQ) : 2; }

template <int NT> DEV float block_sum(float v, float* red) {
#pragma unroll
  for (int o = 32; o > 0; o >>= 1) v += __shfl_xor(v, o);
  __syncthreads();
  if ((threadIdx.x & 63) == 0) red[threadIdx.x >> 6] = v;
  __syncthreads();
  float s = 0.f;
#pragma unroll
  for (int i = 0; i < NT / 64; ++i) s += red[i];
  return s;
}
template <int NT> DEV float block_max(float v, float* red) {
#pragma unroll
  for (int o = 32; o > 0; o >>= 1) v = fmaxf(v, __shfl_xor(v, o));
  __syncthreads();
  if ((threadIdx.x & 63) == 0) red[threadIdx.x >> 6] = v;
  __syncthreads();
  float s = -INFINITY;
#pragma unroll
  for (int i = 0; i < NT / 64; ++i) s = fmaxf(s, red[i]);
  return s;
}

__global__ void __launch_bounds__(256) k_adaln(const float* c, const float* cctx, const float* w0, const float* b0, const float* w1, const float* b1, float* mod) {
  int idx = blockIdx.x * 256 + threadIdx.x;
  int l = idx / 3072, n = idx % 3072;
  const float* w = l ? w1 : w0; const float* bb = l ? b1 : b0;
  float a0 = 0.f, a1 = 0.f, a2 = 0.f;
  for (int k = 0; k < D; ++k) {
    float wv = w[(size_t)k * 3072 + n];
    a0 += siluf(c[k]) * wv; a1 += siluf(c[D + k]) * wv; a2 += siluf(cctx[k]) * wv;
  }
  float bv = bb[n];
  mod[(l * 3 + 0) * 3072 + n] = a0 + bv; mod[(l * 3 + 1) * 3072 + n] = a1 + bv; mod[(l * 3 + 2) * 3072 + n] = a2 + bv;
}

__global__ void __launch_bounds__(256) k_rope(float* rope) {
  int idx = blockIdx.x * 256 + threadIdx.x;
  if (idx >= 128 * 32) return;
  int pos = idx / 32, f = idx % 32;
  float inv = 1.0f / powf(10000.f, (float)f / 32.f);
  float ang = (float)pos * inv;
  rope[idx] = cosf(ang); rope[4096 + idx] = sinf(ang);
}

__global__ void __launch_bounds__(256) k_prep(const float* xlat, const float* xctx, const float* g, const float* mod  , bf16_t* H) {
  __shared__ float red[4];
  int row = blockIdx.x;
  const float* src = row < ML ? xlat + (size_t)row * D : xctx + (size_t)(row - ML) * D;
  const float* m = mod + row_vec(row) * 3072;
  float v[4]; float ss = 0.f;
#pragma unroll
  for (int i = 0; i < 4; ++i) { v[i] = src[threadIdx.x + 256 * i]; ss += v[i] * v[i]; }
  ss = block_sum<256>(ss, red);
  float rstd = rsqrtf(ss / D + EPS);
#pragma unroll
  for (int i = 0; i < 4; ++i) { int k = threadIdx.x + 256 * i; H[(size_t)row * D + k] = f2bf(v[i] * rstd * g[k] * (1.f + m[1024 + k]) + m[k]); }
}

struct EpiProj0 { bf16_t *Y0, *XBC, *Q0, *K0, *V0; float* DTLR;
  DEV void operator()(int m, int n, float v) const {
    if (n < 1024) Y0[(size_t)m * 2048 + n] = f2bf(siluf(v));
    else if (n < 2560) XBC[(size_t)m * 1536 + (n - 1024)] = f2bf(v);
    else if (n < 2592) DTLR[(size_t)m * 64 + (n - 2560)] = v;
    else if (n < 3104) Q0[(size_t)m * 512 + (n - 2592)] = f2bf(v);
    else if (n < 3616) K0[(size_t)m * 512 + (n - 3104)] = f2bf(v);
    else if (n < 4640) V0[(size_t)m * 1024 + (n - 3616)] = f2bf(v);
    else if (n < 5664) Y0[(size_t)m * 2048 + 1024 + (n - 4640)] = f2bf(siluf(v));
    else DTLR[(size_t)m * 64 + 32 + (n - 5664)] = v;
  } };
struct EpiOut0 { const float* x; const float* ctx; const float* mod; float* X1; float* XC1;
  DEV void operator()(int m, int n, float v) const {
    float gate = mod[row_vec(m) * 3072 + 2048 + n];
    if (m < ML) X1[(size_t)m * D + n] = x[(size_t)m * D + n] + gate * v;
    else XC1[(size_t)(m - ML) * D + n] = ctx[(size_t)(m - ML) * D + n] + gate * v;
  } };
struct EpiProj1 { bf16_t *K1, *V1, *Q1, *G1;
  DEV void operator()(int m, int n, float v) const {
    if (n < 512) K1[(size_t)m * 512 + n] = f2bf(v);
    else if (n < 1024) V1[(size_t)m * 512 + (n - 512)] = f2bf(v);
    else if (m < ML) { if (n < 3072) Q1[(size_t)m * 2048 + (n - 1024)] = f2bf(v); else G1[(size_t)m * 2048 + (n - 3072)] = f2bf(siluf(v)); }
  } };
struct EpiOut1 { const float* mod; float* out;
  DEV void operator()(int m, int n, float v) const { float gate = mod[row_vec(m) * 3072 + 2048 + n]; out[(size_t)m * D + n] += gate * v; } };

template <class Epi> __global__ void __launch_bounds__(256) k_gemm(const bf16_t* A, int lda, const float* W, int N, int K, Epi epi) {
  int n = blockIdx.x * 256 + threadIdx.x; int m0 = blockIdx.y * 8;
  if (n >= N) return;
  float acc[8];
#pragma unroll
  for (int i = 0; i < 8; ++i) acc[i] = 0.f;
  for (int k = 0; k < K; ++k) {
    float w = W[(size_t)k * N + n];
#pragma unroll
    for (int i = 0; i < 8; ++i) acc[i] += bf2f(A[(size_t)(m0 + i) * lda + k]) * w;
  }
#pragma unroll
  for (int i = 0; i < 8; ++i) epi(m0 + i, n, acc[i]);
}

__global__ void __launch_bounds__(256) k_ssd_conv(const bf16_t* XBC, const float* cw  , const float* cb, bf16_t* XC) {
  int ch = blockIdx.x * 256 + threadIdx.x; int row = blockIdx.y;
  int t, len, base;
  if (row < ML) { t = row % SEQ; len = SEQ; base = row - t; } else { t = (row - ML) % CTXL; len = CTXL; base = row - t; }
  float a = cb[ch];
#pragma unroll
  for (int k = 0; k < 5; ++k) { int tt = t + k - 2; if (tt >= 0 && tt < len) a += cw[k * 1536 + ch] * bf2f(XBC[(size_t)(base + tt) * 1536 + ch]); }
  XC[(size_t)row * 1536 + ch] = f2bf(siluf(a));
}
__global__ void __launch_bounds__(256) k_ssd_dt(const float* DTLR, const float* dt_bias, const float* a_log, float* SDT, float* SCS, float* SDEC) {
  int idx = blockIdx.x * 256 + threadIdx.x; if (idx >= NCH * 32) return;
  int gc = idx / 32, col = idx % 32, dir = col / 16, h = col % 16;
  float a = -__expf(a_log[col]); float bias = dt_bias[col];
  float cs = 0.f;
  for (int s = 0; s < 128; ++s) {
    int t = dir ? 127 - s : s; size_t row = (size_t)gc * 128 + t;
    float dt = softplusf(DTLR[row * 64 + col] + bias);
    cs += dt * a;
    SDT[row * 32 + col] = dt; SCS[row * 32 + col] = cs;
  }
  SDEC[(gc * 16 + h) * 2 + dir] = __expf(cs);
}
__global__ void __launch_bounds__(256) k_ssd_cb(const bf16_t* XC, float* CB) {
  __shared__ float cs[128];
  int gc = blockIdx.x / 256, g = (blockIdx.x / 128) & 1, i = blockIdx.x & 127;
  int j = threadIdx.x & 127, half = threadIdx.x >> 7;
  size_t r0 = (size_t)gc * 128;
  if (threadIdx.x < 128) cs[threadIdx.x] = bf2f(XC[(r0 + i) * 1536 + 1280 + g * 128 + threadIdx.x]);
  __syncthreads();
  float a = 0.f;
  for (int n = half * 64; n < half * 64 + 64; ++n) a += cs[n] * bf2f(XC[(r0 + j) * 1536 + 1024 + g * 128 + n]);
  __shared__ float part[256];
  part[threadIdx.x] = a; __syncthreads();
  if (threadIdx.x < 128) CB[(((size_t)gc * 2 + g) * 128 + i) * 128 + j] = part[j] + part[128 + j];
}
__global__ void __launch_bounds__(256) k_ssd_u(const bf16_t* XC, const float* SDT, const float* SCS, bf16_t* ST) {
  __shared__ float w[128];
  int gc = blockIdx.x / 32, h = (blockIdx.x / 2) & 15, dir = blockIdx.x & 1; int g = h / 8;
  size_t r0 = (size_t)gc * 128; int col = dir * 16 + h;
  float cs_end = SCS[(r0 + (dir ? 0 : 127)) * 32 + col];
  if (threadIdx.x < 128) w[threadIdx.x] = __expf(cs_end - SCS[(r0 + threadIdx.x) * 32 + col]) * SDT[(r0 + threadIdx.x) * 32 + col];
  __syncthreads();
  int n = threadIdx.x & 127, ph = threadIdx.x >> 7;
  for (int p = ph; p < 64; p += 2) {
    float a = 0.f;
    for (int t = 0; t < 128; ++t) a += w[t] * bf2f(XC[(r0 + t) * 1536 + h * 64 + p]) * bf2f(XC[(r0 + t) * 1536 + 1024 + g * 128 + n]);
    ST[((((size_t)gc * 16 + h) * 2 + dir) * 64 + p) * 128 + n] = f2bf(a);
  }
}
__global__ void __launch_bounds__(256) k_ssd_scan(bf16_t* ST, const float* SDEC) {
  int idx = blockIdx.x * 256 + threadIdx.x;
  int e = idx & 8191, dir = (idx >> 13) & 1, h = (idx >> 14) & 15, b = idx >> 18;
  float S = 0.f;
  for (int s = 0; s < 66; ++s) {
    int gc;
    if (!dir) gc = s < 2 ? 128 + 2 * b + s : b * 64 + (s - 2);
    else gc = s < 2 ? 128 + 2 * b + (1 - s) : b * 64 + (65 - s);
    size_t off = (((size_t)gc * 16 + h) * 2 + dir) * 8192 + e;
    float u = bf2f(ST[off]); ST[off] = f2bf(S);
    S = SDEC[(gc * 16 + h) * 2 + dir] * S + u;
  }
}
__global__ void __launch_bounds__(512) k_ssd_y(const bf16_t* XC, const float* CB, const float* SDT, const float* SCS, const bf16_t* ST, const float* d_skip, const float* norm_g, bf16_t* Y0) {
  __shared__ float cbr[128]; __shared__ float crow[128]; __shared__ float red[8];
  int row = blockIdx.x >> 1, g = blockIdx.x & 1; int gc = row >> 7, i = row & 127; size_t r0 = (size_t)gc * 128;
  int hh = threadIdx.x >> 6, p = threadIdx.x & 63, h = g * 8 + hh;
  if (threadIdx.x < 128) { cbr[threadIdx.x] = CB[(((size_t)gc * 2 + g) * 128 + i) * 128 + threadIdx.x]; crow[threadIdx.x] = bf2f(XC[(size_t)row * 1536 + 1280 + g * 128 + threadIdx.x]); }
  __syncthreads();
  float csf_i = SCS[(size_t)row * 32 + h], csb_i = SCS[(size_t)row * 32 + 16 + h];
  float acc = 0.f;
  for (int j = 0; j <= i; ++j) acc += cbr[j] * __expf(csf_i - SCS[(r0 + j) * 32 + h]) * SDT[(r0 + j) * 32 + h] * bf2f(XC[(r0 + j) * 1536 + h * 64 + p]);
  for (int j = i; j < 128; ++j) acc += cbr[j] * __expf(csb_i - SCS[(r0 + j) * 32 + 16 + h]) * SDT[(r0 + j) * 32 + 16 + h] * bf2f(XC[(r0 + j) * 1536 + h * 64 + p]);
  const bf16_t* Sf = ST + ((((size_t)gc * 16 + h) * 2 + 0) * 64 + p) * 128; const bf16_t* Sb = Sf + 8192;
  float of = 0.f, ob = 0.f;
  for (int n = 0; n < 128; ++n) { of += crow[n] * bf2f(Sf[n]); ob += crow[n] * bf2f(Sb[n]); }
  acc += __expf(csf_i) * of + __expf(csb_i) * ob;
  acc += d_skip[h] * bf2f(XC[(size_t)row * 1536 + h * 64 + p]);
  size_t yo = (size_t)row * 2048 + g * 512 + threadIdx.x;
  acc *= bf2f(Y0[yo]);
  float ss = block_sum<512>(acc * acc, red);
  Y0[yo] = f2bf(acc * rsqrtf(ss / 512.f + EPS) * norm_g[g * 512 + threadIdx.x]);
}

DEV float* gcs_ptr(float* lat, float* ctx, size_t row) { return row < (size_t)ML ? lat + row * 1024 : ctx + (row - ML) * 1024; }
__global__ void __launch_bounds__(256) k_gla_cs(const float* DTLR, const float* gw  , const float* gb  , float* GCSL, float* GCSC, float* GDEC) {
  int idx = blockIdx.x * 256 + threadIdx.x; if (idx >= NCH * 1024) return;
  int gc = idx / 1024, dk = idx % 1024, dir = dk / 512, k = dk % 512;
  float wv[16];
#pragma unroll
  for (int r = 0; r < 16; ++r) wv[r] = gw[(dir * 16 + r) * 512 + k];
  float bias = gb[dir * 512 + k], cs = 0.f;
  for (int s = 0; s < 128; ++s) {
    int t = dir ? 127 - s : s; size_t row = (size_t)gc * 128 + t;
    float lg = bias;
#pragma unroll
    for (int r = 0; r < 16; ++r) lg += DTLR[row * 64 + 32 + dir * 16 + r] * wv[r];
    cs += logsigmoidf(lg) * (1.f / 16.f);
    gcs_ptr(GCSL, GCSC, row)[dk] = cs;
  }
  GDEC[((gc * 4 + k / 128) * 2 + dir) * 128 + (k & 127)] = __expf(cs);
}
__global__ void __launch_bounds__(256) k_gla_u(const bf16_t* K0, const bf16_t* V0, float* GCSL, float* GCSC, bf16_t* ST) {
  int bid = blockIdx.x; int ep = bid & 127; bid >>= 7; int dir = bid & 1; bid >>= 1; int h = bid & 3; int gc = bid >> 2;
  int d = threadIdx.x & 127, e = ep * 2 + (threadIdx.x >> 7);
  size_t r0 = (size_t)gc * 128;
  float cs_end = gcs_ptr(GCSL, GCSC, r0 + (dir ? 0 : 127))[dir * 512 + h * 128 + d];
  float a = 0.f;
  for (int t = 0; t < 128; ++t) {
    float cs = gcs_ptr(GCSL, GCSC, r0 + t)[dir * 512 + h * 128 + d];
    a += bf2f(K0[(r0 + t) * 512 + h * 128 + d]) * __expf(cs_end - cs) * bf2f(V0[(r0 + t) * 1024 + h * 256 + e]);
  }
  ST[((((size_t)gc * 4 + h) * 2 + dir) * 256 + e) * 128 + d] = f2bf(a);
}
__global__ void __launch_bounds__(256) k_gla_scan(bf16_t* ST, const float* GDEC) {
  int idx = blockIdx.x * 256 + threadIdx.x;
  int e = idx & 32767, dir = (idx >> 15) & 1, h = (idx >> 16) & 3, b = idx >> 18;
  int d = e & 127;
  float S = 0.f;
  for (int s = 0; s < 66; ++s) {
    int gc;
    if (!dir) gc = s < 2 ? 128 + 2 * b + s : b * 64 + (s - 2);
    else gc = s < 2 ? 128 + 2 * b + (1 - s) : b * 64 + (65 - s);
    size_t off = (((size_t)gc * 4 + h) * 2 + dir) * 32768 + e;
    float u = bf2f(ST[off]); ST[off] = f2bf(S);
    S = GDEC[((gc * 4 + h) * 2 + dir) * 128 + d] * S + u;
  }
}
__global__ void __launch_bounds__(256) k_gla_o(const bf16_t* Q0, const bf16_t* K0, const bf16_t* V0, float* GCSL, float* GCSC, const bf16_t* ST, const float* norm_g, bf16_t* Y0) {
  __shared__ float q[128]; __shared__ float csi[2][128]; __shared__ float att[2][128]; __shared__ float red[4];
  int row = blockIdx.x >> 2, h = blockIdx.x & 3; int gc = row >> 7, i = row & 127; size_t r0 = (size_t)gc * 128;
  const float scale = 0.08838834764831845f;
  if (threadIdx.x < 128) q[threadIdx.x] = bf2f(Q0[(size_t)row * 512 + h * 128 + threadIdx.x]) * scale;
  { int dir = threadIdx.x >> 7, d = threadIdx.x & 127; csi[dir][d] = gcs_ptr(GCSL, GCSC, row)[dir * 512 + h * 128 + d]; }
  __syncthreads();
  { int dir = threadIdx.x >> 7, j = threadIdx.x & 127; float a = 0.f;
    bool ok = dir ? (j >= i) : (j <= i);
    if (ok) { const float* csj = gcs_ptr(GCSL, GCSC, r0 + j) + dir * 512 + h * 128; const bf16_t* kj = K0 + (r0 + j) * 512 + h * 128;
      for (int d = 0; d < 128; ++d) a += q[d] * bf2f(kj[d]) * __expf(csi[dir][d] - csj[d]); }
    att[dir][j] = a; }
  __syncthreads();
  int e = threadIdx.x;
  float o = 0.f;
  for (int j = 0; j < 128; ++j) o += (att[0][j] + att[1][j]) * bf2f(V0[(r0 + j) * 1024 + h * 256 + e]);
  const bf16_t* Sf = ST + ((((size_t)gc * 4 + h) * 2 + 0) * 256 + e) * 128; const bf16_t* Sb = Sf + 32768;
  for (int d = 0; d < 128; ++d) o += q[d] * (__expf(csi[0][d]) * bf2f(Sf[d]) + __expf(csi[1][d]) * bf2f(Sb[d]));
  float ss = block_sum<256>(o * o, red);
  size_t yo = (size_t)row * 2048 + 1024 + h * 256 + e;
  Y0[yo] = f2bf(o * rsqrtf(ss / 256.f + EPS) * norm_g[h * 256 + e] * bf2f(Y0[yo]));
}

__global__ void __launch_bounds__(128) k_qknorm(bf16_t* Q1, bf16_t* K1, const float* qn, const float* kn, const float* rope) {
  __shared__ float red[2]; __shared__ float buf[128];
  int row = blockIdx.x, d = threadIdx.x;
  bool lat = row < ML; int t = lat ? row % SEQ : 0;
  int a = d >> 6, s = (d >> 5) & 1, f = d & 31; int pos = a ? (t & 63) : (t >> 6);
  float cs = rope[pos * 32 + f], sn = rope[4096 + pos * 32 + f];
  const float scale = 0.08838834764831845f;
  int nh = lat ? 20 : 4;
  for (int hh = 0; hh < nh; ++hh) {
    bool isq = hh >= 4; bf16_t* p = isq ? Q1 + (size_t)row * 2048 + (hh - 4) * 128 : K1 + (size_t)row * 512 + hh * 128;
    float v = bf2f(p[d]);
    float ss = block_sum<128>(v * v, red);
    v = v * rsqrtf(ss / 128.f + EPS) * (isq ? qn[d] : kn[d]);
    if (lat) { buf[d] = v; __syncthreads(); float o = buf[d ^ 32]; v = s ? (v * cs + o * sn) : (v * cs - o * sn); }
    if (isq) v *= scale;
    __syncthreads();
    p[d] = f2bf(v);
  }
}
__global__ void __launch_bounds__(512) k_attn(bf16_t* Q1, const bf16_t* K1, const bf16_t* V1, const bf16_t* G1, const float* sink) {
  __shared__ float q[4][128]; __shared__ float sc[4][648]; __shared__ float red[8]; __shared__ float den[4];
  int row = blockIdx.x >> 2, kvh = blockIdx.x & 3; int b = row / SEQ, t = row % SEQ;
  { int hq = threadIdx.x >> 7, d = threadIdx.x & 127; q[hq][d] = bf2f(Q1[(size_t)row * 2048 + (kvh * 4 + hq) * 128 + d]); }
  __syncthreads();
  int klo = t - 128 < 0 ? 0 : t - 128, khi = t + 128 > SEQ - 1 ? SEQ - 1 : t + 128; int nband = khi - klo + 1, nk = nband + CTXL;
  for (int ki = threadIdx.x; ki < nk; ki += 512) {
    size_t kr = ki < nband ? (size_t)b * SEQ + klo + ki : (size_t)ML + b * CTXL + (ki - nband);
    const bf16_t* kp = K1 + kr * 512 + kvh * 128;
    float a0 = 0.f, a1 = 0.f, a2 = 0.f, a3 = 0.f;
    for (int d = 0; d < 128; ++d) { float kv = bf2f(kp[d]); a0 += q[0][d] * kv; a1 += q[1][d] * kv; a2 += q[2][d] * kv; a3 += q[3][d] * kv; }
    sc[0][ki] = a0; sc[1][ki] = a1; sc[2][ki] = a2; sc[3][ki] = a3;
  }
  __syncthreads();
  for (int hq = 0; hq < 4; ++hq) {
    float sk = sink[kvh * 4 + hq];
    float m = -INFINITY;
    for (int ki = threadIdx.x; ki < nk; ki += 512) m = fmaxf(m, sc[hq][ki]);
    m = fmaxf(block_max<512>(m, red), sk);
    float s = 0.f;
    for (int ki = threadIdx.x; ki < nk; ki += 512) { float p = __expf(sc[hq][ki] - m); sc[hq][ki] = p; s += p; }
    s = block_sum<512>(s, red);
    if (threadIdx.x == 0) den[hq] = s + __expf(sk - m);
  }
  __syncthreads();
  int hq = threadIdx.x >> 7, d = threadIdx.x & 127;
  float o = 0.f;
  for (int ki = 0; ki < nk; ++ki) {
    size_t kr = ki < nband ? (size_t)b * SEQ + klo + ki : (size_t)ML + b * CTXL + (ki - nband);
    o += sc[hq][ki] * bf2f(V1[kr * 512 + kvh * 128 + d]);
  }
  size_t oo = (size_t)row * 2048 + (kvh * 4 + hq) * 128 + d;
  Q1[oo] = f2bf(o / den[hq] * bf2f(G1[oo]));
}

extern "C" void kernel_launch(void* const* d_in, const int* in_sizes, int n_in, void* d_out, int out_size, void* d_ws, size_t ws_size, hipStream_t stream) {
  const float* x = (const float*)d_in[0]; const float* c = (const float*)d_in[1]; const float* ctx = (const float*)d_in[2]; const float* cctx = (const float*)d_in[3];
  const float* e_norm = (const float*)d_in[4]; const float* e_mod_w = (const float*)d_in[5]; const float* e_mod_b = (const float*)d_in[6]; const float* e_w_in = (const float*)d_in[7];
  const float* e_conv_w = (const float*)d_in[8]; const float* e_conv_b = (const float*)d_in[9]; const float* e_dt_bias = (const float*)d_in[10]; const float* e_a_log = (const float*)d_in[11];
  const float* e_d_skip = (const float*)d_in[12]; const float* e_ssd_norm = (const float*)d_in[13]; const float* e_gate_w = (const float*)d_in[14]; const float* e_gate_b = (const float*)d_in[15];
  const float* e_gla_norm = (const float*)d_in[16]; const float* e_w_out = (const float*)d_in[17]; const float* o_norm = (const float*)d_in[18]; const float* o_mod_w = (const float*)d_in[19];
  const float* o_mod_b = (const float*)d_in[20]; const float* o_w_in = (const float*)d_in[21]; const float* o_q_norm = (const float*)d_in[22]; const float* o_k_norm = (const float*)d_in[23];
  const float* o_sink = (const float*)d_in[24]; const float* o_w_out = (const float*)d_in[25];
  char* ws = (char*)d_ws; float* out = (float*)d_out;
  float* MOD = (float*)(ws + WS_MOD); float* ROPE = (float*)(ws + WS_ROPE); float* SDEC = (float*)(ws + WS_SDEC); float* GDEC = (float*)(ws + WS_GDEC);
  float* CB = (float*)(ws + WS_CB); float* SDT = (float*)(ws + WS_SDT); float* SCS = (float*)(ws + WS_SCS); float* GCSC = (float*)(ws + WS_GCSC);
  bf16_t* Y0 = (bf16_t*)(ws + WS_Y0); bf16_t* Q0 = (bf16_t*)(ws + WS_Q0); bf16_t* K0 = (bf16_t*)(ws + WS_K0); bf16_t* V0 = (bf16_t*)(ws + WS_V0);
  float* DTLR = (float*)(ws + WS_DTLR); float* XC1 = (float*)(ws + WS_XC1); bf16_t* XBC = (bf16_t*)(ws + WS_XBC); bf16_t* ST = (bf16_t*)(ws + WS_STATE);
  bf16_t* H1 = (bf16_t*)(ws + WS_H1); bf16_t* K1 = (bf16_t*)(ws + WS_K1); bf16_t* V1 = (bf16_t*)(ws + WS_V1); bf16_t* Q1 = (bf16_t*)(ws + WS_Q1); bf16_t* G1 = (bf16_t*)(ws + WS_G1);
  bf16_t* H0 = (bf16_t*)d_out; bf16_t* XC = (bf16_t*)d_out; float* GCSL = (float*)d_out; float* X1 = (float*)d_out;

  k_adaln<<<24, 256, 0, stream>>>(c, cctx, e_mod_w, e_mod_b, o_mod_w, o_mod_b, MOD);
  k_rope<<<16, 256, 0, stream>>>(ROPE);
  k_prep<<<MA, 256, 0, stream>>>(x, ctx, e_norm, MOD, H0);
  k_gemm<EpiProj0><<<dim3((E_IN + 255) / 256, MA / 8), 256, 0, stream>>>(H0, D, e_w_in, E_IN, D, EpiProj0{Y0, XBC, Q0, K0, V0, DTLR});
  k_ssd_conv<<<dim3(6, MA), 256, 0, stream>>>(XBC, e_conv_w, e_conv_b, XC);
  k_ssd_dt<<<(NCH * 32 + 255) / 256, 256, 0, stream>>>(DTLR, e_dt_bias, e_a_log, SDT, SCS, SDEC);
  k_ssd_cb<<<NCH * 256, 256, 0, stream>>>(XC, CB);
  k_ssd_u<<<NCH * 32, 256, 0, stream>>>(XC, SDT, SCS, ST);
  k_ssd_scan<<<2 * 16 * 2 * 8192 / 256, 256, 0, stream>>>(ST, SDEC);
  k_ssd_y<<<MA * 2, 512, 0, stream>>>(XC, CB, SDT, SCS, ST, e_d_skip, e_ssd_norm, Y0);
  k_gla_cs<<<NCH * 1024 / 256, 256, 0, stream>>>(DTLR, e_gate_w, e_gate_b, GCSL, GCSC, GDEC);
  k_gla_u<<<NCH * 4 * 2 * 128, 256, 0, stream>>>(K0, V0, GCSL, GCSC, ST);
  k_gla_scan<<<2 * 4 * 2 * 32768 / 256, 256, 0, stream>>>(ST, GDEC);
  k_gla_o<<<MA * 4, 256, 0, stream>>>(Q0, K0, V0, GCSL, GCSC, ST, e_gla_norm, Y0);
  k_gemm<EpiOut0><<<dim3(D / 256, MA / 8), 256, 0, stream>>>(Y0, 2048, e_w_out, D, 2048, EpiOut0{x, ctx, MOD, X1, XC1});
  k_prep<<<MA, 256, 0, stream>>>(X1, XC1, o_norm, MOD + 3 * 3072, H1);
  k_gemm<EpiProj1><<<dim3(O_IN / 256, MA / 8), 256, 0, stream>>>(H1, D, o_w_in, O_IN, D, EpiProj1{K1, V1, Q1, G1});
  k_qknorm<<<MA, 128, 0, stream>>>(Q1, K1, o_q_norm, o_k_norm, ROPE);
  k_attn<<<ML * 4, 512, 0, stream>>>(Q1, K1, V1, G1, o_sink);
  k_gemm<EpiOut1><<<dim3(D / 256, ML / 8), 256, 0, stream>>>(Q1, 2048, o_w_out, D, 2048, EpiOut1{MOD + 3 * 3072, out});
}
```

```cpp
#include <hip/hip_runtime.h>
#include <hip/hip_cooperative_groups.h>
#include <stdint.h>
#include <math.h>
#include <cstdio>
namespace cg = cooperative_groups;

typedef unsigned short bf16_t;
#define DEV __device__ __forceinline__

DEV float bf2f(bf16_t v) { return __uint_as_float(((unsigned)v) << 16); }
DEV bf16_t f2bf(float f) { unsigned u = __float_as_uint(f); u = (u + 0x7fffu + ((u >> 16) & 1u)) >> 16; return (bf16_t)u; }
DEV unsigned pk2(float lo, float hi) { return (unsigned)f2bf(lo) | ((unsigned)f2bf(hi) << 16); }
DEV float siluf(float x) { return x / (1.f + __expf(-x)); }
DEV float silu_fast(float x) { return x * __builtin_amdgcn_rcpf(1.f + __expf(-x)); }
DEV float softplusf(float x) { return x > 20.f ? x : log1pf(__expf(x)); }
DEV float logsigmoidf(float x) { return fminf(x, 0.f) - log1pf(__expf(-fabsf(x))); }

constexpr int D = 1024, NB = 2, SEQ = 8192, CTXL = 256;
constexpr int ML = NB * SEQ;
constexpr int MC = NB * CTXL;
constexpr int MA = ML + MC;
constexpr int NCH = MA / 128;
constexpr int E_IN = 5696, O_IN = 5120, E_INP = 5888;
constexpr float EPS = 1e-6f;

constexpr size_t MiB = 1u << 20;
constexpr size_t WS_MOD = 1 * MiB;
constexpr size_t WS_ROPE = 1 * MiB + 128 * 1024;
constexpr size_t WS_SDEC = 1 * MiB + 256 * 1024;
constexpr size_t WS_GDEC = 1 * MiB + 384 * 1024;
constexpr size_t WS_W1T = 2 * MiB;
constexpr size_t WS_W2T = 14 * MiB;
constexpr size_t WS_W3T = 18 * MiB;
constexpr size_t WS_W4T = 28 * MiB;
constexpr size_t WS_Y0 = 32 * MiB;
constexpr size_t WS_Q0 = 98 * MiB;
constexpr size_t WS_K0 = WS_Q0 + 16 * MiB + 512 * 1024;
constexpr size_t WS_V0 = 131 * MiB;
constexpr size_t WS_DTLR = 164 * MiB;
constexpr size_t WS_XC1 = 168 * MiB + 512 * 1024;
constexpr size_t WS_XBC = 171 * MiB;
constexpr size_t WS_STATE = 171 * MiB;
constexpr size_t WS_TAIL = 237 * MiB;
constexpr size_t WS_H1 = 32 * MiB;
constexpr size_t WS_K1 = 65 * MiB;
constexpr size_t WS_V1 = 81 * MiB + 512 * 1024;
constexpr size_t WS_Q1 = 98 * MiB;
constexpr size_t WS_G1 = 171 * MiB;

DEV int row_vec(int row) { return row < ML ? (row / SEQ) : 2; }

template <int NT> DEV float block_sum(float v, float* red) {
#pragma unroll
  for (int o = 32; o > 0; o >>= 1) v += __shfl_xor(v, o);
  __syncthreads();
  if ((threadIdx.x & 63) == 0) red[threadIdx.x >> 6] = v;
  __syncthreads();
  float s = 0.f;
#pragma unroll
  for (int i = 0; i < NT / 64; ++i) s += red[i];
  return s;
}
template <int NT> DEV float block_max(float v, float* red) {
#pragma unroll
  for (int o = 32; o > 0; o >>= 1) v = fmaxf(v, __shfl_xor(v, o));
  __syncthreads();
  if ((threadIdx.x & 63) == 0) red[threadIdx.x >> 6] = v;
  __syncthreads();
  float s = -INFINITY;
#pragma unroll
  for (int i = 0; i < NT / 64; ++i) s = fmaxf(s, red[i]);
  return s;
}
namespace pg8 {
#define PG8_LAS __attribute__((address_space(3)))
typedef unsigned short bf16_t;
typedef short bf16x8 __attribute__((ext_vector_type(8)));
typedef float f32x4 __attribute__((ext_vector_type(4)));
typedef unsigned u32x4 __attribute__((ext_vector_type(4)));
constexpr int BM = 256, BK = 64, HALF = 128, HTB = HALF * BK * 2  , STAGE_BYTES = 8 * HTB, NXCD = 8, WGM = 8;

__host__ __device__ __forceinline__ int lds_byte(int r, int c) { const int st = (r >> 4) * 2 + (c >> 5), rr = r & 15, cc = c & 31, ob = rr * 64 + cc * 2; return st * 1024 + (ob ^ (((ob >> 9) & 1) << 5)); }
__host__ __device__ __forceinline__ void stage_rc(int b, int& R, int& C) { const int st = b / 1024, sb = b % 1024, swz = sb ^ (((sb >> 9) & 1) << 5); R = (st >> 1) * 16 + swz / 64; C = (st & 1) * 32 + (swz % 64) / 2; }
__host__ __device__ __forceinline__ int perm32(int rho) { const int n = rho >> 4, i = rho & 15; return 8 * (i >> 2) + 4 * n + (i & 3); }

struct Unit { int pm, pn; };
struct Gemm { const bf16_t* A; const bf16_t* Bt; int M, N, K; };

struct StaticOrder {
    int nM, nN, nwg, G, c;
    __host__ __device__ void init(int M, int N, int G_, int c_) { nM = M / BM; nN = N / BM; nwg = nM * nN; G = G_; c = c_; }
    __host__ __device__ bool next(int i, Unit& u) const {
        const long L = (long)i * G + c; if (L >= nwg) return false;
        int wgid = (int)L; { const int q = nwg / NXCD, r = nwg % NXCD, xcd = wgid % NXCD, off = wgid / NXCD; wgid = (xcd < r ? xcd * (q + 1) : r * (q + 1) + (xcd - r) * q) + off; }
        const int nig = WGM * nN, gid = wgid / nig, fm = gid * WGM, gsz = (nM - fm) < WGM ? (nM - fm) : WGM;
        u.pm = fm + ((wgid % nig) % gsz); u.pn = (wgid % nig) / gsz; return true;
    }
    __device__ __forceinline__ void a_ready(const Unit&) const {}
    __device__ __forceinline__ void done(const Unit&) const {}
};
__device__ __forceinline__ unsigned cvt_pk_bf16(float lo, float hi) { unsigned r; asm volatile("v_cvt_pk_bf16_f32 %0, %1, %2" : "=v"(r) : "v"(lo), "v"(hi)); return r; }
__device__ __forceinline__ float silu_e(float x) { return x * __builtin_amdgcn_rcpf(1.f + __expf(-x)); }

__device__ __forceinline__ void store_unit_bf16(const f32x4 (&acc)[2][2][4][2], bf16_t* base, int ld, int colt, bool act, const Unit& u, int wr, int wc, int fr, int fq) {
    const int row0 = u.pm * BM + wr * 64 + fr; const int col0 = colt + wc * 32 + 8 * fq;
#pragma unroll
    for (int ai = 0; ai < 2; ++ai)
#pragma unroll
        for (int m = 0; m < 4; ++m) { bf16_t* rowp = base + (size_t)(row0 + ai * HALF + m * 16) * ld + col0;
#pragma unroll
            for (int bj = 0; bj < 2; ++bj) { f32x4 v0 = acc[ai][bj][m][0], v1 = acc[ai][bj][m][1];
                if (act) { v0 = (f32x4){silu_e(v0[0]), silu_e(v0[1]), silu_e(v0[2]), silu_e(v0[3])}; v1 = (f32x4){silu_e(v1[0]), silu_e(v1[1]), silu_e(v1[2]), silu_e(v1[3])}; }
                u32x4 w; w.x = cvt_pk_bf16(v0[0], v0[1]); w.y = cvt_pk_bf16(v0[2], v0[3]); w.z = cvt_pk_bf16(v1[0], v1[1]); w.w = cvt_pk_bf16(v1[2], v1[3]);
                *(u32x4*)(rowp + bj * HALF) = w; } }
}
struct EpiProj0 {
    static constexpr bool PERM = true, AFTER_DRAIN = false;
    bf16_t *Y0, *XBC, *Q0, *K0, *V0; float* DTLR;
    __device__ __forceinline__ void operator()(const f32x4 (&acc)[2][2][4][2], const Unit& u, int wr, int wc, int fr, int fq) const {
        const int pn = u.pn;
        if (pn == 22) {
            if (wc < 2) { const int row0 = u.pm * BM + wr * 64 + fr;
#pragma unroll
                for (int ai = 0; ai < 2; ++ai)
#pragma unroll
                    for (int m = 0; m < 4; ++m) { float* rp = DTLR + (size_t)(row0 + ai * HALF + m * 16) * 64 + wc * 32 + 8 * fq; *(f32x4*)rp = acc[ai][0][m][0]; *(f32x4*)(rp + 4) = acc[ai][0][m][1]; } }
            return;
        }
        bf16_t* base; int ld, colt; bool act = false;
        if (pn < 8) { base = Y0; ld = 2048; colt = pn * 256; act = true; }
        else if (pn < 14) { base = XBC; ld = 1536; colt = (pn - 8) * 256; }
        else if (pn < 16) { base = Q0; ld = 512; colt = (pn - 14) * 256; }
        else if (pn < 18) { base = K0; ld = 512; colt = (pn - 16) * 256; }
        else { base = V0; ld = 1024; colt = (pn - 18) * 256; }
        store_unit_bf16(acc, base, ld, colt, act, u, wr, wc, fr, fq);
    }
};
struct EpiProj1 {
    static constexpr bool PERM = true, AFTER_DRAIN = false;
    bf16_t *K1, *V1, *Q1, *G1;
    __device__ __forceinline__ void operator()(const f32x4 (&acc)[2][2][4][2], const Unit& u, int wr, int wc, int fr, int fq) const {
        const int pn = u.pn; bf16_t* base; int ld, colt; bool act = false;
        if (pn < 2) { base = K1; ld = 512; colt = pn * 256; }
        else if (pn < 4) { base = V1; ld = 512; colt = (pn - 2) * 256; }
        else if (pn < 12) { base = Q1; ld = 2048; colt = (pn - 4) * 256; }
        else { base = G1; ld = 2048; colt = (pn - 12) * 256; act = true; }
        store_unit_bf16(acc, base, ld, colt, act, u, wr, wc, fr, fq);
    }
};
struct EpiResid {
    static constexpr bool PERM = false, AFTER_DRAIN = false;
    const float* res; float* out; const float* mod;
    __device__ __forceinline__ void operator()(const f32x4 (&acc)[2][2][4][2], const Unit& u, int wr, int wc, int fr, int fq) const {
        const int b = (u.pm * BM) / 8192; const float* gate = mod + b * 3072 + 2048;
        const int col0 = u.pn * BM + wc * 32 + 4 * fq;
        f32x4 gv[2][2];
#pragma unroll
        for (int bj = 0; bj < 2; ++bj)
#pragma unroll
            for (int n = 0; n < 2; ++n) gv[bj][n] = *(const f32x4*)(gate + col0 + bj * HALF + n * 16);
#pragma unroll
        for (int ai = 0; ai < 2; ++ai)
#pragma unroll
            for (int m = 0; m < 4; ++m) { const size_t off = (size_t)(u.pm * BM + ai * HALF + wr * 64 + m * 16 + fr) * 1024 + col0;
#pragma unroll
                for (int bj = 0; bj < 2; ++bj)
#pragma unroll
                    for (int n = 0; n < 2; ++n) { const f32x4 r = *(const f32x4*)(res + off + bj * HALF + n * 16); *(f32x4*)(out + off + bj * HALF + n * 16) = r + gv[bj][n] * acc[ai][bj][m][n]; } }
    }
};
template <class Epi, class Sched, bool ALIGN_EPI = false, bool SP2 = false>
__device__ __forceinline__ void gemm_phase(PG8_LAS unsigned char* lds, const Gemm g, const Sched& S, const Epi& E) {
    const int tid = threadIdx.x, wid = __builtin_amdgcn_readfirstlane(tid >> 6), lane = tid & 63, wr = wid >> 2, wc = wid & 3, fr = lane & 15, fq = lane >> 4;
    const int K = g.K, nt = K / BK;
    unsigned voffA[2], voffB[2];
#pragma unroll
    for (int i = 0; i < 2; ++i) { int R, C; stage_rc(tid * 16 + i * 8192, R, C); const int Rb = Epi::PERM ? ((R & ~31) + perm32(R & 31)) : R;
        voffA[i] = (unsigned)(R * K + C) * 2u; voffB[i] = (unsigned)(Rb * K + C) * 2u; }
    const size_t kstep = (size_t)(BK * 2);
    const size_t hstep = (size_t)HALF * K * 2;
    const size_t tstep = 2 * hstep;
    const unsigned ldsw = (unsigned)wid * 1024u;
    const int aoff = lds_byte(wr * 64 + fr, fq * 8), boff = lds_byte(wc * 32 + fr, fq * 8);
#define PG8_SA(b, h) (((b) * 2 + (h)) * HTB)
#define PG8_SB(b, h) ((4 + (b) * 2 + (h)) * HTB)
#define PG8_STAGE(bufoff, gbase, voff) do { _Pragma("unroll") for (int _i = 0; _i < 2; ++_i) \
        __builtin_amdgcn_global_load_lds((const unsigned*)((const char*)(gbase) + (voff)[_i]), (PG8_LAS unsigned*)(lds + (bufoff) + ldsw + _i * 8192), 16, 0, 0); } while (0)
#define PG8_LDA(dst, b, h) do { _Pragma("unroll") for (int m = 0; m < 4; ++m) _Pragma("unroll") for (int k = 0; k < 2; ++k) dst[m][k] = *(const PG8_LAS bf16x8*)(lds + PG8_SA(b, h) + aoff + m * 2048 + k * 1024); } while (0)
#define PG8_LDB(dst, b, h) do { _Pragma("unroll") for (int n = 0; n < 2; ++n) _Pragma("unroll") for (int k = 0; k < 2; ++k) dst[n][k] = *(const PG8_LAS bf16x8*)(lds + PG8_SB(b, h) + boff + n * 2048 + k * 1024); } while (0)
#define PG8_MMA(ai, bj, At, Bt) do { __builtin_amdgcn_s_setprio(1); _Pragma("unroll") for (int m = 0; m < 4; ++m) _Pragma("unroll") for (int n = 0; n < 2; ++n) _Pragma("unroll") for (int k = 0; k < 2; ++k) \
        acc[ai][bj][m][n] = __builtin_amdgcn_mfma_f32_16x16x32_bf16(Bt[n][k], At[m][k], acc[ai][bj][m][n], 0, 0, 0); __builtin_amdgcn_s_setprio(0); } while (0)
#define PG8_WAIT_V(n) asm volatile("s_waitcnt vmcnt(" #n ")" ::: "memory")
#define PG8_WAIT_L(n) asm volatile("s_waitcnt lgkmcnt(" #n ")" ::: "memory")
#define PG8_BAR __builtin_amdgcn_s_barrier()
#define PG8_SCHED __builtin_amdgcn_sched_barrier(0)
    Unit cur, nxt; int ui = 0;
    if (!S.next(0, cur)) return;
    f32x4 acc[2][2][4][2];
#pragma unroll
    for (int a = 0; a < 2; ++a)
#pragma unroll
        for (int b = 0; b < 2; ++b)
#pragma unroll
            for (int m = 0; m < 4; ++m)
#pragma unroll
                for (int n = 0; n < 2; ++n) acc[a][b][m][n] = (f32x4){0.f, 0.f, 0.f, 0.f};
    bf16x8 At[4][2], B0[2][2], B1[2][2];
    const char* cA = (const char*)g.A + (size_t)cur.pm * tstep; const char* cB = (const char*)g.Bt + (size_t)cur.pn * tstep;
    S.a_ready(cur);
    if constexpr (SP2) {
        PG8_STAGE(PG8_SB(0, 0), cB, voffB); PG8_STAGE(PG8_SB(0, 1), cB + hstep, voffB); PG8_STAGE(PG8_SA(0, 0), cA, voffA); PG8_STAGE(PG8_SA(0, 1), cA + hstep, voffA);
        if (wr == 1) PG8_BAR;
        PG8_WAIT_V(2); PG8_BAR;
        PG8_STAGE(PG8_SB(1, 0), cB + kstep, voffB); PG8_STAGE(PG8_SA(1, 0), cA + kstep, voffA); PG8_STAGE(PG8_SB(1, 1), cB + hstep + kstep, voffB);
        PG8_WAIT_V(6); PG8_BAR;
    } else {
        PG8_STAGE(PG8_SB(0, 0), cB, voffB); PG8_STAGE(PG8_SA(0, 0), cA, voffA); PG8_STAGE(PG8_SB(0, 1), cB + hstep, voffB); PG8_STAGE(PG8_SA(0, 1), cA + hstep, voffA);
        if (wr == 1) PG8_BAR;
        PG8_WAIT_V(4); PG8_BAR;
        PG8_STAGE(PG8_SB(1, 0), cB + kstep, voffB); PG8_STAGE(PG8_SA(1, 0), cA + kstep, voffA); PG8_STAGE(PG8_SB(1, 1), cB + hstep + kstep, voffB);
        PG8_WAIT_V(6); PG8_BAR;
    }
    for (;;) {
        const bool has_next = S.next(ui + 1, nxt);
        const char* nA = has_next ? (const char*)g.A + (size_t)nxt.pm * tstep : cA; const char* nB = has_next ? (const char*)g.Bt + (size_t)nxt.pn * tstep : cB;
        for (int t = 0; t < nt; t += 2) {
            const bool last = (t == nt - 2);
            const char* a1 = cA + (size_t)(t + 1) * kstep;
            const char* a2 = last ? nA : cA + (size_t)(t + 2) * kstep; const char* b2 = last ? nB : cB + (size_t)(t + 2) * kstep;
            const char* a3 = a2 + kstep; const char* b3 = b2 + kstep;
            if (last && has_next) S.a_ready(nxt);
            if constexpr (SP2) {
            PG8_LDB(B0, 0, 0); PG8_LDB(B1, 0, 1); PG8_SCHED; PG8_LDA(At, 0, 0); PG8_STAGE(PG8_SA(1, 1), a1 + hstep, voffA);
            PG8_WAIT_V(8); PG8_WAIT_L(0); PG8_BAR; PG8_MMA(0, 0, At, B0); PG8_MMA(0, 1, At, B1); PG8_BAR; PG8_SCHED;
            PG8_LDA(At, 0, 1); PG8_STAGE(PG8_SB(0, 0), b2, voffB); PG8_STAGE(PG8_SB(0, 1), b2 + hstep, voffB); PG8_STAGE(PG8_SA(0, 0), a2, voffA);
            PG8_WAIT_V(8); PG8_WAIT_L(0); PG8_BAR; PG8_MMA(1, 0, At, B0); PG8_MMA(1, 1, At, B1); PG8_BAR; PG8_SCHED;
            PG8_LDB(B0, 1, 0); PG8_LDB(B1, 1, 1); PG8_SCHED; PG8_LDA(At, 1, 0); PG8_STAGE(PG8_SA(0, 1), a2 + hstep, voffA);
            PG8_WAIT_V(8); PG8_WAIT_L(0); PG8_BAR; PG8_MMA(0, 0, At, B0); PG8_MMA(0, 1, At, B1); PG8_BAR; PG8_SCHED;
            PG8_LDA(At, 1, 1); PG8_STAGE(PG8_SB(1, 0), b3, voffB); PG8_STAGE(PG8_SB(1, 1), b3 + hstep, voffB); PG8_STAGE(PG8_SA(1, 0), a3, voffA);
            PG8_WAIT_V(8); PG8_WAIT_L(0); PG8_BAR; PG8_MMA(1, 0, At, B0); PG8_MMA(1, 1, At, B1); PG8_BAR; PG8_SCHED;
            } else {
            PG8_LDB(B0, 0, 0); PG8_SCHED; PG8_LDA(At, 0, 0); PG8_STAGE(PG8_SA(1, 1), a1 + hstep, voffA);
            PG8_WAIT_L(8); PG8_BAR; PG8_WAIT_L(0); PG8_MMA(0, 0, At, B0); PG8_BAR; PG8_SCHED;
            PG8_LDB(B1, 0, 1); PG8_STAGE(PG8_SB(0, 0), b2, voffB);
            PG8_BAR; PG8_WAIT_L(0); PG8_MMA(0, 1, At, B1); PG8_BAR;
            PG8_LDA(At, 0, 1); PG8_STAGE(PG8_SA(0, 0), a2, voffA);
            PG8_BAR; PG8_WAIT_L(0); PG8_MMA(1, 0, At, B0); PG8_BAR; PG8_SCHED;
            PG8_STAGE(PG8_SB(0, 1), b2 + hstep, voffB);
            PG8_WAIT_V(6); PG8_BAR; PG8_MMA(1, 1, At, B1); PG8_BAR;
            PG8_LDB(B0, 1, 0); PG8_SCHED; PG8_LDA(At, 1, 0); PG8_STAGE(PG8_SA(0, 1), a2 + hstep, voffA);
            PG8_WAIT_L(8); PG8_BAR; PG8_WAIT_L(0); PG8_MMA(0, 0, At, B0); PG8_BAR; PG8_SCHED;
            PG8_LDB(B1, 1, 1); PG8_STAGE(PG8_SB(1, 0), b3, voffB);
            PG8_BAR; PG8_WAIT_L(0); PG8_MMA(0, 1, At, B1); PG8_BAR;
            PG8_LDA(At, 1, 1); PG8_STAGE(PG8_SA(1, 0), a3, voffA);
            PG8_BAR; PG8_WAIT_L(0); PG8_MMA(1, 0, At, B0); PG8_BAR; PG8_SCHED;
            PG8_STAGE(PG8_SB(1, 1), b3 + hstep, voffB);
            PG8_WAIT_V(6); PG8_BAR; PG8_MMA(1, 1, At, B1); PG8_BAR;
            }
        }
        if constexpr (ALIGN_EPI) { if (wr == 0) PG8_BAR; }
        if constexpr (!Epi::AFTER_DRAIN) { E(acc, cur, wr, wc, fr, fq); S.done(cur); }
        if (!has_next) break;
#pragma unroll
        for (int a = 0; a < 2; ++a)
#pragma unroll
            for (int b = 0; b < 2; ++b)
#pragma unroll
                for (int m = 0; m < 4; ++m)
#pragma unroll
                    for (int n = 0; n < 2; ++n) acc[a][b][m][n] = (f32x4){0.f, 0.f, 0.f, 0.f};
        cur = nxt; cA = nA; cB = nB; ++ui;
        if constexpr (ALIGN_EPI) { if (wr == 1) PG8_BAR; }
    }
    PG8_WAIT_V(0);
    if constexpr (!ALIGN_EPI) { if (wr == 0) PG8_BAR; }
    PG8_BAR;
    if constexpr (Epi::AFTER_DRAIN) { E.fused(acc, cur, wr, wc, fr, fq, lds, wid, lane); S.done(cur); }
#undef PG8_SA
#undef PG8_SB
#undef PG8_STAGE
#undef PG8_LDA
#undef PG8_LDB
#undef PG8_MMA
#undef PG8_WAIT_V
#undef PG8_WAIT_L
#undef PG8_BAR
#undef PG8_SCHED
}
}
#define LAS __attribute__((address_space(3)))
typedef unsigned v4u __attribute__((ext_vector_type(4)));
typedef float f32x4 __attribute__((ext_vector_type(4)));
typedef short bf16x8 __attribute__((ext_vector_type(8)));
#define LDS_WAIT() asm volatile("s_waitcnt lgkmcnt(0)" ::: "memory")
constexpr int NWAVES = 8;
constexpr int LDS_BYTES = 147456;

struct Params { const float* in[26]; float* out; unsigned char* ws; int ph_lo, ph_hi; };

DEV float wave_sum(float v) {
#pragma unroll
  for (int o = 1; o < 64; o <<= 1) v += __shfl_xor(v, o);
  return v;
}

DEV int w1_dest_row(int n) {
  if (n < 1024) return n;
  if (n < 2560) return 2048 + (n - 1024);
  if (n < 2592) return 5632 + (n - 2560);
  if (n < 3104) return 3584 + (n - 2592);
  if (n < 3616) return 4096 + (n - 3104);
  if (n < 4640) return 4608 + (n - 3616);
  if (n < 5664) return 1024 + (n - 4640);
  return n;
}
DEV void transpose_item(const float* W, int K, int N, int k0, int n0, bf16_t* WT, int drow0, LAS float* scr, int lane) {
#pragma unroll 8
  for (int i = 0; i < 32; ++i) { const int kk = 2 * i + (lane >> 5); scr[kk * 33 + (lane & 31)] = W[(size_t)(k0 + kk) * N + n0 + (lane & 31)]; }
  LDS_WAIT(); asm volatile("" ::: "memory");
  const int c = lane & 7;
#pragma unroll
  for (int j = 0; j < 4; ++j) { const int n = (lane >> 3) + 8 * j; const LAS float* s = scr + (8 * c) * 33 + n;
    v4u o; o.x = pk2(s[0 * 33], s[1 * 33]); o.y = pk2(s[2 * 33], s[3 * 33]); o.z = pk2(s[4 * 33], s[5 * 33]); o.w = pk2(s[6 * 33], s[7 * 33]);
    *(v4u*)(WT + (size_t)(drow0 + n) * K + k0 + 8 * c) = o; }
  LDS_WAIT(); asm volatile("" ::: "memory");
}
DEV void prologue_phase(const Params& p, LAS unsigned char* lds) {
  const int tid = threadIdx.x, lane = tid & 63, wave = tid >> 6;
  unsigned char* ws = p.ws;
  float* MOD = (float*)(ws + WS_MOD);
  {
    LAS float* sc = (LAS float*)lds;
    LAS float* part = (LAS float*)(lds + 12288);
    for (int i = tid; i < 3072; i += 512) { const int v = i >> 10, k = i & 1023; const float cv = v < 2 ? p.in[1][v * 1024 + k] : p.in[3][k]; sc[i] = siluf(cv); }
    __syncthreads();
    for (int task = blockIdx.x; task < 96; task += gridDim.x) {
      const int l = task / 48, n0 = (task % 48) * 64; const float* w = l ? p.in[19] : p.in[5]; const float* bb = l ? p.in[20] : p.in[6];
      const int col = tid & 63, ks = tid >> 6;
      float a0 = 0.f, a1 = 0.f, a2 = 0.f;
#pragma unroll 8
      for (int k = ks * 128; k < ks * 128 + 128; ++k) { const float wv = w[(size_t)k * 3072 + n0 + col]; a0 += sc[k] * wv; a1 += sc[1024 + k] * wv; a2 += sc[2048 + k] * wv; }
      part[(ks * 3 + 0) * 64 + col] = a0; part[(ks * 3 + 1) * 64 + col] = a1; part[(ks * 3 + 2) * 64 + col] = a2;
      __syncthreads();
      if (tid < 192) { const int v = tid >> 6; float s = bb[n0 + col];
#pragma unroll
        for (int q = 0; q < 8; ++q) s += part[(q * 3 + v) * 64 + col];
        MOD[(l * 3 + v) * 3072 + n0 + col] = s; }
      __syncthreads();
    }
  }
  if (blockIdx.x == gridDim.x - 1) { float* rope = (float*)(ws + WS_ROPE);
    for (int idx = tid; idx < 4096; idx += 512) { const int pos = idx >> 5, f = idx & 31; const float inv = 1.0f / powf(10000.f, (float)f / 32.f); const float ang = (float)pos * inv; rope[idx] = cosf(ang); rope[4096 + idx] = sinf(ang); } }
  { v4u* z = (v4u*)(ws + WS_W1T + (size_t)E_IN * 1024 * 2); const v4u zero = {0u, 0u, 0u, 0u};
    for (int i = blockIdx.x * 512 + tid; i < (E_INP - E_IN) * 1024 * 2 / 16; i += gridDim.x * 512) z[i] = zero; }
  __syncthreads();
  {
    LAS float* scr = (LAS float*)(lds + wave * 16384);
    const int gw = blockIdx.x * NWAVES + wave, NGW = gridDim.x * NWAVES;
    constexpr int I1 = 16 * 178, I2 = 32 * 32, I3 = 16 * 160, I4 = 32 * 32;
    for (int it = gw; it < I1 + I2 + I3 + I4; it += NGW) {
      int r = it;
      if (r < I1) { const int kb = r / 178, nb = r % 178; transpose_item(p.in[7], 1024, E_IN, 64 * kb, 32 * nb, (bf16_t*)(ws + WS_W1T), w1_dest_row(32 * nb), scr, lane); continue; } r -= I1;
      if (r < I2) { const int kb = r / 32, nb = r % 32; transpose_item(p.in[17], 2048, 1024, 64 * kb, 32 * nb, (bf16_t*)(ws + WS_W2T), 32 * nb, scr, lane); continue; } r -= I2;
      if (r < I3) { const int kb = r / 160, nb = r % 160; transpose_item(p.in[21], 1024, O_IN, 64 * kb, 32 * nb, (bf16_t*)(ws + WS_W3T), 32 * nb, scr, lane); continue; } r -= I3;
      { const int kb = r / 32, nb = r % 32; transpose_item(p.in[25], 2048, 1024, 64 * kb, 32 * nb, (bf16_t*)(ws + WS_W4T), 32 * nb, scr, lane); }
    }
  }
}
DEV void prep_phase(const float* xlat, const float* xctx, const float* g, const float* mod, bf16_t* H) {
  const int lane = threadIdx.x & 63, wave = threadIdx.x >> 6;
  for (int row = blockIdx.x * NWAVES + wave; row < MA; row += gridDim.x * NWAVES) {
    const float* src = row < ML ? xlat + (size_t)row * D : xctx + (size_t)(row - ML) * D;
    const float* m = mod + row_vec(row) * 3072;
    f32x4 v[4]; float ss = 0.f;
#pragma unroll
    for (int j = 0; j < 4; ++j) { v[j] = *(const f32x4*)(src + 4 * lane + 256 * j); ss += (v[j].x * v[j].x + v[j].y * v[j].y) + (v[j].z * v[j].z + v[j].w * v[j].w); }
    const float rstd = rsqrtf(wave_sum(ss) * (1.f / D) + EPS);
#pragma unroll
    for (int j = 0; j < 4; ++j) { const int k = 4 * lane + 256 * j;
      const f32x4 gg = *(const f32x4*)(g + k), sc = *(const f32x4*)(m + 1024 + k), sh = *(const f32x4*)(m + k);
      const f32x4 o = v[j] * rstd * gg * (sc + 1.f) + sh;
      *(unsigned long long*)(H + (size_t)row * D + k) = (unsigned long long)pk2(o.x, o.y) | ((unsigned long long)pk2(o.z, o.w) << 32); }
  }
}
template <class F> DEV void small_gemm(const bf16_t* A, int lda, const bf16_t* Bt, int ldb, int K, int Mrows, int Ncols, F f) {
  const int lane = threadIdx.x & 63, wid = threadIdx.x >> 6, mt = wid >> 2, nt = wid & 3, r = lane & 15, q = lane >> 4;
  const int ntn = Ncols / 64, ntasks = (Mrows / 32) * ntn;
  for (int task = blockIdx.x; task < ntasks; task += gridDim.x) {
    const int row0 = (task / ntn) * 32 + mt * 16, col0 = (task % ntn) * 64 + nt * 16;
    const bf16_t* ap = A + (size_t)(row0 + r) * lda + 8 * q; const bf16_t* bp = Bt + (size_t)(col0 + r) * ldb + 8 * q;
    f32x4 acc = {0.f, 0.f, 0.f, 0.f};
#pragma unroll 8
    for (int k = 0; k < K; k += 32) { const bf16x8 a = *(const bf16x8*)(ap + k), b = *(const bf16x8*)(bp + k); acc = __builtin_amdgcn_mfma_f32_16x16x32_bf16(a, b, acc, 0, 0, 0); }
#pragma unroll
    for (int j = 0; j < 4; ++j) f(row0 + q * 4 + j, col0 + r, acc[j]);
  }
}

DEV void qknorm_phase(bf16_t* Q1, bf16_t* K1, const float* qn, const float* kn, const float* rope) {
  const int lane = threadIdx.x & 63, wave = threadIdx.x >> 6;
  const int total = ML * 20 + MC * 4;
  const float scale = 0.08838834764831845f;
  for (int wt = blockIdx.x * NWAVES + wave; wt < total; wt += gridDim.x * NWAVES) {
    int row, hh; bool lat = wt < ML * 20;
    if (lat) { row = wt / 20; hh = wt % 20; } else { const int r2 = wt - ML * 20; row = ML + (r2 >> 2); hh = r2 & 3; }
    const bool isq = hh >= 4;
    bf16_t* ptr = isq ? Q1 + (size_t)row * 2048 + (hh - 4) * 128 : K1 + (size_t)row * 512 + hh * 128;
    float v0 = bf2f(ptr[lane]), v1 = bf2f(ptr[64 + lane]);
    const float rstd = rsqrtf(wave_sum(v0 * v0 + v1 * v1) * (1.f / 128.f) + EPS);
    const float* gn = isq ? qn : kn;
    v0 *= rstd * gn[lane]; v1 *= rstd * gn[64 + lane];
    if (lat) {
      const int t = row % SEQ, f = lane & 31, s = (lane >> 5) & 1;
      const float c0 = rope[(t >> 6) * 32 + f], s0 = rope[4096 + (t >> 6) * 32 + f], c1 = rope[(t & 63) * 32 + f], s1 = rope[4096 + (t & 63) * 32 + f];
      const float o0 = __shfl_xor(v0, 32), o1 = __shfl_xor(v1, 32);
      v0 = s ? (v0 * c0 + o0 * s0) : (v0 * c0 - o0 * s0);
      v1 = s ? (v1 * c1 + o1 * s1) : (v1 * c1 - o1 * s1);
    }
    if (isq) { v0 *= scale; v1 *= scale; }
    ptr[lane] = f2bf(v0); ptr[64 + lane] = f2bf(v1);
  }
}
typedef short s16x4 __attribute__((ext_vector_type(4)));
DEV s16x4 tr_read(const LAS bf16_t* p) { return __builtin_bit_cast(s16x4, __builtin_amdgcn_ds_read_tr16_b64_v4i16((LAS s16x4*)p)); }
DEV void attn_phase(bf16_t* Q1, const bf16_t* K1, const bf16_t* V1, const bf16_t* G1, const float* sink, const float* qn, const float* kn, LAS unsigned char* lds) {
  constexpr int KP = 136, VP = 144;
  LAS bf16_t* Ks = (LAS bf16_t*)lds;
  LAS bf16_t* Vs = (LAS bf16_t*)(lds + 2 * 64 * KP * 2);
  LAS float* dsc = (LAS float*)(lds + 2 * 64 * KP * 2 + 2 * 64 * VP * 2);
  const int tid = threadIdx.x, lane = tid & 63, wid = tid >> 6, r = lane & 15, Qd = lane >> 4;
  float mb;
  { float a = fmaxf(fabsf(qn[lane]), fabsf(qn[64 + lane])), b = fmaxf(fabsf(kn[lane]), fabsf(kn[64 + lane]));
#pragma unroll
    for (int o = 1; o < 64; o <<= 1) { a = fmaxf(a, __shfl_xor(a, o)); b = fmaxf(b, __shfl_xor(b, o)); }
    mb = a * b * 11.313708498984761f; }
  for (int task = blockIdx.x; task < 1024; task += gridDim.x) {
    const int b = task >> 9, kvh = (task >> 7) & 3, qt = task & 127;
    const int hq = kvh * 4 + (wid >> 1), qoff = (wid & 1) * 32;
    const size_t qrow0 = (size_t)b * SEQ + qt * 64 + qoff;
    bf16x8 qf[2][4];
#pragma unroll
    for (int m = 0; m < 2; ++m)
#pragma unroll
      for (int ks = 0; ks < 4; ++ks) qf[m][ks] = *(const bf16x8*)(Q1 + (qrow0 + 16 * m + r) * 2048 + hq * 128 + ks * 32 + 8 * Qd);
    const int tlo = (2 - qt) > 0 ? (2 - qt) : 0, thi = (129 - qt) < 4 ? (129 - qt) : 4, nband = thi - tlo + 1, ntile = nband + 4;
    const int skey = tid >> 4, sch = tid & 15;
    v4u kreg[2], vreg[2];
#define TILE_ROW0(i) ((i) < nband ? (size_t)b * SEQ + (size_t)(qt - 2 + tlo + (i)) * 64 : (size_t)ML + b * CTXL + ((i) - nband) * 64)
#define LOAD_TILE(i) do { const size_t r0_ = TILE_ROW0(i); _Pragma("unroll") for (int h_ = 0; h_ < 2; ++h_) { const size_t go_ = (r0_ + skey + 32 * h_) * 512 + kvh * 128 + sch * 8; kreg[h_] = *(const v4u*)(K1 + go_); vreg[h_] = *(const v4u*)(V1 + go_); } } while (0)
#define STORE_TILE(buf) do { _Pragma("unroll") for (int h_ = 0; h_ < 2; ++h_) { *(LAS v4u*)(Ks + (buf) * 64 * KP + (skey + 32 * h_) * KP + sch * 8) = kreg[h_]; *(LAS v4u*)(Vs + (buf) * 64 * VP + (skey + 32 * h_) * VP + sch * 8) = vreg[h_]; } } while (0)
    LOAD_TILE(0);
    __syncthreads();
    STORE_TILE(0);
    __syncthreads();
    f32x4 o[2][8];
#pragma unroll
    for (int m = 0; m < 2; ++m)
#pragma unroll
      for (int n = 0; n < 8; ++n) o[m][n] = (f32x4){0.f, 0.f, 0.f, 0.f};
    float lsum[2] = {0.f, 0.f};
    for (int i = 0; i < ntile; ++i) {
      const int buf = i & 1;
      if (i + 1 < ntile) LOAD_TILE(i + 1);
      const int mtype = (i < nband) ? ((tlo + i) == 0 ? 1 : ((tlo + i) == 4 ? 2 : 0)) : 0;
      const LAS bf16_t* Kb = Ks + buf * 64 * KP; const LAS bf16_t* Vb = Vs + buf * 64 * VP;
      f32x4 s[4][2];
#pragma unroll
      for (int t = 0; t < 4; ++t) { s[t][0] = (f32x4){0.f, 0.f, 0.f, 0.f}; s[t][1] = (f32x4){0.f, 0.f, 0.f, 0.f}; }
#pragma unroll
      for (int ks = 0; ks < 4; ++ks)
#pragma unroll
        for (int t = 0; t < 4; ++t) { const bf16x8 kf = *(const LAS bf16x8*)(Kb + (16 * t + r) * KP + ks * 32 + 8 * Qd);
          s[t][0] = __builtin_amdgcn_mfma_f32_16x16x32_bf16(kf, qf[0][ks], s[t][0], 0, 0, 0);
          s[t][1] = __builtin_amdgcn_mfma_f32_16x16x32_bf16(kf, qf[1][ks], s[t][1], 0, 0, 0); }
      bf16x8 pa[2][2];
#pragma unroll
      for (int m = 0; m < 2; ++m) { const int qi = qoff + 16 * m + r;
#pragma unroll
        for (int t = 0; t < 4; ++t) {
          float pv[4];
#pragma unroll
          for (int j = 0; j < 4; ++j) { const int kj = 16 * t + 4 * Qd + j; float pj = __expf(s[t][m][j] - mb);
            if (mtype == 1) pj = (kj >= qi) ? pj : 0.f; else if (mtype == 2) pj = (kj <= qi) ? pj : 0.f;
            pv[j] = pj; lsum[m] += pj; }
          const unsigned w0 = pk2(pv[0], pv[1]), w1 = pk2(pv[2], pv[3]);
          pa[m][t >> 1][(t & 1) * 4 + 0] = (short)(w0 & 0xffff); pa[m][t >> 1][(t & 1) * 4 + 1] = (short)(w0 >> 16);
          pa[m][t >> 1][(t & 1) * 4 + 2] = (short)(w1 & 0xffff); pa[m][t >> 1][(t & 1) * 4 + 3] = (short)(w1 >> 16); } }
#pragma unroll
      for (int k2 = 0; k2 < 2; ++k2)
#pragma unroll
        for (int n = 0; n < 8; ++n) {
          const s16x4 lo = tr_read(Vb + (32 * k2 + 4 * Qd + (r >> 2)) * VP + 16 * n + 4 * (r & 3));
          const s16x4 hi = tr_read(Vb + (32 * k2 + 16 + 4 * Qd + (r >> 2)) * VP + 16 * n + 4 * (r & 3));
          const bf16x8 vf = (bf16x8){lo[0], lo[1], lo[2], lo[3], hi[0], hi[1], hi[2], hi[3]};
          o[0][n] = __builtin_amdgcn_mfma_f32_16x16x32_bf16(pa[0][k2], vf, o[0][n], 0, 0, 0);
          o[1][n] = __builtin_amdgcn_mfma_f32_16x16x32_bf16(pa[1][k2], vf, o[1][n], 0, 0, 0); }
      if (i + 1 < ntile) STORE_TILE(buf ^ 1);
      __syncthreads();
    }
#undef TILE_ROW0
#undef LOAD_TILE
#undef STORE_TILE
    const float sk = __expf(sink[hq] - mb);
#pragma unroll
    for (int m = 0; m < 2; ++m) { float l = lsum[m]; l += __shfl_xor(l, 16); l += __shfl_xor(l, 32); if (Qd == 0) dsc[wid * 32 + 16 * m + r] = 1.f / (l + sk); }
    LDS_WAIT(); asm volatile("" ::: "memory");
#pragma unroll
    for (int m = 0; m < 2; ++m)
#pragma unroll
      for (int j = 0; j < 4; ++j) { const float inv = dsc[wid * 32 + 16 * m + 4 * Qd + j]; const size_t ro = (qrow0 + 16 * m + 4 * Qd + j) * 2048 + hq * 128 + r;
#pragma unroll
        for (int n = 0; n < 8; ++n) Q1[ro + 16 * n] = f2bf(o[m][n][j] * inv * bf2f(G1[ro + 16 * n])); }
    LDS_WAIT(); asm volatile("" ::: "memory");
  }
}

constexpr size_t DO_SDT = 50 * MiB, DO_SCS = 53 * MiB;
constexpr size_t WS_SSQ = 237 * MiB;
DEV unsigned short bfbits(float f) { return f2bf(f); }
DEV void ssd_prep_phase(const bf16_t* XBC, const float* cw, const float* cb, bf16_t* XC, const float* DTLR, const float* dt_bias, const float* a_log, float* SDT, float* SCS, float* SDEC) {
  const int gtid = blockIdx.x * 512 + threadIdx.x, gth = gridDim.x * 512;
  for (int it = gtid; it < MA * 192; it += gth) {
    const int row = it / 192, c8 = (it % 192) * 8;
    int t, len;
    if (row < ML) { t = row % SEQ; len = SEQ; } else { t = (row - ML) % CTXL; len = CTXL; }
    float acc[8];
    { const f32x4 b0 = *(const f32x4*)(cb + c8), b1 = *(const f32x4*)(cb + c8 + 4); acc[0] = b0.x; acc[1] = b0.y; acc[2] = b0.z; acc[3] = b0.w; acc[4] = b1.x; acc[5] = b1.y; acc[6] = b1.z; acc[7] = b1.w; }
#pragma unroll
    for (int k = 0; k < 5; ++k) { const int tt = t + k - 2;
      if (tt >= 0 && tt < len) { const v4u xv = *(const v4u*)(XBC + (size_t)(row + k - 2) * 1536 + c8); const f32x4 w0 = *(const f32x4*)(cw + k * 1536 + c8), w1 = *(const f32x4*)(cw + k * 1536 + c8 + 4);
        acc[0] += w0.x * __uint_as_float(xv.x << 16); acc[1] += w0.y * __uint_as_float(xv.x & 0xffff0000u); acc[2] += w0.z * __uint_as_float(xv.y << 16); acc[3] += w0.w * __uint_as_float(xv.y & 0xffff0000u);
        acc[4] += w1.x * __uint_as_float(xv.z << 16); acc[5] += w1.y * __uint_as_float(xv.z & 0xffff0000u); acc[6] += w1.z * __uint_as_float(xv.w << 16); acc[7] += w1.w * __uint_as_float(xv.w & 0xffff0000u); } }
    v4u o; o.x = pk2(silu_fast(acc[0]), silu_fast(acc[1])); o.y = pk2(silu_fast(acc[2]), silu_fast(acc[3])); o.z = pk2(silu_fast(acc[4]), silu_fast(acc[5])); o.w = pk2(silu_fast(acc[6]), silu_fast(acc[7]));
    *(v4u*)(XC + (size_t)row * 1536 + c8) = o;
  }
  if (gtid < NCH * 32) {
    const int gc = gtid / 32, col = gtid % 32, dir = col / 16, h = col % 16;
    const float a = -__expf(a_log[col]), bias = dt_bias[col];
    float cs = 0.f;
    for (int s = 0; s < 128; ++s) { const int t = dir ? 127 - s : s; const size_t row = (size_t)gc * 128 + t;
      const float dt = softplusf(DTLR[row * 64 + col] + bias); cs += dt * a; SDT[row * 32 + col] = dt; SCS[row * 32 + col] = cs; }
    SDEC[(gc * 16 + h) * 2 + dir] = __expf(cs);
  }
}
DEV void ssd_u_phase(const bf16_t* XC, const float* SDT, const float* SCS, bf16_t* ST, LAS unsigned char* lds) {
  constexpr int XP = 272, BP = 144;
  LAS bf16_t* Xs = (LAS bf16_t*)lds; LAS bf16_t* Bs = (LAS bf16_t*)(lds + 128 * XP * 2); LAS float* wtab = (LAS float*)(lds + 128 * XP * 2 + 128 * BP * 2);
  const int tid = threadIdx.x, lane = tid & 63, wid = tid >> 6, r = lane & 15, Qd = lane >> 4, hl = wid >> 1, dir = wid & 1;
  for (int task = blockIdx.x; task < NCH * 4; task += gridDim.x) {
    const int gc = task >> 2, g = (task >> 1) & 1, hh = task & 1; const size_t r0 = (size_t)gc * 128; const int h0 = g * 8 + hh * 4;
    __syncthreads();
#pragma unroll
    for (int i = 0; i < 8; ++i) { const int cid = tid + 512 * i, row = cid >> 5, ch = cid & 31; *(LAS v4u*)(Xs + row * XP + ch * 8) = *(const v4u*)(XC + (r0 + row) * 1536 + h0 * 64 + ch * 8); }
#pragma unroll
    for (int i = 0; i < 4; ++i) { const int cid = tid + 512 * i, row = cid >> 4, ch = cid & 15; *(LAS v4u*)(Bs + row * BP + ch * 8) = *(const v4u*)(XC + (r0 + row) * 1536 + 1024 + g * 128 + ch * 8); }
#pragma unroll
    for (int i = 0; i < 2; ++i) { const int e = tid + 512 * i, combo = e >> 7, t = e & 127, col = (combo & 1) * 16 + h0 + (combo >> 1);
      const float cs_end = SCS[(r0 + ((combo & 1) ? 0 : 127)) * 32 + col]; wtab[e] = __expf(cs_end - SCS[(r0 + t) * 32 + col]) * SDT[(r0 + t) * 32 + col]; }
    __syncthreads();
    const LAS float* wt = wtab + wid * 128;
    bf16_t* Sp = ST + ((((size_t)gc * 16 + h0 + hl) * 2 + dir) * 64) * 128;
#pragma unroll 1
    for (int pp = 0; pp < 2; ++pp) {
      f32x4 acc[8][2];
#pragma unroll
      for (int nt = 0; nt < 8; ++nt) { acc[nt][0] = (f32x4){0.f, 0.f, 0.f, 0.f}; acc[nt][1] = (f32x4){0.f, 0.f, 0.f, 0.f}; }
#pragma unroll 1
      for (int k = 0; k < 4; ++k) {
        const f32x4 wlo = *(const LAS f32x4*)(wt + 32 * k + 4 * Qd), whi = *(const LAS f32x4*)(wt + 32 * k + 16 + 4 * Qd);
        bf16x8 xf[2];
#pragma unroll
        for (int pt = 0; pt < 2; ++pt) {
          const s16x4 lo = tr_read(Xs + (32 * k + 4 * Qd + (r >> 2)) * XP + hl * 64 + 32 * pp + 16 * pt + 4 * (r & 3));
          const s16x4 hi = tr_read(Xs + (32 * k + 16 + 4 * Qd + (r >> 2)) * XP + hl * 64 + 32 * pp + 16 * pt + 4 * (r & 3));
          const unsigned w0 = pk2(bf2f((bf16_t)lo[0]) * wlo[0], bf2f((bf16_t)lo[1]) * wlo[1]), w1 = pk2(bf2f((bf16_t)lo[2]) * wlo[2], bf2f((bf16_t)lo[3]) * wlo[3]);
          const unsigned w2 = pk2(bf2f((bf16_t)hi[0]) * whi[0], bf2f((bf16_t)hi[1]) * whi[1]), w3 = pk2(bf2f((bf16_t)hi[2]) * whi[2], bf2f((bf16_t)hi[3]) * whi[3]);
          xf[pt] = (bf16x8){(short)(w0 & 0xffff), (short)(w0 >> 16), (short)(w1 & 0xffff), (short)(w1 >> 16), (short)(w2 & 0xffff), (short)(w2 >> 16), (short)(w3 & 0xffff), (short)(w3 >> 16)};
        }
#pragma unroll
        for (int nt = 0; nt < 8; ++nt) {
          const s16x4 lo = tr_read(Bs + (32 * k + 4 * Qd + (r >> 2)) * BP + 16 * nt + 4 * (r & 3));
          const s16x4 hi = tr_read(Bs + (32 * k + 16 + 4 * Qd + (r >> 2)) * BP + 16 * nt + 4 * (r & 3));
          const bf16x8 bfr = (bf16x8){lo[0], lo[1], lo[2], lo[3], hi[0], hi[1], hi[2], hi[3]};
          acc[nt][0] = __builtin_amdgcn_mfma_f32_16x16x32_bf16(bfr, xf[0], acc[nt][0], 0, 0, 0);
          acc[nt][1] = __builtin_amdgcn_mfma_f32_16x16x32_bf16(bfr, xf[1], acc[nt][1], 0, 0, 0);
        }
      }
#pragma unroll
      for (int nt = 0; nt < 8; ++nt)
#pragma unroll
        for (int pt = 0; pt < 2; ++pt) { const f32x4 v = acc[nt][pt];
          *(unsigned long long*)(Sp + (size_t)(32 * pp + 16 * pt + r) * 128 + 16 * nt + 4 * Qd) = (unsigned long long)pk2(v[0], v[1]) | ((unsigned long long)pk2(v[2], v[3]) << 32); }
    }
  }
}
DEV void ssd_scan_phase(bf16_t* ST, const float* SDEC) {
  for (int item = blockIdx.x * 512 + threadIdx.x; item < 2 * 16 * 2 * 2048; item += gridDim.x * 512) {
    const int e4 = item & 2047, dir = (item >> 11) & 1, h = (item >> 12) & 15, b = item >> 16;
    float S0 = 0.f, S1 = 0.f, S2 = 0.f, S3 = 0.f;
#define SCAN_GC(s) (!dir ? ((s) < 2 ? 128 + 2 * b + (s) : b * 64 + ((s) - 2)) : ((s) < 2 ? 128 + 2 * b + (1 - (s)) : b * 64 + (65 - (s))))
    for (int s0 = 0; s0 < 66; s0 += 6) {
      unsigned long long u[6]; float dec[6];
#pragma unroll
      for (int q = 0; q < 6; ++q) { const int gc = SCAN_GC(s0 + q); u[q] = *(const unsigned long long*)(ST + (((size_t)gc * 16 + h) * 2 + dir) * 8192 + e4 * 4); dec[q] = SDEC[(gc * 16 + h) * 2 + dir]; }
#pragma unroll
      for (int q = 0; q < 6; ++q) { const int gc = SCAN_GC(s0 + q);
        *(unsigned long long*)(ST + (((size_t)gc * 16 + h) * 2 + dir) * 8192 + e4 * 4) = (unsigned long long)pk2(S0, S1) | ((unsigned long long)pk2(S2, S3) << 32);
        const unsigned lo = (unsigned)u[q], hi = (unsigned)(u[q] >> 32);
        S0 = dec[q] * S0 + __uint_as_float(lo << 16); S1 = dec[q] * S1 + __uint_as_float(lo & 0xffff0000u); S2 = dec[q] * S2 + __uint_as_float(hi << 16); S3 = dec[q] * S3 + __uint_as_float(hi & 0xffff0000u); }
    }
#undef SCAN_GC
  }
}
DEV bf16x8 scale_frag(bf16x8 f, float s) {
  bf16x8 o;
#pragma unroll
  for (int e = 0; e < 8; e += 2) { const unsigned w = pk2(bf2f((bf16_t)f[e]) * s, bf2f((bf16_t)f[e + 1]) * s); o[e] = (short)(w & 0xffff); o[e + 1] = (short)(w >> 16); }
  return o;
}
DEV void ssd_y_phase(const bf16_t* XC, const float* SDT, const float* SCS, const bf16_t* ST, const float* d_skip, bf16_t* Y0, float* SSQ, LAS unsigned char* lds) {
  constexpr int XP = 272, BP = 136;
  LAS bf16_t* Xs = (LAS bf16_t*)lds; LAS bf16_t* Bs = (LAS bf16_t*)(lds + 128 * XP * 2);
  LAS float* tab = (LAS float*)(lds + 128 * XP * 2 + 128 * BP * 2);
  LAS float* ssq = tab + 4 * 4 * 128;
  const int tid = threadIdx.x, lane = tid & 63, wid = tid >> 6, r = lane & 15, Qd = lane >> 4, hl = wid >> 1, ih = wid & 1;
  for (int task = blockIdx.x; task < NCH * 4; task += gridDim.x) {
    const int gc = task >> 2, g = (task >> 1) & 1, hh = task & 1; const size_t r0 = (size_t)gc * 128; const int h0 = g * 8 + hh * 4, h = h0 + hl;
    __syncthreads();
#pragma unroll
    for (int i = 0; i < 8; ++i) { const int cid = tid + 512 * i, row = cid >> 5, ch = cid & 31; *(LAS v4u*)(Xs + row * XP + ch * 8) = *(const v4u*)(XC + (r0 + row) * 1536 + h0 * 64 + ch * 8); }
#pragma unroll
    for (int i = 0; i < 4; ++i) { const int cid = tid + 512 * i, row = cid >> 4, ch = cid & 15; *(LAS v4u*)(Bs + row * BP + ch * 8) = *(const v4u*)(XC + (r0 + row) * 1536 + 1024 + g * 128 + ch * 8); }
#pragma unroll
    for (int i = 0; i < 4; ++i) { const int e = tid + 512 * i, hq = e >> 9, which = (e >> 7) & 3, t = e & 127; const int col = (which & 1) * 16 + h0 + hq;
      tab[e] = (which < 2 ? SCS : SDT)[(r0 + t) * 32 + col]; }
    __syncthreads();
    const LAS float* csf = tab + hl * 512; const LAS float* csb = csf + 128; const LAS float* dtf = csf + 256; const LAS float* dtb = csf + 384;
    const float dsk = d_skip[h];
#pragma unroll 1
    for (int m = 0; m < 4; ++m) {
      const int i = 64 * ih + 16 * m + r;
      bf16x8 cf[4];
#pragma unroll
      for (int ks = 0; ks < 4; ++ks) cf[ks] = *(const bf16x8*)(XC + (r0 + i) * 1536 + 1280 + g * 128 + 32 * ks + 8 * Qd);
      f32x4 y[4];
#pragma unroll
      for (int pt = 0; pt < 4; ++pt) y[pt] = (f32x4){0.f, 0.f, 0.f, 0.f};
      const float cfi = csf[i], cbi = csb[i];
#pragma unroll 1
      for (int dir = 0; dir < 2; ++dir) {
        const float sc = __expf(dir ? cbi : cfi);
        const bf16_t* Sp = ST + ((((size_t)gc * 16 + h) * 2 + dir) * 64) * 128;
#pragma unroll
        for (int ks = 0; ks < 4; ++ks) {
          const bf16x8 a = scale_frag(cf[ks], sc);
#pragma unroll
          for (int pt = 0; pt < 4; ++pt) { const bf16x8 sf = *(const bf16x8*)(Sp + (size_t)(16 * pt + r) * 128 + 32 * ks + 8 * Qd); y[pt] = __builtin_amdgcn_mfma_f32_16x16x32_bf16(a, sf, y[pt], 0, 0, 0); }
        }
      }
#pragma unroll 1
      for (int k2 = 0; k2 < 4; ++k2) {
        bf16x8 pa;
#pragma unroll
        for (int tt = 0; tt < 2; ++tt) {
          f32x4 c = {0.f, 0.f, 0.f, 0.f};
#pragma unroll
          for (int ks = 0; ks < 4; ++ks) { const bf16x8 bfr = *(const LAS bf16x8*)(Bs + (32 * k2 + 16 * tt + r) * BP + 32 * ks + 8 * Qd); c = __builtin_amdgcn_mfma_f32_16x16x32_bf16(bfr, cf[ks], c, 0, 0, 0); }
          const int j0 = 32 * k2 + 16 * tt + 4 * Qd;
          const f32x4 jf = *(const LAS f32x4*)(csf + j0), jb = *(const LAS f32x4*)(csb + j0), jdf = *(const LAS f32x4*)(dtf + j0), jdb = *(const LAS f32x4*)(dtb + j0);
          float pv[4];
#pragma unroll
          for (int jj = 0; jj < 4; ++jj) { const int j = j0 + jj;
            const float Lf = __expf(j <= i ? cfi - jf[jj] : -INFINITY) * jdf[jj];
            const float Lb = __expf(j >= i ? cbi - jb[jj] : -INFINITY) * jdb[jj];
            pv[jj] = c[jj] * (Lf + Lb) + (j == i ? dsk : 0.f); }
          const unsigned w0 = pk2(pv[0], pv[1]), w1 = pk2(pv[2], pv[3]);
          pa[tt * 4 + 0] = (short)(w0 & 0xffff); pa[tt * 4 + 1] = (short)(w0 >> 16); pa[tt * 4 + 2] = (short)(w1 & 0xffff); pa[tt * 4 + 3] = (short)(w1 >> 16);
        }
#pragma unroll
        for (int pt = 0; pt < 4; ++pt) {
          const s16x4 lo = tr_read(Xs + (32 * k2 + 4 * Qd + (r >> 2)) * XP + hl * 64 + 16 * pt + 4 * (r & 3));
          const s16x4 hi = tr_read(Xs + (32 * k2 + 16 + 4 * Qd + (r >> 2)) * XP + hl * 64 + 16 * pt + 4 * (r & 3));
          const bf16x8 xf = (bf16x8){lo[0], lo[1], lo[2], lo[3], hi[0], hi[1], hi[2], hi[3]};
          y[pt] = __builtin_amdgcn_mfma_f32_16x16x32_bf16(pa, xf, y[pt], 0, 0, 0);
        }
      }
#pragma unroll
      for (int jj = 0; jj < 4; ++jj) { const int il = 64 * ih + 16 * m + 4 * Qd + jj; const size_t yo = (r0 + il) * 2048 + h * 64 + r; float ss = 0.f;
#pragma unroll
        for (int pt = 0; pt < 4; ++pt) { const float v = y[pt][jj] * bf2f(Y0[yo + 16 * pt]); ss += v * v; Y0[yo + 16 * pt] = f2bf(v); }
        ss += __shfl_xor(ss, 1); ss += __shfl_xor(ss, 2); ss += __shfl_xor(ss, 4); ss += __shfl_xor(ss, 8);
        if (r == 0) ssq[hl * 128 + il] = ss; }
    }
    __syncthreads();
    if (tid < 128) SSQ[((r0 + tid) * 2 + g) * 2 + hh] = (ssq[tid] + ssq[128 + tid]) + (ssq[256 + tid] + ssq[384 + tid]);
  }
}

constexpr size_t WS_GCSC = 237 * MiB + 4 * MiB;
DEV const float* gcs_row(const float* lat, const float* ctx, size_t row) { return row < (size_t)ML ? lat + row * 1024 : ctx + (row - ML) * 1024; }
DEV float* gcs_row_w(float* lat, float* ctx, size_t row) { return row < (size_t)ML ? lat + row * 1024 : ctx + (row - ML) * 1024; }
DEV float logsig_fast(float x) { return fminf(x, 0.f) - __logf(1.f + __expf(-fabsf(x))); }
DEV void gla_cs_phase(const float* DTLR, const float* gw, const float* gb, float* GCSL, float* GCSC, float* GDEC) {
  const int lane = threadIdx.x & 63, wave = threadIdx.x >> 6, kl = lane & 7, seg = lane >> 3;
  for (int wt = blockIdx.x * NWAVES + wave; wt < NCH * 2 * 64; wt += gridDim.x * NWAVES) {
    const int gc = wt >> 7, dir = (wt >> 6) & 1, k = (wt & 63) * 8 + kl;
    float wv[16];
#pragma unroll
    for (int q = 0; q < 16; ++q) wv[q] = gw[(dir * 16 + q) * 512 + k];
    const float bias = gb[dir * 512 + k];
    float v[16]; float run = 0.f;
#pragma unroll
    for (int u = 0; u < 16; ++u) { const int s = seg * 16 + u, t = dir ? 127 - s : s; const float* lr = DTLR + ((size_t)gc * 128 + t) * 64 + 32 + dir * 16;
      const f32x4 l0 = *(const f32x4*)lr, l1 = *(const f32x4*)(lr + 4), l2 = *(const f32x4*)(lr + 8), l3 = *(const f32x4*)(lr + 12);
      float lg = bias + l0.x * wv[0] + l0.y * wv[1] + l0.z * wv[2] + l0.w * wv[3] + l1.x * wv[4] + l1.y * wv[5] + l1.z * wv[6] + l1.w * wv[7]
                 + l2.x * wv[8] + l2.y * wv[9] + l2.z * wv[10] + l2.w * wv[11] + l3.x * wv[12] + l3.y * wv[13] + l3.z * wv[14] + l3.w * wv[15];
      run += logsig_fast(lg) * (1.f / 16.f); v[u] = run; }
    float off = 0.f;
#pragma unroll
    for (int sgi = 0; sgi < 7; ++sgi) { const float tot = __shfl(run, kl + 8 * sgi); off += (sgi < seg) ? tot : 0.f; }
#pragma unroll
    for (int u = 0; u < 16; ++u) { const int s = seg * 16 + u, t = dir ? 127 - s : s; gcs_row_w(GCSL, GCSC, (size_t)gc * 128 + t)[dir * 512 + k] = v[u] + off; }
    if (seg == 7) GDEC[((gc * 4 + (k >> 7)) * 2 + dir) * 128 + (k & 127)] = __expf(run + off);
  }
}
DEV void gla_u_phase(const bf16_t* K0, const bf16_t* V0, const float* GCSL, const float* GCSC, bf16_t* ST, LAS unsigned char* lds) {
  constexpr int VP = 272, KP = 144;
  LAS bf16_t* Vs = (LAS bf16_t*)lds; LAS bf16_t* Kd = (LAS bf16_t*)(lds + 128 * VP * 2);
  const int tid = threadIdx.x, lane = tid & 63, wid = tid >> 6, r = lane & 15, Qd = lane >> 4;
  for (int task = blockIdx.x; task < NCH * 4; task += gridDim.x) {
    const int gc = task >> 2, h = task & 3; const size_t r0 = (size_t)gc * 128;
    __syncthreads();
#pragma unroll
    for (int i = 0; i < 8; ++i) { const int cid = tid + 512 * i, row = cid >> 5, ch = cid & 31; *(LAS v4u*)(Vs + row * VP + ch * 8) = *(const v4u*)(V0 + (r0 + row) * 1024 + h * 256 + ch * 8); }
#pragma unroll
    for (int i = 0; i < 4; ++i) { const int cid = tid + 512 * i, t = cid >> 4, ch = cid & 15;
      const v4u kv = *(const v4u*)(K0 + (r0 + t) * 512 + h * 128 + ch * 8);
      const float kf[8] = {__uint_as_float(kv.x << 16), __uint_as_float(kv.x & 0xffff0000u), __uint_as_float(kv.y << 16), __uint_as_float(kv.y & 0xffff0000u), __uint_as_float(kv.z << 16), __uint_as_float(kv.z & 0xffff0000u), __uint_as_float(kv.w << 16), __uint_as_float(kv.w & 0xffff0000u)};
#pragma unroll
      for (int dir = 0; dir < 2; ++dir) {
        const float* ce = gcs_row(GCSL, GCSC, r0 + (dir ? 0 : 127)) + dir * 512 + h * 128 + ch * 8; const float* ct = gcs_row(GCSL, GCSC, r0 + t) + dir * 512 + h * 128 + ch * 8;
        const f32x4 e0 = *(const f32x4*)ce, e1 = *(const f32x4*)(ce + 4), c0 = *(const f32x4*)ct, c1 = *(const f32x4*)(ct + 4);
        v4u o; o.x = pk2(kf[0] * __expf(e0.x - c0.x), kf[1] * __expf(e0.y - c0.y)); o.y = pk2(kf[2] * __expf(e0.z - c0.z), kf[3] * __expf(e0.w - c0.w));
        o.z = pk2(kf[4] * __expf(e1.x - c1.x), kf[5] * __expf(e1.y - c1.y)); o.w = pk2(kf[6] * __expf(e1.z - c1.z), kf[7] * __expf(e1.w - c1.w));
        *(LAS v4u*)(Kd + dir * 128 * KP + t * KP + ch * 8) = o; } }
    __syncthreads();
#pragma unroll 1
    for (int dir = 0; dir < 2; ++dir) {
      const LAS bf16_t* Kb = Kd + dir * 128 * KP;
      f32x4 acc[8][2];
#pragma unroll
      for (int dt = 0; dt < 8; ++dt) { acc[dt][0] = (f32x4){0.f, 0.f, 0.f, 0.f}; acc[dt][1] = (f32x4){0.f, 0.f, 0.f, 0.f}; }
#pragma unroll 1
      for (int k = 0; k < 4; ++k) {
        bf16x8 vf[2];
#pragma unroll
        for (int et = 0; et < 2; ++et) {
          const s16x4 lo = tr_read(Vs + (32 * k + 4 * Qd + (r >> 2)) * VP + 32 * wid + 16 * et + 4 * (r & 3));
          const s16x4 hi = tr_read(Vs + (32 * k + 16 + 4 * Qd + (r >> 2)) * VP + 32 * wid + 16 * et + 4 * (r & 3));
          vf[et] = (bf16x8){lo[0], lo[1], lo[2], lo[3], hi[0], hi[1], hi[2], hi[3]}; }
#pragma unroll
        for (int dt = 0; dt < 8; ++dt) {
          const s16x4 lo = tr_read(Kb + (32 * k + 4 * Qd + (r >> 2)) * KP + 16 * dt + 4 * (r & 3));
          const s16x4 hi = tr_read(Kb + (32 * k + 16 + 4 * Qd + (r >> 2)) * KP + 16 * dt + 4 * (r & 3));
          const bf16x8 kfr = (bf16x8){lo[0], lo[1], lo[2], lo[3], hi[0], hi[1], hi[2], hi[3]};
          acc[dt][0] = __builtin_amdgcn_mfma_f32_16x16x32_bf16(kfr, vf[0], acc[dt][0], 0, 0, 0);
          acc[dt][1] = __builtin_amdgcn_mfma_f32_16x16x32_bf16(kfr, vf[1], acc[dt][1], 0, 0, 0); }
      }
      bf16_t* Sp = ST + (((size_t)gc * 4 + h) * 2 + dir) * 32768;
#pragma unroll
      for (int dt = 0; dt < 8; ++dt)
#pragma unroll
        for (int et = 0; et < 2; ++et) { const f32x4 v = acc[dt][et];
          *(unsigned long long*)(Sp + (size_t)(32 * wid + 16 * et + r) * 128 + 16 * dt + 4 * Qd) = (unsigned long long)pk2(v[0], v[1]) | ((unsigned long long)pk2(v[2], v[3]) << 32); }
    }
  }
}
DEV void gla_scan_phase(bf16_t* ST, const float* GDEC) {
  for (int item = blockIdx.x * 512 + threadIdx.x; item < 2 * 4 * 2 * 8192; item += gridDim.x * 512) {
    const int e4 = item & 8191, dir = (item >> 13) & 1, h = (item >> 14) & 3, b = item >> 16; const int d0 = (e4 * 4) & 127;
    float S0 = 0.f, S1 = 0.f, S2 = 0.f, S3 = 0.f;
#define SCAN_GC(s) (!dir ? ((s) < 2 ? 128 + 2 * b + (s) : b * 64 + ((s) - 2)) : ((s) < 2 ? 128 + 2 * b + (1 - (s)) : b * 64 + (65 - (s))))
    for (int s0 = 0; s0 < 66; s0 += 6) {
      unsigned long long u[6]; f32x4 dec[6];
#pragma unroll
      for (int q = 0; q < 6; ++q) { const int gc = SCAN_GC(s0 + q); u[q] = *(const unsigned long long*)(ST + (((size_t)gc * 4 + h) * 2 + dir) * 32768 + e4 * 4); dec[q] = *(const f32x4*)(GDEC + ((gc * 4 + h) * 2 + dir) * 128 + d0); }
#pragma unroll
      for (int q = 0; q < 6; ++q) { const int gc = SCAN_GC(s0 + q);
        *(unsigned long long*)(ST + (((size_t)gc * 4 + h) * 2 + dir) * 32768 + e4 * 4) = (unsigned long long)pk2(S0, S1) | ((unsigned long long)pk2(S2, S3) << 32);
        const unsigned lo = (unsigned)u[q], hi = (unsigned)(u[q] >> 32);
        S0 = dec[q].x * S0 + __uint_as_float(lo << 16); S1 = dec[q].y * S1 + __uint_as_float(lo & 0xffff0000u); S2 = dec[q].z * S2 + __uint_as_float(hi << 16); S3 = dec[q].w * S3 + __uint_as_float(hi & 0xffff0000u); }
    }
#undef SCAN_GC
  }
}
DEV void gla_o_phase(const bf16_t* Q0, const bf16_t* K0, const bf16_t* V0, const float* GCSL, const float* GCSC, const bf16_t* ST, const float* gla_norm, const float* SSQ, const float* ssd_norm, bf16_t* Y0, LAS unsigned char* lds) {
  constexpr int VP = 272, KP = 136;
  LAS bf16_t* Vs = (LAS bf16_t*)lds; LAS bf16_t* Kd = (LAS bf16_t*)(lds + 128 * VP * 2);
  const int tid = threadIdx.x, lane = tid & 63, wid = tid >> 6, r = lane & 15, Qd = lane >> 4;
  const float scale = 0.08838834764831845f;
  for (int task = blockIdx.x; task < NCH * 4; task += gridDim.x) {
    const int gc = task >> 2, h = task & 3; const size_t r0 = (size_t)gc * 128;
    __syncthreads();
#pragma unroll
    for (int i = 0; i < 8; ++i) { const int cid = tid + 512 * i, row = cid >> 5, ch = cid & 31; *(LAS v4u*)(Vs + row * VP + ch * 8) = *(const v4u*)(V0 + (r0 + row) * 1024 + h * 256 + ch * 8); }
#pragma unroll
    for (int i = 0; i < 4; ++i) { const int cid = tid + 512 * i, t = cid >> 4, ch = cid & 15;
      const v4u kv = *(const v4u*)(K0 + (r0 + t) * 512 + h * 128 + ch * 8);
      const float kf[8] = {__uint_as_float(kv.x << 16), __uint_as_float(kv.x & 0xffff0000u), __uint_as_float(kv.y << 16), __uint_as_float(kv.y & 0xffff0000u), __uint_as_float(kv.z << 16), __uint_as_float(kv.z & 0xffff0000u), __uint_as_float(kv.w << 16), __uint_as_float(kv.w & 0xffff0000u)};
#pragma unroll
      for (int dir = 0; dir < 2; ++dir) {
        const float* ct = gcs_row(GCSL, GCSC, r0 + t) + dir * 512 + h * 128 + ch * 8;
        const f32x4 c0 = *(const f32x4*)ct, c1 = *(const f32x4*)(ct + 4);
        v4u o; o.x = pk2(kf[0] * __expf(-c0.x), kf[1] * __expf(-c0.y)); o.y = pk2(kf[2] * __expf(-c0.z), kf[3] * __expf(-c0.w));
        o.z = pk2(kf[4] * __expf(-c1.x), kf[5] * __expf(-c1.y)); o.w = pk2(kf[6] * __expf(-c1.z), kf[7] * __expf(-c1.w));
        *(LAS v4u*)(Kd + dir * 128 * KP + t * KP + ch * 8) = o; } }
    __syncthreads();
    const int i = 16 * wid + r;
    f32x4 o[16];
#pragma unroll
    for (int et = 0; et < 16; ++et) o[et] = (f32x4){0.f, 0.f, 0.f, 0.f};
#pragma unroll 1
    for (int dir = 0; dir < 2; ++dir) {
      bf16x8 qd[4];
      { const float* ci = gcs_row(GCSL, GCSC, r0 + i) + dir * 512 + h * 128; const bf16_t* qp = Q0 + (r0 + i) * 512 + h * 128;
#pragma unroll
        for (int ks = 0; ks < 4; ++ks) { const v4u qv = *(const v4u*)(qp + 32 * ks + 8 * Qd); const f32x4 c0 = *(const f32x4*)(ci + 32 * ks + 8 * Qd), c1 = *(const f32x4*)(ci + 32 * ks + 8 * Qd + 4);
          const unsigned w0 = pk2(__uint_as_float(qv.x << 16) * scale * __expf(c0.x), __uint_as_float(qv.x & 0xffff0000u) * scale * __expf(c0.y));
          const unsigned w1 = pk2(__uint_as_float(qv.y << 16) * scale * __expf(c0.z), __uint_as_float(qv.y & 0xffff0000u) * scale * __expf(c0.w));
          const unsigned w2 = pk2(__uint_as_float(qv.z << 16) * scale * __expf(c1.x), __uint_as_float(qv.z & 0xffff0000u) * scale * __expf(c1.y));
          const unsigned w3 = pk2(__uint_as_float(qv.w << 16) * scale * __expf(c1.z), __uint_as_float(qv.w & 0xffff0000u) * scale * __expf(c1.w));
          qd[ks] = (bf16x8){(short)(w0 & 0xffff), (short)(w0 >> 16), (short)(w1 & 0xffff), (short)(w1 >> 16), (short)(w2 & 0xffff), (short)(w2 >> 16), (short)(w3 & 0xffff), (short)(w3 >> 16)}; } }
      const bf16_t* Sp = ST + (((size_t)gc * 4 + h) * 2 + dir) * 32768;
#pragma unroll 1
      for (int ks = 0; ks < 4; ++ks)
#pragma unroll
        for (int et = 0; et < 16; ++et) { const bf16x8 sf = *(const bf16x8*)(Sp + (size_t)(16 * et + r) * 128 + 32 * ks + 8 * Qd); o[et] = __builtin_amdgcn_mfma_f32_16x16x32_bf16(qd[ks], sf, o[et], 0, 0, 0); }
      const LAS bf16_t* Kb = Kd + dir * 128 * KP;
#pragma unroll 1
      for (int k2 = 0; k2 < 4; ++k2) {
        const bool need = dir ? (2 * k2 + 1 >= wid) : (2 * k2 <= wid);
        if (!need) continue;
        bf16x8 pa;
#pragma unroll
        for (int tt = 0; tt < 2; ++tt) { const int t = 2 * k2 + tt;
          f32x4 c = {0.f, 0.f, 0.f, 0.f};
#pragma unroll
          for (int ks = 0; ks < 4; ++ks) { const bf16x8 kfr = *(const LAS bf16x8*)(Kb + (16 * t + r) * KP + 32 * ks + 8 * Qd); c = __builtin_amdgcn_mfma_f32_16x16x32_bf16(kfr, qd[ks], c, 0, 0, 0); }
          float pv[4];
#pragma unroll
          for (int jj = 0; jj < 4; ++jj) { const int j = 16 * t + 4 * Qd + jj; const bool ok = dir ? (j >= i) : (j <= i); pv[jj] = ok ? c[jj] : 0.f; }
          const unsigned w0 = pk2(pv[0], pv[1]), w1 = pk2(pv[2], pv[3]);
          pa[tt * 4 + 0] = (short)(w0 & 0xffff); pa[tt * 4 + 1] = (short)(w0 >> 16); pa[tt * 4 + 2] = (short)(w1 & 0xffff); pa[tt * 4 + 3] = (short)(w1 >> 16); }
#pragma unroll
        for (int et = 0; et < 16; ++et) {
          const s16x4 lo = tr_read(Vs + (32 * k2 + 4 * Qd + (r >> 2)) * VP + 16 * et + 4 * (r & 3));
          const s16x4 hi = tr_read(Vs + (32 * k2 + 16 + 4 * Qd + (r >> 2)) * VP + 16 * et + 4 * (r & 3));
          const bf16x8 vf = (bf16x8){lo[0], lo[1], lo[2], lo[3], hi[0], hi[1], hi[2], hi[3]};
          o[et] = __builtin_amdgcn_mfma_f32_16x16x32_bf16(pa, vf, o[et], 0, 0, 0); }
      }
    }
#pragma unroll
    for (int jj = 0; jj < 4; ++jj) { float ss = 0.f;
#pragma unroll
      for (int et = 0; et < 16; ++et) ss += o[et][jj] * o[et][jj];
      ss += __shfl_xor(ss, 1); ss += __shfl_xor(ss, 2); ss += __shfl_xor(ss, 4); ss += __shfl_xor(ss, 8);
      const float rstd = rsqrtf(ss * (1.f / 256.f) + EPS);
      const size_t yo = (r0 + 16 * wid + 4 * Qd + jj) * 2048 + 1024 + h * 256 + r;
#pragma unroll
      for (int et = 0; et < 16; ++et) Y0[yo + 16 * et] = f2bf(o[et][jj] * rstd * gla_norm[h * 256 + 16 * et + r] * bf2f(Y0[yo + 16 * et])); }
    { const int g = h >> 1, c0 = g * 512 + (h & 1) * 256;
#pragma unroll
      for (int q = 0; q < 8; ++q) { const int cid = tid + 512 * q, row = cid >> 5, ch = cid & 31; const size_t rr = r0 + row;
        const float rstd = rsqrtf((SSQ[(rr * 2 + g) * 2] + SSQ[(rr * 2 + g) * 2 + 1]) * (1.f / 512.f) + EPS);
        bf16_t* yp = Y0 + rr * 2048 + c0 + ch * 8; const v4u yv = *(const v4u*)yp; const f32x4 g0 = *(const f32x4*)(ssd_norm + c0 + ch * 8), g1 = *(const f32x4*)(ssd_norm + c0 + ch * 8 + 4);
        v4u ov; ov.x = pk2(__uint_as_float(yv.x << 16) * rstd * g0.x, __uint_as_float(yv.x & 0xffff0000u) * rstd * g0.y); ov.y = pk2(__uint_as_float(yv.y << 16) * rstd * g0.z, __uint_as_float(yv.y & 0xffff0000u) * rstd * g0.w);
        ov.z = pk2(__uint_as_float(yv.z << 16) * rstd * g1.x, __uint_as_float(yv.z & 0xffff0000u) * rstd * g1.y); ov.w = pk2(__uint_as_float(yv.w << 16) * rstd * g1.z, __uint_as_float(yv.w & 0xffff0000u) * rstd * g1.w);
        *(v4u*)yp = ov; } }
  }
}

__global__ void __launch_bounds__(NWAVES * 64, 2) mega(Params p) {
  extern __shared__ __attribute__((aligned(16))) unsigned char lds_raw[];
  LAS unsigned char* lds = (LAS unsigned char*)lds_raw;
  cg::grid_group grid = cg::this_grid();
  unsigned char* ws = p.ws;
  float* MOD = (float*)(ws + WS_MOD);
  bf16_t* H0 = (bf16_t*)p.out; float* X1 = p.out;
  const int lo = p.ph_lo, hi = p.ph_hi;
#define IN(k) (lo <= (k) && (k) < hi)
#define SEAM(k) do { if ((k) + 1 < hi) grid.sync(); } while (0)
  if (IN(0)) { prologue_phase(p, lds); SEAM(0); }
  if (IN(1)) { prep_phase(p.in[0], p.in[2], p.in[4], MOD, H0); SEAM(1); }
  if (IN(2)) {
    pg8::Gemm g{H0, (const bf16_t*)(ws + WS_W1T), MA, E_INP, D}; pg8::StaticOrder S; S.init(MA, E_INP, gridDim.x, (int)blockIdx.x);
    pg8::EpiProj0 E{(bf16_t*)(ws + WS_Y0), (bf16_t*)(ws + WS_XBC), (bf16_t*)(ws + WS_Q0), (bf16_t*)(ws + WS_K0), (bf16_t*)(ws + WS_V0), (float*)(ws + WS_DTLR)};
    pg8::gemm_phase<pg8::EpiProj0, pg8::StaticOrder, true, true>(lds, g, S, E);
    SEAM(2);
  }
  if (IN(3)) { ssd_prep_phase((const bf16_t*)(ws + WS_XBC), p.in[8], p.in[9], (bf16_t*)p.out, (const float*)(ws + WS_DTLR), p.in[10], p.in[11], (float*)((char*)p.out + DO_SDT), (float*)((char*)p.out + DO_SCS), (float*)(ws + WS_SDEC)); SEAM(3); }
  if (IN(4)) { ssd_u_phase((const bf16_t*)p.out, (const float*)((char*)p.out + DO_SDT), (const float*)((char*)p.out + DO_SCS), (bf16_t*)(ws + WS_STATE), lds); SEAM(4); }
  if (IN(5)) { ssd_scan_phase((bf16_t*)(ws + WS_STATE), (const float*)(ws + WS_SDEC)); SEAM(5); }
  if (IN(6)) { ssd_y_phase((const bf16_t*)p.out, (const float*)((char*)p.out + DO_SDT), (const float*)((char*)p.out + DO_SCS), (const bf16_t*)(ws + WS_STATE), p.in[12], (bf16_t*)(ws + WS_Y0), (float*)(ws + WS_SSQ), lds); SEAM(6); }
  if (IN(7)) { gla_cs_phase((const float*)(ws + WS_DTLR), p.in[14], p.in[15], (float*)p.out, (float*)(ws + WS_GCSC), (float*)(ws + WS_GDEC)); SEAM(7); }
  if (IN(8)) { gla_u_phase((const bf16_t*)(ws + WS_K0), (const bf16_t*)(ws + WS_V0), (const float*)p.out, (const float*)(ws + WS_GCSC), (bf16_t*)(ws + WS_STATE), lds); SEAM(8); }
  if (IN(9)) { gla_scan_phase((bf16_t*)(ws + WS_STATE), (const float*)(ws + WS_GDEC)); SEAM(9); }
  if (IN(10)) { gla_o_phase((const bf16_t*)(ws + WS_Q0), (const bf16_t*)(ws + WS_K0), (const bf16_t*)(ws + WS_V0), (const float*)p.out, (const float*)(ws + WS_GCSC), (const bf16_t*)(ws + WS_STATE), p.in[16], (const float*)(ws + WS_SSQ), p.in[13], (bf16_t*)(ws + WS_Y0), lds); SEAM(10); }
  if (IN(11)) {
    pg8::Gemm g{(const bf16_t*)(ws + WS_Y0), (const bf16_t*)(ws + WS_W2T), ML, D, 2048}; pg8::StaticOrder S; S.init(ML, D, gridDim.x, (int)blockIdx.x);
    pg8::EpiResid E{p.in[0], X1, MOD};
    pg8::gemm_phase<pg8::EpiResid, pg8::StaticOrder, true, true>(lds, g, S, E);
    const float* ctx = p.in[2]; float* XC1 = (float*)(ws + WS_XC1); const float* gate = MOD + 2 * 3072 + 2048;
    small_gemm((const bf16_t*)(ws + WS_Y0) + (size_t)ML * 2048, 2048, (const bf16_t*)(ws + WS_W2T), 2048, 2048, MC, D,
               [=](int m, int n, float v) { XC1[(size_t)m * D + n] = ctx[(size_t)m * D + n] + gate[n] * v; });
    SEAM(11);
  }
  if (IN(12)) { prep_phase(X1, (const float*)(ws + WS_XC1), p.in[18], MOD + 3 * 3072, (bf16_t*)(ws + WS_H1)); SEAM(12); }
  if (IN(13)) {
    pg8::Gemm g{(const bf16_t*)(ws + WS_H1), (const bf16_t*)(ws + WS_W3T), ML, O_IN, D}; pg8::StaticOrder S; S.init(ML, O_IN, gridDim.x, (int)blockIdx.x);
    pg8::EpiProj1 E{(bf16_t*)(ws + WS_K1), (bf16_t*)(ws + WS_V1), (bf16_t*)(ws + WS_Q1), (bf16_t*)(ws + WS_G1)};
    pg8::gemm_phase<pg8::EpiProj1, pg8::StaticOrder, true, true>(lds, g, S, E);
    bf16_t* K1 = (bf16_t*)(ws + WS_K1); bf16_t* V1 = (bf16_t*)(ws + WS_V1);
    small_gemm((const bf16_t*)(ws + WS_H1) + (size_t)ML * D, D, (const bf16_t*)(ws + WS_W3T), D, D, MC, 1024,
               [=](int m, int n, float v) { if (n < 512) K1[(size_t)(ML + m) * 512 + n] = f2bf(v); else V1[(size_t)(ML + m) * 512 + (n - 512)] = f2bf(v); });
    SEAM(13);
  }
  if (IN(14)) { qknorm_phase((bf16_t*)(ws + WS_Q1), (bf16_t*)(ws + WS_K1), p.in[22], p.in[23], (const float*)(ws + WS_ROPE)); SEAM(14); }
  if (IN(15)) { attn_phase((bf16_t*)(ws + WS_Q1), (const bf16_t*)(ws + WS_K1), (const bf16_t*)(ws + WS_V1), (const bf16_t*)(ws + WS_G1), p.in[24], p.in[22], p.in[23], lds); SEAM(15); }
  if (IN(16)) {
    pg8::Gemm g{(const bf16_t*)(ws + WS_Q1), (const bf16_t*)(ws + WS_W4T), ML, D, 2048}; pg8::StaticOrder S; S.init(ML, D, gridDim.x, (int)blockIdx.x);
    pg8::EpiResid E{X1, p.out, MOD + 3 * 3072};
    pg8::gemm_phase<pg8::EpiResid, pg8::StaticOrder, true, true>(lds, g, S, E);
  }
#undef IN
#undef SEAM
}
__global__ void __launch_bounds__(256) k_ssd_conv(const bf16_t* XBC, const float* cw  , const float* cb, bf16_t* XC) {
  int ch = blockIdx.x * 256 + threadIdx.x; int row = blockIdx.y;
  int t, len, base;
  if (row < ML) { t = row % SEQ; len = SEQ; base = row - t; } else { t = (row - ML) % CTXL; len = CTXL; base = row - t; }
  float a = cb[ch];
#pragma unroll
  for (int k = 0; k < 5; ++k) { int tt = t + k - 2; if (tt >= 0 && tt < len) a += cw[k * 1536 + ch] * bf2f(XBC[(size_t)(base + tt) * 1536 + ch]); }
  XC[(size_t)row * 1536 + ch] = f2bf(siluf(a));
}
__global__ void __launch_bounds__(256) k_ssd_dt(const float* DTLR, const float* dt_bias, const float* a_log, float* SDT, float* SCS, float* SDEC) {
  int idx = blockIdx.x * 256 + threadIdx.x; if (idx >= NCH * 32) return;
  int gc = idx / 32, col = idx % 32, dir = col / 16, h = col % 16;
  float a = -__expf(a_log[col]); float bias = dt_bias[col];
  float cs = 0.f;
  for (int s = 0; s < 128; ++s) {
    int t = dir ? 127 - s : s; size_t row = (size_t)gc * 128 + t;
    float dt = softplusf(DTLR[row * 64 + col] + bias);
    cs += dt * a;
    SDT[row * 32 + col] = dt; SCS[row * 32 + col] = cs;
  }
  SDEC[(gc * 16 + h) * 2 + dir] = __expf(cs);
}
__global__ void __launch_bounds__(256) k_ssd_cb(const bf16_t* XC, float* CB) {
  __shared__ float cs[128];
  int gc = blockIdx.x / 256, g = (blockIdx.x / 128) & 1, i = blockIdx.x & 127;
  int j = threadIdx.x & 127, half = threadIdx.x >> 7;
  size_t r0 = (size_t)gc * 128;
  if (threadIdx.x < 128) cs[threadIdx.x] = bf2f(XC[(r0 + i) * 1536 + 1280 + g * 128 + threadIdx.x]);
  __syncthreads();
  float a = 0.f;
  for (int n = half * 64; n < half * 64 + 64; ++n) a += cs[n] * bf2f(XC[(r0 + j) * 1536 + 1024 + g * 128 + n]);
  __shared__ float part[256];
  part[threadIdx.x] = a; __syncthreads();
  if (threadIdx.x < 128) CB[(((size_t)gc * 2 + g) * 128 + i) * 128 + j] = part[j] + part[128 + j];
}
__global__ void __launch_bounds__(256) k_ssd_u(const bf16_t* XC, const float* SDT, const float* SCS, bf16_t* ST) {
  __shared__ float w[128];
  int gc = blockIdx.x / 32, h = (blockIdx.x / 2) & 15, dir = blockIdx.x & 1; int g = h / 8;
  size_t r0 = (size_t)gc * 128; int col = dir * 16 + h;
  float cs_end = SCS[(r0 + (dir ? 0 : 127)) * 32 + col];
  if (threadIdx.x < 128) w[threadIdx.x] = __expf(cs_end - SCS[(r0 + threadIdx.x) * 32 + col]) * SDT[(r0 + threadIdx.x) * 32 + col];
  __syncthreads();
  int n = threadIdx.x & 127, ph = threadIdx.x >> 7;
  for (int p = ph; p < 64; p += 2) {
    float a = 0.f;
    for (int t = 0; t < 128; ++t) a += w[t] * bf2f(XC[(r0 + t) * 1536 + h * 64 + p]) * bf2f(XC[(r0 + t) * 1536 + 1024 + g * 128 + n]);
    ST[((((size_t)gc * 16 + h) * 2 + dir) * 64 + p) * 128 + n] = f2bf(a);
  }
}
__global__ void __launch_bounds__(256) k_ssd_scan(bf16_t* ST, const float* SDEC) {
  int idx = blockIdx.x * 256 + threadIdx.x;
  int e = idx & 8191, dir = (idx >> 13) & 1, h = (idx >> 14) & 15, b = idx >> 18;
  float S = 0.f;
  for (int s = 0; s < 66; ++s) {
    int gc;
    if (!dir) gc = s < 2 ? 128 + 2 * b + s : b * 64 + (s - 2);
    else gc = s < 2 ? 128 + 2 * b + (1 - s) : b * 64 + (65 - s);
    size_t off = (((size_t)gc * 16 + h) * 2 + dir) * 8192 + e;
    float u = bf2f(ST[off]); ST[off] = f2bf(S);
    S = SDEC[(gc * 16 + h) * 2 + dir] * S + u;
  }
}
__global__ void __launch_bounds__(512) k_ssd_y(const bf16_t* XC, const float* CB, const float* SDT, const float* SCS, const bf16_t* ST, const float* d_skip, const float* norm_g, bf16_t* Y0) {
  __shared__ float cbr[128]; __shared__ float crow[128]; __shared__ float red[8];
  int row = blockIdx.x >> 1, g = blockIdx.x & 1; int gc = row >> 7, i = row & 127; size_t r0 = (size_t)gc * 128;
  int hh = threadIdx.x >> 6, p = threadIdx.x & 63, h = g * 8 + hh;
  if (threadIdx.x < 128) { cbr[threadIdx.x] = CB[(((size_t)gc * 2 + g) * 128 + i) * 128 + threadIdx.x]; crow[threadIdx.x] = bf2f(XC[(size_t)row * 1536 + 1280 + g * 128 + threadIdx.x]); }
  __syncthreads();
  float csf_i = SCS[(size_t)row * 32 + h], csb_i = SCS[(size_t)row * 32 + 16 + h];
  float acc = 0.f;
  for (int j = 0; j <= i; ++j) acc += cbr[j] * __expf(csf_i - SCS[(r0 + j) * 32 + h]) * SDT[(r0 + j) * 32 + h] * bf2f(XC[(r0 + j) * 1536 + h * 64 + p]);
  for (int j = i; j < 128; ++j) acc += cbr[j] * __expf(csb_i - SCS[(r0 + j) * 32 + 16 + h]) * SDT[(r0 + j) * 32 + 16 + h] * bf2f(XC[(r0 + j) * 1536 + h * 64 + p]);
  const bf16_t* Sf = ST + ((((size_t)gc * 16 + h) * 2 + 0) * 64 + p) * 128; const bf16_t* Sb = Sf + 8192;
  float of = 0.f, ob = 0.f;
  for (int n = 0; n < 128; ++n) { of += crow[n] * bf2f(Sf[n]); ob += crow[n] * bf2f(Sb[n]); }
  acc += __expf(csf_i) * of + __expf(csb_i) * ob;
  acc += d_skip[h] * bf2f(XC[(size_t)row * 1536 + h * 64 + p]);
  size_t yo = (size_t)row * 2048 + g * 512 + threadIdx.x;
  acc *= bf2f(Y0[yo]);
  float ss = block_sum<512>(acc * acc, red);
  Y0[yo] = f2bf(acc * rsqrtf(ss / 512.f + EPS) * norm_g[g * 512 + threadIdx.x]);
}

DEV float* gcs_ptr(float* lat, float* ctx, size_t row) { return row < (size_t)ML ? lat + row * 1024 : ctx + (row - ML) * 1024; }
__global__ void __launch_bounds__(256) k_gla_cs(const float* DTLR, const float* gw  , const float* gb  , float* GCSL, float* GCSC, float* GDEC) {
  int idx = blockIdx.x * 256 + threadIdx.x; if (idx >= NCH * 1024) return;
  int gc = idx / 1024, dk = idx % 1024, dir = dk / 512, k = dk % 512;
  float wv[16];
#pragma unroll
  for (int r = 0; r < 16; ++r) wv[r] = gw[(dir * 16 + r) * 512 + k];
  float bias = gb[dir * 512 + k], cs = 0.f;
  for (int s = 0; s < 128; ++s) {
    int t = dir ? 127 - s : s; size_t row = (size_t)gc * 128 + t;
    float lg = bias;
#pragma unroll
    for (int r = 0; r < 16; ++r) lg += DTLR[row * 64 + 32 + dir * 16 + r] * wv[r];
    cs += logsigmoidf(lg) * (1.f / 16.f);
    gcs_ptr(GCSL, GCSC, row)[dk] = cs;
  }
  GDEC[((gc * 4 + k / 128) * 2 + dir) * 128 + (k & 127)] = __expf(cs);
}
__global__ void __launch_bounds__(256) k_gla_u(const bf16_t* K0, const bf16_t* V0, float* GCSL, float* GCSC, bf16_t* ST) {
  int bid = blockIdx.x; int ep = bid & 127; bid >>= 7; int dir = bid & 1; bid >>= 1; int h = bid & 3; int gc = bid >> 2;
  int d = threadIdx.x & 127, e = ep * 2 + (threadIdx.x >> 7);
  size_t r0 = (size_t)gc * 128;
  float cs_end = gcs_ptr(GCSL, GCSC, r0 + (dir ? 0 : 127))[dir * 512 + h * 128 + d];
  float a = 0.f;
  for (int t = 0; t < 128; ++t) {
    float cs = gcs_ptr(GCSL, GCSC, r0 + t)[dir * 512 + h * 128 + d];
    a += bf2f(K0[(r0 + t) * 512 + h * 128 + d]) * __expf(cs_end - cs) * bf2f(V0[(r0 + t) * 1024 + h * 256 + e]);
  }
  ST[((((size_t)gc * 4 + h) * 2 + dir) * 256 + e) * 128 + d] = f2bf(a);
}
__global__ void __launch_bounds__(256) k_gla_scan(bf16_t* ST, const float* GDEC) {
  int idx = blockIdx.x * 256 + threadIdx.x;
  int e = idx & 32767, dir = (idx >> 15) & 1, h = (idx >> 16) & 3, b = idx >> 18;
  int d = e & 127;
  float S = 0.f;
  for (int s = 0; s < 66; ++s) {
    int gc;
    if (!dir) gc = s < 2 ? 128 + 2 * b + s : b * 64 + (s - 2);
    else gc = s < 2 ? 128 + 2 * b + (1 - s) : b * 64 + (65 - s);
    size_t off = (((size_t)gc * 4 + h) * 2 + dir) * 32768 + e;
    float u = bf2f(ST[off]); ST[off] = f2bf(S);
    S = GDEC[((gc * 4 + h) * 2 + dir) * 128 + d] * S + u;
  }
}
__global__ void __launch_bounds__(256) k_gla_o(const bf16_t* Q0, const bf16_t* K0, const bf16_t* V0, float* GCSL, float* GCSC, const bf16_t* ST, const float* norm_g, bf16_t* Y0) {
  __shared__ float q[128]; __shared__ float csi[2][128]; __shared__ float att[2][128]; __shared__ float red[4];
  int row = blockIdx.x >> 2, h = blockIdx.x & 3; int gc = row >> 7, i = row & 127; size_t r0 = (size_t)gc * 128;
  const float scale = 0.08838834764831845f;
  if (threadIdx.x < 128) q[threadIdx.x] = bf2f(Q0[(size_t)row * 512 + h * 128 + threadIdx.x]) * scale;
  { int dir = threadIdx.x >> 7, d = threadIdx.x & 127; csi[dir][d] = gcs_ptr(GCSL, GCSC, row)[dir * 512 + h * 128 + d]; }
  __syncthreads();
  { int dir = threadIdx.x >> 7, j = threadIdx.x & 127; float a = 0.f;
    bool ok = dir ? (j >= i) : (j <= i);
    if (ok) { const float* csj = gcs_ptr(GCSL, GCSC, r0 + j) + dir * 512 + h * 128; const bf16_t* kj = K0 + (r0 + j) * 512 + h * 128;
      for (int d = 0; d < 128; ++d) a += q[d] * bf2f(kj[d]) * __expf(csi[dir][d] - csj[d]); }
    att[dir][j] = a; }
  __syncthreads();
  int e = threadIdx.x;
  float o = 0.f;
  for (int j = 0; j < 128; ++j) o += (att[0][j] + att[1][j]) * bf2f(V0[(r0 + j) * 1024 + h * 256 + e]);
  const bf16_t* Sf = ST + ((((size_t)gc * 4 + h) * 2 + 0) * 256 + e) * 128; const bf16_t* Sb = Sf + 32768;
  for (int d = 0; d < 128; ++d) o += q[d] * (__expf(csi[0][d]) * bf2f(Sf[d]) + __expf(csi[1][d]) * bf2f(Sb[d]));
  float ss = block_sum<256>(o * o, red);
  size_t yo = (size_t)row * 2048 + 1024 + h * 256 + e;
  Y0[yo] = f2bf(o * rsqrtf(ss / 256.f + EPS) * norm_g[h * 256 + e] * bf2f(Y0[yo]));
}

__global__ void __launch_bounds__(128) k_qknorm(bf16_t* Q1, bf16_t* K1, const float* qn, const float* kn, const float* rope) {
  __shared__ float red[2]; __shared__ float buf[128];
  int row = blockIdx.x, d = threadIdx.x;
  bool lat = row < ML; int t = lat ? row % SEQ : 0;
  int a = d >> 6, s = (d >> 5) & 1, f = d & 31; int pos = a ? (t & 63) : (t >> 6);
  float cs = rope[pos * 32 + f], sn = rope[4096 + pos * 32 + f];
  const float scale = 0.08838834764831845f;
  int nh = lat ? 20 : 4;
  for (int hh = 0; hh < nh; ++hh) {
    bool isq = hh >= 4; bf16_t* p = isq ? Q1 + (size_t)row * 2048 + (hh - 4) * 128 : K1 + (size_t)row * 512 + hh * 128;
    float v = bf2f(p[d]);
    float ss = block_sum<128>(v * v, red);
    v = v * rsqrtf(ss / 128.f + EPS) * (isq ? qn[d] : kn[d]);
    if (lat) { buf[d] = v; __syncthreads(); float o = buf[d ^ 32]; v = s ? (v * cs + o * sn) : (v * cs - o * sn); }
    if (isq) v *= scale;
    __syncthreads();
    p[d] = f2bf(v);
  }
}
__global__ void __launch_bounds__(512) k_attn(bf16_t* Q1, const bf16_t* K1, const bf16_t* V1, const bf16_t* G1, const float* sink) {
  __shared__ float q[4][128]; __shared__ float sc[4][648]; __shared__ float red[8]; __shared__ float den[4];
  int row = blockIdx.x >> 2, kvh = blockIdx.x & 3; int b = row / SEQ, t = row % SEQ;
  { int hq = threadIdx.x >> 7, d = threadIdx.x & 127; q[hq][d] = bf2f(Q1[(size_t)row * 2048 + (kvh * 4 + hq) * 128 + d]); }
  __syncthreads();
  int klo = t - 128 < 0 ? 0 : t - 128, khi = t + 128 > SEQ - 1 ? SEQ - 1 : t + 128; int nband = khi - klo + 1, nk = nband + CTXL;
  for (int ki = threadIdx.x; ki < nk; ki += 512) {
    size_t kr = ki < nband ? (size_t)b * SEQ + klo + ki : (size_t)ML + b * CTXL + (ki - nband);
    const bf16_t* kp = K1 + kr * 512 + kvh * 128;
    float a0 = 0.f, a1 = 0.f, a2 = 0.f, a3 = 0.f;
    for (int d = 0; d < 128; ++d) { float kv = bf2f(kp[d]); a0 += q[0][d] * kv; a1 += q[1][d] * kv; a2 += q[2][d] * kv; a3 += q[3][d] * kv; }
    sc[0][ki] = a0; sc[1][ki] = a1; sc[2][ki] = a2; sc[3][ki] = a3;
  }
  __syncthreads();
  for (int hq = 0; hq < 4; ++hq) {
    float sk = sink[kvh * 4 + hq];
    float m = -INFINITY;
    for (int ki = threadIdx.x; ki < nk; ki += 512) m = fmaxf(m, sc[hq][ki]);
    m = fmaxf(block_max<512>(m, red), sk);
    float s = 0.f;
    for (int ki = threadIdx.x; ki < nk; ki += 512) { float p = __expf(sc[hq][ki] - m); sc[hq][ki] = p; s += p; }
    s = block_sum<512>(s, red);
    if (threadIdx.x == 0) den[hq] = s + __expf(sk - m);
  }
  __syncthreads();
  int hq = threadIdx.x >> 7, d = threadIdx.x & 127;
  float o = 0.f;
  for (int ki = 0; ki < nk; ++ki) {
    size_t kr = ki < nband ? (size_t)b * SEQ + klo + ki : (size_t)ML + b * CTXL + (ki - nband);
    o += sc[hq][ki] * bf2f(V1[kr * 512 + kvh * 128 + d]);
  }
  size_t oo = (size_t)row * 2048 + (kvh * 4 + hq) * 128 + d;
  Q1[oo] = f2bf(o / den[hq] * bf2f(G1[oo]));
}


__global__ void __launch_bounds__(256) k_ssd_norm(bf16_t* Y0, const float* SSQ, const float* norm_g) {
  int row = blockIdx.x;
  for (int c = threadIdx.x; c < 1024; c += 256) { int g = c >> 9; float ss = SSQ[(row * 2 + g) * 2] + SSQ[(row * 2 + g) * 2 + 1];
    size_t o = (size_t)row * 2048 + c; Y0[o] = f2bf(bf2f(Y0[o]) * rsqrtf(ss / 512.f + EPS) * norm_g[c]); }
}
extern "C" void kernel_launch(void* const* d_in, const int* in_sizes, int n_in, void* d_out, int out_size, void* d_ws, size_t ws_size, hipStream_t stream) {
  static int grid_blocks = 0;
  if (!grid_blocks) {
    int dev = 0, cus = 0, per_cu = 0;
    hipGetDevice(&dev);
    hipDeviceGetAttribute(&cus, hipDeviceAttributeMultiprocessorCount, dev);
    hipFuncSetAttribute((const void*)mega, hipFuncAttributeMaxDynamicSharedMemorySize, LDS_BYTES);
    hipOccupancyMaxActiveBlocksPerMultiprocessor(&per_cu, (const void*)mega, NWAVES * 64, LDS_BYTES);
    if (per_cu < 1) { fprintf(stderr, "kernel_launch: occupancy query says %d blocks per CU\n", per_cu); per_cu = 1; }
    if (per_cu > 1) per_cu = 1;
    grid_blocks = cus * per_cu;
  }
  const float* const* in = (const float* const*)d_in;
  const float* e_conv_w = in[8]; const float* e_conv_b = in[9]; const float* e_dt_bias = in[10]; const float* e_a_log = in[11];
  const float* e_d_skip = in[12]; const float* e_ssd_norm = in[13]; const float* e_gate_w = in[14]; const float* e_gate_b = in[15];
  const float* e_gla_norm = in[16]; const float* o_q_norm = in[22]; const float* o_k_norm = in[23]; const float* o_sink = in[24];
  char* ws = (char*)d_ws;
  float* ROPE = (float*)(ws + WS_ROPE); float* SDEC = (float*)(ws + WS_SDEC); float* GDEC = (float*)(ws + WS_GDEC);
  float* CB = (float*)(ws + WS_TAIL); float* SDT = (float*)((char*)d_out + 50 * MiB); float* SCS = (float*)((char*)d_out + 53 * MiB); float* GCSC = (float*)(ws + WS_TAIL + 4 * MiB);
  bf16_t* Y0 = (bf16_t*)(ws + WS_Y0); bf16_t* Q0 = (bf16_t*)(ws + WS_Q0); bf16_t* K0 = (bf16_t*)(ws + WS_K0); bf16_t* V0 = (bf16_t*)(ws + WS_V0);
  float* DTLR = (float*)(ws + WS_DTLR); bf16_t* XBC = (bf16_t*)(ws + WS_XBC); bf16_t* ST = (bf16_t*)(ws + WS_STATE);
  bf16_t* K1 = (bf16_t*)(ws + WS_K1); bf16_t* V1 = (bf16_t*)(ws + WS_V1); bf16_t* Q1 = (bf16_t*)(ws + WS_Q1); bf16_t* G1 = (bf16_t*)(ws + WS_G1);
  bf16_t* XC = (bf16_t*)d_out; float* GCSL = (float*)d_out;

  Params base{};
  for (int i = 0; i < 26; ++i) base.in[i] = (const float*)d_in[i];
  base.out = (float*)d_out; base.ws = (unsigned char*)d_ws;
  auto launch = [&](int lo, int hi) {
    Params p = base; p.ph_lo = lo; p.ph_hi = hi; void* args[] = {&p};
    hipError_t e = hipLaunchCooperativeKernel((const void*)mega, dim3(grid_blocks), dim3(NWAVES * 64), args, LDS_BYTES, stream);
    if (e != hipSuccess) fprintf(stderr, "cooperative launch failed: %s (grid %d)\n", hipGetErrorString(e), grid_blocks);
  };
  launch(0, 17);
}
```

```cpp
#include <hip/hip_runtime.h>
#include <hip/hip_cooperative_groups.h>
#include <stdint.h>
#include <math.h>
#include <cstdio>
namespace cg = cooperative_groups;
#ifndef PROBE_MASK
#define PROBE_MASK 0u
#endif

typedef unsigned short bf16_t;
#define DEV __device__ __forceinline__

DEV float bf2f(bf16_t v) { return __uint_as_float(((unsigned)v) << 16); }
DEV bf16_t f2bf(float f) { unsigned u = __float_as_uint(f); u = (u + 0x7fffu + ((u >> 16) & 1u)) >> 16; return (bf16_t)u; }
DEV unsigned pk2(float lo, float hi) { return (unsigned)f2bf(lo) | ((unsigned)f2bf(hi) << 16); }
DEV float siluf(float x) { return x / (1.f + __expf(-x)); }
DEV float silu_fast(float x) { return x * __builtin_amdgcn_rcpf(1.f + __expf(-x)); }
DEV float softplusf(float x) { return x > 20.f ? x : log1pf(__expf(x)); }
DEV float logsigmoidf(float x) { return fminf(x, 0.f) - log1pf(__expf(-fabsf(x))); }

constexpr int D = 1024, NB = 2, SEQ = 8192, CTXL = 256;
constexpr int ML = NB * SEQ;
constexpr int MC = NB * CTXL;
constexpr int MA = ML + MC;
constexpr int NCH = MA / 128;
constexpr int E_IN = 5696, O_IN = 5120, E_INP = 5888;
constexpr float EPS = 1e-6f;

constexpr size_t MiB = 1u << 20;
constexpr size_t WS_CTL = 0;
constexpr size_t WS_MOD = 1 * MiB;
constexpr size_t WS_ROPE = 1 * MiB + 128 * 1024;
constexpr size_t WS_SDEC = 1 * MiB + 256 * 1024;
constexpr size_t WS_GDEC = 1 * MiB + 384 * 1024;
constexpr size_t WS_W1T = 2 * MiB;
constexpr size_t WS_W2T = 14 * MiB;
constexpr size_t WS_W3T = 18 * MiB;
constexpr size_t WS_W4T = 28 * MiB;
constexpr size_t WS_Y0 = 32 * MiB;
constexpr size_t WS_Q0 = 98 * MiB;
constexpr size_t WS_K0 = WS_Q0 + 16 * MiB + 512 * 1024;
constexpr size_t WS_V0 = 131 * MiB;
constexpr size_t WS_DTLR = 164 * MiB;
constexpr size_t WS_XC1 = 168 * MiB + 512 * 1024;
constexpr size_t WS_XBC = 171 * MiB;
constexpr size_t WS_STATE = 171 * MiB;
constexpr size_t WS_TAIL = 237 * MiB;
constexpr size_t WS_H1 = 32 * MiB;
constexpr size_t WS_K1 = 65 * MiB;
constexpr size_t WS_V1 = 81 * MiB + 512 * 1024;
constexpr size_t WS_Q1 = 98 * MiB;
constexpr size_t WS_G1 = 171 * MiB;

DEV int row_vec(int row) { return row < ML ? (row / SEQ) : 2; }

namespace pg8 {
#define PG8_LAS __attribute__((address_space(3)))
typedef unsigned short bf16_t;
typedef short bf16x8 __attribute__((ext_vector_type(8)));
typedef float f32x4 __attribute__((ext_vector_type(4)));
typedef unsigned u32x4 __attribute__((ext_vector_type(4)));
constexpr int BM = 256, BK = 64, HALF = 128, HTB = HALF * BK * 2  , STAGE_BYTES = 8 * HTB, NXCD = 8, WGM = 8;

__host__ __device__ __forceinline__ int lds_byte(int r, int c) { const int st = (r >> 4) * 2 + (c >> 5), rr = r & 15, cc = c & 31, ob = rr * 64 + cc * 2; return st * 1024 + (ob ^ (((ob >> 9) & 1) << 5)); }
__host__ __device__ __forceinline__ void stage_rc(int b, int& R, int& C) { const int st = b / 1024, sb = b % 1024, swz = sb ^ (((sb >> 9) & 1) << 5); R = (st >> 1) * 16 + swz / 64; C = (st & 1) * 32 + (swz % 64) / 2; }
__host__ __device__ __forceinline__ int perm32(int rho) { const int n = rho >> 4, i = rho & 15; return 8 * (i >> 2) + 4 * n + (i & 3); }

struct Unit { int pm, pn; };
struct Gemm { const bf16_t* A; const bf16_t* Bt; int M, N, K; };

struct StaticOrder {
    int nM, nN, nwg, G, c;
    __host__ __device__ void init(int M, int N, int G_, int c_) { nM = M / BM; nN = N / BM; nwg = nM * nN; G = G_; c = c_; }
    __host__ __device__ bool next(int i, Unit& u) const {
        const long L = (long)i * G + c; if (L >= nwg) return false;
        int wgid = (int)L; { const int q = nwg / NXCD, r = nwg % NXCD, xcd = wgid % NXCD, off = wgid / NXCD; wgid = (xcd < r ? xcd * (q + 1) : r * (q + 1) + (xcd - r) * q) + off; }
        const int nig = WGM * nN, gid = wgid / nig, fm = gid * WGM, gsz = (nM - fm) < WGM ? (nM - fm) : WGM;
        u.pm = fm + ((wgid % nig) % gsz); u.pn = (wgid % nig) / gsz; return true;
    }
    __device__ __forceinline__ void a_ready(const Unit&) const {}
    __device__ __forceinline__ void done(const Unit&) const {}
};
__device__ __forceinline__ unsigned cvt_pk_bf16(float lo, float hi) { unsigned r; asm volatile("v_cvt_pk_bf16_f32 %0, %1, %2" : "=v"(r) : "v"(lo), "v"(hi)); return r; }
__device__ __forceinline__ float silu_e(float x) { return x * __builtin_amdgcn_rcpf(1.f + __expf(-x)); }

__device__ __forceinline__ void store_unit_bf16(const f32x4 (&acc)[2][2][4][2], bf16_t* base, int ld, int colt, bool act, const Unit& u, int wr, int wc, int fr, int fq) {
    const int row0 = u.pm * BM + wr * 64 + fr; const int col0 = colt + wc * 32 + 8 * fq;
#pragma unroll
    for (int ai = 0; ai < 2; ++ai)
#pragma unroll
        for (int m = 0; m < 4; ++m) { bf16_t* rowp = base + (size_t)(row0 + ai * HALF + m * 16) * ld + col0;
#pragma unroll
            for (int bj = 0; bj < 2; ++bj) { f32x4 v0 = acc[ai][bj][m][0], v1 = acc[ai][bj][m][1];
                if (act) { v0 = (f32x4){silu_e(v0[0]), silu_e(v0[1]), silu_e(v0[2]), silu_e(v0[3])}; v1 = (f32x4){silu_e(v1[0]), silu_e(v1[1]), silu_e(v1[2]), silu_e(v1[3])}; }
                u32x4 w; w.x = cvt_pk_bf16(v0[0], v0[1]); w.y = cvt_pk_bf16(v0[2], v0[3]); w.z = cvt_pk_bf16(v1[0], v1[1]); w.w = cvt_pk_bf16(v1[2], v1[3]);
                *(u32x4*)(rowp + bj * HALF) = w; } }
}
struct EpiProj0 {
    static constexpr bool PERM = true, AFTER_DRAIN = false;
    bf16_t *Y0, *XBC, *Q0, *K0, *V0; float* DTLR;
    __device__ __forceinline__ void operator()(const f32x4 (&acc)[2][2][4][2], const Unit& u, int wr, int wc, int fr, int fq) const {
        const int pn = u.pn;
        if (pn == 22) {
            if (wc < 2) { const int row0 = u.pm * BM + wr * 64 + fr;
#pragma unroll
                for (int ai = 0; ai < 2; ++ai)
#pragma unroll
                    for (int m = 0; m < 4; ++m) { float* rp = DTLR + (size_t)(row0 + ai * HALF + m * 16) * 64 + wc * 32 + 8 * fq; *(f32x4*)rp = acc[ai][0][m][0]; *(f32x4*)(rp + 4) = acc[ai][0][m][1]; } }
            return;
        }
        bf16_t* base; int ld, colt; bool act = false;
        if (pn < 8) { base = Y0; ld = 2048; colt = pn * 256; act = true; }
        else if (pn < 14) { base = XBC; ld = 1536; colt = (pn - 8) * 256; }
        else if (pn < 16) { base = Q0; ld = 512; colt = (pn - 14) * 256; }
        else if (pn < 18) { base = K0; ld = 512; colt = (pn - 16) * 256; }
        else { base = V0; ld = 1024; colt = (pn - 18) * 256; }
        store_unit_bf16(acc, base, ld, colt, act, u, wr, wc, fr, fq);
    }
};
struct EpiProj1 {
    static constexpr bool PERM = true, AFTER_DRAIN = false;
    bf16_t *K1, *V1, *Q1, *G1;
    __device__ __forceinline__ void operator()(const f32x4 (&acc)[2][2][4][2], const Unit& u, int wr, int wc, int fr, int fq) const {
        const int pn = u.pn; bf16_t* base; int ld, colt; bool act = false;
        if (pn < 2) { base = K1; ld = 512; colt = pn * 256; }
        else if (pn < 4) { base = V1; ld = 512; colt = (pn - 2) * 256; }
        else if (pn < 12) { base = Q1; ld = 2048; colt = (pn - 4) * 256; }
        else { base = G1; ld = 2048; colt = (pn - 12) * 256; act = true; }
        store_unit_bf16(acc, base, ld, colt, act, u, wr, wc, fr, fq);
    }
};
struct EpiResid {
    static constexpr bool PERM = false, AFTER_DRAIN = false;
    const float* res; float* out; const float* mod; bool do_store;
    __device__ __forceinline__ void operator()(const f32x4 (&acc)[2][2][4][2], const Unit& u, int wr, int wc, int fr, int fq) const {
        const int b = (u.pm * BM) / 8192; const float* gate = mod + b * 3072 + 2048;
        const int col0 = u.pn * BM + wc * 32 + 4 * fq;
        f32x4 gv[2][2];
#pragma unroll
        for (int bj = 0; bj < 2; ++bj)
#pragma unroll
            for (int n = 0; n < 2; ++n) gv[bj][n] = *(const f32x4*)(gate + col0 + bj * HALF + n * 16);
#pragma unroll
        for (int ai = 0; ai < 2; ++ai)
#pragma unroll
            for (int m = 0; m < 4; ++m) { const size_t off = (size_t)(u.pm * BM + ai * HALF + wr * 64 + m * 16 + fr) * 1024 + col0;
#pragma unroll
                for (int bj = 0; bj < 2; ++bj)
#pragma unroll
                    for (int n = 0; n < 2; ++n) { const f32x4 r = *(const f32x4*)(res + off + bj * HALF + n * 16); const f32x4 ov_ = r + gv[bj][n] * acc[ai][bj][m][n]; if (do_store) *(f32x4*)(out + off + bj * HALF + n * 16) = ov_; } }
    }
};
template <class Epi, class Sched, bool ALIGN_EPI = false, bool SP2 = false>
__device__ __forceinline__ void gemm_phase(PG8_LAS unsigned char* lds, const Gemm g, const Sched& S, const Epi& E) {
    const int tid = threadIdx.x, wid = __builtin_amdgcn_readfirstlane(tid >> 6), lane = tid & 63, wr = wid >> 2, wc = wid & 3, fr = lane & 15, fq = lane >> 4;
    const int K = g.K, nt = K / BK;
    unsigned voffA[2], voffB[2];
#pragma unroll
    for (int i = 0; i < 2; ++i) { int R, C; stage_rc(tid * 16 + i * 8192, R, C); const int Rb = Epi::PERM ? ((R & ~31) + perm32(R & 31)) : R;
        voffA[i] = (unsigned)(R * K + C) * 2u; voffB[i] = (unsigned)(Rb * K + C) * 2u; }
    const size_t kstep = (size_t)(BK * 2);
    const size_t hstep = (size_t)HALF * K * 2;
    const size_t tstep = 2 * hstep;
    const unsigned ldsw = (unsigned)wid * 1024u;
    const int aoff = lds_byte(wr * 64 + fr, fq * 8), boff = lds_byte(wc * 32 + fr, fq * 8);
#define PG8_SA(b, h) (((b) * 2 + (h)) * HTB)
#define PG8_SB(b, h) ((4 + (b) * 2 + (h)) * HTB)
#define PG8_STAGE(bufoff, gbase, voff) do { _Pragma("unroll") for (int _i = 0; _i < 2; ++_i) \
        __builtin_amdgcn_global_load_lds((const unsigned*)((const char*)(gbase) + (voff)[_i]), (PG8_LAS unsigned*)(lds + (bufoff) + ldsw + _i * 8192), 16, 0, 0); } while (0)
#define PG8_LDA(dst, b, h) do { _Pragma("unroll") for (int m = 0; m < 4; ++m) _Pragma("unroll") for (int k = 0; k < 2; ++k) dst[m][k] = *(const PG8_LAS bf16x8*)(lds + PG8_SA(b, h) + aoff + m * 2048 + k * 1024); } while (0)
#define PG8_LDB(dst, b, h) do { _Pragma("unroll") for (int n = 0; n < 2; ++n) _Pragma("unroll") for (int k = 0; k < 2; ++k) dst[n][k] = *(const PG8_LAS bf16x8*)(lds + PG8_SB(b, h) + boff + n * 2048 + k * 1024); } while (0)
#define PG8_MMA(ai, bj, At, Bt) do { __builtin_amdgcn_s_setprio(1); _Pragma("unroll") for (int m = 0; m < 4; ++m) _Pragma("unroll") for (int n = 0; n < 2; ++n) _Pragma("unroll") for (int k = 0; k < 2; ++k) \
        acc[ai][bj][m][n] = __builtin_amdgcn_mfma_f32_16x16x32_bf16(Bt[n][k], At[m][k], acc[ai][bj][m][n], 0, 0, 0); __builtin_amdgcn_s_setprio(0); } while (0)
#define PG8_WAIT_V(n) asm volatile("s_waitcnt vmcnt(" #n ")" ::: "memory")
#define PG8_WAIT_L(n) asm volatile("s_waitcnt lgkmcnt(" #n ")" ::: "memory")
#define PG8_BAR __builtin_amdgcn_s_barrier()
#define PG8_SCHED __builtin_amdgcn_sched_barrier(0)
    Unit cur, nxt; int ui = 0;
    if (!S.next(0, cur)) return;
    f32x4 acc[2][2][4][2];
#pragma unroll
    for (int a = 0; a < 2; ++a)
#pragma unroll
        for (int b = 0; b < 2; ++b)
#pragma unroll
            for (int m = 0; m < 4; ++m)
#pragma unroll
                for (int n = 0; n < 2; ++n) acc[a][b][m][n] = (f32x4){0.f, 0.f, 0.f, 0.f};
    bf16x8 At[4][2], B0[2][2], B1[2][2];
    const char* cA = (const char*)g.A + (size_t)cur.pm * tstep; const char* cB = (const char*)g.Bt + (size_t)cur.pn * tstep;
    S.a_ready(cur);
    if constexpr (SP2) {
        PG8_STAGE(PG8_SB(0, 0), cB, voffB); PG8_STAGE(PG8_SB(0, 1), cB + hstep, voffB); PG8_STAGE(PG8_SA(0, 0), cA, voffA); PG8_STAGE(PG8_SA(0, 1), cA + hstep, voffA);
        if (wr == 1) PG8_BAR;
        PG8_WAIT_V(2); PG8_BAR;
        PG8_STAGE(PG8_SB(1, 0), cB + kstep, voffB); PG8_STAGE(PG8_SA(1, 0), cA + kstep, voffA); PG8_STAGE(PG8_SB(1, 1), cB + hstep + kstep, voffB);
        PG8_WAIT_V(6); PG8_BAR;
    } else {
        PG8_STAGE(PG8_SB(0, 0), cB, voffB); PG8_STAGE(PG8_SA(0, 0), cA, voffA); PG8_STAGE(PG8_SB(0, 1), cB + hstep, voffB); PG8_STAGE(PG8_SA(0, 1), cA + hstep, voffA);
        if (wr == 1) PG8_BAR;
        PG8_WAIT_V(4); PG8_BAR;
        PG8_STAGE(PG8_SB(1, 0), cB + kstep, voffB); PG8_STAGE(PG8_SA(1, 0), cA + kstep, voffA); PG8_STAGE(PG8_SB(1, 1), cB + hstep + kstep, voffB);
        PG8_WAIT_V(6); PG8_BAR;
    }
    for (;;) {
        const bool has_next = S.next(ui + 1, nxt);
        const char* nA = has_next ? (const char*)g.A + (size_t)nxt.pm * tstep : cA; const char* nB = has_next ? (const char*)g.Bt + (size_t)nxt.pn * tstep : cB;
        for (int t = 0; t < nt; t += 2) {
            const bool last = (t == nt - 2);
            const char* a1 = cA + (size_t)(t + 1) * kstep;
            const char* a2 = last ? nA : cA + (size_t)(t + 2) * kstep; const char* b2 = last ? nB : cB + (size_t)(t + 2) * kstep;
            const char* a3 = a2 + kstep; const char* b3 = b2 + kstep;
            if (last && has_next) S.a_ready(nxt);
            if constexpr (SP2) {
            PG8_LDB(B0, 0, 0); PG8_LDB(B1, 0, 1); PG8_SCHED; PG8_LDA(At, 0, 0); PG8_STAGE(PG8_SA(1, 1), a1 + hstep, voffA);
            PG8_WAIT_V(8); PG8_WAIT_L(0); PG8_BAR; PG8_MMA(0, 0, At, B0); PG8_MMA(0, 1, At, B1); PG8_BAR; PG8_SCHED;
            PG8_LDA(At, 0, 1); PG8_STAGE(PG8_SB(0, 0), b2, voffB); PG8_STAGE(PG8_SB(0, 1), b2 + hstep, voffB); PG8_STAGE(PG8_SA(0, 0), a2, voffA);
            PG8_WAIT_V(8); PG8_WAIT_L(0); PG8_BAR; PG8_MMA(1, 0, At, B0); PG8_MMA(1, 1, At, B1); PG8_BAR; PG8_SCHED;
            PG8_LDB(B0, 1, 0); PG8_LDB(B1, 1, 1); PG8_SCHED; PG8_LDA(At, 1, 0); PG8_STAGE(PG8_SA(0, 1), a2 + hstep, voffA);
            PG8_WAIT_V(8); PG8_WAIT_L(0); PG8_BAR; PG8_MMA(0, 0, At, B0); PG8_MMA(0, 1, At, B1); PG8_BAR; PG8_SCHED;
            PG8_LDA(At, 1, 1); PG8_STAGE(PG8_SB(1, 0), b3, voffB); PG8_STAGE(PG8_SB(1, 1), b3 + hstep, voffB); PG8_STAGE(PG8_SA(1, 0), a3, voffA);
            PG8_WAIT_V(8); PG8_WAIT_L(0); PG8_BAR; PG8_MMA(1, 0, At, B0); PG8_MMA(1, 1, At, B1); PG8_BAR; PG8_SCHED;
            } else {
            PG8_LDB(B0, 0, 0); PG8_SCHED; PG8_LDA(At, 0, 0); PG8_STAGE(PG8_SA(1, 1), a1 + hstep, voffA);
            PG8_WAIT_L(8); PG8_BAR; PG8_WAIT_L(0); PG8_MMA(0, 0, At, B0); PG8_BAR; PG8_SCHED;
            PG8_LDB(B1, 0, 1); PG8_STAGE(PG8_SB(0, 0), b2, voffB);
            PG8_BAR; PG8_WAIT_L(0); PG8_MMA(0, 1, At, B1); PG8_BAR;
            PG8_LDA(At, 0, 1); PG8_STAGE(PG8_SA(0, 0), a2, voffA);
            PG8_BAR; PG8_WAIT_L(0); PG8_MMA(1, 0, At, B0); PG8_BAR; PG8_SCHED;
            PG8_STAGE(PG8_SB(0, 1), b2 + hstep, voffB);
            PG8_WAIT_V(6); PG8_BAR; PG8_MMA(1, 1, At, B1); PG8_BAR;
            PG8_LDB(B0, 1, 0); PG8_SCHED; PG8_LDA(At, 1, 0); PG8_STAGE(PG8_SA(0, 1), a2 + hstep, voffA);
            PG8_WAIT_L(8); PG8_BAR; PG8_WAIT_L(0); PG8_MMA(0, 0, At, B0); PG8_BAR; PG8_SCHED;
            PG8_LDB(B1, 1, 1); PG8_STAGE(PG8_SB(1, 0), b3, voffB);
            PG8_BAR; PG8_WAIT_L(0); PG8_MMA(0, 1, At, B1); PG8_BAR;
            PG8_LDA(At, 1, 1); PG8_STAGE(PG8_SA(1, 0), a3, voffA);
            PG8_BAR; PG8_WAIT_L(0); PG8_MMA(1, 0, At, B0); PG8_BAR; PG8_SCHED;
            PG8_STAGE(PG8_SB(1, 1), b3 + hstep, voffB);
            PG8_WAIT_V(6); PG8_BAR; PG8_MMA(1, 1, At, B1); PG8_BAR;
            }
        }
        if constexpr (ALIGN_EPI) { if (wr == 0) PG8_BAR; }
        if constexpr (!Epi::AFTER_DRAIN) { E(acc, cur, wr, wc, fr, fq); S.done(cur); }
        if (!has_next) break;
#pragma unroll
        for (int a = 0; a < 2; ++a)
#pragma unroll
            for (int b = 0; b < 2; ++b)
#pragma unroll
                for (int m = 0; m < 4; ++m)
#pragma unroll
                    for (int n = 0; n < 2; ++n) acc[a][b][m][n] = (f32x4){0.f, 0.f, 0.f, 0.f};
        cur = nxt; cA = nA; cB = nB; ++ui;
        if constexpr (ALIGN_EPI) { if (wr == 1) PG8_BAR; }
    }
    PG8_WAIT_V(0);
    if constexpr (!ALIGN_EPI) { if (wr == 0) PG8_BAR; }
    PG8_BAR;
    if constexpr (Epi::AFTER_DRAIN) { E.fused(acc, cur, wr, wc, fr, fq, lds, wid, lane); S.done(cur); }
#undef PG8_SA
#undef PG8_SB
#undef PG8_STAGE
#undef PG8_LDA
#undef PG8_LDB
#undef PG8_MMA
#undef PG8_WAIT_V
#undef PG8_WAIT_L
#undef PG8_BAR
#undef PG8_SCHED
}
}
#define LAS __attribute__((address_space(3)))
typedef unsigned v4u __attribute__((ext_vector_type(4)));
typedef float f32x4 __attribute__((ext_vector_type(4)));
typedef short bf16x8 __attribute__((ext_vector_type(8)));
#define LDS_WAIT() asm volatile("s_waitcnt lgkmcnt(0)" ::: "memory")
constexpr int NWAVES = 8;
constexpr int LDS_BYTES = 147456;
constexpr int MISC_OFF = 147456 - 128;

struct Params { const float* in[26]; float* out; unsigned char* ws; int ph_lo, ph_hi, rep, pad; };

DEV float wave_sum(float v) {
#pragma unroll
  for (int o = 1; o < 64; o <<= 1) v += __shfl_xor(v, o);
  return v;
}

DEV int w1_dest_row(int n) {
  if (n < 1024) return n;
  if (n < 2560) return 2048 + (n - 1024);
  if (n < 2592) return 5632 + (n - 2560);
  if (n < 3104) return 3584 + (n - 2592);
  if (n < 3616) return 4096 + (n - 3104);
  if (n < 4640) return 4608 + (n - 3616);
  if (n < 5664) return 1024 + (n - 4640);
  return n;
}
DEV void transpose_item(const float* W, int K, int N, int k0, int n0, bf16_t* WT, int drow0, LAS float* scr, int lane) {
#pragma unroll 8
  for (int i = 0; i < 32; ++i) { const int kk = 2 * i + (lane >> 5); scr[kk * 33 + (lane & 31)] = W[(size_t)(k0 + kk) * N + n0 + (lane & 31)]; }
  LDS_WAIT(); asm volatile("" ::: "memory");
  const int c = lane & 7;
#pragma unroll
  for (int j = 0; j < 4; ++j) { const int n = (lane >> 3) + 8 * j; const LAS float* s = scr + (8 * c) * 33 + n;
    v4u o; o.x = pk2(s[0 * 33], s[1 * 33]); o.y = pk2(s[2 * 33], s[3 * 33]); o.z = pk2(s[4 * 33], s[5 * 33]); o.w = pk2(s[6 * 33], s[7 * 33]);
    *(v4u*)(WT + (size_t)(drow0 + n) * K + k0 + 8 * c) = o; }
  LDS_WAIT(); asm volatile("" ::: "memory");
}
DEV void prologue_phase(const Params& p, LAS unsigned char* lds) {
  const int tid = threadIdx.x, lane = tid & 63, wave = tid >> 6;
  unsigned char* ws = p.ws;
  float* MOD = (float*)(ws + WS_MOD);
  {
    LAS float* sc = (LAS float*)lds;
    LAS float* part = (LAS float*)(lds + 12288);
    for (int i = tid; i < 3072; i += 512) { const int v = i >> 10, k = i & 1023; const float cv = v < 2 ? p.in[1][v * 1024 + k] : p.in[3][k]; sc[i] = siluf(cv); }
    __syncthreads();
    for (int task = blockIdx.x; task < 96; task += gridDim.x) {
      const int l = task / 48, n0 = (task % 48) * 64; const float* w = l ? p.in[19] : p.in[5]; const float* bb = l ? p.in[20] : p.in[6];
      const int col = tid & 63, ks = tid >> 6;
      float a0 = 0.f, a1 = 0.f, a2 = 0.f;
#pragma unroll 8
      for (int k = ks * 128; k < ks * 128 + 128; ++k) { const float wv = w[(size_t)k * 3072 + n0 + col]; a0 += sc[k] * wv; a1 += sc[1024 + k] * wv; a2 += sc[2048 + k] * wv; }
      part[(ks * 3 + 0) * 64 + col] = a0; part[(ks * 3 + 1) * 64 + col] = a1; part[(ks * 3 + 2) * 64 + col] = a2;
      __syncthreads();
      if (tid < 192) { const int v = tid >> 6; float s = bb[n0 + col];
#pragma unroll
        for (int q = 0; q < 8; ++q) s += part[(q * 3 + v) * 64 + col];
        MOD[(l * 3 + v) * 3072 + n0 + col] = s; }
      __syncthreads();
    }
  }
  if (blockIdx.x == gridDim.x - 1) { float* rope = (float*)(ws + WS_ROPE);
    for (int idx = tid; idx < 4096; idx += 512) { const int pos = idx >> 5, f = idx & 31; const float inv = 1.0f / powf(10000.f, (float)f / 32.f); const float ang = (float)pos * inv; rope[idx] = cosf(ang); rope[4096 + idx] = sinf(ang); } }
  { v4u* z = (v4u*)(ws + WS_W1T + (size_t)E_IN * 1024 * 2); const v4u zero = {0u, 0u, 0u, 0u};
    for (int i = blockIdx.x * 512 + tid; i < (E_INP - E_IN) * 1024 * 2 / 16; i += gridDim.x * 512) z[i] = zero; }
  __syncthreads();
  {
    LAS float* scr = (LAS float*)(lds + wave * 16384);
    const int gw = blockIdx.x * NWAVES + wave, NGW = gridDim.x * NWAVES;
    constexpr int I1 = 16 * 178, I2 = 32 * 32, I3 = 16 * 160, I4 = 32 * 32;
    for (int it = gw; it < I1 + I2 + I3 + I4; it += NGW) {
      int r = it;
      if (r < I1) { const int kb = r / 178, nb = r % 178; transpose_item(p.in[7], 1024, E_IN, 64 * kb, 32 * nb, (bf16_t*)(ws + WS_W1T), w1_dest_row(32 * nb), scr, lane); continue; } r -= I1;
      if (r < I2) { const int kb = r / 32, nb = r % 32; transpose_item(p.in[17], 2048, 1024, 64 * kb, 32 * nb, (bf16_t*)(ws + WS_W2T), 32 * nb, scr, lane); continue; } r -= I2;
      if (r < I3) { const int kb = r / 160, nb = r % 160; transpose_item(p.in[21], 1024, O_IN, 64 * kb, 32 * nb, (bf16_t*)(ws + WS_W3T), 32 * nb, scr, lane); continue; } r -= I3;
      { const int kb = r / 32, nb = r % 32; transpose_item(p.in[25], 2048, 1024, 64 * kb, 32 * nb, (bf16_t*)(ws + WS_W4T), 32 * nb, scr, lane); }
    }
  }
}
DEV void prep_phase(const float* xlat, const float* xctx, const float* g, const float* mod, bf16_t* H) {
  const int lane = threadIdx.x & 63, wave = threadIdx.x >> 6;
  for (int row = blockIdx.x * NWAVES + wave; row < MA; row += gridDim.x * NWAVES) {
    const float* src = row < ML ? xlat + (size_t)row * D : xctx + (size_t)(row - ML) * D;
    const float* m = mod + row_vec(row) * 3072;
    f32x4 v[4]; float ss = 0.f;
#pragma unroll
    for (int j = 0; j < 4; ++j) { v[j] = *(const f32x4*)(src + 4 * lane + 256 * j); ss += (v[j].x * v[j].x + v[j].y * v[j].y) + (v[j].z * v[j].z + v[j].w * v[j].w); }
    const float rstd = rsqrtf(wave_sum(ss) * (1.f / D) + EPS);
#pragma unroll
    for (int j = 0; j < 4; ++j) { const int k = 4 * lane + 256 * j;
      const f32x4 gg = *(const f32x4*)(g + k), sc = *(const f32x4*)(m + 1024 + k), sh = *(const f32x4*)(m + k);
      const f32x4 o = v[j] * rstd * gg * (sc + 1.f) + sh;
      *(unsigned long long*)(H + (size_t)row * D + k) = (unsigned long long)pk2(o.x, o.y) | ((unsigned long long)pk2(o.z, o.w) << 32); }
  }
}
template <class F> DEV void small_gemm(const bf16_t* A, int lda, const bf16_t* Bt, int ldb, int K, int Mrows, int Ncols, F f) {
  const int lane = threadIdx.x & 63, wid = threadIdx.x >> 6, mt = wid >> 2, nt = wid & 3, r = lane & 15, q = lane >> 4;
  const int ntn = Ncols / 64, ntasks = (Mrows / 32) * ntn;
  for (int task = blockIdx.x; task < ntasks; task += gridDim.x) {
    const int row0 = (task / ntn) * 32 + mt * 16, col0 = (task % ntn) * 64 + nt * 16;
    const bf16_t* ap = A + (size_t)(row0 + r) * lda + 8 * q; const bf16_t* bp = Bt + (size_t)(col0 + r) * ldb + 8 * q;
    f32x4 acc = {0.f, 0.f, 0.f, 0.f};
#pragma unroll 8
    for (int k = 0; k < K; k += 32) { const bf16x8 a = *(const bf16x8*)(ap + k), b = *(const bf16x8*)(bp + k); acc = __builtin_amdgcn_mfma_f32_16x16x32_bf16(a, b, acc, 0, 0, 0); }
#pragma unroll
    for (int j = 0; j < 4; ++j) f(row0 + q * 4 + j, col0 + r, acc[j]);
  }
}

DEV void qknorm_phase(bf16_t* Q1, bf16_t* K1, const float* qn, const float* kn, const float* rope, bool wr) {
  const int lane = threadIdx.x & 63, wave = threadIdx.x >> 6;
  const int total = ML * 20 + MC * 4;
  const float scale = 0.08838834764831845f;
  for (int wt = blockIdx.x * NWAVES + wave; wt < total; wt += gridDim.x * NWAVES) {
    int row, hh; bool lat = wt < ML * 20;
    if (lat) { row = wt / 20; hh = wt % 20; } else { const int r2 = wt - ML * 20; row = ML + (r2 >> 2); hh = r2 & 3; }
    const bool isq = hh >= 4;
    bf16_t* ptr = isq ? Q1 + (size_t)row * 2048 + (hh - 4) * 128 : K1 + (size_t)row * 512 + hh * 128;
    float v0 = bf2f(ptr[lane]), v1 = bf2f(ptr[64 + lane]);
    const float rstd = rsqrtf(wave_sum(v0 * v0 + v1 * v1) * (1.f / 128.f) + EPS);
    const float* gn = isq ? qn : kn;
    v0 *= rstd * gn[lane]; v1 *= rstd * gn[64 + lane];
    if (lat) {
      const int t = row % SEQ, f = lane & 31, s = (lane >> 5) & 1;
      const float c0 = rope[(t >> 6) * 32 + f], s0 = rope[4096 + (t >> 6) * 32 + f], c1 = rope[(t & 63) * 32 + f], s1 = rope[4096 + (t & 63) * 32 + f];
      const float o0 = __shfl_xor(v0, 32), o1 = __shfl_xor(v1, 32);
      v0 = s ? (v0 * c0 + o0 * s0) : (v0 * c0 - o0 * s0);
      v1 = s ? (v1 * c1 + o1 * s1) : (v1 * c1 - o1 * s1);
    }
    if (isq) { v0 *= scale; v1 *= scale; }
    if (wr) { ptr[lane] = f2bf(v0); ptr[64 + lane] = f2bf(v1); }
  }
}
typedef short s16x4 __attribute__((ext_vector_type(4)));
DEV s16x4 tr_read(const LAS bf16_t* p) { return __builtin_bit_cast(s16x4, __builtin_amdgcn_ds_read_tr16_b64_v4i16((LAS s16x4*)p)); }
DEV void attn_phase(bf16_t* Q1, const bf16_t* K1, const bf16_t* V1, const bf16_t* G1, const float* sink, const float* qn, const float* kn, LAS unsigned char* lds, bool wr) {
  constexpr int KP = 136, VP = 144;
  LAS bf16_t* Ks = (LAS bf16_t*)lds;
  LAS bf16_t* Vs = (LAS bf16_t*)(lds + 2 * 64 * KP * 2);
  LAS float* dsc = (LAS float*)(lds + 2 * 64 * KP * 2 + 2 * 64 * VP * 2);
  const int tid = threadIdx.x, lane = tid & 63, wid = tid >> 6, r = lane & 15, Qd = lane >> 4;
  float mb;
  { float a = fmaxf(fabsf(qn[lane]), fabsf(qn[64 + lane])), b = fmaxf(fabsf(kn[lane]), fabsf(kn[64 + lane]));
#pragma unroll
    for (int o = 1; o < 64; o <<= 1) { a = fmaxf(a, __shfl_xor(a, o)); b = fmaxf(b, __shfl_xor(b, o)); }
    mb = a * b * 11.313708498984761f; }
  for (int task = blockIdx.x; task < 1024; task += gridDim.x) {
    const int b = task >> 9, kvh = (task >> 7) & 3, qt = task & 127;
    const int hq = kvh * 4 + (wid >> 1), qoff = (wid & 1) * 32;
    const size_t qrow0 = (size_t)b * SEQ + qt * 64 + qoff;
    bf16x8 qf[2][4];
#pragma unroll
    for (int m = 0; m < 2; ++m)
#pragma unroll
      for (int ks = 0; ks < 4; ++ks) qf[m][ks] = *(const bf16x8*)(Q1 + (qrow0 + 16 * m + r) * 2048 + hq * 128 + ks * 32 + 8 * Qd);
    const int tlo = (2 - qt) > 0 ? (2 - qt) : 0, thi = (129 - qt) < 4 ? (129 - qt) : 4, nband = thi - tlo + 1, ntile = nband + 4;
    const int skey = tid >> 4, sch = tid & 15;
    v4u kreg[2], vreg[2];
#define TILE_ROW0(i) ((i) < nband ? (size_t)b * SEQ + (size_t)(qt - 2 + tlo + (i)) * 64 : (size_t)ML + b * CTXL + ((i) - nband) * 64)
#define LOAD_TILE(i) do { const size_t r0_ = TILE_ROW0(i); _Pragma("unroll") for (int h_ = 0; h_ < 2; ++h_) { const size_t go_ = (r0_ + skey + 32 * h_) * 512 + kvh * 128 + sch * 8; kreg[h_] = *(const v4u*)(K1 + go_); vreg[h_] = *(const v4u*)(V1 + go_); } } while (0)
#define STORE_TILE(buf) do { _Pragma("unroll") for (int h_ = 0; h_ < 2; ++h_) { *(LAS v4u*)(Ks + (buf) * 64 * KP + (skey + 32 * h_) * KP + sch * 8) = kreg[h_]; *(LAS v4u*)(Vs + (buf) * 64 * VP + (skey + 32 * h_) * VP + sch * 8) = vreg[h_]; } } while (0)
    LOAD_TILE(0);
    __syncthreads();
    STORE_TILE(0);
    __syncthreads();
    f32x4 o[2][8];
#pragma unroll
    for (int m = 0; m < 2; ++m)
#pragma unroll
      for (int n = 0; n < 8; ++n) o[m][n] = (f32x4){0.f, 0.f, 0.f, 0.f};
    float lsum[2] = {0.f, 0.f};
    for (int i = 0; i < ntile; ++i) {
      const int buf = i & 1;
      if (i + 1 < ntile) LOAD_TILE(i + 1);
      const int mtype = (i < nband) ? ((tlo + i) == 0 ? 1 : ((tlo + i) == 4 ? 2 : 0)) : 0;
      const LAS bf16_t* Kb = Ks + buf * 64 * KP; const LAS bf16_t* Vb = Vs + buf * 64 * VP;
      f32x4 s[4][2];
#pragma unroll
      for (int t = 0; t < 4; ++t) { s[t][0] = (f32x4){0.f, 0.f, 0.f, 0.f}; s[t][1] = (f32x4){0.f, 0.f, 0.f, 0.f}; }
#pragma unroll
      for (int ks = 0; ks < 4; ++ks)
#pragma unroll
        for (int t = 0; t < 4; ++t) { const bf16x8 kf = *(const LAS bf16x8*)(Kb + (16 * t + r) * KP + ks * 32 + 8 * Qd);
          s[t][0] = __builtin_amdgcn_mfma_f32_16x16x32_bf16(kf, qf[0][ks], s[t][0], 0, 0, 0);
          s[t][1] = __builtin_amdgcn_mfma_f32_16x16x32_bf16(kf, qf[1][ks], s[t][1], 0, 0, 0); }
      bf16x8 pa[2][2];
#pragma unroll
      for (int m = 0; m < 2; ++m) { const int qi = qoff + 16 * m + r;
#pragma unroll
        for (int t = 0; t < 4; ++t) {
          float pv[4];
#pragma unroll
          for (int j = 0; j < 4; ++j) { const int kj = 16 * t + 4 * Qd + j; float pj = __expf(s[t][m][j] - mb);
            if (mtype == 1) pj = (kj >= qi) ? pj : 0.f; else if (mtype == 2) pj = (kj <= qi) ? pj : 0.f;
            pv[j] = pj; lsum[m] += pj; }
          const unsigned w0 = pk2(pv[0], pv[1]), w1 = pk2(pv[2], pv[3]);
          pa[m][t >> 1][(t & 1) * 4 + 0] = (short)(w0 & 0xffff); pa[m][t >> 1][(t & 1) * 4 + 1] = (short)(w0 >> 16);
          pa[m][t >> 1][(t & 1) * 4 + 2] = (short)(w1 & 0xffff); pa[m][t >> 1][(t & 1) * 4 + 3] = (short)(w1 >> 16); } }
#pragma unroll
      for (int k2 = 0; k2 < 2; ++k2)
#pragma unroll
        for (int n = 0; n < 8; ++n) {
          const s16x4 lo = tr_read(Vb + (32 * k2 + 4 * Qd + (r >> 2)) * VP + 16 * n + 4 * (r & 3));
          const s16x4 hi = tr_read(Vb + (32 * k2 + 16 + 4 * Qd + (r >> 2)) * VP + 16 * n + 4 * (r & 3));
          const bf16x8 vf = (bf16x8){lo[0], lo[1], lo[2], lo[3], hi[0], hi[1], hi[2], hi[3]};
          o[0][n] = __builtin_amdgcn_mfma_f32_16x16x32_bf16(pa[0][k2], vf, o[0][n], 0, 0, 0);
          o[1][n] = __builtin_amdgcn_mfma_f32_16x16x32_bf16(pa[1][k2], vf, o[1][n], 0, 0, 0); }
      if (i + 1 < ntile) STORE_TILE(buf ^ 1);
      __syncthreads();
    }
#undef TILE_ROW0
#undef LOAD_TILE
#undef STORE_TILE
    const float sk = __expf(sink[hq] - mb);
#pragma unroll
    for (int m = 0; m < 2; ++m) { float l = lsum[m]; l += __shfl_xor(l, 16); l += __shfl_xor(l, 32); if (Qd == 0) dsc[wid * 32 + 16 * m + r] = 1.f / (l + sk); }
    LDS_WAIT(); asm volatile("" ::: "memory");
#pragma unroll
    for (int m = 0; m < 2; ++m)
#pragma unroll
      for (int j = 0; j < 4; ++j) { const float inv = dsc[wid * 32 + 16 * m + 4 * Qd + j]; const size_t ro = (qrow0 + 16 * m + 4 * Qd + j) * 2048 + hq * 128 + r;
#pragma unroll
        for (int n = 0; n < 8; ++n) { const bf16_t ov_ = f2bf(o[m][n][j] * inv * bf2f(G1[ro + 16 * n])); if (wr) Q1[ro + 16 * n] = ov_; } }
    LDS_WAIT(); asm volatile("" ::: "memory");
  }
}

constexpr size_t DO_SDT = 50 * MiB, DO_SCS = 53 * MiB;
constexpr size_t WS_SSQ = 237 * MiB;
DEV unsigned short bfbits(float f) { return f2bf(f); }
DEV void ssd_prep_phase(const bf16_t* XBC, const float* cw, const float* cb, bf16_t* XC, const float* DTLR, const float* dt_bias, const float* a_log, float* SDT, float* SCS, float* SDEC) {
  const int gtid = blockIdx.x * 512 + threadIdx.x, gth = gridDim.x * 512;
  for (int it = gtid; it < MA * 192; it += gth) {
    const int row = it / 192, c8 = (it % 192) * 8;
    int t, len;
    if (row < ML) { t = row % SEQ; len = SEQ; } else { t = (row - ML) % CTXL; len = CTXL; }
    float acc[8];
    { const f32x4 b0 = *(const f32x4*)(cb + c8), b1 = *(const f32x4*)(cb + c8 + 4); acc[0] = b0.x; acc[1] = b0.y; acc[2] = b0.z; acc[3] = b0.w; acc[4] = b1.x; acc[5] = b1.y; acc[6] = b1.z; acc[7] = b1.w; }
#pragma unroll
    for (int k = 0; k < 5; ++k) { const int tt = t + k - 2;
      if (tt >= 0 && tt < len) { const v4u xv = *(const v4u*)(XBC + (size_t)(row + k - 2) * 1536 + c8); const f32x4 w0 = *(const f32x4*)(cw + k * 1536 + c8), w1 = *(const f32x4*)(cw + k * 1536 + c8 + 4);
        acc[0] += w0.x * __uint_as_float(xv.x << 16); acc[1] += w0.y * __uint_as_float(xv.x & 0xffff0000u); acc[2] += w0.z * __uint_as_float(xv.y << 16); acc[3] += w0.w * __uint_as_float(xv.y & 0xffff0000u);
        acc[4] += w1.x * __uint_as_float(xv.z << 16); acc[5] += w1.y * __uint_as_float(xv.z & 0xffff0000u); acc[6] += w1.z * __uint_as_float(xv.w << 16); acc[7] += w1.w * __uint_as_float(xv.w & 0xffff0000u); } }
    v4u o; o.x = pk2(silu_fast(acc[0]), silu_fast(acc[1])); o.y = pk2(silu_fast(acc[2]), silu_fast(acc[3])); o.z = pk2(silu_fast(acc[4]), silu_fast(acc[5])); o.w = pk2(silu_fast(acc[6]), silu_fast(acc[7]));
    *(v4u*)(XC + (size_t)row * 1536 + c8) = o;
  }
  if (gtid < NCH * 32) {
    const int gc = gtid / 32, col = gtid % 32, dir = col / 16, h = col % 16;
    const float a = -__expf(a_log[col]), bias = dt_bias[col];
    float cs = 0.f;
    for (int s = 0; s < 128; ++s) { const int t = dir ? 127 - s : s; const size_t row = (size_t)gc * 128 + t;
      const float dt = softplusf(DTLR[row * 64 + col] + bias); cs += dt * a; SDT[row * 32 + col] = dt; SCS[row * 32 + col] = cs; }
    SDEC[(gc * 16 + h) * 2 + dir] = __expf(cs);
  }
}
DEV void ssd_u_phase(const bf16_t* XC, const float* SDT, const float* SCS, bf16_t* ST, LAS unsigned char* lds) {
  constexpr int XP = 272, BP = 144;
  LAS bf16_t* Xs = (LAS bf16_t*)lds; LAS bf16_t* Bs = (LAS bf16_t*)(lds + 128 * XP * 2); LAS float* wtab = (LAS float*)(lds + 128 * XP * 2 + 128 * BP * 2);
  const int tid = threadIdx.x, lane = tid & 63, wid = tid >> 6, r = lane & 15, Qd = lane >> 4, hl = wid >> 1, dir = wid & 1;
  for (int task = blockIdx.x; task < NCH * 4; task += gridDim.x) {
    const int gc = task >> 2, g = (task >> 1) & 1, hh = task & 1; const size_t r0 = (size_t)gc * 128; const int h0 = g * 8 + hh * 4;
    __syncthreads();
#pragma unroll
    for (int i = 0; i < 8; ++i) { const int cid = tid + 512 * i, row = cid >> 5, ch = cid & 31; *(LAS v4u*)(Xs + row * XP + ch * 8) = *(const v4u*)(XC + (r0 + row) * 1536 + h0 * 64 + ch * 8); }
#pragma unroll
    for (int i = 0; i < 4; ++i) { const int cid = tid + 512 * i, row = cid >> 4, ch = cid & 15; *(LAS v4u*)(Bs + row * BP + ch * 8) = *(const v4u*)(XC + (r0 + row) * 1536 + 1024 + g * 128 + ch * 8); }
#pragma unroll
    for (int i = 0; i < 2; ++i) { const int e = tid + 512 * i, combo = e >> 7, t = e & 127, col = (combo & 1) * 16 + h0 + (combo >> 1);
      const float cs_end = SCS[(r0 + ((combo & 1) ? 0 : 127)) * 32 + col]; wtab[e] = __expf(cs_end - SCS[(r0 + t) * 32 + col]) * SDT[(r0 + t) * 32 + col]; }
    __syncthreads();
    const LAS float* wt = wtab + wid * 128;
    bf16_t* Sp = ST + ((((size_t)gc * 16 + h0 + hl) * 2 + dir) * 64) * 128;
#pragma unroll 1
    for (int pp = 0; pp < 2; ++pp) {
      f32x4 acc[8][2];
#pragma unroll
      for (int nt = 0; nt < 8; ++nt) { acc[nt][0] = (f32x4){0.f, 0.f, 0.f, 0.f}; acc[nt][1] = (f32x4){0.f, 0.f, 0.f, 0.f}; }
#pragma unroll 1
      for (int k = 0; k < 4; ++k) {
        const f32x4 wlo = *(const LAS f32x4*)(wt + 32 * k + 4 * Qd), whi = *(const LAS f32x4*)(wt + 32 * k + 16 + 4 * Qd);
        bf16x8 xf[2];
#pragma unroll
        for (int pt = 0; pt < 2; ++pt) {
          const s16x4 lo = tr_read(Xs + (32 * k + 4 * Qd + (r >> 2)) * XP + hl * 64 + 32 * pp + 16 * pt + 4 * (r & 3));
          const s16x4 hi = tr_read(Xs + (32 * k + 16 + 4 * Qd + (r >> 2)) * XP + hl * 64 + 32 * pp + 16 * pt + 4 * (r & 3));
          const unsigned w0 = pk2(bf2f((bf16_t)lo[0]) * wlo[0], bf2f((bf16_t)lo[1]) * wlo[1]), w1 = pk2(bf2f((bf16_t)lo[2]) * wlo[2], bf2f((bf16_t)lo[3]) * wlo[3]);
          const unsigned w2 = pk2(bf2f((bf16_t)hi[0]) * whi[0], bf2f((bf16_t)hi[1]) * whi[1]), w3 = pk2(bf2f((bf16_t)hi[2]) * whi[2], bf2f((bf16_t)hi[3]) * whi[3]);
          xf[pt] = (bf16x8){(short)(w0 & 0xffff), (short)(w0 >> 16), (short)(w1 & 0xffff), (short)(w1 >> 16), (short)(w2 & 0xffff), (short)(w2 >> 16), (short)(w3 & 0xffff), (short)(w3 >> 16)};
        }
#pragma unroll
        for (int nt = 0; nt < 8; ++nt) {
          const s16x4 lo = tr_read(Bs + (32 * k + 4 * Qd + (r >> 2)) * BP + 16 * nt + 4 * (r & 3));
          const s16x4 hi = tr_read(Bs + (32 * k + 16 + 4 * Qd + (r >> 2)) * BP + 16 * nt + 4 * (r & 3));
          const bf16x8 bfr = (bf16x8){lo[0], lo[1], lo[2], lo[3], hi[0], hi[1], hi[2], hi[3]};
          acc[nt][0] = __builtin_amdgcn_mfma_f32_16x16x32_bf16(bfr, xf[0], acc[nt][0], 0, 0, 0);
          acc[nt][1] = __builtin_amdgcn_mfma_f32_16x16x32_bf16(bfr, xf[1], acc[nt][1], 0, 0, 0);
        }
      }
#pragma unroll
      for (int nt = 0; nt < 8; ++nt)
#pragma unroll
        for (int pt = 0; pt < 2; ++pt) { const f32x4 v = acc[nt][pt];
          *(unsigned long long*)(Sp + (size_t)(32 * pp + 16 * pt + r) * 128 + 16 * nt + 4 * Qd) = (unsigned long long)pk2(v[0], v[1]) | ((unsigned long long)pk2(v[2], v[3]) << 32); }
    }
  }
}
DEV void ssd_scan_phase(bf16_t* ST, const float* SDEC, bool wr) {
  for (int item = blockIdx.x * 512 + threadIdx.x; item < 2 * 16 * 2 * 2048; item += gridDim.x * 512) {
    const int e4 = item & 2047, dir = (item >> 11) & 1, h = (item >> 12) & 15, b = item >> 16;
    float S0 = 0.f, S1 = 0.f, S2 = 0.f, S3 = 0.f;
#define SCAN_GC(s) (!dir ? ((s) < 2 ? 128 + 2 * b + (s) : b * 64 + ((s) - 2)) : ((s) < 2 ? 128 + 2 * b + (1 - (s)) : b * 64 + (65 - (s))))
    for (int s0 = 0; s0 < 66; s0 += 6) {
      unsigned long long u[6]; float dec[6];
#pragma unroll
      for (int q = 0; q < 6; ++q) { const int gc = SCAN_GC(s0 + q); u[q] = *(const unsigned long long*)(ST + (((size_t)gc * 16 + h) * 2 + dir) * 8192 + e4 * 4); dec[q] = SDEC[(gc * 16 + h) * 2 + dir]; }
#pragma unroll
      for (int q = 0; q < 6; ++q) { const int gc = SCAN_GC(s0 + q);
        if (wr) *(unsigned long long*)(ST + (((size_t)gc * 16 + h) * 2 + dir) * 8192 + e4 * 4) = (unsigned long long)pk2(S0, S1) | ((unsigned long long)pk2(S2, S3) << 32);
        const unsigned lo = (unsigned)u[q], hi = (unsigned)(u[q] >> 32);
        S0 = dec[q] * S0 + __uint_as_float(lo << 16); S1 = dec[q] * S1 + __uint_as_float(lo & 0xffff0000u); S2 = dec[q] * S2 + __uint_as_float(hi << 16); S3 = dec[q] * S3 + __uint_as_float(hi & 0xffff0000u); }
    }
#undef SCAN_GC
  }
}
DEV bf16x8 scale_frag(bf16x8 f, float s) {
  bf16x8 o;
#pragma unroll
  for (int e = 0; e < 8; e += 2) { const unsigned w = pk2(bf2f((bf16_t)f[e]) * s, bf2f((bf16_t)f[e + 1]) * s); o[e] = (short)(w & 0xffff); o[e + 1] = (short)(w >> 16); }
  return o;
}
DEV void ssd_y_phase(const bf16_t* XC, const float* SDT, const float* SCS, const bf16_t* ST, const float* d_skip, bf16_t* Y0, float* SSQ, LAS unsigned char* lds, bool wr) {
  constexpr int XP = 272, BP = 136;
  LAS bf16_t* Xs = (LAS bf16_t*)lds; LAS bf16_t* Bs = (LAS bf16_t*)(lds + 128 * XP * 2);
  LAS float* tab = (LAS float*)(lds + 128 * XP * 2 + 128 * BP * 2);
  LAS float* ssq = tab + 4 * 4 * 128;
  const int tid = threadIdx.x, lane = tid & 63, wid = tid >> 6, r = lane & 15, Qd = lane >> 4, hl = wid >> 1, ih = wid & 1;
  for (int task = blockIdx.x; task < NCH * 4; task += gridDim.x) {
    const int gc = task >> 2, g = (task >> 1) & 1, hh = task & 1; const size_t r0 = (size_t)gc * 128; const int h0 = g * 8 + hh * 4, h = h0 + hl;
    __syncthreads();
#pragma unroll
    for (int i = 0; i < 8; ++i) { const int cid = tid + 512 * i, row = cid >> 5, ch = cid & 31; *(LAS v4u*)(Xs + row * XP + ch * 8) = *(const v4u*)(XC + (r0 + row) * 1536 + h0 * 64 + ch * 8); }
#pragma unroll
    for (int i = 0; i < 4; ++i) { const int cid = tid + 512 * i, row = cid >> 4, ch = cid & 15; *(LAS v4u*)(Bs + row * BP + ch * 8) = *(const v4u*)(XC + (r0 + row) * 1536 + 1024 + g * 128 + ch * 8); }
#pragma unroll
    for (int i = 0; i < 4; ++i) { const int e = tid + 512 * i, hq = e >> 9, which = (e >> 7) & 3, t = e & 127; const int col = (which & 1) * 16 + h0 + hq;
      tab[e] = (which < 2 ? SCS : SDT)[(r0 + t) * 32 + col]; }
    __syncthreads();
    const LAS float* csf = tab + hl * 512; const LAS float* csb = csf + 128; const LAS float* dtf = csf + 256; const LAS float* dtb = csf + 384;
    const float dsk = d_skip[h];
#pragma unroll 1
    for (int m = 0; m < 4; ++m) {
      const int i = 64 * ih + 16 * m + r;
      bf16x8 cf[4];
#pragma unroll
      for (int ks = 0; ks < 4; ++ks) cf[ks] = *(const bf16x8*)(XC + (r0 + i) * 1536 + 1280 + g * 128 + 32 * ks + 8 * Qd);
      f32x4 y[4];
#pragma unroll
      for (int pt = 0; pt < 4; ++pt) y[pt] = (f32x4){0.f, 0.f, 0.f, 0.f};
      const float cfi = csf[i], cbi = csb[i];
#pragma unroll 1
      for (int dir = 0; dir < 2; ++dir) {
        const float sc = __expf(dir ? cbi : cfi);
        const bf16_t* Sp = ST + ((((size_t)gc * 16 + h) * 2 + dir) * 64) * 128;
#pragma unroll
        for (int ks = 0; ks < 4; ++ks) {
          const bf16x8 a = scale_frag(cf[ks], sc);
#pragma unroll
          for (int pt = 0; pt < 4; ++pt) { const bf16x8 sf = *(const bf16x8*)(Sp + (size_t)(16 * pt + r) * 128 + 32 * ks + 8 * Qd); y[pt] = __builtin_amdgcn_mfma_f32_16x16x32_bf16(a, sf, y[pt], 0, 0, 0); }
        }
      }
#pragma unroll 1
      for (int k2 = 0; k2 < 4; ++k2) {
        bf16x8 pa;
#pragma unroll
        for (int tt = 0; tt < 2; ++tt) {
          f32x4 c = {0.f, 0.f, 0.f, 0.f};
#pragma unroll
          for (int ks = 0; ks < 4; ++ks) { const bf16x8 bfr = *(const LAS bf16x8*)(Bs + (32 * k2 + 16 * tt + r) * BP + 32 * ks + 8 * Qd); c = __builtin_amdgcn_mfma_f32_16x16x32_bf16(bfr, cf[ks], c, 0, 0, 0); }
          const int j0 = 32 * k2 + 16 * tt + 4 * Qd;
          const f32x4 jf = *(const LAS f32x4*)(csf + j0), jb = *(const LAS f32x4*)(csb + j0), jdf = *(const LAS f32x4*)(dtf + j0), jdb = *(const LAS f32x4*)(dtb + j0);
          float pv[4];
#pragma unroll
          for (int jj = 0; jj < 4; ++jj) { const int j = j0 + jj;
            const float Lf = __expf(j <= i ? cfi - jf[jj] : -INFINITY) * jdf[jj];
            const float Lb = __expf(j >= i ? cbi - jb[jj] : -INFINITY) * jdb[jj];
            pv[jj] = c[jj] * (Lf + Lb) + (j == i ? dsk : 0.f); }
          const unsigned w0 = pk2(pv[0], pv[1]), w1 = pk2(pv[2], pv[3]);
          pa[tt * 4 + 0] = (short)(w0 & 0xffff); pa[tt * 4 + 1] = (short)(w0 >> 16); pa[tt * 4 + 2] = (short)(w1 & 0xffff); pa[tt * 4 + 3] = (short)(w1 >> 16);
        }
#pragma unroll
        for (int pt = 0; pt < 4; ++pt) {
          const s16x4 lo = tr_read(Xs + (32 * k2 + 4 * Qd + (r >> 2)) * XP + hl * 64 + 16 * pt + 4 * (r & 3));
          const s16x4 hi = tr_read(Xs + (32 * k2 + 16 + 4 * Qd + (r >> 2)) * XP + hl * 64 + 16 * pt + 4 * (r & 3));
          const bf16x8 xf = (bf16x8){lo[0], lo[1], lo[2], lo[3], hi[0], hi[1], hi[2], hi[3]};
          y[pt] = __builtin_amdgcn_mfma_f32_16x16x32_bf16(pa, xf, y[pt], 0, 0, 0);
        }
      }
#pragma unroll
      for (int jj = 0; jj < 4; ++jj) { const int il = 64 * ih + 16 * m + 4 * Qd + jj; const size_t yo = (r0 + il) * 2048 + h * 64 + r; float ss = 0.f;
#pragma unroll
        for (int pt = 0; pt < 4; ++pt) { const float v = y[pt][jj] * bf2f(Y0[yo + 16 * pt]); ss += v * v; if (wr) Y0[yo + 16 * pt] = f2bf(v); }
        ss += __shfl_xor(ss, 1); ss += __shfl_xor(ss, 2); ss += __shfl_xor(ss, 4); ss += __shfl_xor(ss, 8);
        if (r == 0) ssq[hl * 128 + il] = ss; }
    }
    __syncthreads();
    if (tid < 128) SSQ[((r0 + tid) * 2 + g) * 2 + hh] = (ssq[tid] + ssq[128 + tid]) + (ssq[256 + tid] + ssq[384 + tid]);
  }
}

constexpr size_t WS_GCSC = 237 * MiB + 4 * MiB;
DEV const float* gcs_row(const float* lat, const float* ctx, size_t row) { return row < (size_t)ML ? lat + row * 1024 : ctx + (row - ML) * 1024; }
DEV float* gcs_row_w(float* lat, float* ctx, size_t row) { return row < (size_t)ML ? lat + row * 1024 : ctx + (row - ML) * 1024; }
DEV float logsig_fast(float x) { return fminf(x, 0.f) - __logf(1.f + __expf(-fabsf(x))); }
DEV void gla_cs_phase(const float* DTLR, const float* gw, const float* gb, float* GCSL, float* GCSC, float* GDEC) {
  const int lane = threadIdx.x & 63, wave = threadIdx.x >> 6, kl = lane & 7, seg = lane >> 3;
  for (int wt = blockIdx.x * NWAVES + wave; wt < NCH * 2 * 64; wt += gridDim.x * NWAVES) {
    const int gc = wt >> 7, dir = (wt >> 6) & 1, k = (wt & 63) * 8 + kl;
    float wv[16];
#pragma unroll
    for (int q = 0; q < 16; ++q) wv[q] = gw[(dir * 16 + q) * 512 + k];
    const float bias = gb[dir * 512 + k];
    float v[16]; float run = 0.f;
#pragma unroll
    for (int u = 0; u < 16; ++u) { const int s = seg * 16 + u, t = dir ? 127 - s : s; const float* lr = DTLR + ((size_t)gc * 128 + t) * 64 + 32 + dir * 16;
      const f32x4 l0 = *(const f32x4*)lr, l1 = *(const f32x4*)(lr + 4), l2 = *(const f32x4*)(lr + 8), l3 = *(const f32x4*)(lr + 12);
      float lg = bias + l0.x * wv[0] + l0.y * wv[1] + l0.z * wv[2] + l0.w * wv[3] + l1.x * wv[4] + l1.y * wv[5] + l1.z * wv[6] + l1.w * wv[7]
                 + l2.x * wv[8] + l2.y * wv[9] + l2.z * wv[10] + l2.w * wv[11] + l3.x * wv[12] + l3.y * wv[13] + l3.z * wv[14] + l3.w * wv[15];
      run += logsig_fast(lg) * (1.f / 16.f); v[u] = run; }
    float off = 0.f;
#pragma unroll
    for (int sgi = 0; sgi < 7; ++sgi) { const float tot = __shfl(run, kl + 8 * sgi); off += (sgi < seg) ? tot : 0.f; }
#pragma unroll
    for (int u = 0; u < 16; ++u) { const int s = seg * 16 + u, t = dir ? 127 - s : s; gcs_row_w(GCSL, GCSC, (size_t)gc * 128 + t)[dir * 512 + k] = v[u] + off; }
    if (seg == 7) GDEC[((gc * 4 + (k >> 7)) * 2 + dir) * 128 + (k & 127)] = __expf(run + off);
  }
}
DEV void gla_u_phase(const bf16_t* K0, const bf16_t* V0, const float* GCSL, const float* GCSC, bf16_t* ST, LAS unsigned char* lds) {
  constexpr int VP = 272, KP = 144;
  LAS bf16_t* Vs = (LAS bf16_t*)lds; LAS bf16_t* Kd = (LAS bf16_t*)(lds + 128 * VP * 2);
  const int tid = threadIdx.x, lane = tid & 63, wid = tid >> 6, r = lane & 15, Qd = lane >> 4;
  for (int task = blockIdx.x; task < NCH * 4; task += gridDim.x) {
    const int gc = task >> 2, h = task & 3; const size_t r0 = (size_t)gc * 128;
    __syncthreads();
#pragma unroll
    for (int i = 0; i < 8; ++i) { const int cid = tid + 512 * i, row = cid >> 5, ch = cid & 31; *(LAS v4u*)(Vs + row * VP + ch * 8) = *(const v4u*)(V0 + (r0 + row) * 1024 + h * 256 + ch * 8); }
#pragma unroll
    for (int i = 0; i < 4; ++i) { const int cid = tid + 512 * i, t = cid >> 4, ch = cid & 15;
      const v4u kv = *(const v4u*)(K0 + (r0 + t) * 512 + h * 128 + ch * 8);
      const float kf[8] = {__uint_as_float(kv.x << 16), __uint_as_float(kv.x & 0xffff0000u), __uint_as_float(kv.y << 16), __uint_as_float(kv.y & 0xffff0000u), __uint_as_float(kv.z << 16), __uint_as_float(kv.z & 0xffff0000u), __uint_as_float(kv.w << 16), __uint_as_float(kv.w & 0xffff0000u)};
#pragma unroll
      for (int dir = 0; dir < 2; ++dir) {
        const float* ce = gcs_row(GCSL, GCSC, r0 + (dir ? 0 : 127)) + dir * 512 + h * 128 + ch * 8; const float* ct = gcs_row(GCSL, GCSC, r0 + t) + dir * 512 + h * 128 + ch * 8;
        const f32x4 e0 = *(const f32x4*)ce, e1 = *(const f32x4*)(ce + 4), c0 = *(const f32x4*)ct, c1 = *(const f32x4*)(ct + 4);
        v4u o; o.x = pk2(kf[0] * __expf(e0.x - c0.x), kf[1] * __expf(e0.y - c0.y)); o.y = pk2(kf[2] * __expf(e0.z - c0.z), kf[3] * __expf(e0.w - c0.w));
        o.z = pk2(kf[4] * __expf(e1.x - c1.x), kf[5] * __expf(e1.y - c1.y)); o.w = pk2(kf[6] * __expf(e1.z - c1.z), kf[7] * __expf(e1.w - c1.w));
        *(LAS v4u*)(Kd + dir * 128 * KP + t * KP + ch * 8) = o; } }
    __syncthreads();
#pragma unroll 1
    for (int dir = 0; dir < 2; ++dir) {
      const LAS bf16_t* Kb = Kd + dir * 128 * KP;
      f32x4 acc[8][2];
#pragma unroll
      for (int dt = 0; dt < 8; ++dt) { acc[dt][0] = (f32x4){0.f, 0.f, 0.f, 0.f}; acc[dt][1] = (f32x4){0.f, 0.f, 0.f, 0.f}; }
#pragma unroll 1
      for (int k = 0; k < 4; ++k) {
        bf16x8 vf[2];
#pragma unroll
        for (int et = 0; et < 2; ++et) {
          const s16x4 lo = tr_read(Vs + (32 * k + 4 * Qd + (r >> 2)) * VP + 32 * wid + 16 * et + 4 * (r & 3));
          const s16x4 hi = tr_read(Vs + (32 * k + 16 + 4 * Qd + (r >> 2)) * VP + 32 * wid + 16 * et + 4 * (r & 3));
          vf[et] = (bf16x8){lo[0], lo[1], lo[2], lo[3], hi[0], hi[1], hi[2], hi[3]}; }
#pragma unroll
        for (int dt = 0; dt < 8; ++dt) {
          const s16x4 lo = tr_read(Kb + (32 * k + 4 * Qd + (r >> 2)) * KP + 16 * dt + 4 * (r & 3));
          const s16x4 hi = tr_read(Kb + (32 * k + 16 + 4 * Qd + (r >> 2)) * KP + 16 * dt + 4 * (r & 3));
          const bf16x8 kfr = (bf16x8){lo[0], lo[1], lo[2], lo[3], hi[0], hi[1], hi[2], hi[3]};
          acc[dt][0] = __builtin_amdgcn_mfma_f32_16x16x32_bf16(kfr, vf[0], acc[dt][0], 0, 0, 0);
          acc[dt][1] = __builtin_amdgcn_mfma_f32_16x16x32_bf16(kfr, vf[1], acc[dt][1], 0, 0, 0); }
      }
      bf16_t* Sp = ST + (((size_t)gc * 4 + h) * 2 + dir) * 32768;
#pragma unroll
      for (int dt = 0; dt < 8; ++dt)
#pragma unroll
        for (int et = 0; et < 2; ++et) { const f32x4 v = acc[dt][et];
          *(unsigned long long*)(Sp + (size_t)(32 * wid + 16 * et + r) * 128 + 16 * dt + 4 * Qd) = (unsigned long long)pk2(v[0], v[1]) | ((unsigned long long)pk2(v[2], v[3]) << 32); }
    }
  }
}
DEV void gla_scan_phase(bf16_t* ST, const float* GDEC, bool wr) {
  for (int item = blockIdx.x * 512 + threadIdx.x; item < 2 * 4 * 2 * 8192; item += gridDim.x * 512) {
    const int e4 = item & 8191, dir = (item >> 13) & 1, h = (item >> 14) & 3, b = item >> 16; const int d0 = (e4 * 4) & 127;
    float S0 = 0.f, S1 = 0.f, S2 = 0.f, S3 = 0.f;
#define SCAN_GC(s) (!dir ? ((s) < 2 ? 128 + 2 * b + (s) : b * 64 + ((s) - 2)) : ((s) < 2 ? 128 + 2 * b + (1 - (s)) : b * 64 + (65 - (s))))
    for (int s0 = 0; s0 < 66; s0 += 6) {
      unsigned long long u[6]; f32x4 dec[6];
#pragma unroll
      for (int q = 0; q < 6; ++q) { const int gc = SCAN_GC(s0 + q); u[q] = *(const unsigned long long*)(ST + (((size_t)gc * 4 + h) * 2 + dir) * 32768 + e4 * 4); dec[q] = *(const f32x4*)(GDEC + ((gc * 4 + h) * 2 + dir) * 128 + d0); }
#pragma unroll
      for (int q = 0; q < 6; ++q) { const int gc = SCAN_GC(s0 + q);
        if (wr) *(unsigned long long*)(ST + (((size_t)gc * 4 + h) * 2 + dir) * 32768 + e4 * 4) = (unsigned long long)pk2(S0, S1) | ((unsigned long long)pk2(S2, S3) << 32);
        const unsigned lo = (unsigned)u[q], hi = (unsigned)(u[q] >> 32);
        S0 = dec[q].x * S0 + __uint_as_float(lo << 16); S1 = dec[q].y * S1 + __uint_as_float(lo & 0xffff0000u); S2 = dec[q].z * S2 + __uint_as_float(hi << 16); S3 = dec[q].w * S3 + __uint_as_float(hi & 0xffff0000u); }
    }
#undef SCAN_GC
  }
}
DEV void gla_o_phase(const bf16_t* Q0, const bf16_t* K0, const bf16_t* V0, const float* GCSL, const float* GCSC, const bf16_t* ST, const float* gla_norm, const float* SSQ, const float* ssd_norm, bf16_t* Y0, LAS unsigned char* lds, bool wr) {
  constexpr int VP = 272, KP = 136;
  LAS bf16_t* Vs = (LAS bf16_t*)lds; LAS bf16_t* Kd = (LAS bf16_t*)(lds + 128 * VP * 2);
  const int tid = threadIdx.x, lane = tid & 63, wid = tid >> 6, r = lane & 15, Qd = lane >> 4;
  const float scale = 0.08838834764831845f;
  for (int task = blockIdx.x; task < NCH * 4; task += gridDim.x) {
    const int gc = task >> 2, h = task & 3; const size_t r0 = (size_t)gc * 128;
    __syncthreads();
#pragma unroll
    for (int i = 0; i < 8; ++i) { const int cid = tid + 512 * i, row = cid >> 5, ch = cid & 31; *(LAS v4u*)(Vs + row * VP + ch * 8) = *(const v4u*)(V0 + (r0 + row) * 1024 + h * 256 + ch * 8); }
#pragma unroll
    for (int i = 0; i < 4; ++i) { const int cid = tid + 512 * i, t = cid >> 4, ch = cid & 15;
      const v4u kv = *(const v4u*)(K0 + (r0 + t) * 512 + h * 128 + ch * 8);
      const float kf[8] = {__uint_as_float(kv.x << 16), __uint_as_float(kv.x & 0xffff0000u), __uint_as_float(kv.y << 16), __uint_as_float(kv.y & 0xffff0000u), __uint_as_float(kv.z << 16), __uint_as_float(kv.z & 0xffff0000u), __uint_as_float(kv.w << 16), __uint_as_float(kv.w & 0xffff0000u)};
#pragma unroll
      for (int dir = 0; dir < 2; ++dir) {
        const float* ct = gcs_row(GCSL, GCSC, r0 + t) + dir * 512 + h * 128 + ch * 8;
        const f32x4 c0 = *(const f32x4*)ct, c1 = *(const f32x4*)(ct + 4);
        v4u o; o.x = pk2(kf[0] * __expf(-c0.x), kf[1] * __expf(-c0.y)); o.y = pk2(kf[2] * __expf(-c0.z), kf[3] * __expf(-c0.w));
        o.z = pk2(kf[4] * __expf(-c1.x), kf[5] * __expf(-c1.y)); o.w = pk2(kf[6] * __expf(-c1.z), kf[7] * __expf(-c1.w));
        *(LAS v4u*)(Kd + dir * 128 * KP + t * KP + ch * 8) = o; } }
    __syncthreads();
    const int i = 16 * wid + r;
    f32x4 o[16];
#pragma unroll
    for (int et = 0; et < 16; ++et) o[et] = (f32x4){0.f, 0.f, 0.f, 0.f};
#pragma unroll 1
    for (int dir = 0; dir < 2; ++dir) {
      bf16x8 qd[4];
      { const float* ci = gcs_row(GCSL, GCSC, r0 + i) + dir * 512 + h * 128; const bf16_t* qp = Q0 + (r0 + i) * 512 + h * 128;
#pragma unroll
        for (int ks = 0; ks < 4; ++ks) { const v4u qv = *(const v4u*)(qp + 32 * ks + 8 * Qd); const f32x4 c0 = *(const f32x4*)(ci + 32 * ks + 8 * Qd), c1 = *(const f32x4*)(ci + 32 * ks + 8 * Qd + 4);
          const unsigned w0 = pk2(__uint_as_float(qv.x << 16) * scale * __expf(c0.x), __uint_as_float(qv.x & 0xffff0000u) * scale * __expf(c0.y));
          const unsigned w1 = pk2(__uint_as_float(qv.y << 16) * scale * __expf(c0.z), __uint_as_float(qv.y & 0xffff0000u) * scale * __expf(c0.w));
          const unsigned w2 = pk2(__uint_as_float(qv.z << 16) * scale * __expf(c1.x), __uint_as_float(qv.z & 0xffff0000u) * scale * __expf(c1.y));
          const unsigned w3 = pk2(__uint_as_float(qv.w << 16) * scale * __expf(c1.z), __uint_as_float(qv.w & 0xffff0000u) * scale * __expf(c1.w));
          qd[ks] = (bf16x8){(short)(w0 & 0xffff), (short)(w0 >> 16), (short)(w1 & 0xffff), (short)(w1 >> 16), (short)(w2 & 0xffff), (short)(w2 >> 16), (short)(w3 & 0xffff), (short)(w3 >> 16)}; } }
      const bf16_t* Sp = ST + (((size_t)gc * 4 + h) * 2 + dir) * 32768;
#pragma unroll 1
      for (int ks = 0; ks < 4; ++ks)
#pragma unroll
        for (int et = 0; et < 16; ++et) { const bf16x8 sf = *(const bf16x8*)(Sp + (size_t)(16 * et + r) * 128 + 32 * ks + 8 * Qd); o[et] = __builtin_amdgcn_mfma_f32_16x16x32_bf16(qd[ks], sf, o[et], 0, 0, 0); }
      const LAS bf16_t* Kb = Kd + dir * 128 * KP;
#pragma unroll 1
      for (int k2 = 0; k2 < 4; ++k2) {
        const bool need = dir ? (2 * k2 + 1 >= wid) : (2 * k2 <= wid);
        if (!need) continue;
        bf16x8 pa;
#pragma unroll
        for (int tt = 0; tt < 2; ++tt) { const int t = 2 * k2 + tt;
          f32x4 c = {0.f, 0.f, 0.f, 0.f};
#pragma unroll
          for (int ks = 0; ks < 4; ++ks) { const bf16x8 kfr = *(const LAS bf16x8*)(Kb + (16 * t + r) * KP + 32 * ks + 8 * Qd); c = __builtin_amdgcn_mfma_f32_16x16x32_bf16(kfr, qd[ks], c, 0, 0, 0); }
          float pv[4];
#pragma unroll
          for (int jj = 0; jj < 4; ++jj) { const int j = 16 * t + 4 * Qd + jj; const bool ok = dir ? (j >= i) : (j <= i); pv[jj] = ok ? c[jj] : 0.f; }
          const unsigned w0 = pk2(pv[0], pv[1]), w1 = pk2(pv[2], pv[3]);
          pa[tt * 4 + 0] = (short)(w0 & 0xffff); pa[tt * 4 + 1] = (short)(w0 >> 16); pa[tt * 4 + 2] = (short)(w1 & 0xffff); pa[tt * 4 + 3] = (short)(w1 >> 16); }
#pragma unroll
        for (int et = 0; et < 16; ++et) {
          const s16x4 lo = tr_read(Vs + (32 * k2 + 4 * Qd + (r >> 2)) * VP + 16 * et + 4 * (r & 3));
          const s16x4 hi = tr_read(Vs + (32 * k2 + 16 + 4 * Qd + (r >> 2)) * VP + 16 * et + 4 * (r & 3));
          const bf16x8 vf = (bf16x8){lo[0], lo[1], lo[2], lo[3], hi[0], hi[1], hi[2], hi[3]};
          o[et] = __builtin_amdgcn_mfma_f32_16x16x32_bf16(pa, vf, o[et], 0, 0, 0); }
      }
    }
#pragma unroll
    for (int jj = 0; jj < 4; ++jj) { float ss = 0.f;
#pragma unroll
      for (int et = 0; et < 16; ++et) ss += o[et][jj] * o[et][jj];
      ss += __shfl_xor(ss, 1); ss += __shfl_xor(ss, 2); ss += __shfl_xor(ss, 4); ss += __shfl_xor(ss, 8);
      const float rstd = rsqrtf(ss * (1.f / 256.f) + EPS);
      const size_t yo = (r0 + 16 * wid + 4 * Qd + jj) * 2048 + 1024 + h * 256 + r;
#pragma unroll
      for (int et = 0; et < 16; ++et) { const bf16_t ov_ = f2bf(o[et][jj] * rstd * gla_norm[h * 256 + 16 * et + r] * bf2f(Y0[yo + 16 * et])); if (wr) Y0[yo + 16 * et] = ov_; } }
    { const int g = h >> 1, c0 = g * 512 + (h & 1) * 256;
#pragma unroll
      for (int q = 0; q < 8; ++q) { const int cid = tid + 512 * q, row = cid >> 5, ch = cid & 31; const size_t rr = r0 + row;
        const float rstd = rsqrtf((SSQ[(rr * 2 + g) * 2] + SSQ[(rr * 2 + g) * 2 + 1]) * (1.f / 512.f) + EPS);
        bf16_t* yp = Y0 + rr * 2048 + c0 + ch * 8; const v4u yv = *(const v4u*)yp; const f32x4 g0 = *(const f32x4*)(ssd_norm + c0 + ch * 8), g1 = *(const f32x4*)(ssd_norm + c0 + ch * 8 + 4);
        v4u ov; ov.x = pk2(__uint_as_float(yv.x << 16) * rstd * g0.x, __uint_as_float(yv.x & 0xffff0000u) * rstd * g0.y); ov.y = pk2(__uint_as_float(yv.y << 16) * rstd * g0.z, __uint_as_float(yv.y & 0xffff0000u) * rstd * g0.w);
        ov.z = pk2(__uint_as_float(yv.z << 16) * rstd * g1.x, __uint_as_float(yv.z & 0xffff0000u) * rstd * g1.y); ov.w = pk2(__uint_as_float(yv.w << 16) * rstd * g1.z, __uint_as_float(yv.w & 0xffff0000u) * rstd * g1.w);
        if (wr) *(v4u*)yp = ov; } }
  }
}

typedef __attribute__((address_space(1))) unsigned gu32;
#define RLX_AGENT __ATOMIC_RELAXED, __HIP_MEMORY_SCOPE_AGENT
#define XB_TMO      128
#define XB_XCNT(j)  (256  + 64 * (j))
#define XB_XSUB(j)  (1280 + 64 * (j))
#define XB_XGEN(j)  (2304 + 64 * (j))
#define XB_TOP      3328
#define XB_TOPGEN   3392
#define XCD_BAR_WORDS 3456
#define XB_SPIN_CAP (1u << 18)

__device__ __forceinline__ unsigned xb_ld(unsigned* p)              { return __hip_atomic_load(p, __ATOMIC_RELAXED, __HIP_MEMORY_SCOPE_AGENT); }
__device__ __forceinline__ unsigned xb_add(unsigned* p, unsigned v) { return __hip_atomic_fetch_add(p, v, __ATOMIC_RELAXED, __HIP_MEMORY_SCOPE_AGENT); }
__device__ __forceinline__ unsigned xb_xcc_id() { return (unsigned)__builtin_amdgcn_s_getreg((3 << 11) | 20) & 0xFu; }
#define XB_SPIN(cond, bar) do { unsigned _sp = 0; while (cond) { __builtin_amdgcn_s_sleep(1); \
    if ((++_sp & 255u) == 0u) { if (xb_ld(&(bar)[XB_TMO])) break; if (_sp > XB_SPIN_CAP) { atomicAdd(&(bar)[XB_TMO], 1u); break; } } } } while (0)

struct XcdBarrier {
    unsigned* bar; unsigned x;
    volatile LAS unsigned* st;
};

__device__ __forceinline__ XcdBarrier xcd_barrier_post(unsigned* bar, volatile LAS unsigned* st) {
    XcdBarrier b; b.bar = bar; b.x = xb_xcc_id(); b.st = st;
    if (threadIdx.x == 0) (void)xb_add(&bar[XB_XCNT(b.x)], 1u);
    return b;
}
__device__ __forceinline__ void xcd_barrier_complete(unsigned* bar, unsigned x, unsigned& nloc, unsigned& nx) {
    const unsigned G = gridDim.x * gridDim.y * gridDim.z;
    unsigned sum, cnt, mine, sp = 0u;
    for (;;) {
        sum = 0u; cnt = 0u; mine = 0u;
#pragma unroll
        for (unsigned j = 0; j < 16; ++j) { const unsigned c = xb_ld(&bar[XB_XCNT(j)]); sum += c; cnt += (c > 0u) ? 1u : 0u; mine = (j == x) ? c : mine; }
        if (sum == G) break;
        __builtin_amdgcn_s_sleep(1);
        if ((++sp & 255u) == 0u) { if (xb_ld(&bar[XB_TMO])) break; if (sp > XB_SPIN_CAP) { atomicAdd(&bar[XB_TMO], 1u); break; } }
    }
    nloc = mine > 0u ? mine : 1u; nx = cnt > 0u ? cnt : 1u;
}

__device__ __forceinline__ void xcd_barrier(const XcdBarrier& b) {
    asm volatile("s_waitcnt vmcnt(0)" ::: "memory");
    __syncthreads();
    if (threadIdx.x == 0) {
        unsigned* bar = b.bar;
        __builtin_amdgcn_s_waitcnt(0);
        unsigned nloc = b.st[0], nx = b.st[1];
        if (nloc == 0u) { xcd_barrier_complete(bar, b.x, nloc, nx); b.st[0] = nloc; b.st[1] = nx; }
        const unsigned old = xb_add(&bar[XB_XSUB(b.x)], 1u);
        const unsigned gen = old / nloc;
        if (old + 1u == (gen + 1u) * nloc) {
            __builtin_amdgcn_fence(__ATOMIC_RELEASE, "agent");
            asm volatile("s_waitcnt vmcnt(0)" ::: "memory");
            const unsigned og = xb_add(&bar[XB_TOP], 1u);
            const unsigned tg = og / nx;
            if (og + 1u == (tg + 1u) * nx) xb_add(&bar[XB_TOPGEN], 1u);
            else XB_SPIN(xb_ld(&bar[XB_TOPGEN]) == tg, bar);
            __builtin_amdgcn_fence(__ATOMIC_ACQUIRE, "agent");
            xb_add(&bar[XB_XGEN(b.x)], 1u);
            asm volatile("s_waitcnt vmcnt(0)" ::: "memory");
        } else {
            XB_SPIN(xb_ld(&bar[XB_XGEN(b.x)]) == gen, bar);
            __builtin_amdgcn_fence(__ATOMIC_ACQUIRE, "agent");
            asm volatile("s_waitcnt vmcnt(0)" ::: "memory");
        }
    }
    __syncthreads();
}

__global__ void __launch_bounds__(NWAVES * 64, 2) mega(Params p) {
  extern __shared__ __attribute__((aligned(16))) unsigned char lds_raw[];
  LAS unsigned char* lds = (LAS unsigned char*)lds_raw;
  cg::grid_group grid = cg::this_grid();
  volatile LAS unsigned* MISC = (volatile LAS unsigned*)(lds + MISC_OFF);
  if (threadIdx.x < 16) MISC[threadIdx.x] = 0u;
  __syncthreads();
  XcdBarrier bar = xcd_barrier_post((unsigned*)(p.ws + WS_CTL), MISC + 8);
  unsigned char* ws = p.ws;
  float* MOD = (float*)(ws + WS_MOD);
  bf16_t* H0 = (bf16_t*)p.out; float* X1 = p.out;
  const int lo = p.ph_lo, hi = p.ph_hi;
#define IN(k) (lo <= (k) && (k) < hi)
#define SEAM(k) do { if ((k) + 1 < hi) { if ((k) == 0) grid.sync(); else xcd_barrier(bar); } } while (0)
#define PH(k, ...) if (IN(k)) { if ((PROBE_MASK >> (k)) & 1u) { const bool wr = (p.rep < 0); (void)wr; __VA_ARGS__; xcd_barrier(bar); } { const bool wr = true; (void)wr; __VA_ARGS__; } SEAM(k); }
  PH(0, prologue_phase(p, lds))
  PH(1, prep_phase(p.in[0], p.in[2], p.in[4], MOD, H0))
  PH(2, {
    pg8::Gemm g{H0, (const bf16_t*)(ws + WS_W1T), MA, E_INP, D}; pg8::StaticOrder S; S.init(MA, E_INP, gridDim.x, (int)blockIdx.x);
    pg8::EpiProj0 E{(bf16_t*)(ws + WS_Y0), (bf16_t*)(ws + WS_XBC), (bf16_t*)(ws + WS_Q0), (bf16_t*)(ws + WS_K0), (bf16_t*)(ws + WS_V0), (float*)(ws + WS_DTLR)};
    pg8::gemm_phase<pg8::EpiProj0, pg8::StaticOrder, true, true>(lds, g, S, E); })
  PH(3, ssd_prep_phase((const bf16_t*)(ws + WS_XBC), p.in[8], p.in[9], (bf16_t*)p.out, (const float*)(ws + WS_DTLR), p.in[10], p.in[11], (float*)((char*)p.out + DO_SDT), (float*)((char*)p.out + DO_SCS), (float*)(ws + WS_SDEC)))
  PH(4, ssd_u_phase((const bf16_t*)p.out, (const float*)((char*)p.out + DO_SDT), (const float*)((char*)p.out + DO_SCS), (bf16_t*)(ws + WS_STATE), lds))
  PH(5, ssd_scan_phase((bf16_t*)(ws + WS_STATE), (const float*)(ws + WS_SDEC), wr))
  PH(6, ssd_y_phase((const bf16_t*)p.out, (const float*)((char*)p.out + DO_SDT), (const float*)((char*)p.out + DO_SCS), (const bf16_t*)(ws + WS_STATE), p.in[12], (bf16_t*)(ws + WS_Y0), (float*)(ws + WS_SSQ), lds, wr))
  PH(7, gla_cs_phase((const float*)(ws + WS_DTLR), p.in[14], p.in[15], (float*)p.out, (float*)(ws + WS_GCSC), (float*)(ws + WS_GDEC)))
  PH(8, gla_u_phase((const bf16_t*)(ws + WS_K0), (const bf16_t*)(ws + WS_V0), (const float*)p.out, (const float*)(ws + WS_GCSC), (bf16_t*)(ws + WS_STATE), lds))
  PH(9, gla_scan_phase((bf16_t*)(ws + WS_STATE), (const float*)(ws + WS_GDEC), wr))
  PH(10, gla_o_phase((const bf16_t*)(ws + WS_Q0), (const bf16_t*)(ws + WS_K0), (const bf16_t*)(ws + WS_V0), (const float*)p.out, (const float*)(ws + WS_GCSC), (const bf16_t*)(ws + WS_STATE), p.in[16], (const float*)(ws + WS_SSQ), p.in[13], (bf16_t*)(ws + WS_Y0), lds, wr))
  PH(11, {
    pg8::Gemm g{(const bf16_t*)(ws + WS_Y0), (const bf16_t*)(ws + WS_W2T), ML, D, 2048}; pg8::StaticOrder S; S.init(ML, D, gridDim.x, (int)blockIdx.x);
    pg8::EpiResid E{p.in[0], X1, MOD, true};
    pg8::gemm_phase<pg8::EpiResid, pg8::StaticOrder, true, true>(lds, g, S, E);
    const float* ctx = p.in[2]; float* XC1 = (float*)(ws + WS_XC1); const float* gate = MOD + 2 * 3072 + 2048;
    small_gemm((const bf16_t*)(ws + WS_Y0) + (size_t)ML * 2048, 2048, (const bf16_t*)(ws + WS_W2T), 2048, 2048, MC, D,
               [=](int m, int n, float v) { XC1[(size_t)m * D + n] = ctx[(size_t)m * D + n] + gate[n] * v; }); })
  PH(12, prep_phase(X1, (const float*)(ws + WS_XC1), p.in[18], MOD + 3 * 3072, (bf16_t*)(ws + WS_H1)))
  PH(13, {
    pg8::Gemm g{(const bf16_t*)(ws + WS_H1), (const bf16_t*)(ws + WS_W3T), ML, O_IN, D}; pg8::StaticOrder S; S.init(ML, O_IN, gridDim.x, (int)blockIdx.x);
    pg8::EpiProj1 E{(bf16_t*)(ws + WS_K1), (bf16_t*)(ws + WS_V1), (bf16_t*)(ws + WS_Q1), (bf16_t*)(ws + WS_G1)};
    pg8::gemm_phase<pg8::EpiProj1, pg8::StaticOrder, true, true>(lds, g, S, E);
    bf16_t* K1 = (bf16_t*)(ws + WS_K1); bf16_t* V1 = (bf16_t*)(ws + WS_V1);
    small_gemm((const bf16_t*)(ws + WS_H1) + (size_t)ML * D, D, (const bf16_t*)(ws + WS_W3T), D, D, MC, 1024,
               [=](int m, int n, float v) { if (n < 512) K1[(size_t)(ML + m) * 512 + n] = f2bf(v); else V1[(size_t)(ML + m) * 512 + (n - 512)] = f2bf(v); }); })
  PH(14, qknorm_phase((bf16_t*)(ws + WS_Q1), (bf16_t*)(ws + WS_K1), p.in[22], p.in[23], (const float*)(ws + WS_ROPE), wr))
  PH(15, attn_phase((bf16_t*)(ws + WS_Q1), (const bf16_t*)(ws + WS_K1), (const bf16_t*)(ws + WS_V1), (const bf16_t*)(ws + WS_G1), p.in[24], p.in[22], p.in[23], lds, wr))
  PH(16, {
    pg8::Gemm g{(const bf16_t*)(ws + WS_Q1), (const bf16_t*)(ws + WS_W4T), ML, D, 2048}; pg8::StaticOrder S; S.init(ML, D, gridDim.x, (int)blockIdx.x);
    pg8::EpiResid E{X1, p.out, MOD + 3 * 3072, wr};
    pg8::gemm_phase<pg8::EpiResid, pg8::StaticOrder, true, true>(lds, g, S, E); })
#undef PH
#undef IN
#undef SEAM
}
extern "C" void kernel_launch(void* const* d_in, const int* in_sizes, int n_in, void* d_out, int out_size, void* d_ws, size_t ws_size, hipStream_t stream) {
  static int grid_blocks = 0;
  if (!grid_blocks) {
    int dev = 0, cus = 0, per_cu = 0;
    hipGetDevice(&dev);
    hipDeviceGetAttribute(&cus, hipDeviceAttributeMultiprocessorCount, dev);
    hipFuncSetAttribute((const void*)mega, hipFuncAttributeMaxDynamicSharedMemorySize, LDS_BYTES);
    hipOccupancyMaxActiveBlocksPerMultiprocessor(&per_cu, (const void*)mega, NWAVES * 64, LDS_BYTES);
    if (per_cu < 1) { fprintf(stderr, "kernel_launch: occupancy query says %d blocks per CU\n", per_cu); per_cu = 1; }
    if (per_cu > 1) per_cu = 1;
    grid_blocks = cus * per_cu;
  }
  hipMemsetAsync((char*)d_ws + WS_CTL, 0, 64 * 1024, stream);
  Params base{};
  for (int i = 0; i < 26; ++i) base.in[i] = (const float*)d_in[i];
  base.out = (float*)d_out; base.ws = (unsigned char*)d_ws;
  auto launch = [&](int lo, int hi) {
    Params p = base; p.ph_lo = lo; p.ph_hi = hi; p.rep = (int)PROBE_MASK; void* args[] = {&p};
    hipError_t e = hipLaunchCooperativeKernel((const void*)mega, dim3(grid_blocks), dim3(NWAVES * 64), args, LDS_BYTES, stream);
    if (e != hipSuccess) fprintf(stderr, "cooperative launch failed: %s (grid %d)\n", hipGetErrorString(e), grid_blocks);
  };
  launch(0, 17);
}
```

```cpp
#include <hip/hip_runtime.h>
#include <hip/hip_cooperative_groups.h>
#include <stdint.h>
#include <math.h>
#include <cstdio>
namespace cg = cooperative_groups;
#ifndef PROBE_MASK
#define PROBE_MASK 0u
#endif

typedef unsigned short bf16_t;
#define DEV __device__ __forceinline__

DEV float bf2f(bf16_t v) { return __uint_as_float(((unsigned)v) << 16); }
DEV bf16_t f2bf(float f) { unsigned u = __float_as_uint(f); u = (u + 0x7fffu + ((u >> 16) & 1u)) >> 16; return (bf16_t)u; }
DEV unsigned pk2(float lo, float hi) { return (unsigned)f2bf(lo) | ((unsigned)f2bf(hi) << 16); }
DEV float siluf(float x) { return x / (1.f + __expf(-x)); }
DEV float silu_fast(float x) { return x * __builtin_amdgcn_rcpf(1.f + __expf(-x)); }
DEV float softplusf(float x) { return x > 20.f ? x : log1pf(__expf(x)); }
DEV float logsigmoidf(float x) { return fminf(x, 0.f) - log1pf(__expf(-fabsf(x))); }

constexpr int D = 1024, NB = 2, SEQ = 8192, CTXL = 256;
constexpr int ML = NB * SEQ;
constexpr int MC = NB * CTXL;
constexpr int MA = ML + MC;
constexpr int NCH = MA / 128;
constexpr int E_IN = 5696, O_IN = 5120, E_INP = 5888;
constexpr float EPS = 1e-6f;

constexpr size_t MiB = 1u << 20;
constexpr size_t WS_CTL = 0;
constexpr size_t WS_MOD = 1 * MiB;
constexpr size_t WS_ROPE = 1 * MiB + 128 * 1024;
constexpr size_t WS_SDEC = 1 * MiB + 256 * 1024;
constexpr size_t WS_GDEC = 1 * MiB + 384 * 1024;
constexpr size_t WS_W1T = 2 * MiB;
constexpr size_t WS_W2T = 14 * MiB;
constexpr size_t WS_W3T = 18 * MiB;
constexpr size_t WS_W4T = 28 * MiB;
constexpr size_t WS_Y0 = 32 * MiB;
constexpr size_t WS_Q0 = 98 * MiB;
constexpr size_t WS_K0 = WS_Q0 + 16 * MiB + 512 * 1024;
constexpr size_t WS_V0 = 131 * MiB;
constexpr size_t WS_DTLR = 164 * MiB;
constexpr size_t WS_XC1 = 168 * MiB + 512 * 1024;
constexpr size_t WS_XBC = 171 * MiB;
constexpr size_t WS_STATE = 171 * MiB;
constexpr size_t WS_TAIL = 237 * MiB;
constexpr size_t WS_H1 = 32 * MiB;
constexpr size_t WS_K1 = 65 * MiB;
constexpr size_t WS_V1 = 81 * MiB + 512 * 1024;
constexpr size_t WS_Q1 = 98 * MiB;
constexpr size_t WS_G1 = 171 * MiB;

DEV int row_vec(int row) { return row < ML ? (row / SEQ) : 2; }

namespace pg8 {
#define PG8_LAS __attribute__((address_space(3)))
typedef unsigned short bf16_t;
typedef short bf16x8 __attribute__((ext_vector_type(8)));
typedef float f32x4 __attribute__((ext_vector_type(4)));
typedef unsigned u32x4 __attribute__((ext_vector_type(4)));
constexpr int BM = 256, BK = 64, HALF = 128, HTB = HALF * BK * 2  , STAGE_BYTES = 8 * HTB, NXCD = 8, WGM = 8;

__host__ __device__ __forceinline__ int lds_byte(int r, int c) { const int st = (r >> 4) * 2 + (c >> 5), rr = r & 15, cc = c & 31, ob = rr * 64 + cc * 2; return st * 1024 + (ob ^ (((ob >> 9) & 1) << 5)); }
__host__ __device__ __forceinline__ void stage_rc(int b, int& R, int& C) { const int st = b / 1024, sb = b % 1024, swz = sb ^ (((sb >> 9) & 1) << 5); R = (st >> 1) * 16 + swz / 64; C = (st & 1) * 32 + (swz % 64) / 2; }
__host__ __device__ __forceinline__ int perm32(int rho) { const int n = rho >> 4, i = rho & 15; return 8 * (i >> 2) + 4 * n + (i & 3); }

struct Unit { int pm, pn; };
struct Gemm { const bf16_t* A; const bf16_t* Bt; int M, N, K; };

struct StaticOrder {
    int nM, nN, nwg, G, c;
    __host__ __device__ void init(int M, int N, int G_, int c_) { nM = M / BM; nN = N / BM; nwg = nM * nN; G = G_; c = c_; }
    __host__ __device__ bool next(int i, Unit& u) const {
        const long L = (long)i * G + c; if (L >= nwg) return false;
        int wgid = (int)L; { const int q = nwg / NXCD, r = nwg % NXCD, xcd = wgid % NXCD, off = wgid / NXCD; wgid = (xcd < r ? xcd * (q + 1) : r * (q + 1) + (xcd - r) * q) + off; }
        const int nig = WGM * nN, gid = wgid / nig, fm = gid * WGM, gsz = (nM - fm) < WGM ? (nM - fm) : WGM;
        u.pm = fm + ((wgid % nig) % gsz); u.pn = (wgid % nig) / gsz; return true;
    }
    __device__ __forceinline__ void a_ready(const Unit&) const {}
    __device__ __forceinline__ void done(const Unit&) const {}
};
__device__ __forceinline__ unsigned cvt_pk_bf16(float lo, float hi) { unsigned r; asm volatile("v_cvt_pk_bf16_f32 %0, %1, %2" : "=v"(r) : "v"(lo), "v"(hi)); return r; }
__device__ __forceinline__ float silu_e(float x) { return x * __builtin_amdgcn_rcpf(1.f + __expf(-x)); }

__device__ __forceinline__ void store_unit_bf16(const f32x4 (&acc)[2][2][4][2], bf16_t* base, int ld, int colt, bool act, const Unit& u, int wr, int wc, int fr, int fq) {
    const int row0 = u.pm * BM + wr * 64 + fr; const int col0 = colt + wc * 32 + 8 * fq;
#pragma unroll
    for (int ai = 0; ai < 2; ++ai)
#pragma unroll
        for (int m = 0; m < 4; ++m) { bf16_t* rowp = base + (size_t)(row0 + ai * HALF + m * 16) * ld + col0;
#pragma unroll
            for (int bj = 0; bj < 2; ++bj) { f32x4 v0 = acc[ai][bj][m][0], v1 = acc[ai][bj][m][1];
                if (act) { v0 = (f32x4){silu_e(v0[0]), silu_e(v0[1]), silu_e(v0[2]), silu_e(v0[3])}; v1 = (f32x4){silu_e(v1[0]), silu_e(v1[1]), silu_e(v1[2]), silu_e(v1[3])}; }
                u32x4 w; w.x = cvt_pk_bf16(v0[0], v0[1]); w.y = cvt_pk_bf16(v0[2], v0[3]); w.z = cvt_pk_bf16(v1[0], v1[1]); w.w = cvt_pk_bf16(v1[2], v1[3]);
                *(u32x4*)(rowp + bj * HALF) = w; } }
}
struct EpiProj0 {
    static constexpr bool PERM = true, AFTER_DRAIN = false;
    bf16_t *Y0, *XBC, *Q0, *K0, *V0; float* DTLR;
    __device__ __forceinline__ void operator()(const f32x4 (&acc)[2][2][4][2], const Unit& u, int wr, int wc, int fr, int fq) const {
        const int pn = u.pn;
        if (pn == 22) {
            if (wc < 2) { const int row0 = u.pm * BM + wr * 64 + fr;
#pragma unroll
                for (int ai = 0; ai < 2; ++ai)
#pragma unroll
                    for (int m = 0; m < 4; ++m) { float* rp = DTLR + (size_t)(row0 + ai * HALF + m * 16) * 64 + wc * 32 + 8 * fq; *(f32x4*)rp = acc[ai][0][m][0]; *(f32x4*)(rp + 4) = acc[ai][0][m][1]; } }
            return;
        }
        bf16_t* base; int ld, colt; bool act = false;
        if (pn < 8) { base = Y0; ld = 2048; colt = pn * 256; act = true; }
        else if (pn < 14) { base = XBC; ld = 1536; colt = (pn - 8) * 256; }
        else if (pn < 16) { base = Q0; ld = 512; colt = (pn - 14) * 256; }
        else if (pn < 18) { base = K0; ld = 512; colt = (pn - 16) * 256; }
        else { base = V0; ld = 1024; colt = (pn - 18) * 256; }
        store_unit_bf16(acc, base, ld, colt, act, u, wr, wc, fr, fq);
    }
};
struct EpiProj1 {
    static constexpr bool PERM = true, AFTER_DRAIN = false;
    bf16_t *K1, *V1, *Q1, *G1;
    __device__ __forceinline__ void operator()(const f32x4 (&acc)[2][2][4][2], const Unit& u, int wr, int wc, int fr, int fq) const {
        const int pn = u.pn; bf16_t* base; int ld, colt; bool act = false;
        if (pn < 2) { base = K1; ld = 512; colt = pn * 256; }
        else if (pn < 4) { base = V1; ld = 512; colt = (pn - 2) * 256; }
        else if (pn < 12) { base = Q1; ld = 2048; colt = (pn - 4) * 256; }
        else { base = G1; ld = 2048; colt = (pn - 12) * 256; act = true; }
        store_unit_bf16(acc, base, ld, colt, act, u, wr, wc, fr, fq);
    }
};
struct EpiResid {
    static constexpr bool PERM = false, AFTER_DRAIN = false;
    const float* res; float* out; const float* mod; bool do_store;
    __device__ __forceinline__ void operator()(const f32x4 (&acc)[2][2][4][2], const Unit& u, int wr, int wc, int fr, int fq) const {
        const int b = (u.pm * BM) / 8192; const float* gate = mod + b * 3072 + 2048;
        const int col0 = u.pn * BM + wc * 32 + 4 * fq;
        f32x4 gv[2][2];
#pragma unroll
        for (int bj = 0; bj < 2; ++bj)
#pragma unroll
            for (int n = 0; n < 2; ++n) gv[bj][n] = *(const f32x4*)(gate + col0 + bj * HALF + n * 16);
#pragma unroll
        for (int ai = 0; ai < 2; ++ai)
#pragma unroll
            for (int m = 0; m < 4; ++m) { const size_t off = (size_t)(u.pm * BM + ai * HALF + wr * 64 + m * 16 + fr) * 1024 + col0;
#pragma unroll
                for (int bj = 0; bj < 2; ++bj)
#pragma unroll
                    for (int n = 0; n < 2; ++n) { const f32x4 r = *(const f32x4*)(res + off + bj * HALF + n * 16); const f32x4 ov_ = r + gv[bj][n] * acc[ai][bj][m][n]; if (do_store) *(f32x4*)(out + off + bj * HALF + n * 16) = ov_; } }
    }
};
template <class Epi, class Sched, bool ALIGN_EPI = false, bool SP2 = false>
__device__ __forceinline__ void gemm_phase(PG8_LAS unsigned char* lds, const Gemm g, const Sched& S, const Epi& E) {
    const int tid = threadIdx.x, wid = __builtin_amdgcn_readfirstlane(tid >> 6), lane = tid & 63, wr = wid >> 2, wc = wid & 3, fr = lane & 15, fq = lane >> 4;
    const int K = g.K, nt = K / BK;
    unsigned voffA[2], voffB[2];
#pragma unroll
    for (int i = 0; i < 2; ++i) { int R, C; stage_rc(tid * 16 + i * 8192, R, C); const int Rb = Epi::PERM ? ((R & ~31) + perm32(R & 31)) : R;
        voffA[i] = (unsigned)(R * K + C) * 2u; voffB[i] = (unsigned)(Rb * K + C) * 2u; }
    const size_t kstep = (size_t)(BK * 2);
    const size_t hstep = (size_t)HALF * K * 2;
    const size_t tstep = 2 * hstep;
    const unsigned ldsw = (unsigned)wid * 1024u;
    const int aoff = lds_byte(wr * 64 + fr, fq * 8), boff = lds_byte(wc * 32 + fr, fq * 8);
#define PG8_SA(b, h) (((b) * 2 + (h)) * HTB)
#define PG8_SB(b, h) ((4 + (b) * 2 + (h)) * HTB)
#define PG8_STAGE(bufoff, gbase, voff) do { _Pragma("unroll") for (int _i = 0; _i < 2; ++_i) \
        __builtin_amdgcn_global_load_lds((const unsigned*)((const char*)(gbase) + (voff)[_i]), (PG8_LAS unsigned*)(lds + (bufoff) + ldsw + _i * 8192), 16, 0, 0); } while (0)
#define PG8_LDA(dst, b, h) do { _Pragma("unroll") for (int m = 0; m < 4; ++m) _Pragma("unroll") for (int k = 0; k < 2; ++k) dst[m][k] = *(const PG8_LAS bf16x8*)(lds + PG8_SA(b, h) + aoff + m * 2048 + k * 1024); } while (0)
#define PG8_LDB(dst, b, h) do { _Pragma("unroll") for (int n = 0; n < 2; ++n) _Pragma("unroll") for (int k = 0; k < 2; ++k) dst[n][k] = *(const PG8_LAS bf16x8*)(lds + PG8_SB(b, h) + boff + n * 2048 + k * 1024); } while (0)
#define PG8_MMA(ai, bj, At, Bt) do { __builtin_amdgcn_s_setprio(1); _Pragma("unroll") for (int m = 0; m < 4; ++m) _Pragma("unroll") for (int n = 0; n < 2; ++n) _Pragma("unroll") for (int k = 0; k < 2; ++k) \
        acc[ai][bj][m][n] = __builtin_amdgcn_mfma_f32_16x16x32_bf16(Bt[n][k], At[m][k], acc[ai][bj][m][n], 0, 0, 0); __builtin_amdgcn_s_setprio(0); } while (0)
#define PG8_WAIT_V(n) asm volatile("s_waitcnt vmcnt(" #n ")" ::: "memory")
#define PG8_WAIT_L(n) asm volatile("s_waitcnt lgkmcnt(" #n ")" ::: "memory")
#define PG8_BAR __builtin_amdgcn_s_barrier()
#define PG8_SCHED __builtin_amdgcn_sched_barrier(0)
    Unit cur, nxt; int ui = 0;
    if (!S.next(0, cur)) return;
    f32x4 acc[2][2][4][2];
#pragma unroll
    for (int a = 0; a < 2; ++a)
#pragma unroll
        for (int b = 0; b < 2; ++b)
#pragma unroll
            for (int m = 0; m < 4; ++m)
#pragma unroll
                for (int n = 0; n < 2; ++n) acc[a][b][m][n] = (f32x4){0.f, 0.f, 0.f, 0.f};
    bf16x8 At[4][2], B0[2][2], B1[2][2];
    const char* cA = (const char*)g.A + (size_t)cur.pm * tstep; const char* cB = (const char*)g.Bt + (size_t)cur.pn * tstep;
    S.a_ready(cur);
    if constexpr (SP2) {
        PG8_STAGE(PG8_SB(0, 0), cB, voffB); PG8_STAGE(PG8_SB(0, 1), cB + hstep, voffB); PG8_STAGE(PG8_SA(0, 0), cA, voffA); PG8_STAGE(PG8_SA(0, 1), cA + hstep, voffA);
        if (wr == 1) PG8_BAR;
        PG8_WAIT_V(2); PG8_BAR;
        PG8_STAGE(PG8_SB(1, 0), cB + kstep, voffB); PG8_STAGE(PG8_SA(1, 0), cA + kstep, voffA); PG8_STAGE(PG8_SB(1, 1), cB + hstep + kstep, voffB);
        PG8_WAIT_V(6); PG8_BAR;
    } else {
        PG8_STAGE(PG8_SB(0, 0), cB, voffB); PG8_STAGE(PG8_SA(0, 0), cA, voffA); PG8_STAGE(PG8_SB(0, 1), cB + hstep, voffB); PG8_STAGE(PG8_SA(0, 1), cA + hstep, voffA);
        if (wr == 1) PG8_BAR;
        PG8_WAIT_V(4); PG8_BAR;
        PG8_STAGE(PG8_SB(1, 0), cB + kstep, voffB); PG8_STAGE(PG8_SA(1, 0), cA + kstep, voffA); PG8_STAGE(PG8_SB(1, 1), cB + hstep + kstep, voffB);
        PG8_WAIT_V(6); PG8_BAR;
    }
    for (;;) {
        const bool has_next = S.next(ui + 1, nxt);
        const char* nA = has_next ? (const char*)g.A + (size_t)nxt.pm * tstep : cA; const char* nB = has_next ? (const char*)g.Bt + (size_t)nxt.pn * tstep : cB;
        for (int t = 0; t < nt; t += 2) {
            const bool last = (t == nt - 2);
            const char* a1 = cA + (size_t)(t + 1) * kstep;
            const char* a2 = last ? nA : cA + (size_t)(t + 2) * kstep; const char* b2 = last ? nB : cB + (size_t)(t + 2) * kstep;
            const char* a3 = a2 + kstep; const char* b3 = b2 + kstep;
            if (last && has_next) S.a_ready(nxt);
            if constexpr (SP2) {
            PG8_LDB(B0, 0, 0); PG8_LDB(B1, 0, 1); PG8_SCHED; PG8_LDA(At, 0, 0); PG8_STAGE(PG8_SA(1, 1), a1 + hstep, voffA);
            PG8_WAIT_V(8); PG8_WAIT_L(0); PG8_BAR; PG8_MMA(0, 0, At, B0); PG8_MMA(0, 1, At, B1); PG8_BAR; PG8_SCHED;
            PG8_LDA(At, 0, 1); PG8_STAGE(PG8_SB(0, 0), b2, voffB); PG8_STAGE(PG8_SB(0, 1), b2 + hstep, voffB); PG8_STAGE(PG8_SA(0, 0), a2, voffA);
            PG8_WAIT_V(8); PG8_WAIT_L(0); PG8_BAR; PG8_MMA(1, 0, At, B0); PG8_MMA(1, 1, At, B1); PG8_BAR; PG8_SCHED;
            PG8_LDB(B0, 1, 0); PG8_LDB(B1, 1, 1); PG8_SCHED; PG8_LDA(At, 1, 0); PG8_STAGE(PG8_SA(0, 1), a2 + hstep, voffA);
            PG8_WAIT_V(8); PG8_WAIT_L(0); PG8_BAR; PG8_MMA(0, 0, At, B0); PG8_MMA(0, 1, At, B1); PG8_BAR; PG8_SCHED;
            PG8_LDA(At, 1, 1); PG8_STAGE(PG8_SB(1, 0), b3, voffB); PG8_STAGE(PG8_SB(1, 1), b3 + hstep, voffB); PG8_STAGE(PG8_SA(1, 0), a3, voffA);
            PG8_WAIT_V(8); PG8_WAIT_L(0); PG8_BAR; PG8_MMA(1, 0, At, B0); PG8_MMA(1, 1, At, B1); PG8_BAR; PG8_SCHED;
            } else {
            PG8_LDB(B0, 0, 0); PG8_SCHED; PG8_LDA(At, 0, 0); PG8_STAGE(PG8_SA(1, 1), a1 + hstep, voffA);
            PG8_WAIT_L(8); PG8_BAR; PG8_WAIT_L(0); PG8_MMA(0, 0, At, B0); PG8_BAR; PG8_SCHED;
            PG8_LDB(B1, 0, 1); PG8_STAGE(PG8_SB(0, 0), b2, voffB);
            PG8_BAR; PG8_WAIT_L(0); PG8_MMA(0, 1, At, B1); PG8_BAR;
            PG8_LDA(At, 0, 1); PG8_STAGE(PG8_SA(0, 0), a2, voffA);
            PG8_BAR; PG8_WAIT_L(0); PG8_MMA(1, 0, At, B0); PG8_BAR; PG8_SCHED;
            PG8_STAGE(PG8_SB(0, 1), b2 + hstep, voffB);
            PG8_WAIT_V(6); PG8_BAR; PG8_MMA(1, 1, At, B1); PG8_BAR;
            PG8_LDB(B0, 1, 0); PG8_SCHED; PG8_LDA(At, 1, 0); PG8_STAGE(PG8_SA(0, 1), a2 + hstep, voffA);
            PG8_WAIT_L(8); PG8_BAR; PG8_WAIT_L(0); PG8_MMA(0, 0, At, B0); PG8_BAR; PG8_SCHED;
            PG8_LDB(B1, 1, 1); PG8_STAGE(PG8_SB(1, 0), b3, voffB);
            PG8_BAR; PG8_WAIT_L(0); PG8_MMA(0, 1, At, B1); PG8_BAR;
            PG8_LDA(At, 1, 1); PG8_STAGE(PG8_SA(1, 0), a3, voffA);
            PG8_BAR; PG8_WAIT_L(0); PG8_MMA(1, 0, At, B0); PG8_BAR; PG8_SCHED;
            PG8_STAGE(PG8_SB(1, 1), b3 + hstep, voffB);
            PG8_WAIT_V(6); PG8_BAR; PG8_MMA(1, 1, At, B1); PG8_BAR;
            }
        }
        if constexpr (ALIGN_EPI) { if (wr == 0) PG8_BAR; }
        if constexpr (!Epi::AFTER_DRAIN) { E(acc, cur, wr, wc, fr, fq); S.done(cur); }
        if (!has_next) break;
#pragma unroll
        for (int a = 0; a < 2; ++a)
#pragma unroll
            for (int b = 0; b < 2; ++b)
#pragma unroll
                for (int m = 0; m < 4; ++m)
#pragma unroll
                    for (int n = 0; n < 2; ++n) acc[a][b][m][n] = (f32x4){0.f, 0.f, 0.f, 0.f};
        cur = nxt; cA = nA; cB = nB; ++ui;
        if constexpr (ALIGN_EPI) { if (wr == 1) PG8_BAR; }
    }
    PG8_WAIT_V(0);
    if constexpr (!ALIGN_EPI) { if (wr == 0) PG8_BAR; }
    PG8_BAR;
    if constexpr (Epi::AFTER_DRAIN) { E.fused(acc, cur, wr, wc, fr, fq, lds, wid, lane); S.done(cur); }
#undef PG8_SA
#undef PG8_SB
#undef PG8_STAGE
#undef PG8_LDA
#undef PG8_LDB
#undef PG8_MMA
#undef PG8_WAIT_V
#undef PG8_WAIT_L
#undef PG8_BAR
#undef PG8_SCHED
}
}
#define LAS __attribute__((address_space(3)))
typedef unsigned v4u __attribute__((ext_vector_type(4)));
typedef float f32x4 __attribute__((ext_vector_type(4)));
typedef short bf16x8 __attribute__((ext_vector_type(8)));
#define LDS_WAIT() asm volatile("s_waitcnt lgkmcnt(0)" ::: "memory")
constexpr int NWAVES = 8;
constexpr int LDS_BYTES = 147456;
constexpr int MISC_OFF = 147456 - 128;

struct Params { const float* in[26]; float* out; unsigned char* ws; int ph_lo, ph_hi, rep, pad; };

DEV float wave_sum(float v) {
#pragma unroll
  for (int o = 1; o < 64; o <<= 1) v += __shfl_xor(v, o);
  return v;
}

DEV int w1_dest_row(int n) {
  if (n < 1024) return n;
  if (n < 2560) return 2048 + (n - 1024);
  if (n < 2592) return 5632 + (n - 2560);
  if (n < 3104) return 3584 + (n - 2592);
  if (n < 3616) return 4096 + (n - 3104);
  if (n < 4640) return 4608 + (n - 3616);
  if (n < 5664) return 1024 + (n - 4640);
  return n;
}
DEV void transpose_item(const float* W, int K, int N, int k0, int n0, bf16_t* WT, int drow0, LAS float* scr, int lane) {
#pragma unroll 8
  for (int i = 0; i < 32; ++i) { const int kk = 2 * i + (lane >> 5); scr[kk * 33 + (lane & 31)] = W[(size_t)(k0 + kk) * N + n0 + (lane & 31)]; }
  LDS_WAIT(); asm volatile("" ::: "memory");
  const int c = lane & 7;
#pragma unroll
  for (int j = 0; j < 4; ++j) { const int n = (lane >> 3) + 8 * j; const LAS float* s = scr + (8 * c) * 33 + n;
    v4u o; o.x = pk2(s[0 * 33], s[1 * 33]); o.y = pk2(s[2 * 33], s[3 * 33]); o.z = pk2(s[4 * 33], s[5 * 33]); o.w = pk2(s[6 * 33], s[7 * 33]);
    *(v4u*)(WT + (size_t)(drow0 + n) * K + k0 + 8 * c) = o; }
  LDS_WAIT(); asm volatile("" ::: "memory");
}
DEV void prologue_phase(const Params& p, LAS unsigned char* lds) {
  const int tid = threadIdx.x, lane = tid & 63, wave = tid >> 6;
  unsigned char* ws = p.ws;
  float* MOD = (float*)(ws + WS_MOD);
  {
    LAS float* sc = (LAS float*)lds;
    LAS float* part = (LAS float*)(lds + 12288);
    for (int i = tid; i < 3072; i += 512) { const int v = i >> 10, k = i & 1023; const float cv = v < 2 ? p.in[1][v * 1024 + k] : p.in[3][k]; sc[i] = siluf(cv); }
    __syncthreads();
    for (int task = blockIdx.x; task < 96; task += gridDim.x) {
      const int l = task / 48, n0 = (task % 48) * 64; const float* w = l ? p.in[19] : p.in[5]; const float* bb = l ? p.in[20] : p.in[6];
      const int col = tid & 63, ks = tid >> 6;
      float a0 = 0.f, a1 = 0.f, a2 = 0.f;
#pragma unroll 8
      for (int k = ks * 128; k < ks * 128 + 128; ++k) { const float wv = w[(size_t)k * 3072 + n0 + col]; a0 += sc[k] * wv; a1 += sc[1024 + k] * wv; a2 += sc[2048 + k] * wv; }
      part[(ks * 3 + 0) * 64 + col] = a0; part[(ks * 3 + 1) * 64 + col] = a1; part[(ks * 3 + 2) * 64 + col] = a2;
      __syncthreads();
      if (tid < 192) { const int v = tid >> 6; float s = bb[n0 + col];
#pragma unroll
        for (int q = 0; q < 8; ++q) s += part[(q * 3 + v) * 64 + col];
        MOD[(l * 3 + v) * 3072 + n0 + col] = s; }
      __syncthreads();
    }
  }
  if (blockIdx.x == gridDim.x - 1) { float* rope = (float*)(ws + WS_ROPE);
    for (int idx = tid; idx < 4096; idx += 512) { const int pos = idx >> 5, f = idx & 31; const float inv = 1.0f / powf(10000.f, (float)f / 32.f); const float ang = (float)pos * inv; rope[idx] = cosf(ang); rope[4096 + idx] = sinf(ang); } }
  { v4u* z = (v4u*)(ws + WS_W1T + (size_t)E_IN * 1024 * 2); const v4u zero = {0u, 0u, 0u, 0u};
    for (int i = blockIdx.x * 512 + tid; i < (E_INP - E_IN) * 1024 * 2 / 16; i += gridDim.x * 512) z[i] = zero; }
  __syncthreads();
  {
    LAS float* scr = (LAS float*)(lds + wave * 16384);
    const int gw = blockIdx.x * NWAVES + wave, NGW = gridDim.x * NWAVES;
    constexpr int I1 = 16 * 178, I2 = 32 * 32, I3 = 16 * 160, I4 = 32 * 32;
    for (int it = gw; it < I1 + I2 + I3 + I4; it += NGW) {
      int r = it;
      if (r < I1) { const int kb = r / 178, nb = r % 178; transpose_item(p.in[7], 1024, E_IN, 64 * kb, 32 * nb, (bf16_t*)(ws + WS_W1T), w1_dest_row(32 * nb), scr, lane); continue; } r -= I1;
      if (r < I2) { const int kb = r / 32, nb = r % 32; transpose_item(p.in[17], 2048, 1024, 64 * kb, 32 * nb, (bf16_t*)(ws + WS_W2T), 32 * nb, scr, lane); continue; } r -= I2;
      if (r < I3) { const int kb = r / 160, nb = r % 160; transpose_item(p.in[21], 1024, O_IN, 64 * kb, 32 * nb, (bf16_t*)(ws + WS_W3T), 32 * nb, scr, lane); continue; } r -= I3;
      { const int kb = r / 32, nb = r % 32; transpose_item(p.in[25], 2048, 1024, 64 * kb, 32 * nb, (bf16_t*)(ws + WS_W4T), 32 * nb, scr, lane); }
    }
  }
}
DEV void prep_phase(const float* xlat, const float* xctx, const float* g, const float* mod, bf16_t* H) {
  const int lane = threadIdx.x & 63, wave = threadIdx.x >> 6;
  for (int row = blockIdx.x * NWAVES + wave; row < MA; row += gridDim.x * NWAVES) {
    const float* src = row < ML ? xlat + (size_t)row * D : xctx + (size_t)(row - ML) * D;
    const float* m = mod + row_vec(row) * 3072;
    f32x4 v[4]; float ss = 0.f;
#pragma unroll
    for (int j = 0; j < 4; ++j) { v[j] = *(const f32x4*)(src + 4 * lane + 256 * j); ss += (v[j].x * v[j].x + v[j].y * v[j].y) + (v[j].z * v[j].z + v[j].w * v[j].w); }
    const float rstd = rsqrtf(wave_sum(ss) * (1.f / D) + EPS);
#pragma unroll
    for (int j = 0; j < 4; ++j) { const int k = 4 * lane + 256 * j;
      const f32x4 gg = *(const f32x4*)(g + k), sc = *(const f32x4*)(m + 1024 + k), sh = *(const f32x4*)(m + k);
      const f32x4 o = v[j] * rstd * gg * (sc + 1.f) + sh;
      *(unsigned long long*)(H + (size_t)row * D + k) = (unsigned long long)pk2(o.x, o.y) | ((unsigned long long)pk2(o.z, o.w) << 32); }
  }
}
template <class F> DEV void small_gemm(const bf16_t* A, int lda, const bf16_t* Bt, int ldb, int K, int Mrows, int Ncols, F f) {
  const int lane = threadIdx.x & 63, wid = threadIdx.x >> 6, mt = wid >> 2, nt = wid & 3, r = lane & 15, q = lane >> 4;
  const int ntn = Ncols / 64, ntasks = (Mrows / 32) * ntn;
  for (int task = blockIdx.x; task < ntasks; task += gridDim.x) {
    const int row0 = (task / ntn) * 32 + mt * 16, col0 = (task % ntn) * 64 + nt * 16;
    const bf16_t* ap = A + (size_t)(row0 + r) * lda + 8 * q; const bf16_t* bp = Bt + (size_t)(col0 + r) * ldb + 8 * q;
    f32x4 acc = {0.f, 0.f, 0.f, 0.f};
#pragma unroll 8
    for (int k = 0; k < K; k += 32) { const bf16x8 a = *(const bf16x8*)(ap + k), b = *(const bf16x8*)(bp + k); acc = __builtin_amdgcn_mfma_f32_16x16x32_bf16(a, b, acc, 0, 0, 0); }
#pragma unroll
    for (int j = 0; j < 4; ++j) f(row0 + q * 4 + j, col0 + r, acc[j]);
  }
}

DEV void qknorm_phase(bf16_t* Q1, bf16_t* K1, const float* qn, const float* kn, const float* rope, bool wr) {
  const int lane = threadIdx.x & 63, wave = threadIdx.x >> 6, hl = lane >> 4, d0 = (lane & 15) * 8;
  const float scale = 0.08838834764831845f;
  float gq[8], gk[8];
#pragma unroll
  for (int e = 0; e < 8; ++e) { gq[e] = qn[d0 + e] * scale; gk[e] = kn[d0 + e]; }
  const int ax = d0 >> 6, sgn = (d0 >> 5) & 1, f0 = d0 & 31;
  for (int row = blockIdx.x * NWAVES + wave; row < MA; row += gridDim.x * NWAVES) {
    const bool lat = row < ML;
    v4u raw[5];
    raw[0] = *(const v4u*)(K1 + (size_t)row * 512 + hl * 128 + d0);
    if (lat) {
#pragma unroll
      for (int g = 0; g < 4; ++g) raw[1 + g] = *(const v4u*)(Q1 + (size_t)row * 2048 + (g * 4 + hl) * 128 + d0);
    }
    float cs[8], sn[8];
    if (lat) { const int t = row % SEQ, pos = ax ? (t & 63) : (t >> 6);
      const f32x4 c0 = *(const f32x4*)(rope + pos * 32 + f0), c1 = *(const f32x4*)(rope + pos * 32 + f0 + 4), s0 = *(const f32x4*)(rope + 4096 + pos * 32 + f0), s1 = *(const f32x4*)(rope + 4096 + pos * 32 + f0 + 4);
      cs[0] = c0.x; cs[1] = c0.y; cs[2] = c0.z; cs[3] = c0.w; cs[4] = c1.x; cs[5] = c1.y; cs[6] = c1.z; cs[7] = c1.w;
      sn[0] = s0.x; sn[1] = s0.y; sn[2] = s0.z; sn[3] = s0.w; sn[4] = s1.x; sn[5] = s1.y; sn[6] = s1.z; sn[7] = s1.w; }
    const int ng = lat ? 5 : 1;
#pragma unroll
    for (int g = 0; g < 5; ++g) {
      if (g < ng) {
        const v4u rv = raw[g];
        float v[8] = {__uint_as_float(rv.x << 16), __uint_as_float(rv.x & 0xffff0000u), __uint_as_float(rv.y << 16), __uint_as_float(rv.y & 0xffff0000u), __uint_as_float(rv.z << 16), __uint_as_float(rv.z & 0xffff0000u), __uint_as_float(rv.w << 16), __uint_as_float(rv.w & 0xffff0000u)};
        float ss = 0.f;
#pragma unroll
        for (int e = 0; e < 8; ++e) ss += v[e] * v[e];
        ss += __shfl_xor(ss, 1); ss += __shfl_xor(ss, 2); ss += __shfl_xor(ss, 4); ss += __shfl_xor(ss, 8);
        const float rstd = rsqrtf(ss * (1.f / 128.f) + EPS);
#pragma unroll
        for (int e = 0; e < 8; ++e) v[e] *= rstd * (g == 0 ? gk[e] : gq[e]);
        if (lat) {
#pragma unroll
          for (int e = 0; e < 8; ++e) { const float o = __shfl_xor(v[e], 4); v[e] = sgn ? (v[e] * cs[e] + o * sn[e]) : (v[e] * cs[e] - o * sn[e]); }
        }
        v4u ov; ov.x = pk2(v[0], v[1]); ov.y = pk2(v[2], v[3]); ov.z = pk2(v[4], v[5]); ov.w = pk2(v[6], v[7]);
        if (wr) { if (g == 0) *(v4u*)(K1 + (size_t)row * 512 + hl * 128 + d0) = ov; else *(v4u*)(Q1 + (size_t)row * 2048 + ((g - 1) * 4 + hl) * 128 + d0) = ov; }
      }
    }
  }
}
typedef short s16x4 __attribute__((ext_vector_type(4)));
DEV s16x4 tr_read(const LAS bf16_t* p) { return __builtin_bit_cast(s16x4, __builtin_amdgcn_ds_read_tr16_b64_v4i16((LAS s16x4*)p)); }
DEV void attn_phase(bf16_t* Q1, const bf16_t* K1, const bf16_t* V1, const bf16_t* G1, const float* sink, const float* qn, const float* kn, LAS unsigned char* lds, bool wr) {
  constexpr int KP = 136, VP = 144;
  LAS bf16_t* Ks = (LAS bf16_t*)lds;
  LAS bf16_t* Vs = (LAS bf16_t*)(lds + 2 * 64 * KP * 2);
  LAS float* dsc = (LAS float*)(lds + 2 * 64 * KP * 2 + 2 * 64 * VP * 2);
  const int tid = threadIdx.x, lane = tid & 63, wid = tid >> 6, r = lane & 15, Qd = lane >> 4;
  float mb;
  { float a = fmaxf(fabsf(qn[lane]), fabsf(qn[64 + lane])), b = fmaxf(fabsf(kn[lane]), fabsf(kn[64 + lane]));
#pragma unroll
    for (int o = 1; o < 64; o <<= 1) { a = fmaxf(a, __shfl_xor(a, o)); b = fmaxf(b, __shfl_xor(b, o)); }
    mb = a * b * 11.313708498984761f; }
  for (int task = blockIdx.x; task < 1024; task += gridDim.x) {
    const int b = task >> 9, kvh = (task >> 7) & 3, qt = task & 127;
    const int hq = kvh * 4 + (wid >> 1), qoff = (wid & 1) * 32;
    const size_t qrow0 = (size_t)b * SEQ + qt * 64 + qoff;
    bf16x8 qf[2][4];
#pragma unroll
    for (int m = 0; m < 2; ++m)
#pragma unroll
      for (int ks = 0; ks < 4; ++ks) qf[m][ks] = *(const bf16x8*)(Q1 + (qrow0 + 16 * m + r) * 2048 + hq * 128 + ks * 32 + 8 * Qd);
    const int tlo = (2 - qt) > 0 ? (2 - qt) : 0, thi = (129 - qt) < 4 ? (129 - qt) : 4, nband = thi - tlo + 1, ntile = nband + 4;
    const int skey = tid >> 4, sch = tid & 15;
    v4u kreg[2], vreg[2];
#define TILE_ROW0(i) ((i) < nband ? (size_t)b * SEQ + (size_t)(qt - 2 + tlo + (i)) * 64 : (size_t)ML + b * CTXL + ((i) - nband) * 64)
#define LOAD_TILE(i) do { const size_t r0_ = TILE_ROW0(i); _Pragma("unroll") for (int h_ = 0; h_ < 2; ++h_) { const size_t go_ = (r0_ + skey + 32 * h_) * 512 + kvh * 128 + sch * 8; kreg[h_] = *(const v4u*)(K1 + go_); vreg[h_] = *(const v4u*)(V1 + go_); } } while (0)
#define STORE_TILE(buf) do { _Pragma("unroll") for (int h_ = 0; h_ < 2; ++h_) { *(LAS v4u*)(Ks + (buf) * 64 * KP + (skey + 32 * h_) * KP + sch * 8) = kreg[h_]; *(LAS v4u*)(Vs + (buf) * 64 * VP + (skey + 32 * h_) * VP + sch * 8) = vreg[h_]; } } while (0)
    LOAD_TILE(0);
    __syncthreads();
    STORE_TILE(0);
    __syncthreads();
    f32x4 o[2][8];
#pragma unroll
    for (int m = 0; m < 2; ++m)
#pragma unroll
      for (int n = 0; n < 8; ++n) o[m][n] = (f32x4){0.f, 0.f, 0.f, 0.f};
    float lsum[2] = {0.f, 0.f};
    for (int i = 0; i < ntile; ++i) {
      const int buf = i & 1;
      if (i + 1 < ntile) LOAD_TILE(i + 1);
      const int mtype = (i < nband) ? ((tlo + i) == 0 ? 1 : ((tlo + i) == 4 ? 2 : 0)) : 0;
      const LAS bf16_t* Kb = Ks + buf * 64 * KP; const LAS bf16_t* Vb = Vs + buf * 64 * VP;
      f32x4 s[4][2];
#pragma unroll
      for (int t = 0; t < 4; ++t) { s[t][0] = (f32x4){0.f, 0.f, 0.f, 0.f}; s[t][1] = (f32x4){0.f, 0.f, 0.f, 0.f}; }
#pragma unroll
      for (int ks = 0; ks < 4; ++ks)
#pragma unroll
        for (int t = 0; t < 4; ++t) { const bf16x8 kf = *(const LAS bf16x8*)(Kb + (16 * t + r) * KP + ks * 32 + 8 * Qd);
          s[t][0] = __builtin_amdgcn_mfma_f32_16x16x32_bf16(kf, qf[0][ks], s[t][0], 0, 0, 0);
          s[t][1] = __builtin_amdgcn_mfma_f32_16x16x32_bf16(kf, qf[1][ks], s[t][1], 0, 0, 0); }
      bf16x8 pa[2][2];
#pragma unroll
      for (int m = 0; m < 2; ++m) { const int qi = qoff + 16 * m + r;
#pragma unroll
        for (int t = 0; t < 4; ++t) {
          float pv[4];
#pragma unroll
          for (int j = 0; j < 4; ++j) { const int kj = 16 * t + 4 * Qd + j; float pj = __expf(s[t][m][j] - mb);
            if (mtype == 1) pj = (kj >= qi) ? pj : 0.f; else if (mtype == 2) pj = (kj <= qi) ? pj : 0.f;
            pv[j] = pj; lsum[m] += pj; }
          const unsigned w0 = pk2(pv[0], pv[1]), w1 = pk2(pv[2], pv[3]);
          pa[m][t >> 1][(t & 1) * 4 + 0] = (short)(w0 & 0xffff); pa[m][t >> 1][(t & 1) * 4 + 1] = (short)(w0 >> 16);
          pa[m][t >> 1][(t & 1) * 4 + 2] = (short)(w1 & 0xffff); pa[m][t >> 1][(t & 1) * 4 + 3] = (short)(w1 >> 16); } }
#pragma unroll
      for (int k2 = 0; k2 < 2; ++k2)
#pragma unroll
        for (int n = 0; n < 8; ++n) {
          const s16x4 lo = tr_read(Vb + (32 * k2 + 4 * Qd + (r >> 2)) * VP + 16 * n + 4 * (r & 3));
          const s16x4 hi = tr_read(Vb + (32 * k2 + 16 + 4 * Qd + (r >> 2)) * VP + 16 * n + 4 * (r & 3));
          const bf16x8 vf = (bf16x8){lo[0], lo[1], lo[2], lo[3], hi[0], hi[1], hi[2], hi[3]};
          o[0][n] = __builtin_amdgcn_mfma_f32_16x16x32_bf16(pa[0][k2], vf, o[0][n], 0, 0, 0);
          o[1][n] = __builtin_amdgcn_mfma_f32_16x16x32_bf16(pa[1][k2], vf, o[1][n], 0, 0, 0); }
      if (i + 1 < ntile) STORE_TILE(buf ^ 1);
      __syncthreads();
    }
#undef TILE_ROW0
#undef LOAD_TILE
#undef STORE_TILE
    const float sk = __expf(sink[hq] - mb);
#pragma unroll
    for (int m = 0; m < 2; ++m) { float l = lsum[m]; l += __shfl_xor(l, 16); l += __shfl_xor(l, 32); if (Qd == 0) dsc[wid * 32 + 16 * m + r] = 1.f / (l + sk); }
    LDS_WAIT(); asm volatile("" ::: "memory");
#pragma unroll
    for (int m = 0; m < 2; ++m)
#pragma unroll
      for (int j = 0; j < 4; ++j) { const float inv = dsc[wid * 32 + 16 * m + 4 * Qd + j]; const size_t ro = (qrow0 + 16 * m + 4 * Qd + j) * 2048 + hq * 128 + r;
#pragma unroll
        for (int n = 0; n < 8; ++n) { const bf16_t ov_ = f2bf(o[m][n][j] * inv * bf2f(G1[ro + 16 * n])); if (wr) Q1[ro + 16 * n] = ov_; } }
    LDS_WAIT(); asm volatile("" ::: "memory");
  }
}

constexpr size_t DO_SDT = 50 * MiB, DO_SCS = 53 * MiB;
constexpr size_t WS_SSQ = 237 * MiB;
DEV unsigned short bfbits(float f) { return f2bf(f); }
DEV void ssd_prep_phase(const bf16_t* XBC, const float* cw, const float* cb, bf16_t* XC, const float* DTLR, const float* dt_bias, const float* a_log, float* SDT, float* SCS, float* SDEC) {
  const int gtid = blockIdx.x * 512 + threadIdx.x, gth = gridDim.x * 512;
  for (int it = gtid; it < MA * 192; it += gth) {
    const int row = it / 192, c8 = (it % 192) * 8;
    int t, len;
    if (row < ML) { t = row % SEQ; len = SEQ; } else { t = (row - ML) % CTXL; len = CTXL; }
    float acc[8];
    { const f32x4 b0 = *(const f32x4*)(cb + c8), b1 = *(const f32x4*)(cb + c8 + 4); acc[0] = b0.x; acc[1] = b0.y; acc[2] = b0.z; acc[3] = b0.w; acc[4] = b1.x; acc[5] = b1.y; acc[6] = b1.z; acc[7] = b1.w; }
#pragma unroll
    for (int k = 0; k < 5; ++k) { const int tt = t + k - 2;
      if (tt >= 0 && tt < len) { const v4u xv = *(const v4u*)(XBC + (size_t)(row + k - 2) * 1536 + c8); const f32x4 w0 = *(const f32x4*)(cw + k * 1536 + c8), w1 = *(const f32x4*)(cw + k * 1536 + c8 + 4);
        acc[0] += w0.x * __uint_as_float(xv.x << 16); acc[1] += w0.y * __uint_as_float(xv.x & 0xffff0000u); acc[2] += w0.z * __uint_as_float(xv.y << 16); acc[3] += w0.w * __uint_as_float(xv.y & 0xffff0000u);
        acc[4] += w1.x * __uint_as_float(xv.z << 16); acc[5] += w1.y * __uint_as_float(xv.z & 0xffff0000u); acc[6] += w1.z * __uint_as_float(xv.w << 16); acc[7] += w1.w * __uint_as_float(xv.w & 0xffff0000u); } }
    v4u o; o.x = pk2(silu_fast(acc[0]), silu_fast(acc[1])); o.y = pk2(silu_fast(acc[2]), silu_fast(acc[3])); o.z = pk2(silu_fast(acc[4]), silu_fast(acc[5])); o.w = pk2(silu_fast(acc[6]), silu_fast(acc[7]));
    *(v4u*)(XC + (size_t)row * 1536 + c8) = o;
  }
  {
    const int lane = threadIdx.x & 63, wave = threadIdx.x >> 6, cl = lane & 7, seg = lane >> 3;
    for (int wt = blockIdx.x * NWAVES + wave; wt < NCH * 4; wt += gridDim.x * NWAVES) {
      const int gc = wt >> 2, col = (wt & 3) * 8 + cl, dir = col >> 4, h = col & 15;
      const float a = -__expf(a_log[col]), bias = dt_bias[col];
      float dtv[16], v[16]; float run = 0.f;
#pragma unroll
      for (int u = 0; u < 16; ++u) { const int s = seg * 16 + u, t = dir ? 127 - s : s; dtv[u] = softplusf(DTLR[((size_t)gc * 128 + t) * 64 + col] + bias); }
#pragma unroll
      for (int u = 0; u < 16; ++u) { run += dtv[u] * a; v[u] = run; }
      float off = 0.f;
#pragma unroll
      for (int sgi = 0; sgi < 7; ++sgi) { const float tot = __shfl(run, cl + 8 * sgi); off += (sgi < seg) ? tot : 0.f; }
#pragma unroll
      for (int u = 0; u < 16; ++u) { const int s = seg * 16 + u, t = dir ? 127 - s : s; const size_t row = (size_t)gc * 128 + t; SDT[row * 32 + col] = dtv[u]; SCS[row * 32 + col] = v[u] + off; }
      if (seg == 7) SDEC[(gc * 16 + h) * 2 + dir] = __expf(run + off);
    }
  }
}
DEV void ssd_u_phase(const bf16_t* XC, const float* SDT, const float* SCS, bf16_t* ST, LAS unsigned char* lds) {
  constexpr int XP = 272, BP = 144;
  LAS bf16_t* Xs = (LAS bf16_t*)lds; LAS bf16_t* Bs = (LAS bf16_t*)(lds + 128 * XP * 2); LAS float* wtab = (LAS float*)(lds + 128 * XP * 2 + 128 * BP * 2);
  const int tid = threadIdx.x, lane = tid & 63, wid = tid >> 6, r = lane & 15, Qd = lane >> 4, hl = wid >> 1, dir = wid & 1;
  for (int task = blockIdx.x; task < NCH * 4; task += gridDim.x) {
    const int gc = task >> 2, g = (task >> 1) & 1, hh = task & 1; const size_t r0 = (size_t)gc * 128; const int h0 = g * 8 + hh * 4;
    __syncthreads();
#pragma unroll
    for (int i = 0; i < 8; ++i) { const int cid = tid + 512 * i, row = cid >> 5, ch = cid & 31; *(LAS v4u*)(Xs + row * XP + ch * 8) = *(const v4u*)(XC + (r0 + row) * 1536 + h0 * 64 + ch * 8); }
#pragma unroll
    for (int i = 0; i < 4; ++i) { const int cid = tid + 512 * i, row = cid >> 4, ch = cid & 15; *(LAS v4u*)(Bs + row * BP + ch * 8) = *(const v4u*)(XC + (r0 + row) * 1536 + 1024 + g * 128 + ch * 8); }
#pragma unroll
    for (int i = 0; i < 2; ++i) { const int e = tid + 512 * i, combo = e >> 7, t = e & 127, col = (combo & 1) * 16 + h0 + (combo >> 1);
      const float cs_end = SCS[(r0 + ((combo & 1) ? 0 : 127)) * 32 + col]; wtab[e] = __expf(cs_end - SCS[(r0 + t) * 32 + col]) * SDT[(r0 + t) * 32 + col]; }
    __syncthreads();
    const LAS float* wt = wtab + wid * 128;
    bf16_t* Sp = ST + ((((size_t)gc * 16 + h0 + hl) * 2 + dir) * 64) * 128;
#pragma unroll 1
    for (int pp = 0; pp < 2; ++pp) {
      f32x4 acc[8][2];
#pragma unroll
      for (int nt = 0; nt < 8; ++nt) { acc[nt][0] = (f32x4){0.f, 0.f, 0.f, 0.f}; acc[nt][1] = (f32x4){0.f, 0.f, 0.f, 0.f}; }
#pragma unroll 1
      for (int k = 0; k < 4; ++k) {
        const f32x4 wlo = *(const LAS f32x4*)(wt + 32 * k + 4 * Qd), whi = *(const LAS f32x4*)(wt + 32 * k + 16 + 4 * Qd);
        bf16x8 xf[2];
#pragma unroll
        for (int pt = 0; pt < 2; ++pt) {
          const s16x4 lo = tr_read(Xs + (32 * k + 4 * Qd + (r >> 2)) * XP + hl * 64 + 32 * pp + 16 * pt + 4 * (r & 3));
          const s16x4 hi = tr_read(Xs + (32 * k + 16 + 4 * Qd + (r >> 2)) * XP + hl * 64 + 32 * pp + 16 * pt + 4 * (r & 3));
          const unsigned w0 = pk2(bf2f((bf16_t)lo[0]) * wlo[0], bf2f((bf16_t)lo[1]) * wlo[1]), w1 = pk2(bf2f((bf16_t)lo[2]) * wlo[2], bf2f((bf16_t)lo[3]) * wlo[3]);
          const unsigned w2 = pk2(bf2f((bf16_t)hi[0]) * whi[0], bf2f((bf16_t)hi[1]) * whi[1]), w3 = pk2(bf2f((bf16_t)hi[2]) * whi[2], bf2f((bf16_t)hi[3]) * whi[3]);
          xf[pt] = (bf16x8){(short)(w0 & 0xffff), (short)(w0 >> 16), (short)(w1 & 0xffff), (short)(w1 >> 16), (short)(w2 & 0xffff), (short)(w2 >> 16), (short)(w3 & 0xffff), (short)(w3 >> 16)};
        }
#pragma unroll
        for (int nt = 0; nt < 8; ++nt) {
          const s16x4 lo = tr_read(Bs + (32 * k + 4 * Qd + (r >> 2)) * BP + 16 * nt + 4 * (r & 3));
          const s16x4 hi = tr_read(Bs + (32 * k + 16 + 4 * Qd + (r >> 2)) * BP + 16 * nt + 4 * (r & 3));
          const bf16x8 bfr = (bf16x8){lo[0], lo[1], lo[2], lo[3], hi[0], hi[1], hi[2], hi[3]};
          acc[nt][0] = __builtin_amdgcn_mfma_f32_16x16x32_bf16(bfr, xf[0], acc[nt][0], 0, 0, 0);
          acc[nt][1] = __builtin_amdgcn_mfma_f32_16x16x32_bf16(bfr, xf[1], acc[nt][1], 0, 0, 0);
        }
      }
#pragma unroll
      for (int nt = 0; nt < 8; ++nt)
#pragma unroll
        for (int pt = 0; pt < 2; ++pt) { const f32x4 v = acc[nt][pt];
          *(unsigned long long*)(Sp + (size_t)(32 * pp + 16 * pt + r) * 128 + 16 * nt + 4 * Qd) = (unsigned long long)pk2(v[0], v[1]) | ((unsigned long long)pk2(v[2], v[3]) << 32); }
    }
  }
}
DEV void ssd_scan_phase(bf16_t* ST, const float* SDEC, bool wr) {
  for (int item = blockIdx.x * 512 + threadIdx.x; item < 2 * 16 * 2 * 2048; item += gridDim.x * 512) {
    const int e4 = item & 2047, dir = (item >> 11) & 1, h = (item >> 12) & 15, b = item >> 16;
    float S0 = 0.f, S1 = 0.f, S2 = 0.f, S3 = 0.f;
#define SCAN_GC(s) (!dir ? ((s) < 2 ? 128 + 2 * b + (s) : b * 64 + ((s) - 2)) : ((s) < 2 ? 128 + 2 * b + (1 - (s)) : b * 64 + (65 - (s))))
    for (int s0 = 0; s0 < 66; s0 += 6) {
      unsigned long long u[6]; float dec[6];
#pragma unroll
      for (int q = 0; q < 6; ++q) { const int gc = SCAN_GC(s0 + q); u[q] = *(const unsigned long long*)(ST + (((size_t)gc * 16 + h) * 2 + dir) * 8192 + e4 * 4); dec[q] = SDEC[(gc * 16 + h) * 2 + dir]; }
#pragma unroll
      for (int q = 0; q < 6; ++q) { const int gc = SCAN_GC(s0 + q);
        if (wr) *(unsigned long long*)(ST + (((size_t)gc * 16 + h) * 2 + dir) * 8192 + e4 * 4) = (unsigned long long)pk2(S0, S1) | ((unsigned long long)pk2(S2, S3) << 32);
        const unsigned lo = (unsigned)u[q], hi = (unsigned)(u[q] >> 32);
        S0 = dec[q] * S0 + __uint_as_float(lo << 16); S1 = dec[q] * S1 + __uint_as_float(lo & 0xffff0000u); S2 = dec[q] * S2 + __uint_as_float(hi << 16); S3 = dec[q] * S3 + __uint_as_float(hi & 0xffff0000u); }
    }
#undef SCAN_GC
  }
}
DEV bf16x8 scale_frag(bf16x8 f, float s) {
  bf16x8 o;
#pragma unroll
  for (int e = 0; e < 8; e += 2) { const unsigned w = pk2(bf2f((bf16_t)f[e]) * s, bf2f((bf16_t)f[e + 1]) * s); o[e] = (short)(w & 0xffff); o[e + 1] = (short)(w >> 16); }
  return o;
}
DEV void ssd_y_phase(const bf16_t* XC, const float* SDT, const float* SCS, const bf16_t* ST, const float* d_skip, bf16_t* Y0, float* SSQ, LAS unsigned char* lds, bool wr) {
  constexpr int XP = 272, BP = 136;
  LAS bf16_t* Xs = (LAS bf16_t*)lds; LAS bf16_t* Bs = (LAS bf16_t*)(lds + 128 * XP * 2);
  LAS float* tab = (LAS float*)(lds + 128 * XP * 2 + 128 * BP * 2);
  LAS float* ssq = tab + 4 * 4 * 128;
  const int tid = threadIdx.x, lane = tid & 63, wid = tid >> 6, r = lane & 15, Qd = lane >> 4, hl = wid >> 1, ih = wid & 1;
  for (int task = blockIdx.x; task < NCH * 4; task += gridDim.x) {
    const int gc = task >> 2, g = (task >> 1) & 1, hh = task & 1; const size_t r0 = (size_t)gc * 128; const int h0 = g * 8 + hh * 4, h = h0 + hl;
    __syncthreads();
#pragma unroll
    for (int i = 0; i < 8; ++i) { const int cid = tid + 512 * i, row = cid >> 5, ch = cid & 31; *(LAS v4u*)(Xs + row * XP + ch * 8) = *(const v4u*)(XC + (r0 + row) * 1536 + h0 * 64 + ch * 8); }
#pragma unroll
    for (int i = 0; i < 4; ++i) { const int cid = tid + 512 * i, row = cid >> 4, ch = cid & 15; *(LAS v4u*)(Bs + row * BP + ch * 8) = *(const v4u*)(XC + (r0 + row) * 1536 + 1024 + g * 128 + ch * 8); }
#pragma unroll
    for (int i = 0; i < 4; ++i) { const int e = tid + 512 * i, hq = e >> 9, which = (e >> 7) & 3, t = e & 127; const int col = (which & 1) * 16 + h0 + hq;
      tab[e] = (which < 2 ? SCS : SDT)[(r0 + t) * 32 + col]; }
    __syncthreads();
    const LAS float* csf = tab + hl * 512; const LAS float* csb = csf + 128; const LAS float* dtf = csf + 256; const LAS float* dtb = csf + 384;
    const float dsk = d_skip[h];
#pragma unroll 1
    for (int m = 0; m < 4; ++m) {
      const int i = 64 * ih + 16 * m + r;
      bf16x8 cf[4];
#pragma unroll
      for (int ks = 0; ks < 4; ++ks) cf[ks] = *(const bf16x8*)(XC + (r0 + i) * 1536 + 1280 + g * 128 + 32 * ks + 8 * Qd);
      f32x4 y[4];
#pragma unroll
      for (int pt = 0; pt < 4; ++pt) y[pt] = (f32x4){0.f, 0.f, 0.f, 0.f};
      const float cfi = csf[i], cbi = csb[i];
#pragma unroll 1
      for (int dir = 0; dir < 2; ++dir) {
        const float sc = __expf(dir ? cbi : cfi);
        const bf16_t* Sp = ST + ((((size_t)gc * 16 + h) * 2 + dir) * 64) * 128;
#pragma unroll
        for (int ks = 0; ks < 4; ++ks) {
          const bf16x8 a = scale_frag(cf[ks], sc);
#pragma unroll
          for (int pt = 0; pt < 4; ++pt) { const bf16x8 sf = *(const bf16x8*)(Sp + (size_t)(16 * pt + r) * 128 + 32 * ks + 8 * Qd); y[pt] = __builtin_amdgcn_mfma_f32_16x16x32_bf16(a, sf, y[pt], 0, 0, 0); }
        }
      }
#pragma unroll 1
      for (int k2 = 0; k2 < 4; ++k2) {
        bf16x8 pa;
#pragma unroll
        for (int tt = 0; tt < 2; ++tt) {
          f32x4 c = {0.f, 0.f, 0.f, 0.f};
#pragma unroll
          for (int ks = 0; ks < 4; ++ks) { const bf16x8 bfr = *(const LAS bf16x8*)(Bs + (32 * k2 + 16 * tt + r) * BP + 32 * ks + 8 * Qd); c = __builtin_amdgcn_mfma_f32_16x16x32_bf16(bfr, cf[ks], c, 0, 0, 0); }
          const int j0 = 32 * k2 + 16 * tt + 4 * Qd;
          const f32x4 jf = *(const LAS f32x4*)(csf + j0), jb = *(const LAS f32x4*)(csb + j0), jdf = *(const LAS f32x4*)(dtf + j0), jdb = *(const LAS f32x4*)(dtb + j0);
          float pv[4];
#pragma unroll
          for (int jj = 0; jj < 4; ++jj) { const int j = j0 + jj;
            const float Lf = __expf(j <= i ? cfi - jf[jj] : -INFINITY) * jdf[jj];
            const float Lb = __expf(j >= i ? cbi - jb[jj] : -INFINITY) * jdb[jj];
            pv[jj] = c[jj] * (Lf + Lb) + (j == i ? dsk : 0.f); }
          const unsigned w0 = pk2(pv[0], pv[1]), w1 = pk2(pv[2], pv[3]);
          pa[tt * 4 + 0] = (short)(w0 & 0xffff); pa[tt * 4 + 1] = (short)(w0 >> 16); pa[tt * 4 + 2] = (short)(w1 & 0xffff); pa[tt * 4 + 3] = (short)(w1 >> 16);
        }
#pragma unroll
        for (int pt = 0; pt < 4; ++pt) {
          const s16x4 lo = tr_read(Xs + (32 * k2 + 4 * Qd + (r >> 2)) * XP + hl * 64 + 16 * pt + 4 * (r & 3));
          const s16x4 hi = tr_read(Xs + (32 * k2 + 16 + 4 * Qd + (r >> 2)) * XP + hl * 64 + 16 * pt + 4 * (r & 3));
          const bf16x8 xf = (bf16x8){lo[0], lo[1], lo[2], lo[3], hi[0], hi[1], hi[2], hi[3]};
          y[pt] = __builtin_amdgcn_mfma_f32_16x16x32_bf16(pa, xf, y[pt], 0, 0, 0);
        }
      }
#pragma unroll
      for (int jj = 0; jj < 4; ++jj) { const int il = 64 * ih + 16 * m + 4 * Qd + jj; const size_t yo = (r0 + il) * 2048 + h * 64 + r; float ss = 0.f;
#pragma unroll
        for (int pt = 0; pt < 4; ++pt) { const float v = y[pt][jj] * bf2f(Y0[yo + 16 * pt]); ss += v * v; if (wr) Y0[yo + 16 * pt] = f2bf(v); }
        ss += __shfl_xor(ss, 1); ss += __shfl_xor(ss, 2); ss += __shfl_xor(ss, 4); ss += __shfl_xor(ss, 8);
        if (r == 0) ssq[hl * 128 + il] = ss; }
    }
    __syncthreads();
    if (tid < 128) SSQ[((r0 + tid) * 2 + g) * 2 + hh] = (ssq[tid] + ssq[128 + tid]) + (ssq[256 + tid] + ssq[384 + tid]);
  }
}

constexpr size_t WS_GCSC = 237 * MiB + 4 * MiB;
DEV const float* gcs_row(const float* lat, const float* ctx, size_t row) { return row < (size_t)ML ? lat + row * 1024 : ctx + (row - ML) * 1024; }
DEV float* gcs_row_w(float* lat, float* ctx, size_t row) { return row < (size_t)ML ? lat + row * 1024 : ctx + (row - ML) * 1024; }
DEV float logsig_fast(float x) { return fminf(x, 0.f) - __logf(1.f + __expf(-fabsf(x))); }
DEV void gla_cs_phase(const float* DTLR, const float* gw, const float* gb, float* GCSL, float* GCSC, float* GDEC) {
  const int lane = threadIdx.x & 63, wave = threadIdx.x >> 6, kl = lane & 7, seg = lane >> 3;
  for (int wt = blockIdx.x * NWAVES + wave; wt < NCH * 2 * 64; wt += gridDim.x * NWAVES) {
    const int gc = wt >> 7, dir = (wt >> 6) & 1, k = (wt & 63) * 8 + kl;
    float wv[16];
#pragma unroll
    for (int q = 0; q < 16; ++q) wv[q] = gw[(dir * 16 + q) * 512 + k];
    const float bias = gb[dir * 512 + k];
    float v[16]; float run = 0.f;
#pragma unroll
    for (int u = 0; u < 16; ++u) { const int s = seg * 16 + u, t = dir ? 127 - s : s; const float* lr = DTLR + ((size_t)gc * 128 + t) * 64 + 32 + dir * 16;
      const f32x4 l0 = *(const f32x4*)lr, l1 = *(const f32x4*)(lr + 4), l2 = *(const f32x4*)(lr + 8), l3 = *(const f32x4*)(lr + 12);
      float lg = bias + l0.x * wv[0] + l0.y * wv[1] + l0.z * wv[2] + l0.w * wv[3] + l1.x * wv[4] + l1.y * wv[5] + l1.z * wv[6] + l1.w * wv[7]
                 + l2.x * wv[8] + l2.y * wv[9] + l2.z * wv[10] + l2.w * wv[11] + l3.x * wv[12] + l3.y * wv[13] + l3.z * wv[14] + l3.w * wv[15];
      run += logsig_fast(lg) * (1.f / 16.f); v[u] = run; }
    float off = 0.f;
#pragma unroll
    for (int sgi = 0; sgi < 7; ++sgi) { const float tot = __shfl(run, kl + 8 * sgi); off += (sgi < seg) ? tot : 0.f; }
#pragma unroll
    for (int u = 0; u < 16; ++u) { const int s = seg * 16 + u, t = dir ? 127 - s : s; gcs_row_w(GCSL, GCSC, (size_t)gc * 128 + t)[dir * 512 + k] = v[u] + off; }
    if (seg == 7) GDEC[((gc * 4 + (k >> 7)) * 2 + dir) * 128 + (k & 127)] = __expf(run + off);
  }
}
DEV void gla_u_phase(const bf16_t* K0, const bf16_t* V0, const float* GCSL, const float* GCSC, bf16_t* ST, LAS unsigned char* lds) {
  constexpr int VP = 272, KP = 144;
  LAS bf16_t* Vs = (LAS bf16_t*)lds; LAS bf16_t* Kd = (LAS bf16_t*)(lds + 128 * VP * 2);
  const int tid = threadIdx.x, lane = tid & 63, wid = tid >> 6, r = lane & 15, Qd = lane >> 4;
  for (int task = blockIdx.x; task < NCH * 4; task += gridDim.x) {
    const int gc = task >> 2, h = task & 3; const size_t r0 = (size_t)gc * 128;
    __syncthreads();
#pragma unroll
    for (int i = 0; i < 8; ++i) { const int cid = tid + 512 * i, row = cid >> 5, ch = cid & 31; *(LAS v4u*)(Vs + row * VP + ch * 8) = *(const v4u*)(V0 + (r0 + row) * 1024 + h * 256 + ch * 8); }
#pragma unroll
    for (int i = 0; i < 4; ++i) { const int cid = tid + 512 * i, t = cid >> 4, ch = cid & 15;
      const v4u kv = *(const v4u*)(K0 + (r0 + t) * 512 + h * 128 + ch * 8);
      const float kf[8] = {__uint_as_float(kv.x << 16), __uint_as_float(kv.x & 0xffff0000u), __uint_as_float(kv.y << 16), __uint_as_float(kv.y & 0xffff0000u), __uint_as_float(kv.z << 16), __uint_as_float(kv.z & 0xffff0000u), __uint_as_float(kv.w << 16), __uint_as_float(kv.w & 0xffff0000u)};
#pragma unroll
      for (int dir = 0; dir < 2; ++dir) {
        const float* ce = gcs_row(GCSL, GCSC, r0 + (dir ? 0 : 127)) + dir * 512 + h * 128 + ch * 8; const float* ct = gcs_row(GCSL, GCSC, r0 + t) + dir * 512 + h * 128 + ch * 8;
        const f32x4 e0 = *(const f32x4*)ce, e1 = *(const f32x4*)(ce + 4), c0 = *(const f32x4*)ct, c1 = *(const f32x4*)(ct + 4);
        v4u o; o.x = pk2(kf[0] * __expf(e0.x - c0.x), kf[1] * __expf(e0.y - c0.y)); o.y = pk2(kf[2] * __expf(e0.z - c0.z), kf[3] * __expf(e0.w - c0.w));
        o.z = pk2(kf[4] * __expf(e1.x - c1.x), kf[5] * __expf(e1.y - c1.y)); o.w = pk2(kf[6] * __expf(e1.z - c1.z), kf[7] * __expf(e1.w - c1.w));
        *(LAS v4u*)(Kd + dir * 128 * KP + t * KP + ch * 8) = o; } }
    __syncthreads();
#pragma unroll 1
    for (int dir = 0; dir < 2; ++dir) {
      const LAS bf16_t* Kb = Kd + dir * 128 * KP;
      f32x4 acc[8][2];
#pragma unroll
      for (int dt = 0; dt < 8; ++dt) { acc[dt][0] = (f32x4){0.f, 0.f, 0.f, 0.f}; acc[dt][1] = (f32x4){0.f, 0.f, 0.f, 0.f}; }
#pragma unroll 1
      for (int k = 0; k < 4; ++k) {
        bf16x8 vf[2];
#pragma unroll
        for (int et = 0; et < 2; ++et) {
          const s16x4 lo = tr_read(Vs + (32 * k + 4 * Qd + (r >> 2)) * VP + 32 * wid + 16 * et + 4 * (r & 3));
          const s16x4 hi = tr_read(Vs + (32 * k + 16 + 4 * Qd + (r >> 2)) * VP + 32 * wid + 16 * et + 4 * (r & 3));
          vf[et] = (bf16x8){lo[0], lo[1], lo[2], lo[3], hi[0], hi[1], hi[2], hi[3]}; }
#pragma unroll
        for (int dt = 0; dt < 8; ++dt) {
          const s16x4 lo = tr_read(Kb + (32 * k + 4 * Qd + (r >> 2)) * KP + 16 * dt + 4 * (r & 3));
          const s16x4 hi = tr_read(Kb + (32 * k + 16 + 4 * Qd + (r >> 2)) * KP + 16 * dt + 4 * (r & 3));
          const bf16x8 kfr = (bf16x8){lo[0], lo[1], lo[2], lo[3], hi[0], hi[1], hi[2], hi[3]};
          acc[dt][0] = __builtin_amdgcn_mfma_f32_16x16x32_bf16(kfr, vf[0], acc[dt][0], 0, 0, 0);
          acc[dt][1] = __builtin_amdgcn_mfma_f32_16x16x32_bf16(kfr, vf[1], acc[dt][1], 0, 0, 0); }
      }
      bf16_t* Sp = ST + (((size_t)gc * 4 + h) * 2 + dir) * 32768;
#pragma unroll
      for (int dt = 0; dt < 8; ++dt)
#pragma unroll
        for (int et = 0; et < 2; ++et) { const f32x4 v = acc[dt][et];
          *(unsigned long long*)(Sp + (size_t)(32 * wid + 16 * et + r) * 128 + 16 * dt + 4 * Qd) = (unsigned long long)pk2(v[0], v[1]) | ((unsigned long long)pk2(v[2], v[3]) << 32); }
    }
  }
}
DEV void gla_scan_phase(bf16_t* ST, const float* GDEC, bool wr) {
  for (int item = blockIdx.x * 512 + threadIdx.x; item < 2 * 4 * 2 * 8192; item += gridDim.x * 512) {
    const int e4 = item & 8191, dir = (item >> 13) & 1, h = (item >> 14) & 3, b = item >> 16; const int d0 = (e4 * 4) & 127;
    float S0 = 0.f, S1 = 0.f, S2 = 0.f, S3 = 0.f;
#define SCAN_GC(s) (!dir ? ((s) < 2 ? 128 + 2 * b + (s) : b * 64 + ((s) - 2)) : ((s) < 2 ? 128 + 2 * b + (1 - (s)) : b * 64 + (65 - (s))))
    for (int s0 = 0; s0 < 66; s0 += 6) {
      unsigned long long u[6]; f32x4 dec[6];
#pragma unroll
      for (int q = 0; q < 6; ++q) { const int gc = SCAN_GC(s0 + q); u[q] = *(const unsigned long long*)(ST + (((size_t)gc * 4 + h) * 2 + dir) * 32768 + e4 * 4); dec[q] = *(const f32x4*)(GDEC + ((gc * 4 + h) * 2 + dir) * 128 + d0); }
#pragma unroll
      for (int q = 0; q < 6; ++q) { const int gc = SCAN_GC(s0 + q);
        if (wr) *(unsigned long long*)(ST + (((size_t)gc * 4 + h) * 2 + dir) * 32768 + e4 * 4) = (unsigned long long)pk2(S0, S1) | ((unsigned long long)pk2(S2, S3) << 32);
        const unsigned lo = (unsigned)u[q], hi = (unsigned)(u[q] >> 32);
        S0 = dec[q].x * S0 + __uint_as_float(lo << 16); S1 = dec[q].y * S1 + __uint_as_float(lo & 0xffff0000u); S2 = dec[q].z * S2 + __uint_as_float(hi << 16); S3 = dec[q].w * S3 + __uint_as_float(hi & 0xffff0000u); }
    }
#undef SCAN_GC
  }
}
DEV void gla_o_phase(const bf16_t* Q0, const bf16_t* K0, const bf16_t* V0, const float* GCSL, const float* GCSC, const bf16_t* ST, const float* gla_norm, const float* SSQ, const float* ssd_norm, bf16_t* Y0, LAS unsigned char* lds, bool wr) {
  constexpr int VP = 272, KP = 136;
  LAS bf16_t* Vs = (LAS bf16_t*)lds; LAS bf16_t* Kd = (LAS bf16_t*)(lds + 128 * VP * 2);
  const int tid = threadIdx.x, lane = tid & 63, wid = tid >> 6, r = lane & 15, Qd = lane >> 4;
  const float scale = 0.08838834764831845f;
  for (int task = blockIdx.x; task < NCH * 4; task += gridDim.x) {
    const int gc = task >> 2, h = task & 3; const size_t r0 = (size_t)gc * 128;
    __syncthreads();
#pragma unroll
    for (int i = 0; i < 8; ++i) { const int cid = tid + 512 * i, row = cid >> 5, ch = cid & 31; *(LAS v4u*)(Vs + row * VP + ch * 8) = *(const v4u*)(V0 + (r0 + row) * 1024 + h * 256 + ch * 8); }
#pragma unroll
    for (int i = 0; i < 4; ++i) { const int cid = tid + 512 * i, t = cid >> 4, ch = cid & 15;
      const v4u kv = *(const v4u*)(K0 + (r0 + t) * 512 + h * 128 + ch * 8);
      const float kf[8] = {__uint_as_float(kv.x << 16), __uint_as_float(kv.x & 0xffff0000u), __uint_as_float(kv.y << 16), __uint_as_float(kv.y & 0xffff0000u), __uint_as_float(kv.z << 16), __uint_as_float(kv.z & 0xffff0000u), __uint_as_float(kv.w << 16), __uint_as_float(kv.w & 0xffff0000u)};
#pragma unroll
      for (int dir = 0; dir < 2; ++dir) {
        const float* ct = gcs_row(GCSL, GCSC, r0 + t) + dir * 512 + h * 128 + ch * 8;
        const f32x4 c0 = *(const f32x4*)ct, c1 = *(const f32x4*)(ct + 4);
        v4u o; o.x = pk2(kf[0] * __expf(-c0.x), kf[1] * __expf(-c0.y)); o.y = pk2(kf[2] * __expf(-c0.z), kf[3] * __expf(-c0.w));
        o.z = pk2(kf[4] * __expf(-c1.x), kf[5] * __expf(-c1.y)); o.w = pk2(kf[6] * __expf(-c1.z), kf[7] * __expf(-c1.w));
        *(LAS v4u*)(Kd + dir * 128 * KP + t * KP + ch * 8) = o; } }
    __syncthreads();
    const int i = 16 * wid + r;
    f32x4 o[16];
#pragma unroll
    for (int et = 0; et < 16; ++et) o[et] = (f32x4){0.f, 0.f, 0.f, 0.f};
#pragma unroll 1
    for (int dir = 0; dir < 2; ++dir) {
      bf16x8 qd[4];
      { const float* ci = gcs_row(GCSL, GCSC, r0 + i) + dir * 512 + h * 128; const bf16_t* qp = Q0 + (r0 + i) * 512 + h * 128;
#pragma unroll
        for (int ks = 0; ks < 4; ++ks) { const v4u qv = *(const v4u*)(qp + 32 * ks + 8 * Qd); const f32x4 c0 = *(const f32x4*)(ci + 32 * ks + 8 * Qd), c1 = *(const f32x4*)(ci + 32 * ks + 8 * Qd + 4);
          const unsigned w0 = pk2(__uint_as_float(qv.x << 16) * scale * __expf(c0.x), __uint_as_float(qv.x & 0xffff0000u) * scale * __expf(c0.y));
          const unsigned w1 = pk2(__uint_as_float(qv.y << 16) * scale * __expf(c0.z), __uint_as_float(qv.y & 0xffff0000u) * scale * __expf(c0.w));
          const unsigned w2 = pk2(__uint_as_float(qv.z << 16) * scale * __expf(c1.x), __uint_as_float(qv.z & 0xffff0000u) * scale * __expf(c1.y));
          const unsigned w3 = pk2(__uint_as_float(qv.w << 16) * scale * __expf(c1.z), __uint_as_float(qv.w & 0xffff0000u) * scale * __expf(c1.w));
          qd[ks] = (bf16x8){(short)(w0 & 0xffff), (short)(w0 >> 16), (short)(w1 & 0xffff), (short)(w1 >> 16), (short)(w2 & 0xffff), (short)(w2 >> 16), (short)(w3 & 0xffff), (short)(w3 >> 16)}; } }
      const bf16_t* Sp = ST + (((size_t)gc * 4 + h) * 2 + dir) * 32768;
#pragma unroll 1
      for (int ks = 0; ks < 4; ++ks)
#pragma unroll
        for (int et = 0; et < 16; ++et) { const bf16x8 sf = *(const bf16x8*)(Sp + (size_t)(16 * et + r) * 128 + 32 * ks + 8 * Qd); o[et] = __builtin_amdgcn_mfma_f32_16x16x32_bf16(qd[ks], sf, o[et], 0, 0, 0); }
      const LAS bf16_t* Kb = Kd + dir * 128 * KP;
#pragma unroll 1
      for (int k2 = 0; k2 < 4; ++k2) {
        const bool need = dir ? (2 * k2 + 1 >= wid) : (2 * k2 <= wid);
        if (!need) continue;
        bf16x8 pa;
#pragma unroll
        for (int tt = 0; tt < 2; ++tt) { const int t = 2 * k2 + tt;
          f32x4 c = {0.f, 0.f, 0.f, 0.f};
#pragma unroll
          for (int ks = 0; ks < 4; ++ks) { const bf16x8 kfr = *(const LAS bf16x8*)(Kb + (16 * t + r) * KP + 32 * ks + 8 * Qd); c = __builtin_amdgcn_mfma_f32_16x16x32_bf16(kfr, qd[ks], c, 0, 0, 0); }
          float pv[4];
#pragma unroll
          for (int jj = 0; jj < 4; ++jj) { const int j = 16 * t + 4 * Qd + jj; const bool ok = dir ? (j >= i) : (j <= i); pv[jj] = ok ? c[jj] : 0.f; }
          const unsigned w0 = pk2(pv[0], pv[1]), w1 = pk2(pv[2], pv[3]);
          pa[tt * 4 + 0] = (short)(w0 & 0xffff); pa[tt * 4 + 1] = (short)(w0 >> 16); pa[tt * 4 + 2] = (short)(w1 & 0xffff); pa[tt * 4 + 3] = (short)(w1 >> 16); }
#pragma unroll
        for (int et = 0; et < 16; ++et) {
          const s16x4 lo = tr_read(Vs + (32 * k2 + 4 * Qd + (r >> 2)) * VP + 16 * et + 4 * (r & 3));
          const s16x4 hi = tr_read(Vs + (32 * k2 + 16 + 4 * Qd + (r >> 2)) * VP + 16 * et + 4 * (r & 3));
          const bf16x8 vf = (bf16x8){lo[0], lo[1], lo[2], lo[3], hi[0], hi[1], hi[2], hi[3]};
          o[et] = __builtin_amdgcn_mfma_f32_16x16x32_bf16(pa, vf, o[et], 0, 0, 0); }
      }
    }
#pragma unroll
    for (int jj = 0; jj < 4; ++jj) { float ss = 0.f;
#pragma unroll
      for (int et = 0; et < 16; ++et) ss += o[et][jj] * o[et][jj];
      ss += __shfl_xor(ss, 1); ss += __shfl_xor(ss, 2); ss += __shfl_xor(ss, 4); ss += __shfl_xor(ss, 8);
      const float rstd = rsqrtf(ss * (1.f / 256.f) + EPS);
      const size_t yo = (r0 + 16 * wid + 4 * Qd + jj) * 2048 + 1024 + h * 256 + r;
#pragma unroll
      for (int et = 0; et < 16; ++et) { const bf16_t ov_ = f2bf(o[et][jj] * rstd * gla_norm[h * 256 + 16 * et + r] * bf2f(Y0[yo + 16 * et])); if (wr) Y0[yo + 16 * et] = ov_; } }
    { const int g = h >> 1, c0 = g * 512 + (h & 1) * 256;
#pragma unroll
      for (int q = 0; q < 8; ++q) { const int cid = tid + 512 * q, row = cid >> 5, ch = cid & 31; const size_t rr = r0 + row;
        const float rstd = rsqrtf((SSQ[(rr * 2 + g) * 2] + SSQ[(rr * 2 + g) * 2 + 1]) * (1.f / 512.f) + EPS);
        bf16_t* yp = Y0 + rr * 2048 + c0 + ch * 8; const v4u yv = *(const v4u*)yp; const f32x4 g0 = *(const f32x4*)(ssd_norm + c0 + ch * 8), g1 = *(const f32x4*)(ssd_norm + c0 + ch * 8 + 4);
        v4u ov; ov.x = pk2(__uint_as_float(yv.x << 16) * rstd * g0.x, __uint_as_float(yv.x & 0xffff0000u) * rstd * g0.y); ov.y = pk2(__uint_as_float(yv.y << 16) * rstd * g0.z, __uint_as_float(yv.y & 0xffff0000u) * rstd * g0.w);
        ov.z = pk2(__uint_as_float(yv.z << 16) * rstd * g1.x, __uint_as_float(yv.z & 0xffff0000u) * rstd * g1.y); ov.w = pk2(__uint_as_float(yv.w << 16) * rstd * g1.z, __uint_as_float(yv.w & 0xffff0000u) * rstd * g1.w);
        if (wr) *(v4u*)yp = ov; } }
  }
}

typedef __attribute__((address_space(1))) unsigned gu32;
#define RLX_AGENT __ATOMIC_RELAXED, __HIP_MEMORY_SCOPE_AGENT
#define XB_TMO      128
#define XB_XCNT(j)  (256  + 64 * (j))
#define XB_XSUB(j)  (1280 + 64 * (j))
#define XB_XGEN(j)  (2304 + 64 * (j))
#define XB_TOP      3328
#define XB_TOPGEN   3392
#define XCD_BAR_WORDS 3456
#define XB_SPIN_CAP (1u << 18)

__device__ __forceinline__ unsigned xb_ld(unsigned* p)              { return __hip_atomic_load(p, __ATOMIC_RELAXED, __HIP_MEMORY_SCOPE_AGENT); }
__device__ __forceinline__ unsigned xb_add(unsigned* p, unsigned v) { return __hip_atomic_fetch_add(p, v, __ATOMIC_RELAXED, __HIP_MEMORY_SCOPE_AGENT); }
__device__ __forceinline__ unsigned xb_xcc_id() { return (unsigned)__builtin_amdgcn_s_getreg((3 << 11) | 20) & 0xFu; }
#define XB_SPIN(cond, bar) do { unsigned _sp = 0; while (cond) { __builtin_amdgcn_s_sleep(1); \
    if ((++_sp & 255u) == 0u) { if (xb_ld(&(bar)[XB_TMO])) break; if (_sp > XB_SPIN_CAP) { atomicAdd(&(bar)[XB_TMO], 1u); break; } } } } while (0)

struct XcdBarrier {
    unsigned* bar; unsigned x;
    volatile LAS unsigned* st;
};

__device__ __forceinline__ XcdBarrier xcd_barrier_post(unsigned* bar, volatile LAS unsigned* st) {
    XcdBarrier b; b.bar = bar; b.x = xb_xcc_id(); b.st = st;
    if (threadIdx.x == 0) (void)xb_add(&bar[XB_XCNT(b.x)], 1u);
    return b;
}
__device__ __forceinline__ void xcd_barrier_complete(unsigned* bar, unsigned x, unsigned& nloc, unsigned& nx) {
    const unsigned G = gridDim.x * gridDim.y * gridDim.z;
    unsigned sum, cnt, mine, sp = 0u;
    for (;;) {
        sum = 0u; cnt = 0u; mine = 0u;
#pragma unroll
        for (unsigned j = 0; j < 16; ++j) { const unsigned c = xb_ld(&bar[XB_XCNT(j)]); sum += c; cnt += (c > 0u) ? 1u : 0u; mine = (j == x) ? c : mine; }
        if (sum == G) break;
        __builtin_amdgcn_s_sleep(1);
        if ((++sp & 255u) == 0u) { if (xb_ld(&bar[XB_TMO])) break; if (sp > XB_SPIN_CAP) { atomicAdd(&bar[XB_TMO], 1u); break; } }
    }
    nloc = mine > 0u ? mine : 1u; nx = cnt > 0u ? cnt : 1u;
}

__device__ __forceinline__ void xcd_barrier(const XcdBarrier& b) {
    asm volatile("s_waitcnt vmcnt(0)" ::: "memory");
    __syncthreads();
    if (threadIdx.x == 0) {
        unsigned* bar = b.bar;
        __builtin_amdgcn_s_waitcnt(0);
        unsigned nloc = b.st[0], nx = b.st[1];
        if (nloc == 0u) { xcd_barrier_complete(bar, b.x, nloc, nx); b.st[0] = nloc; b.st[1] = nx; }
        const unsigned old = xb_add(&bar[XB_XSUB(b.x)], 1u);
        const unsigned gen = old / nloc;
        if (old + 1u == (gen + 1u) * nloc) {
            __builtin_amdgcn_fence(__ATOMIC_RELEASE, "agent");
            asm volatile("s_waitcnt vmcnt(0)" ::: "memory");
            const unsigned og = xb_add(&bar[XB_TOP], 1u);
            const unsigned tg = og / nx;
            if (og + 1u == (tg + 1u) * nx) xb_add(&bar[XB_TOPGEN], 1u);
            else XB_SPIN(xb_ld(&bar[XB_TOPGEN]) == tg, bar);
            __builtin_amdgcn_fence(__ATOMIC_ACQUIRE, "agent");
            xb_add(&bar[XB_XGEN(b.x)], 1u);
            asm volatile("s_waitcnt vmcnt(0)" ::: "memory");
        } else {
            XB_SPIN(xb_ld(&bar[XB_XGEN(b.x)]) == gen, bar);
            __builtin_amdgcn_fence(__ATOMIC_ACQUIRE, "agent");
            asm volatile("s_waitcnt vmcnt(0)" ::: "memory");
        }
    }
    __syncthreads();
}

__global__ void __launch_bounds__(NWAVES * 64, 2) mega(Params p) {
  extern __shared__ __attribute__((aligned(16))) unsigned char lds_raw[];
  LAS unsigned char* lds = (LAS unsigned char*)lds_raw;
  cg::grid_group grid = cg::this_grid();
  volatile LAS unsigned* MISC = (volatile LAS unsigned*)(lds + MISC_OFF);
  if (threadIdx.x < 16) MISC[threadIdx.x] = 0u;
  __syncthreads();
  XcdBarrier bar = xcd_barrier_post((unsigned*)(p.ws + WS_CTL), MISC + 8);
  unsigned char* ws = p.ws;
  float* MOD = (float*)(ws + WS_MOD);
  bf16_t* H0 = (bf16_t*)p.out; float* X1 = p.out;
  const int lo = p.ph_lo, hi = p.ph_hi;
#define IN(k) (lo <= (k) && (k) < hi)
#define SEAM(k) do { if ((k) + 1 < hi) { if ((k) == 0) grid.sync(); else xcd_barrier(bar); } } while (0)
#define PH(k, ...) if (IN(k)) { if ((PROBE_MASK >> (k)) & 1u) { const bool wr = (p.rep < 0); (void)wr; __VA_ARGS__; xcd_barrier(bar); } { const bool wr = true; (void)wr; __VA_ARGS__; } SEAM(k); }
  PH(0, prologue_phase(p, lds))
  PH(1, prep_phase(p.in[0], p.in[2], p.in[4], MOD, H0))
  PH(2, {
    pg8::Gemm g{H0, (const bf16_t*)(ws + WS_W1T), MA, E_INP, D}; pg8::StaticOrder S; S.init(MA, E_INP, gridDim.x, (int)blockIdx.x);
    pg8::EpiProj0 E{(bf16_t*)(ws + WS_Y0), (bf16_t*)(ws + WS_XBC), (bf16_t*)(ws + WS_Q0), (bf16_t*)(ws + WS_K0), (bf16_t*)(ws + WS_V0), (float*)(ws + WS_DTLR)};
    pg8::gemm_phase<pg8::EpiProj0, pg8::StaticOrder, true, true>(lds, g, S, E); })
  PH(3, ssd_prep_phase((const bf16_t*)(ws + WS_XBC), p.in[8], p.in[9], (bf16_t*)p.out, (const float*)(ws + WS_DTLR), p.in[10], p.in[11], (float*)((char*)p.out + DO_SDT), (float*)((char*)p.out + DO_SCS), (float*)(ws + WS_SDEC)))
  PH(4, ssd_u_phase((const bf16_t*)p.out, (const float*)((char*)p.out + DO_SDT), (const float*)((char*)p.out + DO_SCS), (bf16_t*)(ws + WS_STATE), lds))
  PH(5, ssd_scan_phase((bf16_t*)(ws + WS_STATE), (const float*)(ws + WS_SDEC), wr))
  PH(6, ssd_y_phase((const bf16_t*)p.out, (const float*)((char*)p.out + DO_SDT), (const float*)((char*)p.out + DO_SCS), (const bf16_t*)(ws + WS_STATE), p.in[12], (bf16_t*)(ws + WS_Y0), (float*)(ws + WS_SSQ), lds, wr))
  PH(7, gla_cs_phase((const float*)(ws + WS_DTLR), p.in[14], p.in[15], (float*)p.out, (float*)(ws + WS_GCSC), (float*)(ws + WS_GDEC)))
  PH(8, gla_u_phase((const bf16_t*)(ws + WS_K0), (const bf16_t*)(ws + WS_V0), (const float*)p.out, (const float*)(ws + WS_GCSC), (bf16_t*)(ws + WS_STATE), lds))
  PH(9, gla_scan_phase((bf16_t*)(ws + WS_STATE), (const float*)(ws + WS_GDEC), wr))
  PH(10, gla_o_phase((const bf16_t*)(ws + WS_Q0), (const bf16_t*)(ws + WS_K0), (const bf16_t*)(ws + WS_V0), (const float*)p.out, (const float*)(ws + WS_GCSC), (const bf16_t*)(ws + WS_STATE), p.in[16], (const float*)(ws + WS_SSQ), p.in[13], (bf16_t*)(ws + WS_Y0), lds, wr))
  PH(11, {
    pg8::Gemm g{(const bf16_t*)(ws + WS_Y0), (const bf16_t*)(ws + WS_W2T), ML, D, 2048}; pg8::StaticOrder S; S.init(ML, D, gridDim.x, (int)blockIdx.x);
    pg8::EpiResid E{p.in[0], X1, MOD, true};
    pg8::gemm_phase<pg8::EpiResid, pg8::StaticOrder, true, true>(lds, g, S, E);
    const float* ctx = p.in[2]; float* XC1 = (float*)(ws + WS_XC1); const float* gate = MOD + 2 * 3072 + 2048;
    small_gemm((const bf16_t*)(ws + WS_Y0) + (size_t)ML * 2048, 2048, (const bf16_t*)(ws + WS_W2T), 2048, 2048, MC, D,
               [=](int m, int n, float v) { XC1[(size_t)m * D + n] = ctx[(size_t)m * D + n] + gate[n] * v; }); })
  PH(12, prep_phase(X1, (const float*)(ws + WS_XC1), p.in[18], MOD + 3 * 3072, (bf16_t*)(ws + WS_H1)))
  PH(13, {
    pg8::Gemm g{(const bf16_t*)(ws + WS_H1), (const bf16_t*)(ws + WS_W3T), ML, O_IN, D}; pg8::StaticOrder S; S.init(ML, O_IN, gridDim.x, (int)blockIdx.x);
    pg8::EpiProj1 E{(bf16_t*)(ws + WS_K1), (bf16_t*)(ws + WS_V1), (bf16_t*)(ws + WS_Q1), (bf16_t*)(ws + WS_G1)};
    pg8::gemm_phase<pg8::EpiProj1, pg8::StaticOrder, true, true>(lds, g, S, E);
    bf16_t* K1 = (bf16_t*)(ws + WS_K1); bf16_t* V1 = (bf16_t*)(ws + WS_V1);
    small_gemm((const bf16_t*)(ws + WS_H1) + (size_t)ML * D, D, (const bf16_t*)(ws + WS_W3T), D, D, MC, 1024,
               [=](int m, int n, float v) { if (n < 512) K1[(size_t)(ML + m) * 512 + n] = f2bf(v); else V1[(size_t)(ML + m) * 512 + (n - 512)] = f2bf(v); }); })
  PH(14, qknorm_phase((bf16_t*)(ws + WS_Q1), (bf16_t*)(ws + WS_K1), p.in[22], p.in[23], (const float*)(ws + WS_ROPE), wr))
  PH(15, attn_phase((bf16_t*)(ws + WS_Q1), (const bf16_t*)(ws + WS_K1), (const bf16_t*)(ws + WS_V1), (const bf16_t*)(ws + WS_G1), p.in[24], p.in[22], p.in[23], lds, wr))
  PH(16, {
    pg8::Gemm g{(const bf16_t*)(ws + WS_Q1), (const bf16_t*)(ws + WS_W4T), ML, D, 2048}; pg8::StaticOrder S; S.init(ML, D, gridDim.x, (int)blockIdx.x);
    pg8::EpiResid E{X1, p.out, MOD + 3 * 3072, wr};
    pg8::gemm_phase<pg8::EpiResid, pg8::StaticOrder, true, true>(lds, g, S, E); })
#undef PH
#undef IN
#undef SEAM
}
extern "C" void kernel_launch(void* const* d_in, const int* in_sizes, int n_in, void* d_out, int out_size, void* d_ws, size_t ws_size, hipStream_t stream) {
  static int grid_blocks = 0;
  if (!grid_blocks) {
    int dev = 0, cus = 0, per_cu = 0;
    hipGetDevice(&dev);
    hipDeviceGetAttribute(&cus, hipDeviceAttributeMultiprocessorCount, dev);
    hipFuncSetAttribute((const void*)mega, hipFuncAttributeMaxDynamicSharedMemorySize, LDS_BYTES);
    hipOccupancyMaxActiveBlocksPerMultiprocessor(&per_cu, (const void*)mega, NWAVES * 64, LDS_BYTES);
    if (per_cu < 1) { fprintf(stderr, "kernel_launch: occupancy query says %d blocks per CU\n", per_cu); per_cu = 1; }
    if (per_cu > 1) per_cu = 1;
    grid_blocks = cus * per_cu;
  }
  hipMemsetAsync((char*)d_ws + WS_CTL, 0, 64 * 1024, stream);
  Params base{};
  for (int i = 0; i < 26; ++i) base.in[i] = (const float*)d_in[i];
  base.out = (float*)d_out; base.ws = (unsigned char*)d_ws;
  auto launch = [&](int lo, int hi) {
    Params p = base; p.ph_lo = lo; p.ph_hi = hi; p.rep = (int)PROBE_MASK; void* args[] = {&p};
    hipError_t e = hipLaunchCooperativeKernel((const void*)mega, dim3(grid_blocks), dim3(NWAVES * 64), args, LDS_BYTES, stream);
    if (e != hipSuccess) fprintf(stderr, "cooperative launch failed: %s (grid %d)\n", hipGetErrorString(e), grid_blocks);
  };
  launch(0, 17);
}
```

```cpp
#include <hip/hip_runtime.h>
#include <hip/hip_cooperative_groups.h>
#include <stdint.h>
#include <math.h>
#include <cstdio>
namespace cg = cooperative_groups;
#ifndef PROBE_MASK
#define PROBE_MASK 0u
#endif

typedef unsigned short bf16_t;
#define DEV __device__ __forceinline__

DEV float bf2f(bf16_t v) { return __uint_as_float(((unsigned)v) << 16); }
DEV bf16_t f2bf(float f) { unsigned u = __float_as_uint(f); u = (u + 0x7fffu + ((u >> 16) & 1u)) >> 16; return (bf16_t)u; }
DEV unsigned pk2(float lo, float hi) { return (unsigned)f2bf(lo) | ((unsigned)f2bf(hi) << 16); }
DEV float siluf(float x) { return x / (1.f + __expf(-x)); }
DEV float silu_fast(float x) { return x * __builtin_amdgcn_rcpf(1.f + __expf(-x)); }
DEV float softplusf(float x) { return x > 20.f ? x : log1pf(__expf(x)); }
DEV float logsigmoidf(float x) { return fminf(x, 0.f) - log1pf(__expf(-fabsf(x))); }

constexpr int D = 1024, NB = 2, SEQ = 8192, CTXL = 256;
constexpr int ML = NB * SEQ;
constexpr int MC = NB * CTXL;
constexpr int MA = ML + MC;
constexpr int NCH = MA / 128;
constexpr int E_IN = 5696, O_IN = 5120, E_INP = 5888;
constexpr float EPS = 1e-6f;

constexpr size_t MiB = 1u << 20;
constexpr size_t WS_CTL = 0;
constexpr size_t WS_MOD = 1 * MiB;
constexpr size_t WS_ROPE = 1 * MiB + 128 * 1024;
constexpr size_t WS_SDEC = 1 * MiB + 256 * 1024;
constexpr size_t WS_GDEC = 1 * MiB + 384 * 1024;
constexpr size_t WS_W1T = 2 * MiB;
constexpr size_t WS_W2T = 14 * MiB;
constexpr size_t WS_W3T = 18 * MiB;
constexpr size_t WS_W4T = 28 * MiB;
constexpr size_t WS_Y0 = 32 * MiB;
constexpr size_t WS_Q0 = 98 * MiB;
constexpr size_t WS_K0 = WS_Q0 + 16 * MiB + 512 * 1024;
constexpr size_t WS_V0 = 131 * MiB;
constexpr size_t WS_DTLR = 164 * MiB;
constexpr size_t WS_XC1 = 168 * MiB + 512 * 1024;
constexpr size_t WS_XBC = 171 * MiB;
constexpr size_t WS_STATE = 171 * MiB;
constexpr size_t WS_TAIL = 237 * MiB;
constexpr size_t WS_H1 = 32 * MiB;
constexpr size_t WS_K1 = 65 * MiB;
constexpr size_t WS_V1 = 81 * MiB + 512 * 1024;
constexpr size_t WS_Q1 = 98 * MiB;
constexpr size_t WS_G1 = 171 * MiB;

DEV int row_vec(int row) { return row < ML ? (row / SEQ) : 2; }

namespace pg8 {
#define PG8_LAS __attribute__((address_space(3)))
typedef unsigned short bf16_t;
typedef short bf16x8 __attribute__((ext_vector_type(8)));
typedef float f32x4 __attribute__((ext_vector_type(4)));
typedef unsigned u32x4 __attribute__((ext_vector_type(4)));
constexpr int BM = 256, BK = 64, HALF = 128, HTB = HALF * BK * 2  , STAGE_BYTES = 8 * HTB, NXCD = 8, WGM = 8;

__host__ __device__ __forceinline__ int lds_byte(int r, int c) { const int st = (r >> 4) * 2 + (c >> 5), rr = r & 15, cc = c & 31, ob = rr * 64 + cc * 2; return st * 1024 + (ob ^ (((ob >> 9) & 1) << 5)); }
__host__ __device__ __forceinline__ void stage_rc(int b, int& R, int& C) { const int st = b / 1024, sb = b % 1024, swz = sb ^ (((sb >> 9) & 1) << 5); R = (st >> 1) * 16 + swz / 64; C = (st & 1) * 32 + (swz % 64) / 2; }
__host__ __device__ __forceinline__ int perm32(int rho) { const int n = rho >> 4, i = rho & 15; return 8 * (i >> 2) + 4 * n + (i & 3); }

struct Unit { int pm, pn; };
struct Gemm { const bf16_t* A; const bf16_t* Bt; int M, N, K; };

struct StaticOrder {
    int nM, nN, nwg, G, c;
    __host__ __device__ void init(int M, int N, int G_, int c_) { nM = M / BM; nN = N / BM; nwg = nM * nN; G = G_; c = c_; }
    __host__ __device__ bool next(int i, Unit& u) const {
        const long L = (long)i * G + c; if (L >= nwg) return false;
        int wgid = (int)L; { const int q = nwg / NXCD, r = nwg % NXCD, xcd = wgid % NXCD, off = wgid / NXCD; wgid = (xcd < r ? xcd * (q + 1) : r * (q + 1) + (xcd - r) * q) + off; }
        const int nig = WGM * nN, gid = wgid / nig, fm = gid * WGM, gsz = (nM - fm) < WGM ? (nM - fm) : WGM;
        u.pm = fm + ((wgid % nig) % gsz); u.pn = (wgid % nig) / gsz; return true;
    }
    __device__ __forceinline__ void a_ready(const Unit&) const {}
    __device__ __forceinline__ void done(const Unit&) const {}
};
__device__ __forceinline__ unsigned cvt_pk_bf16(float lo, float hi) { unsigned r; asm volatile("v_cvt_pk_bf16_f32 %0, %1, %2" : "=v"(r) : "v"(lo), "v"(hi)); return r; }
__device__ __forceinline__ float silu_e(float x) { return x * __builtin_amdgcn_rcpf(1.f + __expf(-x)); }

__device__ __forceinline__ void store_unit_bf16(const f32x4 (&acc)[2][2][4][2], bf16_t* base, int ld, int colt, bool act, const Unit& u, int wr, int wc, int fr, int fq) {
    const int row0 = u.pm * BM + wr * 64 + fr; const int col0 = colt + wc * 32 + 8 * fq;
#pragma unroll
    for (int ai = 0; ai < 2; ++ai)
#pragma unroll
        for (int m = 0; m < 4; ++m) { bf16_t* rowp = base + (size_t)(row0 + ai * HALF + m * 16) * ld + col0;
#pragma unroll
            for (int bj = 0; bj < 2; ++bj) { f32x4 v0 = acc[ai][bj][m][0], v1 = acc[ai][bj][m][1];
                if (act) { v0 = (f32x4){silu_e(v0[0]), silu_e(v0[1]), silu_e(v0[2]), silu_e(v0[3])}; v1 = (f32x4){silu_e(v1[0]), silu_e(v1[1]), silu_e(v1[2]), silu_e(v1[3])}; }
                u32x4 w; w.x = cvt_pk_bf16(v0[0], v0[1]); w.y = cvt_pk_bf16(v0[2], v0[3]); w.z = cvt_pk_bf16(v1[0], v1[1]); w.w = cvt_pk_bf16(v1[2], v1[3]);
                *(u32x4*)(rowp + bj * HALF) = w; } }
}
struct EpiProj0 {
    static constexpr bool PERM = true, AFTER_DRAIN = false;
    bf16_t *Y0, *XBC, *Q0, *K0, *V0; float* DTLR;
    __device__ __forceinline__ void operator()(const f32x4 (&acc)[2][2][4][2], const Unit& u, int wr, int wc, int fr, int fq) const {
        const int pn = u.pn;
        if (pn == 22) {
            if (wc < 2) { const int row0 = u.pm * BM + wr * 64 + fr;
#pragma unroll
                for (int ai = 0; ai < 2; ++ai)
#pragma unroll
                    for (int m = 0; m < 4; ++m) { float* rp = DTLR + (size_t)(row0 + ai * HALF + m * 16) * 64 + wc * 32 + 8 * fq; *(f32x4*)rp = acc[ai][0][m][0]; *(f32x4*)(rp + 4) = acc[ai][0][m][1]; } }
            return;
        }
        bf16_t* base; int ld, colt; bool act = false;
        if (pn < 8) { base = Y0; ld = 2048; colt = pn * 256; act = true; }
        else if (pn < 14) { base = XBC; ld = 1536; colt = (pn - 8) * 256; }
        else if (pn < 16) { base = Q0; ld = 512; colt = (pn - 14) * 256; }
        else if (pn < 18) { base = K0; ld = 512; colt = (pn - 16) * 256; }
        else { base = V0; ld = 1024; colt = (pn - 18) * 256; }
        store_unit_bf16(acc, base, ld, colt, act, u, wr, wc, fr, fq);
    }
};
struct EpiProj1 {
    static constexpr bool PERM = true, AFTER_DRAIN = false;
    bf16_t *K1, *V1, *Q1, *G1;
    __device__ __forceinline__ void operator()(const f32x4 (&acc)[2][2][4][2], const Unit& u, int wr, int wc, int fr, int fq) const {
        const int pn = u.pn; bf16_t* base; int ld, colt; bool act = false;
        if (pn < 2) { base = K1; ld = 512; colt = pn * 256; }
        else if (pn < 4) { base = V1; ld = 512; colt = (pn - 2) * 256; }
        else if (pn < 12) { base = Q1; ld = 2048; colt = (pn - 4) * 256; }
        else { base = G1; ld = 2048; colt = (pn - 12) * 256; act = true; }
        store_unit_bf16(acc, base, ld, colt, act, u, wr, wc, fr, fq);
    }
};
struct EpiResid {
    static constexpr bool PERM = false, AFTER_DRAIN = false;
    const float* res; float* out; const float* mod; bool do_store;
    __device__ __forceinline__ void operator()(const f32x4 (&acc)[2][2][4][2], const Unit& u, int wr, int wc, int fr, int fq) const {
        const int b = (u.pm * BM) / 8192; const float* gate = mod + b * 3072 + 2048;
        const int col0 = u.pn * BM + wc * 32 + 4 * fq;
        f32x4 gv[2][2];
#pragma unroll
        for (int bj = 0; bj < 2; ++bj)
#pragma unroll
            for (int n = 0; n < 2; ++n) gv[bj][n] = *(const f32x4*)(gate + col0 + bj * HALF + n * 16);
#pragma unroll
        for (int ai = 0; ai < 2; ++ai)
#pragma unroll
            for (int m = 0; m < 4; ++m) { const size_t off = (size_t)(u.pm * BM + ai * HALF + wr * 64 + m * 16 + fr) * 1024 + col0;
#pragma unroll
                for (int bj = 0; bj < 2; ++bj)
#pragma unroll
                    for (int n = 0; n < 2; ++n) { const f32x4 r = *(const f32x4*)(res + off + bj * HALF + n * 16); const f32x4 ov_ = r + gv[bj][n] * acc[ai][bj][m][n]; if (do_store) *(f32x4*)(out + off + bj * HALF + n * 16) = ov_; } }
    }
};
template <class Epi, class Sched, bool ALIGN_EPI = false, bool SP2 = false>
__device__ __forceinline__ void gemm_phase(PG8_LAS unsigned char* lds, const Gemm g, const Sched& S, const Epi& E) {
    const int tid = threadIdx.x, wid = __builtin_amdgcn_readfirstlane(tid >> 6), lane = tid & 63, wr = wid >> 2, wc = wid & 3, fr = lane & 15, fq = lane >> 4;
    const int K = g.K, nt = K / BK;
    unsigned voffA[2], voffB[2];
#pragma unroll
    for (int i = 0; i < 2; ++i) { int R, C; stage_rc(tid * 16 + i * 8192, R, C); const int Rb = Epi::PERM ? ((R & ~31) + perm32(R & 31)) : R;
        voffA[i] = (unsigned)(R * K + C) * 2u; voffB[i] = (unsigned)(Rb * K + C) * 2u; }
    const size_t kstep = (size_t)(BK * 2);
    const size_t hstep = (size_t)HALF * K * 2;
    const size_t tstep = 2 * hstep;
    const unsigned ldsw = (unsigned)wid * 1024u;
    const int aoff = lds_byte(wr * 64 + fr, fq * 8), boff = lds_byte(wc * 32 + fr, fq * 8);
#define PG8_SA(b, h) (((b) * 2 + (h)) * HTB)
#define PG8_SB(b, h) ((4 + (b) * 2 + (h)) * HTB)
#define PG8_STAGE(bufoff, gbase, voff) do { _Pragma("unroll") for (int _i = 0; _i < 2; ++_i) \
        __builtin_amdgcn_global_load_lds((const unsigned*)((const char*)(gbase) + (voff)[_i]), (PG8_LAS unsigned*)(lds + (bufoff) + ldsw + _i * 8192), 16, 0, 0); } while (0)
#define PG8_LDA(dst, b, h) do { _Pragma("unroll") for (int m = 0; m < 4; ++m) _Pragma("unroll") for (int k = 0; k < 2; ++k) dst[m][k] = *(const PG8_LAS bf16x8*)(lds + PG8_SA(b, h) + aoff + m * 2048 + k * 1024); } while (0)
#define PG8_LDB(dst, b, h) do { _Pragma("unroll") for (int n = 0; n < 2; ++n) _Pragma("unroll") for (int k = 0; k < 2; ++k) dst[n][k] = *(const PG8_LAS bf16x8*)(lds + PG8_SB(b, h) + boff + n * 2048 + k * 1024); } while (0)
#define PG8_MMA(ai, bj, At, Bt) do { __builtin_amdgcn_s_setprio(1); _Pragma("unroll") for (int m = 0; m < 4; ++m) _Pragma("unroll") for (int n = 0; n < 2; ++n) _Pragma("unroll") for (int k = 0; k < 2; ++k) \
        acc[ai][bj][m][n] = __builtin_amdgcn_mfma_f32_16x16x32_bf16(Bt[n][k], At[m][k], acc[ai][bj][m][n], 0, 0, 0); __builtin_amdgcn_s_setprio(0); } while (0)
#define PG8_WAIT_V(n) asm volatile("s_waitcnt vmcnt(" #n ")" ::: "memory")
#define PG8_WAIT_L(n) asm volatile("s_waitcnt lgkmcnt(" #n ")" ::: "memory")
#define PG8_BAR __builtin_amdgcn_s_barrier()
#define PG8_SCHED __builtin_amdgcn_sched_barrier(0)
    Unit cur, nxt; int ui = 0;
    if (!S.next(0, cur)) return;
    f32x4 acc[2][2][4][2];
#pragma unroll
    for (int a = 0; a < 2; ++a)
#pragma unroll
        for (int b = 0; b < 2; ++b)
#pragma unroll
            for (int m = 0; m < 4; ++m)
#pragma unroll
                for (int n = 0; n < 2; ++n) acc[a][b][m][n] = (f32x4){0.f, 0.f, 0.f, 0.f};
    bf16x8 At[4][2], B0[2][2], B1[2][2];
    const char* cA = (const char*)g.A + (size_t)cur.pm * tstep; const char* cB = (const char*)g.Bt + (size_t)cur.pn * tstep;
    S.a_ready(cur);
    if constexpr (SP2) {
        PG8_STAGE(PG8_SB(0, 0), cB, voffB); PG8_STAGE(PG8_SB(0, 1), cB + hstep, voffB); PG8_STAGE(PG8_SA(0, 0), cA, voffA); PG8_STAGE(PG8_SA(0, 1), cA + hstep, voffA);
        if (wr == 1) PG8_BAR;
        PG8_WAIT_V(2); PG8_BAR;
        PG8_STAGE(PG8_SB(1, 0), cB + kstep, voffB); PG8_STAGE(PG8_SA(1, 0), cA + kstep, voffA); PG8_STAGE(PG8_SB(1, 1), cB + hstep + kstep, voffB);
        PG8_WAIT_V(6); PG8_BAR;
    } else {
        PG8_STAGE(PG8_SB(0, 0), cB, voffB); PG8_STAGE(PG8_SA(0, 0), cA, voffA); PG8_STAGE(PG8_SB(0, 1), cB + hstep, voffB); PG8_STAGE(PG8_SA(0, 1), cA + hstep, voffA);
        if (wr == 1) PG8_BAR;
        PG8_WAIT_V(4); PG8_BAR;
        PG8_STAGE(PG8_SB(1, 0), cB + kstep, voffB); PG8_STAGE(PG8_SA(1, 0), cA + kstep, voffA); PG8_STAGE(PG8_SB(1, 1), cB + hstep + kstep, voffB);
        PG8_WAIT_V(6); PG8_BAR;
    }
    for (;;) {
        const bool has_next = S.next(ui + 1, nxt);
        const char* nA = has_next ? (const char*)g.A + (size_t)nxt.pm * tstep : cA; const char* nB = has_next ? (const char*)g.Bt + (size_t)nxt.pn * tstep : cB;
        for (int t = 0; t < nt; t += 2) {
            const bool last = (t == nt - 2);
            const char* a1 = cA + (size_t)(t + 1) * kstep;
            const char* a2 = last ? nA : cA + (size_t)(t + 2) * kstep; const char* b2 = last ? nB : cB + (size_t)(t + 2) * kstep;
            const char* a3 = a2 + kstep; const char* b3 = b2 + kstep;
            if (last && has_next) S.a_ready(nxt);
            if constexpr (SP2) {
            PG8_LDB(B0, 0, 0); PG8_LDB(B1, 0, 1); PG8_SCHED; PG8_LDA(At, 0, 0); PG8_STAGE(PG8_SA(1, 1), a1 + hstep, voffA);
            PG8_WAIT_V(8); PG8_WAIT_L(0); PG8_BAR; PG8_MMA(0, 0, At, B0); PG8_MMA(0, 1, At, B1); PG8_BAR; PG8_SCHED;
            PG8_LDA(At, 0, 1); PG8_STAGE(PG8_SB(0, 0), b2, voffB); PG8_STAGE(PG8_SB(0, 1), b2 + hstep, voffB); PG8_STAGE(PG8_SA(0, 0), a2, voffA);
            PG8_WAIT_V(8); PG8_WAIT_L(0); PG8_BAR; PG8_MMA(1, 0, At, B0); PG8_MMA(1, 1, At, B1); PG8_BAR; PG8_SCHED;
            PG8_LDB(B0, 1, 0); PG8_LDB(B1, 1, 1); PG8_SCHED; PG8_LDA(At, 1, 0); PG8_STAGE(PG8_SA(0, 1), a2 + hstep, voffA);
            PG8_WAIT_V(8); PG8_WAIT_L(0); PG8_BAR; PG8_MMA(0, 0, At, B0); PG8_MMA(0, 1, At, B1); PG8_BAR; PG8_SCHED;
            PG8_LDA(At, 1, 1); PG8_STAGE(PG8_SB(1, 0), b3, voffB); PG8_STAGE(PG8_SB(1, 1), b3 + hstep, voffB); PG8_STAGE(PG8_SA(1, 0), a3, voffA);
            PG8_WAIT_V(8); PG8_WAIT_L(0); PG8_BAR; PG8_MMA(1, 0, At, B0); PG8_MMA(1, 1, At, B1); PG8_BAR; PG8_SCHED;
            } else {
            PG8_LDB(B0, 0, 0); PG8_SCHED; PG8_LDA(At, 0, 0); PG8_STAGE(PG8_SA(1, 1), a1 + hstep, voffA);
            PG8_WAIT_L(8); PG8_BAR; PG8_WAIT_L(0); PG8_MMA(0, 0, At, B0); PG8_BAR; PG8_SCHED;
            PG8_LDB(B1, 0, 1); PG8_STAGE(PG8_SB(0, 0), b2, voffB);
            PG8_BAR; PG8_WAIT_L(0); PG8_MMA(0, 1, At, B1); PG8_BAR;
            PG8_LDA(At, 0, 1); PG8_STAGE(PG8_SA(0, 0), a2, voffA);
            PG8_BAR; PG8_WAIT_L(0); PG8_MMA(1, 0, At, B0); PG8_BAR; PG8_SCHED;
            PG8_STAGE(PG8_SB(0, 1), b2 + hstep, voffB);
            PG8_WAIT_V(6); PG8_BAR; PG8_MMA(1, 1, At, B1); PG8_BAR;
            PG8_LDB(B0, 1, 0); PG8_SCHED; PG8_LDA(At, 1, 0); PG8_STAGE(PG8_SA(0, 1), a2 + hstep, voffA);
            PG8_WAIT_L(8); PG8_BAR; PG8_WAIT_L(0); PG8_MMA(0, 0, At, B0); PG8_BAR; PG8_SCHED;
            PG8_LDB(B1, 1, 1); PG8_STAGE(PG8_SB(1, 0), b3, voffB);
            PG8_BAR; PG8_WAIT_L(0); PG8_MMA(0, 1, At, B1); PG8_BAR;
            PG8_LDA(At, 1, 1); PG8_STAGE(PG8_SA(1, 0), a3, voffA);
            PG8_BAR; PG8_WAIT_L(0); PG8_MMA(1, 0, At, B0); PG8_BAR; PG8_SCHED;
            PG8_STAGE(PG8_SB(1, 1), b3 + hstep, voffB);
            PG8_WAIT_V(6); PG8_BAR; PG8_MMA(1, 1, At, B1); PG8_BAR;
            }
        }
        if constexpr (ALIGN_EPI) { if (wr == 0) PG8_BAR; }
        if constexpr (!Epi::AFTER_DRAIN) { E(acc, cur, wr, wc, fr, fq); S.done(cur); }
        if (!has_next) break;
#pragma unroll
        for (int a = 0; a < 2; ++a)
#pragma unroll
            for (int b = 0; b < 2; ++b)
#pragma unroll
                for (int m = 0; m < 4; ++m)
#pragma unroll
                    for (int n = 0; n < 2; ++n) acc[a][b][m][n] = (f32x4){0.f, 0.f, 0.f, 0.f};
        cur = nxt; cA = nA; cB = nB; ++ui;
        if constexpr (ALIGN_EPI) { if (wr == 1) PG8_BAR; }
    }
    PG8_WAIT_V(0);
    if constexpr (!ALIGN_EPI) { if (wr == 0) PG8_BAR; }
    PG8_BAR;
    if constexpr (Epi::AFTER_DRAIN) { E.fused(acc, cur, wr, wc, fr, fq, lds, wid, lane); S.done(cur); }
#undef PG8_SA
#undef PG8_SB
#undef PG8_STAGE
#undef PG8_LDA
#undef PG8_LDB
#undef PG8_MMA
#undef PG8_WAIT_V
#undef PG8_WAIT_L
#undef PG8_BAR
#undef PG8_SCHED
}
}
#define LAS __attribute__((address_space(3)))
typedef unsigned v4u __attribute__((ext_vector_type(4)));
typedef float f32x4 __attribute__((ext_vector_type(4)));
typedef short bf16x8 __attribute__((ext_vector_type(8)));
#define LDS_WAIT() asm volatile("s_waitcnt lgkmcnt(0)" ::: "memory")
constexpr int NWAVES = 8;
constexpr int LDS_BYTES = 147456;
constexpr int MISC_OFF = 147456 - 128;

struct Params { const float* in[26]; float* out; unsigned char* ws; int ph_lo, ph_hi, rep, pad; };

DEV float wave_sum(float v) {
#pragma unroll
  for (int o = 1; o < 64; o <<= 1) v += __shfl_xor(v, o);
  return v;
}

DEV int w1_dest_row(int n) {
  if (n < 1024) return n;
  if (n < 2560) return 2048 + (n - 1024);
  if (n < 2592) return 5632 + (n - 2560);
  if (n < 3104) return 3584 + (n - 2592);
  if (n < 3616) return 4096 + (n - 3104);
  if (n < 4640) return 4608 + (n - 3616);
  if (n < 5664) return 1024 + (n - 4640);
  return n;
}
DEV void transpose_item(const float* W, int K, int N, int k0, int n0, bf16_t* WT, int drow0, LAS float* scr, int lane) {
#pragma unroll 8
  for (int i = 0; i < 32; ++i) { const int kk = 2 * i + (lane >> 5); scr[kk * 33 + (lane & 31)] = W[(size_t)(k0 + kk) * N + n0 + (lane & 31)]; }
  LDS_WAIT(); asm volatile("" ::: "memory");
  const int c = lane & 7;
#pragma unroll
  for (int j = 0; j < 4; ++j) { const int n = (lane >> 3) + 8 * j; const LAS float* s = scr + (8 * c) * 33 + n;
    v4u o; o.x = pk2(s[0 * 33], s[1 * 33]); o.y = pk2(s[2 * 33], s[3 * 33]); o.z = pk2(s[4 * 33], s[5 * 33]); o.w = pk2(s[6 * 33], s[7 * 33]);
    *(v4u*)(WT + (size_t)(drow0 + n) * K + k0 + 8 * c) = o; }
  LDS_WAIT(); asm volatile("" ::: "memory");
}
DEV void prologue_phase(const Params& p, LAS unsigned char* lds) {
  const int tid = threadIdx.x, lane = tid & 63, wave = tid >> 6;
  unsigned char* ws = p.ws;
  float* MOD = (float*)(ws + WS_MOD);
  {
    LAS float* sc = (LAS float*)lds;
    LAS float* part = (LAS float*)(lds + 12288);
    for (int i = tid; i < 3072; i += 512) { const int v = i >> 10, k = i & 1023; const float cv = v < 2 ? p.in[1][v * 1024 + k] : p.in[3][k]; sc[i] = siluf(cv); }
    __syncthreads();
    for (int task = blockIdx.x; task < 96; task += gridDim.x) {
      const int l = task / 48, n0 = (task % 48) * 64; const float* w = l ? p.in[19] : p.in[5]; const float* bb = l ? p.in[20] : p.in[6];
      const int col = tid & 63, ks = tid >> 6;
      float a0 = 0.f, a1 = 0.f, a2 = 0.f;
#pragma unroll 8
      for (int k = ks * 128; k < ks * 128 + 128; ++k) { const float wv = w[(size_t)k * 3072 + n0 + col]; a0 += sc[k] * wv; a1 += sc[1024 + k] * wv; a2 += sc[2048 + k] * wv; }
      part[(ks * 3 + 0) * 64 + col] = a0; part[(ks * 3 + 1) * 64 + col] = a1; part[(ks * 3 + 2) * 64 + col] = a2;
      __syncthreads();
      if (tid < 192) { const int v = tid >> 6; float s = bb[n0 + col];
#pragma unroll
        for (int q = 0; q < 8; ++q) s += part[(q * 3 + v) * 64 + col];
        MOD[(l * 3 + v) * 3072 + n0 + col] = s; }
      __syncthreads();
    }
  }
  if (blockIdx.x == gridDim.x - 1) { float* rope = (float*)(ws + WS_ROPE);
    for (int idx = tid; idx < 4096; idx += 512) { const int pos = idx >> 5, f = idx & 31; const float inv = 1.0f / powf(10000.f, (float)f / 32.f); const float ang = (float)pos * inv; rope[idx] = cosf(ang); rope[4096 + idx] = sinf(ang); } }
  { v4u* z = (v4u*)(ws + WS_W1T + (size_t)E_IN * 1024 * 2); const v4u zero = {0u, 0u, 0u, 0u};
    for (int i = blockIdx.x * 512 + tid; i < (E_INP - E_IN) * 1024 * 2 / 16; i += gridDim.x * 512) z[i] = zero; }
  __syncthreads();
  {
    LAS float* scr = (LAS float*)(lds + wave * 16384);
    const int gw = blockIdx.x * NWAVES + wave, NGW = gridDim.x * NWAVES;
    constexpr int I1 = 16 * 178, I2 = 32 * 32, I3 = 16 * 160, I4 = 32 * 32;
    for (int it = gw; it < I1 + I2 + I3 + I4; it += NGW) {
      int r = it;
      if (r < I1) { const int kb = r / 178, nb = r % 178; transpose_item(p.in[7], 1024, E_IN, 64 * kb, 32 * nb, (bf16_t*)(ws + WS_W1T), w1_dest_row(32 * nb), scr, lane); continue; } r -= I1;
      if (r < I2) { const int kb = r / 32, nb = r % 32; transpose_item(p.in[17], 2048, 1024, 64 * kb, 32 * nb, (bf16_t*)(ws + WS_W2T), 32 * nb, scr, lane); continue; } r -= I2;
      if (r < I3) { const int kb = r / 160, nb = r % 160; transpose_item(p.in[21], 1024, O_IN, 64 * kb, 32 * nb, (bf16_t*)(ws + WS_W3T), 32 * nb, scr, lane); continue; } r -= I3;
      { const int kb = r / 32, nb = r % 32; transpose_item(p.in[25], 2048, 1024, 64 * kb, 32 * nb, (bf16_t*)(ws + WS_W4T), 32 * nb, scr, lane); }
    }
  }
}
DEV void prep_phase(const float* xlat, const float* xctx, const float* g, const float* mod, bf16_t* H) {
  const int lane = threadIdx.x & 63, wave = threadIdx.x >> 6;
  for (int row = blockIdx.x * NWAVES + wave; row < MA; row += gridDim.x * NWAVES) {
    const float* src = row < ML ? xlat + (size_t)row * D : xctx + (size_t)(row - ML) * D;
    const float* m = mod + row_vec(row) * 3072;
    f32x4 v[4]; float ss = 0.f;
#pragma unroll
    for (int j = 0; j < 4; ++j) { v[j] = *(const f32x4*)(src + 4 * lane + 256 * j); ss += (v[j].x * v[j].x + v[j].y * v[j].y) + (v[j].z * v[j].z + v[j].w * v[j].w); }
    const float rstd = rsqrtf(wave_sum(ss) * (1.f / D) + EPS);
#pragma unroll
    for (int j = 0; j < 4; ++j) { const int k = 4 * lane + 256 * j;
      const f32x4 gg = *(const f32x4*)(g + k), sc = *(const f32x4*)(m + 1024 + k), sh = *(const f32x4*)(m + k);
      const f32x4 o = v[j] * rstd * gg * (sc + 1.f) + sh;
      *(unsigned long long*)(H + (size_t)row * D + k) = (unsigned long long)pk2(o.x, o.y) | ((unsigned long long)pk2(o.z, o.w) << 32); }
  }
}
template <class F> DEV void small_gemm(const bf16_t* A, int lda, const bf16_t* Bt, int ldb, int K, int Mrows, int Ncols, F f) {
  const int lane = threadIdx.x & 63, wid = threadIdx.x >> 6, mt = wid >> 2, nt = wid & 3, r = lane & 15, q = lane >> 4;
  const int ntn = Ncols / 64, ntasks = (Mrows / 32) * ntn;
  for (int task = blockIdx.x; task < ntasks; task += gridDim.x) {
    const int row0 = (task / ntn) * 32 + mt * 16, col0 = (task % ntn) * 64 + nt * 16;
    const bf16_t* ap = A + (size_t)(row0 + r) * lda + 8 * q; const bf16_t* bp = Bt + (size_t)(col0 + r) * ldb + 8 * q;
    f32x4 acc = {0.f, 0.f, 0.f, 0.f};
#pragma unroll 8
    for (int k = 0; k < K; k += 32) { const bf16x8 a = *(const bf16x8*)(ap + k), b = *(const bf16x8*)(bp + k); acc = __builtin_amdgcn_mfma_f32_16x16x32_bf16(a, b, acc, 0, 0, 0); }
#pragma unroll
    for (int j = 0; j < 4; ++j) f(row0 + q * 4 + j, col0 + r, acc[j]);
  }
}

DEV void qknorm_phase(bf16_t* Q1, bf16_t* K1, const float* qn, const float* kn, const float* rope, bool wr) {
  const int lane = threadIdx.x & 63, wave = threadIdx.x >> 6, hl = lane >> 4, d0 = (lane & 15) * 8;
  const float scale = 0.08838834764831845f;
  float gq[8], gk[8];
#pragma unroll
  for (int e = 0; e < 8; ++e) { gq[e] = qn[d0 + e] * scale; gk[e] = kn[d0 + e]; }
  const int ax = d0 >> 6, sgn = (d0 >> 5) & 1, f0 = d0 & 31;
  for (int row = blockIdx.x * NWAVES + wave; row < MA; row += gridDim.x * NWAVES) {
    const bool lat = row < ML;
    v4u raw[5];
    raw[0] = *(const v4u*)(K1 + (size_t)row * 512 + hl * 128 + d0);
    if (lat) {
#pragma unroll
      for (int g = 0; g < 4; ++g) raw[1 + g] = *(const v4u*)(Q1 + (size_t)row * 2048 + (g * 4 + hl) * 128 + d0);
    }
    float cs[8], sn[8];
    if (lat) { const int t = row % SEQ, pos = ax ? (t & 63) : (t >> 6);
      const f32x4 c0 = *(const f32x4*)(rope + pos * 32 + f0), c1 = *(const f32x4*)(rope + pos * 32 + f0 + 4), s0 = *(const f32x4*)(rope + 4096 + pos * 32 + f0), s1 = *(const f32x4*)(rope + 4096 + pos * 32 + f0 + 4);
      cs[0] = c0.x; cs[1] = c0.y; cs[2] = c0.z; cs[3] = c0.w; cs[4] = c1.x; cs[5] = c1.y; cs[6] = c1.z; cs[7] = c1.w;
      sn[0] = s0.x; sn[1] = s0.y; sn[2] = s0.z; sn[3] = s0.w; sn[4] = s1.x; sn[5] = s1.y; sn[6] = s1.z; sn[7] = s1.w; }
    const int ng = lat ? 5 : 1;
#pragma unroll
    for (int g = 0; g < 5; ++g) {
      if (g < ng) {
        const v4u rv = raw[g];
        float v[8] = {__uint_as_float(rv.x << 16), __uint_as_float(rv.x & 0xffff0000u), __uint_as_float(rv.y << 16), __uint_as_float(rv.y & 0xffff0000u), __uint_as_float(rv.z << 16), __uint_as_float(rv.z & 0xffff0000u), __uint_as_float(rv.w << 16), __uint_as_float(rv.w & 0xffff0000u)};
        float ss = 0.f;
#pragma unroll
        for (int e = 0; e < 8; ++e) ss += v[e] * v[e];
        ss += __shfl_xor(ss, 1); ss += __shfl_xor(ss, 2); ss += __shfl_xor(ss, 4); ss += __shfl_xor(ss, 8);
        const float rstd = rsqrtf(ss * (1.f / 128.f) + EPS);
#pragma unroll
        for (int e = 0; e < 8; ++e) v[e] *= rstd * (g == 0 ? gk[e] : gq[e]);
        if (lat) {
#pragma unroll
          for (int e = 0; e < 8; ++e) { const float o = __shfl_xor(v[e], 4); v[e] = sgn ? (v[e] * cs[e] + o * sn[e]) : (v[e] * cs[e] - o * sn[e]); }
        }
        v4u ov; ov.x = pk2(v[0], v[1]); ov.y = pk2(v[2], v[3]); ov.z = pk2(v[4], v[5]); ov.w = pk2(v[6], v[7]);
        if (wr) { if (g == 0) *(v4u*)(K1 + (size_t)row * 512 + hl * 128 + d0) = ov; else *(v4u*)(Q1 + (size_t)row * 2048 + ((g - 1) * 4 + hl) * 128 + d0) = ov; }
      }
    }
  }
}
typedef short s16x4 __attribute__((ext_vector_type(4)));
DEV s16x4 tr_read(const LAS bf16_t* p) { return __builtin_bit_cast(s16x4, __builtin_amdgcn_ds_read_tr16_b64_v4i16((LAS s16x4*)p)); }
DEV void attn_phase(bf16_t* Q1, const bf16_t* K1, const bf16_t* V1, const bf16_t* G1, const float* sink, const float* qn, const float* kn, LAS unsigned char* lds, bool wr) {
  constexpr int KP = 136, VP = 144;
  LAS bf16_t* Ks = (LAS bf16_t*)lds;
  LAS bf16_t* Vs = (LAS bf16_t*)(lds + 2 * 64 * KP * 2);
  LAS float* dsc = (LAS float*)(lds + 2 * 64 * KP * 2 + 2 * 64 * VP * 2);
  const int tid = threadIdx.x, lane = tid & 63, wid = tid >> 6, r = lane & 15, Qd = lane >> 4;
  float mb;
  { float a = fmaxf(fabsf(qn[lane]), fabsf(qn[64 + lane])), b = fmaxf(fabsf(kn[lane]), fabsf(kn[64 + lane]));
#pragma unroll
    for (int o = 1; o < 64; o <<= 1) { a = fmaxf(a, __shfl_xor(a, o)); b = fmaxf(b, __shfl_xor(b, o)); }
    mb = a * b * 11.313708498984761f; }
  for (int task = blockIdx.x; task < 1024; task += gridDim.x) {
    const int b = task >> 9, kvh = (task >> 7) & 3, qt = task & 127;
    const int hq = kvh * 4 + (wid >> 1), qoff = (wid & 1) * 32;
    const size_t qrow0 = (size_t)b * SEQ + qt * 64 + qoff;
    bf16x8 qf[2][4];
#pragma unroll
    for (int m = 0; m < 2; ++m)
#pragma unroll
      for (int ks = 0; ks < 4; ++ks) qf[m][ks] = *(const bf16x8*)(Q1 + (qrow0 + 16 * m + r) * 2048 + hq * 128 + ks * 32 + 8 * Qd);
    const int tlo = (2 - qt) > 0 ? (2 - qt) : 0, thi = (129 - qt) < 4 ? (129 - qt) : 4, nband = thi - tlo + 1, ntile = nband + 4;
    const int skey = tid >> 4, sch = tid & 15;
    v4u kreg[2], vreg[2];
#define TILE_ROW0(i) ((i) < nband ? (size_t)b * SEQ + (size_t)(qt - 2 + tlo + (i)) * 64 : (size_t)ML + b * CTXL + ((i) - nband) * 64)
#define LOAD_TILE(i) do { const size_t r0_ = TILE_ROW0(i); _Pragma("unroll") for (int h_ = 0; h_ < 2; ++h_) { const size_t go_ = (r0_ + skey + 32 * h_) * 512 + kvh * 128 + sch * 8; kreg[h_] = *(const v4u*)(K1 + go_); vreg[h_] = *(const v4u*)(V1 + go_); } } while (0)
#define STORE_TILE(buf) do { _Pragma("unroll") for (int h_ = 0; h_ < 2; ++h_) { *(LAS v4u*)(Ks + (buf) * 64 * KP + (skey + 32 * h_) * KP + sch * 8) = kreg[h_]; *(LAS v4u*)(Vs + (buf) * 64 * VP + (skey + 32 * h_) * VP + sch * 8) = vreg[h_]; } } while (0)
    LOAD_TILE(0);
    __syncthreads();
    STORE_TILE(0);
    __syncthreads();
    f32x4 o[2][8];
#pragma unroll
    for (int m = 0; m < 2; ++m)
#pragma unroll
      for (int n = 0; n < 8; ++n) o[m][n] = (f32x4){0.f, 0.f, 0.f, 0.f};
    float lsum[2] = {0.f, 0.f};
    for (int i = 0; i < ntile; ++i) {
      const int buf = i & 1;
      if (i + 1 < ntile) LOAD_TILE(i + 1);
      const int mtype = (i < nband) ? ((tlo + i) == 0 ? 1 : ((tlo + i) == 4 ? 2 : 0)) : 0;
      const LAS bf16_t* Kb = Ks + buf * 64 * KP; const LAS bf16_t* Vb = Vs + buf * 64 * VP;
      f32x4 s[4][2];
#pragma unroll
      for (int t = 0; t < 4; ++t) { s[t][0] = (f32x4){0.f, 0.f, 0.f, 0.f}; s[t][1] = (f32x4){0.f, 0.f, 0.f, 0.f}; }
#pragma unroll
      for (int ks = 0; ks < 4; ++ks)
#pragma unroll
        for (int t = 0; t < 4; ++t) { const bf16x8 kf = *(const LAS bf16x8*)(Kb + (16 * t + r) * KP + ks * 32 + 8 * Qd);
          s[t][0] = __builtin_amdgcn_mfma_f32_16x16x32_bf16(kf, qf[0][ks], s[t][0], 0, 0, 0);
          s[t][1] = __builtin_amdgcn_mfma_f32_16x16x32_bf16(kf, qf[1][ks], s[t][1], 0, 0, 0); }
      bf16x8 pa[2][2];
#pragma unroll
      for (int m = 0; m < 2; ++m) { const int qi = qoff + 16 * m + r;
#pragma unroll
        for (int t = 0; t < 4; ++t) {
          float pv[4];
#pragma unroll
          for (int j = 0; j < 4; ++j) { const int kj = 16 * t + 4 * Qd + j; float pj = __expf(s[t][m][j] - mb);
            if (mtype == 1) pj = (kj >= qi) ? pj : 0.f; else if (mtype == 2) pj = (kj <= qi) ? pj : 0.f;
            pv[j] = pj; lsum[m] += pj; }
          const unsigned w0 = pk2(pv[0], pv[1]), w1 = pk2(pv[2], pv[3]);
          pa[m][t >> 1][(t & 1) * 4 + 0] = (short)(w0 & 0xffff); pa[m][t >> 1][(t & 1) * 4 + 1] = (short)(w0 >> 16);
          pa[m][t >> 1][(t & 1) * 4 + 2] = (short)(w1 & 0xffff); pa[m][t >> 1][(t & 1) * 4 + 3] = (short)(w1 >> 16); } }
#pragma unroll
      for (int k2 = 0; k2 < 2; ++k2)
#pragma unroll
        for (int n = 0; n < 8; ++n) {
          const s16x4 lo = tr_read(Vb + (32 * k2 + 4 * Qd + (r >> 2)) * VP + 16 * n + 4 * (r & 3));
          const s16x4 hi = tr_read(Vb + (32 * k2 + 16 + 4 * Qd + (r >> 2)) * VP + 16 * n + 4 * (r & 3));
          const bf16x8 vf = (bf16x8){lo[0], lo[1], lo[2], lo[3], hi[0], hi[1], hi[2], hi[3]};
          o[0][n] = __builtin_amdgcn_mfma_f32_16x16x32_bf16(pa[0][k2], vf, o[0][n], 0, 0, 0);
          o[1][n] = __builtin_amdgcn_mfma_f32_16x16x32_bf16(pa[1][k2], vf, o[1][n], 0, 0, 0); }
      if (i + 1 < ntile) STORE_TILE(buf ^ 1);
      __syncthreads();
    }
#undef TILE_ROW0
#undef LOAD_TILE
#undef STORE_TILE
    const float sk = __expf(sink[hq] - mb);
#pragma unroll
    for (int m = 0; m < 2; ++m) { float l = lsum[m]; l += __shfl_xor(l, 16); l += __shfl_xor(l, 32); if (Qd == 0) dsc[wid * 32 + 16 * m + r] = 1.f / (l + sk); }
    LDS_WAIT(); asm volatile("" ::: "memory");
#pragma unroll
    for (int m = 0; m < 2; ++m)
#pragma unroll
      for (int j = 0; j < 4; ++j) { const float inv = dsc[wid * 32 + 16 * m + 4 * Qd + j]; const size_t ro = (qrow0 + 16 * m + 4 * Qd + j) * 2048 + hq * 128 + r;
#pragma unroll
        for (int n = 0; n < 8; ++n) { const bf16_t ov_ = f2bf(o[m][n][j] * inv * bf2f(G1[ro + 16 * n])); if (wr) Q1[ro + 16 * n] = ov_; } }
    LDS_WAIT(); asm volatile("" ::: "memory");
  }
}

constexpr size_t DO_SDT = 50 * MiB, DO_SCS = 53 * MiB;
constexpr size_t WS_SSQ = 237 * MiB;
DEV unsigned short bfbits(float f) { return f2bf(f); }
DEV void ssd_prep_phase(const bf16_t* XBC, const float* cw, const float* cb, bf16_t* XC, const float* DTLR, const float* dt_bias, const float* a_log, float* SDT, float* SCS, float* SDEC) {
  const int gtid = blockIdx.x * 512 + threadIdx.x, gth = gridDim.x * 512;
  for (int it = gtid; it < MA * 192; it += gth) {
    const int row = it / 192, c8 = (it % 192) * 8;
    int t, len;
    if (row < ML) { t = row % SEQ; len = SEQ; } else { t = (row - ML) % CTXL; len = CTXL; }
    float acc[8];
    { const f32x4 b0 = *(const f32x4*)(cb + c8), b1 = *(const f32x4*)(cb + c8 + 4); acc[0] = b0.x; acc[1] = b0.y; acc[2] = b0.z; acc[3] = b0.w; acc[4] = b1.x; acc[5] = b1.y; acc[6] = b1.z; acc[7] = b1.w; }
#pragma unroll
    for (int k = 0; k < 5; ++k) { const int tt = t + k - 2;
      if (tt >= 0 && tt < len) { const v4u xv = *(const v4u*)(XBC + (size_t)(row + k - 2) * 1536 + c8); const f32x4 w0 = *(const f32x4*)(cw + k * 1536 + c8), w1 = *(const f32x4*)(cw + k * 1536 + c8 + 4);
        acc[0] += w0.x * __uint_as_float(xv.x << 16); acc[1] += w0.y * __uint_as_float(xv.x & 0xffff0000u); acc[2] += w0.z * __uint_as_float(xv.y << 16); acc[3] += w0.w * __uint_as_float(xv.y & 0xffff0000u);
        acc[4] += w1.x * __uint_as_float(xv.z << 16); acc[5] += w1.y * __uint_as_float(xv.z & 0xffff0000u); acc[6] += w1.z * __uint_as_float(xv.w << 16); acc[7] += w1.w * __uint_as_float(xv.w & 0xffff0000u); } }
    v4u o; o.x = pk2(silu_fast(acc[0]), silu_fast(acc[1])); o.y = pk2(silu_fast(acc[2]), silu_fast(acc[3])); o.z = pk2(silu_fast(acc[4]), silu_fast(acc[5])); o.w = pk2(silu_fast(acc[6]), silu_fast(acc[7]));
    *(v4u*)(XC + (size_t)row * 1536 + c8) = o;
  }
  {
    const int lane = threadIdx.x & 63, wave = threadIdx.x >> 6, cl = lane & 7, seg = lane >> 3;
    for (int wt = blockIdx.x * NWAVES + wave; wt < NCH * 4; wt += gridDim.x * NWAVES) {
      const int gc = wt >> 2, col = (wt & 3) * 8 + cl, dir = col >> 4, h = col & 15;
      const float a = -__expf(a_log[col]), bias = dt_bias[col];
      float dtv[16], v[16]; float run = 0.f;
#pragma unroll
      for (int u = 0; u < 16; ++u) { const int s = seg * 16 + u, t = dir ? 127 - s : s; dtv[u] = softplusf(DTLR[((size_t)gc * 128 + t) * 64 + col] + bias); }
#pragma unroll
      for (int u = 0; u < 16; ++u) { run += dtv[u] * a; v[u] = run; }
      float off = 0.f;
#pragma unroll
      for (int sgi = 0; sgi < 7; ++sgi) { const float tot = __shfl(run, cl + 8 * sgi); off += (sgi < seg) ? tot : 0.f; }
#pragma unroll
      for (int u = 0; u < 16; ++u) { const int s = seg * 16 + u, t = dir ? 127 - s : s; const size_t row = (size_t)gc * 128 + t; SDT[row * 32 + col] = dtv[u]; SCS[row * 32 + col] = v[u] + off; }
      if (seg == 7) SDEC[(gc * 16 + h) * 2 + dir] = __expf(run + off);
    }
  }
}
DEV void ssd_u_phase(const bf16_t* XC, const float* SDT, const float* SCS, bf16_t* ST, LAS unsigned char* lds) {
  constexpr int XP = 272, BP = 144;
  LAS bf16_t* Xs = (LAS bf16_t*)lds; LAS bf16_t* Bs = (LAS bf16_t*)(lds + 128 * XP * 2); LAS float* wtab = (LAS float*)(lds + 128 * XP * 2 + 128 * BP * 2);
  const int tid = threadIdx.x, lane = tid & 63, wid = tid >> 6, r = lane & 15, Qd = lane >> 4, hl = wid >> 1, dir = wid & 1;
  for (int task = blockIdx.x; task < NCH * 4; task += gridDim.x) {
    const int gc = task >> 2, g = (task >> 1) & 1, hh = task & 1; const size_t r0 = (size_t)gc * 128; const int h0 = g * 8 + hh * 4;
    __syncthreads();
#pragma unroll
    for (int i = 0; i < 8; ++i) { const int cid = tid + 512 * i, row = cid >> 5, ch = cid & 31; *(LAS v4u*)(Xs + row * XP + ch * 8) = *(const v4u*)(XC + (r0 + row) * 1536 + h0 * 64 + ch * 8); }
#pragma unroll
    for (int i = 0; i < 4; ++i) { const int cid = tid + 512 * i, row = cid >> 4, ch = cid & 15; *(LAS v4u*)(Bs + row * BP + ch * 8) = *(const v4u*)(XC + (r0 + row) * 1536 + 1024 + g * 128 + ch * 8); }
#pragma unroll
    for (int i = 0; i < 2; ++i) { const int e = tid + 512 * i, combo = e >> 7, t = e & 127, col = (combo & 1) * 16 + h0 + (combo >> 1);
      const float cs_end = SCS[(r0 + ((combo & 1) ? 0 : 127)) * 32 + col]; wtab[e] = __expf(cs_end - SCS[(r0 + t) * 32 + col]) * SDT[(r0 + t) * 32 + col]; }
    __syncthreads();
    const LAS float* wt = wtab + wid * 128;
    bf16_t* Sp = ST + ((((size_t)gc * 16 + h0 + hl) * 2 + dir) * 64) * 128;
#pragma unroll 1
    for (int pp = 0; pp < 2; ++pp) {
      f32x4 acc[8][2];
#pragma unroll
      for (int nt = 0; nt < 8; ++nt) { acc[nt][0] = (f32x4){0.f, 0.f, 0.f, 0.f}; acc[nt][1] = (f32x4){0.f, 0.f, 0.f, 0.f}; }
#pragma unroll 1
      for (int k = 0; k < 4; ++k) {
        const f32x4 wlo = *(const LAS f32x4*)(wt + 32 * k + 4 * Qd), whi = *(const LAS f32x4*)(wt + 32 * k + 16 + 4 * Qd);
        bf16x8 xf[2];
#pragma unroll
        for (int pt = 0; pt < 2; ++pt) {
          const s16x4 lo = tr_read(Xs + (32 * k + 4 * Qd + (r >> 2)) * XP + hl * 64 + 32 * pp + 16 * pt + 4 * (r & 3));
          const s16x4 hi = tr_read(Xs + (32 * k + 16 + 4 * Qd + (r >> 2)) * XP + hl * 64 + 32 * pp + 16 * pt + 4 * (r & 3));
          const unsigned w0 = pk2(bf2f((bf16_t)lo[0]) * wlo[0], bf2f((bf16_t)lo[1]) * wlo[1]), w1 = pk2(bf2f((bf16_t)lo[2]) * wlo[2], bf2f((bf16_t)lo[3]) * wlo[3]);
          const unsigned w2 = pk2(bf2f((bf16_t)hi[0]) * whi[0], bf2f((bf16_t)hi[1]) * whi[1]), w3 = pk2(bf2f((bf16_t)hi[2]) * whi[2], bf2f((bf16_t)hi[3]) * whi[3]);
          xf[pt] = (bf16x8){(short)(w0 & 0xffff), (short)(w0 >> 16), (short)(w1 & 0xffff), (short)(w1 >> 16), (short)(w2 & 0xffff), (short)(w2 >> 16), (short)(w3 & 0xffff), (short)(w3 >> 16)};
        }
#pragma unroll
        for (int nt = 0; nt < 8; ++nt) {
          const s16x4 lo = tr_read(Bs + (32 * k + 4 * Qd + (r >> 2)) * BP + 16 * nt + 4 * (r & 3));
          const s16x4 hi = tr_read(Bs + (32 * k + 16 + 4 * Qd + (r >> 2)) * BP + 16 * nt + 4 * (r & 3));
          const bf16x8 bfr = (bf16x8){lo[0], lo[1], lo[2], lo[3], hi[0], hi[1], hi[2], hi[3]};
          acc[nt][0] = __builtin_amdgcn_mfma_f32_16x16x32_bf16(bfr, xf[0], acc[nt][0], 0, 0, 0);
          acc[nt][1] = __builtin_amdgcn_mfma_f32_16x16x32_bf16(bfr, xf[1], acc[nt][1], 0, 0, 0);
        }
      }
#pragma unroll
      for (int nt = 0; nt < 8; ++nt)
#pragma unroll
        for (int pt = 0; pt < 2; ++pt) { const f32x4 v = acc[nt][pt];
          *(unsigned long long*)(Sp + (size_t)(32 * pp + 16 * pt + r) * 128 + 16 * nt + 4 * Qd) = (unsigned long long)pk2(v[0], v[1]) | ((unsigned long long)pk2(v[2], v[3]) << 32); }
    }
  }
}
DEV void ssd_scan_phase(bf16_t* ST, const float* SDEC, bool wr) {
  for (int item = blockIdx.x * 512 + threadIdx.x; item < 2 * 16 * 2 * 2048; item += gridDim.x * 512) {
    const int e4 = item & 2047, dir = (item >> 11) & 1, h = (item >> 12) & 15, b = item >> 16;
    float S0 = 0.f, S1 = 0.f, S2 = 0.f, S3 = 0.f;
#define SCAN_GC(s) (!dir ? ((s) < 2 ? 128 + 2 * b + (s) : b * 64 + ((s) - 2)) : ((s) < 2 ? 128 + 2 * b + (1 - (s)) : b * 64 + (65 - (s))))
    for (int s0 = 0; s0 < 66; s0 += 6) {
      unsigned long long u[6]; float dec[6];
#pragma unroll
      for (int q = 0; q < 6; ++q) { const int gc = SCAN_GC(s0 + q); u[q] = *(const unsigned long long*)(ST + (((size_t)gc * 16 + h) * 2 + dir) * 8192 + e4 * 4); dec[q] = SDEC[(gc * 16 + h) * 2 + dir]; }
#pragma unroll
      for (int q = 0; q < 6; ++q) { const int gc = SCAN_GC(s0 + q);
        if (wr) *(unsigned long long*)(ST + (((size_t)gc * 16 + h) * 2 + dir) * 8192 + e4 * 4) = (unsigned long long)pk2(S0, S1) | ((unsigned long long)pk2(S2, S3) << 32);
        const unsigned lo = (unsigned)u[q], hi = (unsigned)(u[q] >> 32);
        S0 = dec[q] * S0 + __uint_as_float(lo << 16); S1 = dec[q] * S1 + __uint_as_float(lo & 0xffff0000u); S2 = dec[q] * S2 + __uint_as_float(hi << 16); S3 = dec[q] * S3 + __uint_as_float(hi & 0xffff0000u); }
    }
#undef SCAN_GC
  }
}
DEV bf16x8 scale_frag(bf16x8 f, float s) {
  bf16x8 o;
#pragma unroll
  for (int e = 0; e < 8; e += 2) { const unsigned w = pk2(bf2f((bf16_t)f[e]) * s, bf2f((bf16_t)f[e + 1]) * s); o[e] = (short)(w & 0xffff); o[e + 1] = (short)(w >> 16); }
  return o;
}
DEV void ssd_y_phase(const bf16_t* XC, const float* SDT, const float* SCS, const bf16_t* ST, const float* d_skip, bf16_t* Y0, float* SSQ, LAS unsigned char* lds, bool wr) {
  constexpr int XP = 272, BP = 136, SP = 72;
  LAS bf16_t* Xs = (LAS bf16_t*)lds; LAS bf16_t* Bs = (LAS bf16_t*)(lds + 128 * XP * 2);
  LAS float* tab = (LAS float*)(lds + 128 * XP * 2 + 128 * BP * 2);
  LAS float* ssq = tab + 4 * 4 * 128;
  LAS bf16_t* stg = (LAS bf16_t*)(ssq + 4 * 128);
  const int tid = threadIdx.x, lane = tid & 63, wid = tid >> 6, r = lane & 15, Qd = lane >> 4, hl = wid >> 1, ih = wid & 1;
  LAS bf16_t* mystg = stg + wid * 16 * SP;
  for (int task = blockIdx.x; task < NCH * 4; task += gridDim.x) {
    const int gc = task >> 2, g = (task >> 1) & 1, hh = task & 1; const size_t r0 = (size_t)gc * 128; const int h0 = g * 8 + hh * 4, h = h0 + hl;
    bf16x8 cf[4][4];
#pragma unroll
    for (int m = 0; m < 4; ++m)
#pragma unroll
      for (int ks = 0; ks < 4; ++ks) cf[m][ks] = *(const bf16x8*)(XC + (r0 + 64 * ih + 16 * m + r) * 1536 + 1280 + g * 128 + 32 * ks + 8 * Qd);
    __syncthreads();
#pragma unroll
    for (int i = 0; i < 8; ++i) { const int cid = tid + 512 * i, row = cid >> 5, ch = cid & 31; *(LAS v4u*)(Xs + row * XP + ch * 8) = *(const v4u*)(XC + (r0 + row) * 1536 + h0 * 64 + ch * 8); }
#pragma unroll
    for (int i = 0; i < 4; ++i) { const int cid = tid + 512 * i, row = cid >> 4, ch = cid & 15; *(LAS v4u*)(Bs + row * BP + ch * 8) = *(const v4u*)(XC + (r0 + row) * 1536 + 1024 + g * 128 + ch * 8); }
#pragma unroll
    for (int i = 0; i < 4; ++i) { const int e = tid + 512 * i, hq = e >> 9, which = (e >> 7) & 3, t = e & 127; const int col = (which & 1) * 16 + h0 + hq;
      tab[e] = (which < 2 ? SCS : SDT)[(r0 + t) * 32 + col]; }
    __syncthreads();
    const LAS float* csf = tab + hl * 512; const LAS float* csb = csf + 128; const LAS float* dtf = csf + 256; const LAS float* dtb = csf + 384;
    const float dsk = d_skip[h];
    f32x4 y[4][4];
#pragma unroll
    for (int m = 0; m < 4; ++m)
#pragma unroll
      for (int pt = 0; pt < 4; ++pt) y[m][pt] = (f32x4){0.f, 0.f, 0.f, 0.f};
#pragma unroll 1
    for (int dir = 0; dir < 2; ++dir) {
      const LAS float* csd = dir ? csb : csf; float sc[4];
#pragma unroll
      for (int m = 0; m < 4; ++m)
#pragma unroll
        for (int ks = 0; ks < 4; ++ks) asm volatile("" : "+v"(cf[m][ks]));
#pragma unroll
      for (int m = 0; m < 4; ++m) sc[m] = __expf(csd[64 * ih + 16 * m + r]);
      const bf16_t* Sp = ST + ((((size_t)gc * 16 + h) * 2 + dir) * 64 + r) * 128 + 8 * Qd;
#pragma unroll
      for (int ks = 0; ks < 4; ++ks) {
        bf16x8 sf[4];
#pragma unroll
        for (int pt = 0; pt < 4; ++pt) sf[pt] = *(const bf16x8*)(Sp + (size_t)(16 * pt) * 128 + 32 * ks);
#pragma unroll
        for (int m = 0; m < 4; ++m) { const bf16x8 a = scale_frag(cf[m][ks], sc[m]);
#pragma unroll
          for (int pt = 0; pt < 4; ++pt) y[m][pt] = __builtin_amdgcn_mfma_f32_16x16x32_bf16(a, sf[pt], y[m][pt], 0, 0, 0);
          __builtin_amdgcn_sched_barrier(0); }
      }
    }
#pragma unroll 1
    for (int m = 0; m < 4; ++m) {
      const int i = 64 * ih + 16 * m + r;
      const float cfi = csf[i], cbi = csb[i];
#pragma unroll 1
      for (int k2 = 0; k2 < 4; ++k2) {
        bf16x8 pa;
#pragma unroll
        for (int tt = 0; tt < 2; ++tt) {
          f32x4 c = {0.f, 0.f, 0.f, 0.f};
#pragma unroll
          for (int ks = 0; ks < 4; ++ks) { const bf16x8 bfr = *(const LAS bf16x8*)(Bs + (32 * k2 + 16 * tt + r) * BP + 32 * ks + 8 * Qd); c = __builtin_amdgcn_mfma_f32_16x16x32_bf16(bfr, cf[0][ks], c, 0, 0, 0); }
          const int j0 = 32 * k2 + 16 * tt + 4 * Qd;
          const f32x4 jf = *(const LAS f32x4*)(csf + j0), jb = *(const LAS f32x4*)(csb + j0), jdf = *(const LAS f32x4*)(dtf + j0), jdb = *(const LAS f32x4*)(dtb + j0);
          float pv[4];
#pragma unroll
          for (int jj = 0; jj < 4; ++jj) { const int j = j0 + jj;
            const float Lf = __expf(j <= i ? cfi - jf[jj] : -INFINITY) * jdf[jj];
            const float Lb = __expf(j >= i ? cbi - jb[jj] : -INFINITY) * jdb[jj];
            pv[jj] = c[jj] * (Lf + Lb) + (j == i ? dsk : 0.f); }
          const unsigned w0 = pk2(pv[0], pv[1]), w1 = pk2(pv[2], pv[3]);
          pa[tt * 4 + 0] = (short)(w0 & 0xffff); pa[tt * 4 + 1] = (short)(w0 >> 16); pa[tt * 4 + 2] = (short)(w1 & 0xffff); pa[tt * 4 + 3] = (short)(w1 >> 16);
        }
#pragma unroll
        for (int pt = 0; pt < 4; ++pt) {
          const s16x4 lo = tr_read(Xs + (32 * k2 + 4 * Qd + (r >> 2)) * XP + hl * 64 + 16 * pt + 4 * (r & 3));
          const s16x4 hi = tr_read(Xs + (32 * k2 + 16 + 4 * Qd + (r >> 2)) * XP + hl * 64 + 16 * pt + 4 * (r & 3));
          const bf16x8 xf = (bf16x8){lo[0], lo[1], lo[2], lo[3], hi[0], hi[1], hi[2], hi[3]};
          y[0][pt] = __builtin_amdgcn_mfma_f32_16x16x32_bf16(pa, xf, y[0][pt], 0, 0, 0);
        }
      }
#pragma unroll
      for (int pt = 0; pt < 4; ++pt)
#pragma unroll
        for (int jj = 0; jj < 4; ++jj) mystg[(4 * Qd + jj) * SP + 16 * pt + r] = f2bf(y[0][pt][jj]);
      LDS_WAIT(); asm volatile("" ::: "memory");
#pragma unroll
      for (int q = 0; q < 2; ++q) { const int c = lane + 64 * q, rowl = c >> 3, ch = c & 7; const int il = 64 * ih + 16 * m + rowl;
        const v4u yv = *(const LAS v4u*)(mystg + rowl * SP + ch * 8); bf16_t* zp = Y0 + (r0 + il) * 2048 + h * 64 + ch * 8; const v4u zv = *(const v4u*)zp;
        const float v0 = __uint_as_float(yv.x << 16) * __uint_as_float(zv.x << 16), v1 = __uint_as_float(yv.x & 0xffff0000u) * __uint_as_float(zv.x & 0xffff0000u);
        const float v2 = __uint_as_float(yv.y << 16) * __uint_as_float(zv.y << 16), v3 = __uint_as_float(yv.y & 0xffff0000u) * __uint_as_float(zv.y & 0xffff0000u);
        const float v4 = __uint_as_float(yv.z << 16) * __uint_as_float(zv.z << 16), v5 = __uint_as_float(yv.z & 0xffff0000u) * __uint_as_float(zv.z & 0xffff0000u);
        const float v6 = __uint_as_float(yv.w << 16) * __uint_as_float(zv.w << 16), v7 = __uint_as_float(yv.w & 0xffff0000u) * __uint_as_float(zv.w & 0xffff0000u);
        float ss = (v0 * v0 + v1 * v1) + (v2 * v2 + v3 * v3) + (v4 * v4 + v5 * v5) + (v6 * v6 + v7 * v7);
        ss += __shfl_xor(ss, 1); ss += __shfl_xor(ss, 2); ss += __shfl_xor(ss, 4);
        v4u ov; ov.x = pk2(v0, v1); ov.y = pk2(v2, v3); ov.z = pk2(v4, v5); ov.w = pk2(v6, v7);
        if (wr) *(v4u*)zp = ov;
        if (ch == 0) ssq[hl * 128 + il] = ss; }
      LDS_WAIT(); asm volatile("" ::: "memory");
#pragma unroll
      for (int ks = 0; ks < 4; ++ks) { cf[0][ks] = cf[1][ks]; cf[1][ks] = cf[2][ks]; cf[2][ks] = cf[3][ks]; }
#pragma unroll
      for (int pt = 0; pt < 4; ++pt) { y[0][pt] = y[1][pt]; y[1][pt] = y[2][pt]; y[2][pt] = y[3][pt]; }
    }
    __syncthreads();
    if (tid < 128) SSQ[((r0 + tid) * 2 + g) * 2 + hh] = (ssq[tid] + ssq[128 + tid]) + (ssq[256 + tid] + ssq[384 + tid]);
  }
}

constexpr size_t WS_GCSC = 237 * MiB + 4 * MiB;
DEV const float* gcs_row(const float* lat, const float* ctx, size_t row) { return row < (size_t)ML ? lat + row * 1024 : ctx + (row - ML) * 1024; }
DEV float* gcs_row_w(float* lat, float* ctx, size_t row) { return row < (size_t)ML ? lat + row * 1024 : ctx + (row - ML) * 1024; }
DEV float logsig_fast(float x) { return fminf(x, 0.f) - __logf(1.f + __expf(-fabsf(x))); }
DEV void gla_cs_phase(const float* DTLR, const float* gw, const float* gb, float* GCSL, float* GCSC, float* GDEC) {
  const int lane = threadIdx.x & 63, wave = threadIdx.x >> 6, kl = lane & 7, seg = lane >> 3;
  for (int wt = blockIdx.x * NWAVES + wave; wt < NCH * 2 * 64; wt += gridDim.x * NWAVES) {
    const int gc = wt >> 7, dir = (wt >> 6) & 1, k = (wt & 63) * 8 + kl;
    float wv[16];
#pragma unroll
    for (int q = 0; q < 16; ++q) wv[q] = gw[(dir * 16 + q) * 512 + k];
    const float bias = gb[dir * 512 + k];
    float v[16]; float run = 0.f;
#pragma unroll
    for (int u = 0; u < 16; ++u) { const int s = seg * 16 + u, t = dir ? 127 - s : s; const float* lr = DTLR + ((size_t)gc * 128 + t) * 64 + 32 + dir * 16;
      const f32x4 l0 = *(const f32x4*)lr, l1 = *(const f32x4*)(lr + 4), l2 = *(const f32x4*)(lr + 8), l3 = *(const f32x4*)(lr + 12);
      float lg = bias + l0.x * wv[0] + l0.y * wv[1] + l0.z * wv[2] + l0.w * wv[3] + l1.x * wv[4] + l1.y * wv[5] + l1.z * wv[6] + l1.w * wv[7]
                 + l2.x * wv[8] + l2.y * wv[9] + l2.z * wv[10] + l2.w * wv[11] + l3.x * wv[12] + l3.y * wv[13] + l3.z * wv[14] + l3.w * wv[15];
      run += logsig_fast(lg) * (1.f / 16.f); v[u] = run; }
    float off = 0.f;
#pragma unroll
    for (int sgi = 0; sgi < 7; ++sgi) { const float tot = __shfl(run, kl + 8 * sgi); off += (sgi < seg) ? tot : 0.f; }
#pragma unroll
    for (int u = 0; u < 16; ++u) { const int s = seg * 16 + u, t = dir ? 127 - s : s; gcs_row_w(GCSL, GCSC, (size_t)gc * 128 + t)[dir * 512 + k] = v[u] + off; }
    if (seg == 7) GDEC[((gc * 4 + (k >> 7)) * 2 + dir) * 128 + (k & 127)] = __expf(run + off);
  }
}
DEV void gla_u_phase(const bf16_t* K0, const bf16_t* V0, const float* GCSL, const float* GCSC, bf16_t* ST, LAS unsigned char* lds) {
  constexpr int VP = 272, KP = 144;
  LAS bf16_t* Vs = (LAS bf16_t*)lds; LAS bf16_t* Kd = (LAS bf16_t*)(lds + 128 * VP * 2);
  const int tid = threadIdx.x, lane = tid & 63, wid = tid >> 6, r = lane & 15, Qd = lane >> 4;
  for (int task = blockIdx.x; task < NCH * 4; task += gridDim.x) {
    const int gc = task >> 2, h = task & 3; const size_t r0 = (size_t)gc * 128;
    __syncthreads();
#pragma unroll
    for (int i = 0; i < 8; ++i) { const int cid = tid + 512 * i, row = cid >> 5, ch = cid & 31; *(LAS v4u*)(Vs + row * VP + ch * 8) = *(const v4u*)(V0 + (r0 + row) * 1024 + h * 256 + ch * 8); }
#pragma unroll
    for (int i = 0; i < 4; ++i) { const int cid = tid + 512 * i, t = cid >> 4, ch = cid & 15;
      const v4u kv = *(const v4u*)(K0 + (r0 + t) * 512 + h * 128 + ch * 8);
      const float kf[8] = {__uint_as_float(kv.x << 16), __uint_as_float(kv.x & 0xffff0000u), __uint_as_float(kv.y << 16), __uint_as_float(kv.y & 0xffff0000u), __uint_as_float(kv.z << 16), __uint_as_float(kv.z & 0xffff0000u), __uint_as_float(kv.w << 16), __uint_as_float(kv.w & 0xffff0000u)};
#pragma unroll
      for (int dir = 0; dir < 2; ++dir) {
        const float* ce = gcs_row(GCSL, GCSC, r0 + (dir ? 0 : 127)) + dir * 512 + h * 128 + ch * 8; const float* ct = gcs_row(GCSL, GCSC, r0 + t) + dir * 512 + h * 128 + ch * 8;
        const f32x4 e0 = *(const f32x4*)ce, e1 = *(const f32x4*)(ce + 4), c0 = *(const f32x4*)ct, c1 = *(const f32x4*)(ct + 4);
        v4u o; o.x = pk2(kf[0] * __expf(e0.x - c0.x), kf[1] * __expf(e0.y - c0.y)); o.y = pk2(kf[2] * __expf(e0.z - c0.z), kf[3] * __expf(e0.w - c0.w));
        o.z = pk2(kf[4] * __expf(e1.x - c1.x), kf[5] * __expf(e1.y - c1.y)); o.w = pk2(kf[6] * __expf(e1.z - c1.z), kf[7] * __expf(e1.w - c1.w));
        *(LAS v4u*)(Kd + dir * 128 * KP + t * KP + ch * 8) = o; } }
    __syncthreads();
#pragma unroll 1
    for (int dir = 0; dir < 2; ++dir) {
      const LAS bf16_t* Kb = Kd + dir * 128 * KP;
      f32x4 acc[8][2];
#pragma unroll
      for (int dt = 0; dt < 8; ++dt) { acc[dt][0] = (f32x4){0.f, 0.f, 0.f, 0.f}; acc[dt][1] = (f32x4){0.f, 0.f, 0.f, 0.f}; }
#pragma unroll 1
      for (int k = 0; k < 4; ++k) {
        bf16x8 vf[2];
#pragma unroll
        for (int et = 0; et < 2; ++et) {
          const s16x4 lo = tr_read(Vs + (32 * k + 4 * Qd + (r >> 2)) * VP + 32 * wid + 16 * et + 4 * (r & 3));
          const s16x4 hi = tr_read(Vs + (32 * k + 16 + 4 * Qd + (r >> 2)) * VP + 32 * wid + 16 * et + 4 * (r & 3));
          vf[et] = (bf16x8){lo[0], lo[1], lo[2], lo[3], hi[0], hi[1], hi[2], hi[3]}; }
#pragma unroll
        for (int dt = 0; dt < 8; ++dt) {
          const s16x4 lo = tr_read(Kb + (32 * k + 4 * Qd + (r >> 2)) * KP + 16 * dt + 4 * (r & 3));
          const s16x4 hi = tr_read(Kb + (32 * k + 16 + 4 * Qd + (r >> 2)) * KP + 16 * dt + 4 * (r & 3));
          const bf16x8 kfr = (bf16x8){lo[0], lo[1], lo[2], lo[3], hi[0], hi[1], hi[2], hi[3]};
          acc[dt][0] = __builtin_amdgcn_mfma_f32_16x16x32_bf16(kfr, vf[0], acc[dt][0], 0, 0, 0);
          acc[dt][1] = __builtin_amdgcn_mfma_f32_16x16x32_bf16(kfr, vf[1], acc[dt][1], 0, 0, 0); }
      }
      bf16_t* Sp = ST + (((size_t)gc * 4 + h) * 2 + dir) * 32768;
#pragma unroll
      for (int dt = 0; dt < 8; ++dt)
#pragma unroll
        for (int et = 0; et < 2; ++et) { const f32x4 v = acc[dt][et];
          *(unsigned long long*)(Sp + (size_t)(32 * wid + 16 * et + r) * 128 + 16 * dt + 4 * Qd) = (unsigned long long)pk2(v[0], v[1]) | ((unsigned long long)pk2(v[2], v[3]) << 32); }
    }
  }
}
DEV void gla_scan_phase(bf16_t* ST, const float* GDEC, bool wr) {
  for (int item = blockIdx.x * 512 + threadIdx.x; item < 2 * 4 * 2 * 8192; item += gridDim.x * 512) {
    const int e4 = item & 8191, dir = (item >> 13) & 1, h = (item >> 14) & 3, b = item >> 16; const int d0 = (e4 * 4) & 127;
    float S0 = 0.f, S1 = 0.f, S2 = 0.f, S3 = 0.f;
#define SCAN_GC(s) (!dir ? ((s) < 2 ? 128 + 2 * b + (s) : b * 64 + ((s) - 2)) : ((s) < 2 ? 128 + 2 * b + (1 - (s)) : b * 64 + (65 - (s))))
    for (int s0 = 0; s0 < 66; s0 += 6) {
      unsigned long long u[6]; f32x4 dec[6];
#pragma unroll
      for (int q = 0; q < 6; ++q) { const int gc = SCAN_GC(s0 + q); u[q] = *(const unsigned long long*)(ST + (((size_t)gc * 4 + h) * 2 + dir) * 32768 + e4 * 4); dec[q] = *(const f32x4*)(GDEC + ((gc * 4 + h) * 2 + dir) * 128 + d0); }
#pragma unroll
      for (int q = 0; q < 6; ++q) { const int gc = SCAN_GC(s0 + q);
        if (wr) *(unsigned long long*)(ST + (((size_t)gc * 4 + h) * 2 + dir) * 32768 + e4 * 4) = (unsigned long long)pk2(S0, S1) | ((unsigned long long)pk2(S2, S3) << 32);
        const unsigned lo = (unsigned)u[q], hi = (unsigned)(u[q] >> 32);
        S0 = dec[q].x * S0 + __uint_as_float(lo << 16); S1 = dec[q].y * S1 + __uint_as_float(lo & 0xffff0000u); S2 = dec[q].z * S2 + __uint_as_float(hi << 16); S3 = dec[q].w * S3 + __uint_as_float(hi & 0xffff0000u); }
    }
#undef SCAN_GC
  }
}
DEV void gla_o_phase(const bf16_t* Q0, const bf16_t* K0, const bf16_t* V0, const float* GCSL, const float* GCSC, const bf16_t* ST, const float* gla_norm, const float* SSQ, const float* ssd_norm, bf16_t* Y0, LAS unsigned char* lds, bool wr) {
  constexpr int VP = 272, KP = 136;
  LAS bf16_t* Vs = (LAS bf16_t*)lds; LAS bf16_t* Kd = (LAS bf16_t*)(lds + 128 * VP * 2);
  const int tid = threadIdx.x, lane = tid & 63, wid = tid >> 6, r = lane & 15, Qd = lane >> 4;
  const float scale = 0.08838834764831845f;
  for (int task = blockIdx.x; task < NCH * 4; task += gridDim.x) {
    const int gc = task >> 2, h = task & 3; const size_t r0 = (size_t)gc * 128;
    __syncthreads();
#pragma unroll
    for (int i = 0; i < 8; ++i) { const int cid = tid + 512 * i, row = cid >> 5, ch = cid & 31; *(LAS v4u*)(Vs + row * VP + ch * 8) = *(const v4u*)(V0 + (r0 + row) * 1024 + h * 256 + ch * 8); }
#pragma unroll
    for (int i = 0; i < 4; ++i) { const int cid = tid + 512 * i, t = cid >> 4, ch = cid & 15;
      const v4u kv = *(const v4u*)(K0 + (r0 + t) * 512 + h * 128 + ch * 8);
      const float kf[8] = {__uint_as_float(kv.x << 16), __uint_as_float(kv.x & 0xffff0000u), __uint_as_float(kv.y << 16), __uint_as_float(kv.y & 0xffff0000u), __uint_as_float(kv.z << 16), __uint_as_float(kv.z & 0xffff0000u), __uint_as_float(kv.w << 16), __uint_as_float(kv.w & 0xffff0000u)};
#pragma unroll
      for (int dir = 0; dir < 2; ++dir) {
        const float* ct = gcs_row(GCSL, GCSC, r0 + t) + dir * 512 + h * 128 + ch * 8;
        const f32x4 c0 = *(const f32x4*)ct, c1 = *(const f32x4*)(ct + 4);
        v4u o; o.x = pk2(kf[0] * __expf(-c0.x), kf[1] * __expf(-c0.y)); o.y = pk2(kf[2] * __expf(-c0.z), kf[3] * __expf(-c0.w));
        o.z = pk2(kf[4] * __expf(-c1.x), kf[5] * __expf(-c1.y)); o.w = pk2(kf[6] * __expf(-c1.z), kf[7] * __expf(-c1.w));
        *(LAS v4u*)(Kd + dir * 128 * KP + t * KP + ch * 8) = o; } }
    __syncthreads();
    const int i = 16 * wid + r;
    f32x4 o[16];
#pragma unroll
    for (int et = 0; et < 16; ++et) o[et] = (f32x4){0.f, 0.f, 0.f, 0.f};
#pragma unroll 1
    for (int dir = 0; dir < 2; ++dir) {
      bf16x8 qd[4];
      { const float* ci = gcs_row(GCSL, GCSC, r0 + i) + dir * 512 + h * 128; const bf16_t* qp = Q0 + (r0 + i) * 512 + h * 128;
#pragma unroll
        for (int ks = 0; ks < 4; ++ks) { const v4u qv = *(const v4u*)(qp + 32 * ks + 8 * Qd); const f32x4 c0 = *(const f32x4*)(ci + 32 * ks + 8 * Qd), c1 = *(const f32x4*)(ci + 32 * ks + 8 * Qd + 4);
          const unsigned w0 = pk2(__uint_as_float(qv.x << 16) * scale * __expf(c0.x), __uint_as_float(qv.x & 0xffff0000u) * scale * __expf(c0.y));
          const unsigned w1 = pk2(__uint_as_float(qv.y << 16) * scale * __expf(c0.z), __uint_as_float(qv.y & 0xffff0000u) * scale * __expf(c0.w));
          const unsigned w2 = pk2(__uint_as_float(qv.z << 16) * scale * __expf(c1.x), __uint_as_float(qv.z & 0xffff0000u) * scale * __expf(c1.y));
          const unsigned w3 = pk2(__uint_as_float(qv.w << 16) * scale * __expf(c1.z), __uint_as_float(qv.w & 0xffff0000u) * scale * __expf(c1.w));
          qd[ks] = (bf16x8){(short)(w0 & 0xffff), (short)(w0 >> 16), (short)(w1 & 0xffff), (short)(w1 >> 16), (short)(w2 & 0xffff), (short)(w2 >> 16), (short)(w3 & 0xffff), (short)(w3 >> 16)}; } }
      const bf16_t* Sp = ST + (((size_t)gc * 4 + h) * 2 + dir) * 32768;
#pragma unroll 1
      for (int ks = 0; ks < 4; ++ks)
#pragma unroll
        for (int et = 0; et < 16; ++et) { const bf16x8 sf = *(const bf16x8*)(Sp + (size_t)(16 * et + r) * 128 + 32 * ks + 8 * Qd); o[et] = __builtin_amdgcn_mfma_f32_16x16x32_bf16(qd[ks], sf, o[et], 0, 0, 0); }
      const LAS bf16_t* Kb = Kd + dir * 128 * KP;
#pragma unroll 1
      for (int k2 = 0; k2 < 4; ++k2) {
        const bool need = dir ? (2 * k2 + 1 >= wid) : (2 * k2 <= wid);
        if (!need) continue;
        bf16x8 pa;
#pragma unroll
        for (int tt = 0; tt < 2; ++tt) { const int t = 2 * k2 + tt;
          f32x4 c = {0.f, 0.f, 0.f, 0.f};
#pragma unroll
          for (int ks = 0; ks < 4; ++ks) { const bf16x8 kfr = *(const LAS bf16x8*)(Kb + (16 * t + r) * KP + 32 * ks + 8 * Qd); c = __builtin_amdgcn_mfma_f32_16x16x32_bf16(kfr, qd[ks], c, 0, 0, 0); }
          float pv[4];
#pragma unroll
          for (int jj = 0; jj < 4; ++jj) { const int j = 16 * t + 4 * Qd + jj; const bool ok = dir ? (j >= i) : (j <= i); pv[jj] = ok ? c[jj] : 0.f; }
          const unsigned w0 = pk2(pv[0], pv[1]), w1 = pk2(pv[2], pv[3]);
          pa[tt * 4 + 0] = (short)(w0 & 0xffff); pa[tt * 4 + 1] = (short)(w0 >> 16); pa[tt * 4 + 2] = (short)(w1 & 0xffff); pa[tt * 4 + 3] = (short)(w1 >> 16); }
#pragma unroll
        for (int et = 0; et < 16; ++et) {
          const s16x4 lo = tr_read(Vs + (32 * k2 + 4 * Qd + (r >> 2)) * VP + 16 * et + 4 * (r & 3));
          const s16x4 hi = tr_read(Vs + (32 * k2 + 16 + 4 * Qd + (r >> 2)) * VP + 16 * et + 4 * (r & 3));
          const bf16x8 vf = (bf16x8){lo[0], lo[1], lo[2], lo[3], hi[0], hi[1], hi[2], hi[3]};
          o[et] = __builtin_amdgcn_mfma_f32_16x16x32_bf16(pa, vf, o[et], 0, 0, 0); }
      }
    }
#pragma unroll
    for (int jj = 0; jj < 4; ++jj) { float ss = 0.f;
#pragma unroll
      for (int et = 0; et < 16; ++et) ss += o[et][jj] * o[et][jj];
      ss += __shfl_xor(ss, 1); ss += __shfl_xor(ss, 2); ss += __shfl_xor(ss, 4); ss += __shfl_xor(ss, 8);
      const float rstd = rsqrtf(ss * (1.f / 256.f) + EPS);
      const size_t yo = (r0 + 16 * wid + 4 * Qd + jj) * 2048 + 1024 + h * 256 + r;
#pragma unroll
      for (int et = 0; et < 16; ++et) { const bf16_t ov_ = f2bf(o[et][jj] * rstd * gla_norm[h * 256 + 16 * et + r] * bf2f(Y0[yo + 16 * et])); if (wr) Y0[yo + 16 * et] = ov_; } }
    { const int g = h >> 1, c0 = g * 512 + (h & 1) * 256;
#pragma unroll
      for (int q = 0; q < 8; ++q) { const int cid = tid + 512 * q, row = cid >> 5, ch = cid & 31; const size_t rr = r0 + row;
        const float rstd = rsqrtf((SSQ[(rr * 2 + g) * 2] + SSQ[(rr * 2 + g) * 2 + 1]) * (1.f / 512.f) + EPS);
        bf16_t* yp = Y0 + rr * 2048 + c0 + ch * 8; const v4u yv = *(const v4u*)yp; const f32x4 g0 = *(const f32x4*)(ssd_norm + c0 + ch * 8), g1 = *(const f32x4*)(ssd_norm + c0 + ch * 8 + 4);
        v4u ov; ov.x = pk2(__uint_as_float(yv.x << 16) * rstd * g0.x, __uint_as_float(yv.x & 0xffff0000u) * rstd * g0.y); ov.y = pk2(__uint_as_float(yv.y << 16) * rstd * g0.z, __uint_as_float(yv.y & 0xffff0000u) * rstd * g0.w);
        ov.z = pk2(__uint_as_float(yv.z << 16) * rstd * g1.x, __uint_as_float(yv.z & 0xffff0000u) * rstd * g1.y); ov.w = pk2(__uint_as_float(yv.w << 16) * rstd * g1.z, __uint_as_float(yv.w & 0xffff0000u) * rstd * g1.w);
        if (wr) *(v4u*)yp = ov; } }
  }
}

typedef __attribute__((address_space(1))) unsigned gu32;
#define RLX_AGENT __ATOMIC_RELAXED, __HIP_MEMORY_SCOPE_AGENT
#define XB_TMO      128
#define XB_XCNT(j)  (256  + 64 * (j))
#define XB_XSUB(j)  (1280 + 64 * (j))
#define XB_XGEN(j)  (2304 + 64 * (j))
#define XB_TOP      3328
#define XB_TOPGEN   3392
#define XCD_BAR_WORDS 3456
#define XB_SPIN_CAP (1u << 18)

__device__ __forceinline__ unsigned xb_ld(unsigned* p)              { return __hip_atomic_load(p, __ATOMIC_RELAXED, __HIP_MEMORY_SCOPE_AGENT); }
__device__ __forceinline__ unsigned xb_add(unsigned* p, unsigned v) { return __hip_atomic_fetch_add(p, v, __ATOMIC_RELAXED, __HIP_MEMORY_SCOPE_AGENT); }
__device__ __forceinline__ unsigned xb_xcc_id() { return (unsigned)__builtin_amdgcn_s_getreg((3 << 11) | 20) & 0xFu; }
#define XB_SPIN(cond, bar) do { unsigned _sp = 0; while (cond) { __builtin_amdgcn_s_sleep(1); \
    if ((++_sp & 255u) == 0u) { if (xb_ld(&(bar)[XB_TMO])) break; if (_sp > XB_SPIN_CAP) { atomicAdd(&(bar)[XB_TMO], 1u); break; } } } } while (0)

struct XcdBarrier {
    unsigned* bar; unsigned x;
    volatile LAS unsigned* st;
};

__device__ __forceinline__ XcdBarrier xcd_barrier_post(unsigned* bar, volatile LAS unsigned* st) {
    XcdBarrier b; b.bar = bar; b.x = xb_xcc_id(); b.st = st;
    if (threadIdx.x == 0) (void)xb_add(&bar[XB_XCNT(b.x)], 1u);
    return b;
}
__device__ __forceinline__ void xcd_barrier_complete(unsigned* bar, unsigned x, unsigned& nloc, unsigned& nx) {
    const unsigned G = gridDim.x * gridDim.y * gridDim.z;
    unsigned sum, cnt, mine, sp = 0u;
    for (;;) {
        sum = 0u; cnt = 0u; mine = 0u;
#pragma unroll
        for (unsigned j = 0; j < 16; ++j) { const unsigned c = xb_ld(&bar[XB_XCNT(j)]); sum += c; cnt += (c > 0u) ? 1u : 0u; mine = (j == x) ? c : mine; }
        if (sum == G) break;
        __builtin_amdgcn_s_sleep(1);
        if ((++sp & 255u) == 0u) { if (xb_ld(&bar[XB_TMO])) break; if (sp > XB_SPIN_CAP) { atomicAdd(&bar[XB_TMO], 1u); break; } }
    }
    nloc = mine > 0u ? mine : 1u; nx = cnt > 0u ? cnt : 1u;
}

__device__ __forceinline__ void xcd_barrier(const XcdBarrier& b) {
    asm volatile("s_waitcnt vmcnt(0)" ::: "memory");
    __syncthreads();
    if (threadIdx.x == 0) {
        unsigned* bar = b.bar;
        __builtin_amdgcn_s_waitcnt(0);
        unsigned nloc = b.st[0], nx = b.st[1];
        if (nloc == 0u) { xcd_barrier_complete(bar, b.x, nloc, nx); b.st[0] = nloc; b.st[1] = nx; }
        const unsigned old = xb_add(&bar[XB_XSUB(b.x)], 1u);
        const unsigned gen = old / nloc;
        if (old + 1u == (gen + 1u) * nloc) {
            __builtin_amdgcn_fence(__ATOMIC_RELEASE, "agent");
            asm volatile("s_waitcnt vmcnt(0)" ::: "memory");
            const unsigned og = xb_add(&bar[XB_TOP], 1u);
            const unsigned tg = og / nx;
            if (og + 1u == (tg + 1u) * nx) xb_add(&bar[XB_TOPGEN], 1u);
            else XB_SPIN(xb_ld(&bar[XB_TOPGEN]) == tg, bar);
            __builtin_amdgcn_fence(__ATOMIC_ACQUIRE, "agent");
            xb_add(&bar[XB_XGEN(b.x)], 1u);
            asm volatile("s_waitcnt vmcnt(0)" ::: "memory");
        } else {
            XB_SPIN(xb_ld(&bar[XB_XGEN(b.x)]) == gen, bar);
            __builtin_amdgcn_fence(__ATOMIC_ACQUIRE, "agent");
            asm volatile("s_waitcnt vmcnt(0)" ::: "memory");
        }
    }
    __syncthreads();
}

__global__ void __launch_bounds__(NWAVES * 64, 2) mega(Params p) {
  extern __shared__ __attribute__((aligned(16))) unsigned char lds_raw[];
  LAS unsigned char* lds = (LAS unsigned char*)lds_raw;
  cg::grid_group grid = cg::this_grid();
  volatile LAS unsigned* MISC = (volatile LAS unsigned*)(lds + MISC_OFF);
  if (threadIdx.x < 16) MISC[threadIdx.x] = 0u;
  __syncthreads();
  XcdBarrier bar = xcd_barrier_post((unsigned*)(p.ws + WS_CTL), MISC + 8);
  unsigned char* ws = p.ws;
  float* MOD = (float*)(ws + WS_MOD);
  bf16_t* H0 = (bf16_t*)p.out; float* X1 = p.out;
  const int lo = p.ph_lo, hi = p.ph_hi;
#define IN(k) (lo <= (k) && (k) < hi)
#define SEAM(k) do { if ((k) + 1 < hi) { if ((k) == 0) grid.sync(); else xcd_barrier(bar); } } while (0)
#define PH(k, ...) if (IN(k)) { if ((PROBE_MASK >> (k)) & 1u) { const bool wr = (p.rep < 0); (void)wr; __VA_ARGS__; xcd_barrier(bar); } { const bool wr = true; (void)wr; __VA_ARGS__; } SEAM(k); }
  PH(0, prologue_phase(p, lds))
  PH(1, prep_phase(p.in[0], p.in[2], p.in[4], MOD, H0))
  PH(2, {
    pg8::Gemm g{H0, (const bf16_t*)(ws + WS_W1T), MA, E_INP, D}; pg8::StaticOrder S; S.init(MA, E_INP, gridDim.x, (int)blockIdx.x);
    pg8::EpiProj0 E{(bf16_t*)(ws + WS_Y0), (bf16_t*)(ws + WS_XBC), (bf16_t*)(ws + WS_Q0), (bf16_t*)(ws + WS_K0), (bf16_t*)(ws + WS_V0), (float*)(ws + WS_DTLR)};
    pg8::gemm_phase<pg8::EpiProj0, pg8::StaticOrder, true, true>(lds, g, S, E); })
  PH(3, ssd_prep_phase((const bf16_t*)(ws + WS_XBC), p.in[8], p.in[9], (bf16_t*)p.out, (const float*)(ws + WS_DTLR), p.in[10], p.in[11], (float*)((char*)p.out + DO_SDT), (float*)((char*)p.out + DO_SCS), (float*)(ws + WS_SDEC)))
  PH(4, ssd_u_phase((const bf16_t*)p.out, (const float*)((char*)p.out + DO_SDT), (const float*)((char*)p.out + DO_SCS), (bf16_t*)(ws + WS_STATE), lds))
  PH(5, ssd_scan_phase((bf16_t*)(ws + WS_STATE), (const float*)(ws + WS_SDEC), wr))
  PH(6, ssd_y_phase((const bf16_t*)p.out, (const float*)((char*)p.out + DO_SDT), (const float*)((char*)p.out + DO_SCS), (const bf16_t*)(ws + WS_STATE), p.in[12], (bf16_t*)(ws + WS_Y0), (float*)(ws + WS_SSQ), lds, wr))
  PH(7, gla_cs_phase((const float*)(ws + WS_DTLR), p.in[14], p.in[15], (float*)p.out, (float*)(ws + WS_GCSC), (float*)(ws + WS_GDEC)))
  PH(8, gla_u_phase((const bf16_t*)(ws + WS_K0), (const bf16_t*)(ws + WS_V0), (const float*)p.out, (const float*)(ws + WS_GCSC), (bf16_t*)(ws + WS_STATE), lds))
  PH(9, gla_scan_phase((bf16_t*)(ws + WS_STATE), (const float*)(ws + WS_GDEC), wr))
  PH(10, gla_o_phase((const bf16_t*)(ws + WS_Q0), (const bf16_t*)(ws + WS_K0), (const bf16_t*)(ws + WS_V0), (const float*)p.out, (const float*)(ws + WS_GCSC), (const bf16_t*)(ws + WS_STATE), p.in[16], (const float*)(ws + WS_SSQ), p.in[13], (bf16_t*)(ws + WS_Y0), lds, wr))
  PH(11, {
    pg8::Gemm g{(const bf16_t*)(ws + WS_Y0), (const bf16_t*)(ws + WS_W2T), ML, D, 2048}; pg8::StaticOrder S; S.init(ML, D, gridDim.x, (int)blockIdx.x);
    pg8::EpiResid E{p.in[0], X1, MOD, true};
    pg8::gemm_phase<pg8::EpiResid, pg8::StaticOrder, true, true>(lds, g, S, E);
    const float* ctx = p.in[2]; float* XC1 = (float*)(ws + WS_XC1); const float* gate = MOD + 2 * 3072 + 2048;
    small_gemm((const bf16_t*)(ws + WS_Y0) + (size_t)ML * 2048, 2048, (const bf16_t*)(ws + WS_W2T), 2048, 2048, MC, D,
               [=](int m, int n, float v) { XC1[(size_t)m * D + n] = ctx[(size_t)m * D + n] + gate[n] * v; }); })
  PH(12, prep_phase(X1, (const float*)(ws + WS_XC1), p.in[18], MOD + 3 * 3072, (bf16_t*)(ws + WS_H1)))
  PH(13, {
    pg8::Gemm g{(const bf16_t*)(ws + WS_H1), (const bf16_t*)(ws + WS_W3T), ML, O_IN, D}; pg8::StaticOrder S; S.init(ML, O_IN, gridDim.x, (int)blockIdx.x);
    pg8::EpiProj1 E{(bf16_t*)(ws + WS_K1), (bf16_t*)(ws + WS_V1), (bf16_t*)(ws + WS_Q1), (bf16_t*)(ws + WS_G1)};
    pg8::gemm_phase<pg8::EpiProj1, pg8::StaticOrder, true, true>(lds, g, S, E);
    bf16_t* K1 = (bf16_t*)(ws + WS_K1); bf16_t* V1 = (bf16_t*)(ws + WS_V1);
    small_gemm((const bf16_t*)(ws + WS_H1) + (size_t)ML * D, D, (const bf16_t*)(ws + WS_W3T), D, D, MC, 1024,
               [=](int m, int n, float v) { if (n < 512) K1[(size_t)(ML + m) * 512 + n] = f2bf(v); else V1[(size_t)(ML + m) * 512 + (n - 512)] = f2bf(v); }); })
  PH(14, qknorm_phase((bf16_t*)(ws + WS_Q1), (bf16_t*)(ws + WS_K1), p.in[22], p.in[23], (const float*)(ws + WS_ROPE), wr))
  PH(15, attn_phase((bf16_t*)(ws + WS_Q1), (const bf16_t*)(ws + WS_K1), (const bf16_t*)(ws + WS_V1), (const bf16_t*)(ws + WS_G1), p.in[24], p.in[22], p.in[23], lds, wr))
  PH(16, {
    pg8::Gemm g{(const bf16_t*)(ws + WS_Q1), (const bf16_t*)(ws + WS_W4T), ML, D, 2048}; pg8::StaticOrder S; S.init(ML, D, gridDim.x, (int)blockIdx.x);
    pg8::EpiResid E{X1, p.out, MOD + 3 * 3072, wr};
    pg8::gemm_phase<pg8::EpiResid, pg8::StaticOrder, true, true>(lds, g, S, E); })
#undef PH
#undef IN
#undef SEAM
}
extern "C" void kernel_launch(void* const* d_in, const int* in_sizes, int n_in, void* d_out, int out_size, void* d_ws, size_t ws_size, hipStream_t stream) {
  static int grid_blocks = 0;
  if (!grid_blocks) {
    int dev = 0, cus = 0, per_cu = 0;
    hipGetDevice(&dev);
    hipDeviceGetAttribute(&cus, hipDeviceAttributeMultiprocessorCount, dev);
    hipFuncSetAttribute((const void*)mega, hipFuncAttributeMaxDynamicSharedMemorySize, LDS_BYTES);
    hipOccupancyMaxActiveBlocksPerMultiprocessor(&per_cu, (const void*)mega, NWAVES * 64, LDS_BYTES);
    if (per_cu < 1) { fprintf(stderr, "kernel_launch: occupancy query says %d blocks per CU\n", per_cu); per_cu = 1; }
    if (per_cu > 1) per_cu = 1;
    grid_blocks = cus * per_cu;
  }
  hipMemsetAsync((char*)d_ws + WS_CTL, 0, 64 * 1024, stream);
  Params base{};
  for (int i = 0; i < 26; ++i) base.in[i] = (const float*)d_in[i];
  base.out = (float*)d_out; base.ws = (unsigned char*)d_ws;
  auto launch = [&](int lo, int hi) {
    Params p = base; p.ph_lo = lo; p.ph_hi = hi; p.rep = (int)PROBE_MASK; void* args[] = {&p};
    hipError_t e = hipLaunchCooperativeKernel((const void*)mega, dim3(grid_blocks), dim3(NWAVES * 64), args, LDS_BYTES, stream);
    if (e != hipSuccess) fprintf(stderr, "cooperative launch failed: %s (grid %d)\n", hipGetErrorString(e), grid_blocks);
  };
  launch(0, 17);
}
```

```cpp
#include <hip/hip_runtime.h>
#include <hip/hip_cooperative_groups.h>
#include <stdint.h>
#include <math.h>
#include <cstdio>
namespace cg = cooperative_groups;
#ifndef PROBE_MASK
#define PROBE_MASK 0u
#endif

typedef unsigned short bf16_t;
#define DEV __device__ __forceinline__

DEV float bf2f(bf16_t v) { return __uint_as_float(((unsigned)v) << 16); }
DEV bf16_t f2bf(float f) { unsigned u = __float_as_uint(f); u = (u + 0x7fffu + ((u >> 16) & 1u)) >> 16; return (bf16_t)u; }
DEV unsigned pk2(float lo, float hi) { return (unsigned)f2bf(lo) | ((unsigned)f2bf(hi) << 16); }
DEV float siluf(float x) { return x / (1.f + __expf(-x)); }
DEV float silu_fast(float x) { return x * __builtin_amdgcn_rcpf(1.f + __expf(-x)); }
DEV float softplusf(float x) { return x > 20.f ? x : log1pf(__expf(x)); }
DEV float logsigmoidf(float x) { return fminf(x, 0.f) - log1pf(__expf(-fabsf(x))); }

constexpr int D = 1024, NB = 2, SEQ = 8192, CTXL = 256;
constexpr int ML = NB * SEQ;
constexpr int MC = NB * CTXL;
constexpr int MA = ML + MC;
constexpr int NCH = MA / 128;
constexpr int E_IN = 5696, O_IN = 5120, E_INP = 5888;
constexpr float EPS = 1e-6f;

constexpr size_t MiB = 1u << 20;
constexpr size_t WS_CTL = 0;
constexpr size_t WS_MOD = 1 * MiB;
constexpr size_t WS_ROPE = 1 * MiB + 128 * 1024;
constexpr size_t WS_SDEC = 1 * MiB + 256 * 1024;
constexpr size_t WS_GDEC = 1 * MiB + 384 * 1024;
constexpr size_t WS_W1T = 2 * MiB;
constexpr size_t WS_W2T = 14 * MiB;
constexpr size_t WS_W3T = 18 * MiB;
constexpr size_t WS_W4T = 28 * MiB;
constexpr size_t WS_Y0 = 32 * MiB;
constexpr size_t WS_Q0 = 98 * MiB;
constexpr size_t WS_K0 = WS_Q0 + 16 * MiB + 512 * 1024;
constexpr size_t WS_V0 = 131 * MiB;
constexpr size_t WS_DTLR = 164 * MiB;
constexpr size_t WS_XC1 = 168 * MiB + 512 * 1024;
constexpr size_t WS_XBC = 171 * MiB;
constexpr size_t WS_STATE = 171 * MiB;
constexpr size_t WS_TAIL = 237 * MiB;
constexpr size_t WS_H1 = 32 * MiB;
constexpr size_t WS_K1 = 65 * MiB;
constexpr size_t WS_V1 = 81 * MiB + 512 * 1024;
constexpr size_t WS_Q1 = 98 * MiB;
constexpr size_t WS_G1 = 171 * MiB;

DEV int row_vec(int row) { return row < ML ? (row / SEQ) : 2; }

namespace pg8 {
#define PG8_LAS __attribute__((address_space(3)))
typedef unsigned short bf16_t;
typedef short bf16x8 __attribute__((ext_vector_type(8)));
typedef float f32x4 __attribute__((ext_vector_type(4)));
typedef unsigned u32x4 __attribute__((ext_vector_type(4)));
constexpr int BM = 256, BK = 64, HALF = 128, HTB = HALF * BK * 2  , STAGE_BYTES = 8 * HTB, NXCD = 8, WGM = 8;

__host__ __device__ __forceinline__ int lds_byte(int r, int c) { const int st = (r >> 4) * 2 + (c >> 5), rr = r & 15, cc = c & 31, ob = rr * 64 + cc * 2; return st * 1024 + (ob ^ (((ob >> 9) & 1) << 5)); }
__host__ __device__ __forceinline__ void stage_rc(int b, int& R, int& C) { const int st = b / 1024, sb = b % 1024, swz = sb ^ (((sb >> 9) & 1) << 5); R = (st >> 1) * 16 + swz / 64; C = (st & 1) * 32 + (swz % 64) / 2; }
__host__ __device__ __forceinline__ int perm32(int rho) { const int n = rho >> 4, i = rho & 15; return 8 * (i >> 2) + 4 * n + (i & 3); }

struct Unit { int pm, pn; };
struct Gemm { const bf16_t* A; const bf16_t* Bt; int M, N, K; };

struct StaticOrder {
    int nM, nN, nwg, G, c;
    __host__ __device__ void init(int M, int N, int G_, int c_) { nM = M / BM; nN = N / BM; nwg = nM * nN; G = G_; c = c_; }
    __host__ __device__ bool next(int i, Unit& u) const {
        const long L = (long)i * G + c; if (L >= nwg) return false;
        int wgid = (int)L; { const int q = nwg / NXCD, r = nwg % NXCD, xcd = wgid % NXCD, off = wgid / NXCD; wgid = (xcd < r ? xcd * (q + 1) : r * (q + 1) + (xcd - r) * q) + off; }
        const int nig = WGM * nN, gid = wgid / nig, fm = gid * WGM, gsz = (nM - fm) < WGM ? (nM - fm) : WGM;
        u.pm = fm + ((wgid % nig) % gsz); u.pn = (wgid % nig) / gsz; return true;
    }
    __device__ __forceinline__ void a_ready(const Unit&) const {}
    __device__ __forceinline__ void done(const Unit&) const {}
};
__device__ __forceinline__ unsigned cvt_pk_bf16(float lo, float hi) { unsigned r; asm volatile("v_cvt_pk_bf16_f32 %0, %1, %2" : "=v"(r) : "v"(lo), "v"(hi)); return r; }
__device__ __forceinline__ float silu_e(float x) { return x * __builtin_amdgcn_rcpf(1.f + __expf(-x)); }

__device__ __forceinline__ void store_unit_bf16(const f32x4 (&acc)[2][2][4][2], bf16_t* base, int ld, int colt, bool act, const Unit& u, int wr, int wc, int fr, int fq) {
    const int row0 = u.pm * BM + wr * 64 + fr; const int col0 = colt + wc * 32 + 8 * fq;
#pragma unroll
    for (int ai = 0; ai < 2; ++ai)
#pragma unroll
        for (int m = 0; m < 4; ++m) { bf16_t* rowp = base + (size_t)(row0 + ai * HALF + m * 16) * ld + col0;
#pragma unroll
            for (int bj = 0; bj < 2; ++bj) { f32x4 v0 = acc[ai][bj][m][0], v1 = acc[ai][bj][m][1];
                if (act) { v0 = (f32x4){silu_e(v0[0]), silu_e(v0[1]), silu_e(v0[2]), silu_e(v0[3])}; v1 = (f32x4){silu_e(v1[0]), silu_e(v1[1]), silu_e(v1[2]), silu_e(v1[3])}; }
                u32x4 w; w.x = cvt_pk_bf16(v0[0], v0[1]); w.y = cvt_pk_bf16(v0[2], v0[3]); w.z = cvt_pk_bf16(v1[0], v1[1]); w.w = cvt_pk_bf16(v1[2], v1[3]);
                *(u32x4*)(rowp + bj * HALF) = w; } }
}
struct EpiProj0 {
    static constexpr bool PERM = true, AFTER_DRAIN = false;
    bf16_t *Y0, *XBC, *Q0, *K0, *V0; float* DTLR;
    __device__ __forceinline__ void operator()(const f32x4 (&acc)[2][2][4][2], const Unit& u, int wr, int wc, int fr, int fq) const {
        const int pn = u.pn;
        if (pn == 22) {
            if (wc < 2) { const int row0 = u.pm * BM + wr * 64 + fr;
#pragma unroll
                for (int ai = 0; ai < 2; ++ai)
#pragma unroll
                    for (int m = 0; m < 4; ++m) { float* rp = DTLR + (size_t)(row0 + ai * HALF + m * 16) * 64 + wc * 32 + 8 * fq; *(f32x4*)rp = acc[ai][0][m][0]; *(f32x4*)(rp + 4) = acc[ai][0][m][1]; } }
            return;
        }
        bf16_t* base; int ld, colt; bool act = false;
        if (pn < 8) { base = Y0; ld = 2048; colt = pn * 256; act = true; }
        else if (pn < 14) { base = XBC; ld = 1536; colt = (pn - 8) * 256; }
        else if (pn < 16) { base = Q0; ld = 512; colt = (pn - 14) * 256; }
        else if (pn < 18) { base = K0; ld = 512; colt = (pn - 16) * 256; }
        else { base = V0; ld = 1024; colt = (pn - 18) * 256; }
        store_unit_bf16(acc, base, ld, colt, act, u, wr, wc, fr, fq);
    }
};
struct EpiProj1 {
    static constexpr bool PERM = true, AFTER_DRAIN = false;
    bf16_t *K1, *V1, *Q1, *G1;
    __device__ __forceinline__ void operator()(const f32x4 (&acc)[2][2][4][2], const Unit& u, int wr, int wc, int fr, int fq) const {
        const int pn = u.pn; bf16_t* base; int ld, colt; bool act = false;
        if (pn < 2) { base = K1; ld = 512; colt = pn * 256; }
        else if (pn < 4) { base = V1; ld = 512; colt = (pn - 2) * 256; }
        else if (pn < 12) { base = Q1; ld = 2048; colt = (pn - 4) * 256; }
        else { base = G1; ld = 2048; colt = (pn - 12) * 256; act = true; }
        store_unit_bf16(acc, base, ld, colt, act, u, wr, wc, fr, fq);
    }
};
struct EpiResid {
    static constexpr bool PERM = false, AFTER_DRAIN = false;
    const float* res; float* out; const float* mod; bool do_store;
    __device__ __forceinline__ void operator()(const f32x4 (&acc)[2][2][4][2], const Unit& u, int wr, int wc, int fr, int fq) const {
        const int b = (u.pm * BM) / 8192; const float* gate = mod + b * 3072 + 2048;
        const int col0 = u.pn * BM + wc * 32 + 4 * fq;
        f32x4 gv[2][2];
#pragma unroll
        for (int bj = 0; bj < 2; ++bj)
#pragma unroll
            for (int n = 0; n < 2; ++n) gv[bj][n] = *(const f32x4*)(gate + col0 + bj * HALF + n * 16);
#pragma unroll
        for (int ai = 0; ai < 2; ++ai)
#pragma unroll
            for (int m = 0; m < 4; ++m) { const size_t off = (size_t)(u.pm * BM + ai * HALF + wr * 64 + m * 16 + fr) * 1024 + col0;
#pragma unroll
                for (int bj = 0; bj < 2; ++bj)
#pragma unroll
                    for (int n = 0; n < 2; ++n) { const f32x4 r = *(const f32x4*)(res + off + bj * HALF + n * 16); const f32x4 ov_ = r + gv[bj][n] * acc[ai][bj][m][n]; if (do_store) *(f32x4*)(out + off + bj * HALF + n * 16) = ov_; } }
    }
};
template <class Epi, class Sched, bool ALIGN_EPI = false, bool SP2 = false>
__device__ __forceinline__ void gemm_phase(PG8_LAS unsigned char* lds, const Gemm g, const Sched& S, const Epi& E) {
    const int tid = threadIdx.x, wid = __builtin_amdgcn_readfirstlane(tid >> 6), lane = tid & 63, wr = wid >> 2, wc = wid & 3, fr = lane & 15, fq = lane >> 4;
    const int K = g.K, nt = K / BK;
    unsigned voffA[2], voffB[2];
#pragma unroll
    for (int i = 0; i < 2; ++i) { int R, C; stage_rc(tid * 16 + i * 8192, R, C); const int Rb = Epi::PERM ? ((R & ~31) + perm32(R & 31)) : R;
        voffA[i] = (unsigned)(R * K + C) * 2u; voffB[i] = (unsigned)(Rb * K + C) * 2u; }
    const size_t kstep = (size_t)(BK * 2);
    const size_t hstep = (size_t)HALF * K * 2;
    const size_t tstep = 2 * hstep;
    const unsigned ldsw = (unsigned)wid * 1024u;
    const int aoff = lds_byte(wr * 64 + fr, fq * 8), boff = lds_byte(wc * 32 + fr, fq * 8);
#define PG8_SA(b, h) (((b) * 2 + (h)) * HTB)
#define PG8_SB(b, h) ((4 + (b) * 2 + (h)) * HTB)
#define PG8_STAGE(bufoff, gbase, voff) do { _Pragma("unroll") for (int _i = 0; _i < 2; ++_i) \
        __builtin_amdgcn_global_load_lds((const unsigned*)((const char*)(gbase) + (voff)[_i]), (PG8_LAS unsigned*)(lds + (bufoff) + ldsw + _i * 8192), 16, 0, 0); } while (0)
#define PG8_LDA(dst, b, h) do { _Pragma("unroll") for (int m = 0; m < 4; ++m) _Pragma("unroll") for (int k = 0; k < 2; ++k) dst[m][k] = *(const PG8_LAS bf16x8*)(lds + PG8_SA(b, h) + aoff + m * 2048 + k * 1024); } while (0)
#define PG8_LDB(dst, b, h) do { _Pragma("unroll") for (int n = 0; n < 2; ++n) _Pragma("unroll") for (int k = 0; k < 2; ++k) dst[n][k] = *(const PG8_LAS bf16x8*)(lds + PG8_SB(b, h) + boff + n * 2048 + k * 1024); } while (0)
#define PG8_MMA(ai, bj, At, Bt) do { __builtin_amdgcn_s_setprio(1); _Pragma("unroll") for (int m = 0; m < 4; ++m) _Pragma("unroll") for (int n = 0; n < 2; ++n) _Pragma("unroll") for (int k = 0; k < 2; ++k) \
        acc[ai][bj][m][n] = __builtin_amdgcn_mfma_f32_16x16x32_bf16(Bt[n][k], At[m][k], acc[ai][bj][m][n], 0, 0, 0); __builtin_amdgcn_s_setprio(0); } while (0)
#define PG8_WAIT_V(n) asm volatile("s_waitcnt vmcnt(" #n ")" ::: "memory")
#define PG8_WAIT_L(n) asm volatile("s_waitcnt lgkmcnt(" #n ")" ::: "memory")
#define PG8_BAR __builtin_amdgcn_s_barrier()
#define PG8_SCHED __builtin_amdgcn_sched_barrier(0)
    Unit cur, nxt; int ui = 0;
    if (!S.next(0, cur)) return;
    f32x4 acc[2][2][4][2];
#pragma unroll
    for (int a = 0; a < 2; ++a)
#pragma unroll
        for (int b = 0; b < 2; ++b)
#pragma unroll
            for (int m = 0; m < 4; ++m)
#pragma unroll
                for (int n = 0; n < 2; ++n) acc[a][b][m][n] = (f32x4){0.f, 0.f, 0.f, 0.f};
    bf16x8 At[4][2], B0[2][2], B1[2][2];
    const char* cA = (const char*)g.A + (size_t)cur.pm * tstep; const char* cB = (const char*)g.Bt + (size_t)cur.pn * tstep;
    S.a_ready(cur);
    if constexpr (SP2) {
        PG8_STAGE(PG8_SB(0, 0), cB, voffB); PG8_STAGE(PG8_SB(0, 1), cB + hstep, voffB); PG8_STAGE(PG8_SA(0, 0), cA, voffA); PG8_STAGE(PG8_SA(0, 1), cA + hstep, voffA);
        if (wr == 1) PG8_BAR;
        PG8_WAIT_V(2); PG8_BAR;
        PG8_STAGE(PG8_SB(1, 0), cB + kstep, voffB); PG8_STAGE(PG8_SA(1, 0), cA + kstep, voffA); PG8_STAGE(PG8_SB(1, 1), cB + hstep + kstep, voffB);
        PG8_WAIT_V(6); PG8_BAR;
    } else {
        PG8_STAGE(PG8_SB(0, 0), cB, voffB); PG8_STAGE(PG8_SA(0, 0), cA, voffA); PG8_STAGE(PG8_SB(0, 1), cB + hstep, voffB); PG8_STAGE(PG8_SA(0, 1), cA + hstep, voffA);
        if (wr == 1) PG8_BAR;
        PG8_WAIT_V(4); PG8_BAR;
        PG8_STAGE(PG8_SB(1, 0), cB + kstep, voffB); PG8_STAGE(PG8_SA(1, 0), cA + kstep, voffA); PG8_STAGE(PG8_SB(1, 1), cB + hstep + kstep, voffB);
        PG8_WAIT_V(6); PG8_BAR;
    }
    for (;;) {
        const bool has_next = S.next(ui + 1, nxt);
        const char* nA = has_next ? (const char*)g.A + (size_t)nxt.pm * tstep : cA; const char* nB = has_next ? (const char*)g.Bt + (size_t)nxt.pn * tstep : cB;
        for (int t = 0; t < nt; t += 2) {
            const bool last = (t == nt - 2);
            const char* a1 = cA + (size_t)(t + 1) * kstep;
            const char* a2 = last ? nA : cA + (size_t)(t + 2) * kstep; const char* b2 = last ? nB : cB + (size_t)(t + 2) * kstep;
            const char* a3 = a2 + kstep; const char* b3 = b2 + kstep;
            if (last && has_next) S.a_ready(nxt);
            if constexpr (SP2) {
            PG8_LDB(B0, 0, 0); PG8_LDB(B1, 0, 1); PG8_SCHED; PG8_LDA(At, 0, 0); PG8_STAGE(PG8_SA(1, 1), a1 + hstep, voffA);
            PG8_WAIT_V(8); PG8_WAIT_L(0); PG8_BAR; PG8_MMA(0, 0, At, B0); PG8_MMA(0, 1, At, B1); PG8_BAR; PG8_SCHED;
            PG8_LDA(At, 0, 1); PG8_STAGE(PG8_SB(0, 0), b2, voffB); PG8_STAGE(PG8_SB(0, 1), b2 + hstep, voffB); PG8_STAGE(PG8_SA(0, 0), a2, voffA);
            PG8_WAIT_V(8); PG8_WAIT_L(0); PG8_BAR; PG8_MMA(1, 0, At, B0); PG8_MMA(1, 1, At, B1); PG8_BAR; PG8_SCHED;
            PG8_LDB(B0, 1, 0); PG8_LDB(B1, 1, 1); PG8_SCHED; PG8_LDA(At, 1, 0); PG8_STAGE(PG8_SA(0, 1), a2 + hstep, voffA);
            PG8_WAIT_V(8); PG8_WAIT_L(0); PG8_BAR; PG8_MMA(0, 0, At, B0); PG8_MMA(0, 1, At, B1); PG8_BAR; PG8_SCHED;
            PG8_LDA(At, 1, 1); PG8_STAGE(PG8_SB(1, 0), b3, voffB); PG8_STAGE(PG8_SB(1, 1), b3 + hstep, voffB); PG8_STAGE(PG8_SA(1, 0), a3, voffA);
            PG8_WAIT_V(8); PG8_WAIT_L(0); PG8_BAR; PG8_MMA(1, 0, At, B0); PG8_MMA(1, 1, At, B1); PG8_BAR; PG8_SCHED;
            } else {
            PG8_LDB(B0, 0, 0); PG8_SCHED; PG8_LDA(At, 0, 0); PG8_STAGE(PG8_SA(1, 1), a1 + hstep, voffA);
            PG8_WAIT_L(8); PG8_BAR; PG8_WAIT_L(0); PG8_MMA(0, 0, At, B0); PG8_BAR; PG8_SCHED;
            PG8_LDB(B1, 0, 1); PG8_STAGE(PG8_SB(0, 0), b2, voffB);
            PG8_BAR; PG8_WAIT_L(0); PG8_MMA(0, 1, At, B1); PG8_BAR;
            PG8_LDA(At, 0, 1); PG8_STAGE(PG8_SA(0, 0), a2, voffA);
            PG8_BAR; PG8_WAIT_L(0); PG8_MMA(1, 0, At, B0); PG8_BAR; PG8_SCHED;
            PG8_STAGE(PG8_SB(0, 1), b2 + hstep, voffB);
            PG8_WAIT_V(6); PG8_BAR; PG8_MMA(1, 1, At, B1); PG8_BAR;
            PG8_LDB(B0, 1, 0); PG8_SCHED; PG8_LDA(At, 1, 0); PG8_STAGE(PG8_SA(0, 1), a2 + hstep, voffA);
            PG8_WAIT_L(8); PG8_BAR; PG8_WAIT_L(0); PG8_MMA(0, 0, At, B0); PG8_BAR; PG8_SCHED;
            PG8_LDB(B1, 1, 1); PG8_STAGE(PG8_SB(1, 0), b3, voffB);
            PG8_BAR; PG8_WAIT_L(0); PG8_MMA(0, 1, At, B1); PG8_BAR;
            PG8_LDA(At, 1, 1); PG8_STAGE(PG8_SA(1, 0), a3, voffA);
            PG8_BAR; PG8_WAIT_L(0); PG8_MMA(1, 0, At, B0); PG8_BAR; PG8_SCHED;
            PG8_STAGE(PG8_SB(1, 1), b3 + hstep, voffB);
            PG8_WAIT_V(6); PG8_BAR; PG8_MMA(1, 1, At, B1); PG8_BAR;
            }
        }
        if constexpr (ALIGN_EPI) { if (wr == 0) PG8_BAR; }
        if constexpr (!Epi::AFTER_DRAIN) { E(acc, cur, wr, wc, fr, fq); S.done(cur); }
        if (!has_next) break;
#pragma unroll
        for (int a = 0; a < 2; ++a)
#pragma unroll
            for (int b = 0; b < 2; ++b)
#pragma unroll
                for (int m = 0; m < 4; ++m)
#pragma unroll
                    for (int n = 0; n < 2; ++n) acc[a][b][m][n] = (f32x4){0.f, 0.f, 0.f, 0.f};
        cur = nxt; cA = nA; cB = nB; ++ui;
        if constexpr (ALIGN_EPI) { if (wr == 1) PG8_BAR; }
    }
    PG8_WAIT_V(0);
    if constexpr (!ALIGN_EPI) { if (wr == 0) PG8_BAR; }
    PG8_BAR;
    if constexpr (Epi::AFTER_DRAIN) { E.fused(acc, cur, wr, wc, fr, fq, lds, wid, lane); S.done(cur); }
#undef PG8_SA
#undef PG8_SB
#undef PG8_STAGE
#undef PG8_LDA
#undef PG8_LDB
#undef PG8_MMA
#undef PG8_WAIT_V
#undef PG8_WAIT_L
#undef PG8_BAR
#undef PG8_SCHED
}
}
#define LAS __attribute__((address_space(3)))
typedef unsigned v4u __attribute__((ext_vector_type(4)));
typedef float f32x4 __attribute__((ext_vector_type(4)));
typedef short bf16x8 __attribute__((ext_vector_type(8)));
#define LDS_WAIT() asm volatile("s_waitcnt lgkmcnt(0)" ::: "memory")
constexpr int NWAVES = 8;
constexpr int LDS_BYTES = 147456;
constexpr int MISC_OFF = 147456 - 128;

struct Params { const float* in[26]; float* out; unsigned char* ws; int ph_lo, ph_hi, rep, pad; };

DEV float wave_sum(float v) {
#pragma unroll
  for (int o = 1; o < 64; o <<= 1) v += __shfl_xor(v, o);
  return v;
}

DEV int w1_dest_row(int n) {
  if (n < 1024) return n;
  if (n < 2560) return 2048 + (n - 1024);
  if (n < 2592) return 5632 + (n - 2560);
  if (n < 3104) return 3584 + (n - 2592);
  if (n < 3616) return 4096 + (n - 3104);
  if (n < 4640) return 4608 + (n - 3616);
  if (n < 5664) return 1024 + (n - 4640);
  return n;
}
DEV void transpose_item(const float* W, int K, int N, int k0, int n0, bf16_t* WT, int drow0, LAS float* scr, int lane) {
#pragma unroll 8
  for (int i = 0; i < 32; ++i) { const int kk = 2 * i + (lane >> 5); scr[kk * 33 + (lane & 31)] = W[(size_t)(k0 + kk) * N + n0 + (lane & 31)]; }
  LDS_WAIT(); asm volatile("" ::: "memory");
  const int c = lane & 7;
#pragma unroll
  for (int j = 0; j < 4; ++j) { const int n = (lane >> 3) + 8 * j; const LAS float* s = scr + (8 * c) * 33 + n;
    v4u o; o.x = pk2(s[0 * 33], s[1 * 33]); o.y = pk2(s[2 * 33], s[3 * 33]); o.z = pk2(s[4 * 33], s[5 * 33]); o.w = pk2(s[6 * 33], s[7 * 33]);
    *(v4u*)(WT + (size_t)(drow0 + n) * K + k0 + 8 * c) = o; }
  LDS_WAIT(); asm volatile("" ::: "memory");
}
DEV void prologue_phase(const Params& p, LAS unsigned char* lds) {
  const int tid = threadIdx.x, lane = tid & 63, wave = tid >> 6;
  unsigned char* ws = p.ws;
  float* MOD = (float*)(ws + WS_MOD);
  {
    LAS float* sc = (LAS float*)lds;
    LAS float* part = (LAS float*)(lds + 12288);
    for (int i = tid; i < 3072; i += 512) { const int v = i >> 10, k = i & 1023; const float cv = v < 2 ? p.in[1][v * 1024 + k] : p.in[3][k]; sc[i] = siluf(cv); }
    __syncthreads();
    for (int task = blockIdx.x; task < 96; task += gridDim.x) {
      const int l = task / 48, n0 = (task % 48) * 64; const float* w = l ? p.in[19] : p.in[5]; const float* bb = l ? p.in[20] : p.in[6];
      const int col = tid & 63, ks = tid >> 6;
      float a0 = 0.f, a1 = 0.f, a2 = 0.f;
#pragma unroll 8
      for (int k = ks * 128; k < ks * 128 + 128; ++k) { const float wv = w[(size_t)k * 3072 + n0 + col]; a0 += sc[k] * wv; a1 += sc[1024 + k] * wv; a2 += sc[2048 + k] * wv; }
      part[(ks * 3 + 0) * 64 + col] = a0; part[(ks * 3 + 1) * 64 + col] = a1; part[(ks * 3 + 2) * 64 + col] = a2;
      __syncthreads();
      if (tid < 192) { const int v = tid >> 6; float s = bb[n0 + col];
#pragma unroll
        for (int q = 0; q < 8; ++q) s += part[(q * 3 + v) * 64 + col];
        MOD[(l * 3 + v) * 3072 + n0 + col] = s; }
      __syncthreads();
    }
  }
  if (blockIdx.x == gridDim.x - 1) { float* rope = (float*)(ws + WS_ROPE);
    for (int idx = tid; idx < 4096; idx += 512) { const int pos = idx >> 5, f = idx & 31; const float inv = 1.0f / powf(10000.f, (float)f / 32.f); const float ang = (float)pos * inv; rope[idx] = cosf(ang); rope[4096 + idx] = sinf(ang); } }
  { v4u* z = (v4u*)(ws + WS_W1T + (size_t)E_IN * 1024 * 2); const v4u zero = {0u, 0u, 0u, 0u};
    for (int i = blockIdx.x * 512 + tid; i < (E_INP - E_IN) * 1024 * 2 / 16; i += gridDim.x * 512) z[i] = zero; }
  __syncthreads();
  {
    LAS float* scr = (LAS float*)(lds + wave * 16384);
    const int gw = blockIdx.x * NWAVES + wave, NGW = gridDim.x * NWAVES;
    constexpr int I1 = 16 * 178, I2 = 32 * 32, I3 = 16 * 160, I4 = 32 * 32;
    for (int it = gw; it < I1 + I2 + I3 + I4; it += NGW) {
      int r = it;
      if (r < I1) { const int kb = r / 178, nb = r % 178; transpose_item(p.in[7], 1024, E_IN, 64 * kb, 32 * nb, (bf16_t*)(ws + WS_W1T), w1_dest_row(32 * nb), scr, lane); continue; } r -= I1;
      if (r < I2) { const int kb = r / 32, nb = r % 32; transpose_item(p.in[17], 2048, 1024, 64 * kb, 32 * nb, (bf16_t*)(ws + WS_W2T), 32 * nb, scr, lane); continue; } r -= I2;
      if (r < I3) { const int kb = r / 160, nb = r % 160; transpose_item(p.in[21], 1024, O_IN, 64 * kb, 32 * nb, (bf16_t*)(ws + WS_W3T), 32 * nb, scr, lane); continue; } r -= I3;
      { const int kb = r / 32, nb = r % 32; transpose_item(p.in[25], 2048, 1024, 64 * kb, 32 * nb, (bf16_t*)(ws + WS_W4T), 32 * nb, scr, lane); }
    }
  }
}
DEV void prep_phase(const float* xlat, const float* xctx, const float* g, const float* mod, bf16_t* H) {
  const int lane = threadIdx.x & 63, wave = threadIdx.x >> 6;
  for (int row = blockIdx.x * NWAVES + wave; row < MA; row += gridDim.x * NWAVES) {
    const float* src = row < ML ? xlat + (size_t)row * D : xctx + (size_t)(row - ML) * D;
    const float* m = mod + row_vec(row) * 3072;
    f32x4 v[4]; float ss = 0.f;
#pragma unroll
    for (int j = 0; j < 4; ++j) { v[j] = *(const f32x4*)(src + 4 * lane + 256 * j); ss += (v[j].x * v[j].x + v[j].y * v[j].y) + (v[j].z * v[j].z + v[j].w * v[j].w); }
    const float rstd = rsqrtf(wave_sum(ss) * (1.f / D) + EPS);
#pragma unroll
    for (int j = 0; j < 4; ++j) { const int k = 4 * lane + 256 * j;
      const f32x4 gg = *(const f32x4*)(g + k), sc = *(const f32x4*)(m + 1024 + k), sh = *(const f32x4*)(m + k);
      const f32x4 o = v[j] * rstd * gg * (sc + 1.f) + sh;
      *(unsigned long long*)(H + (size_t)row * D + k) = (unsigned long long)pk2(o.x, o.y) | ((unsigned long long)pk2(o.z, o.w) << 32); }
  }
}
template <class F> DEV void small_gemm(const bf16_t* A, int lda, const bf16_t* Bt, int ldb, int K, int Mrows, int Ncols, F f) {
  const int lane = threadIdx.x & 63, wid = threadIdx.x >> 6, mt = wid >> 2, nt = wid & 3, r = lane & 15, q = lane >> 4;
  const int ntn = Ncols / 64, ntasks = (Mrows / 32) * ntn;
  for (int task = blockIdx.x; task < ntasks; task += gridDim.x) {
    const int row0 = (task / ntn) * 32 + mt * 16, col0 = (task % ntn) * 64 + nt * 16;
    const bf16_t* ap = A + (size_t)(row0 + r) * lda + 8 * q; const bf16_t* bp = Bt + (size_t)(col0 + r) * ldb + 8 * q;
    f32x4 acc = {0.f, 0.f, 0.f, 0.f};
#pragma unroll 8
    for (int k = 0; k < K; k += 32) { const bf16x8 a = *(const bf16x8*)(ap + k), b = *(const bf16x8*)(bp + k); acc = __builtin_amdgcn_mfma_f32_16x16x32_bf16(a, b, acc, 0, 0, 0); }
#pragma unroll
    for (int j = 0; j < 4; ++j) f(row0 + q * 4 + j, col0 + r, acc[j]);
  }
}

DEV void qknorm_phase(bf16_t* Q1, bf16_t* K1, const float* qn, const float* kn, const float* rope, bool wr) {
  const int lane = threadIdx.x & 63, wave = threadIdx.x >> 6, hl = lane >> 4, d0 = (lane & 15) * 8;
  const float scale = 0.08838834764831845f;
  float gq[8], gk[8];
#pragma unroll
  for (int e = 0; e < 8; ++e) { gq[e] = qn[d0 + e] * scale; gk[e] = kn[d0 + e]; }
  const int ax = d0 >> 6, sgn = (d0 >> 5) & 1, f0 = d0 & 31;
  for (int row = blockIdx.x * NWAVES + wave; row < MA; row += gridDim.x * NWAVES) {
    const bool lat = row < ML;
    v4u raw[5];
    raw[0] = *(const v4u*)(K1 + (size_t)row * 512 + hl * 128 + d0);
    if (lat) {
#pragma unroll
      for (int g = 0; g < 4; ++g) raw[1 + g] = *(const v4u*)(Q1 + (size_t)row * 2048 + (g * 4 + hl) * 128 + d0);
    }
    float cs[8], sn[8];
    if (lat) { const int t = row % SEQ, pos = ax ? (t & 63) : (t >> 6);
      const f32x4 c0 = *(const f32x4*)(rope + pos * 32 + f0), c1 = *(const f32x4*)(rope + pos * 32 + f0 + 4), s0 = *(const f32x4*)(rope + 4096 + pos * 32 + f0), s1 = *(const f32x4*)(rope + 4096 + pos * 32 + f0 + 4);
      cs[0] = c0.x; cs[1] = c0.y; cs[2] = c0.z; cs[3] = c0.w; cs[4] = c1.x; cs[5] = c1.y; cs[6] = c1.z; cs[7] = c1.w;
      sn[0] = s0.x; sn[1] = s0.y; sn[2] = s0.z; sn[3] = s0.w; sn[4] = s1.x; sn[5] = s1.y; sn[6] = s1.z; sn[7] = s1.w; }
    const int ng = lat ? 5 : 1;
#pragma unroll
    for (int g = 0; g < 5; ++g) {
      if (g < ng) {
        const v4u rv = raw[g];
        float v[8] = {__uint_as_float(rv.x << 16), __uint_as_float(rv.x & 0xffff0000u), __uint_as_float(rv.y << 16), __uint_as_float(rv.y & 0xffff0000u), __uint_as_float(rv.z << 16), __uint_as_float(rv.z & 0xffff0000u), __uint_as_float(rv.w << 16), __uint_as_float(rv.w & 0xffff0000u)};
        float ss = 0.f;
#pragma unroll
        for (int e = 0; e < 8; ++e) ss += v[e] * v[e];
        ss += __shfl_xor(ss, 1); ss += __shfl_xor(ss, 2); ss += __shfl_xor(ss, 4); ss += __shfl_xor(ss, 8);
        const float rstd = rsqrtf(ss * (1.f / 128.f) + EPS);
#pragma unroll
        for (int e = 0; e < 8; ++e) v[e] *= rstd * (g == 0 ? gk[e] : gq[e]);
        if (lat) {
#pragma unroll
          for (int e = 0; e < 8; ++e) { const float o = __shfl_xor(v[e], 4); v[e] = sgn ? (v[e] * cs[e] + o * sn[e]) : (v[e] * cs[e] - o * sn[e]); }
        }
        v4u ov; ov.x = pk2(v[0], v[1]); ov.y = pk2(v[2], v[3]); ov.z = pk2(v[4], v[5]); ov.w = pk2(v[6], v[7]);
        if (wr) { if (g == 0) *(v4u*)(K1 + (size_t)row * 512 + hl * 128 + d0) = ov; else *(v4u*)(Q1 + (size_t)row * 2048 + ((g - 1) * 4 + hl) * 128 + d0) = ov; }
      }
    }
  }
}
typedef short s16x4 __attribute__((ext_vector_type(4)));
DEV s16x4 tr_read(const LAS bf16_t* p) { return __builtin_bit_cast(s16x4, __builtin_amdgcn_ds_read_tr16_b64_v4i16((LAS s16x4*)p)); }
DEV void attn_phase(bf16_t* Q1, const bf16_t* K1, const bf16_t* V1, const bf16_t* G1, const float* sink, const float* qn, const float* kn, LAS unsigned char* lds, bool wr) {
  constexpr int KP = 136, VP = 144;
  LAS bf16_t* Ks = (LAS bf16_t*)lds;
  LAS bf16_t* Vs = (LAS bf16_t*)(lds + 2 * 64 * KP * 2);
  LAS float* dsc = (LAS float*)(lds + 2 * 64 * KP * 2 + 2 * 64 * VP * 2);
  const int tid = threadIdx.x, lane = tid & 63, wid = tid >> 6, r = lane & 15, Qd = lane >> 4;
  float mb;
  { float a = fmaxf(fabsf(qn[lane]), fabsf(qn[64 + lane])), b = fmaxf(fabsf(kn[lane]), fabsf(kn[64 + lane]));
#pragma unroll
    for (int o = 1; o < 64; o <<= 1) { a = fmaxf(a, __shfl_xor(a, o)); b = fmaxf(b, __shfl_xor(b, o)); }
    mb = a * b * 11.313708498984761f; }
  for (int task = blockIdx.x; task < 1024; task += gridDim.x) {
    const int b = task >> 9, kvh = (task >> 7) & 3, qt = task & 127;
    const int hq = kvh * 4 + (wid >> 1), qoff = (wid & 1) * 32;
    const size_t qrow0 = (size_t)b * SEQ + qt * 64 + qoff;
    bf16x8 qf[2][4];
#pragma unroll
    for (int m = 0; m < 2; ++m)
#pragma unroll
      for (int ks = 0; ks < 4; ++ks) qf[m][ks] = *(const bf16x8*)(Q1 + (qrow0 + 16 * m + r) * 2048 + hq * 128 + ks * 32 + 8 * Qd);
    const int tlo = (2 - qt) > 0 ? (2 - qt) : 0, thi = (129 - qt) < 4 ? (129 - qt) : 4, nband = thi - tlo + 1, ntile = nband + 4;
    const int skey = tid >> 4, sch = tid & 15;
    v4u kreg[2], vreg[2];
#define TILE_ROW0(i) ((i) < nband ? (size_t)b * SEQ + (size_t)(qt - 2 + tlo + (i)) * 64 : (size_t)ML + b * CTXL + ((i) - nband) * 64)
#define LOAD_TILE(i) do { const size_t r0_ = TILE_ROW0(i); _Pragma("unroll") for (int h_ = 0; h_ < 2; ++h_) { const size_t go_ = (r0_ + skey + 32 * h_) * 512 + kvh * 128 + sch * 8; kreg[h_] = *(const v4u*)(K1 + go_); vreg[h_] = *(const v4u*)(V1 + go_); } } while (0)
#define STORE_TILE(buf) do { _Pragma("unroll") for (int h_ = 0; h_ < 2; ++h_) { *(LAS v4u*)(Ks + (buf) * 64 * KP + (skey + 32 * h_) * KP + sch * 8) = kreg[h_]; *(LAS v4u*)(Vs + (buf) * 64 * VP + (skey + 32 * h_) * VP + sch * 8) = vreg[h_]; } } while (0)
    LOAD_TILE(0);
    __syncthreads();
    STORE_TILE(0);
    __syncthreads();
    f32x4 o[2][8];
#pragma unroll
    for (int m = 0; m < 2; ++m)
#pragma unroll
      for (int n = 0; n < 8; ++n) o[m][n] = (f32x4){0.f, 0.f, 0.f, 0.f};
    float lsum[2] = {0.f, 0.f};
    for (int i = 0; i < ntile; ++i) {
      const int buf = i & 1;
      if (i + 1 < ntile) LOAD_TILE(i + 1);
      const int mtype = (i < nband) ? ((tlo + i) == 0 ? 1 : ((tlo + i) == 4 ? 2 : 0)) : 0;
      const LAS bf16_t* Kb = Ks + buf * 64 * KP; const LAS bf16_t* Vb = Vs + buf * 64 * VP;
      f32x4 s[4][2];
#pragma unroll
      for (int t = 0; t < 4; ++t) { s[t][0] = (f32x4){0.f, 0.f, 0.f, 0.f}; s[t][1] = (f32x4){0.f, 0.f, 0.f, 0.f}; }
#pragma unroll
      for (int ks = 0; ks < 4; ++ks)
#pragma unroll
        for (int t = 0; t < 4; ++t) { const bf16x8 kf = *(const LAS bf16x8*)(Kb + (16 * t + r) * KP + ks * 32 + 8 * Qd);
          s[t][0] = __builtin_amdgcn_mfma_f32_16x16x32_bf16(kf, qf[0][ks], s[t][0], 0, 0, 0);
          s[t][1] = __builtin_amdgcn_mfma_f32_16x16x32_bf16(kf, qf[1][ks], s[t][1], 0, 0, 0); }
      bf16x8 pa[2][2];
#pragma unroll
      for (int m = 0; m < 2; ++m) { const int qi = qoff + 16 * m + r;
#pragma unroll
        for (int t = 0; t < 4; ++t) {
          float pv[4];
#pragma unroll
          for (int j = 0; j < 4; ++j) { const int kj = 16 * t + 4 * Qd + j; float pj = __expf(s[t][m][j] - mb);
            if (mtype == 1) pj = (kj >= qi) ? pj : 0.f; else if (mtype == 2) pj = (kj <= qi) ? pj : 0.f;
            pv[j] = pj; lsum[m] += pj; }
          const unsigned w0 = pk2(pv[0], pv[1]), w1 = pk2(pv[2], pv[3]);
          pa[m][t >> 1][(t & 1) * 4 + 0] = (short)(w0 & 0xffff); pa[m][t >> 1][(t & 1) * 4 + 1] = (short)(w0 >> 16);
          pa[m][t >> 1][(t & 1) * 4 + 2] = (short)(w1 & 0xffff); pa[m][t >> 1][(t & 1) * 4 + 3] = (short)(w1 >> 16); } }
#pragma unroll
      for (int k2 = 0; k2 < 2; ++k2)
#pragma unroll
        for (int n = 0; n < 8; ++n) {
          const s16x4 lo = tr_read(Vb + (32 * k2 + 4 * Qd + (r >> 2)) * VP + 16 * n + 4 * (r & 3));
          const s16x4 hi = tr_read(Vb + (32 * k2 + 16 + 4 * Qd + (r >> 2)) * VP + 16 * n + 4 * (r & 3));
          const bf16x8 vf = (bf16x8){lo[0], lo[1], lo[2], lo[3], hi[0], hi[1], hi[2], hi[3]};
          o[0][n] = __builtin_amdgcn_mfma_f32_16x16x32_bf16(pa[0][k2], vf, o[0][n], 0, 0, 0);
          o[1][n] = __builtin_amdgcn_mfma_f32_16x16x32_bf16(pa[1][k2], vf, o[1][n], 0, 0, 0); }
      if (i + 1 < ntile) STORE_TILE(buf ^ 1);
      __syncthreads();
    }
#undef TILE_ROW0
#undef LOAD_TILE
#undef STORE_TILE
    const float sk = __expf(sink[hq] - mb);
#pragma unroll
    for (int m = 0; m < 2; ++m) { float l = lsum[m]; l += __shfl_xor(l, 16); l += __shfl_xor(l, 32); if (Qd == 0) dsc[wid * 32 + 16 * m + r] = 1.f / (l + sk); }
    LDS_WAIT(); asm volatile("" ::: "memory");
#pragma unroll
    for (int m = 0; m < 2; ++m)
#pragma unroll
      for (int j = 0; j < 4; ++j) { const float inv = dsc[wid * 32 + 16 * m + 4 * Qd + j]; const size_t ro = (qrow0 + 16 * m + 4 * Qd + j) * 2048 + hq * 128 + r;
#pragma unroll
        for (int n = 0; n < 8; ++n) { const bf16_t ov_ = f2bf(o[m][n][j] * inv * bf2f(G1[ro + 16 * n])); if (wr) Q1[ro + 16 * n] = ov_; } }
    LDS_WAIT(); asm volatile("" ::: "memory");
  }
}

constexpr size_t DO_SDT = 50 * MiB, DO_SCS = 53 * MiB;
constexpr size_t WS_SSQ = 237 * MiB;
DEV unsigned short bfbits(float f) { return f2bf(f); }
DEV void ssd_prep_phase(const bf16_t* XBC, const float* cw, const float* cb, bf16_t* XC, const float* DTLR, const float* dt_bias, const float* a_log, float* SDT, float* SCS, float* SDEC) {
  const int gtid = blockIdx.x * 512 + threadIdx.x, gth = gridDim.x * 512;
  for (int it = gtid; it < MA * 192; it += gth) {
    const int row = it / 192, c8 = (it % 192) * 8;
    int t, len;
    if (row < ML) { t = row % SEQ; len = SEQ; } else { t = (row - ML) % CTXL; len = CTXL; }
    float acc[8];
    { const f32x4 b0 = *(const f32x4*)(cb + c8), b1 = *(const f32x4*)(cb + c8 + 4); acc[0] = b0.x; acc[1] = b0.y; acc[2] = b0.z; acc[3] = b0.w; acc[4] = b1.x; acc[5] = b1.y; acc[6] = b1.z; acc[7] = b1.w; }
#pragma unroll
    for (int k = 0; k < 5; ++k) { const int tt = t + k - 2;
      if (tt >= 0 && tt < len) { const v4u xv = *(const v4u*)(XBC + (size_t)(row + k - 2) * 1536 + c8); const f32x4 w0 = *(const f32x4*)(cw + k * 1536 + c8), w1 = *(const f32x4*)(cw + k * 1536 + c8 + 4);
        acc[0] += w0.x * __uint_as_float(xv.x << 16); acc[1] += w0.y * __uint_as_float(xv.x & 0xffff0000u); acc[2] += w0.z * __uint_as_float(xv.y << 16); acc[3] += w0.w * __uint_as_float(xv.y & 0xffff0000u);
        acc[4] += w1.x * __uint_as_float(xv.z << 16); acc[5] += w1.y * __uint_as_float(xv.z & 0xffff0000u); acc[6] += w1.z * __uint_as_float(xv.w << 16); acc[7] += w1.w * __uint_as_float(xv.w & 0xffff0000u); } }
    v4u o; o.x = pk2(silu_fast(acc[0]), silu_fast(acc[1])); o.y = pk2(silu_fast(acc[2]), silu_fast(acc[3])); o.z = pk2(silu_fast(acc[4]), silu_fast(acc[5])); o.w = pk2(silu_fast(acc[6]), silu_fast(acc[7]));
    *(v4u*)(XC + (size_t)row * 1536 + c8) = o;
  }
  {
    const int lane = threadIdx.x & 63, wave = threadIdx.x >> 6, cl = lane & 7, seg = lane >> 3;
    for (int wt = blockIdx.x * NWAVES + wave; wt < NCH * 4; wt += gridDim.x * NWAVES) {
      const int gc = wt >> 2, col = (wt & 3) * 8 + cl, dir = col >> 4, h = col & 15;
      const float a = -__expf(a_log[col]), bias = dt_bias[col];
      float dtv[16], v[16]; float run = 0.f;
#pragma unroll
      for (int u = 0; u < 16; ++u) { const int s = seg * 16 + u, t = dir ? 127 - s : s; dtv[u] = softplusf(DTLR[((size_t)gc * 128 + t) * 64 + col] + bias); }
#pragma unroll
      for (int u = 0; u < 16; ++u) { run += dtv[u] * a; v[u] = run; }
      float off = 0.f;
#pragma unroll
      for (int sgi = 0; sgi < 7; ++sgi) { const float tot = __shfl(run, cl + 8 * sgi); off += (sgi < seg) ? tot : 0.f; }
#pragma unroll
      for (int u = 0; u < 16; ++u) { const int s = seg * 16 + u, t = dir ? 127 - s : s; const size_t row = (size_t)gc * 128 + t; SDT[row * 32 + col] = dtv[u]; SCS[row * 32 + col] = v[u] + off; }
      if (seg == 7) SDEC[(gc * 16 + h) * 2 + dir] = __expf(run + off);
    }
  }
}
DEV void ssd_u_phase(const bf16_t* XC, const float* SDT, const float* SCS, bf16_t* ST, LAS unsigned char* lds) {
  constexpr int XP = 272, BP = 144;
  LAS bf16_t* Xs = (LAS bf16_t*)lds; LAS bf16_t* Bs = (LAS bf16_t*)(lds + 128 * XP * 2); LAS float* wtab = (LAS float*)(lds + 128 * XP * 2 + 128 * BP * 2);
  const int tid = threadIdx.x, lane = tid & 63, wid = tid >> 6, r = lane & 15, Qd = lane >> 4, hl = wid >> 1, dir = wid & 1;
  for (int task = blockIdx.x; task < NCH * 4; task += gridDim.x) {
    const int gc = task >> 2, g = (task >> 1) & 1, hh = task & 1; const size_t r0 = (size_t)gc * 128; const int h0 = g * 8 + hh * 4;
    __syncthreads();
#pragma unroll
    for (int i = 0; i < 8; ++i) { const int cid = tid + 512 * i, row = cid >> 5, ch = cid & 31; *(LAS v4u*)(Xs + row * XP + ch * 8) = *(const v4u*)(XC + (r0 + row) * 1536 + h0 * 64 + ch * 8); }
#pragma unroll
    for (int i = 0; i < 4; ++i) { const int cid = tid + 512 * i, row = cid >> 4, ch = cid & 15; *(LAS v4u*)(Bs + row * BP + ch * 8) = *(const v4u*)(XC + (r0 + row) * 1536 + 1024 + g * 128 + ch * 8); }
#pragma unroll
    for (int i = 0; i < 2; ++i) { const int e = tid + 512 * i, combo = e >> 7, t = e & 127, col = (combo & 1) * 16 + h0 + (combo >> 1);
      const float cs_end = SCS[(r0 + ((combo & 1) ? 0 : 127)) * 32 + col]; wtab[e] = __expf(cs_end - SCS[(r0 + t) * 32 + col]) * SDT[(r0 + t) * 32 + col]; }
    __syncthreads();
    const LAS float* wt = wtab + wid * 128;
    bf16_t* Sp = ST + ((((size_t)gc * 16 + h0 + hl) * 2 + dir) * 64) * 128;
#pragma unroll 1
    for (int pp = 0; pp < 2; ++pp) {
      f32x4 acc[8][2];
#pragma unroll
      for (int nt = 0; nt < 8; ++nt) { acc[nt][0] = (f32x4){0.f, 0.f, 0.f, 0.f}; acc[nt][1] = (f32x4){0.f, 0.f, 0.f, 0.f}; }
#pragma unroll 1
      for (int k = 0; k < 4; ++k) {
        const f32x4 wlo = *(const LAS f32x4*)(wt + 32 * k + 4 * Qd), whi = *(const LAS f32x4*)(wt + 32 * k + 16 + 4 * Qd);
        bf16x8 xf[2];
#pragma unroll
        for (int pt = 0; pt < 2; ++pt) {
          const s16x4 lo = tr_read(Xs + (32 * k + 4 * Qd + (r >> 2)) * XP + hl * 64 + 32 * pp + 16 * pt + 4 * (r & 3));
          const s16x4 hi = tr_read(Xs + (32 * k + 16 + 4 * Qd + (r >> 2)) * XP + hl * 64 + 32 * pp + 16 * pt + 4 * (r & 3));
          const unsigned w0 = pk2(bf2f((bf16_t)lo[0]) * wlo[0], bf2f((bf16_t)lo[1]) * wlo[1]), w1 = pk2(bf2f((bf16_t)lo[2]) * wlo[2], bf2f((bf16_t)lo[3]) * wlo[3]);
          const unsigned w2 = pk2(bf2f((bf16_t)hi[0]) * whi[0], bf2f((bf16_t)hi[1]) * whi[1]), w3 = pk2(bf2f((bf16_t)hi[2]) * whi[2], bf2f((bf16_t)hi[3]) * whi[3]);
          xf[pt] = (bf16x8){(short)(w0 & 0xffff), (short)(w0 >> 16), (short)(w1 & 0xffff), (short)(w1 >> 16), (short)(w2 & 0xffff), (short)(w2 >> 16), (short)(w3 & 0xffff), (short)(w3 >> 16)};
        }
#pragma unroll
        for (int nt = 0; nt < 8; ++nt) {
          const s16x4 lo = tr_read(Bs + (32 * k + 4 * Qd + (r >> 2)) * BP + 16 * nt + 4 * (r & 3));
          const s16x4 hi = tr_read(Bs + (32 * k + 16 + 4 * Qd + (r >> 2)) * BP + 16 * nt + 4 * (r & 3));
          const bf16x8 bfr = (bf16x8){lo[0], lo[1], lo[2], lo[3], hi[0], hi[1], hi[2], hi[3]};
          acc[nt][0] = __builtin_amdgcn_mfma_f32_16x16x32_bf16(bfr, xf[0], acc[nt][0], 0, 0, 0);
          acc[nt][1] = __builtin_amdgcn_mfma_f32_16x16x32_bf16(bfr, xf[1], acc[nt][1], 0, 0, 0);
        }
      }
#pragma unroll
      for (int nt = 0; nt < 8; ++nt)
#pragma unroll
        for (int pt = 0; pt < 2; ++pt) { const f32x4 v = acc[nt][pt];
          *(unsigned long long*)(Sp + ((((2 * pp + pt) * 4 + (nt >> 1)) * 64 + ((nt & 1) * 2 + (Qd >> 1)) * 16 + r) * 8 + 4 * (Qd & 1))) = (unsigned long long)pk2(v[0], v[1]) | ((unsigned long long)pk2(v[2], v[3]) << 32); }
    }
  }
}
DEV void ssd_scan_phase(bf16_t* ST, const float* SDEC, bool wr) {
  for (int item = blockIdx.x * 512 + threadIdx.x; item < 2 * 16 * 2 * 2048; item += gridDim.x * 512) {
    const int e4 = item & 2047, dir = (item >> 11) & 1, h = (item >> 12) & 15, b = item >> 16;
    float S0 = 0.f, S1 = 0.f, S2 = 0.f, S3 = 0.f;
#define SCAN_GC(s) (!dir ? ((s) < 2 ? 128 + 2 * b + (s) : b * 64 + ((s) - 2)) : ((s) < 2 ? 128 + 2 * b + (1 - (s)) : b * 64 + (65 - (s))))
    for (int s0 = 0; s0 < 66; s0 += 6) {
      unsigned long long u[6]; float dec[6];
#pragma unroll
      for (int q = 0; q < 6; ++q) { const int gc = SCAN_GC(s0 + q); u[q] = *(const unsigned long long*)(ST + (((size_t)gc * 16 + h) * 2 + dir) * 8192 + e4 * 4); dec[q] = SDEC[(gc * 16 + h) * 2 + dir]; }
#pragma unroll
      for (int q = 0; q < 6; ++q) { const int gc = SCAN_GC(s0 + q);
        if (wr) *(unsigned long long*)(ST + (((size_t)gc * 16 + h) * 2 + dir) * 8192 + e4 * 4) = (unsigned long long)pk2(S0, S1) | ((unsigned long long)pk2(S2, S3) << 32);
        const unsigned lo = (unsigned)u[q], hi = (unsigned)(u[q] >> 32);
        S0 = dec[q] * S0 + __uint_as_float(lo << 16); S1 = dec[q] * S1 + __uint_as_float(lo & 0xffff0000u); S2 = dec[q] * S2 + __uint_as_float(hi << 16); S3 = dec[q] * S3 + __uint_as_float(hi & 0xffff0000u); }
    }
#undef SCAN_GC
  }
}
DEV bf16x8 scale_frag(bf16x8 f, float s) {
  bf16x8 o;
#pragma unroll
  for (int e = 0; e < 8; e += 2) { const unsigned w = pk2(bf2f((bf16_t)f[e]) * s, bf2f((bf16_t)f[e + 1]) * s); o[e] = (short)(w & 0xffff); o[e + 1] = (short)(w >> 16); }
  return o;
}
DEV void ssd_y_phase(const bf16_t* XC, const float* SDT, const float* SCS, const bf16_t* ST, const float* d_skip, bf16_t* Y0, float* SSQ, LAS unsigned char* lds, bool wr) {
  constexpr int XP = 272, BP = 136, SP = 72;
  LAS bf16_t* Xs = (LAS bf16_t*)lds; LAS bf16_t* Bs = (LAS bf16_t*)(lds + 128 * XP * 2);
  LAS float* tab = (LAS float*)(lds + 128 * XP * 2 + 128 * BP * 2);
  LAS float* ssq = tab + 4 * 4 * 128;
  LAS bf16_t* stg = (LAS bf16_t*)(ssq + 4 * 128);
  const int tid = threadIdx.x, lane = tid & 63, wid = tid >> 6, r = lane & 15, Qd = lane >> 4, hl = wid >> 1, ih = wid & 1;
  LAS bf16_t* mystg = stg + wid * 16 * SP;
  for (int task = blockIdx.x; task < NCH * 4; task += gridDim.x) {
    const int gc = task >> 2, g = (task >> 1) & 1, hh = task & 1; const size_t r0 = (size_t)gc * 128; const int h0 = g * 8 + hh * 4, h = h0 + hl;
    bf16x8 cf[4][4];
#pragma unroll
    for (int m = 0; m < 4; ++m)
#pragma unroll
      for (int ks = 0; ks < 4; ++ks) cf[m][ks] = *(const bf16x8*)(XC + (r0 + 64 * ih + 16 * m + r) * 1536 + 1280 + g * 128 + 32 * ks + 8 * Qd);
    __syncthreads();
#pragma unroll
    for (int i = 0; i < 8; ++i) { const int cid = tid + 512 * i, row = cid >> 5, ch = cid & 31; *(LAS v4u*)(Xs + row * XP + ch * 8) = *(const v4u*)(XC + (r0 + row) * 1536 + h0 * 64 + ch * 8); }
#pragma unroll
    for (int i = 0; i < 4; ++i) { const int cid = tid + 512 * i, row = cid >> 4, ch = cid & 15; *(LAS v4u*)(Bs + row * BP + ch * 8) = *(const v4u*)(XC + (r0 + row) * 1536 + 1024 + g * 128 + ch * 8); }
#pragma unroll
    for (int i = 0; i < 4; ++i) { const int e = tid + 512 * i, hq = e >> 9, which = (e >> 7) & 3, t = e & 127; const int col = (which & 1) * 16 + h0 + hq;
      tab[e] = (which < 2 ? SCS : SDT)[(r0 + t) * 32 + col]; }
    __syncthreads();
    const LAS float* csf = tab + hl * 512; const LAS float* csb = csf + 128; const LAS float* dtf = csf + 256; const LAS float* dtb = csf + 384;
    const float dsk = d_skip[h];
    f32x4 y[4][4];
#pragma unroll
    for (int m = 0; m < 4; ++m)
#pragma unroll
      for (int pt = 0; pt < 4; ++pt) y[m][pt] = (f32x4){0.f, 0.f, 0.f, 0.f};
#pragma unroll 1
    for (int dir = 0; dir < 2; ++dir) {
      const LAS float* csd = dir ? csb : csf; float sc[4];
#pragma unroll
      for (int m = 0; m < 4; ++m)
#pragma unroll
        for (int ks = 0; ks < 4; ++ks) asm volatile("" : "+v"(cf[m][ks]));
#pragma unroll
      for (int m = 0; m < 4; ++m) sc[m] = __expf(csd[64 * ih + 16 * m + r]);
      const bf16_t* Sp = ST + (((size_t)gc * 16 + h) * 2 + dir) * 8192 + lane * 8;
#pragma unroll
      for (int ks = 0; ks < 4; ++ks) {
        bf16x8 sf[4];
#pragma unroll
        for (int pt = 0; pt < 4; ++pt) sf[pt] = *(const bf16x8*)(Sp + (pt * 4 + ks) * 512);
#pragma unroll
        for (int m = 0; m < 4; ++m) { const bf16x8 a = scale_frag(cf[m][ks], sc[m]);
#pragma unroll
          for (int pt = 0; pt < 4; ++pt) y[m][pt] = __builtin_amdgcn_mfma_f32_16x16x32_bf16(a, sf[pt], y[m][pt], 0, 0, 0);
          __builtin_amdgcn_sched_barrier(0); }
      }
    }
#pragma unroll 1
    for (int m = 0; m < 4; ++m) {
      const int i = 64 * ih + 16 * m + r;
      const float cfi = csf[i], cbi = csb[i];
#pragma unroll 1
      for (int k2 = 0; k2 < 4; ++k2) {
        bf16x8 pa;
#pragma unroll
        for (int tt = 0; tt < 2; ++tt) {
          f32x4 c = {0.f, 0.f, 0.f, 0.f};
#pragma unroll
          for (int ks = 0; ks < 4; ++ks) { const bf16x8 bfr = *(const LAS bf16x8*)(Bs + (32 * k2 + 16 * tt + r) * BP + 32 * ks + 8 * Qd); c = __builtin_amdgcn_mfma_f32_16x16x32_bf16(bfr, cf[0][ks], c, 0, 0, 0); }
          const int j0 = 32 * k2 + 16 * tt + 4 * Qd;
          const f32x4 jf = *(const LAS f32x4*)(csf + j0), jb = *(const LAS f32x4*)(csb + j0), jdf = *(const LAS f32x4*)(dtf + j0), jdb = *(const LAS f32x4*)(dtb + j0);
          float pv[4];
#pragma unroll
          for (int jj = 0; jj < 4; ++jj) { const int j = j0 + jj;
            const float Lf = __expf(j <= i ? cfi - jf[jj] : -INFINITY) * jdf[jj];
            const float Lb = __expf(j >= i ? cbi - jb[jj] : -INFINITY) * jdb[jj];
            pv[jj] = c[jj] * (Lf + Lb) + (j == i ? dsk : 0.f); }
          const unsigned w0 = pk2(pv[0], pv[1]), w1 = pk2(pv[2], pv[3]);
          pa[tt * 4 + 0] = (short)(w0 & 0xffff); pa[tt * 4 + 1] = (short)(w0 >> 16); pa[tt * 4 + 2] = (short)(w1 & 0xffff); pa[tt * 4 + 3] = (short)(w1 >> 16);
        }
#pragma unroll
        for (int pt = 0; pt < 4; ++pt) {
          const s16x4 lo = tr_read(Xs + (32 * k2 + 4 * Qd + (r >> 2)) * XP + hl * 64 + 16 * pt + 4 * (r & 3));
          const s16x4 hi = tr_read(Xs + (32 * k2 + 16 + 4 * Qd + (r >> 2)) * XP + hl * 64 + 16 * pt + 4 * (r & 3));
          const bf16x8 xf = (bf16x8){lo[0], lo[1], lo[2], lo[3], hi[0], hi[1], hi[2], hi[3]};
          y[0][pt] = __builtin_amdgcn_mfma_f32_16x16x32_bf16(pa, xf, y[0][pt], 0, 0, 0);
        }
      }
#pragma unroll
      for (int pt = 0; pt < 4; ++pt)
#pragma unroll
        for (int jj = 0; jj < 4; ++jj) mystg[(4 * Qd + jj) * SP + 16 * pt + r] = f2bf(y[0][pt][jj]);
      LDS_WAIT(); asm volatile("" ::: "memory");
#pragma unroll
      for (int q = 0; q < 2; ++q) { const int c = lane + 64 * q, rowl = c >> 3, ch = c & 7; const int il = 64 * ih + 16 * m + rowl;
        const v4u yv = *(const LAS v4u*)(mystg + rowl * SP + ch * 8); bf16_t* zp = Y0 + (r0 + il) * 2048 + h * 64 + ch * 8; const v4u zv = *(const v4u*)zp;
        const float v0 = __uint_as_float(yv.x << 16) * __uint_as_float(zv.x << 16), v1 = __uint_as_float(yv.x & 0xffff0000u) * __uint_as_float(zv.x & 0xffff0000u);
        const float v2 = __uint_as_float(yv.y << 16) * __uint_as_float(zv.y << 16), v3 = __uint_as_float(yv.y & 0xffff0000u) * __uint_as_float(zv.y & 0xffff0000u);
        const float v4 = __uint_as_float(yv.z << 16) * __uint_as_float(zv.z << 16), v5 = __uint_as_float(yv.z & 0xffff0000u) * __uint_as_float(zv.z & 0xffff0000u);
        const float v6 = __uint_as_float(yv.w << 16) * __uint_as_float(zv.w << 16), v7 = __uint_as_float(yv.w & 0xffff0000u) * __uint_as_float(zv.w & 0xffff0000u);
        float ss = (v0 * v0 + v1 * v1) + (v2 * v2 + v3 * v3) + (v4 * v4 + v5 * v5) + (v6 * v6 + v7 * v7);
        ss += __shfl_xor(ss, 1); ss += __shfl_xor(ss, 2); ss += __shfl_xor(ss, 4);
        v4u ov; ov.x = pk2(v0, v1); ov.y = pk2(v2, v3); ov.z = pk2(v4, v5); ov.w = pk2(v6, v7);
        if (wr) *(v4u*)zp = ov;
        if (ch == 0) ssq[hl * 128 + il] = ss; }
      LDS_WAIT(); asm volatile("" ::: "memory");
#pragma unroll
      for (int ks = 0; ks < 4; ++ks) { cf[0][ks] = cf[1][ks]; cf[1][ks] = cf[2][ks]; cf[2][ks] = cf[3][ks]; }
#pragma unroll
      for (int pt = 0; pt < 4; ++pt) { y[0][pt] = y[1][pt]; y[1][pt] = y[2][pt]; y[2][pt] = y[3][pt]; }
    }
    __syncthreads();
    if (tid < 128) SSQ[((r0 + tid) * 2 + g) * 2 + hh] = (ssq[tid] + ssq[128 + tid]) + (ssq[256 + tid] + ssq[384 + tid]);
  }
}

constexpr size_t WS_GCSC = 237 * MiB + 4 * MiB;
DEV const float* gcs_row(const float* lat, const float* ctx, size_t row) { return row < (size_t)ML ? lat + row * 1024 : ctx + (row - ML) * 1024; }
DEV float* gcs_row_w(float* lat, float* ctx, size_t row) { return row < (size_t)ML ? lat + row * 1024 : ctx + (row - ML) * 1024; }
DEV float logsig_fast(float x) { return fminf(x, 0.f) - __logf(1.f + __expf(-fabsf(x))); }
DEV void gla_cs_phase(const float* DTLR, const float* gw, const float* gb, float* GCSL, float* GCSC, float* GDEC) {
  const int lane = threadIdx.x & 63, wave = threadIdx.x >> 6, kl = lane & 7, seg = lane >> 3;
  for (int wt = blockIdx.x * NWAVES + wave; wt < NCH * 2 * 64; wt += gridDim.x * NWAVES) {
    const int gc = wt >> 7, dir = (wt >> 6) & 1, k = (wt & 63) * 8 + kl;
    float wv[16];
#pragma unroll
    for (int q = 0; q < 16; ++q) wv[q] = gw[(dir * 16 + q) * 512 + k];
    const float bias = gb[dir * 512 + k];
    float v[16]; float run = 0.f;
#pragma unroll
    for (int u = 0; u < 16; ++u) { const int s = seg * 16 + u, t = dir ? 127 - s : s; const float* lr = DTLR + ((size_t)gc * 128 + t) * 64 + 32 + dir * 16;
      const f32x4 l0 = *(const f32x4*)lr, l1 = *(const f32x4*)(lr + 4), l2 = *(const f32x4*)(lr + 8), l3 = *(const f32x4*)(lr + 12);
      float lg = bias + l0.x * wv[0] + l0.y * wv[1] + l0.z * wv[2] + l0.w * wv[3] + l1.x * wv[4] + l1.y * wv[5] + l1.z * wv[6] + l1.w * wv[7]
                 + l2.x * wv[8] + l2.y * wv[9] + l2.z * wv[10] + l2.w * wv[11] + l3.x * wv[12] + l3.y * wv[13] + l3.z * wv[14] + l3.w * wv[15];
      run += logsig_fast(lg) * (1.f / 16.f); v[u] = run; }
    float off = 0.f;
#pragma unroll
    for (int sgi = 0; sgi < 7; ++sgi) { const float tot = __shfl(run, kl + 8 * sgi); off += (sgi < seg) ? tot : 0.f; }
#pragma unroll
    for (int u = 0; u < 16; ++u) { const int s = seg * 16 + u, t = dir ? 127 - s : s; gcs_row_w(GCSL, GCSC, (size_t)gc * 128 + t)[dir * 512 + k] = v[u] + off; }
    if (seg == 7) GDEC[((gc * 4 + (k >> 7)) * 2 + dir) * 128 + (k & 127)] = __expf(run + off);
  }
}
DEV void gla_u_phase(const bf16_t* K0, const bf16_t* V0, const float* GCSL, const float* GCSC, bf16_t* ST, LAS unsigned char* lds) {
  constexpr int VP = 272, KP = 144;
  LAS bf16_t* Vs = (LAS bf16_t*)lds; LAS bf16_t* Kd = (LAS bf16_t*)(lds + 128 * VP * 2);
  const int tid = threadIdx.x, lane = tid & 63, wid = tid >> 6, r = lane & 15, Qd = lane >> 4;
  for (int task = blockIdx.x; task < NCH * 4; task += gridDim.x) {
    const int gc = task >> 2, h = task & 3; const size_t r0 = (size_t)gc * 128;
    __syncthreads();
#pragma unroll
    for (int i = 0; i < 8; ++i) { const int cid = tid + 512 * i, row = cid >> 5, ch = cid & 31; *(LAS v4u*)(Vs + row * VP + ch * 8) = *(const v4u*)(V0 + (r0 + row) * 1024 + h * 256 + ch * 8); }
#pragma unroll
    for (int i = 0; i < 4; ++i) { const int cid = tid + 512 * i, t = cid >> 4, ch = cid & 15;
      const v4u kv = *(const v4u*)(K0 + (r0 + t) * 512 + h * 128 + ch * 8);
      const float kf[8] = {__uint_as_float(kv.x << 16), __uint_as_float(kv.x & 0xffff0000u), __uint_as_float(kv.y << 16), __uint_as_float(kv.y & 0xffff0000u), __uint_as_float(kv.z << 16), __uint_as_float(kv.z & 0xffff0000u), __uint_as_float(kv.w << 16), __uint_as_float(kv.w & 0xffff0000u)};
#pragma unroll
      for (int dir = 0; dir < 2; ++dir) {
        const float* ce = gcs_row(GCSL, GCSC, r0 + (dir ? 0 : 127)) + dir * 512 + h * 128 + ch * 8; const float* ct = gcs_row(GCSL, GCSC, r0 + t) + dir * 512 + h * 128 + ch * 8;
        const f32x4 e0 = *(const f32x4*)ce, e1 = *(const f32x4*)(ce + 4), c0 = *(const f32x4*)ct, c1 = *(const f32x4*)(ct + 4);
        v4u o; o.x = pk2(kf[0] * __expf(e0.x - c0.x), kf[1] * __expf(e0.y - c0.y)); o.y = pk2(kf[2] * __expf(e0.z - c0.z), kf[3] * __expf(e0.w - c0.w));
        o.z = pk2(kf[4] * __expf(e1.x - c1.x), kf[5] * __expf(e1.y - c1.y)); o.w = pk2(kf[6] * __expf(e1.z - c1.z), kf[7] * __expf(e1.w - c1.w));
        *(LAS v4u*)(Kd + dir * 128 * KP + t * KP + ch * 8) = o; } }
    __syncthreads();
#pragma unroll 1
    for (int dir = 0; dir < 2; ++dir) {
      const LAS bf16_t* Kb = Kd + dir * 128 * KP;
      f32x4 acc[8][2];
#pragma unroll
      for (int dt = 0; dt < 8; ++dt) { acc[dt][0] = (f32x4){0.f, 0.f, 0.f, 0.f}; acc[dt][1] = (f32x4){0.f, 0.f, 0.f, 0.f}; }
#pragma unroll 1
      for (int k = 0; k < 4; ++k) {
        bf16x8 vf[2];
#pragma unroll
        for (int et = 0; et < 2; ++et) {
          const s16x4 lo = tr_read(Vs + (32 * k + 4 * Qd + (r >> 2)) * VP + 32 * wid + 16 * et + 4 * (r & 3));
          const s16x4 hi = tr_read(Vs + (32 * k + 16 + 4 * Qd + (r >> 2)) * VP + 32 * wid + 16 * et + 4 * (r & 3));
          vf[et] = (bf16x8){lo[0], lo[1], lo[2], lo[3], hi[0], hi[1], hi[2], hi[3]}; }
#pragma unroll
        for (int dt = 0; dt < 8; ++dt) {
          const s16x4 lo = tr_read(Kb + (32 * k + 4 * Qd + (r >> 2)) * KP + 16 * dt + 4 * (r & 3));
          const s16x4 hi = tr_read(Kb + (32 * k + 16 + 4 * Qd + (r >> 2)) * KP + 16 * dt + 4 * (r & 3));
          const bf16x8 kfr = (bf16x8){lo[0], lo[1], lo[2], lo[3], hi[0], hi[1], hi[2], hi[3]};
          acc[dt][0] = __builtin_amdgcn_mfma_f32_16x16x32_bf16(kfr, vf[0], acc[dt][0], 0, 0, 0);
          acc[dt][1] = __builtin_amdgcn_mfma_f32_16x16x32_bf16(kfr, vf[1], acc[dt][1], 0, 0, 0); }
      }
      bf16_t* Sp = ST + (((size_t)gc * 4 + h) * 2 + dir) * 32768;
#pragma unroll
      for (int dt = 0; dt < 8; ++dt)
#pragma unroll
        for (int et = 0; et < 2; ++et) { const f32x4 v = acc[dt][et];
          *(unsigned long long*)(Sp + ((((2 * wid + et) * 4 + (dt >> 1)) * 64 + ((dt & 1) * 2 + (Qd >> 1)) * 16 + r) * 8 + 4 * (Qd & 1))) = (unsigned long long)pk2(v[0], v[1]) | ((unsigned long long)pk2(v[2], v[3]) << 32); }
    }
  }
}
DEV void gla_scan_phase(bf16_t* ST, const float* GDEC, bool wr) {
  for (int item = blockIdx.x * 512 + threadIdx.x; item < 2 * 4 * 2 * 8192; item += gridDim.x * 512) {
    const int e4 = item & 8191, dir = (item >> 13) & 1, h = (item >> 14) & 3, b = item >> 16; const int d0 = 32 * ((e4 >> 7) & 3) + 8 * ((e4 >> 5) & 3) + 4 * (e4 & 1);
    float S0 = 0.f, S1 = 0.f, S2 = 0.f, S3 = 0.f;
#define SCAN_GC(s) (!dir ? ((s) < 2 ? 128 + 2 * b + (s) : b * 64 + ((s) - 2)) : ((s) < 2 ? 128 + 2 * b + (1 - (s)) : b * 64 + (65 - (s))))
    for (int s0 = 0; s0 < 66; s0 += 6) {
      unsigned long long u[6]; f32x4 dec[6];
#pragma unroll
      for (int q = 0; q < 6; ++q) { const int gc = SCAN_GC(s0 + q); u[q] = *(const unsigned long long*)(ST + (((size_t)gc * 4 + h) * 2 + dir) * 32768 + e4 * 4); dec[q] = *(const f32x4*)(GDEC + ((gc * 4 + h) * 2 + dir) * 128 + d0); }
#pragma unroll
      for (int q = 0; q < 6; ++q) { const int gc = SCAN_GC(s0 + q);
        if (wr) *(unsigned long long*)(ST + (((size_t)gc * 4 + h) * 2 + dir) * 32768 + e4 * 4) = (unsigned long long)pk2(S0, S1) | ((unsigned long long)pk2(S2, S3) << 32);
        const unsigned lo = (unsigned)u[q], hi = (unsigned)(u[q] >> 32);
        S0 = dec[q].x * S0 + __uint_as_float(lo << 16); S1 = dec[q].y * S1 + __uint_as_float(lo & 0xffff0000u); S2 = dec[q].z * S2 + __uint_as_float(hi << 16); S3 = dec[q].w * S3 + __uint_as_float(hi & 0xffff0000u); }
    }
#undef SCAN_GC
  }
}
DEV void gla_o_phase(const bf16_t* Q0, const bf16_t* K0, const bf16_t* V0, const float* GCSL, const float* GCSC, const bf16_t* ST, const float* gla_norm, const float* SSQ, const float* ssd_norm, bf16_t* Y0, LAS unsigned char* lds, bool wr) {
  constexpr int VP = 272, KP = 136;
  LAS bf16_t* Vs = (LAS bf16_t*)lds; LAS bf16_t* Kd = (LAS bf16_t*)(lds + 128 * VP * 2);
  const int tid = threadIdx.x, lane = tid & 63, wid = tid >> 6, r = lane & 15, Qd = lane >> 4;
  const float scale = 0.08838834764831845f;
  for (int task = blockIdx.x; task < NCH * 4; task += gridDim.x) {
    const int gc = task >> 2, h = task & 3; const size_t r0 = (size_t)gc * 128;
    __syncthreads();
#pragma unroll
    for (int i = 0; i < 8; ++i) { const int cid = tid + 512 * i, row = cid >> 5, ch = cid & 31; *(LAS v4u*)(Vs + row * VP + ch * 8) = *(const v4u*)(V0 + (r0 + row) * 1024 + h * 256 + ch * 8); }
#pragma unroll
    for (int i = 0; i < 4; ++i) { const int cid = tid + 512 * i, t = cid >> 4, ch = cid & 15;
      const v4u kv = *(const v4u*)(K0 + (r0 + t) * 512 + h * 128 + ch * 8);
      const float kf[8] = {__uint_as_float(kv.x << 16), __uint_as_float(kv.x & 0xffff0000u), __uint_as_float(kv.y << 16), __uint_as_float(kv.y & 0xffff0000u), __uint_as_float(kv.z << 16), __uint_as_float(kv.z & 0xffff0000u), __uint_as_float(kv.w << 16), __uint_as_float(kv.w & 0xffff0000u)};
#pragma unroll
      for (int dir = 0; dir < 2; ++dir) {
        const float* ct = gcs_row(GCSL, GCSC, r0 + t) + dir * 512 + h * 128 + ch * 8;
        const f32x4 c0 = *(const f32x4*)ct, c1 = *(const f32x4*)(ct + 4);
        v4u o; o.x = pk2(kf[0] * __expf(-c0.x), kf[1] * __expf(-c0.y)); o.y = pk2(kf[2] * __expf(-c0.z), kf[3] * __expf(-c0.w));
        o.z = pk2(kf[4] * __expf(-c1.x), kf[5] * __expf(-c1.y)); o.w = pk2(kf[6] * __expf(-c1.z), kf[7] * __expf(-c1.w));
        *(LAS v4u*)(Kd + dir * 128 * KP + t * KP + ch * 8) = o; } }
    __syncthreads();
    const int i = 16 * wid + r;
    f32x4 o[16];
#pragma unroll
    for (int et = 0; et < 16; ++et) o[et] = (f32x4){0.f, 0.f, 0.f, 0.f};
#pragma unroll 1
    for (int dir = 0; dir < 2; ++dir) {
      bf16x8 qd[4];
      { const float* ci = gcs_row(GCSL, GCSC, r0 + i) + dir * 512 + h * 128; const bf16_t* qp = Q0 + (r0 + i) * 512 + h * 128;
#pragma unroll
        for (int ks = 0; ks < 4; ++ks) { const v4u qv = *(const v4u*)(qp + 32 * ks + 8 * Qd); const f32x4 c0 = *(const f32x4*)(ci + 32 * ks + 8 * Qd), c1 = *(const f32x4*)(ci + 32 * ks + 8 * Qd + 4);
          const unsigned w0 = pk2(__uint_as_float(qv.x << 16) * scale * __expf(c0.x), __uint_as_float(qv.x & 0xffff0000u) * scale * __expf(c0.y));
          const unsigned w1 = pk2(__uint_as_float(qv.y << 16) * scale * __expf(c0.z), __uint_as_float(qv.y & 0xffff0000u) * scale * __expf(c0.w));
          const unsigned w2 = pk2(__uint_as_float(qv.z << 16) * scale * __expf(c1.x), __uint_as_float(qv.z & 0xffff0000u) * scale * __expf(c1.y));
          const unsigned w3 = pk2(__uint_as_float(qv.w << 16) * scale * __expf(c1.z), __uint_as_float(qv.w & 0xffff0000u) * scale * __expf(c1.w));
          qd[ks] = (bf16x8){(short)(w0 & 0xffff), (short)(w0 >> 16), (short)(w1 & 0xffff), (short)(w1 >> 16), (short)(w2 & 0xffff), (short)(w2 >> 16), (short)(w3 & 0xffff), (short)(w3 >> 16)}; } }
      const bf16_t* Sp = ST + (((size_t)gc * 4 + h) * 2 + dir) * 32768 + lane * 8;
      {
        bf16x8 sA[4], sB[4];
#pragma unroll
        for (int q = 0; q < 4; ++q) sA[q] = *(const bf16x8*)(Sp + (q * 4 + 0) * 512);
#pragma unroll
        for (int bi = 0; bi < 16; ++bi) {
          const int ks = bi >> 2, e0 = 4 * (bi & 3);
          if (bi + 1 < 16) { const int ks2 = (bi + 1) >> 2, e2 = 4 * ((bi + 1) & 3);
#pragma unroll
            for (int q = 0; q < 4; ++q) { if (bi & 1) sA[q] = *(const bf16x8*)(Sp + ((e2 + q) * 4 + ks2) * 512); else sB[q] = *(const bf16x8*)(Sp + ((e2 + q) * 4 + ks2) * 512); } }
#pragma unroll
          for (int q = 0; q < 4; ++q) o[e0 + q] = __builtin_amdgcn_mfma_f32_16x16x32_bf16(qd[ks], (bi & 1) ? sB[q] : sA[q], o[e0 + q], 0, 0, 0);
          __builtin_amdgcn_sched_barrier(0);
        }
      }
      const LAS bf16_t* Kb = Kd + dir * 128 * KP;
#pragma unroll 1
      for (int k2 = 0; k2 < 4; ++k2) {
        const bool need = dir ? (2 * k2 + 1 >= wid) : (2 * k2 <= wid);
        if (!need) continue;
        bf16x8 pa;
#pragma unroll
        for (int tt = 0; tt < 2; ++tt) { const int t = 2 * k2 + tt;
          f32x4 c = {0.f, 0.f, 0.f, 0.f};
#pragma unroll
          for (int ks = 0; ks < 4; ++ks) { const bf16x8 kfr = *(const LAS bf16x8*)(Kb + (16 * t + r) * KP + 32 * ks + 8 * Qd); c = __builtin_amdgcn_mfma_f32_16x16x32_bf16(kfr, qd[ks], c, 0, 0, 0); }
          float pv[4];
#pragma unroll
          for (int jj = 0; jj < 4; ++jj) { const int j = 16 * t + 4 * Qd + jj; const bool ok = dir ? (j >= i) : (j <= i); pv[jj] = ok ? c[jj] : 0.f; }
          const unsigned w0 = pk2(pv[0], pv[1]), w1 = pk2(pv[2], pv[3]);
          pa[tt * 4 + 0] = (short)(w0 & 0xffff); pa[tt * 4 + 1] = (short)(w0 >> 16); pa[tt * 4 + 2] = (short)(w1 & 0xffff); pa[tt * 4 + 3] = (short)(w1 >> 16); }
#pragma unroll
        for (int et = 0; et < 16; ++et) {
          const s16x4 lo = tr_read(Vs + (32 * k2 + 4 * Qd + (r >> 2)) * VP + 16 * et + 4 * (r & 3));
          const s16x4 hi = tr_read(Vs + (32 * k2 + 16 + 4 * Qd + (r >> 2)) * VP + 16 * et + 4 * (r & 3));
          const bf16x8 vf = (bf16x8){lo[0], lo[1], lo[2], lo[3], hi[0], hi[1], hi[2], hi[3]};
          o[et] = __builtin_amdgcn_mfma_f32_16x16x32_bf16(pa, vf, o[et], 0, 0, 0); }
      }
    }
#pragma unroll
    for (int jj = 0; jj < 4; ++jj) { float ss = 0.f;
#pragma unroll
      for (int et = 0; et < 16; ++et) ss += o[et][jj] * o[et][jj];
      ss += __shfl_xor(ss, 1); ss += __shfl_xor(ss, 2); ss += __shfl_xor(ss, 4); ss += __shfl_xor(ss, 8);
      const float rstd = rsqrtf(ss * (1.f / 256.f) + EPS);
      const size_t yo = (r0 + 16 * wid + 4 * Qd + jj) * 2048 + 1024 + h * 256 + r;
#pragma unroll
      for (int et = 0; et < 16; ++et) { const bf16_t ov_ = f2bf(o[et][jj] * rstd * gla_norm[h * 256 + 16 * et + r] * bf2f(Y0[yo + 16 * et])); if (wr) Y0[yo + 16 * et] = ov_; } }
    { const int g = h >> 1, c0 = g * 512 + (h & 1) * 256;
#pragma unroll
      for (int q = 0; q < 8; ++q) { const int cid = tid + 512 * q, row = cid >> 5, ch = cid & 31; const size_t rr = r0 + row;
        const float rstd = rsqrtf((SSQ[(rr * 2 + g) * 2] + SSQ[(rr * 2 + g) * 2 + 1]) * (1.f / 512.f) + EPS);
        bf16_t* yp = Y0 + rr * 2048 + c0 + ch * 8; const v4u yv = *(const v4u*)yp; const f32x4 g0 = *(const f32x4*)(ssd_norm + c0 + ch * 8), g1 = *(const f32x4*)(ssd_norm + c0 + ch * 8 + 4);
        v4u ov; ov.x = pk2(__uint_as_float(yv.x << 16) * rstd * g0.x, __uint_as_float(yv.x & 0xffff0000u) * rstd * g0.y); ov.y = pk2(__uint_as_float(yv.y << 16) * rstd * g0.z, __uint_as_float(yv.y & 0xffff0000u) * rstd * g0.w);
        ov.z = pk2(__uint_as_float(yv.z << 16) * rstd * g1.x, __uint_as_float(yv.z & 0xffff0000u) * rstd * g1.y); ov.w = pk2(__uint_as_float(yv.w << 16) * rstd * g1.z, __uint_as_float(yv.w & 0xffff0000u) * rstd * g1.w);
        if (wr) *(v4u*)yp = ov; } }
  }
}

typedef __attribute__((address_space(1))) unsigned gu32;
#define RLX_AGENT __ATOMIC_RELAXED, __HIP_MEMORY_SCOPE_AGENT
#define XB_TMO      128
#define XB_XCNT(j)  (256  + 64 * (j))
#define XB_XSUB(j)  (1280 + 64 * (j))
#define XB_XGEN(j)  (2304 + 64 * (j))
#define XB_TOP      3328
#define XB_TOPGEN   3392
#define XCD_BAR_WORDS 3456
#define XB_SPIN_CAP (1u << 18)

__device__ __forceinline__ unsigned xb_ld(unsigned* p)              { return __hip_atomic_load(p, __ATOMIC_RELAXED, __HIP_MEMORY_SCOPE_AGENT); }
__device__ __forceinline__ unsigned xb_add(unsigned* p, unsigned v) { return __hip_atomic_fetch_add(p, v, __ATOMIC_RELAXED, __HIP_MEMORY_SCOPE_AGENT); }
__device__ __forceinline__ unsigned xb_xcc_id() { return (unsigned)__builtin_amdgcn_s_getreg((3 << 11) | 20) & 0xFu; }
#define XB_SPIN(cond, bar) do { unsigned _sp = 0; while (cond) { __builtin_amdgcn_s_sleep(1); \
    if ((++_sp & 255u) == 0u) { if (xb_ld(&(bar)[XB_TMO])) break; if (_sp > XB_SPIN_CAP) { atomicAdd(&(bar)[XB_TMO], 1u); break; } } } } while (0)

struct XcdBarrier {
    unsigned* bar; unsigned x;
    volatile LAS unsigned* st;
};

__device__ __forceinline__ XcdBarrier xcd_barrier_post(unsigned* bar, volatile LAS unsigned* st) {
    XcdBarrier b; b.bar = bar; b.x = xb_xcc_id(); b.st = st;
    if (threadIdx.x == 0) (void)xb_add(&bar[XB_XCNT(b.x)], 1u);
    return b;
}
__device__ __forceinline__ void xcd_barrier_complete(unsigned* bar, unsigned x, unsigned& nloc, unsigned& nx) {
    const unsigned G = gridDim.x * gridDim.y * gridDim.z;
    unsigned sum, cnt, mine, sp = 0u;
    for (;;) {
        sum = 0u; cnt = 0u; mine = 0u;
#pragma unroll
        for (unsigned j = 0; j < 16; ++j) { const unsigned c = xb_ld(&bar[XB_XCNT(j)]); sum += c; cnt += (c > 0u) ? 1u : 0u; mine = (j == x) ? c : mine; }
        if (sum == G) break;
        __builtin_amdgcn_s_sleep(1);
        if ((++sp & 255u) == 0u) { if (xb_ld(&bar[XB_TMO])) break; if (sp > XB_SPIN_CAP) { atomicAdd(&bar[XB_TMO], 1u); break; } }
    }
    nloc = mine > 0u ? mine : 1u; nx = cnt > 0u ? cnt : 1u;
}

__device__ __forceinline__ void xcd_barrier(const XcdBarrier& b) {
    asm volatile("s_waitcnt vmcnt(0)" ::: "memory");
    __syncthreads();
    if (threadIdx.x == 0) {
        unsigned* bar = b.bar;
        __builtin_amdgcn_s_waitcnt(0);
        unsigned nloc = b.st[0], nx = b.st[1];
        if (nloc == 0u) { xcd_barrier_complete(bar, b.x, nloc, nx); b.st[0] = nloc; b.st[1] = nx; }
        const unsigned old = xb_add(&bar[XB_XSUB(b.x)], 1u);
        const unsigned gen = old / nloc;
        if (old + 1u == (gen + 1u) * nloc) {
            __builtin_amdgcn_fence(__ATOMIC_RELEASE, "agent");
            asm volatile("s_waitcnt vmcnt(0)" ::: "memory");
            const unsigned og = xb_add(&bar[XB_TOP], 1u);
            const unsigned tg = og / nx;
            if (og + 1u == (tg + 1u) * nx) xb_add(&bar[XB_TOPGEN], 1u);
            else XB_SPIN(xb_ld(&bar[XB_TOPGEN]) == tg, bar);
            __builtin_amdgcn_fence(__ATOMIC_ACQUIRE, "agent");
            xb_add(&bar[XB_XGEN(b.x)], 1u);
            asm volatile("s_waitcnt vmcnt(0)" ::: "memory");
        } else {
            XB_SPIN(xb_ld(&bar[XB_XGEN(b.x)]) == gen, bar);
            __builtin_amdgcn_fence(__ATOMIC_ACQUIRE, "agent");
            asm volatile("s_waitcnt vmcnt(0)" ::: "memory");
        }
    }
    __syncthreads();
}

__global__ void __launch_bounds__(NWAVES * 64, 2) mega(Params p) {
  extern __shared__ __attribute__((aligned(16))) unsigned char lds_raw[];
  LAS unsigned char* lds = (LAS unsigned char*)lds_raw;
  cg::grid_group grid = cg::this_grid();
  volatile LAS unsigned* MISC = (volatile LAS unsigned*)(lds + MISC_OFF);
  if (threadIdx.x < 16) MISC[threadIdx.x] = 0u;
  __syncthreads();
  XcdBarrier bar = xcd_barrier_post((unsigned*)(p.ws + WS_CTL), MISC + 8);
  unsigned char* ws = p.ws;
  float* MOD = (float*)(ws + WS_MOD);
  bf16_t* H0 = (bf16_t*)p.out; float* X1 = p.out;
  const int lo = p.ph_lo, hi = p.ph_hi;
#define IN(k) (lo <= (k) && (k) < hi)
#define SEAM(k) do { if ((k) + 1 < hi) { if ((k) == 0) grid.sync(); else xcd_barrier(bar); } } while (0)
#define PH(k, ...) if (IN(k)) { if ((PROBE_MASK >> (k)) & 1u) { const bool wr = (p.rep < 0); (void)wr; __VA_ARGS__; xcd_barrier(bar); } { const bool wr = true; (void)wr; __VA_ARGS__; } SEAM(k); }
  PH(0, prologue_phase(p, lds))
  PH(1, prep_phase(p.in[0], p.in[2], p.in[4], MOD, H0))
  PH(2, {
    pg8::Gemm g{H0, (const bf16_t*)(ws + WS_W1T), MA, E_INP, D}; pg8::StaticOrder S; S.init(MA, E_INP, gridDim.x, (int)blockIdx.x);
    pg8::EpiProj0 E{(bf16_t*)(ws + WS_Y0), (bf16_t*)(ws + WS_XBC), (bf16_t*)(ws + WS_Q0), (bf16_t*)(ws + WS_K0), (bf16_t*)(ws + WS_V0), (float*)(ws + WS_DTLR)};
    pg8::gemm_phase<pg8::EpiProj0, pg8::StaticOrder, true, true>(lds, g, S, E); })
  PH(3, ssd_prep_phase((const bf16_t*)(ws + WS_XBC), p.in[8], p.in[9], (bf16_t*)p.out, (const float*)(ws + WS_DTLR), p.in[10], p.in[11], (float*)((char*)p.out + DO_SDT), (float*)((char*)p.out + DO_SCS), (float*)(ws + WS_SDEC)))
  PH(4, ssd_u_phase((const bf16_t*)p.out, (const float*)((char*)p.out + DO_SDT), (const float*)((char*)p.out + DO_SCS), (bf16_t*)(ws + WS_STATE), lds))
  PH(5, ssd_scan_phase((bf16_t*)(ws + WS_STATE), (const float*)(ws + WS_SDEC), wr))
  PH(6, ssd_y_phase((const bf16_t*)p.out, (const float*)((char*)p.out + DO_SDT), (const float*)((char*)p.out + DO_SCS), (const bf16_t*)(ws + WS_STATE), p.in[12], (bf16_t*)(ws + WS_Y0), (float*)(ws + WS_SSQ), lds, wr))
  PH(7, gla_cs_phase((const float*)(ws + WS_DTLR), p.in[14], p.in[15], (float*)p.out, (float*)(ws + WS_GCSC), (float*)(ws + WS_GDEC)))
  PH(8, gla_u_phase((const bf16_t*)(ws + WS_K0), (const bf16_t*)(ws + WS_V0), (const float*)p.out, (const float*)(ws + WS_GCSC), (bf16_t*)(ws + WS_STATE), lds))
  PH(9, gla_scan_phase((bf16_t*)(ws + WS_STATE), (const float*)(ws + WS_GDEC), wr))
  PH(10, gla_o_phase((const bf16_t*)(ws + WS_Q0), (const bf16_t*)(ws + WS_K0), (const bf16_t*)(ws + WS_V0), (const float*)p.out, (const float*)(ws + WS_GCSC), (const bf16_t*)(ws + WS_STATE), p.in[16], (const float*)(ws + WS_SSQ), p.in[13], (bf16_t*)(ws + WS_Y0), lds, wr))
  PH(11, {
    pg8::Gemm g{(const bf16_t*)(ws + WS_Y0), (const bf16_t*)(ws + WS_W2T), ML, D, 2048}; pg8::StaticOrder S; S.init(ML, D, gridDim.x, (int)blockIdx.x);
    pg8::EpiResid E{p.in[0], X1, MOD, true};
    pg8::gemm_phase<pg8::EpiResid, pg8::StaticOrder, true, true>(lds, g, S, E);
    const float* ctx = p.in[2]; float* XC1 = (float*)(ws + WS_XC1); const float* gate = MOD + 2 * 3072 + 2048;
    small_gemm((const bf16_t*)(ws + WS_Y0) + (size_t)ML * 2048, 2048, (const bf16_t*)(ws + WS_W2T), 2048, 2048, MC, D,
               [=](int m, int n, float v) { XC1[(size_t)m * D + n] = ctx[(size_t)m * D + n] + gate[n] * v; }); })
  PH(12, prep_phase(X1, (const float*)(ws + WS_XC1), p.in[18], MOD + 3 * 3072, (bf16_t*)(ws + WS_H1)))
  PH(13, {
    pg8::Gemm g{(const bf16_t*)(ws + WS_H1), (const bf16_t*)(ws + WS_W3T), ML, O_IN, D}; pg8::StaticOrder S; S.init(ML, O_IN, gridDim.x, (int)blockIdx.x);
    pg8::EpiProj1 E{(bf16_t*)(ws + WS_K1), (bf16_t*)(ws + WS_V1), (bf16_t*)(ws + WS_Q1), (bf16_t*)(ws + WS_G1)};
    pg8::gemm_phase<pg8::EpiProj1, pg8::StaticOrder, true, true>(lds, g, S, E);
    bf16_t* K1 = (bf16_t*)(ws + WS_K1); bf16_t* V1 = (bf16_t*)(ws + WS_V1);
    small_gemm((const bf16_t*)(ws + WS_H1) + (size_t)ML * D, D, (const bf16_t*)(ws + WS_W3T), D, D, MC, 1024,
               [=](int m, int n, float v) { if (n < 512) K1[(size_t)(ML + m) * 512 + n] = f2bf(v); else V1[(size_t)(ML + m) * 512 + (n - 512)] = f2bf(v); }); })
  PH(14, qknorm_phase((bf16_t*)(ws + WS_Q1), (bf16_t*)(ws + WS_K1), p.in[22], p.in[23], (const float*)(ws + WS_ROPE), wr))
  PH(15, attn_phase((bf16_t*)(ws + WS_Q1), (const bf16_t*)(ws + WS_K1), (const bf16_t*)(ws + WS_V1), (const bf16_t*)(ws + WS_G1), p.in[24], p.in[22], p.in[23], lds, wr))
  PH(16, {
    pg8::Gemm g{(const bf16_t*)(ws + WS_Q1), (const bf16_t*)(ws + WS_W4T), ML, D, 2048}; pg8::StaticOrder S; S.init(ML, D, gridDim.x, (int)blockIdx.x);
    pg8::EpiResid E{X1, p.out, MOD + 3 * 3072, wr};
    pg8::gemm_phase<pg8::EpiResid, pg8::StaticOrder, true, true>(lds, g, S, E); })
#undef PH
#undef IN
#undef SEAM
}
extern "C" void kernel_launch(void* const* d_in, const int* in_sizes, int n_in, void* d_out, int out_size, void* d_ws, size_t ws_size, hipStream_t stream) {
  static int grid_blocks = 0;
  if (!grid_blocks) {
    int dev = 0, cus = 0, per_cu = 0;
    hipGetDevice(&dev);
    hipDeviceGetAttribute(&cus, hipDeviceAttributeMultiprocessorCount, dev);
    hipFuncSetAttribute((const void*)mega, hipFuncAttributeMaxDynamicSharedMemorySize, LDS_BYTES);
    hipOccupancyMaxActiveBlocksPerMultiprocessor(&per_cu, (const void*)mega, NWAVES * 64, LDS_BYTES);
    if (per_cu < 1) { fprintf(stderr, "kernel_launch: occupancy query says %d blocks per CU\n", per_cu); per_cu = 1; }
    if (per_cu > 1) per_cu = 1;
    grid_blocks = cus * per_cu;
  }
  hipMemsetAsync((char*)d_ws + WS_CTL, 0, 64 * 1024, stream);
  Params base{};
  for (int i = 0; i < 26; ++i) base.in[i] = (const float*)d_in[i];
  base.out = (float*)d_out; base.ws = (unsigned char*)d_ws;
  auto launch = [&](int lo, int hi) {
    Params p = base; p.ph_lo = lo; p.ph_hi = hi; p.rep = (int)PROBE_MASK; void* args[] = {&p};
    hipError_t e = hipLaunchCooperativeKernel((const void*)mega, dim3(grid_blocks), dim3(NWAVES * 64), args, LDS_BYTES, stream);
    if (e != hipSuccess) fprintf(stderr, "cooperative launch failed: %s (grid %d)\n", hipGetErrorString(e), grid_blocks);
  };
  launch(0, 17);
}
```

```cpp
#include <hip/hip_runtime.h>
#include <hip/hip_cooperative_groups.h>
#include <stdint.h>
#include <math.h>
#include <cstdio>
namespace cg = cooperative_groups;
#ifndef PROBE_MASK
#define PROBE_MASK 0u
#endif

typedef unsigned short bf16_t;
#define DEV __device__ __forceinline__

DEV float bf2f(bf16_t v) { return __uint_as_float(((unsigned)v) << 16); }
DEV bf16_t f2bf(float f) { unsigned u = __float_as_uint(f); u = (u + 0x7fffu + ((u >> 16) & 1u)) >> 16; return (bf16_t)u; }
DEV unsigned pk2(float lo, float hi) { return (unsigned)f2bf(lo) | ((unsigned)f2bf(hi) << 16); }
DEV float siluf(float x) { return x / (1.f + __expf(-x)); }
DEV float silu_fast(float x) { return x * __builtin_amdgcn_rcpf(1.f + __expf(-x)); }
DEV float softplusf(float x) { return x > 20.f ? x : log1pf(__expf(x)); }
DEV float logsigmoidf(float x) { return fminf(x, 0.f) - log1pf(__expf(-fabsf(x))); }

constexpr int D = 1024, NB = 2, SEQ = 8192, CTXL = 256;
constexpr int ML = NB * SEQ;
constexpr int MC = NB * CTXL;
constexpr int MA = ML + MC;
constexpr int NCH = MA / 128;
constexpr int E_IN = 5696, O_IN = 5120, E_INP = 5888;
constexpr float EPS = 1e-6f;

constexpr size_t MiB = 1u << 20;
constexpr size_t WS_CTL = 0;
constexpr size_t WS_MOD = 1 * MiB;
constexpr size_t WS_ROPE = 1 * MiB + 128 * 1024;
constexpr size_t WS_SDEC = 1 * MiB + 256 * 1024;
constexpr size_t WS_GDEC = 1 * MiB + 384 * 1024;
constexpr size_t WS_W1T = 2 * MiB;
constexpr size_t WS_W2T = 14 * MiB;
constexpr size_t WS_W3T = 18 * MiB;
constexpr size_t WS_W4T = 28 * MiB;
constexpr size_t WS_Y0 = 32 * MiB;
constexpr size_t WS_Q0 = 98 * MiB;
constexpr size_t WS_K0 = WS_Q0 + 16 * MiB + 512 * 1024;
constexpr size_t WS_V0 = 131 * MiB;
constexpr size_t WS_DTLR = 164 * MiB;
constexpr size_t WS_XC1 = 168 * MiB + 512 * 1024;
constexpr size_t WS_XBC = 171 * MiB;
constexpr size_t WS_STATE = 171 * MiB;
constexpr size_t WS_TAIL = 237 * MiB;
constexpr size_t WS_H1 = 32 * MiB;
constexpr size_t WS_K1 = 65 * MiB;
constexpr size_t WS_V1 = 81 * MiB + 512 * 1024;
constexpr size_t WS_Q1 = 98 * MiB;
constexpr size_t WS_G1 = 171 * MiB;

DEV int row_vec(int row) { return row < ML ? (row / SEQ) : 2; }

namespace pg8 {
#define PG8_LAS __attribute__((address_space(3)))
typedef unsigned short bf16_t;
typedef short bf16x8 __attribute__((ext_vector_type(8)));
typedef float f32x4 __attribute__((ext_vector_type(4)));
typedef unsigned u32x4 __attribute__((ext_vector_type(4)));
constexpr int BM = 256, BK = 64, HALF = 128, HTB = HALF * BK * 2  , STAGE_BYTES = 8 * HTB, NXCD = 8, WGM = 8;

__host__ __device__ __forceinline__ int lds_byte(int r, int c) { const int st = (r >> 4) * 2 + (c >> 5), rr = r & 15, cc = c & 31, ob = rr * 64 + cc * 2; return st * 1024 + (ob ^ (((ob >> 9) & 1) << 5)); }
__host__ __device__ __forceinline__ void stage_rc(int b, int& R, int& C) { const int st = b / 1024, sb = b % 1024, swz = sb ^ (((sb >> 9) & 1) << 5); R = (st >> 1) * 16 + swz / 64; C = (st & 1) * 32 + (swz % 64) / 2; }
__host__ __device__ __forceinline__ int perm32(int rho) { const int n = rho >> 4, i = rho & 15; return 8 * (i >> 2) + 4 * n + (i & 3); }

struct Unit { int pm, pn; };
struct Gemm { const bf16_t* A; const bf16_t* Bt; int M, N, K; };

struct StaticOrder {
    int nM, nN, nwg, G, c;
    __host__ __device__ void init(int M, int N, int G_, int c_) { nM = M / BM; nN = N / BM; nwg = nM * nN; G = G_; c = c_; }
    __host__ __device__ bool next(int i, Unit& u) const {
        const long L = (long)i * G + c; if (L >= nwg) return false;
        int wgid = (int)L; { const int q = nwg / NXCD, r = nwg % NXCD, xcd = wgid % NXCD, off = wgid / NXCD; wgid = (xcd < r ? xcd * (q + 1) : r * (q + 1) + (xcd - r) * q) + off; }
        const int nig = WGM * nN, gid = wgid / nig, fm = gid * WGM, gsz = (nM - fm) < WGM ? (nM - fm) : WGM;
        u.pm = fm + ((wgid % nig) % gsz); u.pn = (wgid % nig) / gsz; return true;
    }
    __device__ __forceinline__ void a_ready(const Unit&) const {}
    __device__ __forceinline__ void done(const Unit&) const {}
};
__device__ __forceinline__ unsigned cvt_pk_bf16(float lo, float hi) { unsigned r; asm volatile("v_cvt_pk_bf16_f32 %0, %1, %2" : "=v"(r) : "v"(lo), "v"(hi)); return r; }
__device__ __forceinline__ float silu_e(float x) { return x * __builtin_amdgcn_rcpf(1.f + __expf(-x)); }

__device__ __forceinline__ void store_unit_bf16(const f32x4 (&acc)[2][2][4][2], bf16_t* base, int ld, int colt, bool act, const Unit& u, int wr, int wc, int fr, int fq) {
    const int row0 = u.pm * BM + wr * 64 + fr; const int col0 = colt + wc * 32 + 8 * fq;
#pragma unroll
    for (int ai = 0; ai < 2; ++ai)
#pragma unroll
        for (int m = 0; m < 4; ++m) { bf16_t* rowp = base + (size_t)(row0 + ai * HALF + m * 16) * ld + col0;
#pragma unroll
            for (int bj = 0; bj < 2; ++bj) { f32x4 v0 = acc[ai][bj][m][0], v1 = acc[ai][bj][m][1];
                if (act) { v0 = (f32x4){silu_e(v0[0]), silu_e(v0[1]), silu_e(v0[2]), silu_e(v0[3])}; v1 = (f32x4){silu_e(v1[0]), silu_e(v1[1]), silu_e(v1[2]), silu_e(v1[3])}; }
                u32x4 w; w.x = cvt_pk_bf16(v0[0], v0[1]); w.y = cvt_pk_bf16(v0[2], v0[3]); w.z = cvt_pk_bf16(v1[0], v1[1]); w.w = cvt_pk_bf16(v1[2], v1[3]);
                *(u32x4*)(rowp + bj * HALF) = w; } }
}
struct EpiProj0 {
    static constexpr bool PERM = true, AFTER_DRAIN = false;
    bf16_t *Y0, *XBC, *Q0, *K0, *V0; float* DTLR;
    __device__ __forceinline__ void operator()(const f32x4 (&acc)[2][2][4][2], const Unit& u, int wr, int wc, int fr, int fq) const {
        const int pn = u.pn;
        if (pn == 22) {
            if (wc < 2) { const int row0 = u.pm * BM + wr * 64 + fr;
#pragma unroll
                for (int ai = 0; ai < 2; ++ai)
#pragma unroll
                    for (int m = 0; m < 4; ++m) { float* rp = DTLR + (size_t)(row0 + ai * HALF + m * 16) * 64 + wc * 32 + 8 * fq; *(f32x4*)rp = acc[ai][0][m][0]; *(f32x4*)(rp + 4) = acc[ai][0][m][1]; } }
            return;
        }
        bf16_t* base; int ld, colt; bool act = false;
        if (pn < 8) { base = Y0; ld = 2048; colt = pn * 256; act = true; }
        else if (pn < 14) { base = XBC; ld = 1536; colt = (pn - 8) * 256; }
        else if (pn < 16) { base = Q0; ld = 512; colt = (pn - 14) * 256; }
        else if (pn < 18) { base = K0; ld = 512; colt = (pn - 16) * 256; }
        else { base = V0; ld = 1024; colt = (pn - 18) * 256; }
        store_unit_bf16(acc, base, ld, colt, act, u, wr, wc, fr, fq);
    }
};
struct EpiProj1 {
    static constexpr bool PERM = true, AFTER_DRAIN = false;
    bf16_t *K1, *V1, *Q1, *G1;
    __device__ __forceinline__ void operator()(const f32x4 (&acc)[2][2][4][2], const Unit& u, int wr, int wc, int fr, int fq) const {
        const int pn = u.pn; bf16_t* base; int ld, colt; bool act = false;
        if (pn < 2) { base = K1; ld = 512; colt = pn * 256; }
        else if (pn < 4) { base = V1; ld = 512; colt = (pn - 2) * 256; }
        else if (pn < 12) { base = Q1; ld = 2048; colt = (pn - 4) * 256; }
        else { base = G1; ld = 2048; colt = (pn - 12) * 256; act = true; }
        store_unit_bf16(acc, base, ld, colt, act, u, wr, wc, fr, fq);
    }
};
struct EpiResid {
    static constexpr bool PERM = false, AFTER_DRAIN = false;
    const float* res; float* out; const float* mod; bool do_store;
    __device__ __forceinline__ void operator()(const f32x4 (&acc)[2][2][4][2], const Unit& u, int wr, int wc, int fr, int fq) const {
        const int b = (u.pm * BM) / 8192; const float* gate = mod + b * 3072 + 2048;
        const int col0 = u.pn * BM + wc * 32 + 4 * fq;
        f32x4 gv[2][2];
#pragma unroll
        for (int bj = 0; bj < 2; ++bj)
#pragma unroll
            for (int n = 0; n < 2; ++n) gv[bj][n] = *(const f32x4*)(gate + col0 + bj * HALF + n * 16);
#pragma unroll
        for (int ai = 0; ai < 2; ++ai)
#pragma unroll
            for (int m = 0; m < 4; ++m) { const size_t off = (size_t)(u.pm * BM + ai * HALF + wr * 64 + m * 16 + fr) * 1024 + col0;
#pragma unroll
                for (int bj = 0; bj < 2; ++bj)
#pragma unroll
                    for (int n = 0; n < 2; ++n) { const f32x4 r = *(const f32x4*)(res + off + bj * HALF + n * 16); const f32x4 ov_ = r + gv[bj][n] * acc[ai][bj][m][n]; if (do_store) *(f32x4*)(out + off + bj * HALF + n * 16) = ov_; } }
    }
};
template <class Epi, class Sched, bool ALIGN_EPI = false, bool SP2 = false>
__device__ __forceinline__ void gemm_phase(PG8_LAS unsigned char* lds, const Gemm g, const Sched& S, const Epi& E) {
    const int tid = threadIdx.x, wid = __builtin_amdgcn_readfirstlane(tid >> 6), lane = tid & 63, wr = wid >> 2, wc = wid & 3, fr = lane & 15, fq = lane >> 4;
    const int K = g.K, nt = K / BK;
    unsigned voffA[2], voffB[2];
#pragma unroll
    for (int i = 0; i < 2; ++i) { int R, C; stage_rc(tid * 16 + i * 8192, R, C); const int Rb = Epi::PERM ? ((R & ~31) + perm32(R & 31)) : R;
        voffA[i] = (unsigned)(R * K + C) * 2u; voffB[i] = (unsigned)(Rb * K + C) * 2u; }
    const size_t kstep = (size_t)(BK * 2);
    const size_t hstep = (size_t)HALF * K * 2;
    const size_t tstep = 2 * hstep;
    const unsigned ldsw = (unsigned)wid * 1024u;
    const int aoff = lds_byte(wr * 64 + fr, fq * 8), boff = lds_byte(wc * 32 + fr, fq * 8);
#define PG8_SA(b, h) (((b) * 2 + (h)) * HTB)
#define PG8_SB(b, h) ((4 + (b) * 2 + (h)) * HTB)
#define PG8_STAGE(bufoff, gbase, voff) do { _Pragma("unroll") for (int _i = 0; _i < 2; ++_i) \
        __builtin_amdgcn_global_load_lds((const unsigned*)((const char*)(gbase) + (voff)[_i]), (PG8_LAS unsigned*)(lds + (bufoff) + ldsw + _i * 8192), 16, 0, 0); } while (0)
#define PG8_LDA(dst, b, h) do { _Pragma("unroll") for (int m = 0; m < 4; ++m) _Pragma("unroll") for (int k = 0; k < 2; ++k) dst[m][k] = *(const PG8_LAS bf16x8*)(lds + PG8_SA(b, h) + aoff + m * 2048 + k * 1024); } while (0)
#define PG8_LDB(dst, b, h) do { _Pragma("unroll") for (int n = 0; n < 2; ++n) _Pragma("unroll") for (int k = 0; k < 2; ++k) dst[n][k] = *(const PG8_LAS bf16x8*)(lds + PG8_SB(b, h) + boff + n * 2048 + k * 1024); } while (0)
#define PG8_MMA(ai, bj, At, Bt) do { __builtin_amdgcn_s_setprio(1); _Pragma("unroll") for (int m = 0; m < 4; ++m) _Pragma("unroll") for (int n = 0; n < 2; ++n) _Pragma("unroll") for (int k = 0; k < 2; ++k) \
        acc[ai][bj][m][n] = __builtin_amdgcn_mfma_f32_16x16x32_bf16(Bt[n][k], At[m][k], acc[ai][bj][m][n], 0, 0, 0); __builtin_amdgcn_s_setprio(0); } while (0)
#define PG8_WAIT_V(n) asm volatile("s_waitcnt vmcnt(" #n ")" ::: "memory")
#define PG8_WAIT_L(n) asm volatile("s_waitcnt lgkmcnt(" #n ")" ::: "memory")
#define PG8_BAR __builtin_amdgcn_s_barrier()
#define PG8_SCHED __builtin_amdgcn_sched_barrier(0)
    Unit cur, nxt; int ui = 0;
    if (!S.next(0, cur)) return;
    f32x4 acc[2][2][4][2];
#pragma unroll
    for (int a = 0; a < 2; ++a)
#pragma unroll
        for (int b = 0; b < 2; ++b)
#pragma unroll
            for (int m = 0; m < 4; ++m)
#pragma unroll
                for (int n = 0; n < 2; ++n) acc[a][b][m][n] = (f32x4){0.f, 0.f, 0.f, 0.f};
    bf16x8 At[4][2], B0[2][2], B1[2][2];
    const char* cA = (const char*)g.A + (size_t)cur.pm * tstep; const char* cB = (const char*)g.Bt + (size_t)cur.pn * tstep;
    S.a_ready(cur);
    if constexpr (SP2) {
        PG8_STAGE(PG8_SB(0, 0), cB, voffB); PG8_STAGE(PG8_SB(0, 1), cB + hstep, voffB); PG8_STAGE(PG8_SA(0, 0), cA, voffA); PG8_STAGE(PG8_SA(0, 1), cA + hstep, voffA);
        if (wr == 1) PG8_BAR;
        PG8_WAIT_V(2); PG8_BAR;
        PG8_STAGE(PG8_SB(1, 0), cB + kstep, voffB); PG8_STAGE(PG8_SA(1, 0), cA + kstep, voffA); PG8_STAGE(PG8_SB(1, 1), cB + hstep + kstep, voffB);
        PG8_WAIT_V(6); PG8_BAR;
    } else {
        PG8_STAGE(PG8_SB(0, 0), cB, voffB); PG8_STAGE(PG8_SA(0, 0), cA, voffA); PG8_STAGE(PG8_SB(0, 1), cB + hstep, voffB); PG8_STAGE(PG8_SA(0, 1), cA + hstep, voffA);
        if (wr == 1) PG8_BAR;
        PG8_WAIT_V(4); PG8_BAR;
        PG8_STAGE(PG8_SB(1, 0), cB + kstep, voffB); PG8_STAGE(PG8_SA(1, 0), cA + kstep, voffA); PG8_STAGE(PG8_SB(1, 1), cB + hstep + kstep, voffB);
        PG8_WAIT_V(6); PG8_BAR;
    }
    for (;;) {
        const bool has_next = S.next(ui + 1, nxt);
        const char* nA = has_next ? (const char*)g.A + (size_t)nxt.pm * tstep : cA; const char* nB = has_next ? (const char*)g.Bt + (size_t)nxt.pn * tstep : cB;
        for (int t = 0; t < nt; t += 2) {
            const bool last = (t == nt - 2);
            const char* a1 = cA + (size_t)(t + 1) * kstep;
            const char* a2 = last ? nA : cA + (size_t)(t + 2) * kstep; const char* b2 = last ? nB : cB + (size_t)(t + 2) * kstep;
            const char* a3 = a2 + kstep; const char* b3 = b2 + kstep;
            if (last && has_next) S.a_ready(nxt);
            if constexpr (SP2) {
            PG8_LDB(B0, 0, 0); PG8_LDB(B1, 0, 1); PG8_SCHED; PG8_LDA(At, 0, 0); PG8_STAGE(PG8_SA(1, 1), a1 + hstep, voffA);
            PG8_WAIT_V(8); PG8_WAIT_L(0); PG8_BAR; PG8_MMA(0, 0, At, B0); PG8_MMA(0, 1, At, B1); PG8_BAR; PG8_SCHED;
            PG8_LDA(At, 0, 1); PG8_STAGE(PG8_SB(0, 0), b2, voffB); PG8_STAGE(PG8_SB(0, 1), b2 + hstep, voffB); PG8_STAGE(PG8_SA(0, 0), a2, voffA);
            PG8_WAIT_V(8); PG8_WAIT_L(0); PG8_BAR; PG8_MMA(1, 0, At, B0); PG8_MMA(1, 1, At, B1); PG8_BAR; PG8_SCHED;
            PG8_LDB(B0, 1, 0); PG8_LDB(B1, 1, 1); PG8_SCHED; PG8_LDA(At, 1, 0); PG8_STAGE(PG8_SA(0, 1), a2 + hstep, voffA);
            PG8_WAIT_V(8); PG8_WAIT_L(0); PG8_BAR; PG8_MMA(0, 0, At, B0); PG8_MMA(0, 1, At, B1); PG8_BAR; PG8_SCHED;
            PG8_LDA(At, 1, 1); PG8_STAGE(PG8_SB(1, 0), b3, voffB); PG8_STAGE(PG8_SB(1, 1), b3 + hstep, voffB); PG8_STAGE(PG8_SA(1, 0), a3, voffA);
            PG8_WAIT_V(8); PG8_WAIT_L(0); PG8_BAR; PG8_MMA(1, 0, At, B0); PG8_MMA(1, 1, At, B1); PG8_BAR; PG8_SCHED;
            } else {
            PG8_LDB(B0, 0, 0); PG8_SCHED; PG8_LDA(At, 0, 0); PG8_STAGE(PG8_SA(1, 1), a1 + hstep, voffA);
            PG8_WAIT_L(8); PG8_BAR; PG8_WAIT_L(0); PG8_MMA(0, 0, At, B0); PG8_BAR; PG8_SCHED;
            PG8_LDB(B1, 0, 1); PG8_STAGE(PG8_SB(0, 0), b2, voffB);
            PG8_BAR; PG8_WAIT_L(0); PG8_MMA(0, 1, At, B1); PG8_BAR;
            PG8_LDA(At, 0, 1); PG8_STAGE(PG8_SA(0, 0), a2, voffA);
            PG8_BAR; PG8_WAIT_L(0); PG8_MMA(1, 0, At, B0); PG8_BAR; PG8_SCHED;
            PG8_STAGE(PG8_SB(0, 1), b2 + hstep, voffB);
            PG8_WAIT_V(6); PG8_BAR; PG8_MMA(1, 1, At, B1); PG8_BAR;
            PG8_LDB(B0, 1, 0); PG8_SCHED; PG8_LDA(At, 1, 0); PG8_STAGE(PG8_SA(0, 1), a2 + hstep, voffA);
            PG8_WAIT_L(8); PG8_BAR; PG8_WAIT_L(0); PG8_MMA(0, 0, At, B0); PG8_BAR; PG8_SCHED;
            PG8_LDB(B1, 1, 1); PG8_STAGE(PG8_SB(1, 0), b3, voffB);
            PG8_BAR; PG8_WAIT_L(0); PG8_MMA(0, 1, At, B1); PG8_BAR;
            PG8_LDA(At, 1, 1); PG8_STAGE(PG8_SA(1, 0), a3, voffA);
            PG8_BAR; PG8_WAIT_L(0); PG8_MMA(1, 0, At, B0); PG8_BAR; PG8_SCHED;
            PG8_STAGE(PG8_SB(1, 1), b3 + hstep, voffB);
            PG8_WAIT_V(6); PG8_BAR; PG8_MMA(1, 1, At, B1); PG8_BAR;
            }
        }
        if constexpr (ALIGN_EPI) { if (wr == 0) PG8_BAR; }
        if constexpr (!Epi::AFTER_DRAIN) { E(acc, cur, wr, wc, fr, fq); S.done(cur); }
        if (!has_next) break;
#pragma unroll
        for (int a = 0; a < 2; ++a)
#pragma unroll
            for (int b = 0; b < 2; ++b)
#pragma unroll
                for (int m = 0; m < 4; ++m)
#pragma unroll
                    for (int n = 0; n < 2; ++n) acc[a][b][m][n] = (f32x4){0.f, 0.f, 0.f, 0.f};
        cur = nxt; cA = nA; cB = nB; ++ui;
        if constexpr (ALIGN_EPI) { if (wr == 1) PG8_BAR; }
    }
    PG8_WAIT_V(0);
    if constexpr (!ALIGN_EPI) { if (wr == 0) PG8_BAR; }
    PG8_BAR;
    if constexpr (Epi::AFTER_DRAIN) { E.fused(acc, cur, wr, wc, fr, fq, lds, wid, lane); S.done(cur); }
#undef PG8_SA
#undef PG8_SB
#undef PG8_STAGE
#undef PG8_LDA
#undef PG8_LDB
#undef PG8_MMA
#undef PG8_WAIT_V
#undef PG8_WAIT_L
#undef PG8_BAR
#undef PG8_SCHED
}
}
#define LAS __attribute__((address_space(3)))
typedef unsigned v4u __attribute__((ext_vector_type(4)));
typedef float f32x4 __attribute__((ext_vector_type(4)));
typedef short bf16x8 __attribute__((ext_vector_type(8)));
#define LDS_WAIT() asm volatile("s_waitcnt lgkmcnt(0)" ::: "memory")
constexpr int NWAVES = 8;
constexpr int LDS_BYTES = 147456;
constexpr int MISC_OFF = 147456 - 128;

struct Params { const float* in[26]; float* out; unsigned char* ws; int ph_lo, ph_hi, rep, pad; };

DEV float wave_sum(float v) {
#pragma unroll
  for (int o = 1; o < 64; o <<= 1) v += __shfl_xor(v, o);
  return v;
}

DEV int w1_dest_row(int n) {
  if (n < 1024) return n;
  if (n < 2560) return 2048 + (n - 1024);
  if (n < 2592) return 5632 + (n - 2560);
  if (n < 3104) return 3584 + (n - 2592);
  if (n < 3616) return 4096 + (n - 3104);
  if (n < 4640) return 4608 + (n - 3616);
  if (n < 5664) return 1024 + (n - 4640);
  return n;
}
DEV void transpose_item(const float* W, int K, int N, int k0, int n0, bf16_t* WT, int drow0, LAS float* scr, int lane) {
#pragma unroll 8
  for (int i = 0; i < 32; ++i) { const int kk = 2 * i + (lane >> 5); scr[kk * 33 + (lane & 31)] = W[(size_t)(k0 + kk) * N + n0 + (lane & 31)]; }
  LDS_WAIT(); asm volatile("" ::: "memory");
  const int c = lane & 7;
#pragma unroll
  for (int j = 0; j < 4; ++j) { const int n = (lane >> 3) + 8 * j; const LAS float* s = scr + (8 * c) * 33 + n;
    v4u o; o.x = pk2(s[0 * 33], s[1 * 33]); o.y = pk2(s[2 * 33], s[3 * 33]); o.z = pk2(s[4 * 33], s[5 * 33]); o.w = pk2(s[6 * 33], s[7 * 33]);
    *(v4u*)(WT + (size_t)(drow0 + n) * K + k0 + 8 * c) = o; }
  LDS_WAIT(); asm volatile("" ::: "memory");
}
DEV void prologue_phase(const Params& p, LAS unsigned char* lds) {
  const int tid = threadIdx.x, lane = tid & 63, wave = tid >> 6;
  unsigned char* ws = p.ws;
  float* MOD = (float*)(ws + WS_MOD);
  {
    LAS float* sc = (LAS float*)lds;
    LAS float* part = (LAS float*)(lds + 12288);
    for (int i = tid; i < 3072; i += 512) { const int v = i >> 10, k = i & 1023; const float cv = v < 2 ? p.in[1][v * 1024 + k] : p.in[3][k]; sc[i] = siluf(cv); }
    __syncthreads();
    for (int task = blockIdx.x; task < 96; task += gridDim.x) {
      const int l = task / 48, n0 = (task % 48) * 64; const float* w = l ? p.in[19] : p.in[5]; const float* bb = l ? p.in[20] : p.in[6];
      const int col = tid & 63, ks = tid >> 6;
      float a0 = 0.f, a1 = 0.f, a2 = 0.f;
#pragma unroll 8
      for (int k = ks * 128; k < ks * 128 + 128; ++k) { const float wv = w[(size_t)k * 3072 + n0 + col]; a0 += sc[k] * wv; a1 += sc[1024 + k] * wv; a2 += sc[2048 + k] * wv; }
      part[(ks * 3 + 0) * 64 + col] = a0; part[(ks * 3 + 1) * 64 + col] = a1; part[(ks * 3 + 2) * 64 + col] = a2;
      __syncthreads();
      if (tid < 192) { const int v = tid >> 6; float s = bb[n0 + col];
#pragma unroll
        for (int q = 0; q < 8; ++q) s += part[(q * 3 + v) * 64 + col];
        MOD[(l * 3 + v) * 3072 + n0 + col] = s; }
      __syncthreads();
    }
  }
  if (blockIdx.x == gridDim.x - 1) { float* rope = (float*)(ws + WS_ROPE);
    for (int idx = tid; idx < 4096; idx += 512) { const int pos = idx >> 5, f = idx & 31; const float inv = 1.0f / powf(10000.f, (float)f / 32.f); const float ang = (float)pos * inv; rope[idx] = cosf(ang); rope[4096 + idx] = sinf(ang); } }
  { v4u* z = (v4u*)(ws + WS_W1T + (size_t)E_IN * 1024 * 2); const v4u zero = {0u, 0u, 0u, 0u};
    for (int i = blockIdx.x * 512 + tid; i < (E_INP - E_IN) * 1024 * 2 / 16; i += gridDim.x * 512) z[i] = zero; }
  __syncthreads();
  {
    LAS float* scr = (LAS float*)(lds + wave * 16384);
    const int gw = blockIdx.x * NWAVES + wave, NGW = gridDim.x * NWAVES;
    constexpr int I1 = 16 * 178;
    for (int it = gw; it < I1; it += NGW) { const int kb = it / 178, nb = it % 178; transpose_item(p.in[7], 1024, E_IN, 64 * kb, 32 * nb, (bf16_t*)(ws + WS_W1T), w1_dest_row(32 * nb), scr, lane); }
  }
}
DEV void late_weights(const Params& p, LAS unsigned char* lds, int vblock, int nvblocks) {
  const int lane = threadIdx.x & 63, wave = threadIdx.x >> 6; unsigned char* ws = p.ws;
  LAS float* scr = (LAS float*)(lds + wave * 16384);
  constexpr int I2 = 32 * 32, I3 = 16 * 160, I4 = 32 * 32;
  for (int it = vblock * NWAVES + wave; it < I2 + I3 + I4; it += nvblocks * NWAVES) {
    int r = it;
    if (r < I2) { const int kb = r / 32, nb = r % 32; transpose_item(p.in[17], 2048, 1024, 64 * kb, 32 * nb, (bf16_t*)(ws + WS_W2T), 32 * nb, scr, lane); continue; } r -= I2;
    if (r < I3) { const int kb = r / 160, nb = r % 160; transpose_item(p.in[21], 1024, O_IN, 64 * kb, 32 * nb, (bf16_t*)(ws + WS_W3T), 32 * nb, scr, lane); continue; } r -= I3;
    { const int kb = r / 32, nb = r % 32; transpose_item(p.in[25], 2048, 1024, 64 * kb, 32 * nb, (bf16_t*)(ws + WS_W4T), 32 * nb, scr, lane); }
  }
}
DEV void prep_phase(const float* xlat, const float* xctx, const float* g, const float* mod, bf16_t* H) {
  const int lane = threadIdx.x & 63, wave = threadIdx.x >> 6;
  for (int row = blockIdx.x * NWAVES + wave; row < MA; row += gridDim.x * NWAVES) {
    const float* src = row < ML ? xlat + (size_t)row * D : xctx + (size_t)(row - ML) * D;
    const float* m = mod + row_vec(row) * 3072;
    f32x4 v[4]; float ss = 0.f;
#pragma unroll
    for (int j = 0; j < 4; ++j) { v[j] = *(const f32x4*)(src + 4 * lane + 256 * j); ss += (v[j].x * v[j].x + v[j].y * v[j].y) + (v[j].z * v[j].z + v[j].w * v[j].w); }
    const float rstd = rsqrtf(wave_sum(ss) * (1.f / D) + EPS);
#pragma unroll
    for (int j = 0; j < 4; ++j) { const int k = 4 * lane + 256 * j;
      const f32x4 gg = *(const f32x4*)(g + k), sc = *(const f32x4*)(m + 1024 + k), sh = *(const f32x4*)(m + k);
      const f32x4 o = v[j] * rstd * gg * (sc + 1.f) + sh;
      *(unsigned long long*)(H + (size_t)row * D + k) = (unsigned long long)pk2(o.x, o.y) | ((unsigned long long)pk2(o.z, o.w) << 32); }
  }
}
template <class F> DEV void small_gemm(const bf16_t* A, int lda, const bf16_t* Bt, int ldb, int K, int Mrows, int Ncols, F f) {
  const int lane = threadIdx.x & 63, wid = threadIdx.x >> 6, mt = wid >> 2, nt = wid & 3, r = lane & 15, q = lane >> 4;
  const int ntn = Ncols / 64, ntasks = (Mrows / 32) * ntn;
  for (int task = blockIdx.x; task < ntasks; task += gridDim.x) {
    const int row0 = (task / ntn) * 32 + mt * 16, col0 = (task % ntn) * 64 + nt * 16;
    const bf16_t* ap = A + (size_t)(row0 + r) * lda + 8 * q; const bf16_t* bp = Bt + (size_t)(col0 + r) * ldb + 8 * q;
    f32x4 acc = {0.f, 0.f, 0.f, 0.f};
#pragma unroll 8
    for (int k = 0; k < K; k += 32) { const bf16x8 a = *(const bf16x8*)(ap + k), b = *(const bf16x8*)(bp + k); acc = __builtin_amdgcn_mfma_f32_16x16x32_bf16(a, b, acc, 0, 0, 0); }
#pragma unroll
    for (int j = 0; j < 4; ++j) f(row0 + q * 4 + j, col0 + r, acc[j]);
  }
}

DEV void qknorm_phase(bf16_t* Q1, bf16_t* K1, const float* qn, const float* kn, const float* rope, bool wr) {
  const int lane = threadIdx.x & 63, wave = threadIdx.x >> 6, hl = lane >> 4, d0 = (lane & 15) * 8;
  const float scale = 0.08838834764831845f;
  float gq[8], gk[8];
#pragma unroll
  for (int e = 0; e < 8; ++e) { gq[e] = qn[d0 + e] * scale; gk[e] = kn[d0 + e]; }
  const int ax = d0 >> 6, sgn = (d0 >> 5) & 1, f0 = d0 & 31;
  for (int row = blockIdx.x * NWAVES + wave; row < MA; row += gridDim.x * NWAVES) {
    const bool lat = row < ML;
    v4u raw[5];
    raw[0] = *(const v4u*)(K1 + (size_t)row * 512 + hl * 128 + d0);
    if (lat) {
#pragma unroll
      for (int g = 0; g < 4; ++g) raw[1 + g] = *(const v4u*)(Q1 + (size_t)row * 2048 + (g * 4 + hl) * 128 + d0);
    }
    float cs[8], sn[8];
    if (lat) { const int t = row % SEQ, pos = ax ? (t & 63) : (t >> 6);
      const f32x4 c0 = *(const f32x4*)(rope + pos * 32 + f0), c1 = *(const f32x4*)(rope + pos * 32 + f0 + 4), s0 = *(const f32x4*)(rope + 4096 + pos * 32 + f0), s1 = *(const f32x4*)(rope + 4096 + pos * 32 + f0 + 4);
      cs[0] = c0.x; cs[1] = c0.y; cs[2] = c0.z; cs[3] = c0.w; cs[4] = c1.x; cs[5] = c1.y; cs[6] = c1.z; cs[7] = c1.w;
      sn[0] = s0.x; sn[1] = s0.y; sn[2] = s0.z; sn[3] = s0.w; sn[4] = s1.x; sn[5] = s1.y; sn[6] = s1.z; sn[7] = s1.w; }
    const int ng = lat ? 5 : 1;
#pragma unroll
    for (int g = 0; g < 5; ++g) {
      if (g < ng) {
        const v4u rv = raw[g];
        float v[8] = {__uint_as_float(rv.x << 16), __uint_as_float(rv.x & 0xffff0000u), __uint_as_float(rv.y << 16), __uint_as_float(rv.y & 0xffff0000u), __uint_as_float(rv.z << 16), __uint_as_float(rv.z & 0xffff0000u), __uint_as_float(rv.w << 16), __uint_as_float(rv.w & 0xffff0000u)};
        float ss = 0.f;
#pragma unroll
        for (int e = 0; e < 8; ++e) ss += v[e] * v[e];
        ss += __shfl_xor(ss, 1); ss += __shfl_xor(ss, 2); ss += __shfl_xor(ss, 4); ss += __shfl_xor(ss, 8);
        const float rstd = rsqrtf(ss * (1.f / 128.f) + EPS);
#pragma unroll
        for (int e = 0; e < 8; ++e) v[e] *= rstd * (g == 0 ? gk[e] : gq[e]);
        if (lat) {
#pragma unroll
          for (int e = 0; e < 8; ++e) { const float o = __shfl_xor(v[e], 4); v[e] = sgn ? (v[e] * cs[e] + o * sn[e]) : (v[e] * cs[e] - o * sn[e]); }
        }
        v4u ov; ov.x = pk2(v[0], v[1]); ov.y = pk2(v[2], v[3]); ov.z = pk2(v[4], v[5]); ov.w = pk2(v[6], v[7]);
        if (wr) { if (g == 0) *(v4u*)(K1 + (size_t)row * 512 + hl * 128 + d0) = ov; else *(v4u*)(Q1 + (size_t)row * 2048 + ((g - 1) * 4 + hl) * 128 + d0) = ov; }
      }
    }
  }
}
typedef short s16x4 __attribute__((ext_vector_type(4)));
DEV s16x4 tr_read(const LAS bf16_t* p) { return __builtin_bit_cast(s16x4, __builtin_amdgcn_ds_read_tr16_b64_v4i16((LAS s16x4*)p)); }
DEV void attn_phase(bf16_t* Q1, const bf16_t* K1, const bf16_t* V1, const bf16_t* G1, const float* sink, const float* qn, const float* kn, LAS unsigned char* lds, bool wr) {
  constexpr int KP = 136, VP = 144;
  LAS bf16_t* Ks = (LAS bf16_t*)lds;
  LAS bf16_t* Vs = (LAS bf16_t*)(lds + 2 * 64 * KP * 2);
  LAS float* dsc = (LAS float*)(lds + 2 * 64 * KP * 2 + 2 * 64 * VP * 2);
  const int tid = threadIdx.x, lane = tid & 63, wid = tid >> 6, r = lane & 15, Qd = lane >> 4;
  float mb;
  { float a = fmaxf(fabsf(qn[lane]), fabsf(qn[64 + lane])), b = fmaxf(fabsf(kn[lane]), fabsf(kn[64 + lane]));
#pragma unroll
    for (int o = 1; o < 64; o <<= 1) { a = fmaxf(a, __shfl_xor(a, o)); b = fmaxf(b, __shfl_xor(b, o)); }
    mb = a * b * 11.313708498984761f; }
  for (int task = blockIdx.x; task < 1024; task += gridDim.x) {
    const int b = task >> 9, kvh = (task >> 7) & 3, qt = task & 127;
    const int hq = kvh * 4 + (wid >> 1), qoff = (wid & 1) * 32;
    const size_t qrow0 = (size_t)b * SEQ + qt * 64 + qoff;
    bf16x8 qf[2][4];
#pragma unroll
    for (int m = 0; m < 2; ++m)
#pragma unroll
      for (int ks = 0; ks < 4; ++ks) qf[m][ks] = *(const bf16x8*)(Q1 + (qrow0 + 16 * m + r) * 2048 + hq * 128 + ks * 32 + 8 * Qd);
    const int tlo = (2 - qt) > 0 ? (2 - qt) : 0, thi = (129 - qt) < 4 ? (129 - qt) : 4, nband = thi - tlo + 1, ntile = nband + 4;
    const int skey = tid >> 4, sch = tid & 15;
    v4u kreg[2], vreg[2];
#define TILE_ROW0(i) ((i) < nband ? (size_t)b * SEQ + (size_t)(qt - 2 + tlo + (i)) * 64 : (size_t)ML + b * CTXL + ((i) - nband) * 64)
#define LOAD_TILE(i) do { const size_t r0_ = TILE_ROW0(i); _Pragma("unroll") for (int h_ = 0; h_ < 2; ++h_) { const size_t go_ = (r0_ + skey + 32 * h_) * 512 + kvh * 128 + sch * 8; kreg[h_] = *(const v4u*)(K1 + go_); vreg[h_] = *(const v4u*)(V1 + go_); } } while (0)
#define STORE_TILE(buf) do { _Pragma("unroll") for (int h_ = 0; h_ < 2; ++h_) { *(LAS v4u*)(Ks + (buf) * 64 * KP + (skey + 32 * h_) * KP + sch * 8) = kreg[h_]; *(LAS v4u*)(Vs + (buf) * 64 * VP + (skey + 32 * h_) * VP + sch * 8) = vreg[h_]; } } while (0)
    LOAD_TILE(0);
    __syncthreads();
    STORE_TILE(0);
    __syncthreads();
    f32x4 o[2][8];
#pragma unroll
    for (int m = 0; m < 2; ++m)
#pragma unroll
      for (int n = 0; n < 8; ++n) o[m][n] = (f32x4){0.f, 0.f, 0.f, 0.f};
    float lsum[2] = {0.f, 0.f};
    for (int i = 0; i < ntile; ++i) {
      const int buf = i & 1;
      if (i + 1 < ntile) LOAD_TILE(i + 1);
      const int mtype = (i < nband) ? ((tlo + i) == 0 ? 1 : ((tlo + i) == 4 ? 2 : 0)) : 0;
      const LAS bf16_t* Kb = Ks + buf * 64 * KP; const LAS bf16_t* Vb = Vs + buf * 64 * VP;
      f32x4 s[4][2];
#pragma unroll
      for (int t = 0; t < 4; ++t) { s[t][0] = (f32x4){0.f, 0.f, 0.f, 0.f}; s[t][1] = (f32x4){0.f, 0.f, 0.f, 0.f}; }
#pragma unroll
      for (int ks = 0; ks < 4; ++ks)
#pragma unroll
        for (int t = 0; t < 4; ++t) { const bf16x8 kf = *(const LAS bf16x8*)(Kb + (16 * t + r) * KP + ks * 32 + 8 * Qd);
          s[t][0] = __builtin_amdgcn_mfma_f32_16x16x32_bf16(kf, qf[0][ks], s[t][0], 0, 0, 0);
          s[t][1] = __builtin_amdgcn_mfma_f32_16x16x32_bf16(kf, qf[1][ks], s[t][1], 0, 0, 0); }
      bf16x8 pa[2][2];
#pragma unroll
      for (int m = 0; m < 2; ++m) { const int qi = qoff + 16 * m + r;
#pragma unroll
        for (int t = 0; t < 4; ++t) {
          float pv[4];
#pragma unroll
          for (int j = 0; j < 4; ++j) { const int kj = 16 * t + 4 * Qd + j; float pj = __expf(s[t][m][j] - mb);
            if (mtype == 1) pj = (kj >= qi) ? pj : 0.f; else if (mtype == 2) pj = (kj <= qi) ? pj : 0.f;
            pv[j] = pj; lsum[m] += pj; }
          const unsigned w0 = pk2(pv[0], pv[1]), w1 = pk2(pv[2], pv[3]);
          pa[m][t >> 1][(t & 1) * 4 + 0] = (short)(w0 & 0xffff); pa[m][t >> 1][(t & 1) * 4 + 1] = (short)(w0 >> 16);
          pa[m][t >> 1][(t & 1) * 4 + 2] = (short)(w1 & 0xffff); pa[m][t >> 1][(t & 1) * 4 + 3] = (short)(w1 >> 16); } }
#pragma unroll
      for (int k2 = 0; k2 < 2; ++k2)
#pragma unroll
        for (int n = 0; n < 8; ++n) {
          const s16x4 lo = tr_read(Vb + (32 * k2 + 4 * Qd + (r >> 2)) * VP + 16 * n + 4 * (r & 3));
          const s16x4 hi = tr_read(Vb + (32 * k2 + 16 + 4 * Qd + (r >> 2)) * VP + 16 * n + 4 * (r & 3));
          const bf16x8 vf = (bf16x8){lo[0], lo[1], lo[2], lo[3], hi[0], hi[1], hi[2], hi[3]};
          o[0][n] = __builtin_amdgcn_mfma_f32_16x16x32_bf16(pa[0][k2], vf, o[0][n], 0, 0, 0);
          o[1][n] = __builtin_amdgcn_mfma_f32_16x16x32_bf16(pa[1][k2], vf, o[1][n], 0, 0, 0); }
      if (i + 1 < ntile) STORE_TILE(buf ^ 1);
      __syncthreads();
    }
#undef TILE_ROW0
#undef LOAD_TILE
#undef STORE_TILE
    const float sk = __expf(sink[hq] - mb);
#pragma unroll
    for (int m = 0; m < 2; ++m) { float l = lsum[m]; l += __shfl_xor(l, 16); l += __shfl_xor(l, 32); if (Qd == 0) dsc[wid * 32 + 16 * m + r] = 1.f / (l + sk); }
    LDS_WAIT(); asm volatile("" ::: "memory");
#pragma unroll
    for (int m = 0; m < 2; ++m)
#pragma unroll
      for (int j = 0; j < 4; ++j) { const float inv = dsc[wid * 32 + 16 * m + 4 * Qd + j]; const size_t ro = (qrow0 + 16 * m + 4 * Qd + j) * 2048 + hq * 128 + r;
#pragma unroll
        for (int n = 0; n < 8; ++n) { const bf16_t ov_ = f2bf(o[m][n][j] * inv * bf2f(G1[ro + 16 * n])); if (wr) Q1[ro + 16 * n] = ov_; } }
    LDS_WAIT(); asm volatile("" ::: "memory");
  }
}

constexpr size_t DO_SDT = 50 * MiB, DO_SCS = 53 * MiB;
constexpr size_t WS_SSQ = 237 * MiB;
DEV unsigned short bfbits(float f) { return f2bf(f); }
DEV void ssd_prep_phase(const bf16_t* XBC, const float* cw, const float* cb, bf16_t* XC, const float* DTLR, const float* dt_bias, const float* a_log, float* SDT, float* SCS, float* SDEC) {
  const int gtid = blockIdx.x * 512 + threadIdx.x, gth = gridDim.x * 512;
  for (int it = gtid; it < MA * 192; it += gth) {
    const int row = it / 192, c8 = (it % 192) * 8;
    int t, len;
    if (row < ML) { t = row % SEQ; len = SEQ; } else { t = (row - ML) % CTXL; len = CTXL; }
    float acc[8];
    { const f32x4 b0 = *(const f32x4*)(cb + c8), b1 = *(const f32x4*)(cb + c8 + 4); acc[0] = b0.x; acc[1] = b0.y; acc[2] = b0.z; acc[3] = b0.w; acc[4] = b1.x; acc[5] = b1.y; acc[6] = b1.z; acc[7] = b1.w; }
#pragma unroll
    for (int k = 0; k < 5; ++k) { const int tt = t + k - 2;
      if (tt >= 0 && tt < len) { const v4u xv = *(const v4u*)(XBC + (size_t)(row + k - 2) * 1536 + c8); const f32x4 w0 = *(const f32x4*)(cw + k * 1536 + c8), w1 = *(const f32x4*)(cw + k * 1536 + c8 + 4);
        acc[0] += w0.x * __uint_as_float(xv.x << 16); acc[1] += w0.y * __uint_as_float(xv.x & 0xffff0000u); acc[2] += w0.z * __uint_as_float(xv.y << 16); acc[3] += w0.w * __uint_as_float(xv.y & 0xffff0000u);
        acc[4] += w1.x * __uint_as_float(xv.z << 16); acc[5] += w1.y * __uint_as_float(xv.z & 0xffff0000u); acc[6] += w1.z * __uint_as_float(xv.w << 16); acc[7] += w1.w * __uint_as_float(xv.w & 0xffff0000u); } }
    v4u o; o.x = pk2(silu_fast(acc[0]), silu_fast(acc[1])); o.y = pk2(silu_fast(acc[2]), silu_fast(acc[3])); o.z = pk2(silu_fast(acc[4]), silu_fast(acc[5])); o.w = pk2(silu_fast(acc[6]), silu_fast(acc[7]));
    *(v4u*)(XC + (size_t)row * 1536 + c8) = o;
  }
  {
    const int lane = threadIdx.x & 63, wave = threadIdx.x >> 6, cl = lane & 7, seg = lane >> 3;
    for (int wt = blockIdx.x * NWAVES + wave; wt < NCH * 4; wt += gridDim.x * NWAVES) {
      const int gc = wt >> 2, col = (wt & 3) * 8 + cl, dir = col >> 4, h = col & 15;
      const float a = -__expf(a_log[col]), bias = dt_bias[col];
      float dtv[16], v[16]; float run = 0.f;
#pragma unroll
      for (int u = 0; u < 16; ++u) { const int s = seg * 16 + u, t = dir ? 127 - s : s; dtv[u] = softplusf(DTLR[((size_t)gc * 128 + t) * 64 + col] + bias); }
#pragma unroll
      for (int u = 0; u < 16; ++u) { run += dtv[u] * a; v[u] = run; }
      float off = 0.f;
#pragma unroll
      for (int sgi = 0; sgi < 7; ++sgi) { const float tot = __shfl(run, cl + 8 * sgi); off += (sgi < seg) ? tot : 0.f; }
#pragma unroll
      for (int u = 0; u < 16; ++u) { const int s = seg * 16 + u, t = dir ? 127 - s : s; const size_t row = (size_t)gc * 128 + t; SDT[row * 32 + col] = dtv[u]; SCS[row * 32 + col] = v[u] + off; }
      if (seg == 7) SDEC[(gc * 16 + h) * 2 + dir] = __expf(run + off);
    }
  }
}
DEV void ssd_u_phase(const bf16_t* XC, const float* SDT, const float* SCS, bf16_t* ST, LAS unsigned char* lds) {
  constexpr int XP = 272, BP = 144;
  LAS bf16_t* Xs = (LAS bf16_t*)lds; LAS bf16_t* Bs = (LAS bf16_t*)(lds + 128 * XP * 2); LAS float* wtab = (LAS float*)(lds + 128 * XP * 2 + 128 * BP * 2);
  const int tid = threadIdx.x, lane = tid & 63, wid = tid >> 6, r = lane & 15, Qd = lane >> 4, hl = wid >> 1, dir = wid & 1;
  for (int task = blockIdx.x; task < NCH * 4; task += gridDim.x) {
    const int gc = task >> 2, g = (task >> 1) & 1, hh = task & 1; const size_t r0 = (size_t)gc * 128; const int h0 = g * 8 + hh * 4;
    __syncthreads();
#pragma unroll
    for (int i = 0; i < 8; ++i) { const int cid = tid + 512 * i, row = cid >> 5, ch = cid & 31; *(LAS v4u*)(Xs + row * XP + ch * 8) = *(const v4u*)(XC + (r0 + row) * 1536 + h0 * 64 + ch * 8); }
#pragma unroll
    for (int i = 0; i < 4; ++i) { const int cid = tid + 512 * i, row = cid >> 4, ch = cid & 15; *(LAS v4u*)(Bs + row * BP + ch * 8) = *(const v4u*)(XC + (r0 + row) * 1536 + 1024 + g * 128 + ch * 8); }
#pragma unroll
    for (int i = 0; i < 2; ++i) { const int e = tid + 512 * i, combo = e >> 7, t = e & 127, col = (combo & 1) * 16 + h0 + (combo >> 1);
      const float cs_end = SCS[(r0 + ((combo & 1) ? 0 : 127)) * 32 + col]; wtab[e] = __expf(cs_end - SCS[(r0 + t) * 32 + col]) * SDT[(r0 + t) * 32 + col]; }
    __syncthreads();
    const LAS float* wt = wtab + wid * 128;
    bf16_t* Sp = ST + ((((size_t)gc * 16 + h0 + hl) * 2 + dir) * 64) * 128;
#pragma unroll 1
    for (int pp = 0; pp < 2; ++pp) {
      f32x4 acc[8][2];
#pragma unroll
      for (int nt = 0; nt < 8; ++nt) { acc[nt][0] = (f32x4){0.f, 0.f, 0.f, 0.f}; acc[nt][1] = (f32x4){0.f, 0.f, 0.f, 0.f}; }
#pragma unroll 1
      for (int k = 0; k < 4; ++k) {
        const f32x4 wlo = *(const LAS f32x4*)(wt + 32 * k + 4 * Qd), whi = *(const LAS f32x4*)(wt + 32 * k + 16 + 4 * Qd);
        bf16x8 xf[2];
#pragma unroll
        for (int pt = 0; pt < 2; ++pt) {
          const s16x4 lo = tr_read(Xs + (32 * k + 4 * Qd + (r >> 2)) * XP + hl * 64 + 32 * pp + 16 * pt + 4 * (r & 3));
          const s16x4 hi = tr_read(Xs + (32 * k + 16 + 4 * Qd + (r >> 2)) * XP + hl * 64 + 32 * pp + 16 * pt + 4 * (r & 3));
          const unsigned w0 = pk2(bf2f((bf16_t)lo[0]) * wlo[0], bf2f((bf16_t)lo[1]) * wlo[1]), w1 = pk2(bf2f((bf16_t)lo[2]) * wlo[2], bf2f((bf16_t)lo[3]) * wlo[3]);
          const unsigned w2 = pk2(bf2f((bf16_t)hi[0]) * whi[0], bf2f((bf16_t)hi[1]) * whi[1]), w3 = pk2(bf2f((bf16_t)hi[2]) * whi[2], bf2f((bf16_t)hi[3]) * whi[3]);
          xf[pt] = (bf16x8){(short)(w0 & 0xffff), (short)(w0 >> 16), (short)(w1 & 0xffff), (short)(w1 >> 16), (short)(w2 & 0xffff), (short)(w2 >> 16), (short)(w3 & 0xffff), (short)(w3 >> 16)};
        }
#pragma unroll
        for (int nt = 0; nt < 8; ++nt) {
          const s16x4 lo = tr_read(Bs + (32 * k + 4 * Qd + (r >> 2)) * BP + 16 * nt + 4 * (r & 3));
          const s16x4 hi = tr_read(Bs + (32 * k + 16 + 4 * Qd + (r >> 2)) * BP + 16 * nt + 4 * (r & 3));
          const bf16x8 bfr = (bf16x8){lo[0], lo[1], lo[2], lo[3], hi[0], hi[1], hi[2], hi[3]};
          acc[nt][0] = __builtin_amdgcn_mfma_f32_16x16x32_bf16(bfr, xf[0], acc[nt][0], 0, 0, 0);
          acc[nt][1] = __builtin_amdgcn_mfma_f32_16x16x32_bf16(bfr, xf[1], acc[nt][1], 0, 0, 0);
        }
      }
#pragma unroll
      for (int nt = 0; nt < 8; ++nt)
#pragma unroll
        for (int pt = 0; pt < 2; ++pt) { const f32x4 v = acc[nt][pt];
          *(unsigned long long*)(Sp + ((((2 * pp + pt) * 4 + (nt >> 1)) * 64 + ((nt & 1) * 2 + (Qd >> 1)) * 16 + r) * 8 + 4 * (Qd & 1))) = (unsigned long long)pk2(v[0], v[1]) | ((unsigned long long)pk2(v[2], v[3]) << 32); }
    }
  }
}
DEV void ssd_scan_phase(bf16_t* ST, const float* SDEC, bool wr) {
  for (int item = blockIdx.x * 512 + threadIdx.x; item < 2 * 16 * 2 * 2048; item += gridDim.x * 512) {
    const int e4 = item & 2047, dir = (item >> 11) & 1, h = (item >> 12) & 15, b = item >> 16;
    float S0 = 0.f, S1 = 0.f, S2 = 0.f, S3 = 0.f;
#define SCAN_GC(s) (!dir ? ((s) < 2 ? 128 + 2 * b + (s) : b * 64 + ((s) - 2)) : ((s) < 2 ? 128 + 2 * b + (1 - (s)) : b * 64 + (65 - (s))))
    for (int s0 = 0; s0 < 66; s0 += 6) {
      unsigned long long u[6]; float dec[6];
#pragma unroll
      for (int q = 0; q < 6; ++q) { const int gc = SCAN_GC(s0 + q); u[q] = *(const unsigned long long*)(ST + (((size_t)gc * 16 + h) * 2 + dir) * 8192 + e4 * 4); dec[q] = SDEC[(gc * 16 + h) * 2 + dir]; }
#pragma unroll
      for (int q = 0; q < 6; ++q) { const int gc = SCAN_GC(s0 + q);
        if (wr) *(unsigned long long*)(ST + (((size_t)gc * 16 + h) * 2 + dir) * 8192 + e4 * 4) = (unsigned long long)pk2(S0, S1) | ((unsigned long long)pk2(S2, S3) << 32);
        const unsigned lo = (unsigned)u[q], hi = (unsigned)(u[q] >> 32);
        S0 = dec[q] * S0 + __uint_as_float(lo << 16); S1 = dec[q] * S1 + __uint_as_float(lo & 0xffff0000u); S2 = dec[q] * S2 + __uint_as_float(hi << 16); S3 = dec[q] * S3 + __uint_as_float(hi & 0xffff0000u); }
    }
#undef SCAN_GC
  }
}
DEV bf16x8 scale_frag(bf16x8 f, float s) {
  bf16x8 o;
#pragma unroll
  for (int e = 0; e < 8; e += 2) { const unsigned w = pk2(bf2f((bf16_t)f[e]) * s, bf2f((bf16_t)f[e + 1]) * s); o[e] = (short)(w & 0xffff); o[e + 1] = (short)(w >> 16); }
  return o;
}
DEV void ssd_y_phase(const bf16_t* XC, const float* SDT, const float* SCS, const bf16_t* ST, const float* d_skip, bf16_t* Y0, float* SSQ, LAS unsigned char* lds, bool wr) {
  constexpr int XP = 272, BP = 136, SP = 72;
  LAS bf16_t* Xs = (LAS bf16_t*)lds; LAS bf16_t* Bs = (LAS bf16_t*)(lds + 128 * XP * 2);
  LAS float* tab = (LAS float*)(lds + 128 * XP * 2 + 128 * BP * 2);
  LAS float* ssq = tab + 4 * 4 * 128;
  LAS bf16_t* stg = (LAS bf16_t*)(ssq + 4 * 128);
  const int tid = threadIdx.x, lane = tid & 63, wid = tid >> 6, r = lane & 15, Qd = lane >> 4, hl = wid >> 1, ih = wid & 1;
  LAS bf16_t* mystg = stg + wid * 16 * SP;
  for (int task = blockIdx.x; task < NCH * 4; task += gridDim.x) {
    const int gc = task >> 2, g = (task >> 1) & 1, hh = task & 1; const size_t r0 = (size_t)gc * 128; const int h0 = g * 8 + hh * 4, h = h0 + hl;
    bf16x8 cstrip[4], cf[4][4];
#pragma unroll
    for (int ks = 0; ks < 4; ++ks) cstrip[ks] = *(const bf16x8*)(XC + (r0 + 16 * wid + r) * 1536 + 1280 + g * 128 + 32 * ks + 8 * Qd);
#pragma unroll
    for (int m = 0; m < 4; ++m)
#pragma unroll
      for (int ks = 0; ks < 4; ++ks) cf[m][ks] = *(const bf16x8*)(XC + (r0 + 64 * ih + 16 * m + r) * 1536 + 1280 + g * 128 + 32 * ks + 8 * Qd);
    __syncthreads();
#pragma unroll
    for (int i = 0; i < 8; ++i) { const int cid = tid + 512 * i, row = cid >> 5, ch = cid & 31; *(LAS v4u*)(Xs + row * XP + ch * 8) = *(const v4u*)(XC + (r0 + row) * 1536 + h0 * 64 + ch * 8); }
#pragma unroll
    for (int i = 0; i < 4; ++i) { const int cid = tid + 512 * i, row = cid >> 4, ch = cid & 15; *(LAS v4u*)(Bs + row * BP + ch * 8) = *(const v4u*)(XC + (r0 + row) * 1536 + 1024 + g * 128 + ch * 8); }
#pragma unroll
    for (int i = 0; i < 4; ++i) { const int e = tid + 512 * i, hq = e >> 9, which = (e >> 7) & 3, t = e & 127; const int col = (which & 1) * 16 + h0 + hq;
      tab[e] = (which < 2 ? SCS : SDT)[(r0 + t) * 32 + col]; }
    __syncthreads();
    {
      f32x4 cb[8];
#pragma unroll
      for (int t = 0; t < 8; ++t) { f32x4 c = {0.f, 0.f, 0.f, 0.f};
#pragma unroll
        for (int ks = 0; ks < 4; ++ks) { const bf16x8 bfr = *(const LAS bf16x8*)(Bs + (16 * t + r) * BP + 32 * ks + 8 * Qd); c = __builtin_amdgcn_mfma_f32_16x16x32_bf16(bfr, cstrip[ks], c, 0, 0, 0); }
        cb[t] = c; }
      __syncthreads();
#pragma unroll
      for (int t = 0; t < 8; ++t) *(LAS unsigned long long*)(Bs + (16 * wid + r) * BP + 16 * t + 4 * Qd) = (unsigned long long)pk2(cb[t][0], cb[t][1]) | ((unsigned long long)pk2(cb[t][2], cb[t][3]) << 32);
      __syncthreads();
    }
    const LAS float* csf = tab + hl * 512; const LAS float* csb = csf + 128; const LAS float* dtf = csf + 256; const LAS float* dtb = csf + 384;
    const float dsk = d_skip[h];
    f32x4 y[4][4];
#pragma unroll
    for (int m = 0; m < 4; ++m)
#pragma unroll
      for (int pt = 0; pt < 4; ++pt) y[m][pt] = (f32x4){0.f, 0.f, 0.f, 0.f};
#pragma unroll 1
    for (int dir = 0; dir < 2; ++dir) {
      const LAS float* csd = dir ? csb : csf; float sc[4];
#pragma unroll
      for (int m = 0; m < 4; ++m)
#pragma unroll
        for (int ks = 0; ks < 4; ++ks) asm volatile("" : "+v"(cf[m][ks]));
#pragma unroll
      for (int m = 0; m < 4; ++m) sc[m] = __expf(csd[64 * ih + 16 * m + r]);
      const bf16_t* Sp = ST + (((size_t)gc * 16 + h) * 2 + dir) * 8192 + lane * 8;
#pragma unroll
      for (int ks = 0; ks < 4; ++ks) {
        bf16x8 sf[4];
#pragma unroll
        for (int pt = 0; pt < 4; ++pt) sf[pt] = *(const bf16x8*)(Sp + (pt * 4 + ks) * 512);
#pragma unroll
        for (int m = 0; m < 4; ++m) { const bf16x8 a = scale_frag(cf[m][ks], sc[m]);
#pragma unroll
          for (int pt = 0; pt < 4; ++pt) y[m][pt] = __builtin_amdgcn_mfma_f32_16x16x32_bf16(a, sf[pt], y[m][pt], 0, 0, 0);
          __builtin_amdgcn_sched_barrier(0); }
      }
    }
#pragma unroll 1
    for (int m = 0; m < 4; ++m) {
      const int i0 = 64 * ih + 16 * m, i = i0 + r;
      const float cfi = csf[i], cbi = csb[i];
#pragma unroll 1
      for (int k2 = 0; k2 < 4; ++k2) {
        const int j0 = 32 * k2 + 8 * Qd;
        const v4u cbv = *(const LAS v4u*)(Bs + i * BP + j0);
        const float cbe[8] = {__uint_as_float(cbv.x << 16), __uint_as_float(cbv.x & 0xffff0000u), __uint_as_float(cbv.y << 16), __uint_as_float(cbv.y & 0xffff0000u), __uint_as_float(cbv.z << 16), __uint_as_float(cbv.z & 0xffff0000u), __uint_as_float(cbv.w << 16), __uint_as_float(cbv.w & 0xffff0000u)};
        float pv[8];
        const bool dofwd = (32 * k2 <= i0 + 15), dobwd = (32 * k2 + 31 >= i0);
#pragma unroll
        for (int e = 0; e < 8; ++e) pv[e] = (j0 + e == i) ? dsk : 0.f;
        if (dofwd) { const f32x4 a0 = *(const LAS f32x4*)(csf + j0), a1 = *(const LAS f32x4*)(csf + j0 + 4), d0 = *(const LAS f32x4*)(dtf + j0), d1 = *(const LAS f32x4*)(dtf + j0 + 4);
          const float jc[8] = {a0.x, a0.y, a0.z, a0.w, a1.x, a1.y, a1.z, a1.w}; const float jd[8] = {d0.x, d0.y, d0.z, d0.w, d1.x, d1.y, d1.z, d1.w};
#pragma unroll
          for (int e = 0; e < 8; ++e) pv[e] += cbe[e] * __expf(j0 + e <= i ? cfi - jc[e] : -INFINITY) * jd[e]; }
        if (dobwd) { const f32x4 a0 = *(const LAS f32x4*)(csb + j0), a1 = *(const LAS f32x4*)(csb + j0 + 4), d0 = *(const LAS f32x4*)(dtb + j0), d1 = *(const LAS f32x4*)(dtb + j0 + 4);
          const float jc[8] = {a0.x, a0.y, a0.z, a0.w, a1.x, a1.y, a1.z, a1.w}; const float jd[8] = {d0.x, d0.y, d0.z, d0.w, d1.x, d1.y, d1.z, d1.w};
#pragma unroll
          for (int e = 0; e < 8; ++e) pv[e] += cbe[e] * __expf(j0 + e >= i ? cbi - jc[e] : -INFINITY) * jd[e]; }
        const unsigned w0 = pk2(pv[0], pv[1]), w1 = pk2(pv[2], pv[3]), w2 = pk2(pv[4], pv[5]), w3 = pk2(pv[6], pv[7]);
        const bf16x8 pa = (bf16x8){(short)(w0 & 0xffff), (short)(w0 >> 16), (short)(w1 & 0xffff), (short)(w1 >> 16), (short)(w2 & 0xffff), (short)(w2 >> 16), (short)(w3 & 0xffff), (short)(w3 >> 16)};
#pragma unroll
        for (int pt = 0; pt < 4; ++pt) {
          const s16x4 lo = tr_read(Xs + (32 * k2 + 8 * Qd + (r >> 2)) * XP + hl * 64 + 16 * pt + 4 * (r & 3));
          const s16x4 hi = tr_read(Xs + (32 * k2 + 8 * Qd + 4 + (r >> 2)) * XP + hl * 64 + 16 * pt + 4 * (r & 3));
          const bf16x8 xf = (bf16x8){lo[0], lo[1], lo[2], lo[3], hi[0], hi[1], hi[2], hi[3]};
          y[0][pt] = __builtin_amdgcn_mfma_f32_16x16x32_bf16(pa, xf, y[0][pt], 0, 0, 0);
        }
      }
#pragma unroll
      for (int pt = 0; pt < 4; ++pt)
#pragma unroll
        for (int jj = 0; jj < 4; ++jj) mystg[(4 * Qd + jj) * SP + 16 * pt + r] = f2bf(y[0][pt][jj]);
      LDS_WAIT(); asm volatile("" ::: "memory");
#pragma unroll
      for (int q = 0; q < 2; ++q) { const int c = lane + 64 * q, rowl = c >> 3, ch = c & 7; const int il = 64 * ih + 16 * m + rowl;
        const v4u yv = *(const LAS v4u*)(mystg + rowl * SP + ch * 8); bf16_t* zp = Y0 + (r0 + il) * 2048 + h * 64 + ch * 8; const v4u zv = *(const v4u*)zp;
        const float v0 = __uint_as_float(yv.x << 16) * __uint_as_float(zv.x << 16), v1 = __uint_as_float(yv.x & 0xffff0000u) * __uint_as_float(zv.x & 0xffff0000u);
        const float v2 = __uint_as_float(yv.y << 16) * __uint_as_float(zv.y << 16), v3 = __uint_as_float(yv.y & 0xffff0000u) * __uint_as_float(zv.y & 0xffff0000u);
        const float v4 = __uint_as_float(yv.z << 16) * __uint_as_float(zv.z << 16), v5 = __uint_as_float(yv.z & 0xffff0000u) * __uint_as_float(zv.z & 0xffff0000u);
        const float v6 = __uint_as_float(yv.w << 16) * __uint_as_float(zv.w << 16), v7 = __uint_as_float(yv.w & 0xffff0000u) * __uint_as_float(zv.w & 0xffff0000u);
        float ss = (v0 * v0 + v1 * v1) + (v2 * v2 + v3 * v3) + (v4 * v4 + v5 * v5) + (v6 * v6 + v7 * v7);
        ss += __shfl_xor(ss, 1); ss += __shfl_xor(ss, 2); ss += __shfl_xor(ss, 4);
        v4u ov; ov.x = pk2(v0, v1); ov.y = pk2(v2, v3); ov.z = pk2(v4, v5); ov.w = pk2(v6, v7);
        if (wr) *(v4u*)zp = ov;
        if (ch == 0) ssq[hl * 128 + il] = ss; }
      LDS_WAIT(); asm volatile("" ::: "memory");
#pragma unroll
      for (int pt = 0; pt < 4; ++pt) { y[0][pt] = y[1][pt]; y[1][pt] = y[2][pt]; y[2][pt] = y[3][pt]; }
    }
    __syncthreads();
    if (tid < 128) SSQ[((r0 + tid) * 2 + g) * 2 + hh] = (ssq[tid] + ssq[128 + tid]) + (ssq[256 + tid] + ssq[384 + tid]);
  }
}

constexpr size_t WS_GCSC = 237 * MiB + 4 * MiB;
typedef _Float16 h16_t;
typedef _Float16 h16x8 __attribute__((ext_vector_type(8)));
DEV const h16_t* gcs_row(const h16_t* lat, const h16_t* ctx, size_t row) { return row < (size_t)ML ? lat + row * 1024 : ctx + (row - ML) * 1024; }
DEV h16_t* gcs_row_w(h16_t* lat, h16_t* ctx, size_t row) { return row < (size_t)ML ? lat + row * 1024 : ctx + (row - ML) * 1024; }
DEV float logsig_fast(float x) { return fminf(x, 0.f) - __logf(1.f + __expf(-fabsf(x))); }
DEV void gla_cs_phase(const float* DTLR, const float* gw, const float* gb, h16_t* GCSL, h16_t* GCSC, float* GDEC) {
  const int lane = threadIdx.x & 63, wave = threadIdx.x >> 6, kl = lane & 7, seg = lane >> 3;
  for (int wt = blockIdx.x * NWAVES + wave; wt < NCH * 2 * 64; wt += gridDim.x * NWAVES) {
    const int gc = wt >> 7, dir = (wt >> 6) & 1, k = (wt & 63) * 8 + kl;
    float wv[16];
#pragma unroll
    for (int q = 0; q < 16; ++q) wv[q] = gw[(dir * 16 + q) * 512 + k];
    const float bias = gb[dir * 512 + k];
    float v[16]; float run = 0.f;
#pragma unroll
    for (int u = 0; u < 16; ++u) { const int s = seg * 16 + u, t = dir ? 127 - s : s; const float* lr = DTLR + ((size_t)gc * 128 + t) * 64 + 32 + dir * 16;
      const f32x4 l0 = *(const f32x4*)lr, l1 = *(const f32x4*)(lr + 4), l2 = *(const f32x4*)(lr + 8), l3 = *(const f32x4*)(lr + 12);
      float lg = bias + l0.x * wv[0] + l0.y * wv[1] + l0.z * wv[2] + l0.w * wv[3] + l1.x * wv[4] + l1.y * wv[5] + l1.z * wv[6] + l1.w * wv[7]
                 + l2.x * wv[8] + l2.y * wv[9] + l2.z * wv[10] + l2.w * wv[11] + l3.x * wv[12] + l3.y * wv[13] + l3.z * wv[14] + l3.w * wv[15];
      run += logsig_fast(lg) * (1.f / 16.f); v[u] = run; }
    float off = 0.f;
#pragma unroll
    for (int sgi = 0; sgi < 7; ++sgi) { const float tot = __shfl(run, kl + 8 * sgi); off += (sgi < seg) ? tot : 0.f; }
#pragma unroll
    for (int u = 0; u < 16; ++u) { const int s = seg * 16 + u, t = dir ? 127 - s : s; gcs_row_w(GCSL, GCSC, (size_t)gc * 128 + t)[dir * 512 + k] = (h16_t)(v[u] + off); }
    if (seg == 7) GDEC[((gc * 4 + (k >> 7)) * 2 + dir) * 128 + (k & 127)] = __expf(run + off);
  }
}
DEV void gla_u_phase(const bf16_t* K0, const bf16_t* V0, const h16_t* GCSL, const h16_t* GCSC, bf16_t* ST, LAS unsigned char* lds) {
  constexpr int VP = 272, KP = 144;
  LAS bf16_t* Vs = (LAS bf16_t*)lds; LAS bf16_t* Kd = (LAS bf16_t*)(lds + 128 * VP * 2);
  const int tid = threadIdx.x, lane = tid & 63, wid = tid >> 6, r = lane & 15, Qd = lane >> 4;
  for (int task = blockIdx.x; task < NCH * 4; task += gridDim.x) {
    const int gc = task >> 2, h = task & 3; const size_t r0 = (size_t)gc * 128;
    __syncthreads();
#pragma unroll
    for (int i = 0; i < 8; ++i) { const int cid = tid + 512 * i, row = cid >> 5, ch = cid & 31; *(LAS v4u*)(Vs + row * VP + ch * 8) = *(const v4u*)(V0 + (r0 + row) * 1024 + h * 256 + ch * 8); }
#pragma unroll
    for (int i = 0; i < 4; ++i) { const int cid = tid + 512 * i, t = cid >> 4, ch = cid & 15;
      const v4u kv = *(const v4u*)(K0 + (r0 + t) * 512 + h * 128 + ch * 8);
      const float kf[8] = {__uint_as_float(kv.x << 16), __uint_as_float(kv.x & 0xffff0000u), __uint_as_float(kv.y << 16), __uint_as_float(kv.y & 0xffff0000u), __uint_as_float(kv.z << 16), __uint_as_float(kv.z & 0xffff0000u), __uint_as_float(kv.w << 16), __uint_as_float(kv.w & 0xffff0000u)};
#pragma unroll
      for (int dir = 0; dir < 2; ++dir) {
        const h16x8 ce = *(const h16x8*)(gcs_row(GCSL, GCSC, r0 + (dir ? 0 : 127)) + dir * 512 + h * 128 + ch * 8), ct = *(const h16x8*)(gcs_row(GCSL, GCSC, r0 + t) + dir * 512 + h * 128 + ch * 8);
        v4u o; o.x = pk2(kf[0] * __expf((float)ce[0] - (float)ct[0]), kf[1] * __expf((float)ce[1] - (float)ct[1])); o.y = pk2(kf[2] * __expf((float)ce[2] - (float)ct[2]), kf[3] * __expf((float)ce[3] - (float)ct[3]));
        o.z = pk2(kf[4] * __expf((float)ce[4] - (float)ct[4]), kf[5] * __expf((float)ce[5] - (float)ct[5])); o.w = pk2(kf[6] * __expf((float)ce[6] - (float)ct[6]), kf[7] * __expf((float)ce[7] - (float)ct[7]));
        *(LAS v4u*)(Kd + dir * 128 * KP + t * KP + ch * 8) = o; } }
    __syncthreads();
#pragma unroll 1
    for (int dir = 0; dir < 2; ++dir) {
      const LAS bf16_t* Kb = Kd + dir * 128 * KP;
      f32x4 acc[8][2];
#pragma unroll
      for (int dt = 0; dt < 8; ++dt) { acc[dt][0] = (f32x4){0.f, 0.f, 0.f, 0.f}; acc[dt][1] = (f32x4){0.f, 0.f, 0.f, 0.f}; }
#pragma unroll 1
      for (int k = 0; k < 4; ++k) {
        bf16x8 vf[2];
#pragma unroll
        for (int et = 0; et < 2; ++et) {
          const s16x4 lo = tr_read(Vs + (32 * k + 4 * Qd + (r >> 2)) * VP + 32 * wid + 16 * et + 4 * (r & 3));
          const s16x4 hi = tr_read(Vs + (32 * k + 16 + 4 * Qd + (r >> 2)) * VP + 32 * wid + 16 * et + 4 * (r & 3));
          vf[et] = (bf16x8){lo[0], lo[1], lo[2], lo[3], hi[0], hi[1], hi[2], hi[3]}; }
#pragma unroll
        for (int dt = 0; dt < 8; ++dt) {
          const s16x4 lo = tr_read(Kb + (32 * k + 4 * Qd + (r >> 2)) * KP + 16 * dt + 4 * (r & 3));
          const s16x4 hi = tr_read(Kb + (32 * k + 16 + 4 * Qd + (r >> 2)) * KP + 16 * dt + 4 * (r & 3));
          const bf16x8 kfr = (bf16x8){lo[0], lo[1], lo[2], lo[3], hi[0], hi[1], hi[2], hi[3]};
          acc[dt][0] = __builtin_amdgcn_mfma_f32_16x16x32_bf16(kfr, vf[0], acc[dt][0], 0, 0, 0);
          acc[dt][1] = __builtin_amdgcn_mfma_f32_16x16x32_bf16(kfr, vf[1], acc[dt][1], 0, 0, 0); }
      }
      bf16_t* Sp = ST + (((size_t)gc * 4 + h) * 2 + dir) * 32768;
#pragma unroll
      for (int dt = 0; dt < 8; ++dt)
#pragma unroll
        for (int et = 0; et < 2; ++et) { const f32x4 v = acc[dt][et];
          *(unsigned long long*)(Sp + ((((2 * wid + et) * 4 + (dt >> 1)) * 64 + ((dt & 1) * 2 + (Qd >> 1)) * 16 + r) * 8 + 4 * (Qd & 1))) = (unsigned long long)pk2(v[0], v[1]) | ((unsigned long long)pk2(v[2], v[3]) << 32); }
    }
  }
}
DEV void gla_scan_phase(bf16_t* ST, const float* GDEC, bool wr) {
  for (int item = blockIdx.x * 512 + threadIdx.x; item < 2 * 4 * 2 * 8192; item += gridDim.x * 512) {
    const int e4 = item & 8191, dir = (item >> 13) & 1, h = (item >> 14) & 3, b = item >> 16; const int d0 = 32 * ((e4 >> 7) & 3) + 8 * ((e4 >> 5) & 3) + 4 * (e4 & 1);
    float S0 = 0.f, S1 = 0.f, S2 = 0.f, S3 = 0.f;
#define SCAN_GC(s) (!dir ? ((s) < 2 ? 128 + 2 * b + (s) : b * 64 + ((s) - 2)) : ((s) < 2 ? 128 + 2 * b + (1 - (s)) : b * 64 + (65 - (s))))
    for (int s0 = 0; s0 < 66; s0 += 6) {
      unsigned long long u[6]; f32x4 dec[6];
#pragma unroll
      for (int q = 0; q < 6; ++q) { const int gc = SCAN_GC(s0 + q); u[q] = *(const unsigned long long*)(ST + (((size_t)gc * 4 + h) * 2 + dir) * 32768 + e4 * 4); dec[q] = *(const f32x4*)(GDEC + ((gc * 4 + h) * 2 + dir) * 128 + d0); }
#pragma unroll
      for (int q = 0; q < 6; ++q) { const int gc = SCAN_GC(s0 + q);
        if (wr) *(unsigned long long*)(ST + (((size_t)gc * 4 + h) * 2 + dir) * 32768 + e4 * 4) = (unsigned long long)pk2(S0, S1) | ((unsigned long long)pk2(S2, S3) << 32);
        const unsigned lo = (unsigned)u[q], hi = (unsigned)(u[q] >> 32);
        S0 = dec[q].x * S0 + __uint_as_float(lo << 16); S1 = dec[q].y * S1 + __uint_as_float(lo & 0xffff0000u); S2 = dec[q].z * S2 + __uint_as_float(hi << 16); S3 = dec[q].w * S3 + __uint_as_float(hi & 0xffff0000u); }
    }
#undef SCAN_GC
  }
}
DEV void gla_o_phase(const bf16_t* Q0, const bf16_t* K0, const bf16_t* V0, const h16_t* GCSL, const h16_t* GCSC, const bf16_t* ST, const float* gla_norm, const float* SSQ, const float* ssd_norm, bf16_t* Y0, LAS unsigned char* lds, bool wr) {
  constexpr int VP = 272, KP = 136;
  LAS bf16_t* Vs = (LAS bf16_t*)lds; LAS bf16_t* Kd = (LAS bf16_t*)(lds + 128 * VP * 2);
  const int tid = threadIdx.x, lane = tid & 63, wid = tid >> 6, r = lane & 15, Qd = lane >> 4;
  const float scale = 0.08838834764831845f;
  for (int task = blockIdx.x; task < NCH * 4; task += gridDim.x) {
    const int gc = task >> 2, h = task & 3; const size_t r0 = (size_t)gc * 128;
    __syncthreads();
#pragma unroll
    for (int i = 0; i < 8; ++i) { const int cid = tid + 512 * i, row = cid >> 5, ch = cid & 31; *(LAS v4u*)(Vs + row * VP + ch * 8) = *(const v4u*)(V0 + (r0 + row) * 1024 + h * 256 + ch * 8); }
#pragma unroll
    for (int i = 0; i < 4; ++i) { const int cid = tid + 512 * i, t = cid >> 4, ch = cid & 15;
      const v4u kv = *(const v4u*)(K0 + (r0 + t) * 512 + h * 128 + ch * 8);
      const float kf[8] = {__uint_as_float(kv.x << 16), __uint_as_float(kv.x & 0xffff0000u), __uint_as_float(kv.y << 16), __uint_as_float(kv.y & 0xffff0000u), __uint_as_float(kv.z << 16), __uint_as_float(kv.z & 0xffff0000u), __uint_as_float(kv.w << 16), __uint_as_float(kv.w & 0xffff0000u)};
#pragma unroll
      for (int dir = 0; dir < 2; ++dir) {
        const h16x8 ct = *(const h16x8*)(gcs_row(GCSL, GCSC, r0 + t) + dir * 512 + h * 128 + ch * 8);
        v4u o; o.x = pk2(kf[0] * __expf(-(float)ct[0]), kf[1] * __expf(-(float)ct[1])); o.y = pk2(kf[2] * __expf(-(float)ct[2]), kf[3] * __expf(-(float)ct[3]));
        o.z = pk2(kf[4] * __expf(-(float)ct[4]), kf[5] * __expf(-(float)ct[5])); o.w = pk2(kf[6] * __expf(-(float)ct[6]), kf[7] * __expf(-(float)ct[7]));
        *(LAS v4u*)(Kd + dir * 128 * KP + t * KP + ch * 8) = o; } }
    __syncthreads();
    const int i = 16 * wid + r;
    f32x4 o[16];
#pragma unroll
    for (int et = 0; et < 16; ++et) o[et] = (f32x4){0.f, 0.f, 0.f, 0.f};
#pragma unroll 1
    for (int dir = 0; dir < 2; ++dir) {
      bf16x8 qd[4];
      { const h16_t* ci = gcs_row(GCSL, GCSC, r0 + i) + dir * 512 + h * 128; const bf16_t* qp = Q0 + (r0 + i) * 512 + h * 128;
#pragma unroll
        for (int ks = 0; ks < 4; ++ks) { const v4u qv = *(const v4u*)(qp + 32 * ks + 8 * Qd); const h16x8 cc = *(const h16x8*)(ci + 32 * ks + 8 * Qd);
          const f32x4 c0 = {(float)cc[0], (float)cc[1], (float)cc[2], (float)cc[3]}, c1 = {(float)cc[4], (float)cc[5], (float)cc[6], (float)cc[7]};
          const unsigned w0 = pk2(__uint_as_float(qv.x << 16) * scale * __expf(c0.x), __uint_as_float(qv.x & 0xffff0000u) * scale * __expf(c0.y));
          const unsigned w1 = pk2(__uint_as_float(qv.y << 16) * scale * __expf(c0.z), __uint_as_float(qv.y & 0xffff0000u) * scale * __expf(c0.w));
          const unsigned w2 = pk2(__uint_as_float(qv.z << 16) * scale * __expf(c1.x), __uint_as_float(qv.z & 0xffff0000u) * scale * __expf(c1.y));
          const unsigned w3 = pk2(__uint_as_float(qv.w << 16) * scale * __expf(c1.z), __uint_as_float(qv.w & 0xffff0000u) * scale * __expf(c1.w));
          qd[ks] = (bf16x8){(short)(w0 & 0xffff), (short)(w0 >> 16), (short)(w1 & 0xffff), (short)(w1 >> 16), (short)(w2 & 0xffff), (short)(w2 >> 16), (short)(w3 & 0xffff), (short)(w3 >> 16)}; } }
      const bf16_t* Sp = ST + (((size_t)gc * 4 + h) * 2 + dir) * 32768 + lane * 8;
      {
        bf16x8 sA[4], sB[4];
#pragma unroll
        for (int q = 0; q < 4; ++q) sA[q] = *(const bf16x8*)(Sp + (q * 4 + 0) * 512);
#pragma unroll
        for (int bi = 0; bi < 16; ++bi) {
          const int ks = bi >> 2, e0 = 4 * (bi & 3);
          if (bi + 1 < 16) { const int ks2 = (bi + 1) >> 2, e2 = 4 * ((bi + 1) & 3);
#pragma unroll
            for (int q = 0; q < 4; ++q) { if (bi & 1) sA[q] = *(const bf16x8*)(Sp + ((e2 + q) * 4 + ks2) * 512); else sB[q] = *(const bf16x8*)(Sp + ((e2 + q) * 4 + ks2) * 512); } }
#pragma unroll
          for (int q = 0; q < 4; ++q) o[e0 + q] = __builtin_amdgcn_mfma_f32_16x16x32_bf16(qd[ks], (bi & 1) ? sB[q] : sA[q], o[e0 + q], 0, 0, 0);
          __builtin_amdgcn_sched_barrier(0);
        }
      }
      const LAS bf16_t* Kb = Kd + dir * 128 * KP;
#pragma unroll 1
      for (int k2 = 0; k2 < 4; ++k2) {
        const bool need = dir ? (2 * k2 + 1 >= wid) : (2 * k2 <= wid);
        if (!need) continue;
        bf16x8 pa;
#pragma unroll
        for (int tt = 0; tt < 2; ++tt) { const int t = 2 * k2 + tt;
          f32x4 c = {0.f, 0.f, 0.f, 0.f};
#pragma unroll
          for (int ks = 0; ks < 4; ++ks) { const bf16x8 kfr = *(const LAS bf16x8*)(Kb + (16 * t + r) * KP + 32 * ks + 8 * Qd); c = __builtin_amdgcn_mfma_f32_16x16x32_bf16(kfr, qd[ks], c, 0, 0, 0); }
          float pv[4];
#pragma unroll
          for (int jj = 0; jj < 4; ++jj) { const int j = 16 * t + 4 * Qd + jj; const bool ok = dir ? (j >= i) : (j <= i); pv[jj] = ok ? c[jj] : 0.f; }
          const unsigned w0 = pk2(pv[0], pv[1]), w1 = pk2(pv[2], pv[3]);
          pa[tt * 4 + 0] = (short)(w0 & 0xffff); pa[tt * 4 + 1] = (short)(w0 >> 16); pa[tt * 4 + 2] = (short)(w1 & 0xffff); pa[tt * 4 + 3] = (short)(w1 >> 16); }
#pragma unroll
        for (int et = 0; et < 16; ++et) {
          const s16x4 lo = tr_read(Vs + (32 * k2 + 4 * Qd + (r >> 2)) * VP + 16 * et + 4 * (r & 3));
          const s16x4 hi = tr_read(Vs + (32 * k2 + 16 + 4 * Qd + (r >> 2)) * VP + 16 * et + 4 * (r & 3));
          const bf16x8 vf = (bf16x8){lo[0], lo[1], lo[2], lo[3], hi[0], hi[1], hi[2], hi[3]};
          o[et] = __builtin_amdgcn_mfma_f32_16x16x32_bf16(pa, vf, o[et], 0, 0, 0); }
      }
    }
#pragma unroll
    for (int jj = 0; jj < 4; ++jj) { float ss = 0.f;
#pragma unroll
      for (int et = 0; et < 16; ++et) ss += o[et][jj] * o[et][jj];
      ss += __shfl_xor(ss, 1); ss += __shfl_xor(ss, 2); ss += __shfl_xor(ss, 4); ss += __shfl_xor(ss, 8);
      const float rstd = rsqrtf(ss * (1.f / 256.f) + EPS);
      const size_t yo = (r0 + 16 * wid + 4 * Qd + jj) * 2048 + 1024 + h * 256 + r;
#pragma unroll
      for (int et = 0; et < 16; ++et) { const bf16_t ov_ = f2bf(o[et][jj] * rstd * gla_norm[h * 256 + 16 * et + r] * bf2f(Y0[yo + 16 * et])); if (wr) Y0[yo + 16 * et] = ov_; } }
    { const int g = h >> 1, c0 = g * 512 + (h & 1) * 256;
#pragma unroll
      for (int q = 0; q < 8; ++q) { const int cid = tid + 512 * q, row = cid >> 5, ch = cid & 31; const size_t rr = r0 + row;
        const float rstd = rsqrtf((SSQ[(rr * 2 + g) * 2] + SSQ[(rr * 2 + g) * 2 + 1]) * (1.f / 512.f) + EPS);
        bf16_t* yp = Y0 + rr * 2048 + c0 + ch * 8; const v4u yv = *(const v4u*)yp; const f32x4 g0 = *(const f32x4*)(ssd_norm + c0 + ch * 8), g1 = *(const f32x4*)(ssd_norm + c0 + ch * 8 + 4);
        v4u ov; ov.x = pk2(__uint_as_float(yv.x << 16) * rstd * g0.x, __uint_as_float(yv.x & 0xffff0000u) * rstd * g0.y); ov.y = pk2(__uint_as_float(yv.y << 16) * rstd * g0.z, __uint_as_float(yv.y & 0xffff0000u) * rstd * g0.w);
        ov.z = pk2(__uint_as_float(yv.z << 16) * rstd * g1.x, __uint_as_float(yv.z & 0xffff0000u) * rstd * g1.y); ov.w = pk2(__uint_as_float(yv.w << 16) * rstd * g1.z, __uint_as_float(yv.w & 0xffff0000u) * rstd * g1.w);
        if (wr) *(v4u*)yp = ov; } }
  }
}

typedef __attribute__((address_space(1))) unsigned gu32;
#define RLX_AGENT __ATOMIC_RELAXED, __HIP_MEMORY_SCOPE_AGENT
#define XB_TMO      128
#define XB_XCNT(j)  (256  + 64 * (j))
#define XB_XSUB(j)  (1280 + 64 * (j))
#define XB_XGEN(j)  (2304 + 64 * (j))
#define XB_TOP      3328
#define XB_TOPGEN   3392
#define XCD_BAR_WORDS 3456
#define XB_SPIN_CAP (1u << 18)

__device__ __forceinline__ unsigned xb_ld(unsigned* p)              { return __hip_atomic_load(p, __ATOMIC_RELAXED, __HIP_MEMORY_SCOPE_AGENT); }
__device__ __forceinline__ unsigned xb_add(unsigned* p, unsigned v) { return __hip_atomic_fetch_add(p, v, __ATOMIC_RELAXED, __HIP_MEMORY_SCOPE_AGENT); }
__device__ __forceinline__ unsigned xb_xcc_id() { return (unsigned)__builtin_amdgcn_s_getreg((3 << 11) | 20) & 0xFu; }
#define XB_SPIN(cond, bar) do { unsigned _sp = 0; while (cond) { __builtin_amdgcn_s_sleep(1); \
    if ((++_sp & 255u) == 0u) { if (xb_ld(&(bar)[XB_TMO])) break; if (_sp > XB_SPIN_CAP) { atomicAdd(&(bar)[XB_TMO], 1u); break; } } } } while (0)

struct XcdBarrier {
    unsigned* bar; unsigned x;
    volatile LAS unsigned* st;
};

__device__ __forceinline__ XcdBarrier xcd_barrier_post(unsigned* bar, volatile LAS unsigned* st) {
    XcdBarrier b; b.bar = bar; b.x = xb_xcc_id(); b.st = st;
    if (threadIdx.x == 0) (void)xb_add(&bar[XB_XCNT(b.x)], 1u);
    return b;
}
__device__ __forceinline__ void xcd_barrier_complete(unsigned* bar, unsigned x, unsigned& nloc, unsigned& nx) {
    const unsigned G = gridDim.x * gridDim.y * gridDim.z;
    unsigned sum, cnt, mine, sp = 0u;
    for (;;) {
        sum = 0u; cnt = 0u; mine = 0u;
#pragma unroll
        for (unsigned j = 0; j < 16; ++j) { const unsigned c = xb_ld(&bar[XB_XCNT(j)]); sum += c; cnt += (c > 0u) ? 1u : 0u; mine = (j == x) ? c : mine; }
        if (sum == G) break;
        __builtin_amdgcn_s_sleep(1);
        if ((++sp & 255u) == 0u) { if (xb_ld(&bar[XB_TMO])) break; if (sp > XB_SPIN_CAP) { atomicAdd(&bar[XB_TMO], 1u); break; } }
    }
    nloc = mine > 0u ? mine : 1u; nx = cnt > 0u ? cnt : 1u;
}

__device__ __forceinline__ void xcd_barrier(const XcdBarrier& b) {
    asm volatile("s_waitcnt vmcnt(0)" ::: "memory");
    __syncthreads();
    if (threadIdx.x == 0) {
        unsigned* bar = b.bar;
        __builtin_amdgcn_s_waitcnt(0);
        unsigned nloc = b.st[0], nx = b.st[1];
        if (nloc == 0u) { xcd_barrier_complete(bar, b.x, nloc, nx); b.st[0] = nloc; b.st[1] = nx; }
        const unsigned old = xb_add(&bar[XB_XSUB(b.x)], 1u);
        const unsigned gen = old / nloc;
        if (old + 1u == (gen + 1u) * nloc) {
            __builtin_amdgcn_fence(__ATOMIC_RELEASE, "agent");
            asm volatile("s_waitcnt vmcnt(0)" ::: "memory");
            const unsigned og = xb_add(&bar[XB_TOP], 1u);
            const unsigned tg = og / nx;
            if (og + 1u == (tg + 1u) * nx) xb_add(&bar[XB_TOPGEN], 1u);
            else XB_SPIN(xb_ld(&bar[XB_TOPGEN]) == tg, bar);
            __builtin_amdgcn_fence(__ATOMIC_ACQUIRE, "agent");
            xb_add(&bar[XB_XGEN(b.x)], 1u);
            asm volatile("s_waitcnt vmcnt(0)" ::: "memory");
        } else {
            XB_SPIN(xb_ld(&bar[XB_XGEN(b.x)]) == gen, bar);
            __builtin_amdgcn_fence(__ATOMIC_ACQUIRE, "agent");
            asm volatile("s_waitcnt vmcnt(0)" ::: "memory");
        }
    }
    __syncthreads();
}

__global__ void __launch_bounds__(NWAVES * 64, 2) mega(Params p) {
  extern __shared__ __attribute__((aligned(16))) unsigned char lds_raw[];
  LAS unsigned char* lds = (LAS unsigned char*)lds_raw;
  cg::grid_group grid = cg::this_grid();
  volatile LAS unsigned* MISC = (volatile LAS unsigned*)(lds + MISC_OFF);
  if (threadIdx.x < 16) MISC[threadIdx.x] = 0u;
  __syncthreads();
  XcdBarrier bar = xcd_barrier_post((unsigned*)(p.ws + WS_CTL), MISC + 8);
  unsigned char* ws = p.ws;
  float* MOD = (float*)(ws + WS_MOD);
  bf16_t* H0 = (bf16_t*)p.out; float* X1 = p.out;
  const int lo = p.ph_lo, hi = p.ph_hi;
  if (lo < 0) grid.sync();
#define IN(k) (lo <= (k) && (k) < hi)
#define SEAM(k) do { if ((k) + 1 < hi) xcd_barrier(bar); } while (0)
#define PH(k, ...) if (IN(k)) { if ((PROBE_MASK >> (k)) & 1u) { const bool wr = (p.rep < 0); (void)wr; __VA_ARGS__; xcd_barrier(bar); } { const bool wr = true; (void)wr; __VA_ARGS__; } SEAM(k); }
  PH(0, prologue_phase(p, lds))
  PH(1, prep_phase(p.in[0], p.in[2], p.in[4], MOD, H0))
  PH(2, {
    pg8::Gemm g{H0, (const bf16_t*)(ws + WS_W1T), MA, E_INP, D}; pg8::StaticOrder S; S.init(MA, E_INP, gridDim.x, (int)blockIdx.x);
    pg8::EpiProj0 E{(bf16_t*)(ws + WS_Y0), (bf16_t*)(ws + WS_XBC), (bf16_t*)(ws + WS_Q0), (bf16_t*)(ws + WS_K0), (bf16_t*)(ws + WS_V0), (float*)(ws + WS_DTLR)};
    pg8::gemm_phase<pg8::EpiProj0, pg8::StaticOrder, true, true>(lds, g, S, E); })
  PH(3, ssd_prep_phase((const bf16_t*)(ws + WS_XBC), p.in[8], p.in[9], (bf16_t*)p.out, (const float*)(ws + WS_DTLR), p.in[10], p.in[11], (float*)((char*)p.out + DO_SDT), (float*)((char*)p.out + DO_SCS), (float*)(ws + WS_SDEC)))
  PH(4, { ssd_u_phase((const bf16_t*)p.out, (const float*)((char*)p.out + DO_SDT), (const float*)((char*)p.out + DO_SCS), (bf16_t*)(ws + WS_STATE), lds);
    { const int nbusy = (NCH * 4) % (int)gridDim.x, nfree = (int)gridDim.x - nbusy;
      if ((int)blockIdx.x >= nbusy || nfree <= 0) { __syncthreads(); late_weights(p, lds, nfree > 0 ? (int)blockIdx.x - nbusy : (int)blockIdx.x, nfree > 0 ? nfree : (int)gridDim.x); } } })
  PH(5, ssd_scan_phase((bf16_t*)(ws + WS_STATE), (const float*)(ws + WS_SDEC), wr))
  PH(6, ssd_y_phase((const bf16_t*)p.out, (const float*)((char*)p.out + DO_SDT), (const float*)((char*)p.out + DO_SCS), (const bf16_t*)(ws + WS_STATE), p.in[12], (bf16_t*)(ws + WS_Y0), (float*)(ws + WS_SSQ), lds, wr))
  PH(7, gla_cs_phase((const float*)(ws + WS_DTLR), p.in[14], p.in[15], (h16_t*)p.out, (h16_t*)(ws + WS_GCSC), (float*)(ws + WS_GDEC)))
  PH(8, gla_u_phase((const bf16_t*)(ws + WS_K0), (const bf16_t*)(ws + WS_V0), (const h16_t*)p.out, (const h16_t*)(ws + WS_GCSC), (bf16_t*)(ws + WS_STATE), lds))
  PH(9, gla_scan_phase((bf16_t*)(ws + WS_STATE), (const float*)(ws + WS_GDEC), wr))
  PH(10, gla_o_phase((const bf16_t*)(ws + WS_Q0), (const bf16_t*)(ws + WS_K0), (const bf16_t*)(ws + WS_V0), (const h16_t*)p.out, (const h16_t*)(ws + WS_GCSC), (const bf16_t*)(ws + WS_STATE), p.in[16], (const float*)(ws + WS_SSQ), p.in[13], (bf16_t*)(ws + WS_Y0), lds, wr))
  PH(11, {
    pg8::Gemm g{(const bf16_t*)(ws + WS_Y0), (const bf16_t*)(ws + WS_W2T), ML, D, 2048}; pg8::StaticOrder S; S.init(ML, D, gridDim.x, (int)blockIdx.x);
    pg8::EpiResid E{p.in[0], X1, MOD, true};
    pg8::gemm_phase<pg8::EpiResid, pg8::StaticOrder, true, true>(lds, g, S, E);
    const float* ctx = p.in[2]; float* XC1 = (float*)(ws + WS_XC1); const float* gate = MOD + 2 * 3072 + 2048;
    small_gemm((const bf16_t*)(ws + WS_Y0) + (size_t)ML * 2048, 2048, (const bf16_t*)(ws + WS_W2T), 2048, 2048, MC, D,
               [=](int m, int n, float v) { XC1[(size_t)m * D + n] = ctx[(size_t)m * D + n] + gate[n] * v; }); })
  PH(12, prep_phase(X1, (const float*)(ws + WS_XC1), p.in[18], MOD + 3 * 3072, (bf16_t*)(ws + WS_H1)))
  PH(13, {
    pg8::Gemm g{(const bf16_t*)(ws + WS_H1), (const bf16_t*)(ws + WS_W3T), ML, O_IN, D}; pg8::StaticOrder S; S.init(ML, O_IN, gridDim.x, (int)blockIdx.x);
    pg8::EpiProj1 E{(bf16_t*)(ws + WS_K1), (bf16_t*)(ws + WS_V1), (bf16_t*)(ws + WS_Q1), (bf16_t*)(ws + WS_G1)};
    pg8::gemm_phase<pg8::EpiProj1, pg8::StaticOrder, true, true>(lds, g, S, E);
    bf16_t* K1 = (bf16_t*)(ws + WS_K1); bf16_t* V1 = (bf16_t*)(ws + WS_V1);
    small_gemm((const bf16_t*)(ws + WS_H1) + (size_t)ML * D, D, (const bf16_t*)(ws + WS_W3T), D, D, MC, 1024,
               [=](int m, int n, float v) { if (n < 512) K1[(size_t)(ML + m) * 512 + n] = f2bf(v); else V1[(size_t)(ML + m) * 512 + (n - 512)] = f2bf(v); }); })
  PH(14, qknorm_phase((bf16_t*)(ws + WS_Q1), (bf16_t*)(ws + WS_K1), p.in[22], p.in[23], (const float*)(ws + WS_ROPE), wr))
  PH(15, attn_phase((bf16_t*)(ws + WS_Q1), (const bf16_t*)(ws + WS_K1), (const bf16_t*)(ws + WS_V1), (const bf16_t*)(ws + WS_G1), p.in[24], p.in[22], p.in[23], lds, wr))
  PH(16, {
    pg8::Gemm g{(const bf16_t*)(ws + WS_Q1), (const bf16_t*)(ws + WS_W4T), ML, D, 2048}; pg8::StaticOrder S; S.init(ML, D, gridDim.x, (int)blockIdx.x);
    pg8::EpiResid E{X1, p.out, MOD + 3 * 3072, wr};
    pg8::gemm_phase<pg8::EpiResid, pg8::StaticOrder, true, true>(lds, g, S, E); })
#undef PH
#undef IN
#undef SEAM
}
extern "C" void kernel_launch(void* const* d_in, const int* in_sizes, int n_in, void* d_out, int out_size, void* d_ws, size_t ws_size, hipStream_t stream) {
  static int grid_blocks = 0;
  if (!grid_blocks) {
    int dev = 0, cus = 0, per_cu = 0;
    hipGetDevice(&dev);
    hipDeviceGetAttribute(&cus, hipDeviceAttributeMultiprocessorCount, dev);
    hipFuncSetAttribute((const void*)mega, hipFuncAttributeMaxDynamicSharedMemorySize, LDS_BYTES);
    hipOccupancyMaxActiveBlocksPerMultiprocessor(&per_cu, (const void*)mega, NWAVES * 64, LDS_BYTES);
    if (per_cu < 1) { fprintf(stderr, "kernel_launch: occupancy query says %d blocks per CU\n", per_cu); per_cu = 1; }
    if (per_cu > 1) per_cu = 1;
    grid_blocks = cus * per_cu;
  }
  hipMemsetAsync((char*)d_ws + WS_CTL, 0, 64 * 1024, stream);
  Params base{};
  for (int i = 0; i < 26; ++i) base.in[i] = (const float*)d_in[i];
  base.out = (float*)d_out; base.ws = (unsigned char*)d_ws;
  auto launch = [&](int lo, int hi) {
    Params p = base; p.ph_lo = lo; p.ph_hi = hi; p.rep = (int)PROBE_MASK; void* args[] = {&p};
    hipError_t e = hipLaunchCooperativeKernel((const void*)mega, dim3(grid_blocks), dim3(NWAVES * 64), args, LDS_BYTES, stream);
    if (e != hipSuccess) fprintf(stderr, "cooperative launch failed: %s (grid %d)\n", hipGetErrorString(e), grid_blocks);
  };
  launch(0, 17);
}
```

```cpp
#include <hip/hip_runtime.h>
#include <hip/hip_cooperative_groups.h>
#include <stdint.h>
#include <math.h>
#include <cstdio>
namespace cg = cooperative_groups;
#ifndef PROBE_MASK
#define PROBE_MASK 0u
#endif

typedef unsigned short bf16_t;
#define DEV __device__ __forceinline__

DEV float bf2f(bf16_t v) { return __uint_as_float(((unsigned)v) << 16); }
typedef float f32x2_t __attribute__((ext_vector_type(2))); typedef __bf16 bf16x2_t __attribute__((ext_vector_type(2)));
DEV unsigned pk2(float lo, float hi) { const f32x2_t v = {lo, hi}; const bf16x2_t b = __builtin_convertvector(v, bf16x2_t); return __builtin_bit_cast(unsigned, b); }
DEV bf16_t f2bf(float f) { return (bf16_t)(pk2(f, 0.f) & 0xffffu); }
DEV float fexp(float x) { return __builtin_amdgcn_exp2f(x * 1.4426950408889634f); }
DEV float siluf(float x) { return x / (1.f + fexp(-x)); }
DEV float silu_fast(float x) { return x * __builtin_amdgcn_rcpf(1.f + fexp(-x)); }
DEV float softplusf(float x) { return x > 20.f ? x : log1pf(fexp(x)); }
DEV float logsigmoidf(float x) { return fminf(x, 0.f) - log1pf(fexp(-fabsf(x))); }

constexpr int D = 1024, NB = 2, SEQ = 8192, CTXL = 256;
constexpr int ML = NB * SEQ;
constexpr int MC = NB * CTXL;
constexpr int MA = ML + MC;
constexpr int NCH = MA / 128;
constexpr int E_IN = 5696, O_IN = 5120, E_INP = 5888;
constexpr float EPS = 1e-6f;

constexpr size_t MiB = 1u << 20;
constexpr size_t WS_CTL = 0;
constexpr size_t WS_MOD = 1 * MiB;
constexpr size_t WS_ROPE = 1 * MiB + 128 * 1024;
constexpr size_t WS_SDEC = 1 * MiB + 256 * 1024;
constexpr size_t WS_GDEC = 1 * MiB + 384 * 1024;
constexpr size_t WS_W1T = 2 * MiB;
constexpr size_t WS_W2T = 14 * MiB;
constexpr size_t WS_W3T = 18 * MiB;
constexpr size_t WS_W4T = 28 * MiB;
constexpr size_t WS_Y0 = 32 * MiB;
constexpr size_t WS_Q0 = 98 * MiB;
constexpr size_t WS_K0 = WS_Q0 + 16 * MiB + 512 * 1024;
constexpr size_t WS_V0 = 131 * MiB;
constexpr size_t WS_DTLR = 164 * MiB;
constexpr size_t WS_XC1 = 168 * MiB + 512 * 1024;
constexpr size_t WS_XBC = 171 * MiB;
constexpr size_t WS_STATE = 171 * MiB;
constexpr size_t WS_TAIL = 237 * MiB;
constexpr size_t WS_H1 = 32 * MiB;
constexpr size_t WS_K1 = 65 * MiB;
constexpr size_t WS_V1 = 81 * MiB + 512 * 1024;
constexpr size_t WS_Q1 = 98 * MiB;
constexpr size_t WS_G1 = 171 * MiB;

DEV int row_vec(int row) { return row < ML ? (row / SEQ) : 2; }

namespace pg8 {
#define PG8_LAS __attribute__((address_space(3)))
typedef unsigned short bf16_t;
typedef short bf16x8 __attribute__((ext_vector_type(8)));
typedef float f32x4 __attribute__((ext_vector_type(4)));
typedef unsigned u32x4 __attribute__((ext_vector_type(4)));
constexpr int BM = 256, BK = 64, HALF = 128, HTB = HALF * BK * 2  , STAGE_BYTES = 8 * HTB, NXCD = 8, WGM = 8;

__host__ __device__ __forceinline__ int lds_byte(int r, int c) { const int st = (r >> 4) * 2 + (c >> 5), rr = r & 15, cc = c & 31, ob = rr * 64 + cc * 2; return st * 1024 + (ob ^ (((ob >> 9) & 1) << 5)); }
__host__ __device__ __forceinline__ void stage_rc(int b, int& R, int& C) { const int st = b / 1024, sb = b % 1024, swz = sb ^ (((sb >> 9) & 1) << 5); R = (st >> 1) * 16 + swz / 64; C = (st & 1) * 32 + (swz % 64) / 2; }
__host__ __device__ __forceinline__ int perm32(int rho) { const int n = rho >> 4, i = rho & 15; return 8 * (i >> 2) + 4 * n + (i & 3); }

struct Unit { int pm, pn; };
struct Gemm { const bf16_t* A; const bf16_t* Bt; int M, N, K; };

struct StaticOrder {
    int nM, nN, nwg, G, c;
    __host__ __device__ void init(int M, int N, int G_, int c_) { nM = M / BM; nN = N / BM; nwg = nM * nN; G = G_; c = c_; }
    __host__ __device__ bool next(int i, Unit& u) const {
        const long L = (long)i * G + c; if (L >= nwg) return false;
        int wgid = (int)L; { const int q = nwg / NXCD, r = nwg % NXCD, xcd = wgid % NXCD, off = wgid / NXCD; wgid = (xcd < r ? xcd * (q + 1) : r * (q + 1) + (xcd - r) * q) + off; }
        const int nig = WGM * nN, gid = wgid / nig, fm = gid * WGM, gsz = (nM - fm) < WGM ? (nM - fm) : WGM;
        u.pm = fm + ((wgid % nig) % gsz); u.pn = (wgid % nig) / gsz; return true;
    }
    __device__ __forceinline__ void a_ready(const Unit&) const {}
    __device__ __forceinline__ void done(const Unit&) const {}
};
__device__ __forceinline__ unsigned cvt_pk_bf16(float lo, float hi) { unsigned r; asm volatile("v_cvt_pk_bf16_f32 %0, %1, %2" : "=v"(r) : "v"(lo), "v"(hi)); return r; }
__device__ __forceinline__ float silu_e(float x) { return x * __builtin_amdgcn_rcpf(1.f + fexp(-x)); }

__device__ __forceinline__ void store_unit_bf16(const f32x4 (&acc)[2][2][4][2], bf16_t* base, int ld, int colt, bool act, const Unit& u, int wr, int wc, int fr, int fq) {
    const int row0 = u.pm * BM + wr * 64 + fr; const int col0 = colt + wc * 32 + 8 * fq;
#pragma unroll
    for (int ai = 0; ai < 2; ++ai)
#pragma unroll
        for (int m = 0; m < 4; ++m) { bf16_t* rowp = base + (size_t)(row0 + ai * HALF + m * 16) * ld + col0;
#pragma unroll
            for (int bj = 0; bj < 2; ++bj) { f32x4 v0 = acc[ai][bj][m][0], v1 = acc[ai][bj][m][1];
                if (act) { v0 = (f32x4){silu_e(v0[0]), silu_e(v0[1]), silu_e(v0[2]), silu_e(v0[3])}; v1 = (f32x4){silu_e(v1[0]), silu_e(v1[1]), silu_e(v1[2]), silu_e(v1[3])}; }
                u32x4 w; w.x = cvt_pk_bf16(v0[0], v0[1]); w.y = cvt_pk_bf16(v0[2], v0[3]); w.z = cvt_pk_bf16(v1[0], v1[1]); w.w = cvt_pk_bf16(v1[2], v1[3]);
                *(u32x4*)(rowp + bj * HALF) = w; } }
}
struct EpiProj0 {
    static constexpr bool PERM = true, AFTER_DRAIN = false;
    bf16_t *Y0, *XBC, *Q0, *K0, *V0; float* DTLR;
    __device__ __forceinline__ void operator()(const f32x4 (&acc)[2][2][4][2], const Unit& u, int wr, int wc, int fr, int fq) const {
        const int pn = u.pn;
        if (pn == 22) {
            if (wc < 2) { const int row0 = u.pm * BM + wr * 64 + fr;
#pragma unroll
                for (int ai = 0; ai < 2; ++ai)
#pragma unroll
                    for (int m = 0; m < 4; ++m) { float* rp = DTLR + (size_t)(row0 + ai * HALF + m * 16) * 64 + wc * 32 + 8 * fq; *(f32x4*)rp = acc[ai][0][m][0]; *(f32x4*)(rp + 4) = acc[ai][0][m][1]; } }
            return;
        }
        bf16_t* base; int ld, colt; bool act = false;
        if (pn < 8) { base = Y0; ld = 2048; colt = pn * 256; act = true; }
        else if (pn < 14) { base = XBC; ld = 1536; colt = (pn - 8) * 256; }
        else if (pn < 16) { base = Q0; ld = 512; colt = (pn - 14) * 256; }
        else if (pn < 18) { base = K0; ld = 512; colt = (pn - 16) * 256; }
        else { base = V0; ld = 1024; colt = (pn - 18) * 256; }
        store_unit_bf16(acc, base, ld, colt, act, u, wr, wc, fr, fq);
    }
};
struct EpiProj1 {
    static constexpr bool PERM = true, AFTER_DRAIN = false;
    bf16_t *K1, *V1, *Q1, *G1;
    __device__ __forceinline__ void operator()(const f32x4 (&acc)[2][2][4][2], const Unit& u, int wr, int wc, int fr, int fq) const {
        const int pn = u.pn; bf16_t* base; int ld, colt; bool act = false;
        if (pn < 2) { base = K1; ld = 512; colt = pn * 256; }
        else if (pn < 4) { base = V1; ld = 512; colt = (pn - 2) * 256; }
        else if (pn < 12) { base = Q1; ld = 2048; colt = (pn - 4) * 256; }
        else { base = G1; ld = 2048; colt = (pn - 12) * 256; act = true; }
        store_unit_bf16(acc, base, ld, colt, act, u, wr, wc, fr, fq);
    }
};
struct EpiResid {
    static constexpr bool PERM = false, AFTER_DRAIN = false;
    const float* res; float* out; const float* mod; bool do_store;
    __device__ __forceinline__ void operator()(const f32x4 (&acc)[2][2][4][2], const Unit& u, int wr, int wc, int fr, int fq) const {
        const int b = (u.pm * BM) / 8192; const float* gate = mod + b * 3072 + 2048;
        const int col0 = u.pn * BM + wc * 32 + 4 * fq;
        f32x4 gv[2][2];
#pragma unroll
        for (int bj = 0; bj < 2; ++bj)
#pragma unroll
            for (int n = 0; n < 2; ++n) gv[bj][n] = *(const f32x4*)(gate + col0 + bj * HALF + n * 16);
#pragma unroll
        for (int ai = 0; ai < 2; ++ai)
#pragma unroll
            for (int m = 0; m < 4; ++m) { const size_t off = (size_t)(u.pm * BM + ai * HALF + wr * 64 + m * 16 + fr) * 1024 + col0;
#pragma unroll
                for (int bj = 0; bj < 2; ++bj)
#pragma unroll
                    for (int n = 0; n < 2; ++n) { const f32x4 r = *(const f32x4*)(res + off + bj * HALF + n * 16); const f32x4 ov_ = r + gv[bj][n] * acc[ai][bj][m][n]; if (do_store) *(f32x4*)(out + off + bj * HALF + n * 16) = ov_; } }
    }
};
template <class Epi, class Sched, bool ALIGN_EPI = false, bool SP2 = false>
__device__ __forceinline__ void gemm_phase(PG8_LAS unsigned char* lds, const Gemm g, const Sched& S, const Epi& E) {
    const int tid = threadIdx.x, wid = __builtin_amdgcn_readfirstlane(tid >> 6), lane = tid & 63, wr = wid >> 2, wc = wid & 3, fr = lane & 15, fq = lane >> 4;
    const int K = g.K, nt = K / BK;
    unsigned voffA[2], voffB[2];
#pragma unroll
    for (int i = 0; i < 2; ++i) { int R, C; stage_rc(tid * 16 + i * 8192, R, C); const int Rb = Epi::PERM ? ((R & ~31) + perm32(R & 31)) : R;
        voffA[i] = (unsigned)(R * K + C) * 2u; voffB[i] = (unsigned)(Rb * K + C) * 2u; }
    const size_t kstep = (size_t)(BK * 2);
    const size_t hstep = (size_t)HALF * K * 2;
    const size_t tstep = 2 * hstep;
    const unsigned ldsw = (unsigned)wid * 1024u;
    const int aoff = lds_byte(wr * 64 + fr, fq * 8), boff = lds_byte(wc * 32 + fr, fq * 8);
#define PG8_SA(b, h) (((b) * 2 + (h)) * HTB)
#define PG8_SB(b, h) ((4 + (b) * 2 + (h)) * HTB)
#define PG8_STAGE(bufoff, gbase, voff) do { _Pragma("unroll") for (int _i = 0; _i < 2; ++_i) \
        __builtin_amdgcn_global_load_lds((const unsigned*)((const char*)(gbase) + (voff)[_i]), (PG8_LAS unsigned*)(lds + (bufoff) + ldsw + _i * 8192), 16, 0, 0); } while (0)
#define PG8_LDA(dst, b, h) do { _Pragma("unroll") for (int m = 0; m < 4; ++m) _Pragma("unroll") for (int k = 0; k < 2; ++k) dst[m][k] = *(const PG8_LAS bf16x8*)(lds + PG8_SA(b, h) + aoff + m * 2048 + k * 1024); } while (0)
#define PG8_LDB(dst, b, h) do { _Pragma("unroll") for (int n = 0; n < 2; ++n) _Pragma("unroll") for (int k = 0; k < 2; ++k) dst[n][k] = *(const PG8_LAS bf16x8*)(lds + PG8_SB(b, h) + boff + n * 2048 + k * 1024); } while (0)
#define PG8_MMA(ai, bj, At, Bt) do { __builtin_amdgcn_s_setprio(1); _Pragma("unroll") for (int m = 0; m < 4; ++m) _Pragma("unroll") for (int n = 0; n < 2; ++n) _Pragma("unroll") for (int k = 0; k < 2; ++k) \
        acc[ai][bj][m][n] = __builtin_amdgcn_mfma_f32_16x16x32_bf16(Bt[n][k], At[m][k], acc[ai][bj][m][n], 0, 0, 0); __builtin_amdgcn_s_setprio(0); } while (0)
#define PG8_WAIT_V(n) asm volatile("s_waitcnt vmcnt(" #n ")" ::: "memory")
#define PG8_WAIT_L(n) asm volatile("s_waitcnt lgkmcnt(" #n ")" ::: "memory")
#define PG8_BAR __builtin_amdgcn_s_barrier()
#define PG8_SCHED __builtin_amdgcn_sched_barrier(0)
    Unit cur, nxt; int ui = 0;
    if (!S.next(0, cur)) return;
    f32x4 acc[2][2][4][2];
#pragma unroll
    for (int a = 0; a < 2; ++a)
#pragma unroll
        for (int b = 0; b < 2; ++b)
#pragma unroll
            for (int m = 0; m < 4; ++m)
#pragma unroll
                for (int n = 0; n < 2; ++n) acc[a][b][m][n] = (f32x4){0.f, 0.f, 0.f, 0.f};
    bf16x8 At[4][2], B0[2][2], B1[2][2];
    const char* cA = (const char*)g.A + (size_t)cur.pm * tstep; const char* cB = (const char*)g.Bt + (size_t)cur.pn * tstep;
    S.a_ready(cur);
    if constexpr (SP2) {
        PG8_STAGE(PG8_SB(0, 0), cB, voffB); PG8_STAGE(PG8_SB(0, 1), cB + hstep, voffB); PG8_STAGE(PG8_SA(0, 0), cA, voffA); PG8_STAGE(PG8_SA(0, 1), cA + hstep, voffA);
        if (wr == 1) PG8_BAR;
        PG8_WAIT_V(2); PG8_BAR;
        PG8_STAGE(PG8_SB(1, 0), cB + kstep, voffB); PG8_STAGE(PG8_SA(1, 0), cA + kstep, voffA); PG8_STAGE(PG8_SB(1, 1), cB + hstep + kstep, voffB);
        PG8_WAIT_V(6); PG8_BAR;
    } else {
        PG8_STAGE(PG8_SB(0, 0), cB, voffB); PG8_STAGE(PG8_SA(0, 0), cA, voffA); PG8_STAGE(PG8_SB(0, 1), cB + hstep, voffB); PG8_STAGE(PG8_SA(0, 1), cA + hstep, voffA);
        if (wr == 1) PG8_BAR;
        PG8_WAIT_V(4); PG8_BAR;
        PG8_STAGE(PG8_SB(1, 0), cB + kstep, voffB); PG8_STAGE(PG8_SA(1, 0), cA + kstep, voffA); PG8_STAGE(PG8_SB(1, 1), cB + hstep + kstep, voffB);
        PG8_WAIT_V(6); PG8_BAR;
    }
    for (;;) {
        const bool has_next = S.next(ui + 1, nxt);
        const char* nA = has_next ? (const char*)g.A + (size_t)nxt.pm * tstep : cA; const char* nB = has_next ? (const char*)g.Bt + (size_t)nxt.pn * tstep : cB;
        for (int t = 0; t < nt; t += 2) {
            const bool last = (t == nt - 2);
            const char* a1 = cA + (size_t)(t + 1) * kstep;
            const char* a2 = last ? nA : cA + (size_t)(t + 2) * kstep; const char* b2 = last ? nB : cB + (size_t)(t + 2) * kstep;
            const char* a3 = a2 + kstep; const char* b3 = b2 + kstep;
            if (last && has_next) S.a_ready(nxt);
            if constexpr (SP2) {
            PG8_LDB(B0, 0, 0); PG8_LDB(B1, 0, 1); PG8_SCHED; PG8_LDA(At, 0, 0); PG8_STAGE(PG8_SA(1, 1), a1 + hstep, voffA);
            PG8_WAIT_V(8); PG8_WAIT_L(0); PG8_BAR; PG8_MMA(0, 0, At, B0); PG8_MMA(0, 1, At, B1); PG8_BAR; PG8_SCHED;
            PG8_LDA(At, 0, 1); PG8_STAGE(PG8_SB(0, 0), b2, voffB); PG8_STAGE(PG8_SB(0, 1), b2 + hstep, voffB); PG8_STAGE(PG8_SA(0, 0), a2, voffA);
            PG8_WAIT_V(8); PG8_WAIT_L(0); PG8_BAR; PG8_MMA(1, 0, At, B0); PG8_MMA(1, 1, At, B1); PG8_BAR; PG8_SCHED;
            PG8_LDB(B0, 1, 0); PG8_LDB(B1, 1, 1); PG8_SCHED; PG8_LDA(At, 1, 0); PG8_STAGE(PG8_SA(0, 1), a2 + hstep, voffA);
            PG8_WAIT_V(8); PG8_WAIT_L(0); PG8_BAR; PG8_MMA(0, 0, At, B0); PG8_MMA(0, 1, At, B1); PG8_BAR; PG8_SCHED;
            PG8_LDA(At, 1, 1); PG8_STAGE(PG8_SB(1, 0), b3, voffB); PG8_STAGE(PG8_SB(1, 1), b3 + hstep, voffB); PG8_STAGE(PG8_SA(1, 0), a3, voffA);
            PG8_WAIT_V(8); PG8_WAIT_L(0); PG8_BAR; PG8_MMA(1, 0, At, B0); PG8_MMA(1, 1, At, B1); PG8_BAR; PG8_SCHED;
            } else {
            PG8_LDB(B0, 0, 0); PG8_SCHED; PG8_LDA(At, 0, 0); PG8_STAGE(PG8_SA(1, 1), a1 + hstep, voffA);
            PG8_WAIT_L(8); PG8_BAR; PG8_WAIT_L(0); PG8_MMA(0, 0, At, B0); PG8_BAR; PG8_SCHED;
            PG8_LDB(B1, 0, 1); PG8_STAGE(PG8_SB(0, 0), b2, voffB);
            PG8_BAR; PG8_WAIT_L(0); PG8_MMA(0, 1, At, B1); PG8_BAR;
            PG8_LDA(At, 0, 1); PG8_STAGE(PG8_SA(0, 0), a2, voffA);
            PG8_BAR; PG8_WAIT_L(0); PG8_MMA(1, 0, At, B0); PG8_BAR; PG8_SCHED;
            PG8_STAGE(PG8_SB(0, 1), b2 + hstep, voffB);
            PG8_WAIT_V(6); PG8_BAR; PG8_MMA(1, 1, At, B1); PG8_BAR;
            PG8_LDB(B0, 1, 0); PG8_SCHED; PG8_LDA(At, 1, 0); PG8_STAGE(PG8_SA(0, 1), a2 + hstep, voffA);
            PG8_WAIT_L(8); PG8_BAR; PG8_WAIT_L(0); PG8_MMA(0, 0, At, B0); PG8_BAR; PG8_SCHED;
            PG8_LDB(B1, 1, 1); PG8_STAGE(PG8_SB(1, 0), b3, voffB);
            PG8_BAR; PG8_WAIT_L(0); PG8_MMA(0, 1, At, B1); PG8_BAR;
            PG8_LDA(At, 1, 1); PG8_STAGE(PG8_SA(1, 0), a3, voffA);
            PG8_BAR; PG8_WAIT_L(0); PG8_MMA(1, 0, At, B0); PG8_BAR; PG8_SCHED;
            PG8_STAGE(PG8_SB(1, 1), b3 + hstep, voffB);
            PG8_WAIT_V(6); PG8_BAR; PG8_MMA(1, 1, At, B1); PG8_BAR;
            }
        }
        if constexpr (ALIGN_EPI) { if (wr == 0) PG8_BAR; }
        if constexpr (!Epi::AFTER_DRAIN) { E(acc, cur, wr, wc, fr, fq); S.done(cur); }
        if (!has_next) break;
#pragma unroll
        for (int a = 0; a < 2; ++a)
#pragma unroll
            for (int b = 0; b < 2; ++b)
#pragma unroll
                for (int m = 0; m < 4; ++m)
#pragma unroll
                    for (int n = 0; n < 2; ++n) acc[a][b][m][n] = (f32x4){0.f, 0.f, 0.f, 0.f};
        cur = nxt; cA = nA; cB = nB; ++ui;
        if constexpr (ALIGN_EPI) { if (wr == 1) PG8_BAR; }
    }
    PG8_WAIT_V(0);
    if constexpr (!ALIGN_EPI) { if (wr == 0) PG8_BAR; }
    PG8_BAR;
    if constexpr (Epi::AFTER_DRAIN) { E.fused(acc, cur, wr, wc, fr, fq, lds, wid, lane); S.done(cur); }
#undef PG8_SA
#undef PG8_SB
#undef PG8_STAGE
#undef PG8_LDA
#undef PG8_LDB
#undef PG8_MMA
#undef PG8_WAIT_V
#undef PG8_WAIT_L
#undef PG8_BAR
#undef PG8_SCHED
}
}
#define LAS __attribute__((address_space(3)))
typedef unsigned v4u __attribute__((ext_vector_type(4)));
typedef float f32x4 __attribute__((ext_vector_type(4)));
typedef short bf16x8 __attribute__((ext_vector_type(8)));
#define LDS_WAIT() asm volatile("s_waitcnt lgkmcnt(0)" ::: "memory")
constexpr int NWAVES = 8;
constexpr int LDS_BYTES = 147456;
constexpr int MISC_OFF = 147456 - 128;

struct Params { const float* in[26]; float* out; unsigned char* ws; int ph_lo, ph_hi, rep, pad; };

DEV float wave_sum(float v) {
#pragma unroll
  for (int o = 1; o < 64; o <<= 1) v += __shfl_xor(v, o);
  return v;
}

DEV int w1_dest_row(int n) {
  if (n < 1024) return n;
  if (n < 2560) return 2048 + (n - 1024);
  if (n < 2592) return 5632 + (n - 2560);
  if (n < 3104) return 3584 + (n - 2592);
  if (n < 3616) return 4096 + (n - 3104);
  if (n < 4640) return 4608 + (n - 3616);
  if (n < 5664) return 1024 + (n - 4640);
  return n;
}
DEV void transpose_item(const float* W, int K, int N, int k0, int n0, bf16_t* WT, int drow0, LAS float* scr, int lane) {
#pragma unroll 8
  for (int i = 0; i < 32; ++i) { const int kk = 2 * i + (lane >> 5); scr[kk * 33 + (lane & 31)] = W[(size_t)(k0 + kk) * N + n0 + (lane & 31)]; }
  LDS_WAIT(); asm volatile("" ::: "memory");
  const int c = lane & 7;
#pragma unroll
  for (int j = 0; j < 4; ++j) { const int n = (lane >> 3) + 8 * j; const LAS float* s = scr + (8 * c) * 33 + n;
    v4u o; o.x = pk2(s[0 * 33], s[1 * 33]); o.y = pk2(s[2 * 33], s[3 * 33]); o.z = pk2(s[4 * 33], s[5 * 33]); o.w = pk2(s[6 * 33], s[7 * 33]);
    *(v4u*)(WT + (size_t)(drow0 + n) * K + k0 + 8 * c) = o; }
  LDS_WAIT(); asm volatile("" ::: "memory");
}
DEV void prologue_phase(const Params& p, LAS unsigned char* lds) {
  const int tid = threadIdx.x, lane = tid & 63, wave = tid >> 6;
  unsigned char* ws = p.ws;
  float* MOD = (float*)(ws + WS_MOD);
  {
    LAS float* sc = (LAS float*)lds;
    LAS float* part = (LAS float*)(lds + 12288);
    for (int i = tid; i < 3072; i += 512) { const int v = i >> 10, k = i & 1023; const float cv = v < 2 ? p.in[1][v * 1024 + k] : p.in[3][k]; sc[i] = siluf(cv); }
    __syncthreads();
    for (int task = blockIdx.x; task < 96; task += gridDim.x) {
      const int l = task / 48, n0 = (task % 48) * 64; const float* w = l ? p.in[19] : p.in[5]; const float* bb = l ? p.in[20] : p.in[6];
      const int col = tid & 63, ks = tid >> 6;
      float a0 = 0.f, a1 = 0.f, a2 = 0.f;
#pragma unroll 8
      for (int k = ks * 128; k < ks * 128 + 128; ++k) { const float wv = w[(size_t)k * 3072 + n0 + col]; a0 += sc[k] * wv; a1 += sc[1024 + k] * wv; a2 += sc[2048 + k] * wv; }
      part[(ks * 3 + 0) * 64 + col] = a0; part[(ks * 3 + 1) * 64 + col] = a1; part[(ks * 3 + 2) * 64 + col] = a2;
      __syncthreads();
      if (tid < 192) { const int v = tid >> 6; float s = bb[n0 + col];
#pragma unroll
        for (int q = 0; q < 8; ++q) s += part[(q * 3 + v) * 64 + col];
        MOD[(l * 3 + v) * 3072 + n0 + col] = s; }
      __syncthreads();
    }
  }
  if (blockIdx.x == gridDim.x - 1) { float* rope = (float*)(ws + WS_ROPE);
    for (int idx = tid; idx < 4096; idx += 512) { const int pos = idx >> 5, f = idx & 31; const float inv = 1.0f / powf(10000.f, (float)f / 32.f); const float ang = (float)pos * inv; rope[idx] = cosf(ang); rope[4096 + idx] = sinf(ang); } }
  { v4u* z = (v4u*)(ws + WS_W1T + (size_t)E_IN * 1024 * 2); const v4u zero = {0u, 0u, 0u, 0u};
    for (int i = blockIdx.x * 512 + tid; i < (E_INP - E_IN) * 1024 * 2 / 16; i += gridDim.x * 512) z[i] = zero; }
  __syncthreads();
  {
    LAS float* scr = (LAS float*)(lds + wave * 16384);
    const int gw = blockIdx.x * NWAVES + wave, NGW = gridDim.x * NWAVES;
    constexpr int I1 = 16 * 178;
    for (int it = gw; it < I1; it += NGW) { const int kb = it / 178, nb = it % 178; transpose_item(p.in[7], 1024, E_IN, 64 * kb, 32 * nb, (bf16_t*)(ws + WS_W1T), w1_dest_row(32 * nb), scr, lane); }
  }
}
DEV void late_weights(const Params& p, LAS unsigned char* lds, int vblock, int nvblocks) {
  const int lane = threadIdx.x & 63, wave = threadIdx.x >> 6; unsigned char* ws = p.ws;
  LAS float* scr = (LAS float*)(lds + wave * 16384);
  constexpr int I2 = 32 * 32, I3 = 16 * 160, I4 = 32 * 32;
  for (int it = vblock * NWAVES + wave; it < I2 + I3 + I4; it += nvblocks * NWAVES) {
    int r = it;
    if (r < I2) { const int kb = r / 32, nb = r % 32; transpose_item(p.in[17], 2048, 1024, 64 * kb, 32 * nb, (bf16_t*)(ws + WS_W2T), 32 * nb, scr, lane); continue; } r -= I2;
    if (r < I3) { const int kb = r / 160, nb = r % 160; transpose_item(p.in[21], 1024, O_IN, 64 * kb, 32 * nb, (bf16_t*)(ws + WS_W3T), 32 * nb, scr, lane); continue; } r -= I3;
    { const int kb = r / 32, nb = r % 32; transpose_item(p.in[25], 2048, 1024, 64 * kb, 32 * nb, (bf16_t*)(ws + WS_W4T), 32 * nb, scr, lane); }
  }
}
DEV void prep_phase(const float* xlat, const float* xctx, const float* g, const float* mod, bf16_t* H) {
  const int lane = threadIdx.x & 63, wave = threadIdx.x >> 6;
  for (int row = blockIdx.x * NWAVES + wave; row < MA; row += gridDim.x * NWAVES) {
    const float* src = row < ML ? xlat + (size_t)row * D : xctx + (size_t)(row - ML) * D;
    const float* m = mod + row_vec(row) * 3072;
    f32x4 v[4]; float ss = 0.f;
#pragma unroll
    for (int j = 0; j < 4; ++j) { v[j] = *(const f32x4*)(src + 4 * lane + 256 * j); ss += (v[j].x * v[j].x + v[j].y * v[j].y) + (v[j].z * v[j].z + v[j].w * v[j].w); }
    const float rstd = rsqrtf(wave_sum(ss) * (1.f / D) + EPS);
#pragma unroll
    for (int j = 0; j < 4; ++j) { const int k = 4 * lane + 256 * j;
      const f32x4 gg = *(const f32x4*)(g + k), sc = *(const f32x4*)(m + 1024 + k), sh = *(const f32x4*)(m + k);
      const f32x4 o = v[j] * rstd * gg * (sc + 1.f) + sh;
      *(unsigned long long*)(H + (size_t)row * D + k) = (unsigned long long)pk2(o.x, o.y) | ((unsigned long long)pk2(o.z, o.w) << 32); }
  }
}
template <class F> DEV void small_gemm(const bf16_t* A, int lda, const bf16_t* Bt, int ldb, int K, int Mrows, int Ncols, F f) {
  const int lane = threadIdx.x & 63, wid = threadIdx.x >> 6, mt = wid >> 2, nt = wid & 3, r = lane & 15, q = lane >> 4;
  const int ntn = Ncols / 64, ntasks = (Mrows / 32) * ntn;
  for (int task = blockIdx.x; task < ntasks; task += gridDim.x) {
    const int row0 = (task / ntn) * 32 + mt * 16, col0 = (task % ntn) * 64 + nt * 16;
    const bf16_t* ap = A + (size_t)(row0 + r) * lda + 8 * q; const bf16_t* bp = Bt + (size_t)(col0 + r) * ldb + 8 * q;
    f32x4 acc = {0.f, 0.f, 0.f, 0.f};
#pragma unroll 8
    for (int k = 0; k < K; k += 32) { const bf16x8 a = *(const bf16x8*)(ap + k), b = *(const bf16x8*)(bp + k); acc = __builtin_amdgcn_mfma_f32_16x16x32_bf16(a, b, acc, 0, 0, 0); }
#pragma unroll
    for (int j = 0; j < 4; ++j) f(row0 + q * 4 + j, col0 + r, acc[j]);
  }
}

DEV void qknorm_phase(bf16_t* Q1, bf16_t* K1, const float* qn, const float* kn, const float* rope, bool wr) {
  const int lane = threadIdx.x & 63, wave = threadIdx.x >> 6, hl = lane >> 4, d0 = (lane & 15) * 8;
  const float scale = 0.08838834764831845f * 1.4426950408889634f;
  float gq[8], gk[8];
#pragma unroll
  for (int e = 0; e < 8; ++e) { gq[e] = qn[d0 + e] * scale; gk[e] = kn[d0 + e]; }
  const int ax = d0 >> 6, sgn = (d0 >> 5) & 1, f0 = d0 & 31;
  for (int row = blockIdx.x * NWAVES + wave; row < MA; row += gridDim.x * NWAVES) {
    const bool lat = row < ML;
    v4u raw[5];
    raw[0] = *(const v4u*)(K1 + (size_t)row * 512 + hl * 128 + d0);
    if (lat) {
#pragma unroll
      for (int g = 0; g < 4; ++g) raw[1 + g] = *(const v4u*)(Q1 + (size_t)row * 2048 + (g * 4 + hl) * 128 + d0);
    }
    float cs[8], sn[8];
    if (lat) { const int t = row % SEQ, pos = ax ? (t & 63) : (t >> 6);
      const f32x4 c0 = *(const f32x4*)(rope + pos * 32 + f0), c1 = *(const f32x4*)(rope + pos * 32 + f0 + 4), s0 = *(const f32x4*)(rope + 4096 + pos * 32 + f0), s1 = *(const f32x4*)(rope + 4096 + pos * 32 + f0 + 4);
      cs[0] = c0.x; cs[1] = c0.y; cs[2] = c0.z; cs[3] = c0.w; cs[4] = c1.x; cs[5] = c1.y; cs[6] = c1.z; cs[7] = c1.w;
      sn[0] = s0.x; sn[1] = s0.y; sn[2] = s0.z; sn[3] = s0.w; sn[4] = s1.x; sn[5] = s1.y; sn[6] = s1.z; sn[7] = s1.w; }
    const int ng = lat ? 5 : 1;
#pragma unroll
    for (int g = 0; g < 5; ++g) {
      if (g < ng) {
        const v4u rv = raw[g];
        float v[8] = {__uint_as_float(rv.x << 16), __uint_as_float(rv.x & 0xffff0000u), __uint_as_float(rv.y << 16), __uint_as_float(rv.y & 0xffff0000u), __uint_as_float(rv.z << 16), __uint_as_float(rv.z & 0xffff0000u), __uint_as_float(rv.w << 16), __uint_as_float(rv.w & 0xffff0000u)};
        float ss = 0.f;
#pragma unroll
        for (int e = 0; e < 8; ++e) ss += v[e] * v[e];
        ss += __shfl_xor(ss, 1); ss += __shfl_xor(ss, 2); ss += __shfl_xor(ss, 4); ss += __shfl_xor(ss, 8);
        const float rstd = rsqrtf(ss * (1.f / 128.f) + EPS);
#pragma unroll
        for (int e = 0; e < 8; ++e) v[e] *= rstd * (g == 0 ? gk[e] : gq[e]);
        if (lat) {
#pragma unroll
          for (int e = 0; e < 8; ++e) { const float o = __shfl_xor(v[e], 4); v[e] = sgn ? (v[e] * cs[e] + o * sn[e]) : (v[e] * cs[e] - o * sn[e]); }
        }
        v4u ov; ov.x = pk2(v[0], v[1]); ov.y = pk2(v[2], v[3]); ov.z = pk2(v[4], v[5]); ov.w = pk2(v[6], v[7]);
        if (wr) { if (g == 0) *(v4u*)(K1 + (size_t)row * 512 + hl * 128 + d0) = ov; else *(v4u*)(Q1 + (size_t)row * 2048 + ((g - 1) * 4 + hl) * 128 + d0) = ov; }
      }
    }
  }
}
typedef short s16x4 __attribute__((ext_vector_type(4)));
DEV s16x4 tr_read(const LAS bf16_t* p) { return __builtin_bit_cast(s16x4, __builtin_amdgcn_ds_read_tr16_b64_v4i16((LAS s16x4*)p)); }
DEV void attn_phase(bf16_t* Q1, const bf16_t* K1, const bf16_t* V1, const bf16_t* G1, const float* sink, const float* qn, const float* kn, LAS unsigned char* lds, bool wr) {
  constexpr int KP = 136, VP = 144;
  LAS bf16_t* Ks = (LAS bf16_t*)lds;
  LAS bf16_t* Vs = (LAS bf16_t*)(lds + 2 * 64 * KP * 2);
  LAS float* dsc = (LAS float*)(lds + 2 * 64 * KP * 2 + 2 * 64 * VP * 2);
  const int tid = threadIdx.x, lane = tid & 63, wid = tid >> 6, r = lane & 15, Qd = lane >> 4;
  float mb;
  { float a = fmaxf(fabsf(qn[lane]), fabsf(qn[64 + lane])), b = fmaxf(fabsf(kn[lane]), fabsf(kn[64 + lane]));
#pragma unroll
    for (int o = 1; o < 64; o <<= 1) { a = fmaxf(a, __shfl_xor(a, o)); b = fmaxf(b, __shfl_xor(b, o)); }
    mb = a * b * 11.313708498984761f * 1.4426950408889634f; }
  for (int task = blockIdx.x; task < 1024; task += gridDim.x) {
    const int b = task >> 9, kvh = (task >> 7) & 3, qt = task & 127;
    const int hq = kvh * 4 + (wid >> 1), qoff = (wid & 1) * 32;
    const size_t qrow0 = (size_t)b * SEQ + qt * 64 + qoff;
    bf16x8 qf[2][4];
#pragma unroll
    for (int m = 0; m < 2; ++m)
#pragma unroll
      for (int ks = 0; ks < 4; ++ks) qf[m][ks] = *(const bf16x8*)(Q1 + (qrow0 + 16 * m + r) * 2048 + hq * 128 + ks * 32 + 8 * Qd);
    const int tlo = (2 - qt) > 0 ? (2 - qt) : 0, thi = (129 - qt) < 4 ? (129 - qt) : 4, nband = thi - tlo + 1, ntile = nband + 4;
    const int skey = tid >> 4, sch = tid & 15;
    v4u kreg[2], vreg[2];
#define TILE_ROW0(i) ((i) < nband ? (size_t)b * SEQ + (size_t)(qt - 2 + tlo + (i)) * 64 : (size_t)ML + b * CTXL + ((i) - nband) * 64)
#define LOAD_TILE(i) do { const size_t r0_ = TILE_ROW0(i); _Pragma("unroll") for (int h_ = 0; h_ < 2; ++h_) { const size_t go_ = (r0_ + skey + 32 * h_) * 512 + kvh * 128 + sch * 8; kreg[h_] = *(const v4u*)(K1 + go_); vreg[h_] = *(const v4u*)(V1 + go_); } } while (0)
#define STORE_TILE(buf) do { _Pragma("unroll") for (int h_ = 0; h_ < 2; ++h_) { *(LAS v4u*)(Ks + (buf) * 64 * KP + (skey + 32 * h_) * KP + sch * 8) = kreg[h_]; *(LAS v4u*)(Vs + (buf) * 64 * VP + (skey + 32 * h_) * VP + sch * 8) = vreg[h_]; } } while (0)
    LOAD_TILE(0);
    __syncthreads();
    STORE_TILE(0);
    __syncthreads();
    f32x4 o[2][8];
#pragma unroll
    for (int m = 0; m < 2; ++m)
#pragma unroll
      for (int n = 0; n < 8; ++n) o[m][n] = (f32x4){0.f, 0.f, 0.f, 0.f};
    float lsum[2] = {0.f, 0.f};
    for (int i = 0; i < ntile; ++i) {
      const int buf = i & 1;
      if (i + 1 < ntile) LOAD_TILE(i + 1);
      const int mtype = (i < nband) ? ((tlo + i) == 0 ? 1 : ((tlo + i) == 4 ? 2 : 0)) : 0;
      const LAS bf16_t* Kb = Ks + buf * 64 * KP; const LAS bf16_t* Vb = Vs + buf * 64 * VP;
      f32x4 s[4][2];
#pragma unroll
      for (int t = 0; t < 4; ++t) { s[t][0] = (f32x4){-mb, -mb, -mb, -mb}; s[t][1] = (f32x4){-mb, -mb, -mb, -mb}; }
#pragma unroll
      for (int ks = 0; ks < 4; ++ks)
#pragma unroll
        for (int t = 0; t < 4; ++t) { const bf16x8 kf = *(const LAS bf16x8*)(Kb + (16 * t + r) * KP + ks * 32 + 8 * Qd);
          s[t][0] = __builtin_amdgcn_mfma_f32_16x16x32_bf16(kf, qf[0][ks], s[t][0], 0, 0, 0);
          s[t][1] = __builtin_amdgcn_mfma_f32_16x16x32_bf16(kf, qf[1][ks], s[t][1], 0, 0, 0); }
      bf16x8 pa[2][2];
#pragma unroll
      for (int m = 0; m < 2; ++m) { const int qi = qoff + 16 * m + r;
#pragma unroll
        for (int t = 0; t < 4; ++t) {
          float pv[4];
#pragma unroll
          for (int j = 0; j < 4; ++j) { const int kj = 16 * t + 4 * Qd + j; float pj = __builtin_amdgcn_exp2f(s[t][m][j]);
            if (mtype != 0) { if (mtype == 1) pj = (kj >= qi) ? pj : 0.f; else pj = (kj <= qi) ? pj : 0.f; }
            pv[j] = pj; lsum[m] += pj; }
          const unsigned w0 = pk2(pv[0], pv[1]), w1 = pk2(pv[2], pv[3]);
          pa[m][t >> 1][(t & 1) * 4 + 0] = (short)(w0 & 0xffff); pa[m][t >> 1][(t & 1) * 4 + 1] = (short)(w0 >> 16);
          pa[m][t >> 1][(t & 1) * 4 + 2] = (short)(w1 & 0xffff); pa[m][t >> 1][(t & 1) * 4 + 3] = (short)(w1 >> 16); } }
#pragma unroll
      for (int k2 = 0; k2 < 2; ++k2)
#pragma unroll
        for (int n = 0; n < 8; ++n) {
          const s16x4 lo = tr_read(Vb + (32 * k2 + 4 * Qd + (r >> 2)) * VP + 16 * n + 4 * (r & 3));
          const s16x4 hi = tr_read(Vb + (32 * k2 + 16 + 4 * Qd + (r >> 2)) * VP + 16 * n + 4 * (r & 3));
          const bf16x8 vf = (bf16x8){lo[0], lo[1], lo[2], lo[3], hi[0], hi[1], hi[2], hi[3]};
          o[0][n] = __builtin_amdgcn_mfma_f32_16x16x32_bf16(pa[0][k2], vf, o[0][n], 0, 0, 0);
          o[1][n] = __builtin_amdgcn_mfma_f32_16x16x32_bf16(pa[1][k2], vf, o[1][n], 0, 0, 0); }
      if (i + 1 < ntile) STORE_TILE(buf ^ 1);
      __syncthreads();
    }
#undef TILE_ROW0
#undef LOAD_TILE
#undef STORE_TILE
    const float sk = __builtin_amdgcn_exp2f(sink[hq] * 1.4426950408889634f - mb);
#pragma unroll
    for (int m = 0; m < 2; ++m) { float l = lsum[m]; l += __shfl_xor(l, 16); l += __shfl_xor(l, 32); if (Qd == 0) dsc[wid * 32 + 16 * m + r] = 1.f / (l + sk); }
    LDS_WAIT(); asm volatile("" ::: "memory");
    { LAS bf16_t* stg = (LAS bf16_t*)lds + wid * 32 * 136;
#pragma unroll
      for (int m = 0; m < 2; ++m)
#pragma unroll
        for (int j = 0; j < 4; ++j) { const float inv = dsc[wid * 32 + 16 * m + 4 * Qd + j];
#pragma unroll
          for (int n = 0; n < 8; ++n) stg[(16 * m + 4 * Qd + j) * 136 + 16 * n + r] = f2bf(o[m][n][j] * inv); }
      LDS_WAIT(); asm volatile("" ::: "memory");
#pragma unroll
      for (int q = 0; q < 8; ++q) { const int c = lane + 64 * q, rowl = c >> 4, ch = c & 15; const size_t go = (qrow0 + rowl) * 2048 + hq * 128 + ch * 8;
        const v4u ov = *(const LAS v4u*)(stg + rowl * 136 + ch * 8), gv = *(const v4u*)(G1 + go);
        v4u w; w.x = pk2(__uint_as_float(ov.x << 16) * __uint_as_float(gv.x << 16), __uint_as_float(ov.x & 0xffff0000u) * __uint_as_float(gv.x & 0xffff0000u));
        w.y = pk2(__uint_as_float(ov.y << 16) * __uint_as_float(gv.y << 16), __uint_as_float(ov.y & 0xffff0000u) * __uint_as_float(gv.y & 0xffff0000u));
        w.z = pk2(__uint_as_float(ov.z << 16) * __uint_as_float(gv.z << 16), __uint_as_float(ov.z & 0xffff0000u) * __uint_as_float(gv.z & 0xffff0000u));
        w.w = pk2(__uint_as_float(ov.w << 16) * __uint_as_float(gv.w << 16), __uint_as_float(ov.w & 0xffff0000u) * __uint_as_float(gv.w & 0xffff0000u));
        if (wr) *(v4u*)(Q1 + go) = w; }
      LDS_WAIT(); asm volatile("" ::: "memory"); }
  }
}

constexpr size_t DO_SDT = 50 * MiB, DO_SCS = 53 * MiB;
constexpr size_t WS_SSQ = 237 * MiB;
DEV unsigned short bfbits(float f) { return f2bf(f); }
DEV void ssd_prep_phase(const bf16_t* XBC, const float* cw, const float* cb, bf16_t* XC, const float* DTLR, const float* dt_bias, const float* a_log, float* SDT, float* SCS, float* SDEC) {
  const int gtid = blockIdx.x * 512 + threadIdx.x, gth = gridDim.x * 512;
  for (int it = gtid; it < (MA / 32) * 192; it += gth) {
    const int rg = it / 192, c8 = (it % 192) * 8, row0 = rg * 32;
    int t0, len;
    if (row0 < ML) { t0 = row0 % SEQ; len = SEQ; } else { t0 = (row0 - ML) % CTXL; len = CTXL; }
    float w[5][8], bias[8];
#pragma unroll
    for (int k = 0; k < 5; ++k) { const f32x4 w0 = *(const f32x4*)(cw + k * 1536 + c8), w1 = *(const f32x4*)(cw + k * 1536 + c8 + 4);
      w[k][0] = w0.x; w[k][1] = w0.y; w[k][2] = w0.z; w[k][3] = w0.w; w[k][4] = w1.x; w[k][5] = w1.y; w[k][6] = w1.z; w[k][7] = w1.w; }
    { const f32x4 b0 = *(const f32x4*)(cb + c8), b1 = *(const f32x4*)(cb + c8 + 4); bias[0] = b0.x; bias[1] = b0.y; bias[2] = b0.z; bias[3] = b0.w; bias[4] = b1.x; bias[5] = b1.y; bias[6] = b1.z; bias[7] = b1.w; }
    const v4u zero4 = {0u, 0u, 0u, 0u};
    v4u win[4];
#pragma unroll
    for (int q = 0; q < 4; ++q) { const int tt = t0 - 2 + q; win[q] = (tt >= 0 && tt < len) ? *(const v4u*)(XBC + (size_t)(row0 - 2 + q) * 1536 + c8) : zero4; }
#pragma unroll 4
    for (int i = 0; i < 32; ++i) {
      const int tt = t0 + i + 2; const v4u nx = (tt < len) ? *(const v4u*)(XBC + (size_t)(row0 + i + 2) * 1536 + c8) : zero4;
      float acc[8];
#pragma unroll
      for (int e = 0; e < 8; ++e) acc[e] = bias[e];
#define CONV_TAP(k, xv) do { acc[0] += w[k][0] * __uint_as_float((xv).x << 16); acc[1] += w[k][1] * __uint_as_float((xv).x & 0xffff0000u); acc[2] += w[k][2] * __uint_as_float((xv).y << 16); acc[3] += w[k][3] * __uint_as_float((xv).y & 0xffff0000u); \
        acc[4] += w[k][4] * __uint_as_float((xv).z << 16); acc[5] += w[k][5] * __uint_as_float((xv).z & 0xffff0000u); acc[6] += w[k][6] * __uint_as_float((xv).w << 16); acc[7] += w[k][7] * __uint_as_float((xv).w & 0xffff0000u); } while (0)
      CONV_TAP(0, win[0]); CONV_TAP(1, win[1]); CONV_TAP(2, win[2]); CONV_TAP(3, win[3]); CONV_TAP(4, nx);
#undef CONV_TAP
      v4u o; o.x = pk2(silu_fast(acc[0]), silu_fast(acc[1])); o.y = pk2(silu_fast(acc[2]), silu_fast(acc[3])); o.z = pk2(silu_fast(acc[4]), silu_fast(acc[5])); o.w = pk2(silu_fast(acc[6]), silu_fast(acc[7]));
      *(v4u*)(XC + (size_t)(row0 + i) * 1536 + c8) = o;
      win[0] = win[1]; win[1] = win[2]; win[2] = win[3]; win[3] = nx;
    }
  }
  {
    const int lane = threadIdx.x & 63, wave = threadIdx.x >> 6, cl = lane & 7, seg = lane >> 3;
    for (int wt = blockIdx.x * NWAVES + wave; wt < NCH * 4; wt += gridDim.x * NWAVES) {
      const int gc = wt >> 2, col = (wt & 3) * 8 + cl, dir = col >> 4, h = col & 15;
      const float a = -fexp(a_log[col]), bias = dt_bias[col];
      float dtv[16], v[16]; float run = 0.f;
#pragma unroll
      for (int u = 0; u < 16; ++u) { const int s = seg * 16 + u, t = dir ? 127 - s : s; dtv[u] = softplusf(DTLR[((size_t)gc * 128 + t) * 64 + col] + bias); }
#pragma unroll
      for (int u = 0; u < 16; ++u) { run += dtv[u] * a; v[u] = run; }
      float off = 0.f;
#pragma unroll
      for (int sgi = 0; sgi < 7; ++sgi) { const float tot = __shfl(run, cl + 8 * sgi); off += (sgi < seg) ? tot : 0.f; }
#pragma unroll
      for (int u = 0; u < 16; ++u) { const int s = seg * 16 + u, t = dir ? 127 - s : s; const size_t row = (size_t)gc * 128 + t; SDT[row * 32 + col] = dtv[u]; SCS[row * 32 + col] = v[u] + off; }
      if (seg == 7) SDEC[(gc * 16 + h) * 2 + dir] = fexp(run + off);
    }
  }
}
DEV void ssd_u_phase(const bf16_t* XC, const float* SDT, const float* SCS, bf16_t* ST, LAS unsigned char* lds) {
  constexpr int XP = 272, BP = 144;
  LAS bf16_t* Xs = (LAS bf16_t*)lds; LAS bf16_t* Bs = (LAS bf16_t*)(lds + 128 * XP * 2); LAS float* wtab = (LAS float*)(lds + 128 * XP * 2 + 128 * BP * 2);
  const int tid = threadIdx.x, lane = tid & 63, wid = tid >> 6, r = lane & 15, Qd = lane >> 4, hl = wid >> 1, dir = wid & 1;
  for (int task = blockIdx.x; task < NCH * 4; task += gridDim.x) {
    const int gc = task >> 2, g = (task >> 1) & 1, hh = task & 1; const size_t r0 = (size_t)gc * 128; const int h0 = g * 8 + hh * 4;
    __syncthreads();
#pragma unroll
    for (int i = 0; i < 8; ++i) { const int cid = tid + 512 * i, row = cid >> 5, ch = cid & 31; *(LAS v4u*)(Xs + row * XP + ch * 8) = *(const v4u*)(XC + (r0 + row) * 1536 + h0 * 64 + ch * 8); }
#pragma unroll
    for (int i = 0; i < 4; ++i) { const int cid = tid + 512 * i, row = cid >> 4, ch = cid & 15; *(LAS v4u*)(Bs + row * BP + ch * 8) = *(const v4u*)(XC + (r0 + row) * 1536 + 1024 + g * 128 + ch * 8); }
#pragma unroll
    for (int i = 0; i < 2; ++i) { const int e = tid + 512 * i, combo = e >> 7, t = e & 127, col = (combo & 1) * 16 + h0 + (combo >> 1);
      const float cs_end = SCS[(r0 + ((combo & 1) ? 0 : 127)) * 32 + col]; wtab[e] = fexp(cs_end - SCS[(r0 + t) * 32 + col]) * SDT[(r0 + t) * 32 + col]; }
    __syncthreads();
    const LAS float* wt = wtab + wid * 128;
    bf16_t* Sp = ST + ((((size_t)gc * 16 + h0 + hl) * 2 + dir) * 64) * 128;
#pragma unroll 1
    for (int pp = 0; pp < 2; ++pp) {
      f32x4 acc[8][2];
#pragma unroll
      for (int nt = 0; nt < 8; ++nt) { acc[nt][0] = (f32x4){0.f, 0.f, 0.f, 0.f}; acc[nt][1] = (f32x4){0.f, 0.f, 0.f, 0.f}; }
#pragma unroll 1
      for (int k = 0; k < 4; ++k) {
        const f32x4 wlo = *(const LAS f32x4*)(wt + 32 * k + 4 * Qd), whi = *(const LAS f32x4*)(wt + 32 * k + 16 + 4 * Qd);
        bf16x8 xf[2];
#pragma unroll
        for (int pt = 0; pt < 2; ++pt) {
          const s16x4 lo = tr_read(Xs + (32 * k + 4 * Qd + (r >> 2)) * XP + hl * 64 + 32 * pp + 16 * pt + 4 * (r & 3));
          const s16x4 hi = tr_read(Xs + (32 * k + 16 + 4 * Qd + (r >> 2)) * XP + hl * 64 + 32 * pp + 16 * pt + 4 * (r & 3));
          const unsigned w0 = pk2(bf2f((bf16_t)lo[0]) * wlo[0], bf2f((bf16_t)lo[1]) * wlo[1]), w1 = pk2(bf2f((bf16_t)lo[2]) * wlo[2], bf2f((bf16_t)lo[3]) * wlo[3]);
          const unsigned w2 = pk2(bf2f((bf16_t)hi[0]) * whi[0], bf2f((bf16_t)hi[1]) * whi[1]), w3 = pk2(bf2f((bf16_t)hi[2]) * whi[2], bf2f((bf16_t)hi[3]) * whi[3]);
          xf[pt] = (bf16x8){(short)(w0 & 0xffff), (short)(w0 >> 16), (short)(w1 & 0xffff), (short)(w1 >> 16), (short)(w2 & 0xffff), (short)(w2 >> 16), (short)(w3 & 0xffff), (short)(w3 >> 16)};
        }
#pragma unroll
        for (int nt = 0; nt < 8; ++nt) {
          const s16x4 lo = tr_read(Bs + (32 * k + 4 * Qd + (r >> 2)) * BP + 16 * nt + 4 * (r & 3));
          const s16x4 hi = tr_read(Bs + (32 * k + 16 + 4 * Qd + (r >> 2)) * BP + 16 * nt + 4 * (r & 3));
          const bf16x8 bfr = (bf16x8){lo[0], lo[1], lo[2], lo[3], hi[0], hi[1], hi[2], hi[3]};
          acc[nt][0] = __builtin_amdgcn_mfma_f32_16x16x32_bf16(bfr, xf[0], acc[nt][0], 0, 0, 0);
          acc[nt][1] = __builtin_amdgcn_mfma_f32_16x16x32_bf16(bfr, xf[1], acc[nt][1], 0, 0, 0);
        }
      }
#pragma unroll
      for (int nt = 0; nt < 8; ++nt)
#pragma unroll
        for (int pt = 0; pt < 2; ++pt) { const f32x4 v = acc[nt][pt];
          *(unsigned long long*)(Sp + ((((2 * pp + pt) * 4 + (nt >> 1)) * 64 + ((nt & 1) * 2 + (Qd >> 1)) * 16 + r) * 8 + 4 * (Qd & 1))) = (unsigned long long)pk2(v[0], v[1]) | ((unsigned long long)pk2(v[2], v[3]) << 32); }
    }
  }
}
DEV void ssd_scan_phase(bf16_t* ST, const float* SDEC, bool wr) {
  for (int item = blockIdx.x * 512 + threadIdx.x; item < 2 * 16 * 2 * 2048; item += gridDim.x * 512) {
    const int e4 = item & 2047, dir = (item >> 11) & 1, h = (item >> 12) & 15, b = item >> 16;
    float S0 = 0.f, S1 = 0.f, S2 = 0.f, S3 = 0.f;
#define SCAN_GC(s) (!dir ? ((s) < 2 ? 128 + 2 * b + (s) : b * 64 + ((s) - 2)) : ((s) < 2 ? 128 + 2 * b + (1 - (s)) : b * 64 + (65 - (s))))
    for (int s0 = 0; s0 < 66; s0 += 6) {
      unsigned long long u[6]; float dec[6];
#pragma unroll
      for (int q = 0; q < 6; ++q) { const int gc = SCAN_GC(s0 + q); u[q] = *(const unsigned long long*)(ST + (((size_t)gc * 16 + h) * 2 + dir) * 8192 + e4 * 4); dec[q] = SDEC[(gc * 16 + h) * 2 + dir]; }
#pragma unroll
      for (int q = 0; q < 6; ++q) { const int gc = SCAN_GC(s0 + q);
        if (wr) *(unsigned long long*)(ST + (((size_t)gc * 16 + h) * 2 + dir) * 8192 + e4 * 4) = (unsigned long long)pk2(S0, S1) | ((unsigned long long)pk2(S2, S3) << 32);
        const unsigned lo = (unsigned)u[q], hi = (unsigned)(u[q] >> 32);
        S0 = dec[q] * S0 + __uint_as_float(lo << 16); S1 = dec[q] * S1 + __uint_as_float(lo & 0xffff0000u); S2 = dec[q] * S2 + __uint_as_float(hi << 16); S3 = dec[q] * S3 + __uint_as_float(hi & 0xffff0000u); }
    }
#undef SCAN_GC
  }
}
DEV bf16x8 scale_frag(bf16x8 f, float s) {
  bf16x8 o;
#pragma unroll
  for (int e = 0; e < 8; e += 2) { const unsigned w = pk2(bf2f((bf16_t)f[e]) * s, bf2f((bf16_t)f[e + 1]) * s); o[e] = (short)(w & 0xffff); o[e + 1] = (short)(w >> 16); }
  return o;
}
DEV void ssd_y_phase(const bf16_t* XC, const float* SDT, const float* SCS, const bf16_t* ST, const float* d_skip, bf16_t* Y0, float* SSQ, LAS unsigned char* lds, bool wr) {
  constexpr int XP = 272, BP = 136, SP = 72;
  LAS bf16_t* Xs = (LAS bf16_t*)lds; LAS bf16_t* Bs = (LAS bf16_t*)(lds + 128 * XP * 2);
  LAS float* tab = (LAS float*)(lds + 128 * XP * 2 + 128 * BP * 2);
  LAS float* ssq = tab + 4 * 4 * 128;
  LAS bf16_t* stg = (LAS bf16_t*)(ssq + 4 * 128);
  const int tid = threadIdx.x, lane = tid & 63, wid = tid >> 6, r = lane & 15, Qd = lane >> 4, hl = wid >> 1, ih = wid & 1;
  LAS bf16_t* mystg = stg + wid * 16 * SP;
  for (int task = blockIdx.x; task < NCH * 4; task += gridDim.x) {
    const int gc = task >> 2, g = (task >> 1) & 1, hh = task & 1; const size_t r0 = (size_t)gc * 128; const int h0 = g * 8 + hh * 4, h = h0 + hl;
    bf16x8 cstrip[4], cf[4][4];
#pragma unroll
    for (int ks = 0; ks < 4; ++ks) cstrip[ks] = *(const bf16x8*)(XC + (r0 + 16 * wid + r) * 1536 + 1280 + g * 128 + 32 * ks + 8 * Qd);
#pragma unroll
    for (int m = 0; m < 4; ++m)
#pragma unroll
      for (int ks = 0; ks < 4; ++ks) cf[m][ks] = *(const bf16x8*)(XC + (r0 + 64 * ih + 16 * m + r) * 1536 + 1280 + g * 128 + 32 * ks + 8 * Qd);
    __syncthreads();
#pragma unroll
    for (int i = 0; i < 8; ++i) { const int cid = tid + 512 * i, row = cid >> 5, ch = cid & 31; *(LAS v4u*)(Xs + row * XP + ch * 8) = *(const v4u*)(XC + (r0 + row) * 1536 + h0 * 64 + ch * 8); }
#pragma unroll
    for (int i = 0; i < 4; ++i) { const int cid = tid + 512 * i, row = cid >> 4, ch = cid & 15; *(LAS v4u*)(Bs + row * BP + ch * 8) = *(const v4u*)(XC + (r0 + row) * 1536 + 1024 + g * 128 + ch * 8); }
#pragma unroll
    for (int i = 0; i < 4; ++i) { const int e = tid + 512 * i, hq = e >> 9, which = (e >> 7) & 3, t = e & 127; const int col = (which & 1) * 16 + h0 + hq;
      tab[e] = (which < 2 ? SCS : SDT)[(r0 + t) * 32 + col]; }
    __syncthreads();
    {
      f32x4 cb[8];
#pragma unroll
      for (int t = 0; t < 8; ++t) { f32x4 c = {0.f, 0.f, 0.f, 0.f};
#pragma unroll
        for (int ks = 0; ks < 4; ++ks) { const bf16x8 bfr = *(const LAS bf16x8*)(Bs + (16 * t + r) * BP + 32 * ks + 8 * Qd); c = __builtin_amdgcn_mfma_f32_16x16x32_bf16(bfr, cstrip[ks], c, 0, 0, 0); }
        cb[t] = c; }
      __syncthreads();
#pragma unroll
      for (int t = 0; t < 8; ++t) *(LAS unsigned long long*)(Bs + (16 * wid + r) * BP + 16 * t + 4 * Qd) = (unsigned long long)pk2(cb[t][0], cb[t][1]) | ((unsigned long long)pk2(cb[t][2], cb[t][3]) << 32);
      __syncthreads();
    }
    const LAS float* csf = tab + hl * 512; const LAS float* csb = csf + 128; const LAS float* dtf = csf + 256; const LAS float* dtb = csf + 384;
    const float dsk = d_skip[h];
    f32x4 y[4][4];
#pragma unroll
    for (int m = 0; m < 4; ++m)
#pragma unroll
      for (int pt = 0; pt < 4; ++pt) y[m][pt] = (f32x4){0.f, 0.f, 0.f, 0.f};
#pragma unroll 1
    for (int dir = 0; dir < 2; ++dir) {
      const LAS float* csd = dir ? csb : csf; float sc[4];
#pragma unroll
      for (int m = 0; m < 4; ++m)
#pragma unroll
        for (int ks = 0; ks < 4; ++ks) asm volatile("" : "+v"(cf[m][ks]));
#pragma unroll
      for (int m = 0; m < 4; ++m) sc[m] = fexp(csd[64 * ih + 16 * m + r]);
      const bf16_t* Sp = ST + (((size_t)gc * 16 + h) * 2 + dir) * 8192 + lane * 8;
#pragma unroll
      for (int ks = 0; ks < 4; ++ks) {
        bf16x8 sf[4];
#pragma unroll
        for (int pt = 0; pt < 4; ++pt) sf[pt] = *(const bf16x8*)(Sp + (pt * 4 + ks) * 512);
#pragma unroll
        for (int m = 0; m < 4; ++m) { const bf16x8 a = scale_frag(cf[m][ks], sc[m]);
#pragma unroll
          for (int pt = 0; pt < 4; ++pt) y[m][pt] = __builtin_amdgcn_mfma_f32_16x16x32_bf16(a, sf[pt], y[m][pt], 0, 0, 0);
          __builtin_amdgcn_sched_barrier(0); }
      }
    }
#pragma unroll 1
    for (int m = 0; m < 4; ++m) {
      const int i0 = 64 * ih + 16 * m, i = i0 + r;
      const float cfi = csf[i], cbi = csb[i];
#pragma unroll 1
      for (int k2 = 0; k2 < 4; ++k2) {
        const int j0 = 32 * k2 + 8 * Qd;
        const v4u cbv = *(const LAS v4u*)(Bs + i * BP + j0);
        const float cbe[8] = {__uint_as_float(cbv.x << 16), __uint_as_float(cbv.x & 0xffff0000u), __uint_as_float(cbv.y << 16), __uint_as_float(cbv.y & 0xffff0000u), __uint_as_float(cbv.z << 16), __uint_as_float(cbv.z & 0xffff0000u), __uint_as_float(cbv.w << 16), __uint_as_float(cbv.w & 0xffff0000u)};
        float pv[8];
        const bool dofwd = (32 * k2 <= i0 + 15), dobwd = (32 * k2 + 31 >= i0);
#pragma unroll
        for (int e = 0; e < 8; ++e) pv[e] = (j0 + e == i) ? dsk : 0.f;
        if (dofwd) { const f32x4 a0 = *(const LAS f32x4*)(csf + j0), a1 = *(const LAS f32x4*)(csf + j0 + 4), d0 = *(const LAS f32x4*)(dtf + j0), d1 = *(const LAS f32x4*)(dtf + j0 + 4);
          const float jc[8] = {a0.x, a0.y, a0.z, a0.w, a1.x, a1.y, a1.z, a1.w}; const float jd[8] = {d0.x, d0.y, d0.z, d0.w, d1.x, d1.y, d1.z, d1.w};
#pragma unroll
          for (int e = 0; e < 8; ++e) pv[e] += cbe[e] * fexp(j0 + e <= i ? cfi - jc[e] : -INFINITY) * jd[e]; }
        if (dobwd) { const f32x4 a0 = *(const LAS f32x4*)(csb + j0), a1 = *(const LAS f32x4*)(csb + j0 + 4), d0 = *(const LAS f32x4*)(dtb + j0), d1 = *(const LAS f32x4*)(dtb + j0 + 4);
          const float jc[8] = {a0.x, a0.y, a0.z, a0.w, a1.x, a1.y, a1.z, a1.w}; const float jd[8] = {d0.x, d0.y, d0.z, d0.w, d1.x, d1.y, d1.z, d1.w};
#pragma unroll
          for (int e = 0; e < 8; ++e) pv[e] += cbe[e] * fexp(j0 + e >= i ? cbi - jc[e] : -INFINITY) * jd[e]; }
        const unsigned w0 = pk2(pv[0], pv[1]), w1 = pk2(pv[2], pv[3]), w2 = pk2(pv[4], pv[5]), w3 = pk2(pv[6], pv[7]);
        const bf16x8 pa = (bf16x8){(short)(w0 & 0xffff), (short)(w0 >> 16), (short)(w1 & 0xffff), (short)(w1 >> 16), (short)(w2 & 0xffff), (short)(w2 >> 16), (short)(w3 & 0xffff), (short)(w3 >> 16)};
#pragma unroll
        for (int pt = 0; pt < 4; ++pt) {
          const s16x4 lo = tr_read(Xs + (32 * k2 + 8 * Qd + (r >> 2)) * XP + hl * 64 + 16 * pt + 4 * (r & 3));
          const s16x4 hi = tr_read(Xs + (32 * k2 + 8 * Qd + 4 + (r >> 2)) * XP + hl * 64 + 16 * pt + 4 * (r & 3));
          const bf16x8 xf = (bf16x8){lo[0], lo[1], lo[2], lo[3], hi[0], hi[1], hi[2], hi[3]};
          y[0][pt] = __builtin_amdgcn_mfma_f32_16x16x32_bf16(pa, xf, y[0][pt], 0, 0, 0);
        }
      }
#pragma unroll
      for (int pt = 0; pt < 4; ++pt)
#pragma unroll
        for (int jj = 0; jj < 4; ++jj) mystg[(4 * Qd + jj) * SP + 16 * pt + r] = f2bf(y[0][pt][jj]);
      LDS_WAIT(); asm volatile("" ::: "memory");
#pragma unroll
      for (int q = 0; q < 2; ++q) { const int c = lane + 64 * q, rowl = c >> 3, ch = c & 7; const int il = 64 * ih + 16 * m + rowl;
        const v4u yv = *(const LAS v4u*)(mystg + rowl * SP + ch * 8); bf16_t* zp = Y0 + (r0 + il) * 2048 + h * 64 + ch * 8; const v4u zv = *(const v4u*)zp;
        const float v0 = __uint_as_float(yv.x << 16) * __uint_as_float(zv.x << 16), v1 = __uint_as_float(yv.x & 0xffff0000u) * __uint_as_float(zv.x & 0xffff0000u);
        const float v2 = __uint_as_float(yv.y << 16) * __uint_as_float(zv.y << 16), v3 = __uint_as_float(yv.y & 0xffff0000u) * __uint_as_float(zv.y & 0xffff0000u);
        const float v4 = __uint_as_float(yv.z << 16) * __uint_as_float(zv.z << 16), v5 = __uint_as_float(yv.z & 0xffff0000u) * __uint_as_float(zv.z & 0xffff0000u);
        const float v6 = __uint_as_float(yv.w << 16) * __uint_as_float(zv.w << 16), v7 = __uint_as_float(yv.w & 0xffff0000u) * __uint_as_float(zv.w & 0xffff0000u);
        float ss = (v0 * v0 + v1 * v1) + (v2 * v2 + v3 * v3) + (v4 * v4 + v5 * v5) + (v6 * v6 + v7 * v7);
        ss += __shfl_xor(ss, 1); ss += __shfl_xor(ss, 2); ss += __shfl_xor(ss, 4);
        v4u ov; ov.x = pk2(v0, v1); ov.y = pk2(v2, v3); ov.z = pk2(v4, v5); ov.w = pk2(v6, v7);
        if (wr) *(v4u*)zp = ov;
        if (ch == 0) ssq[hl * 128 + il] = ss; }
      LDS_WAIT(); asm volatile("" ::: "memory");
#pragma unroll
      for (int pt = 0; pt < 4; ++pt) { y[0][pt] = y[1][pt]; y[1][pt] = y[2][pt]; y[2][pt] = y[3][pt]; }
    }
    __syncthreads();
    if (tid < 128) SSQ[((r0 + tid) * 2 + g) * 2 + hh] = (ssq[tid] + ssq[128 + tid]) + (ssq[256 + tid] + ssq[384 + tid]);
  }
}

constexpr size_t WS_GCSC = 237 * MiB + 4 * MiB;
typedef _Float16 h16_t;
typedef _Float16 h16x8 __attribute__((ext_vector_type(8)));
DEV const h16_t* gcs_row(const h16_t* lat, const h16_t* ctx, size_t row) { return row < (size_t)ML ? lat + row * 1024 : ctx + (row - ML) * 1024; }
DEV h16_t* gcs_row_w(h16_t* lat, h16_t* ctx, size_t row) { return row < (size_t)ML ? lat + row * 1024 : ctx + (row - ML) * 1024; }
DEV float logsig_fast(float x) { return fminf(x, 0.f) - 0.6931471805599453f * __builtin_amdgcn_logf(1.f + __builtin_amdgcn_exp2f(-1.4426950408889634f * fabsf(x))); }
DEV void gla_cs_phase(const float* DTLR, const float* gw, const float* gb, h16_t* GCSL, h16_t* GCSC, float* GDEC, LAS unsigned char* lds) {
  const int lane = threadIdx.x & 63, wave = threadIdx.x >> 6;
  LAS float* lrs = (LAS float*)(lds + wave * 8192);
  LAS h16_t* tile = (LAS h16_t*)(lds + 65536 + wave * 1024);
  for (int wt = blockIdx.x * NWAVES + wave; wt < NCH * 2 * 8; wt += gridDim.x * NWAVES) {
    const int gc = wt >> 4, dir = (wt >> 3) & 1, k = (wt & 7) * 64 + lane;
#pragma unroll
    for (int q = 0; q < 8; ++q) { const int c = lane + 64 * q, row = c >> 2, part = c & 3;
      *(LAS f32x4*)(lrs + row * 16 + part * 4) = *(const f32x4*)(DTLR + ((size_t)gc * 128 + row) * 64 + 32 + dir * 16 + part * 4); }
    float wv[16];
#pragma unroll
    for (int q = 0; q < 16; ++q) wv[q] = gw[(dir * 16 + q) * 512 + k];
    const float bias = gb[dir * 512 + k];
    LDS_WAIT(); asm volatile("" ::: "memory");
    float run = 0.f;
#pragma unroll 1
    for (int s0 = 0; s0 < 128; s0 += 8) {
      float lg[8];
#pragma unroll
      for (int u = 0; u < 8; ++u) { const int s = s0 + u, t = dir ? 127 - s : s; const LAS float* lr = lrs + t * 16;
        const f32x4 l0 = *(const LAS f32x4*)lr, l1 = *(const LAS f32x4*)(lr + 4), l2 = *(const LAS f32x4*)(lr + 8), l3 = *(const LAS f32x4*)(lr + 12);
        const float x = bias + l0.x * wv[0] + l0.y * wv[1] + l0.z * wv[2] + l0.w * wv[3] + l1.x * wv[4] + l1.y * wv[5] + l1.z * wv[6] + l1.w * wv[7]
                        + l2.x * wv[8] + l2.y * wv[9] + l2.z * wv[10] + l2.w * wv[11] + l3.x * wv[12] + l3.y * wv[13] + l3.z * wv[14] + l3.w * wv[15];
        lg[u] = logsig_fast(x) * (1.f / 16.f); }
#pragma unroll
      for (int u = 0; u < 8; ++u) { run += lg[u]; tile[u * 64 + lane] = (h16_t)run; }
      LDS_WAIT(); asm volatile("" ::: "memory");
      { const int u = lane >> 3, ch = lane & 7, s = s0 + u, t = dir ? 127 - s : s;
        *(v4u*)(gcs_row_w(GCSL, GCSC, (size_t)gc * 128 + t) + dir * 512 + (k - lane) + ch * 8) = *(const LAS v4u*)(tile + u * 64 + ch * 8); }
      LDS_WAIT(); asm volatile("" ::: "memory");
    }
    GDEC[((gc * 4 + (k >> 7)) * 2 + dir) * 128 + (k & 127)] = fexp(run);
    LDS_WAIT(); asm volatile("" ::: "memory");
  }
}
DEV void gla_u_phase(const bf16_t* K0, const bf16_t* V0, const h16_t* GCSL, const h16_t* GCSC, bf16_t* ST, LAS unsigned char* lds) {
  constexpr int VP = 272, KP = 144;
  LAS bf16_t* Vs = (LAS bf16_t*)lds; LAS bf16_t* Kd = (LAS bf16_t*)(lds + 128 * VP * 2);
  const int tid = threadIdx.x, lane = tid & 63, wid = tid >> 6, r = lane & 15, Qd = lane >> 4;
  for (int task = blockIdx.x; task < NCH * 4; task += gridDim.x) {
    const int gc = task >> 2, h = task & 3; const size_t r0 = (size_t)gc * 128;
    __syncthreads();
#pragma unroll
    for (int i = 0; i < 8; ++i) { const int cid = tid + 512 * i, row = cid >> 5, ch = cid & 31; *(LAS v4u*)(Vs + row * VP + ch * 8) = *(const v4u*)(V0 + (r0 + row) * 1024 + h * 256 + ch * 8); }
#pragma unroll
    for (int i = 0; i < 4; ++i) { const int cid = tid + 512 * i, t = cid >> 4, ch = cid & 15;
      const v4u kv = *(const v4u*)(K0 + (r0 + t) * 512 + h * 128 + ch * 8);
      const float kf[8] = {__uint_as_float(kv.x << 16), __uint_as_float(kv.x & 0xffff0000u), __uint_as_float(kv.y << 16), __uint_as_float(kv.y & 0xffff0000u), __uint_as_float(kv.z << 16), __uint_as_float(kv.z & 0xffff0000u), __uint_as_float(kv.w << 16), __uint_as_float(kv.w & 0xffff0000u)};
#pragma unroll
      for (int dir = 0; dir < 2; ++dir) {
        const h16x8 ce = *(const h16x8*)(gcs_row(GCSL, GCSC, r0 + (dir ? 0 : 127)) + dir * 512 + h * 128 + ch * 8), ct = *(const h16x8*)(gcs_row(GCSL, GCSC, r0 + t) + dir * 512 + h * 128 + ch * 8);
        v4u o; o.x = pk2(kf[0] * fexp((float)ce[0] - (float)ct[0]), kf[1] * fexp((float)ce[1] - (float)ct[1])); o.y = pk2(kf[2] * fexp((float)ce[2] - (float)ct[2]), kf[3] * fexp((float)ce[3] - (float)ct[3]));
        o.z = pk2(kf[4] * fexp((float)ce[4] - (float)ct[4]), kf[5] * fexp((float)ce[5] - (float)ct[5])); o.w = pk2(kf[6] * fexp((float)ce[6] - (float)ct[6]), kf[7] * fexp((float)ce[7] - (float)ct[7]));
        *(LAS v4u*)(Kd + dir * 128 * KP + t * KP + ch * 8) = o; } }
    __syncthreads();
#pragma unroll 1
    for (int dir = 0; dir < 2; ++dir) {
      const LAS bf16_t* Kb = Kd + dir * 128 * KP;
      f32x4 acc[8][2];
#pragma unroll
      for (int dt = 0; dt < 8; ++dt) { acc[dt][0] = (f32x4){0.f, 0.f, 0.f, 0.f}; acc[dt][1] = (f32x4){0.f, 0.f, 0.f, 0.f}; }
#pragma unroll 1
      for (int k = 0; k < 4; ++k) {
        bf16x8 vf[2];
#pragma unroll
        for (int et = 0; et < 2; ++et) {
          const s16x4 lo = tr_read(Vs + (32 * k + 4 * Qd + (r >> 2)) * VP + 32 * wid + 16 * et + 4 * (r & 3));
          const s16x4 hi = tr_read(Vs + (32 * k + 16 + 4 * Qd + (r >> 2)) * VP + 32 * wid + 16 * et + 4 * (r & 3));
          vf[et] = (bf16x8){lo[0], lo[1], lo[2], lo[3], hi[0], hi[1], hi[2], hi[3]}; }
#pragma unroll
        for (int dt = 0; dt < 8; ++dt) {
          const s16x4 lo = tr_read(Kb + (32 * k + 4 * Qd + (r >> 2)) * KP + 16 * dt + 4 * (r & 3));
          const s16x4 hi = tr_read(Kb + (32 * k + 16 + 4 * Qd + (r >> 2)) * KP + 16 * dt + 4 * (r & 3));
          const bf16x8 kfr = (bf16x8){lo[0], lo[1], lo[2], lo[3], hi[0], hi[1], hi[2], hi[3]};
          acc[dt][0] = __builtin_amdgcn_mfma_f32_16x16x32_bf16(kfr, vf[0], acc[dt][0], 0, 0, 0);
          acc[dt][1] = __builtin_amdgcn_mfma_f32_16x16x32_bf16(kfr, vf[1], acc[dt][1], 0, 0, 0); }
      }
      bf16_t* Sp = ST + (((size_t)gc * 4 + h) * 2 + dir) * 32768;
#pragma unroll
      for (int dt = 0; dt < 8; ++dt)
#pragma unroll
        for (int et = 0; et < 2; ++et) { const f32x4 v = acc[dt][et];
          *(unsigned long long*)(Sp + ((((2 * wid + et) * 4 + (dt >> 1)) * 64 + ((dt & 1) * 2 + (Qd >> 1)) * 16 + r) * 8 + 4 * (Qd & 1))) = (unsigned long long)pk2(v[0], v[1]) | ((unsigned long long)pk2(v[2], v[3]) << 32); }
    }
  }
}
DEV void gla_scan_phase(bf16_t* ST, const float* GDEC, bool wr) {
  for (int item = blockIdx.x * 512 + threadIdx.x; item < 2 * 4 * 2 * 8192; item += gridDim.x * 512) {
    const int e4 = item & 8191, dir = (item >> 13) & 1, h = (item >> 14) & 3, b = item >> 16; const int d0 = 32 * ((e4 >> 7) & 3) + 8 * ((e4 >> 5) & 3) + 4 * (e4 & 1);
    float S0 = 0.f, S1 = 0.f, S2 = 0.f, S3 = 0.f;
#define SCAN_GC(s) (!dir ? ((s) < 2 ? 128 + 2 * b + (s) : b * 64 + ((s) - 2)) : ((s) < 2 ? 128 + 2 * b + (1 - (s)) : b * 64 + (65 - (s))))
    for (int s0 = 0; s0 < 66; s0 += 6) {
      unsigned long long u[6]; f32x4 dec[6];
#pragma unroll
      for (int q = 0; q < 6; ++q) { const int gc = SCAN_GC(s0 + q); u[q] = *(const unsigned long long*)(ST + (((size_t)gc * 4 + h) * 2 + dir) * 32768 + e4 * 4); dec[q] = *(const f32x4*)(GDEC + ((gc * 4 + h) * 2 + dir) * 128 + d0); }
#pragma unroll
      for (int q = 0; q < 6; ++q) { const int gc = SCAN_GC(s0 + q);
        if (wr) *(unsigned long long*)(ST + (((size_t)gc * 4 + h) * 2 + dir) * 32768 + e4 * 4) = (unsigned long long)pk2(S0, S1) | ((unsigned long long)pk2(S2, S3) << 32);
        const unsigned lo = (unsigned)u[q], hi = (unsigned)(u[q] >> 32);
        S0 = dec[q].x * S0 + __uint_as_float(lo << 16); S1 = dec[q].y * S1 + __uint_as_float(lo & 0xffff0000u); S2 = dec[q].z * S2 + __uint_as_float(hi << 16); S3 = dec[q].w * S3 + __uint_as_float(hi & 0xffff0000u); }
    }
#undef SCAN_GC
  }
}
DEV void gla_o_phase(const bf16_t* Q0, const bf16_t* K0, const bf16_t* V0, const h16_t* GCSL, const h16_t* GCSC, const bf16_t* ST, const float* gla_norm, const float* SSQ, const float* ssd_norm, bf16_t* Y0, LAS unsigned char* lds, bool wr) {
  constexpr int VP = 272, KP = 136;
  LAS bf16_t* Vs = (LAS bf16_t*)lds; LAS bf16_t* Kd = (LAS bf16_t*)(lds + 128 * VP * 2);
  const int tid = threadIdx.x, lane = tid & 63, wid = tid >> 6, r = lane & 15, Qd = lane >> 4;
  const float scale = 0.08838834764831845f;
  for (int task = blockIdx.x; task < NCH * 4; task += gridDim.x) {
    const int gc = task >> 2, h = task & 3; const size_t r0 = (size_t)gc * 128;
    __syncthreads();
#pragma unroll
    for (int i = 0; i < 8; ++i) { const int cid = tid + 512 * i, row = cid >> 5, ch = cid & 31; *(LAS v4u*)(Vs + row * VP + ch * 8) = *(const v4u*)(V0 + (r0 + row) * 1024 + h * 256 + ch * 8); }
#pragma unroll
    for (int i = 0; i < 4; ++i) { const int cid = tid + 512 * i, t = cid >> 4, ch = cid & 15;
      const v4u kv = *(const v4u*)(K0 + (r0 + t) * 512 + h * 128 + ch * 8);
      const float kf[8] = {__uint_as_float(kv.x << 16), __uint_as_float(kv.x & 0xffff0000u), __uint_as_float(kv.y << 16), __uint_as_float(kv.y & 0xffff0000u), __uint_as_float(kv.z << 16), __uint_as_float(kv.z & 0xffff0000u), __uint_as_float(kv.w << 16), __uint_as_float(kv.w & 0xffff0000u)};
#pragma unroll
      for (int dir = 0; dir < 2; ++dir) {
        const h16x8 ct = *(const h16x8*)(gcs_row(GCSL, GCSC, r0 + t) + dir * 512 + h * 128 + ch * 8);
        v4u o; o.x = pk2(kf[0] * fexp(-(float)ct[0]), kf[1] * fexp(-(float)ct[1])); o.y = pk2(kf[2] * fexp(-(float)ct[2]), kf[3] * fexp(-(float)ct[3]));
        o.z = pk2(kf[4] * fexp(-(float)ct[4]), kf[5] * fexp(-(float)ct[5])); o.w = pk2(kf[6] * fexp(-(float)ct[6]), kf[7] * fexp(-(float)ct[7]));
        *(LAS v4u*)(Kd + dir * 128 * KP + t * KP + ch * 8) = o; } }
    __syncthreads();
    const int i = 16 * wid + r;
    f32x4 o[16];
#pragma unroll
    for (int et = 0; et < 16; ++et) o[et] = (f32x4){0.f, 0.f, 0.f, 0.f};
#pragma unroll 1
    for (int dir = 0; dir < 2; ++dir) {
      bf16x8 qd[4];
      { const h16_t* ci = gcs_row(GCSL, GCSC, r0 + i) + dir * 512 + h * 128; const bf16_t* qp = Q0 + (r0 + i) * 512 + h * 128;
#pragma unroll
        for (int ks = 0; ks < 4; ++ks) { const v4u qv = *(const v4u*)(qp + 32 * ks + 8 * Qd); const h16x8 cc = *(const h16x8*)(ci + 32 * ks + 8 * Qd);
          const f32x4 c0 = {(float)cc[0], (float)cc[1], (float)cc[2], (float)cc[3]}, c1 = {(float)cc[4], (float)cc[5], (float)cc[6], (float)cc[7]};
          const unsigned w0 = pk2(__uint_as_float(qv.x << 16) * scale * fexp(c0.x), __uint_as_float(qv.x & 0xffff0000u) * scale * fexp(c0.y));
          const unsigned w1 = pk2(__uint_as_float(qv.y << 16) * scale * fexp(c0.z), __uint_as_float(qv.y & 0xffff0000u) * scale * fexp(c0.w));
          const unsigned w2 = pk2(__uint_as_float(qv.z << 16) * scale * fexp(c1.x), __uint_as_float(qv.z & 0xffff0000u) * scale * fexp(c1.y));
          const unsigned w3 = pk2(__uint_as_float(qv.w << 16) * scale * fexp(c1.z), __uint_as_float(qv.w & 0xffff0000u) * scale * fexp(c1.w));
          qd[ks] = (bf16x8){(short)(w0 & 0xffff), (short)(w0 >> 16), (short)(w1 & 0xffff), (short)(w1 >> 16), (short)(w2 & 0xffff), (short)(w2 >> 16), (short)(w3 & 0xffff), (short)(w3 >> 16)}; } }
      const bf16_t* Sp = ST + (((size_t)gc * 4 + h) * 2 + dir) * 32768 + lane * 8;
      {
        bf16x8 sA[4], sB[4];
#pragma unroll
        for (int q = 0; q < 4; ++q) sA[q] = *(const bf16x8*)(Sp + (q * 4 + 0) * 512);
#pragma unroll
        for (int bi = 0; bi < 16; ++bi) {
          const int ks = bi >> 2, e0 = 4 * (bi & 3);
          if (bi + 1 < 16) { const int ks2 = (bi + 1) >> 2, e2 = 4 * ((bi + 1) & 3);
#pragma unroll
            for (int q = 0; q < 4; ++q) { if (bi & 1) sA[q] = *(const bf16x8*)(Sp + ((e2 + q) * 4 + ks2) * 512); else sB[q] = *(const bf16x8*)(Sp + ((e2 + q) * 4 + ks2) * 512); } }
#pragma unroll
          for (int q = 0; q < 4; ++q) o[e0 + q] = __builtin_amdgcn_mfma_f32_16x16x32_bf16(qd[ks], (bi & 1) ? sB[q] : sA[q], o[e0 + q], 0, 0, 0);
          __builtin_amdgcn_sched_barrier(0);
        }
      }
      const LAS bf16_t* Kb = Kd + dir * 128 * KP;
#pragma unroll 1
      for (int k2 = 0; k2 < 4; ++k2) {
        const bool need = dir ? (2 * k2 + 1 >= wid) : (2 * k2 <= wid);
        if (!need) continue;
        bf16x8 pa;
#pragma unroll
        for (int tt = 0; tt < 2; ++tt) { const int t = 2 * k2 + tt;
          f32x4 c = {0.f, 0.f, 0.f, 0.f};
#pragma unroll
          for (int ks = 0; ks < 4; ++ks) { const bf16x8 kfr = *(const LAS bf16x8*)(Kb + (16 * t + r) * KP + 32 * ks + 8 * Qd); c = __builtin_amdgcn_mfma_f32_16x16x32_bf16(kfr, qd[ks], c, 0, 0, 0); }
          float pv[4];
#pragma unroll
          for (int jj = 0; jj < 4; ++jj) { const int j = 16 * t + 4 * Qd + jj; const bool ok = dir ? (j >= i) : (j <= i); pv[jj] = ok ? c[jj] : 0.f; }
          const unsigned w0 = pk2(pv[0], pv[1]), w1 = pk2(pv[2], pv[3]);
          pa[tt * 4 + 0] = (short)(w0 & 0xffff); pa[tt * 4 + 1] = (short)(w0 >> 16); pa[tt * 4 + 2] = (short)(w1 & 0xffff); pa[tt * 4 + 3] = (short)(w1 >> 16); }
#pragma unroll
        for (int et = 0; et < 16; ++et) {
          const s16x4 lo = tr_read(Vs + (32 * k2 + 4 * Qd + (r >> 2)) * VP + 16 * et + 4 * (r & 3));
          const s16x4 hi = tr_read(Vs + (32 * k2 + 16 + 4 * Qd + (r >> 2)) * VP + 16 * et + 4 * (r & 3));
          const bf16x8 vf = (bf16x8){lo[0], lo[1], lo[2], lo[3], hi[0], hi[1], hi[2], hi[3]};
          o[et] = __builtin_amdgcn_mfma_f32_16x16x32_bf16(pa, vf, o[et], 0, 0, 0); }
      }
    }
#pragma unroll
    for (int jj = 0; jj < 4; ++jj) { float ss = 0.f;
#pragma unroll
      for (int et = 0; et < 16; ++et) ss += o[et][jj] * o[et][jj];
      ss += __shfl_xor(ss, 1); ss += __shfl_xor(ss, 2); ss += __shfl_xor(ss, 4); ss += __shfl_xor(ss, 8);
      const float rstd = rsqrtf(ss * (1.f / 256.f) + EPS);
      const size_t yo = (r0 + 16 * wid + 4 * Qd + jj) * 2048 + 1024 + h * 256 + r;
#pragma unroll
      for (int et = 0; et < 16; ++et) { const bf16_t ov_ = f2bf(o[et][jj] * rstd * gla_norm[h * 256 + 16 * et + r] * bf2f(Y0[yo + 16 * et])); if (wr) Y0[yo + 16 * et] = ov_; } }
    { const int g = h >> 1, c0 = g * 512 + (h & 1) * 256;
#pragma unroll
      for (int q = 0; q < 8; ++q) { const int cid = tid + 512 * q, row = cid >> 5, ch = cid & 31; const size_t rr = r0 + row;
        const float rstd = rsqrtf((SSQ[(rr * 2 + g) * 2] + SSQ[(rr * 2 + g) * 2 + 1]) * (1.f / 512.f) + EPS);
        bf16_t* yp = Y0 + rr * 2048 + c0 + ch * 8; const v4u yv = *(const v4u*)yp; const f32x4 g0 = *(const f32x4*)(ssd_norm + c0 + ch * 8), g1 = *(const f32x4*)(ssd_norm + c0 + ch * 8 + 4);
        v4u ov; ov.x = pk2(__uint_as_float(yv.x << 16) * rstd * g0.x, __uint_as_float(yv.x & 0xffff0000u) * rstd * g0.y); ov.y = pk2(__uint_as_float(yv.y << 16) * rstd * g0.z, __uint_as_float(yv.y & 0xffff0000u) * rstd * g0.w);
        ov.z = pk2(__uint_as_float(yv.z << 16) * rstd * g1.x, __uint_as_float(yv.z & 0xffff0000u) * rstd * g1.y); ov.w = pk2(__uint_as_float(yv.w << 16) * rstd * g1.z, __uint_as_float(yv.w & 0xffff0000u) * rstd * g1.w);
        if (wr) *(v4u*)yp = ov; } }
  }
}

typedef __attribute__((address_space(1))) unsigned gu32;
#define RLX_AGENT __ATOMIC_RELAXED, __HIP_MEMORY_SCOPE_AGENT
#define XB_TMO      128
#define XB_XCNT(j)  (256  + 64 * (j))
#define XB_XSUB(j)  (1280 + 64 * (j))
#define XB_XGEN(j)  (2304 + 64 * (j))
#define XB_TOP      3328
#define XB_TOPGEN   3392
#define XCD_BAR_WORDS 3456
#define XB_SPIN_CAP (1u << 18)

__device__ __forceinline__ unsigned xb_ld(unsigned* p)              { return __hip_atomic_load(p, __ATOMIC_RELAXED, __HIP_MEMORY_SCOPE_AGENT); }
__device__ __forceinline__ unsigned xb_add(unsigned* p, unsigned v) { return __hip_atomic_fetch_add(p, v, __ATOMIC_RELAXED, __HIP_MEMORY_SCOPE_AGENT); }
__device__ __forceinline__ unsigned xb_xcc_id() { return (unsigned)__builtin_amdgcn_s_getreg((3 << 11) | 20) & 0xFu; }
#define XB_SPIN(cond, bar) do { unsigned _sp = 0; while (cond) { __builtin_amdgcn_s_sleep(1); \
    if ((++_sp & 255u) == 0u) { if (xb_ld(&(bar)[XB_TMO])) break; if (_sp > XB_SPIN_CAP) { atomicAdd(&(bar)[XB_TMO], 1u); break; } } } } while (0)

struct XcdBarrier {
    unsigned* bar; unsigned x;
    volatile LAS unsigned* st;
};

__device__ __forceinline__ XcdBarrier xcd_barrier_post(unsigned* bar, volatile LAS unsigned* st) {
    XcdBarrier b; b.bar = bar; b.x = xb_xcc_id(); b.st = st;
    if (threadIdx.x == 0) (void)xb_add(&bar[XB_XCNT(b.x)], 1u);
    return b;
}
__device__ __forceinline__ void xcd_barrier_complete(unsigned* bar, unsigned x, unsigned& nloc, unsigned& nx) {
    const unsigned G = gridDim.x * gridDim.y * gridDim.z;
    unsigned sum, cnt, mine, sp = 0u;
    for (;;) {
        sum = 0u; cnt = 0u; mine = 0u;
#pragma unroll
        for (unsigned j = 0; j < 16; ++j) { const unsigned c = xb_ld(&bar[XB_XCNT(j)]); sum += c; cnt += (c > 0u) ? 1u : 0u; mine = (j == x) ? c : mine; }
        if (sum == G) break;
        __builtin_amdgcn_s_sleep(1);
        if ((++sp & 255u) == 0u) { if (xb_ld(&bar[XB_TMO])) break; if (sp > XB_SPIN_CAP) { atomicAdd(&bar[XB_TMO], 1u); break; } }
    }
    nloc = mine > 0u ? mine : 1u; nx = cnt > 0u ? cnt : 1u;
}

__device__ __forceinline__ void xcd_barrier(const XcdBarrier& b) {
    asm volatile("s_waitcnt vmcnt(0)" ::: "memory");
    __syncthreads();
    if (threadIdx.x == 0) {
        unsigned* bar = b.bar;
        __builtin_amdgcn_s_waitcnt(0);
        unsigned nloc = b.st[0], nx = b.st[1];
        if (nloc == 0u) { xcd_barrier_complete(bar, b.x, nloc, nx); b.st[0] = nloc; b.st[1] = nx; }
        const unsigned old = xb_add(&bar[XB_XSUB(b.x)], 1u);
        const unsigned gen = old / nloc;
        if (old + 1u == (gen + 1u) * nloc) {
            __builtin_amdgcn_fence(__ATOMIC_RELEASE, "agent");
            asm volatile("s_waitcnt vmcnt(0)" ::: "memory");
            const unsigned og = xb_add(&bar[XB_TOP], 1u);
            const unsigned tg = og / nx;
            if (og + 1u == (tg + 1u) * nx) xb_add(&bar[XB_TOPGEN], 1u);
            else XB_SPIN(xb_ld(&bar[XB_TOPGEN]) == tg, bar);
            __builtin_amdgcn_fence(__ATOMIC_ACQUIRE, "agent");
            xb_add(&bar[XB_XGEN(b.x)], 1u);
            asm volatile("s_waitcnt vmcnt(0)" ::: "memory");
        } else {
            XB_SPIN(xb_ld(&bar[XB_XGEN(b.x)]) == gen, bar);
            __builtin_amdgcn_fence(__ATOMIC_ACQUIRE, "agent");
            asm volatile("s_waitcnt vmcnt(0)" ::: "memory");
        }
    }
    __syncthreads();
}

__global__ void __launch_bounds__(NWAVES * 64, 2) mega(Params p) {
  extern __shared__ __attribute__((aligned(16))) unsigned char lds_raw[];
  LAS unsigned char* lds = (LAS unsigned char*)lds_raw;
  cg::grid_group grid = cg::this_grid();
  volatile LAS unsigned* MISC = (volatile LAS unsigned*)(lds + MISC_OFF);
  if (threadIdx.x < 16) MISC[threadIdx.x] = 0u;
  __syncthreads();
  XcdBarrier bar = xcd_barrier_post((unsigned*)(p.ws + WS_CTL), MISC + 8);
  unsigned char* ws = p.ws;
  float* MOD = (float*)(ws + WS_MOD);
  bf16_t* H0 = (bf16_t*)p.out; float* X1 = p.out;
  const int lo = p.ph_lo, hi = p.ph_hi;
  if (lo < 0) grid.sync();
#define IN(k) (lo <= (k) && (k) < hi)
#define SEAM(k) do { if ((k) + 1 < hi) xcd_barrier(bar); } while (0)
#define PH(k, ...) if (IN(k)) { if ((PROBE_MASK >> (k)) & 1u) { const bool wr = (p.rep < 0); (void)wr; __VA_ARGS__; xcd_barrier(bar); } { const bool wr = true; (void)wr; __VA_ARGS__; } SEAM(k); }
  PH(0, prologue_phase(p, lds))
  PH(1, prep_phase(p.in[0], p.in[2], p.in[4], MOD, H0))
  PH(2, {
    pg8::Gemm g{H0, (const bf16_t*)(ws + WS_W1T), MA, E_INP, D}; pg8::StaticOrder S; S.init(MA, E_INP, gridDim.x, (int)blockIdx.x);
    pg8::EpiProj0 E{(bf16_t*)(ws + WS_Y0), (bf16_t*)(ws + WS_XBC), (bf16_t*)(ws + WS_Q0), (bf16_t*)(ws + WS_K0), (bf16_t*)(ws + WS_V0), (float*)(ws + WS_DTLR)};
    pg8::gemm_phase<pg8::EpiProj0, pg8::StaticOrder, true, true>(lds, g, S, E); })
  PH(3, ssd_prep_phase((const bf16_t*)(ws + WS_XBC), p.in[8], p.in[9], (bf16_t*)p.out, (const float*)(ws + WS_DTLR), p.in[10], p.in[11], (float*)((char*)p.out + DO_SDT), (float*)((char*)p.out + DO_SCS), (float*)(ws + WS_SDEC)))
  PH(4, { ssd_u_phase((const bf16_t*)p.out, (const float*)((char*)p.out + DO_SDT), (const float*)((char*)p.out + DO_SCS), (bf16_t*)(ws + WS_STATE), lds);
    { const int nbusy = (NCH * 4) % (int)gridDim.x, nfree = (int)gridDim.x - nbusy;
      if ((int)blockIdx.x >= nbusy || nfree <= 0) { __syncthreads(); late_weights(p, lds, nfree > 0 ? (int)blockIdx.x - nbusy : (int)blockIdx.x, nfree > 0 ? nfree : (int)gridDim.x); } } })
  PH(5, ssd_scan_phase((bf16_t*)(ws + WS_STATE), (const float*)(ws + WS_SDEC), wr))
  PH(6, ssd_y_phase((const bf16_t*)p.out, (const float*)((char*)p.out + DO_SDT), (const float*)((char*)p.out + DO_SCS), (const bf16_t*)(ws + WS_STATE), p.in[12], (bf16_t*)(ws + WS_Y0), (float*)(ws + WS_SSQ), lds, wr))
  PH(7, gla_cs_phase((const float*)(ws + WS_DTLR), p.in[14], p.in[15], (h16_t*)p.out, (h16_t*)(ws + WS_GCSC), (float*)(ws + WS_GDEC), lds))
  PH(8, gla_u_phase((const bf16_t*)(ws + WS_K0), (const bf16_t*)(ws + WS_V0), (const h16_t*)p.out, (const h16_t*)(ws + WS_GCSC), (bf16_t*)(ws + WS_STATE), lds))
  PH(9, gla_scan_phase((bf16_t*)(ws + WS_STATE), (const float*)(ws + WS_GDEC), wr))
  PH(10, gla_o_phase((const bf16_t*)(ws + WS_Q0), (const bf16_t*)(ws + WS_K0), (const bf16_t*)(ws + WS_V0), (const h16_t*)p.out, (const h16_t*)(ws + WS_GCSC), (const bf16_t*)(ws + WS_STATE), p.in[16], (const float*)(ws + WS_SSQ), p.in[13], (bf16_t*)(ws + WS_Y0), lds, wr))
  PH(11, {
    pg8::Gemm g{(const bf16_t*)(ws + WS_Y0), (const bf16_t*)(ws + WS_W2T), ML, D, 2048}; pg8::StaticOrder S; S.init(ML, D, gridDim.x, (int)blockIdx.x);
    pg8::EpiResid E{p.in[0], X1, MOD, true};
    pg8::gemm_phase<pg8::EpiResid, pg8::StaticOrder, true, true>(lds, g, S, E);
    const float* ctx = p.in[2]; float* XC1 = (float*)(ws + WS_XC1); const float* gate = MOD + 2 * 3072 + 2048;
    small_gemm((const bf16_t*)(ws + WS_Y0) + (size_t)ML * 2048, 2048, (const bf16_t*)(ws + WS_W2T), 2048, 2048, MC, D,
               [=](int m, int n, float v) { XC1[(size_t)m * D + n] = ctx[(size_t)m * D + n] + gate[n] * v; }); })
  PH(12, prep_phase(X1, (const float*)(ws + WS_XC1), p.in[18], MOD + 3 * 3072, (bf16_t*)(ws + WS_H1)))
  PH(13, {
    pg8::Gemm g{(const bf16_t*)(ws + WS_H1), (const bf16_t*)(ws + WS_W3T), ML, O_IN, D}; pg8::StaticOrder S; S.init(ML, O_IN, gridDim.x, (int)blockIdx.x);
    pg8::EpiProj1 E{(bf16_t*)(ws + WS_K1), (bf16_t*)(ws + WS_V1), (bf16_t*)(ws + WS_Q1), (bf16_t*)(ws + WS_G1)};
    pg8::gemm_phase<pg8::EpiProj1, pg8::StaticOrder, true, true>(lds, g, S, E);
    bf16_t* K1 = (bf16_t*)(ws + WS_K1); bf16_t* V1 = (bf16_t*)(ws + WS_V1);
    small_gemm((const bf16_t*)(ws + WS_H1) + (size_t)ML * D, D, (const bf16_t*)(ws + WS_W3T), D, D, MC, 1024,
               [=](int m, int n, float v) { if (n < 512) K1[(size_t)(ML + m) * 512 + n] = f2bf(v); else V1[(size_t)(ML + m) * 512 + (n - 512)] = f2bf(v); }); })
  PH(14, qknorm_phase((bf16_t*)(ws + WS_Q1), (bf16_t*)(ws + WS_K1), p.in[22], p.in[23], (const float*)(ws + WS_ROPE), wr))
  PH(15, attn_phase((bf16_t*)(ws + WS_Q1), (const bf16_t*)(ws + WS_K1), (const bf16_t*)(ws + WS_V1), (const bf16_t*)(ws + WS_G1), p.in[24], p.in[22], p.in[23], lds, wr))
  PH(16, {
    pg8::Gemm g{(const bf16_t*)(ws + WS_Q1), (const bf16_t*)(ws + WS_W4T), ML, D, 2048}; pg8::StaticOrder S; S.init(ML, D, gridDim.x, (int)blockIdx.x);
    pg8::EpiResid E{X1, p.out, MOD + 3 * 3072, wr};
    pg8::gemm_phase<pg8::EpiResid, pg8::StaticOrder, true, true>(lds, g, S, E); })
#undef PH
#undef IN
#undef SEAM
}
extern "C" void kernel_launch(void* const* d_in, const int* in_sizes, int n_in, void* d_out, int out_size, void* d_ws, size_t ws_size, hipStream_t stream) {
  static int grid_blocks = 0;
  if (!grid_blocks) {
    int dev = 0, cus = 0, per_cu = 0;
    hipGetDevice(&dev);
    hipDeviceGetAttribute(&cus, hipDeviceAttributeMultiprocessorCount, dev);
    hipFuncSetAttribute((const void*)mega, hipFuncAttributeMaxDynamicSharedMemorySize, LDS_BYTES);
    hipOccupancyMaxActiveBlocksPerMultiprocessor(&per_cu, (const void*)mega, NWAVES * 64, LDS_BYTES);
    if (per_cu < 1) { fprintf(stderr, "kernel_launch: occupancy query says %d blocks per CU\n", per_cu); per_cu = 1; }
    if (per_cu > 1) per_cu = 1;
    grid_blocks = cus * per_cu;
  }
  hipMemsetAsync((char*)d_ws + WS_CTL, 0, 64 * 1024, stream);
  Params base{};
  for (int i = 0; i < 26; ++i) base.in[i] = (const float*)d_in[i];
  base.out = (float*)d_out; base.ws = (unsigned char*)d_ws;
  auto launch = [&](int lo, int hi) {
    Params p = base; p.ph_lo = lo; p.ph_hi = hi; p.rep = (int)PROBE_MASK; void* args[] = {&p};
    hipError_t e = hipLaunchCooperativeKernel((const void*)mega, dim3(grid_blocks), dim3(NWAVES * 64), args, LDS_BYTES, stream);
    if (e != hipSuccess) fprintf(stderr, "cooperative launch failed: %s (grid %d)\n", hipGetErrorString(e), grid_blocks);
  };
  launch(0, 17);
}
```

```cpp
#include <hip/hip_runtime.h>
#include <hip/hip_cooperative_groups.h>
#include <stdint.h>
#include <math.h>
#include <cstdio>
namespace cg = cooperative_groups;
#ifndef PROBE_SKIP
#define PROBE_SKIP 0
#endif
#ifndef PROBE_MASK
#define PROBE_MASK 0u
#endif

typedef unsigned short bf16_t;
#define DEV __device__ __forceinline__

DEV float bf2f(bf16_t v) { return __uint_as_float(((unsigned)v) << 16); }
typedef float f32x2_t __attribute__((ext_vector_type(2))); typedef __bf16 bf16x2_t __attribute__((ext_vector_type(2)));
DEV unsigned pk2(float lo, float hi) { const f32x2_t v = {lo, hi}; const bf16x2_t b = __builtin_convertvector(v, bf16x2_t); return __builtin_bit_cast(unsigned, b); }
DEV bf16_t f2bf(float f) { return (bf16_t)(pk2(f, 0.f) & 0xffffu); }
DEV float fexp(float x) { return __builtin_amdgcn_exp2f(x * 1.4426950408889634f); }
DEV float siluf(float x) { return x / (1.f + fexp(-x)); }
DEV float silu_fast(float x) { return x * __builtin_amdgcn_rcpf(1.f + fexp(-x)); }
DEV float softplusf(float x) { return x > 20.f ? x : log1pf(fexp(x)); }
DEV float logsigmoidf(float x) { return fminf(x, 0.f) - log1pf(fexp(-fabsf(x))); }

constexpr int D = 1024, NB = 2, SEQ = 8192, CTXL = 256;
constexpr int ML = NB * SEQ;
constexpr int MC = NB * CTXL;
constexpr int MA = ML + MC;
constexpr int NCH = MA / 128;
constexpr int E_IN = 5696, O_IN = 5120, E_INP = 5888;
constexpr float EPS = 1e-6f;

constexpr size_t MiB = 1u << 20;
constexpr size_t WS_CTL = 0;
constexpr size_t WS_MOD = 1 * MiB;
constexpr size_t WS_ROPE = 1 * MiB + 128 * 1024;
constexpr size_t WS_SDEC = 1 * MiB + 256 * 1024;
constexpr size_t WS_GDEC = 1 * MiB + 384 * 1024;
constexpr size_t WS_W1T = 2 * MiB;
constexpr size_t WS_W2T = 14 * MiB;
constexpr size_t WS_W3T = 18 * MiB;
constexpr size_t WS_W4T = 28 * MiB;
constexpr size_t WS_Y0 = 32 * MiB;
constexpr size_t WS_Q0 = 98 * MiB;
constexpr size_t WS_K0 = WS_Q0 + 16 * MiB + 512 * 1024;
constexpr size_t WS_V0 = 131 * MiB;
constexpr size_t WS_DTLR = 164 * MiB;
constexpr size_t WS_XC1 = 168 * MiB + 512 * 1024;
constexpr size_t WS_XBC = 171 * MiB;
constexpr size_t WS_STATE = 171 * MiB;
constexpr size_t WS_TAIL = 237 * MiB;
constexpr size_t WS_H1 = 32 * MiB;
constexpr size_t WS_K1 = 65 * MiB;
constexpr size_t WS_V1 = 81 * MiB + 512 * 1024;
constexpr size_t WS_Q1 = 98 * MiB;
constexpr size_t WS_G1 = 171 * MiB;

DEV int row_vec(int row) { return row < ML ? (row / SEQ) : 2; }

namespace pg8 {
#define PG8_LAS __attribute__((address_space(3)))
typedef unsigned short bf16_t;
typedef short bf16x8 __attribute__((ext_vector_type(8)));
typedef float f32x4 __attribute__((ext_vector_type(4)));
typedef unsigned u32x4 __attribute__((ext_vector_type(4)));
constexpr int BM = 256, BK = 64, HALF = 128, HTB = HALF * BK * 2  , STAGE_BYTES = 8 * HTB, NXCD = 8, WGM = 8;

__host__ __device__ __forceinline__ int lds_byte(int r, int c) { const int st = (r >> 4) * 2 + (c >> 5), rr = r & 15, cc = c & 31, ob = rr * 64 + cc * 2; return st * 1024 + (ob ^ (((ob >> 9) & 1) << 5)); }
__host__ __device__ __forceinline__ void stage_rc(int b, int& R, int& C) { const int st = b / 1024, sb = b % 1024, swz = sb ^ (((sb >> 9) & 1) << 5); R = (st >> 1) * 16 + swz / 64; C = (st & 1) * 32 + (swz % 64) / 2; }
__host__ __device__ __forceinline__ int perm32(int rho) { const int n = rho >> 4, i = rho & 15; return 8 * (i >> 2) + 4 * n + (i & 3); }

struct Unit { int pm, pn; };
struct Gemm { const bf16_t* A; const bf16_t* Bt; int M, N, K; };

struct StaticOrder {
    int nM, nN, nwg, G, c;
    __host__ __device__ void init(int M, int N, int G_, int c_) { nM = M / BM; nN = N / BM; nwg = nM * nN; G = G_; c = c_; }
    __host__ __device__ bool next(int i, Unit& u) const {
        const long L = (long)i * G + c; if (L >= nwg) return false;
        int wgid = (int)L; { const int q = nwg / NXCD, r = nwg % NXCD, xcd = wgid % NXCD, off = wgid / NXCD; wgid = (xcd < r ? xcd * (q + 1) : r * (q + 1) + (xcd - r) * q) + off; }
        const int nig = WGM * nN, gid = wgid / nig, fm = gid * WGM, gsz = (nM - fm) < WGM ? (nM - fm) : WGM;
        u.pm = fm + ((wgid % nig) % gsz); u.pn = (wgid % nig) / gsz; return true;
    }
    __device__ __forceinline__ void a_ready(const Unit&) const {}
    __device__ __forceinline__ void done(const Unit&) const {}
};
__device__ __forceinline__ unsigned cvt_pk_bf16(float lo, float hi) { unsigned r; asm volatile("v_cvt_pk_bf16_f32 %0, %1, %2" : "=v"(r) : "v"(lo), "v"(hi)); return r; }
__device__ __forceinline__ float silu_e(float x) { return x * __builtin_amdgcn_rcpf(1.f + fexp(-x)); }

__device__ __forceinline__ void store_unit_bf16(const f32x4 (&acc)[2][2][4][2], bf16_t* base, int ld, int colt, bool act, const Unit& u, int wr, int wc, int fr, int fq) {
    const int row0 = u.pm * BM + wr * 64 + fr; const int col0 = colt + wc * 32 + 8 * fq;
#pragma unroll
    for (int ai = 0; ai < 2; ++ai)
#pragma unroll
        for (int m = 0; m < 4; ++m) { bf16_t* rowp = base + (size_t)(row0 + ai * HALF + m * 16) * ld + col0;
#pragma unroll
            for (int bj = 0; bj < 2; ++bj) { f32x4 v0 = acc[ai][bj][m][0], v1 = acc[ai][bj][m][1];
                if (act) { v0 = (f32x4){silu_e(v0[0]), silu_e(v0[1]), silu_e(v0[2]), silu_e(v0[3])}; v1 = (f32x4){silu_e(v1[0]), silu_e(v1[1]), silu_e(v1[2]), silu_e(v1[3])}; }
                u32x4 w; w.x = cvt_pk_bf16(v0[0], v0[1]); w.y = cvt_pk_bf16(v0[2], v0[3]); w.z = cvt_pk_bf16(v1[0], v1[1]); w.w = cvt_pk_bf16(v1[2], v1[3]);
                *(u32x4*)(rowp + bj * HALF) = w; } }
}
struct EpiProj0 {
    static constexpr bool PERM = true, AFTER_DRAIN = false;
    bf16_t *Y0, *XBC, *Q0, *K0, *V0; float* DTLR;
    __device__ __forceinline__ void operator()(const f32x4 (&acc)[2][2][4][2], const Unit& u, int wr, int wc, int fr, int fq) const {
        const int pn = u.pn;
        if (pn == 22) {
            if (wc < 2) { const int row0 = u.pm * BM + wr * 64 + fr;
#pragma unroll
                for (int ai = 0; ai < 2; ++ai)
#pragma unroll
                    for (int m = 0; m < 4; ++m) { float* rp = DTLR + (size_t)(row0 + ai * HALF + m * 16) * 64 + wc * 32 + 8 * fq; *(f32x4*)rp = acc[ai][0][m][0]; *(f32x4*)(rp + 4) = acc[ai][0][m][1]; } }
            return;
        }
        bf16_t* base; int ld, colt; bool act = false;
        if (pn < 8) { base = Y0; ld = 2048; colt = pn * 256; act = true; }
        else if (pn < 14) { base = XBC; ld = 1536; colt = (pn - 8) * 256; }
        else if (pn < 16) { base = Q0; ld = 512; colt = (pn - 14) * 256; }
        else if (pn < 18) { base = K0; ld = 512; colt = (pn - 16) * 256; }
        else { base = V0; ld = 1024; colt = (pn - 18) * 256; }
        store_unit_bf16(acc, base, ld, colt, act, u, wr, wc, fr, fq);
    }
};
struct EpiProj1 {
    static constexpr bool PERM = true, AFTER_DRAIN = false;
    bf16_t *K1, *V1, *Q1, *G1;
    __device__ __forceinline__ void operator()(const f32x4 (&acc)[2][2][4][2], const Unit& u, int wr, int wc, int fr, int fq) const {
        const int pn = u.pn; bf16_t* base; int ld, colt; bool act = false;
        if (pn < 2) { base = K1; ld = 512; colt = pn * 256; }
        else if (pn < 4) { base = V1; ld = 512; colt = (pn - 2) * 256; }
        else if (pn < 12) { base = Q1; ld = 2048; colt = (pn - 4) * 256; }
        else { base = G1; ld = 2048; colt = (pn - 12) * 256; act = true; }
        store_unit_bf16(acc, base, ld, colt, act, u, wr, wc, fr, fq);
    }
};
struct EpiResid {
    static constexpr bool PERM = false, AFTER_DRAIN = false;
    const float* res; float* out; const float* mod; bool do_store;
    __device__ __forceinline__ void operator()(const f32x4 (&acc)[2][2][4][2], const Unit& u, int wr, int wc, int fr, int fq) const {
        const int b = (u.pm * BM) / 8192; const float* gate = mod + b * 3072 + 2048;
        const int col0 = u.pn * BM + wc * 32 + 4 * fq;
        f32x4 gv[2][2];
#pragma unroll
        for (int bj = 0; bj < 2; ++bj)
#pragma unroll
            for (int n = 0; n < 2; ++n) gv[bj][n] = *(const f32x4*)(gate + col0 + bj * HALF + n * 16);
#pragma unroll
        for (int ai = 0; ai < 2; ++ai)
#pragma unroll
            for (int m = 0; m < 4; ++m) { const size_t off = (size_t)(u.pm * BM + ai * HALF + wr * 64 + m * 16 + fr) * 1024 + col0;
#pragma unroll
                for (int bj = 0; bj < 2; ++bj)
#pragma unroll
                    for (int n = 0; n < 2; ++n) { const f32x4 r = *(const f32x4*)(res + off + bj * HALF + n * 16); const f32x4 ov_ = r + gv[bj][n] * acc[ai][bj][m][n]; if (do_store) *(f32x4*)(out + off + bj * HALF + n * 16) = ov_; } }
    }
};
template <class Epi, class Sched, bool ALIGN_EPI = false, bool SP2 = false>
__device__ __forceinline__ void gemm_phase(PG8_LAS unsigned char* lds, const Gemm g, const Sched& S, const Epi& E) {
    const int tid = threadIdx.x, wid = __builtin_amdgcn_readfirstlane(tid >> 6), lane = tid & 63, wr = wid >> 2, wc = wid & 3, fr = lane & 15, fq = lane >> 4;
    const int K = g.K, nt = K / BK;
    unsigned voffA[2], voffB[2];
#pragma unroll
    for (int i = 0; i < 2; ++i) { int R, C; stage_rc(tid * 16 + i * 8192, R, C); const int Rb = Epi::PERM ? ((R & ~31) + perm32(R & 31)) : R;
        voffA[i] = (unsigned)(R * K + C) * 2u; voffB[i] = (unsigned)(Rb * K + C) * 2u; }
    const size_t kstep = (size_t)(BK * 2);
    const size_t hstep = (size_t)HALF * K * 2;
    const size_t tstep = 2 * hstep;
    const unsigned ldsw = (unsigned)wid * 1024u;
    const int aoff = lds_byte(wr * 64 + fr, fq * 8), boff = lds_byte(wc * 32 + fr, fq * 8);
#define PG8_SA(b, h) (((b) * 2 + (h)) * HTB)
#define PG8_SB(b, h) ((4 + (b) * 2 + (h)) * HTB)
#define PG8_STAGE(bufoff, gbase, voff) do { _Pragma("unroll") for (int _i = 0; _i < 2; ++_i) \
        __builtin_amdgcn_global_load_lds((const unsigned*)((const char*)(gbase) + (voff)[_i]), (PG8_LAS unsigned*)(lds + (bufoff) + ldsw + _i * 8192), 16, 0, 0); } while (0)
#define PG8_LDA(dst, b, h) do { _Pragma("unroll") for (int m = 0; m < 4; ++m) _Pragma("unroll") for (int k = 0; k < 2; ++k) dst[m][k] = *(const PG8_LAS bf16x8*)(lds + PG8_SA(b, h) + aoff + m * 2048 + k * 1024); } while (0)
#define PG8_LDB(dst, b, h) do { _Pragma("unroll") for (int n = 0; n < 2; ++n) _Pragma("unroll") for (int k = 0; k < 2; ++k) dst[n][k] = *(const PG8_LAS bf16x8*)(lds + PG8_SB(b, h) + boff + n * 2048 + k * 1024); } while (0)
#define PG8_MMA(ai, bj, At, Bt) do { __builtin_amdgcn_s_setprio(1); _Pragma("unroll") for (int m = 0; m < 4; ++m) _Pragma("unroll") for (int n = 0; n < 2; ++n) _Pragma("unroll") for (int k = 0; k < 2; ++k) \
        acc[ai][bj][m][n] = __builtin_amdgcn_mfma_f32_16x16x32_bf16(Bt[n][k], At[m][k], acc[ai][bj][m][n], 0, 0, 0); __builtin_amdgcn_s_setprio(0); } while (0)
#define PG8_WAIT_V(n) asm volatile("s_waitcnt vmcnt(" #n ")" ::: "memory")
#define PG8_WAIT_L(n) asm volatile("s_waitcnt lgkmcnt(" #n ")" ::: "memory")
#define PG8_BAR __builtin_amdgcn_s_barrier()
#define PG8_SCHED __builtin_amdgcn_sched_barrier(0)
    Unit cur, nxt; int ui = 0;
    if (!S.next(0, cur)) return;
    f32x4 acc[2][2][4][2];
#pragma unroll
    for (int a = 0; a < 2; ++a)
#pragma unroll
        for (int b = 0; b < 2; ++b)
#pragma unroll
            for (int m = 0; m < 4; ++m)
#pragma unroll
                for (int n = 0; n < 2; ++n) acc[a][b][m][n] = (f32x4){0.f, 0.f, 0.f, 0.f};
    bf16x8 At[4][2], B0[2][2], B1[2][2];
    const char* cA = (const char*)g.A + (size_t)cur.pm * tstep; const char* cB = (const char*)g.Bt + (size_t)cur.pn * tstep;
    S.a_ready(cur);
    if constexpr (SP2) {
        PG8_STAGE(PG8_SB(0, 0), cB, voffB); PG8_STAGE(PG8_SB(0, 1), cB + hstep, voffB); PG8_STAGE(PG8_SA(0, 0), cA, voffA); PG8_STAGE(PG8_SA(0, 1), cA + hstep, voffA);
        if (wr == 1) PG8_BAR;
        PG8_WAIT_V(2); PG8_BAR;
        PG8_STAGE(PG8_SB(1, 0), cB + kstep, voffB); PG8_STAGE(PG8_SA(1, 0), cA + kstep, voffA); PG8_STAGE(PG8_SB(1, 1), cB + hstep + kstep, voffB);
        PG8_WAIT_V(6); PG8_BAR;
    } else {
        PG8_STAGE(PG8_SB(0, 0), cB, voffB); PG8_STAGE(PG8_SA(0, 0), cA, voffA); PG8_STAGE(PG8_SB(0, 1), cB + hstep, voffB); PG8_STAGE(PG8_SA(0, 1), cA + hstep, voffA);
        if (wr == 1) PG8_BAR;
        PG8_WAIT_V(4); PG8_BAR;
        PG8_STAGE(PG8_SB(1, 0), cB + kstep, voffB); PG8_STAGE(PG8_SA(1, 0), cA + kstep, voffA); PG8_STAGE(PG8_SB(1, 1), cB + hstep + kstep, voffB);
        PG8_WAIT_V(6); PG8_BAR;
    }
    for (;;) {
        const bool has_next = S.next(ui + 1, nxt);
        const char* nA = has_next ? (const char*)g.A + (size_t)nxt.pm * tstep : cA; const char* nB = has_next ? (const char*)g.Bt + (size_t)nxt.pn * tstep : cB;
        for (int t = 0; t < nt; t += 2) {
            const bool last = (t == nt - 2);
            const char* a1 = cA + (size_t)(t + 1) * kstep;
            const char* a2 = last ? nA : cA + (size_t)(t + 2) * kstep; const char* b2 = last ? nB : cB + (size_t)(t + 2) * kstep;
            const char* a3 = a2 + kstep; const char* b3 = b2 + kstep;
            if (last && has_next) S.a_ready(nxt);
            if constexpr (SP2) {
            PG8_LDB(B0, 0, 0); PG8_LDB(B1, 0, 1); PG8_SCHED; PG8_LDA(At, 0, 0); PG8_STAGE(PG8_SA(1, 1), a1 + hstep, voffA);
            PG8_WAIT_V(8); PG8_WAIT_L(0); PG8_BAR; PG8_MMA(0, 0, At, B0); PG8_MMA(0, 1, At, B1); PG8_BAR; PG8_SCHED;
            PG8_LDA(At, 0, 1); PG8_STAGE(PG8_SB(0, 0), b2, voffB); PG8_STAGE(PG8_SB(0, 1), b2 + hstep, voffB); PG8_STAGE(PG8_SA(0, 0), a2, voffA);
            PG8_WAIT_V(8); PG8_WAIT_L(0); PG8_BAR; PG8_MMA(1, 0, At, B0); PG8_MMA(1, 1, At, B1); PG8_BAR; PG8_SCHED;
            PG8_LDB(B0, 1, 0); PG8_LDB(B1, 1, 1); PG8_SCHED; PG8_LDA(At, 1, 0); PG8_STAGE(PG8_SA(0, 1), a2 + hstep, voffA);
            PG8_WAIT_V(8); PG8_WAIT_L(0); PG8_BAR; PG8_MMA(0, 0, At, B0); PG8_MMA(0, 1, At, B1); PG8_BAR; PG8_SCHED;
            PG8_LDA(At, 1, 1); PG8_STAGE(PG8_SB(1, 0), b3, voffB); PG8_STAGE(PG8_SB(1, 1), b3 + hstep, voffB); PG8_STAGE(PG8_SA(1, 0), a3, voffA);
            PG8_WAIT_V(8); PG8_WAIT_L(0); PG8_BAR; PG8_MMA(1, 0, At, B0); PG8_MMA(1, 1, At, B1); PG8_BAR; PG8_SCHED;
            } else {
            PG8_LDB(B0, 0, 0); PG8_SCHED; PG8_LDA(At, 0, 0); PG8_STAGE(PG8_SA(1, 1), a1 + hstep, voffA);
            PG8_WAIT_L(8); PG8_BAR; PG8_WAIT_L(0); PG8_MMA(0, 0, At, B0); PG8_BAR; PG8_SCHED;
            PG8_LDB(B1, 0, 1); PG8_STAGE(PG8_SB(0, 0), b2, voffB);
            PG8_BAR; PG8_WAIT_L(0); PG8_MMA(0, 1, At, B1); PG8_BAR;
            PG8_LDA(At, 0, 1); PG8_STAGE(PG8_SA(0, 0), a2, voffA);
            PG8_BAR; PG8_WAIT_L(0); PG8_MMA(1, 0, At, B0); PG8_BAR; PG8_SCHED;
            PG8_STAGE(PG8_SB(0, 1), b2 + hstep, voffB);
            PG8_WAIT_V(6); PG8_BAR; PG8_MMA(1, 1, At, B1); PG8_BAR;
            PG8_LDB(B0, 1, 0); PG8_SCHED; PG8_LDA(At, 1, 0); PG8_STAGE(PG8_SA(0, 1), a2 + hstep, voffA);
            PG8_WAIT_L(8); PG8_BAR; PG8_WAIT_L(0); PG8_MMA(0, 0, At, B0); PG8_BAR; PG8_SCHED;
            PG8_LDB(B1, 1, 1); PG8_STAGE(PG8_SB(1, 0), b3, voffB);
            PG8_BAR; PG8_WAIT_L(0); PG8_MMA(0, 1, At, B1); PG8_BAR;
            PG8_LDA(At, 1, 1); PG8_STAGE(PG8_SA(1, 0), a3, voffA);
            PG8_BAR; PG8_WAIT_L(0); PG8_MMA(1, 0, At, B0); PG8_BAR; PG8_SCHED;
            PG8_STAGE(PG8_SB(1, 1), b3 + hstep, voffB);
            PG8_WAIT_V(6); PG8_BAR; PG8_MMA(1, 1, At, B1); PG8_BAR;
            }
        }
        if constexpr (ALIGN_EPI) { if (wr == 0) PG8_BAR; }
        if constexpr (!Epi::AFTER_DRAIN) { E(acc, cur, wr, wc, fr, fq); S.done(cur); }
        if (!has_next) break;
#pragma unroll
        for (int a = 0; a < 2; ++a)
#pragma unroll
            for (int b = 0; b < 2; ++b)
#pragma unroll
                for (int m = 0; m < 4; ++m)
#pragma unroll
                    for (int n = 0; n < 2; ++n) acc[a][b][m][n] = (f32x4){0.f, 0.f, 0.f, 0.f};
        cur = nxt; cA = nA; cB = nB; ++ui;
        if constexpr (ALIGN_EPI) { if (wr == 1) PG8_BAR; }
    }
    PG8_WAIT_V(0);
    if constexpr (!ALIGN_EPI) { if (wr == 0) PG8_BAR; }
    PG8_BAR;
    if constexpr (Epi::AFTER_DRAIN) { E.fused(acc, cur, wr, wc, fr, fq, lds, wid, lane); S.done(cur); }
#undef PG8_SA
#undef PG8_SB
#undef PG8_STAGE
#undef PG8_LDA
#undef PG8_LDB
#undef PG8_MMA
#undef PG8_WAIT_V
#undef PG8_WAIT_L
#undef PG8_BAR
#undef PG8_SCHED
}
}
#define LAS __attribute__((address_space(3)))
typedef unsigned v4u __attribute__((ext_vector_type(4)));
typedef float f32x4 __attribute__((ext_vector_type(4)));
typedef short bf16x8 __attribute__((ext_vector_type(8)));
#define LDS_WAIT() asm volatile("s_waitcnt lgkmcnt(0)" ::: "memory")
constexpr int NWAVES = 8;
constexpr int LDS_BYTES = 147456;
constexpr int MISC_OFF = 147456 - 128;

struct Params { const float* in[26]; float* out; unsigned char* ws; int ph_lo, ph_hi, rep, pad; };

DEV int virt_block() { const int G = (int)gridDim.x, b = (int)blockIdx.x; return (G % 8 == 0) ? (b % 8) * (G / 8) + b / 8 : b; }
DEV float wave_sum(float v) {
#pragma unroll
  for (int o = 1; o < 64; o <<= 1) v += __shfl_xor(v, o);
  return v;
}

DEV int w1_dest_row(int n) {
  if (n < 1024) return n;
  if (n < 2560) return 2048 + (n - 1024);
  if (n < 2592) return 5632 + (n - 2560);
  if (n < 3104) return 3584 + (n - 2592);
  if (n < 3616) return 4096 + (n - 3104);
  if (n < 4640) return 4608 + (n - 3616);
  if (n < 5664) return 1024 + (n - 4640);
  return n;
}
DEV void transpose_item(const float* W, int K, int N, int k0, int n0, bf16_t* WT, int drow0, LAS float* scr, int lane) {
#pragma unroll 8
  for (int i = 0; i < 32; ++i) { const int kk = 2 * i + (lane >> 5); scr[kk * 33 + (lane & 31)] = W[(size_t)(k0 + kk) * N + n0 + (lane & 31)]; }
  LDS_WAIT(); asm volatile("" ::: "memory");
  const int c = lane & 7;
#pragma unroll
  for (int j = 0; j < 4; ++j) { const int n = (lane >> 3) + 8 * j; const LAS float* s = scr + (8 * c) * 33 + n;
    v4u o; o.x = pk2(s[0 * 33], s[1 * 33]); o.y = pk2(s[2 * 33], s[3 * 33]); o.z = pk2(s[4 * 33], s[5 * 33]); o.w = pk2(s[6 * 33], s[7 * 33]);
    *(v4u*)(WT + (size_t)(drow0 + n) * K + k0 + 8 * c) = o; }
  LDS_WAIT(); asm volatile("" ::: "memory");
}
DEV void prologue_phase(const Params& p, LAS unsigned char* lds) {
  const int tid = threadIdx.x, lane = tid & 63, wave = tid >> 6;
  unsigned char* ws = p.ws;
  float* MOD = (float*)(ws + WS_MOD);
  {
    LAS float* sc = (LAS float*)lds;
    LAS float* part = (LAS float*)(lds + 12288);
    for (int i = tid; i < 3072; i += 512) { const int v = i >> 10, k = i & 1023; const float cv = v < 2 ? p.in[1][v * 1024 + k] : p.in[3][k]; sc[i] = siluf(cv); }
    __syncthreads();
    for (int task = blockIdx.x; task < 96; task += gridDim.x) {
      const int l = task / 48, n0 = (task % 48) * 64; const float* w = l ? p.in[19] : p.in[5]; const float* bb = l ? p.in[20] : p.in[6];
      const int col = tid & 63, ks = tid >> 6;
      float a0 = 0.f, a1 = 0.f, a2 = 0.f;
#pragma unroll 8
      for (int k = ks * 128; k < ks * 128 + 128; ++k) { const float wv = w[(size_t)k * 3072 + n0 + col]; a0 += sc[k] * wv; a1 += sc[1024 + k] * wv; a2 += sc[2048 + k] * wv; }
      part[(ks * 3 + 0) * 64 + col] = a0; part[(ks * 3 + 1) * 64 + col] = a1; part[(ks * 3 + 2) * 64 + col] = a2;
      __syncthreads();
      if (tid < 192) { const int v = tid >> 6; float s = bb[n0 + col];
#pragma unroll
        for (int q = 0; q < 8; ++q) s += part[(q * 3 + v) * 64 + col];
        MOD[(l * 3 + v) * 3072 + n0 + col] = s; }
      __syncthreads();
    }
  }
  if (blockIdx.x == gridDim.x - 1) { float* rope = (float*)(ws + WS_ROPE);
    for (int idx = tid; idx < 4096; idx += 512) { const int pos = idx >> 5, f = idx & 31; const float inv = 1.0f / powf(10000.f, (float)f / 32.f); const float ang = (float)pos * inv; rope[idx] = cosf(ang); rope[4096 + idx] = sinf(ang); } }
  { v4u* z = (v4u*)(ws + WS_W1T + (size_t)E_IN * 1024 * 2); const v4u zero = {0u, 0u, 0u, 0u};
    for (int i = blockIdx.x * 512 + tid; i < (E_INP - E_IN) * 1024 * 2 / 16; i += gridDim.x * 512) z[i] = zero; }
  __syncthreads();
  {
    LAS float* scr = (LAS float*)(lds + wave * 16384);
    const int gw = blockIdx.x * NWAVES + wave, NGW = gridDim.x * NWAVES;
    constexpr int I1 = 16 * 178;
    for (int it = gw; it < I1; it += NGW) { const int kb = it / 178, nb = it % 178; transpose_item(p.in[7], 1024, E_IN, 64 * kb, 32 * nb, (bf16_t*)(ws + WS_W1T), w1_dest_row(32 * nb), scr, lane); }
  }
}
DEV void late_weights(const Params& p, LAS unsigned char* lds, int vblock, int nvblocks) {
  const int lane = threadIdx.x & 63, wave = threadIdx.x >> 6; unsigned char* ws = p.ws;
  LAS float* scr = (LAS float*)(lds + wave * 16384);
  constexpr int I2 = 32 * 32, I3 = 16 * 160, I4 = 32 * 32;
  for (int it = vblock * NWAVES + wave; it < I2 + I3 + I4; it += nvblocks * NWAVES) {
    int r = it;
    if (r < I2) { const int kb = r / 32, nb = r % 32; transpose_item(p.in[17], 2048, 1024, 64 * kb, 32 * nb, (bf16_t*)(ws + WS_W2T), 32 * nb, scr, lane); continue; } r -= I2;
    if (r < I3) { const int kb = r / 160, nb = r % 160; transpose_item(p.in[21], 1024, O_IN, 64 * kb, 32 * nb, (bf16_t*)(ws + WS_W3T), 32 * nb, scr, lane); continue; } r -= I3;
    { const int kb = r / 32, nb = r % 32; transpose_item(p.in[25], 2048, 1024, 64 * kb, 32 * nb, (bf16_t*)(ws + WS_W4T), 32 * nb, scr, lane); }
  }
}
DEV void prep_phase(const float* xlat, const float* xctx, const float* g, const float* mod, bf16_t* H) {
  const int lane = threadIdx.x & 63, wave = threadIdx.x >> 6;
  for (int row = blockIdx.x * NWAVES + wave; row < MA; row += gridDim.x * NWAVES) {
    const float* src = row < ML ? xlat + (size_t)row * D : xctx + (size_t)(row - ML) * D;
    const float* m = mod + row_vec(row) * 3072;
    f32x4 v[4]; float ss = 0.f;
#pragma unroll
    for (int j = 0; j < 4; ++j) { v[j] = *(const f32x4*)(src + 4 * lane + 256 * j); ss += (v[j].x * v[j].x + v[j].y * v[j].y) + (v[j].z * v[j].z + v[j].w * v[j].w); }
    const float rstd = rsqrtf(wave_sum(ss) * (1.f / D) + EPS);
#pragma unroll
    for (int j = 0; j < 4; ++j) { const int k = 4 * lane + 256 * j;
      const f32x4 gg = *(const f32x4*)(g + k), sc = *(const f32x4*)(m + 1024 + k), sh = *(const f32x4*)(m + k);
      const f32x4 o = v[j] * rstd * gg * (sc + 1.f) + sh;
      *(unsigned long long*)(H + (size_t)row * D + k) = (unsigned long long)pk2(o.x, o.y) | ((unsigned long long)pk2(o.z, o.w) << 32); }
  }
}
template <class F> DEV void small_gemm(const bf16_t* A, int lda, const bf16_t* Bt, int ldb, int K, int Mrows, int Ncols, F f) {
  const int lane = threadIdx.x & 63, wid = threadIdx.x >> 6, mt = wid >> 2, nt = wid & 3, r = lane & 15, q = lane >> 4;
  const int ntn = Ncols / 64, ntasks = (Mrows / 32) * ntn;
  for (int task = blockIdx.x; task < ntasks; task += gridDim.x) {
    const int row0 = (task / ntn) * 32 + mt * 16, col0 = (task % ntn) * 64 + nt * 16;
    const bf16_t* ap = A + (size_t)(row0 + r) * lda + 8 * q; const bf16_t* bp = Bt + (size_t)(col0 + r) * ldb + 8 * q;
    f32x4 acc = {0.f, 0.f, 0.f, 0.f};
#pragma unroll 8
    for (int k = 0; k < K; k += 32) { const bf16x8 a = *(const bf16x8*)(ap + k), b = *(const bf16x8*)(bp + k); acc = __builtin_amdgcn_mfma_f32_16x16x32_bf16(a, b, acc, 0, 0, 0); }
#pragma unroll
    for (int j = 0; j < 4; ++j) f(row0 + q * 4 + j, col0 + r, acc[j]);
  }
}

DEV void qknorm_phase(bf16_t* Q1, bf16_t* K1, const float* qn, const float* kn, const float* rope, bool wr) {
  const int lane = threadIdx.x & 63, wave = threadIdx.x >> 6, hl = lane >> 4, d0 = (lane & 15) * 8;
  const float scale = 0.08838834764831845f * 1.4426950408889634f;
  float gq[8], gk[8];
#pragma unroll
  for (int e = 0; e < 8; ++e) { gq[e] = qn[d0 + e] * scale; gk[e] = kn[d0 + e]; }
  const int ax = d0 >> 6, sgn = (d0 >> 5) & 1, f0 = d0 & 31;
  for (int row = blockIdx.x * NWAVES + wave; row < MA; row += gridDim.x * NWAVES) {
    const bool lat = row < ML;
    v4u raw[5];
    raw[0] = *(const v4u*)(K1 + (size_t)row * 512 + hl * 128 + d0);
    if (lat) {
#pragma unroll
      for (int g = 0; g < 4; ++g) raw[1 + g] = *(const v4u*)(Q1 + (size_t)row * 2048 + (g * 4 + hl) * 128 + d0);
    }
    float cs[8], sn[8];
    if (lat) { const int t = row % SEQ, pos = ax ? (t & 63) : (t >> 6);
      const f32x4 c0 = *(const f32x4*)(rope + pos * 32 + f0), c1 = *(const f32x4*)(rope + pos * 32 + f0 + 4), s0 = *(const f32x4*)(rope + 4096 + pos * 32 + f0), s1 = *(const f32x4*)(rope + 4096 + pos * 32 + f0 + 4);
      cs[0] = c0.x; cs[1] = c0.y; cs[2] = c0.z; cs[3] = c0.w; cs[4] = c1.x; cs[5] = c1.y; cs[6] = c1.z; cs[7] = c1.w;
      sn[0] = s0.x; sn[1] = s0.y; sn[2] = s0.z; sn[3] = s0.w; sn[4] = s1.x; sn[5] = s1.y; sn[6] = s1.z; sn[7] = s1.w; }
    const int ng = lat ? 5 : 1;
#pragma unroll
    for (int g = 0; g < 5; ++g) {
      if (g < ng) {
        const v4u rv = raw[g];
        float v[8] = {__uint_as_float(rv.x << 16), __uint_as_float(rv.x & 0xffff0000u), __uint_as_float(rv.y << 16), __uint_as_float(rv.y & 0xffff0000u), __uint_as_float(rv.z << 16), __uint_as_float(rv.z & 0xffff0000u), __uint_as_float(rv.w << 16), __uint_as_float(rv.w & 0xffff0000u)};
        float ss = 0.f;
#pragma unroll
        for (int e = 0; e < 8; ++e) ss += v[e] * v[e];
        ss += __shfl_xor(ss, 1); ss += __shfl_xor(ss, 2); ss += __shfl_xor(ss, 4); ss += __shfl_xor(ss, 8);
        const float rstd = rsqrtf(ss * (1.f / 128.f) + EPS);
#pragma unroll
        for (int e = 0; e < 8; ++e) v[e] *= rstd * (g == 0 ? gk[e] : gq[e]);
        if (lat) {
#pragma unroll
          for (int e = 0; e < 8; ++e) { const float o = __shfl_xor(v[e], 4); v[e] = sgn ? (v[e] * cs[e] + o * sn[e]) : (v[e] * cs[e] - o * sn[e]); }
        }
        v4u ov; ov.x = pk2(v[0], v[1]); ov.y = pk2(v[2], v[3]); ov.z = pk2(v[4], v[5]); ov.w = pk2(v[6], v[7]);
        if (wr) { if (g == 0) *(v4u*)(K1 + (size_t)row * 512 + hl * 128 + d0) = ov; else *(v4u*)(Q1 + (size_t)row * 2048 + ((g - 1) * 4 + hl) * 128 + d0) = ov; }
      }
    }
  }
}
typedef short s16x4 __attribute__((ext_vector_type(4)));
DEV s16x4 tr_read(const LAS bf16_t* p) { return __builtin_bit_cast(s16x4, __builtin_amdgcn_ds_read_tr16_b64_v4i16((LAS s16x4*)p)); }
DEV void attn_phase(bf16_t* Q1, const bf16_t* K1, const bf16_t* V1, const bf16_t* G1, const float* sink, const float* qn, const float* kn, LAS unsigned char* lds, bool wr) {
  constexpr int KP = 136, VP = 144;
  LAS bf16_t* Ks = (LAS bf16_t*)lds;
  LAS bf16_t* Vs = (LAS bf16_t*)(lds + 2 * 64 * KP * 2);
  LAS float* dsc = (LAS float*)(lds + 2 * 64 * KP * 2 + 2 * 64 * VP * 2);
  const int tid = threadIdx.x, lane = tid & 63, wid = tid >> 6, r = lane & 15, Qd = lane >> 4;
  float mb;
  { float a = fmaxf(fabsf(qn[lane]), fabsf(qn[64 + lane])), b = fmaxf(fabsf(kn[lane]), fabsf(kn[64 + lane]));
#pragma unroll
    for (int o = 1; o < 64; o <<= 1) { a = fmaxf(a, __shfl_xor(a, o)); b = fmaxf(b, __shfl_xor(b, o)); }
    mb = a * b * 11.313708498984761f * 1.4426950408889634f; }
  for (int task = virt_block(); task < 1024; task += gridDim.x) {
    const int b = task >> 9, kvh = (task >> 7) & 3, qt = task & 127;
    const int hq = kvh * 4 + (wid >> 1), qoff = (wid & 1) * 32;
    const size_t qrow0 = (size_t)b * SEQ + qt * 64 + qoff;
    bf16x8 qf[2][4];
#pragma unroll
    for (int m = 0; m < 2; ++m)
#pragma unroll
      for (int ks = 0; ks < 4; ++ks) qf[m][ks] = *(const bf16x8*)(Q1 + (qrow0 + 16 * m + r) * 2048 + hq * 128 + ks * 32 + 8 * Qd);
    const int tlo = (2 - qt) > 0 ? (2 - qt) : 0, thi = (129 - qt) < 4 ? (129 - qt) : 4, nband = thi - tlo + 1, ntile = nband + 4;
    const int skey = tid >> 4, sch = tid & 15;
    v4u kreg[2], vreg[2];
#define TILE_ROW0(i) ((i) < nband ? (size_t)b * SEQ + (size_t)(qt - 2 + tlo + (i)) * 64 : (size_t)ML + b * CTXL + ((i) - nband) * 64)
#define LOAD_TILE(i) do { const size_t r0_ = TILE_ROW0(i); _Pragma("unroll") for (int h_ = 0; h_ < 2; ++h_) { const size_t go_ = (r0_ + skey + 32 * h_) * 512 + kvh * 128 + sch * 8; kreg[h_] = *(const v4u*)(K1 + go_); vreg[h_] = *(const v4u*)(V1 + go_); } } while (0)
#define STORE_TILE(buf) do { _Pragma("unroll") for (int h_ = 0; h_ < 2; ++h_) { *(LAS v4u*)(Ks + (buf) * 64 * KP + (skey + 32 * h_) * KP + sch * 8) = kreg[h_]; *(LAS v4u*)(Vs + (buf) * 64 * VP + (skey + 32 * h_) * VP + sch * 8) = vreg[h_]; } } while (0)
    LOAD_TILE(0);
    __syncthreads();
    STORE_TILE(0);
    __syncthreads();
    f32x4 o[2][8];
#pragma unroll
    for (int m = 0; m < 2; ++m)
#pragma unroll
      for (int n = 0; n < 8; ++n) o[m][n] = (f32x4){0.f, 0.f, 0.f, 0.f};
    float lsum[2] = {0.f, 0.f};
    for (int i = 0; i < ntile; ++i) {
      const int buf = i & 1;
      if (i + 1 < ntile) LOAD_TILE(i + 1);
      const int mtype = (i < nband) ? ((tlo + i) == 0 ? 1 : ((tlo + i) == 4 ? 2 : 0)) : 0;
      const LAS bf16_t* Kb = Ks + buf * 64 * KP; const LAS bf16_t* Vb = Vs + buf * 64 * VP;
      f32x4 s[4][2];
#pragma unroll
      for (int t = 0; t < 4; ++t) { s[t][0] = (f32x4){-mb, -mb, -mb, -mb}; s[t][1] = (f32x4){-mb, -mb, -mb, -mb}; }
#pragma unroll
      for (int ks = 0; ks < 4; ++ks)
#pragma unroll
        for (int t = 0; t < 4; ++t) { const bf16x8 kf = *(const LAS bf16x8*)(Kb + (16 * t + r) * KP + ks * 32 + 8 * Qd);
          s[t][0] = __builtin_amdgcn_mfma_f32_16x16x32_bf16(kf, qf[0][ks], s[t][0], 0, 0, 0);
          s[t][1] = __builtin_amdgcn_mfma_f32_16x16x32_bf16(kf, qf[1][ks], s[t][1], 0, 0, 0); }
      bf16x8 pa[2][2];
#pragma unroll
      for (int m = 0; m < 2; ++m) { const int qi = qoff + 16 * m + r;
#pragma unroll
        for (int t = 0; t < 4; ++t) {
          float pv[4];
#pragma unroll
          for (int j = 0; j < 4; ++j) { const int kj = 16 * t + 4 * Qd + j; float pj = __builtin_amdgcn_exp2f(s[t][m][j]);
            if (mtype != 0) { if (mtype == 1) pj = (kj >= qi) ? pj : 0.f; else pj = (kj <= qi) ? pj : 0.f; }
            pv[j] = pj; lsum[m] += pj; }
          const unsigned w0 = pk2(pv[0], pv[1]), w1 = pk2(pv[2], pv[3]);
          pa[m][t >> 1][(t & 1) * 4 + 0] = (short)(w0 & 0xffff); pa[m][t >> 1][(t & 1) * 4 + 1] = (short)(w0 >> 16);
          pa[m][t >> 1][(t & 1) * 4 + 2] = (short)(w1 & 0xffff); pa[m][t >> 1][(t & 1) * 4 + 3] = (short)(w1 >> 16); } }
#pragma unroll
      for (int k2 = 0; k2 < 2; ++k2)
#pragma unroll
        for (int n = 0; n < 8; ++n) {
          const s16x4 lo = tr_read(Vb + (32 * k2 + 4 * Qd + (r >> 2)) * VP + 16 * n + 4 * (r & 3));
          const s16x4 hi = tr_read(Vb + (32 * k2 + 16 + 4 * Qd + (r >> 2)) * VP + 16 * n + 4 * (r & 3));
          const bf16x8 vf = (bf16x8){lo[0], lo[1], lo[2], lo[3], hi[0], hi[1], hi[2], hi[3]};
          o[0][n] = __builtin_amdgcn_mfma_f32_16x16x32_bf16(pa[0][k2], vf, o[0][n], 0, 0, 0);
          o[1][n] = __builtin_amdgcn_mfma_f32_16x16x32_bf16(pa[1][k2], vf, o[1][n], 0, 0, 0); }
      if (i + 1 < ntile) STORE_TILE(buf ^ 1);
      __syncthreads();
    }
#undef TILE_ROW0
#undef LOAD_TILE
#undef STORE_TILE
    const float sk = __builtin_amdgcn_exp2f(sink[hq] * 1.4426950408889634f - mb);
#pragma unroll
    for (int m = 0; m < 2; ++m) { float l = lsum[m]; l += __shfl_xor(l, 16); l += __shfl_xor(l, 32); if (Qd == 0) dsc[wid * 32 + 16 * m + r] = 1.f / (l + sk); }
    LDS_WAIT(); asm volatile("" ::: "memory");
    { LAS bf16_t* stg = (LAS bf16_t*)lds + wid * 32 * 136;
#pragma unroll
      for (int m = 0; m < 2; ++m)
#pragma unroll
        for (int j = 0; j < 4; ++j) { const float inv = dsc[wid * 32 + 16 * m + 4 * Qd + j];
#pragma unroll
          for (int n = 0; n < 8; ++n) stg[(16 * m + 4 * Qd + j) * 136 + 16 * n + r] = f2bf(o[m][n][j] * inv); }
      LDS_WAIT(); asm volatile("" ::: "memory");
#pragma unroll
      for (int q = 0; q < 8; ++q) { const int c = lane + 64 * q, rowl = c >> 4, ch = c & 15; const size_t go = (qrow0 + rowl) * 2048 + hq * 128 + ch * 8;
        const v4u ov = *(const LAS v4u*)(stg + rowl * 136 + ch * 8), gv = *(const v4u*)(G1 + go);
        v4u w; w.x = pk2(__uint_as_float(ov.x << 16) * __uint_as_float(gv.x << 16), __uint_as_float(ov.x & 0xffff0000u) * __uint_as_float(gv.x & 0xffff0000u));
        w.y = pk2(__uint_as_float(ov.y << 16) * __uint_as_float(gv.y << 16), __uint_as_float(ov.y & 0xffff0000u) * __uint_as_float(gv.y & 0xffff0000u));
        w.z = pk2(__uint_as_float(ov.z << 16) * __uint_as_float(gv.z << 16), __uint_as_float(ov.z & 0xffff0000u) * __uint_as_float(gv.z & 0xffff0000u));
        w.w = pk2(__uint_as_float(ov.w << 16) * __uint_as_float(gv.w << 16), __uint_as_float(ov.w & 0xffff0000u) * __uint_as_float(gv.w & 0xffff0000u));
        if (wr) *(v4u*)(Q1 + go) = w; }
      LDS_WAIT(); asm volatile("" ::: "memory"); }
  }
}

constexpr size_t DO_SDT = 50 * MiB, DO_SCS = 53 * MiB;
constexpr size_t WS_SSQ = 237 * MiB;
DEV unsigned short bfbits(float f) { return f2bf(f); }
DEV void ssd_prep_phase(const bf16_t* XBC, const float* cw, const float* cb, bf16_t* XC, const float* DTLR, const float* dt_bias, const float* a_log, float* SDT, float* SCS, float* SDEC) {
  const int gtid = blockIdx.x * 512 + threadIdx.x, gth = gridDim.x * 512;
  for (int it = gtid; it < (MA / 32) * 192; it += gth) {
    const int rg = it / 192, c8 = (it % 192) * 8, row0 = rg * 32;
    int t0, len;
    if (row0 < ML) { t0 = row0 % SEQ; len = SEQ; } else { t0 = (row0 - ML) % CTXL; len = CTXL; }
    float w[5][8], bias[8];
#pragma unroll
    for (int k = 0; k < 5; ++k) { const f32x4 w0 = *(const f32x4*)(cw + k * 1536 + c8), w1 = *(const f32x4*)(cw + k * 1536 + c8 + 4);
      w[k][0] = w0.x; w[k][1] = w0.y; w[k][2] = w0.z; w[k][3] = w0.w; w[k][4] = w1.x; w[k][5] = w1.y; w[k][6] = w1.z; w[k][7] = w1.w; }
    { const f32x4 b0 = *(const f32x4*)(cb + c8), b1 = *(const f32x4*)(cb + c8 + 4); bias[0] = b0.x; bias[1] = b0.y; bias[2] = b0.z; bias[3] = b0.w; bias[4] = b1.x; bias[5] = b1.y; bias[6] = b1.z; bias[7] = b1.w; }
    const v4u zero4 = {0u, 0u, 0u, 0u};
    v4u win[4];
#pragma unroll
    for (int q = 0; q < 4; ++q) { const int tt = t0 - 2 + q; win[q] = (tt >= 0 && tt < len) ? *(const v4u*)(XBC + (size_t)(row0 - 2 + q) * 1536 + c8) : zero4; }
#pragma unroll 4
    for (int i = 0; i < 32; ++i) {
      const int tt = t0 + i + 2; const v4u nx = (tt < len) ? *(const v4u*)(XBC + (size_t)(row0 + i + 2) * 1536 + c8) : zero4;
      float acc[8];
#pragma unroll
      for (int e = 0; e < 8; ++e) acc[e] = bias[e];
#define CONV_TAP(k, xv) do { acc[0] += w[k][0] * __uint_as_float((xv).x << 16); acc[1] += w[k][1] * __uint_as_float((xv).x & 0xffff0000u); acc[2] += w[k][2] * __uint_as_float((xv).y << 16); acc[3] += w[k][3] * __uint_as_float((xv).y & 0xffff0000u); \
        acc[4] += w[k][4] * __uint_as_float((xv).z << 16); acc[5] += w[k][5] * __uint_as_float((xv).z & 0xffff0000u); acc[6] += w[k][6] * __uint_as_float((xv).w << 16); acc[7] += w[k][7] * __uint_as_float((xv).w & 0xffff0000u); } while (0)
      CONV_TAP(0, win[0]); CONV_TAP(1, win[1]); CONV_TAP(2, win[2]); CONV_TAP(3, win[3]); CONV_TAP(4, nx);
#undef CONV_TAP
      v4u o; o.x = pk2(silu_fast(acc[0]), silu_fast(acc[1])); o.y = pk2(silu_fast(acc[2]), silu_fast(acc[3])); o.z = pk2(silu_fast(acc[4]), silu_fast(acc[5])); o.w = pk2(silu_fast(acc[6]), silu_fast(acc[7]));
      *(v4u*)(XC + (size_t)(row0 + i) * 1536 + c8) = o;
      win[0] = win[1]; win[1] = win[2]; win[2] = win[3]; win[3] = nx;
    }
  }
  {
    const int lane = threadIdx.x & 63, wave = threadIdx.x >> 6, cl = lane & 7, seg = lane >> 3;
    for (int wt = blockIdx.x * NWAVES + wave; wt < NCH * 4; wt += gridDim.x * NWAVES) {
      const int gc = wt >> 2, col = (wt & 3) * 8 + cl, dir = col >> 4, h = col & 15;
      const float a = -fexp(a_log[col]), bias = dt_bias[col];
      float dtv[16], v[16]; float run = 0.f;
#pragma unroll
      for (int u = 0; u < 16; ++u) { const int s = seg * 16 + u, t = dir ? 127 - s : s; dtv[u] = softplusf(DTLR[((size_t)gc * 128 + t) * 64 + col] + bias); }
#pragma unroll
      for (int u = 0; u < 16; ++u) { run += dtv[u] * a; v[u] = run; }
      float off = 0.f;
#pragma unroll
      for (int sgi = 0; sgi < 7; ++sgi) { const float tot = __shfl(run, cl + 8 * sgi); off += (sgi < seg) ? tot : 0.f; }
#pragma unroll
      for (int u = 0; u < 16; ++u) { const int s = seg * 16 + u, t = dir ? 127 - s : s; const size_t row = (size_t)gc * 128 + t; SDT[row * 32 + col] = dtv[u]; SCS[row * 32 + col] = v[u] + off; }
      if (seg == 7) SDEC[(gc * 16 + h) * 2 + dir] = fexp(run + off);
    }
  }
}
DEV void ssd_u_phase(const bf16_t* XC, const float* SDT, const float* SCS, bf16_t* ST, LAS unsigned char* lds) {
  constexpr int XP = 272, BP = 144;
  LAS bf16_t* Xs = (LAS bf16_t*)lds; LAS bf16_t* Bs = (LAS bf16_t*)(lds + 128 * XP * 2); LAS float* wtab = (LAS float*)(lds + 128 * XP * 2 + 128 * BP * 2);
  const int tid = threadIdx.x, lane = tid & 63, wid = tid >> 6, r = lane & 15, Qd = lane >> 4, hl = wid >> 1, dir = wid & 1;
  for (int task = virt_block(); task < NCH * 4; task += gridDim.x) {
    const int gc = task >> 2, g = (task >> 1) & 1, hh = task & 1; const size_t r0 = (size_t)gc * 128; const int h0 = g * 8 + hh * 4;
    __syncthreads();
#pragma unroll
    for (int i = 0; i < 8; ++i) { const int cid = tid + 512 * i, row = cid >> 5, ch = cid & 31; *(LAS v4u*)(Xs + row * XP + ch * 8) = *(const v4u*)(XC + (r0 + row) * 1536 + h0 * 64 + ch * 8); }
#pragma unroll
    for (int i = 0; i < 4; ++i) { const int cid = tid + 512 * i, row = cid >> 4, ch = cid & 15; *(LAS v4u*)(Bs + row * BP + ch * 8) = *(const v4u*)(XC + (r0 + row) * 1536 + 1024 + g * 128 + ch * 8); }
    if (tid < 256) { const int d_ = tid >> 7, t = tid & 127;
      const f32x4 ce = *(const f32x4*)(SCS + (r0 + (d_ ? 0 : 127)) * 32 + d_ * 16 + h0), ct = *(const f32x4*)(SCS + (r0 + t) * 32 + d_ * 16 + h0), dt = *(const f32x4*)(SDT + (r0 + t) * 32 + d_ * 16 + h0);
      wtab[(0 * 2 + d_) * 128 + t] = fexp(ce.x - ct.x) * dt.x; wtab[(1 * 2 + d_) * 128 + t] = fexp(ce.y - ct.y) * dt.y; wtab[(2 * 2 + d_) * 128 + t] = fexp(ce.z - ct.z) * dt.z; wtab[(3 * 2 + d_) * 128 + t] = fexp(ce.w - ct.w) * dt.w; }
    __syncthreads();
    const LAS float* wt = wtab + wid * 128;
    bf16_t* Sp = ST + ((((size_t)gc * 16 + h0 + hl) * 2 + dir) * 64) * 128;
#pragma unroll 1
    for (int pp = 0; pp < 2; ++pp) {
      f32x4 acc[8][2];
#pragma unroll
      for (int nt = 0; nt < 8; ++nt) { acc[nt][0] = (f32x4){0.f, 0.f, 0.f, 0.f}; acc[nt][1] = (f32x4){0.f, 0.f, 0.f, 0.f}; }
#pragma unroll 1
      for (int k = 0; k < 4; ++k) {
        const f32x4 wlo = *(const LAS f32x4*)(wt + 32 * k + 4 * Qd), whi = *(const LAS f32x4*)(wt + 32 * k + 16 + 4 * Qd);
        bf16x8 xf[2];
#pragma unroll
        for (int pt = 0; pt < 2; ++pt) {
          const s16x4 lo = tr_read(Xs + (32 * k + 4 * Qd + (r >> 2)) * XP + hl * 64 + 32 * pp + 16 * pt + 4 * (r & 3));
          const s16x4 hi = tr_read(Xs + (32 * k + 16 + 4 * Qd + (r >> 2)) * XP + hl * 64 + 32 * pp + 16 * pt + 4 * (r & 3));
          const unsigned w0 = pk2(bf2f((bf16_t)lo[0]) * wlo[0], bf2f((bf16_t)lo[1]) * wlo[1]), w1 = pk2(bf2f((bf16_t)lo[2]) * wlo[2], bf2f((bf16_t)lo[3]) * wlo[3]);
          const unsigned w2 = pk2(bf2f((bf16_t)hi[0]) * whi[0], bf2f((bf16_t)hi[1]) * whi[1]), w3 = pk2(bf2f((bf16_t)hi[2]) * whi[2], bf2f((bf16_t)hi[3]) * whi[3]);
          xf[pt] = (bf16x8){(short)(w0 & 0xffff), (short)(w0 >> 16), (short)(w1 & 0xffff), (short)(w1 >> 16), (short)(w2 & 0xffff), (short)(w2 >> 16), (short)(w3 & 0xffff), (short)(w3 >> 16)};
        }
#pragma unroll
        for (int nt = 0; nt < 8; ++nt) {
          const s16x4 lo = tr_read(Bs + (32 * k + 4 * Qd + (r >> 2)) * BP + 16 * nt + 4 * (r & 3));
          const s16x4 hi = tr_read(Bs + (32 * k + 16 + 4 * Qd + (r >> 2)) * BP + 16 * nt + 4 * (r & 3));
          const bf16x8 bfr = (bf16x8){lo[0], lo[1], lo[2], lo[3], hi[0], hi[1], hi[2], hi[3]};
          acc[nt][0] = __builtin_amdgcn_mfma_f32_16x16x32_bf16(bfr, xf[0], acc[nt][0], 0, 0, 0);
          acc[nt][1] = __builtin_amdgcn_mfma_f32_16x16x32_bf16(bfr, xf[1], acc[nt][1], 0, 0, 0);
        }
      }
#pragma unroll
      for (int nt = 0; nt < 8; ++nt)
#pragma unroll
        for (int pt = 0; pt < 2; ++pt) { const f32x4 v = acc[nt][pt];
          *(unsigned long long*)(Sp + ((((2 * pp + pt) * 4 + (nt >> 1)) * 64 + ((nt & 1) * 2 + (Qd >> 1)) * 16 + r) * 8 + 4 * (Qd & 1))) = (unsigned long long)pk2(v[0], v[1]) | ((unsigned long long)pk2(v[2], v[3]) << 32); }
    }
  }
}
DEV void ssd_scan_phase(bf16_t* ST, const float* SDEC, bool wr) {
  for (int item = blockIdx.x * 512 + threadIdx.x; item < 2 * 16 * 2 * 2048; item += gridDim.x * 512) {
    const int e4 = item & 2047, dir = (item >> 11) & 1, h = (item >> 12) & 15, b = item >> 16;
    float S0 = 0.f, S1 = 0.f, S2 = 0.f, S3 = 0.f;
#define SCAN_GC(s) (!dir ? ((s) < 2 ? 128 + 2 * b + (s) : b * 64 + ((s) - 2)) : ((s) < 2 ? 128 + 2 * b + (1 - (s)) : b * 64 + (65 - (s))))
    for (int s0 = 0; s0 < 66; s0 += 6) {
      unsigned long long u[6]; float dec[6];
#pragma unroll
      for (int q = 0; q < 6; ++q) { const int gc = SCAN_GC(s0 + q); u[q] = *(const unsigned long long*)(ST + (((size_t)gc * 16 + h) * 2 + dir) * 8192 + e4 * 4); dec[q] = SDEC[(gc * 16 + h) * 2 + dir]; }
#pragma unroll
      for (int q = 0; q < 6; ++q) { const int gc = SCAN_GC(s0 + q);
        if (wr) *(unsigned long long*)(ST + (((size_t)gc * 16 + h) * 2 + dir) * 8192 + e4 * 4) = (unsigned long long)pk2(S0, S1) | ((unsigned long long)pk2(S2, S3) << 32);
        const unsigned lo = (unsigned)u[q], hi = (unsigned)(u[q] >> 32);
        S0 = dec[q] * S0 + __uint_as_float(lo << 16); S1 = dec[q] * S1 + __uint_as_float(lo & 0xffff0000u); S2 = dec[q] * S2 + __uint_as_float(hi << 16); S3 = dec[q] * S3 + __uint_as_float(hi & 0xffff0000u); }
    }
#undef SCAN_GC
  }
}
DEV bf16x8 scale_frag(bf16x8 f, float s) {
  bf16x8 o;
#pragma unroll
  for (int e = 0; e < 8; e += 2) { const unsigned w = pk2(bf2f((bf16_t)f[e]) * s, bf2f((bf16_t)f[e + 1]) * s); o[e] = (short)(w & 0xffff); o[e + 1] = (short)(w >> 16); }
  return o;
}
DEV void ssd_y_phase(const bf16_t* XC, const float* SDT, const float* SCS, const bf16_t* ST, const float* d_skip, bf16_t* Y0, float* SSQ, LAS unsigned char* lds, bool wr) {
  constexpr int XP = 272, BP = 136, SP = 72;
  LAS bf16_t* Xs = (LAS bf16_t*)lds; LAS bf16_t* Bs = (LAS bf16_t*)(lds + 128 * XP * 2);
  LAS float* tab = (LAS float*)(lds + 128 * XP * 2 + 128 * BP * 2);
  LAS float* ssq = tab + 4 * 4 * 128;
  LAS bf16_t* stg = (LAS bf16_t*)(ssq + 4 * 128);
  const int tid = threadIdx.x, lane = tid & 63, wid = tid >> 6, r = lane & 15, Qd = lane >> 4, hl = wid >> 1, ih = wid & 1;
  LAS bf16_t* mystg = stg + wid * 16 * SP;
  for (int task = virt_block(); task < NCH * 4; task += gridDim.x) {
    const int gc = task >> 2, g = (task >> 1) & 1, hh = task & 1; const size_t r0 = (size_t)gc * 128; const int h0 = g * 8 + hh * 4, h = h0 + hl;
    bf16x8 cstrip[4], cf[4][4];
#pragma unroll
    for (int ks = 0; ks < 4; ++ks) cstrip[ks] = *(const bf16x8*)(XC + (r0 + 16 * wid + r) * 1536 + 1280 + g * 128 + 32 * ks + 8 * Qd);
#pragma unroll
    for (int m = 0; m < 4; ++m)
#pragma unroll
      for (int ks = 0; ks < 4; ++ks) cf[m][ks] = *(const bf16x8*)(XC + (r0 + 64 * ih + 16 * m + r) * 1536 + 1280 + g * 128 + 32 * ks + 8 * Qd);
    __syncthreads();
#pragma unroll
    for (int i = 0; i < 8; ++i) { const int cid = tid + 512 * i, row = cid >> 5, ch = cid & 31; *(LAS v4u*)(Xs + row * XP + ch * 8) = *(const v4u*)(XC + (r0 + row) * 1536 + h0 * 64 + ch * 8); }
#pragma unroll
    for (int i = 0; i < 4; ++i) { const int cid = tid + 512 * i, row = cid >> 4, ch = cid & 15; *(LAS v4u*)(Bs + row * BP + ch * 8) = *(const v4u*)(XC + (r0 + row) * 1536 + 1024 + g * 128 + ch * 8); }
    { const int which = tid >> 7, t = tid & 127; const f32x4 v = *(const f32x4*)((which < 2 ? SCS : SDT) + (r0 + t) * 32 + (which & 1) * 16 + h0);
      tab[0 * 512 + which * 128 + t] = v.x; tab[1 * 512 + which * 128 + t] = v.y; tab[2 * 512 + which * 128 + t] = v.z; tab[3 * 512 + which * 128 + t] = v.w; }
    __syncthreads();
    {
      f32x4 cb[8];
#pragma unroll
      for (int t = 0; t < 8; ++t) { f32x4 c = {0.f, 0.f, 0.f, 0.f};
#pragma unroll
        for (int ks = 0; ks < 4; ++ks) { const bf16x8 bfr = *(const LAS bf16x8*)(Bs + (16 * t + r) * BP + 32 * ks + 8 * Qd); c = __builtin_amdgcn_mfma_f32_16x16x32_bf16(bfr, cstrip[ks], c, 0, 0, 0); }
        cb[t] = c; }
      __syncthreads();
#pragma unroll
      for (int t = 0; t < 8; ++t) *(LAS unsigned long long*)(Bs + (16 * wid + r) * BP + 16 * t + 4 * Qd) = (unsigned long long)pk2(cb[t][0], cb[t][1]) | ((unsigned long long)pk2(cb[t][2], cb[t][3]) << 32);
      __syncthreads();
    }
    const LAS float* csf = tab + hl * 512; const LAS float* csb = csf + 128; const LAS float* dtf = csf + 256; const LAS float* dtb = csf + 384;
    const float dsk = d_skip[h];
    f32x4 y[4][4];
#pragma unroll
    for (int m = 0; m < 4; ++m)
#pragma unroll
      for (int pt = 0; pt < 4; ++pt) y[m][pt] = (f32x4){0.f, 0.f, 0.f, 0.f};
    if (wr || !(PROBE_SKIP & 1))
#pragma unroll 1
    for (int dir = 0; dir < 2; ++dir) {
      const LAS float* csd = dir ? csb : csf; float sc[4];
#pragma unroll
      for (int m = 0; m < 4; ++m)
#pragma unroll
        for (int ks = 0; ks < 4; ++ks) asm volatile("" : "+v"(cf[m][ks]));
#pragma unroll
      for (int m = 0; m < 4; ++m) sc[m] = fexp(csd[64 * ih + 16 * m + r]);
      const bf16_t* Sp = ST + (((size_t)gc * 16 + h) * 2 + dir) * 8192 + lane * 8;
#pragma unroll
      for (int ks = 0; ks < 4; ++ks) {
        bf16x8 sf[4];
#pragma unroll
        for (int pt = 0; pt < 4; ++pt) sf[pt] = *(const bf16x8*)(Sp + (pt * 4 + ks) * 512);
#pragma unroll
        for (int m = 0; m < 4; ++m) { const bf16x8 a = scale_frag(cf[m][ks], sc[m]);
#pragma unroll
          for (int pt = 0; pt < 4; ++pt) y[m][pt] = __builtin_amdgcn_mfma_f32_16x16x32_bf16(a, sf[pt], y[m][pt], 0, 0, 0);
          __builtin_amdgcn_sched_barrier(0); }
      }
    }
#pragma unroll 1
    for (int m = 0; m < 4; ++m) {
      const int i0 = 64 * ih + 16 * m, i = i0 + r;
      const float cfi = csf[i], cbi = csb[i];
      v4u zpre[2];
#pragma unroll
      for (int q = 0; q < 2; ++q) { const int c = lane + 64 * q; zpre[q] = *(const v4u*)(Y0 + (r0 + i0 + (c >> 3)) * 2048 + h * 64 + (c & 7) * 8); }
      if (wr || !(PROBE_SKIP & 2))
#pragma unroll 1
      for (int k2 = 0; k2 < 4; ++k2) {
        const int j0 = 32 * k2 + 8 * Qd;
        const v4u cbv = *(const LAS v4u*)(Bs + i * BP + j0);
        const float cbe[8] = {__uint_as_float(cbv.x << 16), __uint_as_float(cbv.x & 0xffff0000u), __uint_as_float(cbv.y << 16), __uint_as_float(cbv.y & 0xffff0000u), __uint_as_float(cbv.z << 16), __uint_as_float(cbv.z & 0xffff0000u), __uint_as_float(cbv.w << 16), __uint_as_float(cbv.w & 0xffff0000u)};
        float pv[8];
        const bool dofwd = (32 * k2 <= i0 + 15), dobwd = (32 * k2 + 31 >= i0);
#pragma unroll
        for (int e = 0; e < 8; ++e) pv[e] = (j0 + e == i) ? dsk : 0.f;
        if (dofwd) { const f32x4 a0 = *(const LAS f32x4*)(csf + j0), a1 = *(const LAS f32x4*)(csf + j0 + 4), d0 = *(const LAS f32x4*)(dtf + j0), d1 = *(const LAS f32x4*)(dtf + j0 + 4);
          const float jc[8] = {a0.x, a0.y, a0.z, a0.w, a1.x, a1.y, a1.z, a1.w}; const float jd[8] = {d0.x, d0.y, d0.z, d0.w, d1.x, d1.y, d1.z, d1.w};
#pragma unroll
          for (int e = 0; e < 8; ++e) pv[e] += cbe[e] * fexp(j0 + e <= i ? cfi - jc[e] : -INFINITY) * jd[e]; }
        if (dobwd) { const f32x4 a0 = *(const LAS f32x4*)(csb + j0), a1 = *(const LAS f32x4*)(csb + j0 + 4), d0 = *(const LAS f32x4*)(dtb + j0), d1 = *(const LAS f32x4*)(dtb + j0 + 4);
          const float jc[8] = {a0.x, a0.y, a0.z, a0.w, a1.x, a1.y, a1.z, a1.w}; const float jd[8] = {d0.x, d0.y, d0.z, d0.w, d1.x, d1.y, d1.z, d1.w};
#pragma unroll
          for (int e = 0; e < 8; ++e) pv[e] += cbe[e] * fexp(j0 + e >= i ? cbi - jc[e] : -INFINITY) * jd[e]; }
        const unsigned w0 = pk2(pv[0], pv[1]), w1 = pk2(pv[2], pv[3]), w2 = pk2(pv[4], pv[5]), w3 = pk2(pv[6], pv[7]);
        const bf16x8 pa = (bf16x8){(short)(w0 & 0xffff), (short)(w0 >> 16), (short)(w1 & 0xffff), (short)(w1 >> 16), (short)(w2 & 0xffff), (short)(w2 >> 16), (short)(w3 & 0xffff), (short)(w3 >> 16)};
#pragma unroll
        for (int pt = 0; pt < 4; ++pt) {
          const s16x4 lo = tr_read(Xs + (32 * k2 + 8 * Qd + (r >> 2)) * XP + hl * 64 + 16 * pt + 4 * (r & 3));
          const s16x4 hi = tr_read(Xs + (32 * k2 + 8 * Qd + 4 + (r >> 2)) * XP + hl * 64 + 16 * pt + 4 * (r & 3));
          const bf16x8 xf = (bf16x8){lo[0], lo[1], lo[2], lo[3], hi[0], hi[1], hi[2], hi[3]};
          y[0][pt] = __builtin_amdgcn_mfma_f32_16x16x32_bf16(pa, xf, y[0][pt], 0, 0, 0);
        }
      }
      if (wr || !(PROBE_SKIP & 4)) {
#pragma unroll
      for (int pt = 0; pt < 4; ++pt)
#pragma unroll
        for (int jj = 0; jj < 4; ++jj) mystg[(4 * Qd + jj) * SP + 16 * pt + r] = f2bf(y[0][pt][jj]);
      LDS_WAIT(); asm volatile("" ::: "memory");
#pragma unroll
      for (int q = 0; q < 2; ++q) { const int c = lane + 64 * q, rowl = c >> 3, ch = c & 7; const int il = 64 * ih + 16 * m + rowl;
        const v4u yv = *(const LAS v4u*)(mystg + rowl * SP + ch * 8); bf16_t* zp = Y0 + (r0 + il) * 2048 + h * 64 + ch * 8; const v4u zv = zpre[q];
        const float v0 = __uint_as_float(yv.x << 16) * __uint_as_float(zv.x << 16), v1 = __uint_as_float(yv.x & 0xffff0000u) * __uint_as_float(zv.x & 0xffff0000u);
        const float v2 = __uint_as_float(yv.y << 16) * __uint_as_float(zv.y << 16), v3 = __uint_as_float(yv.y & 0xffff0000u) * __uint_as_float(zv.y & 0xffff0000u);
        const float v4 = __uint_as_float(yv.z << 16) * __uint_as_float(zv.z << 16), v5 = __uint_as_float(yv.z & 0xffff0000u) * __uint_as_float(zv.z & 0xffff0000u);
        const float v6 = __uint_as_float(yv.w << 16) * __uint_as_float(zv.w << 16), v7 = __uint_as_float(yv.w & 0xffff0000u) * __uint_as_float(zv.w & 0xffff0000u);
        float ss = (v0 * v0 + v1 * v1) + (v2 * v2 + v3 * v3) + (v4 * v4 + v5 * v5) + (v6 * v6 + v7 * v7);
        ss += __shfl_xor(ss, 1); ss += __shfl_xor(ss, 2); ss += __shfl_xor(ss, 4);
        v4u ov; ov.x = pk2(v0, v1); ov.y = pk2(v2, v3); ov.z = pk2(v4, v5); ov.w = pk2(v6, v7);
        if (wr) *(v4u*)zp = ov;
        if (ch == 0) ssq[hl * 128 + il] = ss; }
      LDS_WAIT(); asm volatile("" ::: "memory");
      }
#pragma unroll
      for (int pt = 0; pt < 4; ++pt) { y[0][pt] = y[1][pt]; y[1][pt] = y[2][pt]; y[2][pt] = y[3][pt]; }
    }
    __syncthreads();
    if (tid < 128) SSQ[((r0 + tid) * 2 + g) * 2 + hh] = (ssq[tid] + ssq[128 + tid]) + (ssq[256 + tid] + ssq[384 + tid]);
  }
}

constexpr size_t WS_GCSC = 237 * MiB + 4 * MiB;
typedef _Float16 h16_t;
typedef _Float16 h16x8 __attribute__((ext_vector_type(8)));
DEV const h16_t* gcs_row(const h16_t* lat, const h16_t* ctx, size_t row) { return row < (size_t)ML ? lat + row * 1024 : ctx + (row - ML) * 1024; }
DEV h16_t* gcs_row_w(h16_t* lat, h16_t* ctx, size_t row) { return row < (size_t)ML ? lat + row * 1024 : ctx + (row - ML) * 1024; }
DEV float logsig_fast(float x) { return fminf(x, 0.f) - 0.6931471805599453f * __builtin_amdgcn_logf(1.f + __builtin_amdgcn_exp2f(-1.4426950408889634f * fabsf(x))); }
DEV void gla_cs_phase(const float* DTLR, const float* gw, const float* gb, h16_t* GCSL, h16_t* GCSC, float* GDEC, LAS unsigned char* lds) {
  const int lane = threadIdx.x & 63, wave = threadIdx.x >> 6;
  LAS float* lrs = (LAS float*)(lds + wave * 8192);
  LAS h16_t* tile = (LAS h16_t*)(lds + 65536 + wave * 1024);
  for (int wt = blockIdx.x * NWAVES + wave; wt < NCH * 2 * 8; wt += gridDim.x * NWAVES) {
    const int gc = wt >> 4, dir = (wt >> 3) & 1, k = (wt & 7) * 64 + lane;
#pragma unroll
    for (int q = 0; q < 8; ++q) { const int c = lane + 64 * q, row = c >> 2, part = c & 3;
      *(LAS f32x4*)(lrs + row * 16 + part * 4) = *(const f32x4*)(DTLR + ((size_t)gc * 128 + row) * 64 + 32 + dir * 16 + part * 4); }
    float wv[16];
#pragma unroll
    for (int q = 0; q < 16; ++q) wv[q] = gw[(dir * 16 + q) * 512 + k];
    const float bias = gb[dir * 512 + k];
    LDS_WAIT(); asm volatile("" ::: "memory");
    float run = 0.f;
#pragma unroll 1
    for (int s0 = 0; s0 < 128; s0 += 8) {
      float lg[8];
#pragma unroll
      for (int u = 0; u < 8; ++u) { const int s = s0 + u, t = dir ? 127 - s : s; const LAS float* lr = lrs + t * 16;
        const f32x4 l0 = *(const LAS f32x4*)lr, l1 = *(const LAS f32x4*)(lr + 4), l2 = *(const LAS f32x4*)(lr + 8), l3 = *(const LAS f32x4*)(lr + 12);
        const float x = bias + l0.x * wv[0] + l0.y * wv[1] + l0.z * wv[2] + l0.w * wv[3] + l1.x * wv[4] + l1.y * wv[5] + l1.z * wv[6] + l1.w * wv[7]
                        + l2.x * wv[8] + l2.y * wv[9] + l2.z * wv[10] + l2.w * wv[11] + l3.x * wv[12] + l3.y * wv[13] + l3.z * wv[14] + l3.w * wv[15];
        lg[u] = logsig_fast(x) * (1.f / 16.f); }
#pragma unroll
      for (int u = 0; u < 8; ++u) { run += lg[u]; tile[u * 64 + lane] = (h16_t)run; }
      LDS_WAIT(); asm volatile("" ::: "memory");
      { const int u = lane >> 3, ch = lane & 7, s = s0 + u, t = dir ? 127 - s : s;
        *(v4u*)(gcs_row_w(GCSL, GCSC, (size_t)gc * 128 + t) + dir * 512 + (k - lane) + ch * 8) = *(const LAS v4u*)(tile + u * 64 + ch * 8); }
      LDS_WAIT(); asm volatile("" ::: "memory");
    }
    GDEC[((gc * 4 + (k >> 7)) * 2 + dir) * 128 + (k & 127)] = fexp(run);
    LDS_WAIT(); asm volatile("" ::: "memory");
  }
}
DEV void gla_u_phase(const bf16_t* K0, const bf16_t* V0, const h16_t* GCSL, const h16_t* GCSC, bf16_t* ST, LAS unsigned char* lds) {
  constexpr int VP = 272, KP = 144;
  LAS bf16_t* Vs = (LAS bf16_t*)lds; LAS bf16_t* Kd = (LAS bf16_t*)(lds + 128 * VP * 2);
  const int tid = threadIdx.x, lane = tid & 63, wid = tid >> 6, r = lane & 15, Qd = lane >> 4;
  for (int task = virt_block(); task < NCH * 4; task += gridDim.x) {
    const int gc = task >> 2, h = task & 3; const size_t r0 = (size_t)gc * 128;
    __syncthreads();
#pragma unroll
    for (int i = 0; i < 8; ++i) { const int cid = tid + 512 * i, row = cid >> 5, ch = cid & 31; *(LAS v4u*)(Vs + row * VP + ch * 8) = *(const v4u*)(V0 + (r0 + row) * 1024 + h * 256 + ch * 8); }
#pragma unroll
    for (int i = 0; i < 4; ++i) { const int cid = tid + 512 * i, t = cid >> 4, ch = cid & 15;
      const v4u kv = *(const v4u*)(K0 + (r0 + t) * 512 + h * 128 + ch * 8);
      const float kf[8] = {__uint_as_float(kv.x << 16), __uint_as_float(kv.x & 0xffff0000u), __uint_as_float(kv.y << 16), __uint_as_float(kv.y & 0xffff0000u), __uint_as_float(kv.z << 16), __uint_as_float(kv.z & 0xffff0000u), __uint_as_float(kv.w << 16), __uint_as_float(kv.w & 0xffff0000u)};
#pragma unroll
      for (int dir = 0; dir < 2; ++dir) {
        const h16x8 ce = *(const h16x8*)(gcs_row(GCSL, GCSC, r0 + (dir ? 0 : 127)) + dir * 512 + h * 128 + ch * 8), ct = *(const h16x8*)(gcs_row(GCSL, GCSC, r0 + t) + dir * 512 + h * 128 + ch * 8);
        v4u o; o.x = pk2(kf[0] * fexp((float)ce[0] - (float)ct[0]), kf[1] * fexp((float)ce[1] - (float)ct[1])); o.y = pk2(kf[2] * fexp((float)ce[2] - (float)ct[2]), kf[3] * fexp((float)ce[3] - (float)ct[3]));
        o.z = pk2(kf[4] * fexp((float)ce[4] - (float)ct[4]), kf[5] * fexp((float)ce[5] - (float)ct[5])); o.w = pk2(kf[6] * fexp((float)ce[6] - (float)ct[6]), kf[7] * fexp((float)ce[7] - (float)ct[7]));
        *(LAS v4u*)(Kd + dir * 128 * KP + t * KP + ch * 8) = o; } }
    __syncthreads();
#pragma unroll 1
    for (int dir = 0; dir < 2; ++dir) {
      const LAS bf16_t* Kb = Kd + dir * 128 * KP;
      f32x4 acc[8][2];
#pragma unroll
      for (int dt = 0; dt < 8; ++dt) { acc[dt][0] = (f32x4){0.f, 0.f, 0.f, 0.f}; acc[dt][1] = (f32x4){0.f, 0.f, 0.f, 0.f}; }
#pragma unroll 1
      for (int k = 0; k < 4; ++k) {
        bf16x8 vf[2];
#pragma unroll
        for (int et = 0; et < 2; ++et) {
          const s16x4 lo = tr_read(Vs + (32 * k + 4 * Qd + (r >> 2)) * VP + 32 * wid + 16 * et + 4 * (r & 3));
          const s16x4 hi = tr_read(Vs + (32 * k + 16 + 4 * Qd + (r >> 2)) * VP + 32 * wid + 16 * et + 4 * (r & 3));
          vf[et] = (bf16x8){lo[0], lo[1], lo[2], lo[3], hi[0], hi[1], hi[2], hi[3]}; }
#pragma unroll
        for (int dt = 0; dt < 8; ++dt) {
          const s16x4 lo = tr_read(Kb + (32 * k + 4 * Qd + (r >> 2)) * KP + 16 * dt + 4 * (r & 3));
          const s16x4 hi = tr_read(Kb + (32 * k + 16 + 4 * Qd + (r >> 2)) * KP + 16 * dt + 4 * (r & 3));
          const bf16x8 kfr = (bf16x8){lo[0], lo[1], lo[2], lo[3], hi[0], hi[1], hi[2], hi[3]};
          acc[dt][0] = __builtin_amdgcn_mfma_f32_16x16x32_bf16(kfr, vf[0], acc[dt][0], 0, 0, 0);
          acc[dt][1] = __builtin_amdgcn_mfma_f32_16x16x32_bf16(kfr, vf[1], acc[dt][1], 0, 0, 0); }
      }
      bf16_t* Sp = ST + (((size_t)gc * 4 + h) * 2 + dir) * 32768;
#pragma unroll
      for (int dt = 0; dt < 8; ++dt)
#pragma unroll
        for (int et = 0; et < 2; ++et) { const f32x4 v = acc[dt][et];
          *(unsigned long long*)(Sp + ((((2 * wid + et) * 4 + (dt >> 1)) * 64 + ((dt & 1) * 2 + (Qd >> 1)) * 16 + r) * 8 + 4 * (Qd & 1))) = (unsigned long long)pk2(v[0], v[1]) | ((unsigned long long)pk2(v[2], v[3]) << 32); }
    }
  }
}
DEV void gla_scan_phase(bf16_t* ST, const float* GDEC, bool wr) {
  for (int item = blockIdx.x * 512 + threadIdx.x; item < 2 * 4 * 2 * 8192; item += gridDim.x * 512) {
    const int e4 = item & 8191, dir = (item >> 13) & 1, h = (item >> 14) & 3, b = item >> 16; const int d0 = 32 * ((e4 >> 7) & 3) + 8 * ((e4 >> 5) & 3) + 4 * (e4 & 1);
    float S0 = 0.f, S1 = 0.f, S2 = 0.f, S3 = 0.f;
#define SCAN_GC(s) (!dir ? ((s) < 2 ? 128 + 2 * b + (s) : b * 64 + ((s) - 2)) : ((s) < 2 ? 128 + 2 * b + (1 - (s)) : b * 64 + (65 - (s))))
    for (int s0 = 0; s0 < 66; s0 += 6) {
      unsigned long long u[6]; f32x4 dec[6];
#pragma unroll
      for (int q = 0; q < 6; ++q) { const int gc = SCAN_GC(s0 + q); u[q] = *(const unsigned long long*)(ST + (((size_t)gc * 4 + h) * 2 + dir) * 32768 + e4 * 4); dec[q] = *(const f32x4*)(GDEC + ((gc * 4 + h) * 2 + dir) * 128 + d0); }
#pragma unroll
      for (int q = 0; q < 6; ++q) { const int gc = SCAN_GC(s0 + q);
        if (wr) *(unsigned long long*)(ST + (((size_t)gc * 4 + h) * 2 + dir) * 32768 + e4 * 4) = (unsigned long long)pk2(S0, S1) | ((unsigned long long)pk2(S2, S3) << 32);
        const unsigned lo = (unsigned)u[q], hi = (unsigned)(u[q] >> 32);
        S0 = dec[q].x * S0 + __uint_as_float(lo << 16); S1 = dec[q].y * S1 + __uint_as_float(lo & 0xffff0000u); S2 = dec[q].z * S2 + __uint_as_float(hi << 16); S3 = dec[q].w * S3 + __uint_as_float(hi & 0xffff0000u); }
    }
#undef SCAN_GC
  }
}
DEV void gla_o_phase(const bf16_t* Q0, const bf16_t* K0, const bf16_t* V0, const h16_t* GCSL, const h16_t* GCSC, const bf16_t* ST, const float* gla_norm, const float* SSQ, const float* ssd_norm, bf16_t* Y0, LAS unsigned char* lds, bool wr) {
  constexpr int VP = 272, KP = 136;
  LAS bf16_t* Vs = (LAS bf16_t*)lds; LAS bf16_t* Kd = (LAS bf16_t*)(lds + 128 * VP * 2);
  const int tid = threadIdx.x, lane = tid & 63, wid = tid >> 6, r = lane & 15, Qd = lane >> 4;
  const float scale = 0.08838834764831845f;
  for (int task = virt_block(); task < NCH * 4; task += gridDim.x) {
    const int gc = task >> 2, h = task & 3; const size_t r0 = (size_t)gc * 128;
    __syncthreads();
#pragma unroll
    for (int i = 0; i < 8; ++i) { const int cid = tid + 512 * i, row = cid >> 5, ch = cid & 31; *(LAS v4u*)(Vs + row * VP + ch * 8) = *(const v4u*)(V0 + (r0 + row) * 1024 + h * 256 + ch * 8); }
#pragma unroll
    for (int i = 0; i < 4; ++i) { const int cid = tid + 512 * i, t = cid >> 4, ch = cid & 15;
      const v4u kv = *(const v4u*)(K0 + (r0 + t) * 512 + h * 128 + ch * 8);
      const float kf[8] = {__uint_as_float(kv.x << 16), __uint_as_float(kv.x & 0xffff0000u), __uint_as_float(kv.y << 16), __uint_as_float(kv.y & 0xffff0000u), __uint_as_float(kv.z << 16), __uint_as_float(kv.z & 0xffff0000u), __uint_as_float(kv.w << 16), __uint_as_float(kv.w & 0xffff0000u)};
#pragma unroll
      for (int dir = 0; dir < 2; ++dir) {
        const h16x8 ct = *(const h16x8*)(gcs_row(GCSL, GCSC, r0 + t) + dir * 512 + h * 128 + ch * 8);
        v4u o; o.x = pk2(kf[0] * fexp(-(float)ct[0]), kf[1] * fexp(-(float)ct[1])); o.y = pk2(kf[2] * fexp(-(float)ct[2]), kf[3] * fexp(-(float)ct[3]));
        o.z = pk2(kf[4] * fexp(-(float)ct[4]), kf[5] * fexp(-(float)ct[5])); o.w = pk2(kf[6] * fexp(-(float)ct[6]), kf[7] * fexp(-(float)ct[7]));
        *(LAS v4u*)(Kd + dir * 128 * KP + t * KP + ch * 8) = o; } }
    __syncthreads();
    const int i = 16 * wid + r;
    f32x4 o[16];
#pragma unroll
    for (int et = 0; et < 16; ++et) o[et] = (f32x4){0.f, 0.f, 0.f, 0.f};
#pragma unroll 1
    for (int dir = 0; dir < 2; ++dir) {
      bf16x8 qd[4];
      { const h16_t* ci = gcs_row(GCSL, GCSC, r0 + i) + dir * 512 + h * 128; const bf16_t* qp = Q0 + (r0 + i) * 512 + h * 128;
#pragma unroll
        for (int ks = 0; ks < 4; ++ks) { const v4u qv = *(const v4u*)(qp + 32 * ks + 8 * Qd); const h16x8 cc = *(const h16x8*)(ci + 32 * ks + 8 * Qd);
          const f32x4 c0 = {(float)cc[0], (float)cc[1], (float)cc[2], (float)cc[3]}, c1 = {(float)cc[4], (float)cc[5], (float)cc[6], (float)cc[7]};
          const unsigned w0 = pk2(__uint_as_float(qv.x << 16) * scale * fexp(c0.x), __uint_as_float(qv.x & 0xffff0000u) * scale * fexp(c0.y));
          const unsigned w1 = pk2(__uint_as_float(qv.y << 16) * scale * fexp(c0.z), __uint_as_float(qv.y & 0xffff0000u) * scale * fexp(c0.w));
          const unsigned w2 = pk2(__uint_as_float(qv.z << 16) * scale * fexp(c1.x), __uint_as_float(qv.z & 0xffff0000u) * scale * fexp(c1.y));
          const unsigned w3 = pk2(__uint_as_float(qv.w << 16) * scale * fexp(c1.z), __uint_as_float(qv.w & 0xffff0000u) * scale * fexp(c1.w));
          qd[ks] = (bf16x8){(short)(w0 & 0xffff), (short)(w0 >> 16), (short)(w1 & 0xffff), (short)(w1 >> 16), (short)(w2 & 0xffff), (short)(w2 >> 16), (short)(w3 & 0xffff), (short)(w3 >> 16)}; } }
      const bf16_t* Sp = ST + (((size_t)gc * 4 + h) * 2 + dir) * 32768 + lane * 8;
      {
        bf16x8 sA[4], sB[4];
#pragma unroll
        for (int q = 0; q < 4; ++q) sA[q] = *(const bf16x8*)(Sp + (q * 4 + 0) * 512);
#pragma unroll
        for (int bi = 0; bi < 16; ++bi) {
          const int ks = bi >> 2, e0 = 4 * (bi & 3);
          if (bi + 1 < 16) { const int ks2 = (bi + 1) >> 2, e2 = 4 * ((bi + 1) & 3);
#pragma unroll
            for (int q = 0; q < 4; ++q) { if (bi & 1) sA[q] = *(const bf16x8*)(Sp + ((e2 + q) * 4 + ks2) * 512); else sB[q] = *(const bf16x8*)(Sp + ((e2 + q) * 4 + ks2) * 512); } }
#pragma unroll
          for (int q = 0; q < 4; ++q) o[e0 + q] = __builtin_amdgcn_mfma_f32_16x16x32_bf16(qd[ks], (bi & 1) ? sB[q] : sA[q], o[e0 + q], 0, 0, 0);
          __builtin_amdgcn_sched_barrier(0);
        }
      }
      const LAS bf16_t* Kb = Kd + dir * 128 * KP;
#pragma unroll 1
      for (int k2 = 0; k2 < 4; ++k2) {
        const bool need = dir ? (2 * k2 + 1 >= wid) : (2 * k2 <= wid);
        if (!need) continue;
        bf16x8 pa;
#pragma unroll
        for (int tt = 0; tt < 2; ++tt) { const int t = 2 * k2 + tt;
          f32x4 c = {0.f, 0.f, 0.f, 0.f};
#pragma unroll
          for (int ks = 0; ks < 4; ++ks) { const bf16x8 kfr = *(const LAS bf16x8*)(Kb + (16 * t + r) * KP + 32 * ks + 8 * Qd); c = __builtin_amdgcn_mfma_f32_16x16x32_bf16(kfr, qd[ks], c, 0, 0, 0); }
          float pv[4];
#pragma unroll
          for (int jj = 0; jj < 4; ++jj) { const int j = 16 * t + 4 * Qd + jj; const bool ok = dir ? (j >= i) : (j <= i); pv[jj] = ok ? c[jj] : 0.f; }
          const unsigned w0 = pk2(pv[0], pv[1]), w1 = pk2(pv[2], pv[3]);
          pa[tt * 4 + 0] = (short)(w0 & 0xffff); pa[tt * 4 + 1] = (short)(w0 >> 16); pa[tt * 4 + 2] = (short)(w1 & 0xffff); pa[tt * 4 + 3] = (short)(w1 >> 16); }
#pragma unroll
        for (int et = 0; et < 16; ++et) {
          const s16x4 lo = tr_read(Vs + (32 * k2 + 4 * Qd + (r >> 2)) * VP + 16 * et + 4 * (r & 3));
          const s16x4 hi = tr_read(Vs + (32 * k2 + 16 + 4 * Qd + (r >> 2)) * VP + 16 * et + 4 * (r & 3));
          const bf16x8 vf = (bf16x8){lo[0], lo[1], lo[2], lo[3], hi[0], hi[1], hi[2], hi[3]};
          o[et] = __builtin_amdgcn_mfma_f32_16x16x32_bf16(pa, vf, o[et], 0, 0, 0); }
      }
    }
#pragma unroll
    for (int jj = 0; jj < 4; ++jj) { float ss = 0.f;
#pragma unroll
      for (int et = 0; et < 16; ++et) ss += o[et][jj] * o[et][jj];
      ss += __shfl_xor(ss, 1); ss += __shfl_xor(ss, 2); ss += __shfl_xor(ss, 4); ss += __shfl_xor(ss, 8);
      const float rstd = rsqrtf(ss * (1.f / 256.f) + EPS);
      const size_t yo = (r0 + 16 * wid + 4 * Qd + jj) * 2048 + 1024 + h * 256 + r;
#pragma unroll
      for (int et = 0; et < 16; ++et) { const bf16_t ov_ = f2bf(o[et][jj] * rstd * gla_norm[h * 256 + 16 * et + r] * bf2f(Y0[yo + 16 * et])); if (wr) Y0[yo + 16 * et] = ov_; } }
    { const int g = h >> 1, c0 = g * 512 + (h & 1) * 256;
#pragma unroll
      for (int q = 0; q < 8; ++q) { const int cid = tid + 512 * q, row = cid >> 5, ch = cid & 31; const size_t rr = r0 + row;
        const float rstd = rsqrtf((SSQ[(rr * 2 + g) * 2] + SSQ[(rr * 2 + g) * 2 + 1]) * (1.f / 512.f) + EPS);
        bf16_t* yp = Y0 + rr * 2048 + c0 + ch * 8; const v4u yv = *(const v4u*)yp; const f32x4 g0 = *(const f32x4*)(ssd_norm + c0 + ch * 8), g1 = *(const f32x4*)(ssd_norm + c0 + ch * 8 + 4);
        v4u ov; ov.x = pk2(__uint_as_float(yv.x << 16) * rstd * g0.x, __uint_as_float(yv.x & 0xffff0000u) * rstd * g0.y); ov.y = pk2(__uint_as_float(yv.y << 16) * rstd * g0.z, __uint_as_float(yv.y & 0xffff0000u) * rstd * g0.w);
        ov.z = pk2(__uint_as_float(yv.z << 16) * rstd * g1.x, __uint_as_float(yv.z & 0xffff0000u) * rstd * g1.y); ov.w = pk2(__uint_as_float(yv.w << 16) * rstd * g1.z, __uint_as_float(yv.w & 0xffff0000u) * rstd * g1.w);
        if (wr) *(v4u*)yp = ov; } }
  }
}

typedef __attribute__((address_space(1))) unsigned gu32;
#define RLX_AGENT __ATOMIC_RELAXED, __HIP_MEMORY_SCOPE_AGENT
#define XB_TMO      128
#define XB_XCNT(j)  (256  + 64 * (j))
#define XB_XSUB(j)  (1280 + 64 * (j))
#define XB_XGEN(j)  (2304 + 64 * (j))
#define XB_TOP      3328
#define XB_TOPGEN   3392
#define XCD_BAR_WORDS 3456
#define XB_SPIN_CAP (1u << 18)

__device__ __forceinline__ unsigned xb_ld(unsigned* p)              { return __hip_atomic_load(p, __ATOMIC_RELAXED, __HIP_MEMORY_SCOPE_AGENT); }
__device__ __forceinline__ unsigned xb_add(unsigned* p, unsigned v) { return __hip_atomic_fetch_add(p, v, __ATOMIC_RELAXED, __HIP_MEMORY_SCOPE_AGENT); }
__device__ __forceinline__ unsigned xb_xcc_id() { return (unsigned)__builtin_amdgcn_s_getreg((3 << 11) | 20) & 0xFu; }
#define XB_SPIN(cond, bar) do { unsigned _sp = 0; while (cond) { __builtin_amdgcn_s_sleep(1); \
    if ((++_sp & 255u) == 0u) { if (xb_ld(&(bar)[XB_TMO])) break; if (_sp > XB_SPIN_CAP) { atomicAdd(&(bar)[XB_TMO], 1u); break; } } } } while (0)

struct XcdBarrier {
    unsigned* bar; unsigned x;
    volatile LAS unsigned* st;
};

__device__ __forceinline__ XcdBarrier xcd_barrier_post(unsigned* bar, volatile LAS unsigned* st) {
    XcdBarrier b; b.bar = bar; b.x = xb_xcc_id(); b.st = st;
    if (threadIdx.x == 0) (void)xb_add(&bar[XB_XCNT(b.x)], 1u);
    return b;
}
__device__ __forceinline__ void xcd_barrier_complete(unsigned* bar, unsigned x, unsigned& nloc, unsigned& nx) {
    const unsigned G = gridDim.x * gridDim.y * gridDim.z;
    unsigned sum, cnt, mine, sp = 0u;
    for (;;) {
        sum = 0u; cnt = 0u; mine = 0u;
#pragma unroll
        for (unsigned j = 0; j < 16; ++j) { const unsigned c = xb_ld(&bar[XB_XCNT(j)]); sum += c; cnt += (c > 0u) ? 1u : 0u; mine = (j == x) ? c : mine; }
        if (sum == G) break;
        __builtin_amdgcn_s_sleep(1);
        if ((++sp & 255u) == 0u) { if (xb_ld(&bar[XB_TMO])) break; if (sp > XB_SPIN_CAP) { atomicAdd(&bar[XB_TMO], 1u); break; } }
    }
    nloc = mine > 0u ? mine : 1u; nx = cnt > 0u ? cnt : 1u;
}

__device__ __forceinline__ void xcd_barrier(const XcdBarrier& b) {
    asm volatile("s_waitcnt vmcnt(0)" ::: "memory");
    __syncthreads();
    if (threadIdx.x == 0) {
        unsigned* bar = b.bar;
        __builtin_amdgcn_s_waitcnt(0);
        unsigned nloc = b.st[0], nx = b.st[1];
        if (nloc == 0u) { xcd_barrier_complete(bar, b.x, nloc, nx); b.st[0] = nloc; b.st[1] = nx; }
        const unsigned old = xb_add(&bar[XB_XSUB(b.x)], 1u);
        const unsigned gen = old / nloc;
        if (old + 1u == (gen + 1u) * nloc) {
            __builtin_amdgcn_fence(__ATOMIC_RELEASE, "agent");
            asm volatile("s_waitcnt vmcnt(0)" ::: "memory");
            const unsigned og = xb_add(&bar[XB_TOP], 1u);
            const unsigned tg = og / nx;
            if (og + 1u == (tg + 1u) * nx) xb_add(&bar[XB_TOPGEN], 1u);
            else XB_SPIN(xb_ld(&bar[XB_TOPGEN]) == tg, bar);
            __builtin_amdgcn_fence(__ATOMIC_ACQUIRE, "agent");
            xb_add(&bar[XB_XGEN(b.x)], 1u);
            asm volatile("s_waitcnt vmcnt(0)" ::: "memory");
        } else {
            XB_SPIN(xb_ld(&bar[XB_XGEN(b.x)]) == gen, bar);
            __builtin_amdgcn_fence(__ATOMIC_ACQUIRE, "agent");
            asm volatile("s_waitcnt vmcnt(0)" ::: "memory");
        }
    }
    __syncthreads();
}

__global__ void __launch_bounds__(NWAVES * 64, 2) mega(Params p) {
  extern __shared__ __attribute__((aligned(16))) unsigned char lds_raw[];
  LAS unsigned char* lds = (LAS unsigned char*)lds_raw;
  volatile LAS unsigned* MISC = (volatile LAS unsigned*)(lds + MISC_OFF);
  if (threadIdx.x < 16) MISC[threadIdx.x] = 0u;
  __syncthreads();
  XcdBarrier bar = xcd_barrier_post((unsigned*)(p.ws + WS_CTL), MISC + 8);
  unsigned char* ws = p.ws;
  float* MOD = (float*)(ws + WS_MOD);
  bf16_t* H0 = (bf16_t*)p.out; float* X1 = p.out;
  const int lo = p.ph_lo, hi = p.ph_hi;
#define IN(k) (lo <= (k) && (k) < hi)
#define SEAM(k) do { if ((k) + 1 < hi) xcd_barrier(bar); } while (0)
#define PH(k, ...) if (IN(k)) { if ((PROBE_MASK >> (k)) & 1u) { const bool wr = (p.rep < 0); (void)wr; __VA_ARGS__; xcd_barrier(bar); } { const bool wr = true; (void)wr; __VA_ARGS__; } SEAM(k); }
  PH(0, prologue_phase(p, lds))
  PH(1, prep_phase(p.in[0], p.in[2], p.in[4], MOD, H0))
  PH(2, {
    pg8::Gemm g{H0, (const bf16_t*)(ws + WS_W1T), MA, E_INP, D}; pg8::StaticOrder S; S.init(MA, E_INP, gridDim.x, (int)blockIdx.x);
    pg8::EpiProj0 E{(bf16_t*)(ws + WS_Y0), (bf16_t*)(ws + WS_XBC), (bf16_t*)(ws + WS_Q0), (bf16_t*)(ws + WS_K0), (bf16_t*)(ws + WS_V0), (float*)(ws + WS_DTLR)};
    pg8::gemm_phase<pg8::EpiProj0, pg8::StaticOrder, true, true>(lds, g, S, E); })
  PH(3, ssd_prep_phase((const bf16_t*)(ws + WS_XBC), p.in[8], p.in[9], (bf16_t*)p.out, (const float*)(ws + WS_DTLR), p.in[10], p.in[11], (float*)((char*)p.out + DO_SDT), (float*)((char*)p.out + DO_SCS), (float*)(ws + WS_SDEC)))
  PH(4, { ssd_u_phase((const bf16_t*)p.out, (const float*)((char*)p.out + DO_SDT), (const float*)((char*)p.out + DO_SCS), (bf16_t*)(ws + WS_STATE), lds);
    { const int nbusy = (NCH * 4) % (int)gridDim.x, nfree = (int)gridDim.x - nbusy;
      const int vb_ = virt_block(); if (vb_ >= nbusy || nfree <= 0) { __syncthreads(); late_weights(p, lds, nfree > 0 ? vb_ - nbusy : vb_, nfree > 0 ? nfree : (int)gridDim.x); } } })
  PH(5, ssd_scan_phase((bf16_t*)(ws + WS_STATE), (const float*)(ws + WS_SDEC), wr))
  PH(6, ssd_y_phase((const bf16_t*)p.out, (const float*)((char*)p.out + DO_SDT), (const float*)((char*)p.out + DO_SCS), (const bf16_t*)(ws + WS_STATE), p.in[12], (bf16_t*)(ws + WS_Y0), (float*)(ws + WS_SSQ), lds, wr))
  PH(7, gla_cs_phase((const float*)(ws + WS_DTLR), p.in[14], p.in[15], (h16_t*)p.out, (h16_t*)(ws + WS_GCSC), (float*)(ws + WS_GDEC), lds))
  PH(8, gla_u_phase((const bf16_t*)(ws + WS_K0), (const bf16_t*)(ws + WS_V0), (const h16_t*)p.out, (const h16_t*)(ws + WS_GCSC), (bf16_t*)(ws + WS_STATE), lds))
  PH(9, gla_scan_phase((bf16_t*)(ws + WS_STATE), (const float*)(ws + WS_GDEC), wr))
  PH(10, gla_o_phase((const bf16_t*)(ws + WS_Q0), (const bf16_t*)(ws + WS_K0), (const bf16_t*)(ws + WS_V0), (const h16_t*)p.out, (const h16_t*)(ws + WS_GCSC), (const bf16_t*)(ws + WS_STATE), p.in[16], (const float*)(ws + WS_SSQ), p.in[13], (bf16_t*)(ws + WS_Y0), lds, wr))
  PH(11, {
    pg8::Gemm g{(const bf16_t*)(ws + WS_Y0), (const bf16_t*)(ws + WS_W2T), ML, D, 2048}; pg8::StaticOrder S; S.init(ML, D, gridDim.x, (int)blockIdx.x);
    pg8::EpiResid E{p.in[0], X1, MOD, true};
    pg8::gemm_phase<pg8::EpiResid, pg8::StaticOrder, true, true>(lds, g, S, E);
    const float* ctx = p.in[2]; float* XC1 = (float*)(ws + WS_XC1); const float* gate = MOD + 2 * 3072 + 2048;
    small_gemm((const bf16_t*)(ws + WS_Y0) + (size_t)ML * 2048, 2048, (const bf16_t*)(ws + WS_W2T), 2048, 2048, MC, D,
               [=](int m, int n, float v) { XC1[(size_t)m * D + n] = ctx[(size_t)m * D + n] + gate[n] * v; }); })
  PH(12, prep_phase(X1, (const float*)(ws + WS_XC1), p.in[18], MOD + 3 * 3072, (bf16_t*)(ws + WS_H1)))
  PH(13, {
    pg8::Gemm g{(const bf16_t*)(ws + WS_H1), (const bf16_t*)(ws + WS_W3T), ML, O_IN, D}; pg8::StaticOrder S; S.init(ML, O_IN, gridDim.x, (int)blockIdx.x);
    pg8::EpiProj1 E{(bf16_t*)(ws + WS_K1), (bf16_t*)(ws + WS_V1), (bf16_t*)(ws + WS_Q1), (bf16_t*)(ws + WS_G1)};
    pg8::gemm_phase<pg8::EpiProj1, pg8::StaticOrder, true, true>(lds, g, S, E);
    bf16_t* K1 = (bf16_t*)(ws + WS_K1); bf16_t* V1 = (bf16_t*)(ws + WS_V1);
    small_gemm((const bf16_t*)(ws + WS_H1) + (size_t)ML * D, D, (const bf16_t*)(ws + WS_W3T), D, D, MC, 1024,
               [=](int m, int n, float v) { if (n < 512) K1[(size_t)(ML + m) * 512 + n] = f2bf(v); else V1[(size_t)(ML + m) * 512 + (n - 512)] = f2bf(v); }); })
  PH(14, qknorm_phase((bf16_t*)(ws + WS_Q1), (bf16_t*)(ws + WS_K1), p.in[22], p.in[23], (const float*)(ws + WS_ROPE), wr))
  PH(15, attn_phase((bf16_t*)(ws + WS_Q1), (const bf16_t*)(ws + WS_K1), (const bf16_t*)(ws + WS_V1), (const bf16_t*)(ws + WS_G1), p.in[24], p.in[22], p.in[23], lds, wr))
  PH(16, {
    pg8::Gemm g{(const bf16_t*)(ws + WS_Q1), (const bf16_t*)(ws + WS_W4T), ML, D, 2048}; pg8::StaticOrder S; S.init(ML, D, gridDim.x, (int)blockIdx.x);
    pg8::EpiResid E{X1, p.out, MOD + 3 * 3072, wr};
    pg8::gemm_phase<pg8::EpiResid, pg8::StaticOrder, true, true>(lds, g, S, E); })
#undef PH
#undef IN
#undef SEAM
}
extern "C" void kernel_launch(void* const* d_in, const int* in_sizes, int n_in, void* d_out, int out_size, void* d_ws, size_t ws_size, hipStream_t stream) {
  static int grid_blocks = 0;
  if (!grid_blocks) {
    int dev = 0, cus = 0, per_cu = 0;
    hipGetDevice(&dev);
    hipDeviceGetAttribute(&cus, hipDeviceAttributeMultiprocessorCount, dev);
    hipFuncSetAttribute((const void*)mega, hipFuncAttributeMaxDynamicSharedMemorySize, LDS_BYTES);
    hipOccupancyMaxActiveBlocksPerMultiprocessor(&per_cu, (const void*)mega, NWAVES * 64, LDS_BYTES);
    if (per_cu < 1) { fprintf(stderr, "kernel_launch: occupancy query says %d blocks per CU\n", per_cu); per_cu = 1; }
    if (per_cu > 1) per_cu = 1;
    grid_blocks = cus * per_cu;
  }
  hipMemsetAsync((char*)d_ws + WS_CTL, 0, 64 * 1024, stream);
  Params base{};
  for (int i = 0; i < 26; ++i) base.in[i] = (const float*)d_in[i];
  base.out = (float*)d_out; base.ws = (unsigned char*)d_ws;
  auto launch = [&](int lo, int hi) {
    Params p = base; p.ph_lo = lo; p.ph_hi = hi; p.rep = (int)PROBE_MASK; void* args[] = {&p};
    hipError_t e = hipLaunchCooperativeKernel((const void*)mega, dim3(grid_blocks), dim3(NWAVES * 64), args, LDS_BYTES, stream);
    if (e != hipSuccess) fprintf(stderr, "cooperative launch failed: %s (grid %d)\n", hipGetErrorString(e), grid_blocks);
  };
  launch(0, 17);
}
```

```cpp
#include <hip/hip_runtime.h>
#include <hip/hip_cooperative_groups.h>
#include <stdint.h>
#include <math.h>
#include <cstdio>
namespace cg = cooperative_groups;
#ifndef PROBE_SKIP
#define PROBE_SKIP 0
#endif
#ifndef PROBE_MASK
#define PROBE_MASK 0u
#endif

typedef unsigned short bf16_t;
#define DEV __device__ __forceinline__

DEV float bf2f(bf16_t v) { return __uint_as_float(((unsigned)v) << 16); }
typedef float f32x2_t __attribute__((ext_vector_type(2))); typedef __bf16 bf16x2_t __attribute__((ext_vector_type(2)));
DEV unsigned pk2(float lo, float hi) { const f32x2_t v = {lo, hi}; const bf16x2_t b = __builtin_convertvector(v, bf16x2_t); return __builtin_bit_cast(unsigned, b); }
DEV bf16_t f2bf(float f) { return (bf16_t)(pk2(f, 0.f) & 0xffffu); }
DEV float fexp(float x) { return __builtin_amdgcn_exp2f(x * 1.4426950408889634f); }
DEV float siluf(float x) { return x / (1.f + fexp(-x)); }
DEV float silu_fast(float x) { return x * __builtin_amdgcn_rcpf(1.f + fexp(-x)); }
DEV float softplusf(float x) { return x > 20.f ? x : log1pf(fexp(x)); }
DEV float logsigmoidf(float x) { return fminf(x, 0.f) - log1pf(fexp(-fabsf(x))); }

constexpr int D = 1024, NB = 2, SEQ = 8192, CTXL = 256;
constexpr int ML = NB * SEQ;
constexpr int MC = NB * CTXL;
constexpr int MA = ML + MC;
constexpr int NCH = MA / 128;
constexpr int E_IN = 5696, O_IN = 5120, E_INP = 5888;
constexpr float EPS = 1e-6f;

constexpr size_t MiB = 1u << 20;
constexpr int CW_CSQ = 8192;
constexpr size_t WS_CTL = 0;
constexpr size_t WS_MOD = 1 * MiB;
constexpr size_t WS_ROPE = 1 * MiB + 128 * 1024;
constexpr size_t WS_SDEC = 1 * MiB + 256 * 1024;
constexpr size_t WS_GDEC = 1 * MiB + 384 * 1024;
constexpr size_t WS_W1T = 2 * MiB;
constexpr size_t WS_W2T = 14 * MiB;
constexpr size_t WS_W3T = 18 * MiB;
constexpr size_t WS_W4T = 28 * MiB;
constexpr size_t WS_Y0 = 32 * MiB;
constexpr size_t WS_Q0 = 98 * MiB;
constexpr size_t WS_K0 = WS_Q0 + 16 * MiB + 512 * 1024;
constexpr size_t WS_V0 = 131 * MiB;
constexpr size_t WS_DTLR = 164 * MiB;
constexpr size_t WS_XC1 = 168 * MiB + 512 * 1024;
constexpr size_t WS_XBC = 171 * MiB;
constexpr size_t WS_STATE = 171 * MiB;
constexpr size_t WS_TAIL = 237 * MiB;
constexpr size_t WS_H1 = 32 * MiB;
constexpr size_t WS_K1 = 65 * MiB;
constexpr size_t WS_V1 = 81 * MiB + 512 * 1024;
constexpr size_t WS_Q1 = 98 * MiB;
constexpr size_t WS_G1 = 171 * MiB;

DEV int row_vec(int row) { return row < ML ? (row / SEQ) : 2; }

namespace pg8 {
#define PG8_LAS __attribute__((address_space(3)))
typedef unsigned short bf16_t;
typedef short bf16x8 __attribute__((ext_vector_type(8)));
typedef float f32x4 __attribute__((ext_vector_type(4)));
typedef unsigned u32x4 __attribute__((ext_vector_type(4)));
constexpr int BM = 256, BK = 64, HALF = 128, HTB = HALF * BK * 2  , STAGE_BYTES = 8 * HTB, NXCD = 8, WGM = 8;

__host__ __device__ __forceinline__ int lds_byte(int r, int c) { const int st = (r >> 4) * 2 + (c >> 5), rr = r & 15, cc = c & 31, ob = rr * 64 + cc * 2; return st * 1024 + (ob ^ (((ob >> 9) & 1) << 5)); }
__host__ __device__ __forceinline__ void stage_rc(int b, int& R, int& C) { const int st = b / 1024, sb = b % 1024, swz = sb ^ (((sb >> 9) & 1) << 5); R = (st >> 1) * 16 + swz / 64; C = (st & 1) * 32 + (swz % 64) / 2; }
__host__ __device__ __forceinline__ int perm32(int rho) { const int n = rho >> 4, i = rho & 15; return 8 * (i >> 2) + 4 * n + (i & 3); }

struct Unit { int pm, pn; };
struct Gemm { const bf16_t* A; const bf16_t* Bt; int M, N, K; };

struct StaticOrder {
    int nM, nN, nwg, G, c;
    __host__ __device__ void init(int M, int N, int G_, int c_) { nM = M / BM; nN = N / BM; nwg = nM * nN; G = G_; c = c_; }
    __host__ __device__ bool next(int i, Unit& u) const {
        const long L = (long)i * G + c; if (L >= nwg) return false;
        int wgid = (int)L; { const int q = nwg / NXCD, r = nwg % NXCD, xcd = wgid % NXCD, off = wgid / NXCD; wgid = (xcd < r ? xcd * (q + 1) : r * (q + 1) + (xcd - r) * q) + off; }
        const int nig = WGM * nN, gid = wgid / nig, fm = gid * WGM, gsz = (nM - fm) < WGM ? (nM - fm) : WGM;
        u.pm = fm + ((wgid % nig) % gsz); u.pn = (wgid % nig) / gsz; return true;
    }
    __device__ __forceinline__ void a_ready(const Unit&) const {}
    __device__ __forceinline__ void done(const Unit&) const {}
};
__device__ __forceinline__ unsigned cvt_pk_bf16(float lo, float hi) { unsigned r; asm volatile("v_cvt_pk_bf16_f32 %0, %1, %2" : "=v"(r) : "v"(lo), "v"(hi)); return r; }
__device__ __forceinline__ float silu_e(float x) { return x * __builtin_amdgcn_rcpf(1.f + fexp(-x)); }

__device__ __forceinline__ void store_unit_bf16(const f32x4 (&acc)[2][2][4][2], bf16_t* base, int ld, int colt, bool act, const Unit& u, int wr, int wc, int fr, int fq) {
    const int row0 = u.pm * BM + wr * 64 + fr; const int col0 = colt + wc * 32 + 8 * fq;
#pragma unroll
    for (int ai = 0; ai < 2; ++ai)
#pragma unroll
        for (int m = 0; m < 4; ++m) { bf16_t* rowp = base + (size_t)(row0 + ai * HALF + m * 16) * ld + col0;
#pragma unroll
            for (int bj = 0; bj < 2; ++bj) { f32x4 v0 = acc[ai][bj][m][0], v1 = acc[ai][bj][m][1];
                if (act) { v0 = (f32x4){silu_e(v0[0]), silu_e(v0[1]), silu_e(v0[2]), silu_e(v0[3])}; v1 = (f32x4){silu_e(v1[0]), silu_e(v1[1]), silu_e(v1[2]), silu_e(v1[3])}; }
                u32x4 w; w.x = cvt_pk_bf16(v0[0], v0[1]); w.y = cvt_pk_bf16(v0[2], v0[3]); w.z = cvt_pk_bf16(v1[0], v1[1]); w.w = cvt_pk_bf16(v1[2], v1[3]);
                *(u32x4*)(rowp + bj * HALF) = w; } }
}
struct EpiProj0 {
    static constexpr bool PERM = true, AFTER_DRAIN = false;
    bf16_t *Y0, *XBC, *Q0, *K0, *V0; float* DTLR;
    __device__ __forceinline__ void operator()(const f32x4 (&acc)[2][2][4][2], const Unit& u, int wr, int wc, int fr, int fq) const {
        const int pn = u.pn;
        if (pn == 22) {
            if (wc < 2) { const int row0 = u.pm * BM + wr * 64 + fr;
#pragma unroll
                for (int ai = 0; ai < 2; ++ai)
#pragma unroll
                    for (int m = 0; m < 4; ++m) { float* rp = DTLR + (size_t)(row0 + ai * HALF + m * 16) * 64 + wc * 32 + 8 * fq; *(f32x4*)rp = acc[ai][0][m][0]; *(f32x4*)(rp + 4) = acc[ai][0][m][1]; } }
            return;
        }
        bf16_t* base; int ld, colt; bool act = false;
        if (pn < 8) { base = Y0; ld = 2048; colt = pn * 256; act = true; }
        else if (pn < 14) { base = XBC; ld = 1536; colt = (pn - 8) * 256; }
        else if (pn < 16) { base = Q0; ld = 512; colt = (pn - 14) * 256; }
        else if (pn < 18) { base = K0; ld = 512; colt = (pn - 16) * 256; }
        else { base = V0; ld = 1024; colt = (pn - 18) * 256; }
        store_unit_bf16(acc, base, ld, colt, act, u, wr, wc, fr, fq);
    }
};
struct EpiProj1 {
    static constexpr bool PERM = true, AFTER_DRAIN = false;
    bf16_t *K1, *V1, *Q1, *G1;
    __device__ __forceinline__ void operator()(const f32x4 (&acc)[2][2][4][2], const Unit& u, int wr, int wc, int fr, int fq) const {
        const int pn = u.pn; bf16_t* base; int ld, colt; bool act = false;
        if (pn < 2) { base = K1; ld = 512; colt = pn * 256; }
        else if (pn < 4) { base = V1; ld = 512; colt = (pn - 2) * 256; }
        else if (pn < 12) { base = Q1; ld = 2048; colt = (pn - 4) * 256; }
        else { base = G1; ld = 2048; colt = (pn - 12) * 256; act = true; }
        store_unit_bf16(acc, base, ld, colt, act, u, wr, wc, fr, fq);
    }
};
struct EpiResid {
    static constexpr bool PERM = false, AFTER_DRAIN = false;
    const float* res; float* out; const float* mod; bool do_store;
    __device__ __forceinline__ void operator()(const f32x4 (&acc)[2][2][4][2], const Unit& u, int wr, int wc, int fr, int fq) const {
        const int b = (u.pm * BM) / 8192; const float* gate = mod + b * 3072 + 2048;
        const int col0 = u.pn * BM + wc * 32 + 4 * fq;
        f32x4 gv[2][2];
#pragma unroll
        for (int bj = 0; bj < 2; ++bj)
#pragma unroll
            for (int n = 0; n < 2; ++n) gv[bj][n] = *(const f32x4*)(gate + col0 + bj * HALF + n * 16);
#pragma unroll
        for (int ai = 0; ai < 2; ++ai)
#pragma unroll
            for (int m = 0; m < 4; ++m) { const size_t off = (size_t)(u.pm * BM + ai * HALF + wr * 64 + m * 16 + fr) * 1024 + col0;
#pragma unroll
                for (int bj = 0; bj < 2; ++bj)
#pragma unroll
                    for (int n = 0; n < 2; ++n) { const f32x4 r = *(const f32x4*)(res + off + bj * HALF + n * 16); const f32x4 ov_ = r + gv[bj][n] * acc[ai][bj][m][n]; if (do_store) *(f32x4*)(out + off + bj * HALF + n * 16) = ov_; } }
    }
};
template <class Epi, class Sched, bool ALIGN_EPI = false, bool SP2 = false>
__device__ __forceinline__ void gemm_phase(PG8_LAS unsigned char* lds, const Gemm g, const Sched& S, const Epi& E) {
    const int tid = threadIdx.x, wid = __builtin_amdgcn_readfirstlane(tid >> 6), lane = tid & 63, wr = wid >> 2, wc = wid & 3, fr = lane & 15, fq = lane >> 4;
    const int K = g.K, nt = K / BK;
    unsigned voffA[2], voffB[2];
#pragma unroll
    for (int i = 0; i < 2; ++i) { int R, C; stage_rc(tid * 16 + i * 8192, R, C); const int Rb = Epi::PERM ? ((R & ~31) + perm32(R & 31)) : R;
        voffA[i] = (unsigned)(R * K + C) * 2u; voffB[i] = (unsigned)(Rb * K + C) * 2u; }
    const size_t kstep = (size_t)(BK * 2);
    const size_t hstep = (size_t)HALF * K * 2;
    const size_t tstep = 2 * hstep;
    const unsigned ldsw = (unsigned)wid * 1024u;
    const int aoff = lds_byte(wr * 64 + fr, fq * 8), boff = lds_byte(wc * 32 + fr, fq * 8);
#define PG8_SA(b, h) (((b) * 2 + (h)) * HTB)
#define PG8_SB(b, h) ((4 + (b) * 2 + (h)) * HTB)
#define PG8_STAGE(bufoff, gbase, voff) do { _Pragma("unroll") for (int _i = 0; _i < 2; ++_i) \
        __builtin_amdgcn_global_load_lds((const unsigned*)((const char*)(gbase) + (voff)[_i]), (PG8_LAS unsigned*)(lds + (bufoff) + ldsw + _i * 8192), 16, 0, 0); } while (0)
#define PG8_LDA(dst, b, h) do { _Pragma("unroll") for (int m = 0; m < 4; ++m) _Pragma("unroll") for (int k = 0; k < 2; ++k) dst[m][k] = *(const PG8_LAS bf16x8*)(lds + PG8_SA(b, h) + aoff + m * 2048 + k * 1024); } while (0)
#define PG8_LDB(dst, b, h) do { _Pragma("unroll") for (int n = 0; n < 2; ++n) _Pragma("unroll") for (int k = 0; k < 2; ++k) dst[n][k] = *(const PG8_LAS bf16x8*)(lds + PG8_SB(b, h) + boff + n * 2048 + k * 1024); } while (0)
#define PG8_MMA(ai, bj, At, Bt) do { __builtin_amdgcn_s_setprio(1); _Pragma("unroll") for (int m = 0; m < 4; ++m) _Pragma("unroll") for (int n = 0; n < 2; ++n) _Pragma("unroll") for (int k = 0; k < 2; ++k) \
        acc[ai][bj][m][n] = __builtin_amdgcn_mfma_f32_16x16x32_bf16(Bt[n][k], At[m][k], acc[ai][bj][m][n], 0, 0, 0); __builtin_amdgcn_s_setprio(0); } while (0)
#define PG8_WAIT_V(n) asm volatile("s_waitcnt vmcnt(" #n ")" ::: "memory")
#define PG8_WAIT_L(n) asm volatile("s_waitcnt lgkmcnt(" #n ")" ::: "memory")
#define PG8_BAR __builtin_amdgcn_s_barrier()
#define PG8_SCHED __builtin_amdgcn_sched_barrier(0)
    Unit cur, nxt; int ui = 0;
    if (!S.next(0, cur)) return;
    f32x4 acc[2][2][4][2];
#pragma unroll
    for (int a = 0; a < 2; ++a)
#pragma unroll
        for (int b = 0; b < 2; ++b)
#pragma unroll
            for (int m = 0; m < 4; ++m)
#pragma unroll
                for (int n = 0; n < 2; ++n) acc[a][b][m][n] = (f32x4){0.f, 0.f, 0.f, 0.f};
    bf16x8 At[4][2], B0[2][2], B1[2][2];
    const char* cA = (const char*)g.A + (size_t)cur.pm * tstep; const char* cB = (const char*)g.Bt + (size_t)cur.pn * tstep;
    S.a_ready(cur);
    if constexpr (SP2) {
        PG8_STAGE(PG8_SB(0, 0), cB, voffB); PG8_STAGE(PG8_SB(0, 1), cB + hstep, voffB); PG8_STAGE(PG8_SA(0, 0), cA, voffA); PG8_STAGE(PG8_SA(0, 1), cA + hstep, voffA);
        if (wr == 1) PG8_BAR;
        PG8_WAIT_V(2); PG8_BAR;
        PG8_STAGE(PG8_SB(1, 0), cB + kstep, voffB); PG8_STAGE(PG8_SA(1, 0), cA + kstep, voffA); PG8_STAGE(PG8_SB(1, 1), cB + hstep + kstep, voffB);
        PG8_WAIT_V(6); PG8_BAR;
    } else {
        PG8_STAGE(PG8_SB(0, 0), cB, voffB); PG8_STAGE(PG8_SA(0, 0), cA, voffA); PG8_STAGE(PG8_SB(0, 1), cB + hstep, voffB); PG8_STAGE(PG8_SA(0, 1), cA + hstep, voffA);
        if (wr == 1) PG8_BAR;
        PG8_WAIT_V(4); PG8_BAR;
        PG8_STAGE(PG8_SB(1, 0), cB + kstep, voffB); PG8_STAGE(PG8_SA(1, 0), cA + kstep, voffA); PG8_STAGE(PG8_SB(1, 1), cB + hstep + kstep, voffB);
        PG8_WAIT_V(6); PG8_BAR;
    }
    for (;;) {
        const bool has_next = S.next(ui + 1, nxt);
        const char* nA = has_next ? (const char*)g.A + (size_t)nxt.pm * tstep : cA; const char* nB = has_next ? (const char*)g.Bt + (size_t)nxt.pn * tstep : cB;
        for (int t = 0; t < nt; t += 2) {
            const bool last = (t == nt - 2);
            const char* a1 = cA + (size_t)(t + 1) * kstep;
            const char* a2 = last ? nA : cA + (size_t)(t + 2) * kstep; const char* b2 = last ? nB : cB + (size_t)(t + 2) * kstep;
            const char* a3 = a2 + kstep; const char* b3 = b2 + kstep;
            if (last && has_next) S.a_ready(nxt);
            if constexpr (SP2) {
            PG8_LDB(B0, 0, 0); PG8_LDB(B1, 0, 1); PG8_SCHED; PG8_LDA(At, 0, 0); PG8_STAGE(PG8_SA(1, 1), a1 + hstep, voffA);
            PG8_WAIT_V(8); PG8_WAIT_L(0); PG8_BAR; PG8_MMA(0, 0, At, B0); PG8_MMA(0, 1, At, B1); PG8_BAR; PG8_SCHED;
            PG8_LDA(At, 0, 1); PG8_STAGE(PG8_SB(0, 0), b2, voffB); PG8_STAGE(PG8_SB(0, 1), b2 + hstep, voffB); PG8_STAGE(PG8_SA(0, 0), a2, voffA);
            PG8_WAIT_V(8); PG8_WAIT_L(0); PG8_BAR; PG8_MMA(1, 0, At, B0); PG8_MMA(1, 1, At, B1); PG8_BAR; PG8_SCHED;
            PG8_LDB(B0, 1, 0); PG8_LDB(B1, 1, 1); PG8_SCHED; PG8_LDA(At, 1, 0); PG8_STAGE(PG8_SA(0, 1), a2 + hstep, voffA);
            PG8_WAIT_V(8); PG8_WAIT_L(0); PG8_BAR; PG8_MMA(0, 0, At, B0); PG8_MMA(0, 1, At, B1); PG8_BAR; PG8_SCHED;
            PG8_LDA(At, 1, 1); PG8_STAGE(PG8_SB(1, 0), b3, voffB); PG8_STAGE(PG8_SB(1, 1), b3 + hstep, voffB); PG8_STAGE(PG8_SA(1, 0), a3, voffA);
            PG8_WAIT_V(8); PG8_WAIT_L(0); PG8_BAR; PG8_MMA(1, 0, At, B0); PG8_MMA(1, 1, At, B1); PG8_BAR; PG8_SCHED;
            } else {
            PG8_LDB(B0, 0, 0); PG8_SCHED; PG8_LDA(At, 0, 0); PG8_STAGE(PG8_SA(1, 1), a1 + hstep, voffA);
            PG8_WAIT_L(8); PG8_BAR; PG8_WAIT_L(0); PG8_MMA(0, 0, At, B0); PG8_BAR; PG8_SCHED;
            PG8_LDB(B1, 0, 1); PG8_STAGE(PG8_SB(0, 0), b2, voffB);
            PG8_BAR; PG8_WAIT_L(0); PG8_MMA(0, 1, At, B1); PG8_BAR;
            PG8_LDA(At, 0, 1); PG8_STAGE(PG8_SA(0, 0), a2, voffA);
            PG8_BAR; PG8_WAIT_L(0); PG8_MMA(1, 0, At, B0); PG8_BAR; PG8_SCHED;
            PG8_STAGE(PG8_SB(0, 1), b2 + hstep, voffB);
            PG8_WAIT_V(6); PG8_BAR; PG8_MMA(1, 1, At, B1); PG8_BAR;
            PG8_LDB(B0, 1, 0); PG8_SCHED; PG8_LDA(At, 1, 0); PG8_STAGE(PG8_SA(0, 1), a2 + hstep, voffA);
            PG8_WAIT_L(8); PG8_BAR; PG8_WAIT_L(0); PG8_MMA(0, 0, At, B0); PG8_BAR; PG8_SCHED;
            PG8_LDB(B1, 1, 1); PG8_STAGE(PG8_SB(1, 0), b3, voffB);
            PG8_BAR; PG8_WAIT_L(0); PG8_MMA(0, 1, At, B1); PG8_BAR;
            PG8_LDA(At, 1, 1); PG8_STAGE(PG8_SA(1, 0), a3, voffA);
            PG8_BAR; PG8_WAIT_L(0); PG8_MMA(1, 0, At, B0); PG8_BAR; PG8_SCHED;
            PG8_STAGE(PG8_SB(1, 1), b3 + hstep, voffB);
            PG8_WAIT_V(6); PG8_BAR; PG8_MMA(1, 1, At, B1); PG8_BAR;
            }
        }
        if constexpr (ALIGN_EPI) { if (wr == 0) PG8_BAR; }
        if constexpr (!Epi::AFTER_DRAIN) { E(acc, cur, wr, wc, fr, fq); S.done(cur); }
        if (!has_next) break;
#pragma unroll
        for (int a = 0; a < 2; ++a)
#pragma unroll
            for (int b = 0; b < 2; ++b)
#pragma unroll
                for (int m = 0; m < 4; ++m)
#pragma unroll
                    for (int n = 0; n < 2; ++n) acc[a][b][m][n] = (f32x4){0.f, 0.f, 0.f, 0.f};
        cur = nxt; cA = nA; cB = nB; ++ui;
        if constexpr (ALIGN_EPI) { if (wr == 1) PG8_BAR; }
    }
    PG8_WAIT_V(0);
    if constexpr (!ALIGN_EPI) { if (wr == 0) PG8_BAR; }
    PG8_BAR;
    if constexpr (Epi::AFTER_DRAIN) { E.fused(acc, cur, wr, wc, fr, fq, lds, wid, lane); S.done(cur); }
#undef PG8_SA
#undef PG8_SB
#undef PG8_STAGE
#undef PG8_LDA
#undef PG8_LDB
#undef PG8_MMA
#undef PG8_WAIT_V
#undef PG8_WAIT_L
#undef PG8_BAR
#undef PG8_SCHED
}
}
#define LAS __attribute__((address_space(3)))
typedef unsigned v4u __attribute__((ext_vector_type(4)));
typedef float f32x4 __attribute__((ext_vector_type(4)));
typedef short bf16x8 __attribute__((ext_vector_type(8)));
#define LDS_WAIT() asm volatile("s_waitcnt lgkmcnt(0)" ::: "memory")
constexpr int NWAVES = 8;
constexpr int LDS_BYTES = 147456;
constexpr int MISC_OFF = 147456 - 128;

struct Params { const float* in[26]; float* out; unsigned char* ws; int ph_lo, ph_hi, rep, pad; };

DEV int virt_block() { const int G = (int)gridDim.x, b = (int)blockIdx.x; return (G % 8 == 0) ? (b % 8) * (G / 8) + b / 8 : b; }
DEV float wave_sum(float v) {
#pragma unroll
  for (int o = 1; o < 64; o <<= 1) v += __shfl_xor(v, o);
  return v;
}

DEV int w1_dest_row(int n) {
  if (n < 1024) return n;
  if (n < 2560) return 2048 + (n - 1024);
  if (n < 2592) return 5632 + (n - 2560);
  if (n < 3104) return 3584 + (n - 2592);
  if (n < 3616) return 4096 + (n - 3104);
  if (n < 4640) return 4608 + (n - 3616);
  if (n < 5664) return 1024 + (n - 4640);
  return n;
}
DEV void transpose_item(const float* W, int K, int N, int k0, int n0, bf16_t* WT, int drow0, LAS float* scr, int lane) {
#pragma unroll 8
  for (int i = 0; i < 32; ++i) { const int kk = 2 * i + (lane >> 5); scr[kk * 33 + (lane & 31)] = W[(size_t)(k0 + kk) * N + n0 + (lane & 31)]; }
  LDS_WAIT(); asm volatile("" ::: "memory");
  const int c = lane & 7;
#pragma unroll
  for (int j = 0; j < 4; ++j) { const int n = (lane >> 3) + 8 * j; const LAS float* s = scr + (8 * c) * 33 + n;
    v4u o; o.x = pk2(s[0 * 33], s[1 * 33]); o.y = pk2(s[2 * 33], s[3 * 33]); o.z = pk2(s[4 * 33], s[5 * 33]); o.w = pk2(s[6 * 33], s[7 * 33]);
    *(v4u*)(WT + (size_t)(drow0 + n) * K + k0 + 8 * c) = o; }
  LDS_WAIT(); asm volatile("" ::: "memory");
}
DEV void prologue_phase(const Params& p, LAS unsigned char* lds) {
  const int tid = threadIdx.x, lane = tid & 63, wave = tid >> 6;
  unsigned char* ws = p.ws;
  float* MOD = (float*)(ws + WS_MOD);
  {
    LAS float* sc = (LAS float*)lds;
    LAS float* part = (LAS float*)(lds + 12288);
    for (int i = tid; i < 3072; i += 512) { const int v = i >> 10, k = i & 1023; const float cv = v < 2 ? p.in[1][v * 1024 + k] : p.in[3][k]; sc[i] = siluf(cv); }
    __syncthreads();
    for (int task = blockIdx.x; task < 96; task += gridDim.x) {
      const int l = task / 48, n0 = (task % 48) * 64; const float* w = l ? p.in[19] : p.in[5]; const float* bb = l ? p.in[20] : p.in[6];
      const int col = tid & 63, ks = tid >> 6;
      float a0 = 0.f, a1 = 0.f, a2 = 0.f;
#pragma unroll 8
      for (int k = ks * 128; k < ks * 128 + 128; ++k) { const float wv = w[(size_t)k * 3072 + n0 + col]; a0 += sc[k] * wv; a1 += sc[1024 + k] * wv; a2 += sc[2048 + k] * wv; }
      part[(ks * 3 + 0) * 64 + col] = a0; part[(ks * 3 + 1) * 64 + col] = a1; part[(ks * 3 + 2) * 64 + col] = a2;
      __syncthreads();
      if (tid < 192) { const int v = tid >> 6; float s = bb[n0 + col];
#pragma unroll
        for (int q = 0; q < 8; ++q) s += part[(q * 3 + v) * 64 + col];
        MOD[(l * 3 + v) * 3072 + n0 + col] = s; }
      __syncthreads();
    }
  }
  if (blockIdx.x == gridDim.x - 1) { float* rope = (float*)(ws + WS_ROPE);
    for (int idx = tid; idx < 4096; idx += 512) { const int pos = idx >> 5, f = idx & 31; const float inv = 1.0f / powf(10000.f, (float)f / 32.f); const float ang = (float)pos * inv; rope[idx] = cosf(ang); rope[4096 + idx] = sinf(ang); } }
  { v4u* z = (v4u*)(ws + WS_W1T + (size_t)E_IN * 1024 * 2); const v4u zero = {0u, 0u, 0u, 0u};
    for (int i = blockIdx.x * 512 + tid; i < (E_INP - E_IN) * 1024 * 2 / 16; i += gridDim.x * 512) z[i] = zero; }
  __syncthreads();
  {
    LAS float* scr = (LAS float*)(lds + wave * 16384);
    const int gw = blockIdx.x * NWAVES + wave, NGW = gridDim.x * NWAVES;
    constexpr int I1 = 16 * 178;
    for (int it = gw; it < I1; it += NGW) { const int kb = it / 178, nb = it % 178; transpose_item(p.in[7], 1024, E_IN, 64 * kb, 32 * nb, (bf16_t*)(ws + WS_W1T), w1_dest_row(32 * nb), scr, lane); }
  }
}
DEV void late_weights(const Params& p, LAS unsigned char* lds, int vblock, int nvblocks) {
  const int lane = threadIdx.x & 63, wave = threadIdx.x >> 6; unsigned char* ws = p.ws;
  LAS float* scr = (LAS float*)(lds + wave * 16384);
  constexpr int I2 = 32 * 32, I3 = 16 * 160, I4 = 32 * 32;
  for (int it = vblock * NWAVES + wave; it < I2 + I3 + I4; it += nvblocks * NWAVES) {
    int r = it;
    if (r < I2) { const int kb = r / 32, nb = r % 32; transpose_item(p.in[17], 2048, 1024, 64 * kb, 32 * nb, (bf16_t*)(ws + WS_W2T), 32 * nb, scr, lane); continue; } r -= I2;
    if (r < I3) { const int kb = r / 160, nb = r % 160; transpose_item(p.in[21], 1024, O_IN, 64 * kb, 32 * nb, (bf16_t*)(ws + WS_W3T), 32 * nb, scr, lane); continue; } r -= I3;
    { const int kb = r / 32, nb = r % 32; transpose_item(p.in[25], 2048, 1024, 64 * kb, 32 * nb, (bf16_t*)(ws + WS_W4T), 32 * nb, scr, lane); }
  }
}
DEV void prep_phase(const float* xlat, const float* xctx, const float* g, const float* mod, bf16_t* H) {
  const int lane = threadIdx.x & 63, wave = threadIdx.x >> 6;
  for (int row = blockIdx.x * NWAVES + wave; row < MA; row += gridDim.x * NWAVES) {
    const float* src = row < ML ? xlat + (size_t)row * D : xctx + (size_t)(row - ML) * D;
    const float* m = mod + row_vec(row) * 3072;
    f32x4 v[4]; float ss = 0.f;
#pragma unroll
    for (int j = 0; j < 4; ++j) { v[j] = *(const f32x4*)(src + 4 * lane + 256 * j); ss += (v[j].x * v[j].x + v[j].y * v[j].y) + (v[j].z * v[j].z + v[j].w * v[j].w); }
    const float rstd = rsqrtf(wave_sum(ss) * (1.f / D) + EPS);
#pragma unroll
    for (int j = 0; j < 4; ++j) { const int k = 4 * lane + 256 * j;
      const f32x4 gg = *(const f32x4*)(g + k), sc = *(const f32x4*)(m + 1024 + k), sh = *(const f32x4*)(m + k);
      const f32x4 o = v[j] * rstd * gg * (sc + 1.f) + sh;
      *(unsigned long long*)(H + (size_t)row * D + k) = (unsigned long long)pk2(o.x, o.y) | ((unsigned long long)pk2(o.z, o.w) << 32); }
  }
}
template <class F> DEV void small_gemm(const bf16_t* A, int lda, const bf16_t* Bt, int ldb, int K, int Mrows, int Ncols, F f) {
  const int lane = threadIdx.x & 63, wid = threadIdx.x >> 6, mt = wid >> 2, nt = wid & 3, r = lane & 15, q = lane >> 4;
  const int ntn = Ncols / 64, ntasks = (Mrows / 32) * ntn;
  for (int task = blockIdx.x; task < ntasks; task += gridDim.x) {
    const int row0 = (task / ntn) * 32 + mt * 16, col0 = (task % ntn) * 64 + nt * 16;
    const bf16_t* ap = A + (size_t)(row0 + r) * lda + 8 * q; const bf16_t* bp = Bt + (size_t)(col0 + r) * ldb + 8 * q;
    f32x4 acc = {0.f, 0.f, 0.f, 0.f};
#pragma unroll 8
    for (int k = 0; k < K; k += 32) { const bf16x8 a = *(const bf16x8*)(ap + k), b = *(const bf16x8*)(bp + k); acc = __builtin_amdgcn_mfma_f32_16x16x32_bf16(a, b, acc, 0, 0, 0); }
#pragma unroll
    for (int j = 0; j < 4; ++j) f(row0 + q * 4 + j, col0 + r, acc[j]);
  }
}

DEV void qknorm_phase(bf16_t* Q1, bf16_t* K1, const float* qn, const float* kn, const float* rope, bool wr) {
  const int lane = threadIdx.x & 63, wave = threadIdx.x >> 6, hl = lane >> 4, d0 = (lane & 15) * 8;
  const float scale = 0.08838834764831845f * 1.4426950408889634f;
  float gq[8], gk[8];
#pragma unroll
  for (int e = 0; e < 8; ++e) { gq[e] = qn[d0 + e] * scale; gk[e] = kn[d0 + e]; }
  const int ax = d0 >> 6, sgn = (d0 >> 5) & 1, f0 = d0 & 31;
  for (int row = blockIdx.x * NWAVES + wave; row < MA; row += gridDim.x * NWAVES) {
    const bool lat = row < ML;
    v4u raw[5];
    raw[0] = *(const v4u*)(K1 + (size_t)row * 512 + hl * 128 + d0);
    if (lat) {
#pragma unroll
      for (int g = 0; g < 4; ++g) raw[1 + g] = *(const v4u*)(Q1 + (size_t)row * 2048 + (g * 4 + hl) * 128 + d0);
    }
    float cs[8], sn[8];
    if (lat) { const int t = row % SEQ, pos = ax ? (t & 63) : (t >> 6);
      const f32x4 c0 = *(const f32x4*)(rope + pos * 32 + f0), c1 = *(const f32x4*)(rope + pos * 32 + f0 + 4), s0 = *(const f32x4*)(rope + 4096 + pos * 32 + f0), s1 = *(const f32x4*)(rope + 4096 + pos * 32 + f0 + 4);
      cs[0] = c0.x; cs[1] = c0.y; cs[2] = c0.z; cs[3] = c0.w; cs[4] = c1.x; cs[5] = c1.y; cs[6] = c1.z; cs[7] = c1.w;
      sn[0] = s0.x; sn[1] = s0.y; sn[2] = s0.z; sn[3] = s0.w; sn[4] = s1.x; sn[5] = s1.y; sn[6] = s1.z; sn[7] = s1.w; }
    const int ng = lat ? 5 : 1;
#pragma unroll
    for (int g = 0; g < 5; ++g) {
      if (g < ng) {
        const v4u rv = raw[g];
        float v[8] = {__uint_as_float(rv.x << 16), __uint_as_float(rv.x & 0xffff0000u), __uint_as_float(rv.y << 16), __uint_as_float(rv.y & 0xffff0000u), __uint_as_float(rv.z << 16), __uint_as_float(rv.z & 0xffff0000u), __uint_as_float(rv.w << 16), __uint_as_float(rv.w & 0xffff0000u)};
        float ss = 0.f;
#pragma unroll
        for (int e = 0; e < 8; ++e) ss += v[e] * v[e];
        ss += __shfl_xor(ss, 1); ss += __shfl_xor(ss, 2); ss += __shfl_xor(ss, 4); ss += __shfl_xor(ss, 8);
        const float rstd = rsqrtf(ss * (1.f / 128.f) + EPS);
#pragma unroll
        for (int e = 0; e < 8; ++e) v[e] *= rstd * (g == 0 ? gk[e] : gq[e]);
        if (lat) {
#pragma unroll
          for (int e = 0; e < 8; ++e) { const float o = __shfl_xor(v[e], 4); v[e] = sgn ? (v[e] * cs[e] + o * sn[e]) : (v[e] * cs[e] - o * sn[e]); }
        }
        v4u ov; ov.x = pk2(v[0], v[1]); ov.y = pk2(v[2], v[3]); ov.z = pk2(v[4], v[5]); ov.w = pk2(v[6], v[7]);
        if (wr) { if (g == 0) *(v4u*)(K1 + (size_t)row * 512 + hl * 128 + d0) = ov; else *(v4u*)(Q1 + (size_t)row * 2048 + ((g - 1) * 4 + hl) * 128 + d0) = ov; }
      }
    }
  }
}
typedef short s16x4 __attribute__((ext_vector_type(4)));
DEV s16x4 tr_read(const LAS bf16_t* p) { return __builtin_bit_cast(s16x4, __builtin_amdgcn_ds_read_tr16_b64_v4i16((LAS s16x4*)p)); }
DEV void attn_phase(bf16_t* Q1, const bf16_t* K1, const bf16_t* V1, const bf16_t* G1, const float* sink, const float* qn, const float* kn, LAS unsigned char* lds, bool wr) {
  constexpr int KP = 136, VP = 144;
  LAS bf16_t* Ks = (LAS bf16_t*)lds;
  LAS bf16_t* Vs = (LAS bf16_t*)(lds + 2 * 64 * KP * 2);
  LAS float* dsc = (LAS float*)(lds + 2 * 64 * KP * 2 + 2 * 64 * VP * 2);
  const int tid = threadIdx.x, lane = tid & 63, wid = tid >> 6, r = lane & 15, Qd = lane >> 4;
  float mb;
  { float a = fmaxf(fabsf(qn[lane]), fabsf(qn[64 + lane])), b = fmaxf(fabsf(kn[lane]), fabsf(kn[64 + lane]));
#pragma unroll
    for (int o = 1; o < 64; o <<= 1) { a = fmaxf(a, __shfl_xor(a, o)); b = fmaxf(b, __shfl_xor(b, o)); }
    mb = a * b * 11.313708498984761f * 1.4426950408889634f; }
  for (int task = virt_block(); task < 1024; task += gridDim.x) {
    const int b = task >> 9, kvh = (task >> 7) & 3, qt = task & 127;
    const int hq = kvh * 4 + (wid >> 1), qoff = (wid & 1) * 32;
    const size_t qrow0 = (size_t)b * SEQ + qt * 64 + qoff;
    bf16x8 qf[2][4];
#pragma unroll
    for (int m = 0; m < 2; ++m)
#pragma unroll
      for (int ks = 0; ks < 4; ++ks) qf[m][ks] = *(const bf16x8*)(Q1 + (qrow0 + 16 * m + r) * 2048 + hq * 128 + ks * 32 + 8 * Qd);
    const int tlo = (2 - qt) > 0 ? (2 - qt) : 0, thi = (129 - qt) < 4 ? (129 - qt) : 4, nband = thi - tlo + 1, ntile = nband + 4;
    const int skey = tid >> 4, sch = tid & 15;
    v4u kreg[2], vreg[2];
#define TILE_ROW0(i) ((i) < nband ? (size_t)b * SEQ + (size_t)(qt - 2 + tlo + (i)) * 64 : (size_t)ML + b * CTXL + ((i) - nband) * 64)
#define LOAD_TILE(i) do { const size_t r0_ = TILE_ROW0(i); _Pragma("unroll") for (int h_ = 0; h_ < 2; ++h_) { const size_t go_ = (r0_ + skey + 32 * h_) * 512 + kvh * 128 + sch * 8; kreg[h_] = *(const v4u*)(K1 + go_); vreg[h_] = *(const v4u*)(V1 + go_); } } while (0)
#define STORE_TILE(buf) do { _Pragma("unroll") for (int h_ = 0; h_ < 2; ++h_) { *(LAS v4u*)(Ks + (buf) * 64 * KP + (skey + 32 * h_) * KP + sch * 8) = kreg[h_]; *(LAS v4u*)(Vs + (buf) * 64 * VP + (skey + 32 * h_) * VP + sch * 8) = vreg[h_]; } } while (0)
    LOAD_TILE(0);
    __syncthreads();
    STORE_TILE(0);
    __syncthreads();
    f32x4 o[2][8];
#pragma unroll
    for (int m = 0; m < 2; ++m)
#pragma unroll
      for (int n = 0; n < 8; ++n) o[m][n] = (f32x4){0.f, 0.f, 0.f, 0.f};
    float lsum[2] = {0.f, 0.f};
    for (int i = 0; i < ntile; ++i) {
      const int buf = i & 1;
      if (i + 1 < ntile) LOAD_TILE(i + 1);
      const int mtype = (i < nband) ? ((tlo + i) == 0 ? 1 : ((tlo + i) == 4 ? 2 : 0)) : 0;
      const LAS bf16_t* Kb = Ks + buf * 64 * KP; const LAS bf16_t* Vb = Vs + buf * 64 * VP;
      f32x4 s[4][2];
#pragma unroll
      for (int t = 0; t < 4; ++t) { s[t][0] = (f32x4){-mb, -mb, -mb, -mb}; s[t][1] = (f32x4){-mb, -mb, -mb, -mb}; }
#pragma unroll
      for (int ks = 0; ks < 4; ++ks)
#pragma unroll
        for (int t = 0; t < 4; ++t) { const bf16x8 kf = *(const LAS bf16x8*)(Kb + (16 * t + r) * KP + ks * 32 + 8 * Qd);
          s[t][0] = __builtin_amdgcn_mfma_f32_16x16x32_bf16(kf, qf[0][ks], s[t][0], 0, 0, 0);
          s[t][1] = __builtin_amdgcn_mfma_f32_16x16x32_bf16(kf, qf[1][ks], s[t][1], 0, 0, 0); }
      bf16x8 pa[2][2];
#pragma unroll
      for (int m = 0; m < 2; ++m) { const int qi = qoff + 16 * m + r;
#pragma unroll
        for (int t = 0; t < 4; ++t) {
          float pv[4];
#pragma unroll
          for (int j = 0; j < 4; ++j) { const int kj = 16 * t + 4 * Qd + j; float pj = __builtin_amdgcn_exp2f(s[t][m][j]);
            if (mtype != 0) { if (mtype == 1) pj = (kj >= qi) ? pj : 0.f; else pj = (kj <= qi) ? pj : 0.f; }
            pv[j] = pj; lsum[m] += pj; }
          const unsigned w0 = pk2(pv[0], pv[1]), w1 = pk2(pv[2], pv[3]);
          pa[m][t >> 1][(t & 1) * 4 + 0] = (short)(w0 & 0xffff); pa[m][t >> 1][(t & 1) * 4 + 1] = (short)(w0 >> 16);
          pa[m][t >> 1][(t & 1) * 4 + 2] = (short)(w1 & 0xffff); pa[m][t >> 1][(t & 1) * 4 + 3] = (short)(w1 >> 16); } }
#pragma unroll
      for (int k2 = 0; k2 < 2; ++k2)
#pragma unroll
        for (int n = 0; n < 8; ++n) {
          const s16x4 lo = tr_read(Vb + (32 * k2 + 4 * Qd + (r >> 2)) * VP + 16 * n + 4 * (r & 3));
          const s16x4 hi = tr_read(Vb + (32 * k2 + 16 + 4 * Qd + (r >> 2)) * VP + 16 * n + 4 * (r & 3));
          const bf16x8 vf = (bf16x8){lo[0], lo[1], lo[2], lo[3], hi[0], hi[1], hi[2], hi[3]};
          o[0][n] = __builtin_amdgcn_mfma_f32_16x16x32_bf16(pa[0][k2], vf, o[0][n], 0, 0, 0);
          o[1][n] = __builtin_amdgcn_mfma_f32_16x16x32_bf16(pa[1][k2], vf, o[1][n], 0, 0, 0); }
      if (i + 1 < ntile) STORE_TILE(buf ^ 1);
      __syncthreads();
    }
#undef TILE_ROW0
#undef LOAD_TILE
#undef STORE_TILE
    const float sk = __builtin_amdgcn_exp2f(sink[hq] * 1.4426950408889634f - mb);
#pragma unroll
    for (int m = 0; m < 2; ++m) { float l = lsum[m]; l += __shfl_xor(l, 16); l += __shfl_xor(l, 32); if (Qd == 0) dsc[wid * 32 + 16 * m + r] = 1.f / (l + sk); }
    LDS_WAIT(); asm volatile("" ::: "memory");
    { LAS bf16_t* stg = (LAS bf16_t*)lds + wid * 32 * 136;
#pragma unroll
      for (int m = 0; m < 2; ++m)
#pragma unroll
        for (int j = 0; j < 4; ++j) { const float inv = dsc[wid * 32 + 16 * m + 4 * Qd + j];
#pragma unroll
          for (int n = 0; n < 8; ++n) stg[(16 * m + 4 * Qd + j) * 136 + 16 * n + r] = f2bf(o[m][n][j] * inv); }
      LDS_WAIT(); asm volatile("" ::: "memory");
#pragma unroll
      for (int q = 0; q < 8; ++q) { const int c = lane + 64 * q, rowl = c >> 4, ch = c & 15; const size_t go = (qrow0 + rowl) * 2048 + hq * 128 + ch * 8;
        const v4u ov = *(const LAS v4u*)(stg + rowl * 136 + ch * 8), gv = *(const v4u*)(G1 + go);
        v4u w; w.x = pk2(__uint_as_float(ov.x << 16) * __uint_as_float(gv.x << 16), __uint_as_float(ov.x & 0xffff0000u) * __uint_as_float(gv.x & 0xffff0000u));
        w.y = pk2(__uint_as_float(ov.y << 16) * __uint_as_float(gv.y << 16), __uint_as_float(ov.y & 0xffff0000u) * __uint_as_float(gv.y & 0xffff0000u));
        w.z = pk2(__uint_as_float(ov.z << 16) * __uint_as_float(gv.z << 16), __uint_as_float(ov.z & 0xffff0000u) * __uint_as_float(gv.z & 0xffff0000u));
        w.w = pk2(__uint_as_float(ov.w << 16) * __uint_as_float(gv.w << 16), __uint_as_float(ov.w & 0xffff0000u) * __uint_as_float(gv.w & 0xffff0000u));
        if (wr) *(v4u*)(Q1 + go) = w; }
      LDS_WAIT(); asm volatile("" ::: "memory"); }
  }
}

constexpr size_t DO_SDT = 50 * MiB, DO_SCS = 53 * MiB;
constexpr size_t WS_SSQ = 237 * MiB;
DEV unsigned short bfbits(float f) { return f2bf(f); }
DEV void ssd_prep_phase(const bf16_t* XBC, const float* cw, const float* cb, bf16_t* XC, const float* DTLR, const float* dt_bias, const float* a_log, float* SDT, float* SCS, float* SDEC) {
  const int gtid = blockIdx.x * 512 + threadIdx.x, gth = gridDim.x * 512;
  for (int it = gtid; it < (MA / 32) * 192; it += gth) {
    const int rg = it / 192, c8 = (it % 192) * 8, row0 = rg * 32;
    int t0, len;
    if (row0 < ML) { t0 = row0 % SEQ; len = SEQ; } else { t0 = (row0 - ML) % CTXL; len = CTXL; }
    float w[5][8], bias[8];
#pragma unroll
    for (int k = 0; k < 5; ++k) { const f32x4 w0 = *(const f32x4*)(cw + k * 1536 + c8), w1 = *(const f32x4*)(cw + k * 1536 + c8 + 4);
      w[k][0] = w0.x; w[k][1] = w0.y; w[k][2] = w0.z; w[k][3] = w0.w; w[k][4] = w1.x; w[k][5] = w1.y; w[k][6] = w1.z; w[k][7] = w1.w; }
    { const f32x4 b0 = *(const f32x4*)(cb + c8), b1 = *(const f32x4*)(cb + c8 + 4); bias[0] = b0.x; bias[1] = b0.y; bias[2] = b0.z; bias[3] = b0.w; bias[4] = b1.x; bias[5] = b1.y; bias[6] = b1.z; bias[7] = b1.w; }
    const v4u zero4 = {0u, 0u, 0u, 0u};
    v4u win[4];
#pragma unroll
    for (int q = 0; q < 4; ++q) { const int tt = t0 - 2 + q; win[q] = (tt >= 0 && tt < len) ? *(const v4u*)(XBC + (size_t)(row0 - 2 + q) * 1536 + c8) : zero4; }
#pragma unroll 4
    for (int i = 0; i < 32; ++i) {
      const int tt = t0 + i + 2; const v4u nx = (tt < len) ? *(const v4u*)(XBC + (size_t)(row0 + i + 2) * 1536 + c8) : zero4;
      float acc[8];
#pragma unroll
      for (int e = 0; e < 8; ++e) acc[e] = bias[e];
#define CONV_TAP(k, xv) do { acc[0] += w[k][0] * __uint_as_float((xv).x << 16); acc[1] += w[k][1] * __uint_as_float((xv).x & 0xffff0000u); acc[2] += w[k][2] * __uint_as_float((xv).y << 16); acc[3] += w[k][3] * __uint_as_float((xv).y & 0xffff0000u); \
        acc[4] += w[k][4] * __uint_as_float((xv).z << 16); acc[5] += w[k][5] * __uint_as_float((xv).z & 0xffff0000u); acc[6] += w[k][6] * __uint_as_float((xv).w << 16); acc[7] += w[k][7] * __uint_as_float((xv).w & 0xffff0000u); } while (0)
      CONV_TAP(0, win[0]); CONV_TAP(1, win[1]); CONV_TAP(2, win[2]); CONV_TAP(3, win[3]); CONV_TAP(4, nx);
#undef CONV_TAP
      v4u o; o.x = pk2(silu_fast(acc[0]), silu_fast(acc[1])); o.y = pk2(silu_fast(acc[2]), silu_fast(acc[3])); o.z = pk2(silu_fast(acc[4]), silu_fast(acc[5])); o.w = pk2(silu_fast(acc[6]), silu_fast(acc[7]));
      *(v4u*)(XC + (size_t)(row0 + i) * 1536 + c8) = o;
      win[0] = win[1]; win[1] = win[2]; win[2] = win[3]; win[3] = nx;
    }
  }
  {
    const int lane = threadIdx.x & 63, wave = threadIdx.x >> 6, cl = lane & 7, seg = lane >> 3;
    for (int wt = blockIdx.x * NWAVES + wave; wt < NCH * 4; wt += gridDim.x * NWAVES) {
      const int gc = wt >> 2, col = (wt & 3) * 8 + cl, dir = col >> 4, h = col & 15;
      const float a = -fexp(a_log[col]), bias = dt_bias[col];
      float dtv[16], v[16]; float run = 0.f;
#pragma unroll
      for (int u = 0; u < 16; ++u) { const int s = seg * 16 + u, t = dir ? 127 - s : s; dtv[u] = softplusf(DTLR[((size_t)gc * 128 + t) * 64 + col] + bias); }
#pragma unroll
      for (int u = 0; u < 16; ++u) { run += dtv[u] * a; v[u] = run; }
      float off = 0.f;
#pragma unroll
      for (int sgi = 0; sgi < 7; ++sgi) { const float tot = __shfl(run, cl + 8 * sgi); off += (sgi < seg) ? tot : 0.f; }
#pragma unroll
      for (int u = 0; u < 16; ++u) { const int s = seg * 16 + u, t = dir ? 127 - s : s; const size_t row = (size_t)gc * 128 + t; SDT[row * 32 + col] = dtv[u]; SCS[row * 32 + col] = v[u] + off; }
      if (seg == 7) SDEC[(gc * 16 + h) * 2 + dir] = fexp(run + off);
    }
  }
}
DEV void ssd_u_phase(const bf16_t* XC, const float* SDT, const float* SCS, bf16_t* ST, LAS unsigned char* lds) {
  constexpr int XP = 272, BP = 144;
  LAS bf16_t* Xs = (LAS bf16_t*)lds; LAS bf16_t* Bs = (LAS bf16_t*)(lds + 128 * XP * 2); LAS float* wtab = (LAS float*)(lds + 128 * XP * 2 + 128 * BP * 2);
  const int tid = threadIdx.x, lane = tid & 63, wid = tid >> 6, r = lane & 15, Qd = lane >> 4, hl = wid >> 1, dir = wid & 1;
  for (int task = virt_block(); task < NCH * 4; task += gridDim.x) {
    const int gc = task >> 2, g = (task >> 1) & 1, hh = task & 1; const size_t r0 = (size_t)gc * 128; const int h0 = g * 8 + hh * 4;
    __syncthreads();
#pragma unroll
    for (int i = 0; i < 8; ++i) { const int cid = tid + 512 * i, row = cid >> 5, ch = cid & 31; *(LAS v4u*)(Xs + row * XP + ch * 8) = *(const v4u*)(XC + (r0 + row) * 1536 + h0 * 64 + ch * 8); }
#pragma unroll
    for (int i = 0; i < 4; ++i) { const int cid = tid + 512 * i, row = cid >> 4, ch = cid & 15; *(LAS v4u*)(Bs + row * BP + ch * 8) = *(const v4u*)(XC + (r0 + row) * 1536 + 1024 + g * 128 + ch * 8); }
    if (tid < 256) { const int d_ = tid >> 7, t = tid & 127;
      const f32x4 ce = *(const f32x4*)(SCS + (r0 + (d_ ? 0 : 127)) * 32 + d_ * 16 + h0), ct = *(const f32x4*)(SCS + (r0 + t) * 32 + d_ * 16 + h0), dt = *(const f32x4*)(SDT + (r0 + t) * 32 + d_ * 16 + h0);
      wtab[(0 * 2 + d_) * 128 + t] = fexp(ce.x - ct.x) * dt.x; wtab[(1 * 2 + d_) * 128 + t] = fexp(ce.y - ct.y) * dt.y; wtab[(2 * 2 + d_) * 128 + t] = fexp(ce.z - ct.z) * dt.z; wtab[(3 * 2 + d_) * 128 + t] = fexp(ce.w - ct.w) * dt.w; }
    __syncthreads();
    const LAS float* wt = wtab + wid * 128;
    bf16_t* Sp = ST + ((((size_t)gc * 16 + h0 + hl) * 2 + dir) * 64) * 128;
#pragma unroll 1
    for (int pp = 0; pp < 2; ++pp) {
      f32x4 acc[8][2];
#pragma unroll
      for (int nt = 0; nt < 8; ++nt) { acc[nt][0] = (f32x4){0.f, 0.f, 0.f, 0.f}; acc[nt][1] = (f32x4){0.f, 0.f, 0.f, 0.f}; }
#pragma unroll 1
      for (int k = 0; k < 4; ++k) {
        const f32x4 wlo = *(const LAS f32x4*)(wt + 32 * k + 4 * Qd), whi = *(const LAS f32x4*)(wt + 32 * k + 16 + 4 * Qd);
        bf16x8 xf[2];
#pragma unroll
        for (int pt = 0; pt < 2; ++pt) {
          const s16x4 lo = tr_read(Xs + (32 * k + 4 * Qd + (r >> 2)) * XP + hl * 64 + 32 * pp + 16 * pt + 4 * (r & 3));
          const s16x4 hi = tr_read(Xs + (32 * k + 16 + 4 * Qd + (r >> 2)) * XP + hl * 64 + 32 * pp + 16 * pt + 4 * (r & 3));
          const unsigned w0 = pk2(bf2f((bf16_t)lo[0]) * wlo[0], bf2f((bf16_t)lo[1]) * wlo[1]), w1 = pk2(bf2f((bf16_t)lo[2]) * wlo[2], bf2f((bf16_t)lo[3]) * wlo[3]);
          const unsigned w2 = pk2(bf2f((bf16_t)hi[0]) * whi[0], bf2f((bf16_t)hi[1]) * whi[1]), w3 = pk2(bf2f((bf16_t)hi[2]) * whi[2], bf2f((bf16_t)hi[3]) * whi[3]);
          xf[pt] = (bf16x8){(short)(w0 & 0xffff), (short)(w0 >> 16), (short)(w1 & 0xffff), (short)(w1 >> 16), (short)(w2 & 0xffff), (short)(w2 >> 16), (short)(w3 & 0xffff), (short)(w3 >> 16)};
        }
#pragma unroll
        for (int nt = 0; nt < 8; ++nt) {
          const s16x4 lo = tr_read(Bs + (32 * k + 4 * Qd + (r >> 2)) * BP + 16 * nt + 4 * (r & 3));
          const s16x4 hi = tr_read(Bs + (32 * k + 16 + 4 * Qd + (r >> 2)) * BP + 16 * nt + 4 * (r & 3));
          const bf16x8 bfr = (bf16x8){lo[0], lo[1], lo[2], lo[3], hi[0], hi[1], hi[2], hi[3]};
          acc[nt][0] = __builtin_amdgcn_mfma_f32_16x16x32_bf16(bfr, xf[0], acc[nt][0], 0, 0, 0);
          acc[nt][1] = __builtin_amdgcn_mfma_f32_16x16x32_bf16(bfr, xf[1], acc[nt][1], 0, 0, 0);
        }
      }
#pragma unroll
      for (int nt = 0; nt < 8; ++nt)
#pragma unroll
        for (int pt = 0; pt < 2; ++pt) { const f32x4 v = acc[nt][pt];
          *(unsigned long long*)(Sp + ((((2 * pp + pt) * 4 + (nt >> 1)) * 64 + ((nt & 1) * 2 + (Qd >> 1)) * 16 + r) * 8 + 4 * (Qd & 1))) = (unsigned long long)pk2(v[0], v[1]) | ((unsigned long long)pk2(v[2], v[3]) << 32); }
    }
  }
}
DEV void ssd_scan_phase(bf16_t* ST, const float* SDEC, bool wr) {
  for (int item = blockIdx.x * 512 + threadIdx.x; item < 2 * 16 * 2 * 2048; item += gridDim.x * 512) {
    const int e4 = item & 2047, dir = (item >> 11) & 1, h = (item >> 12) & 15, b = item >> 16;
    float S0 = 0.f, S1 = 0.f, S2 = 0.f, S3 = 0.f;
#define SCAN_GC(s) (!dir ? ((s) < 2 ? 128 + 2 * b + (s) : b * 64 + ((s) - 2)) : ((s) < 2 ? 128 + 2 * b + (1 - (s)) : b * 64 + (65 - (s))))
    for (int s0 = 0; s0 < 66; s0 += 6) {
      unsigned long long u[6]; float dec[6];
#pragma unroll
      for (int q = 0; q < 6; ++q) { const int gc = SCAN_GC(s0 + q); u[q] = *(const unsigned long long*)(ST + (((size_t)gc * 16 + h) * 2 + dir) * 8192 + e4 * 4); dec[q] = SDEC[(gc * 16 + h) * 2 + dir]; }
#pragma unroll
      for (int q = 0; q < 6; ++q) { const int gc = SCAN_GC(s0 + q);
        if (wr) *(unsigned long long*)(ST + (((size_t)gc * 16 + h) * 2 + dir) * 8192 + e4 * 4) = (unsigned long long)pk2(S0, S1) | ((unsigned long long)pk2(S2, S3) << 32);
        const unsigned lo = (unsigned)u[q], hi = (unsigned)(u[q] >> 32);
        S0 = dec[q] * S0 + __uint_as_float(lo << 16); S1 = dec[q] * S1 + __uint_as_float(lo & 0xffff0000u); S2 = dec[q] * S2 + __uint_as_float(hi << 16); S3 = dec[q] * S3 + __uint_as_float(hi & 0xffff0000u); }
    }
#undef SCAN_GC
  }
}
DEV bf16x8 scale_frag(bf16x8 f, float s) {
  bf16x8 o;
#pragma unroll
  for (int e = 0; e < 8; e += 2) { const unsigned w = pk2(bf2f((bf16_t)f[e]) * s, bf2f((bf16_t)f[e + 1]) * s); o[e] = (short)(w & 0xffff); o[e + 1] = (short)(w >> 16); }
  return o;
}
DEV void ssd_y_phase(const bf16_t* XC, const float* SDT, const float* SCS, const bf16_t* ST, const float* d_skip, bf16_t* Y0, float* SSQ, LAS unsigned char* lds, bool wr) {
  constexpr int XP = 272, BP = 136, SP = 72;
  LAS bf16_t* Xs = (LAS bf16_t*)lds; LAS bf16_t* Bs = (LAS bf16_t*)(lds + 128 * XP * 2);
  LAS float* tab = (LAS float*)(lds + 128 * XP * 2 + 128 * BP * 2);
  LAS float* ssq = tab + 4 * 4 * 128;
  LAS bf16_t* stg = (LAS bf16_t*)(ssq + 4 * 128);
  const int tid = threadIdx.x, lane = tid & 63, wid = tid >> 6, r = lane & 15, Qd = lane >> 4, hl = wid >> 1, ih = wid & 1;
  LAS bf16_t* mystg = stg + wid * 16 * SP;
  for (int task = virt_block(); task < NCH * 4; task += gridDim.x) {
    const int gc = task >> 2, g = (task >> 1) & 1, hh = task & 1; const size_t r0 = (size_t)gc * 128; const int h0 = g * 8 + hh * 4, h = h0 + hl;
    bf16x8 cstrip[4], cf[4][4];
#pragma unroll
    for (int ks = 0; ks < 4; ++ks) cstrip[ks] = *(const bf16x8*)(XC + (r0 + 16 * wid + r) * 1536 + 1280 + g * 128 + 32 * ks + 8 * Qd);
#pragma unroll
    for (int m = 0; m < 4; ++m)
#pragma unroll
      for (int ks = 0; ks < 4; ++ks) cf[m][ks] = *(const bf16x8*)(XC + (r0 + 64 * ih + 16 * m + r) * 1536 + 1280 + g * 128 + 32 * ks + 8 * Qd);
    __syncthreads();
#pragma unroll
    for (int i = 0; i < 8; ++i) { const int cid = tid + 512 * i, row = cid >> 5, ch = cid & 31; *(LAS v4u*)(Xs + row * XP + ch * 8) = *(const v4u*)(XC + (r0 + row) * 1536 + h0 * 64 + ch * 8); }
#pragma unroll
    for (int i = 0; i < 4; ++i) { const int cid = tid + 512 * i, row = cid >> 4, ch = cid & 15; *(LAS v4u*)(Bs + row * BP + ch * 8) = *(const v4u*)(XC + (r0 + row) * 1536 + 1024 + g * 128 + ch * 8); }
    { const int which = tid >> 7, t = tid & 127; const f32x4 v = *(const f32x4*)((which < 2 ? SCS : SDT) + (r0 + t) * 32 + (which & 1) * 16 + h0);
      tab[0 * 512 + which * 128 + t] = v.x; tab[1 * 512 + which * 128 + t] = v.y; tab[2 * 512 + which * 128 + t] = v.z; tab[3 * 512 + which * 128 + t] = v.w; }
    __syncthreads();
    {
      f32x4 cb[8];
#pragma unroll
      for (int t = 0; t < 8; ++t) { f32x4 c = {0.f, 0.f, 0.f, 0.f};
#pragma unroll
        for (int ks = 0; ks < 4; ++ks) { const bf16x8 bfr = *(const LAS bf16x8*)(Bs + (16 * t + r) * BP + 32 * ks + 8 * Qd); c = __builtin_amdgcn_mfma_f32_16x16x32_bf16(bfr, cstrip[ks], c, 0, 0, 0); }
        cb[t] = c; }
      __syncthreads();
#pragma unroll
      for (int t = 0; t < 8; ++t) *(LAS unsigned long long*)(Bs + (16 * wid + r) * BP + 16 * t + 4 * Qd) = (unsigned long long)pk2(cb[t][0], cb[t][1]) | ((unsigned long long)pk2(cb[t][2], cb[t][3]) << 32);
      __syncthreads();
    }
    const LAS float* csf = tab + hl * 512; const LAS float* csb = csf + 128; const LAS float* dtf = csf + 256; const LAS float* dtb = csf + 384;
    const float dsk = d_skip[h];
    f32x4 y[4][4];
#pragma unroll
    for (int m = 0; m < 4; ++m)
#pragma unroll
      for (int pt = 0; pt < 4; ++pt) y[m][pt] = (f32x4){0.f, 0.f, 0.f, 0.f};
    if (wr || !(PROBE_SKIP & 1))
#pragma unroll 1
    for (int dir = 0; dir < 2; ++dir) {
      const LAS float* csd = dir ? csb : csf; float sc[4];
#pragma unroll
      for (int m = 0; m < 4; ++m)
#pragma unroll
        for (int ks = 0; ks < 4; ++ks) asm volatile("" : "+v"(cf[m][ks]));
#pragma unroll
      for (int m = 0; m < 4; ++m) sc[m] = fexp(csd[64 * ih + 16 * m + r]);
      const bf16_t* Sp = ST + (((size_t)gc * 16 + h) * 2 + dir) * 8192 + lane * 8;
#pragma unroll
      for (int ks = 0; ks < 4; ++ks) {
        bf16x8 sf[4];
#pragma unroll
        for (int pt = 0; pt < 4; ++pt) sf[pt] = *(const bf16x8*)(Sp + (pt * 4 + ks) * 512);
#pragma unroll
        for (int m = 0; m < 4; ++m) { const bf16x8 a = scale_frag(cf[m][ks], sc[m]);
#pragma unroll
          for (int pt = 0; pt < 4; ++pt) y[m][pt] = __builtin_amdgcn_mfma_f32_16x16x32_bf16(a, sf[pt], y[m][pt], 0, 0, 0);
          __builtin_amdgcn_sched_barrier(0); }
      }
    }
#pragma unroll 1
    for (int m = 0; m < 4; ++m) {
      const int i0 = 64 * ih + 16 * m, i = i0 + r;
      const float cfi = csf[i], cbi = csb[i];
      v4u zpre[2];
#pragma unroll
      for (int q = 0; q < 2; ++q) { const int c = lane + 64 * q; zpre[q] = *(const v4u*)(Y0 + (r0 + i0 + (c >> 3)) * 2048 + h * 64 + (c & 7) * 8); }
      if (wr || !(PROBE_SKIP & 2))
#pragma unroll 1
      for (int k2 = 0; k2 < 4; ++k2) {
        const int j0 = 32 * k2 + 8 * Qd;
        const v4u cbv = *(const LAS v4u*)(Bs + i * BP + j0);
        const float cbe[8] = {__uint_as_float(cbv.x << 16), __uint_as_float(cbv.x & 0xffff0000u), __uint_as_float(cbv.y << 16), __uint_as_float(cbv.y & 0xffff0000u), __uint_as_float(cbv.z << 16), __uint_as_float(cbv.z & 0xffff0000u), __uint_as_float(cbv.w << 16), __uint_as_float(cbv.w & 0xffff0000u)};
        float pv[8];
        const bool dofwd = (32 * k2 <= i0 + 15), dobwd = (32 * k2 + 31 >= i0);
#pragma unroll
        for (int e = 0; e < 8; ++e) pv[e] = (j0 + e == i) ? dsk : 0.f;
        if (dofwd) { const f32x4 a0 = *(const LAS f32x4*)(csf + j0), a1 = *(const LAS f32x4*)(csf + j0 + 4), d0 = *(const LAS f32x4*)(dtf + j0), d1 = *(const LAS f32x4*)(dtf + j0 + 4);
          const float jc[8] = {a0.x, a0.y, a0.z, a0.w, a1.x, a1.y, a1.z, a1.w}; const float jd[8] = {d0.x, d0.y, d0.z, d0.w, d1.x, d1.y, d1.z, d1.w};
#pragma unroll
          for (int e = 0; e < 8; ++e) pv[e] += cbe[e] * fexp(j0 + e <= i ? cfi - jc[e] : -INFINITY) * jd[e]; }
        if (dobwd) { const f32x4 a0 = *(const LAS f32x4*)(csb + j0), a1 = *(const LAS f32x4*)(csb + j0 + 4), d0 = *(const LAS f32x4*)(dtb + j0), d1 = *(const LAS f32x4*)(dtb + j0 + 4);
          const float jc[8] = {a0.x, a0.y, a0.z, a0.w, a1.x, a1.y, a1.z, a1.w}; const float jd[8] = {d0.x, d0.y, d0.z, d0.w, d1.x, d1.y, d1.z, d1.w};
#pragma unroll
          for (int e = 0; e < 8; ++e) pv[e] += cbe[e] * fexp(j0 + e >= i ? cbi - jc[e] : -INFINITY) * jd[e]; }
        const unsigned w0 = pk2(pv[0], pv[1]), w1 = pk2(pv[2], pv[3]), w2 = pk2(pv[4], pv[5]), w3 = pk2(pv[6], pv[7]);
        const bf16x8 pa = (bf16x8){(short)(w0 & 0xffff), (short)(w0 >> 16), (short)(w1 & 0xffff), (short)(w1 >> 16), (short)(w2 & 0xffff), (short)(w2 >> 16), (short)(w3 & 0xffff), (short)(w3 >> 16)};
#pragma unroll
        for (int pt = 0; pt < 4; ++pt) {
          const s16x4 lo = tr_read(Xs + (32 * k2 + 8 * Qd + (r >> 2)) * XP + hl * 64 + 16 * pt + 4 * (r & 3));
          const s16x4 hi = tr_read(Xs + (32 * k2 + 8 * Qd + 4 + (r >> 2)) * XP + hl * 64 + 16 * pt + 4 * (r & 3));
          const bf16x8 xf = (bf16x8){lo[0], lo[1], lo[2], lo[3], hi[0], hi[1], hi[2], hi[3]};
          y[0][pt] = __builtin_amdgcn_mfma_f32_16x16x32_bf16(pa, xf, y[0][pt], 0, 0, 0);
        }
      }
      if (wr || !(PROBE_SKIP & 4)) {
#pragma unroll
      for (int pt = 0; pt < 4; ++pt)
#pragma unroll
        for (int jj = 0; jj < 4; ++jj) mystg[(4 * Qd + jj) * SP + 16 * pt + r] = f2bf(y[0][pt][jj]);
      LDS_WAIT(); asm volatile("" ::: "memory");
#pragma unroll
      for (int q = 0; q < 2; ++q) { const int c = lane + 64 * q, rowl = c >> 3, ch = c & 7; const int il = 64 * ih + 16 * m + rowl;
        const v4u yv = *(const LAS v4u*)(mystg + rowl * SP + ch * 8); bf16_t* zp = Y0 + (r0 + il) * 2048 + h * 64 + ch * 8; const v4u zv = zpre[q];
        const float v0 = __uint_as_float(yv.x << 16) * __uint_as_float(zv.x << 16), v1 = __uint_as_float(yv.x & 0xffff0000u) * __uint_as_float(zv.x & 0xffff0000u);
        const float v2 = __uint_as_float(yv.y << 16) * __uint_as_float(zv.y << 16), v3 = __uint_as_float(yv.y & 0xffff0000u) * __uint_as_float(zv.y & 0xffff0000u);
        const float v4 = __uint_as_float(yv.z << 16) * __uint_as_float(zv.z << 16), v5 = __uint_as_float(yv.z & 0xffff0000u) * __uint_as_float(zv.z & 0xffff0000u);
        const float v6 = __uint_as_float(yv.w << 16) * __uint_as_float(zv.w << 16), v7 = __uint_as_float(yv.w & 0xffff0000u) * __uint_as_float(zv.w & 0xffff0000u);
        float ss = (v0 * v0 + v1 * v1) + (v2 * v2 + v3 * v3) + (v4 * v4 + v5 * v5) + (v6 * v6 + v7 * v7);
        ss += __shfl_xor(ss, 1); ss += __shfl_xor(ss, 2); ss += __shfl_xor(ss, 4);
        v4u ov; ov.x = pk2(v0, v1); ov.y = pk2(v2, v3); ov.z = pk2(v4, v5); ov.w = pk2(v6, v7);
        if (wr) *(v4u*)zp = ov;
        if (ch == 0) ssq[hl * 128 + il] = ss; }
      LDS_WAIT(); asm volatile("" ::: "memory");
      }
#pragma unroll
      for (int pt = 0; pt < 4; ++pt) { y[0][pt] = y[1][pt]; y[1][pt] = y[2][pt]; y[2][pt] = y[3][pt]; }
    }
    __syncthreads();
    if (tid < 128) SSQ[((r0 + tid) * 2 + g) * 2 + hh] = (ssq[tid] + ssq[128 + tid]) + (ssq[256 + tid] + ssq[384 + tid]);
  }
}

constexpr size_t WS_GCSC = 237 * MiB + 4 * MiB;
typedef _Float16 h16_t;
typedef _Float16 h16x8 __attribute__((ext_vector_type(8)));
DEV const h16_t* gcs_row(const h16_t* wsb, const h16_t* outb, size_t row) {
  return row < 9472 ? (const h16_t*)((const char*)wsb + 237 * MiB + 512 * 1024) + row * 1024 : (row < 13824 ? (const h16_t*)((const char*)outb + 55 * MiB + 512 * 1024) + (row - 9472) * 1024 : (const h16_t*)((const char*)wsb + 2 * MiB) + (row - 13824) * 1024); }
DEV h16_t* gcs_row_w(h16_t* wsb, h16_t* outb, size_t row) { return (h16_t*)gcs_row(wsb, outb, row); }
DEV float logsig_fast(float x) { return fminf(x, 0.f) - 0.6931471805599453f * __builtin_amdgcn_logf(1.f + __builtin_amdgcn_exp2f(-1.4426950408889634f * fabsf(x))); }
DEV void gla_cs_phase(const float* DTLR, const float* gw, const float* gb, h16_t* GCSL, h16_t* GCSC, float* GDEC, LAS unsigned char* lds, unsigned* queue) {
  const int lane = threadIdx.x & 63, wave = threadIdx.x >> 6;
  LAS float* lrs = (LAS float*)(lds + wave * 8192);
  LAS h16_t* tile = (LAS h16_t*)(lds + 65536 + wave * 1024);
  for (;;) {
    unsigned wt_ = 0u; if (lane == 0) wt_ = __hip_atomic_fetch_add(queue, 1u, __ATOMIC_RELAXED, __HIP_MEMORY_SCOPE_AGENT);
    wt_ = (unsigned)__builtin_amdgcn_readfirstlane((int)wt_); if (wt_ >= (unsigned)(NCH * 2 * 8)) break;
    const int wt = (int)wt_;
    const int gc = wt >> 4, dir = (wt >> 3) & 1, k = (wt & 7) * 64 + lane;
#pragma unroll
    for (int q = 0; q < 8; ++q) { const int c = lane + 64 * q, row = c >> 2, part = c & 3;
      *(LAS f32x4*)(lrs + row * 16 + part * 4) = *(const f32x4*)(DTLR + ((size_t)gc * 128 + row) * 64 + 32 + dir * 16 + part * 4); }
    float wv[16];
#pragma unroll
    for (int q = 0; q < 16; ++q) wv[q] = gw[(dir * 16 + q) * 512 + k];
    const float bias = gb[dir * 512 + k];
    LDS_WAIT(); asm volatile("" ::: "memory");
    float run = 0.f;
#pragma unroll 1
    for (int s0 = 0; s0 < 128; s0 += 8) {
      float lg[8];
#pragma unroll
      for (int u = 0; u < 8; ++u) { const int s = s0 + u, t = dir ? 127 - s : s; const LAS float* lr = lrs + t * 16;
        const f32x4 l0 = *(const LAS f32x4*)lr, l1 = *(const LAS f32x4*)(lr + 4), l2 = *(const LAS f32x4*)(lr + 8), l3 = *(const LAS f32x4*)(lr + 12);
        const float x = bias + l0.x * wv[0] + l0.y * wv[1] + l0.z * wv[2] + l0.w * wv[3] + l1.x * wv[4] + l1.y * wv[5] + l1.z * wv[6] + l1.w * wv[7]
                        + l2.x * wv[8] + l2.y * wv[9] + l2.z * wv[10] + l2.w * wv[11] + l3.x * wv[12] + l3.y * wv[13] + l3.z * wv[14] + l3.w * wv[15];
        lg[u] = logsig_fast(x) * (1.f / 16.f); }
#pragma unroll
      for (int u = 0; u < 8; ++u) { run += lg[u]; tile[u * 64 + lane] = (h16_t)run; }
      LDS_WAIT(); asm volatile("" ::: "memory");
      { const int u = lane >> 3, ch = lane & 7, s = s0 + u, t = dir ? 127 - s : s;
        *(v4u*)(gcs_row_w(GCSL, GCSC, (size_t)gc * 128 + t) + dir * 512 + (k - lane) + ch * 8) = *(const LAS v4u*)(tile + u * 64 + ch * 8); }
      LDS_WAIT(); asm volatile("" ::: "memory");
    }
    GDEC[((gc * 4 + (k >> 7)) * 2 + dir) * 128 + (k & 127)] = fexp(run);
    LDS_WAIT(); asm volatile("" ::: "memory");
  }
}
DEV void gla_u_phase(const bf16_t* K0, const bf16_t* V0, const h16_t* GCSL, const h16_t* GCSC, bf16_t* ST, LAS unsigned char* lds) {
  constexpr int VP = 272, KP = 144;
  LAS bf16_t* Vs = (LAS bf16_t*)lds; LAS bf16_t* Kd = (LAS bf16_t*)(lds + 128 * VP * 2);
  const int tid = threadIdx.x, lane = tid & 63, wid = tid >> 6, r = lane & 15, Qd = lane >> 4;
  for (int task = virt_block(); task < NCH * 4; task += gridDim.x) {
    const int gc = task >> 2, h = task & 3; const size_t r0 = (size_t)gc * 128;
    __syncthreads();
#pragma unroll
    for (int i = 0; i < 8; ++i) { const int cid = tid + 512 * i, row = cid >> 5, ch = cid & 31; *(LAS v4u*)(Vs + row * VP + ch * 8) = *(const v4u*)(V0 + (r0 + row) * 1024 + h * 256 + ch * 8); }
#pragma unroll
    for (int i = 0; i < 4; ++i) { const int cid = tid + 512 * i, t = cid >> 4, ch = cid & 15;
      const v4u kv = *(const v4u*)(K0 + (r0 + t) * 512 + h * 128 + ch * 8);
      const float kf[8] = {__uint_as_float(kv.x << 16), __uint_as_float(kv.x & 0xffff0000u), __uint_as_float(kv.y << 16), __uint_as_float(kv.y & 0xffff0000u), __uint_as_float(kv.z << 16), __uint_as_float(kv.z & 0xffff0000u), __uint_as_float(kv.w << 16), __uint_as_float(kv.w & 0xffff0000u)};
#pragma unroll
      for (int dir = 0; dir < 2; ++dir) {
        const h16x8 ce = *(const h16x8*)(gcs_row(GCSL, GCSC, r0 + (dir ? 0 : 127)) + dir * 512 + h * 128 + ch * 8), ct = *(const h16x8*)(gcs_row(GCSL, GCSC, r0 + t) + dir * 512 + h * 128 + ch * 8);
        v4u o; o.x = pk2(kf[0] * fexp((float)ce[0] - (float)ct[0]), kf[1] * fexp((float)ce[1] - (float)ct[1])); o.y = pk2(kf[2] * fexp((float)ce[2] - (float)ct[2]), kf[3] * fexp((float)ce[3] - (float)ct[3]));
        o.z = pk2(kf[4] * fexp((float)ce[4] - (float)ct[4]), kf[5] * fexp((float)ce[5] - (float)ct[5])); o.w = pk2(kf[6] * fexp((float)ce[6] - (float)ct[6]), kf[7] * fexp((float)ce[7] - (float)ct[7]));
        *(LAS v4u*)(Kd + dir * 128 * KP + t * KP + ch * 8) = o; } }
    __syncthreads();
#pragma unroll 1
    for (int dir = 0; dir < 2; ++dir) {
      const LAS bf16_t* Kb = Kd + dir * 128 * KP;
      f32x4 acc[8][2];
#pragma unroll
      for (int dt = 0; dt < 8; ++dt) { acc[dt][0] = (f32x4){0.f, 0.f, 0.f, 0.f}; acc[dt][1] = (f32x4){0.f, 0.f, 0.f, 0.f}; }
#pragma unroll 1
      for (int k = 0; k < 4; ++k) {
        bf16x8 vf[2];
#pragma unroll
        for (int et = 0; et < 2; ++et) {
          const s16x4 lo = tr_read(Vs + (32 * k + 4 * Qd + (r >> 2)) * VP + 32 * wid + 16 * et + 4 * (r & 3));
          const s16x4 hi = tr_read(Vs + (32 * k + 16 + 4 * Qd + (r >> 2)) * VP + 32 * wid + 16 * et + 4 * (r & 3));
          vf[et] = (bf16x8){lo[0], lo[1], lo[2], lo[3], hi[0], hi[1], hi[2], hi[3]}; }
#pragma unroll
        for (int dt = 0; dt < 8; ++dt) {
          const s16x4 lo = tr_read(Kb + (32 * k + 4 * Qd + (r >> 2)) * KP + 16 * dt + 4 * (r & 3));
          const s16x4 hi = tr_read(Kb + (32 * k + 16 + 4 * Qd + (r >> 2)) * KP + 16 * dt + 4 * (r & 3));
          const bf16x8 kfr = (bf16x8){lo[0], lo[1], lo[2], lo[3], hi[0], hi[1], hi[2], hi[3]};
          acc[dt][0] = __builtin_amdgcn_mfma_f32_16x16x32_bf16(kfr, vf[0], acc[dt][0], 0, 0, 0);
          acc[dt][1] = __builtin_amdgcn_mfma_f32_16x16x32_bf16(kfr, vf[1], acc[dt][1], 0, 0, 0); }
      }
      bf16_t* Sp = ST + (((size_t)gc * 4 + h) * 2 + dir) * 32768;
#pragma unroll
      for (int dt = 0; dt < 8; ++dt)
#pragma unroll
        for (int et = 0; et < 2; ++et) { const f32x4 v = acc[dt][et];
          *(unsigned long long*)(Sp + ((((2 * wid + et) * 4 + (dt >> 1)) * 64 + ((dt & 1) * 2 + (Qd >> 1)) * 16 + r) * 8 + 4 * (Qd & 1))) = (unsigned long long)pk2(v[0], v[1]) | ((unsigned long long)pk2(v[2], v[3]) << 32); }
    }
  }
}
DEV void gla_scan_phase(bf16_t* ST, const float* GDEC, bool wr) {
  for (int item = blockIdx.x * 512 + threadIdx.x; item < 2 * 4 * 2 * 8192; item += gridDim.x * 512) {
    const int e4 = item & 8191, dir = (item >> 13) & 1, h = (item >> 14) & 3, b = item >> 16; const int d0 = 32 * ((e4 >> 7) & 3) + 8 * ((e4 >> 5) & 3) + 4 * (e4 & 1);
    float S0 = 0.f, S1 = 0.f, S2 = 0.f, S3 = 0.f;
#define SCAN_GC(s) (!dir ? ((s) < 2 ? 128 + 2 * b + (s) : b * 64 + ((s) - 2)) : ((s) < 2 ? 128 + 2 * b + (1 - (s)) : b * 64 + (65 - (s))))
    for (int s0 = 0; s0 < 66; s0 += 6) {
      unsigned long long u[6]; f32x4 dec[6];
#pragma unroll
      for (int q = 0; q < 6; ++q) { const int gc = SCAN_GC(s0 + q); u[q] = *(const unsigned long long*)(ST + (((size_t)gc * 4 + h) * 2 + dir) * 32768 + e4 * 4); dec[q] = *(const f32x4*)(GDEC + ((gc * 4 + h) * 2 + dir) * 128 + d0); }
#pragma unroll
      for (int q = 0; q < 6; ++q) { const int gc = SCAN_GC(s0 + q);
        if (wr) *(unsigned long long*)(ST + (((size_t)gc * 4 + h) * 2 + dir) * 32768 + e4 * 4) = (unsigned long long)pk2(S0, S1) | ((unsigned long long)pk2(S2, S3) << 32);
        const unsigned lo = (unsigned)u[q], hi = (unsigned)(u[q] >> 32);
        S0 = dec[q].x * S0 + __uint_as_float(lo << 16); S1 = dec[q].y * S1 + __uint_as_float(lo & 0xffff0000u); S2 = dec[q].z * S2 + __uint_as_float(hi << 16); S3 = dec[q].w * S3 + __uint_as_float(hi & 0xffff0000u); }
    }
#undef SCAN_GC
  }
}
DEV void gla_o_phase(const bf16_t* Q0, const bf16_t* K0, const bf16_t* V0, const h16_t* GCSL, const h16_t* GCSC, const bf16_t* ST, const float* gla_norm, const float* SSQ, const float* ssd_norm, bf16_t* Y0, LAS unsigned char* lds, bool wr) {
  constexpr int VP = 272, KP = 136;
  LAS bf16_t* Vs = (LAS bf16_t*)lds; LAS bf16_t* Kd = (LAS bf16_t*)(lds + 128 * VP * 2);
  const int tid = threadIdx.x, lane = tid & 63, wid = tid >> 6, r = lane & 15, Qd = lane >> 4;
  const float scale = 0.08838834764831845f;
  for (int task = virt_block(); task < NCH * 4; task += gridDim.x) {
    const int gc = task >> 2, h = task & 3; const size_t r0 = (size_t)gc * 128;
    __syncthreads();
#pragma unroll
    for (int i = 0; i < 8; ++i) { const int cid = tid + 512 * i, row = cid >> 5, ch = cid & 31; *(LAS v4u*)(Vs + row * VP + ch * 8) = *(const v4u*)(V0 + (r0 + row) * 1024 + h * 256 + ch * 8); }
#pragma unroll
    for (int i = 0; i < 4; ++i) { const int cid = tid + 512 * i, t = cid >> 4, ch = cid & 15;
      const v4u kv = *(const v4u*)(K0 + (r0 + t) * 512 + h * 128 + ch * 8);
      const float kf[8] = {__uint_as_float(kv.x << 16), __uint_as_float(kv.x & 0xffff0000u), __uint_as_float(kv.y << 16), __uint_as_float(kv.y & 0xffff0000u), __uint_as_float(kv.z << 16), __uint_as_float(kv.z & 0xffff0000u), __uint_as_float(kv.w << 16), __uint_as_float(kv.w & 0xffff0000u)};
#pragma unroll
      for (int dir = 0; dir < 2; ++dir) {
        const h16x8 ct = *(const h16x8*)(gcs_row(GCSL, GCSC, r0 + t) + dir * 512 + h * 128 + ch * 8);
        v4u o; o.x = pk2(kf[0] * fexp(-(float)ct[0]), kf[1] * fexp(-(float)ct[1])); o.y = pk2(kf[2] * fexp(-(float)ct[2]), kf[3] * fexp(-(float)ct[3]));
        o.z = pk2(kf[4] * fexp(-(float)ct[4]), kf[5] * fexp(-(float)ct[5])); o.w = pk2(kf[6] * fexp(-(float)ct[6]), kf[7] * fexp(-(float)ct[7]));
        *(LAS v4u*)(Kd + dir * 128 * KP + t * KP + ch * 8) = o; } }
    __syncthreads();
    const int i = 16 * wid + r;
    f32x4 o[16];
#pragma unroll
    for (int et = 0; et < 16; ++et) o[et] = (f32x4){0.f, 0.f, 0.f, 0.f};
#pragma unroll 1
    for (int dir = 0; dir < 2; ++dir) {
      bf16x8 qd[4];
      { const h16_t* ci = gcs_row(GCSL, GCSC, r0 + i) + dir * 512 + h * 128; const bf16_t* qp = Q0 + (r0 + i) * 512 + h * 128;
#pragma unroll
        for (int ks = 0; ks < 4; ++ks) { const v4u qv = *(const v4u*)(qp + 32 * ks + 8 * Qd); const h16x8 cc = *(const h16x8*)(ci + 32 * ks + 8 * Qd);
          const f32x4 c0 = {(float)cc[0], (float)cc[1], (float)cc[2], (float)cc[3]}, c1 = {(float)cc[4], (float)cc[5], (float)cc[6], (float)cc[7]};
          const unsigned w0 = pk2(__uint_as_float(qv.x << 16) * scale * fexp(c0.x), __uint_as_float(qv.x & 0xffff0000u) * scale * fexp(c0.y));
          const unsigned w1 = pk2(__uint_as_float(qv.y << 16) * scale * fexp(c0.z), __uint_as_float(qv.y & 0xffff0000u) * scale * fexp(c0.w));
          const unsigned w2 = pk2(__uint_as_float(qv.z << 16) * scale * fexp(c1.x), __uint_as_float(qv.z & 0xffff0000u) * scale * fexp(c1.y));
          const unsigned w3 = pk2(__uint_as_float(qv.w << 16) * scale * fexp(c1.z), __uint_as_float(qv.w & 0xffff0000u) * scale * fexp(c1.w));
          qd[ks] = (bf16x8){(short)(w0 & 0xffff), (short)(w0 >> 16), (short)(w1 & 0xffff), (short)(w1 >> 16), (short)(w2 & 0xffff), (short)(w2 >> 16), (short)(w3 & 0xffff), (short)(w3 >> 16)}; } }
      const bf16_t* Sp = ST + (((size_t)gc * 4 + h) * 2 + dir) * 32768 + lane * 8;
      {
        bf16x8 sA[4], sB[4];
#pragma unroll
        for (int q = 0; q < 4; ++q) sA[q] = *(const bf16x8*)(Sp + (q * 4 + 0) * 512);
#pragma unroll
        for (int bi = 0; bi < 16; ++bi) {
          const int ks = bi >> 2, e0 = 4 * (bi & 3);
          if (bi + 1 < 16) { const int ks2 = (bi + 1) >> 2, e2 = 4 * ((bi + 1) & 3);
#pragma unroll
            for (int q = 0; q < 4; ++q) { if (bi & 1) sA[q] = *(const bf16x8*)(Sp + ((e2 + q) * 4 + ks2) * 512); else sB[q] = *(const bf16x8*)(Sp + ((e2 + q) * 4 + ks2) * 512); } }
#pragma unroll
          for (int q = 0; q < 4; ++q) o[e0 + q] = __builtin_amdgcn_mfma_f32_16x16x32_bf16(qd[ks], (bi & 1) ? sB[q] : sA[q], o[e0 + q], 0, 0, 0);
          __builtin_amdgcn_sched_barrier(0);
        }
      }
      const LAS bf16_t* Kb = Kd + dir * 128 * KP;
#pragma unroll 1
      for (int k2 = 0; k2 < 4; ++k2) {
        const bool need = dir ? (2 * k2 + 1 >= wid) : (2 * k2 <= wid);
        if (!need) continue;
        bf16x8 pa;
#pragma unroll
        for (int tt = 0; tt < 2; ++tt) { const int t = 2 * k2 + tt;
          f32x4 c = {0.f, 0.f, 0.f, 0.f};
#pragma unroll
          for (int ks = 0; ks < 4; ++ks) { const bf16x8 kfr = *(const LAS bf16x8*)(Kb + (16 * t + r) * KP + 32 * ks + 8 * Qd); c = __builtin_amdgcn_mfma_f32_16x16x32_bf16(kfr, qd[ks], c, 0, 0, 0); }
          float pv[4];
#pragma unroll
          for (int jj = 0; jj < 4; ++jj) { const int j = 16 * t + 4 * Qd + jj; const bool ok = dir ? (j >= i) : (j <= i); pv[jj] = ok ? c[jj] : 0.f; }
          const unsigned w0 = pk2(pv[0], pv[1]), w1 = pk2(pv[2], pv[3]);
          pa[tt * 4 + 0] = (short)(w0 & 0xffff); pa[tt * 4 + 1] = (short)(w0 >> 16); pa[tt * 4 + 2] = (short)(w1 & 0xffff); pa[tt * 4 + 3] = (short)(w1 >> 16); }
#pragma unroll
        for (int et = 0; et < 16; ++et) {
          const s16x4 lo = tr_read(Vs + (32 * k2 + 4 * Qd + (r >> 2)) * VP + 16 * et + 4 * (r & 3));
          const s16x4 hi = tr_read(Vs + (32 * k2 + 16 + 4 * Qd + (r >> 2)) * VP + 16 * et + 4 * (r & 3));
          const bf16x8 vf = (bf16x8){lo[0], lo[1], lo[2], lo[3], hi[0], hi[1], hi[2], hi[3]};
          o[et] = __builtin_amdgcn_mfma_f32_16x16x32_bf16(pa, vf, o[et], 0, 0, 0); }
      }
    }
#pragma unroll
    for (int jj = 0; jj < 4; ++jj) { float ss = 0.f;
#pragma unroll
      for (int et = 0; et < 16; ++et) ss += o[et][jj] * o[et][jj];
      ss += __shfl_xor(ss, 1); ss += __shfl_xor(ss, 2); ss += __shfl_xor(ss, 4); ss += __shfl_xor(ss, 8);
      const float rstd = rsqrtf(ss * (1.f / 256.f) + EPS);
      const size_t yo = (r0 + 16 * wid + 4 * Qd + jj) * 2048 + 1024 + h * 256 + r;
#pragma unroll
      for (int et = 0; et < 16; ++et) { const bf16_t ov_ = f2bf(o[et][jj] * rstd * gla_norm[h * 256 + 16 * et + r] * bf2f(Y0[yo + 16 * et])); if (wr) Y0[yo + 16 * et] = ov_; } }
    { const int g = h >> 1, c0 = g * 512 + (h & 1) * 256;
#pragma unroll
      for (int q = 0; q < 8; ++q) { const int cid = tid + 512 * q, row = cid >> 5, ch = cid & 31; const size_t rr = r0 + row;
        const float rstd = rsqrtf((SSQ[(rr * 2 + g) * 2] + SSQ[(rr * 2 + g) * 2 + 1]) * (1.f / 512.f) + EPS);
        bf16_t* yp = Y0 + rr * 2048 + c0 + ch * 8; const v4u yv = *(const v4u*)yp; const f32x4 g0 = *(const f32x4*)(ssd_norm + c0 + ch * 8), g1 = *(const f32x4*)(ssd_norm + c0 + ch * 8 + 4);
        v4u ov; ov.x = pk2(__uint_as_float(yv.x << 16) * rstd * g0.x, __uint_as_float(yv.x & 0xffff0000u) * rstd * g0.y); ov.y = pk2(__uint_as_float(yv.y << 16) * rstd * g0.z, __uint_as_float(yv.y & 0xffff0000u) * rstd * g0.w);
        ov.z = pk2(__uint_as_float(yv.z << 16) * rstd * g1.x, __uint_as_float(yv.z & 0xffff0000u) * rstd * g1.y); ov.w = pk2(__uint_as_float(yv.w << 16) * rstd * g1.z, __uint_as_float(yv.w & 0xffff0000u) * rstd * g1.w);
        if (wr) *(v4u*)yp = ov; } }
  }
}

typedef __attribute__((address_space(1))) unsigned gu32;
#define RLX_AGENT __ATOMIC_RELAXED, __HIP_MEMORY_SCOPE_AGENT
#define XB_TMO      128
#define XB_XCNT(j)  (256  + 64 * (j))
#define XB_XSUB(j)  (1280 + 64 * (j))
#define XB_XGEN(j)  (2304 + 64 * (j))
#define XB_TOP      3328
#define XB_TOPGEN   3392
#define XCD_BAR_WORDS 3456
#define XB_SPIN_CAP (1u << 18)

__device__ __forceinline__ unsigned xb_ld(unsigned* p)              { return __hip_atomic_load(p, __ATOMIC_RELAXED, __HIP_MEMORY_SCOPE_AGENT); }
__device__ __forceinline__ unsigned xb_add(unsigned* p, unsigned v) { return __hip_atomic_fetch_add(p, v, __ATOMIC_RELAXED, __HIP_MEMORY_SCOPE_AGENT); }
__device__ __forceinline__ unsigned xb_xcc_id() { return (unsigned)__builtin_amdgcn_s_getreg((3 << 11) | 20) & 0xFu; }
#define XB_SPIN(cond, bar) do { unsigned _sp = 0; while (cond) { __builtin_amdgcn_s_sleep(1); \
    if ((++_sp & 255u) == 0u) { if (xb_ld(&(bar)[XB_TMO])) break; if (_sp > XB_SPIN_CAP) { atomicAdd(&(bar)[XB_TMO], 1u); break; } } } } while (0)

struct XcdBarrier {
    unsigned* bar; unsigned x;
    volatile LAS unsigned* st;
};

__device__ __forceinline__ XcdBarrier xcd_barrier_post(unsigned* bar, volatile LAS unsigned* st) {
    XcdBarrier b; b.bar = bar; b.x = xb_xcc_id(); b.st = st;
    if (threadIdx.x == 0) (void)xb_add(&bar[XB_XCNT(b.x)], 1u);
    return b;
}
__device__ __forceinline__ void xcd_barrier_complete(unsigned* bar, unsigned x, unsigned& nloc, unsigned& nx) {
    const unsigned G = gridDim.x * gridDim.y * gridDim.z;
    unsigned sum, cnt, mine, sp = 0u;
    for (;;) {
        sum = 0u; cnt = 0u; mine = 0u;
#pragma unroll
        for (unsigned j = 0; j < 16; ++j) { const unsigned c = xb_ld(&bar[XB_XCNT(j)]); sum += c; cnt += (c > 0u) ? 1u : 0u; mine = (j == x) ? c : mine; }
        if (sum == G) break;
        __builtin_amdgcn_s_sleep(1);
        if ((++sp & 255u) == 0u) { if (xb_ld(&bar[XB_TMO])) break; if (sp > XB_SPIN_CAP) { atomicAdd(&bar[XB_TMO], 1u); break; } }
    }
    nloc = mine > 0u ? mine : 1u; nx = cnt > 0u ? cnt : 1u;
}

__device__ __forceinline__ void xcd_barrier(const XcdBarrier& b) {
    asm volatile("s_waitcnt vmcnt(0)" ::: "memory");
    __syncthreads();
    if (threadIdx.x == 0) {
        unsigned* bar = b.bar;
        __builtin_amdgcn_s_waitcnt(0);
        unsigned nloc = b.st[0], nx = b.st[1];
        if (nloc == 0u) { xcd_barrier_complete(bar, b.x, nloc, nx); b.st[0] = nloc; b.st[1] = nx; }
        const unsigned old = xb_add(&bar[XB_XSUB(b.x)], 1u);
        const unsigned gen = old / nloc;
        if (old + 1u == (gen + 1u) * nloc) {
            __builtin_amdgcn_fence(__ATOMIC_RELEASE, "agent");
            asm volatile("s_waitcnt vmcnt(0)" ::: "memory");
            const unsigned og = xb_add(&bar[XB_TOP], 1u);
            const unsigned tg = og / nx;
            if (og + 1u == (tg + 1u) * nx) xb_add(&bar[XB_TOPGEN], 1u);
            else XB_SPIN(xb_ld(&bar[XB_TOPGEN]) == tg, bar);
            __builtin_amdgcn_fence(__ATOMIC_ACQUIRE, "agent");
            xb_add(&bar[XB_XGEN(b.x)], 1u);
            asm volatile("s_waitcnt vmcnt(0)" ::: "memory");
        } else {
            XB_SPIN(xb_ld(&bar[XB_XGEN(b.x)]) == gen, bar);
            __builtin_amdgcn_fence(__ATOMIC_ACQUIRE, "agent");
            asm volatile("s_waitcnt vmcnt(0)" ::: "memory");
        }
    }
    __syncthreads();
}

__global__ void __launch_bounds__(NWAVES * 64, 2) mega(Params p) {
  extern __shared__ __attribute__((aligned(16))) unsigned char lds_raw[];
  LAS unsigned char* lds = (LAS unsigned char*)lds_raw;
  volatile LAS unsigned* MISC = (volatile LAS unsigned*)(lds + MISC_OFF);
  if (threadIdx.x < 16) MISC[threadIdx.x] = 0u;
  __syncthreads();
  XcdBarrier bar = xcd_barrier_post((unsigned*)(p.ws + WS_CTL), MISC + 8);
  unsigned char* ws = p.ws;
  float* MOD = (float*)(ws + WS_MOD);
  bf16_t* H0 = (bf16_t*)p.out; float* X1 = p.out;
  const int lo = p.ph_lo, hi = p.ph_hi;
#define IN(k) (lo <= (k) && (k) < hi)
#define SEAM(k) do { if ((k) + 1 < hi) xcd_barrier(bar); } while (0)
#define PH(k, ...) if (IN(k)) { if ((PROBE_MASK >> (k)) & 1u) { const bool wr = (p.rep < 0); (void)wr; __VA_ARGS__; xcd_barrier(bar); } { const bool wr = true; (void)wr; __VA_ARGS__; } SEAM(k); }
  PH(0, prologue_phase(p, lds))
  PH(1, prep_phase(p.in[0], p.in[2], p.in[4], MOD, H0))
  PH(2, {
    pg8::Gemm g{H0, (const bf16_t*)(ws + WS_W1T), MA, E_INP, D}; pg8::StaticOrder S; S.init(MA, E_INP, gridDim.x, (int)blockIdx.x);
    pg8::EpiProj0 E{(bf16_t*)(ws + WS_Y0), (bf16_t*)(ws + WS_XBC), (bf16_t*)(ws + WS_Q0), (bf16_t*)(ws + WS_K0), (bf16_t*)(ws + WS_V0), (float*)(ws + WS_DTLR)};
    pg8::gemm_phase<pg8::EpiProj0, pg8::StaticOrder, true, true>(lds, g, S, E); })
  PH(3, ssd_prep_phase((const bf16_t*)(ws + WS_XBC), p.in[8], p.in[9], (bf16_t*)p.out, (const float*)(ws + WS_DTLR), p.in[10], p.in[11], (float*)((char*)p.out + DO_SDT), (float*)((char*)p.out + DO_SCS), (float*)(ws + WS_SDEC)))
  PH(4, { ssd_u_phase((const bf16_t*)p.out, (const float*)((char*)p.out + DO_SDT), (const float*)((char*)p.out + DO_SCS), (bf16_t*)(ws + WS_STATE), lds);
    { const int nbusy = (NCH * 4) % (int)gridDim.x, nfree = (int)gridDim.x - nbusy;
      const int vb_ = virt_block(); if (vb_ >= nbusy || nfree <= 0) { __syncthreads(); late_weights(p, lds, nfree > 0 ? vb_ - nbusy : vb_, nfree > 0 ? nfree : (int)gridDim.x); } } })
  PH(5, ssd_scan_phase((bf16_t*)(ws + WS_STATE), (const float*)(ws + WS_SDEC), wr))
  PH(6, { ssd_y_phase((const bf16_t*)p.out, (const float*)((char*)p.out + DO_SDT), (const float*)((char*)p.out + DO_SCS), (const bf16_t*)(ws + WS_STATE), p.in[12], (bf16_t*)(ws + WS_Y0), (float*)(ws + WS_SSQ), lds, wr);
    if (wr) gla_cs_phase((const float*)(ws + WS_DTLR), p.in[14], p.in[15], (h16_t*)ws, (h16_t*)p.out, (float*)(ws + WS_GDEC), lds, (unsigned*)(ws + WS_CTL) + CW_CSQ); })
  PH(8, gla_u_phase((const bf16_t*)(ws + WS_K0), (const bf16_t*)(ws + WS_V0), (const h16_t*)ws, (const h16_t*)p.out, (bf16_t*)(ws + WS_STATE), lds))
  PH(9, gla_scan_phase((bf16_t*)(ws + WS_STATE), (const float*)(ws + WS_GDEC), wr))
  PH(10, gla_o_phase((const bf16_t*)(ws + WS_Q0), (const bf16_t*)(ws + WS_K0), (const bf16_t*)(ws + WS_V0), (const h16_t*)ws, (const h16_t*)p.out, (const bf16_t*)(ws + WS_STATE), p.in[16], (const float*)(ws + WS_SSQ), p.in[13], (bf16_t*)(ws + WS_Y0), lds, wr))
  PH(11, {
    pg8::Gemm g{(const bf16_t*)(ws + WS_Y0), (const bf16_t*)(ws + WS_W2T), ML, D, 2048}; pg8::StaticOrder S; S.init(ML, D, gridDim.x, (int)blockIdx.x);
    pg8::EpiResid E{p.in[0], X1, MOD, true};
    pg8::gemm_phase<pg8::EpiResid, pg8::StaticOrder, true, true>(lds, g, S, E);
    const float* ctx = p.in[2]; float* XC1 = (float*)(ws + WS_XC1); const float* gate = MOD + 2 * 3072 + 2048;
    small_gemm((const bf16_t*)(ws + WS_Y0) + (size_t)ML * 2048, 2048, (const bf16_t*)(ws + WS_W2T), 2048, 2048, MC, D,
               [=](int m, int n, float v) { XC1[(size_t)m * D + n] = ctx[(size_t)m * D + n] + gate[n] * v; }); })
  PH(12, prep_phase(X1, (const float*)(ws + WS_XC1), p.in[18], MOD + 3 * 3072, (bf16_t*)(ws + WS_H1)))
  PH(13, {
    pg8::Gemm g{(const bf16_t*)(ws + WS_H1), (const bf16_t*)(ws + WS_W3T), ML, O_IN, D}; pg8::StaticOrder S; S.init(ML, O_IN, gridDim.x, (int)blockIdx.x);
    pg8::EpiProj1 E{(bf16_t*)(ws + WS_K1), (bf16_t*)(ws + WS_V1), (bf16_t*)(ws + WS_Q1), (bf16_t*)(ws + WS_G1)};
    pg8::gemm_phase<pg8::EpiProj1, pg8::StaticOrder, true, true>(lds, g, S, E);
    bf16_t* K1 = (bf16_t*)(ws + WS_K1); bf16_t* V1 = (bf16_t*)(ws + WS_V1);
    small_gemm((const bf16_t*)(ws + WS_H1) + (size_t)ML * D, D, (const bf16_t*)(ws + WS_W3T), D, D, MC, 1024,
               [=](int m, int n, float v) { if (n < 512) K1[(size_t)(ML + m) * 512 + n] = f2bf(v); else V1[(size_t)(ML + m) * 512 + (n - 512)] = f2bf(v); }); })
  PH(14, qknorm_phase((bf16_t*)(ws + WS_Q1), (bf16_t*)(ws + WS_K1), p.in[22], p.in[23], (const float*)(ws + WS_ROPE), wr))
  PH(15, attn_phase((bf16_t*)(ws + WS_Q1), (const bf16_t*)(ws + WS_K1), (const bf16_t*)(ws + WS_V1), (const bf16_t*)(ws + WS_G1), p.in[24], p.in[22], p.in[23], lds, wr))
  PH(16, {
    pg8::Gemm g{(const bf16_t*)(ws + WS_Q1), (const bf16_t*)(ws + WS_W4T), ML, D, 2048}; pg8::StaticOrder S; S.init(ML, D, gridDim.x, (int)blockIdx.x);
    pg8::EpiResid E{X1, p.out, MOD + 3 * 3072, wr};
    pg8::gemm_phase<pg8::EpiResid, pg8::StaticOrder, true, true>(lds, g, S, E); })
#undef PH
#undef IN
#undef SEAM
}
extern "C" void kernel_launch(void* const* d_in, const int* in_sizes, int n_in, void* d_out, int out_size, void* d_ws, size_t ws_size, hipStream_t stream) {
  static int grid_blocks = 0;
  if (!grid_blocks) {
    int dev = 0, cus = 0, per_cu = 0;
    hipGetDevice(&dev);
    hipDeviceGetAttribute(&cus, hipDeviceAttributeMultiprocessorCount, dev);
    hipFuncSetAttribute((const void*)mega, hipFuncAttributeMaxDynamicSharedMemorySize, LDS_BYTES);
    hipOccupancyMaxActiveBlocksPerMultiprocessor(&per_cu, (const void*)mega, NWAVES * 64, LDS_BYTES);
    if (per_cu < 1) { fprintf(stderr, "kernel_launch: occupancy query says %d blocks per CU\n", per_cu); per_cu = 1; }
    if (per_cu > 1) per_cu = 1;
    grid_blocks = cus * per_cu;
  }
  hipMemsetAsync((char*)d_ws + WS_CTL, 0, 64 * 1024, stream);
  Params base{};
  for (int i = 0; i < 26; ++i) base.in[i] = (const float*)d_in[i];
  base.out = (float*)d_out; base.ws = (unsigned char*)d_ws;
  auto launch = [&](int lo, int hi) {
    Params p = base; p.ph_lo = lo; p.ph_hi = hi; p.rep = (int)PROBE_MASK; void* args[] = {&p};
    hipError_t e = hipLaunchCooperativeKernel((const void*)mega, dim3(grid_blocks), dim3(NWAVES * 64), args, LDS_BYTES, stream);
    if (e != hipSuccess) fprintf(stderr, "cooperative launch failed: %s (grid %d)\n", hipGetErrorString(e), grid_blocks);
  };
  launch(0, 17);
}
```

```cpp
#include <hip/hip_runtime.h>
#include <hip/hip_cooperative_groups.h>
#include <stdint.h>
#include <math.h>
#include <cstdio>
namespace cg = cooperative_groups;
#ifndef PROBE_SKIP
#define PROBE_SKIP 0
#endif
#ifndef PROBE_MASK
#define PROBE_MASK 0u
#endif

typedef unsigned short bf16_t;
#define DEV __device__ __forceinline__

DEV float bf2f(bf16_t v) { return __uint_as_float(((unsigned)v) << 16); }
typedef float f32x2_t __attribute__((ext_vector_type(2))); typedef __bf16 bf16x2_t __attribute__((ext_vector_type(2)));
DEV unsigned pk2(float lo, float hi) { const f32x2_t v = {lo, hi}; const bf16x2_t b = __builtin_convertvector(v, bf16x2_t); return __builtin_bit_cast(unsigned, b); }
DEV bf16_t f2bf(float f) { return (bf16_t)(pk2(f, 0.f) & 0xffffu); }
DEV float fexp(float x) { return __builtin_amdgcn_exp2f(x * 1.4426950408889634f); }
DEV float siluf(float x) { return x / (1.f + fexp(-x)); }
DEV float silu_fast(float x) { return x * __builtin_amdgcn_rcpf(1.f + fexp(-x)); }
DEV float softplusf(float x) { return x > 20.f ? x : log1pf(fexp(x)); }
DEV float logsigmoidf(float x) { return fminf(x, 0.f) - log1pf(fexp(-fabsf(x))); }

constexpr int D = 1024, NB = 2, SEQ = 8192, CTXL = 256;
constexpr int ML = NB * SEQ;
constexpr int MC = NB * CTXL;
constexpr int MA = ML + MC;
constexpr int NCH = MA / 128;
constexpr int E_IN = 5696, O_IN = 5120, E_INP = 5888;
constexpr float EPS = 1e-6f;

constexpr size_t MiB = 1u << 20;
constexpr int CW_CSQ = 8192;
constexpr size_t WS_CTL = 0;
constexpr size_t WS_MOD = 1 * MiB;
constexpr size_t WS_ROPE = 1 * MiB + 128 * 1024;
constexpr size_t WS_SDEC = 1 * MiB + 256 * 1024;
constexpr size_t WS_GDEC = 1 * MiB + 384 * 1024;
constexpr size_t WS_W1T = 2 * MiB;
constexpr size_t WS_W2T = 14 * MiB;
constexpr size_t WS_W3T = 18 * MiB;
constexpr size_t WS_W4T = 28 * MiB;
constexpr size_t WS_Y0 = 32 * MiB;
constexpr size_t WS_Q0 = 98 * MiB;
constexpr size_t WS_K0 = WS_Q0 + 16 * MiB + 512 * 1024;
constexpr size_t WS_V0 = 131 * MiB;
constexpr size_t WS_DTLR = 164 * MiB;
constexpr size_t WS_XC1 = 168 * MiB + 512 * 1024;
constexpr size_t WS_XBC = 171 * MiB;
constexpr size_t WS_STATE = 171 * MiB;
constexpr size_t WS_TAIL = 237 * MiB;
constexpr size_t WS_H1 = 32 * MiB;
constexpr size_t WS_K1 = 65 * MiB;
constexpr size_t WS_V1 = 81 * MiB + 512 * 1024;
constexpr size_t WS_Q1 = 98 * MiB;
constexpr size_t WS_G1 = 171 * MiB;

DEV int row_vec(int row) { return row < ML ? (row / SEQ) : 2; }

namespace pg8 {
#define PG8_LAS __attribute__((address_space(3)))
typedef unsigned short bf16_t;
typedef short bf16x8 __attribute__((ext_vector_type(8)));
typedef float f32x4 __attribute__((ext_vector_type(4)));
typedef unsigned u32x4 __attribute__((ext_vector_type(4)));
constexpr int BM = 256, BK = 64, HALF = 128, HTB = HALF * BK * 2  , STAGE_BYTES = 8 * HTB, NXCD = 8, WGM = 8;

__host__ __device__ __forceinline__ int lds_byte(int r, int c) { const int st = (r >> 4) * 2 + (c >> 5), rr = r & 15, cc = c & 31, ob = rr * 64 + cc * 2; return st * 1024 + (ob ^ (((ob >> 9) & 1) << 5)); }
__host__ __device__ __forceinline__ void stage_rc(int b, int& R, int& C) { const int st = b / 1024, sb = b % 1024, swz = sb ^ (((sb >> 9) & 1) << 5); R = (st >> 1) * 16 + swz / 64; C = (st & 1) * 32 + (swz % 64) / 2; }
__host__ __device__ __forceinline__ int perm32(int rho) { const int n = rho >> 4, i = rho & 15; return 8 * (i >> 2) + 4 * n + (i & 3); }

struct Unit { int pm, pn; };
struct Gemm { const bf16_t* A; const bf16_t* Bt; int M, N, K; };

struct StaticOrder {
    int nM, nN, nwg, G, c;
    __host__ __device__ void init(int M, int N, int G_, int c_) { nM = M / BM; nN = N / BM; nwg = nM * nN; G = G_; c = c_; }
    __host__ __device__ bool next(int i, Unit& u) const {
        const long L = (long)i * G + c; if (L >= nwg) return false;
        int wgid = (int)L; { const int q = nwg / NXCD, r = nwg % NXCD, xcd = wgid % NXCD, off = wgid / NXCD; wgid = (xcd < r ? xcd * (q + 1) : r * (q + 1) + (xcd - r) * q) + off; }
        const int nig = WGM * nN, gid = wgid / nig, fm = gid * WGM, gsz = (nM - fm) < WGM ? (nM - fm) : WGM;
        u.pm = fm + ((wgid % nig) % gsz); u.pn = (wgid % nig) / gsz; return true;
    }
    __device__ __forceinline__ void a_ready(const Unit&) const {}
    __device__ __forceinline__ void done(const Unit&) const {}
};
__device__ __forceinline__ unsigned cvt_pk_bf16(float lo, float hi) { unsigned r; asm volatile("v_cvt_pk_bf16_f32 %0, %1, %2" : "=v"(r) : "v"(lo), "v"(hi)); return r; }
__device__ __forceinline__ float silu_e(float x) { return x * __builtin_amdgcn_rcpf(1.f + fexp(-x)); }

__device__ __forceinline__ void store_unit_bf16(const f32x4 (&acc)[2][2][4][2], bf16_t* base, int ld, int colt, bool act, const Unit& u, int wr, int wc, int fr, int fq) {
    const int row0 = u.pm * BM + wr * 64 + fr; const int col0 = colt + wc * 32 + 8 * fq;
#pragma unroll
    for (int ai = 0; ai < 2; ++ai)
#pragma unroll
        for (int m = 0; m < 4; ++m) { bf16_t* rowp = base + (size_t)(row0 + ai * HALF + m * 16) * ld + col0;
#pragma unroll
            for (int bj = 0; bj < 2; ++bj) { f32x4 v0 = acc[ai][bj][m][0], v1 = acc[ai][bj][m][1];
                if (act) { v0 = (f32x4){silu_e(v0[0]), silu_e(v0[1]), silu_e(v0[2]), silu_e(v0[3])}; v1 = (f32x4){silu_e(v1[0]), silu_e(v1[1]), silu_e(v1[2]), silu_e(v1[3])}; }
                u32x4 w; w.x = cvt_pk_bf16(v0[0], v0[1]); w.y = cvt_pk_bf16(v0[2], v0[3]); w.z = cvt_pk_bf16(v1[0], v1[1]); w.w = cvt_pk_bf16(v1[2], v1[3]);
                *(u32x4*)(rowp + bj * HALF) = w; } }
}
struct EpiProj0 {
    static constexpr bool PERM = true, AFTER_DRAIN = false;
    bf16_t *Y0, *XBC, *Q0, *K0, *V0; float* DTLR;
    __device__ __forceinline__ void operator()(const f32x4 (&acc)[2][2][4][2], const Unit& u, int wr, int wc, int fr, int fq) const {
        const int pn = u.pn;
        if (pn == 22) {
            if (wc < 2) { const int row0 = u.pm * BM + wr * 64 + fr;
#pragma unroll
                for (int ai = 0; ai < 2; ++ai)
#pragma unroll
                    for (int m = 0; m < 4; ++m) { float* rp = DTLR + (size_t)(row0 + ai * HALF + m * 16) * 64 + wc * 32 + 8 * fq; *(f32x4*)rp = acc[ai][0][m][0]; *(f32x4*)(rp + 4) = acc[ai][0][m][1]; } }
            return;
        }
        bf16_t* base; int ld, colt; bool act = false;
        if (pn < 8) { base = Y0; ld = 2048; colt = pn * 256; act = true; }
        else if (pn < 14) { base = XBC; ld = 1536; colt = (pn - 8) * 256; }
        else if (pn < 16) { base = Q0; ld = 512; colt = (pn - 14) * 256; }
        else if (pn < 18) { base = K0; ld = 512; colt = (pn - 16) * 256; }
        else { base = V0; ld = 1024; colt = (pn - 18) * 256; }
        store_unit_bf16(acc, base, ld, colt, act, u, wr, wc, fr, fq);
    }
};
struct EpiProj1 {
    static constexpr bool PERM = true, AFTER_DRAIN = false;
    bf16_t *K1, *V1, *Q1, *G1;
    __device__ __forceinline__ void operator()(const f32x4 (&acc)[2][2][4][2], const Unit& u, int wr, int wc, int fr, int fq) const {
        const int pn = u.pn; bf16_t* base; int ld, colt; bool act = false;
        if (pn < 2) { base = K1; ld = 512; colt = pn * 256; }
        else if (pn < 4) { base = V1; ld = 512; colt = (pn - 2) * 256; }
        else if (pn < 12) { base = Q1; ld = 2048; colt = (pn - 4) * 256; }
        else { base = G1; ld = 2048; colt = (pn - 12) * 256; act = true; }
        store_unit_bf16(acc, base, ld, colt, act, u, wr, wc, fr, fq);
    }
};
struct EpiResid {
    static constexpr bool PERM = false, AFTER_DRAIN = false;
    const float* res; float* out; const float* mod; bool do_store;
    __device__ __forceinline__ void operator()(const f32x4 (&acc)[2][2][4][2], const Unit& u, int wr, int wc, int fr, int fq) const {
        const int b = (u.pm * BM) / 8192; const float* gate = mod + b * 3072 + 2048;
        const int col0 = u.pn * BM + wc * 32 + 4 * fq;
        f32x4 gv[2][2];
#pragma unroll
        for (int bj = 0; bj < 2; ++bj)
#pragma unroll
            for (int n = 0; n < 2; ++n) gv[bj][n] = *(const f32x4*)(gate + col0 + bj * HALF + n * 16);
#pragma unroll
        for (int ai = 0; ai < 2; ++ai)
#pragma unroll
            for (int m = 0; m < 4; ++m) { const size_t off = (size_t)(u.pm * BM + ai * HALF + wr * 64 + m * 16 + fr) * 1024 + col0;
#pragma unroll
                for (int bj = 0; bj < 2; ++bj)
#pragma unroll
                    for (int n = 0; n < 2; ++n) { const f32x4 r = *(const f32x4*)(res + off + bj * HALF + n * 16); const f32x4 ov_ = r + gv[bj][n] * acc[ai][bj][m][n]; if (do_store) *(f32x4*)(out + off + bj * HALF + n * 16) = ov_; } }
    }
};
template <class Epi, class Sched, bool ALIGN_EPI = false, bool SP2 = false>
__device__ __forceinline__ void gemm_phase(PG8_LAS unsigned char* lds, const Gemm g, const Sched& S, const Epi& E) {
    const int tid = threadIdx.x, wid = __builtin_amdgcn_readfirstlane(tid >> 6), lane = tid & 63, wr = wid >> 2, wc = wid & 3, fr = lane & 15, fq = lane >> 4;
    const int K = g.K, nt = K / BK;
    unsigned voffA[2], voffB[2];
#pragma unroll
    for (int i = 0; i < 2; ++i) { int R, C; stage_rc(tid * 16 + i * 8192, R, C); const int Rb = Epi::PERM ? ((R & ~31) + perm32(R & 31)) : R;
        voffA[i] = (unsigned)(R * K + C) * 2u; voffB[i] = (unsigned)(Rb * K + C) * 2u; }
    const size_t kstep = (size_t)(BK * 2);
    const size_t hstep = (size_t)HALF * K * 2;
    const size_t tstep = 2 * hstep;
    const unsigned ldsw = (unsigned)wid * 1024u;
    const int aoff = lds_byte(wr * 64 + fr, fq * 8), boff = lds_byte(wc * 32 + fr, fq * 8);
#define PG8_SA(b, h) (((b) * 2 + (h)) * HTB)
#define PG8_SB(b, h) ((4 + (b) * 2 + (h)) * HTB)
#define PG8_STAGE(bufoff, gbase, voff) do { _Pragma("unroll") for (int _i = 0; _i < 2; ++_i) \
        __builtin_amdgcn_global_load_lds((const unsigned*)((const char*)(gbase) + (voff)[_i]), (PG8_LAS unsigned*)(lds + (bufoff) + ldsw + _i * 8192), 16, 0, 0); } while (0)
#define PG8_LDA(dst, b, h) do { _Pragma("unroll") for (int m = 0; m < 4; ++m) _Pragma("unroll") for (int k = 0; k < 2; ++k) dst[m][k] = *(const PG8_LAS bf16x8*)(lds + PG8_SA(b, h) + aoff + m * 2048 + k * 1024); } while (0)
#define PG8_LDB(dst, b, h) do { _Pragma("unroll") for (int n = 0; n < 2; ++n) _Pragma("unroll") for (int k = 0; k < 2; ++k) dst[n][k] = *(const PG8_LAS bf16x8*)(lds + PG8_SB(b, h) + boff + n * 2048 + k * 1024); } while (0)
#define PG8_MMA(ai, bj, At, Bt) do { __builtin_amdgcn_s_setprio(1); _Pragma("unroll") for (int m = 0; m < 4; ++m) _Pragma("unroll") for (int n = 0; n < 2; ++n) _Pragma("unroll") for (int k = 0; k < 2; ++k) \
        acc[ai][bj][m][n] = __builtin_amdgcn_mfma_f32_16x16x32_bf16(Bt[n][k], At[m][k], acc[ai][bj][m][n], 0, 0, 0); __builtin_amdgcn_s_setprio(0); } while (0)
#define PG8_WAIT_V(n) asm volatile("s_waitcnt vmcnt(" #n ")" ::: "memory")
#define PG8_WAIT_L(n) asm volatile("s_waitcnt lgkmcnt(" #n ")" ::: "memory")
#define PG8_BAR __builtin_amdgcn_s_barrier()
#define PG8_SCHED __builtin_amdgcn_sched_barrier(0)
    Unit cur, nxt; int ui = 0;
    if (!S.next(0, cur)) return;
    f32x4 acc[2][2][4][2];
#pragma unroll
    for (int a = 0; a < 2; ++a)
#pragma unroll
        for (int b = 0; b < 2; ++b)
#pragma unroll
            for (int m = 0; m < 4; ++m)
#pragma unroll
                for (int n = 0; n < 2; ++n) acc[a][b][m][n] = (f32x4){0.f, 0.f, 0.f, 0.f};
    bf16x8 At[4][2], B0[2][2], B1[2][2];
    const char* cA = (const char*)g.A + (size_t)cur.pm * tstep; const char* cB = (const char*)g.Bt + (size_t)cur.pn * tstep;
    S.a_ready(cur);
    if constexpr (SP2) {
        PG8_STAGE(PG8_SB(0, 0), cB, voffB); PG8_STAGE(PG8_SB(0, 1), cB + hstep, voffB); PG8_STAGE(PG8_SA(0, 0), cA, voffA); PG8_STAGE(PG8_SA(0, 1), cA + hstep, voffA);
        if (wr == 1) PG8_BAR;
        PG8_WAIT_V(2); PG8_BAR;
        PG8_STAGE(PG8_SB(1, 0), cB + kstep, voffB); PG8_STAGE(PG8_SA(1, 0), cA + kstep, voffA); PG8_STAGE(PG8_SB(1, 1), cB + hstep + kstep, voffB);
        PG8_WAIT_V(6); PG8_BAR;
    } else {
        PG8_STAGE(PG8_SB(0, 0), cB, voffB); PG8_STAGE(PG8_SA(0, 0), cA, voffA); PG8_STAGE(PG8_SB(0, 1), cB + hstep, voffB); PG8_STAGE(PG8_SA(0, 1), cA + hstep, voffA);
        if (wr == 1) PG8_BAR;
        PG8_WAIT_V(4); PG8_BAR;
        PG8_STAGE(PG8_SB(1, 0), cB + kstep, voffB); PG8_STAGE(PG8_SA(1, 0), cA + kstep, voffA); PG8_STAGE(PG8_SB(1, 1), cB + hstep + kstep, voffB);
        PG8_WAIT_V(6); PG8_BAR;
    }
    for (;;) {
        const bool has_next = S.next(ui + 1, nxt);
        const char* nA = has_next ? (const char*)g.A + (size_t)nxt.pm * tstep : cA; const char* nB = has_next ? (const char*)g.Bt + (size_t)nxt.pn * tstep : cB;
        for (int t = 0; t < nt; t += 2) {
            const bool last = (t == nt - 2);
            const char* a1 = cA + (size_t)(t + 1) * kstep;
            const char* a2 = last ? nA : cA + (size_t)(t + 2) * kstep; const char* b2 = last ? nB : cB + (size_t)(t + 2) * kstep;
            const char* a3 = a2 + kstep; const char* b3 = b2 + kstep;
            if (last && has_next) S.a_ready(nxt);
            if constexpr (SP2) {
            PG8_LDB(B0, 0, 0); PG8_LDB(B1, 0, 1); PG8_SCHED; PG8_LDA(At, 0, 0); PG8_STAGE(PG8_SA(1, 1), a1 + hstep, voffA);
            PG8_WAIT_V(8); PG8_WAIT_L(0); PG8_BAR; PG8_MMA(0, 0, At, B0); PG8_MMA(0, 1, At, B1); PG8_BAR; PG8_SCHED;
            PG8_LDA(At, 0, 1); PG8_STAGE(PG8_SB(0, 0), b2, voffB); PG8_STAGE(PG8_SB(0, 1), b2 + hstep, voffB); PG8_STAGE(PG8_SA(0, 0), a2, voffA);
            PG8_WAIT_V(8); PG8_WAIT_L(0); PG8_BAR; PG8_MMA(1, 0, At, B0); PG8_MMA(1, 1, At, B1); PG8_BAR; PG8_SCHED;
            PG8_LDB(B0, 1, 0); PG8_LDB(B1, 1, 1); PG8_SCHED; PG8_LDA(At, 1, 0); PG8_STAGE(PG8_SA(0, 1), a2 + hstep, voffA);
            PG8_WAIT_V(8); PG8_WAIT_L(0); PG8_BAR; PG8_MMA(0, 0, At, B0); PG8_MMA(0, 1, At, B1); PG8_BAR; PG8_SCHED;
            PG8_LDA(At, 1, 1); PG8_STAGE(PG8_SB(1, 0), b3, voffB); PG8_STAGE(PG8_SB(1, 1), b3 + hstep, voffB); PG8_STAGE(PG8_SA(1, 0), a3, voffA);
            PG8_WAIT_V(8); PG8_WAIT_L(0); PG8_BAR; PG8_MMA(1, 0, At, B0); PG8_MMA(1, 1, At, B1); PG8_BAR; PG8_SCHED;
            } else {
            PG8_LDB(B0, 0, 0); PG8_SCHED; PG8_LDA(At, 0, 0); PG8_STAGE(PG8_SA(1, 1), a1 + hstep, voffA);
            PG8_WAIT_L(8); PG8_BAR; PG8_WAIT_L(0); PG8_MMA(0, 0, At, B0); PG8_BAR; PG8_SCHED;
            PG8_LDB(B1, 0, 1); PG8_STAGE(PG8_SB(0, 0), b2, voffB);
            PG8_BAR; PG8_WAIT_L(0); PG8_MMA(0, 1, At, B1); PG8_BAR;
            PG8_LDA(At, 0, 1); PG8_STAGE(PG8_SA(0, 0), a2, voffA);
            PG8_BAR; PG8_WAIT_L(0); PG8_MMA(1, 0, At, B0); PG8_BAR; PG8_SCHED;
            PG8_STAGE(PG8_SB(0, 1), b2 + hstep, voffB);
            PG8_WAIT_V(6); PG8_BAR; PG8_MMA(1, 1, At, B1); PG8_BAR;
            PG8_LDB(B0, 1, 0); PG8_SCHED; PG8_LDA(At, 1, 0); PG8_STAGE(PG8_SA(0, 1), a2 + hstep, voffA);
            PG8_WAIT_L(8); PG8_BAR; PG8_WAIT_L(0); PG8_MMA(0, 0, At, B0); PG8_BAR; PG8_SCHED;
            PG8_LDB(B1, 1, 1); PG8_STAGE(PG8_SB(1, 0), b3, voffB);
            PG8_BAR; PG8_WAIT_L(0); PG8_MMA(0, 1, At, B1); PG8_BAR;
            PG8_LDA(At, 1, 1); PG8_STAGE(PG8_SA(1, 0), a3, voffA);
            PG8_BAR; PG8_WAIT_L(0); PG8_MMA(1, 0, At, B0); PG8_BAR; PG8_SCHED;
            PG8_STAGE(PG8_SB(1, 1), b3 + hstep, voffB);
            PG8_WAIT_V(6); PG8_BAR; PG8_MMA(1, 1, At, B1); PG8_BAR;
            }
        }
        if constexpr (ALIGN_EPI) { if (wr == 0) PG8_BAR; }
        if constexpr (!Epi::AFTER_DRAIN) { E(acc, cur, wr, wc, fr, fq); S.done(cur); }
        if (!has_next) break;
#pragma unroll
        for (int a = 0; a < 2; ++a)
#pragma unroll
            for (int b = 0; b < 2; ++b)
#pragma unroll
                for (int m = 0; m < 4; ++m)
#pragma unroll
                    for (int n = 0; n < 2; ++n) acc[a][b][m][n] = (f32x4){0.f, 0.f, 0.f, 0.f};
        cur = nxt; cA = nA; cB = nB; ++ui;
        if constexpr (ALIGN_EPI) { if (wr == 1) PG8_BAR; }
    }
    PG8_WAIT_V(0);
    if constexpr (!ALIGN_EPI) { if (wr == 0) PG8_BAR; }
    PG8_BAR;
    if constexpr (Epi::AFTER_DRAIN) { E.fused(acc, cur, wr, wc, fr, fq, lds, wid, lane); S.done(cur); }
#undef PG8_SA
#undef PG8_SB
#undef PG8_STAGE
#undef PG8_LDA
#undef PG8_LDB
#undef PG8_MMA
#undef PG8_WAIT_V
#undef PG8_WAIT_L
#undef PG8_BAR
#undef PG8_SCHED
}
}
#define LAS __attribute__((address_space(3)))
typedef unsigned v4u __attribute__((ext_vector_type(4)));
typedef float f32x4 __attribute__((ext_vector_type(4)));
typedef short bf16x8 __attribute__((ext_vector_type(8)));
#define LDS_WAIT() asm volatile("s_waitcnt lgkmcnt(0)" ::: "memory")
constexpr int NWAVES = 8;
constexpr int LDS_BYTES = 147456;
constexpr int MISC_OFF = 147456 - 128;

struct Params { const float* in[26]; float* out; unsigned char* ws; int ph_lo, ph_hi, rep, pad; };

DEV int virt_block() { const int G = (int)gridDim.x, b = (int)blockIdx.x; return (G % 8 == 0) ? (b % 8) * (G / 8) + b / 8 : b; }
DEV float wave_sum(float v) {
#pragma unroll
  for (int o = 1; o < 64; o <<= 1) v += __shfl_xor(v, o);
  return v;
}

DEV int w1_dest_row(int n) {
  if (n < 1024) return n;
  if (n < 2560) return 2048 + (n - 1024);
  if (n < 2592) return 5632 + (n - 2560);
  if (n < 3104) return 3584 + (n - 2592);
  if (n < 3616) return 4096 + (n - 3104);
  if (n < 4640) return 4608 + (n - 3616);
  if (n < 5664) return 1024 + (n - 4640);
  return n;
}
DEV void transpose_item(const float* W, int K, int N, int k0, int n0, bf16_t* WT, int drow0, LAS float* scr, int lane) {
#pragma unroll 8
  for (int i = 0; i < 32; ++i) { const int kk = 2 * i + (lane >> 5); scr[kk * 33 + (lane & 31)] = W[(size_t)(k0 + kk) * N + n0 + (lane & 31)]; }
  LDS_WAIT(); asm volatile("" ::: "memory");
  const int c = lane & 7;
#pragma unroll
  for (int j = 0; j < 4; ++j) { const int n = (lane >> 3) + 8 * j; const LAS float* s = scr + (8 * c) * 33 + n;
    v4u o; o.x = pk2(s[0 * 33], s[1 * 33]); o.y = pk2(s[2 * 33], s[3 * 33]); o.z = pk2(s[4 * 33], s[5 * 33]); o.w = pk2(s[6 * 33], s[7 * 33]);
    *(v4u*)(WT + (size_t)(drow0 + n) * K + k0 + 8 * c) = o; }
  LDS_WAIT(); asm volatile("" ::: "memory");
}
DEV void prologue_phase(const Params& p, LAS unsigned char* lds) {
  const int tid = threadIdx.x, lane = tid & 63, wave = tid >> 6;
  unsigned char* ws = p.ws;
  float* MOD = (float*)(ws + WS_MOD);
  {
    LAS float* sc = (LAS float*)lds;
    LAS float* part = (LAS float*)(lds + 12288);
    for (int i = tid; i < 3072; i += 512) { const int v = i >> 10, k = i & 1023; const float cv = v < 2 ? p.in[1][v * 1024 + k] : p.in[3][k]; sc[i] = siluf(cv); }
    __syncthreads();
    for (int task = blockIdx.x; task < 96; task += gridDim.x) {
      const int l = task / 48, n0 = (task % 48) * 64; const float* w = l ? p.in[19] : p.in[5]; const float* bb = l ? p.in[20] : p.in[6];
      const int col = tid & 63, ks = tid >> 6;
      float a0 = 0.f, a1 = 0.f, a2 = 0.f;
#pragma unroll 8
      for (int k = ks * 128; k < ks * 128 + 128; ++k) { const float wv = w[(size_t)k * 3072 + n0 + col]; a0 += sc[k] * wv; a1 += sc[1024 + k] * wv; a2 += sc[2048 + k] * wv; }
      part[(ks * 3 + 0) * 64 + col] = a0; part[(ks * 3 + 1) * 64 + col] = a1; part[(ks * 3 + 2) * 64 + col] = a2;
      __syncthreads();
      if (tid < 192) { const int v = tid >> 6; float s = bb[n0 + col];
#pragma unroll
        for (int q = 0; q < 8; ++q) s += part[(q * 3 + v) * 64 + col];
        MOD[(l * 3 + v) * 3072 + n0 + col] = s; }
      __syncthreads();
    }
  }
  if (blockIdx.x == gridDim.x - 1) { float* rope = (float*)(ws + WS_ROPE);
    for (int idx = tid; idx < 4096; idx += 512) { const int pos = idx >> 5, f = idx & 31; const float inv = 1.0f / powf(10000.f, (float)f / 32.f); const float ang = (float)pos * inv; rope[idx] = cosf(ang); rope[4096 + idx] = sinf(ang); } }
  { v4u* z = (v4u*)(ws + WS_W1T + (size_t)E_IN * 1024 * 2); const v4u zero = {0u, 0u, 0u, 0u};
    for (int i = blockIdx.x * 512 + tid; i < (E_INP - E_IN) * 1024 * 2 / 16; i += gridDim.x * 512) z[i] = zero; }
  __syncthreads();
  {
    LAS float* scr = (LAS float*)(lds + wave * 16384);
    const int gw = blockIdx.x * NWAVES + wave, NGW = gridDim.x * NWAVES;
    constexpr int I1 = 16 * 178;
    for (int it = gw; it < I1; it += NGW) { const int kb = it / 178, nb = it % 178; transpose_item(p.in[7], 1024, E_IN, 64 * kb, 32 * nb, (bf16_t*)(ws + WS_W1T), w1_dest_row(32 * nb), scr, lane); }
  }
}
DEV void late_weights(const Params& p, LAS unsigned char* lds, int vblock, int nvblocks) {
  const int lane = threadIdx.x & 63, wave = threadIdx.x >> 6; unsigned char* ws = p.ws;
  LAS float* scr = (LAS float*)(lds + wave * 16384);
  constexpr int I2 = 32 * 32, I3 = 16 * 160, I4 = 32 * 32;
  for (int it = vblock * NWAVES + wave; it < I2 + I3 + I4; it += nvblocks * NWAVES) {
    int r = it;
    if (r < I2) { const int kb = r / 32, nb = r % 32; transpose_item(p.in[17], 2048, 1024, 64 * kb, 32 * nb, (bf16_t*)(ws + WS_W2T), 32 * nb, scr, lane); continue; } r -= I2;
    if (r < I3) { const int kb = r / 160, nb = r % 160; transpose_item(p.in[21], 1024, O_IN, 64 * kb, 32 * nb, (bf16_t*)(ws + WS_W3T), 32 * nb, scr, lane); continue; } r -= I3;
    { const int kb = r / 32, nb = r % 32; transpose_item(p.in[25], 2048, 1024, 64 * kb, 32 * nb, (bf16_t*)(ws + WS_W4T), 32 * nb, scr, lane); }
  }
}
DEV void prep_phase(const float* xlat, const float* xctx, const float* g, const float* mod, bf16_t* H) {
  const int lane = threadIdx.x & 63, wave = threadIdx.x >> 6;
  for (int row = blockIdx.x * NWAVES + wave; row < MA; row += gridDim.x * NWAVES) {
    const float* src = row < ML ? xlat + (size_t)row * D : xctx + (size_t)(row - ML) * D;
    const float* m = mod + row_vec(row) * 3072;
    f32x4 v[4]; float ss = 0.f;
#pragma unroll
    for (int j = 0; j < 4; ++j) { v[j] = *(const f32x4*)(src + 4 * lane + 256 * j); ss += (v[j].x * v[j].x + v[j].y * v[j].y) + (v[j].z * v[j].z + v[j].w * v[j].w); }
    const float rstd = rsqrtf(wave_sum(ss) * (1.f / D) + EPS);
#pragma unroll
    for (int j = 0; j < 4; ++j) { const int k = 4 * lane + 256 * j;
      const f32x4 gg = *(const f32x4*)(g + k), sc = *(const f32x4*)(m + 1024 + k), sh = *(const f32x4*)(m + k);
      const f32x4 o = v[j] * rstd * gg * (sc + 1.f) + sh;
      *(unsigned long long*)(H + (size_t)row * D + k) = (unsigned long long)pk2(o.x, o.y) | ((unsigned long long)pk2(o.z, o.w) << 32); }
  }
}
template <class F> DEV void small_gemm(const bf16_t* A, int lda, const bf16_t* Bt, int ldb, int K, int Mrows, int Ncols, F f) {
  const int lane = threadIdx.x & 63, wid = threadIdx.x >> 6, mt = wid >> 2, nt = wid & 3, r = lane & 15, q = lane >> 4;
  const int ntn = Ncols / 64, ntasks = (Mrows / 32) * ntn;
  for (int task = blockIdx.x; task < ntasks; task += gridDim.x) {
    const int row0 = (task / ntn) * 32 + mt * 16, col0 = (task % ntn) * 64 + nt * 16;
    const bf16_t* ap = A + (size_t)(row0 + r) * lda + 8 * q; const bf16_t* bp = Bt + (size_t)(col0 + r) * ldb + 8 * q;
    f32x4 acc = {0.f, 0.f, 0.f, 0.f};
#pragma unroll 8
    for (int k = 0; k < K; k += 32) { const bf16x8 a = *(const bf16x8*)(ap + k), b = *(const bf16x8*)(bp + k); acc = __builtin_amdgcn_mfma_f32_16x16x32_bf16(a, b, acc, 0, 0, 0); }
#pragma unroll
    for (int j = 0; j < 4; ++j) f(row0 + q * 4 + j, col0 + r, acc[j]);
  }
}

DEV void qknorm_phase(bf16_t* Q1, bf16_t* K1, const float* qn, const float* kn, const float* rope, bool wr) {
  const int lane = threadIdx.x & 63, wave = threadIdx.x >> 6, hl = lane >> 4, d0 = (lane & 15) * 8;
  const float scale = 0.08838834764831845f * 1.4426950408889634f;
  float gq[8], gk[8];
#pragma unroll
  for (int e = 0; e < 8; ++e) { gq[e] = qn[d0 + e] * scale; gk[e] = kn[d0 + e]; }
  const int ax = d0 >> 6, sgn = (d0 >> 5) & 1, f0 = d0 & 31;
  for (int row = blockIdx.x * NWAVES + wave; row < MA; row += gridDim.x * NWAVES) {
    const bool lat = row < ML;
    v4u raw[5];
    raw[0] = *(const v4u*)(K1 + (size_t)row * 512 + hl * 128 + d0);
    if (lat) {
#pragma unroll
      for (int g = 0; g < 4; ++g) raw[1 + g] = *(const v4u*)(Q1 + (size_t)row * 2048 + (g * 4 + hl) * 128 + d0);
    }
    float cs[8], sn[8];
    if (lat) { const int t = row % SEQ, pos = ax ? (t & 63) : (t >> 6);
      const f32x4 c0 = *(const f32x4*)(rope + pos * 32 + f0), c1 = *(const f32x4*)(rope + pos * 32 + f0 + 4), s0 = *(const f32x4*)(rope + 4096 + pos * 32 + f0), s1 = *(const f32x4*)(rope + 4096 + pos * 32 + f0 + 4);
      cs[0] = c0.x; cs[1] = c0.y; cs[2] = c0.z; cs[3] = c0.w; cs[4] = c1.x; cs[5] = c1.y; cs[6] = c1.z; cs[7] = c1.w;
      sn[0] = s0.x; sn[1] = s0.y; sn[2] = s0.z; sn[3] = s0.w; sn[4] = s1.x; sn[5] = s1.y; sn[6] = s1.z; sn[7] = s1.w; }
    const int ng = lat ? 5 : 1;
#pragma unroll
    for (int g = 0; g < 5; ++g) {
      if (g < ng) {
        const v4u rv = raw[g];
        float v[8] = {__uint_as_float(rv.x << 16), __uint_as_float(rv.x & 0xffff0000u), __uint_as_float(rv.y << 16), __uint_as_float(rv.y & 0xffff0000u), __uint_as_float(rv.z << 16), __uint_as_float(rv.z & 0xffff0000u), __uint_as_float(rv.w << 16), __uint_as_float(rv.w & 0xffff0000u)};
        float ss = 0.f;
#pragma unroll
        for (int e = 0; e < 8; ++e) ss += v[e] * v[e];
        ss += __shfl_xor(ss, 1); ss += __shfl_xor(ss, 2); ss += __shfl_xor(ss, 4); ss += __shfl_xor(ss, 8);
        const float rstd = rsqrtf(ss * (1.f / 128.f) + EPS);
#pragma unroll
        for (int e = 0; e < 8; ++e) v[e] *= rstd * (g == 0 ? gk[e] : gq[e]);
        if (lat) {
#pragma unroll
          for (int e = 0; e < 8; ++e) { const float o = __shfl_xor(v[e], 4); v[e] = sgn ? (v[e] * cs[e] + o * sn[e]) : (v[e] * cs[e] - o * sn[e]); }
        }
        v4u ov; ov.x = pk2(v[0], v[1]); ov.y = pk2(v[2], v[3]); ov.z = pk2(v[4], v[5]); ov.w = pk2(v[6], v[7]);
        if (wr) { if (g == 0) *(v4u*)(K1 + (size_t)row * 512 + hl * 128 + d0) = ov; else *(v4u*)(Q1 + (size_t)row * 2048 + ((g - 1) * 4 + hl) * 128 + d0) = ov; }
      }
    }
  }
}
typedef short s16x4 __attribute__((ext_vector_type(4)));
DEV s16x4 tr_read(const LAS bf16_t* p) { return __builtin_bit_cast(s16x4, __builtin_amdgcn_ds_read_tr16_b64_v4i16((LAS s16x4*)p)); }
DEV void attn_phase(bf16_t* Q1, const bf16_t* K1, const bf16_t* V1, const bf16_t* G1, const float* sink, const float* qn, const float* kn, LAS unsigned char* lds, bool wr) {
  constexpr int KP = 136, VP = 144;
  LAS bf16_t* Ks = (LAS bf16_t*)lds;
  LAS bf16_t* Vs = (LAS bf16_t*)(lds + 2 * 64 * KP * 2);
  LAS float* dsc = (LAS float*)(lds + 2 * 64 * KP * 2 + 2 * 64 * VP * 2);
  const int tid = threadIdx.x, lane = tid & 63, wid = tid >> 6, r = lane & 15, Qd = lane >> 4;
  float mb;
  { float a = fmaxf(fabsf(qn[lane]), fabsf(qn[64 + lane])), b = fmaxf(fabsf(kn[lane]), fabsf(kn[64 + lane]));
#pragma unroll
    for (int o = 1; o < 64; o <<= 1) { a = fmaxf(a, __shfl_xor(a, o)); b = fmaxf(b, __shfl_xor(b, o)); }
    mb = a * b * 11.313708498984761f * 1.4426950408889634f; }
  for (int task = virt_block(); task < 1024; task += gridDim.x) {
    const int b = task >> 9, kvh = (task >> 7) & 3, qt = task & 127;
    const int hq = kvh * 4 + (wid >> 1), qoff = (wid & 1) * 32;
    const size_t qrow0 = (size_t)b * SEQ + qt * 64 + qoff;
    bf16x8 qf[2][4];
#pragma unroll
    for (int m = 0; m < 2; ++m)
#pragma unroll
      for (int ks = 0; ks < 4; ++ks) qf[m][ks] = *(const bf16x8*)(Q1 + (qrow0 + 16 * m + r) * 2048 + hq * 128 + ks * 32 + 8 * Qd);
    const int tlo = (2 - qt) > 0 ? (2 - qt) : 0, thi = (129 - qt) < 4 ? (129 - qt) : 4, nband = thi - tlo + 1, ntile = nband + 4;
    const int skey = tid >> 4, sch = tid & 15;
    v4u kreg[2], vreg[2];
#define TILE_ROW0(i) ((i) < nband ? (size_t)b * SEQ + (size_t)(qt - 2 + tlo + (i)) * 64 : (size_t)ML + b * CTXL + ((i) - nband) * 64)
#define LOAD_TILE(i) do { const size_t r0_ = TILE_ROW0(i); _Pragma("unroll") for (int h_ = 0; h_ < 2; ++h_) { const size_t go_ = (r0_ + skey + 32 * h_) * 512 + kvh * 128 + sch * 8; kreg[h_] = *(const v4u*)(K1 + go_); vreg[h_] = *(const v4u*)(V1 + go_); } } while (0)
#define STORE_TILE(buf) do { _Pragma("unroll") for (int h_ = 0; h_ < 2; ++h_) { *(LAS v4u*)(Ks + (buf) * 64 * KP + (skey + 32 * h_) * KP + sch * 8) = kreg[h_]; *(LAS v4u*)(Vs + (buf) * 64 * VP + (skey + 32 * h_) * VP + sch * 8) = vreg[h_]; } } while (0)
    LOAD_TILE(0);
    __syncthreads();
    STORE_TILE(0);
    __syncthreads();
    f32x4 o[2][8];
#pragma unroll
    for (int m = 0; m < 2; ++m)
#pragma unroll
      for (int n = 0; n < 8; ++n) o[m][n] = (f32x4){0.f, 0.f, 0.f, 0.f};
    float lsum[2] = {0.f, 0.f};
    for (int i = 0; i < ntile; ++i) {
      const int buf = i & 1;
      if (i + 1 < ntile) LOAD_TILE(i + 1);
      const int mtype = (i < nband) ? ((tlo + i) == 0 ? 1 : ((tlo + i) == 4 ? 2 : 0)) : 0;
      const LAS bf16_t* Kb = Ks + buf * 64 * KP; const LAS bf16_t* Vb = Vs + buf * 64 * VP;
      f32x4 s[4][2];
#pragma unroll
      for (int t = 0; t < 4; ++t) { s[t][0] = (f32x4){-mb, -mb, -mb, -mb}; s[t][1] = (f32x4){-mb, -mb, -mb, -mb}; }
#pragma unroll
      for (int ks = 0; ks < 4; ++ks)
#pragma unroll
        for (int t = 0; t < 4; ++t) { const bf16x8 kf = *(const LAS bf16x8*)(Kb + (16 * t + r) * KP + ks * 32 + 8 * Qd);
          s[t][0] = __builtin_amdgcn_mfma_f32_16x16x32_bf16(kf, qf[0][ks], s[t][0], 0, 0, 0);
          s[t][1] = __builtin_amdgcn_mfma_f32_16x16x32_bf16(kf, qf[1][ks], s[t][1], 0, 0, 0); }
      bf16x8 pa[2][2];
#pragma unroll
      for (int m = 0; m < 2; ++m) { const int qi = qoff + 16 * m + r;
#pragma unroll
        for (int t = 0; t < 4; ++t) {
          float pv[4];
#pragma unroll
          for (int j = 0; j < 4; ++j) { const int kj = 16 * t + 4 * Qd + j; float pj = __builtin_amdgcn_exp2f(s[t][m][j]);
            if (mtype != 0) { if (mtype == 1) pj = (kj >= qi) ? pj : 0.f; else pj = (kj <= qi) ? pj : 0.f; }
            pv[j] = pj; lsum[m] += pj; }
          const unsigned w0 = pk2(pv[0], pv[1]), w1 = pk2(pv[2], pv[3]);
          pa[m][t >> 1][(t & 1) * 4 + 0] = (short)(w0 & 0xffff); pa[m][t >> 1][(t & 1) * 4 + 1] = (short)(w0 >> 16);
          pa[m][t >> 1][(t & 1) * 4 + 2] = (short)(w1 & 0xffff); pa[m][t >> 1][(t & 1) * 4 + 3] = (short)(w1 >> 16); } }
#pragma unroll
      for (int k2 = 0; k2 < 2; ++k2)
#pragma unroll
        for (int n = 0; n < 8; ++n) {
          const s16x4 lo = tr_read(Vb + (32 * k2 + 4 * Qd + (r >> 2)) * VP + 16 * n + 4 * (r & 3));
          const s16x4 hi = tr_read(Vb + (32 * k2 + 16 + 4 * Qd + (r >> 2)) * VP + 16 * n + 4 * (r & 3));
          const bf16x8 vf = (bf16x8){lo[0], lo[1], lo[2], lo[3], hi[0], hi[1], hi[2], hi[3]};
          o[0][n] = __builtin_amdgcn_mfma_f32_16x16x32_bf16(pa[0][k2], vf, o[0][n], 0, 0, 0);
          o[1][n] = __builtin_amdgcn_mfma_f32_16x16x32_bf16(pa[1][k2], vf, o[1][n], 0, 0, 0); }
      if (i + 1 < ntile) STORE_TILE(buf ^ 1);
      __syncthreads();
    }
#undef TILE_ROW0
#undef LOAD_TILE
#undef STORE_TILE
    const float sk = __builtin_amdgcn_exp2f(sink[hq] * 1.4426950408889634f - mb);
#pragma unroll
    for (int m = 0; m < 2; ++m) { float l = lsum[m]; l += __shfl_xor(l, 16); l += __shfl_xor(l, 32); if (Qd == 0) dsc[wid * 32 + 16 * m + r] = 1.f / (l + sk); }
    LDS_WAIT(); asm volatile("" ::: "memory");
    { LAS bf16_t* stg = (LAS bf16_t*)lds + wid * 32 * 136;
#pragma unroll
      for (int m = 0; m < 2; ++m)
#pragma unroll
        for (int j = 0; j < 4; ++j) { const float inv = dsc[wid * 32 + 16 * m + 4 * Qd + j];
#pragma unroll
          for (int n = 0; n < 8; ++n) stg[(16 * m + 4 * Qd + j) * 136 + 16 * n + r] = f2bf(o[m][n][j] * inv); }
      LDS_WAIT(); asm volatile("" ::: "memory");
#pragma unroll
      for (int q = 0; q < 8; ++q) { const int c = lane + 64 * q, rowl = c >> 4, ch = c & 15; const size_t go = (qrow0 + rowl) * 2048 + hq * 128 + ch * 8;
        const v4u ov = *(const LAS v4u*)(stg + rowl * 136 + ch * 8), gv = *(const v4u*)(G1 + go);
        v4u w; w.x = pk2(__uint_as_float(ov.x << 16) * __uint_as_float(gv.x << 16), __uint_as_float(ov.x & 0xffff0000u) * __uint_as_float(gv.x & 0xffff0000u));
        w.y = pk2(__uint_as_float(ov.y << 16) * __uint_as_float(gv.y << 16), __uint_as_float(ov.y & 0xffff0000u) * __uint_as_float(gv.y & 0xffff0000u));
        w.z = pk2(__uint_as_float(ov.z << 16) * __uint_as_float(gv.z << 16), __uint_as_float(ov.z & 0xffff0000u) * __uint_as_float(gv.z & 0xffff0000u));
        w.w = pk2(__uint_as_float(ov.w << 16) * __uint_as_float(gv.w << 16), __uint_as_float(ov.w & 0xffff0000u) * __uint_as_float(gv.w & 0xffff0000u));
        if (wr) *(v4u*)(Q1 + go) = w; }
      LDS_WAIT(); asm volatile("" ::: "memory"); }
  }
}

constexpr size_t DO_SDT = 50 * MiB, DO_SCS = 53 * MiB;
constexpr size_t WS_SSQ = 237 * MiB;
DEV unsigned short bfbits(float f) { return f2bf(f); }
DEV void ssd_prep_phase(const bf16_t* XBC, const float* cw, const float* cb, bf16_t* XC, const float* DTLR, const float* dt_bias, const float* a_log, float* SDT, float* SCS, float* SDEC) {
  const int gtid = blockIdx.x * 512 + threadIdx.x, gth = gridDim.x * 512;
  for (int it = gtid; it < (MA / 32) * 192; it += gth) {
    const int rg = it / 192, c8 = (it % 192) * 8, row0 = rg * 32;
    int t0, len;
    if (row0 < ML) { t0 = row0 % SEQ; len = SEQ; } else { t0 = (row0 - ML) % CTXL; len = CTXL; }
    float w[5][8], bias[8];
#pragma unroll
    for (int k = 0; k < 5; ++k) { const f32x4 w0 = *(const f32x4*)(cw + k * 1536 + c8), w1 = *(const f32x4*)(cw + k * 1536 + c8 + 4);
      w[k][0] = w0.x; w[k][1] = w0.y; w[k][2] = w0.z; w[k][3] = w0.w; w[k][4] = w1.x; w[k][5] = w1.y; w[k][6] = w1.z; w[k][7] = w1.w; }
    { const f32x4 b0 = *(const f32x4*)(cb + c8), b1 = *(const f32x4*)(cb + c8 + 4); bias[0] = b0.x; bias[1] = b0.y; bias[2] = b0.z; bias[3] = b0.w; bias[4] = b1.x; bias[5] = b1.y; bias[6] = b1.z; bias[7] = b1.w; }
    const v4u zero4 = {0u, 0u, 0u, 0u};
    v4u win[4];
#pragma unroll
    for (int q = 0; q < 4; ++q) { const int tt = t0 - 2 + q; win[q] = (tt >= 0 && tt < len) ? *(const v4u*)(XBC + (size_t)(row0 - 2 + q) * 1536 + c8) : zero4; }
#pragma unroll 4
    for (int i = 0; i < 32; ++i) {
      const int tt = t0 + i + 2; const v4u nx = (tt < len) ? *(const v4u*)(XBC + (size_t)(row0 + i + 2) * 1536 + c8) : zero4;
      float acc[8];
#pragma unroll
      for (int e = 0; e < 8; ++e) acc[e] = bias[e];
#define CONV_TAP(k, xv) do { acc[0] += w[k][0] * __uint_as_float((xv).x << 16); acc[1] += w[k][1] * __uint_as_float((xv).x & 0xffff0000u); acc[2] += w[k][2] * __uint_as_float((xv).y << 16); acc[3] += w[k][3] * __uint_as_float((xv).y & 0xffff0000u); \
        acc[4] += w[k][4] * __uint_as_float((xv).z << 16); acc[5] += w[k][5] * __uint_as_float((xv).z & 0xffff0000u); acc[6] += w[k][6] * __uint_as_float((xv).w << 16); acc[7] += w[k][7] * __uint_as_float((xv).w & 0xffff0000u); } while (0)
      CONV_TAP(0, win[0]); CONV_TAP(1, win[1]); CONV_TAP(2, win[2]); CONV_TAP(3, win[3]); CONV_TAP(4, nx);
#undef CONV_TAP
      v4u o; o.x = pk2(silu_fast(acc[0]), silu_fast(acc[1])); o.y = pk2(silu_fast(acc[2]), silu_fast(acc[3])); o.z = pk2(silu_fast(acc[4]), silu_fast(acc[5])); o.w = pk2(silu_fast(acc[6]), silu_fast(acc[7]));
      *(v4u*)(XC + (size_t)(row0 + i) * 1536 + c8) = o;
      win[0] = win[1]; win[1] = win[2]; win[2] = win[3]; win[3] = nx;
    }
  }
  {
    const int lane = threadIdx.x & 63, wave = threadIdx.x >> 6, cl = lane & 7, seg = lane >> 3;
    for (int wt = blockIdx.x * NWAVES + wave; wt < NCH * 4; wt += gridDim.x * NWAVES) {
      const int gc = wt >> 2, col = (wt & 3) * 8 + cl, dir = col >> 4, h = col & 15;
      const float a = -fexp(a_log[col]), bias = dt_bias[col];
      float dtv[16], v[16]; float run = 0.f;
#pragma unroll
      for (int u = 0; u < 16; ++u) { const int s = seg * 16 + u, t = dir ? 127 - s : s; dtv[u] = softplusf(DTLR[((size_t)gc * 128 + t) * 64 + col] + bias); }
#pragma unroll
      for (int u = 0; u < 16; ++u) { run += dtv[u] * a; v[u] = run; }
      float off = 0.f;
#pragma unroll
      for (int sgi = 0; sgi < 7; ++sgi) { const float tot = __shfl(run, cl + 8 * sgi); off += (sgi < seg) ? tot : 0.f; }
#pragma unroll
      for (int u = 0; u < 16; ++u) { const int s = seg * 16 + u, t = dir ? 127 - s : s; const size_t row = (size_t)gc * 128 + t; SDT[row * 32 + col] = dtv[u]; SCS[row * 32 + col] = v[u] + off; }
      if (seg == 7) SDEC[(gc * 16 + h) * 2 + dir] = fexp(run + off);
    }
  }
}
DEV void ssd_u_phase(const bf16_t* XC, const float* SDT, const float* SCS, bf16_t* ST, LAS unsigned char* lds) {
  constexpr int XP = 272, BP = 144;
  LAS bf16_t* Xs = (LAS bf16_t*)lds; LAS bf16_t* Bs = (LAS bf16_t*)(lds + 128 * XP * 2); LAS float* wtab = (LAS float*)(lds + 128 * XP * 2 + 128 * BP * 2);
  const int tid = threadIdx.x, lane = tid & 63, wid = tid >> 6, r = lane & 15, Qd = lane >> 4, hl = wid >> 1, dir = wid & 1;
  for (int task = virt_block(); task < NCH * 4; task += gridDim.x) {
    const int gc = task >> 2, g = (task >> 1) & 1, hh = task & 1; const size_t r0 = (size_t)gc * 128; const int h0 = g * 8 + hh * 4;
    __syncthreads();
#pragma unroll
    for (int i = 0; i < 8; ++i) { const int cid = tid + 512 * i, row = cid >> 5, ch = cid & 31; *(LAS v4u*)(Xs + row * XP + ch * 8) = *(const v4u*)(XC + (r0 + row) * 1536 + h0 * 64 + ch * 8); }
#pragma unroll
    for (int i = 0; i < 4; ++i) { const int cid = tid + 512 * i, row = cid >> 4, ch = cid & 15; *(LAS v4u*)(Bs + row * BP + ch * 8) = *(const v4u*)(XC + (r0 + row) * 1536 + 1024 + g * 128 + ch * 8); }
    if (tid < 256) { const int d_ = tid >> 7, t = tid & 127;
      const f32x4 ce = *(const f32x4*)(SCS + (r0 + (d_ ? 0 : 127)) * 32 + d_ * 16 + h0), ct = *(const f32x4*)(SCS + (r0 + t) * 32 + d_ * 16 + h0), dt = *(const f32x4*)(SDT + (r0 + t) * 32 + d_ * 16 + h0);
      wtab[(0 * 2 + d_) * 128 + t] = fexp(ce.x - ct.x) * dt.x; wtab[(1 * 2 + d_) * 128 + t] = fexp(ce.y - ct.y) * dt.y; wtab[(2 * 2 + d_) * 128 + t] = fexp(ce.z - ct.z) * dt.z; wtab[(3 * 2 + d_) * 128 + t] = fexp(ce.w - ct.w) * dt.w; }
    __syncthreads();
    const LAS float* wt = wtab + wid * 128;
    bf16_t* Sp = ST + ((((size_t)gc * 16 + h0 + hl) * 2 + dir) * 64) * 128;
#pragma unroll 1
    for (int pp = 0; pp < 2; ++pp) {
      f32x4 acc[8][2];
#pragma unroll
      for (int nt = 0; nt < 8; ++nt) { acc[nt][0] = (f32x4){0.f, 0.f, 0.f, 0.f}; acc[nt][1] = (f32x4){0.f, 0.f, 0.f, 0.f}; }
#pragma unroll 1
      for (int k = 0; k < 4; ++k) {
        const f32x4 wlo = *(const LAS f32x4*)(wt + 32 * k + 4 * Qd), whi = *(const LAS f32x4*)(wt + 32 * k + 16 + 4 * Qd);
        bf16x8 xf[2];
#pragma unroll
        for (int pt = 0; pt < 2; ++pt) {
          const s16x4 lo = tr_read(Xs + (32 * k + 4 * Qd + (r >> 2)) * XP + hl * 64 + 32 * pp + 16 * pt + 4 * (r & 3));
          const s16x4 hi = tr_read(Xs + (32 * k + 16 + 4 * Qd + (r >> 2)) * XP + hl * 64 + 32 * pp + 16 * pt + 4 * (r & 3));
          const unsigned w0 = pk2(bf2f((bf16_t)lo[0]) * wlo[0], bf2f((bf16_t)lo[1]) * wlo[1]), w1 = pk2(bf2f((bf16_t)lo[2]) * wlo[2], bf2f((bf16_t)lo[3]) * wlo[3]);
          const unsigned w2 = pk2(bf2f((bf16_t)hi[0]) * whi[0], bf2f((bf16_t)hi[1]) * whi[1]), w3 = pk2(bf2f((bf16_t)hi[2]) * whi[2], bf2f((bf16_t)hi[3]) * whi[3]);
          xf[pt] = (bf16x8){(short)(w0 & 0xffff), (short)(w0 >> 16), (short)(w1 & 0xffff), (short)(w1 >> 16), (short)(w2 & 0xffff), (short)(w2 >> 16), (short)(w3 & 0xffff), (short)(w3 >> 16)};
        }
#pragma unroll
        for (int nt = 0; nt < 8; ++nt) {
          const s16x4 lo = tr_read(Bs + (32 * k + 4 * Qd + (r >> 2)) * BP + 16 * nt + 4 * (r & 3));
          const s16x4 hi = tr_read(Bs + (32 * k + 16 + 4 * Qd + (r >> 2)) * BP + 16 * nt + 4 * (r & 3));
          const bf16x8 bfr = (bf16x8){lo[0], lo[1], lo[2], lo[3], hi[0], hi[1], hi[2], hi[3]};
          acc[nt][0] = __builtin_amdgcn_mfma_f32_16x16x32_bf16(bfr, xf[0], acc[nt][0], 0, 0, 0);
          acc[nt][1] = __builtin_amdgcn_mfma_f32_16x16x32_bf16(bfr, xf[1], acc[nt][1], 0, 0, 0);
        }
      }
#pragma unroll
      for (int nt = 0; nt < 8; ++nt)
#pragma unroll
        for (int pt = 0; pt < 2; ++pt) { const f32x4 v = acc[nt][pt];
          *(unsigned long long*)(Sp + ((((2 * pp + pt) * 4 + (nt >> 1)) * 64 + ((nt & 1) * 2 + (Qd >> 1)) * 16 + r) * 8 + 4 * (Qd & 1))) = (unsigned long long)pk2(v[0], v[1]) | ((unsigned long long)pk2(v[2], v[3]) << 32); }
    }
  }
}
DEV void ssd_scan_phase(bf16_t* ST, const float* SDEC, bool wr) {
  for (int item = blockIdx.x * 512 + threadIdx.x; item < 2 * 16 * 2 * 2048; item += gridDim.x * 512) {
    const int e4 = item & 2047, dir = (item >> 11) & 1, h = (item >> 12) & 15, b = item >> 16;
    float S0 = 0.f, S1 = 0.f, S2 = 0.f, S3 = 0.f;
#define SCAN_GC(s) (!dir ? ((s) < 2 ? 128 + 2 * b + (s) : b * 64 + ((s) - 2)) : ((s) < 2 ? 128 + 2 * b + (1 - (s)) : b * 64 + (65 - (s))))
    for (int s0 = 0; s0 < 66; s0 += 6) {
      unsigned long long u[6]; float dec[6];
#pragma unroll
      for (int q = 0; q < 6; ++q) { const int gc = SCAN_GC(s0 + q); u[q] = *(const unsigned long long*)(ST + (((size_t)gc * 16 + h) * 2 + dir) * 8192 + e4 * 4); dec[q] = SDEC[(gc * 16 + h) * 2 + dir]; }
#pragma unroll
      for (int q = 0; q < 6; ++q) { const int gc = SCAN_GC(s0 + q);
        if (wr) *(unsigned long long*)(ST + (((size_t)gc * 16 + h) * 2 + dir) * 8192 + e4 * 4) = (unsigned long long)pk2(S0, S1) | ((unsigned long long)pk2(S2, S3) << 32);
        const unsigned lo = (unsigned)u[q], hi = (unsigned)(u[q] >> 32);
        S0 = dec[q] * S0 + __uint_as_float(lo << 16); S1 = dec[q] * S1 + __uint_as_float(lo & 0xffff0000u); S2 = dec[q] * S2 + __uint_as_float(hi << 16); S3 = dec[q] * S3 + __uint_as_float(hi & 0xffff0000u); }
    }
#undef SCAN_GC
  }
}
DEV bf16x8 scale_frag(bf16x8 f, float s) {
  bf16x8 o;
#pragma unroll
  for (int e = 0; e < 8; e += 2) { const unsigned w = pk2(bf2f((bf16_t)f[e]) * s, bf2f((bf16_t)f[e + 1]) * s); o[e] = (short)(w & 0xffff); o[e + 1] = (short)(w >> 16); }
  return o;
}
DEV void ssd_y_phase(const bf16_t* XC, const float* SDT, const float* SCS, const bf16_t* ST, const float* d_skip, bf16_t* Y0, float* SSQ, LAS unsigned char* lds, bool wr) {
  constexpr int XP = 272, BP = 136, SP = 72;
  LAS bf16_t* Xs = (LAS bf16_t*)lds; LAS bf16_t* Bs = (LAS bf16_t*)(lds + 128 * XP * 2);
  LAS float* tab = (LAS float*)(lds + 128 * XP * 2 + 128 * BP * 2);
  LAS float* ssq = tab + 4 * 4 * 128;
  LAS bf16_t* stg = (LAS bf16_t*)(ssq + 4 * 128);
  const int tid = threadIdx.x, lane = tid & 63, wid = tid >> 6, r = lane & 15, Qd = lane >> 4, hl = wid >> 1, ih = wid & 1;
  LAS bf16_t* mystg = stg + wid * 16 * SP;
  for (int task = virt_block(); task < NCH * 4; task += gridDim.x) {
    const int gc = task >> 2, g = (task >> 1) & 1, hh = task & 1; const size_t r0 = (size_t)gc * 128; const int h0 = g * 8 + hh * 4, h = h0 + hl;
    bf16x8 cstrip[4], cf[4][4];
#pragma unroll
    for (int ks = 0; ks < 4; ++ks) cstrip[ks] = *(const bf16x8*)(XC + (r0 + 16 * wid + r) * 1536 + 1280 + g * 128 + 32 * ks + 8 * Qd);
#pragma unroll
    for (int m = 0; m < 4; ++m)
#pragma unroll
      for (int ks = 0; ks < 4; ++ks) cf[m][ks] = *(const bf16x8*)(XC + (r0 + 64 * ih + 16 * m + r) * 1536 + 1280 + g * 128 + 32 * ks + 8 * Qd);
    __syncthreads();
#pragma unroll
    for (int i = 0; i < 8; ++i) { const int cid = tid + 512 * i, row = cid >> 5, ch = cid & 31; *(LAS v4u*)(Xs + row * XP + ch * 8) = *(const v4u*)(XC + (r0 + row) * 1536 + h0 * 64 + ch * 8); }
#pragma unroll
    for (int i = 0; i < 4; ++i) { const int cid = tid + 512 * i, row = cid >> 4, ch = cid & 15; *(LAS v4u*)(Bs + row * BP + ch * 8) = *(const v4u*)(XC + (r0 + row) * 1536 + 1024 + g * 128 + ch * 8); }
    { const int which = tid >> 7, t = tid & 127; const f32x4 v = *(const f32x4*)((which < 2 ? SCS : SDT) + (r0 + t) * 32 + (which & 1) * 16 + h0);
      tab[0 * 512 + which * 128 + t] = v.x; tab[1 * 512 + which * 128 + t] = v.y; tab[2 * 512 + which * 128 + t] = v.z; tab[3 * 512 + which * 128 + t] = v.w; }
    __syncthreads();
    {
      f32x4 cb[8];
#pragma unroll
      for (int t = 0; t < 8; ++t) { f32x4 c = {0.f, 0.f, 0.f, 0.f};
#pragma unroll
        for (int ks = 0; ks < 4; ++ks) { const bf16x8 bfr = *(const LAS bf16x8*)(Bs + (16 * t + r) * BP + 32 * ks + 8 * Qd); c = __builtin_amdgcn_mfma_f32_16x16x32_bf16(bfr, cstrip[ks], c, 0, 0, 0); }
        cb[t] = c; }
      __syncthreads();
#pragma unroll
      for (int t = 0; t < 8; ++t) *(LAS unsigned long long*)(Bs + (16 * wid + r) * BP + 16 * t + 4 * Qd) = (unsigned long long)pk2(cb[t][0], cb[t][1]) | ((unsigned long long)pk2(cb[t][2], cb[t][3]) << 32);
      __syncthreads();
    }
    const LAS float* csf = tab + hl * 512; const LAS float* csb = csf + 128; const LAS float* dtf = csf + 256; const LAS float* dtb = csf + 384;
    const float dsk = d_skip[h];
    f32x4 y[4][4];
#pragma unroll
    for (int m = 0; m < 4; ++m)
#pragma unroll
      for (int pt = 0; pt < 4; ++pt) y[m][pt] = (f32x4){0.f, 0.f, 0.f, 0.f};
    if (wr || !(PROBE_SKIP & 1))
#pragma unroll 1
    for (int dir = 0; dir < 2; ++dir) {
      const LAS float* csd = dir ? csb : csf; float sc[4];
#pragma unroll
      for (int m = 0; m < 4; ++m)
#pragma unroll
        for (int ks = 0; ks < 4; ++ks) asm volatile("" : "+v"(cf[m][ks]));
#pragma unroll
      for (int m = 0; m < 4; ++m) sc[m] = fexp(csd[64 * ih + 16 * m + r]);
      const bf16_t* Sp = ST + (((size_t)gc * 16 + h) * 2 + dir) * 8192 + lane * 8;
#pragma unroll
      for (int ks = 0; ks < 4; ++ks) {
        bf16x8 sf[4];
#pragma unroll
        for (int pt = 0; pt < 4; ++pt) sf[pt] = *(const bf16x8*)(Sp + (pt * 4 + ks) * 512);
#pragma unroll
        for (int m = 0; m < 4; ++m) { const bf16x8 a = scale_frag(cf[m][ks], sc[m]);
#pragma unroll
          for (int pt = 0; pt < 4; ++pt) y[m][pt] = __builtin_amdgcn_mfma_f32_16x16x32_bf16(a, sf[pt], y[m][pt], 0, 0, 0);
          __builtin_amdgcn_sched_barrier(0); }
      }
    }
#pragma unroll 1
    for (int m = 0; m < 4; ++m) {
      const int i0 = 64 * ih + 16 * m, i = i0 + r;
      const float cfi = csf[i], cbi = csb[i];
      v4u zpre[2];
#pragma unroll
      for (int q = 0; q < 2; ++q) { const int c = lane + 64 * q; zpre[q] = *(const v4u*)(Y0 + (r0 + i0 + (c >> 3)) * 2048 + h * 64 + (c & 7) * 8); }
      if (wr || !(PROBE_SKIP & 2))
#pragma unroll 1
      for (int k2 = 0; k2 < 4; ++k2) {
        const int j0 = 32 * k2 + 8 * Qd;
        const v4u cbv = *(const LAS v4u*)(Bs + i * BP + j0);
        const float cbe[8] = {__uint_as_float(cbv.x << 16), __uint_as_float(cbv.x & 0xffff0000u), __uint_as_float(cbv.y << 16), __uint_as_float(cbv.y & 0xffff0000u), __uint_as_float(cbv.z << 16), __uint_as_float(cbv.z & 0xffff0000u), __uint_as_float(cbv.w << 16), __uint_as_float(cbv.w & 0xffff0000u)};
        float pv[8];
        const bool dofwd = (32 * k2 <= i0 + 15), dobwd = (32 * k2 + 31 >= i0);
#pragma unroll
        for (int e = 0; e < 8; ++e) pv[e] = (j0 + e == i) ? dsk : 0.f;
        if (dofwd) { const f32x4 a0 = *(const LAS f32x4*)(csf + j0), a1 = *(const LAS f32x4*)(csf + j0 + 4), d0 = *(const LAS f32x4*)(dtf + j0), d1 = *(const LAS f32x4*)(dtf + j0 + 4);
          const float jc[8] = {a0.x, a0.y, a0.z, a0.w, a1.x, a1.y, a1.z, a1.w}; const float jd[8] = {d0.x, d0.y, d0.z, d0.w, d1.x, d1.y, d1.z, d1.w};
#pragma unroll
          for (int e = 0; e < 8; ++e) pv[e] += cbe[e] * fexp(j0 + e <= i ? cfi - jc[e] : -INFINITY) * jd[e]; }
        if (dobwd) { const f32x4 a0 = *(const LAS f32x4*)(csb + j0), a1 = *(const LAS f32x4*)(csb + j0 + 4), d0 = *(const LAS f32x4*)(dtb + j0), d1 = *(const LAS f32x4*)(dtb + j0 + 4);
          const float jc[8] = {a0.x, a0.y, a0.z, a0.w, a1.x, a1.y, a1.z, a1.w}; const float jd[8] = {d0.x, d0.y, d0.z, d0.w, d1.x, d1.y, d1.z, d1.w};
#pragma unroll
          for (int e = 0; e < 8; ++e) pv[e] += cbe[e] * fexp(j0 + e >= i ? cbi - jc[e] : -INFINITY) * jd[e]; }
        const unsigned w0 = pk2(pv[0], pv[1]), w1 = pk2(pv[2], pv[3]), w2 = pk2(pv[4], pv[5]), w3 = pk2(pv[6], pv[7]);
        const bf16x8 pa = (bf16x8){(short)(w0 & 0xffff), (short)(w0 >> 16), (short)(w1 & 0xffff), (short)(w1 >> 16), (short)(w2 & 0xffff), (short)(w2 >> 16), (short)(w3 & 0xffff), (short)(w3 >> 16)};
#pragma unroll
        for (int pt = 0; pt < 4; ++pt) {
          const s16x4 lo = tr_read(Xs + (32 * k2 + 8 * Qd + (r >> 2)) * XP + hl * 64 + 16 * pt + 4 * (r & 3));
          const s16x4 hi = tr_read(Xs + (32 * k2 + 8 * Qd + 4 + (r >> 2)) * XP + hl * 64 + 16 * pt + 4 * (r & 3));
          const bf16x8 xf = (bf16x8){lo[0], lo[1], lo[2], lo[3], hi[0], hi[1], hi[2], hi[3]};
          y[0][pt] = __builtin_amdgcn_mfma_f32_16x16x32_bf16(pa, xf, y[0][pt], 0, 0, 0);
        }
      }
      if (wr || !(PROBE_SKIP & 4)) {
#pragma unroll
      for (int pt = 0; pt < 4; ++pt)
#pragma unroll
        for (int jj = 0; jj < 4; ++jj) mystg[(4 * Qd + jj) * SP + 16 * pt + r] = f2bf(y[0][pt][jj]);
      LDS_WAIT(); asm volatile("" ::: "memory");
#pragma unroll
      for (int q = 0; q < 2; ++q) { const int c = lane + 64 * q, rowl = c >> 3, ch = c & 7; const int il = 64 * ih + 16 * m + rowl;
        const v4u yv = *(const LAS v4u*)(mystg + rowl * SP + ch * 8); bf16_t* zp = Y0 + (r0 + il) * 2048 + h * 64 + ch * 8; const v4u zv = zpre[q];
        const float v0 = __uint_as_float(yv.x << 16) * __uint_as_float(zv.x << 16), v1 = __uint_as_float(yv.x & 0xffff0000u) * __uint_as_float(zv.x & 0xffff0000u);
        const float v2 = __uint_as_float(yv.y << 16) * __uint_as_float(zv.y << 16), v3 = __uint_as_float(yv.y & 0xffff0000u) * __uint_as_float(zv.y & 0xffff0000u);
        const float v4 = __uint_as_float(yv.z << 16) * __uint_as_float(zv.z << 16), v5 = __uint_as_float(yv.z & 0xffff0000u) * __uint_as_float(zv.z & 0xffff0000u);
        const float v6 = __uint_as_float(yv.w << 16) * __uint_as_float(zv.w << 16), v7 = __uint_as_float(yv.w & 0xffff0000u) * __uint_as_float(zv.w & 0xffff0000u);
        float ss = (v0 * v0 + v1 * v1) + (v2 * v2 + v3 * v3) + (v4 * v4 + v5 * v5) + (v6 * v6 + v7 * v7);
        ss += __shfl_xor(ss, 1); ss += __shfl_xor(ss, 2); ss += __shfl_xor(ss, 4);
        v4u ov; ov.x = pk2(v0, v1); ov.y = pk2(v2, v3); ov.z = pk2(v4, v5); ov.w = pk2(v6, v7);
        if (wr) *(v4u*)zp = ov;
        if (ch == 0) ssq[hl * 128 + il] = ss; }
      LDS_WAIT(); asm volatile("" ::: "memory");
      }
#pragma unroll
      for (int pt = 0; pt < 4; ++pt) { y[0][pt] = y[1][pt]; y[1][pt] = y[2][pt]; y[2][pt] = y[3][pt]; }
    }
    __syncthreads();
    if (tid < 128) SSQ[((r0 + tid) * 2 + g) * 2 + hh] = (ssq[tid] + ssq[128 + tid]) + (ssq[256 + tid] + ssq[384 + tid]);
  }
}

typedef _Float16 h16_t;
typedef _Float16 h16x8 __attribute__((ext_vector_type(8)));
DEV const h16_t* gcs_row(const h16_t* wsb, const h16_t* outb, size_t row) {
  return row < 9472 ? (const h16_t*)((const char*)wsb + 237 * MiB + 512 * 1024) + row * 1024 : (row < 13824 ? (const h16_t*)((const char*)outb + 55 * MiB + 512 * 1024) + (row - 9472) * 1024 : (const h16_t*)((const char*)wsb + 2 * MiB) + (row - 13824) * 1024); }
DEV h16_t* gcs_row_w(h16_t* wsb, h16_t* outb, size_t row) { return (h16_t*)gcs_row(wsb, outb, row); }
DEV float logsig_fast(float x) { return fminf(x, 0.f) - 0.6931471805599453f * __builtin_amdgcn_logf(1.f + __builtin_amdgcn_exp2f(-1.4426950408889634f * fabsf(x))); }
DEV void gla_cs_phase(const float* DTLR, const float* gw, const float* gb, h16_t* GCSL, h16_t* GCSC, float* GDEC, LAS unsigned char* lds, unsigned* queue) {
  const int lane = threadIdx.x & 63, wave = threadIdx.x >> 6;
  LAS float* lrs = (LAS float*)(lds + wave * 8192);
  LAS h16_t* tile = (LAS h16_t*)(lds + 65536 + wave * 1024);
  for (;;) {
    unsigned wt_ = 0u; if (lane == 0) wt_ = __hip_atomic_fetch_add(queue, 1u, __ATOMIC_RELAXED, __HIP_MEMORY_SCOPE_AGENT);
    wt_ = (unsigned)__builtin_amdgcn_readfirstlane((int)wt_); if (wt_ >= (unsigned)(NCH * 2 * 8)) break;
    const int wt = (int)wt_;
    const int gc = wt >> 4, dir = (wt >> 3) & 1, k = (wt & 7) * 64 + lane;
#pragma unroll
    for (int q = 0; q < 8; ++q) { const int c = lane + 64 * q, row = c >> 2, part = c & 3;
      *(LAS f32x4*)(lrs + row * 16 + part * 4) = *(const f32x4*)(DTLR + ((size_t)gc * 128 + row) * 64 + 32 + dir * 16 + part * 4); }
    float wv[16];
#pragma unroll
    for (int q = 0; q < 16; ++q) wv[q] = gw[(dir * 16 + q) * 512 + k];
    const float bias = gb[dir * 512 + k];
    LDS_WAIT(); asm volatile("" ::: "memory");
    float run = 0.f;
#pragma unroll 1
    for (int s0 = 0; s0 < 128; s0 += 8) {
      float lg[8];
#pragma unroll
      for (int u = 0; u < 8; ++u) { const int s = s0 + u, t = dir ? 127 - s : s; const LAS float* lr = lrs + t * 16;
        const f32x4 l0 = *(const LAS f32x4*)lr, l1 = *(const LAS f32x4*)(lr + 4), l2 = *(const LAS f32x4*)(lr + 8), l3 = *(const LAS f32x4*)(lr + 12);
        const float x = bias + l0.x * wv[0] + l0.y * wv[1] + l0.z * wv[2] + l0.w * wv[3] + l1.x * wv[4] + l1.y * wv[5] + l1.z * wv[6] + l1.w * wv[7]
                        + l2.x * wv[8] + l2.y * wv[9] + l2.z * wv[10] + l2.w * wv[11] + l3.x * wv[12] + l3.y * wv[13] + l3.z * wv[14] + l3.w * wv[15];
        lg[u] = logsig_fast(x) * (1.f / 16.f); }
#pragma unroll
      for (int u = 0; u < 8; ++u) { run += lg[u]; tile[u * 64 + lane] = (h16_t)run; }
      LDS_WAIT(); asm volatile("" ::: "memory");
      { const int u = lane >> 3, ch = lane & 7, s = s0 + u, t = dir ? 127 - s : s;
        *(v4u*)(gcs_row_w(GCSL, GCSC, (size_t)gc * 128 + t) + dir * 512 + (k - lane) + ch * 8) = *(const LAS v4u*)(tile + u * 64 + ch * 8); }
      LDS_WAIT(); asm volatile("" ::: "memory");
    }
    GDEC[((gc * 4 + (k >> 7)) * 2 + dir) * 128 + (k & 127)] = fexp(run);
    LDS_WAIT(); asm volatile("" ::: "memory");
  }
}
DEV void gla_u_phase(const bf16_t* K0, const bf16_t* V0, const h16_t* GCSL, const h16_t* GCSC, bf16_t* ST, LAS unsigned char* lds) {
  constexpr int VP = 272, KP = 144;
  LAS bf16_t* Vs = (LAS bf16_t*)lds; LAS bf16_t* Kd = (LAS bf16_t*)(lds + 128 * VP * 2);
  const int tid = threadIdx.x, lane = tid & 63, wid = tid >> 6, r = lane & 15, Qd = lane >> 4;
  for (int task = virt_block(); task < NCH * 4; task += gridDim.x) {
    const int gc = task >> 2, h = task & 3; const size_t r0 = (size_t)gc * 128;
    __syncthreads();
#pragma unroll
    for (int i = 0; i < 8; ++i) { const int cid = tid + 512 * i, row = cid >> 5, ch = cid & 31; *(LAS v4u*)(Vs + row * VP + ch * 8) = *(const v4u*)(V0 + (r0 + row) * 1024 + h * 256 + ch * 8); }
#pragma unroll
    for (int i = 0; i < 4; ++i) { const int cid = tid + 512 * i, t = cid >> 4, ch = cid & 15;
      const v4u kv = *(const v4u*)(K0 + (r0 + t) * 512 + h * 128 + ch * 8);
      const float kf[8] = {__uint_as_float(kv.x << 16), __uint_as_float(kv.x & 0xffff0000u), __uint_as_float(kv.y << 16), __uint_as_float(kv.y & 0xffff0000u), __uint_as_float(kv.z << 16), __uint_as_float(kv.z & 0xffff0000u), __uint_as_float(kv.w << 16), __uint_as_float(kv.w & 0xffff0000u)};
#pragma unroll
      for (int dir = 0; dir < 2; ++dir) {
        const h16x8 ce = *(const h16x8*)(gcs_row(GCSL, GCSC, r0 + (dir ? 0 : 127)) + dir * 512 + h * 128 + ch * 8), ct = *(const h16x8*)(gcs_row(GCSL, GCSC, r0 + t) + dir * 512 + h * 128 + ch * 8);
        v4u o; o.x = pk2(kf[0] * fexp((float)ce[0] - (float)ct[0]), kf[1] * fexp((float)ce[1] - (float)ct[1])); o.y = pk2(kf[2] * fexp((float)ce[2] - (float)ct[2]), kf[3] * fexp((float)ce[3] - (float)ct[3]));
        o.z = pk2(kf[4] * fexp((float)ce[4] - (float)ct[4]), kf[5] * fexp((float)ce[5] - (float)ct[5])); o.w = pk2(kf[6] * fexp((float)ce[6] - (float)ct[6]), kf[7] * fexp((float)ce[7] - (float)ct[7]));
        *(LAS v4u*)(Kd + dir * 128 * KP + t * KP + ch * 8) = o; } }
    __syncthreads();
#pragma unroll 1
    for (int dir = 0; dir < 2; ++dir) {
      const LAS bf16_t* Kb = Kd + dir * 128 * KP;
      f32x4 acc[8][2];
#pragma unroll
      for (int dt = 0; dt < 8; ++dt) { acc[dt][0] = (f32x4){0.f, 0.f, 0.f, 0.f}; acc[dt][1] = (f32x4){0.f, 0.f, 0.f, 0.f}; }
#pragma unroll 1
      for (int k = 0; k < 4; ++k) {
        bf16x8 vf[2];
#pragma unroll
        for (int et = 0; et < 2; ++et) {
          const s16x4 lo = tr_read(Vs + (32 * k + 4 * Qd + (r >> 2)) * VP + 32 * wid + 16 * et + 4 * (r & 3));
          const s16x4 hi = tr_read(Vs + (32 * k + 16 + 4 * Qd + (r >> 2)) * VP + 32 * wid + 16 * et + 4 * (r & 3));
          vf[et] = (bf16x8){lo[0], lo[1], lo[2], lo[3], hi[0], hi[1], hi[2], hi[3]}; }
#pragma unroll
        for (int dt = 0; dt < 8; ++dt) {
          const s16x4 lo = tr_read(Kb + (32 * k + 4 * Qd + (r >> 2)) * KP + 16 * dt + 4 * (r & 3));
          const s16x4 hi = tr_read(Kb + (32 * k + 16 + 4 * Qd + (r >> 2)) * KP + 16 * dt + 4 * (r & 3));
          const bf16x8 kfr = (bf16x8){lo[0], lo[1], lo[2], lo[3], hi[0], hi[1], hi[2], hi[3]};
          acc[dt][0] = __builtin_amdgcn_mfma_f32_16x16x32_bf16(kfr, vf[0], acc[dt][0], 0, 0, 0);
          acc[dt][1] = __builtin_amdgcn_mfma_f32_16x16x32_bf16(kfr, vf[1], acc[dt][1], 0, 0, 0); }
      }
      bf16_t* Sp = ST + (((size_t)gc * 4 + h) * 2 + dir) * 32768;
#pragma unroll
      for (int dt = 0; dt < 8; ++dt)
#pragma unroll
        for (int et = 0; et < 2; ++et) { const f32x4 v = acc[dt][et];
          *(unsigned long long*)(Sp + ((((2 * wid + et) * 4 + (dt >> 1)) * 64 + ((dt & 1) * 2 + (Qd >> 1)) * 16 + r) * 8 + 4 * (Qd & 1))) = (unsigned long long)pk2(v[0], v[1]) | ((unsigned long long)pk2(v[2], v[3]) << 32); }
    }
  }
}
DEV void gla_scan_phase(bf16_t* ST, const float* GDEC, bool wr) {
  for (int item = blockIdx.x * 512 + threadIdx.x; item < 2 * 4 * 2 * 8192; item += gridDim.x * 512) {
    const int e4 = item & 8191, dir = (item >> 13) & 1, h = (item >> 14) & 3, b = item >> 16; const int d0 = 32 * ((e4 >> 7) & 3) + 8 * ((e4 >> 5) & 3) + 4 * (e4 & 1);
    float S0 = 0.f, S1 = 0.f, S2 = 0.f, S3 = 0.f;
#define SCAN_GC(s) (!dir ? ((s) < 2 ? 128 + 2 * b + (s) : b * 64 + ((s) - 2)) : ((s) < 2 ? 128 + 2 * b + (1 - (s)) : b * 64 + (65 - (s))))
    for (int s0 = 0; s0 < 66; s0 += 6) {
      unsigned long long u[6]; f32x4 dec[6];
#pragma unroll
      for (int q = 0; q < 6; ++q) { const int gc = SCAN_GC(s0 + q); u[q] = *(const unsigned long long*)(ST + (((size_t)gc * 4 + h) * 2 + dir) * 32768 + e4 * 4); dec[q] = *(const f32x4*)(GDEC + ((gc * 4 + h) * 2 + dir) * 128 + d0); }
#pragma unroll
      for (int q = 0; q < 6; ++q) { const int gc = SCAN_GC(s0 + q);
        if (wr) *(unsigned long long*)(ST + (((size_t)gc * 4 + h) * 2 + dir) * 32768 + e4 * 4) = (unsigned long long)pk2(S0, S1) | ((unsigned long long)pk2(S2, S3) << 32);
        const unsigned lo = (unsigned)u[q], hi = (unsigned)(u[q] >> 32);
        S0 = dec[q].x * S0 + __uint_as_float(lo << 16); S1 = dec[q].y * S1 + __uint_as_float(lo & 0xffff0000u); S2 = dec[q].z * S2 + __uint_as_float(hi << 16); S3 = dec[q].w * S3 + __uint_as_float(hi & 0xffff0000u); }
    }
#undef SCAN_GC
  }
}
DEV void gla_o_phase(const bf16_t* Q0, const bf16_t* K0, const bf16_t* V0, const h16_t* GCSL, const h16_t* GCSC, const bf16_t* ST, const float* gla_norm, const float* SSQ, const float* ssd_norm, bf16_t* Y0, LAS unsigned char* lds, bool wr) {
  constexpr int VP = 272, KP = 136;
  LAS bf16_t* Vs = (LAS bf16_t*)lds; LAS bf16_t* Kd = (LAS bf16_t*)(lds + 128 * VP * 2);
  const int tid = threadIdx.x, lane = tid & 63, wid = tid >> 6, r = lane & 15, Qd = lane >> 4;
  const float scale = 0.08838834764831845f;
  for (int task = virt_block(); task < NCH * 4; task += gridDim.x) {
    const int gc = task >> 2, h = task & 3; const size_t r0 = (size_t)gc * 128;
    __syncthreads();
#pragma unroll
    for (int i = 0; i < 8; ++i) { const int cid = tid + 512 * i, row = cid >> 5, ch = cid & 31; *(LAS v4u*)(Vs + row * VP + ch * 8) = *(const v4u*)(V0 + (r0 + row) * 1024 + h * 256 + ch * 8); }
#pragma unroll
    for (int i = 0; i < 4; ++i) { const int cid = tid + 512 * i, t = cid >> 4, ch = cid & 15;
      const v4u kv = *(const v4u*)(K0 + (r0 + t) * 512 + h * 128 + ch * 8);
      const float kf[8] = {__uint_as_float(kv.x << 16), __uint_as_float(kv.x & 0xffff0000u), __uint_as_float(kv.y << 16), __uint_as_float(kv.y & 0xffff0000u), __uint_as_float(kv.z << 16), __uint_as_float(kv.z & 0xffff0000u), __uint_as_float(kv.w << 16), __uint_as_float(kv.w & 0xffff0000u)};
#pragma unroll
      for (int dir = 0; dir < 2; ++dir) {
        const h16x8 ct = *(const h16x8*)(gcs_row(GCSL, GCSC, r0 + t) + dir * 512 + h * 128 + ch * 8);
        v4u o; o.x = pk2(kf[0] * fexp(-(float)ct[0]), kf[1] * fexp(-(float)ct[1])); o.y = pk2(kf[2] * fexp(-(float)ct[2]), kf[3] * fexp(-(float)ct[3]));
        o.z = pk2(kf[4] * fexp(-(float)ct[4]), kf[5] * fexp(-(float)ct[5])); o.w = pk2(kf[6] * fexp(-(float)ct[6]), kf[7] * fexp(-(float)ct[7]));
        *(LAS v4u*)(Kd + dir * 128 * KP + t * KP + ch * 8) = o; } }
    __syncthreads();
    const int i = 16 * wid + r;
    f32x4 o[16];
#pragma unroll
    for (int et = 0; et < 16; ++et) o[et] = (f32x4){0.f, 0.f, 0.f, 0.f};
#pragma unroll 1
    for (int dir = 0; dir < 2; ++dir) {
      bf16x8 qd[4];
      { const h16_t* ci = gcs_row(GCSL, GCSC, r0 + i) + dir * 512 + h * 128; const bf16_t* qp = Q0 + (r0 + i) * 512 + h * 128;
#pragma unroll
        for (int ks = 0; ks < 4; ++ks) { const v4u qv = *(const v4u*)(qp + 32 * ks + 8 * Qd); const h16x8 cc = *(const h16x8*)(ci + 32 * ks + 8 * Qd);
          const f32x4 c0 = {(float)cc[0], (float)cc[1], (float)cc[2], (float)cc[3]}, c1 = {(float)cc[4], (float)cc[5], (float)cc[6], (float)cc[7]};
          const unsigned w0 = pk2(__uint_as_float(qv.x << 16) * scale * fexp(c0.x), __uint_as_float(qv.x & 0xffff0000u) * scale * fexp(c0.y));
          const unsigned w1 = pk2(__uint_as_float(qv.y << 16) * scale * fexp(c0.z), __uint_as_float(qv.y & 0xffff0000u) * scale * fexp(c0.w));
          const unsigned w2 = pk2(__uint_as_float(qv.z << 16) * scale * fexp(c1.x), __uint_as_float(qv.z & 0xffff0000u) * scale * fexp(c1.y));
          const unsigned w3 = pk2(__uint_as_float(qv.w << 16) * scale * fexp(c1.z), __uint_as_float(qv.w & 0xffff0000u) * scale * fexp(c1.w));
          qd[ks] = (bf16x8){(short)(w0 & 0xffff), (short)(w0 >> 16), (short)(w1 & 0xffff), (short)(w1 >> 16), (short)(w2 & 0xffff), (short)(w2 >> 16), (short)(w3 & 0xffff), (short)(w3 >> 16)}; } }
      const bf16_t* Sp = ST + (((size_t)gc * 4 + h) * 2 + dir) * 32768 + lane * 8;
      {
        bf16x8 sA[4], sB[4];
#pragma unroll
        for (int q = 0; q < 4; ++q) sA[q] = *(const bf16x8*)(Sp + (q * 4 + 0) * 512);
#pragma unroll
        for (int bi = 0; bi < 16; ++bi) {
          const int ks = bi >> 2, e0 = 4 * (bi & 3);
          if (bi + 1 < 16) { const int ks2 = (bi + 1) >> 2, e2 = 4 * ((bi + 1) & 3);
#pragma unroll
            for (int q = 0; q < 4; ++q) { if (bi & 1) sA[q] = *(const bf16x8*)(Sp + ((e2 + q) * 4 + ks2) * 512); else sB[q] = *(const bf16x8*)(Sp + ((e2 + q) * 4 + ks2) * 512); } }
#pragma unroll
          for (int q = 0; q < 4; ++q) o[e0 + q] = __builtin_amdgcn_mfma_f32_16x16x32_bf16(qd[ks], (bi & 1) ? sB[q] : sA[q], o[e0 + q], 0, 0, 0);
          __builtin_amdgcn_sched_barrier(0);
        }
      }
      const LAS bf16_t* Kb = Kd + dir * 128 * KP;
#pragma unroll 1
      for (int k2 = 0; k2 < 4; ++k2) {
        const bool need = dir ? (2 * k2 + 1 >= wid) : (2 * k2 <= wid);
        if (!need) continue;
        bf16x8 pa;
#pragma unroll
        for (int tt = 0; tt < 2; ++tt) { const int t = 2 * k2 + tt;
          f32x4 c = {0.f, 0.f, 0.f, 0.f};
#pragma unroll
          for (int ks = 0; ks < 4; ++ks) { const bf16x8 kfr = *(const LAS bf16x8*)(Kb + (16 * t + r) * KP + 32 * ks + 8 * Qd); c = __builtin_amdgcn_mfma_f32_16x16x32_bf16(kfr, qd[ks], c, 0, 0, 0); }
          float pv[4];
#pragma unroll
          for (int jj = 0; jj < 4; ++jj) { const int j = 16 * t + 4 * Qd + jj; const bool ok = dir ? (j >= i) : (j <= i); pv[jj] = ok ? c[jj] : 0.f; }
          const unsigned w0 = pk2(pv[0], pv[1]), w1 = pk2(pv[2], pv[3]);
          pa[tt * 4 + 0] = (short)(w0 & 0xffff); pa[tt * 4 + 1] = (short)(w0 >> 16); pa[tt * 4 + 2] = (short)(w1 & 0xffff); pa[tt * 4 + 3] = (short)(w1 >> 16); }
#pragma unroll
        for (int et = 0; et < 16; ++et) {
          const s16x4 lo = tr_read(Vs + (32 * k2 + 4 * Qd + (r >> 2)) * VP + 16 * et + 4 * (r & 3));
          const s16x4 hi = tr_read(Vs + (32 * k2 + 16 + 4 * Qd + (r >> 2)) * VP + 16 * et + 4 * (r & 3));
          const bf16x8 vf = (bf16x8){lo[0], lo[1], lo[2], lo[3], hi[0], hi[1], hi[2], hi[3]};
          o[et] = __builtin_amdgcn_mfma_f32_16x16x32_bf16(pa, vf, o[et], 0, 0, 0); }
      }
    }
#pragma unroll
    for (int jj = 0; jj < 4; ++jj) { float ss = 0.f;
#pragma unroll
      for (int et = 0; et < 16; ++et) ss += o[et][jj] * o[et][jj];
      ss += __shfl_xor(ss, 1); ss += __shfl_xor(ss, 2); ss += __shfl_xor(ss, 4); ss += __shfl_xor(ss, 8);
      const float rstd = rsqrtf(ss * (1.f / 256.f) + EPS);
      const size_t yo = (r0 + 16 * wid + 4 * Qd + jj) * 2048 + 1024 + h * 256 + r;
#pragma unroll
      for (int et = 0; et < 16; ++et) { const bf16_t ov_ = f2bf(o[et][jj] * rstd * gla_norm[h * 256 + 16 * et + r] * bf2f(Y0[yo + 16 * et])); if (wr) Y0[yo + 16 * et] = ov_; } }
    { const int g = h >> 1, c0 = g * 512 + (h & 1) * 256;
#pragma unroll
      for (int q = 0; q < 8; ++q) { const int cid = tid + 512 * q, row = cid >> 5, ch = cid & 31; const size_t rr = r0 + row;
        const float rstd = rsqrtf((SSQ[(rr * 2 + g) * 2] + SSQ[(rr * 2 + g) * 2 + 1]) * (1.f / 512.f) + EPS);
        bf16_t* yp = Y0 + rr * 2048 + c0 + ch * 8; const v4u yv = *(const v4u*)yp; const f32x4 g0 = *(const f32x4*)(ssd_norm + c0 + ch * 8), g1 = *(const f32x4*)(ssd_norm + c0 + ch * 8 + 4);
        v4u ov; ov.x = pk2(__uint_as_float(yv.x << 16) * rstd * g0.x, __uint_as_float(yv.x & 0xffff0000u) * rstd * g0.y); ov.y = pk2(__uint_as_float(yv.y << 16) * rstd * g0.z, __uint_as_float(yv.y & 0xffff0000u) * rstd * g0.w);
        ov.z = pk2(__uint_as_float(yv.z << 16) * rstd * g1.x, __uint_as_float(yv.z & 0xffff0000u) * rstd * g1.y); ov.w = pk2(__uint_as_float(yv.w << 16) * rstd * g1.z, __uint_as_float(yv.w & 0xffff0000u) * rstd * g1.w);
        if (wr) *(v4u*)yp = ov; } }
  }
}

typedef __attribute__((address_space(1))) unsigned gu32;
#define RLX_AGENT __ATOMIC_RELAXED, __HIP_MEMORY_SCOPE_AGENT
#define XB_TMO      128
#define XB_XCNT(j)  (256  + 64 * (j))
#define XB_XSUB(j)  (1280 + 64 * (j))
#define XB_XGEN(j)  (2304 + 64 * (j))
#define XB_TOP      3328
#define XB_TOPGEN   3392
#define XCD_BAR_WORDS 3456
#define XB_SPIN_CAP (1u << 18)

__device__ __forceinline__ unsigned xb_ld(unsigned* p)              { return __hip_atomic_load(p, __ATOMIC_RELAXED, __HIP_MEMORY_SCOPE_AGENT); }
__device__ __forceinline__ unsigned xb_add(unsigned* p, unsigned v) { return __hip_atomic_fetch_add(p, v, __ATOMIC_RELAXED, __HIP_MEMORY_SCOPE_AGENT); }
__device__ __forceinline__ unsigned xb_xcc_id() { return (unsigned)__builtin_amdgcn_s_getreg((3 << 11) | 20) & 0xFu; }
#define XB_SPIN(cond, bar) do { unsigned _sp = 0; while (cond) { __builtin_amdgcn_s_sleep(1); \
    if ((++_sp & 255u) == 0u) { if (xb_ld(&(bar)[XB_TMO])) break; if (_sp > XB_SPIN_CAP) { atomicAdd(&(bar)[XB_TMO], 1u); break; } } } } while (0)

struct XcdBarrier {
    unsigned* bar; unsigned x;
    volatile LAS unsigned* st;
};

__device__ __forceinline__ XcdBarrier xcd_barrier_post(unsigned* bar, volatile LAS unsigned* st) {
    XcdBarrier b; b.bar = bar; b.x = xb_xcc_id(); b.st = st;
    if (threadIdx.x == 0) (void)xb_add(&bar[XB_XCNT(b.x)], 1u);
    return b;
}
__device__ __forceinline__ void xcd_barrier_complete(unsigned* bar, unsigned x, unsigned& nloc, unsigned& nx) {
    const unsigned G = gridDim.x * gridDim.y * gridDim.z;
    unsigned sum, cnt, mine, sp = 0u;
    for (;;) {
        sum = 0u; cnt = 0u; mine = 0u;
#pragma unroll
        for (unsigned j = 0; j < 16; ++j) { const unsigned c = xb_ld(&bar[XB_XCNT(j)]); sum += c; cnt += (c > 0u) ? 1u : 0u; mine = (j == x) ? c : mine; }
        if (sum == G) break;
        __builtin_amdgcn_s_sleep(1);
        if ((++sp & 255u) == 0u) { if (xb_ld(&bar[XB_TMO])) break; if (sp > XB_SPIN_CAP) { atomicAdd(&bar[XB_TMO], 1u); break; } }
    }
    nloc = mine > 0u ? mine : 1u; nx = cnt > 0u ? cnt : 1u;
}

__device__ __forceinline__ void xcd_barrier(const XcdBarrier& b) {
    asm volatile("s_waitcnt vmcnt(0)" ::: "memory");
    __syncthreads();
    if (threadIdx.x == 0) {
        unsigned* bar = b.bar;
        __builtin_amdgcn_s_waitcnt(0);
        unsigned nloc = b.st[0], nx = b.st[1];
        if (nloc == 0u) { xcd_barrier_complete(bar, b.x, nloc, nx); b.st[0] = nloc; b.st[1] = nx; }
        const unsigned old = xb_add(&bar[XB_XSUB(b.x)], 1u);
        const unsigned gen = old / nloc;
        if (old + 1u == (gen + 1u) * nloc) {
            __builtin_amdgcn_fence(__ATOMIC_RELEASE, "agent");
            asm volatile("s_waitcnt vmcnt(0)" ::: "memory");
            const unsigned og = xb_add(&bar[XB_TOP], 1u);
            const unsigned tg = og / nx;
            if (og + 1u == (tg + 1u) * nx) xb_add(&bar[XB_TOPGEN], 1u);
            else XB_SPIN(xb_ld(&bar[XB_TOPGEN]) == tg, bar);
            __builtin_amdgcn_fence(__ATOMIC_ACQUIRE, "agent");
            xb_add(&bar[XB_XGEN(b.x)], 1u);
            asm volatile("s_waitcnt vmcnt(0)" ::: "memory");
        } else {
            XB_SPIN(xb_ld(&bar[XB_XGEN(b.x)]) == gen, bar);
            __builtin_amdgcn_fence(__ATOMIC_ACQUIRE, "agent");
            asm volatile("s_waitcnt vmcnt(0)" ::: "memory");
        }
    }
    __syncthreads();
}

__global__ void __launch_bounds__(NWAVES * 64, 2) mega(Params p) {
  extern __shared__ __attribute__((aligned(16))) unsigned char lds_raw[];
  LAS unsigned char* lds = (LAS unsigned char*)lds_raw;
  volatile LAS unsigned* MISC = (volatile LAS unsigned*)(lds + MISC_OFF);
  if (threadIdx.x < 16) MISC[threadIdx.x] = 0u;
  __syncthreads();
  XcdBarrier bar = xcd_barrier_post((unsigned*)(p.ws + WS_CTL), MISC + 8);
  unsigned char* ws = p.ws;
  float* MOD = (float*)(ws + WS_MOD);
  bf16_t* H0 = (bf16_t*)p.out; float* X1 = p.out;
  const int lo = p.ph_lo, hi = p.ph_hi;
#define IN(k) (lo <= (k) && (k) < hi)
#define SEAM(k) do { if ((k) + 1 < hi) xcd_barrier(bar); } while (0)
#define PH(k, ...) if (IN(k)) { if ((PROBE_MASK >> (k)) & 1u) { const bool wr = (p.rep < 0); (void)wr; __VA_ARGS__; xcd_barrier(bar); } { const bool wr = true; (void)wr; __VA_ARGS__; } SEAM(k); }
  PH(0, prologue_phase(p, lds))
  PH(1, prep_phase(p.in[0], p.in[2], p.in[4], MOD, H0))
  PH(2, {
    pg8::Gemm g{H0, (const bf16_t*)(ws + WS_W1T), MA, E_INP, D}; pg8::StaticOrder S; S.init(MA, E_INP, gridDim.x, (int)blockIdx.x);
    pg8::EpiProj0 E{(bf16_t*)(ws + WS_Y0), (bf16_t*)(ws + WS_XBC), (bf16_t*)(ws + WS_Q0), (bf16_t*)(ws + WS_K0), (bf16_t*)(ws + WS_V0), (float*)(ws + WS_DTLR)};
    pg8::gemm_phase<pg8::EpiProj0, pg8::StaticOrder, true, true>(lds, g, S, E); })
  PH(3, ssd_prep_phase((const bf16_t*)(ws + WS_XBC), p.in[8], p.in[9], (bf16_t*)p.out, (const float*)(ws + WS_DTLR), p.in[10], p.in[11], (float*)((char*)p.out + DO_SDT), (float*)((char*)p.out + DO_SCS), (float*)(ws + WS_SDEC)))
  PH(4, { ssd_u_phase((const bf16_t*)p.out, (const float*)((char*)p.out + DO_SDT), (const float*)((char*)p.out + DO_SCS), (bf16_t*)(ws + WS_STATE), lds);
    { const int nbusy = (NCH * 4) % (int)gridDim.x, nfree = (int)gridDim.x - nbusy;
      const int vb_ = virt_block(); if (vb_ >= nbusy || nfree <= 0) { __syncthreads(); late_weights(p, lds, nfree > 0 ? vb_ - nbusy : vb_, nfree > 0 ? nfree : (int)gridDim.x); } } })
  PH(5, ssd_scan_phase((bf16_t*)(ws + WS_STATE), (const float*)(ws + WS_SDEC), wr))
  PH(6, { ssd_y_phase((const bf16_t*)p.out, (const float*)((char*)p.out + DO_SDT), (const float*)((char*)p.out + DO_SCS), (const bf16_t*)(ws + WS_STATE), p.in[12], (bf16_t*)(ws + WS_Y0), (float*)(ws + WS_SSQ), lds, wr);
    if (wr) gla_cs_phase((const float*)(ws + WS_DTLR), p.in[14], p.in[15], (h16_t*)ws, (h16_t*)p.out, (float*)(ws + WS_GDEC), lds, (unsigned*)(ws + WS_CTL) + CW_CSQ); })
  PH(8, gla_u_phase((const bf16_t*)(ws + WS_K0), (const bf16_t*)(ws + WS_V0), (const h16_t*)ws, (const h16_t*)p.out, (bf16_t*)(ws + WS_STATE), lds))
  PH(9, gla_scan_phase((bf16_t*)(ws + WS_STATE), (const float*)(ws + WS_GDEC), wr))
  PH(10, gla_o_phase((const bf16_t*)(ws + WS_Q0), (const bf16_t*)(ws + WS_K0), (const bf16_t*)(ws + WS_V0), (const h16_t*)ws, (const h16_t*)p.out, (const bf16_t*)(ws + WS_STATE), p.in[16], (const float*)(ws + WS_SSQ), p.in[13], (bf16_t*)(ws + WS_Y0), lds, wr))
  PH(11, {
    pg8::Gemm g{(const bf16_t*)(ws + WS_Y0), (const bf16_t*)(ws + WS_W2T), ML, D, 2048}; pg8::StaticOrder S; S.init(ML, D, gridDim.x, (int)blockIdx.x);
    pg8::EpiResid E{p.in[0], X1, MOD, true};
    pg8::gemm_phase<pg8::EpiResid, pg8::StaticOrder, true, true>(lds, g, S, E);
    const float* ctx = p.in[2]; float* XC1 = (float*)(ws + WS_XC1); const float* gate = MOD + 2 * 3072 + 2048;
    small_gemm((const bf16_t*)(ws + WS_Y0) + (size_t)ML * 2048, 2048, (const bf16_t*)(ws + WS_W2T), 2048, 2048, MC, D,
               [=](int m, int n, float v) { XC1[(size_t)m * D + n] = ctx[(size_t)m * D + n] + gate[n] * v; }); })
  PH(12, prep_phase(X1, (const float*)(ws + WS_XC1), p.in[18], MOD + 3 * 3072, (bf16_t*)(ws + WS_H1)))
  PH(13, {
    pg8::Gemm g{(const bf16_t*)(ws + WS_H1), (const bf16_t*)(ws + WS_W3T), ML, O_IN, D}; pg8::StaticOrder S; S.init(ML, O_IN, gridDim.x, (int)blockIdx.x);
    pg8::EpiProj1 E{(bf16_t*)(ws + WS_K1), (bf16_t*)(ws + WS_V1), (bf16_t*)(ws + WS_Q1), (bf16_t*)(ws + WS_G1)};
    pg8::gemm_phase<pg8::EpiProj1, pg8::StaticOrder, true, true>(lds, g, S, E);
    bf16_t* K1 = (bf16_t*)(ws + WS_K1); bf16_t* V1 = (bf16_t*)(ws + WS_V1);
    small_gemm((const bf16_t*)(ws + WS_H1) + (size_t)ML * D, D, (const bf16_t*)(ws + WS_W3T), D, D, MC, 1024,
               [=](int m, int n, float v) { if (n < 512) K1[(size_t)(ML + m) * 512 + n] = f2bf(v); else V1[(size_t)(ML + m) * 512 + (n - 512)] = f2bf(v); }); })
  PH(14, qknorm_phase((bf16_t*)(ws + WS_Q1), (bf16_t*)(ws + WS_K1), p.in[22], p.in[23], (const float*)(ws + WS_ROPE), wr))
  PH(15, attn_phase((bf16_t*)(ws + WS_Q1), (const bf16_t*)(ws + WS_K1), (const bf16_t*)(ws + WS_V1), (const bf16_t*)(ws + WS_G1), p.in[24], p.in[22], p.in[23], lds, wr))
  PH(16, {
    pg8::Gemm g{(const bf16_t*)(ws + WS_Q1), (const bf16_t*)(ws + WS_W4T), ML, D, 2048}; pg8::StaticOrder S; S.init(ML, D, gridDim.x, (int)blockIdx.x);
    pg8::EpiResid E{X1, p.out, MOD + 3 * 3072, wr};
    pg8::gemm_phase<pg8::EpiResid, pg8::StaticOrder, true, true>(lds, g, S, E); })
#undef PH
#undef IN
#undef SEAM
}
extern "C" void kernel_launch(void* const* d_in, const int* in_sizes, int n_in, void* d_out, int out_size, void* d_ws, size_t ws_size, hipStream_t stream) {
  static int grid_blocks = 0;
  if (!grid_blocks) {
    int dev = 0, cus = 0, per_cu = 0;
    hipGetDevice(&dev);
    hipDeviceGetAttribute(&cus, hipDeviceAttributeMultiprocessorCount, dev);
    hipFuncSetAttribute((const void*)mega, hipFuncAttributeMaxDynamicSharedMemorySize, LDS_BYTES);
    hipOccupancyMaxActiveBlocksPerMultiprocessor(&per_cu, (const void*)mega, NWAVES * 64, LDS_BYTES);
    if (per_cu < 1) { fprintf(stderr, "kernel_launch: occupancy query says %d blocks per CU\n", per_cu); per_cu = 1; }
    if (per_cu > 1) per_cu = 1;
    grid_blocks = cus * per_cu;
  }
  hipMemsetAsync((char*)d_ws + WS_CTL, 0, 64 * 1024, stream);
  Params base{};
  for (int i = 0; i < 26; ++i) base.in[i] = (const float*)d_in[i];
  base.out = (float*)d_out; base.ws = (unsigned char*)d_ws;
  auto launch = [&](int lo, int hi) {
    Params p = base; p.ph_lo = lo; p.ph_hi = hi; p.rep = (int)PROBE_MASK; void* args[] = {&p};
    hipError_t e = hipLaunchCooperativeKernel((const void*)mega, dim3(grid_blocks), dim3(NWAVES * 64), args, LDS_BYTES, stream);
    if (e != hipSuccess) fprintf(stderr, "cooperative launch failed: %s (grid %d)\n", hipGetErrorString(e), grid_blocks);
  };
  launch(0, 17);
}
```

```cpp
#include <hip/hip_runtime.h>
#include <hip/hip_cooperative_groups.h>
#include <stdint.h>
#include <math.h>
#include <cstdio>
namespace cg = cooperative_groups;
#ifndef PROBE_SKIP
#define PROBE_SKIP 0
#endif
#ifndef PROBE_MASK
#define PROBE_MASK 0u
#endif

typedef unsigned short bf16_t;
#define DEV __device__ __forceinline__

DEV float bf2f(bf16_t v) { return __uint_as_float(((unsigned)v) << 16); }
typedef float f32x2_t __attribute__((ext_vector_type(2))); typedef __bf16 bf16x2_t __attribute__((ext_vector_type(2)));
DEV unsigned pk2(float lo, float hi) { const f32x2_t v = {lo, hi}; const bf16x2_t b = __builtin_convertvector(v, bf16x2_t); return __builtin_bit_cast(unsigned, b); }
DEV bf16_t f2bf(float f) { return (bf16_t)(pk2(f, 0.f) & 0xffffu); }
DEV float fexp(float x) { return __builtin_amdgcn_exp2f(x * 1.4426950408889634f); }
DEV float siluf(float x) { return x / (1.f + fexp(-x)); }
DEV float silu_fast(float x) { return x * __builtin_amdgcn_rcpf(1.f + fexp(-x)); }
DEV float softplusf(float x) { return x > 20.f ? x : log1pf(fexp(x)); }
DEV float logsigmoidf(float x) { return fminf(x, 0.f) - log1pf(fexp(-fabsf(x))); }

constexpr int D = 1024, NB = 2, SEQ = 8192, CTXL = 256;
constexpr int ML = NB * SEQ;
constexpr int MC = NB * CTXL;
constexpr int MA = ML + MC;
constexpr int NCH = MA / 128;
constexpr int E_IN = 5696, O_IN = 5120, E_INP = 5888;
constexpr float EPS = 1e-6f;

constexpr size_t MiB = 1u << 20;
constexpr int CW_CSQ = 8192;
constexpr size_t WS_CTL = 0;
constexpr size_t WS_MOD = 1 * MiB;
constexpr size_t WS_ROPE = 1 * MiB + 128 * 1024;
constexpr size_t WS_SDEC = 1 * MiB + 256 * 1024;
constexpr size_t WS_GDEC = 1 * MiB + 384 * 1024;
constexpr size_t WS_W1T = 2 * MiB;
constexpr size_t WS_W2T = 14 * MiB;
constexpr size_t WS_W3T = 18 * MiB;
constexpr size_t WS_W4T = 28 * MiB;
constexpr size_t WS_Y0 = 32 * MiB;
constexpr size_t WS_Q0 = 98 * MiB;
constexpr size_t WS_K0 = WS_Q0 + 16 * MiB + 512 * 1024;
constexpr size_t WS_V0 = 131 * MiB;
constexpr size_t WS_DTLR = 164 * MiB;
constexpr size_t WS_XC1 = 168 * MiB + 512 * 1024;
constexpr size_t WS_XBC = 171 * MiB;
constexpr size_t WS_STATE = 171 * MiB;
constexpr size_t WS_TAIL = 237 * MiB;
constexpr size_t WS_H1 = 32 * MiB;
constexpr size_t WS_K1 = 65 * MiB;
constexpr size_t WS_V1 = 81 * MiB + 512 * 1024;
constexpr size_t WS_Q1 = 98 * MiB;
constexpr size_t WS_G1 = 171 * MiB;

DEV int row_vec(int row) { return row < ML ? (row / SEQ) : 2; }

namespace pg8 {
#define PG8_LAS __attribute__((address_space(3)))
typedef unsigned short bf16_t;
typedef short bf16x8 __attribute__((ext_vector_type(8)));
typedef float f32x4 __attribute__((ext_vector_type(4)));
typedef unsigned u32x4 __attribute__((ext_vector_type(4)));
constexpr int BM = 256, BK = 64, HALF = 128, HTB = HALF * BK * 2  , STAGE_BYTES = 8 * HTB, NXCD = 8, WGM = 8;

__host__ __device__ __forceinline__ int lds_byte(int r, int c) { const int st = (r >> 4) * 2 + (c >> 5), rr = r & 15, cc = c & 31, ob = rr * 64 + cc * 2; return st * 1024 + (ob ^ (((ob >> 9) & 1) << 5)); }
__host__ __device__ __forceinline__ void stage_rc(int b, int& R, int& C) { const int st = b / 1024, sb = b % 1024, swz = sb ^ (((sb >> 9) & 1) << 5); R = (st >> 1) * 16 + swz / 64; C = (st & 1) * 32 + (swz % 64) / 2; }
__host__ __device__ __forceinline__ int perm32(int rho) { const int n = rho >> 4, i = rho & 15; return 8 * (i >> 2) + 4 * n + (i & 3); }

struct Unit { int pm, pn; };
struct Gemm { const bf16_t* A; const bf16_t* Bt; int M, N, K; };

struct StaticOrder {
    int nM, nN, nwg, G, c;
    __host__ __device__ void init(int M, int N, int G_, int c_) { nM = M / BM; nN = N / BM; nwg = nM * nN; G = G_; c = c_; }
    __host__ __device__ bool next(int i, Unit& u) const {
        const long L = (long)i * G + c; if (L >= nwg) return false;
        int wgid = (int)L; { const int q = nwg / NXCD, r = nwg % NXCD, xcd = wgid % NXCD, off = wgid / NXCD; wgid = (xcd < r ? xcd * (q + 1) : r * (q + 1) + (xcd - r) * q) + off; }
        const int nig = WGM * nN, gid = wgid / nig, fm = gid * WGM, gsz = (nM - fm) < WGM ? (nM - fm) : WGM;
        u.pm = fm + ((wgid % nig) % gsz); u.pn = (wgid % nig) / gsz; return true;
    }
    __device__ __forceinline__ void a_ready(const Unit&) const {}
    __device__ __forceinline__ void done(const Unit&) const {}
};
__device__ __forceinline__ unsigned cvt_pk_bf16(float lo, float hi) { unsigned r; asm volatile("v_cvt_pk_bf16_f32 %0, %1, %2" : "=v"(r) : "v"(lo), "v"(hi)); return r; }
__device__ __forceinline__ float silu_e(float x) { return x * __builtin_amdgcn_rcpf(1.f + fexp(-x)); }

__device__ __forceinline__ void store_unit_bf16(const f32x4 (&acc)[2][2][4][2], bf16_t* base, int ld, int colt, bool act, const Unit& u, int wr, int wc, int fr, int fq) {
    const int row0 = u.pm * BM + wr * 64 + fr; const int col0 = colt + wc * 32 + 8 * fq;
#pragma unroll
    for (int ai = 0; ai < 2; ++ai)
#pragma unroll
        for (int m = 0; m < 4; ++m) { bf16_t* rowp = base + (size_t)(row0 + ai * HALF + m * 16) * ld + col0;
#pragma unroll
            for (int bj = 0; bj < 2; ++bj) { f32x4 v0 = acc[ai][bj][m][0], v1 = acc[ai][bj][m][1];
                if (act) { v0 = (f32x4){silu_e(v0[0]), silu_e(v0[1]), silu_e(v0[2]), silu_e(v0[3])}; v1 = (f32x4){silu_e(v1[0]), silu_e(v1[1]), silu_e(v1[2]), silu_e(v1[3])}; }
                u32x4 w; w.x = cvt_pk_bf16(v0[0], v0[1]); w.y = cvt_pk_bf16(v0[2], v0[3]); w.z = cvt_pk_bf16(v1[0], v1[1]); w.w = cvt_pk_bf16(v1[2], v1[3]);
                *(u32x4*)(rowp + bj * HALF) = w; } }
}
struct EpiProj0 {
    static constexpr bool PERM = true, AFTER_DRAIN = false;
    bf16_t *Y0, *XBC, *Q0, *K0, *V0; float* DTLR;
    __device__ __forceinline__ void operator()(const f32x4 (&acc)[2][2][4][2], const Unit& u, int wr, int wc, int fr, int fq) const {
        const int pn = u.pn;
        if (pn == 22) {
            if (wc < 2) { const int row0 = u.pm * BM + wr * 64 + fr;
#pragma unroll
                for (int ai = 0; ai < 2; ++ai)
#pragma unroll
                    for (int m = 0; m < 4; ++m) { float* rp = DTLR + (size_t)(row0 + ai * HALF + m * 16) * 64 + wc * 32 + 8 * fq; *(f32x4*)rp = acc[ai][0][m][0]; *(f32x4*)(rp + 4) = acc[ai][0][m][1]; } }
            return;
        }
        bf16_t* base; int ld, colt; bool act = false;
        if (pn < 8) { base = Y0; ld = 2048; colt = pn * 256; act = true; }
        else if (pn < 14) { base = XBC; ld = 1536; colt = (pn - 8) * 256; }
        else if (pn < 16) { base = Q0; ld = 512; colt = (pn - 14) * 256; }
        else if (pn < 18) { base = K0; ld = 512; colt = (pn - 16) * 256; }
        else { base = V0; ld = 1024; colt = (pn - 18) * 256; }
        store_unit_bf16(acc, base, ld, colt, act, u, wr, wc, fr, fq);
    }
};
struct EpiProj1 {
    static constexpr bool PERM = true, AFTER_DRAIN = false;
    bf16_t *K1, *V1, *Q1, *G1; const float *qn, *kn, *rope; PG8_LAS float* part;
    __device__ __forceinline__ void operator()(const f32x4 (&acc)[2][2][4][2], const Unit& u, int wr, int wc, int fr, int fq) const {
        const int pn = u.pn; bf16_t* base; int ld, colt; bool act = false;
        if (pn < 2) { base = K1; ld = 512; colt = pn * 256; }
        else if (pn < 4) { base = V1; ld = 512; colt = (pn - 2) * 256; }
        else if (pn < 12) { base = Q1; ld = 2048; colt = (pn - 4) * 256; }
        else { base = G1; ld = 2048; colt = (pn - 12) * 256; act = true; }
        const bool isk = pn < 2, isq = pn >= 4 && pn < 12;
        if (!(isk || isq)) { store_unit_bf16(acc, base, ld, colt, act, u, wr, wc, fr, fq); return; }
#pragma unroll
        for (int ai = 0; ai < 2; ++ai)
#pragma unroll
            for (int m = 0; m < 4; ++m)
#pragma unroll
                for (int bj = 0; bj < 2; ++bj) { const f32x4 x0 = acc[ai][bj][m][0], x1 = acc[ai][bj][m][1];
                    float s = (x0[0] * x0[0] + x0[1] * x0[1]) + (x0[2] * x0[2] + x0[3] * x0[3]) + (x1[0] * x1[0] + x1[1] * x1[1]) + (x1[2] * x1[2] + x1[3] * x1[3]);
                    s += __shfl_xor(s, 16); s += __shfl_xor(s, 32);
                    if (fq == 0) part[(ai * HALF + wr * 64 + m * 16 + fr) * 8 + bj * 4 + wc] = s; }
        asm volatile("s_waitcnt lgkmcnt(0)" ::: "memory"); __builtin_amdgcn_s_barrier(); asm volatile("" ::: "memory");
        const int a = wc >> 1, f0 = 16 * (wc & 1) + 4 * fq;
        const float* gn = (isq ? qn : kn) + a * 64 + f0;
        const f32x4 g0 = *(const f32x4*)gn, g1 = *(const f32x4*)(gn + 32);
        const float osc = isq ? 0.08838834764831845f * 1.4426950408889634f : 1.f;
        const int col0 = colt + wc * 32 + 8 * fq;
#pragma unroll
        for (int ai = 0; ai < 2; ++ai)
#pragma unroll
            for (int m = 0; m < 4; ++m) { const int rowl = ai * HALF + wr * 64 + m * 16 + fr, row = u.pm * BM + rowl, t = row & 8191, pos = a ? (t & 63) : (t >> 6);
                const f32x4 cs = *(const f32x4*)(rope + pos * 32 + f0), sn = *(const f32x4*)(rope + 4096 + pos * 32 + f0);
                bf16_t* rowp = base + (size_t)row * ld + col0;
#pragma unroll
                for (int bj = 0; bj < 2; ++bj) { const f32x4 p4 = *(const PG8_LAS f32x4*)(part + rowl * 8 + bj * 4);
                    const float rstd = __builtin_amdgcn_rsqf(((p4[0] + p4[1]) + (p4[2] + p4[3])) * (1.f / 128.f) + 1e-6f) * osc;
                    const f32x4 t1 = acc[ai][bj][m][0] * g0 * rstd, t2 = acc[ai][bj][m][1] * g1 * rstd;
                    const f32x4 o1 = t1 * cs - t2 * sn, o2 = t2 * cs + t1 * sn;
                    u32x4 w; w.x = cvt_pk_bf16(o1[0], o1[1]); w.y = cvt_pk_bf16(o1[2], o1[3]); w.z = cvt_pk_bf16(o2[0], o2[1]); w.w = cvt_pk_bf16(o2[2], o2[3]);
                    *(u32x4*)(rowp + bj * HALF) = w; } }
    }
};
struct EpiResid {
    static constexpr bool PERM = false, AFTER_DRAIN = false;
    const float* res; float* out; const float* mod; bool do_store;
    __device__ __forceinline__ void operator()(const f32x4 (&acc)[2][2][4][2], const Unit& u, int wr, int wc, int fr, int fq) const {
        const int b = (u.pm * BM) / 8192; const float* gate = mod + b * 3072 + 2048;
        const int col0 = u.pn * BM + wc * 32 + 4 * fq;
        f32x4 gv[2][2];
#pragma unroll
        for (int bj = 0; bj < 2; ++bj)
#pragma unroll
            for (int n = 0; n < 2; ++n) gv[bj][n] = *(const f32x4*)(gate + col0 + bj * HALF + n * 16);
#pragma unroll
        for (int ai = 0; ai < 2; ++ai)
#pragma unroll
            for (int m = 0; m < 4; ++m) { const size_t off = (size_t)(u.pm * BM + ai * HALF + wr * 64 + m * 16 + fr) * 1024 + col0;
#pragma unroll
                for (int bj = 0; bj < 2; ++bj)
#pragma unroll
                    for (int n = 0; n < 2; ++n) { const f32x4 r = *(const f32x4*)(res + off + bj * HALF + n * 16); const f32x4 ov_ = r + gv[bj][n] * acc[ai][bj][m][n]; if (do_store) *(f32x4*)(out + off + bj * HALF + n * 16) = ov_; } }
    }
};
template <class Epi, class Sched, bool ALIGN_EPI = false, bool SP2 = false>
__device__ __forceinline__ void gemm_phase(PG8_LAS unsigned char* lds, const Gemm g, const Sched& S, const Epi& E) {
    const int tid = threadIdx.x, wid = __builtin_amdgcn_readfirstlane(tid >> 6), lane = tid & 63, wr = wid >> 2, wc = wid & 3, fr = lane & 15, fq = lane >> 4;
    const int K = g.K, nt = K / BK;
    unsigned voffA[2], voffB[2];
#pragma unroll
    for (int i = 0; i < 2; ++i) { int R, C; stage_rc(tid * 16 + i * 8192, R, C); const int Rb = Epi::PERM ? ((R & ~31) + perm32(R & 31)) : R;
        voffA[i] = (unsigned)(R * K + C) * 2u; voffB[i] = (unsigned)(Rb * K + C) * 2u; }
    const size_t kstep = (size_t)(BK * 2);
    const size_t hstep = (size_t)HALF * K * 2;
    const size_t tstep = 2 * hstep;
    const unsigned ldsw = (unsigned)wid * 1024u;
    const int aoff = lds_byte(wr * 64 + fr, fq * 8), boff = lds_byte(wc * 32 + fr, fq * 8);
#define PG8_SA(b, h) (((b) * 2 + (h)) * HTB)
#define PG8_SB(b, h) ((4 + (b) * 2 + (h)) * HTB)
#define PG8_STAGE(bufoff, gbase, voff) do { _Pragma("unroll") for (int _i = 0; _i < 2; ++_i) \
        __builtin_amdgcn_global_load_lds((const unsigned*)((const char*)(gbase) + (voff)[_i]), (PG8_LAS unsigned*)(lds + (bufoff) + ldsw + _i * 8192), 16, 0, 0); } while (0)
#define PG8_LDA(dst, b, h) do { _Pragma("unroll") for (int m = 0; m < 4; ++m) _Pragma("unroll") for (int k = 0; k < 2; ++k) dst[m][k] = *(const PG8_LAS bf16x8*)(lds + PG8_SA(b, h) + aoff + m * 2048 + k * 1024); } while (0)
#define PG8_LDB(dst, b, h) do { _Pragma("unroll") for (int n = 0; n < 2; ++n) _Pragma("unroll") for (int k = 0; k < 2; ++k) dst[n][k] = *(const PG8_LAS bf16x8*)(lds + PG8_SB(b, h) + boff + n * 2048 + k * 1024); } while (0)
#define PG8_MMA(ai, bj, At, Bt) do { __builtin_amdgcn_s_setprio(1); _Pragma("unroll") for (int m = 0; m < 4; ++m) _Pragma("unroll") for (int n = 0; n < 2; ++n) _Pragma("unroll") for (int k = 0; k < 2; ++k) \
        acc[ai][bj][m][n] = __builtin_amdgcn_mfma_f32_16x16x32_bf16(Bt[n][k], At[m][k], acc[ai][bj][m][n], 0, 0, 0); __builtin_amdgcn_s_setprio(0); } while (0)
#define PG8_WAIT_V(n) asm volatile("s_waitcnt vmcnt(" #n ")" ::: "memory")
#define PG8_WAIT_L(n) asm volatile("s_waitcnt lgkmcnt(" #n ")" ::: "memory")
#define PG8_BAR __builtin_amdgcn_s_barrier()
#define PG8_SCHED __builtin_amdgcn_sched_barrier(0)
    Unit cur, nxt; int ui = 0;
    if (!S.next(0, cur)) return;
    f32x4 acc[2][2][4][2];
#pragma unroll
    for (int a = 0; a < 2; ++a)
#pragma unroll
        for (int b = 0; b < 2; ++b)
#pragma unroll
            for (int m = 0; m < 4; ++m)
#pragma unroll
                for (int n = 0; n < 2; ++n) acc[a][b][m][n] = (f32x4){0.f, 0.f, 0.f, 0.f};
    bf16x8 At[4][2], B0[2][2], B1[2][2];
    const char* cA = (const char*)g.A + (size_t)cur.pm * tstep; const char* cB = (const char*)g.Bt + (size_t)cur.pn * tstep;
    S.a_ready(cur);
    if constexpr (SP2) {
        PG8_STAGE(PG8_SB(0, 0), cB, voffB); PG8_STAGE(PG8_SB(0, 1), cB + hstep, voffB); PG8_STAGE(PG8_SA(0, 0), cA, voffA); PG8_STAGE(PG8_SA(0, 1), cA + hstep, voffA);
        if (wr == 1) PG8_BAR;
        PG8_WAIT_V(2); PG8_BAR;
        PG8_STAGE(PG8_SB(1, 0), cB + kstep, voffB); PG8_STAGE(PG8_SA(1, 0), cA + kstep, voffA); PG8_STAGE(PG8_SB(1, 1), cB + hstep + kstep, voffB);
        PG8_WAIT_V(6); PG8_BAR;
    } else {
        PG8_STAGE(PG8_SB(0, 0), cB, voffB); PG8_STAGE(PG8_SA(0, 0), cA, voffA); PG8_STAGE(PG8_SB(0, 1), cB + hstep, voffB); PG8_STAGE(PG8_SA(0, 1), cA + hstep, voffA);
        if (wr == 1) PG8_BAR;
        PG8_WAIT_V(4); PG8_BAR;
        PG8_STAGE(PG8_SB(1, 0), cB + kstep, voffB); PG8_STAGE(PG8_SA(1, 0), cA + kstep, voffA); PG8_STAGE(PG8_SB(1, 1), cB + hstep + kstep, voffB);
        PG8_WAIT_V(6); PG8_BAR;
    }
    for (;;) {
        const bool has_next = S.next(ui + 1, nxt);
        const char* nA = has_next ? (const char*)g.A + (size_t)nxt.pm * tstep : cA; const char* nB = has_next ? (const char*)g.Bt + (size_t)nxt.pn * tstep : cB;
        for (int t = 0; t < nt; t += 2) {
            const bool last = (t == nt - 2);
            const char* a1 = cA + (size_t)(t + 1) * kstep;
            const char* a2 = last ? nA : cA + (size_t)(t + 2) * kstep; const char* b2 = last ? nB : cB + (size_t)(t + 2) * kstep;
            const char* a3 = a2 + kstep; const char* b3 = b2 + kstep;
            if (last && has_next) S.a_ready(nxt);
            if constexpr (SP2) {
            PG8_LDB(B0, 0, 0); PG8_LDB(B1, 0, 1); PG8_SCHED; PG8_LDA(At, 0, 0); PG8_STAGE(PG8_SA(1, 1), a1 + hstep, voffA);
            PG8_WAIT_V(8); PG8_WAIT_L(0); PG8_BAR; PG8_MMA(0, 0, At, B0); PG8_MMA(0, 1, At, B1); PG8_BAR; PG8_SCHED;
            PG8_LDA(At, 0, 1); PG8_STAGE(PG8_SB(0, 0), b2, voffB); PG8_STAGE(PG8_SB(0, 1), b2 + hstep, voffB); PG8_STAGE(PG8_SA(0, 0), a2, voffA);
            PG8_WAIT_V(8); PG8_WAIT_L(0); PG8_BAR; PG8_MMA(1, 0, At, B0); PG8_MMA(1, 1, At, B1); PG8_BAR; PG8_SCHED;
            PG8_LDB(B0, 1, 0); PG8_LDB(B1, 1, 1); PG8_SCHED; PG8_LDA(At, 1, 0); PG8_STAGE(PG8_SA(0, 1), a2 + hstep, voffA);
            PG8_WAIT_V(8); PG8_WAIT_L(0); PG8_BAR; PG8_MMA(0, 0, At, B0); PG8_MMA(0, 1, At, B1); PG8_BAR; PG8_SCHED;
            PG8_LDA(At, 1, 1); PG8_STAGE(PG8_SB(1, 0), b3, voffB); PG8_STAGE(PG8_SB(1, 1), b3 + hstep, voffB); PG8_STAGE(PG8_SA(1, 0), a3, voffA);
            PG8_WAIT_V(8); PG8_WAIT_L(0); PG8_BAR; PG8_MMA(1, 0, At, B0); PG8_MMA(1, 1, At, B1); PG8_BAR; PG8_SCHED;
            } else {
            PG8_LDB(B0, 0, 0); PG8_SCHED; PG8_LDA(At, 0, 0); PG8_STAGE(PG8_SA(1, 1), a1 + hstep, voffA);
            PG8_WAIT_L(8); PG8_BAR; PG8_WAIT_L(0); PG8_MMA(0, 0, At, B0); PG8_BAR; PG8_SCHED;
            PG8_LDB(B1, 0, 1); PG8_STAGE(PG8_SB(0, 0), b2, voffB);
            PG8_BAR; PG8_WAIT_L(0); PG8_MMA(0, 1, At, B1); PG8_BAR;
            PG8_LDA(At, 0, 1); PG8_STAGE(PG8_SA(0, 0), a2, voffA);
            PG8_BAR; PG8_WAIT_L(0); PG8_MMA(1, 0, At, B0); PG8_BAR; PG8_SCHED;
            PG8_STAGE(PG8_SB(0, 1), b2 + hstep, voffB);
            PG8_WAIT_V(6); PG8_BAR; PG8_MMA(1, 1, At, B1); PG8_BAR;
            PG8_LDB(B0, 1, 0); PG8_SCHED; PG8_LDA(At, 1, 0); PG8_STAGE(PG8_SA(0, 1), a2 + hstep, voffA);
            PG8_WAIT_L(8); PG8_BAR; PG8_WAIT_L(0); PG8_MMA(0, 0, At, B0); PG8_BAR; PG8_SCHED;
            PG8_LDB(B1, 1, 1); PG8_STAGE(PG8_SB(1, 0), b3, voffB);
            PG8_BAR; PG8_WAIT_L(0); PG8_MMA(0, 1, At, B1); PG8_BAR;
            PG8_LDA(At, 1, 1); PG8_STAGE(PG8_SA(1, 0), a3, voffA);
            PG8_BAR; PG8_WAIT_L(0); PG8_MMA(1, 0, At, B0); PG8_BAR; PG8_SCHED;
            PG8_STAGE(PG8_SB(1, 1), b3 + hstep, voffB);
            PG8_WAIT_V(6); PG8_BAR; PG8_MMA(1, 1, At, B1); PG8_BAR;
            }
        }
        if constexpr (ALIGN_EPI) { if (wr == 0) PG8_BAR; }
        if constexpr (!Epi::AFTER_DRAIN) { E(acc, cur, wr, wc, fr, fq); S.done(cur); }
        if (!has_next) break;
#pragma unroll
        for (int a = 0; a < 2; ++a)
#pragma unroll
            for (int b = 0; b < 2; ++b)
#pragma unroll
                for (int m = 0; m < 4; ++m)
#pragma unroll
                    for (int n = 0; n < 2; ++n) acc[a][b][m][n] = (f32x4){0.f, 0.f, 0.f, 0.f};
        cur = nxt; cA = nA; cB = nB; ++ui;
        if constexpr (ALIGN_EPI) { if (wr == 1) PG8_BAR; }
    }
    PG8_WAIT_V(0);
    if constexpr (!ALIGN_EPI) { if (wr == 0) PG8_BAR; }
    PG8_BAR;
    if constexpr (Epi::AFTER_DRAIN) { E.fused(acc, cur, wr, wc, fr, fq, lds, wid, lane); S.done(cur); }
#undef PG8_SA
#undef PG8_SB
#undef PG8_STAGE
#undef PG8_LDA
#undef PG8_LDB
#undef PG8_MMA
#undef PG8_WAIT_V
#undef PG8_WAIT_L
#undef PG8_BAR
#undef PG8_SCHED
}
}
#define LAS __attribute__((address_space(3)))
typedef unsigned v4u __attribute__((ext_vector_type(4)));
typedef float f32x4 __attribute__((ext_vector_type(4)));
typedef short bf16x8 __attribute__((ext_vector_type(8)));
#define LDS_WAIT() asm volatile("s_waitcnt lgkmcnt(0)" ::: "memory")
constexpr int NWAVES = 8;
constexpr int LDS_BYTES = 147456;
constexpr int MISC_OFF = 147456 - 128;

struct Params { const float* in[26]; float* out; unsigned char* ws; int ph_lo, ph_hi, rep, pad; };

DEV int virt_block() { const int G = (int)gridDim.x, b = (int)blockIdx.x; return (G % 8 == 0) ? (b % 8) * (G / 8) + b / 8 : b; }
DEV float wave_sum(float v) {
#pragma unroll
  for (int o = 1; o < 64; o <<= 1) v += __shfl_xor(v, o);
  return v;
}

DEV int w1_dest_row(int n) {
  if (n < 1024) return n;
  if (n < 2560) return 2048 + (n - 1024);
  if (n < 2592) return 5632 + (n - 2560);
  if (n < 3104) return 3584 + (n - 2592);
  if (n < 3616) return 4096 + (n - 3104);
  if (n < 4640) return 4608 + (n - 3616);
  if (n < 5664) return 1024 + (n - 4640);
  return n;
}
DEV int qk_pos(int d) { const int a = d >> 6, s = (d >> 5) & 1, f = d & 31; return 32 * (2 * a + (f >> 4)) + 8 * ((f >> 2) & 3) + 4 * s + (f & 3); }
DEV void transpose_item(const float* W, int K, int N, int k0, int n0, bf16_t* WT, int drow0, LAS float* scr, int lane, int headbase = -1) {
#pragma unroll 8
  for (int i = 0; i < 32; ++i) { const int kk = 2 * i + (lane >> 5); scr[kk * 33 + (lane & 31)] = W[(size_t)(k0 + kk) * N + n0 + (lane & 31)]; }
  LDS_WAIT(); asm volatile("" ::: "memory");
  const int c = lane & 7;
#pragma unroll
  for (int j = 0; j < 4; ++j) { const int n = (lane >> 3) + 8 * j; const LAS float* s = scr + (8 * c) * 33 + n;
    v4u o; o.x = pk2(s[0 * 33], s[1 * 33]); o.y = pk2(s[2 * 33], s[3 * 33]); o.z = pk2(s[4 * 33], s[5 * 33]); o.w = pk2(s[6 * 33], s[7 * 33]);
    const int drow = headbase >= 0 ? headbase + qk_pos((n0 & 127) + n) : drow0 + n;
    *(v4u*)(WT + (size_t)drow * K + k0 + 8 * c) = o; }
  LDS_WAIT(); asm volatile("" ::: "memory");
}
DEV void prologue_phase(const Params& p, LAS unsigned char* lds) {
  const int tid = threadIdx.x, lane = tid & 63, wave = tid >> 6;
  unsigned char* ws = p.ws;
  float* MOD = (float*)(ws + WS_MOD);
  {
    LAS float* sc = (LAS float*)lds;
    LAS float* part = (LAS float*)(lds + 12288);
    for (int i = tid; i < 3072; i += 512) { const int v = i >> 10, k = i & 1023; const float cv = v < 2 ? p.in[1][v * 1024 + k] : p.in[3][k]; sc[i] = siluf(cv); }
    __syncthreads();
    for (int task = blockIdx.x; task < 96; task += gridDim.x) {
      const int l = task / 48, n0 = (task % 48) * 64; const float* w = l ? p.in[19] : p.in[5]; const float* bb = l ? p.in[20] : p.in[6];
      const int col = tid & 63, ks = tid >> 6;
      float a0 = 0.f, a1 = 0.f, a2 = 0.f;
#pragma unroll 8
      for (int k = ks * 128; k < ks * 128 + 128; ++k) { const float wv = w[(size_t)k * 3072 + n0 + col]; a0 += sc[k] * wv; a1 += sc[1024 + k] * wv; a2 += sc[2048 + k] * wv; }
      part[(ks * 3 + 0) * 64 + col] = a0; part[(ks * 3 + 1) * 64 + col] = a1; part[(ks * 3 + 2) * 64 + col] = a2;
      __syncthreads();
      if (tid < 192) { const int v = tid >> 6; float s = bb[n0 + col];
#pragma unroll
        for (int q = 0; q < 8; ++q) s += part[(q * 3 + v) * 64 + col];
        MOD[(l * 3 + v) * 3072 + n0 + col] = s; }
      __syncthreads();
    }
  }
  if (blockIdx.x == gridDim.x - 1) { float* rope = (float*)(ws + WS_ROPE);
    for (int idx = tid; idx < 4096; idx += 512) { const int pos = idx >> 5, f = idx & 31; const float inv = 1.0f / powf(10000.f, (float)f / 32.f); const float ang = (float)pos * inv; rope[idx] = cosf(ang); rope[4096 + idx] = sinf(ang); } }
  { v4u* z = (v4u*)(ws + WS_W1T + (size_t)E_IN * 1024 * 2); const v4u zero = {0u, 0u, 0u, 0u};
    for (int i = blockIdx.x * 512 + tid; i < (E_INP - E_IN) * 1024 * 2 / 16; i += gridDim.x * 512) z[i] = zero; }
  __syncthreads();
  {
    LAS float* scr = (LAS float*)(lds + wave * 16384);
    const int gw = blockIdx.x * NWAVES + wave, NGW = gridDim.x * NWAVES;
    constexpr int I1 = 16 * 178;
    for (int it = gw; it < I1; it += NGW) { const int kb = it / 178, nb = it % 178; transpose_item(p.in[7], 1024, E_IN, 64 * kb, 32 * nb, (bf16_t*)(ws + WS_W1T), w1_dest_row(32 * nb), scr, lane); }
  }
}
DEV void late_weights(const Params& p, LAS unsigned char* lds, int vblock, int nvblocks) {
  const int lane = threadIdx.x & 63, wave = threadIdx.x >> 6; unsigned char* ws = p.ws;
  LAS float* scr = (LAS float*)(lds + wave * 16384);
  constexpr int I2 = 32 * 32, I3 = 16 * 160, I4 = 32 * 32;
  for (int it = vblock * NWAVES + wave; it < I2 + I3 + I4; it += nvblocks * NWAVES) {
    int r = it;
    if (r < I2) { const int kb = r / 32, nb = r % 32; transpose_item(p.in[17], 2048, 1024, 64 * kb, 32 * nb, (bf16_t*)(ws + WS_W2T), 32 * nb, scr, lane); continue; } r -= I2;
    if (r < I3) { const int kb = r / 160, nb = r % 160, n0 = 32 * nb; const bool qk = n0 < 512 || (n0 >= 1024 && n0 < 3072);
      transpose_item(p.in[21], 1024, O_IN, 64 * kb, n0, (bf16_t*)(ws + WS_W3T), n0, scr, lane, qk ? (n0 & ~127) : -1); continue; } r -= I3;
    { const int kb = r / 32, nb = r % 32; transpose_item(p.in[25], 2048, 1024, 64 * kb, 32 * nb, (bf16_t*)(ws + WS_W4T), 32 * nb, scr, lane); }
  }
}
DEV void prep_phase(const float* xlat, const float* xctx, const float* g, const float* mod, bf16_t* H) {
  const int lane = threadIdx.x & 63, wave = threadIdx.x >> 6;
  for (int row = blockIdx.x * NWAVES + wave; row < MA; row += gridDim.x * NWAVES) {
    const float* src = row < ML ? xlat + (size_t)row * D : xctx + (size_t)(row - ML) * D;
    const float* m = mod + row_vec(row) * 3072;
    f32x4 v[4]; float ss = 0.f;
#pragma unroll
    for (int j = 0; j < 4; ++j) { v[j] = *(const f32x4*)(src + 4 * lane + 256 * j); ss += (v[j].x * v[j].x + v[j].y * v[j].y) + (v[j].z * v[j].z + v[j].w * v[j].w); }
    const float rstd = rsqrtf(wave_sum(ss) * (1.f / D) + EPS);
#pragma unroll
    for (int j = 0; j < 4; ++j) { const int k = 4 * lane + 256 * j;
      const f32x4 gg = *(const f32x4*)(g + k), sc = *(const f32x4*)(m + 1024 + k), sh = *(const f32x4*)(m + k);
      const f32x4 o = v[j] * rstd * gg * (sc + 1.f) + sh;
      *(unsigned long long*)(H + (size_t)row * D + k) = (unsigned long long)pk2(o.x, o.y) | ((unsigned long long)pk2(o.z, o.w) << 32); }
  }
}
template <class F> DEV void small_gemm(const bf16_t* A, int lda, const bf16_t* Bt, int ldb, int K, int Mrows, int Ncols, F f) {
  const int lane = threadIdx.x & 63, wid = threadIdx.x >> 6, mt = wid >> 2, nt = wid & 3, r = lane & 15, q = lane >> 4;
  const int ntn = Ncols / 64, ntasks = (Mrows / 32) * ntn;
  for (int task = blockIdx.x; task < ntasks; task += gridDim.x) {
    const int row0 = (task / ntn) * 32 + mt * 16, col0 = (task % ntn) * 64 + nt * 16;
    const bf16_t* ap = A + (size_t)(row0 + r) * lda + 8 * q; const bf16_t* bp = Bt + (size_t)(col0 + r) * ldb + 8 * q;
    f32x4 acc = {0.f, 0.f, 0.f, 0.f};
#pragma unroll 8
    for (int k = 0; k < K; k += 32) { const bf16x8 a = *(const bf16x8*)(ap + k), b = *(const bf16x8*)(bp + k); acc = __builtin_amdgcn_mfma_f32_16x16x32_bf16(a, b, acc, 0, 0, 0); }
#pragma unroll
    for (int j = 0; j < 4; ++j) f(row0 + q * 4 + j, col0 + r, acc[j]);
  }
}

DEV void qknorm_phase(bf16_t* Q1, bf16_t* K1, const float* qn, const float* kn, const float* rope, bool wr) {
  const int lane = threadIdx.x & 63, wave = threadIdx.x >> 6, hl = lane >> 4, d0 = (lane & 15) * 8;
  const float scale = 0.08838834764831845f * 1.4426950408889634f;
  float gq[8], gk[8];
#pragma unroll
  for (int e = 0; e < 8; ++e) { gq[e] = qn[d0 + e] * scale; gk[e] = kn[d0 + e]; }
  const int ax = d0 >> 6, sgn = (d0 >> 5) & 1, f0 = d0 & 31;
  for (int row = blockIdx.x * NWAVES + wave; row < MA; row += gridDim.x * NWAVES) {
    const bool lat = row < ML;
    v4u raw[5];
    raw[0] = *(const v4u*)(K1 + (size_t)row * 512 + hl * 128 + d0);
    if (lat) {
#pragma unroll
      for (int g = 0; g < 4; ++g) raw[1 + g] = *(const v4u*)(Q1 + (size_t)row * 2048 + (g * 4 + hl) * 128 + d0);
    }
    float cs[8], sn[8];
    if (lat) { const int t = row % SEQ, pos = ax ? (t & 63) : (t >> 6);
      const f32x4 c0 = *(const f32x4*)(rope + pos * 32 + f0), c1 = *(const f32x4*)(rope + pos * 32 + f0 + 4), s0 = *(const f32x4*)(rope + 4096 + pos * 32 + f0), s1 = *(const f32x4*)(rope + 4096 + pos * 32 + f0 + 4);
      cs[0] = c0.x; cs[1] = c0.y; cs[2] = c0.z; cs[3] = c0.w; cs[4] = c1.x; cs[5] = c1.y; cs[6] = c1.z; cs[7] = c1.w;
      sn[0] = s0.x; sn[1] = s0.y; sn[2] = s0.z; sn[3] = s0.w; sn[4] = s1.x; sn[5] = s1.y; sn[6] = s1.z; sn[7] = s1.w; }
    const int ng = lat ? 5 : 1;
#pragma unroll
    for (int g = 0; g < 5; ++g) {
      if (g < ng) {
        const v4u rv = raw[g];
        float v[8] = {__uint_as_float(rv.x << 16), __uint_as_float(rv.x & 0xffff0000u), __uint_as_float(rv.y << 16), __uint_as_float(rv.y & 0xffff0000u), __uint_as_float(rv.z << 16), __uint_as_float(rv.z & 0xffff0000u), __uint_as_float(rv.w << 16), __uint_as_float(rv.w & 0xffff0000u)};
        float ss = 0.f;
#pragma unroll
        for (int e = 0; e < 8; ++e) ss += v[e] * v[e];
        ss += __shfl_xor(ss, 1); ss += __shfl_xor(ss, 2); ss += __shfl_xor(ss, 4); ss += __shfl_xor(ss, 8);
        const float rstd = rsqrtf(ss * (1.f / 128.f) + EPS);
#pragma unroll
        for (int e = 0; e < 8; ++e) v[e] *= rstd * (g == 0 ? gk[e] : gq[e]);
        if (lat) {
#pragma unroll
          for (int e = 0; e < 8; ++e) { const float o = __shfl_xor(v[e], 4); v[e] = sgn ? (v[e] * cs[e] + o * sn[e]) : (v[e] * cs[e] - o * sn[e]); }
        }
        v4u ov; ov.x = pk2(v[0], v[1]); ov.y = pk2(v[2], v[3]); ov.z = pk2(v[4], v[5]); ov.w = pk2(v[6], v[7]);
        if (wr) { if (g == 0) *(v4u*)(K1 + (size_t)row * 512 + hl * 128 + d0) = ov; else *(v4u*)(Q1 + (size_t)row * 2048 + ((g - 1) * 4 + hl) * 128 + d0) = ov; }
      }
    }
  }
}
typedef short s16x4 __attribute__((ext_vector_type(4)));
DEV s16x4 tr_read(const LAS bf16_t* p) { return __builtin_bit_cast(s16x4, __builtin_amdgcn_ds_read_tr16_b64_v4i16((LAS s16x4*)p)); }
DEV void attn_phase(bf16_t* Q1, const bf16_t* K1, const bf16_t* V1, const bf16_t* G1, const float* sink, const float* qn, const float* kn, LAS unsigned char* lds, bool wr) {
  constexpr int KP = 136, VP = 144;
  LAS bf16_t* Ks = (LAS bf16_t*)lds;
  LAS bf16_t* Vs = (LAS bf16_t*)(lds + 2 * 64 * KP * 2);
  LAS float* dsc = (LAS float*)(lds + 2 * 64 * KP * 2 + 2 * 64 * VP * 2);
  const int tid = threadIdx.x, lane = tid & 63, wid = tid >> 6, r = lane & 15, Qd = lane >> 4;
  float mb;
  { float a = fmaxf(fabsf(qn[lane]), fabsf(qn[64 + lane])), b = fmaxf(fabsf(kn[lane]), fabsf(kn[64 + lane]));
#pragma unroll
    for (int o = 1; o < 64; o <<= 1) { a = fmaxf(a, __shfl_xor(a, o)); b = fmaxf(b, __shfl_xor(b, o)); }
    mb = a * b * 11.313708498984761f * 1.4426950408889634f; }
  for (int task = virt_block(); task < 1024; task += gridDim.x) {
    const int b = task >> 9, kvh = (task >> 7) & 3, qt = task & 127;
    const int hq = kvh * 4 + (wid >> 1), qoff = (wid & 1) * 32;
    const size_t qrow0 = (size_t)b * SEQ + qt * 64 + qoff;
    bf16x8 qf[2][4];
#pragma unroll
    for (int m = 0; m < 2; ++m)
#pragma unroll
      for (int ks = 0; ks < 4; ++ks) qf[m][ks] = *(const bf16x8*)(Q1 + (qrow0 + 16 * m + r) * 2048 + hq * 128 + ks * 32 + 8 * Qd);
    const int tlo = (2 - qt) > 0 ? (2 - qt) : 0, thi = (129 - qt) < 4 ? (129 - qt) : 4, nband = thi - tlo + 1, ntile = nband + 4;
    const int skey = tid >> 4, sch = tid & 15;
    float gk[8];
    { const int dA = ((sch >> 2) >> 1) * 64 + 16 * ((sch >> 2) & 1) + 4 * (sch & 3); const f32x4 ga = *(const f32x4*)(kn + dA), gb_ = *(const f32x4*)(kn + dA + 32);
      gk[0] = ga.x; gk[1] = ga.y; gk[2] = ga.z; gk[3] = ga.w; gk[4] = gb_.x; gk[5] = gb_.y; gk[6] = gb_.z; gk[7] = gb_.w; }
    v4u kreg[2], vreg[2];
#define TILE_ROW0(i) ((i) < nband ? (size_t)b * SEQ + (size_t)(qt - 2 + tlo + (i)) * 64 : (size_t)ML + b * CTXL + ((i) - nband) * 64)
#define LOAD_TILE(i) do { const size_t r0_ = TILE_ROW0(i); _Pragma("unroll") for (int h_ = 0; h_ < 2; ++h_) { const size_t go_ = (r0_ + skey + 32 * h_) * 512 + kvh * 128 + sch * 8; kreg[h_] = *(const v4u*)(K1 + go_); vreg[h_] = *(const v4u*)(V1 + go_); } } while (0)
#define STORE_TILE(buf, ti) do { const bool ctx_ = (ti) >= nband; _Pragma("unroll") for (int h_ = 0; h_ < 2; ++h_) { v4u kw_ = kreg[h_]; \
      if (ctx_) { float v_[8] = {__uint_as_float(kw_.x << 16), __uint_as_float(kw_.x & 0xffff0000u), __uint_as_float(kw_.y << 16), __uint_as_float(kw_.y & 0xffff0000u), __uint_as_float(kw_.z << 16), __uint_as_float(kw_.z & 0xffff0000u), __uint_as_float(kw_.w << 16), __uint_as_float(kw_.w & 0xffff0000u)}; \
        float ss_ = 0.f; _Pragma("unroll") for (int e_ = 0; e_ < 8; ++e_) ss_ += v_[e_] * v_[e_]; \
        ss_ += __shfl_xor(ss_, 1); ss_ += __shfl_xor(ss_, 2); ss_ += __shfl_xor(ss_, 4); ss_ += __shfl_xor(ss_, 8); \
        const float rs_ = rsqrtf(ss_ * (1.f / 128.f) + EPS); _Pragma("unroll") for (int e_ = 0; e_ < 8; ++e_) v_[e_] *= rs_ * gk[e_]; \
        kw_.x = pk2(v_[0], v_[1]); kw_.y = pk2(v_[2], v_[3]); kw_.z = pk2(v_[4], v_[5]); kw_.w = pk2(v_[6], v_[7]); } \
      *(LAS v4u*)(Ks + (buf) * 64 * KP + (skey + 32 * h_) * KP + sch * 8) = kw_; *(LAS v4u*)(Vs + (buf) * 64 * VP + (skey + 32 * h_) * VP + sch * 8) = vreg[h_]; } } while (0)
    LOAD_TILE(0);
    __syncthreads();
    STORE_TILE(0, 0);
    __syncthreads();
    f32x4 o[2][8];
#pragma unroll
    for (int m = 0; m < 2; ++m)
#pragma unroll
      for (int n = 0; n < 8; ++n) o[m][n] = (f32x4){0.f, 0.f, 0.f, 0.f};
    float lsum[2] = {0.f, 0.f};
    for (int i = 0; i < ntile; ++i) {
      const int buf = i & 1;
      if (i + 1 < ntile) LOAD_TILE(i + 1);
      const int mtype = (i < nband) ? ((tlo + i) == 0 ? 1 : ((tlo + i) == 4 ? 2 : 0)) : 0;
      const LAS bf16_t* Kb = Ks + buf * 64 * KP; const LAS bf16_t* Vb = Vs + buf * 64 * VP;
      f32x4 s[4][2];
#pragma unroll
      for (int t = 0; t < 4; ++t) { s[t][0] = (f32x4){-mb, -mb, -mb, -mb}; s[t][1] = (f32x4){-mb, -mb, -mb, -mb}; }
#pragma unroll
      for (int ks = 0; ks < 4; ++ks)
#pragma unroll
        for (int t = 0; t < 4; ++t) { const bf16x8 kf = *(const LAS bf16x8*)(Kb + (16 * t + r) * KP + ks * 32 + 8 * Qd);
          s[t][0] = __builtin_amdgcn_mfma_f32_16x16x32_bf16(kf, qf[0][ks], s[t][0], 0, 0, 0);
          s[t][1] = __builtin_amdgcn_mfma_f32_16x16x32_bf16(kf, qf[1][ks], s[t][1], 0, 0, 0); }
      bf16x8 pa[2][2];
#pragma unroll
      for (int m = 0; m < 2; ++m) { const int qi = qoff + 16 * m + r;
#pragma unroll
        for (int t = 0; t < 4; ++t) {
          float pv[4];
#pragma unroll
          for (int j = 0; j < 4; ++j) { const int kj = 16 * t + 4 * Qd + j; float pj = __builtin_amdgcn_exp2f(s[t][m][j]);
            if (mtype != 0) { if (mtype == 1) pj = (kj >= qi) ? pj : 0.f; else pj = (kj <= qi) ? pj : 0.f; }
            pv[j] = pj; lsum[m] += pj; }
          const unsigned w0 = pk2(pv[0], pv[1]), w1 = pk2(pv[2], pv[3]);
          pa[m][t >> 1][(t & 1) * 4 + 0] = (short)(w0 & 0xffff); pa[m][t >> 1][(t & 1) * 4 + 1] = (short)(w0 >> 16);
          pa[m][t >> 1][(t & 1) * 4 + 2] = (short)(w1 & 0xffff); pa[m][t >> 1][(t & 1) * 4 + 3] = (short)(w1 >> 16); } }
#pragma unroll
      for (int k2 = 0; k2 < 2; ++k2)
#pragma unroll
        for (int n = 0; n < 8; ++n) {
          const s16x4 lo = tr_read(Vb + (32 * k2 + 4 * Qd + (r >> 2)) * VP + 16 * n + 4 * (r & 3));
          const s16x4 hi = tr_read(Vb + (32 * k2 + 16 + 4 * Qd + (r >> 2)) * VP + 16 * n + 4 * (r & 3));
          const bf16x8 vf = (bf16x8){lo[0], lo[1], lo[2], lo[3], hi[0], hi[1], hi[2], hi[3]};
          o[0][n] = __builtin_amdgcn_mfma_f32_16x16x32_bf16(pa[0][k2], vf, o[0][n], 0, 0, 0);
          o[1][n] = __builtin_amdgcn_mfma_f32_16x16x32_bf16(pa[1][k2], vf, o[1][n], 0, 0, 0); }
      if (i + 1 < ntile) STORE_TILE(buf ^ 1, i + 1);
      __syncthreads();
    }
#undef TILE_ROW0
#undef LOAD_TILE
#undef STORE_TILE
    const float sk = __builtin_amdgcn_exp2f(sink[hq] * 1.4426950408889634f - mb);
#pragma unroll
    for (int m = 0; m < 2; ++m) { float l = lsum[m]; l += __shfl_xor(l, 16); l += __shfl_xor(l, 32); if (Qd == 0) dsc[wid * 32 + 16 * m + r] = 1.f / (l + sk); }
    LDS_WAIT(); asm volatile("" ::: "memory");
    { LAS bf16_t* stg = (LAS bf16_t*)lds + wid * 32 * 136;
#pragma unroll
      for (int m = 0; m < 2; ++m)
#pragma unroll
        for (int j = 0; j < 4; ++j) { const float inv = dsc[wid * 32 + 16 * m + 4 * Qd + j];
#pragma unroll
          for (int n = 0; n < 8; ++n) stg[(16 * m + 4 * Qd + j) * 136 + 16 * n + r] = f2bf(o[m][n][j] * inv); }
      LDS_WAIT(); asm volatile("" ::: "memory");
#pragma unroll
      for (int q = 0; q < 8; ++q) { const int c = lane + 64 * q, rowl = c >> 4, ch = c & 15; const size_t go = (qrow0 + rowl) * 2048 + hq * 128 + ch * 8;
        const v4u ov = *(const LAS v4u*)(stg + rowl * 136 + ch * 8), gv = *(const v4u*)(G1 + go);
        v4u w; w.x = pk2(__uint_as_float(ov.x << 16) * __uint_as_float(gv.x << 16), __uint_as_float(ov.x & 0xffff0000u) * __uint_as_float(gv.x & 0xffff0000u));
        w.y = pk2(__uint_as_float(ov.y << 16) * __uint_as_float(gv.y << 16), __uint_as_float(ov.y & 0xffff0000u) * __uint_as_float(gv.y & 0xffff0000u));
        w.z = pk2(__uint_as_float(ov.z << 16) * __uint_as_float(gv.z << 16), __uint_as_float(ov.z & 0xffff0000u) * __uint_as_float(gv.z & 0xffff0000u));
        w.w = pk2(__uint_as_float(ov.w << 16) * __uint_as_float(gv.w << 16), __uint_as_float(ov.w & 0xffff0000u) * __uint_as_float(gv.w & 0xffff0000u));
        if (wr) *(v4u*)(Q1 + go) = w; }
      LDS_WAIT(); asm volatile("" ::: "memory"); }
  }
}

constexpr size_t DO_SDT = 50 * MiB, DO_SCS = 53 * MiB;
constexpr size_t WS_SSQ = 237 * MiB;
DEV unsigned short bfbits(float f) { return f2bf(f); }
DEV void ssd_prep_phase(const bf16_t* XBC, const float* cw, const float* cb, bf16_t* XC, const float* DTLR, const float* dt_bias, const float* a_log, float* SDT, float* SCS, float* SDEC) {
  const int gtid = blockIdx.x * 512 + threadIdx.x, gth = gridDim.x * 512;
  for (int it = gtid; it < (MA / 32) * 192; it += gth) {
    const int rg = it / 192, c8 = (it % 192) * 8, row0 = rg * 32;
    int t0, len;
    if (row0 < ML) { t0 = row0 % SEQ; len = SEQ; } else { t0 = (row0 - ML) % CTXL; len = CTXL; }
    float w[5][8], bias[8];
#pragma unroll
    for (int k = 0; k < 5; ++k) { const f32x4 w0 = *(const f32x4*)(cw + k * 1536 + c8), w1 = *(const f32x4*)(cw + k * 1536 + c8 + 4);
      w[k][0] = w0.x; w[k][1] = w0.y; w[k][2] = w0.z; w[k][3] = w0.w; w[k][4] = w1.x; w[k][5] = w1.y; w[k][6] = w1.z; w[k][7] = w1.w; }
    { const f32x4 b0 = *(const f32x4*)(cb + c8), b1 = *(const f32x4*)(cb + c8 + 4); bias[0] = b0.x; bias[1] = b0.y; bias[2] = b0.z; bias[3] = b0.w; bias[4] = b1.x; bias[5] = b1.y; bias[6] = b1.z; bias[7] = b1.w; }
    const v4u zero4 = {0u, 0u, 0u, 0u};
    v4u win[4];
#pragma unroll
    for (int q = 0; q < 4; ++q) { const int tt = t0 - 2 + q; win[q] = (tt >= 0 && tt < len) ? *(const v4u*)(XBC + (size_t)(row0 - 2 + q) * 1536 + c8) : zero4; }
#pragma unroll 4
    for (int i = 0; i < 32; ++i) {
      const int tt = t0 + i + 2; const v4u nx = (tt < len) ? *(const v4u*)(XBC + (size_t)(row0 + i + 2) * 1536 + c8) : zero4;
      float acc[8];
#pragma unroll
      for (int e = 0; e < 8; ++e) acc[e] = bias[e];
#define CONV_TAP(k, xv) do { acc[0] += w[k][0] * __uint_as_float((xv).x << 16); acc[1] += w[k][1] * __uint_as_float((xv).x & 0xffff0000u); acc[2] += w[k][2] * __uint_as_float((xv).y << 16); acc[3] += w[k][3] * __uint_as_float((xv).y & 0xffff0000u); \
        acc[4] += w[k][4] * __uint_as_float((xv).z << 16); acc[5] += w[k][5] * __uint_as_float((xv).z & 0xffff0000u); acc[6] += w[k][6] * __uint_as_float((xv).w << 16); acc[7] += w[k][7] * __uint_as_float((xv).w & 0xffff0000u); } while (0)
      CONV_TAP(0, win[0]); CONV_TAP(1, win[1]); CONV_TAP(2, win[2]); CONV_TAP(3, win[3]); CONV_TAP(4, nx);
#undef CONV_TAP
      v4u o; o.x = pk2(silu_fast(acc[0]), silu_fast(acc[1])); o.y = pk2(silu_fast(acc[2]), silu_fast(acc[3])); o.z = pk2(silu_fast(acc[4]), silu_fast(acc[5])); o.w = pk2(silu_fast(acc[6]), silu_fast(acc[7]));
      *(v4u*)(XC + (size_t)(row0 + i) * 1536 + c8) = o;
      win[0] = win[1]; win[1] = win[2]; win[2] = win[3]; win[3] = nx;
    }
  }
  {
    const int lane = threadIdx.x & 63, wave = threadIdx.x >> 6, cl = lane & 7, seg = lane >> 3;
    for (int wt = blockIdx.x * NWAVES + wave; wt < NCH * 4; wt += gridDim.x * NWAVES) {
      const int gc = wt >> 2, col = (wt & 3) * 8 + cl, dir = col >> 4, h = col & 15;
      const float a = -fexp(a_log[col]), bias = dt_bias[col];
      float dtv[16], v[16]; float run = 0.f;
#pragma unroll
      for (int u = 0; u < 16; ++u) { const int s = seg * 16 + u, t = dir ? 127 - s : s; dtv[u] = softplusf(DTLR[((size_t)gc * 128 + t) * 64 + col] + bias); }
#pragma unroll
      for (int u = 0; u < 16; ++u) { run += dtv[u] * a; v[u] = run; }
      float off = 0.f;
#pragma unroll
      for (int sgi = 0; sgi < 7; ++sgi) { const float tot = __shfl(run, cl + 8 * sgi); off += (sgi < seg) ? tot : 0.f; }
#pragma unroll
      for (int u = 0; u < 16; ++u) { const int s = seg * 16 + u, t = dir ? 127 - s : s; const size_t row = (size_t)gc * 128 + t; SDT[row * 32 + col] = dtv[u]; SCS[row * 32 + col] = v[u] + off; }
      if (seg == 7) SDEC[(gc * 16 + h) * 2 + dir] = fexp(run + off);
    }
  }
}
DEV void ssd_u_phase(const bf16_t* XC, const float* SDT, const float* SCS, bf16_t* ST, LAS unsigned char* lds) {
  constexpr int XP = 272, BP = 144;
  LAS bf16_t* Xs = (LAS bf16_t*)lds; LAS bf16_t* Bs = (LAS bf16_t*)(lds + 128 * XP * 2); LAS float* wtab = (LAS float*)(lds + 128 * XP * 2 + 128 * BP * 2);
  const int tid = threadIdx.x, lane = tid & 63, wid = tid >> 6, r = lane & 15, Qd = lane >> 4, hl = wid >> 1, dir = wid & 1;
  for (int task = virt_block(); task < NCH * 4; task += gridDim.x) {
    const int gc = task >> 2, g = (task >> 1) & 1, hh = task & 1; const size_t r0 = (size_t)gc * 128; const int h0 = g * 8 + hh * 4;
    __syncthreads();
#pragma unroll
    for (int i = 0; i < 8; ++i) { const int cid = tid + 512 * i, row = cid >> 5, ch = cid & 31; *(LAS v4u*)(Xs + row * XP + ch * 8) = *(const v4u*)(XC + (r0 + row) * 1536 + h0 * 64 + ch * 8); }
#pragma unroll
    for (int i = 0; i < 4; ++i) { const int cid = tid + 512 * i, row = cid >> 4, ch = cid & 15; *(LAS v4u*)(Bs + row * BP + ch * 8) = *(const v4u*)(XC + (r0 + row) * 1536 + 1024 + g * 128 + ch * 8); }
    if (tid < 256) { const int d_ = tid >> 7, t = tid & 127;
      const f32x4 ce = *(const f32x4*)(SCS + (r0 + (d_ ? 0 : 127)) * 32 + d_ * 16 + h0), ct = *(const f32x4*)(SCS + (r0 + t) * 32 + d_ * 16 + h0), dt = *(const f32x4*)(SDT + (r0 + t) * 32 + d_ * 16 + h0);
      wtab[(0 * 2 + d_) * 128 + t] = fexp(ce.x - ct.x) * dt.x; wtab[(1 * 2 + d_) * 128 + t] = fexp(ce.y - ct.y) * dt.y; wtab[(2 * 2 + d_) * 128 + t] = fexp(ce.z - ct.z) * dt.z; wtab[(3 * 2 + d_) * 128 + t] = fexp(ce.w - ct.w) * dt.w; }
    __syncthreads();
    const LAS float* wt = wtab + wid * 128;
    bf16_t* Sp = ST + ((((size_t)gc * 16 + h0 + hl) * 2 + dir) * 64) * 128;
#pragma unroll 1
    for (int pp = 0; pp < 2; ++pp) {
      f32x4 acc[8][2];
#pragma unroll
      for (int nt = 0; nt < 8; ++nt) { acc[nt][0] = (f32x4){0.f, 0.f, 0.f, 0.f}; acc[nt][1] = (f32x4){0.f, 0.f, 0.f, 0.f}; }
#pragma unroll 1
      for (int k = 0; k < 4; ++k) {
        const f32x4 wlo = *(const LAS f32x4*)(wt + 32 * k + 4 * Qd), whi = *(const LAS f32x4*)(wt + 32 * k + 16 + 4 * Qd);
        bf16x8 xf[2];
#pragma unroll
        for (int pt = 0; pt < 2; ++pt) {
          const s16x4 lo = tr_read(Xs + (32 * k + 4 * Qd + (r >> 2)) * XP + hl * 64 + 32 * pp + 16 * pt + 4 * (r & 3));
          const s16x4 hi = tr_read(Xs + (32 * k + 16 + 4 * Qd + (r >> 2)) * XP + hl * 64 + 32 * pp + 16 * pt + 4 * (r & 3));
          const unsigned w0 = pk2(bf2f((bf16_t)lo[0]) * wlo[0], bf2f((bf16_t)lo[1]) * wlo[1]), w1 = pk2(bf2f((bf16_t)lo[2]) * wlo[2], bf2f((bf16_t)lo[3]) * wlo[3]);
          const unsigned w2 = pk2(bf2f((bf16_t)hi[0]) * whi[0], bf2f((bf16_t)hi[1]) * whi[1]), w3 = pk2(bf2f((bf16_t)hi[2]) * whi[2], bf2f((bf16_t)hi[3]) * whi[3]);
          xf[pt] = (bf16x8){(short)(w0 & 0xffff), (short)(w0 >> 16), (short)(w1 & 0xffff), (short)(w1 >> 16), (short)(w2 & 0xffff), (short)(w2 >> 16), (short)(w3 & 0xffff), (short)(w3 >> 16)};
        }
#pragma unroll
        for (int nt = 0; nt < 8; ++nt) {
          const s16x4 lo = tr_read(Bs + (32 * k + 4 * Qd + (r >> 2)) * BP + 16 * nt + 4 * (r & 3));
          const s16x4 hi = tr_read(Bs + (32 * k + 16 + 4 * Qd + (r >> 2)) * BP + 16 * nt + 4 * (r & 3));
          const bf16x8 bfr = (bf16x8){lo[0], lo[1], lo[2], lo[3], hi[0], hi[1], hi[2], hi[3]};
          acc[nt][0] = __builtin_amdgcn_mfma_f32_16x16x32_bf16(bfr, xf[0], acc[nt][0], 0, 0, 0);
          acc[nt][1] = __builtin_amdgcn_mfma_f32_16x16x32_bf16(bfr, xf[1], acc[nt][1], 0, 0, 0);
        }
      }
#pragma unroll
      for (int nt = 0; nt < 8; ++nt)
#pragma unroll
        for (int pt = 0; pt < 2; ++pt) { const f32x4 v = acc[nt][pt];
          *(unsigned long long*)(Sp + ((((2 * pp + pt) * 4 + (nt >> 1)) * 64 + ((nt & 1) * 2 + (Qd >> 1)) * 16 + r) * 8 + 4 * (Qd & 1))) = (unsigned long long)pk2(v[0], v[1]) | ((unsigned long long)pk2(v[2], v[3]) << 32); }
    }
  }
}
DEV void ssd_scan_phase(bf16_t* ST, const float* SDEC, bool wr) {
  for (int item = blockIdx.x * 512 + threadIdx.x; item < 2 * 16 * 2 * 2048; item += gridDim.x * 512) {
    const int e4 = item & 2047, dir = (item >> 11) & 1, h = (item >> 12) & 15, b = item >> 16;
    float S0 = 0.f, S1 = 0.f, S2 = 0.f, S3 = 0.f;
#define SCAN_GC(s) (!dir ? ((s) < 2 ? 128 + 2 * b + (s) : b * 64 + ((s) - 2)) : ((s) < 2 ? 128 + 2 * b + (1 - (s)) : b * 64 + (65 - (s))))
    for (int s0 = 0; s0 < 66; s0 += 6) {
      unsigned long long u[6]; float dec[6];
#pragma unroll
      for (int q = 0; q < 6; ++q) { const int gc = SCAN_GC(s0 + q); u[q] = *(const unsigned long long*)(ST + (((size_t)gc * 16 + h) * 2 + dir) * 8192 + e4 * 4); dec[q] = SDEC[(gc * 16 + h) * 2 + dir]; }
#pragma unroll
      for (int q = 0; q < 6; ++q) { const int gc = SCAN_GC(s0 + q);
        if (wr) *(unsigned long long*)(ST + (((size_t)gc * 16 + h) * 2 + dir) * 8192 + e4 * 4) = (unsigned long long)pk2(S0, S1) | ((unsigned long long)pk2(S2, S3) << 32);
        const unsigned lo = (unsigned)u[q], hi = (unsigned)(u[q] >> 32);
        S0 = dec[q] * S0 + __uint_as_float(lo << 16); S1 = dec[q] * S1 + __uint_as_float(lo & 0xffff0000u); S2 = dec[q] * S2 + __uint_as_float(hi << 16); S3 = dec[q] * S3 + __uint_as_float(hi & 0xffff0000u); }
    }
#undef SCAN_GC
  }
}
DEV bf16x8 scale_frag(bf16x8 f, float s) {
  bf16x8 o;
#pragma unroll
  for (int e = 0; e < 8; e += 2) { const unsigned w = pk2(bf2f((bf16_t)f[e]) * s, bf2f((bf16_t)f[e + 1]) * s); o[e] = (short)(w & 0xffff); o[e + 1] = (short)(w >> 16); }
  return o;
}
DEV void ssd_y_phase(const bf16_t* XC, const float* SDT, const float* SCS, const bf16_t* ST, const float* d_skip, bf16_t* Y0, float* SSQ, LAS unsigned char* lds, bool wr) {
  constexpr int XP = 272, BP = 136, SP = 72;
  LAS bf16_t* Xs = (LAS bf16_t*)lds; LAS bf16_t* Bs = (LAS bf16_t*)(lds + 128 * XP * 2);
  LAS float* tab = (LAS float*)(lds + 128 * XP * 2 + 128 * BP * 2);
  LAS float* ssq = tab + 4 * 4 * 128;
  LAS bf16_t* stg = (LAS bf16_t*)(ssq + 4 * 128);
  const int tid = threadIdx.x, lane = tid & 63, wid = tid >> 6, r = lane & 15, Qd = lane >> 4, hl = wid >> 1, ih = wid & 1;
  LAS bf16_t* mystg = stg + wid * 16 * SP;
  for (int task = virt_block(); task < NCH * 4; task += gridDim.x) {
    const int gc = task >> 2, g = (task >> 1) & 1, hh = task & 1; const size_t r0 = (size_t)gc * 128; const int h0 = g * 8 + hh * 4, h = h0 + hl;
    bf16x8 cstrip[4], cf[4][4];
#pragma unroll
    for (int ks = 0; ks < 4; ++ks) cstrip[ks] = *(const bf16x8*)(XC + (r0 + 16 * wid + r) * 1536 + 1280 + g * 128 + 32 * ks + 8 * Qd);
#pragma unroll
    for (int m = 0; m < 4; ++m)
#pragma unroll
      for (int ks = 0; ks < 4; ++ks) cf[m][ks] = *(const bf16x8*)(XC + (r0 + 64 * ih + 16 * m + r) * 1536 + 1280 + g * 128 + 32 * ks + 8 * Qd);
    __syncthreads();
#pragma unroll
    for (int i = 0; i < 8; ++i) { const int cid = tid + 512 * i, row = cid >> 5, ch = cid & 31; *(LAS v4u*)(Xs + row * XP + ch * 8) = *(const v4u*)(XC + (r0 + row) * 1536 + h0 * 64 + ch * 8); }
#pragma unroll
    for (int i = 0; i < 4; ++i) { const int cid = tid + 512 * i, row = cid >> 4, ch = cid & 15; *(LAS v4u*)(Bs + row * BP + ch * 8) = *(const v4u*)(XC + (r0 + row) * 1536 + 1024 + g * 128 + ch * 8); }
    { const int which = tid >> 7, t = tid & 127; const f32x4 v = *(const f32x4*)((which < 2 ? SCS : SDT) + (r0 + t) * 32 + (which & 1) * 16 + h0);
      tab[0 * 512 + which * 128 + t] = v.x; tab[1 * 512 + which * 128 + t] = v.y; tab[2 * 512 + which * 128 + t] = v.z; tab[3 * 512 + which * 128 + t] = v.w; }
    __syncthreads();
    {
      f32x4 cb[8];
#pragma unroll
      for (int t = 0; t < 8; ++t) { f32x4 c = {0.f, 0.f, 0.f, 0.f};
#pragma unroll
        for (int ks = 0; ks < 4; ++ks) { const bf16x8 bfr = *(const LAS bf16x8*)(Bs + (16 * t + r) * BP + 32 * ks + 8 * Qd); c = __builtin_amdgcn_mfma_f32_16x16x32_bf16(bfr, cstrip[ks], c, 0, 0, 0); }
        cb[t] = c; }
      __syncthreads();
#pragma unroll
      for (int t = 0; t < 8; ++t) *(LAS unsigned long long*)(Bs + (16 * wid + r) * BP + 16 * t + 4 * Qd) = (unsigned long long)pk2(cb[t][0], cb[t][1]) | ((unsigned long long)pk2(cb[t][2], cb[t][3]) << 32);
      __syncthreads();
    }
    const LAS float* csf = tab + hl * 512; const LAS float* csb = csf + 128; const LAS float* dtf = csf + 256; const LAS float* dtb = csf + 384;
    const float dsk = d_skip[h];
    f32x4 y[4][4];
#pragma unroll
    for (int m = 0; m < 4; ++m)
#pragma unroll
      for (int pt = 0; pt < 4; ++pt) y[m][pt] = (f32x4){0.f, 0.f, 0.f, 0.f};
    if (wr || !(PROBE_SKIP & 1))
#pragma unroll 1
    for (int dir = 0; dir < 2; ++dir) {
      const LAS float* csd = dir ? csb : csf; float sc[4];
#pragma unroll
      for (int m = 0; m < 4; ++m)
#pragma unroll
        for (int ks = 0; ks < 4; ++ks) asm volatile("" : "+v"(cf[m][ks]));
#pragma unroll
      for (int m = 0; m < 4; ++m) sc[m] = fexp(csd[64 * ih + 16 * m + r]);
      const bf16_t* Sp = ST + (((size_t)gc * 16 + h) * 2 + dir) * 8192 + lane * 8;
#pragma unroll
      for (int ks = 0; ks < 4; ++ks) {
        bf16x8 sf[4];
#pragma unroll
        for (int pt = 0; pt < 4; ++pt) sf[pt] = *(const bf16x8*)(Sp + (pt * 4 + ks) * 512);
#pragma unroll
        for (int m = 0; m < 4; ++m) { const bf16x8 a = scale_frag(cf[m][ks], sc[m]);
#pragma unroll
          for (int pt = 0; pt < 4; ++pt) y[m][pt] = __builtin_amdgcn_mfma_f32_16x16x32_bf16(a, sf[pt], y[m][pt], 0, 0, 0);
          __builtin_amdgcn_sched_barrier(0); }
      }
    }
#pragma unroll 1
    for (int m = 0; m < 4; ++m) {
      const int i0 = 64 * ih + 16 * m, i = i0 + r;
      const float cfi = csf[i], cbi = csb[i];
      v4u zpre[2];
#pragma unroll
      for (int q = 0; q < 2; ++q) { const int c = lane + 64 * q; zpre[q] = *(const v4u*)(Y0 + (r0 + i0 + (c >> 3)) * 2048 + h * 64 + (c & 7) * 8); }
      if (wr || !(PROBE_SKIP & 2))
#pragma unroll 1
      for (int k2 = 0; k2 < 4; ++k2) {
        const int j0 = 32 * k2 + 8 * Qd;
        const v4u cbv = *(const LAS v4u*)(Bs + i * BP + j0);
        const float cbe[8] = {__uint_as_float(cbv.x << 16), __uint_as_float(cbv.x & 0xffff0000u), __uint_as_float(cbv.y << 16), __uint_as_float(cbv.y & 0xffff0000u), __uint_as_float(cbv.z << 16), __uint_as_float(cbv.z & 0xffff0000u), __uint_as_float(cbv.w << 16), __uint_as_float(cbv.w & 0xffff0000u)};
        float pv[8];
        const bool dofwd = (32 * k2 <= i0 + 15), dobwd = (32 * k2 + 31 >= i0);
#pragma unroll
        for (int e = 0; e < 8; ++e) pv[e] = (j0 + e == i) ? dsk : 0.f;
        if (dofwd) { const f32x4 a0 = *(const LAS f32x4*)(csf + j0), a1 = *(const LAS f32x4*)(csf + j0 + 4), d0 = *(const LAS f32x4*)(dtf + j0), d1 = *(const LAS f32x4*)(dtf + j0 + 4);
          const float jc[8] = {a0.x, a0.y, a0.z, a0.w, a1.x, a1.y, a1.z, a1.w}; const float jd[8] = {d0.x, d0.y, d0.z, d0.w, d1.x, d1.y, d1.z, d1.w};
#pragma unroll
          for (int e = 0; e < 8; ++e) pv[e] += cbe[e] * fexp(j0 + e <= i ? cfi - jc[e] : -INFINITY) * jd[e]; }
        if (dobwd) { const f32x4 a0 = *(const LAS f32x4*)(csb + j0), a1 = *(const LAS f32x4*)(csb + j0 + 4), d0 = *(const LAS f32x4*)(dtb + j0), d1 = *(const LAS f32x4*)(dtb + j0 + 4);
          const float jc[8] = {a0.x, a0.y, a0.z, a0.w, a1.x, a1.y, a1.z, a1.w}; const float jd[8] = {d0.x, d0.y, d0.z, d0.w, d1.x, d1.y, d1.z, d1.w};
#pragma unroll
          for (int e = 0; e < 8; ++e) pv[e] += cbe[e] * fexp(j0 + e >= i ? cbi - jc[e] : -INFINITY) * jd[e]; }
        const unsigned w0 = pk2(pv[0], pv[1]), w1 = pk2(pv[2], pv[3]), w2 = pk2(pv[4], pv[5]), w3 = pk2(pv[6], pv[7]);
        const bf16x8 pa = (bf16x8){(short)(w0 & 0xffff), (short)(w0 >> 16), (short)(w1 & 0xffff), (short)(w1 >> 16), (short)(w2 & 0xffff), (short)(w2 >> 16), (short)(w3 & 0xffff), (short)(w3 >> 16)};
#pragma unroll
        for (int pt = 0; pt < 4; ++pt) {
          const s16x4 lo = tr_read(Xs + (32 * k2 + 8 * Qd + (r >> 2)) * XP + hl * 64 + 16 * pt + 4 * (r & 3));
          const s16x4 hi = tr_read(Xs + (32 * k2 + 8 * Qd + 4 + (r >> 2)) * XP + hl * 64 + 16 * pt + 4 * (r & 3));
          const bf16x8 xf = (bf16x8){lo[0], lo[1], lo[2], lo[3], hi[0], hi[1], hi[2], hi[3]};
          y[0][pt] = __builtin_amdgcn_mfma_f32_16x16x32_bf16(pa, xf, y[0][pt], 0, 0, 0);
        }
      }
      if (wr || !(PROBE_SKIP & 4)) {
#pragma unroll
      for (int pt = 0; pt < 4; ++pt)
#pragma unroll
        for (int jj = 0; jj < 4; ++jj) mystg[(4 * Qd + jj) * SP + 16 * pt + r] = f2bf(y[0][pt][jj]);
      LDS_WAIT(); asm volatile("" ::: "memory");
#pragma unroll
      for (int q = 0; q < 2; ++q) { const int c = lane + 64 * q, rowl = c >> 3, ch = c & 7; const int il = 64 * ih + 16 * m + rowl;
        const v4u yv = *(const LAS v4u*)(mystg + rowl * SP + ch * 8); bf16_t* zp = Y0 + (r0 + il) * 2048 + h * 64 + ch * 8; const v4u zv = zpre[q];
        const float v0 = __uint_as_float(yv.x << 16) * __uint_as_float(zv.x << 16), v1 = __uint_as_float(yv.x & 0xffff0000u) * __uint_as_float(zv.x & 0xffff0000u);
        const float v2 = __uint_as_float(yv.y << 16) * __uint_as_float(zv.y << 16), v3 = __uint_as_float(yv.y & 0xffff0000u) * __uint_as_float(zv.y & 0xffff0000u);
        const float v4 = __uint_as_float(yv.z << 16) * __uint_as_float(zv.z << 16), v5 = __uint_as_float(yv.z & 0xffff0000u) * __uint_as_float(zv.z & 0xffff0000u);
        const float v6 = __uint_as_float(yv.w << 16) * __uint_as_float(zv.w << 16), v7 = __uint_as_float(yv.w & 0xffff0000u) * __uint_as_float(zv.w & 0xffff0000u);
        float ss = (v0 * v0 + v1 * v1) + (v2 * v2 + v3 * v3) + (v4 * v4 + v5 * v5) + (v6 * v6 + v7 * v7);
        ss += __shfl_xor(ss, 1); ss += __shfl_xor(ss, 2); ss += __shfl_xor(ss, 4);
        v4u ov; ov.x = pk2(v0, v1); ov.y = pk2(v2, v3); ov.z = pk2(v4, v5); ov.w = pk2(v6, v7);
        if (wr) *(v4u*)zp = ov;
        if (ch == 0) ssq[hl * 128 + il] = ss; }
      LDS_WAIT(); asm volatile("" ::: "memory");
      }
#pragma unroll
      for (int pt = 0; pt < 4; ++pt) { y[0][pt] = y[1][pt]; y[1][pt] = y[2][pt]; y[2][pt] = y[3][pt]; }
    }
    __syncthreads();
    if (tid < 128) SSQ[((r0 + tid) * 2 + g) * 2 + hh] = (ssq[tid] + ssq[128 + tid]) + (ssq[256 + tid] + ssq[384 + tid]);
  }
}

typedef _Float16 h16_t;
typedef _Float16 h16x8 __attribute__((ext_vector_type(8)));
DEV const h16_t* gcs_row(const h16_t* wsb, const h16_t* outb, size_t row) {
  return row < 9472 ? (const h16_t*)((const char*)wsb + 237 * MiB + 512 * 1024) + row * 1024 : (row < 13824 ? (const h16_t*)((const char*)outb + 55 * MiB + 512 * 1024) + (row - 9472) * 1024 : (const h16_t*)((const char*)wsb + 2 * MiB) + (row - 13824) * 1024); }
DEV h16_t* gcs_row_w(h16_t* wsb, h16_t* outb, size_t row) { return (h16_t*)gcs_row(wsb, outb, row); }
DEV float logsig_fast(float x) { return fminf(x, 0.f) - 0.6931471805599453f * __builtin_amdgcn_logf(1.f + __builtin_amdgcn_exp2f(-1.4426950408889634f * fabsf(x))); }
DEV void gla_cs_phase(const float* DTLR, const float* gw, const float* gb, h16_t* GCSL, h16_t* GCSC, float* GDEC, LAS unsigned char* lds, unsigned* queue) {
  const int lane = threadIdx.x & 63, wave = threadIdx.x >> 6;
  LAS float* lrs = (LAS float*)(lds + wave * 8192);
  LAS h16_t* tile = (LAS h16_t*)(lds + 65536 + wave * 1024);
  for (;;) {
    unsigned wt_ = 0u; if (lane == 0) wt_ = __hip_atomic_fetch_add(queue, 1u, __ATOMIC_RELAXED, __HIP_MEMORY_SCOPE_AGENT);
    wt_ = (unsigned)__builtin_amdgcn_readfirstlane((int)wt_); if (wt_ >= (unsigned)(NCH * 2 * 8)) break;
    const int wt = (int)wt_;
    const int gc = wt >> 4, dir = (wt >> 3) & 1, k = (wt & 7) * 64 + lane;
#pragma unroll
    for (int q = 0; q < 8; ++q) { const int c = lane + 64 * q, row = c >> 2, part = c & 3;
      *(LAS f32x4*)(lrs + row * 16 + part * 4) = *(const f32x4*)(DTLR + ((size_t)gc * 128 + row) * 64 + 32 + dir * 16 + part * 4); }
    float wv[16];
#pragma unroll
    for (int q = 0; q < 16; ++q) wv[q] = gw[(dir * 16 + q) * 512 + k];
    const float bias = gb[dir * 512 + k];
    LDS_WAIT(); asm volatile("" ::: "memory");
    float run = 0.f;
#pragma unroll 1
    for (int s0 = 0; s0 < 128; s0 += 8) {
      float lg[8];
#pragma unroll
      for (int u = 0; u < 8; ++u) { const int s = s0 + u, t = dir ? 127 - s : s; const LAS float* lr = lrs + t * 16;
        const f32x4 l0 = *(const LAS f32x4*)lr, l1 = *(const LAS f32x4*)(lr + 4), l2 = *(const LAS f32x4*)(lr + 8), l3 = *(const LAS f32x4*)(lr + 12);
        const float x = bias + l0.x * wv[0] + l0.y * wv[1] + l0.z * wv[2] + l0.w * wv[3] + l1.x * wv[4] + l1.y * wv[5] + l1.z * wv[6] + l1.w * wv[7]
                        + l2.x * wv[8] + l2.y * wv[9] + l2.z * wv[10] + l2.w * wv[11] + l3.x * wv[12] + l3.y * wv[13] + l3.z * wv[14] + l3.w * wv[15];
        lg[u] = logsig_fast(x) * (1.f / 16.f); }
#pragma unroll
      for (int u = 0; u < 8; ++u) { run += lg[u]; tile[u * 64 + lane] = (h16_t)run; }
      LDS_WAIT(); asm volatile("" ::: "memory");
      { const int u = lane >> 3, ch = lane & 7, s = s0 + u, t = dir ? 127 - s : s;
        *(v4u*)(gcs_row_w(GCSL, GCSC, (size_t)gc * 128 + t) + dir * 512 + (k - lane) + ch * 8) = *(const LAS v4u*)(tile + u * 64 + ch * 8); }
      LDS_WAIT(); asm volatile("" ::: "memory");
    }
    GDEC[((gc * 4 + (k >> 7)) * 2 + dir) * 128 + (k & 127)] = fexp(run);
    LDS_WAIT(); asm volatile("" ::: "memory");
  }
}
DEV void gla_u_phase(const bf16_t* K0, const bf16_t* V0, const h16_t* GCSL, const h16_t* GCSC, bf16_t* ST, LAS unsigned char* lds) {
  constexpr int VP = 272, KP = 144;
  LAS bf16_t* Vs = (LAS bf16_t*)lds; LAS bf16_t* Kd = (LAS bf16_t*)(lds + 128 * VP * 2);
  const int tid = threadIdx.x, lane = tid & 63, wid = tid >> 6, r = lane & 15, Qd = lane >> 4;
  for (int task = virt_block(); task < NCH * 4; task += gridDim.x) {
    const int gc = task >> 2, h = task & 3; const size_t r0 = (size_t)gc * 128;
    __syncthreads();
#pragma unroll
    for (int i = 0; i < 8; ++i) { const int cid = tid + 512 * i, row = cid >> 5, ch = cid & 31; *(LAS v4u*)(Vs + row * VP + ch * 8) = *(const v4u*)(V0 + (r0 + row) * 1024 + h * 256 + ch * 8); }
#pragma unroll
    for (int i = 0; i < 4; ++i) { const int cid = tid + 512 * i, t = cid >> 4, ch = cid & 15;
      const v4u kv = *(const v4u*)(K0 + (r0 + t) * 512 + h * 128 + ch * 8);
      const float kf[8] = {__uint_as_float(kv.x << 16), __uint_as_float(kv.x & 0xffff0000u), __uint_as_float(kv.y << 16), __uint_as_float(kv.y & 0xffff0000u), __uint_as_float(kv.z << 16), __uint_as_float(kv.z & 0xffff0000u), __uint_as_float(kv.w << 16), __uint_as_float(kv.w & 0xffff0000u)};
#pragma unroll
      for (int dir = 0; dir < 2; ++dir) {
        const h16x8 ce = *(const h16x8*)(gcs_row(GCSL, GCSC, r0 + (dir ? 0 : 127)) + dir * 512 + h * 128 + ch * 8), ct = *(const h16x8*)(gcs_row(GCSL, GCSC, r0 + t) + dir * 512 + h * 128 + ch * 8);
        v4u o; o.x = pk2(kf[0] * fexp((float)ce[0] - (float)ct[0]), kf[1] * fexp((float)ce[1] - (float)ct[1])); o.y = pk2(kf[2] * fexp((float)ce[2] - (float)ct[2]), kf[3] * fexp((float)ce[3] - (float)ct[3]));
        o.z = pk2(kf[4] * fexp((float)ce[4] - (float)ct[4]), kf[5] * fexp((float)ce[5] - (float)ct[5])); o.w = pk2(kf[6] * fexp((float)ce[6] - (float)ct[6]), kf[7] * fexp((float)ce[7] - (float)ct[7]));
        *(LAS v4u*)(Kd + dir * 128 * KP + t * KP + ch * 8) = o; } }
    __syncthreads();
#pragma unroll 1
    for (int dir = 0; dir < 2; ++dir) {
      const LAS bf16_t* Kb = Kd + dir * 128 * KP;
      f32x4 acc[8][2];
#pragma unroll
      for (int dt = 0; dt < 8; ++dt) { acc[dt][0] = (f32x4){0.f, 0.f, 0.f, 0.f}; acc[dt][1] = (f32x4){0.f, 0.f, 0.f, 0.f}; }
#pragma unroll 1
      for (int k = 0; k < 4; ++k) {
        bf16x8 vf[2];
#pragma unroll
        for (int et = 0; et < 2; ++et) {
          const s16x4 lo = tr_read(Vs + (32 * k + 4 * Qd + (r >> 2)) * VP + 32 * wid + 16 * et + 4 * (r & 3));
          const s16x4 hi = tr_read(Vs + (32 * k + 16 + 4 * Qd + (r >> 2)) * VP + 32 * wid + 16 * et + 4 * (r & 3));
          vf[et] = (bf16x8){lo[0], lo[1], lo[2], lo[3], hi[0], hi[1], hi[2], hi[3]}; }
#pragma unroll
        for (int dt = 0; dt < 8; ++dt) {
          const s16x4 lo = tr_read(Kb + (32 * k + 4 * Qd + (r >> 2)) * KP + 16 * dt + 4 * (r & 3));
          const s16x4 hi = tr_read(Kb + (32 * k + 16 + 4 * Qd + (r >> 2)) * KP + 16 * dt + 4 * (r & 3));
          const bf16x8 kfr = (bf16x8){lo[0], lo[1], lo[2], lo[3], hi[0], hi[1], hi[2], hi[3]};
          acc[dt][0] = __builtin_amdgcn_mfma_f32_16x16x32_bf16(kfr, vf[0], acc[dt][0], 0, 0, 0);
          acc[dt][1] = __builtin_amdgcn_mfma_f32_16x16x32_bf16(kfr, vf[1], acc[dt][1], 0, 0, 0); }
      }
      bf16_t* Sp = ST + (((size_t)gc * 4 + h) * 2 + dir) * 32768;
#pragma unroll
      for (int dt = 0; dt < 8; ++dt)
#pragma unroll
        for (int et = 0; et < 2; ++et) { const f32x4 v = acc[dt][et];
          *(unsigned long long*)(Sp + ((((2 * wid + et) * 4 + (dt >> 1)) * 64 + ((dt & 1) * 2 + (Qd >> 1)) * 16 + r) * 8 + 4 * (Qd & 1))) = (unsigned long long)pk2(v[0], v[1]) | ((unsigned long long)pk2(v[2], v[3]) << 32); }
    }
  }
}
DEV void gla_scan_phase(bf16_t* ST, const float* GDEC, bool wr) {
  for (int item = blockIdx.x * 512 + threadIdx.x; item < 2 * 4 * 2 * 8192; item += gridDim.x * 512) {
    const int e4 = item & 8191, dir = (item >> 13) & 1, h = (item >> 14) & 3, b = item >> 16; const int d0 = 32 * ((e4 >> 7) & 3) + 8 * ((e4 >> 5) & 3) + 4 * (e4 & 1);
    float S0 = 0.f, S1 = 0.f, S2 = 0.f, S3 = 0.f;
#define SCAN_GC(s) (!dir ? ((s) < 2 ? 128 + 2 * b + (s) : b * 64 + ((s) - 2)) : ((s) < 2 ? 128 + 2 * b + (1 - (s)) : b * 64 + (65 - (s))))
    for (int s0 = 0; s0 < 66; s0 += 6) {
      unsigned long long u[6]; f32x4 dec[6];
#pragma unroll
      for (int q = 0; q < 6; ++q) { const int gc = SCAN_GC(s0 + q); u[q] = *(const unsigned long long*)(ST + (((size_t)gc * 4 + h) * 2 + dir) * 32768 + e4 * 4); dec[q] = *(const f32x4*)(GDEC + ((gc * 4 + h) * 2 + dir) * 128 + d0); }
#pragma unroll
      for (int q = 0; q < 6; ++q) { const int gc = SCAN_GC(s0 + q);
        if (wr) *(unsigned long long*)(ST + (((size_t)gc * 4 + h) * 2 + dir) * 32768 + e4 * 4) = (unsigned long long)pk2(S0, S1) | ((unsigned long long)pk2(S2, S3) << 32);
        const unsigned lo = (unsigned)u[q], hi = (unsigned)(u[q] >> 32);
        S0 = dec[q].x * S0 + __uint_as_float(lo << 16); S1 = dec[q].y * S1 + __uint_as_float(lo & 0xffff0000u); S2 = dec[q].z * S2 + __uint_as_float(hi << 16); S3 = dec[q].w * S3 + __uint_as_float(hi & 0xffff0000u); }
    }
#undef SCAN_GC
  }
}
DEV void gla_o_phase(const bf16_t* Q0, const bf16_t* K0, const bf16_t* V0, const h16_t* GCSL, const h16_t* GCSC, const bf16_t* ST, const float* gla_norm, const float* SSQ, const float* ssd_norm, bf16_t* Y0, LAS unsigned char* lds, bool wr) {
  constexpr int VP = 272, KP = 136;
  LAS bf16_t* Vs = (LAS bf16_t*)lds; LAS bf16_t* Kd = (LAS bf16_t*)(lds + 128 * VP * 2);
  const int tid = threadIdx.x, lane = tid & 63, wid = tid >> 6, r = lane & 15, Qd = lane >> 4;
  const float scale = 0.08838834764831845f;
  for (int task = virt_block(); task < NCH * 4; task += gridDim.x) {
    const int gc = task >> 2, h = task & 3; const size_t r0 = (size_t)gc * 128;
    __syncthreads();
#pragma unroll
    for (int i = 0; i < 8; ++i) { const int cid = tid + 512 * i, row = cid >> 5, ch = cid & 31; *(LAS v4u*)(Vs + row * VP + ch * 8) = *(const v4u*)(V0 + (r0 + row) * 1024 + h * 256 + ch * 8); }
#pragma unroll
    for (int i = 0; i < 4; ++i) { const int cid = tid + 512 * i, t = cid >> 4, ch = cid & 15;
      const v4u kv = *(const v4u*)(K0 + (r0 + t) * 512 + h * 128 + ch * 8);
      const float kf[8] = {__uint_as_float(kv.x << 16), __uint_as_float(kv.x & 0xffff0000u), __uint_as_float(kv.y << 16), __uint_as_float(kv.y & 0xffff0000u), __uint_as_float(kv.z << 16), __uint_as_float(kv.z & 0xffff0000u), __uint_as_float(kv.w << 16), __uint_as_float(kv.w & 0xffff0000u)};
#pragma unroll
      for (int dir = 0; dir < 2; ++dir) {
        const h16x8 ct = *(const h16x8*)(gcs_row(GCSL, GCSC, r0 + t) + dir * 512 + h * 128 + ch * 8);
        v4u o; o.x = pk2(kf[0] * fexp(-(float)ct[0]), kf[1] * fexp(-(float)ct[1])); o.y = pk2(kf[2] * fexp(-(float)ct[2]), kf[3] * fexp(-(float)ct[3]));
        o.z = pk2(kf[4] * fexp(-(float)ct[4]), kf[5] * fexp(-(float)ct[5])); o.w = pk2(kf[6] * fexp(-(float)ct[6]), kf[7] * fexp(-(float)ct[7]));
        *(LAS v4u*)(Kd + dir * 128 * KP + t * KP + ch * 8) = o; } }
    __syncthreads();
    const int i = 16 * wid + r;
    f32x4 o[16];
#pragma unroll
    for (int et = 0; et < 16; ++et) o[et] = (f32x4){0.f, 0.f, 0.f, 0.f};
#pragma unroll 1
    for (int dir = 0; dir < 2; ++dir) {
      bf16x8 qd[4];
      { const h16_t* ci = gcs_row(GCSL, GCSC, r0 + i) + dir * 512 + h * 128; const bf16_t* qp = Q0 + (r0 + i) * 512 + h * 128;
#pragma unroll
        for (int ks = 0; ks < 4; ++ks) { const v4u qv = *(const v4u*)(qp + 32 * ks + 8 * Qd); const h16x8 cc = *(const h16x8*)(ci + 32 * ks + 8 * Qd);
          const f32x4 c0 = {(float)cc[0], (float)cc[1], (float)cc[2], (float)cc[3]}, c1 = {(float)cc[4], (float)cc[5], (float)cc[6], (float)cc[7]};
          const unsigned w0 = pk2(__uint_as_float(qv.x << 16) * scale * fexp(c0.x), __uint_as_float(qv.x & 0xffff0000u) * scale * fexp(c0.y));
          const unsigned w1 = pk2(__uint_as_float(qv.y << 16) * scale * fexp(c0.z), __uint_as_float(qv.y & 0xffff0000u) * scale * fexp(c0.w));
          const unsigned w2 = pk2(__uint_as_float(qv.z << 16) * scale * fexp(c1.x), __uint_as_float(qv.z & 0xffff0000u) * scale * fexp(c1.y));
          const unsigned w3 = pk2(__uint_as_float(qv.w << 16) * scale * fexp(c1.z), __uint_as_float(qv.w & 0xffff0000u) * scale * fexp(c1.w));
          qd[ks] = (bf16x8){(short)(w0 & 0xffff), (short)(w0 >> 16), (short)(w1 & 0xffff), (short)(w1 >> 16), (short)(w2 & 0xffff), (short)(w2 >> 16), (short)(w3 & 0xffff), (short)(w3 >> 16)}; } }
      const bf16_t* Sp = ST + (((size_t)gc * 4 + h) * 2 + dir) * 32768 + lane * 8;
      {
        bf16x8 sA[4], sB[4];
#pragma unroll
        for (int q = 0; q < 4; ++q) sA[q] = *(const bf16x8*)(Sp + (q * 4 + 0) * 512);
#pragma unroll
        for (int bi = 0; bi < 16; ++bi) {
          const int ks = bi >> 2, e0 = 4 * (bi & 3);
          if (bi + 1 < 16) { const int ks2 = (bi + 1) >> 2, e2 = 4 * ((bi + 1) & 3);
#pragma unroll
            for (int q = 0; q < 4; ++q) { if (bi & 1) sA[q] = *(const bf16x8*)(Sp + ((e2 + q) * 4 + ks2) * 512); else sB[q] = *(const bf16x8*)(Sp + ((e2 + q) * 4 + ks2) * 512); } }
#pragma unroll
          for (int q = 0; q < 4; ++q) o[e0 + q] = __builtin_amdgcn_mfma_f32_16x16x32_bf16(qd[ks], (bi & 1) ? sB[q] : sA[q], o[e0 + q], 0, 0, 0);
          __builtin_amdgcn_sched_barrier(0);
        }
      }
      const LAS bf16_t* Kb = Kd + dir * 128 * KP;
#pragma unroll 1
      for (int k2 = 0; k2 < 4; ++k2) {
        const bool need = dir ? (2 * k2 + 1 >= wid) : (2 * k2 <= wid);
        if (!need) continue;
        bf16x8 pa;
#pragma unroll
        for (int tt = 0; tt < 2; ++tt) { const int t = 2 * k2 + tt;
          f32x4 c = {0.f, 0.f, 0.f, 0.f};
#pragma unroll
          for (int ks = 0; ks < 4; ++ks) { const bf16x8 kfr = *(const LAS bf16x8*)(Kb + (16 * t + r) * KP + 32 * ks + 8 * Qd); c = __builtin_amdgcn_mfma_f32_16x16x32_bf16(kfr, qd[ks], c, 0, 0, 0); }
          float pv[4];
#pragma unroll
          for (int jj = 0; jj < 4; ++jj) { const int j = 16 * t + 4 * Qd + jj; const bool ok = dir ? (j >= i) : (j <= i); pv[jj] = ok ? c[jj] : 0.f; }
          const unsigned w0 = pk2(pv[0], pv[1]), w1 = pk2(pv[2], pv[3]);
          pa[tt * 4 + 0] = (short)(w0 & 0xffff); pa[tt * 4 + 1] = (short)(w0 >> 16); pa[tt * 4 + 2] = (short)(w1 & 0xffff); pa[tt * 4 + 3] = (short)(w1 >> 16); }
#pragma unroll
        for (int et = 0; et < 16; ++et) {
          const s16x4 lo = tr_read(Vs + (32 * k2 + 4 * Qd + (r >> 2)) * VP + 16 * et + 4 * (r & 3));
          const s16x4 hi = tr_read(Vs + (32 * k2 + 16 + 4 * Qd + (r >> 2)) * VP + 16 * et + 4 * (r & 3));
          const bf16x8 vf = (bf16x8){lo[0], lo[1], lo[2], lo[3], hi[0], hi[1], hi[2], hi[3]};
          o[et] = __builtin_amdgcn_mfma_f32_16x16x32_bf16(pa, vf, o[et], 0, 0, 0); }
      }
    }
#pragma unroll
    for (int jj = 0; jj < 4; ++jj) { float ss = 0.f;
#pragma unroll
      for (int et = 0; et < 16; ++et) ss += o[et][jj] * o[et][jj];
      ss += __shfl_xor(ss, 1); ss += __shfl_xor(ss, 2); ss += __shfl_xor(ss, 4); ss += __shfl_xor(ss, 8);
      const float rstd = rsqrtf(ss * (1.f / 256.f) + EPS);
      const size_t yo = (r0 + 16 * wid + 4 * Qd + jj) * 2048 + 1024 + h * 256 + r;
#pragma unroll
      for (int et = 0; et < 16; ++et) { const bf16_t ov_ = f2bf(o[et][jj] * rstd * gla_norm[h * 256 + 16 * et + r] * bf2f(Y0[yo + 16 * et])); if (wr) Y0[yo + 16 * et] = ov_; } }
    { const int g = h >> 1, c0 = g * 512 + (h & 1) * 256;
#pragma unroll
      for (int q = 0; q < 8; ++q) { const int cid = tid + 512 * q, row = cid >> 5, ch = cid & 31; const size_t rr = r0 + row;
        const float rstd = rsqrtf((SSQ[(rr * 2 + g) * 2] + SSQ[(rr * 2 + g) * 2 + 1]) * (1.f / 512.f) + EPS);
        bf16_t* yp = Y0 + rr * 2048 + c0 + ch * 8; const v4u yv = *(const v4u*)yp; const f32x4 g0 = *(const f32x4*)(ssd_norm + c0 + ch * 8), g1 = *(const f32x4*)(ssd_norm + c0 + ch * 8 + 4);
        v4u ov; ov.x = pk2(__uint_as_float(yv.x << 16) * rstd * g0.x, __uint_as_float(yv.x & 0xffff0000u) * rstd * g0.y); ov.y = pk2(__uint_as_float(yv.y << 16) * rstd * g0.z, __uint_as_float(yv.y & 0xffff0000u) * rstd * g0.w);
        ov.z = pk2(__uint_as_float(yv.z << 16) * rstd * g1.x, __uint_as_float(yv.z & 0xffff0000u) * rstd * g1.y); ov.w = pk2(__uint_as_float(yv.w << 16) * rstd * g1.z, __uint_as_float(yv.w & 0xffff0000u) * rstd * g1.w);
        if (wr) *(v4u*)yp = ov; } }
  }
}

typedef __attribute__((address_space(1))) unsigned gu32;
#define RLX_AGENT __ATOMIC_RELAXED, __HIP_MEMORY_SCOPE_AGENT
#define XB_TMO      128
#define XB_XCNT(j)  (256  + 64 * (j))
#define XB_XSUB(j)  (1280 + 64 * (j))
#define XB_XGEN(j)  (2304 + 64 * (j))
#define XB_TOP      3328
#define XB_TOPGEN   3392
#define XCD_BAR_WORDS 3456
#define XB_SPIN_CAP (1u << 18)

__device__ __forceinline__ unsigned xb_ld(unsigned* p)              { return __hip_atomic_load(p, __ATOMIC_RELAXED, __HIP_MEMORY_SCOPE_AGENT); }
__device__ __forceinline__ unsigned xb_add(unsigned* p, unsigned v) { return __hip_atomic_fetch_add(p, v, __ATOMIC_RELAXED, __HIP_MEMORY_SCOPE_AGENT); }
__device__ __forceinline__ unsigned xb_xcc_id() { return (unsigned)__builtin_amdgcn_s_getreg((3 << 11) | 20) & 0xFu; }
#define XB_SPIN(cond, bar) do { unsigned _sp = 0; while (cond) { __builtin_amdgcn_s_sleep(1); \
    if ((++_sp & 255u) == 0u) { if (xb_ld(&(bar)[XB_TMO])) break; if (_sp > XB_SPIN_CAP) { atomicAdd(&(bar)[XB_TMO], 1u); break; } } } } while (0)

struct XcdBarrier {
    unsigned* bar; unsigned x;
    volatile LAS unsigned* st;
};

__device__ __forceinline__ XcdBarrier xcd_barrier_post(unsigned* bar, volatile LAS unsigned* st) {
    XcdBarrier b; b.bar = bar; b.x = xb_xcc_id(); b.st = st;
    if (threadIdx.x == 0) (void)xb_add(&bar[XB_XCNT(b.x)], 1u);
    return b;
}
__device__ __forceinline__ void xcd_barrier_complete(unsigned* bar, unsigned x, unsigned& nloc, unsigned& nx) {
    const unsigned G = gridDim.x * gridDim.y * gridDim.z;
    unsigned sum, cnt, mine, sp = 0u;
    for (;;) {
        sum = 0u; cnt = 0u; mine = 0u;
#pragma unroll
        for (unsigned j = 0; j < 16; ++j) { const unsigned c = xb_ld(&bar[XB_XCNT(j)]); sum += c; cnt += (c > 0u) ? 1u : 0u; mine = (j == x) ? c : mine; }
        if (sum == G) break;
        __builtin_amdgcn_s_sleep(1);
        if ((++sp & 255u) == 0u) { if (xb_ld(&bar[XB_TMO])) break; if (sp > XB_SPIN_CAP) { atomicAdd(&bar[XB_TMO], 1u); break; } }
    }
    nloc = mine > 0u ? mine : 1u; nx = cnt > 0u ? cnt : 1u;
}

__device__ __forceinline__ void xcd_barrier(const XcdBarrier& b) {
    asm volatile("s_waitcnt vmcnt(0)" ::: "memory");
    __syncthreads();
    if (threadIdx.x == 0) {
        unsigned* bar = b.bar;
        __builtin_amdgcn_s_waitcnt(0);
        unsigned nloc = b.st[0], nx = b.st[1];
        if (nloc == 0u) { xcd_barrier_complete(bar, b.x, nloc, nx); b.st[0] = nloc; b.st[1] = nx; }
        const unsigned old = xb_add(&bar[XB_XSUB(b.x)], 1u);
        const unsigned gen = old / nloc;
        if (old + 1u == (gen + 1u) * nloc) {
            __builtin_amdgcn_fence(__ATOMIC_RELEASE, "agent");
            asm volatile("s_waitcnt vmcnt(0)" ::: "memory");
            const unsigned og = xb_add(&bar[XB_TOP], 1u);
            const unsigned tg = og / nx;
            if (og + 1u == (tg + 1u) * nx) xb_add(&bar[XB_TOPGEN], 1u);
            else XB_SPIN(xb_ld(&bar[XB_TOPGEN]) == tg, bar);
            __builtin_amdgcn_fence(__ATOMIC_ACQUIRE, "agent");
            xb_add(&bar[XB_XGEN(b.x)], 1u);
            asm volatile("s_waitcnt vmcnt(0)" ::: "memory");
        } else {
            XB_SPIN(xb_ld(&bar[XB_XGEN(b.x)]) == gen, bar);
            __builtin_amdgcn_fence(__ATOMIC_ACQUIRE, "agent");
            asm volatile("s_waitcnt vmcnt(0)" ::: "memory");
        }
    }
    __syncthreads();
}

__global__ void __launch_bounds__(NWAVES * 64, 2) mega(Params p) {
  extern __shared__ __attribute__((aligned(16))) unsigned char lds_raw[];
  LAS unsigned char* lds = (LAS unsigned char*)lds_raw;
  volatile LAS unsigned* MISC = (volatile LAS unsigned*)(lds + MISC_OFF);
  if (threadIdx.x < 16) MISC[threadIdx.x] = 0u;
  __syncthreads();
  XcdBarrier bar = xcd_barrier_post((unsigned*)(p.ws + WS_CTL), MISC + 8);
  unsigned char* ws = p.ws;
  float* MOD = (float*)(ws + WS_MOD);
  bf16_t* H0 = (bf16_t*)p.out; float* X1 = p.out;
  const int lo = p.ph_lo, hi = p.ph_hi;
#define IN(k) (lo <= (k) && (k) < hi)
#define SEAM(k) do { if ((k) + 1 < hi) xcd_barrier(bar); } while (0)
#define PH(k, ...) if (IN(k)) { if ((PROBE_MASK >> (k)) & 1u) { const bool wr = (p.rep < 0); (void)wr; __VA_ARGS__; xcd_barrier(bar); } { const bool wr = true; (void)wr; __VA_ARGS__; } SEAM(k); }
  PH(0, prologue_phase(p, lds))
  PH(1, prep_phase(p.in[0], p.in[2], p.in[4], MOD, H0))
  PH(2, {
    pg8::Gemm g{H0, (const bf16_t*)(ws + WS_W1T), MA, E_INP, D}; pg8::StaticOrder S; S.init(MA, E_INP, gridDim.x, (int)blockIdx.x);
    pg8::EpiProj0 E{(bf16_t*)(ws + WS_Y0), (bf16_t*)(ws + WS_XBC), (bf16_t*)(ws + WS_Q0), (bf16_t*)(ws + WS_K0), (bf16_t*)(ws + WS_V0), (float*)(ws + WS_DTLR)};
    pg8::gemm_phase<pg8::EpiProj0, pg8::StaticOrder, true, true>(lds, g, S, E); })
  PH(3, ssd_prep_phase((const bf16_t*)(ws + WS_XBC), p.in[8], p.in[9], (bf16_t*)p.out, (const float*)(ws + WS_DTLR), p.in[10], p.in[11], (float*)((char*)p.out + DO_SDT), (float*)((char*)p.out + DO_SCS), (float*)(ws + WS_SDEC)))
  PH(4, { ssd_u_phase((const bf16_t*)p.out, (const float*)((char*)p.out + DO_SDT), (const float*)((char*)p.out + DO_SCS), (bf16_t*)(ws + WS_STATE), lds);
    { const int nbusy = (NCH * 4) % (int)gridDim.x, nfree = (int)gridDim.x - nbusy;
      const int vb_ = virt_block(); if (vb_ >= nbusy || nfree <= 0) { __syncthreads(); late_weights(p, lds, nfree > 0 ? vb_ - nbusy : vb_, nfree > 0 ? nfree : (int)gridDim.x); } } })
  PH(5, ssd_scan_phase((bf16_t*)(ws + WS_STATE), (const float*)(ws + WS_SDEC), wr))
  PH(6, { ssd_y_phase((const bf16_t*)p.out, (const float*)((char*)p.out + DO_SDT), (const float*)((char*)p.out + DO_SCS), (const bf16_t*)(ws + WS_STATE), p.in[12], (bf16_t*)(ws + WS_Y0), (float*)(ws + WS_SSQ), lds, wr);
    if (wr) gla_cs_phase((const float*)(ws + WS_DTLR), p.in[14], p.in[15], (h16_t*)ws, (h16_t*)p.out, (float*)(ws + WS_GDEC), lds, (unsigned*)(ws + WS_CTL) + CW_CSQ); })
  PH(8, gla_u_phase((const bf16_t*)(ws + WS_K0), (const bf16_t*)(ws + WS_V0), (const h16_t*)ws, (const h16_t*)p.out, (bf16_t*)(ws + WS_STATE), lds))
  PH(9, gla_scan_phase((bf16_t*)(ws + WS_STATE), (const float*)(ws + WS_GDEC), wr))
  PH(10, gla_o_phase((const bf16_t*)(ws + WS_Q0), (const bf16_t*)(ws + WS_K0), (const bf16_t*)(ws + WS_V0), (const h16_t*)ws, (const h16_t*)p.out, (const bf16_t*)(ws + WS_STATE), p.in[16], (const float*)(ws + WS_SSQ), p.in[13], (bf16_t*)(ws + WS_Y0), lds, wr))
  PH(11, {
    pg8::Gemm g{(const bf16_t*)(ws + WS_Y0), (const bf16_t*)(ws + WS_W2T), ML, D, 2048}; pg8::StaticOrder S; S.init(ML, D, gridDim.x, (int)blockIdx.x);
    pg8::EpiResid E{p.in[0], X1, MOD, true};
    pg8::gemm_phase<pg8::EpiResid, pg8::StaticOrder, true, true>(lds, g, S, E);
    const float* ctx = p.in[2]; float* XC1 = (float*)(ws + WS_XC1); const float* gate = MOD + 2 * 3072 + 2048;
    small_gemm((const bf16_t*)(ws + WS_Y0) + (size_t)ML * 2048, 2048, (const bf16_t*)(ws + WS_W2T), 2048, 2048, MC, D,
               [=](int m, int n, float v) { XC1[(size_t)m * D + n] = ctx[(size_t)m * D + n] + gate[n] * v; }); })
  PH(12, prep_phase(X1, (const float*)(ws + WS_XC1), p.in[18], MOD + 3 * 3072, (bf16_t*)(ws + WS_H1)))
  PH(13, {
    pg8::Gemm g{(const bf16_t*)(ws + WS_H1), (const bf16_t*)(ws + WS_W3T), ML, O_IN, D}; pg8::StaticOrder S; S.init(ML, O_IN, gridDim.x, (int)blockIdx.x);
    pg8::EpiProj1 E{(bf16_t*)(ws + WS_K1), (bf16_t*)(ws + WS_V1), (bf16_t*)(ws + WS_Q1), (bf16_t*)(ws + WS_G1), p.in[22], p.in[23], (const float*)(ws + WS_ROPE), (LAS float*)(lds + 131072)};
    pg8::gemm_phase<pg8::EpiProj1, pg8::StaticOrder, true, true>(lds, g, S, E);
    bf16_t* K1 = (bf16_t*)(ws + WS_K1); bf16_t* V1 = (bf16_t*)(ws + WS_V1);
    small_gemm((const bf16_t*)(ws + WS_H1) + (size_t)ML * D, D, (const bf16_t*)(ws + WS_W3T), D, D, MC, 1024,
               [=](int m, int n, float v) { if (n < 512) K1[(size_t)(ML + m) * 512 + n] = f2bf(v); else V1[(size_t)(ML + m) * 512 + (n - 512)] = f2bf(v); }); })
  PH(15, attn_phase((bf16_t*)(ws + WS_Q1), (const bf16_t*)(ws + WS_K1), (const bf16_t*)(ws + WS_V1), (const bf16_t*)(ws + WS_G1), p.in[24], p.in[22], p.in[23], lds, wr))
  PH(16, {
    pg8::Gemm g{(const bf16_t*)(ws + WS_Q1), (const bf16_t*)(ws + WS_W4T), ML, D, 2048}; pg8::StaticOrder S; S.init(ML, D, gridDim.x, (int)blockIdx.x);
    pg8::EpiResid E{X1, p.out, MOD + 3 * 3072, wr};
    pg8::gemm_phase<pg8::EpiResid, pg8::StaticOrder, true, true>(lds, g, S, E); })
#undef PH
#undef IN
#undef SEAM
}
extern "C" void kernel_launch(void* const* d_in, const int* in_sizes, int n_in, void* d_out, int out_size, void* d_ws, size_t ws_size, hipStream_t stream) {
  static int grid_blocks = 0;
  if (!grid_blocks) {
    int dev = 0, cus = 0, per_cu = 0;
    hipGetDevice(&dev);
    hipDeviceGetAttribute(&cus, hipDeviceAttributeMultiprocessorCount, dev);
    hipFuncSetAttribute((const void*)mega, hipFuncAttributeMaxDynamicSharedMemorySize, LDS_BYTES);
    hipOccupancyMaxActiveBlocksPerMultiprocessor(&per_cu, (const void*)mega, NWAVES * 64, LDS_BYTES);
    if (per_cu < 1) { fprintf(stderr, "kernel_launch: occupancy query says %d blocks per CU\n", per_cu); per_cu = 1; }
    if (per_cu > 1) per_cu = 1;
    grid_blocks = cus * per_cu;
  }
  hipMemsetAsync((char*)d_ws + WS_CTL, 0, 64 * 1024, stream);
  Params base{};
  for (int i = 0; i < 26; ++i) base.in[i] = (const float*)d_in[i];
  base.out = (float*)d_out; base.ws = (unsigned char*)d_ws;
  auto launch = [&](int lo, int hi) {
    Params p = base; p.ph_lo = lo; p.ph_hi = hi; p.rep = (int)PROBE_MASK; void* args[] = {&p};
    hipError_t e = hipLaunchCooperativeKernel((const void*)mega, dim3(grid_blocks), dim3(NWAVES * 64), args, LDS_BYTES, stream);
    if (e != hipSuccess) fprintf(stderr, "cooperative launch failed: %s (grid %d)\n", hipGetErrorString(e), grid_blocks);
  };
  launch(0, 17);
}
```

```cpp
#include <hip/hip_runtime.h>
#include <hip/hip_cooperative_groups.h>
#include <stdint.h>
#include <math.h>
#include <cstdio>
namespace cg = cooperative_groups;
#ifndef PROBE_SKIP
#define PROBE_SKIP 0
#endif
#ifndef PROBE_MASK
#define PROBE_MASK 0u
#endif

typedef unsigned short bf16_t;
#define DEV __device__ __forceinline__

DEV float bf2f(bf16_t v) { return __uint_as_float(((unsigned)v) << 16); }
typedef float f32x2_t __attribute__((ext_vector_type(2))); typedef __bf16 bf16x2_t __attribute__((ext_vector_type(2)));
DEV unsigned pk2(float lo, float hi) { const f32x2_t v = {lo, hi}; const bf16x2_t b = __builtin_convertvector(v, bf16x2_t); return __builtin_bit_cast(unsigned, b); }
DEV bf16_t f2bf(float f) { return (bf16_t)(pk2(f, 0.f) & 0xffffu); }
DEV float fexp(float x) { return __builtin_amdgcn_exp2f(x * 1.4426950408889634f); }
DEV float siluf(float x) { return x / (1.f + fexp(-x)); }
DEV float silu_fast(float x) { return x * __builtin_amdgcn_rcpf(1.f + fexp(-x)); }
DEV float softplusf(float x) { return x > 20.f ? x : log1pf(fexp(x)); }
DEV float logsigmoidf(float x) { return fminf(x, 0.f) - log1pf(fexp(-fabsf(x))); }

constexpr int D = 1024, NB = 2, SEQ = 8192, CTXL = 256;
constexpr int ML = NB * SEQ;
constexpr int MC = NB * CTXL;
constexpr int MA = ML + MC;
constexpr int NCH = MA / 128;
constexpr int E_IN = 5696, O_IN = 5120, E_INP = 5888;
constexpr float EPS = 1e-6f;

constexpr size_t MiB = 1u << 20;
constexpr int CW_CSQ = 8192;
constexpr size_t WS_CTL = 0;
constexpr size_t WS_MOD = 1 * MiB;
constexpr size_t WS_ROPE = 1 * MiB + 128 * 1024;
constexpr size_t WS_SDEC = 1 * MiB + 256 * 1024;
constexpr size_t WS_GDEC = 1 * MiB + 384 * 1024;
constexpr size_t WS_W1T = 2 * MiB;
constexpr size_t WS_W2T = 14 * MiB;
constexpr size_t WS_W3T = 18 * MiB;
constexpr size_t WS_W4T = 28 * MiB;
constexpr size_t WS_Y0 = 32 * MiB;
constexpr size_t WS_Q0 = 98 * MiB;
constexpr size_t WS_K0 = WS_Q0 + 16 * MiB + 512 * 1024;
constexpr size_t WS_V0 = 131 * MiB;
constexpr size_t WS_DTLR = 164 * MiB;
constexpr size_t WS_XC1 = 168 * MiB + 512 * 1024;
constexpr size_t WS_XBC = 171 * MiB;
constexpr size_t WS_STATE = 171 * MiB;
constexpr size_t WS_TAIL = 237 * MiB;
constexpr size_t WS_H1 = 32 * MiB;
constexpr size_t WS_K1 = 65 * MiB;
constexpr size_t WS_V1 = 81 * MiB + 512 * 1024;
constexpr size_t WS_Q1 = 98 * MiB;
constexpr size_t WS_G1 = 171 * MiB;

DEV int row_vec(int row) { return row < ML ? (row / SEQ) : 2; }

namespace pg8 {
#define PG8_LAS __attribute__((address_space(3)))
typedef unsigned short bf16_t;
typedef short bf16x8 __attribute__((ext_vector_type(8)));
typedef float f32x4 __attribute__((ext_vector_type(4)));
typedef unsigned u32x4 __attribute__((ext_vector_type(4)));
constexpr int BM = 256, BK = 64, HALF = 128, HTB = HALF * BK * 2  , STAGE_BYTES = 8 * HTB, NXCD = 8, WGM = 8;

__host__ __device__ __forceinline__ int lds_byte(int r, int c) { const int st = (r >> 4) * 2 + (c >> 5), rr = r & 15, cc = c & 31, ob = rr * 64 + cc * 2; return st * 1024 + (ob ^ (((ob >> 9) & 1) << 5)); }
__host__ __device__ __forceinline__ void stage_rc(int b, int& R, int& C) { const int st = b / 1024, sb = b % 1024, swz = sb ^ (((sb >> 9) & 1) << 5); R = (st >> 1) * 16 + swz / 64; C = (st & 1) * 32 + (swz % 64) / 2; }
__host__ __device__ __forceinline__ int perm32(int rho) { const int n = rho >> 4, i = rho & 15; return 8 * (i >> 2) + 4 * n + (i & 3); }

struct Unit { int pm, pn; };
struct Gemm { const bf16_t* A; const bf16_t* Bt; int M, N, K; };

struct StaticOrder {
    int nM, nN, nwg, G, c;
    __host__ __device__ void init(int M, int N, int G_, int c_) { nM = M / BM; nN = N / BM; nwg = nM * nN; G = G_; c = c_; }
    __host__ __device__ bool next(int i, Unit& u) const {
        const long L = (long)i * G + c; if (L >= nwg) return false;
        int wgid = (int)L; { const int q = nwg / NXCD, r = nwg % NXCD, xcd = wgid % NXCD, off = wgid / NXCD; wgid = (xcd < r ? xcd * (q + 1) : r * (q + 1) + (xcd - r) * q) + off; }
        const int nig = WGM * nN, gid = wgid / nig, fm = gid * WGM, gsz = (nM - fm) < WGM ? (nM - fm) : WGM;
        u.pm = fm + ((wgid % nig) % gsz); u.pn = (wgid % nig) / gsz; return true;
    }
    __device__ __forceinline__ void a_ready(const Unit&) const {}
    __device__ __forceinline__ void done(const Unit&) const {}
};
__device__ __forceinline__ unsigned cvt_pk_bf16(float lo, float hi) { unsigned r; asm volatile("v_cvt_pk_bf16_f32 %0, %1, %2" : "=v"(r) : "v"(lo), "v"(hi)); return r; }
__device__ __forceinline__ float silu_e(float x) { return x * __builtin_amdgcn_rcpf(1.f + fexp(-x)); }

__device__ __forceinline__ void store_unit_bf16(const f32x4 (&acc)[2][2][4][2], bf16_t* base, int ld, int colt, bool act, const Unit& u, int wr, int wc, int fr, int fq) {
    const int row0 = u.pm * BM + wr * 64 + fr; const int col0 = colt + wc * 32 + 8 * fq;
#pragma unroll
    for (int ai = 0; ai < 2; ++ai)
#pragma unroll
        for (int m = 0; m < 4; ++m) { bf16_t* rowp = base + (size_t)(row0 + ai * HALF + m * 16) * ld + col0;
#pragma unroll
            for (int bj = 0; bj < 2; ++bj) { f32x4 v0 = acc[ai][bj][m][0], v1 = acc[ai][bj][m][1];
                if (act) { v0 = (f32x4){silu_e(v0[0]), silu_e(v0[1]), silu_e(v0[2]), silu_e(v0[3])}; v1 = (f32x4){silu_e(v1[0]), silu_e(v1[1]), silu_e(v1[2]), silu_e(v1[3])}; }
                u32x4 w; w.x = cvt_pk_bf16(v0[0], v0[1]); w.y = cvt_pk_bf16(v0[2], v0[3]); w.z = cvt_pk_bf16(v1[0], v1[1]); w.w = cvt_pk_bf16(v1[2], v1[3]);
                *(u32x4*)(rowp + bj * HALF) = w; } }
}
struct EpiProj0 {
    static constexpr bool PERM = true, AFTER_DRAIN = false;
    bf16_t *Y0, *XBC, *Q0, *K0, *V0; float* DTLR;
    __device__ __forceinline__ void operator()(const f32x4 (&acc)[2][2][4][2], const Unit& u, int wr, int wc, int fr, int fq) const {
        const int pn = u.pn;
        if (pn == 22) {
            if (wc < 2) { const int row0 = u.pm * BM + wr * 64 + fr;
#pragma unroll
                for (int ai = 0; ai < 2; ++ai)
#pragma unroll
                    for (int m = 0; m < 4; ++m) { float* rp = DTLR + (size_t)(row0 + ai * HALF + m * 16) * 64 + wc * 32 + 8 * fq; *(f32x4*)rp = acc[ai][0][m][0]; *(f32x4*)(rp + 4) = acc[ai][0][m][1]; } }
            return;
        }
        bf16_t* base; int ld, colt; bool act = false;
        if (pn < 8) { base = Y0; ld = 2048; colt = pn * 256; act = true; }
        else if (pn < 14) { base = XBC; ld = 1536; colt = (pn - 8) * 256; }
        else if (pn < 16) { base = Q0; ld = 512; colt = (pn - 14) * 256; }
        else if (pn < 18) { base = K0; ld = 512; colt = (pn - 16) * 256; }
        else { base = V0; ld = 1024; colt = (pn - 18) * 256; }
        store_unit_bf16(acc, base, ld, colt, act, u, wr, wc, fr, fq);
    }
};
struct EpiProj1 {
    static constexpr bool PERM = true, AFTER_DRAIN = false;
    bf16_t *K1, *V1, *Q1, *G1; const float *qn, *kn, *rope; PG8_LAS float* part;
    __device__ __forceinline__ void operator()(const f32x4 (&acc)[2][2][4][2], const Unit& u, int wr, int wc, int fr, int fq) const {
        const int pn = u.pn; bf16_t* base; int ld, colt; bool act = false;
        if (pn < 2) { base = K1; ld = 512; colt = pn * 256; }
        else if (pn < 4) { base = V1; ld = 512; colt = (pn - 2) * 256; }
        else if (pn < 12) { base = Q1; ld = 2048; colt = (pn - 4) * 256; }
        else { base = G1; ld = 2048; colt = (pn - 12) * 256; act = true; }
        const bool isk = pn < 2, isq = pn >= 4 && pn < 12;
        if (!(isk || isq)) { store_unit_bf16(acc, base, ld, colt, act, u, wr, wc, fr, fq); return; }
#pragma unroll
        for (int ai = 0; ai < 2; ++ai)
#pragma unroll
            for (int m = 0; m < 4; ++m)
#pragma unroll
                for (int bj = 0; bj < 2; ++bj) { const f32x4 x0 = acc[ai][bj][m][0], x1 = acc[ai][bj][m][1];
                    float s = (x0[0] * x0[0] + x0[1] * x0[1]) + (x0[2] * x0[2] + x0[3] * x0[3]) + (x1[0] * x1[0] + x1[1] * x1[1]) + (x1[2] * x1[2] + x1[3] * x1[3]);
                    s += __shfl_xor(s, 16); s += __shfl_xor(s, 32);
                    if (fq == 0) part[(ai * HALF + wr * 64 + m * 16 + fr) * 8 + bj * 4 + wc] = s; }
        asm volatile("s_waitcnt lgkmcnt(0)" ::: "memory"); __builtin_amdgcn_s_barrier(); asm volatile("" ::: "memory");
        const int a = wc >> 1, f0 = 16 * (wc & 1) + 4 * fq;
        const float* gn = (isq ? qn : kn) + a * 64 + f0;
        const f32x4 g0 = *(const f32x4*)gn, g1 = *(const f32x4*)(gn + 32);
        const float osc = isq ? 0.08838834764831845f * 1.4426950408889634f : 1.f;
        const int col0 = colt + wc * 32 + 8 * fq;
        f32x4 w_[2][2][4][2];
#pragma unroll
        for (int ai = 0; ai < 2; ++ai)
#pragma unroll
            for (int bj = 0; bj < 2; ++bj)
#pragma unroll
                for (int m = 0; m < 4; ++m) { w_[ai][bj][m][0] = acc[ai][bj][m][0]; w_[ai][bj][m][1] = acc[ai][bj][m][1]; }
#pragma unroll 1
        for (int m = 0; m < 4; ++m) {
#pragma unroll
            for (int ai = 0; ai < 2; ++ai) { const int rowl = ai * HALF + wr * 64 + m * 16 + fr, row = u.pm * BM + rowl, t = row & 8191, pos = a ? (t & 63) : (t >> 6);
                const f32x4 cs = *(const f32x4*)(rope + pos * 32 + f0), sn = *(const f32x4*)(rope + 4096 + pos * 32 + f0);
                bf16_t* rowp = base + (size_t)row * ld + col0;
#pragma unroll
                for (int bj = 0; bj < 2; ++bj) { const f32x4 p4 = *(const PG8_LAS f32x4*)(part + rowl * 8 + bj * 4);
                    const float rstd = __builtin_amdgcn_rsqf(((p4[0] + p4[1]) + (p4[2] + p4[3])) * (1.f / 128.f) + 1e-6f) * osc;
                    const f32x4 t1 = w_[ai][bj][0][0] * g0 * rstd, t2 = w_[ai][bj][0][1] * g1 * rstd;
                    const f32x4 o1 = t1 * cs - t2 * sn, o2 = t2 * cs + t1 * sn;
                    u32x4 w; w.x = cvt_pk_bf16(o1[0], o1[1]); w.y = cvt_pk_bf16(o1[2], o1[3]); w.z = cvt_pk_bf16(o2[0], o2[1]); w.w = cvt_pk_bf16(o2[2], o2[3]);
                    *(u32x4*)(rowp + bj * HALF) = w; } }
#pragma unroll
            for (int ai = 0; ai < 2; ++ai)
#pragma unroll
                for (int bj = 0; bj < 2; ++bj)
#pragma unroll
                    for (int n = 0; n < 2; ++n) { w_[ai][bj][0][n] = w_[ai][bj][1][n]; w_[ai][bj][1][n] = w_[ai][bj][2][n]; w_[ai][bj][2][n] = w_[ai][bj][3][n]; }
        }
    }
};
struct EpiResid {
    static constexpr bool PERM = false, AFTER_DRAIN = false;
    const float* res; float* out; const float* mod; bool do_store;
    __device__ __forceinline__ void operator()(const f32x4 (&acc)[2][2][4][2], const Unit& u, int wr, int wc, int fr, int fq) const {
        const int b = (u.pm * BM) / 8192; const float* gate = mod + b * 3072 + 2048;
        const int col0 = u.pn * BM + wc * 32 + 4 * fq;
        f32x4 gv[2][2];
#pragma unroll
        for (int bj = 0; bj < 2; ++bj)
#pragma unroll
            for (int n = 0; n < 2; ++n) gv[bj][n] = *(const f32x4*)(gate + col0 + bj * HALF + n * 16);
#pragma unroll
        for (int ai = 0; ai < 2; ++ai)
#pragma unroll
            for (int m = 0; m < 4; ++m) { const size_t off = (size_t)(u.pm * BM + ai * HALF + wr * 64 + m * 16 + fr) * 1024 + col0;
#pragma unroll
                for (int bj = 0; bj < 2; ++bj)
#pragma unroll
                    for (int n = 0; n < 2; ++n) { const f32x4 r = *(const f32x4*)(res + off + bj * HALF + n * 16); const f32x4 ov_ = r + gv[bj][n] * acc[ai][bj][m][n]; if (do_store) *(f32x4*)(out + off + bj * HALF + n * 16) = ov_; } }
    }
};
template <class Epi, class Sched, bool ALIGN_EPI = false, bool SP2 = false>
__device__ __forceinline__ void gemm_phase(PG8_LAS unsigned char* lds, const Gemm g, const Sched& S, const Epi& E) {
    const int tid = threadIdx.x, wid = __builtin_amdgcn_readfirstlane(tid >> 6), lane = tid & 63, wr = wid >> 2, wc = wid & 3, fr = lane & 15, fq = lane >> 4;
    const int K = g.K, nt = K / BK;
    unsigned voffA[2], voffB[2];
#pragma unroll
    for (int i = 0; i < 2; ++i) { int R, C; stage_rc(tid * 16 + i * 8192, R, C); const int Rb = Epi::PERM ? ((R & ~31) + perm32(R & 31)) : R;
        voffA[i] = (unsigned)(R * K + C) * 2u; voffB[i] = (unsigned)(Rb * K + C) * 2u; }
    const size_t kstep = (size_t)(BK * 2);
    const size_t hstep = (size_t)HALF * K * 2;
    const size_t tstep = 2 * hstep;
    const unsigned ldsw = (unsigned)wid * 1024u;
    const int aoff = lds_byte(wr * 64 + fr, fq * 8), boff = lds_byte(wc * 32 + fr, fq * 8);
#define PG8_SA(b, h) (((b) * 2 + (h)) * HTB)
#define PG8_SB(b, h) ((4 + (b) * 2 + (h)) * HTB)
#define PG8_STAGE(bufoff, gbase, voff) do { _Pragma("unroll") for (int _i = 0; _i < 2; ++_i) \
        __builtin_amdgcn_global_load_lds((const unsigned*)((const char*)(gbase) + (voff)[_i]), (PG8_LAS unsigned*)(lds + (bufoff) + ldsw + _i * 8192), 16, 0, 0); } while (0)
#define PG8_LDA(dst, b, h) do { _Pragma("unroll") for (int m = 0; m < 4; ++m) _Pragma("unroll") for (int k = 0; k < 2; ++k) dst[m][k] = *(const PG8_LAS bf16x8*)(lds + PG8_SA(b, h) + aoff + m * 2048 + k * 1024); } while (0)
#define PG8_LDB(dst, b, h) do { _Pragma("unroll") for (int n = 0; n < 2; ++n) _Pragma("unroll") for (int k = 0; k < 2; ++k) dst[n][k] = *(const PG8_LAS bf16x8*)(lds + PG8_SB(b, h) + boff + n * 2048 + k * 1024); } while (0)
#define PG8_MMA(ai, bj, At, Bt) do { __builtin_amdgcn_s_setprio(1); _Pragma("unroll") for (int m = 0; m < 4; ++m) _Pragma("unroll") for (int n = 0; n < 2; ++n) _Pragma("unroll") for (int k = 0; k < 2; ++k) \
        acc[ai][bj][m][n] = __builtin_amdgcn_mfma_f32_16x16x32_bf16(Bt[n][k], At[m][k], acc[ai][bj][m][n], 0, 0, 0); __builtin_amdgcn_s_setprio(0); } while (0)
#define PG8_WAIT_V(n) asm volatile("s_waitcnt vmcnt(" #n ")" ::: "memory")
#define PG8_WAIT_L(n) asm volatile("s_waitcnt lgkmcnt(" #n ")" ::: "memory")
#define PG8_BAR __builtin_amdgcn_s_barrier()
#define PG8_SCHED __builtin_amdgcn_sched_barrier(0)
    Unit cur, nxt; int ui = 0;
    if (!S.next(0, cur)) return;
    f32x4 acc[2][2][4][2];
#pragma unroll
    for (int a = 0; a < 2; ++a)
#pragma unroll
        for (int b = 0; b < 2; ++b)
#pragma unroll
            for (int m = 0; m < 4; ++m)
#pragma unroll
                for (int n = 0; n < 2; ++n) acc[a][b][m][n] = (f32x4){0.f, 0.f, 0.f, 0.f};
    bf16x8 At[4][2], B0[2][2], B1[2][2];
    const char* cA = (const char*)g.A + (size_t)cur.pm * tstep; const char* cB = (const char*)g.Bt + (size_t)cur.pn * tstep;
    S.a_ready(cur);
    if constexpr (SP2) {
        PG8_STAGE(PG8_SB(0, 0), cB, voffB); PG8_STAGE(PG8_SB(0, 1), cB + hstep, voffB); PG8_STAGE(PG8_SA(0, 0), cA, voffA); PG8_STAGE(PG8_SA(0, 1), cA + hstep, voffA);
        if (wr == 1) PG8_BAR;
        PG8_WAIT_V(2); PG8_BAR;
        PG8_STAGE(PG8_SB(1, 0), cB + kstep, voffB); PG8_STAGE(PG8_SA(1, 0), cA + kstep, voffA); PG8_STAGE(PG8_SB(1, 1), cB + hstep + kstep, voffB);
        PG8_WAIT_V(6); PG8_BAR;
    } else {
        PG8_STAGE(PG8_SB(0, 0), cB, voffB); PG8_STAGE(PG8_SA(0, 0), cA, voffA); PG8_STAGE(PG8_SB(0, 1), cB + hstep, voffB); PG8_STAGE(PG8_SA(0, 1), cA + hstep, voffA);
        if (wr == 1) PG8_BAR;
        PG8_WAIT_V(4); PG8_BAR;
        PG8_STAGE(PG8_SB(1, 0), cB + kstep, voffB); PG8_STAGE(PG8_SA(1, 0), cA + kstep, voffA); PG8_STAGE(PG8_SB(1, 1), cB + hstep + kstep, voffB);
        PG8_WAIT_V(6); PG8_BAR;
    }
    for (;;) {
        const bool has_next = S.next(ui + 1, nxt);
        const char* nA = has_next ? (const char*)g.A + (size_t)nxt.pm * tstep : cA; const char* nB = has_next ? (const char*)g.Bt + (size_t)nxt.pn * tstep : cB;
        for (int t = 0; t < nt; t += 2) {
            const bool last = (t == nt - 2);
            const char* a1 = cA + (size_t)(t + 1) * kstep;
            const char* a2 = last ? nA : cA + (size_t)(t + 2) * kstep; const char* b2 = last ? nB : cB + (size_t)(t + 2) * kstep;
            const char* a3 = a2 + kstep; const char* b3 = b2 + kstep;
            if (last && has_next) S.a_ready(nxt);
            if constexpr (SP2) {
            PG8_LDB(B0, 0, 0); PG8_LDB(B1, 0, 1); PG8_SCHED; PG8_LDA(At, 0, 0); PG8_STAGE(PG8_SA(1, 1), a1 + hstep, voffA);
            PG8_WAIT_V(8); PG8_WAIT_L(0); PG8_BAR; PG8_MMA(0, 0, At, B0); PG8_MMA(0, 1, At, B1); PG8_BAR; PG8_SCHED;
            PG8_LDA(At, 0, 1); PG8_STAGE(PG8_SB(0, 0), b2, voffB); PG8_STAGE(PG8_SB(0, 1), b2 + hstep, voffB); PG8_STAGE(PG8_SA(0, 0), a2, voffA);
            PG8_WAIT_V(8); PG8_WAIT_L(0); PG8_BAR; PG8_MMA(1, 0, At, B0); PG8_MMA(1, 1, At, B1); PG8_BAR; PG8_SCHED;
            PG8_LDB(B0, 1, 0); PG8_LDB(B1, 1, 1); PG8_SCHED; PG8_LDA(At, 1, 0); PG8_STAGE(PG8_SA(0, 1), a2 + hstep, voffA);
            PG8_WAIT_V(8); PG8_WAIT_L(0); PG8_BAR; PG8_MMA(0, 0, At, B0); PG8_MMA(0, 1, At, B1); PG8_BAR; PG8_SCHED;
            PG8_LDA(At, 1, 1); PG8_STAGE(PG8_SB(1, 0), b3, voffB); PG8_STAGE(PG8_SB(1, 1), b3 + hstep, voffB); PG8_STAGE(PG8_SA(1, 0), a3, voffA);
            PG8_WAIT_V(8); PG8_WAIT_L(0); PG8_BAR; PG8_MMA(1, 0, At, B0); PG8_MMA(1, 1, At, B1); PG8_BAR; PG8_SCHED;
            } else {
            PG8_LDB(B0, 0, 0); PG8_SCHED; PG8_LDA(At, 0, 0); PG8_STAGE(PG8_SA(1, 1), a1 + hstep, voffA);
            PG8_WAIT_L(8); PG8_BAR; PG8_WAIT_L(0); PG8_MMA(0, 0, At, B0); PG8_BAR; PG8_SCHED;
            PG8_LDB(B1, 0, 1); PG8_STAGE(PG8_SB(0, 0), b2, voffB);
            PG8_BAR; PG8_WAIT_L(0); PG8_MMA(0, 1, At, B1); PG8_BAR;
            PG8_LDA(At, 0, 1); PG8_STAGE(PG8_SA(0, 0), a2, voffA);
            PG8_BAR; PG8_WAIT_L(0); PG8_MMA(1, 0, At, B0); PG8_BAR; PG8_SCHED;
            PG8_STAGE(PG8_SB(0, 1), b2 + hstep, voffB);
            PG8_WAIT_V(6); PG8_BAR; PG8_MMA(1, 1, At, B1); PG8_BAR;
            PG8_LDB(B0, 1, 0); PG8_SCHED; PG8_LDA(At, 1, 0); PG8_STAGE(PG8_SA(0, 1), a2 + hstep, voffA);
            PG8_WAIT_L(8); PG8_BAR; PG8_WAIT_L(0); PG8_MMA(0, 0, At, B0); PG8_BAR; PG8_SCHED;
            PG8_LDB(B1, 1, 1); PG8_STAGE(PG8_SB(1, 0), b3, voffB);
            PG8_BAR; PG8_WAIT_L(0); PG8_MMA(0, 1, At, B1); PG8_BAR;
            PG8_LDA(At, 1, 1); PG8_STAGE(PG8_SA(1, 0), a3, voffA);
            PG8_BAR; PG8_WAIT_L(0); PG8_MMA(1, 0, At, B0); PG8_BAR; PG8_SCHED;
            PG8_STAGE(PG8_SB(1, 1), b3 + hstep, voffB);
            PG8_WAIT_V(6); PG8_BAR; PG8_MMA(1, 1, At, B1); PG8_BAR;
            }
        }
        if constexpr (ALIGN_EPI) { if (wr == 0) PG8_BAR; }
        if constexpr (!Epi::AFTER_DRAIN) { E(acc, cur, wr, wc, fr, fq); S.done(cur); }
        if (!has_next) break;
#pragma unroll
        for (int a = 0; a < 2; ++a)
#pragma unroll
            for (int b = 0; b < 2; ++b)
#pragma unroll
                for (int m = 0; m < 4; ++m)
#pragma unroll
                    for (int n = 0; n < 2; ++n) acc[a][b][m][n] = (f32x4){0.f, 0.f, 0.f, 0.f};
        cur = nxt; cA = nA; cB = nB; ++ui;
        if constexpr (ALIGN_EPI) { if (wr == 1) PG8_BAR; }
    }
    PG8_WAIT_V(0);
    if constexpr (!ALIGN_EPI) { if (wr == 0) PG8_BAR; }
    PG8_BAR;
    if constexpr (Epi::AFTER_DRAIN) { E.fused(acc, cur, wr, wc, fr, fq, lds, wid, lane); S.done(cur); }
#undef PG8_SA
#undef PG8_SB
#undef PG8_STAGE
#undef PG8_LDA
#undef PG8_LDB
#undef PG8_MMA
#undef PG8_WAIT_V
#undef PG8_WAIT_L
#undef PG8_BAR
#undef PG8_SCHED
}
}
#define LAS __attribute__((address_space(3)))
typedef unsigned v4u __attribute__((ext_vector_type(4)));
typedef float f32x4 __attribute__((ext_vector_type(4)));
typedef short bf16x8 __attribute__((ext_vector_type(8)));
#define LDS_WAIT() asm volatile("s_waitcnt lgkmcnt(0)" ::: "memory")
constexpr int NWAVES = 8;
constexpr int LDS_BYTES = 147456;
constexpr int MISC_OFF = 147456 - 128;

struct Params { const float* in[26]; float* out; unsigned char* ws; int ph_lo, ph_hi, rep, pad; };

DEV int virt_block() { const int G = (int)gridDim.x, b = (int)blockIdx.x; return (G % 8 == 0) ? (b % 8) * (G / 8) + b / 8 : b; }
DEV float wave_sum(float v) {
#pragma unroll
  for (int o = 1; o < 64; o <<= 1) v += __shfl_xor(v, o);
  return v;
}

DEV int w1_dest_row(int n) {
  if (n < 1024) return n;
  if (n < 2560) return 2048 + (n - 1024);
  if (n < 2592) return 5632 + (n - 2560);
  if (n < 3104) return 3584 + (n - 2592);
  if (n < 3616) return 4096 + (n - 3104);
  if (n < 4640) return 4608 + (n - 3616);
  if (n < 5664) return 1024 + (n - 4640);
  return n;
}
DEV int qk_pos(int d) { const int a = d >> 6, s = (d >> 5) & 1, f = d & 31; return 32 * (2 * a + (f >> 4)) + 8 * ((f >> 2) & 3) + 4 * s + (f & 3); }
DEV void transpose_item(const float* W, int K, int N, int k0, int n0, bf16_t* WT, int drow0, LAS float* scr, int lane, int headbase = -1) {
#pragma unroll 8
  for (int i = 0; i < 32; ++i) { const int kk = 2 * i + (lane >> 5); scr[kk * 33 + (lane & 31)] = W[(size_t)(k0 + kk) * N + n0 + (lane & 31)]; }
  LDS_WAIT(); asm volatile("" ::: "memory");
  const int c = lane & 7;
#pragma unroll
  for (int j = 0; j < 4; ++j) { const int n = (lane >> 3) + 8 * j; const LAS float* s = scr + (8 * c) * 33 + n;
    v4u o; o.x = pk2(s[0 * 33], s[1 * 33]); o.y = pk2(s[2 * 33], s[3 * 33]); o.z = pk2(s[4 * 33], s[5 * 33]); o.w = pk2(s[6 * 33], s[7 * 33]);
    const int drow = headbase >= 0 ? headbase + qk_pos((n0 & 127) + n) : drow0 + n;
    *(v4u*)(WT + (size_t)drow * K + k0 + 8 * c) = o; }
  LDS_WAIT(); asm volatile("" ::: "memory");
}
DEV void prologue_phase(const Params& p, LAS unsigned char* lds) {
  const int tid = threadIdx.x, lane = tid & 63, wave = tid >> 6;
  unsigned char* ws = p.ws;
  float* MOD = (float*)(ws + WS_MOD);
  {
    LAS float* sc = (LAS float*)lds;
    LAS float* part = (LAS float*)(lds + 12288);
    for (int i = tid; i < 3072; i += 512) { const int v = i >> 10, k = i & 1023; const float cv = v < 2 ? p.in[1][v * 1024 + k] : p.in[3][k]; sc[i] = siluf(cv); }
    __syncthreads();
    for (int task = blockIdx.x; task < 96; task += gridDim.x) {
      const int l = task / 48, n0 = (task % 48) * 64; const float* w = l ? p.in[19] : p.in[5]; const float* bb = l ? p.in[20] : p.in[6];
      const int col = tid & 63, ks = tid >> 6;
      float a0 = 0.f, a1 = 0.f, a2 = 0.f;
#pragma unroll 8
      for (int k = ks * 128; k < ks * 128 + 128; ++k) { const float wv = w[(size_t)k * 3072 + n0 + col]; a0 += sc[k] * wv; a1 += sc[1024 + k] * wv; a2 += sc[2048 + k] * wv; }
      part[(ks * 3 + 0) * 64 + col] = a0; part[(ks * 3 + 1) * 64 + col] = a1; part[(ks * 3 + 2) * 64 + col] = a2;
      __syncthreads();
      if (tid < 192) { const int v = tid >> 6; float s = bb[n0 + col];
#pragma unroll
        for (int q = 0; q < 8; ++q) s += part[(q * 3 + v) * 64 + col];
        MOD[(l * 3 + v) * 3072 + n0 + col] = s; }
      __syncthreads();
    }
  }
  if (blockIdx.x == gridDim.x - 1) { float* rope = (float*)(ws + WS_ROPE);
    for (int idx = tid; idx < 4096; idx += 512) { const int pos = idx >> 5, f = idx & 31; const float inv = 1.0f / powf(10000.f, (float)f / 32.f); const float ang = (float)pos * inv; rope[idx] = cosf(ang); rope[4096 + idx] = sinf(ang); } }
  { v4u* z = (v4u*)(ws + WS_W1T + (size_t)E_IN * 1024 * 2); const v4u zero = {0u, 0u, 0u, 0u};
    for (int i = blockIdx.x * 512 + tid; i < (E_INP - E_IN) * 1024 * 2 / 16; i += gridDim.x * 512) z[i] = zero; }
  __syncthreads();
  {
    LAS float* scr = (LAS float*)(lds + wave * 16384);
    const int gw = blockIdx.x * NWAVES + wave, NGW = gridDim.x * NWAVES;
    constexpr int I1 = 16 * 178;
    for (int it = gw; it < I1; it += NGW) { const int kb = it / 178, nb = it % 178; transpose_item(p.in[7], 1024, E_IN, 64 * kb, 32 * nb, (bf16_t*)(ws + WS_W1T), w1_dest_row(32 * nb), scr, lane); }
  }
}
DEV void late_weights(const Params& p, LAS unsigned char* lds, int vblock, int nvblocks) {
  const int lane = threadIdx.x & 63, wave = threadIdx.x >> 6; unsigned char* ws = p.ws;
  LAS float* scr = (LAS float*)(lds + wave * 16384);
  constexpr int I2 = 32 * 32, I3 = 16 * 160, I4 = 32 * 32;
  for (int it = vblock * NWAVES + wave; it < I2 + I3 + I4; it += nvblocks * NWAVES) {
    int r = it;
    if (r < I2) { const int kb = r / 32, nb = r % 32; transpose_item(p.in[17], 2048, 1024, 64 * kb, 32 * nb, (bf16_t*)(ws + WS_W2T), 32 * nb, scr, lane); continue; } r -= I2;
    if (r < I3) { const int kb = r / 160, nb = r % 160, n0 = 32 * nb; const bool qk = n0 < 512 || (n0 >= 1024 && n0 < 3072);
      transpose_item(p.in[21], 1024, O_IN, 64 * kb, n0, (bf16_t*)(ws + WS_W3T), n0, scr, lane, qk ? (n0 & ~127) : -1); continue; } r -= I3;
    { const int kb = r / 32, nb = r % 32; transpose_item(p.in[25], 2048, 1024, 64 * kb, 32 * nb, (bf16_t*)(ws + WS_W4T), 32 * nb, scr, lane); }
  }
}
DEV void prep_phase(const float* xlat, const float* xctx, const float* g, const float* mod, bf16_t* H) {
  const int lane = threadIdx.x & 63, wave = threadIdx.x >> 6;
  for (int row = blockIdx.x * NWAVES + wave; row < MA; row += gridDim.x * NWAVES) {
    const float* src = row < ML ? xlat + (size_t)row * D : xctx + (size_t)(row - ML) * D;
    const float* m = mod + row_vec(row) * 3072;
    f32x4 v[4]; float ss = 0.f;
#pragma unroll
    for (int j = 0; j < 4; ++j) { v[j] = *(const f32x4*)(src + 4 * lane + 256 * j); ss += (v[j].x * v[j].x + v[j].y * v[j].y) + (v[j].z * v[j].z + v[j].w * v[j].w); }
    const float rstd = rsqrtf(wave_sum(ss) * (1.f / D) + EPS);
#pragma unroll
    for (int j = 0; j < 4; ++j) { const int k = 4 * lane + 256 * j;
      const f32x4 gg = *(const f32x4*)(g + k), sc = *(const f32x4*)(m + 1024 + k), sh = *(const f32x4*)(m + k);
      const f32x4 o = v[j] * rstd * gg * (sc + 1.f) + sh;
      *(unsigned long long*)(H + (size_t)row * D + k) = (unsigned long long)pk2(o.x, o.y) | ((unsigned long long)pk2(o.z, o.w) << 32); }
  }
}
template <class F> DEV void small_gemm(const bf16_t* A, int lda, const bf16_t* Bt, int ldb, int K, int Mrows, int Ncols, F f) {
  const int lane = threadIdx.x & 63, wid = threadIdx.x >> 6, mt = wid >> 2, nt = wid & 3, r = lane & 15, q = lane >> 4;
  const int ntn = Ncols / 64, ntasks = (Mrows / 32) * ntn;
  for (int task = blockIdx.x; task < ntasks; task += gridDim.x) {
    const int row0 = (task / ntn) * 32 + mt * 16, col0 = (task % ntn) * 64 + nt * 16;
    const bf16_t* ap = A + (size_t)(row0 + r) * lda + 8 * q; const bf16_t* bp = Bt + (size_t)(col0 + r) * ldb + 8 * q;
    f32x4 acc = {0.f, 0.f, 0.f, 0.f};
#pragma unroll 8
    for (int k = 0; k < K; k += 32) { const bf16x8 a = *(const bf16x8*)(ap + k), b = *(const bf16x8*)(bp + k); acc = __builtin_amdgcn_mfma_f32_16x16x32_bf16(a, b, acc, 0, 0, 0); }
#pragma unroll
    for (int j = 0; j < 4; ++j) f(row0 + q * 4 + j, col0 + r, acc[j]);
  }
}

template <class F> DEV void small_gemm_splitk(const bf16_t* A, int lda, const bf16_t* Bt, int ldb, int K, int Mrows, int Ncols, LAS unsigned char* lds, F f) {
  const int tid = threadIdx.x, lane = tid & 63, wid = tid >> 6, r = lane & 15, q = lane >> 4;
  LAS float* red = (LAS float*)lds;
  const int ntn = Ncols / 64, ntasks = (Mrows / 32) * ntn, kw = K / 8;
  for (int task = virt_block(); task < ntasks; task += gridDim.x) {
    const int row0 = (task / ntn) * 32, col0 = (task % ntn) * 64;
    const bf16_t* ap = A + (size_t)(row0 + r) * lda + wid * kw + 8 * q; const bf16_t* bp = Bt + (size_t)(col0 + r) * ldb + wid * kw + 8 * q;
    f32x4 acc[2][4];
#pragma unroll
    for (int mt = 0; mt < 2; ++mt)
#pragma unroll
      for (int nt = 0; nt < 4; ++nt) acc[mt][nt] = (f32x4){0.f, 0.f, 0.f, 0.f};
#pragma unroll 4
    for (int k = 0; k < kw; k += 32) {
      bf16x8 a[2], b[4];
#pragma unroll
      for (int mt = 0; mt < 2; ++mt) a[mt] = *(const bf16x8*)(ap + (size_t)(16 * mt) * lda + k);
#pragma unroll
      for (int nt = 0; nt < 4; ++nt) b[nt] = *(const bf16x8*)(bp + (size_t)(16 * nt) * ldb + k);
#pragma unroll
      for (int mt = 0; mt < 2; ++mt)
#pragma unroll
        for (int nt = 0; nt < 4; ++nt) acc[mt][nt] = __builtin_amdgcn_mfma_f32_16x16x32_bf16(a[mt], b[nt], acc[mt][nt], 0, 0, 0);
    }
    __syncthreads();
#pragma unroll
    for (int mt = 0; mt < 2; ++mt)
#pragma unroll
      for (int nt = 0; nt < 4; ++nt)
#pragma unroll
        for (int j = 0; j < 4; ++j) red[wid * 2048 + (16 * mt + 4 * q + j) * 64 + 16 * nt + r] = acc[mt][nt][j];
    __syncthreads();
#pragma unroll
    for (int o = 0; o < 4; ++o) { const int e = tid + 512 * o; float s = 0.f;
#pragma unroll
      for (int w = 0; w < 8; ++w) s += red[w * 2048 + e];
      f(row0 + (e >> 6), col0 + (e & 63), s); }
  }
}

DEV void qknorm_phase(bf16_t* Q1, bf16_t* K1, const float* qn, const float* kn, const float* rope, bool wr) {
  const int lane = threadIdx.x & 63, wave = threadIdx.x >> 6, hl = lane >> 4, d0 = (lane & 15) * 8;
  const float scale = 0.08838834764831845f * 1.4426950408889634f;
  float gq[8], gk[8];
#pragma unroll
  for (int e = 0; e < 8; ++e) { gq[e] = qn[d0 + e] * scale; gk[e] = kn[d0 + e]; }
  const int ax = d0 >> 6, sgn = (d0 >> 5) & 1, f0 = d0 & 31;
  for (int row = blockIdx.x * NWAVES + wave; row < MA; row += gridDim.x * NWAVES) {
    const bool lat = row < ML;
    v4u raw[5];
    raw[0] = *(const v4u*)(K1 + (size_t)row * 512 + hl * 128 + d0);
    if (lat) {
#pragma unroll
      for (int g = 0; g < 4; ++g) raw[1 + g] = *(const v4u*)(Q1 + (size_t)row * 2048 + (g * 4 + hl) * 128 + d0);
    }
    float cs[8], sn[8];
    if (lat) { const int t = row % SEQ, pos = ax ? (t & 63) : (t >> 6);
      const f32x4 c0 = *(const f32x4*)(rope + pos * 32 + f0), c1 = *(const f32x4*)(rope + pos * 32 + f0 + 4), s0 = *(const f32x4*)(rope + 4096 + pos * 32 + f0), s1 = *(const f32x4*)(rope + 4096 + pos * 32 + f0 + 4);
      cs[0] = c0.x; cs[1] = c0.y; cs[2] = c0.z; cs[3] = c0.w; cs[4] = c1.x; cs[5] = c1.y; cs[6] = c1.z; cs[7] = c1.w;
      sn[0] = s0.x; sn[1] = s0.y; sn[2] = s0.z; sn[3] = s0.w; sn[4] = s1.x; sn[5] = s1.y; sn[6] = s1.z; sn[7] = s1.w; }
    const int ng = lat ? 5 : 1;
#pragma unroll
    for (int g = 0; g < 5; ++g) {
      if (g < ng) {
        const v4u rv = raw[g];
        float v[8] = {__uint_as_float(rv.x << 16), __uint_as_float(rv.x & 0xffff0000u), __uint_as_float(rv.y << 16), __uint_as_float(rv.y & 0xffff0000u), __uint_as_float(rv.z << 16), __uint_as_float(rv.z & 0xffff0000u), __uint_as_float(rv.w << 16), __uint_as_float(rv.w & 0xffff0000u)};
        float ss = 0.f;
#pragma unroll
        for (int e = 0; e < 8; ++e) ss += v[e] * v[e];
        ss += __shfl_xor(ss, 1); ss += __shfl_xor(ss, 2); ss += __shfl_xor(ss, 4); ss += __shfl_xor(ss, 8);
        const float rstd = rsqrtf(ss * (1.f / 128.f) + EPS);
#pragma unroll
        for (int e = 0; e < 8; ++e) v[e] *= rstd * (g == 0 ? gk[e] : gq[e]);
        if (lat) {
#pragma unroll
          for (int e = 0; e < 8; ++e) { const float o = __shfl_xor(v[e], 4); v[e] = sgn ? (v[e] * cs[e] + o * sn[e]) : (v[e] * cs[e] - o * sn[e]); }
        }
        v4u ov; ov.x = pk2(v[0], v[1]); ov.y = pk2(v[2], v[3]); ov.z = pk2(v[4], v[5]); ov.w = pk2(v[6], v[7]);
        if (wr) { if (g == 0) *(v4u*)(K1 + (size_t)row * 512 + hl * 128 + d0) = ov; else *(v4u*)(Q1 + (size_t)row * 2048 + ((g - 1) * 4 + hl) * 128 + d0) = ov; }
      }
    }
  }
}
typedef short s16x4 __attribute__((ext_vector_type(4)));
DEV s16x4 tr_read(const LAS bf16_t* p) { return __builtin_bit_cast(s16x4, __builtin_amdgcn_ds_read_tr16_b64_v4i16((LAS s16x4*)p)); }
DEV void attn_phase(bf16_t* Q1, const bf16_t* K1, const bf16_t* V1, const bf16_t* G1, const float* sink, const float* qn, const float* kn, LAS unsigned char* lds, bool wr) {
  constexpr int KP = 136, VP = 144;
  LAS bf16_t* Ks = (LAS bf16_t*)lds;
  LAS bf16_t* Vs = (LAS bf16_t*)(lds + 2 * 64 * KP * 2);
  LAS float* dsc = (LAS float*)(lds + 2 * 64 * KP * 2 + 2 * 64 * VP * 2);
  const int tid = threadIdx.x, lane = tid & 63, wid = tid >> 6, r = lane & 15, Qd = lane >> 4;
  float mb;
  { float a = fmaxf(fabsf(qn[lane]), fabsf(qn[64 + lane])), b = fmaxf(fabsf(kn[lane]), fabsf(kn[64 + lane]));
#pragma unroll
    for (int o = 1; o < 64; o <<= 1) { a = fmaxf(a, __shfl_xor(a, o)); b = fmaxf(b, __shfl_xor(b, o)); }
    mb = a * b * 11.313708498984761f * 1.4426950408889634f; }
  for (int task = virt_block(); task < 1024; task += gridDim.x) {
    const int b = task >> 9, kvh = (task >> 7) & 3, qt = task & 127;
    const int hq = kvh * 4 + (wid >> 1), qoff = (wid & 1) * 32;
    const size_t qrow0 = (size_t)b * SEQ + qt * 64 + qoff;
    bf16x8 qf[2][4];
#pragma unroll
    for (int m = 0; m < 2; ++m)
#pragma unroll
      for (int ks = 0; ks < 4; ++ks) qf[m][ks] = *(const bf16x8*)(Q1 + (qrow0 + 16 * m + r) * 2048 + hq * 128 + ks * 32 + 8 * Qd);
    const int tlo = (2 - qt) > 0 ? (2 - qt) : 0, thi = (129 - qt) < 4 ? (129 - qt) : 4, nband = thi - tlo + 1, ntile = nband + 4;
    const int skey = tid >> 4, sch = tid & 15;
    float gk[8];
    { const int dA = ((sch >> 2) >> 1) * 64 + 16 * ((sch >> 2) & 1) + 4 * (sch & 3); const f32x4 ga = *(const f32x4*)(kn + dA), gb_ = *(const f32x4*)(kn + dA + 32);
      gk[0] = ga.x; gk[1] = ga.y; gk[2] = ga.z; gk[3] = ga.w; gk[4] = gb_.x; gk[5] = gb_.y; gk[6] = gb_.z; gk[7] = gb_.w; }
    v4u kreg[2], vreg[2];
#define TILE_ROW0(i) ((i) < nband ? (size_t)b * SEQ + (size_t)(qt - 2 + tlo + (i)) * 64 : (size_t)ML + b * CTXL + ((i) - nband) * 64)
#define LOAD_TILE(i) do { const size_t r0_ = TILE_ROW0(i); _Pragma("unroll") for (int h_ = 0; h_ < 2; ++h_) { const size_t go_ = (r0_ + skey + 32 * h_) * 512 + kvh * 128 + sch * 8; kreg[h_] = *(const v4u*)(K1 + go_); vreg[h_] = *(const v4u*)(V1 + go_); } } while (0)
#define STORE_TILE(buf, ti) do { const bool ctx_ = (ti) >= nband; _Pragma("unroll") for (int h_ = 0; h_ < 2; ++h_) { v4u kw_ = kreg[h_]; \
      if (ctx_) { float v_[8] = {__uint_as_float(kw_.x << 16), __uint_as_float(kw_.x & 0xffff0000u), __uint_as_float(kw_.y << 16), __uint_as_float(kw_.y & 0xffff0000u), __uint_as_float(kw_.z << 16), __uint_as_float(kw_.z & 0xffff0000u), __uint_as_float(kw_.w << 16), __uint_as_float(kw_.w & 0xffff0000u)}; \
        float ss_ = 0.f; _Pragma("unroll") for (int e_ = 0; e_ < 8; ++e_) ss_ += v_[e_] * v_[e_]; \
        ss_ += __shfl_xor(ss_, 1); ss_ += __shfl_xor(ss_, 2); ss_ += __shfl_xor(ss_, 4); ss_ += __shfl_xor(ss_, 8); \
        const float rs_ = rsqrtf(ss_ * (1.f / 128.f) + EPS); _Pragma("unroll") for (int e_ = 0; e_ < 8; ++e_) v_[e_] *= rs_ * gk[e_]; \
        kw_.x = pk2(v_[0], v_[1]); kw_.y = pk2(v_[2], v_[3]); kw_.z = pk2(v_[4], v_[5]); kw_.w = pk2(v_[6], v_[7]); } \
      *(LAS v4u*)(Ks + (buf) * 64 * KP + (skey + 32 * h_) * KP + sch * 8) = kw_; *(LAS v4u*)(Vs + (buf) * 64 * VP + (skey + 32 * h_) * VP + sch * 8) = vreg[h_]; } } while (0)
    LOAD_TILE(0);
    __syncthreads();
    STORE_TILE(0, 0);
    __syncthreads();
    f32x4 o[2][8];
#pragma unroll
    for (int m = 0; m < 2; ++m)
#pragma unroll
      for (int n = 0; n < 8; ++n) o[m][n] = (f32x4){0.f, 0.f, 0.f, 0.f};
    float lsum[2] = {0.f, 0.f};
    for (int i = 0; i < ntile; ++i) {
      const int buf = i & 1;
      if (i + 1 < ntile) LOAD_TILE(i + 1);
      const int mtype = (i < nband) ? ((tlo + i) == 0 ? 1 : ((tlo + i) == 4 ? 2 : 0)) : 0;
      const LAS bf16_t* Kb = Ks + buf * 64 * KP; const LAS bf16_t* Vb = Vs + buf * 64 * VP;
      f32x4 s[4][2];
#pragma unroll
      for (int t = 0; t < 4; ++t) { s[t][0] = (f32x4){-mb, -mb, -mb, -mb}; s[t][1] = (f32x4){-mb, -mb, -mb, -mb}; }
#pragma unroll
      for (int ks = 0; ks < 4; ++ks)
#pragma unroll
        for (int t = 0; t < 4; ++t) { const bf16x8 kf = *(const LAS bf16x8*)(Kb + (16 * t + r) * KP + ks * 32 + 8 * Qd);
          s[t][0] = __builtin_amdgcn_mfma_f32_16x16x32_bf16(kf, qf[0][ks], s[t][0], 0, 0, 0);
          s[t][1] = __builtin_amdgcn_mfma_f32_16x16x32_bf16(kf, qf[1][ks], s[t][1], 0, 0, 0); }
      bf16x8 pa[2][2];
#pragma unroll
      for (int m = 0; m < 2; ++m) { const int qi = qoff + 16 * m + r;
#pragma unroll
        for (int t = 0; t < 4; ++t) {
          float pv[4];
#pragma unroll
          for (int j = 0; j < 4; ++j) { const int kj = 16 * t + 4 * Qd + j; float pj = __builtin_amdgcn_exp2f(s[t][m][j]);
            if (mtype != 0) { if (mtype == 1) pj = (kj >= qi) ? pj : 0.f; else pj = (kj <= qi) ? pj : 0.f; }
            pv[j] = pj; lsum[m] += pj; }
          const unsigned w0 = pk2(pv[0], pv[1]), w1 = pk2(pv[2], pv[3]);
          pa[m][t >> 1][(t & 1) * 4 + 0] = (short)(w0 & 0xffff); pa[m][t >> 1][(t & 1) * 4 + 1] = (short)(w0 >> 16);
          pa[m][t >> 1][(t & 1) * 4 + 2] = (short)(w1 & 0xffff); pa[m][t >> 1][(t & 1) * 4 + 3] = (short)(w1 >> 16); } }
#pragma unroll
      for (int k2 = 0; k2 < 2; ++k2)
#pragma unroll
        for (int n = 0; n < 8; ++n) {
          const s16x4 lo = tr_read(Vb + (32 * k2 + 4 * Qd + (r >> 2)) * VP + 16 * n + 4 * (r & 3));
          const s16x4 hi = tr_read(Vb + (32 * k2 + 16 + 4 * Qd + (r >> 2)) * VP + 16 * n + 4 * (r & 3));
          const bf16x8 vf = (bf16x8){lo[0], lo[1], lo[2], lo[3], hi[0], hi[1], hi[2], hi[3]};
          o[0][n] = __builtin_amdgcn_mfma_f32_16x16x32_bf16(pa[0][k2], vf, o[0][n], 0, 0, 0);
          o[1][n] = __builtin_amdgcn_mfma_f32_16x16x32_bf16(pa[1][k2], vf, o[1][n], 0, 0, 0); }
      if (i + 1 < ntile) STORE_TILE(buf ^ 1, i + 1);
      __syncthreads();
    }
#undef TILE_ROW0
#undef LOAD_TILE
#undef STORE_TILE
    const float sk = __builtin_amdgcn_exp2f(sink[hq] * 1.4426950408889634f - mb);
#pragma unroll
    for (int m = 0; m < 2; ++m) { float l = lsum[m]; l += __shfl_xor(l, 16); l += __shfl_xor(l, 32); if (Qd == 0) dsc[wid * 32 + 16 * m + r] = 1.f / (l + sk); }
    LDS_WAIT(); asm volatile("" ::: "memory");
    { LAS bf16_t* stg = (LAS bf16_t*)lds + wid * 32 * 136;
#pragma unroll
      for (int m = 0; m < 2; ++m)
#pragma unroll
        for (int j = 0; j < 4; ++j) { const float inv = dsc[wid * 32 + 16 * m + 4 * Qd + j];
#pragma unroll
          for (int n = 0; n < 8; ++n) stg[(16 * m + 4 * Qd + j) * 136 + 16 * n + r] = f2bf(o[m][n][j] * inv); }
      LDS_WAIT(); asm volatile("" ::: "memory");
#pragma unroll
      for (int q = 0; q < 8; ++q) { const int c = lane + 64 * q, rowl = c >> 4, ch = c & 15; const size_t go = (qrow0 + rowl) * 2048 + hq * 128 + ch * 8;
        const v4u ov = *(const LAS v4u*)(stg + rowl * 136 + ch * 8), gv = *(const v4u*)(G1 + go);
        v4u w; w.x = pk2(__uint_as_float(ov.x << 16) * __uint_as_float(gv.x << 16), __uint_as_float(ov.x & 0xffff0000u) * __uint_as_float(gv.x & 0xffff0000u));
        w.y = pk2(__uint_as_float(ov.y << 16) * __uint_as_float(gv.y << 16), __uint_as_float(ov.y & 0xffff0000u) * __uint_as_float(gv.y & 0xffff0000u));
        w.z = pk2(__uint_as_float(ov.z << 16) * __uint_as_float(gv.z << 16), __uint_as_float(ov.z & 0xffff0000u) * __uint_as_float(gv.z & 0xffff0000u));
        w.w = pk2(__uint_as_float(ov.w << 16) * __uint_as_float(gv.w << 16), __uint_as_float(ov.w & 0xffff0000u) * __uint_as_float(gv.w & 0xffff0000u));
        if (wr) *(v4u*)(Q1 + go) = w; }
      LDS_WAIT(); asm volatile("" ::: "memory"); }
  }
}

constexpr size_t DO_SDT = 50 * MiB, DO_SCS = 53 * MiB;
constexpr size_t WS_SSQ = 237 * MiB;
DEV unsigned short bfbits(float f) { return f2bf(f); }
DEV void ssd_prep_phase(const bf16_t* XBC, const float* cw, const float* cb, bf16_t* XC, const float* DTLR, const float* dt_bias, const float* a_log, float* SDT, float* SCS, float* SDEC) {
  const int gtid = blockIdx.x * 512 + threadIdx.x, gth = gridDim.x * 512;
  for (int it = gtid; it < (MA / 32) * 192; it += gth) {
    const int rg = it / 192, c8 = (it % 192) * 8, row0 = rg * 32;
    int t0, len;
    if (row0 < ML) { t0 = row0 % SEQ; len = SEQ; } else { t0 = (row0 - ML) % CTXL; len = CTXL; }
    float w[5][8], bias[8];
#pragma unroll
    for (int k = 0; k < 5; ++k) { const f32x4 w0 = *(const f32x4*)(cw + k * 1536 + c8), w1 = *(const f32x4*)(cw + k * 1536 + c8 + 4);
      w[k][0] = w0.x; w[k][1] = w0.y; w[k][2] = w0.z; w[k][3] = w0.w; w[k][4] = w1.x; w[k][5] = w1.y; w[k][6] = w1.z; w[k][7] = w1.w; }
    { const f32x4 b0 = *(const f32x4*)(cb + c8), b1 = *(const f32x4*)(cb + c8 + 4); bias[0] = b0.x; bias[1] = b0.y; bias[2] = b0.z; bias[3] = b0.w; bias[4] = b1.x; bias[5] = b1.y; bias[6] = b1.z; bias[7] = b1.w; }
    const v4u zero4 = {0u, 0u, 0u, 0u};
    v4u win[4];
#pragma unroll
    for (int q = 0; q < 4; ++q) { const int tt = t0 - 2 + q; win[q] = (tt >= 0 && tt < len) ? *(const v4u*)(XBC + (size_t)(row0 - 2 + q) * 1536 + c8) : zero4; }
#pragma unroll 4
    for (int i = 0; i < 32; ++i) {
      const int tt = t0 + i + 2; const v4u nx = (tt < len) ? *(const v4u*)(XBC + (size_t)(row0 + i + 2) * 1536 + c8) : zero4;
      float acc[8];
#pragma unroll
      for (int e = 0; e < 8; ++e) acc[e] = bias[e];
#define CONV_TAP(k, xv) do { acc[0] += w[k][0] * __uint_as_float((xv).x << 16); acc[1] += w[k][1] * __uint_as_float((xv).x & 0xffff0000u); acc[2] += w[k][2] * __uint_as_float((xv).y << 16); acc[3] += w[k][3] * __uint_as_float((xv).y & 0xffff0000u); \
        acc[4] += w[k][4] * __uint_as_float((xv).z << 16); acc[5] += w[k][5] * __uint_as_float((xv).z & 0xffff0000u); acc[6] += w[k][6] * __uint_as_float((xv).w << 16); acc[7] += w[k][7] * __uint_as_float((xv).w & 0xffff0000u); } while (0)
      CONV_TAP(0, win[0]); CONV_TAP(1, win[1]); CONV_TAP(2, win[2]); CONV_TAP(3, win[3]); CONV_TAP(4, nx);
#undef CONV_TAP
      v4u o; o.x = pk2(silu_fast(acc[0]), silu_fast(acc[1])); o.y = pk2(silu_fast(acc[2]), silu_fast(acc[3])); o.z = pk2(silu_fast(acc[4]), silu_fast(acc[5])); o.w = pk2(silu_fast(acc[6]), silu_fast(acc[7]));
      *(v4u*)(XC + (size_t)(row0 + i) * 1536 + c8) = o;
      win[0] = win[1]; win[1] = win[2]; win[2] = win[3]; win[3] = nx;
    }
  }
  {
    const int lane = threadIdx.x & 63, wave = threadIdx.x >> 6, cl = lane & 7, seg = lane >> 3;
    for (int wt = blockIdx.x * NWAVES + wave; wt < NCH * 4; wt += gridDim.x * NWAVES) {
      const int gc = wt >> 2, col = (wt & 3) * 8 + cl, dir = col >> 4, h = col & 15;
      const float a = -fexp(a_log[col]), bias = dt_bias[col];
      float dtv[16], v[16]; float run = 0.f;
#pragma unroll
      for (int u = 0; u < 16; ++u) { const int s = seg * 16 + u, t = dir ? 127 - s : s; dtv[u] = softplusf(DTLR[((size_t)gc * 128 + t) * 64 + col] + bias); }
#pragma unroll
      for (int u = 0; u < 16; ++u) { run += dtv[u] * a; v[u] = run; }
      float off = 0.f;
#pragma unroll
      for (int sgi = 0; sgi < 7; ++sgi) { const float tot = __shfl(run, cl + 8 * sgi); off += (sgi < seg) ? tot : 0.f; }
#pragma unroll
      for (int u = 0; u < 16; ++u) { const int s = seg * 16 + u, t = dir ? 127 - s : s; const size_t row = (size_t)gc * 128 + t; SDT[row * 32 + col] = dtv[u]; SCS[row * 32 + col] = v[u] + off; }
      if (seg == 7) SDEC[(gc * 16 + h) * 2 + dir] = fexp(run + off);
    }
  }
}
DEV void ssd_u_phase(const bf16_t* XC, const float* SDT, const float* SCS, bf16_t* ST, LAS unsigned char* lds) {
  constexpr int XP = 272, BP = 144;
  LAS bf16_t* Xs = (LAS bf16_t*)lds; LAS bf16_t* Bs = (LAS bf16_t*)(lds + 128 * XP * 2); LAS float* wtab = (LAS float*)(lds + 128 * XP * 2 + 128 * BP * 2);
  const int tid = threadIdx.x, lane = tid & 63, wid = tid >> 6, r = lane & 15, Qd = lane >> 4, hl = wid >> 1, dir = wid & 1;
  for (int task = virt_block(); task < NCH * 4; task += gridDim.x) {
    const int gc = task >> 2, g = (task >> 1) & 1, hh = task & 1; const size_t r0 = (size_t)gc * 128; const int h0 = g * 8 + hh * 4;
    __syncthreads();
#pragma unroll
    for (int i = 0; i < 8; ++i) { const int cid = tid + 512 * i, row = cid >> 5, ch = cid & 31; *(LAS v4u*)(Xs + row * XP + ch * 8) = *(const v4u*)(XC + (r0 + row) * 1536 + h0 * 64 + ch * 8); }
#pragma unroll
    for (int i = 0; i < 4; ++i) { const int cid = tid + 512 * i, row = cid >> 4, ch = cid & 15; *(LAS v4u*)(Bs + row * BP + ch * 8) = *(const v4u*)(XC + (r0 + row) * 1536 + 1024 + g * 128 + ch * 8); }
    if (tid < 256) { const int d_ = tid >> 7, t = tid & 127;
      const f32x4 ce = *(const f32x4*)(SCS + (r0 + (d_ ? 0 : 127)) * 32 + d_ * 16 + h0), ct = *(const f32x4*)(SCS + (r0 + t) * 32 + d_ * 16 + h0), dt = *(const f32x4*)(SDT + (r0 + t) * 32 + d_ * 16 + h0);
      wtab[(0 * 2 + d_) * 128 + t] = fexp(ce.x - ct.x) * dt.x; wtab[(1 * 2 + d_) * 128 + t] = fexp(ce.y - ct.y) * dt.y; wtab[(2 * 2 + d_) * 128 + t] = fexp(ce.z - ct.z) * dt.z; wtab[(3 * 2 + d_) * 128 + t] = fexp(ce.w - ct.w) * dt.w; }
    __syncthreads();
    const LAS float* wt = wtab + wid * 128;
    bf16_t* Sp = ST + ((((size_t)gc * 16 + h0 + hl) * 2 + dir) * 64) * 128;
#pragma unroll 1
    for (int pp = 0; pp < 2; ++pp) {
      f32x4 acc[8][2];
#pragma unroll
      for (int nt = 0; nt < 8; ++nt) { acc[nt][0] = (f32x4){0.f, 0.f, 0.f, 0.f}; acc[nt][1] = (f32x4){0.f, 0.f, 0.f, 0.f}; }
#pragma unroll 1
      for (int k = 0; k < 4; ++k) {
        const f32x4 wlo = *(const LAS f32x4*)(wt + 32 * k + 4 * Qd), whi = *(const LAS f32x4*)(wt + 32 * k + 16 + 4 * Qd);
        bf16x8 xf[2];
#pragma unroll
        for (int pt = 0; pt < 2; ++pt) {
          const s16x4 lo = tr_read(Xs + (32 * k + 4 * Qd + (r >> 2)) * XP + hl * 64 + 32 * pp + 16 * pt + 4 * (r & 3));
          const s16x4 hi = tr_read(Xs + (32 * k + 16 + 4 * Qd + (r >> 2)) * XP + hl * 64 + 32 * pp + 16 * pt + 4 * (r & 3));
          const unsigned w0 = pk2(bf2f((bf16_t)lo[0]) * wlo[0], bf2f((bf16_t)lo[1]) * wlo[1]), w1 = pk2(bf2f((bf16_t)lo[2]) * wlo[2], bf2f((bf16_t)lo[3]) * wlo[3]);
          const unsigned w2 = pk2(bf2f((bf16_t)hi[0]) * whi[0], bf2f((bf16_t)hi[1]) * whi[1]), w3 = pk2(bf2f((bf16_t)hi[2]) * whi[2], bf2f((bf16_t)hi[3]) * whi[3]);
          xf[pt] = (bf16x8){(short)(w0 & 0xffff), (short)(w0 >> 16), (short)(w1 & 0xffff), (short)(w1 >> 16), (short)(w2 & 0xffff), (short)(w2 >> 16), (short)(w3 & 0xffff), (short)(w3 >> 16)};
        }
#pragma unroll
        for (int nt = 0; nt < 8; ++nt) {
          const s16x4 lo = tr_read(Bs + (32 * k + 4 * Qd + (r >> 2)) * BP + 16 * nt + 4 * (r & 3));
          const s16x4 hi = tr_read(Bs + (32 * k + 16 + 4 * Qd + (r >> 2)) * BP + 16 * nt + 4 * (r & 3));
          const bf16x8 bfr = (bf16x8){lo[0], lo[1], lo[2], lo[3], hi[0], hi[1], hi[2], hi[3]};
          acc[nt][0] = __builtin_amdgcn_mfma_f32_16x16x32_bf16(bfr, xf[0], acc[nt][0], 0, 0, 0);
          acc[nt][1] = __builtin_amdgcn_mfma_f32_16x16x32_bf16(bfr, xf[1], acc[nt][1], 0, 0, 0);
        }
      }
#pragma unroll
      for (int nt = 0; nt < 8; ++nt)
#pragma unroll
        for (int pt = 0; pt < 2; ++pt) { const f32x4 v = acc[nt][pt];
          *(unsigned long long*)(Sp + ((((2 * pp + pt) * 4 + (nt >> 1)) * 64 + ((nt & 1) * 2 + (Qd >> 1)) * 16 + r) * 8 + 4 * (Qd & 1))) = (unsigned long long)pk2(v[0], v[1]) | ((unsigned long long)pk2(v[2], v[3]) << 32); }
    }
  }
}
DEV void ssd_scan_phase(bf16_t* ST, const float* SDEC, bool wr) {
  for (int item = blockIdx.x * 512 + threadIdx.x; item < 2 * 16 * 2 * 2048; item += gridDim.x * 512) {
    const int e4 = item & 2047, dir = (item >> 11) & 1, h = (item >> 12) & 15, b = item >> 16;
    float S0 = 0.f, S1 = 0.f, S2 = 0.f, S3 = 0.f;
#define SCAN_GC(s) (!dir ? ((s) < 2 ? 128 + 2 * b + (s) : b * 64 + ((s) - 2)) : ((s) < 2 ? 128 + 2 * b + (1 - (s)) : b * 64 + (65 - (s))))
    for (int s0 = 0; s0 < 66; s0 += 6) {
      unsigned long long u[6]; float dec[6];
#pragma unroll
      for (int q = 0; q < 6; ++q) { const int gc = SCAN_GC(s0 + q); u[q] = *(const unsigned long long*)(ST + (((size_t)gc * 16 + h) * 2 + dir) * 8192 + e4 * 4); dec[q] = SDEC[(gc * 16 + h) * 2 + dir]; }
#pragma unroll
      for (int q = 0; q < 6; ++q) { const int gc = SCAN_GC(s0 + q);
        if (wr) *(unsigned long long*)(ST + (((size_t)gc * 16 + h) * 2 + dir) * 8192 + e4 * 4) = (unsigned long long)pk2(S0, S1) | ((unsigned long long)pk2(S2, S3) << 32);
        const unsigned lo = (unsigned)u[q], hi = (unsigned)(u[q] >> 32);
        S0 = dec[q] * S0 + __uint_as_float(lo << 16); S1 = dec[q] * S1 + __uint_as_float(lo & 0xffff0000u); S2 = dec[q] * S2 + __uint_as_float(hi << 16); S3 = dec[q] * S3 + __uint_as_float(hi & 0xffff0000u); }
    }
#undef SCAN_GC
  }
}
DEV bf16x8 scale_frag(bf16x8 f, float s) {
  bf16x8 o;
#pragma unroll
  for (int e = 0; e < 8; e += 2) { const unsigned w = pk2(bf2f((bf16_t)f[e]) * s, bf2f((bf16_t)f[e + 1]) * s); o[e] = (short)(w & 0xffff); o[e + 1] = (short)(w >> 16); }
  return o;
}
DEV void ssd_y_phase(const bf16_t* XC, const float* SDT, const float* SCS, const bf16_t* ST, const float* d_skip, bf16_t* Y0, float* SSQ, LAS unsigned char* lds, bool wr) {
  constexpr int XP = 272, BP = 136, SP = 72;
  LAS bf16_t* Xs = (LAS bf16_t*)lds; LAS bf16_t* Bs = (LAS bf16_t*)(lds + 128 * XP * 2);
  LAS float* tab = (LAS float*)(lds + 128 * XP * 2 + 128 * BP * 2);
  LAS float* ssq = tab + 4 * 4 * 128;
  LAS bf16_t* stg = (LAS bf16_t*)(ssq + 4 * 128);
  const int tid = threadIdx.x, lane = tid & 63, wid = tid >> 6, r = lane & 15, Qd = lane >> 4, hl = wid >> 1, ih = wid & 1;
  LAS bf16_t* mystg = stg + wid * 16 * SP;
  for (int task = virt_block(); task < NCH * 4; task += gridDim.x) {
    const int gc = task >> 2, g = (task >> 1) & 1, hh = task & 1; const size_t r0 = (size_t)gc * 128; const int h0 = g * 8 + hh * 4, h = h0 + hl;
    bf16x8 cstrip[4], cf[4][4];
#pragma unroll
    for (int ks = 0; ks < 4; ++ks) cstrip[ks] = *(const bf16x8*)(XC + (r0 + 16 * wid + r) * 1536 + 1280 + g * 128 + 32 * ks + 8 * Qd);
#pragma unroll
    for (int m = 0; m < 4; ++m)
#pragma unroll
      for (int ks = 0; ks < 4; ++ks) cf[m][ks] = *(const bf16x8*)(XC + (r0 + 64 * ih + 16 * m + r) * 1536 + 1280 + g * 128 + 32 * ks + 8 * Qd);
    __syncthreads();
#pragma unroll
    for (int i = 0; i < 8; ++i) { const int cid = tid + 512 * i, row = cid >> 5, ch = cid & 31; *(LAS v4u*)(Xs + row * XP + ch * 8) = *(const v4u*)(XC + (r0 + row) * 1536 + h0 * 64 + ch * 8); }
#pragma unroll
    for (int i = 0; i < 4; ++i) { const int cid = tid + 512 * i, row = cid >> 4, ch = cid & 15; *(LAS v4u*)(Bs + row * BP + ch * 8) = *(const v4u*)(XC + (r0 + row) * 1536 + 1024 + g * 128 + ch * 8); }
    { const int which = tid >> 7, t = tid & 127; const f32x4 v = *(const f32x4*)((which < 2 ? SCS : SDT) + (r0 + t) * 32 + (which & 1) * 16 + h0);
      tab[0 * 512 + which * 128 + t] = v.x; tab[1 * 512 + which * 128 + t] = v.y; tab[2 * 512 + which * 128 + t] = v.z; tab[3 * 512 + which * 128 + t] = v.w; }
    __syncthreads();
    {
      f32x4 cb[8];
#pragma unroll
      for (int t = 0; t < 8; ++t) { f32x4 c = {0.f, 0.f, 0.f, 0.f};
#pragma unroll
        for (int ks = 0; ks < 4; ++ks) { const bf16x8 bfr = *(const LAS bf16x8*)(Bs + (16 * t + r) * BP + 32 * ks + 8 * Qd); c = __builtin_amdgcn_mfma_f32_16x16x32_bf16(bfr, cstrip[ks], c, 0, 0, 0); }
        cb[t] = c; }
      __syncthreads();
#pragma unroll
      for (int t = 0; t < 8; ++t) *(LAS unsigned long long*)(Bs + (16 * wid + r) * BP + 16 * t + 4 * Qd) = (unsigned long long)pk2(cb[t][0], cb[t][1]) | ((unsigned long long)pk2(cb[t][2], cb[t][3]) << 32);
      __syncthreads();
    }
    const LAS float* csf = tab + hl * 512; const LAS float* csb = csf + 128; const LAS float* dtf = csf + 256; const LAS float* dtb = csf + 384;
    const float dsk = d_skip[h];
    f32x4 y[4][4];
#pragma unroll
    for (int m = 0; m < 4; ++m)
#pragma unroll
      for (int pt = 0; pt < 4; ++pt) y[m][pt] = (f32x4){0.f, 0.f, 0.f, 0.f};
    if (wr || !(PROBE_SKIP & 1))
#pragma unroll 1
    for (int dir = 0; dir < 2; ++dir) {
      const LAS float* csd = dir ? csb : csf; float sc[4];
#pragma unroll
      for (int m = 0; m < 4; ++m)
#pragma unroll
        for (int ks = 0; ks < 4; ++ks) asm volatile("" : "+v"(cf[m][ks]));
#pragma unroll
      for (int m = 0; m < 4; ++m) sc[m] = fexp(csd[64 * ih + 16 * m + r]);
      const bf16_t* Sp = ST + (((size_t)gc * 16 + h) * 2 + dir) * 8192 + lane * 8;
#pragma unroll
      for (int ks = 0; ks < 4; ++ks) {
        bf16x8 sf[4];
#pragma unroll
        for (int pt = 0; pt < 4; ++pt) sf[pt] = *(const bf16x8*)(Sp + (pt * 4 + ks) * 512);
#pragma unroll
        for (int m = 0; m < 4; ++m) { const bf16x8 a = scale_frag(cf[m][ks], sc[m]);
#pragma unroll
          for (int pt = 0; pt < 4; ++pt) y[m][pt] = __builtin_amdgcn_mfma_f32_16x16x32_bf16(a, sf[pt], y[m][pt], 0, 0, 0);
          __builtin_amdgcn_sched_barrier(0); }
      }
    }
#pragma unroll 1
    for (int m = 0; m < 4; ++m) {
      const int i0 = 64 * ih + 16 * m, i = i0 + r;
      const float cfi = csf[i], cbi = csb[i];
      v4u zpre[2];
#pragma unroll
      for (int q = 0; q < 2; ++q) { const int c = lane + 64 * q; zpre[q] = *(const v4u*)(Y0 + (r0 + i0 + (c >> 3)) * 2048 + h * 64 + (c & 7) * 8); }
      if (wr || !(PROBE_SKIP & 2))
#pragma unroll 1
      for (int k2 = 0; k2 < 4; ++k2) {
        const int j0 = 32 * k2 + 8 * Qd;
        const v4u cbv = *(const LAS v4u*)(Bs + i * BP + j0);
        const float cbe[8] = {__uint_as_float(cbv.x << 16), __uint_as_float(cbv.x & 0xffff0000u), __uint_as_float(cbv.y << 16), __uint_as_float(cbv.y & 0xffff0000u), __uint_as_float(cbv.z << 16), __uint_as_float(cbv.z & 0xffff0000u), __uint_as_float(cbv.w << 16), __uint_as_float(cbv.w & 0xffff0000u)};
        float pv[8];
        const bool dofwd = (32 * k2 <= i0 + 15), dobwd = (32 * k2 + 31 >= i0);
#pragma unroll
        for (int e = 0; e < 8; ++e) pv[e] = (j0 + e == i) ? dsk : 0.f;
        if (dofwd) { const f32x4 a0 = *(const LAS f32x4*)(csf + j0), a1 = *(const LAS f32x4*)(csf + j0 + 4), d0 = *(const LAS f32x4*)(dtf + j0), d1 = *(const LAS f32x4*)(dtf + j0 + 4);
          const float jc[8] = {a0.x, a0.y, a0.z, a0.w, a1.x, a1.y, a1.z, a1.w}; const float jd[8] = {d0.x, d0.y, d0.z, d0.w, d1.x, d1.y, d1.z, d1.w};
#pragma unroll
          for (int e = 0; e < 8; ++e) pv[e] += cbe[e] * fexp(j0 + e <= i ? cfi - jc[e] : -INFINITY) * jd[e]; }
        if (dobwd) { const f32x4 a0 = *(const LAS f32x4*)(csb + j0), a1 = *(const LAS f32x4*)(csb + j0 + 4), d0 = *(const LAS f32x4*)(dtb + j0), d1 = *(const LAS f32x4*)(dtb + j0 + 4);
          const float jc[8] = {a0.x, a0.y, a0.z, a0.w, a1.x, a1.y, a1.z, a1.w}; const float jd[8] = {d0.x, d0.y, d0.z, d0.w, d1.x, d1.y, d1.z, d1.w};
#pragma unroll
          for (int e = 0; e < 8; ++e) pv[e] += cbe[e] * fexp(j0 + e >= i ? cbi - jc[e] : -INFINITY) * jd[e]; }
        const unsigned w0 = pk2(pv[0], pv[1]), w1 = pk2(pv[2], pv[3]), w2 = pk2(pv[4], pv[5]), w3 = pk2(pv[6], pv[7]);
        const bf16x8 pa = (bf16x8){(short)(w0 & 0xffff), (short)(w0 >> 16), (short)(w1 & 0xffff), (short)(w1 >> 16), (short)(w2 & 0xffff), (short)(w2 >> 16), (short)(w3 & 0xffff), (short)(w3 >> 16)};
#pragma unroll
        for (int pt = 0; pt < 4; ++pt) {
          const s16x4 lo = tr_read(Xs + (32 * k2 + 8 * Qd + (r >> 2)) * XP + hl * 64 + 16 * pt + 4 * (r & 3));
          const s16x4 hi = tr_read(Xs + (32 * k2 + 8 * Qd + 4 + (r >> 2)) * XP + hl * 64 + 16 * pt + 4 * (r & 3));
          const bf16x8 xf = (bf16x8){lo[0], lo[1], lo[2], lo[3], hi[0], hi[1], hi[2], hi[3]};
          y[0][pt] = __builtin_amdgcn_mfma_f32_16x16x32_bf16(pa, xf, y[0][pt], 0, 0, 0);
        }
      }
      if (wr || !(PROBE_SKIP & 4)) {
#pragma unroll
      for (int pt = 0; pt < 4; ++pt)
#pragma unroll
        for (int jj = 0; jj < 4; ++jj) mystg[(4 * Qd + jj) * SP + 16 * pt + r] = f2bf(y[0][pt][jj]);
      LDS_WAIT(); asm volatile("" ::: "memory");
#pragma unroll
      for (int q = 0; q < 2; ++q) { const int c = lane + 64 * q, rowl = c >> 3, ch = c & 7; const int il = 64 * ih + 16 * m + rowl;
        const v4u yv = *(const LAS v4u*)(mystg + rowl * SP + ch * 8); bf16_t* zp = Y0 + (r0 + il) * 2048 + h * 64 + ch * 8; const v4u zv = zpre[q];
        const float v0 = __uint_as_float(yv.x << 16) * __uint_as_float(zv.x << 16), v1 = __uint_as_float(yv.x & 0xffff0000u) * __uint_as_float(zv.x & 0xffff0000u);
        const float v2 = __uint_as_float(yv.y << 16) * __uint_as_float(zv.y << 16), v3 = __uint_as_float(yv.y & 0xffff0000u) * __uint_as_float(zv.y & 0xffff0000u);
        const float v4 = __uint_as_float(yv.z << 16) * __uint_as_float(zv.z << 16), v5 = __uint_as_float(yv.z & 0xffff0000u) * __uint_as_float(zv.z & 0xffff0000u);
        const float v6 = __uint_as_float(yv.w << 16) * __uint_as_float(zv.w << 16), v7 = __uint_as_float(yv.w & 0xffff0000u) * __uint_as_float(zv.w & 0xffff0000u);
        float ss = (v0 * v0 + v1 * v1) + (v2 * v2 + v3 * v3) + (v4 * v4 + v5 * v5) + (v6 * v6 + v7 * v7);
        ss += __shfl_xor(ss, 1); ss += __shfl_xor(ss, 2); ss += __shfl_xor(ss, 4);
        v4u ov; ov.x = pk2(v0, v1); ov.y = pk2(v2, v3); ov.z = pk2(v4, v5); ov.w = pk2(v6, v7);
        if (wr) *(v4u*)zp = ov;
        if (ch == 0) ssq[hl * 128 + il] = ss; }
      LDS_WAIT(); asm volatile("" ::: "memory");
      }
#pragma unroll
      for (int pt = 0; pt < 4; ++pt) { y[0][pt] = y[1][pt]; y[1][pt] = y[2][pt]; y[2][pt] = y[3][pt]; }
    }
    __syncthreads();
    if (tid < 128) SSQ[((r0 + tid) * 2 + g) * 2 + hh] = (ssq[tid] + ssq[128 + tid]) + (ssq[256 + tid] + ssq[384 + tid]);
  }
}

typedef _Float16 h16_t;
typedef _Float16 h16x8 __attribute__((ext_vector_type(8)));
DEV const h16_t* gcs_row(const h16_t* wsb, const h16_t* outb, size_t row) {
  return row < 9472 ? (const h16_t*)((const char*)wsb + 237 * MiB + 512 * 1024) + row * 1024 : (row < 13824 ? (const h16_t*)((const char*)outb + 55 * MiB + 512 * 1024) + (row - 9472) * 1024 : (const h16_t*)((const char*)wsb + 2 * MiB) + (row - 13824) * 1024); }
DEV h16_t* gcs_row_w(h16_t* wsb, h16_t* outb, size_t row) { return (h16_t*)gcs_row(wsb, outb, row); }
DEV float logsig_fast(float x) { return fminf(x, 0.f) - 0.6931471805599453f * __builtin_amdgcn_logf(1.f + __builtin_amdgcn_exp2f(-1.4426950408889634f * fabsf(x))); }
DEV void gla_cs_phase(const float* DTLR, const float* gw, const float* gb, h16_t* GCSL, h16_t* GCSC, float* GDEC, LAS unsigned char* lds, unsigned* queue) {
  const int lane = threadIdx.x & 63, wave = threadIdx.x >> 6;
  LAS float* lrs = (LAS float*)(lds + wave * 8192);
  LAS h16_t* tile = (LAS h16_t*)(lds + 65536 + wave * 1024);
  for (;;) {
    unsigned wt_ = 0u; if (lane == 0) wt_ = __hip_atomic_fetch_add(queue, 1u, __ATOMIC_RELAXED, __HIP_MEMORY_SCOPE_AGENT);
    wt_ = (unsigned)__builtin_amdgcn_readfirstlane((int)wt_); if (wt_ >= (unsigned)(NCH * 2 * 8)) break;
    const int wt = (int)wt_;
    const int gc = wt >> 4, dir = (wt >> 3) & 1, k = (wt & 7) * 64 + lane;
#pragma unroll
    for (int q = 0; q < 8; ++q) { const int c = lane + 64 * q, row = c >> 2, part = c & 3;
      *(LAS f32x4*)(lrs + row * 16 + part * 4) = *(const f32x4*)(DTLR + ((size_t)gc * 128 + row) * 64 + 32 + dir * 16 + part * 4); }
    float wv[16];
#pragma unroll
    for (int q = 0; q < 16; ++q) wv[q] = gw[(dir * 16 + q) * 512 + k];
    const float bias = gb[dir * 512 + k];
    LDS_WAIT(); asm volatile("" ::: "memory");
    float run = 0.f;
#pragma unroll 1
    for (int s0 = 0; s0 < 128; s0 += 8) {
      float lg[8];
#pragma unroll
      for (int u = 0; u < 8; ++u) { const int s = s0 + u, t = dir ? 127 - s : s; const LAS float* lr = lrs + t * 16;
        const f32x4 l0 = *(const LAS f32x4*)lr, l1 = *(const LAS f32x4*)(lr + 4), l2 = *(const LAS f32x4*)(lr + 8), l3 = *(const LAS f32x4*)(lr + 12);
        const float x = bias + l0.x * wv[0] + l0.y * wv[1] + l0.z * wv[2] + l0.w * wv[3] + l1.x * wv[4] + l1.y * wv[5] + l1.z * wv[6] + l1.w * wv[7]
                        + l2.x * wv[8] + l2.y * wv[9] + l2.z * wv[10] + l2.w * wv[11] + l3.x * wv[12] + l3.y * wv[13] + l3.z * wv[14] + l3.w * wv[15];
        lg[u] = logsig_fast(x) * (1.f / 16.f); }
#pragma unroll
      for (int u = 0; u < 8; ++u) { run += lg[u]; tile[u * 64 + lane] = (h16_t)run; }
      LDS_WAIT(); asm volatile("" ::: "memory");
      { const int u = lane >> 3, ch = lane & 7, s = s0 + u, t = dir ? 127 - s : s;
        *(v4u*)(gcs_row_w(GCSL, GCSC, (size_t)gc * 128 + t) + dir * 512 + (k - lane) + ch * 8) = *(const LAS v4u*)(tile + u * 64 + ch * 8); }
      LDS_WAIT(); asm volatile("" ::: "memory");
    }
    GDEC[((gc * 4 + (k >> 7)) * 2 + dir) * 128 + (k & 127)] = fexp(run);
    LDS_WAIT(); asm volatile("" ::: "memory");
  }
}
DEV void gla_u_phase(const bf16_t* K0, const bf16_t* V0, const h16_t* GCSL, const h16_t* GCSC, bf16_t* ST, LAS unsigned char* lds) {
  constexpr int VP = 272, KP = 144;
  LAS bf16_t* Vs = (LAS bf16_t*)lds; LAS bf16_t* Kd = (LAS bf16_t*)(lds + 128 * VP * 2);
  const int tid = threadIdx.x, lane = tid & 63, wid = tid >> 6, r = lane & 15, Qd = lane >> 4;
  for (int task = virt_block(); task < NCH * 4; task += gridDim.x) {
    const int gc = task >> 2, h = task & 3; const size_t r0 = (size_t)gc * 128;
    __syncthreads();
#pragma unroll
    for (int i = 0; i < 8; ++i) { const int cid = tid + 512 * i, row = cid >> 5, ch = cid & 31; *(LAS v4u*)(Vs + row * VP + ch * 8) = *(const v4u*)(V0 + (r0 + row) * 1024 + h * 256 + ch * 8); }
#pragma unroll
    for (int i = 0; i < 4; ++i) { const int cid = tid + 512 * i, t = cid >> 4, ch = cid & 15;
      const v4u kv = *(const v4u*)(K0 + (r0 + t) * 512 + h * 128 + ch * 8);
      const float kf[8] = {__uint_as_float(kv.x << 16), __uint_as_float(kv.x & 0xffff0000u), __uint_as_float(kv.y << 16), __uint_as_float(kv.y & 0xffff0000u), __uint_as_float(kv.z << 16), __uint_as_float(kv.z & 0xffff0000u), __uint_as_float(kv.w << 16), __uint_as_float(kv.w & 0xffff0000u)};
#pragma unroll
      for (int dir = 0; dir < 2; ++dir) {
        const h16x8 ce = *(const h16x8*)(gcs_row(GCSL, GCSC, r0 + (dir ? 0 : 127)) + dir * 512 + h * 128 + ch * 8), ct = *(const h16x8*)(gcs_row(GCSL, GCSC, r0 + t) + dir * 512 + h * 128 + ch * 8);
        v4u o; o.x = pk2(kf[0] * fexp((float)ce[0] - (float)ct[0]), kf[1] * fexp((float)ce[1] - (float)ct[1])); o.y = pk2(kf[2] * fexp((float)ce[2] - (float)ct[2]), kf[3] * fexp((float)ce[3] - (float)ct[3]));
        o.z = pk2(kf[4] * fexp((float)ce[4] - (float)ct[4]), kf[5] * fexp((float)ce[5] - (float)ct[5])); o.w = pk2(kf[6] * fexp((float)ce[6] - (float)ct[6]), kf[7] * fexp((float)ce[7] - (float)ct[7]));
        *(LAS v4u*)(Kd + dir * 128 * KP + t * KP + ch * 8) = o; } }
    __syncthreads();
#pragma unroll 1
    for (int dir = 0; dir < 2; ++dir) {
      const LAS bf16_t* Kb = Kd + dir * 128 * KP;
      f32x4 acc[8][2];
#pragma unroll
      for (int dt = 0; dt < 8; ++dt) { acc[dt][0] = (f32x4){0.f, 0.f, 0.f, 0.f}; acc[dt][1] = (f32x4){0.f, 0.f, 0.f, 0.f}; }
#pragma unroll 1
      for (int k = 0; k < 4; ++k) {
        bf16x8 vf[2];
#pragma unroll
        for (int et = 0; et < 2; ++et) {
          const s16x4 lo = tr_read(Vs + (32 * k + 4 * Qd + (r >> 2)) * VP + 32 * wid + 16 * et + 4 * (r & 3));
          const s16x4 hi = tr_read(Vs + (32 * k + 16 + 4 * Qd + (r >> 2)) * VP + 32 * wid + 16 * et + 4 * (r & 3));
          vf[et] = (bf16x8){lo[0], lo[1], lo[2], lo[3], hi[0], hi[1], hi[2], hi[3]}; }
#pragma unroll
        for (int dt = 0; dt < 8; ++dt) {
          const s16x4 lo = tr_read(Kb + (32 * k + 4 * Qd + (r >> 2)) * KP + 16 * dt + 4 * (r & 3));
          const s16x4 hi = tr_read(Kb + (32 * k + 16 + 4 * Qd + (r >> 2)) * KP + 16 * dt + 4 * (r & 3));
          const bf16x8 kfr = (bf16x8){lo[0], lo[1], lo[2], lo[3], hi[0], hi[1], hi[2], hi[3]};
          acc[dt][0] = __builtin_amdgcn_mfma_f32_16x16x32_bf16(kfr, vf[0], acc[dt][0], 0, 0, 0);
          acc[dt][1] = __builtin_amdgcn_mfma_f32_16x16x32_bf16(kfr, vf[1], acc[dt][1], 0, 0, 0); }
      }
      bf16_t* Sp = ST + (((size_t)gc * 4 + h) * 2 + dir) * 32768;
#pragma unroll
      for (int dt = 0; dt < 8; ++dt)
#pragma unroll
        for (int et = 0; et < 2; ++et) { const f32x4 v = acc[dt][et];
          *(unsigned long long*)(Sp + ((((2 * wid + et) * 4 + (dt >> 1)) * 64 + ((dt & 1) * 2 + (Qd >> 1)) * 16 + r) * 8 + 4 * (Qd & 1))) = (unsigned long long)pk2(v[0], v[1]) | ((unsigned long long)pk2(v[2], v[3]) << 32); }
    }
  }
}
DEV void gla_scan_phase(bf16_t* ST, const float* GDEC, bool wr) {
  for (int item = blockIdx.x * 512 + threadIdx.x; item < 2 * 4 * 2 * 8192; item += gridDim.x * 512) {
    const int e4 = item & 8191, dir = (item >> 13) & 1, h = (item >> 14) & 3, b = item >> 16; const int d0 = 32 * ((e4 >> 7) & 3) + 8 * ((e4 >> 5) & 3) + 4 * (e4 & 1);
    float S0 = 0.f, S1 = 0.f, S2 = 0.f, S3 = 0.f;
#define SCAN_GC(s) (!dir ? ((s) < 2 ? 128 + 2 * b + (s) : b * 64 + ((s) - 2)) : ((s) < 2 ? 128 + 2 * b + (1 - (s)) : b * 64 + (65 - (s))))
    for (int s0 = 0; s0 < 66; s0 += 6) {
      unsigned long long u[6]; f32x4 dec[6];
#pragma unroll
      for (int q = 0; q < 6; ++q) { const int gc = SCAN_GC(s0 + q); u[q] = *(const unsigned long long*)(ST + (((size_t)gc * 4 + h) * 2 + dir) * 32768 + e4 * 4); dec[q] = *(const f32x4*)(GDEC + ((gc * 4 + h) * 2 + dir) * 128 + d0); }
#pragma unroll
      for (int q = 0; q < 6; ++q) { const int gc = SCAN_GC(s0 + q);
        if (wr) *(unsigned long long*)(ST + (((size_t)gc * 4 + h) * 2 + dir) * 32768 + e4 * 4) = (unsigned long long)pk2(S0, S1) | ((unsigned long long)pk2(S2, S3) << 32);
        const unsigned lo = (unsigned)u[q], hi = (unsigned)(u[q] >> 32);
        S0 = dec[q].x * S0 + __uint_as_float(lo << 16); S1 = dec[q].y * S1 + __uint_as_float(lo & 0xffff0000u); S2 = dec[q].z * S2 + __uint_as_float(hi << 16); S3 = dec[q].w * S3 + __uint_as_float(hi & 0xffff0000u); }
    }
#undef SCAN_GC
  }
}
DEV void gla_o_phase(const bf16_t* Q0, const bf16_t* K0, const bf16_t* V0, const h16_t* GCSL, const h16_t* GCSC, const bf16_t* ST, const float* gla_norm, const float* SSQ, const float* ssd_norm, bf16_t* Y0, LAS unsigned char* lds, bool wr) {
  constexpr int VP = 272, KP = 136;
  LAS bf16_t* Vs = (LAS bf16_t*)lds; LAS bf16_t* Kd = (LAS bf16_t*)(lds + 128 * VP * 2);
  const int tid = threadIdx.x, lane = tid & 63, wid = tid >> 6, r = lane & 15, Qd = lane >> 4;
  const float scale = 0.08838834764831845f;
  for (int task = virt_block(); task < NCH * 4; task += gridDim.x) {
    const int gc = task >> 2, h = task & 3; const size_t r0 = (size_t)gc * 128;
    __syncthreads();
#pragma unroll
    for (int i = 0; i < 8; ++i) { const int cid = tid + 512 * i, row = cid >> 5, ch = cid & 31; *(LAS v4u*)(Vs + row * VP + ch * 8) = *(const v4u*)(V0 + (r0 + row) * 1024 + h * 256 + ch * 8); }
#pragma unroll
    for (int i = 0; i < 4; ++i) { const int cid = tid + 512 * i, t = cid >> 4, ch = cid & 15;
      const v4u kv = *(const v4u*)(K0 + (r0 + t) * 512 + h * 128 + ch * 8);
      const float kf[8] = {__uint_as_float(kv.x << 16), __uint_as_float(kv.x & 0xffff0000u), __uint_as_float(kv.y << 16), __uint_as_float(kv.y & 0xffff0000u), __uint_as_float(kv.z << 16), __uint_as_float(kv.z & 0xffff0000u), __uint_as_float(kv.w << 16), __uint_as_float(kv.w & 0xffff0000u)};
#pragma unroll
      for (int dir = 0; dir < 2; ++dir) {
        const h16x8 ct = *(const h16x8*)(gcs_row(GCSL, GCSC, r0 + t) + dir * 512 + h * 128 + ch * 8);
        v4u o; o.x = pk2(kf[0] * fexp(-(float)ct[0]), kf[1] * fexp(-(float)ct[1])); o.y = pk2(kf[2] * fexp(-(float)ct[2]), kf[3] * fexp(-(float)ct[3]));
        o.z = pk2(kf[4] * fexp(-(float)ct[4]), kf[5] * fexp(-(float)ct[5])); o.w = pk2(kf[6] * fexp(-(float)ct[6]), kf[7] * fexp(-(float)ct[7]));
        *(LAS v4u*)(Kd + dir * 128 * KP + t * KP + ch * 8) = o; } }
    __syncthreads();
    const int i = 16 * wid + r;
    f32x4 o[16];
#pragma unroll
    for (int et = 0; et < 16; ++et) o[et] = (f32x4){0.f, 0.f, 0.f, 0.f};
#pragma unroll 1
    for (int dir = 0; dir < 2; ++dir) {
      bf16x8 qd[4];
      { const h16_t* ci = gcs_row(GCSL, GCSC, r0 + i) + dir * 512 + h * 128; const bf16_t* qp = Q0 + (r0 + i) * 512 + h * 128;
#pragma unroll
        for (int ks = 0; ks < 4; ++ks) { const v4u qv = *(const v4u*)(qp + 32 * ks + 8 * Qd); const h16x8 cc = *(const h16x8*)(ci + 32 * ks + 8 * Qd);
          const f32x4 c0 = {(float)cc[0], (float)cc[1], (float)cc[2], (float)cc[3]}, c1 = {(float)cc[4], (float)cc[5], (float)cc[6], (float)cc[7]};
          const unsigned w0 = pk2(__uint_as_float(qv.x << 16) * scale * fexp(c0.x), __uint_as_float(qv.x & 0xffff0000u) * scale * fexp(c0.y));
          const unsigned w1 = pk2(__uint_as_float(qv.y << 16) * scale * fexp(c0.z), __uint_as_float(qv.y & 0xffff0000u) * scale * fexp(c0.w));
          const unsigned w2 = pk2(__uint_as_float(qv.z << 16) * scale * fexp(c1.x), __uint_as_float(qv.z & 0xffff0000u) * scale * fexp(c1.y));
          const unsigned w3 = pk2(__uint_as_float(qv.w << 16) * scale * fexp(c1.z), __uint_as_float(qv.w & 0xffff0000u) * scale * fexp(c1.w));
          qd[ks] = (bf16x8){(short)(w0 & 0xffff), (short)(w0 >> 16), (short)(w1 & 0xffff), (short)(w1 >> 16), (short)(w2 & 0xffff), (short)(w2 >> 16), (short)(w3 & 0xffff), (short)(w3 >> 16)}; } }
      const bf16_t* Sp = ST + (((size_t)gc * 4 + h) * 2 + dir) * 32768 + lane * 8;
      {
        bf16x8 sA[4], sB[4];
#pragma unroll
        for (int q = 0; q < 4; ++q) sA[q] = *(const bf16x8*)(Sp + (q * 4 + 0) * 512);
#pragma unroll
        for (int bi = 0; bi < 16; ++bi) {
          const int ks = bi >> 2, e0 = 4 * (bi & 3);
          if (bi + 1 < 16) { const int ks2 = (bi + 1) >> 2, e2 = 4 * ((bi + 1) & 3);
#pragma unroll
            for (int q = 0; q < 4; ++q) { if (bi & 1) sA[q] = *(const bf16x8*)(Sp + ((e2 + q) * 4 + ks2) * 512); else sB[q] = *(const bf16x8*)(Sp + ((e2 + q) * 4 + ks2) * 512); } }
#pragma unroll
          for (int q = 0; q < 4; ++q) o[e0 + q] = __builtin_amdgcn_mfma_f32_16x16x32_bf16(qd[ks], (bi & 1) ? sB[q] : sA[q], o[e0 + q], 0, 0, 0);
          __builtin_amdgcn_sched_barrier(0);
        }
      }
      const LAS bf16_t* Kb = Kd + dir * 128 * KP;
#pragma unroll 1
      for (int k2 = 0; k2 < 4; ++k2) {
        const bool need = dir ? (2 * k2 + 1 >= wid) : (2 * k2 <= wid);
        if (!need) continue;
        bf16x8 pa;
#pragma unroll
        for (int tt = 0; tt < 2; ++tt) { const int t = 2 * k2 + tt;
          f32x4 c = {0.f, 0.f, 0.f, 0.f};
#pragma unroll
          for (int ks = 0; ks < 4; ++ks) { const bf16x8 kfr = *(const LAS bf16x8*)(Kb + (16 * t + r) * KP + 32 * ks + 8 * Qd); c = __builtin_amdgcn_mfma_f32_16x16x32_bf16(kfr, qd[ks], c, 0, 0, 0); }
          float pv[4];
#pragma unroll
          for (int jj = 0; jj < 4; ++jj) { const int j = 16 * t + 4 * Qd + jj; const bool ok = dir ? (j >= i) : (j <= i); pv[jj] = ok ? c[jj] : 0.f; }
          const unsigned w0 = pk2(pv[0], pv[1]), w1 = pk2(pv[2], pv[3]);
          pa[tt * 4 + 0] = (short)(w0 & 0xffff); pa[tt * 4 + 1] = (short)(w0 >> 16); pa[tt * 4 + 2] = (short)(w1 & 0xffff); pa[tt * 4 + 3] = (short)(w1 >> 16); }
#pragma unroll
        for (int et = 0; et < 16; ++et) {
          const s16x4 lo = tr_read(Vs + (32 * k2 + 4 * Qd + (r >> 2)) * VP + 16 * et + 4 * (r & 3));
          const s16x4 hi = tr_read(Vs + (32 * k2 + 16 + 4 * Qd + (r >> 2)) * VP + 16 * et + 4 * (r & 3));
          const bf16x8 vf = (bf16x8){lo[0], lo[1], lo[2], lo[3], hi[0], hi[1], hi[2], hi[3]};
          o[et] = __builtin_amdgcn_mfma_f32_16x16x32_bf16(pa, vf, o[et], 0, 0, 0); }
      }
    }
#pragma unroll
    for (int jj = 0; jj < 4; ++jj) { float ss = 0.f;
#pragma unroll
      for (int et = 0; et < 16; ++et) ss += o[et][jj] * o[et][jj];
      ss += __shfl_xor(ss, 1); ss += __shfl_xor(ss, 2); ss += __shfl_xor(ss, 4); ss += __shfl_xor(ss, 8);
      const float rstd = rsqrtf(ss * (1.f / 256.f) + EPS);
      const size_t yo = (r0 + 16 * wid + 4 * Qd + jj) * 2048 + 1024 + h * 256 + r;
#pragma unroll
      for (int et = 0; et < 16; ++et) { const bf16_t ov_ = f2bf(o[et][jj] * rstd * gla_norm[h * 256 + 16 * et + r] * bf2f(Y0[yo + 16 * et])); if (wr) Y0[yo + 16 * et] = ov_; } }
    { const int g = h >> 1, c0 = g * 512 + (h & 1) * 256;
#pragma unroll
      for (int q = 0; q < 8; ++q) { const int cid = tid + 512 * q, row = cid >> 5, ch = cid & 31; const size_t rr = r0 + row;
        const float rstd = rsqrtf((SSQ[(rr * 2 + g) * 2] + SSQ[(rr * 2 + g) * 2 + 1]) * (1.f / 512.f) + EPS);
        bf16_t* yp = Y0 + rr * 2048 + c0 + ch * 8; const v4u yv = *(const v4u*)yp; const f32x4 g0 = *(const f32x4*)(ssd_norm + c0 + ch * 8), g1 = *(const f32x4*)(ssd_norm + c0 + ch * 8 + 4);
        v4u ov; ov.x = pk2(__uint_as_float(yv.x << 16) * rstd * g0.x, __uint_as_float(yv.x & 0xffff0000u) * rstd * g0.y); ov.y = pk2(__uint_as_float(yv.y << 16) * rstd * g0.z, __uint_as_float(yv.y & 0xffff0000u) * rstd * g0.w);
        ov.z = pk2(__uint_as_float(yv.z << 16) * rstd * g1.x, __uint_as_float(yv.z & 0xffff0000u) * rstd * g1.y); ov.w = pk2(__uint_as_float(yv.w << 16) * rstd * g1.z, __uint_as_float(yv.w & 0xffff0000u) * rstd * g1.w);
        if (wr) *(v4u*)yp = ov; } }
  }
}

typedef __attribute__((address_space(1))) unsigned gu32;
#define RLX_AGENT __ATOMIC_RELAXED, __HIP_MEMORY_SCOPE_AGENT
#define XB_TMO      128
#define XB_XCNT(j)  (256  + 64 * (j))
#define XB_XSUB(j)  (1280 + 64 * (j))
#define XB_XGEN(j)  (2304 + 64 * (j))
#define XB_TOP      3328
#define XB_TOPGEN   3392
#define XCD_BAR_WORDS 3456
#define XB_SPIN_CAP (1u << 18)

__device__ __forceinline__ unsigned xb_ld(unsigned* p)              { return __hip_atomic_load(p, __ATOMIC_RELAXED, __HIP_MEMORY_SCOPE_AGENT); }
__device__ __forceinline__ unsigned xb_add(unsigned* p, unsigned v) { return __hip_atomic_fetch_add(p, v, __ATOMIC_RELAXED, __HIP_MEMORY_SCOPE_AGENT); }
__device__ __forceinline__ unsigned xb_xcc_id() { return (unsigned)__builtin_amdgcn_s_getreg((3 << 11) | 20) & 0xFu; }
#define XB_SPIN(cond, bar) do { unsigned _sp = 0; while (cond) { __builtin_amdgcn_s_sleep(1); \
    if ((++_sp & 255u) == 0u) { if (xb_ld(&(bar)[XB_TMO])) break; if (_sp > XB_SPIN_CAP) { atomicAdd(&(bar)[XB_TMO], 1u); break; } } } } while (0)

struct XcdBarrier {
    unsigned* bar; unsigned x;
    volatile LAS unsigned* st;
};

__device__ __forceinline__ XcdBarrier xcd_barrier_post(unsigned* bar, volatile LAS unsigned* st) {
    XcdBarrier b; b.bar = bar; b.x = xb_xcc_id(); b.st = st;
    if (threadIdx.x == 0) (void)xb_add(&bar[XB_XCNT(b.x)], 1u);
    return b;
}
__device__ __forceinline__ void xcd_barrier_complete(unsigned* bar, unsigned x, unsigned& nloc, unsigned& nx) {
    const unsigned G = gridDim.x * gridDim.y * gridDim.z;
    unsigned sum, cnt, mine, sp = 0u;
    for (;;) {
        sum = 0u; cnt = 0u; mine = 0u;
#pragma unroll
        for (unsigned j = 0; j < 16; ++j) { const unsigned c = xb_ld(&bar[XB_XCNT(j)]); sum += c; cnt += (c > 0u) ? 1u : 0u; mine = (j == x) ? c : mine; }
        if (sum == G) break;
        __builtin_amdgcn_s_sleep(1);
        if ((++sp & 255u) == 0u) { if (xb_ld(&bar[XB_TMO])) break; if (sp > XB_SPIN_CAP) { atomicAdd(&bar[XB_TMO], 1u); break; } }
    }
    nloc = mine > 0u ? mine : 1u; nx = cnt > 0u ? cnt : 1u;
}

__device__ __forceinline__ void xcd_barrier(const XcdBarrier& b) {
    asm volatile("s_waitcnt vmcnt(0)" ::: "memory");
    __syncthreads();
    if (threadIdx.x == 0) {
        unsigned* bar = b.bar;
        __builtin_amdgcn_s_waitcnt(0);
        unsigned nloc = b.st[0], nx = b.st[1];
        if (nloc == 0u) { xcd_barrier_complete(bar, b.x, nloc, nx); b.st[0] = nloc; b.st[1] = nx; }
        const unsigned old = xb_add(&bar[XB_XSUB(b.x)], 1u);
        const unsigned gen = old / nloc;
        if (old + 1u == (gen + 1u) * nloc) {
            __builtin_amdgcn_fence(__ATOMIC_RELEASE, "agent");
            asm volatile("s_waitcnt vmcnt(0)" ::: "memory");
            const unsigned og = xb_add(&bar[XB_TOP], 1u);
            const unsigned tg = og / nx;
            if (og + 1u == (tg + 1u) * nx) xb_add(&bar[XB_TOPGEN], 1u);
            else XB_SPIN(xb_ld(&bar[XB_TOPGEN]) == tg, bar);
            __builtin_amdgcn_fence(__ATOMIC_ACQUIRE, "agent");
            xb_add(&bar[XB_XGEN(b.x)], 1u);
            asm volatile("s_waitcnt vmcnt(0)" ::: "memory");
        } else {
            XB_SPIN(xb_ld(&bar[XB_XGEN(b.x)]) == gen, bar);
            __builtin_amdgcn_fence(__ATOMIC_ACQUIRE, "agent");
            asm volatile("s_waitcnt vmcnt(0)" ::: "memory");
        }
    }
    __syncthreads();
}

__global__ void __launch_bounds__(NWAVES * 64, 2) mega(Params p) {
  extern __shared__ __attribute__((aligned(16))) unsigned char lds_raw[];
  LAS unsigned char* lds = (LAS unsigned char*)lds_raw;
  volatile LAS unsigned* MISC = (volatile LAS unsigned*)(lds + MISC_OFF);
  if (threadIdx.x < 16) MISC[threadIdx.x] = 0u;
  __syncthreads();
  XcdBarrier bar = xcd_barrier_post((unsigned*)(p.ws + WS_CTL), MISC + 8);
  unsigned char* ws = p.ws;
  float* MOD = (float*)(ws + WS_MOD);
  bf16_t* H0 = (bf16_t*)p.out; float* X1 = p.out;
  const int lo = p.ph_lo, hi = p.ph_hi;
#define IN(k) (lo <= (k) && (k) < hi)
#define SEAM(k) do { if ((k) + 1 < hi) xcd_barrier(bar); } while (0)
#define PH(k, ...) if (IN(k)) { if ((PROBE_MASK >> (k)) & 1u) { const bool wr = (p.rep < 0); (void)wr; __VA_ARGS__; xcd_barrier(bar); } { const bool wr = true; (void)wr; __VA_ARGS__; } SEAM(k); }
  PH(0, prologue_phase(p, lds))
  PH(1, prep_phase(p.in[0], p.in[2], p.in[4], MOD, H0))
  PH(2, {
    pg8::Gemm g{H0, (const bf16_t*)(ws + WS_W1T), MA, E_INP, D}; pg8::StaticOrder S; S.init(MA, E_INP, gridDim.x, (int)blockIdx.x);
    pg8::EpiProj0 E{(bf16_t*)(ws + WS_Y0), (bf16_t*)(ws + WS_XBC), (bf16_t*)(ws + WS_Q0), (bf16_t*)(ws + WS_K0), (bf16_t*)(ws + WS_V0), (float*)(ws + WS_DTLR)};
    pg8::gemm_phase<pg8::EpiProj0, pg8::StaticOrder, true, true>(lds, g, S, E); })
  PH(3, ssd_prep_phase((const bf16_t*)(ws + WS_XBC), p.in[8], p.in[9], (bf16_t*)p.out, (const float*)(ws + WS_DTLR), p.in[10], p.in[11], (float*)((char*)p.out + DO_SDT), (float*)((char*)p.out + DO_SCS), (float*)(ws + WS_SDEC)))
  PH(4, { ssd_u_phase((const bf16_t*)p.out, (const float*)((char*)p.out + DO_SDT), (const float*)((char*)p.out + DO_SCS), (bf16_t*)(ws + WS_STATE), lds);
    { const int nbusy = (NCH * 4) % (int)gridDim.x, nfree = (int)gridDim.x - nbusy;
      const int vb_ = virt_block(); if (vb_ >= nbusy || nfree <= 0) { __syncthreads(); late_weights(p, lds, nfree > 0 ? vb_ - nbusy : vb_, nfree > 0 ? nfree : (int)gridDim.x); } } })
  PH(5, ssd_scan_phase((bf16_t*)(ws + WS_STATE), (const float*)(ws + WS_SDEC), wr))
  PH(6, { ssd_y_phase((const bf16_t*)p.out, (const float*)((char*)p.out + DO_SDT), (const float*)((char*)p.out + DO_SCS), (const bf16_t*)(ws + WS_STATE), p.in[12], (bf16_t*)(ws + WS_Y0), (float*)(ws + WS_SSQ), lds, wr);
    if (wr) gla_cs_phase((const float*)(ws + WS_DTLR), p.in[14], p.in[15], (h16_t*)ws, (h16_t*)p.out, (float*)(ws + WS_GDEC), lds, (unsigned*)(ws + WS_CTL) + CW_CSQ); })
  PH(8, gla_u_phase((const bf16_t*)(ws + WS_K0), (const bf16_t*)(ws + WS_V0), (const h16_t*)ws, (const h16_t*)p.out, (bf16_t*)(ws + WS_STATE), lds))
  PH(9, gla_scan_phase((bf16_t*)(ws + WS_STATE), (const float*)(ws + WS_GDEC), wr))
  PH(10, gla_o_phase((const bf16_t*)(ws + WS_Q0), (const bf16_t*)(ws + WS_K0), (const bf16_t*)(ws + WS_V0), (const h16_t*)ws, (const h16_t*)p.out, (const bf16_t*)(ws + WS_STATE), p.in[16], (const float*)(ws + WS_SSQ), p.in[13], (bf16_t*)(ws + WS_Y0), lds, wr))
  PH(11, {
    pg8::Gemm g{(const bf16_t*)(ws + WS_Y0), (const bf16_t*)(ws + WS_W2T), ML, D, 2048}; pg8::StaticOrder S; S.init(ML, D, gridDim.x, (int)blockIdx.x);
    pg8::EpiResid E{p.in[0], X1, MOD, true};
    pg8::gemm_phase<pg8::EpiResid, pg8::StaticOrder, true, true>(lds, g, S, E);
    const float* ctx = p.in[2]; float* XC1 = (float*)(ws + WS_XC1); const float* gate = MOD + 2 * 3072 + 2048;
    small_gemm_splitk((const bf16_t*)(ws + WS_Y0) + (size_t)ML * 2048, 2048, (const bf16_t*)(ws + WS_W2T), 2048, 2048, MC, D, lds,
               [=](int m, int n, float v) { XC1[(size_t)m * D + n] = ctx[(size_t)m * D + n] + gate[n] * v; }); })
  PH(12, prep_phase(X1, (const float*)(ws + WS_XC1), p.in[18], MOD + 3 * 3072, (bf16_t*)(ws + WS_H1)))
  PH(13, {
    pg8::Gemm g{(const bf16_t*)(ws + WS_H1), (const bf16_t*)(ws + WS_W3T), ML, O_IN, D}; pg8::StaticOrder S; S.init(ML, O_IN, gridDim.x, (int)blockIdx.x);
    pg8::EpiProj1 E{(bf16_t*)(ws + WS_K1), (bf16_t*)(ws + WS_V1), (bf16_t*)(ws + WS_Q1), (bf16_t*)(ws + WS_G1), p.in[22], p.in[23], (const float*)(ws + WS_ROPE), (LAS float*)(lds + 131072)};
    pg8::gemm_phase<pg8::EpiProj1, pg8::StaticOrder, true, true>(lds, g, S, E);
    bf16_t* K1 = (bf16_t*)(ws + WS_K1); bf16_t* V1 = (bf16_t*)(ws + WS_V1);
    small_gemm((const bf16_t*)(ws + WS_H1) + (size_t)ML * D, D, (const bf16_t*)(ws + WS_W3T), D, D, MC, 1024,
               [=](int m, int n, float v) { if (n < 512) K1[(size_t)(ML + m) * 512 + n] = f2bf(v); else V1[(size_t)(ML + m) * 512 + (n - 512)] = f2bf(v); }); })
  PH(15, attn_phase((bf16_t*)(ws + WS_Q1), (const bf16_t*)(ws + WS_K1), (const bf16_t*)(ws + WS_V1), (const bf16_t*)(ws + WS_G1), p.in[24], p.in[22], p.in[23], lds, wr))
  PH(16, {
    pg8::Gemm g{(const bf16_t*)(ws + WS_Q1), (const bf16_t*)(ws + WS_W4T), ML, D, 2048}; pg8::StaticOrder S; S.init(ML, D, gridDim.x, (int)blockIdx.x);
    pg8::EpiResid E{X1, p.out, MOD + 3 * 3072, wr};
    pg8::gemm_phase<pg8::EpiResid, pg8::StaticOrder, true, true>(lds, g, S, E); })
#undef PH
#undef IN
#undef SEAM
}
extern "C" void kernel_launch(void* const* d_in, const int* in_sizes, int n_in, void* d_out, int out_size, void* d_ws, size_t ws_size, hipStream_t stream) {
  static int grid_blocks = 0;
  if (!grid_blocks) {
    int dev = 0, cus = 0, per_cu = 0;
    hipGetDevice(&dev);
    hipDeviceGetAttribute(&cus, hipDeviceAttributeMultiprocessorCount, dev);
    hipFuncSetAttribute((const void*)mega, hipFuncAttributeMaxDynamicSharedMemorySize, LDS_BYTES);
    hipOccupancyMaxActiveBlocksPerMultiprocessor(&per_cu, (const void*)mega, NWAVES * 64, LDS_BYTES);
    if (per_cu < 1) { fprintf(stderr, "kernel_launch: occupancy query says %d blocks per CU\n", per_cu); per_cu = 1; }
    if (per_cu > 1) per_cu = 1;
    grid_blocks = cus * per_cu;
  }
  hipMemsetAsync((char*)d_ws + WS_CTL, 0, 64 * 1024, stream);
  Params base{};
  for (int i = 0; i < 26; ++i) base.in[i] = (const float*)d_in[i];
  base.out = (float*)d_out; base.ws = (unsigned char*)d_ws;
  auto launch = [&](int lo, int hi) {
    Params p = base; p.ph_lo = lo; p.ph_hi = hi; p.rep = (int)PROBE_MASK; void* args[] = {&p};
    hipError_t e = hipLaunchCooperativeKernel((const void*)mega, dim3(grid_blocks), dim3(NWAVES * 64), args, LDS_BYTES, stream);
    if (e != hipSuccess) fprintf(stderr, "cooperative launch failed: %s (grid %d)\n", hipGetErrorString(e), grid_blocks);
  };
  launch(0, 17);
}
```

```cpp
#include <hip/hip_runtime.h>
#include <hip/hip_cooperative_groups.h>
#include <stdint.h>
#include <math.h>
#include <cstdio>
namespace cg = cooperative_groups;
#ifndef PROBE_SKIP
#define PROBE_SKIP 0
#endif
#ifndef PROBE_MASK
#define PROBE_MASK 0u
#endif

typedef unsigned short bf16_t;
#define DEV __device__ __forceinline__

DEV float bf2f(bf16_t v) { return __uint_as_float(((unsigned)v) << 16); }
typedef float f32x2_t __attribute__((ext_vector_type(2))); typedef __bf16 bf16x2_t __attribute__((ext_vector_type(2)));
DEV unsigned pk2(float lo, float hi) { const f32x2_t v = {lo, hi}; const bf16x2_t b = __builtin_convertvector(v, bf16x2_t); return __builtin_bit_cast(unsigned, b); }
DEV bf16_t f2bf(float f) { return (bf16_t)(pk2(f, 0.f) & 0xffffu); }
DEV float fexp(float x) { return __builtin_amdgcn_exp2f(x * 1.4426950408889634f); }
DEV float siluf(float x) { return x / (1.f + fexp(-x)); }
DEV float silu_fast(float x) { return x * __builtin_amdgcn_rcpf(1.f + fexp(-x)); }
DEV float softplusf(float x) { return x > 20.f ? x : log1pf(fexp(x)); }
DEV float logsigmoidf(float x) { return fminf(x, 0.f) - log1pf(fexp(-fabsf(x))); }

constexpr int D = 1024, NB = 2, SEQ = 8192, CTXL = 256;
constexpr int ML = NB * SEQ;
constexpr int MC = NB * CTXL;
constexpr int MA = ML + MC;
constexpr int NCH = MA / 128;
constexpr int E_IN = 5696, O_IN = 5120, E_INP = 5888;
constexpr float EPS = 1e-6f;

constexpr size_t MiB = 1u << 20;
constexpr int CW_CSQ = 8192;
constexpr size_t WS_CTL = 0;
constexpr size_t WS_MOD = 1 * MiB;
constexpr size_t WS_ROPE = 1 * MiB + 128 * 1024;
constexpr size_t WS_SDEC = 1 * MiB + 256 * 1024;
constexpr size_t WS_GDEC = 1 * MiB + 384 * 1024;
constexpr size_t WS_W1T = 2 * MiB;
constexpr size_t WS_W2T = 14 * MiB;
constexpr size_t WS_W3T = 18 * MiB;
constexpr size_t WS_W4T = 28 * MiB;
constexpr size_t WS_Y0 = 32 * MiB;
constexpr size_t WS_Q0 = 98 * MiB;
constexpr size_t WS_K0 = WS_Q0 + 16 * MiB + 512 * 1024;
constexpr size_t WS_V0 = 131 * MiB;
constexpr size_t WS_DTLR = 164 * MiB;
constexpr size_t WS_XC1 = 168 * MiB + 512 * 1024;
constexpr size_t WS_XBC = 171 * MiB;
constexpr size_t WS_STATE = 171 * MiB;
constexpr size_t WS_TAIL = 237 * MiB;
constexpr size_t WS_H1 = 32 * MiB;
constexpr size_t WS_K1 = 65 * MiB;
constexpr size_t WS_V1 = 81 * MiB + 512 * 1024;
constexpr size_t WS_Q1 = 98 * MiB;
constexpr size_t WS_G1 = 171 * MiB;

DEV int row_vec(int row) { return row < ML ? (row / SEQ) : 2; }

namespace pg8 {
#define PG8_LAS __attribute__((address_space(3)))
typedef unsigned short bf16_t;
typedef short bf16x8 __attribute__((ext_vector_type(8)));
typedef float f32x4 __attribute__((ext_vector_type(4)));
typedef unsigned u32x4 __attribute__((ext_vector_type(4)));
constexpr int BM = 256, BK = 64, HALF = 128, HTB = HALF * BK * 2  , STAGE_BYTES = 8 * HTB, NXCD = 8, WGM = 8;

__host__ __device__ __forceinline__ int lds_byte(int r, int c) { const int st = (r >> 4) * 2 + (c >> 5), rr = r & 15, cc = c & 31, ob = rr * 64 + cc * 2; return st * 1024 + (ob ^ (((ob >> 9) & 1) << 5)); }
__host__ __device__ __forceinline__ void stage_rc(int b, int& R, int& C) { const int st = b / 1024, sb = b % 1024, swz = sb ^ (((sb >> 9) & 1) << 5); R = (st >> 1) * 16 + swz / 64; C = (st & 1) * 32 + (swz % 64) / 2; }
__host__ __device__ __forceinline__ int perm32(int rho) { const int n = rho >> 4, i = rho & 15; return 8 * (i >> 2) + 4 * n + (i & 3); }

struct Unit { int pm, pn; };
struct Gemm { const bf16_t* A; const bf16_t* Bt; int M, N, K; };

struct StaticOrder {
    int nM, nN, nwg, G, c;
    __host__ __device__ __forceinline__ void init(int M, int N, int G_, int c_) { nM = M / BM; nN = N / BM; nwg = nM * nN; G = G_; c = c_; }
    __host__ __device__ __forceinline__ bool next(int i, Unit& u) const {
        const long L = (long)i * G + c; if (L >= nwg) return false;
        int wgid = (int)L; { const int q = nwg / NXCD, r = nwg % NXCD, xcd = wgid % NXCD, off = wgid / NXCD; wgid = (xcd < r ? xcd * (q + 1) : r * (q + 1) + (xcd - r) * q) + off; }
        const int nig = WGM * nN, gid = wgid / nig, fm = gid * WGM, gsz = (nM - fm) < WGM ? (nM - fm) : WGM;
        u.pm = fm + ((wgid % nig) % gsz); u.pn = (wgid % nig) / gsz; return true;
    }
    __device__ __forceinline__ void a_ready(const Unit&) const {}
    __device__ __forceinline__ void done(const Unit&) const {}
};
__device__ __forceinline__ unsigned cvt_pk_bf16(float lo, float hi) { unsigned r; asm volatile("v_cvt_pk_bf16_f32 %0, %1, %2" : "=v"(r) : "v"(lo), "v"(hi)); return r; }
__device__ __forceinline__ float silu_e(float x) { return x * __builtin_amdgcn_rcpf(1.f + fexp(-x)); }

__device__ __forceinline__ void store_unit_bf16(const f32x4 (&acc)[2][2][4][2], bf16_t* base, int ld, int colt, bool act, const Unit& u, int wr, int wc, int fr, int fq) {
    const int row0 = u.pm * BM + wr * 64 + fr; const int col0 = colt + wc * 32 + 8 * fq;
#pragma unroll
    for (int ai = 0; ai < 2; ++ai)
#pragma unroll
        for (int m = 0; m < 4; ++m) { bf16_t* rowp = base + (size_t)(row0 + ai * HALF + m * 16) * ld + col0;
#pragma unroll
            for (int bj = 0; bj < 2; ++bj) { f32x4 v0 = acc[ai][bj][m][0], v1 = acc[ai][bj][m][1];
                if (act) { v0 = (f32x4){silu_e(v0[0]), silu_e(v0[1]), silu_e(v0[2]), silu_e(v0[3])}; v1 = (f32x4){silu_e(v1[0]), silu_e(v1[1]), silu_e(v1[2]), silu_e(v1[3])}; }
                u32x4 w; w.x = cvt_pk_bf16(v0[0], v0[1]); w.y = cvt_pk_bf16(v0[2], v0[3]); w.z = cvt_pk_bf16(v1[0], v1[1]); w.w = cvt_pk_bf16(v1[2], v1[3]);
                *(u32x4*)(rowp + bj * HALF) = w; } }
}
struct EpiProj0 {
    static constexpr bool PERM = true, AFTER_DRAIN = false;
    bf16_t *Y0, *XBC, *Q0, *K0, *V0; float* DTLR;
    __device__ __forceinline__ void operator()(const f32x4 (&acc)[2][2][4][2], const Unit& u, int wr, int wc, int fr, int fq) const {
        const int pn = u.pn;
        if (pn == 22) {
            if (wc < 2) { const int row0 = u.pm * BM + wr * 64 + fr;
#pragma unroll
                for (int ai = 0; ai < 2; ++ai)
#pragma unroll
                    for (int m = 0; m < 4; ++m) { float* rp = DTLR + (size_t)(row0 + ai * HALF + m * 16) * 64 + wc * 32 + 8 * fq; *(f32x4*)rp = acc[ai][0][m][0]; *(f32x4*)(rp + 4) = acc[ai][0][m][1]; } }
            return;
        }
        bf16_t* base; int ld, colt; bool act = false;
        if (pn < 8) { base = Y0; ld = 2048; colt = pn * 256; act = true; }
        else if (pn < 14) { base = XBC; ld = 1536; colt = (pn - 8) * 256; }
        else if (pn < 16) { base = Q0; ld = 512; colt = (pn - 14) * 256; }
        else if (pn < 18) { base = K0; ld = 512; colt = (pn - 16) * 256; }
        else { base = V0; ld = 1024; colt = (pn - 18) * 256; }
        store_unit_bf16(acc, base, ld, colt, act, u, wr, wc, fr, fq);
    }
};
struct EpiProj1 {
    static constexpr bool PERM = true, AFTER_DRAIN = false;
    bf16_t *K1, *V1, *Q1, *G1; const float *qn, *kn, *rope; PG8_LAS float* part;
    __device__ __forceinline__ void operator()(const f32x4 (&acc)[2][2][4][2], const Unit& u, int wr, int wc, int fr, int fq) const {
        const int pn = u.pn; bf16_t* base; int ld, colt; bool act = false;
        if (pn < 2) { base = K1; ld = 512; colt = pn * 256; }
        else if (pn < 4) { base = V1; ld = 512; colt = (pn - 2) * 256; }
        else if (pn < 12) { base = Q1; ld = 2048; colt = (pn - 4) * 256; }
        else { base = G1; ld = 2048; colt = (pn - 12) * 256; act = true; }
        const bool isk = pn < 2, isq = pn >= 4 && pn < 12;
        if (!(isk || isq)) { store_unit_bf16(acc, base, ld, colt, act, u, wr, wc, fr, fq); return; }
#pragma unroll
        for (int ai = 0; ai < 2; ++ai)
#pragma unroll
            for (int m = 0; m < 4; ++m)
#pragma unroll
                for (int bj = 0; bj < 2; ++bj) { const f32x4 x0 = acc[ai][bj][m][0], x1 = acc[ai][bj][m][1];
                    float s = (x0[0] * x0[0] + x0[1] * x0[1]) + (x0[2] * x0[2] + x0[3] * x0[3]) + (x1[0] * x1[0] + x1[1] * x1[1]) + (x1[2] * x1[2] + x1[3] * x1[3]);
                    s += __shfl_xor(s, 16); s += __shfl_xor(s, 32);
                    if (fq == 0) part[(ai * HALF + wr * 64 + m * 16 + fr) * 8 + bj * 4 + wc] = s; }
        asm volatile("s_waitcnt lgkmcnt(0)" ::: "memory"); __builtin_amdgcn_s_barrier(); asm volatile("" ::: "memory");
        const int a = wc >> 1, f0 = 16 * (wc & 1) + 4 * fq;
        const float* gn = (isq ? qn : kn) + a * 64 + f0;
        const f32x4 g0 = *(const f32x4*)gn, g1 = *(const f32x4*)(gn + 32);
        const float osc = isq ? 0.08838834764831845f * 1.4426950408889634f : 1.f;
        const int col0 = colt + wc * 32 + 8 * fq;
        f32x4 w_[2][2][4][2];
#pragma unroll
        for (int ai = 0; ai < 2; ++ai)
#pragma unroll
            for (int bj = 0; bj < 2; ++bj)
#pragma unroll
                for (int m = 0; m < 4; ++m) { w_[ai][bj][m][0] = acc[ai][bj][m][0]; w_[ai][bj][m][1] = acc[ai][bj][m][1]; }
#pragma unroll 1
        for (int m = 0; m < 4; ++m) {
#pragma unroll
            for (int ai = 0; ai < 2; ++ai) { const int rowl = ai * HALF + wr * 64 + m * 16 + fr, row = u.pm * BM + rowl, t = row & 8191, pos = a ? (t & 63) : (t >> 6);
                const f32x4 cs = *(const f32x4*)(rope + pos * 32 + f0), sn = *(const f32x4*)(rope + 4096 + pos * 32 + f0);
                bf16_t* rowp = base + (size_t)row * ld + col0;
#pragma unroll
                for (int bj = 0; bj < 2; ++bj) { const f32x4 p4 = *(const PG8_LAS f32x4*)(part + rowl * 8 + bj * 4);
                    const float rstd = __builtin_amdgcn_rsqf(((p4[0] + p4[1]) + (p4[2] + p4[3])) * (1.f / 128.f) + 1e-6f) * osc;
                    const f32x4 t1 = w_[ai][bj][0][0] * g0 * rstd, t2 = w_[ai][bj][0][1] * g1 * rstd;
                    const f32x4 o1 = t1 * cs - t2 * sn, o2 = t2 * cs + t1 * sn;
                    u32x4 w; w.x = cvt_pk_bf16(o1[0], o1[1]); w.y = cvt_pk_bf16(o1[2], o1[3]); w.z = cvt_pk_bf16(o2[0], o2[1]); w.w = cvt_pk_bf16(o2[2], o2[3]);
                    *(u32x4*)(rowp + bj * HALF) = w; } }
#pragma unroll
            for (int ai = 0; ai < 2; ++ai)
#pragma unroll
                for (int bj = 0; bj < 2; ++bj)
#pragma unroll
                    for (int n = 0; n < 2; ++n) { w_[ai][bj][0][n] = w_[ai][bj][1][n]; w_[ai][bj][1][n] = w_[ai][bj][2][n]; w_[ai][bj][2][n] = w_[ai][bj][3][n]; }
        }
    }
};
struct EpiResid {
    static constexpr bool PERM = false, AFTER_DRAIN = false;
    const float* res; float* out; const float* mod; bool do_store;
    __device__ __forceinline__ void operator()(const f32x4 (&acc)[2][2][4][2], const Unit& u, int wr, int wc, int fr, int fq) const {
        const int b = (u.pm * BM) / 8192; const float* gate = mod + b * 3072 + 2048;
        const int col0 = u.pn * BM + wc * 32 + 4 * fq;
        f32x4 gv[2][2];
#pragma unroll
        for (int bj = 0; bj < 2; ++bj)
#pragma unroll
            for (int n = 0; n < 2; ++n) gv[bj][n] = *(const f32x4*)(gate + col0 + bj * HALF + n * 16);
#pragma unroll
        for (int ai = 0; ai < 2; ++ai)
#pragma unroll
            for (int m = 0; m < 4; ++m) { const size_t off = (size_t)(u.pm * BM + ai * HALF + wr * 64 + m * 16 + fr) * 1024 + col0;
#pragma unroll
                for (int bj = 0; bj < 2; ++bj)
#pragma unroll
                    for (int n = 0; n < 2; ++n) { const f32x4 r = *(const f32x4*)(res + off + bj * HALF + n * 16); const f32x4 ov_ = r + gv[bj][n] * acc[ai][bj][m][n]; if (do_store) *(f32x4*)(out + off + bj * HALF + n * 16) = ov_; } }
    }
};
template <class Epi, class Sched, bool ALIGN_EPI = false, bool SP2 = false>
__device__ __forceinline__ void gemm_phase(PG8_LAS unsigned char* lds, const Gemm g, const Sched& S, const Epi& E) {
    const int tid = threadIdx.x, wid = __builtin_amdgcn_readfirstlane(tid >> 6), lane = tid & 63, wr = wid >> 2, wc = wid & 3, fr = lane & 15, fq = lane >> 4;
    const int K = g.K, nt = K / BK;
    unsigned voffA[2], voffB[2];
#pragma unroll
    for (int i = 0; i < 2; ++i) { int R, C; stage_rc(tid * 16 + i * 8192, R, C); const int Rb = Epi::PERM ? ((R & ~31) + perm32(R & 31)) : R;
        voffA[i] = (unsigned)(R * K + C) * 2u; voffB[i] = (unsigned)(Rb * K + C) * 2u; }
    const size_t kstep = (size_t)(BK * 2);
    const size_t hstep = (size_t)HALF * K * 2;
    const size_t tstep = 2 * hstep;
    const unsigned ldsw = (unsigned)wid * 1024u;
    const int aoff = lds_byte(wr * 64 + fr, fq * 8), boff = lds_byte(wc * 32 + fr, fq * 8);
#define PG8_SA(b, h) (((b) * 2 + (h)) * HTB)
#define PG8_SB(b, h) ((4 + (b) * 2 + (h)) * HTB)
#define PG8_STAGE(bufoff, gbase, voff) do { _Pragma("unroll") for (int _i = 0; _i < 2; ++_i) \
        __builtin_amdgcn_global_load_lds((const unsigned*)((const char*)(gbase) + (voff)[_i]), (PG8_LAS unsigned*)(lds + (bufoff) + ldsw + _i * 8192), 16, 0, 0); } while (0)
#define PG8_LDA(dst, b, h) do { _Pragma("unroll") for (int m = 0; m < 4; ++m) _Pragma("unroll") for (int k = 0; k < 2; ++k) dst[m][k] = *(const PG8_LAS bf16x8*)(lds + PG8_SA(b, h) + aoff + m * 2048 + k * 1024); } while (0)
#define PG8_LDB(dst, b, h) do { _Pragma("unroll") for (int n = 0; n < 2; ++n) _Pragma("unroll") for (int k = 0; k < 2; ++k) dst[n][k] = *(const PG8_LAS bf16x8*)(lds + PG8_SB(b, h) + boff + n * 2048 + k * 1024); } while (0)
#define PG8_MMA(ai, bj, At, Bt) do { __builtin_amdgcn_s_setprio(1); _Pragma("unroll") for (int m = 0; m < 4; ++m) _Pragma("unroll") for (int n = 0; n < 2; ++n) _Pragma("unroll") for (int k = 0; k < 2; ++k) \
        acc[ai][bj][m][n] = __builtin_amdgcn_mfma_f32_16x16x32_bf16(Bt[n][k], At[m][k], acc[ai][bj][m][n], 0, 0, 0); __builtin_amdgcn_s_setprio(0); } while (0)
#define PG8_WAIT_V(n) asm volatile("s_waitcnt vmcnt(" #n ")" ::: "memory")
#define PG8_WAIT_L(n) asm volatile("s_waitcnt lgkmcnt(" #n ")" ::: "memory")
#define PG8_BAR __builtin_amdgcn_s_barrier()
#define PG8_SCHED __builtin_amdgcn_sched_barrier(0)
    Unit cur, nxt; int ui = 0;
    if (!S.next(0, cur)) return;
    f32x4 acc[2][2][4][2];
#pragma unroll
    for (int a = 0; a < 2; ++a)
#pragma unroll
        for (int b = 0; b < 2; ++b)
#pragma unroll
            for (int m = 0; m < 4; ++m)
#pragma unroll
                for (int n = 0; n < 2; ++n) acc[a][b][m][n] = (f32x4){0.f, 0.f, 0.f, 0.f};
    bf16x8 At[4][2], B0[2][2], B1[2][2];
    const char* cA = (const char*)g.A + (size_t)cur.pm * tstep; const char* cB = (const char*)g.Bt + (size_t)cur.pn * tstep;
    S.a_ready(cur);
    if constexpr (SP2) {
        PG8_STAGE(PG8_SB(0, 0), cB, voffB); PG8_STAGE(PG8_SB(0, 1), cB + hstep, voffB); PG8_STAGE(PG8_SA(0, 0), cA, voffA); PG8_STAGE(PG8_SA(0, 1), cA + hstep, voffA);
        if (wr == 1) PG8_BAR;
        PG8_WAIT_V(2); PG8_BAR;
        PG8_STAGE(PG8_SB(1, 0), cB + kstep, voffB); PG8_STAGE(PG8_SA(1, 0), cA + kstep, voffA); PG8_STAGE(PG8_SB(1, 1), cB + hstep + kstep, voffB);
        PG8_WAIT_V(6); PG8_BAR;
    } else {
        PG8_STAGE(PG8_SB(0, 0), cB, voffB); PG8_STAGE(PG8_SA(0, 0), cA, voffA); PG8_STAGE(PG8_SB(0, 1), cB + hstep, voffB); PG8_STAGE(PG8_SA(0, 1), cA + hstep, voffA);
        if (wr == 1) PG8_BAR;
        PG8_WAIT_V(4); PG8_BAR;
        PG8_STAGE(PG8_SB(1, 0), cB + kstep, voffB); PG8_STAGE(PG8_SA(1, 0), cA + kstep, voffA); PG8_STAGE(PG8_SB(1, 1), cB + hstep + kstep, voffB);
        PG8_WAIT_V(6); PG8_BAR;
    }
    for (;;) {
        const bool has_next = S.next(ui + 1, nxt);
        const char* nA = has_next ? (const char*)g.A + (size_t)nxt.pm * tstep : cA; const char* nB = has_next ? (const char*)g.Bt + (size_t)nxt.pn * tstep : cB;
        for (int t = 0; t < nt; t += 2) {
            const bool last = (t == nt - 2);
            const char* a1 = cA + (size_t)(t + 1) * kstep;
            const char* a2 = last ? nA : cA + (size_t)(t + 2) * kstep; const char* b2 = last ? nB : cB + (size_t)(t + 2) * kstep;
            const char* a3 = a2 + kstep; const char* b3 = b2 + kstep;
            if (last && has_next) S.a_ready(nxt);
            if constexpr (SP2) {
            PG8_LDB(B0, 0, 0); PG8_LDB(B1, 0, 1); PG8_SCHED; PG8_LDA(At, 0, 0); PG8_STAGE(PG8_SA(1, 1), a1 + hstep, voffA);
            PG8_WAIT_V(8); PG8_WAIT_L(0); PG8_BAR; PG8_MMA(0, 0, At, B0); PG8_MMA(0, 1, At, B1); PG8_BAR; PG8_SCHED;
            PG8_LDA(At, 0, 1); PG8_STAGE(PG8_SB(0, 0), b2, voffB); PG8_STAGE(PG8_SB(0, 1), b2 + hstep, voffB); PG8_STAGE(PG8_SA(0, 0), a2, voffA);
            PG8_WAIT_V(8); PG8_WAIT_L(0); PG8_BAR; PG8_MMA(1, 0, At, B0); PG8_MMA(1, 1, At, B1); PG8_BAR; PG8_SCHED;
            PG8_LDB(B0, 1, 0); PG8_LDB(B1, 1, 1); PG8_SCHED; PG8_LDA(At, 1, 0); PG8_STAGE(PG8_SA(0, 1), a2 + hstep, voffA);
            PG8_WAIT_V(8); PG8_WAIT_L(0); PG8_BAR; PG8_MMA(0, 0, At, B0); PG8_MMA(0, 1, At, B1); PG8_BAR; PG8_SCHED;
            PG8_LDA(At, 1, 1); PG8_STAGE(PG8_SB(1, 0), b3, voffB); PG8_STAGE(PG8_SB(1, 1), b3 + hstep, voffB); PG8_STAGE(PG8_SA(1, 0), a3, voffA);
            PG8_WAIT_V(8); PG8_WAIT_L(0); PG8_BAR; PG8_MMA(1, 0, At, B0); PG8_MMA(1, 1, At, B1); PG8_BAR; PG8_SCHED;
            } else {
            PG8_LDB(B0, 0, 0); PG8_SCHED; PG8_LDA(At, 0, 0); PG8_STAGE(PG8_SA(1, 1), a1 + hstep, voffA);
            PG8_WAIT_L(8); PG8_BAR; PG8_WAIT_L(0); PG8_MMA(0, 0, At, B0); PG8_BAR; PG8_SCHED;
            PG8_LDB(B1, 0, 1); PG8_STAGE(PG8_SB(0, 0), b2, voffB);
            PG8_BAR; PG8_WAIT_L(0); PG8_MMA(0, 1, At, B1); PG8_BAR;
            PG8_LDA(At, 0, 1); PG8_STAGE(PG8_SA(0, 0), a2, voffA);
            PG8_BAR; PG8_WAIT_L(0); PG8_MMA(1, 0, At, B0); PG8_BAR; PG8_SCHED;
            PG8_STAGE(PG8_SB(0, 1), b2 + hstep, voffB);
            PG8_WAIT_V(6); PG8_BAR; PG8_MMA(1, 1, At, B1); PG8_BAR;
            PG8_LDB(B0, 1, 0); PG8_SCHED; PG8_LDA(At, 1, 0); PG8_STAGE(PG8_SA(0, 1), a2 + hstep, voffA);
            PG8_WAIT_L(8); PG8_BAR; PG8_WAIT_L(0); PG8_MMA(0, 0, At, B0); PG8_BAR; PG8_SCHED;
            PG8_LDB(B1, 1, 1); PG8_STAGE(PG8_SB(1, 0), b3, voffB);
            PG8_BAR; PG8_WAIT_L(0); PG8_MMA(0, 1, At, B1); PG8_BAR;
            PG8_LDA(At, 1, 1); PG8_STAGE(PG8_SA(1, 0), a3, voffA);
            PG8_BAR; PG8_WAIT_L(0); PG8_MMA(1, 0, At, B0); PG8_BAR; PG8_SCHED;
            PG8_STAGE(PG8_SB(1, 1), b3 + hstep, voffB);
            PG8_WAIT_V(6); PG8_BAR; PG8_MMA(1, 1, At, B1); PG8_BAR;
            }
        }
        if constexpr (ALIGN_EPI) { if (wr == 0) PG8_BAR; }
        if constexpr (!Epi::AFTER_DRAIN) { E(acc, cur, wr, wc, fr, fq); S.done(cur); }
        if (!has_next) break;
#pragma unroll
        for (int a = 0; a < 2; ++a)
#pragma unroll
            for (int b = 0; b < 2; ++b)
#pragma unroll
                for (int m = 0; m < 4; ++m)
#pragma unroll
                    for (int n = 0; n < 2; ++n) acc[a][b][m][n] = (f32x4){0.f, 0.f, 0.f, 0.f};
        cur = nxt; cA = nA; cB = nB; ++ui;
        if constexpr (ALIGN_EPI) { if (wr == 1) PG8_BAR; }
    }
    PG8_WAIT_V(0);
    if constexpr (!ALIGN_EPI) { if (wr == 0) PG8_BAR; }
    PG8_BAR;
    if constexpr (Epi::AFTER_DRAIN) { E.fused(acc, cur, wr, wc, fr, fq, lds, wid, lane); S.done(cur); }
#undef PG8_SA
#undef PG8_SB
#undef PG8_STAGE
#undef PG8_LDA
#undef PG8_LDB
#undef PG8_MMA
#undef PG8_WAIT_V
#undef PG8_WAIT_L
#undef PG8_BAR
#undef PG8_SCHED
}
}
#define LAS __attribute__((address_space(3)))
typedef unsigned v4u __attribute__((ext_vector_type(4)));
typedef float f32x4 __attribute__((ext_vector_type(4)));
typedef short bf16x8 __attribute__((ext_vector_type(8)));
#define LDS_WAIT() asm volatile("s_waitcnt lgkmcnt(0)" ::: "memory")
constexpr int NWAVES = 8;
constexpr int LDS_BYTES = 147456;
constexpr int MISC_OFF = 147456 - 128;

struct Params { const float* in[26]; float* out; unsigned char* ws; int ph_lo, ph_hi, rep, pad; };

DEV int virt_block() { const int G = (int)gridDim.x, b = (int)blockIdx.x; return (G % 8 == 0) ? (b % 8) * (G / 8) + b / 8 : b; }
DEV float wave_sum(float v) {
#pragma unroll
  for (int o = 1; o < 64; o <<= 1) v += __shfl_xor(v, o);
  return v;
}

DEV int w1_dest_row(int n) {
  if (n < 1024) return n;
  if (n < 2560) return 2048 + (n - 1024);
  if (n < 2592) return 5632 + (n - 2560);
  if (n < 3104) return 3584 + (n - 2592);
  if (n < 3616) return 4096 + (n - 3104);
  if (n < 4640) return 4608 + (n - 3616);
  if (n < 5664) return 1024 + (n - 4640);
  return n;
}
DEV int qk_pos(int d) { const int a = d >> 6, s = (d >> 5) & 1, f = d & 31; return 32 * (2 * a + (f >> 4)) + 8 * ((f >> 2) & 3) + 4 * s + (f & 3); }
DEV void transpose_item(const float* W, int K, int N, int k0, int n0, bf16_t* WT, int drow0, LAS float* scr, int lane, int headbase = -1) {
#pragma unroll 8
  for (int i = 0; i < 32; ++i) { const int kk = 2 * i + (lane >> 5); scr[kk * 33 + (lane & 31)] = W[(size_t)(k0 + kk) * N + n0 + (lane & 31)]; }
  LDS_WAIT(); asm volatile("" ::: "memory");
  const int c = lane & 7;
#pragma unroll
  for (int j = 0; j < 4; ++j) { const int n = (lane >> 3) + 8 * j; const LAS float* s = scr + (8 * c) * 33 + n;
    v4u o; o.x = pk2(s[0 * 33], s[1 * 33]); o.y = pk2(s[2 * 33], s[3 * 33]); o.z = pk2(s[4 * 33], s[5 * 33]); o.w = pk2(s[6 * 33], s[7 * 33]);
    const int drow = headbase >= 0 ? headbase + qk_pos((n0 & 127) + n) : drow0 + n;
    *(v4u*)(WT + (size_t)drow * K + k0 + 8 * c) = o; }
  LDS_WAIT(); asm volatile("" ::: "memory");
}
DEV void prologue_phase(const Params& p, LAS unsigned char* lds) {
  const int tid = threadIdx.x, lane = tid & 63, wave = tid >> 6;
  unsigned char* ws = p.ws;
  float* MOD = (float*)(ws + WS_MOD);
  {
    LAS float* sc = (LAS float*)lds;
    LAS float* part = (LAS float*)(lds + 12288);
    for (int i = tid; i < 3072; i += 512) { const int v = i >> 10, k = i & 1023; const float cv = v < 2 ? p.in[1][v * 1024 + k] : p.in[3][k]; sc[i] = siluf(cv); }
    __syncthreads();
    for (int task = blockIdx.x; task < 96; task += gridDim.x) {
      const int l = task / 48, n0 = (task % 48) * 64; const float* w = l ? p.in[19] : p.in[5]; const float* bb = l ? p.in[20] : p.in[6];
      const int col = tid & 63, ks = tid >> 6;
      float a0 = 0.f, a1 = 0.f, a2 = 0.f;
#pragma unroll 8
      for (int k = ks * 128; k < ks * 128 + 128; ++k) { const float wv = w[(size_t)k * 3072 + n0 + col]; a0 += sc[k] * wv; a1 += sc[1024 + k] * wv; a2 += sc[2048 + k] * wv; }
      part[(ks * 3 + 0) * 64 + col] = a0; part[(ks * 3 + 1) * 64 + col] = a1; part[(ks * 3 + 2) * 64 + col] = a2;
      __syncthreads();
      if (tid < 192) { const int v = tid >> 6; float s = bb[n0 + col];
#pragma unroll
        for (int q = 0; q < 8; ++q) s += part[(q * 3 + v) * 64 + col];
        MOD[(l * 3 + v) * 3072 + n0 + col] = s; }
      __syncthreads();
    }
  }
  if (blockIdx.x == gridDim.x - 1) { float* rope = (float*)(ws + WS_ROPE);
    for (int idx = tid; idx < 4096; idx += 512) { const int pos = idx >> 5, f = idx & 31; const float inv = 1.0f / powf(10000.f, (float)f / 32.f); const float ang = (float)pos * inv; rope[idx] = cosf(ang); rope[4096 + idx] = sinf(ang); } }
  { v4u* z = (v4u*)(ws + WS_W1T + (size_t)E_IN * 1024 * 2); const v4u zero = {0u, 0u, 0u, 0u};
    for (int i = blockIdx.x * 512 + tid; i < (E_INP - E_IN) * 1024 * 2 / 16; i += gridDim.x * 512) z[i] = zero; }
  __syncthreads();
  {
    LAS float* scr = (LAS float*)(lds + wave * 16384);
    const int gw = blockIdx.x * NWAVES + wave, NGW = gridDim.x * NWAVES;
    constexpr int I1 = 16 * 178;
    for (int it = gw; it < I1; it += NGW) { const int kb = it / 178, nb = it % 178; transpose_item(p.in[7], 1024, E_IN, 64 * kb, 32 * nb, (bf16_t*)(ws + WS_W1T), w1_dest_row(32 * nb), scr, lane); }
  }
}
DEV void late_weights(const Params& p, LAS unsigned char* lds, int vblock, int nvblocks) {
  const int lane = threadIdx.x & 63, wave = threadIdx.x >> 6; unsigned char* ws = p.ws;
  LAS float* scr = (LAS float*)(lds + wave * 16384);
  constexpr int I2 = 32 * 32, I3 = 16 * 160, I4 = 32 * 32;
  for (int it = vblock * NWAVES + wave; it < I2 + I3 + I4; it += nvblocks * NWAVES) {
    int r = it;
    if (r < I2) { const int kb = r / 32, nb = r % 32; transpose_item(p.in[17], 2048, 1024, 64 * kb, 32 * nb, (bf16_t*)(ws + WS_W2T), 32 * nb, scr, lane); continue; } r -= I2;
    if (r < I3) { const int kb = r / 160, nb = r % 160, n0 = 32 * nb; const bool qk = n0 < 512 || (n0 >= 1024 && n0 < 3072);
      transpose_item(p.in[21], 1024, O_IN, 64 * kb, n0, (bf16_t*)(ws + WS_W3T), n0, scr, lane, qk ? (n0 & ~127) : -1); continue; } r -= I3;
    { const int kb = r / 32, nb = r % 32; transpose_item(p.in[25], 2048, 1024, 64 * kb, 32 * nb, (bf16_t*)(ws + WS_W4T), 32 * nb, scr, lane); }
  }
}
DEV void prep_phase(const float* xlat, const float* xctx, const float* g, const float* mod, bf16_t* H) {
  const int lane = threadIdx.x & 63, wave = threadIdx.x >> 6;
  for (int row = blockIdx.x * NWAVES + wave; row < MA; row += gridDim.x * NWAVES) {
    const float* src = row < ML ? xlat + (size_t)row * D : xctx + (size_t)(row - ML) * D;
    const float* m = mod + row_vec(row) * 3072;
    f32x4 v[4]; float ss = 0.f;
#pragma unroll
    for (int j = 0; j < 4; ++j) { v[j] = *(const f32x4*)(src + 4 * lane + 256 * j); ss += (v[j].x * v[j].x + v[j].y * v[j].y) + (v[j].z * v[j].z + v[j].w * v[j].w); }
    const float rstd = rsqrtf(wave_sum(ss) * (1.f / D) + EPS);
#pragma unroll
    for (int j = 0; j < 4; ++j) { const int k = 4 * lane + 256 * j;
      const f32x4 gg = *(const f32x4*)(g + k), sc = *(const f32x4*)(m + 1024 + k), sh = *(const f32x4*)(m + k);
      const f32x4 o = v[j] * rstd * gg * (sc + 1.f) + sh;
      *(unsigned long long*)(H + (size_t)row * D + k) = (unsigned long long)pk2(o.x, o.y) | ((unsigned long long)pk2(o.z, o.w) << 32); }
  }
}
template <class F> DEV void small_gemm(const bf16_t* A, int lda, const bf16_t* Bt, int ldb, int K, int Mrows, int Ncols, F f) {
  const int lane = threadIdx.x & 63, wid = threadIdx.x >> 6, mt = wid >> 2, nt = wid & 3, r = lane & 15, q = lane >> 4;
  const int ntn = Ncols / 64, ntasks = (Mrows / 32) * ntn;
  for (int task = blockIdx.x; task < ntasks; task += gridDim.x) {
    const int row0 = (task / ntn) * 32 + mt * 16, col0 = (task % ntn) * 64 + nt * 16;
    const bf16_t* ap = A + (size_t)(row0 + r) * lda + 8 * q; const bf16_t* bp = Bt + (size_t)(col0 + r) * ldb + 8 * q;
    f32x4 acc = {0.f, 0.f, 0.f, 0.f};
#pragma unroll 8
    for (int k = 0; k < K; k += 32) { const bf16x8 a = *(const bf16x8*)(ap + k), b = *(const bf16x8*)(bp + k); acc = __builtin_amdgcn_mfma_f32_16x16x32_bf16(a, b, acc, 0, 0, 0); }
#pragma unroll
    for (int j = 0; j < 4; ++j) f(row0 + q * 4 + j, col0 + r, acc[j]);
  }
}

template <class F> DEV void small_gemm_splitk(const bf16_t* A, int lda, const bf16_t* Bt, int ldb, int K, int Mrows, int Ncols, LAS unsigned char* lds, F f) {
  const int tid = threadIdx.x, lane = tid & 63, wid = tid >> 6, r = lane & 15, q = lane >> 4;
  LAS float* red = (LAS float*)lds;
  const int ntn = Ncols / 64, ntasks = (Mrows / 32) * ntn, kw = K / 8;
  for (int task = virt_block(); task < ntasks; task += gridDim.x) {
    const int row0 = (task / ntn) * 32, col0 = (task % ntn) * 64;
    const bf16_t* ap = A + (size_t)(row0 + r) * lda + wid * kw + 8 * q; const bf16_t* bp = Bt + (size_t)(col0 + r) * ldb + wid * kw + 8 * q;
    f32x4 acc[2][4];
#pragma unroll
    for (int mt = 0; mt < 2; ++mt)
#pragma unroll
      for (int nt = 0; nt < 4; ++nt) acc[mt][nt] = (f32x4){0.f, 0.f, 0.f, 0.f};
#pragma unroll 4
    for (int k = 0; k < kw; k += 32) {
      bf16x8 a[2], b[4];
#pragma unroll
      for (int mt = 0; mt < 2; ++mt) a[mt] = *(const bf16x8*)(ap + (size_t)(16 * mt) * lda + k);
#pragma unroll
      for (int nt = 0; nt < 4; ++nt) b[nt] = *(const bf16x8*)(bp + (size_t)(16 * nt) * ldb + k);
#pragma unroll
      for (int mt = 0; mt < 2; ++mt)
#pragma unroll
        for (int nt = 0; nt < 4; ++nt) acc[mt][nt] = __builtin_amdgcn_mfma_f32_16x16x32_bf16(a[mt], b[nt], acc[mt][nt], 0, 0, 0);
    }
    __syncthreads();
#pragma unroll
    for (int mt = 0; mt < 2; ++mt)
#pragma unroll
      for (int nt = 0; nt < 4; ++nt)
#pragma unroll
        for (int j = 0; j < 4; ++j) red[wid * 2048 + (16 * mt + 4 * q + j) * 64 + 16 * nt + r] = acc[mt][nt][j];
    __syncthreads();
#pragma unroll
    for (int o = 0; o < 4; ++o) { const int e = tid + 512 * o; float s = 0.f;
#pragma unroll
      for (int w = 0; w < 8; ++w) s += red[w * 2048 + e];
      f(row0 + (e >> 6), col0 + (e & 63), s); }
  }
}

DEV void qknorm_phase(bf16_t* Q1, bf16_t* K1, const float* qn, const float* kn, const float* rope, bool wr) {
  const int lane = threadIdx.x & 63, wave = threadIdx.x >> 6, hl = lane >> 4, d0 = (lane & 15) * 8;
  const float scale = 0.08838834764831845f * 1.4426950408889634f;
  float gq[8], gk[8];
#pragma unroll
  for (int e = 0; e < 8; ++e) { gq[e] = qn[d0 + e] * scale; gk[e] = kn[d0 + e]; }
  const int ax = d0 >> 6, sgn = (d0 >> 5) & 1, f0 = d0 & 31;
  for (int row = blockIdx.x * NWAVES + wave; row < MA; row += gridDim.x * NWAVES) {
    const bool lat = row < ML;
    v4u raw[5];
    raw[0] = *(const v4u*)(K1 + (size_t)row * 512 + hl * 128 + d0);
    if (lat) {
#pragma unroll
      for (int g = 0; g < 4; ++g) raw[1 + g] = *(const v4u*)(Q1 + (size_t)row * 2048 + (g * 4 + hl) * 128 + d0);
    }
    float cs[8], sn[8];
    if (lat) { const int t = row % SEQ, pos = ax ? (t & 63) : (t >> 6);
      const f32x4 c0 = *(const f32x4*)(rope + pos * 32 + f0), c1 = *(const f32x4*)(rope + pos * 32 + f0 + 4), s0 = *(const f32x4*)(rope + 4096 + pos * 32 + f0), s1 = *(const f32x4*)(rope + 4096 + pos * 32 + f0 + 4);
      cs[0] = c0.x; cs[1] = c0.y; cs[2] = c0.z; cs[3] = c0.w; cs[4] = c1.x; cs[5] = c1.y; cs[6] = c1.z; cs[7] = c1.w;
      sn[0] = s0.x; sn[1] = s0.y; sn[2] = s0.z; sn[3] = s0.w; sn[4] = s1.x; sn[5] = s1.y; sn[6] = s1.z; sn[7] = s1.w; }
    const int ng = lat ? 5 : 1;
#pragma unroll
    for (int g = 0; g < 5; ++g) {
      if (g < ng) {
        const v4u rv = raw[g];
        float v[8] = {__uint_as_float(rv.x << 16), __uint_as_float(rv.x & 0xffff0000u), __uint_as_float(rv.y << 16), __uint_as_float(rv.y & 0xffff0000u), __uint_as_float(rv.z << 16), __uint_as_float(rv.z & 0xffff0000u), __uint_as_float(rv.w << 16), __uint_as_float(rv.w & 0xffff0000u)};
        float ss = 0.f;
#pragma unroll
        for (int e = 0; e < 8; ++e) ss += v[e] * v[e];
        ss += __shfl_xor(ss, 1); ss += __shfl_xor(ss, 2); ss += __shfl_xor(ss, 4); ss += __shfl_xor(ss, 8);
        const float rstd = rsqrtf(ss * (1.f / 128.f) + EPS);
#pragma unroll
        for (int e = 0; e < 8; ++e) v[e] *= rstd * (g == 0 ? gk[e] : gq[e]);
        if (lat) {
#pragma unroll
          for (int e = 0; e < 8; ++e) { const float o = __shfl_xor(v[e], 4); v[e] = sgn ? (v[e] * cs[e] + o * sn[e]) : (v[e] * cs[e] - o * sn[e]); }
        }
        v4u ov; ov.x = pk2(v[0], v[1]); ov.y = pk2(v[2], v[3]); ov.z = pk2(v[4], v[5]); ov.w = pk2(v[6], v[7]);
        if (wr) { if (g == 0) *(v4u*)(K1 + (size_t)row * 512 + hl * 128 + d0) = ov; else *(v4u*)(Q1 + (size_t)row * 2048 + ((g - 1) * 4 + hl) * 128 + d0) = ov; }
      }
    }
  }
}
typedef short s16x4 __attribute__((ext_vector_type(4)));
DEV s16x4 tr_read(const LAS bf16_t* p) { return __builtin_bit_cast(s16x4, __builtin_amdgcn_ds_read_tr16_b64_v4i16((LAS s16x4*)p)); }
DEV void attn_phase(bf16_t* Q1, const bf16_t* K1, const bf16_t* V1, const bf16_t* G1, const float* sink, const float* qn, const float* kn, LAS unsigned char* lds, bool wr) {
  constexpr int KP = 136, VP = 144;
  LAS bf16_t* Ks = (LAS bf16_t*)lds;
  LAS bf16_t* Vs = (LAS bf16_t*)(lds + 2 * 64 * KP * 2);
  LAS float* dsc = (LAS float*)(lds + 2 * 64 * KP * 2 + 2 * 64 * VP * 2);
  const int tid = threadIdx.x, lane = tid & 63, wid = tid >> 6, r = lane & 15, Qd = lane >> 4;
  float mb;
  { float a = fmaxf(fabsf(qn[lane]), fabsf(qn[64 + lane])), b = fmaxf(fabsf(kn[lane]), fabsf(kn[64 + lane]));
#pragma unroll
    for (int o = 1; o < 64; o <<= 1) { a = fmaxf(a, __shfl_xor(a, o)); b = fmaxf(b, __shfl_xor(b, o)); }
    mb = a * b * 11.313708498984761f * 1.4426950408889634f; }
  for (int task = virt_block(); task < 1024; task += gridDim.x) {
    const int b = task >> 9, kvh = (task >> 7) & 3, qt = task & 127;
    const int hq = kvh * 4 + (wid >> 1), qoff = (wid & 1) * 32;
    const size_t qrow0 = (size_t)b * SEQ + qt * 64 + qoff;
    bf16x8 qf[2][4];
#pragma unroll
    for (int m = 0; m < 2; ++m)
#pragma unroll
      for (int ks = 0; ks < 4; ++ks) qf[m][ks] = *(const bf16x8*)(Q1 + (qrow0 + 16 * m + r) * 2048 + hq * 128 + ks * 32 + 8 * Qd);
    const int tlo = (2 - qt) > 0 ? (2 - qt) : 0, thi = (129 - qt) < 4 ? (129 - qt) : 4, nband = thi - tlo + 1, ntile = nband + 4;
    const int skey = tid >> 4, sch = tid & 15;
    float gk[8];
    { const int dA = ((sch >> 2) >> 1) * 64 + 16 * ((sch >> 2) & 1) + 4 * (sch & 3); const f32x4 ga = *(const f32x4*)(kn + dA), gb_ = *(const f32x4*)(kn + dA + 32);
      gk[0] = ga.x; gk[1] = ga.y; gk[2] = ga.z; gk[3] = ga.w; gk[4] = gb_.x; gk[5] = gb_.y; gk[6] = gb_.z; gk[7] = gb_.w; }
    v4u kreg[2], vreg[2];
#define TILE_ROW0(i) ((i) < nband ? (size_t)b * SEQ + (size_t)(qt - 2 + tlo + (i)) * 64 : (size_t)ML + b * CTXL + ((i) - nband) * 64)
#define LOAD_TILE(i) do { const size_t r0_ = TILE_ROW0(i); _Pragma("unroll") for (int h_ = 0; h_ < 2; ++h_) { const size_t go_ = (r0_ + skey + 32 * h_) * 512 + kvh * 128 + sch * 8; kreg[h_] = *(const v4u*)(K1 + go_); vreg[h_] = *(const v4u*)(V1 + go_); } } while (0)
#define STORE_TILE(buf, ti) do { const bool ctx_ = (ti) >= nband; _Pragma("unroll") for (int h_ = 0; h_ < 2; ++h_) { v4u kw_ = kreg[h_]; \
      if (ctx_) { float v_[8] = {__uint_as_float(kw_.x << 16), __uint_as_float(kw_.x & 0xffff0000u), __uint_as_float(kw_.y << 16), __uint_as_float(kw_.y & 0xffff0000u), __uint_as_float(kw_.z << 16), __uint_as_float(kw_.z & 0xffff0000u), __uint_as_float(kw_.w << 16), __uint_as_float(kw_.w & 0xffff0000u)}; \
        float ss_ = 0.f; _Pragma("unroll") for (int e_ = 0; e_ < 8; ++e_) ss_ += v_[e_] * v_[e_]; \
        ss_ += __shfl_xor(ss_, 1); ss_ += __shfl_xor(ss_, 2); ss_ += __shfl_xor(ss_, 4); ss_ += __shfl_xor(ss_, 8); \
        const float rs_ = rsqrtf(ss_ * (1.f / 128.f) + EPS); _Pragma("unroll") for (int e_ = 0; e_ < 8; ++e_) v_[e_] *= rs_ * gk[e_]; \
        kw_.x = pk2(v_[0], v_[1]); kw_.y = pk2(v_[2], v_[3]); kw_.z = pk2(v_[4], v_[5]); kw_.w = pk2(v_[6], v_[7]); } \
      *(LAS v4u*)(Ks + (buf) * 64 * KP + (skey + 32 * h_) * KP + sch * 8) = kw_; *(LAS v4u*)(Vs + (buf) * 64 * VP + (skey + 32 * h_) * VP + sch * 8) = vreg[h_]; } } while (0)
    LOAD_TILE(0);
    __syncthreads();
    STORE_TILE(0, 0);
    __syncthreads();
    f32x4 o[2][8];
#pragma unroll
    for (int m = 0; m < 2; ++m)
#pragma unroll
      for (int n = 0; n < 8; ++n) o[m][n] = (f32x4){0.f, 0.f, 0.f, 0.f};
    float lsum[2] = {0.f, 0.f};
    for (int i = 0; i < ntile; ++i) {
      const int buf = i & 1;
      if (i + 1 < ntile) LOAD_TILE(i + 1);
      const int mtype = (i < nband) ? ((tlo + i) == 0 ? 1 : ((tlo + i) == 4 ? 2 : 0)) : 0;
      const LAS bf16_t* Kb = Ks + buf * 64 * KP; const LAS bf16_t* Vb = Vs + buf * 64 * VP;
      f32x4 s[4][2];
#pragma unroll
      for (int t = 0; t < 4; ++t) { s[t][0] = (f32x4){-mb, -mb, -mb, -mb}; s[t][1] = (f32x4){-mb, -mb, -mb, -mb}; }
#pragma unroll
      for (int ks = 0; ks < 4; ++ks)
#pragma unroll
        for (int t = 0; t < 4; ++t) { const bf16x8 kf = *(const LAS bf16x8*)(Kb + (16 * t + r) * KP + ks * 32 + 8 * Qd);
          s[t][0] = __builtin_amdgcn_mfma_f32_16x16x32_bf16(kf, qf[0][ks], s[t][0], 0, 0, 0);
          s[t][1] = __builtin_amdgcn_mfma_f32_16x16x32_bf16(kf, qf[1][ks], s[t][1], 0, 0, 0); }
      bf16x8 pa[2][2];
#pragma unroll
      for (int m = 0; m < 2; ++m) { const int qi = qoff + 16 * m + r;
#pragma unroll
        for (int t = 0; t < 4; ++t) {
          float pv[4];
#pragma unroll
          for (int j = 0; j < 4; ++j) { const int kj = 16 * t + 4 * Qd + j; float pj = __builtin_amdgcn_exp2f(s[t][m][j]);
            if (mtype != 0) { if (mtype == 1) pj = (kj >= qi) ? pj : 0.f; else pj = (kj <= qi) ? pj : 0.f; }
            pv[j] = pj; lsum[m] += pj; }
          const unsigned w0 = pk2(pv[0], pv[1]), w1 = pk2(pv[2], pv[3]);
          pa[m][t >> 1][(t & 1) * 4 + 0] = (short)(w0 & 0xffff); pa[m][t >> 1][(t & 1) * 4 + 1] = (short)(w0 >> 16);
          pa[m][t >> 1][(t & 1) * 4 + 2] = (short)(w1 & 0xffff); pa[m][t >> 1][(t & 1) * 4 + 3] = (short)(w1 >> 16); } }
#pragma unroll
      for (int k2 = 0; k2 < 2; ++k2)
#pragma unroll
        for (int n = 0; n < 8; ++n) {
          const s16x4 lo = tr_read(Vb + (32 * k2 + 4 * Qd + (r >> 2)) * VP + 16 * n + 4 * (r & 3));
          const s16x4 hi = tr_read(Vb + (32 * k2 + 16 + 4 * Qd + (r >> 2)) * VP + 16 * n + 4 * (r & 3));
          const bf16x8 vf = (bf16x8){lo[0], lo[1], lo[2], lo[3], hi[0], hi[1], hi[2], hi[3]};
          o[0][n] = __builtin_amdgcn_mfma_f32_16x16x32_bf16(pa[0][k2], vf, o[0][n], 0, 0, 0);
          o[1][n] = __builtin_amdgcn_mfma_f32_16x16x32_bf16(pa[1][k2], vf, o[1][n], 0, 0, 0); }
      if (i + 1 < ntile) STORE_TILE(buf ^ 1, i + 1);
      __syncthreads();
    }
#undef TILE_ROW0
#undef LOAD_TILE
#undef STORE_TILE
    const float sk = __builtin_amdgcn_exp2f(sink[hq] * 1.4426950408889634f - mb);
#pragma unroll
    for (int m = 0; m < 2; ++m) { float l = lsum[m]; l += __shfl_xor(l, 16); l += __shfl_xor(l, 32); if (Qd == 0) dsc[wid * 32 + 16 * m + r] = 1.f / (l + sk); }
    LDS_WAIT(); asm volatile("" ::: "memory");
    { LAS bf16_t* stg = (LAS bf16_t*)lds + wid * 32 * 136;
#pragma unroll
      for (int m = 0; m < 2; ++m)
#pragma unroll
        for (int j = 0; j < 4; ++j) { const float inv = dsc[wid * 32 + 16 * m + 4 * Qd + j];
#pragma unroll
          for (int n = 0; n < 8; ++n) stg[(16 * m + 4 * Qd + j) * 136 + 16 * n + r] = f2bf(o[m][n][j] * inv); }
      LDS_WAIT(); asm volatile("" ::: "memory");
#pragma unroll
      for (int q = 0; q < 8; ++q) { const int c = lane + 64 * q, rowl = c >> 4, ch = c & 15; const size_t go = (qrow0 + rowl) * 2048 + hq * 128 + ch * 8;
        const v4u ov = *(const LAS v4u*)(stg + rowl * 136 + ch * 8), gv = *(const v4u*)(G1 + go);
        v4u w; w.x = pk2(__uint_as_float(ov.x << 16) * __uint_as_float(gv.x << 16), __uint_as_float(ov.x & 0xffff0000u) * __uint_as_float(gv.x & 0xffff0000u));
        w.y = pk2(__uint_as_float(ov.y << 16) * __uint_as_float(gv.y << 16), __uint_as_float(ov.y & 0xffff0000u) * __uint_as_float(gv.y & 0xffff0000u));
        w.z = pk2(__uint_as_float(ov.z << 16) * __uint_as_float(gv.z << 16), __uint_as_float(ov.z & 0xffff0000u) * __uint_as_float(gv.z & 0xffff0000u));
        w.w = pk2(__uint_as_float(ov.w << 16) * __uint_as_float(gv.w << 16), __uint_as_float(ov.w & 0xffff0000u) * __uint_as_float(gv.w & 0xffff0000u));
        if (wr) *(v4u*)(Q1 + go) = w; }
      LDS_WAIT(); asm volatile("" ::: "memory"); }
  }
}

constexpr size_t DO_SDT = 50 * MiB, DO_SCS = 53 * MiB;
constexpr size_t WS_SSQ = 237 * MiB;
DEV unsigned short bfbits(float f) { return f2bf(f); }
DEV void ssd_prep_phase(const bf16_t* XBC, const float* cw, const float* cb, bf16_t* XC, const float* DTLR, const float* dt_bias, const float* a_log, float* SDT, float* SCS, float* SDEC) {
  const int gtid = blockIdx.x * 512 + threadIdx.x, gth = gridDim.x * 512;
  for (int it = gtid; it < (MA / 32) * 192; it += gth) {
    const int rg = it / 192, c8 = (it % 192) * 8, row0 = rg * 32;
    int t0, len;
    if (row0 < ML) { t0 = row0 % SEQ; len = SEQ; } else { t0 = (row0 - ML) % CTXL; len = CTXL; }
    float w[5][8], bias[8];
#pragma unroll
    for (int k = 0; k < 5; ++k) { const f32x4 w0 = *(const f32x4*)(cw + k * 1536 + c8), w1 = *(const f32x4*)(cw + k * 1536 + c8 + 4);
      w[k][0] = w0.x; w[k][1] = w0.y; w[k][2] = w0.z; w[k][3] = w0.w; w[k][4] = w1.x; w[k][5] = w1.y; w[k][6] = w1.z; w[k][7] = w1.w; }
    { const f32x4 b0 = *(const f32x4*)(cb + c8), b1 = *(const f32x4*)(cb + c8 + 4); bias[0] = b0.x; bias[1] = b0.y; bias[2] = b0.z; bias[3] = b0.w; bias[4] = b1.x; bias[5] = b1.y; bias[6] = b1.z; bias[7] = b1.w; }
    const v4u zero4 = {0u, 0u, 0u, 0u};
    v4u win[4];
#pragma unroll
    for (int q = 0; q < 4; ++q) { const int tt = t0 - 2 + q; win[q] = (tt >= 0 && tt < len) ? *(const v4u*)(XBC + (size_t)(row0 - 2 + q) * 1536 + c8) : zero4; }
#pragma unroll 4
    for (int i = 0; i < 32; ++i) {
      const int tt = t0 + i + 2; const v4u nx = (tt < len) ? *(const v4u*)(XBC + (size_t)(row0 + i + 2) * 1536 + c8) : zero4;
      float acc[8];
#pragma unroll
      for (int e = 0; e < 8; ++e) acc[e] = bias[e];
#define CONV_TAP(k, xv) do { acc[0] += w[k][0] * __uint_as_float((xv).x << 16); acc[1] += w[k][1] * __uint_as_float((xv).x & 0xffff0000u); acc[2] += w[k][2] * __uint_as_float((xv).y << 16); acc[3] += w[k][3] * __uint_as_float((xv).y & 0xffff0000u); \
        acc[4] += w[k][4] * __uint_as_float((xv).z << 16); acc[5] += w[k][5] * __uint_as_float((xv).z & 0xffff0000u); acc[6] += w[k][6] * __uint_as_float((xv).w << 16); acc[7] += w[k][7] * __uint_as_float((xv).w & 0xffff0000u); } while (0)
      CONV_TAP(0, win[0]); CONV_TAP(1, win[1]); CONV_TAP(2, win[2]); CONV_TAP(3, win[3]); CONV_TAP(4, nx);
#undef CONV_TAP
      v4u o; o.x = pk2(silu_fast(acc[0]), silu_fast(acc[1])); o.y = pk2(silu_fast(acc[2]), silu_fast(acc[3])); o.z = pk2(silu_fast(acc[4]), silu_fast(acc[5])); o.w = pk2(silu_fast(acc[6]), silu_fast(acc[7]));
      *(v4u*)(XC + (size_t)(row0 + i) * 1536 + c8) = o;
      win[0] = win[1]; win[1] = win[2]; win[2] = win[3]; win[3] = nx;
    }
  }
  {
    const int lane = threadIdx.x & 63, wave = threadIdx.x >> 6, cl = lane & 7, seg = lane >> 3;
    for (int wt = blockIdx.x * NWAVES + wave; wt < NCH * 4; wt += gridDim.x * NWAVES) {
      const int gc = wt >> 2, col = (wt & 3) * 8 + cl, dir = col >> 4, h = col & 15;
      const float a = -fexp(a_log[col]), bias = dt_bias[col];
      float dtv[16], v[16]; float run = 0.f;
#pragma unroll
      for (int u = 0; u < 16; ++u) { const int s = seg * 16 + u, t = dir ? 127 - s : s; dtv[u] = softplusf(DTLR[((size_t)gc * 128 + t) * 64 + col] + bias); }
#pragma unroll
      for (int u = 0; u < 16; ++u) { run += dtv[u] * a; v[u] = run; }
      float off = 0.f;
#pragma unroll
      for (int sgi = 0; sgi < 7; ++sgi) { const float tot = __shfl(run, cl + 8 * sgi); off += (sgi < seg) ? tot : 0.f; }
#pragma unroll
      for (int u = 0; u < 16; ++u) { const int s = seg * 16 + u, t = dir ? 127 - s : s; const size_t row = (size_t)gc * 128 + t; SDT[row * 32 + col] = dtv[u]; SCS[row * 32 + col] = v[u] + off; }
      if (seg == 7) SDEC[(gc * 16 + h) * 2 + dir] = fexp(run + off);
    }
  }
}
DEV void ssd_u_phase(const bf16_t* XC, const float* SDT, const float* SCS, bf16_t* ST, LAS unsigned char* lds) {
  constexpr int XP = 272, BP = 144;
  LAS bf16_t* Xs = (LAS bf16_t*)lds; LAS bf16_t* Bs = (LAS bf16_t*)(lds + 128 * XP * 2); LAS float* wtab = (LAS float*)(lds + 128 * XP * 2 + 128 * BP * 2);
  const int tid = threadIdx.x, lane = tid & 63, wid = tid >> 6, r = lane & 15, Qd = lane >> 4, hl = wid >> 1, dir = wid & 1;
  for (int task = virt_block(); task < NCH * 4; task += gridDim.x) {
    const int gc = task >> 2, g = (task >> 1) & 1, hh = task & 1; const size_t r0 = (size_t)gc * 128; const int h0 = g * 8 + hh * 4;
    __syncthreads();
#pragma unroll
    for (int i = 0; i < 8; ++i) { const int cid = tid + 512 * i, row = cid >> 5, ch = cid & 31; *(LAS v4u*)(Xs + row * XP + ch * 8) = *(const v4u*)(XC + (r0 + row) * 1536 + h0 * 64 + ch * 8); }
#pragma unroll
    for (int i = 0; i < 4; ++i) { const int cid = tid + 512 * i, row = cid >> 4, ch = cid & 15; *(LAS v4u*)(Bs + row * BP + ch * 8) = *(const v4u*)(XC + (r0 + row) * 1536 + 1024 + g * 128 + ch * 8); }
    if (tid < 256) { const int d_ = tid >> 7, t = tid & 127;
      const f32x4 ce = *(const f32x4*)(SCS + (r0 + (d_ ? 0 : 127)) * 32 + d_ * 16 + h0), ct = *(const f32x4*)(SCS + (r0 + t) * 32 + d_ * 16 + h0), dt = *(const f32x4*)(SDT + (r0 + t) * 32 + d_ * 16 + h0);
      wtab[(0 * 2 + d_) * 128 + t] = fexp(ce.x - ct.x) * dt.x; wtab[(1 * 2 + d_) * 128 + t] = fexp(ce.y - ct.y) * dt.y; wtab[(2 * 2 + d_) * 128 + t] = fexp(ce.z - ct.z) * dt.z; wtab[(3 * 2 + d_) * 128 + t] = fexp(ce.w - ct.w) * dt.w; }
    __syncthreads();
    const LAS float* wt = wtab + wid * 128;
    bf16_t* Sp = ST + ((((size_t)gc * 16 + h0 + hl) * 2 + dir) * 64) * 128;
#pragma unroll 1
    for (int pp = 0; pp < 2; ++pp) {
      f32x4 acc[8][2];
#pragma unroll
      for (int nt = 0; nt < 8; ++nt) { acc[nt][0] = (f32x4){0.f, 0.f, 0.f, 0.f}; acc[nt][1] = (f32x4){0.f, 0.f, 0.f, 0.f}; }
#pragma unroll 1
      for (int k = 0; k < 4; ++k) {
        const f32x4 wlo = *(const LAS f32x4*)(wt + 32 * k + 4 * Qd), whi = *(const LAS f32x4*)(wt + 32 * k + 16 + 4 * Qd);
        bf16x8 xf[2];
#pragma unroll
        for (int pt = 0; pt < 2; ++pt) {
          const s16x4 lo = tr_read(Xs + (32 * k + 4 * Qd + (r >> 2)) * XP + hl * 64 + 32 * pp + 16 * pt + 4 * (r & 3));
          const s16x4 hi = tr_read(Xs + (32 * k + 16 + 4 * Qd + (r >> 2)) * XP + hl * 64 + 32 * pp + 16 * pt + 4 * (r & 3));
          const unsigned w0 = pk2(bf2f((bf16_t)lo[0]) * wlo[0], bf2f((bf16_t)lo[1]) * wlo[1]), w1 = pk2(bf2f((bf16_t)lo[2]) * wlo[2], bf2f((bf16_t)lo[3]) * wlo[3]);
          const unsigned w2 = pk2(bf2f((bf16_t)hi[0]) * whi[0], bf2f((bf16_t)hi[1]) * whi[1]), w3 = pk2(bf2f((bf16_t)hi[2]) * whi[2], bf2f((bf16_t)hi[3]) * whi[3]);
          xf[pt] = (bf16x8){(short)(w0 & 0xffff), (short)(w0 >> 16), (short)(w1 & 0xffff), (short)(w1 >> 16), (short)(w2 & 0xffff), (short)(w2 >> 16), (short)(w3 & 0xffff), (short)(w3 >> 16)};
        }
#pragma unroll
        for (int nt = 0; nt < 8; ++nt) {
          const s16x4 lo = tr_read(Bs + (32 * k + 4 * Qd + (r >> 2)) * BP + 16 * nt + 4 * (r & 3));
          const s16x4 hi = tr_read(Bs + (32 * k + 16 + 4 * Qd + (r >> 2)) * BP + 16 * nt + 4 * (r & 3));
          const bf16x8 bfr = (bf16x8){lo[0], lo[1], lo[2], lo[3], hi[0], hi[1], hi[2], hi[3]};
          acc[nt][0] = __builtin_amdgcn_mfma_f32_16x16x32_bf16(bfr, xf[0], acc[nt][0], 0, 0, 0);
          acc[nt][1] = __builtin_amdgcn_mfma_f32_16x16x32_bf16(bfr, xf[1], acc[nt][1], 0, 0, 0);
        }
      }
#pragma unroll
      for (int nt = 0; nt < 8; ++nt)
#pragma unroll
        for (int pt = 0; pt < 2; ++pt) { const f32x4 v = acc[nt][pt];
          *(unsigned long long*)(Sp + ((((2 * pp + pt) * 4 + (nt >> 1)) * 64 + ((nt & 1) * 2 + (Qd >> 1)) * 16 + r) * 8 + 4 * (Qd & 1))) = (unsigned long long)pk2(v[0], v[1]) | ((unsigned long long)pk2(v[2], v[3]) << 32); }
    }
  }
}
DEV void ssd_scan_phase(bf16_t* ST, const float* SDEC, bool wr) {
  for (int item = blockIdx.x * 512 + threadIdx.x; item < 2 * 16 * 2 * 2048; item += gridDim.x * 512) {
    const int e4 = item & 2047, dir = (item >> 11) & 1, h = (item >> 12) & 15, b = item >> 16;
    float S0 = 0.f, S1 = 0.f, S2 = 0.f, S3 = 0.f;
#define SCAN_GC(s) (!dir ? ((s) < 2 ? 128 + 2 * b + (s) : b * 64 + ((s) - 2)) : ((s) < 2 ? 128 + 2 * b + (1 - (s)) : b * 64 + (65 - (s))))
    for (int s0 = 0; s0 < 66; s0 += 6) {
      unsigned long long u[6]; float dec[6];
#pragma unroll
      for (int q = 0; q < 6; ++q) { const int gc = SCAN_GC(s0 + q); u[q] = *(const unsigned long long*)(ST + (((size_t)gc * 16 + h) * 2 + dir) * 8192 + e4 * 4); dec[q] = SDEC[(gc * 16 + h) * 2 + dir]; }
#pragma unroll
      for (int q = 0; q < 6; ++q) { const int gc = SCAN_GC(s0 + q);
        if (wr) *(unsigned long long*)(ST + (((size_t)gc * 16 + h) * 2 + dir) * 8192 + e4 * 4) = (unsigned long long)pk2(S0, S1) | ((unsigned long long)pk2(S2, S3) << 32);
        const unsigned lo = (unsigned)u[q], hi = (unsigned)(u[q] >> 32);
        S0 = dec[q] * S0 + __uint_as_float(lo << 16); S1 = dec[q] * S1 + __uint_as_float(lo & 0xffff0000u); S2 = dec[q] * S2 + __uint_as_float(hi << 16); S3 = dec[q] * S3 + __uint_as_float(hi & 0xffff0000u); }
    }
#undef SCAN_GC
  }
}
DEV bf16x8 scale_frag(bf16x8 f, float s) {
  bf16x8 o;
#pragma unroll
  for (int e = 0; e < 8; e += 2) { const unsigned w = pk2(bf2f((bf16_t)f[e]) * s, bf2f((bf16_t)f[e + 1]) * s); o[e] = (short)(w & 0xffff); o[e + 1] = (short)(w >> 16); }
  return o;
}
DEV void ssd_y_phase(const bf16_t* XC, const float* SDT, const float* SCS, const bf16_t* ST, const float* d_skip, bf16_t* Y0, float* SSQ, LAS unsigned char* lds, bool wr) {
  constexpr int XP = 272, BP = 136, SP = 72;
  LAS bf16_t* Xs = (LAS bf16_t*)lds; LAS bf16_t* Bs = (LAS bf16_t*)(lds + 128 * XP * 2);
  LAS float* tab = (LAS float*)(lds + 128 * XP * 2 + 128 * BP * 2);
  LAS float* ssq = tab + 4 * 4 * 128;
  LAS bf16_t* stg = (LAS bf16_t*)(ssq + 4 * 128);
  const int tid = threadIdx.x, lane = tid & 63, wid = tid >> 6, r = lane & 15, Qd = lane >> 4, hl = wid >> 1, ih = wid & 1;
  LAS bf16_t* mystg = stg + wid * 16 * SP;
  for (int task = virt_block(); task < NCH * 4; task += gridDim.x) {
    const int gc = task >> 2, g = (task >> 1) & 1, hh = task & 1; const size_t r0 = (size_t)gc * 128; const int h0 = g * 8 + hh * 4, h = h0 + hl;
    bf16x8 cstrip[4], cf[4][4];
#pragma unroll
    for (int ks = 0; ks < 4; ++ks) cstrip[ks] = *(const bf16x8*)(XC + (r0 + 16 * wid + r) * 1536 + 1280 + g * 128 + 32 * ks + 8 * Qd);
#pragma unroll
    for (int m = 0; m < 4; ++m)
#pragma unroll
      for (int ks = 0; ks < 4; ++ks) cf[m][ks] = *(const bf16x8*)(XC + (r0 + 64 * ih + 16 * m + r) * 1536 + 1280 + g * 128 + 32 * ks + 8 * Qd);
    __syncthreads();
#pragma unroll
    for (int i = 0; i < 8; ++i) { const int cid = tid + 512 * i, row = cid >> 5, ch = cid & 31; *(LAS v4u*)(Xs + row * XP + ch * 8) = *(const v4u*)(XC + (r0 + row) * 1536 + h0 * 64 + ch * 8); }
#pragma unroll
    for (int i = 0; i < 4; ++i) { const int cid = tid + 512 * i, row = cid >> 4, ch = cid & 15; *(LAS v4u*)(Bs + row * BP + ch * 8) = *(const v4u*)(XC + (r0 + row) * 1536 + 1024 + g * 128 + ch * 8); }
    { const int which = tid >> 7, t = tid & 127; const f32x4 v = *(const f32x4*)((which < 2 ? SCS : SDT) + (r0 + t) * 32 + (which & 1) * 16 + h0);
      tab[0 * 512 + which * 128 + t] = v.x; tab[1 * 512 + which * 128 + t] = v.y; tab[2 * 512 + which * 128 + t] = v.z; tab[3 * 512 + which * 128 + t] = v.w; }
    __syncthreads();
    {
      f32x4 cb[8];
#pragma unroll
      for (int t = 0; t < 8; ++t) { f32x4 c = {0.f, 0.f, 0.f, 0.f};
#pragma unroll
        for (int ks = 0; ks < 4; ++ks) { const bf16x8 bfr = *(const LAS bf16x8*)(Bs + (16 * t + r) * BP + 32 * ks + 8 * Qd); c = __builtin_amdgcn_mfma_f32_16x16x32_bf16(bfr, cstrip[ks], c, 0, 0, 0); }
        cb[t] = c; }
      __syncthreads();
#pragma unroll
      for (int t = 0; t < 8; ++t) *(LAS unsigned long long*)(Bs + (16 * wid + r) * BP + 16 * t + 4 * Qd) = (unsigned long long)pk2(cb[t][0], cb[t][1]) | ((unsigned long long)pk2(cb[t][2], cb[t][3]) << 32);
      __syncthreads();
    }
    const LAS float* csf = tab + hl * 512; const LAS float* csb = csf + 128; const LAS float* dtf = csf + 256; const LAS float* dtb = csf + 384;
    const float dsk = d_skip[h];
    f32x4 y[4][4];
#pragma unroll
    for (int m = 0; m < 4; ++m)
#pragma unroll
      for (int pt = 0; pt < 4; ++pt) y[m][pt] = (f32x4){0.f, 0.f, 0.f, 0.f};
    if (wr || !(PROBE_SKIP & 1))
#pragma unroll 1
    for (int dir = 0; dir < 2; ++dir) {
      const LAS float* csd = dir ? csb : csf; float sc[4];
#pragma unroll
      for (int m = 0; m < 4; ++m)
#pragma unroll
        for (int ks = 0; ks < 4; ++ks) asm volatile("" : "+v"(cf[m][ks]));
#pragma unroll
      for (int m = 0; m < 4; ++m) sc[m] = fexp(csd[64 * ih + 16 * m + r]);
      const bf16_t* Sp = ST + (((size_t)gc * 16 + h) * 2 + dir) * 8192 + lane * 8;
#pragma unroll
      for (int ks = 0; ks < 4; ++ks) {
        bf16x8 sf[4];
#pragma unroll
        for (int pt = 0; pt < 4; ++pt) sf[pt] = *(const bf16x8*)(Sp + (pt * 4 + ks) * 512);
#pragma unroll
        for (int m = 0; m < 4; ++m) { const bf16x8 a = scale_frag(cf[m][ks], sc[m]);
#pragma unroll
          for (int pt = 0; pt < 4; ++pt) y[m][pt] = __builtin_amdgcn_mfma_f32_16x16x32_bf16(a, sf[pt], y[m][pt], 0, 0, 0);
          __builtin_amdgcn_sched_barrier(0); }
      }
    }
#pragma unroll 1
    for (int m = 0; m < 4; ++m) {
      const int i0 = 64 * ih + 16 * m, i = i0 + r;
      const float cfi = csf[i], cbi = csb[i];
      v4u zpre[2];
#pragma unroll
      for (int q = 0; q < 2; ++q) { const int c = lane + 64 * q; zpre[q] = *(const v4u*)(Y0 + (r0 + i0 + (c >> 3)) * 2048 + h * 64 + (c & 7) * 8); }
      if (wr || !(PROBE_SKIP & 2))
#pragma unroll 1
      for (int k2 = 0; k2 < 4; ++k2) {
        const int j0 = 32 * k2 + 8 * Qd;
        const v4u cbv = *(const LAS v4u*)(Bs + i * BP + j0);
        const float cbe[8] = {__uint_as_float(cbv.x << 16), __uint_as_float(cbv.x & 0xffff0000u), __uint_as_float(cbv.y << 16), __uint_as_float(cbv.y & 0xffff0000u), __uint_as_float(cbv.z << 16), __uint_as_float(cbv.z & 0xffff0000u), __uint_as_float(cbv.w << 16), __uint_as_float(cbv.w & 0xffff0000u)};
        float pv[8];
        const bool dofwd = (32 * k2 <= i0 + 15), dobwd = (32 * k2 + 31 >= i0);
#pragma unroll
        for (int e = 0; e < 8; ++e) pv[e] = (j0 + e == i) ? dsk : 0.f;
        if (dofwd) { const f32x4 a0 = *(const LAS f32x4*)(csf + j0), a1 = *(const LAS f32x4*)(csf + j0 + 4), d0 = *(const LAS f32x4*)(dtf + j0), d1 = *(const LAS f32x4*)(dtf + j0 + 4);
          const float jc[8] = {a0.x, a0.y, a0.z, a0.w, a1.x, a1.y, a1.z, a1.w}; const float jd[8] = {d0.x, d0.y, d0.z, d0.w, d1.x, d1.y, d1.z, d1.w};
#pragma unroll
          for (int e = 0; e < 8; ++e) pv[e] += cbe[e] * fexp(j0 + e <= i ? cfi - jc[e] : -INFINITY) * jd[e]; }
        if (dobwd) { const f32x4 a0 = *(const LAS f32x4*)(csb + j0), a1 = *(const LAS f32x4*)(csb + j0 + 4), d0 = *(const LAS f32x4*)(dtb + j0), d1 = *(const LAS f32x4*)(dtb + j0 + 4);
          const float jc[8] = {a0.x, a0.y, a0.z, a0.w, a1.x, a1.y, a1.z, a1.w}; const float jd[8] = {d0.x, d0.y, d0.z, d0.w, d1.x, d1.y, d1.z, d1.w};
#pragma unroll
          for (int e = 0; e < 8; ++e) pv[e] += cbe[e] * fexp(j0 + e >= i ? cbi - jc[e] : -INFINITY) * jd[e]; }
        const unsigned w0 = pk2(pv[0], pv[1]), w1 = pk2(pv[2], pv[3]), w2 = pk2(pv[4], pv[5]), w3 = pk2(pv[6], pv[7]);
        const bf16x8 pa = (bf16x8){(short)(w0 & 0xffff), (short)(w0 >> 16), (short)(w1 & 0xffff), (short)(w1 >> 16), (short)(w2 & 0xffff), (short)(w2 >> 16), (short)(w3 & 0xffff), (short)(w3 >> 16)};
#pragma unroll
        for (int pt = 0; pt < 4; ++pt) {
          const s16x4 lo = tr_read(Xs + (32 * k2 + 8 * Qd + (r >> 2)) * XP + hl * 64 + 16 * pt + 4 * (r & 3));
          const s16x4 hi = tr_read(Xs + (32 * k2 + 8 * Qd + 4 + (r >> 2)) * XP + hl * 64 + 16 * pt + 4 * (r & 3));
          const bf16x8 xf = (bf16x8){lo[0], lo[1], lo[2], lo[3], hi[0], hi[1], hi[2], hi[3]};
          y[0][pt] = __builtin_amdgcn_mfma_f32_16x16x32_bf16(pa, xf, y[0][pt], 0, 0, 0);
        }
      }
      if (wr || !(PROBE_SKIP & 4)) {
#pragma unroll
      for (int pt = 0; pt < 4; ++pt)
#pragma unroll
        for (int jj = 0; jj < 4; ++jj) mystg[(4 * Qd + jj) * SP + 16 * pt + r] = f2bf(y[0][pt][jj]);
      LDS_WAIT(); asm volatile("" ::: "memory");
#pragma unroll
      for (int q = 0; q < 2; ++q) { const int c = lane + 64 * q, rowl = c >> 3, ch = c & 7; const int il = 64 * ih + 16 * m + rowl;
        const v4u yv = *(const LAS v4u*)(mystg + rowl * SP + ch * 8); bf16_t* zp = Y0 + (r0 + il) * 2048 + h * 64 + ch * 8; const v4u zv = zpre[q];
        const float v0 = __uint_as_float(yv.x << 16) * __uint_as_float(zv.x << 16), v1 = __uint_as_float(yv.x & 0xffff0000u) * __uint_as_float(zv.x & 0xffff0000u);
        const float v2 = __uint_as_float(yv.y << 16) * __uint_as_float(zv.y << 16), v3 = __uint_as_float(yv.y & 0xffff0000u) * __uint_as_float(zv.y & 0xffff0000u);
        const float v4 = __uint_as_float(yv.z << 16) * __uint_as_float(zv.z << 16), v5 = __uint_as_float(yv.z & 0xffff0000u) * __uint_as_float(zv.z & 0xffff0000u);
        const float v6 = __uint_as_float(yv.w << 16) * __uint_as_float(zv.w << 16), v7 = __uint_as_float(yv.w & 0xffff0000u) * __uint_as_float(zv.w & 0xffff0000u);
        float ss = (v0 * v0 + v1 * v1) + (v2 * v2 + v3 * v3) + (v4 * v4 + v5 * v5) + (v6 * v6 + v7 * v7);
        ss += __shfl_xor(ss, 1); ss += __shfl_xor(ss, 2); ss += __shfl_xor(ss, 4);
        v4u ov; ov.x = pk2(v0, v1); ov.y = pk2(v2, v3); ov.z = pk2(v4, v5); ov.w = pk2(v6, v7);
        if (wr) *(v4u*)zp = ov;
        if (ch == 0) ssq[hl * 128 + il] = ss; }
      LDS_WAIT(); asm volatile("" ::: "memory");
      }
#pragma unroll
      for (int pt = 0; pt < 4; ++pt) { y[0][pt] = y[1][pt]; y[1][pt] = y[2][pt]; y[2][pt] = y[3][pt]; }
    }
    __syncthreads();
    if (tid < 128) SSQ[((r0 + tid) * 2 + g) * 2 + hh] = (ssq[tid] + ssq[128 + tid]) + (ssq[256 + tid] + ssq[384 + tid]);
  }
}

typedef _Float16 h16_t;
typedef _Float16 h16x8 __attribute__((ext_vector_type(8)));
DEV const h16_t* gcs_row(const h16_t* wsb, const h16_t* outb, size_t row) {
  return row < 9472 ? (const h16_t*)((const char*)wsb + 237 * MiB + 512 * 1024) + row * 1024 : (row < 13824 ? (const h16_t*)((const char*)outb + 55 * MiB + 512 * 1024) + (row - 9472) * 1024 : (const h16_t*)((const char*)wsb + 2 * MiB) + (row - 13824) * 1024); }
DEV h16_t* gcs_row_w(h16_t* wsb, h16_t* outb, size_t row) { return (h16_t*)gcs_row(wsb, outb, row); }
DEV float logsig_fast(float x) { return fminf(x, 0.f) - 0.6931471805599453f * __builtin_amdgcn_logf(1.f + __builtin_amdgcn_exp2f(-1.4426950408889634f * fabsf(x))); }
DEV void gla_cs_phase(const float* DTLR, const float* gw, const float* gb, h16_t* GCSL, h16_t* GCSC, float* GDEC, LAS unsigned char* lds, unsigned* queue) {
  const int lane = threadIdx.x & 63, wave = threadIdx.x >> 6;
  LAS float* lrs = (LAS float*)(lds + wave * 8192);
  LAS h16_t* tile = (LAS h16_t*)(lds + 65536 + wave * 1024);
  for (;;) {
    unsigned wt_ = 0u; if (lane == 0) wt_ = __hip_atomic_fetch_add(queue, 1u, __ATOMIC_RELAXED, __HIP_MEMORY_SCOPE_AGENT);
    wt_ = (unsigned)__builtin_amdgcn_readfirstlane((int)wt_); if (wt_ >= (unsigned)(NCH * 2 * 8)) break;
    const int wt = (int)wt_;
    const int gc = wt >> 4, dir = (wt >> 3) & 1, k = (wt & 7) * 64 + lane;
#pragma unroll
    for (int q = 0; q < 8; ++q) { const int c = lane + 64 * q, row = c >> 2, part = c & 3;
      *(LAS f32x4*)(lrs + row * 16 + part * 4) = *(const f32x4*)(DTLR + ((size_t)gc * 128 + row) * 64 + 32 + dir * 16 + part * 4); }
    float wv[16];
#pragma unroll
    for (int q = 0; q < 16; ++q) wv[q] = gw[(dir * 16 + q) * 512 + k];
    const float bias = gb[dir * 512 + k];
    LDS_WAIT(); asm volatile("" ::: "memory");
    float run = 0.f;
#pragma unroll 1
    for (int s0 = 0; s0 < 128; s0 += 8) {
      float lg[8];
#pragma unroll
      for (int u = 0; u < 8; ++u) { const int s = s0 + u, t = dir ? 127 - s : s; const LAS float* lr = lrs + t * 16;
        const f32x4 l0 = *(const LAS f32x4*)lr, l1 = *(const LAS f32x4*)(lr + 4), l2 = *(const LAS f32x4*)(lr + 8), l3 = *(const LAS f32x4*)(lr + 12);
        const float x = bias + l0.x * wv[0] + l0.y * wv[1] + l0.z * wv[2] + l0.w * wv[3] + l1.x * wv[4] + l1.y * wv[5] + l1.z * wv[6] + l1.w * wv[7]
                        + l2.x * wv[8] + l2.y * wv[9] + l2.z * wv[10] + l2.w * wv[11] + l3.x * wv[12] + l3.y * wv[13] + l3.z * wv[14] + l3.w * wv[15];
        lg[u] = logsig_fast(x) * (1.f / 16.f); }
#pragma unroll
      for (int u = 0; u < 8; ++u) { run += lg[u]; tile[u * 64 + lane] = (h16_t)run; }
      LDS_WAIT(); asm volatile("" ::: "memory");
      { const int u = lane >> 3, ch = lane & 7, s = s0 + u, t = dir ? 127 - s : s;
        *(v4u*)(gcs_row_w(GCSL, GCSC, (size_t)gc * 128 + t) + dir * 512 + (k - lane) + ch * 8) = *(const LAS v4u*)(tile + u * 64 + ch * 8); }
      LDS_WAIT(); asm volatile("" ::: "memory");
    }
    GDEC[((gc * 4 + (k >> 7)) * 2 + dir) * 128 + (k & 127)] = fexp(run);
    LDS_WAIT(); asm volatile("" ::: "memory");
  }
}
DEV void gla_u_phase(const bf16_t* K0, const bf16_t* V0, const h16_t* GCSL, const h16_t* GCSC, bf16_t* ST, LAS unsigned char* lds) {
  constexpr int VP = 272, KP = 144;
  LAS bf16_t* Vs = (LAS bf16_t*)lds; LAS bf16_t* Kd = (LAS bf16_t*)(lds + 128 * VP * 2);
  const int tid = threadIdx.x, lane = tid & 63, wid = tid >> 6, r = lane & 15, Qd = lane >> 4;
  for (int task = virt_block(); task < NCH * 4; task += gridDim.x) {
    const int gc = task >> 2, h = task & 3; const size_t r0 = (size_t)gc * 128;
    __syncthreads();
#pragma unroll
    for (int i = 0; i < 8; ++i) { const int cid = tid + 512 * i, row = cid >> 5, ch = cid & 31; *(LAS v4u*)(Vs + row * VP + ch * 8) = *(const v4u*)(V0 + (r0 + row) * 1024 + h * 256 + ch * 8); }
#pragma unroll
    for (int i = 0; i < 4; ++i) { const int cid = tid + 512 * i, t = cid >> 4, ch = cid & 15;
      const v4u kv = *(const v4u*)(K0 + (r0 + t) * 512 + h * 128 + ch * 8);
      const float kf[8] = {__uint_as_float(kv.x << 16), __uint_as_float(kv.x & 0xffff0000u), __uint_as_float(kv.y << 16), __uint_as_float(kv.y & 0xffff0000u), __uint_as_float(kv.z << 16), __uint_as_float(kv.z & 0xffff0000u), __uint_as_float(kv.w << 16), __uint_as_float(kv.w & 0xffff0000u)};
#pragma unroll
      for (int dir = 0; dir < 2; ++dir) {
        const h16x8 ce = *(const h16x8*)(gcs_row(GCSL, GCSC, r0 + (dir ? 0 : 127)) + dir * 512 + h * 128 + ch * 8), ct = *(const h16x8*)(gcs_row(GCSL, GCSC, r0 + t) + dir * 512 + h * 128 + ch * 8);
        v4u o; o.x = pk2(kf[0] * fexp((float)ce[0] - (float)ct[0]), kf[1] * fexp((float)ce[1] - (float)ct[1])); o.y = pk2(kf[2] * fexp((float)ce[2] - (float)ct[2]), kf[3] * fexp((float)ce[3] - (float)ct[3]));
        o.z = pk2(kf[4] * fexp((float)ce[4] - (float)ct[4]), kf[5] * fexp((float)ce[5] - (float)ct[5])); o.w = pk2(kf[6] * fexp((float)ce[6] - (float)ct[6]), kf[7] * fexp((float)ce[7] - (float)ct[7]));
        *(LAS v4u*)(Kd + dir * 128 * KP + t * KP + ch * 8) = o; } }
    __syncthreads();
#pragma unroll 1
    for (int dir = 0; dir < 2; ++dir) {
      const LAS bf16_t* Kb = Kd + dir * 128 * KP;
      f32x4 acc[8][2];
#pragma unroll
      for (int dt = 0; dt < 8; ++dt) { acc[dt][0] = (f32x4){0.f, 0.f, 0.f, 0.f}; acc[dt][1] = (f32x4){0.f, 0.f, 0.f, 0.f}; }
#pragma unroll 1
      for (int k = 0; k < 4; ++k) {
        bf16x8 vf[2];
#pragma unroll
        for (int et = 0; et < 2; ++et) {
          const s16x4 lo = tr_read(Vs + (32 * k + 4 * Qd + (r >> 2)) * VP + 32 * wid + 16 * et + 4 * (r & 3));
          const s16x4 hi = tr_read(Vs + (32 * k + 16 + 4 * Qd + (r >> 2)) * VP + 32 * wid + 16 * et + 4 * (r & 3));
          vf[et] = (bf16x8){lo[0], lo[1], lo[2], lo[3], hi[0], hi[1], hi[2], hi[3]}; }
#pragma unroll
        for (int dt = 0; dt < 8; ++dt) {
          const s16x4 lo = tr_read(Kb + (32 * k + 4 * Qd + (r >> 2)) * KP + 16 * dt + 4 * (r & 3));
          const s16x4 hi = tr_read(Kb + (32 * k + 16 + 4 * Qd + (r >> 2)) * KP + 16 * dt + 4 * (r & 3));
          const bf16x8 kfr = (bf16x8){lo[0], lo[1], lo[2], lo[3], hi[0], hi[1], hi[2], hi[3]};
          acc[dt][0] = __builtin_amdgcn_mfma_f32_16x16x32_bf16(kfr, vf[0], acc[dt][0], 0, 0, 0);
          acc[dt][1] = __builtin_amdgcn_mfma_f32_16x16x32_bf16(kfr, vf[1], acc[dt][1], 0, 0, 0); }
      }
      bf16_t* Sp = ST + (((size_t)gc * 4 + h) * 2 + dir) * 32768;
#pragma unroll
      for (int dt = 0; dt < 8; ++dt)
#pragma unroll
        for (int et = 0; et < 2; ++et) { const f32x4 v = acc[dt][et];
          *(unsigned long long*)(Sp + ((((2 * wid + et) * 4 + (dt >> 1)) * 64 + ((dt & 1) * 2 + (Qd >> 1)) * 16 + r) * 8 + 4 * (Qd & 1))) = (unsigned long long)pk2(v[0], v[1]) | ((unsigned long long)pk2(v[2], v[3]) << 32); }
    }
  }
}
DEV void gla_scan_phase(bf16_t* ST, const float* GDEC, bool wr) {
  for (int item = blockIdx.x * 512 + threadIdx.x; item < 2 * 4 * 2 * 8192; item += gridDim.x * 512) {
    const int e4 = item & 8191, dir = (item >> 13) & 1, h = (item >> 14) & 3, b = item >> 16; const int d0 = 32 * ((e4 >> 7) & 3) + 8 * ((e4 >> 5) & 3) + 4 * (e4 & 1);
    float S0 = 0.f, S1 = 0.f, S2 = 0.f, S3 = 0.f;
#define SCAN_GC(s) (!dir ? ((s) < 2 ? 128 + 2 * b + (s) : b * 64 + ((s) - 2)) : ((s) < 2 ? 128 + 2 * b + (1 - (s)) : b * 64 + (65 - (s))))
    for (int s0 = 0; s0 < 66; s0 += 6) {
      unsigned long long u[6]; f32x4 dec[6];
#pragma unroll
      for (int q = 0; q < 6; ++q) { const int gc = SCAN_GC(s0 + q); u[q] = *(const unsigned long long*)(ST + (((size_t)gc * 4 + h) * 2 + dir) * 32768 + e4 * 4); dec[q] = *(const f32x4*)(GDEC + ((gc * 4 + h) * 2 + dir) * 128 + d0); }
#pragma unroll
      for (int q = 0; q < 6; ++q) { const int gc = SCAN_GC(s0 + q);
        if (wr) *(unsigned long long*)(ST + (((size_t)gc * 4 + h) * 2 + dir) * 32768 + e4 * 4) = (unsigned long long)pk2(S0, S1) | ((unsigned long long)pk2(S2, S3) << 32);
        const unsigned lo = (unsigned)u[q], hi = (unsigned)(u[q] >> 32);
        S0 = dec[q].x * S0 + __uint_as_float(lo << 16); S1 = dec[q].y * S1 + __uint_as_float(lo & 0xffff0000u); S2 = dec[q].z * S2 + __uint_as_float(hi << 16); S3 = dec[q].w * S3 + __uint_as_float(hi & 0xffff0000u); }
    }
#undef SCAN_GC
  }
}
DEV void gla_o_phase(const bf16_t* Q0, const bf16_t* K0, const bf16_t* V0, const h16_t* GCSL, const h16_t* GCSC, const bf16_t* ST, const float* gla_norm, const float* SSQ, const float* ssd_norm, bf16_t* Y0, LAS unsigned char* lds, bool wr) {
  constexpr int VP = 272, KP = 136;
  LAS bf16_t* Vs = (LAS bf16_t*)lds; LAS bf16_t* Kd = (LAS bf16_t*)(lds + 128 * VP * 2);
  const int tid = threadIdx.x, lane = tid & 63, wid = tid >> 6, r = lane & 15, Qd = lane >> 4;
  const float scale = 0.08838834764831845f;
  for (int task = virt_block(); task < NCH * 4; task += gridDim.x) {
    const int gc = task >> 2, h = task & 3; const size_t r0 = (size_t)gc * 128;
    __syncthreads();
#pragma unroll
    for (int i = 0; i < 8; ++i) { const int cid = tid + 512 * i, row = cid >> 5, ch = cid & 31; *(LAS v4u*)(Vs + row * VP + ch * 8) = *(const v4u*)(V0 + (r0 + row) * 1024 + h * 256 + ch * 8); }
#pragma unroll
    for (int i = 0; i < 4; ++i) { const int cid = tid + 512 * i, t = cid >> 4, ch = cid & 15;
      const v4u kv = *(const v4u*)(K0 + (r0 + t) * 512 + h * 128 + ch * 8);
      const float kf[8] = {__uint_as_float(kv.x << 16), __uint_as_float(kv.x & 0xffff0000u), __uint_as_float(kv.y << 16), __uint_as_float(kv.y & 0xffff0000u), __uint_as_float(kv.z << 16), __uint_as_float(kv.z & 0xffff0000u), __uint_as_float(kv.w << 16), __uint_as_float(kv.w & 0xffff0000u)};
#pragma unroll
      for (int dir = 0; dir < 2; ++dir) {
        const h16x8 ct = *(const h16x8*)(gcs_row(GCSL, GCSC, r0 + t) + dir * 512 + h * 128 + ch * 8);
        v4u o; o.x = pk2(kf[0] * fexp(-(float)ct[0]), kf[1] * fexp(-(float)ct[1])); o.y = pk2(kf[2] * fexp(-(float)ct[2]), kf[3] * fexp(-(float)ct[3]));
        o.z = pk2(kf[4] * fexp(-(float)ct[4]), kf[5] * fexp(-(float)ct[5])); o.w = pk2(kf[6] * fexp(-(float)ct[6]), kf[7] * fexp(-(float)ct[7]));
        *(LAS v4u*)(Kd + dir * 128 * KP + t * KP + ch * 8) = o; } }
    __syncthreads();
    const int i = 16 * wid + r;
    f32x4 o[16];
#pragma unroll
    for (int et = 0; et < 16; ++et) o[et] = (f32x4){0.f, 0.f, 0.f, 0.f};
#pragma unroll 1
    for (int dir = 0; dir < 2; ++dir) {
      bf16x8 qd[4];
      { const h16_t* ci = gcs_row(GCSL, GCSC, r0 + i) + dir * 512 + h * 128; const bf16_t* qp = Q0 + (r0 + i) * 512 + h * 128;
#pragma unroll
        for (int ks = 0; ks < 4; ++ks) { const v4u qv = *(const v4u*)(qp + 32 * ks + 8 * Qd); const h16x8 cc = *(const h16x8*)(ci + 32 * ks + 8 * Qd);
          const f32x4 c0 = {(float)cc[0], (float)cc[1], (float)cc[2], (float)cc[3]}, c1 = {(float)cc[4], (float)cc[5], (float)cc[6], (float)cc[7]};
          const unsigned w0 = pk2(__uint_as_float(qv.x << 16) * scale * fexp(c0.x), __uint_as_float(qv.x & 0xffff0000u) * scale * fexp(c0.y));
          const unsigned w1 = pk2(__uint_as_float(qv.y << 16) * scale * fexp(c0.z), __uint_as_float(qv.y & 0xffff0000u) * scale * fexp(c0.w));
          const unsigned w2 = pk2(__uint_as_float(qv.z << 16) * scale * fexp(c1.x), __uint_as_float(qv.z & 0xffff0000u) * scale * fexp(c1.y));
          const unsigned w3 = pk2(__uint_as_float(qv.w << 16) * scale * fexp(c1.z), __uint_as_float(qv.w & 0xffff0000u) * scale * fexp(c1.w));
          qd[ks] = (bf16x8){(short)(w0 & 0xffff), (short)(w0 >> 16), (short)(w1 & 0xffff), (short)(w1 >> 16), (short)(w2 & 0xffff), (short)(w2 >> 16), (short)(w3 & 0xffff), (short)(w3 >> 16)}; } }
      const bf16_t* Sp = ST + (((size_t)gc * 4 + h) * 2 + dir) * 32768 + lane * 8;
      {
        bf16x8 sA[4], sB[4];
#pragma unroll
        for (int q = 0; q < 4; ++q) sA[q] = *(const bf16x8*)(Sp + (q * 4 + 0) * 512);
#pragma unroll
        for (int bi = 0; bi < 16; ++bi) {
          const int ks = bi >> 2, e0 = 4 * (bi & 3);
          if (bi + 1 < 16) { const int ks2 = (bi + 1) >> 2, e2 = 4 * ((bi + 1) & 3);
#pragma unroll
            for (int q = 0; q < 4; ++q) { if (bi & 1) sA[q] = *(const bf16x8*)(Sp + ((e2 + q) * 4 + ks2) * 512); else sB[q] = *(const bf16x8*)(Sp + ((e2 + q) * 4 + ks2) * 512); } }
#pragma unroll
          for (int q = 0; q < 4; ++q) o[e0 + q] = __builtin_amdgcn_mfma_f32_16x16x32_bf16(qd[ks], (bi & 1) ? sB[q] : sA[q], o[e0 + q], 0, 0, 0);
          __builtin_amdgcn_sched_barrier(0);
        }
      }
      const LAS bf16_t* Kb = Kd + dir * 128 * KP;
#pragma unroll 1
      for (int k2 = 0; k2 < 4; ++k2) {
        const bool need = dir ? (2 * k2 + 1 >= wid) : (2 * k2 <= wid);
        if (!need) continue;
        bf16x8 pa;
#pragma unroll
        for (int tt = 0; tt < 2; ++tt) { const int t = 2 * k2 + tt;
          f32x4 c = {0.f, 0.f, 0.f, 0.f};
#pragma unroll
          for (int ks = 0; ks < 4; ++ks) { const bf16x8 kfr = *(const LAS bf16x8*)(Kb + (16 * t + r) * KP + 32 * ks + 8 * Qd); c = __builtin_amdgcn_mfma_f32_16x16x32_bf16(kfr, qd[ks], c, 0, 0, 0); }
          float pv[4];
#pragma unroll
          for (int jj = 0; jj < 4; ++jj) { const int j = 16 * t + 4 * Qd + jj; const bool ok = dir ? (j >= i) : (j <= i); pv[jj] = ok ? c[jj] : 0.f; }
          const unsigned w0 = pk2(pv[0], pv[1]), w1 = pk2(pv[2], pv[3]);
          pa[tt * 4 + 0] = (short)(w0 & 0xffff); pa[tt * 4 + 1] = (short)(w0 >> 16); pa[tt * 4 + 2] = (short)(w1 & 0xffff); pa[tt * 4 + 3] = (short)(w1 >> 16); }
#pragma unroll
        for (int et = 0; et < 16; ++et) {
          const s16x4 lo = tr_read(Vs + (32 * k2 + 4 * Qd + (r >> 2)) * VP + 16 * et + 4 * (r & 3));
          const s16x4 hi = tr_read(Vs + (32 * k2 + 16 + 4 * Qd + (r >> 2)) * VP + 16 * et + 4 * (r & 3));
          const bf16x8 vf = (bf16x8){lo[0], lo[1], lo[2], lo[3], hi[0], hi[1], hi[2], hi[3]};
          o[et] = __builtin_amdgcn_mfma_f32_16x16x32_bf16(pa, vf, o[et], 0, 0, 0); }
      }
    }
#pragma unroll
    for (int jj = 0; jj < 4; ++jj) { float ss = 0.f;
#pragma unroll
      for (int et = 0; et < 16; ++et) ss += o[et][jj] * o[et][jj];
      ss += __shfl_xor(ss, 1); ss += __shfl_xor(ss, 2); ss += __shfl_xor(ss, 4); ss += __shfl_xor(ss, 8);
      const float rstd = rsqrtf(ss * (1.f / 256.f) + EPS);
      const size_t yo = (r0 + 16 * wid + 4 * Qd + jj) * 2048 + 1024 + h * 256 + r;
#pragma unroll
      for (int et = 0; et < 16; ++et) { const bf16_t ov_ = f2bf(o[et][jj] * rstd * gla_norm[h * 256 + 16 * et + r] * bf2f(Y0[yo + 16 * et])); if (wr) Y0[yo + 16 * et] = ov_; } }
    { const int g = h >> 1, c0 = g * 512 + (h & 1) * 256;
#pragma unroll
      for (int q = 0; q < 8; ++q) { const int cid = tid + 512 * q, row = cid >> 5, ch = cid & 31; const size_t rr = r0 + row;
        const float rstd = rsqrtf((SSQ[(rr * 2 + g) * 2] + SSQ[(rr * 2 + g) * 2 + 1]) * (1.f / 512.f) + EPS);
        bf16_t* yp = Y0 + rr * 2048 + c0 + ch * 8; const v4u yv = *(const v4u*)yp; const f32x4 g0 = *(const f32x4*)(ssd_norm + c0 + ch * 8), g1 = *(const f32x4*)(ssd_norm + c0 + ch * 8 + 4);
        v4u ov; ov.x = pk2(__uint_as_float(yv.x << 16) * rstd * g0.x, __uint_as_float(yv.x & 0xffff0000u) * rstd * g0.y); ov.y = pk2(__uint_as_float(yv.y << 16) * rstd * g0.z, __uint_as_float(yv.y & 0xffff0000u) * rstd * g0.w);
        ov.z = pk2(__uint_as_float(yv.z << 16) * rstd * g1.x, __uint_as_float(yv.z & 0xffff0000u) * rstd * g1.y); ov.w = pk2(__uint_as_float(yv.w << 16) * rstd * g1.z, __uint_as_float(yv.w & 0xffff0000u) * rstd * g1.w);
        if (wr) *(v4u*)yp = ov; } }
  }
}

typedef __attribute__((address_space(1))) unsigned gu32;
#define RLX_AGENT __ATOMIC_RELAXED, __HIP_MEMORY_SCOPE_AGENT
#define XB_TMO      128
#define XB_XCNT(j)  (256  + 64 * (j))
#define XB_XSUB(j)  (1280 + 64 * (j))
#define XB_XGEN(j)  (2304 + 64 * (j))
#define XB_TOP      3328
#define XB_TOPGEN   3392
#define XCD_BAR_WORDS 3456
#define XB_SPIN_CAP (1u << 18)

__device__ __forceinline__ unsigned xb_ld(unsigned* p)              { return __hip_atomic_load(p, __ATOMIC_RELAXED, __HIP_MEMORY_SCOPE_AGENT); }
__device__ __forceinline__ unsigned xb_add(unsigned* p, unsigned v) { return __hip_atomic_fetch_add(p, v, __ATOMIC_RELAXED, __HIP_MEMORY_SCOPE_AGENT); }
__device__ __forceinline__ unsigned xb_xcc_id() { return (unsigned)__builtin_amdgcn_s_getreg((3 << 11) | 20) & 0xFu; }
#define XB_SPIN(cond, bar) do { unsigned _sp = 0; while (cond) { __builtin_amdgcn_s_sleep(1); \
    if ((++_sp & 255u) == 0u) { if (xb_ld(&(bar)[XB_TMO])) break; if (_sp > XB_SPIN_CAP) { atomicAdd(&(bar)[XB_TMO], 1u); break; } } } } while (0)

struct XcdBarrier {
    unsigned* bar; unsigned x;
    volatile LAS unsigned* st;
};

__device__ __forceinline__ XcdBarrier xcd_barrier_post(unsigned* bar, volatile LAS unsigned* st) {
    XcdBarrier b; b.bar = bar; b.x = xb_xcc_id(); b.st = st;
    if (threadIdx.x == 0) (void)xb_add(&bar[XB_XCNT(b.x)], 1u);
    return b;
}
__device__ __forceinline__ void xcd_barrier_complete(unsigned* bar, unsigned x, unsigned& nloc, unsigned& nx) {
    const unsigned G = gridDim.x * gridDim.y * gridDim.z;
    unsigned sum, cnt, mine, sp = 0u;
    for (;;) {
        sum = 0u; cnt = 0u; mine = 0u;
#pragma unroll
        for (unsigned j = 0; j < 16; ++j) { const unsigned c = xb_ld(&bar[XB_XCNT(j)]); sum += c; cnt += (c > 0u) ? 1u : 0u; mine = (j == x) ? c : mine; }
        if (sum == G) break;
        __builtin_amdgcn_s_sleep(1);
        if ((++sp & 255u) == 0u) { if (xb_ld(&bar[XB_TMO])) break; if (sp > XB_SPIN_CAP) { atomicAdd(&bar[XB_TMO], 1u); break; } }
    }
    nloc = mine > 0u ? mine : 1u; nx = cnt > 0u ? cnt : 1u;
}

__device__ __forceinline__ void xcd_barrier(const XcdBarrier& b) {
    asm volatile("s_waitcnt vmcnt(0)" ::: "memory");
    __syncthreads();
    if (threadIdx.x == 0) {
        unsigned* bar = b.bar;
        __builtin_amdgcn_s_waitcnt(0);
        unsigned nloc = b.st[0], nx = b.st[1];
        if (nloc == 0u) { xcd_barrier_complete(bar, b.x, nloc, nx); b.st[0] = nloc; b.st[1] = nx; }
        const unsigned old = xb_add(&bar[XB_XSUB(b.x)], 1u);
        const unsigned gen = old / nloc;
        if (old + 1u == (gen + 1u) * nloc) {
            __builtin_amdgcn_fence(__ATOMIC_RELEASE, "agent");
            asm volatile("s_waitcnt vmcnt(0)" ::: "memory");
            const unsigned og = xb_add(&bar[XB_TOP], 1u);
            const unsigned tg = og / nx;
            if (og + 1u == (tg + 1u) * nx) xb_add(&bar[XB_TOPGEN], 1u);
            else XB_SPIN(xb_ld(&bar[XB_TOPGEN]) == tg, bar);
            __builtin_amdgcn_fence(__ATOMIC_ACQUIRE, "agent");
            xb_add(&bar[XB_XGEN(b.x)], 1u);
            asm volatile("s_waitcnt vmcnt(0)" ::: "memory");
        } else {
            XB_SPIN(xb_ld(&bar[XB_XGEN(b.x)]) == gen, bar);
            __builtin_amdgcn_fence(__ATOMIC_ACQUIRE, "agent");
            asm volatile("s_waitcnt vmcnt(0)" ::: "memory");
        }
    }
    __syncthreads();
}

__global__ void __launch_bounds__(NWAVES * 64, 2) __attribute__((amdgpu_num_sgpr(92))) mega(Params p) {
  extern __shared__ __attribute__((aligned(16))) unsigned char lds_raw[];
  LAS unsigned char* lds = (LAS unsigned char*)lds_raw;
  volatile LAS unsigned* MISC = (volatile LAS unsigned*)(lds + MISC_OFF);
  if (threadIdx.x < 16) MISC[threadIdx.x] = 0u;
  __syncthreads();
  XcdBarrier bar = xcd_barrier_post((unsigned*)(p.ws + WS_CTL), MISC + 8);
  unsigned char* ws = p.ws;
  float* MOD = (float*)(ws + WS_MOD);
  bf16_t* H0 = (bf16_t*)p.out; float* X1 = p.out;
  const int lo = p.ph_lo, hi = p.ph_hi;
#define IN(k) (lo <= (k) && (k) < hi)
#define SEAM(k) do { if ((k) + 1 < hi) xcd_barrier(bar); } while (0)
#define PH(k, ...) if (IN(k)) { if ((PROBE_MASK >> (k)) & 1u) { const bool wr = (p.rep < 0); (void)wr; __VA_ARGS__; xcd_barrier(bar); } { const bool wr = true; (void)wr; __VA_ARGS__; } SEAM(k); }
  PH(0, prologue_phase(p, lds))
  PH(1, prep_phase(p.in[0], p.in[2], p.in[4], MOD, H0))
  PH(2, {
    pg8::Gemm g{H0, (const bf16_t*)(ws + WS_W1T), MA, E_INP, D}; pg8::StaticOrder S; S.init(MA, E_INP, gridDim.x, (int)blockIdx.x);
    pg8::EpiProj0 E{(bf16_t*)(ws + WS_Y0), (bf16_t*)(ws + WS_XBC), (bf16_t*)(ws + WS_Q0), (bf16_t*)(ws + WS_K0), (bf16_t*)(ws + WS_V0), (float*)(ws + WS_DTLR)};
    pg8::gemm_phase<pg8::EpiProj0, pg8::StaticOrder, true, true>(lds, g, S, E); })
  PH(3, ssd_prep_phase((const bf16_t*)(ws + WS_XBC), p.in[8], p.in[9], (bf16_t*)p.out, (const float*)(ws + WS_DTLR), p.in[10], p.in[11], (float*)((char*)p.out + DO_SDT), (float*)((char*)p.out + DO_SCS), (float*)(ws + WS_SDEC)))
  PH(4, { ssd_u_phase((const bf16_t*)p.out, (const float*)((char*)p.out + DO_SDT), (const float*)((char*)p.out + DO_SCS), (bf16_t*)(ws + WS_STATE), lds);
    { const int nbusy = (NCH * 4) % (int)gridDim.x, nfree = (int)gridDim.x - nbusy;
      const int vb_ = virt_block(); if (vb_ >= nbusy || nfree <= 0) { __syncthreads(); late_weights(p, lds, nfree > 0 ? vb_ - nbusy : vb_, nfree > 0 ? nfree : (int)gridDim.x); } } })
  PH(5, ssd_scan_phase((bf16_t*)(ws + WS_STATE), (const float*)(ws + WS_SDEC), wr))
  PH(6, { ssd_y_phase((const bf16_t*)p.out, (const float*)((char*)p.out + DO_SDT), (const float*)((char*)p.out + DO_SCS), (const bf16_t*)(ws + WS_STATE), p.in[12], (bf16_t*)(ws + WS_Y0), (float*)(ws + WS_SSQ), lds, wr);
    if (wr) gla_cs_phase((const float*)(ws + WS_DTLR), p.in[14], p.in[15], (h16_t*)ws, (h16_t*)p.out, (float*)(ws + WS_GDEC), lds, (unsigned*)(ws + WS_CTL) + CW_CSQ); })
  PH(8, gla_u_phase((const bf16_t*)(ws + WS_K0), (const bf16_t*)(ws + WS_V0), (const h16_t*)ws, (const h16_t*)p.out, (bf16_t*)(ws + WS_STATE), lds))
  PH(9, gla_scan_phase((bf16_t*)(ws + WS_STATE), (const float*)(ws + WS_GDEC), wr))
  PH(10, gla_o_phase((const bf16_t*)(ws + WS_Q0), (const bf16_t*)(ws + WS_K0), (const bf16_t*)(ws + WS_V0), (const h16_t*)ws, (const h16_t*)p.out, (const bf16_t*)(ws + WS_STATE), p.in[16], (const float*)(ws + WS_SSQ), p.in[13], (bf16_t*)(ws + WS_Y0), lds, wr))
  PH(11, {
    pg8::Gemm g{(const bf16_t*)(ws + WS_Y0), (const bf16_t*)(ws + WS_W2T), ML, D, 2048}; pg8::StaticOrder S; S.init(ML, D, gridDim.x, (int)blockIdx.x);
    pg8::EpiResid E{p.in[0], X1, MOD, true};
    pg8::gemm_phase<pg8::EpiResid, pg8::StaticOrder, true, true>(lds, g, S, E);
    const float* ctx = p.in[2]; float* XC1 = (float*)(ws + WS_XC1); const float* gate = MOD + 2 * 3072 + 2048;
    small_gemm_splitk((const bf16_t*)(ws + WS_Y0) + (size_t)ML * 2048, 2048, (const bf16_t*)(ws + WS_W2T), 2048, 2048, MC, D, lds,
               [=](int m, int n, float v) { XC1[(size_t)m * D + n] = ctx[(size_t)m * D + n] + gate[n] * v; }); })
  PH(12, prep_phase(X1, (const float*)(ws + WS_XC1), p.in[18], MOD + 3 * 3072, (bf16_t*)(ws + WS_H1)))
  PH(13, {
    pg8::Gemm g{(const bf16_t*)(ws + WS_H1), (const bf16_t*)(ws + WS_W3T), ML, O_IN, D}; pg8::StaticOrder S; S.init(ML, O_IN, gridDim.x, (int)blockIdx.x);
    pg8::EpiProj1 E{(bf16_t*)(ws + WS_K1), (bf16_t*)(ws + WS_V1), (bf16_t*)(ws + WS_Q1), (bf16_t*)(ws + WS_G1), p.in[22], p.in[23], (const float*)(ws + WS_ROPE), (LAS float*)(lds + 131072)};
    pg8::gemm_phase<pg8::EpiProj1, pg8::StaticOrder, true, true>(lds, g, S, E);
    bf16_t* K1 = (bf16_t*)(ws + WS_K1); bf16_t* V1 = (bf16_t*)(ws + WS_V1);
    small_gemm_splitk((const bf16_t*)(ws + WS_H1) + (size_t)ML * D, D, (const bf16_t*)(ws + WS_W3T), D, D, MC, 1024, lds,
               [=](int m, int n, float v) { if (n < 512) K1[(size_t)(ML + m) * 512 + n] = f2bf(v); else V1[(size_t)(ML + m) * 512 + (n - 512)] = f2bf(v); }); })
  PH(15, attn_phase((bf16_t*)(ws + WS_Q1), (const bf16_t*)(ws + WS_K1), (const bf16_t*)(ws + WS_V1), (const bf16_t*)(ws + WS_G1), p.in[24], p.in[22], p.in[23], lds, wr))
  PH(16, {
    pg8::Gemm g{(const bf16_t*)(ws + WS_Q1), (const bf16_t*)(ws + WS_W4T), ML, D, 2048}; pg8::StaticOrder S; S.init(ML, D, gridDim.x, (int)blockIdx.x);
    pg8::EpiResid E{X1, p.out, MOD + 3 * 3072, wr};
    pg8::gemm_phase<pg8::EpiResid, pg8::StaticOrder, true, true>(lds, g, S, E); })
#undef PH
#undef IN
#undef SEAM
}
extern "C" void kernel_launch(void* const* d_in, const int* in_sizes, int n_in, void* d_out, int out_size, void* d_ws, size_t ws_size, hipStream_t stream) {
  static int grid_blocks = 0;
  if (!grid_blocks) {
    int dev = 0, cus = 0, per_cu = 0;
    hipGetDevice(&dev);
    hipDeviceGetAttribute(&cus, hipDeviceAttributeMultiprocessorCount, dev);
    hipFuncSetAttribute((const void*)mega, hipFuncAttributeMaxDynamicSharedMemorySize, LDS_BYTES);
    hipOccupancyMaxActiveBlocksPerMultiprocessor(&per_cu, (const void*)mega, NWAVES * 64, LDS_BYTES);
    if (per_cu < 1) { fprintf(stderr, "kernel_launch: occupancy query says %d blocks per CU\n", per_cu); per_cu = 1; }
    if (per_cu > 1) per_cu = 1;
    grid_blocks = cus * per_cu;
  }
  hipMemsetAsync((char*)d_ws + WS_CTL, 0, 64 * 1024, stream);
  Params base{};
  for (int i = 0; i < 26; ++i) base.in[i] = (const float*)d_in[i];
  base.out = (float*)d_out; base.ws = (unsigned char*)d_ws;
  auto launch = [&](int lo, int hi) {
    Params p = base; p.ph_lo = lo; p.ph_hi = hi; p.rep = (int)PROBE_MASK; void* args[] = {&p};
    hipError_t e = hipLaunchCooperativeKernel((const void*)mega, dim3(grid_blocks), dim3(NWAVES * 64), args, LDS_BYTES, stream);
    if (e != hipSuccess) fprintf(stderr, "cooperative launch failed: %s (grid %d)\n", hipGetErrorString(e), grid_blocks);
  };
  launch(0, 17);
}
```

```cpp
#include <hip/hip_runtime.h>
#include <hip/hip_cooperative_groups.h>
#include <stdint.h>
#include <math.h>
#include <cstdio>
namespace cg = cooperative_groups;
#ifndef PROBE_SKIP
#define PROBE_SKIP 0
#endif
#ifndef PROBE_MASK
#define PROBE_MASK 0u
#endif

typedef unsigned short bf16_t;
#define DEV __device__ __forceinline__

DEV float bf2f(bf16_t v) { return __uint_as_float(((unsigned)v) << 16); }
typedef float f32x2_t __attribute__((ext_vector_type(2))); typedef __bf16 bf16x2_t __attribute__((ext_vector_type(2)));
DEV unsigned pk2(float lo, float hi) { const f32x2_t v = {lo, hi}; const bf16x2_t b = __builtin_convertvector(v, bf16x2_t); return __builtin_bit_cast(unsigned, b); }
DEV bf16_t f2bf(float f) { return (bf16_t)(pk2(f, 0.f) & 0xffffu); }
DEV float fexp(float x) { return __builtin_amdgcn_exp2f(x * 1.4426950408889634f); }
DEV float siluf(float x) { return x / (1.f + fexp(-x)); }
DEV float silu_fast(float x) { return x * __builtin_amdgcn_rcpf(1.f + fexp(-x)); }
DEV float softplusf(float x) { return x > 20.f ? x : log1pf(fexp(x)); }
DEV float logsigmoidf(float x) { return fminf(x, 0.f) - log1pf(fexp(-fabsf(x))); }

constexpr int D = 1024, NB = 2, SEQ = 8192, CTXL = 256;
constexpr int ML = NB * SEQ;
constexpr int MC = NB * CTXL;
constexpr int MA = ML + MC;
constexpr int NCH = MA / 128;
constexpr int E_IN = 5696, O_IN = 5120, E_INP = 5888;
constexpr float EPS = 1e-6f;

constexpr size_t MiB = 1u << 20;
constexpr int CW_CSQ = 8192;
constexpr size_t WS_CTL = 0;
constexpr size_t WS_MOD = 1 * MiB;
constexpr size_t WS_ROPE = 1 * MiB + 128 * 1024;
constexpr size_t WS_SDEC = 1 * MiB + 256 * 1024;
constexpr size_t WS_GDEC = 1 * MiB + 384 * 1024;
constexpr size_t WS_W1T = 2 * MiB;
constexpr size_t WS_W2T = 14 * MiB;
constexpr size_t WS_W3T = 18 * MiB;
constexpr size_t WS_W4T = 28 * MiB;
constexpr size_t WS_Y0 = 32 * MiB;
constexpr size_t WS_Q0 = 98 * MiB;
constexpr size_t WS_K0 = WS_Q0 + 16 * MiB + 512 * 1024;
constexpr size_t WS_V0 = 131 * MiB;
constexpr size_t WS_DTLR = 164 * MiB;
constexpr size_t WS_XC1 = 168 * MiB + 512 * 1024;
constexpr size_t WS_XBC = 171 * MiB;
constexpr size_t WS_STATE = 171 * MiB;
constexpr size_t WS_TAIL = 237 * MiB;
constexpr size_t WS_H1 = 32 * MiB;
constexpr size_t WS_K1 = 65 * MiB;
constexpr size_t WS_V1 = 81 * MiB + 512 * 1024;
constexpr size_t WS_Q1 = 98 * MiB;
constexpr size_t WS_G1 = 171 * MiB;

DEV int row_vec(int row) { return row < ML ? (row / SEQ) : 2; }

namespace pg8 {
#define PG8_LAS __attribute__((address_space(3)))
typedef unsigned short bf16_t;
typedef short bf16x8 __attribute__((ext_vector_type(8)));
typedef float f32x4 __attribute__((ext_vector_type(4)));
typedef unsigned u32x4 __attribute__((ext_vector_type(4)));
constexpr int BM = 256, BK = 64, HALF = 128, HTB = HALF * BK * 2  , STAGE_BYTES = 8 * HTB, NXCD = 8, WGM = 8;

__host__ __device__ __forceinline__ int lds_byte(int r, int c) { const int st = (r >> 4) * 2 + (c >> 5), rr = r & 15, cc = c & 31, ob = rr * 64 + cc * 2; return st * 1024 + (ob ^ (((ob >> 9) & 1) << 5)); }
__host__ __device__ __forceinline__ void stage_rc(int b, int& R, int& C) { const int st = b / 1024, sb = b % 1024, swz = sb ^ (((sb >> 9) & 1) << 5); R = (st >> 1) * 16 + swz / 64; C = (st & 1) * 32 + (swz % 64) / 2; }
__host__ __device__ __forceinline__ int perm32(int rho) { const int n = rho >> 4, i = rho & 15; return 8 * (i >> 2) + 4 * n + (i & 3); }

struct Unit { int pm, pn; };
struct Gemm { const bf16_t* A; const bf16_t* Bt; int M, N, K; };

struct StaticOrder {
    int nM, nN, nwg, G, c;
    __host__ __device__ __forceinline__ void init(int M, int N, int G_, int c_) { nM = M / BM; nN = N / BM; nwg = nM * nN; G = G_; c = c_; }
    __host__ __device__ __forceinline__ bool next(int i, Unit& u) const {
        const long L = (long)i * G + c; if (L >= nwg) return false;
        int wgid = (int)L; { const int q = nwg / NXCD, r = nwg % NXCD, xcd = wgid % NXCD, off = wgid / NXCD; wgid = (xcd < r ? xcd * (q + 1) : r * (q + 1) + (xcd - r) * q) + off; }
        const int nig = WGM * nN, gid = wgid / nig, fm = gid * WGM, gsz = (nM - fm) < WGM ? (nM - fm) : WGM;
        u.pm = fm + ((wgid % nig) % gsz); u.pn = (wgid % nig) / gsz; return true;
    }
    __device__ __forceinline__ void a_ready(const Unit&) const {}
    __device__ __forceinline__ void done(const Unit&) const {}
};
__device__ __forceinline__ unsigned cvt_pk_bf16(float lo, float hi) { unsigned r; asm volatile("v_cvt_pk_bf16_f32 %0, %1, %2" : "=v"(r) : "v"(lo), "v"(hi)); return r; }
__device__ __forceinline__ float silu_e(float x) { return x * __builtin_amdgcn_rcpf(1.f + fexp(-x)); }

__device__ __forceinline__ void store_unit_bf16(const f32x4 (&acc)[2][2][4][2], bf16_t* base, int ld, int colt, bool act, const Unit& u, int wr, int wc, int fr, int fq) {
    const int row0 = u.pm * BM + wr * 64 + fr; const int col0 = colt + wc * 32 + 8 * fq;
#pragma unroll
    for (int ai = 0; ai < 2; ++ai)
#pragma unroll
        for (int m = 0; m < 4; ++m) { bf16_t* rowp = base + (size_t)(row0 + ai * HALF + m * 16) * ld + col0;
#pragma unroll
            for (int bj = 0; bj < 2; ++bj) { f32x4 v0 = acc[ai][bj][m][0], v1 = acc[ai][bj][m][1];
                if (act) { v0 = (f32x4){silu_e(v0[0]), silu_e(v0[1]), silu_e(v0[2]), silu_e(v0[3])}; v1 = (f32x4){silu_e(v1[0]), silu_e(v1[1]), silu_e(v1[2]), silu_e(v1[3])}; }
                u32x4 w; w.x = cvt_pk_bf16(v0[0], v0[1]); w.y = cvt_pk_bf16(v0[2], v0[3]); w.z = cvt_pk_bf16(v1[0], v1[1]); w.w = cvt_pk_bf16(v1[2], v1[3]);
                *(u32x4*)(rowp + bj * HALF) = w; } }
}
struct EpiProj0 {
    static constexpr bool PERM = true, AFTER_DRAIN = false;
    bf16_t *Y0, *XBC, *Q0, *K0, *V0; float* DTLR;
    __device__ __forceinline__ void operator()(const f32x4 (&acc)[2][2][4][2], const Unit& u, int wr, int wc, int fr, int fq) const {
        const int pn = u.pn;
        if (pn == 22) {
            if (wc < 2) { const int row0 = u.pm * BM + wr * 64 + fr;
#pragma unroll
                for (int ai = 0; ai < 2; ++ai)
#pragma unroll
                    for (int m = 0; m < 4; ++m) { float* rp = DTLR + (size_t)(row0 + ai * HALF + m * 16) * 64 + wc * 32 + 8 * fq; *(f32x4*)rp = acc[ai][0][m][0]; *(f32x4*)(rp + 4) = acc[ai][0][m][1]; } }
            return;
        }
        bf16_t* base; int ld, colt; bool act = false;
        if (pn < 8) { base = Y0; ld = 2048; colt = pn * 256; act = true; }
        else if (pn < 14) { base = XBC; ld = 1536; colt = (pn - 8) * 256; }
        else if (pn < 16) { base = Q0; ld = 512; colt = (pn - 14) * 256; }
        else if (pn < 18) { base = K0; ld = 512; colt = (pn - 16) * 256; }
        else { base = V0; ld = 1024; colt = (pn - 18) * 256; }
        store_unit_bf16(acc, base, ld, colt, act, u, wr, wc, fr, fq);
    }
};
struct EpiProj1 {
    static constexpr bool PERM = true, AFTER_DRAIN = false;
    bf16_t *K1, *V1, *Q1, *G1; const float *qn, *kn, *rope; PG8_LAS float* part;
    __device__ __forceinline__ void operator()(const f32x4 (&acc)[2][2][4][2], const Unit& u, int wr, int wc, int fr, int fq) const {
        const int pn = u.pn; bf16_t* base; int ld, colt; bool act = false;
        if (pn < 2) { base = K1; ld = 512; colt = pn * 256; }
        else if (pn < 4) { base = V1; ld = 512; colt = (pn - 2) * 256; }
        else if (pn < 12) { base = Q1; ld = 2048; colt = (pn - 4) * 256; }
        else { base = G1; ld = 2048; colt = (pn - 12) * 256; act = true; }
        const bool isk = pn < 2, isq = pn >= 4 && pn < 12;
        if (!(isk || isq)) { store_unit_bf16(acc, base, ld, colt, act, u, wr, wc, fr, fq); return; }
#pragma unroll
        for (int ai = 0; ai < 2; ++ai)
#pragma unroll
            for (int m = 0; m < 4; ++m)
#pragma unroll
                for (int bj = 0; bj < 2; ++bj) { const f32x4 x0 = acc[ai][bj][m][0], x1 = acc[ai][bj][m][1];
                    float s = (x0[0] * x0[0] + x0[1] * x0[1]) + (x0[2] * x0[2] + x0[3] * x0[3]) + (x1[0] * x1[0] + x1[1] * x1[1]) + (x1[2] * x1[2] + x1[3] * x1[3]);
                    s += __shfl_xor(s, 16); s += __shfl_xor(s, 32);
                    if (fq == 0) part[(ai * HALF + wr * 64 + m * 16 + fr) * 8 + bj * 4 + wc] = s; }
        asm volatile("s_waitcnt lgkmcnt(0)" ::: "memory"); __builtin_amdgcn_s_barrier(); asm volatile("" ::: "memory");
        const int a = wc >> 1, f0 = 16 * (wc & 1) + 4 * fq;
        const float* gn = (isq ? qn : kn) + a * 64 + f0;
        const f32x4 g0 = *(const f32x4*)gn, g1 = *(const f32x4*)(gn + 32);
        const float osc = isq ? 0.08838834764831845f * 1.4426950408889634f : 1.f;
        const int col0 = colt + wc * 32 + 8 * fq;
        f32x4 w_[2][2][4][2];
#pragma unroll
        for (int ai = 0; ai < 2; ++ai)
#pragma unroll
            for (int bj = 0; bj < 2; ++bj)
#pragma unroll
                for (int m = 0; m < 4; ++m) { w_[ai][bj][m][0] = acc[ai][bj][m][0]; w_[ai][bj][m][1] = acc[ai][bj][m][1]; }
#pragma unroll 1
        for (int m = 0; m < 4; ++m) {
#pragma unroll
            for (int ai = 0; ai < 2; ++ai) { const int rowl = ai * HALF + wr * 64 + m * 16 + fr, row = u.pm * BM + rowl, t = row & 8191, pos = a ? (t & 63) : (t >> 6);
                const f32x4 cs = *(const f32x4*)(rope + pos * 32 + f0), sn = *(const f32x4*)(rope + 4096 + pos * 32 + f0);
                bf16_t* rowp = base + (size_t)row * ld + col0;
#pragma unroll
                for (int bj = 0; bj < 2; ++bj) { const f32x4 p4 = *(const PG8_LAS f32x4*)(part + rowl * 8 + bj * 4);
                    const float rstd = __builtin_amdgcn_rsqf(((p4[0] + p4[1]) + (p4[2] + p4[3])) * (1.f / 128.f) + 1e-6f) * osc;
                    const f32x4 t1 = w_[ai][bj][0][0] * g0 * rstd, t2 = w_[ai][bj][0][1] * g1 * rstd;
                    const f32x4 o1 = t1 * cs - t2 * sn, o2 = t2 * cs + t1 * sn;
                    u32x4 w; w.x = cvt_pk_bf16(o1[0], o1[1]); w.y = cvt_pk_bf16(o1[2], o1[3]); w.z = cvt_pk_bf16(o2[0], o2[1]); w.w = cvt_pk_bf16(o2[2], o2[3]);
                    *(u32x4*)(rowp + bj * HALF) = w; } }
#pragma unroll
            for (int ai = 0; ai < 2; ++ai)
#pragma unroll
                for (int bj = 0; bj < 2; ++bj)
#pragma unroll
                    for (int n = 0; n < 2; ++n) { w_[ai][bj][0][n] = w_[ai][bj][1][n]; w_[ai][bj][1][n] = w_[ai][bj][2][n]; w_[ai][bj][2][n] = w_[ai][bj][3][n]; }
        }
    }
};
struct EpiResid {
    static constexpr bool PERM = false, AFTER_DRAIN = false;
    const float* res; float* out; const float* mod; bool do_store;
    __device__ __forceinline__ void operator()(const f32x4 (&acc)[2][2][4][2], const Unit& u, int wr, int wc, int fr, int fq) const {
        const int b = (u.pm * BM) / 8192; const float* gate = mod + b * 3072 + 2048;
        const int col0 = u.pn * BM + wc * 32 + 4 * fq;
        f32x4 gv[2][2];
#pragma unroll
        for (int bj = 0; bj < 2; ++bj)
#pragma unroll
            for (int n = 0; n < 2; ++n) gv[bj][n] = *(const f32x4*)(gate + col0 + bj * HALF + n * 16);
#pragma unroll
        for (int ai = 0; ai < 2; ++ai)
#pragma unroll
            for (int m = 0; m < 4; ++m) { const size_t off = (size_t)(u.pm * BM + ai * HALF + wr * 64 + m * 16 + fr) * 1024 + col0;
#pragma unroll
                for (int bj = 0; bj < 2; ++bj)
#pragma unroll
                    for (int n = 0; n < 2; ++n) { const f32x4 r = *(const f32x4*)(res + off + bj * HALF + n * 16); const f32x4 ov_ = r + gv[bj][n] * acc[ai][bj][m][n]; if (do_store) *(f32x4*)(out + off + bj * HALF + n * 16) = ov_; } }
    }
};
template <class Epi, class Sched, bool ALIGN_EPI = false, bool SP2 = false>
__device__ __forceinline__ void gemm_phase(PG8_LAS unsigned char* lds, const Gemm g, const Sched& S, const Epi& E) {
    const int tid = threadIdx.x, wid = __builtin_amdgcn_readfirstlane(tid >> 6), lane = tid & 63, wr = wid >> 2, wc = wid & 3, fr = lane & 15, fq = lane >> 4;
    const int K = g.K, nt = K / BK;
    unsigned voffA[2], voffB[2];
#pragma unroll
    for (int i = 0; i < 2; ++i) { int R, C; stage_rc(tid * 16 + i * 8192, R, C); const int Rb = Epi::PERM ? ((R & ~31) + perm32(R & 31)) : R;
        voffA[i] = (unsigned)(R * K + C) * 2u; voffB[i] = (unsigned)(Rb * K + C) * 2u; }
    const size_t kstep = (size_t)(BK * 2);
    const size_t hstep = (size_t)HALF * K * 2;
    const size_t tstep = 2 * hstep;
    const unsigned ldsw = (unsigned)wid * 1024u;
    const int aoff = lds_byte(wr * 64 + fr, fq * 8), boff = lds_byte(wc * 32 + fr, fq * 8);
#define PG8_SA(b, h) (((b) * 2 + (h)) * HTB)
#define PG8_SB(b, h) ((4 + (b) * 2 + (h)) * HTB)
#define PG8_STAGE(bufoff, gbase, voff) do { _Pragma("unroll") for (int _i = 0; _i < 2; ++_i) \
        __builtin_amdgcn_global_load_lds((const unsigned*)((const char*)(gbase) + (voff)[_i]), (PG8_LAS unsigned*)(lds + (bufoff) + ldsw + _i * 8192), 16, 0, 0); } while (0)
#define PG8_LDA(dst, b, h) do { _Pragma("unroll") for (int m = 0; m < 4; ++m) _Pragma("unroll") for (int k = 0; k < 2; ++k) dst[m][k] = *(const PG8_LAS bf16x8*)(lds + PG8_SA(b, h) + aoff + m * 2048 + k * 1024); } while (0)
#define PG8_LDB(dst, b, h) do { _Pragma("unroll") for (int n = 0; n < 2; ++n) _Pragma("unroll") for (int k = 0; k < 2; ++k) dst[n][k] = *(const PG8_LAS bf16x8*)(lds + PG8_SB(b, h) + boff + n * 2048 + k * 1024); } while (0)
#define PG8_MMA(ai, bj, At, Bt) do { __builtin_amdgcn_s_setprio(1); _Pragma("unroll") for (int m = 0; m < 4; ++m) _Pragma("unroll") for (int n = 0; n < 2; ++n) _Pragma("unroll") for (int k = 0; k < 2; ++k) \
        acc[ai][bj][m][n] = __builtin_amdgcn_mfma_f32_16x16x32_bf16(Bt[n][k], At[m][k], acc[ai][bj][m][n], 0, 0, 0); __builtin_amdgcn_s_setprio(0); } while (0)
#define PG8_WAIT_V(n) asm volatile("s_waitcnt vmcnt(" #n ")" ::: "memory")
#define PG8_WAIT_L(n) asm volatile("s_waitcnt lgkmcnt(" #n ")" ::: "memory")
#define PG8_BAR __builtin_amdgcn_s_barrier()
#define PG8_SCHED __builtin_amdgcn_sched_barrier(0)
    Unit cur, nxt; int ui = 0;
    if (!S.next(0, cur)) return;
    f32x4 acc[2][2][4][2];
#pragma unroll
    for (int a = 0; a < 2; ++a)
#pragma unroll
        for (int b = 0; b < 2; ++b)
#pragma unroll
            for (int m = 0; m < 4; ++m)
#pragma unroll
                for (int n = 0; n < 2; ++n) acc[a][b][m][n] = (f32x4){0.f, 0.f, 0.f, 0.f};
    bf16x8 At[4][2], B0[2][2], B1[2][2];
    const char* cA = (const char*)g.A + (size_t)cur.pm * tstep; const char* cB = (const char*)g.Bt + (size_t)cur.pn * tstep;
    S.a_ready(cur);
    if constexpr (SP2) {
        PG8_STAGE(PG8_SB(0, 0), cB, voffB); PG8_STAGE(PG8_SB(0, 1), cB + hstep, voffB); PG8_STAGE(PG8_SA(0, 0), cA, voffA); PG8_STAGE(PG8_SA(0, 1), cA + hstep, voffA);
        if (wr == 1) PG8_BAR;
        PG8_WAIT_V(2); PG8_BAR;
        PG8_STAGE(PG8_SB(1, 0), cB + kstep, voffB); PG8_STAGE(PG8_SA(1, 0), cA + kstep, voffA); PG8_STAGE(PG8_SB(1, 1), cB + hstep + kstep, voffB);
        PG8_WAIT_V(6); PG8_BAR;
    } else {
        PG8_STAGE(PG8_SB(0, 0), cB, voffB); PG8_STAGE(PG8_SA(0, 0), cA, voffA); PG8_STAGE(PG8_SB(0, 1), cB + hstep, voffB); PG8_STAGE(PG8_SA(0, 1), cA + hstep, voffA);
        if (wr == 1) PG8_BAR;
        PG8_WAIT_V(4); PG8_BAR;
        PG8_STAGE(PG8_SB(1, 0), cB + kstep, voffB); PG8_STAGE(PG8_SA(1, 0), cA + kstep, voffA); PG8_STAGE(PG8_SB(1, 1), cB + hstep + kstep, voffB);
        PG8_WAIT_V(6); PG8_BAR;
    }
    for (;;) {
        const bool has_next = S.next(ui + 1, nxt);
        const char* nA = has_next ? (const char*)g.A + (size_t)nxt.pm * tstep : cA; const char* nB = has_next ? (const char*)g.Bt + (size_t)nxt.pn * tstep : cB;
        for (int t = 0; t < nt; t += 2) {
            const bool last = (t == nt - 2);
            const char* a1 = cA + (size_t)(t + 1) * kstep;
            const char* a2 = last ? nA : cA + (size_t)(t + 2) * kstep; const char* b2 = last ? nB : cB + (size_t)(t + 2) * kstep;
            const char* a3 = a2 + kstep; const char* b3 = b2 + kstep;
            if (last && has_next) S.a_ready(nxt);
            if constexpr (SP2) {
            PG8_LDB(B0, 0, 0); PG8_LDB(B1, 0, 1); PG8_SCHED; PG8_LDA(At, 0, 0); PG8_STAGE(PG8_SA(1, 1), a1 + hstep, voffA);
            PG8_WAIT_V(8); PG8_WAIT_L(0); PG8_BAR; PG8_MMA(0, 0, At, B0); PG8_MMA(0, 1, At, B1); PG8_BAR; PG8_SCHED;
            PG8_LDA(At, 0, 1); PG8_STAGE(PG8_SB(0, 0), b2, voffB); PG8_STAGE(PG8_SB(0, 1), b2 + hstep, voffB); PG8_STAGE(PG8_SA(0, 0), a2, voffA);
            PG8_WAIT_V(8); PG8_WAIT_L(0); PG8_BAR; PG8_MMA(1, 0, At, B0); PG8_MMA(1, 1, At, B1); PG8_BAR; PG8_SCHED;
            PG8_LDB(B0, 1, 0); PG8_LDB(B1, 1, 1); PG8_SCHED; PG8_LDA(At, 1, 0); PG8_STAGE(PG8_SA(0, 1), a2 + hstep, voffA);
            PG8_WAIT_V(8); PG8_WAIT_L(0); PG8_BAR; PG8_MMA(0, 0, At, B0); PG8_MMA(0, 1, At, B1); PG8_BAR; PG8_SCHED;
            PG8_LDA(At, 1, 1); PG8_STAGE(PG8_SB(1, 0), b3, voffB); PG8_STAGE(PG8_SB(1, 1), b3 + hstep, voffB); PG8_STAGE(PG8_SA(1, 0), a3, voffA);
            PG8_WAIT_V(8); PG8_WAIT_L(0); PG8_BAR; PG8_MMA(1, 0, At, B0); PG8_MMA(1, 1, At, B1); PG8_BAR; PG8_SCHED;
            } else {
            PG8_LDB(B0, 0, 0); PG8_SCHED; PG8_LDA(At, 0, 0); PG8_STAGE(PG8_SA(1, 1), a1 + hstep, voffA);
            PG8_WAIT_L(8); PG8_BAR; PG8_WAIT_L(0); PG8_MMA(0, 0, At, B0); PG8_BAR; PG8_SCHED;
            PG8_LDB(B1, 0, 1); PG8_STAGE(PG8_SB(0, 0), b2, voffB);
            PG8_BAR; PG8_WAIT_L(0); PG8_MMA(0, 1, At, B1); PG8_BAR;
            PG8_LDA(At, 0, 1); PG8_STAGE(PG8_SA(0, 0), a2, voffA);
            PG8_BAR; PG8_WAIT_L(0); PG8_MMA(1, 0, At, B0); PG8_BAR; PG8_SCHED;
            PG8_STAGE(PG8_SB(0, 1), b2 + hstep, voffB);
            PG8_WAIT_V(6); PG8_BAR; PG8_MMA(1, 1, At, B1); PG8_BAR;
            PG8_LDB(B0, 1, 0); PG8_SCHED; PG8_LDA(At, 1, 0); PG8_STAGE(PG8_SA(0, 1), a2 + hstep, voffA);
            PG8_WAIT_L(8); PG8_BAR; PG8_WAIT_L(0); PG8_MMA(0, 0, At, B0); PG8_BAR; PG8_SCHED;
            PG8_LDB(B1, 1, 1); PG8_STAGE(PG8_SB(1, 0), b3, voffB);
            PG8_BAR; PG8_WAIT_L(0); PG8_MMA(0, 1, At, B1); PG8_BAR;
            PG8_LDA(At, 1, 1); PG8_STAGE(PG8_SA(1, 0), a3, voffA);
            PG8_BAR; PG8_WAIT_L(0); PG8_MMA(1, 0, At, B0); PG8_BAR; PG8_SCHED;
            PG8_STAGE(PG8_SB(1, 1), b3 + hstep, voffB);
            PG8_WAIT_V(6); PG8_BAR; PG8_MMA(1, 1, At, B1); PG8_BAR;
            }
        }
        if constexpr (ALIGN_EPI) { if (wr == 0) PG8_BAR; }
        if constexpr (!Epi::AFTER_DRAIN) { E(acc, cur, wr, wc, fr, fq); S.done(cur); }
        if (!has_next) break;
#pragma unroll
        for (int a = 0; a < 2; ++a)
#pragma unroll
            for (int b = 0; b < 2; ++b)
#pragma unroll
                for (int m = 0; m < 4; ++m)
#pragma unroll
                    for (int n = 0; n < 2; ++n) acc[a][b][m][n] = (f32x4){0.f, 0.f, 0.f, 0.f};
        cur = nxt; cA = nA; cB = nB; ++ui;
        if constexpr (ALIGN_EPI) { if (wr == 1) PG8_BAR; }
    }
    PG8_WAIT_V(0);
    if constexpr (!ALIGN_EPI) { if (wr == 0) PG8_BAR; }
    PG8_BAR;
    if constexpr (Epi::AFTER_DRAIN) { E.fused(acc, cur, wr, wc, fr, fq, lds, wid, lane); S.done(cur); }
#undef PG8_SA
#undef PG8_SB
#undef PG8_STAGE
#undef PG8_LDA
#undef PG8_LDB
#undef PG8_MMA
#undef PG8_WAIT_V
#undef PG8_WAIT_L
#undef PG8_BAR
#undef PG8_SCHED
}
}
#define LAS __attribute__((address_space(3)))
typedef unsigned v4u __attribute__((ext_vector_type(4)));
typedef float f32x4 __attribute__((ext_vector_type(4)));
typedef short bf16x8 __attribute__((ext_vector_type(8)));
#define LDS_WAIT() asm volatile("s_waitcnt lgkmcnt(0)" ::: "memory")
constexpr int NWAVES = 8;
constexpr int LDS_BYTES = 147456;
constexpr int MISC_OFF = 147456 - 128;

struct Params { const float* in[26]; float* out; unsigned char* ws; int ph_lo, ph_hi, rep, pad; };

DEV int virt_block() { const int G = (int)gridDim.x, b = (int)blockIdx.x; return (G % 8 == 0) ? (b % 8) * (G / 8) + b / 8 : b; }
DEV float wave_sum(float v) {
#pragma unroll
  for (int o = 1; o < 64; o <<= 1) v += __shfl_xor(v, o);
  return v;
}

DEV int w1_dest_row(int n) {
  if (n < 1024) return n;
  if (n < 2560) return 2048 + (n - 1024);
  if (n < 2592) return 5632 + (n - 2560);
  if (n < 3104) return 3584 + (n - 2592);
  if (n < 3616) return 4096 + (n - 3104);
  if (n < 4640) return 4608 + (n - 3616);
  if (n < 5664) return 1024 + (n - 4640);
  return n;
}
DEV int qk_pos(int d) { const int a = d >> 6, s = (d >> 5) & 1, f = d & 31; return 32 * (2 * a + (f >> 4)) + 8 * ((f >> 2) & 3) + 4 * s + (f & 3); }
DEV void transpose_item(const float* W, int K, int N, int k0, int n0, bf16_t* WT, int drow0, LAS float* scr, int lane, int headbase = -1) {
#pragma unroll 8
  for (int i = 0; i < 32; ++i) { const int kk = 2 * i + (lane >> 5); scr[kk * 33 + (lane & 31)] = W[(size_t)(k0 + kk) * N + n0 + (lane & 31)]; }
  LDS_WAIT(); asm volatile("" ::: "memory");
  const int c = lane & 7;
#pragma unroll
  for (int j = 0; j < 4; ++j) { const int n = (lane >> 3) + 8 * j; const LAS float* s = scr + (8 * c) * 33 + n;
    v4u o; o.x = pk2(s[0 * 33], s[1 * 33]); o.y = pk2(s[2 * 33], s[3 * 33]); o.z = pk2(s[4 * 33], s[5 * 33]); o.w = pk2(s[6 * 33], s[7 * 33]);
    const int drow = headbase >= 0 ? headbase + qk_pos((n0 & 127) + n) : drow0 + n;
    *(v4u*)(WT + (size_t)drow * K + k0 + 8 * c) = o; }
  LDS_WAIT(); asm volatile("" ::: "memory");
}
DEV void prologue_phase(const Params& p, LAS unsigned char* lds) {
  const int tid = threadIdx.x, lane = tid & 63, wave = tid >> 6;
  unsigned char* ws = p.ws;
  float* MOD = (float*)(ws + WS_MOD);
  {
    LAS float* sc = (LAS float*)lds;
    LAS float* part = (LAS float*)(lds + 12288);
    for (int i = tid; i < 3072; i += 512) { const int v = i >> 10, k = i & 1023; const float cv = v < 2 ? p.in[1][v * 1024 + k] : p.in[3][k]; sc[i] = siluf(cv); }
    __syncthreads();
    for (int task = blockIdx.x; task < 192; task += gridDim.x) {
      const int l = task / 96, n0 = (task % 96) * 32; const float* w = l ? p.in[19] : p.in[5]; const float* bb = l ? p.in[20] : p.in[6];
      const int col = tid & 31, ks = tid >> 5;
      float a0 = 0.f, a1 = 0.f, a2 = 0.f;
#pragma unroll 16
      for (int k = ks * 64; k < ks * 64 + 64; ++k) { const float wv = w[(size_t)k * 3072 + n0 + col]; a0 += sc[k] * wv; a1 += sc[1024 + k] * wv; a2 += sc[2048 + k] * wv; }
      part[(ks * 3 + 0) * 32 + col] = a0; part[(ks * 3 + 1) * 32 + col] = a1; part[(ks * 3 + 2) * 32 + col] = a2;
      __syncthreads();
      if (tid < 96) { const int v = tid >> 5; float s = bb[n0 + col];
#pragma unroll
        for (int q = 0; q < 16; ++q) s += part[(q * 3 + v) * 32 + col];
        MOD[(l * 3 + v) * 3072 + n0 + col] = s; }
      __syncthreads();
    }
  }
  if (blockIdx.x == gridDim.x - 1) { float* rope = (float*)(ws + WS_ROPE);
    for (int idx = tid; idx < 4096; idx += 512) { const int pos = idx >> 5, f = idx & 31; const float inv = 1.0f / powf(10000.f, (float)f / 32.f); const float ang = (float)pos * inv; rope[idx] = cosf(ang); rope[4096 + idx] = sinf(ang); } }
  { v4u* z = (v4u*)(ws + WS_W1T + (size_t)E_IN * 1024 * 2); const v4u zero = {0u, 0u, 0u, 0u};
    for (int i = blockIdx.x * 512 + tid; i < (E_INP - E_IN) * 1024 * 2 / 16; i += gridDim.x * 512) z[i] = zero; }
  __syncthreads();
  {
    LAS float* scr = (LAS float*)(lds + wave * 16384);
    const int gw = blockIdx.x * NWAVES + wave, NGW = gridDim.x * NWAVES;
    constexpr int I1 = 16 * 178;
    for (int it = gw; it < I1; it += NGW) { const int kb = it / 178, nb = it % 178; transpose_item(p.in[7], 1024, E_IN, 64 * kb, 32 * nb, (bf16_t*)(ws + WS_W1T), w1_dest_row(32 * nb), scr, lane); }
  }
}
DEV void late_weights(const Params& p, LAS unsigned char* lds, int vblock, int nvblocks) {
  const int lane = threadIdx.x & 63, wave = threadIdx.x >> 6; unsigned char* ws = p.ws;
  LAS float* scr = (LAS float*)(lds + wave * 16384);
  constexpr int I2 = 32 * 32, I3 = 16 * 160, I4 = 32 * 32;
  for (int it = vblock * NWAVES + wave; it < I2 + I3 + I4; it += nvblocks * NWAVES) {
    int r = it;
    if (r < I2) { const int kb = r / 32, nb = r % 32; transpose_item(p.in[17], 2048, 1024, 64 * kb, 32 * nb, (bf16_t*)(ws + WS_W2T), 32 * nb, scr, lane); continue; } r -= I2;
    if (r < I3) { const int kb = r / 160, nb = r % 160, n0 = 32 * nb; const bool qk = n0 < 512 || (n0 >= 1024 && n0 < 3072);
      transpose_item(p.in[21], 1024, O_IN, 64 * kb, n0, (bf16_t*)(ws + WS_W3T), n0, scr, lane, qk ? (n0 & ~127) : -1); continue; } r -= I3;
    { const int kb = r / 32, nb = r % 32; transpose_item(p.in[25], 2048, 1024, 64 * kb, 32 * nb, (bf16_t*)(ws + WS_W4T), 32 * nb, scr, lane); }
  }
}
DEV void prep_phase(const float* xlat, const float* xctx, const float* g, const float* mod, bf16_t* H) {
  const int lane = threadIdx.x & 63, wave = threadIdx.x >> 6, NW = gridDim.x * NWAVES;
  for (int row = blockIdx.x * NWAVES + wave; row < MA; row += 2 * NW) {
    const int row2 = row + NW; const bool has2 = row2 < MA;
    const float* s0 = row < ML ? xlat + (size_t)row * D : xctx + (size_t)(row - ML) * D;
    const float* s1 = has2 ? (row2 < ML ? xlat + (size_t)row2 * D : xctx + (size_t)(row2 - ML) * D) : s0;
    f32x4 v0[4], v1[4]; float ss0 = 0.f, ss1 = 0.f;
#pragma unroll
    for (int j = 0; j < 4; ++j) { v0[j] = *(const f32x4*)(s0 + 4 * lane + 256 * j); v1[j] = *(const f32x4*)(s1 + 4 * lane + 256 * j); }
#pragma unroll
    for (int j = 0; j < 4; ++j) { ss0 += (v0[j].x * v0[j].x + v0[j].y * v0[j].y) + (v0[j].z * v0[j].z + v0[j].w * v0[j].w); ss1 += (v1[j].x * v1[j].x + v1[j].y * v1[j].y) + (v1[j].z * v1[j].z + v1[j].w * v1[j].w); }
#pragma unroll
    for (int o = 1; o < 64; o <<= 1) { ss0 += __shfl_xor(ss0, o); ss1 += __shfl_xor(ss1, o); }
    const float r0 = rsqrtf(ss0 * (1.f / D) + EPS), r1 = rsqrtf(ss1 * (1.f / D) + EPS);
    const float* m0 = mod + row_vec(row) * 3072; const float* m1 = mod + row_vec(has2 ? row2 : row) * 3072;
#pragma unroll
    for (int j = 0; j < 4; ++j) { const int k = 4 * lane + 256 * j; const f32x4 gg = *(const f32x4*)(g + k);
      { const f32x4 sc = *(const f32x4*)(m0 + 1024 + k), sh = *(const f32x4*)(m0 + k); const f32x4 o = v0[j] * r0 * gg * (sc + 1.f) + sh;
        *(unsigned long long*)(H + (size_t)row * D + k) = (unsigned long long)pk2(o.x, o.y) | ((unsigned long long)pk2(o.z, o.w) << 32); }
      if (has2) { const f32x4 sc = *(const f32x4*)(m1 + 1024 + k), sh = *(const f32x4*)(m1 + k); const f32x4 o = v1[j] * r1 * gg * (sc + 1.f) + sh;
        *(unsigned long long*)(H + (size_t)row2 * D + k) = (unsigned long long)pk2(o.x, o.y) | ((unsigned long long)pk2(o.z, o.w) << 32); } }
  }
}
template <class F> DEV void small_gemm(const bf16_t* A, int lda, const bf16_t* Bt, int ldb, int K, int Mrows, int Ncols, F f) {
  const int lane = threadIdx.x & 63, wid = threadIdx.x >> 6, mt = wid >> 2, nt = wid & 3, r = lane & 15, q = lane >> 4;
  const int ntn = Ncols / 64, ntasks = (Mrows / 32) * ntn;
  for (int task = blockIdx.x; task < ntasks; task += gridDim.x) {
    const int row0 = (task / ntn) * 32 + mt * 16, col0 = (task % ntn) * 64 + nt * 16;
    const bf16_t* ap = A + (size_t)(row0 + r) * lda + 8 * q; const bf16_t* bp = Bt + (size_t)(col0 + r) * ldb + 8 * q;
    f32x4 acc = {0.f, 0.f, 0.f, 0.f};
#pragma unroll 8
    for (int k = 0; k < K; k += 32) { const bf16x8 a = *(const bf16x8*)(ap + k), b = *(const bf16x8*)(bp + k); acc = __builtin_amdgcn_mfma_f32_16x16x32_bf16(a, b, acc, 0, 0, 0); }
#pragma unroll
    for (int j = 0; j < 4; ++j) f(row0 + q * 4 + j, col0 + r, acc[j]);
  }
}

template <class F> DEV void small_gemm_splitk(const bf16_t* A, int lda, const bf16_t* Bt, int ldb, int K, int Mrows, int Ncols, LAS unsigned char* lds, F f) {
  const int tid = threadIdx.x, lane = tid & 63, wid = tid >> 6, r = lane & 15, q = lane >> 4;
  LAS float* red = (LAS float*)lds;
  const int ntn = Ncols / 64, ntasks = (Mrows / 32) * ntn, kw = K / 8;
  for (int task = virt_block(); task < ntasks; task += gridDim.x) {
    const int row0 = (task / ntn) * 32, col0 = (task % ntn) * 64;
    const bf16_t* ap = A + (size_t)(row0 + r) * lda + wid * kw + 8 * q; const bf16_t* bp = Bt + (size_t)(col0 + r) * ldb + wid * kw + 8 * q;
    f32x4 acc[2][4];
#pragma unroll
    for (int mt = 0; mt < 2; ++mt)
#pragma unroll
      for (int nt = 0; nt < 4; ++nt) acc[mt][nt] = (f32x4){0.f, 0.f, 0.f, 0.f};
#pragma unroll 4
    for (int k = 0; k < kw; k += 32) {
      bf16x8 a[2], b[4];
#pragma unroll
      for (int mt = 0; mt < 2; ++mt) a[mt] = *(const bf16x8*)(ap + (size_t)(16 * mt) * lda + k);
#pragma unroll
      for (int nt = 0; nt < 4; ++nt) b[nt] = *(const bf16x8*)(bp + (size_t)(16 * nt) * ldb + k);
#pragma unroll
      for (int mt = 0; mt < 2; ++mt)
#pragma unroll
        for (int nt = 0; nt < 4; ++nt) acc[mt][nt] = __builtin_amdgcn_mfma_f32_16x16x32_bf16(a[mt], b[nt], acc[mt][nt], 0, 0, 0);
    }
    __syncthreads();
#pragma unroll
    for (int mt = 0; mt < 2; ++mt)
#pragma unroll
      for (int nt = 0; nt < 4; ++nt)
#pragma unroll
        for (int j = 0; j < 4; ++j) red[wid * 2048 + (16 * mt + 4 * q + j) * 64 + 16 * nt + r] = acc[mt][nt][j];
    __syncthreads();
#pragma unroll
    for (int o = 0; o < 4; ++o) { const int e = tid + 512 * o; float s = 0.f;
#pragma unroll
      for (int w = 0; w < 8; ++w) s += red[w * 2048 + e];
      f(row0 + (e >> 6), col0 + (e & 63), s); }
  }
}

DEV void qknorm_phase(bf16_t* Q1, bf16_t* K1, const float* qn, const float* kn, const float* rope, bool wr) {
  const int lane = threadIdx.x & 63, wave = threadIdx.x >> 6, hl = lane >> 4, d0 = (lane & 15) * 8;
  const float scale = 0.08838834764831845f * 1.4426950408889634f;
  float gq[8], gk[8];
#pragma unroll
  for (int e = 0; e < 8; ++e) { gq[e] = qn[d0 + e] * scale; gk[e] = kn[d0 + e]; }
  const int ax = d0 >> 6, sgn = (d0 >> 5) & 1, f0 = d0 & 31;
  for (int row = blockIdx.x * NWAVES + wave; row < MA; row += gridDim.x * NWAVES) {
    const bool lat = row < ML;
    v4u raw[5];
    raw[0] = *(const v4u*)(K1 + (size_t)row * 512 + hl * 128 + d0);
    if (lat) {
#pragma unroll
      for (int g = 0; g < 4; ++g) raw[1 + g] = *(const v4u*)(Q1 + (size_t)row * 2048 + (g * 4 + hl) * 128 + d0);
    }
    float cs[8], sn[8];
    if (lat) { const int t = row % SEQ, pos = ax ? (t & 63) : (t >> 6);
      const f32x4 c0 = *(const f32x4*)(rope + pos * 32 + f0), c1 = *(const f32x4*)(rope + pos * 32 + f0 + 4), s0 = *(const f32x4*)(rope + 4096 + pos * 32 + f0), s1 = *(const f32x4*)(rope + 4096 + pos * 32 + f0 + 4);
      cs[0] = c0.x; cs[1] = c0.y; cs[2] = c0.z; cs[3] = c0.w; cs[4] = c1.x; cs[5] = c1.y; cs[6] = c1.z; cs[7] = c1.w;
      sn[0] = s0.x; sn[1] = s0.y; sn[2] = s0.z; sn[3] = s0.w; sn[4] = s1.x; sn[5] = s1.y; sn[6] = s1.z; sn[7] = s1.w; }
    const int ng = lat ? 5 : 1;
#pragma unroll
    for (int g = 0; g < 5; ++g) {
      if (g < ng) {
        const v4u rv = raw[g];
        float v[8] = {__uint_as_float(rv.x << 16), __uint_as_float(rv.x & 0xffff0000u), __uint_as_float(rv.y << 16), __uint_as_float(rv.y & 0xffff0000u), __uint_as_float(rv.z << 16), __uint_as_float(rv.z & 0xffff0000u), __uint_as_float(rv.w << 16), __uint_as_float(rv.w & 0xffff0000u)};
        float ss = 0.f;
#pragma unroll
        for (int e = 0; e < 8; ++e) ss += v[e] * v[e];
        ss += __shfl_xor(ss, 1); ss += __shfl_xor(ss, 2); ss += __shfl_xor(ss, 4); ss += __shfl_xor(ss, 8);
        const float rstd = rsqrtf(ss * (1.f / 128.f) + EPS);
#pragma unroll
        for (int e = 0; e < 8; ++e) v[e] *= rstd * (g == 0 ? gk[e] : gq[e]);
        if (lat) {
#pragma unroll
          for (int e = 0; e < 8; ++e) { const float o = __shfl_xor(v[e], 4); v[e] = sgn ? (v[e] * cs[e] + o * sn[e]) : (v[e] * cs[e] - o * sn[e]); }
        }
        v4u ov; ov.x = pk2(v[0], v[1]); ov.y = pk2(v[2], v[3]); ov.z = pk2(v[4], v[5]); ov.w = pk2(v[6], v[7]);
        if (wr) { if (g == 0) *(v4u*)(K1 + (size_t)row * 512 + hl * 128 + d0) = ov; else *(v4u*)(Q1 + (size_t)row * 2048 + ((g - 1) * 4 + hl) * 128 + d0) = ov; }
      }
    }
  }
}
typedef short s16x4 __attribute__((ext_vector_type(4)));
DEV s16x4 tr_read(const LAS bf16_t* p) { return __builtin_bit_cast(s16x4, __builtin_amdgcn_ds_read_tr16_b64_v4i16((LAS s16x4*)p)); }
DEV void attn_phase(bf16_t* Q1, const bf16_t* K1, const bf16_t* V1, const bf16_t* G1, const float* sink, const float* qn, const float* kn, LAS unsigned char* lds, bool wr) {
  constexpr int KP = 136, VP = 144;
  LAS bf16_t* Ks = (LAS bf16_t*)lds;
  LAS bf16_t* Vs = (LAS bf16_t*)(lds + 2 * 64 * KP * 2);
  LAS float* dsc = (LAS float*)(lds + 2 * 64 * KP * 2 + 2 * 64 * VP * 2);
  const int tid = threadIdx.x, lane = tid & 63, wid = tid >> 6, r = lane & 15, Qd = lane >> 4;
  float mb;
  { float a = fmaxf(fabsf(qn[lane]), fabsf(qn[64 + lane])), b = fmaxf(fabsf(kn[lane]), fabsf(kn[64 + lane]));
#pragma unroll
    for (int o = 1; o < 64; o <<= 1) { a = fmaxf(a, __shfl_xor(a, o)); b = fmaxf(b, __shfl_xor(b, o)); }
    mb = a * b * 11.313708498984761f * 1.4426950408889634f; }
  for (int task = virt_block(); task < 1024; task += gridDim.x) {
    const int b = task >> 9, kvh = (task >> 7) & 3, qt = task & 127;
    const int hq = kvh * 4 + (wid >> 1), qoff = (wid & 1) * 32;
    const size_t qrow0 = (size_t)b * SEQ + qt * 64 + qoff;
    bf16x8 qf[2][4];
#pragma unroll
    for (int m = 0; m < 2; ++m)
#pragma unroll
      for (int ks = 0; ks < 4; ++ks) qf[m][ks] = *(const bf16x8*)(Q1 + (qrow0 + 16 * m + r) * 2048 + hq * 128 + ks * 32 + 8 * Qd);
    const int tlo = (2 - qt) > 0 ? (2 - qt) : 0, thi = (129 - qt) < 4 ? (129 - qt) : 4, nband = thi - tlo + 1, ntile = nband + 4;
    const int skey = tid >> 4, sch = tid & 15;
    float gk[8];
    { const int dA = ((sch >> 2) >> 1) * 64 + 16 * ((sch >> 2) & 1) + 4 * (sch & 3); const f32x4 ga = *(const f32x4*)(kn + dA), gb_ = *(const f32x4*)(kn + dA + 32);
      gk[0] = ga.x; gk[1] = ga.y; gk[2] = ga.z; gk[3] = ga.w; gk[4] = gb_.x; gk[5] = gb_.y; gk[6] = gb_.z; gk[7] = gb_.w; }
    v4u kreg[2], vreg[2];
#define TILE_ROW0(i) ((i) < nband ? (size_t)b * SEQ + (size_t)(qt - 2 + tlo + (i)) * 64 : (size_t)ML + b * CTXL + ((i) - nband) * 64)
#define LOAD_TILE(i) do { const size_t r0_ = TILE_ROW0(i); _Pragma("unroll") for (int h_ = 0; h_ < 2; ++h_) { const size_t go_ = (r0_ + skey + 32 * h_) * 512 + kvh * 128 + sch * 8; kreg[h_] = *(const v4u*)(K1 + go_); vreg[h_] = *(const v4u*)(V1 + go_); } } while (0)
#define STORE_TILE(buf, ti) do { const bool ctx_ = (ti) >= nband; _Pragma("unroll") for (int h_ = 0; h_ < 2; ++h_) { v4u kw_ = kreg[h_]; \
      if (ctx_) { float v_[8] = {__uint_as_float(kw_.x << 16), __uint_as_float(kw_.x & 0xffff0000u), __uint_as_float(kw_.y << 16), __uint_as_float(kw_.y & 0xffff0000u), __uint_as_float(kw_.z << 16), __uint_as_float(kw_.z & 0xffff0000u), __uint_as_float(kw_.w << 16), __uint_as_float(kw_.w & 0xffff0000u)}; \
        float ss_ = 0.f; _Pragma("unroll") for (int e_ = 0; e_ < 8; ++e_) ss_ += v_[e_] * v_[e_]; \
        ss_ += __shfl_xor(ss_, 1); ss_ += __shfl_xor(ss_, 2); ss_ += __shfl_xor(ss_, 4); ss_ += __shfl_xor(ss_, 8); \
        const float rs_ = rsqrtf(ss_ * (1.f / 128.f) + EPS); _Pragma("unroll") for (int e_ = 0; e_ < 8; ++e_) v_[e_] *= rs_ * gk[e_]; \
        kw_.x = pk2(v_[0], v_[1]); kw_.y = pk2(v_[2], v_[3]); kw_.z = pk2(v_[4], v_[5]); kw_.w = pk2(v_[6], v_[7]); } \
      *(LAS v4u*)(Ks + (buf) * 64 * KP + (skey + 32 * h_) * KP + sch * 8) = kw_; *(LAS v4u*)(Vs + (buf) * 64 * VP + (skey + 32 * h_) * VP + sch * 8) = vreg[h_]; } } while (0)
    LOAD_TILE(0);
    __syncthreads();
    STORE_TILE(0, 0);
    __syncthreads();
    f32x4 o[2][8];
#pragma unroll
    for (int m = 0; m < 2; ++m)
#pragma unroll
      for (int n = 0; n < 8; ++n) o[m][n] = (f32x4){0.f, 0.f, 0.f, 0.f};
    float lsum[2] = {0.f, 0.f};
    for (int i = 0; i < ntile; ++i) {
      const int buf = i & 1;
      if (i + 1 < ntile) LOAD_TILE(i + 1);
      const int mtype = (i < nband) ? ((tlo + i) == 0 ? 1 : ((tlo + i) == 4 ? 2 : 0)) : 0;
      const LAS bf16_t* Kb = Ks + buf * 64 * KP; const LAS bf16_t* Vb = Vs + buf * 64 * VP;
      f32x4 s[4][2];
#pragma unroll
      for (int t = 0; t < 4; ++t) { s[t][0] = (f32x4){-mb, -mb, -mb, -mb}; s[t][1] = (f32x4){-mb, -mb, -mb, -mb}; }
#pragma unroll
      for (int ks = 0; ks < 4; ++ks)
#pragma unroll
        for (int t = 0; t < 4; ++t) { const bf16x8 kf = *(const LAS bf16x8*)(Kb + (16 * t + r) * KP + ks * 32 + 8 * Qd);
          s[t][0] = __builtin_amdgcn_mfma_f32_16x16x32_bf16(kf, qf[0][ks], s[t][0], 0, 0, 0);
          s[t][1] = __builtin_amdgcn_mfma_f32_16x16x32_bf16(kf, qf[1][ks], s[t][1], 0, 0, 0); }
      bf16x8 pa[2][2];
#pragma unroll
      for (int m = 0; m < 2; ++m) { const int qi = qoff + 16 * m + r;
#pragma unroll
        for (int t = 0; t < 4; ++t) {
          float pv[4];
#pragma unroll
          for (int j = 0; j < 4; ++j) { const int kj = 16 * t + 4 * Qd + j; float pj = __builtin_amdgcn_exp2f(s[t][m][j]);
            if (mtype != 0) { if (mtype == 1) pj = (kj >= qi) ? pj : 0.f; else pj = (kj <= qi) ? pj : 0.f; }
            pv[j] = pj; lsum[m] += pj; }
          const unsigned w0 = pk2(pv[0], pv[1]), w1 = pk2(pv[2], pv[3]);
          pa[m][t >> 1][(t & 1) * 4 + 0] = (short)(w0 & 0xffff); pa[m][t >> 1][(t & 1) * 4 + 1] = (short)(w0 >> 16);
          pa[m][t >> 1][(t & 1) * 4 + 2] = (short)(w1 & 0xffff); pa[m][t >> 1][(t & 1) * 4 + 3] = (short)(w1 >> 16); } }
#pragma unroll
      for (int k2 = 0; k2 < 2; ++k2)
#pragma unroll
        for (int n = 0; n < 8; ++n) {
          const s16x4 lo = tr_read(Vb + (32 * k2 + 4 * Qd + (r >> 2)) * VP + 16 * n + 4 * (r & 3));
          const s16x4 hi = tr_read(Vb + (32 * k2 + 16 + 4 * Qd + (r >> 2)) * VP + 16 * n + 4 * (r & 3));
          const bf16x8 vf = (bf16x8){lo[0], lo[1], lo[2], lo[3], hi[0], hi[1], hi[2], hi[3]};
          o[0][n] = __builtin_amdgcn_mfma_f32_16x16x32_bf16(pa[0][k2], vf, o[0][n], 0, 0, 0);
          o[1][n] = __builtin_amdgcn_mfma_f32_16x16x32_bf16(pa[1][k2], vf, o[1][n], 0, 0, 0); }
      if (i + 1 < ntile) STORE_TILE(buf ^ 1, i + 1);
      __syncthreads();
    }
#undef TILE_ROW0
#undef LOAD_TILE
#undef STORE_TILE
    const float sk = __builtin_amdgcn_exp2f(sink[hq] * 1.4426950408889634f - mb);
#pragma unroll
    for (int m = 0; m < 2; ++m) { float l = lsum[m]; l += __shfl_xor(l, 16); l += __shfl_xor(l, 32); if (Qd == 0) dsc[wid * 32 + 16 * m + r] = 1.f / (l + sk); }
    LDS_WAIT(); asm volatile("" ::: "memory");
    { LAS bf16_t* stg = (LAS bf16_t*)lds + wid * 32 * 136;
#pragma unroll
      for (int m = 0; m < 2; ++m)
#pragma unroll
        for (int j = 0; j < 4; ++j) { const float inv = dsc[wid * 32 + 16 * m + 4 * Qd + j];
#pragma unroll
          for (int n = 0; n < 8; ++n) stg[(16 * m + 4 * Qd + j) * 136 + 16 * n + r] = f2bf(o[m][n][j] * inv); }
      LDS_WAIT(); asm volatile("" ::: "memory");
#pragma unroll
      for (int q = 0; q < 8; ++q) { const int c = lane + 64 * q, rowl = c >> 4, ch = c & 15; const size_t go = (qrow0 + rowl) * 2048 + hq * 128 + ch * 8;
        const v4u ov = *(const LAS v4u*)(stg + rowl * 136 + ch * 8), gv = *(const v4u*)(G1 + go);
        v4u w; w.x = pk2(__uint_as_float(ov.x << 16) * __uint_as_float(gv.x << 16), __uint_as_float(ov.x & 0xffff0000u) * __uint_as_float(gv.x & 0xffff0000u));
        w.y = pk2(__uint_as_float(ov.y << 16) * __uint_as_float(gv.y << 16), __uint_as_float(ov.y & 0xffff0000u) * __uint_as_float(gv.y & 0xffff0000u));
        w.z = pk2(__uint_as_float(ov.z << 16) * __uint_as_float(gv.z << 16), __uint_as_float(ov.z & 0xffff0000u) * __uint_as_float(gv.z & 0xffff0000u));
        w.w = pk2(__uint_as_float(ov.w << 16) * __uint_as_float(gv.w << 16), __uint_as_float(ov.w & 0xffff0000u) * __uint_as_float(gv.w & 0xffff0000u));
        if (wr) *(v4u*)(Q1 + go) = w; }
      LDS_WAIT(); asm volatile("" ::: "memory"); }
  }
}

constexpr size_t DO_SDT = 50 * MiB, DO_SCS = 53 * MiB;
constexpr size_t WS_SSQ = 237 * MiB;
DEV unsigned short bfbits(float f) { return f2bf(f); }
DEV void ssd_prep_phase(const bf16_t* XBC, const float* cw, const float* cb, bf16_t* XC, const float* DTLR, const float* dt_bias, const float* a_log, float* SDT, float* SCS, float* SDEC) {
  const int gtid = blockIdx.x * 512 + threadIdx.x, gth = gridDim.x * 512;
  for (int it = gtid; it < (MA / 32) * 192; it += gth) {
    const int rg = it / 192, c8 = (it % 192) * 8, row0 = rg * 32;
    int t0, len;
    if (row0 < ML) { t0 = row0 % SEQ; len = SEQ; } else { t0 = (row0 - ML) % CTXL; len = CTXL; }
    float w[5][8], bias[8];
#pragma unroll
    for (int k = 0; k < 5; ++k) { const f32x4 w0 = *(const f32x4*)(cw + k * 1536 + c8), w1 = *(const f32x4*)(cw + k * 1536 + c8 + 4);
      w[k][0] = w0.x; w[k][1] = w0.y; w[k][2] = w0.z; w[k][3] = w0.w; w[k][4] = w1.x; w[k][5] = w1.y; w[k][6] = w1.z; w[k][7] = w1.w; }
    { const f32x4 b0 = *(const f32x4*)(cb + c8), b1 = *(const f32x4*)(cb + c8 + 4); bias[0] = b0.x; bias[1] = b0.y; bias[2] = b0.z; bias[3] = b0.w; bias[4] = b1.x; bias[5] = b1.y; bias[6] = b1.z; bias[7] = b1.w; }
    const v4u zero4 = {0u, 0u, 0u, 0u};
    v4u win[4];
#pragma unroll
    for (int q = 0; q < 4; ++q) { const int tt = t0 - 2 + q; win[q] = (tt >= 0 && tt < len) ? *(const v4u*)(XBC + (size_t)(row0 - 2 + q) * 1536 + c8) : zero4; }
#pragma unroll 4
    for (int i = 0; i < 32; ++i) {
      const int tt = t0 + i + 2; const v4u nx = (tt < len) ? *(const v4u*)(XBC + (size_t)(row0 + i + 2) * 1536 + c8) : zero4;
      float acc[8];
#pragma unroll
      for (int e = 0; e < 8; ++e) acc[e] = bias[e];
#define CONV_TAP(k, xv) do { acc[0] += w[k][0] * __uint_as_float((xv).x << 16); acc[1] += w[k][1] * __uint_as_float((xv).x & 0xffff0000u); acc[2] += w[k][2] * __uint_as_float((xv).y << 16); acc[3] += w[k][3] * __uint_as_float((xv).y & 0xffff0000u); \
        acc[4] += w[k][4] * __uint_as_float((xv).z << 16); acc[5] += w[k][5] * __uint_as_float((xv).z & 0xffff0000u); acc[6] += w[k][6] * __uint_as_float((xv).w << 16); acc[7] += w[k][7] * __uint_as_float((xv).w & 0xffff0000u); } while (0)
      CONV_TAP(0, win[0]); CONV_TAP(1, win[1]); CONV_TAP(2, win[2]); CONV_TAP(3, win[3]); CONV_TAP(4, nx);
#undef CONV_TAP
      v4u o; o.x = pk2(silu_fast(acc[0]), silu_fast(acc[1])); o.y = pk2(silu_fast(acc[2]), silu_fast(acc[3])); o.z = pk2(silu_fast(acc[4]), silu_fast(acc[5])); o.w = pk2(silu_fast(acc[6]), silu_fast(acc[7]));
      *(v4u*)(XC + (size_t)(row0 + i) * 1536 + c8) = o;
      win[0] = win[1]; win[1] = win[2]; win[2] = win[3]; win[3] = nx;
    }
  }
  {
    const int lane = threadIdx.x & 63, wave = threadIdx.x >> 6, cl = lane & 7, seg = lane >> 3;
    for (int wt = blockIdx.x * NWAVES + wave; wt < NCH * 4; wt += gridDim.x * NWAVES) {
      const int gc = wt >> 2, col = (wt & 3) * 8 + cl, dir = col >> 4, h = col & 15;
      const float a = -fexp(a_log[col]), bias = dt_bias[col];
      float dtv[16], v[16]; float run = 0.f;
#pragma unroll
      for (int u = 0; u < 16; ++u) { const int s = seg * 16 + u, t = dir ? 127 - s : s; dtv[u] = softplusf(DTLR[((size_t)gc * 128 + t) * 64 + col] + bias); }
#pragma unroll
      for (int u = 0; u < 16; ++u) { run += dtv[u] * a; v[u] = run; }
      float off = 0.f;
#pragma unroll
      for (int sgi = 0; sgi < 7; ++sgi) { const float tot = __shfl(run, cl + 8 * sgi); off += (sgi < seg) ? tot : 0.f; }
#pragma unroll
      for (int u = 0; u < 16; ++u) { const int s = seg * 16 + u, t = dir ? 127 - s : s; const size_t row = (size_t)gc * 128 + t; SDT[row * 32 + col] = dtv[u]; SCS[row * 32 + col] = v[u] + off; }
      if (seg == 7) SDEC[(gc * 16 + h) * 2 + dir] = fexp(run + off);
    }
  }
}
DEV void ssd_u_phase(const bf16_t* XC, const float* SDT, const float* SCS, bf16_t* ST, LAS unsigned char* lds) {
  constexpr int XP = 272, BP = 144;
  LAS bf16_t* Xs = (LAS bf16_t*)lds; LAS bf16_t* Bs = (LAS bf16_t*)(lds + 128 * XP * 2); LAS float* wtab = (LAS float*)(lds + 128 * XP * 2 + 128 * BP * 2);
  const int tid = threadIdx.x, lane = tid & 63, wid = tid >> 6, r = lane & 15, Qd = lane >> 4, hl = wid >> 1, dir = wid & 1;
  for (int task = virt_block(); task < NCH * 4; task += gridDim.x) {
    const int gc = task >> 2, g = (task >> 1) & 1, hh = task & 1; const size_t r0 = (size_t)gc * 128; const int h0 = g * 8 + hh * 4;
    __syncthreads();
#pragma unroll
    for (int i = 0; i < 8; ++i) { const int cid = tid + 512 * i, row = cid >> 5, ch = cid & 31; *(LAS v4u*)(Xs + row * XP + ch * 8) = *(const v4u*)(XC + (r0 + row) * 1536 + h0 * 64 + ch * 8); }
#pragma unroll
    for (int i = 0; i < 4; ++i) { const int cid = tid + 512 * i, row = cid >> 4, ch = cid & 15; *(LAS v4u*)(Bs + row * BP + ch * 8) = *(const v4u*)(XC + (r0 + row) * 1536 + 1024 + g * 128 + ch * 8); }
    if (tid < 256) { const int d_ = tid >> 7, t = tid & 127;
      const f32x4 ce = *(const f32x4*)(SCS + (r0 + (d_ ? 0 : 127)) * 32 + d_ * 16 + h0), ct = *(const f32x4*)(SCS + (r0 + t) * 32 + d_ * 16 + h0), dt = *(const f32x4*)(SDT + (r0 + t) * 32 + d_ * 16 + h0);
      wtab[(0 * 2 + d_) * 128 + t] = fexp(ce.x - ct.x) * dt.x; wtab[(1 * 2 + d_) * 128 + t] = fexp(ce.y - ct.y) * dt.y; wtab[(2 * 2 + d_) * 128 + t] = fexp(ce.z - ct.z) * dt.z; wtab[(3 * 2 + d_) * 128 + t] = fexp(ce.w - ct.w) * dt.w; }
    __syncthreads();
    const LAS float* wt = wtab + wid * 128;
    bf16_t* Sp = ST + ((((size_t)gc * 16 + h0 + hl) * 2 + dir) * 64) * 128;
#pragma unroll 1
    for (int pp = 0; pp < 2; ++pp) {
      f32x4 acc[8][2];
#pragma unroll
      for (int nt = 0; nt < 8; ++nt) { acc[nt][0] = (f32x4){0.f, 0.f, 0.f, 0.f}; acc[nt][1] = (f32x4){0.f, 0.f, 0.f, 0.f}; }
#pragma unroll 1
      for (int k = 0; k < 4; ++k) {
        const f32x4 wlo = *(const LAS f32x4*)(wt + 32 * k + 4 * Qd), whi = *(const LAS f32x4*)(wt + 32 * k + 16 + 4 * Qd);
        bf16x8 xf[2];
#pragma unroll
        for (int pt = 0; pt < 2; ++pt) {
          const s16x4 lo = tr_read(Xs + (32 * k + 4 * Qd + (r >> 2)) * XP + hl * 64 + 32 * pp + 16 * pt + 4 * (r & 3));
          const s16x4 hi = tr_read(Xs + (32 * k + 16 + 4 * Qd + (r >> 2)) * XP + hl * 64 + 32 * pp + 16 * pt + 4 * (r & 3));
          const unsigned w0 = pk2(bf2f((bf16_t)lo[0]) * wlo[0], bf2f((bf16_t)lo[1]) * wlo[1]), w1 = pk2(bf2f((bf16_t)lo[2]) * wlo[2], bf2f((bf16_t)lo[3]) * wlo[3]);
          const unsigned w2 = pk2(bf2f((bf16_t)hi[0]) * whi[0], bf2f((bf16_t)hi[1]) * whi[1]), w3 = pk2(bf2f((bf16_t)hi[2]) * whi[2], bf2f((bf16_t)hi[3]) * whi[3]);
          xf[pt] = (bf16x8){(short)(w0 & 0xffff), (short)(w0 >> 16), (short)(w1 & 0xffff), (short)(w1 >> 16), (short)(w2 & 0xffff), (short)(w2 >> 16), (short)(w3 & 0xffff), (short)(w3 >> 16)};
        }
#pragma unroll
        for (int nt = 0; nt < 8; ++nt) {
          const s16x4 lo = tr_read(Bs + (32 * k + 4 * Qd + (r >> 2)) * BP + 16 * nt + 4 * (r & 3));
          const s16x4 hi = tr_read(Bs + (32 * k + 16 + 4 * Qd + (r >> 2)) * BP + 16 * nt + 4 * (r & 3));
          const bf16x8 bfr = (bf16x8){lo[0], lo[1], lo[2], lo[3], hi[0], hi[1], hi[2], hi[3]};
          acc[nt][0] = __builtin_amdgcn_mfma_f32_16x16x32_bf16(bfr, xf[0], acc[nt][0], 0, 0, 0);
          acc[nt][1] = __builtin_amdgcn_mfma_f32_16x16x32_bf16(bfr, xf[1], acc[nt][1], 0, 0, 0);
        }
      }
#pragma unroll
      for (int nt = 0; nt < 8; ++nt)
#pragma unroll
        for (int pt = 0; pt < 2; ++pt) { const f32x4 v = acc[nt][pt];
          *(unsigned long long*)(Sp + ((((2 * pp + pt) * 4 + (nt >> 1)) * 64 + ((nt & 1) * 2 + (Qd >> 1)) * 16 + r) * 8 + 4 * (Qd & 1))) = (unsigned long long)pk2(v[0], v[1]) | ((unsigned long long)pk2(v[2], v[3]) << 32); }
    }
  }
}
DEV void ssd_scan_phase(bf16_t* ST, const float* SDEC, bool wr) {
  for (int item = blockIdx.x * 512 + threadIdx.x; item < 2 * 16 * 2 * 2048; item += gridDim.x * 512) {
    const int e4 = item & 2047, dir = (item >> 11) & 1, h = (item >> 12) & 15, b = item >> 16;
    float S0 = 0.f, S1 = 0.f, S2 = 0.f, S3 = 0.f;
#define SCAN_GC(s) (!dir ? ((s) < 2 ? 128 + 2 * b + (s) : b * 64 + ((s) - 2)) : ((s) < 2 ? 128 + 2 * b + (1 - (s)) : b * 64 + (65 - (s))))
    for (int s0 = 0; s0 < 66; s0 += 6) {
      unsigned long long u[6]; float dec[6];
#pragma unroll
      for (int q = 0; q < 6; ++q) { const int gc = SCAN_GC(s0 + q); u[q] = *(const unsigned long long*)(ST + (((size_t)gc * 16 + h) * 2 + dir) * 8192 + e4 * 4); dec[q] = SDEC[(gc * 16 + h) * 2 + dir]; }
#pragma unroll
      for (int q = 0; q < 6; ++q) { const int gc = SCAN_GC(s0 + q);
        if (wr) *(unsigned long long*)(ST + (((size_t)gc * 16 + h) * 2 + dir) * 8192 + e4 * 4) = (unsigned long long)pk2(S0, S1) | ((unsigned long long)pk2(S2, S3) << 32);
        const unsigned lo = (unsigned)u[q], hi = (unsigned)(u[q] >> 32);
        S0 = dec[q] * S0 + __uint_as_float(lo << 16); S1 = dec[q] * S1 + __uint_as_float(lo & 0xffff0000u); S2 = dec[q] * S2 + __uint_as_float(hi << 16); S3 = dec[q] * S3 + __uint_as_float(hi & 0xffff0000u); }
    }
#undef SCAN_GC
  }
}
DEV bf16x8 scale_frag(bf16x8 f, float s) {
  bf16x8 o;
#pragma unroll
  for (int e = 0; e < 8; e += 2) { const unsigned w = pk2(bf2f((bf16_t)f[e]) * s, bf2f((bf16_t)f[e + 1]) * s); o[e] = (short)(w & 0xffff); o[e + 1] = (short)(w >> 16); }
  return o;
}
DEV void ssd_y_phase(const bf16_t* XC, const float* SDT, const float* SCS, const bf16_t* ST, const float* d_skip, bf16_t* Y0, float* SSQ, LAS unsigned char* lds, bool wr) {
  constexpr int XP = 272, BP = 136, SP = 72;
  LAS bf16_t* Xs = (LAS bf16_t*)lds; LAS bf16_t* Bs = (LAS bf16_t*)(lds + 128 * XP * 2);
  LAS float* tab = (LAS float*)(lds + 128 * XP * 2 + 128 * BP * 2);
  LAS float* ssq = tab + 4 * 4 * 128;
  LAS bf16_t* stg = (LAS bf16_t*)(ssq + 4 * 128);
  const int tid = threadIdx.x, lane = tid & 63, wid = tid >> 6, r = lane & 15, Qd = lane >> 4, hl = wid >> 1, ih = wid & 1;
  LAS bf16_t* mystg = stg + wid * 16 * SP;
  for (int task = virt_block(); task < NCH * 4; task += gridDim.x) {
    const int gc = task >> 2, g = (task >> 1) & 1, hh = task & 1; const size_t r0 = (size_t)gc * 128; const int h0 = g * 8 + hh * 4, h = h0 + hl;
    bf16x8 cstrip[4], cf[4][4];
#pragma unroll
    for (int ks = 0; ks < 4; ++ks) cstrip[ks] = *(const bf16x8*)(XC + (r0 + 16 * wid + r) * 1536 + 1280 + g * 128 + 32 * ks + 8 * Qd);
#pragma unroll
    for (int m = 0; m < 4; ++m)
#pragma unroll
      for (int ks = 0; ks < 4; ++ks) cf[m][ks] = *(const bf16x8*)(XC + (r0 + 64 * ih + 16 * m + r) * 1536 + 1280 + g * 128 + 32 * ks + 8 * Qd);
    __syncthreads();
#pragma unroll
    for (int i = 0; i < 8; ++i) { const int cid = tid + 512 * i, row = cid >> 5, ch = cid & 31; *(LAS v4u*)(Xs + row * XP + ch * 8) = *(const v4u*)(XC + (r0 + row) * 1536 + h0 * 64 + ch * 8); }
#pragma unroll
    for (int i = 0; i < 4; ++i) { const int cid = tid + 512 * i, row = cid >> 4, ch = cid & 15; *(LAS v4u*)(Bs + row * BP + ch * 8) = *(const v4u*)(XC + (r0 + row) * 1536 + 1024 + g * 128 + ch * 8); }
    { const int which = tid >> 7, t = tid & 127; const f32x4 v = *(const f32x4*)((which < 2 ? SCS : SDT) + (r0 + t) * 32 + (which & 1) * 16 + h0);
      tab[0 * 512 + which * 128 + t] = v.x; tab[1 * 512 + which * 128 + t] = v.y; tab[2 * 512 + which * 128 + t] = v.z; tab[3 * 512 + which * 128 + t] = v.w; }
    __syncthreads();
    {
      f32x4 cb[8];
#pragma unroll
      for (int t = 0; t < 8; ++t) { f32x4 c = {0.f, 0.f, 0.f, 0.f};
#pragma unroll
        for (int ks = 0; ks < 4; ++ks) { const bf16x8 bfr = *(const LAS bf16x8*)(Bs + (16 * t + r) * BP + 32 * ks + 8 * Qd); c = __builtin_amdgcn_mfma_f32_16x16x32_bf16(bfr, cstrip[ks], c, 0, 0, 0); }
        cb[t] = c; }
      __syncthreads();
#pragma unroll
      for (int t = 0; t < 8; ++t) *(LAS unsigned long long*)(Bs + (16 * wid + r) * BP + 16 * t + 4 * Qd) = (unsigned long long)pk2(cb[t][0], cb[t][1]) | ((unsigned long long)pk2(cb[t][2], cb[t][3]) << 32);
      __syncthreads();
    }
    const LAS float* csf = tab + hl * 512; const LAS float* csb = csf + 128; const LAS float* dtf = csf + 256; const LAS float* dtb = csf + 384;
    const float dsk = d_skip[h];
    f32x4 y[4][4];
#pragma unroll
    for (int m = 0; m < 4; ++m)
#pragma unroll
      for (int pt = 0; pt < 4; ++pt) y[m][pt] = (f32x4){0.f, 0.f, 0.f, 0.f};
    if (wr || !(PROBE_SKIP & 1))
#pragma unroll 1
    for (int dir = 0; dir < 2; ++dir) {
      const LAS float* csd = dir ? csb : csf; float sc[4];
#pragma unroll
      for (int m = 0; m < 4; ++m)
#pragma unroll
        for (int ks = 0; ks < 4; ++ks) asm volatile("" : "+v"(cf[m][ks]));
#pragma unroll
      for (int m = 0; m < 4; ++m) sc[m] = fexp(csd[64 * ih + 16 * m + r]);
      const bf16_t* Sp = ST + (((size_t)gc * 16 + h) * 2 + dir) * 8192 + lane * 8;
#pragma unroll
      for (int ks = 0; ks < 4; ++ks) {
        bf16x8 sf[4];
#pragma unroll
        for (int pt = 0; pt < 4; ++pt) sf[pt] = *(const bf16x8*)(Sp + (pt * 4 + ks) * 512);
#pragma unroll
        for (int m = 0; m < 4; ++m) { const bf16x8 a = scale_frag(cf[m][ks], sc[m]);
#pragma unroll
          for (int pt = 0; pt < 4; ++pt) y[m][pt] = __builtin_amdgcn_mfma_f32_16x16x32_bf16(a, sf[pt], y[m][pt], 0, 0, 0);
          __builtin_amdgcn_sched_barrier(0); }
      }
    }
#pragma unroll 1
    for (int m = 0; m < 4; ++m) {
      const int i0 = 64 * ih + 16 * m, i = i0 + r;
      const float cfi = csf[i], cbi = csb[i];
      v4u zpre[2];
#pragma unroll
      for (int q = 0; q < 2; ++q) { const int c = lane + 64 * q; zpre[q] = *(const v4u*)(Y0 + (r0 + i0 + (c >> 3)) * 2048 + h * 64 + (c & 7) * 8); }
      if (wr || !(PROBE_SKIP & 2))
#pragma unroll 1
      for (int k2 = 0; k2 < 4; ++k2) {
        const int j0 = 32 * k2 + 8 * Qd;
        const v4u cbv = *(const LAS v4u*)(Bs + i * BP + j0);
        const float cbe[8] = {__uint_as_float(cbv.x << 16), __uint_as_float(cbv.x & 0xffff0000u), __uint_as_float(cbv.y << 16), __uint_as_float(cbv.y & 0xffff0000u), __uint_as_float(cbv.z << 16), __uint_as_float(cbv.z & 0xffff0000u), __uint_as_float(cbv.w << 16), __uint_as_float(cbv.w & 0xffff0000u)};
        float pv[8];
        const bool dofwd = (32 * k2 <= i0 + 15), dobwd = (32 * k2 + 31 >= i0);
#pragma unroll
        for (int e = 0; e < 8; ++e) pv[e] = (j0 + e == i) ? dsk : 0.f;
        if (dofwd) { const f32x4 a0 = *(const LAS f32x4*)(csf + j0), a1 = *(const LAS f32x4*)(csf + j0 + 4), d0 = *(const LAS f32x4*)(dtf + j0), d1 = *(const LAS f32x4*)(dtf + j0 + 4);
          const float jc[8] = {a0.x, a0.y, a0.z, a0.w, a1.x, a1.y, a1.z, a1.w}; const float jd[8] = {d0.x, d0.y, d0.z, d0.w, d1.x, d1.y, d1.z, d1.w};
#pragma unroll
          for (int e = 0; e < 8; ++e) pv[e] += cbe[e] * fexp(j0 + e <= i ? cfi - jc[e] : -INFINITY) * jd[e]; }
        if (dobwd) { const f32x4 a0 = *(const LAS f32x4*)(csb + j0), a1 = *(const LAS f32x4*)(csb + j0 + 4), d0 = *(const LAS f32x4*)(dtb + j0), d1 = *(const LAS f32x4*)(dtb + j0 + 4);
          const float jc[8] = {a0.x, a0.y, a0.z, a0.w, a1.x, a1.y, a1.z, a1.w}; const float jd[8] = {d0.x, d0.y, d0.z, d0.w, d1.x, d1.y, d1.z, d1.w};
#pragma unroll
          for (int e = 0; e < 8; ++e) pv[e] += cbe[e] * fexp(j0 + e >= i ? cbi - jc[e] : -INFINITY) * jd[e]; }
        const unsigned w0 = pk2(pv[0], pv[1]), w1 = pk2(pv[2], pv[3]), w2 = pk2(pv[4], pv[5]), w3 = pk2(pv[6], pv[7]);
        const bf16x8 pa = (bf16x8){(short)(w0 & 0xffff), (short)(w0 >> 16), (short)(w1 & 0xffff), (short)(w1 >> 16), (short)(w2 & 0xffff), (short)(w2 >> 16), (short)(w3 & 0xffff), (short)(w3 >> 16)};
#pragma unroll
        for (int pt = 0; pt < 4; ++pt) {
          const s16x4 lo = tr_read(Xs + (32 * k2 + 8 * Qd + (r >> 2)) * XP + hl * 64 + 16 * pt + 4 * (r & 3));
          const s16x4 hi = tr_read(Xs + (32 * k2 + 8 * Qd + 4 + (r >> 2)) * XP + hl * 64 + 16 * pt + 4 * (r & 3));
          const bf16x8 xf = (bf16x8){lo[0], lo[1], lo[2], lo[3], hi[0], hi[1], hi[2], hi[3]};
          y[0][pt] = __builtin_amdgcn_mfma_f32_16x16x32_bf16(pa, xf, y[0][pt], 0, 0, 0);
        }
      }
      if (wr || !(PROBE_SKIP & 4)) {
#pragma unroll
      for (int pt = 0; pt < 4; ++pt)
#pragma unroll
        for (int jj = 0; jj < 4; ++jj) mystg[(4 * Qd + jj) * SP + 16 * pt + r] = f2bf(y[0][pt][jj]);
      LDS_WAIT(); asm volatile("" ::: "memory");
#pragma unroll
      for (int q = 0; q < 2; ++q) { const int c = lane + 64 * q, rowl = c >> 3, ch = c & 7; const int il = 64 * ih + 16 * m + rowl;
        const v4u yv = *(const LAS v4u*)(mystg + rowl * SP + ch * 8); bf16_t* zp = Y0 + (r0 + il) * 2048 + h * 64 + ch * 8; const v4u zv = zpre[q];
        const float v0 = __uint_as_float(yv.x << 16) * __uint_as_float(zv.x << 16), v1 = __uint_as_float(yv.x & 0xffff0000u) * __uint_as_float(zv.x & 0xffff0000u);
        const float v2 = __uint_as_float(yv.y << 16) * __uint_as_float(zv.y << 16), v3 = __uint_as_float(yv.y & 0xffff0000u) * __uint_as_float(zv.y & 0xffff0000u);
        const float v4 = __uint_as_float(yv.z << 16) * __uint_as_float(zv.z << 16), v5 = __uint_as_float(yv.z & 0xffff0000u) * __uint_as_float(zv.z & 0xffff0000u);
        const float v6 = __uint_as_float(yv.w << 16) * __uint_as_float(zv.w << 16), v7 = __uint_as_float(yv.w & 0xffff0000u) * __uint_as_float(zv.w & 0xffff0000u);
        float ss = (v0 * v0 + v1 * v1) + (v2 * v2 + v3 * v3) + (v4 * v4 + v5 * v5) + (v6 * v6 + v7 * v7);
        ss += __shfl_xor(ss, 1); ss += __shfl_xor(ss, 2); ss += __shfl_xor(ss, 4);
        v4u ov; ov.x = pk2(v0, v1); ov.y = pk2(v2, v3); ov.z = pk2(v4, v5); ov.w = pk2(v6, v7);
        if (wr) *(v4u*)zp = ov;
        if (ch == 0) ssq[hl * 128 + il] = ss; }
      LDS_WAIT(); asm volatile("" ::: "memory");
      }
#pragma unroll
      for (int pt = 0; pt < 4; ++pt) { y[0][pt] = y[1][pt]; y[1][pt] = y[2][pt]; y[2][pt] = y[3][pt]; }
    }
    __syncthreads();
    if (tid < 128) SSQ[((r0 + tid) * 2 + g) * 2 + hh] = (ssq[tid] + ssq[128 + tid]) + (ssq[256 + tid] + ssq[384 + tid]);
  }
}

typedef _Float16 h16_t;
typedef _Float16 h16x8 __attribute__((ext_vector_type(8)));
DEV const h16_t* gcs_row(const h16_t* wsb, const h16_t* outb, size_t row) {
  return row < 9472 ? (const h16_t*)((const char*)wsb + 237 * MiB + 512 * 1024) + row * 1024 : (row < 13824 ? (const h16_t*)((const char*)outb + 55 * MiB + 512 * 1024) + (row - 9472) * 1024 : (const h16_t*)((const char*)wsb + 2 * MiB) + (row - 13824) * 1024); }
DEV h16_t* gcs_row_w(h16_t* wsb, h16_t* outb, size_t row) { return (h16_t*)gcs_row(wsb, outb, row); }
DEV float logsig_fast(float x) { return fminf(x, 0.f) - 0.6931471805599453f * __builtin_amdgcn_logf(1.f + __builtin_amdgcn_exp2f(-1.4426950408889634f * fabsf(x))); }
DEV void gla_cs_phase(const float* DTLR, const float* gw, const float* gb, h16_t* GCSL, h16_t* GCSC, float* GDEC, LAS unsigned char* lds, unsigned* queue) {
  const int lane = threadIdx.x & 63, wave = threadIdx.x >> 6;
  LAS float* lrs = (LAS float*)(lds + wave * 8192);
  LAS h16_t* tile = (LAS h16_t*)(lds + 65536 + wave * 1024);
  for (;;) {
    unsigned wt_ = 0u; if (lane == 0) wt_ = __hip_atomic_fetch_add(queue, 1u, __ATOMIC_RELAXED, __HIP_MEMORY_SCOPE_AGENT);
    wt_ = (unsigned)__builtin_amdgcn_readfirstlane((int)wt_); if (wt_ >= (unsigned)(NCH * 2 * 8)) break;
    const int wt = (int)wt_;
    const int gc = wt >> 4, dir = (wt >> 3) & 1, k = (wt & 7) * 64 + lane;
#pragma unroll
    for (int q = 0; q < 8; ++q) { const int c = lane + 64 * q, row = c >> 2, part = c & 3;
      *(LAS f32x4*)(lrs + row * 16 + part * 4) = *(const f32x4*)(DTLR + ((size_t)gc * 128 + row) * 64 + 32 + dir * 16 + part * 4); }
    float wv[16];
#pragma unroll
    for (int q = 0; q < 16; ++q) wv[q] = gw[(dir * 16 + q) * 512 + k];
    const float bias = gb[dir * 512 + k];
    LDS_WAIT(); asm volatile("" ::: "memory");
    float run = 0.f;
#pragma unroll 1
    for (int s0 = 0; s0 < 128; s0 += 8) {
      float lg[8];
#pragma unroll
      for (int u = 0; u < 8; ++u) { const int s = s0 + u, t = dir ? 127 - s : s; const LAS float* lr = lrs + t * 16;
        const f32x4 l0 = *(const LAS f32x4*)lr, l1 = *(const LAS f32x4*)(lr + 4), l2 = *(const LAS f32x4*)(lr + 8), l3 = *(const LAS f32x4*)(lr + 12);
        const float x = bias + l0.x * wv[0] + l0.y * wv[1] + l0.z * wv[2] + l0.w * wv[3] + l1.x * wv[4] + l1.y * wv[5] + l1.z * wv[6] + l1.w * wv[7]
                        + l2.x * wv[8] + l2.y * wv[9] + l2.z * wv[10] + l2.w * wv[11] + l3.x * wv[12] + l3.y * wv[13] + l3.z * wv[14] + l3.w * wv[15];
        lg[u] = logsig_fast(x) * (1.f / 16.f); }
#pragma unroll
      for (int u = 0; u < 8; ++u) { run += lg[u]; tile[u * 64 + lane] = (h16_t)run; }
      LDS_WAIT(); asm volatile("" ::: "memory");
      { const int u = lane >> 3, ch = lane & 7, s = s0 + u, t = dir ? 127 - s : s;
        *(v4u*)(gcs_row_w(GCSL, GCSC, (size_t)gc * 128 + t) + dir * 512 + (k - lane) + ch * 8) = *(const LAS v4u*)(tile + u * 64 + ch * 8); }
      LDS_WAIT(); asm volatile("" ::: "memory");
    }
    GDEC[((gc * 4 + (k >> 7)) * 2 + dir) * 128 + (k & 127)] = fexp(run);
    LDS_WAIT(); asm volatile("" ::: "memory");
  }
}
DEV void gla_u_phase(const bf16_t* K0, const bf16_t* V0, const h16_t* GCSL, const h16_t* GCSC, bf16_t* ST, LAS unsigned char* lds) {
  constexpr int VP = 272, KP = 144;
  LAS bf16_t* Vs = (LAS bf16_t*)lds; LAS bf16_t* Kd = (LAS bf16_t*)(lds + 128 * VP * 2);
  const int tid = threadIdx.x, lane = tid & 63, wid = tid >> 6, r = lane & 15, Qd = lane >> 4;
  for (int task = virt_block(); task < NCH * 4; task += gridDim.x) {
    const int gc = task >> 2, h = task & 3; const size_t r0 = (size_t)gc * 128;
    __syncthreads();
#pragma unroll
    for (int i = 0; i < 8; ++i) { const int cid = tid + 512 * i, row = cid >> 5, ch = cid & 31; *(LAS v4u*)(Vs + row * VP + ch * 8) = *(const v4u*)(V0 + (r0 + row) * 1024 + h * 256 + ch * 8); }
#pragma unroll
    for (int i = 0; i < 4; ++i) { const int cid = tid + 512 * i, t = cid >> 4, ch = cid & 15;
      const v4u kv = *(const v4u*)(K0 + (r0 + t) * 512 + h * 128 + ch * 8);
      const float kf[8] = {__uint_as_float(kv.x << 16), __uint_as_float(kv.x & 0xffff0000u), __uint_as_float(kv.y << 16), __uint_as_float(kv.y & 0xffff0000u), __uint_as_float(kv.z << 16), __uint_as_float(kv.z & 0xffff0000u), __uint_as_float(kv.w << 16), __uint_as_float(kv.w & 0xffff0000u)};
#pragma unroll
      for (int dir = 0; dir < 2; ++dir) {
        const h16x8 ce = *(const h16x8*)(gcs_row(GCSL, GCSC, r0 + (dir ? 0 : 127)) + dir * 512 + h * 128 + ch * 8), ct = *(const h16x8*)(gcs_row(GCSL, GCSC, r0 + t) + dir * 512 + h * 128 + ch * 8);
        v4u o; o.x = pk2(kf[0] * fexp((float)ce[0] - (float)ct[0]), kf[1] * fexp((float)ce[1] - (float)ct[1])); o.y = pk2(kf[2] * fexp((float)ce[2] - (float)ct[2]), kf[3] * fexp((float)ce[3] - (float)ct[3]));
        o.z = pk2(kf[4] * fexp((float)ce[4] - (float)ct[4]), kf[5] * fexp((float)ce[5] - (float)ct[5])); o.w = pk2(kf[6] * fexp((float)ce[6] - (float)ct[6]), kf[7] * fexp((float)ce[7] - (float)ct[7]));
        *(LAS v4u*)(Kd + dir * 128 * KP + t * KP + ch * 8) = o; } }
    __syncthreads();
#pragma unroll 1
    for (int dir = 0; dir < 2; ++dir) {
      const LAS bf16_t* Kb = Kd + dir * 128 * KP;
      f32x4 acc[8][2];
#pragma unroll
      for (int dt = 0; dt < 8; ++dt) { acc[dt][0] = (f32x4){0.f, 0.f, 0.f, 0.f}; acc[dt][1] = (f32x4){0.f, 0.f, 0.f, 0.f}; }
#pragma unroll 1
      for (int k = 0; k < 4; ++k) {
        bf16x8 vf[2];
#pragma unroll
        for (int et = 0; et < 2; ++et) {
          const s16x4 lo = tr_read(Vs + (32 * k + 4 * Qd + (r >> 2)) * VP + 32 * wid + 16 * et + 4 * (r & 3));
          const s16x4 hi = tr_read(Vs + (32 * k + 16 + 4 * Qd + (r >> 2)) * VP + 32 * wid + 16 * et + 4 * (r & 3));
          vf[et] = (bf16x8){lo[0], lo[1], lo[2], lo[3], hi[0], hi[1], hi[2], hi[3]}; }
#pragma unroll
        for (int dt = 0; dt < 8; ++dt) {
          const s16x4 lo = tr_read(Kb + (32 * k + 4 * Qd + (r >> 2)) * KP + 16 * dt + 4 * (r & 3));
          const s16x4 hi = tr_read(Kb + (32 * k + 16 + 4 * Qd + (r >> 2)) * KP + 16 * dt + 4 * (r & 3));
          const bf16x8 kfr = (bf16x8){lo[0], lo[1], lo[2], lo[3], hi[0], hi[1], hi[2], hi[3]};
          acc[dt][0] = __builtin_amdgcn_mfma_f32_16x16x32_bf16(kfr, vf[0], acc[dt][0], 0, 0, 0);
          acc[dt][1] = __builtin_amdgcn_mfma_f32_16x16x32_bf16(kfr, vf[1], acc[dt][1], 0, 0, 0); }
      }
      bf16_t* Sp = ST + (((size_t)gc * 4 + h) * 2 + dir) * 32768;
#pragma unroll
      for (int dt = 0; dt < 8; ++dt)
#pragma unroll
        for (int et = 0; et < 2; ++et) { const f32x4 v = acc[dt][et];
          *(unsigned long long*)(Sp + ((((2 * wid + et) * 4 + (dt >> 1)) * 64 + ((dt & 1) * 2 + (Qd >> 1)) * 16 + r) * 8 + 4 * (Qd & 1))) = (unsigned long long)pk2(v[0], v[1]) | ((unsigned long long)pk2(v[2], v[3]) << 32); }
    }
  }
}
DEV void gla_scan_phase(bf16_t* ST, const float* GDEC, bool wr) {
  for (int item = blockIdx.x * 512 + threadIdx.x; item < 2 * 4 * 2 * 8192; item += gridDim.x * 512) {
    const int e4 = item & 8191, dir = (item >> 13) & 1, h = (item >> 14) & 3, b = item >> 16; const int d0 = 32 * ((e4 >> 7) & 3) + 8 * ((e4 >> 5) & 3) + 4 * (e4 & 1);
    float S0 = 0.f, S1 = 0.f, S2 = 0.f, S3 = 0.f;
#define SCAN_GC(s) (!dir ? ((s) < 2 ? 128 + 2 * b + (s) : b * 64 + ((s) - 2)) : ((s) < 2 ? 128 + 2 * b + (1 - (s)) : b * 64 + (65 - (s))))
    for (int s0 = 0; s0 < 66; s0 += 6) {
      unsigned long long u[6]; f32x4 dec[6];
#pragma unroll
      for (int q = 0; q < 6; ++q) { const int gc = SCAN_GC(s0 + q); u[q] = *(const unsigned long long*)(ST + (((size_t)gc * 4 + h) * 2 + dir) * 32768 + e4 * 4); dec[q] = *(const f32x4*)(GDEC + ((gc * 4 + h) * 2 + dir) * 128 + d0); }
#pragma unroll
      for (int q = 0; q < 6; ++q) { const int gc = SCAN_GC(s0 + q);
        if (wr) *(unsigned long long*)(ST + (((size_t)gc * 4 + h) * 2 + dir) * 32768 + e4 * 4) = (unsigned long long)pk2(S0, S1) | ((unsigned long long)pk2(S2, S3) << 32);
        const unsigned lo = (unsigned)u[q], hi = (unsigned)(u[q] >> 32);
        S0 = dec[q].x * S0 + __uint_as_float(lo << 16); S1 = dec[q].y * S1 + __uint_as_float(lo & 0xffff0000u); S2 = dec[q].z * S2 + __uint_as_float(hi << 16); S3 = dec[q].w * S3 + __uint_as_float(hi & 0xffff0000u); }
    }
#undef SCAN_GC
  }
}
DEV void gla_o_phase(const bf16_t* Q0, const bf16_t* K0, const bf16_t* V0, const h16_t* GCSL, const h16_t* GCSC, const bf16_t* ST, const float* gla_norm, const float* SSQ, const float* ssd_norm, bf16_t* Y0, LAS unsigned char* lds, bool wr) {
  constexpr int VP = 272, KP = 136;
  LAS bf16_t* Vs = (LAS bf16_t*)lds; LAS bf16_t* Kd = (LAS bf16_t*)(lds + 128 * VP * 2);
  const int tid = threadIdx.x, lane = tid & 63, wid = tid >> 6, r = lane & 15, Qd = lane >> 4;
  const float scale = 0.08838834764831845f;
  for (int task = virt_block(); task < NCH * 4; task += gridDim.x) {
    const int gc = task >> 2, h = task & 3; const size_t r0 = (size_t)gc * 128;
    __syncthreads();
#pragma unroll
    for (int i = 0; i < 8; ++i) { const int cid = tid + 512 * i, row = cid >> 5, ch = cid & 31; *(LAS v4u*)(Vs + row * VP + ch * 8) = *(const v4u*)(V0 + (r0 + row) * 1024 + h * 256 + ch * 8); }
#pragma unroll
    for (int i = 0; i < 4; ++i) { const int cid = tid + 512 * i, t = cid >> 4, ch = cid & 15;
      const v4u kv = *(const v4u*)(K0 + (r0 + t) * 512 + h * 128 + ch * 8);
      const float kf[8] = {__uint_as_float(kv.x << 16), __uint_as_float(kv.x & 0xffff0000u), __uint_as_float(kv.y << 16), __uint_as_float(kv.y & 0xffff0000u), __uint_as_float(kv.z << 16), __uint_as_float(kv.z & 0xffff0000u), __uint_as_float(kv.w << 16), __uint_as_float(kv.w & 0xffff0000u)};
#pragma unroll
      for (int dir = 0; dir < 2; ++dir) {
        const h16x8 ct = *(const h16x8*)(gcs_row(GCSL, GCSC, r0 + t) + dir * 512 + h * 128 + ch * 8);
        v4u o; o.x = pk2(kf[0] * fexp(-(float)ct[0]), kf[1] * fexp(-(float)ct[1])); o.y = pk2(kf[2] * fexp(-(float)ct[2]), kf[3] * fexp(-(float)ct[3]));
        o.z = pk2(kf[4] * fexp(-(float)ct[4]), kf[5] * fexp(-(float)ct[5])); o.w = pk2(kf[6] * fexp(-(float)ct[6]), kf[7] * fexp(-(float)ct[7]));
        *(LAS v4u*)(Kd + dir * 128 * KP + t * KP + ch * 8) = o; } }
    __syncthreads();
    const int i = 16 * wid + r;
    f32x4 o[16];
#pragma unroll
    for (int et = 0; et < 16; ++et) o[et] = (f32x4){0.f, 0.f, 0.f, 0.f};
#pragma unroll 1
    for (int dir = 0; dir < 2; ++dir) {
      bf16x8 qd[4];
      { const h16_t* ci = gcs_row(GCSL, GCSC, r0 + i) + dir * 512 + h * 128; const bf16_t* qp = Q0 + (r0 + i) * 512 + h * 128;
#pragma unroll
        for (int ks = 0; ks < 4; ++ks) { const v4u qv = *(const v4u*)(qp + 32 * ks + 8 * Qd); const h16x8 cc = *(const h16x8*)(ci + 32 * ks + 8 * Qd);
          const f32x4 c0 = {(float)cc[0], (float)cc[1], (float)cc[2], (float)cc[3]}, c1 = {(float)cc[4], (float)cc[5], (float)cc[6], (float)cc[7]};
          const unsigned w0 = pk2(__uint_as_float(qv.x << 16) * scale * fexp(c0.x), __uint_as_float(qv.x & 0xffff0000u) * scale * fexp(c0.y));
          const unsigned w1 = pk2(__uint_as_float(qv.y << 16) * scale * fexp(c0.z), __uint_as_float(qv.y & 0xffff0000u) * scale * fexp(c0.w));
          const unsigned w2 = pk2(__uint_as_float(qv.z << 16) * scale * fexp(c1.x), __uint_as_float(qv.z & 0xffff0000u) * scale * fexp(c1.y));
          const unsigned w3 = pk2(__uint_as_float(qv.w << 16) * scale * fexp(c1.z), __uint_as_float(qv.w & 0xffff0000u) * scale * fexp(c1.w));
          qd[ks] = (bf16x8){(short)(w0 & 0xffff), (short)(w0 >> 16), (short)(w1 & 0xffff), (short)(w1 >> 16), (short)(w2 & 0xffff), (short)(w2 >> 16), (short)(w3 & 0xffff), (short)(w3 >> 16)}; } }
      const bf16_t* Sp = ST + (((size_t)gc * 4 + h) * 2 + dir) * 32768 + lane * 8;
      {
        bf16x8 sA[4], sB[4];
#pragma unroll
        for (int q = 0; q < 4; ++q) sA[q] = *(const bf16x8*)(Sp + (q * 4 + 0) * 512);
#pragma unroll
        for (int bi = 0; bi < 16; ++bi) {
          const int ks = bi >> 2, e0 = 4 * (bi & 3);
          if (bi + 1 < 16) { const int ks2 = (bi + 1) >> 2, e2 = 4 * ((bi + 1) & 3);
#pragma unroll
            for (int q = 0; q < 4; ++q) { if (bi & 1) sA[q] = *(const bf16x8*)(Sp + ((e2 + q) * 4 + ks2) * 512); else sB[q] = *(const bf16x8*)(Sp + ((e2 + q) * 4 + ks2) * 512); } }
#pragma unroll
          for (int q = 0; q < 4; ++q) o[e0 + q] = __builtin_amdgcn_mfma_f32_16x16x32_bf16(qd[ks], (bi & 1) ? sB[q] : sA[q], o[e0 + q], 0, 0, 0);
          __builtin_amdgcn_sched_barrier(0);
        }
      }
      const LAS bf16_t* Kb = Kd + dir * 128 * KP;
#pragma unroll 1
      for (int k2 = 0; k2 < 4; ++k2) {
        const bool need = dir ? (2 * k2 + 1 >= wid) : (2 * k2 <= wid);
        if (!need) continue;
        bf16x8 pa;
#pragma unroll
        for (int tt = 0; tt < 2; ++tt) { const int t = 2 * k2 + tt;
          f32x4 c = {0.f, 0.f, 0.f, 0.f};
#pragma unroll
          for (int ks = 0; ks < 4; ++ks) { const bf16x8 kfr = *(const LAS bf16x8*)(Kb + (16 * t + r) * KP + 32 * ks + 8 * Qd); c = __builtin_amdgcn_mfma_f32_16x16x32_bf16(kfr, qd[ks], c, 0, 0, 0); }
          float pv[4];
#pragma unroll
          for (int jj = 0; jj < 4; ++jj) { const int j = 16 * t + 4 * Qd + jj; const bool ok = dir ? (j >= i) : (j <= i); pv[jj] = ok ? c[jj] : 0.f; }
          const unsigned w0 = pk2(pv[0], pv[1]), w1 = pk2(pv[2], pv[3]);
          pa[tt * 4 + 0] = (short)(w0 & 0xffff); pa[tt * 4 + 1] = (short)(w0 >> 16); pa[tt * 4 + 2] = (short)(w1 & 0xffff); pa[tt * 4 + 3] = (short)(w1 >> 16); }
#pragma unroll
        for (int et = 0; et < 16; ++et) {
          const s16x4 lo = tr_read(Vs + (32 * k2 + 4 * Qd + (r >> 2)) * VP + 16 * et + 4 * (r & 3));
          const s16x4 hi = tr_read(Vs + (32 * k2 + 16 + 4 * Qd + (r >> 2)) * VP + 16 * et + 4 * (r & 3));
          const bf16x8 vf = (bf16x8){lo[0], lo[1], lo[2], lo[3], hi[0], hi[1], hi[2], hi[3]};
          o[et] = __builtin_amdgcn_mfma_f32_16x16x32_bf16(pa, vf, o[et], 0, 0, 0); }
      }
    }
#pragma unroll
    for (int jj = 0; jj < 4; ++jj) { float ss = 0.f;
#pragma unroll
      for (int et = 0; et < 16; ++et) ss += o[et][jj] * o[et][jj];
      ss += __shfl_xor(ss, 1); ss += __shfl_xor(ss, 2); ss += __shfl_xor(ss, 4); ss += __shfl_xor(ss, 8);
      const float rstd = rsqrtf(ss * (1.f / 256.f) + EPS);
      const size_t yo = (r0 + 16 * wid + 4 * Qd + jj) * 2048 + 1024 + h * 256 + r;
#pragma unroll
      for (int et = 0; et < 16; ++et) { const bf16_t ov_ = f2bf(o[et][jj] * rstd * gla_norm[h * 256 + 16 * et + r] * bf2f(Y0[yo + 16 * et])); if (wr) Y0[yo + 16 * et] = ov_; } }
    { const int g = h >> 1, c0 = g * 512 + (h & 1) * 256;
#pragma unroll
      for (int q = 0; q < 8; ++q) { const int cid = tid + 512 * q, row = cid >> 5, ch = cid & 31; const size_t rr = r0 + row;
        const float rstd = rsqrtf((SSQ[(rr * 2 + g) * 2] + SSQ[(rr * 2 + g) * 2 + 1]) * (1.f / 512.f) + EPS);
        bf16_t* yp = Y0 + rr * 2048 + c0 + ch * 8; const v4u yv = *(const v4u*)yp; const f32x4 g0 = *(const f32x4*)(ssd_norm + c0 + ch * 8), g1 = *(const f32x4*)(ssd_norm + c0 + ch * 8 + 4);
        v4u ov; ov.x = pk2(__uint_as_float(yv.x << 16) * rstd * g0.x, __uint_as_float(yv.x & 0xffff0000u) * rstd * g0.y); ov.y = pk2(__uint_as_float(yv.y << 16) * rstd * g0.z, __uint_as_float(yv.y & 0xffff0000u) * rstd * g0.w);
        ov.z = pk2(__uint_as_float(yv.z << 16) * rstd * g1.x, __uint_as_float(yv.z & 0xffff0000u) * rstd * g1.y); ov.w = pk2(__uint_as_float(yv.w << 16) * rstd * g1.z, __uint_as_float(yv.w & 0xffff0000u) * rstd * g1.w);
        if (wr) *(v4u*)yp = ov; } }
  }
}

typedef __attribute__((address_space(1))) unsigned gu32;
#define RLX_AGENT __ATOMIC_RELAXED, __HIP_MEMORY_SCOPE_AGENT
#define XB_TMO      128
#define XB_XCNT(j)  (256  + 64 * (j))
#define XB_XSUB(j)  (1280 + 64 * (j))
#define XB_XGEN(j)  (2304 + 64 * (j))
#define XB_TOP      3328
#define XB_TOPGEN   3392
#define XCD_BAR_WORDS 3456
#define XB_SPIN_CAP (1u << 18)

__device__ __forceinline__ unsigned xb_ld(unsigned* p)              { return __hip_atomic_load(p, __ATOMIC_RELAXED, __HIP_MEMORY_SCOPE_AGENT); }
__device__ __forceinline__ unsigned xb_add(unsigned* p, unsigned v) { return __hip_atomic_fetch_add(p, v, __ATOMIC_RELAXED, __HIP_MEMORY_SCOPE_AGENT); }
__device__ __forceinline__ unsigned xb_xcc_id() { return (unsigned)__builtin_amdgcn_s_getreg((3 << 11) | 20) & 0xFu; }
#define XB_SPIN(cond, bar) do { unsigned _sp = 0; while (cond) { __builtin_amdgcn_s_sleep(1); \
    if ((++_sp & 255u) == 0u) { if (xb_ld(&(bar)[XB_TMO])) break; if (_sp > XB_SPIN_CAP) { atomicAdd(&(bar)[XB_TMO], 1u); break; } } } } while (0)

struct XcdBarrier {
    unsigned* bar; unsigned x;
    volatile LAS unsigned* st;
};

__device__ __forceinline__ XcdBarrier xcd_barrier_post(unsigned* bar, volatile LAS unsigned* st) {
    XcdBarrier b; b.bar = bar; b.x = xb_xcc_id(); b.st = st;
    if (threadIdx.x == 0) (void)xb_add(&bar[XB_XCNT(b.x)], 1u);
    return b;
}
__device__ __forceinline__ void xcd_barrier_complete(unsigned* bar, unsigned x, unsigned& nloc, unsigned& nx) {
    const unsigned G = gridDim.x * gridDim.y * gridDim.z;
    unsigned sum, cnt, mine, sp = 0u;
    for (;;) {
        sum = 0u; cnt = 0u; mine = 0u;
#pragma unroll
        for (unsigned j = 0; j < 16; ++j) { const unsigned c = xb_ld(&bar[XB_XCNT(j)]); sum += c; cnt += (c > 0u) ? 1u : 0u; mine = (j == x) ? c : mine; }
        if (sum == G) break;
        __builtin_amdgcn_s_sleep(1);
        if ((++sp & 255u) == 0u) { if (xb_ld(&bar[XB_TMO])) break; if (sp > XB_SPIN_CAP) { atomicAdd(&bar[XB_TMO], 1u); break; } }
    }
    nloc = mine > 0u ? mine : 1u; nx = cnt > 0u ? cnt : 1u;
}

__device__ __forceinline__ void xcd_barrier(const XcdBarrier& b) {
    asm volatile("s_waitcnt vmcnt(0)" ::: "memory");
    __syncthreads();
    if (threadIdx.x == 0) {
        unsigned* bar = b.bar;
        __builtin_amdgcn_s_waitcnt(0);
        unsigned nloc = b.st[0], nx = b.st[1];
        if (nloc == 0u) { xcd_barrier_complete(bar, b.x, nloc, nx); b.st[0] = nloc; b.st[1] = nx; }
        const unsigned old = xb_add(&bar[XB_XSUB(b.x)], 1u);
        const unsigned gen = old / nloc;
        if (old + 1u == (gen + 1u) * nloc) {
            __builtin_amdgcn_fence(__ATOMIC_RELEASE, "agent");
            asm volatile("s_waitcnt vmcnt(0)" ::: "memory");
            const unsigned og = xb_add(&bar[XB_TOP], 1u);
            const unsigned tg = og / nx;
            if (og + 1u == (tg + 1u) * nx) xb_add(&bar[XB_TOPGEN], 1u);
            else XB_SPIN(xb_ld(&bar[XB_TOPGEN]) == tg, bar);
            __builtin_amdgcn_fence(__ATOMIC_ACQUIRE, "agent");
            xb_add(&bar[XB_XGEN(b.x)], 1u);
            asm volatile("s_waitcnt vmcnt(0)" ::: "memory");
        } else {
            XB_SPIN(xb_ld(&bar[XB_XGEN(b.x)]) == gen, bar);
            __builtin_amdgcn_fence(__ATOMIC_ACQUIRE, "agent");
            asm volatile("s_waitcnt vmcnt(0)" ::: "memory");
        }
    }
    __syncthreads();
}

__global__ void __launch_bounds__(NWAVES * 64, 2) __attribute__((amdgpu_num_sgpr(92))) mega(Params p) {
  extern __shared__ __attribute__((aligned(16))) unsigned char lds_raw[];
  LAS unsigned char* lds = (LAS unsigned char*)lds_raw;
  volatile LAS unsigned* MISC = (volatile LAS unsigned*)(lds + MISC_OFF);
  if (threadIdx.x < 16) MISC[threadIdx.x] = 0u;
  __syncthreads();
  XcdBarrier bar = xcd_barrier_post((unsigned*)(p.ws + WS_CTL), MISC + 8);
  unsigned char* ws = p.ws;
  float* MOD = (float*)(ws + WS_MOD);
  bf16_t* H0 = (bf16_t*)p.out; float* X1 = p.out;
  const int lo = p.ph_lo, hi = p.ph_hi;
#define IN(k) (lo <= (k) && (k) < hi)
#define SEAM(k) do { if ((k) + 1 < hi) xcd_barrier(bar); } while (0)
#define PH(k, ...) if (IN(k)) { if ((PROBE_MASK >> (k)) & 1u) { const bool wr = (p.rep < 0); (void)wr; __VA_ARGS__; xcd_barrier(bar); } { const bool wr = true; (void)wr; __VA_ARGS__; } SEAM(k); }
  PH(0, prologue_phase(p, lds))
  PH(1, prep_phase(p.in[0], p.in[2], p.in[4], MOD, H0))
  PH(2, {
    pg8::Gemm g{H0, (const bf16_t*)(ws + WS_W1T), MA, E_INP, D}; pg8::StaticOrder S; S.init(MA, E_INP, gridDim.x, (int)blockIdx.x);
    pg8::EpiProj0 E{(bf16_t*)(ws + WS_Y0), (bf16_t*)(ws + WS_XBC), (bf16_t*)(ws + WS_Q0), (bf16_t*)(ws + WS_K0), (bf16_t*)(ws + WS_V0), (float*)(ws + WS_DTLR)};
    pg8::gemm_phase<pg8::EpiProj0, pg8::StaticOrder, true, true>(lds, g, S, E); })
  PH(3, ssd_prep_phase((const bf16_t*)(ws + WS_XBC), p.in[8], p.in[9], (bf16_t*)p.out, (const float*)(ws + WS_DTLR), p.in[10], p.in[11], (float*)((char*)p.out + DO_SDT), (float*)((char*)p.out + DO_SCS), (float*)(ws + WS_SDEC)))
  PH(4, { ssd_u_phase((const bf16_t*)p.out, (const float*)((char*)p.out + DO_SDT), (const float*)((char*)p.out + DO_SCS), (bf16_t*)(ws + WS_STATE), lds);
    { const int nbusy = (NCH * 4) % (int)gridDim.x, nfree = (int)gridDim.x - nbusy;
      const int vb_ = virt_block(); if (vb_ >= nbusy || nfree <= 0) { __syncthreads(); late_weights(p, lds, nfree > 0 ? vb_ - nbusy : vb_, nfree > 0 ? nfree : (int)gridDim.x); } } })
  PH(5, ssd_scan_phase((bf16_t*)(ws + WS_STATE), (const float*)(ws + WS_SDEC), wr))
  PH(6, { ssd_y_phase((const bf16_t*)p.out, (const float*)((char*)p.out + DO_SDT), (const float*)((char*)p.out + DO_SCS), (const bf16_t*)(ws + WS_STATE), p.in[12], (bf16_t*)(ws + WS_Y0), (float*)(ws + WS_SSQ), lds, wr);
    if (wr) gla_cs_phase((const float*)(ws + WS_DTLR), p.in[14], p.in[15], (h16_t*)ws, (h16_t*)p.out, (float*)(ws + WS_GDEC), lds, (unsigned*)(ws + WS_CTL) + CW_CSQ); })
  PH(8, gla_u_phase((const bf16_t*)(ws + WS_K0), (const bf16_t*)(ws + WS_V0), (const h16_t*)ws, (const h16_t*)p.out, (bf16_t*)(ws + WS_STATE), lds))
  PH(9, gla_scan_phase((bf16_t*)(ws + WS_STATE), (const float*)(ws + WS_GDEC), wr))
  PH(10, gla_o_phase((const bf16_t*)(ws + WS_Q0), (const bf16_t*)(ws + WS_K0), (const bf16_t*)(ws + WS_V0), (const h16_t*)ws, (const h16_t*)p.out, (const bf16_t*)(ws + WS_STATE), p.in[16], (const float*)(ws + WS_SSQ), p.in[13], (bf16_t*)(ws + WS_Y0), lds, wr))
  PH(11, {
    pg8::Gemm g{(const bf16_t*)(ws + WS_Y0), (const bf16_t*)(ws + WS_W2T), ML, D, 2048}; pg8::StaticOrder S; S.init(ML, D, gridDim.x, (int)blockIdx.x);
    pg8::EpiResid E{p.in[0], X1, MOD, true};
    pg8::gemm_phase<pg8::EpiResid, pg8::StaticOrder, true, true>(lds, g, S, E);
    const float* ctx = p.in[2]; float* XC1 = (float*)(ws + WS_XC1); const float* gate = MOD + 2 * 3072 + 2048;
    small_gemm_splitk((const bf16_t*)(ws + WS_Y0) + (size_t)ML * 2048, 2048, (const bf16_t*)(ws + WS_W2T), 2048, 2048, MC, D, lds,
               [=](int m, int n, float v) { XC1[(size_t)m * D + n] = ctx[(size_t)m * D + n] + gate[n] * v; }); })
  PH(12, prep_phase(X1, (const float*)(ws + WS_XC1), p.in[18], MOD + 3 * 3072, (bf16_t*)(ws + WS_H1)))
  PH(13, {
    pg8::Gemm g{(const bf16_t*)(ws + WS_H1), (const bf16_t*)(ws + WS_W3T), ML, O_IN, D}; pg8::StaticOrder S; S.init(ML, O_IN, gridDim.x, (int)blockIdx.x);
    pg8::EpiProj1 E{(bf16_t*)(ws + WS_K1), (bf16_t*)(ws + WS_V1), (bf16_t*)(ws + WS_Q1), (bf16_t*)(ws + WS_G1), p.in[22], p.in[23], (const float*)(ws + WS_ROPE), (LAS float*)(lds + 131072)};
    pg8::gemm_phase<pg8::EpiProj1, pg8::StaticOrder, true, true>(lds, g, S, E);
    bf16_t* K1 = (bf16_t*)(ws + WS_K1); bf16_t* V1 = (bf16_t*)(ws + WS_V1);
    small_gemm_splitk((const bf16_t*)(ws + WS_H1) + (size_t)ML * D, D, (const bf16_t*)(ws + WS_W3T), D, D, MC, 1024, lds,
               [=](int m, int n, float v) { if (n < 512) K1[(size_t)(ML + m) * 512 + n] = f2bf(v); else V1[(size_t)(ML + m) * 512 + (n - 512)] = f2bf(v); }); })
  PH(15, attn_phase((bf16_t*)(ws + WS_Q1), (const bf16_t*)(ws + WS_K1), (const bf16_t*)(ws + WS_V1), (const bf16_t*)(ws + WS_G1), p.in[24], p.in[22], p.in[23], lds, wr))
  PH(16, {
    pg8::Gemm g{(const bf16_t*)(ws + WS_Q1), (const bf16_t*)(ws + WS_W4T), ML, D, 2048}; pg8::StaticOrder S; S.init(ML, D, gridDim.x, (int)blockIdx.x);
    pg8::EpiResid E{X1, p.out, MOD + 3 * 3072, wr};
    pg8::gemm_phase<pg8::EpiResid, pg8::StaticOrder, true, true>(lds, g, S, E); })
#undef PH
#undef IN
#undef SEAM
}
extern "C" void kernel_launch(void* const* d_in, const int* in_sizes, int n_in, void* d_out, int out_size, void* d_ws, size_t ws_size, hipStream_t stream) {
  static int grid_blocks = 0;
  if (!grid_blocks) {
    int dev = 0, cus = 0, per_cu = 0;
    hipGetDevice(&dev);
    hipDeviceGetAttribute(&cus, hipDeviceAttributeMultiprocessorCount, dev);
    hipFuncSetAttribute((const void*)mega, hipFuncAttributeMaxDynamicSharedMemorySize, LDS_BYTES);
    hipOccupancyMaxActiveBlocksPerMultiprocessor(&per_cu, (const void*)mega, NWAVES * 64, LDS_BYTES);
    if (per_cu < 1) { fprintf(stderr, "kernel_launch: occupancy query says %d blocks per CU\n", per_cu); per_cu = 1; }
    if (per_cu > 1) per_cu = 1;
    grid_blocks = cus * per_cu;
  }
  hipMemsetAsync((char*)d_ws + WS_CTL, 0, 64 * 1024, stream);
  Params base{};
  for (int i = 0; i < 26; ++i) base.in[i] = (const float*)d_in[i];
  base.out = (float*)d_out; base.ws = (unsigned char*)d_ws;
  auto launch = [&](int lo, int hi) {
    Params p = base; p.ph_lo = lo; p.ph_hi = hi; p.rep = (int)PROBE_MASK; void* args[] = {&p};
    hipError_t e = hipLaunchCooperativeKernel((const void*)mega, dim3(grid_blocks), dim3(NWAVES * 64), args, LDS_BYTES, stream);
    if (e != hipSuccess) fprintf(stderr, "cooperative launch failed: %s (grid %d)\n", hipGetErrorString(e), grid_blocks);
  };
  launch(0, 17);
}
```

```cpp
#include <hip/hip_runtime.h>
#include <hip/hip_cooperative_groups.h>
#include <stdint.h>
#include <math.h>
#include <cstdio>
namespace cg = cooperative_groups;
#ifndef PROBE_SKIP
#define PROBE_SKIP 0
#endif
#ifndef PROBE_MASK
#define PROBE_MASK 0u
#endif

typedef unsigned short bf16_t;
#define DEV __device__ __forceinline__

DEV float bf2f(bf16_t v) { return __uint_as_float(((unsigned)v) << 16); }
typedef float f32x2_t __attribute__((ext_vector_type(2))); typedef __bf16 bf16x2_t __attribute__((ext_vector_type(2)));
DEV unsigned pk2(float lo, float hi) { const f32x2_t v = {lo, hi}; const bf16x2_t b = __builtin_convertvector(v, bf16x2_t); return __builtin_bit_cast(unsigned, b); }
DEV bf16_t f2bf(float f) { return (bf16_t)(pk2(f, 0.f) & 0xffffu); }
DEV float fexp(float x) { return __builtin_amdgcn_exp2f(x * 1.4426950408889634f); }
DEV float siluf(float x) { return x / (1.f + fexp(-x)); }
DEV float silu_fast(float x) { return x * __builtin_amdgcn_rcpf(1.f + fexp(-x)); }
DEV float softplusf(float x) { return x > 20.f ? x : log1pf(fexp(x)); }
DEV float logsigmoidf(float x) { return fminf(x, 0.f) - log1pf(fexp(-fabsf(x))); }

constexpr int D = 1024, NB = 2, SEQ = 8192, CTXL = 256;
constexpr int ML = NB * SEQ;
constexpr int MC = NB * CTXL;
constexpr int MA = ML + MC;
constexpr int NCH = MA / 128;
constexpr int E_IN = 5696, O_IN = 5120, E_INP = 5888;
constexpr float EPS = 1e-6f;

constexpr size_t MiB = 1u << 20;
constexpr int CW_CSQ = 8192;
constexpr size_t WS_CTL = 0;
constexpr size_t WS_MOD = 1 * MiB;
constexpr size_t WS_ROPE = 1 * MiB + 128 * 1024;
constexpr size_t WS_SDEC = 1 * MiB + 256 * 1024;
constexpr size_t WS_GDEC = 1 * MiB + 384 * 1024;
constexpr size_t WS_W1T = 2 * MiB;
constexpr size_t WS_W2T = 14 * MiB;
constexpr size_t WS_W3T = 18 * MiB;
constexpr size_t WS_W4T = 28 * MiB;
constexpr size_t WS_Y0 = 32 * MiB;
constexpr size_t WS_Q0 = 98 * MiB;
constexpr size_t WS_K0 = WS_Q0 + 16 * MiB + 512 * 1024;
constexpr size_t WS_V0 = 131 * MiB;
constexpr size_t WS_DTLR = 164 * MiB;
constexpr size_t WS_XC1 = 168 * MiB + 512 * 1024;
constexpr size_t WS_XBC = 171 * MiB;
constexpr size_t WS_STATE = 171 * MiB;
constexpr size_t WS_TAIL = 237 * MiB;
constexpr size_t WS_H1 = 32 * MiB;
constexpr size_t WS_K1 = 65 * MiB;
constexpr size_t WS_V1 = 81 * MiB + 512 * 1024;
constexpr size_t WS_Q1 = 98 * MiB;
constexpr size_t WS_G1 = 171 * MiB;

DEV int row_vec(int row) { return row < ML ? (row / SEQ) : 2; }

namespace pg8 {
#define PG8_LAS __attribute__((address_space(3)))
typedef unsigned short bf16_t;
typedef short bf16x8 __attribute__((ext_vector_type(8)));
typedef float f32x4 __attribute__((ext_vector_type(4)));
typedef unsigned u32x4 __attribute__((ext_vector_type(4)));
constexpr int BM = 256, BK = 64, HALF = 128, HTB = HALF * BK * 2  , STAGE_BYTES = 8 * HTB, NXCD = 8, WGM = 8;

__host__ __device__ __forceinline__ int lds_byte(int r, int c) { const int st = (r >> 4) * 2 + (c >> 5), rr = r & 15, cc = c & 31, ob = rr * 64 + cc * 2; return st * 1024 + (ob ^ (((ob >> 9) & 1) << 5)); }
__host__ __device__ __forceinline__ void stage_rc(int b, int& R, int& C) { const int st = b / 1024, sb = b % 1024, swz = sb ^ (((sb >> 9) & 1) << 5); R = (st >> 1) * 16 + swz / 64; C = (st & 1) * 32 + (swz % 64) / 2; }
__host__ __device__ __forceinline__ int perm32(int rho) { const int n = rho >> 4, i = rho & 15; return 8 * (i >> 2) + 4 * n + (i & 3); }

struct Unit { int pm, pn; };
struct Gemm { const bf16_t* A; const bf16_t* Bt; int M, N, K; };

struct StaticOrder {
    int nM, nN, nwg, G, c;
    __host__ __device__ __forceinline__ void init(int M, int N, int G_, int c_) { nM = M / BM; nN = N / BM; nwg = nM * nN; G = G_; c = c_; }
    __host__ __device__ __forceinline__ bool next(int i, Unit& u) const {
        const long L = (long)i * G + c; if (L >= nwg) return false;
        int wgid = (int)L; { const int q = nwg / NXCD, r = nwg % NXCD, xcd = wgid % NXCD, off = wgid / NXCD; wgid = (xcd < r ? xcd * (q + 1) : r * (q + 1) + (xcd - r) * q) + off; }
        const int nig = WGM * nN, gid = wgid / nig, fm = gid * WGM, gsz = (nM - fm) < WGM ? (nM - fm) : WGM;
        u.pm = fm + ((wgid % nig) % gsz); u.pn = (wgid % nig) / gsz; return true;
    }
    __device__ __forceinline__ void a_ready(const Unit&) const {}
    __device__ __forceinline__ void done(const Unit&) const {}
};
__device__ __forceinline__ unsigned cvt_pk_bf16(float lo, float hi) { unsigned r; asm volatile("v_cvt_pk_bf16_f32 %0, %1, %2" : "=v"(r) : "v"(lo), "v"(hi)); return r; }
__device__ __forceinline__ float silu_e(float x) { return x * __builtin_amdgcn_rcpf(1.f + fexp(-x)); }

__device__ __forceinline__ void store_unit_bf16(const f32x4 (&acc)[2][2][4][2], bf16_t* base, int ld, int colt, bool act, const Unit& u, int wr, int wc, int fr, int fq) {
    const int row0 = u.pm * BM + wr * 64 + fr; const int col0 = colt + wc * 32 + 8 * fq;
#pragma unroll
    for (int ai = 0; ai < 2; ++ai)
#pragma unroll
        for (int m = 0; m < 4; ++m) { bf16_t* rowp = base + (size_t)(row0 + ai * HALF + m * 16) * ld + col0;
#pragma unroll
            for (int bj = 0; bj < 2; ++bj) { f32x4 v0 = acc[ai][bj][m][0], v1 = acc[ai][bj][m][1];
                if (act) { v0 = (f32x4){silu_e(v0[0]), silu_e(v0[1]), silu_e(v0[2]), silu_e(v0[3])}; v1 = (f32x4){silu_e(v1[0]), silu_e(v1[1]), silu_e(v1[2]), silu_e(v1[3])}; }
                u32x4 w; w.x = cvt_pk_bf16(v0[0], v0[1]); w.y = cvt_pk_bf16(v0[2], v0[3]); w.z = cvt_pk_bf16(v1[0], v1[1]); w.w = cvt_pk_bf16(v1[2], v1[3]);
                *(u32x4*)(rowp + bj * HALF) = w; } }
}
struct EpiProj0 {
    static constexpr bool PERM = true, AFTER_DRAIN = false;
    bf16_t *Y0, *XBC, *Q0, *K0, *V0; float* DTLR;
    __device__ __forceinline__ void operator()(const f32x4 (&acc)[2][2][4][2], const Unit& u, int wr, int wc, int fr, int fq) const {
        const int pn = u.pn;
        if (pn == 22) {
            if (wc < 2) { const int row0 = u.pm * BM + wr * 64 + fr;
#pragma unroll
                for (int ai = 0; ai < 2; ++ai)
#pragma unroll
                    for (int m = 0; m < 4; ++m) { float* rp = DTLR + (size_t)(row0 + ai * HALF + m * 16) * 64 + wc * 32 + 8 * fq; *(f32x4*)rp = acc[ai][0][m][0]; *(f32x4*)(rp + 4) = acc[ai][0][m][1]; } }
            return;
        }
        bf16_t* base; int ld, colt; bool act = false;
        if (pn < 8) { base = Y0; ld = 2048; colt = pn * 256; act = true; }
        else if (pn < 14) { base = XBC; ld = 1536; colt = (pn - 8) * 256; }
        else if (pn < 16) { base = Q0; ld = 512; colt = (pn - 14) * 256; }
        else if (pn < 18) { base = K0; ld = 512; colt = (pn - 16) * 256; }
        else { base = V0; ld = 1024; colt = (pn - 18) * 256; }
        store_unit_bf16(acc, base, ld, colt, act, u, wr, wc, fr, fq);
    }
};
struct EpiProj1 {
    static constexpr bool PERM = true, AFTER_DRAIN = false;
    bf16_t *K1, *V1, *Q1, *G1; const float *qn, *kn, *rope; PG8_LAS float* part;
    __device__ __forceinline__ void operator()(const f32x4 (&acc)[2][2][4][2], const Unit& u, int wr, int wc, int fr, int fq) const {
        const int pn = u.pn; bf16_t* base; int ld, colt; bool act = false;
        if (pn < 2) { base = K1; ld = 512; colt = pn * 256; }
        else if (pn < 4) { base = V1; ld = 512; colt = (pn - 2) * 256; }
        else if (pn < 12) { base = Q1; ld = 2048; colt = (pn - 4) * 256; }
        else { base = G1; ld = 2048; colt = (pn - 12) * 256; act = true; }
        const bool isk = pn < 2, isq = pn >= 4 && pn < 12;
        if (!(isk || isq)) { store_unit_bf16(acc, base, ld, colt, act, u, wr, wc, fr, fq); return; }
#pragma unroll
        for (int ai = 0; ai < 2; ++ai)
#pragma unroll
            for (int m = 0; m < 4; ++m)
#pragma unroll
                for (int bj = 0; bj < 2; ++bj) { const f32x4 x0 = acc[ai][bj][m][0], x1 = acc[ai][bj][m][1];
                    float s = (x0[0] * x0[0] + x0[1] * x0[1]) + (x0[2] * x0[2] + x0[3] * x0[3]) + (x1[0] * x1[0] + x1[1] * x1[1]) + (x1[2] * x1[2] + x1[3] * x1[3]);
                    s += __shfl_xor(s, 16); s += __shfl_xor(s, 32);
                    if (fq == 0) part[(ai * HALF + wr * 64 + m * 16 + fr) * 8 + bj * 4 + wc] = s; }
        asm volatile("s_waitcnt lgkmcnt(0)" ::: "memory"); __builtin_amdgcn_s_barrier(); asm volatile("" ::: "memory");
        const int a = wc >> 1, f0 = 16 * (wc & 1) + 4 * fq;
        const float* gn = (isq ? qn : kn) + a * 64 + f0;
        const f32x4 g0 = *(const f32x4*)gn, g1 = *(const f32x4*)(gn + 32);
        const float osc = isq ? 0.08838834764831845f * 1.4426950408889634f : 1.f;
        const int col0 = colt + wc * 32 + 8 * fq;
        f32x4 w_[2][2][4][2];
#pragma unroll
        for (int ai = 0; ai < 2; ++ai)
#pragma unroll
            for (int bj = 0; bj < 2; ++bj)
#pragma unroll
                for (int m = 0; m < 4; ++m) { w_[ai][bj][m][0] = acc[ai][bj][m][0]; w_[ai][bj][m][1] = acc[ai][bj][m][1]; }
#pragma unroll 1
        for (int m = 0; m < 4; ++m) {
#pragma unroll
            for (int ai = 0; ai < 2; ++ai) { const int rowl = ai * HALF + wr * 64 + m * 16 + fr, row = u.pm * BM + rowl, t = row & 8191, pos = a ? (t & 63) : (t >> 6);
                const f32x4 cs = *(const f32x4*)(rope + pos * 32 + f0), sn = *(const f32x4*)(rope + 4096 + pos * 32 + f0);
                bf16_t* rowp = base + (size_t)row * ld + col0;
#pragma unroll
                for (int bj = 0; bj < 2; ++bj) { const f32x4 p4 = *(const PG8_LAS f32x4*)(part + rowl * 8 + bj * 4);
                    const float rstd = __builtin_amdgcn_rsqf(((p4[0] + p4[1]) + (p4[2] + p4[3])) * (1.f / 128.f) + 1e-6f) * osc;
                    const f32x4 t1 = w_[ai][bj][0][0] * g0 * rstd, t2 = w_[ai][bj][0][1] * g1 * rstd;
                    const f32x4 o1 = t1 * cs - t2 * sn, o2 = t2 * cs + t1 * sn;
                    u32x4 w; w.x = cvt_pk_bf16(o1[0], o1[1]); w.y = cvt_pk_bf16(o1[2], o1[3]); w.z = cvt_pk_bf16(o2[0], o2[1]); w.w = cvt_pk_bf16(o2[2], o2[3]);
                    *(u32x4*)(rowp + bj * HALF) = w; } }
#pragma unroll
            for (int ai = 0; ai < 2; ++ai)
#pragma unroll
                for (int bj = 0; bj < 2; ++bj)
#pragma unroll
                    for (int n = 0; n < 2; ++n) { w_[ai][bj][0][n] = w_[ai][bj][1][n]; w_[ai][bj][1][n] = w_[ai][bj][2][n]; w_[ai][bj][2][n] = w_[ai][bj][3][n]; }
        }
    }
};
struct EpiResid {
    static constexpr bool PERM = false, AFTER_DRAIN = false;
    const float* res; float* out; const float* mod; bool do_store;
    __device__ __forceinline__ void operator()(const f32x4 (&acc)[2][2][4][2], const Unit& u, int wr, int wc, int fr, int fq) const {
        const int b = (u.pm * BM) / 8192; const float* gate = mod + b * 3072 + 2048;
        const int col0 = u.pn * BM + wc * 32 + 4 * fq;
        f32x4 gv[2][2];
#pragma unroll
        for (int bj = 0; bj < 2; ++bj)
#pragma unroll
            for (int n = 0; n < 2; ++n) gv[bj][n] = *(const f32x4*)(gate + col0 + bj * HALF + n * 16);
#pragma unroll
        for (int ai = 0; ai < 2; ++ai)
#pragma unroll
            for (int m = 0; m < 4; ++m) { const size_t off = (size_t)(u.pm * BM + ai * HALF + wr * 64 + m * 16 + fr) * 1024 + col0;
#pragma unroll
                for (int bj = 0; bj < 2; ++bj)
#pragma unroll
                    for (int n = 0; n < 2; ++n) { const f32x4 r = *(const f32x4*)(res + off + bj * HALF + n * 16); const f32x4 ov_ = r + gv[bj][n] * acc[ai][bj][m][n]; if (do_store) *(f32x4*)(out + off + bj * HALF + n * 16) = ov_; } }
    }
};
template <class Epi, class Sched, bool ALIGN_EPI = false, bool SP2 = false, bool RS = false>
__device__ __forceinline__ void gemm_phase(PG8_LAS unsigned char* lds, const Gemm g, const Sched& S, const Epi& E, const PG8_LAS float* rs = nullptr) {
    const int tid = threadIdx.x, wid = __builtin_amdgcn_readfirstlane(tid >> 6), lane = tid & 63, wr = wid >> 2, wc = wid & 3, fr = lane & 15, fq = lane >> 4;
    const int K = g.K, nt = K / BK;
    unsigned voffA[2], voffB[2];
#pragma unroll
    for (int i = 0; i < 2; ++i) { int R, C; stage_rc(tid * 16 + i * 8192, R, C); const int Rb = Epi::PERM ? ((R & ~31) + perm32(R & 31)) : R;
        voffA[i] = (unsigned)(R * K + C) * 2u; voffB[i] = (unsigned)(Rb * K + C) * 2u; }
    const size_t kstep = (size_t)(BK * 2);
    const size_t hstep = (size_t)HALF * K * 2;
    const size_t tstep = 2 * hstep;
    const unsigned ldsw = (unsigned)wid * 1024u;
    const int aoff = lds_byte(wr * 64 + fr, fq * 8), boff = lds_byte(wc * 32 + fr, fq * 8);
#define PG8_SA(b, h) (((b) * 2 + (h)) * HTB)
#define PG8_SB(b, h) ((4 + (b) * 2 + (h)) * HTB)
#define PG8_STAGE(bufoff, gbase, voff) do { _Pragma("unroll") for (int _i = 0; _i < 2; ++_i) \
        __builtin_amdgcn_global_load_lds((const unsigned*)((const char*)(gbase) + (voff)[_i]), (PG8_LAS unsigned*)(lds + (bufoff) + ldsw + _i * 8192), 16, 0, 0); } while (0)
#define PG8_LDA(dst, b, h) do { _Pragma("unroll") for (int m = 0; m < 4; ++m) _Pragma("unroll") for (int k = 0; k < 2; ++k) dst[m][k] = *(const PG8_LAS bf16x8*)(lds + PG8_SA(b, h) + aoff + m * 2048 + k * 1024); } while (0)
#define PG8_LDB(dst, b, h) do { _Pragma("unroll") for (int n = 0; n < 2; ++n) _Pragma("unroll") for (int k = 0; k < 2; ++k) dst[n][k] = *(const PG8_LAS bf16x8*)(lds + PG8_SB(b, h) + boff + n * 2048 + k * 1024); } while (0)
#define PG8_MMA(ai, bj, At, Bt) do { __builtin_amdgcn_s_setprio(1); _Pragma("unroll") for (int m = 0; m < 4; ++m) _Pragma("unroll") for (int n = 0; n < 2; ++n) _Pragma("unroll") for (int k = 0; k < 2; ++k) \
        acc[ai][bj][m][n] = __builtin_amdgcn_mfma_f32_16x16x32_bf16(Bt[n][k], At[m][k], acc[ai][bj][m][n], 0, 0, 0); __builtin_amdgcn_s_setprio(0); } while (0)
#define PG8_WAIT_V(n) asm volatile("s_waitcnt vmcnt(" #n ")" ::: "memory")
#define PG8_WAIT_L(n) asm volatile("s_waitcnt lgkmcnt(" #n ")" ::: "memory")
#define PG8_BAR __builtin_amdgcn_s_barrier()
#define PG8_SCHED __builtin_amdgcn_sched_barrier(0)
    Unit cur, nxt; int ui = 0;
    if (!S.next(0, cur)) return;
    f32x4 acc[2][2][4][2];
#pragma unroll
    for (int a = 0; a < 2; ++a)
#pragma unroll
        for (int b = 0; b < 2; ++b)
#pragma unroll
            for (int m = 0; m < 4; ++m)
#pragma unroll
                for (int n = 0; n < 2; ++n) acc[a][b][m][n] = (f32x4){0.f, 0.f, 0.f, 0.f};
    bf16x8 At[4][2], B0[2][2], B1[2][2];
    const char* cA = (const char*)g.A + (size_t)cur.pm * tstep; const char* cB = (const char*)g.Bt + (size_t)cur.pn * tstep;
    S.a_ready(cur);
    if constexpr (SP2) {
        PG8_STAGE(PG8_SB(0, 0), cB, voffB); PG8_STAGE(PG8_SB(0, 1), cB + hstep, voffB); PG8_STAGE(PG8_SA(0, 0), cA, voffA); PG8_STAGE(PG8_SA(0, 1), cA + hstep, voffA);
        if (wr == 1) PG8_BAR;
        PG8_WAIT_V(2); PG8_BAR;
        PG8_STAGE(PG8_SB(1, 0), cB + kstep, voffB); PG8_STAGE(PG8_SA(1, 0), cA + kstep, voffA); PG8_STAGE(PG8_SB(1, 1), cB + hstep + kstep, voffB);
        PG8_WAIT_V(6); PG8_BAR;
    } else {
        PG8_STAGE(PG8_SB(0, 0), cB, voffB); PG8_STAGE(PG8_SA(0, 0), cA, voffA); PG8_STAGE(PG8_SB(0, 1), cB + hstep, voffB); PG8_STAGE(PG8_SA(0, 1), cA + hstep, voffA);
        if (wr == 1) PG8_BAR;
        PG8_WAIT_V(4); PG8_BAR;
        PG8_STAGE(PG8_SB(1, 0), cB + kstep, voffB); PG8_STAGE(PG8_SA(1, 0), cA + kstep, voffA); PG8_STAGE(PG8_SB(1, 1), cB + hstep + kstep, voffB);
        PG8_WAIT_V(6); PG8_BAR;
    }
    for (;;) {
        const bool has_next = S.next(ui + 1, nxt);
        const char* nA = has_next ? (const char*)g.A + (size_t)nxt.pm * tstep : cA; const char* nB = has_next ? (const char*)g.Bt + (size_t)nxt.pn * tstep : cB;
        for (int t = 0; t < nt; t += 2) {
            if constexpr (RS) { if (t == 8 || t == 16) { const int sel = (t == 16);
#pragma unroll
                for (int ai = 0; ai < 2; ++ai)
#pragma unroll
                    for (int m = 0; m < 4; ++m) { const float sc = rs[(ai * HALF + wr * 64 + m * 16 + fr) * 2 + sel];
#pragma unroll
                        for (int bj = 0; bj < 2; ++bj)
#pragma unroll
                            for (int n = 0; n < 2; ++n) acc[ai][bj][m][n] = acc[ai][bj][m][n] * sc; } } }
            const bool last = (t == nt - 2);
            const char* a1 = cA + (size_t)(t + 1) * kstep;
            const char* a2 = last ? nA : cA + (size_t)(t + 2) * kstep; const char* b2 = last ? nB : cB + (size_t)(t + 2) * kstep;
            const char* a3 = a2 + kstep; const char* b3 = b2 + kstep;
            if (last && has_next) S.a_ready(nxt);
            if constexpr (SP2) {
            PG8_LDB(B0, 0, 0); PG8_LDB(B1, 0, 1); PG8_SCHED; PG8_LDA(At, 0, 0); PG8_STAGE(PG8_SA(1, 1), a1 + hstep, voffA);
            PG8_WAIT_V(8); PG8_WAIT_L(0); PG8_BAR; PG8_MMA(0, 0, At, B0); PG8_MMA(0, 1, At, B1); PG8_BAR; PG8_SCHED;
            PG8_LDA(At, 0, 1); PG8_STAGE(PG8_SB(0, 0), b2, voffB); PG8_STAGE(PG8_SB(0, 1), b2 + hstep, voffB); PG8_STAGE(PG8_SA(0, 0), a2, voffA);
            PG8_WAIT_V(8); PG8_WAIT_L(0); PG8_BAR; PG8_MMA(1, 0, At, B0); PG8_MMA(1, 1, At, B1); PG8_BAR; PG8_SCHED;
            PG8_LDB(B0, 1, 0); PG8_LDB(B1, 1, 1); PG8_SCHED; PG8_LDA(At, 1, 0); PG8_STAGE(PG8_SA(0, 1), a2 + hstep, voffA);
            PG8_WAIT_V(8); PG8_WAIT_L(0); PG8_BAR; PG8_MMA(0, 0, At, B0); PG8_MMA(0, 1, At, B1); PG8_BAR; PG8_SCHED;
            PG8_LDA(At, 1, 1); PG8_STAGE(PG8_SB(1, 0), b3, voffB); PG8_STAGE(PG8_SB(1, 1), b3 + hstep, voffB); PG8_STAGE(PG8_SA(1, 0), a3, voffA);
            PG8_WAIT_V(8); PG8_WAIT_L(0); PG8_BAR; PG8_MMA(1, 0, At, B0); PG8_MMA(1, 1, At, B1); PG8_BAR; PG8_SCHED;
            } else {
            PG8_LDB(B0, 0, 0); PG8_SCHED; PG8_LDA(At, 0, 0); PG8_STAGE(PG8_SA(1, 1), a1 + hstep, voffA);
            PG8_WAIT_L(8); PG8_BAR; PG8_WAIT_L(0); PG8_MMA(0, 0, At, B0); PG8_BAR; PG8_SCHED;
            PG8_LDB(B1, 0, 1); PG8_STAGE(PG8_SB(0, 0), b2, voffB);
            PG8_BAR; PG8_WAIT_L(0); PG8_MMA(0, 1, At, B1); PG8_BAR;
            PG8_LDA(At, 0, 1); PG8_STAGE(PG8_SA(0, 0), a2, voffA);
            PG8_BAR; PG8_WAIT_L(0); PG8_MMA(1, 0, At, B0); PG8_BAR; PG8_SCHED;
            PG8_STAGE(PG8_SB(0, 1), b2 + hstep, voffB);
            PG8_WAIT_V(6); PG8_BAR; PG8_MMA(1, 1, At, B1); PG8_BAR;
            PG8_LDB(B0, 1, 0); PG8_SCHED; PG8_LDA(At, 1, 0); PG8_STAGE(PG8_SA(0, 1), a2 + hstep, voffA);
            PG8_WAIT_L(8); PG8_BAR; PG8_WAIT_L(0); PG8_MMA(0, 0, At, B0); PG8_BAR; PG8_SCHED;
            PG8_LDB(B1, 1, 1); PG8_STAGE(PG8_SB(1, 0), b3, voffB);
            PG8_BAR; PG8_WAIT_L(0); PG8_MMA(0, 1, At, B1); PG8_BAR;
            PG8_LDA(At, 1, 1); PG8_STAGE(PG8_SA(1, 0), a3, voffA);
            PG8_BAR; PG8_WAIT_L(0); PG8_MMA(1, 0, At, B0); PG8_BAR; PG8_SCHED;
            PG8_STAGE(PG8_SB(1, 1), b3 + hstep, voffB);
            PG8_WAIT_V(6); PG8_BAR; PG8_MMA(1, 1, At, B1); PG8_BAR;
            }
        }
        if constexpr (ALIGN_EPI) { if (wr == 0) PG8_BAR; }
        if constexpr (!Epi::AFTER_DRAIN) { E(acc, cur, wr, wc, fr, fq); S.done(cur); }
        if (!has_next) break;
#pragma unroll
        for (int a = 0; a < 2; ++a)
#pragma unroll
            for (int b = 0; b < 2; ++b)
#pragma unroll
                for (int m = 0; m < 4; ++m)
#pragma unroll
                    for (int n = 0; n < 2; ++n) acc[a][b][m][n] = (f32x4){0.f, 0.f, 0.f, 0.f};
        cur = nxt; cA = nA; cB = nB; ++ui;
        if constexpr (ALIGN_EPI) { if (wr == 1) PG8_BAR; }
    }
    PG8_WAIT_V(0);
    if constexpr (!ALIGN_EPI) { if (wr == 0) PG8_BAR; }
    PG8_BAR;
    if constexpr (Epi::AFTER_DRAIN) { E.fused(acc, cur, wr, wc, fr, fq, lds, wid, lane); S.done(cur); }
#undef PG8_SA
#undef PG8_SB
#undef PG8_STAGE
#undef PG8_LDA
#undef PG8_LDB
#undef PG8_MMA
#undef PG8_WAIT_V
#undef PG8_WAIT_L
#undef PG8_BAR
#undef PG8_SCHED
}
}
#define LAS __attribute__((address_space(3)))
typedef unsigned v4u __attribute__((ext_vector_type(4)));
typedef float f32x4 __attribute__((ext_vector_type(4)));
typedef short bf16x8 __attribute__((ext_vector_type(8)));
#define LDS_WAIT() asm volatile("s_waitcnt lgkmcnt(0)" ::: "memory")
constexpr int NWAVES = 8;
constexpr int LDS_BYTES = 147456;
constexpr int MISC_OFF = 147456 - 128;

struct Params { const float* in[26]; float* out; unsigned char* ws; int ph_lo, ph_hi, rep, pad; };

DEV int virt_block() { const int G = (int)gridDim.x, b = (int)blockIdx.x; return (G % 8 == 0) ? (b % 8) * (G / 8) + b / 8 : b; }
DEV float wave_sum(float v) {
#pragma unroll
  for (int o = 1; o < 64; o <<= 1) v += __shfl_xor(v, o);
  return v;
}

DEV int w1_dest_row(int n) {
  if (n < 1024) return n;
  if (n < 2560) return 2048 + (n - 1024);
  if (n < 2592) return 5632 + (n - 2560);
  if (n < 3104) return 3584 + (n - 2592);
  if (n < 3616) return 4096 + (n - 3104);
  if (n < 4640) return 4608 + (n - 3616);
  if (n < 5664) return 1024 + (n - 4640);
  return n;
}
DEV int qk_pos(int d) { const int a = d >> 6, s = (d >> 5) & 1, f = d & 31; return 32 * (2 * a + (f >> 4)) + 8 * ((f >> 2) & 3) + 4 * s + (f & 3); }
DEV void transpose_item(const float* W, int K, int N, int k0, int n0, bf16_t* WT, int drow0, LAS float* scr, int lane, int headbase = -1, const float* kscale = nullptr) {
#pragma unroll 8
  for (int i = 0; i < 32; ++i) { const int kk = 2 * i + (lane >> 5); scr[kk * 33 + (lane & 31)] = W[(size_t)(k0 + kk) * N + n0 + (lane & 31)]; }
  LDS_WAIT(); asm volatile("" ::: "memory");
  const int c = lane & 7;
#pragma unroll
  for (int j = 0; j < 4; ++j) { const int n = (lane >> 3) + 8 * j; const LAS float* s = scr + (8 * c) * 33 + n;
    f32x4 k0s = {1.f, 1.f, 1.f, 1.f}, k1s = k0s; if (kscale) { k0s = *(const f32x4*)(kscale + k0 + 8 * c); k1s = *(const f32x4*)(kscale + k0 + 8 * c + 4); }
    v4u o; o.x = pk2(s[0 * 33] * k0s.x, s[1 * 33] * k0s.y); o.y = pk2(s[2 * 33] * k0s.z, s[3 * 33] * k0s.w); o.z = pk2(s[4 * 33] * k1s.x, s[5 * 33] * k1s.y); o.w = pk2(s[6 * 33] * k1s.z, s[7 * 33] * k1s.w);
    const int drow = headbase >= 0 ? headbase + qk_pos((n0 & 127) + n) : drow0 + n;
    *(v4u*)(WT + (size_t)drow * K + k0 + 8 * c) = o; }
  LDS_WAIT(); asm volatile("" ::: "memory");
}
DEV void prologue_phase(const Params& p, LAS unsigned char* lds) {
  const int tid = threadIdx.x, lane = tid & 63, wave = tid >> 6;
  unsigned char* ws = p.ws;
  float* MOD = (float*)(ws + WS_MOD);
  {
    LAS float* sc = (LAS float*)lds;
    LAS float* part = (LAS float*)(lds + 12288);
    for (int i = tid; i < 3072; i += 512) { const int v = i >> 10, k = i & 1023; const float cv = v < 2 ? p.in[1][v * 1024 + k] : p.in[3][k]; sc[i] = siluf(cv); }
    __syncthreads();
    for (int task = blockIdx.x; task < 192; task += gridDim.x) {
      const int l = task / 96, n0 = (task % 96) * 32; const float* w = l ? p.in[19] : p.in[5]; const float* bb = l ? p.in[20] : p.in[6];
      const int col = tid & 31, ks = tid >> 5;
      float a0 = 0.f, a1 = 0.f, a2 = 0.f;
#pragma unroll 16
      for (int k = ks * 64; k < ks * 64 + 64; ++k) { const float wv = w[(size_t)k * 3072 + n0 + col]; a0 += sc[k] * wv; a1 += sc[1024 + k] * wv; a2 += sc[2048 + k] * wv; }
      part[(ks * 3 + 0) * 32 + col] = a0; part[(ks * 3 + 1) * 32 + col] = a1; part[(ks * 3 + 2) * 32 + col] = a2;
      __syncthreads();
      if (tid < 96) { const int v = tid >> 5; float s = bb[n0 + col];
#pragma unroll
        for (int q = 0; q < 16; ++q) s += part[(q * 3 + v) * 32 + col];
        MOD[(l * 3 + v) * 3072 + n0 + col] = s; }
      __syncthreads();
    }
  }
  if (blockIdx.x == gridDim.x - 1) { float* rope = (float*)(ws + WS_ROPE);
    for (int idx = tid; idx < 4096; idx += 512) { const int pos = idx >> 5, f = idx & 31; const float inv = 1.0f / powf(10000.f, (float)f / 32.f); const float ang = (float)pos * inv; rope[idx] = cosf(ang); rope[4096 + idx] = sinf(ang); } }
  { v4u* z = (v4u*)(ws + WS_W1T + (size_t)E_IN * 1024 * 2); const v4u zero = {0u, 0u, 0u, 0u};
    for (int i = blockIdx.x * 512 + tid; i < (E_INP - E_IN) * 1024 * 2 / 16; i += gridDim.x * 512) z[i] = zero; }
  __syncthreads();
  {
    LAS float* scr = (LAS float*)(lds + wave * 16384);
    const int gw = blockIdx.x * NWAVES + wave, NGW = gridDim.x * NWAVES;
    constexpr int I1 = 16 * 178;
    for (int it = gw; it < I1; it += NGW) { const int kb = it / 178, nb = it % 178; transpose_item(p.in[7], 1024, E_IN, 64 * kb, 32 * nb, (bf16_t*)(ws + WS_W1T), w1_dest_row(32 * nb), scr, lane); }
  }
}
DEV void late_weights(const Params& p, LAS unsigned char* lds, int vblock, int nvblocks) {
  const int lane = threadIdx.x & 63, wave = threadIdx.x >> 6; unsigned char* ws = p.ws;
  LAS float* scr = (LAS float*)(lds + wave * 16384);
  constexpr int I2 = 32 * 32, I3 = 16 * 160, I4 = 32 * 32;
  for (int it = vblock * NWAVES + wave; it < I2 + I3 + I4; it += nvblocks * NWAVES) {
    int r = it;
    if (r < I2) { const int kb = r / 32, nb = r % 32; transpose_item(p.in[17], 2048, 1024, 64 * kb, 32 * nb, (bf16_t*)(ws + WS_W2T), 32 * nb, scr, lane, -1, kb < 16 ? p.in[13] : nullptr); continue; }
    r -= I2;
    if (r < I3) { const int kb = r / 160, nb = r % 160, n0 = 32 * nb; const bool qk = n0 < 512 || (n0 >= 1024 && n0 < 3072);
      transpose_item(p.in[21], 1024, O_IN, 64 * kb, n0, (bf16_t*)(ws + WS_W3T), n0, scr, lane, qk ? (n0 & ~127) : -1); continue; } r -= I3;
    { const int kb = r / 32, nb = r % 32; transpose_item(p.in[25], 2048, 1024, 64 * kb, 32 * nb, (bf16_t*)(ws + WS_W4T), 32 * nb, scr, lane); }
  }
}
DEV void prep_phase(const float* xlat, const float* xctx, const float* g, const float* mod, bf16_t* H) {
  const int lane = threadIdx.x & 63, wave = threadIdx.x >> 6, NW = gridDim.x * NWAVES;
  for (int row = blockIdx.x * NWAVES + wave; row < MA; row += 2 * NW) {
    const int row2 = row + NW; const bool has2 = row2 < MA;
    const float* s0 = row < ML ? xlat + (size_t)row * D : xctx + (size_t)(row - ML) * D;
    const float* s1 = has2 ? (row2 < ML ? xlat + (size_t)row2 * D : xctx + (size_t)(row2 - ML) * D) : s0;
    f32x4 v0[4], v1[4]; float ss0 = 0.f, ss1 = 0.f;
#pragma unroll
    for (int j = 0; j < 4; ++j) { v0[j] = *(const f32x4*)(s0 + 4 * lane + 256 * j); v1[j] = *(const f32x4*)(s1 + 4 * lane + 256 * j); }
#pragma unroll
    for (int j = 0; j < 4; ++j) { ss0 += (v0[j].x * v0[j].x + v0[j].y * v0[j].y) + (v0[j].z * v0[j].z + v0[j].w * v0[j].w); ss1 += (v1[j].x * v1[j].x + v1[j].y * v1[j].y) + (v1[j].z * v1[j].z + v1[j].w * v1[j].w); }
#pragma unroll
    for (int o = 1; o < 64; o <<= 1) { ss0 += __shfl_xor(ss0, o); ss1 += __shfl_xor(ss1, o); }
    const float r0 = rsqrtf(ss0 * (1.f / D) + EPS), r1 = rsqrtf(ss1 * (1.f / D) + EPS);
    const float* m0 = mod + row_vec(row) * 3072; const float* m1 = mod + row_vec(has2 ? row2 : row) * 3072;
#pragma unroll
    for (int j = 0; j < 4; ++j) { const int k = 4 * lane + 256 * j; const f32x4 gg = *(const f32x4*)(g + k);
      { const f32x4 sc = *(const f32x4*)(m0 + 1024 + k), sh = *(const f32x4*)(m0 + k); const f32x4 o = v0[j] * r0 * gg * (sc + 1.f) + sh;
        *(unsigned long long*)(H + (size_t)row * D + k) = (unsigned long long)pk2(o.x, o.y) | ((unsigned long long)pk2(o.z, o.w) << 32); }
      if (has2) { const f32x4 sc = *(const f32x4*)(m1 + 1024 + k), sh = *(const f32x4*)(m1 + k); const f32x4 o = v1[j] * r1 * gg * (sc + 1.f) + sh;
        *(unsigned long long*)(H + (size_t)row2 * D + k) = (unsigned long long)pk2(o.x, o.y) | ((unsigned long long)pk2(o.z, o.w) << 32); } }
  }
}
template <class F> DEV void small_gemm(const bf16_t* A, int lda, const bf16_t* Bt, int ldb, int K, int Mrows, int Ncols, F f) {
  const int lane = threadIdx.x & 63, wid = threadIdx.x >> 6, mt = wid >> 2, nt = wid & 3, r = lane & 15, q = lane >> 4;
  const int ntn = Ncols / 64, ntasks = (Mrows / 32) * ntn;
  for (int task = blockIdx.x; task < ntasks; task += gridDim.x) {
    const int row0 = (task / ntn) * 32 + mt * 16, col0 = (task % ntn) * 64 + nt * 16;
    const bf16_t* ap = A + (size_t)(row0 + r) * lda + 8 * q; const bf16_t* bp = Bt + (size_t)(col0 + r) * ldb + 8 * q;
    f32x4 acc = {0.f, 0.f, 0.f, 0.f};
#pragma unroll 8
    for (int k = 0; k < K; k += 32) { const bf16x8 a = *(const bf16x8*)(ap + k), b = *(const bf16x8*)(bp + k); acc = __builtin_amdgcn_mfma_f32_16x16x32_bf16(a, b, acc, 0, 0, 0); }
#pragma unroll
    for (int j = 0; j < 4; ++j) f(row0 + q * 4 + j, col0 + r, acc[j]);
  }
}

template <class F> DEV void small_gemm_splitk(const bf16_t* A, int lda, const bf16_t* Bt, int ldb, int K, int Mrows, int Ncols, LAS unsigned char* lds, const float* ssq  , F f) {
  const int tid = threadIdx.x, lane = tid & 63, wid = tid >> 6, r = lane & 15, q = lane >> 4;
  LAS float* red = (LAS float*)lds;
  const int ntn = Ncols / 64, ntasks = (Mrows / 32) * ntn, kw = K / 8;
  for (int task = virt_block(); task < ntasks; task += gridDim.x) {
    const int row0 = (task / ntn) * 32, col0 = (task % ntn) * 64;
    asm volatile("s_waitcnt vmcnt(0)" ::: "memory");
    const bf16_t* ap = A + (size_t)(row0 + r) * lda + wid * kw + 8 * q; const bf16_t* bp = Bt + (size_t)(col0 + r) * ldb + wid * kw + 8 * q;
    f32x4 acc[2][4];
#pragma unroll
    for (int mt = 0; mt < 2; ++mt)
#pragma unroll
      for (int nt = 0; nt < 4; ++nt) acc[mt][nt] = (f32x4){0.f, 0.f, 0.f, 0.f};
#pragma unroll 4
    for (int k = 0; k < kw; k += 32) {
      bf16x8 a[2], b[4];
#pragma unroll
      for (int mt = 0; mt < 2; ++mt) a[mt] = *(const bf16x8*)(ap + (size_t)(16 * mt) * lda + k);
#pragma unroll
      for (int nt = 0; nt < 4; ++nt) b[nt] = *(const bf16x8*)(bp + (size_t)(16 * nt) * ldb + k);
#pragma unroll
      for (int mt = 0; mt < 2; ++mt)
#pragma unroll
        for (int nt = 0; nt < 4; ++nt) acc[mt][nt] = __builtin_amdgcn_mfma_f32_16x16x32_bf16(a[mt], b[nt], acc[mt][nt], 0, 0, 0);
    }
    __syncthreads();
#pragma unroll
    for (int mt = 0; mt < 2; ++mt)
#pragma unroll
      for (int nt = 0; nt < 4; ++nt)
#pragma unroll
        for (int j = 0; j < 4; ++j) { const int rl = 16 * mt + 4 * q + j; float sc = 1.f;
          if (ssq && wid < 4) { const float* sp = ssq + ((size_t)(row0 + rl) * 2 + (wid >> 1)) * 2; sc = rsqrtf((sp[0] + sp[1]) * (1.f / 512.f) + EPS); }
          red[wid * 2048 + rl * 64 + 16 * nt + r] = acc[mt][nt][j] * sc; }
    __syncthreads();
#pragma unroll
    for (int o = 0; o < 4; ++o) { const int e = tid + 512 * o; float s = 0.f;
#pragma unroll
      for (int w = 0; w < 8; ++w) s += red[w * 2048 + e];
      f(row0 + (e >> 6), col0 + (e & 63), s, __shfl_xor(s, 1)); }
  }
}

DEV void qknorm_phase(bf16_t* Q1, bf16_t* K1, const float* qn, const float* kn, const float* rope, bool wr) {
  const int lane = threadIdx.x & 63, wave = threadIdx.x >> 6, hl = lane >> 4, d0 = (lane & 15) * 8;
  const float scale = 0.08838834764831845f * 1.4426950408889634f;
  float gq[8], gk[8];
#pragma unroll
  for (int e = 0; e < 8; ++e) { gq[e] = qn[d0 + e] * scale; gk[e] = kn[d0 + e]; }
  const int ax = d0 >> 6, sgn = (d0 >> 5) & 1, f0 = d0 & 31;
  for (int row = blockIdx.x * NWAVES + wave; row < MA; row += gridDim.x * NWAVES) {
    const bool lat = row < ML;
    v4u raw[5];
    raw[0] = *(const v4u*)(K1 + (size_t)row * 512 + hl * 128 + d0);
    if (lat) {
#pragma unroll
      for (int g = 0; g < 4; ++g) raw[1 + g] = *(const v4u*)(Q1 + (size_t)row * 2048 + (g * 4 + hl) * 128 + d0);
    }
    float cs[8], sn[8];
    if (lat) { const int t = row % SEQ, pos = ax ? (t & 63) : (t >> 6);
      const f32x4 c0 = *(const f32x4*)(rope + pos * 32 + f0), c1 = *(const f32x4*)(rope + pos * 32 + f0 + 4), s0 = *(const f32x4*)(rope + 4096 + pos * 32 + f0), s1 = *(const f32x4*)(rope + 4096 + pos * 32 + f0 + 4);
      cs[0] = c0.x; cs[1] = c0.y; cs[2] = c0.z; cs[3] = c0.w; cs[4] = c1.x; cs[5] = c1.y; cs[6] = c1.z; cs[7] = c1.w;
      sn[0] = s0.x; sn[1] = s0.y; sn[2] = s0.z; sn[3] = s0.w; sn[4] = s1.x; sn[5] = s1.y; sn[6] = s1.z; sn[7] = s1.w; }
    const int ng = lat ? 5 : 1;
#pragma unroll
    for (int g = 0; g < 5; ++g) {
      if (g < ng) {
        const v4u rv = raw[g];
        float v[8] = {__uint_as_float(rv.x << 16), __uint_as_float(rv.x & 0xffff0000u), __uint_as_float(rv.y << 16), __uint_as_float(rv.y & 0xffff0000u), __uint_as_float(rv.z << 16), __uint_as_float(rv.z & 0xffff0000u), __uint_as_float(rv.w << 16), __uint_as_float(rv.w & 0xffff0000u)};
        float ss = 0.f;
#pragma unroll
        for (int e = 0; e < 8; ++e) ss += v[e] * v[e];
        ss += __shfl_xor(ss, 1); ss += __shfl_xor(ss, 2); ss += __shfl_xor(ss, 4); ss += __shfl_xor(ss, 8);
        const float rstd = rsqrtf(ss * (1.f / 128.f) + EPS);
#pragma unroll
        for (int e = 0; e < 8; ++e) v[e] *= rstd * (g == 0 ? gk[e] : gq[e]);
        if (lat) {
#pragma unroll
          for (int e = 0; e < 8; ++e) { const float o = __shfl_xor(v[e], 4); v[e] = sgn ? (v[e] * cs[e] + o * sn[e]) : (v[e] * cs[e] - o * sn[e]); }
        }
        v4u ov; ov.x = pk2(v[0], v[1]); ov.y = pk2(v[2], v[3]); ov.z = pk2(v[4], v[5]); ov.w = pk2(v[6], v[7]);
        if (wr) { if (g == 0) *(v4u*)(K1 + (size_t)row * 512 + hl * 128 + d0) = ov; else *(v4u*)(Q1 + (size_t)row * 2048 + ((g - 1) * 4 + hl) * 128 + d0) = ov; }
      }
    }
  }
}
typedef short s16x4 __attribute__((ext_vector_type(4)));
DEV s16x4 tr_read(const LAS bf16_t* p) { return __builtin_bit_cast(s16x4, __builtin_amdgcn_ds_read_tr16_b64_v4i16((LAS s16x4*)p)); }
DEV void attn_phase(bf16_t* Q1, const bf16_t* K1, const bf16_t* V1, const bf16_t* G1, const float* sink, const float* qn, const float* kn, LAS unsigned char* lds, bool wr) {
  constexpr int KP = 136, VP = 144;
  LAS bf16_t* Ks = (LAS bf16_t*)lds;
  LAS bf16_t* Vs = (LAS bf16_t*)(lds + 2 * 64 * KP * 2);
  LAS float* dsc = (LAS float*)(lds + 2 * 64 * KP * 2 + 2 * 64 * VP * 2);
  const int tid = threadIdx.x, lane = tid & 63, wid = tid >> 6, r = lane & 15, Qd = lane >> 4;
  float mb;
  { float a = fmaxf(fabsf(qn[lane]), fabsf(qn[64 + lane])), b = fmaxf(fabsf(kn[lane]), fabsf(kn[64 + lane]));
#pragma unroll
    for (int o = 1; o < 64; o <<= 1) { a = fmaxf(a, __shfl_xor(a, o)); b = fmaxf(b, __shfl_xor(b, o)); }
    mb = a * b * 11.313708498984761f * 1.4426950408889634f; }
  for (int task = virt_block(); task < 1024; task += gridDim.x) {
    const int b = task >> 9, kvh = (task >> 7) & 3, qt = task & 127;
    const int hq = kvh * 4 + (wid >> 1), qoff = (wid & 1) * 32;
    const size_t qrow0 = (size_t)b * SEQ + qt * 64 + qoff;
    bf16x8 qf[2][4];
#pragma unroll
    for (int m = 0; m < 2; ++m)
#pragma unroll
      for (int ks = 0; ks < 4; ++ks) qf[m][ks] = *(const bf16x8*)(Q1 + (qrow0 + 16 * m + r) * 2048 + hq * 128 + ks * 32 + 8 * Qd);
    const int tlo = (2 - qt) > 0 ? (2 - qt) : 0, thi = (129 - qt) < 4 ? (129 - qt) : 4, nband = thi - tlo + 1, ntile = nband + 4;
    const int skey = tid >> 4, sch = tid & 15;
    float gk[8];
    { const int dA = ((sch >> 2) >> 1) * 64 + 16 * ((sch >> 2) & 1) + 4 * (sch & 3); const f32x4 ga = *(const f32x4*)(kn + dA), gb_ = *(const f32x4*)(kn + dA + 32);
      gk[0] = ga.x; gk[1] = ga.y; gk[2] = ga.z; gk[3] = ga.w; gk[4] = gb_.x; gk[5] = gb_.y; gk[6] = gb_.z; gk[7] = gb_.w; }
    v4u kreg[2], vreg[2];
#define TILE_ROW0(i) ((i) < nband ? (size_t)b * SEQ + (size_t)(qt - 2 + tlo + (i)) * 64 : (size_t)ML + b * CTXL + ((i) - nband) * 64)
#define LOAD_TILE(i) do { const size_t r0_ = TILE_ROW0(i); _Pragma("unroll") for (int h_ = 0; h_ < 2; ++h_) { const size_t go_ = (r0_ + skey + 32 * h_) * 512 + kvh * 128 + sch * 8; kreg[h_] = *(const v4u*)(K1 + go_); vreg[h_] = *(const v4u*)(V1 + go_); } } while (0)
#define STORE_TILE(buf, ti) do { const bool ctx_ = (ti) >= nband; _Pragma("unroll") for (int h_ = 0; h_ < 2; ++h_) { v4u kw_ = kreg[h_]; \
      if (ctx_) { float v_[8] = {__uint_as_float(kw_.x << 16), __uint_as_float(kw_.x & 0xffff0000u), __uint_as_float(kw_.y << 16), __uint_as_float(kw_.y & 0xffff0000u), __uint_as_float(kw_.z << 16), __uint_as_float(kw_.z & 0xffff0000u), __uint_as_float(kw_.w << 16), __uint_as_float(kw_.w & 0xffff0000u)}; \
        float ss_ = 0.f; _Pragma("unroll") for (int e_ = 0; e_ < 8; ++e_) ss_ += v_[e_] * v_[e_]; \
        ss_ += __shfl_xor(ss_, 1); ss_ += __shfl_xor(ss_, 2); ss_ += __shfl_xor(ss_, 4); ss_ += __shfl_xor(ss_, 8); \
        const float rs_ = rsqrtf(ss_ * (1.f / 128.f) + EPS); _Pragma("unroll") for (int e_ = 0; e_ < 8; ++e_) v_[e_] *= rs_ * gk[e_]; \
        kw_.x = pk2(v_[0], v_[1]); kw_.y = pk2(v_[2], v_[3]); kw_.z = pk2(v_[4], v_[5]); kw_.w = pk2(v_[6], v_[7]); } \
      *(LAS v4u*)(Ks + (buf) * 64 * KP + (skey + 32 * h_) * KP + sch * 8) = kw_; *(LAS v4u*)(Vs + (buf) * 64 * VP + (skey + 32 * h_) * VP + sch * 8) = vreg[h_]; } } while (0)
    LOAD_TILE(0);
    __syncthreads();
    STORE_TILE(0, 0);
    __syncthreads();
    f32x4 o[2][8];
#pragma unroll
    for (int m = 0; m < 2; ++m)
#pragma unroll
      for (int n = 0; n < 8; ++n) o[m][n] = (f32x4){0.f, 0.f, 0.f, 0.f};
    float lsum[2] = {0.f, 0.f};
    for (int i = 0; i < ntile; ++i) {
      const int buf = i & 1;
      if (i + 1 < ntile) LOAD_TILE(i + 1);
      const int mtype = (i < nband) ? ((tlo + i) == 0 ? 1 : ((tlo + i) == 4 ? 2 : 0)) : 0;
      const LAS bf16_t* Kb = Ks + buf * 64 * KP; const LAS bf16_t* Vb = Vs + buf * 64 * VP;
      f32x4 s[4][2];
#pragma unroll
      for (int t = 0; t < 4; ++t) { s[t][0] = (f32x4){-mb, -mb, -mb, -mb}; s[t][1] = (f32x4){-mb, -mb, -mb, -mb}; }
#pragma unroll
      for (int ks = 0; ks < 4; ++ks)
#pragma unroll
        for (int t = 0; t < 4; ++t) { const bf16x8 kf = *(const LAS bf16x8*)(Kb + (16 * t + r) * KP + ks * 32 + 8 * Qd);
          s[t][0] = __builtin_amdgcn_mfma_f32_16x16x32_bf16(kf, qf[0][ks], s[t][0], 0, 0, 0);
          s[t][1] = __builtin_amdgcn_mfma_f32_16x16x32_bf16(kf, qf[1][ks], s[t][1], 0, 0, 0); }
      bf16x8 pa[2][2];
#pragma unroll
      for (int m = 0; m < 2; ++m) { const int qi = qoff + 16 * m + r;
#pragma unroll
        for (int t = 0; t < 4; ++t) {
          float pv[4];
#pragma unroll
          for (int j = 0; j < 4; ++j) { const int kj = 16 * t + 4 * Qd + j; float pj = __builtin_amdgcn_exp2f(s[t][m][j]);
            if (mtype != 0) { if (mtype == 1) pj = (kj >= qi) ? pj : 0.f; else pj = (kj <= qi) ? pj : 0.f; }
            pv[j] = pj; lsum[m] += pj; }
          const unsigned w0 = pk2(pv[0], pv[1]), w1 = pk2(pv[2], pv[3]);
          pa[m][t >> 1][(t & 1) * 4 + 0] = (short)(w0 & 0xffff); pa[m][t >> 1][(t & 1) * 4 + 1] = (short)(w0 >> 16);
          pa[m][t >> 1][(t & 1) * 4 + 2] = (short)(w1 & 0xffff); pa[m][t >> 1][(t & 1) * 4 + 3] = (short)(w1 >> 16); } }
#pragma unroll
      for (int k2 = 0; k2 < 2; ++k2)
#pragma unroll
        for (int n = 0; n < 8; ++n) {
          const s16x4 lo = tr_read(Vb + (32 * k2 + 4 * Qd + (r >> 2)) * VP + 16 * n + 4 * (r & 3));
          const s16x4 hi = tr_read(Vb + (32 * k2 + 16 + 4 * Qd + (r >> 2)) * VP + 16 * n + 4 * (r & 3));
          const bf16x8 vf = (bf16x8){lo[0], lo[1], lo[2], lo[3], hi[0], hi[1], hi[2], hi[3]};
          o[0][n] = __builtin_amdgcn_mfma_f32_16x16x32_bf16(pa[0][k2], vf, o[0][n], 0, 0, 0);
          o[1][n] = __builtin_amdgcn_mfma_f32_16x16x32_bf16(pa[1][k2], vf, o[1][n], 0, 0, 0); }
      if (i + 1 < ntile) STORE_TILE(buf ^ 1, i + 1);
      __syncthreads();
    }
#undef TILE_ROW0
#undef LOAD_TILE
#undef STORE_TILE
    const float sk = __builtin_amdgcn_exp2f(sink[hq] * 1.4426950408889634f - mb);
#pragma unroll
    for (int m = 0; m < 2; ++m) { float l = lsum[m]; l += __shfl_xor(l, 16); l += __shfl_xor(l, 32); if (Qd == 0) dsc[wid * 32 + 16 * m + r] = 1.f / (l + sk); }
    LDS_WAIT(); asm volatile("" ::: "memory");
    { LAS bf16_t* stg = (LAS bf16_t*)lds + wid * 32 * 136;
#pragma unroll
      for (int m = 0; m < 2; ++m)
#pragma unroll
        for (int j = 0; j < 4; ++j) { const float inv = dsc[wid * 32 + 16 * m + 4 * Qd + j];
#pragma unroll
          for (int n = 0; n < 8; ++n) stg[(16 * m + 4 * Qd + j) * 136 + 16 * n + r] = f2bf(o[m][n][j] * inv); }
      LDS_WAIT(); asm volatile("" ::: "memory");
#pragma unroll
      for (int q = 0; q < 8; ++q) { const int c = lane + 64 * q, rowl = c >> 4, ch = c & 15; const size_t go = (qrow0 + rowl) * 2048 + hq * 128 + ch * 8;
        const v4u ov = *(const LAS v4u*)(stg + rowl * 136 + ch * 8), gv = *(const v4u*)(G1 + go);
        v4u w; w.x = pk2(__uint_as_float(ov.x << 16) * __uint_as_float(gv.x << 16), __uint_as_float(ov.x & 0xffff0000u) * __uint_as_float(gv.x & 0xffff0000u));
        w.y = pk2(__uint_as_float(ov.y << 16) * __uint_as_float(gv.y << 16), __uint_as_float(ov.y & 0xffff0000u) * __uint_as_float(gv.y & 0xffff0000u));
        w.z = pk2(__uint_as_float(ov.z << 16) * __uint_as_float(gv.z << 16), __uint_as_float(ov.z & 0xffff0000u) * __uint_as_float(gv.z & 0xffff0000u));
        w.w = pk2(__uint_as_float(ov.w << 16) * __uint_as_float(gv.w << 16), __uint_as_float(ov.w & 0xffff0000u) * __uint_as_float(gv.w & 0xffff0000u));
        if (wr) *(v4u*)(Q1 + go) = w; }
      LDS_WAIT(); asm volatile("" ::: "memory"); }
  }
}

constexpr size_t DO_SDT = 50 * MiB, DO_SCS = 53 * MiB;
constexpr size_t WS_SSQ = 237 * MiB;
DEV unsigned short bfbits(float f) { return f2bf(f); }
DEV void ssd_prep_phase(const bf16_t* XBC, const float* cw, const float* cb, bf16_t* XC, const float* DTLR, const float* dt_bias, const float* a_log, float* SDT, float* SCS, float* SDEC) {
  const int gtid = blockIdx.x * 512 + threadIdx.x, gth = gridDim.x * 512;
  for (int it = gtid; it < (MA / 32) * 192; it += gth) {
    const int rg = it / 192, c8 = (it % 192) * 8, row0 = rg * 32;
    int t0, len;
    if (row0 < ML) { t0 = row0 % SEQ; len = SEQ; } else { t0 = (row0 - ML) % CTXL; len = CTXL; }
    float w[5][8], bias[8];
#pragma unroll
    for (int k = 0; k < 5; ++k) { const f32x4 w0 = *(const f32x4*)(cw + k * 1536 + c8), w1 = *(const f32x4*)(cw + k * 1536 + c8 + 4);
      w[k][0] = w0.x; w[k][1] = w0.y; w[k][2] = w0.z; w[k][3] = w0.w; w[k][4] = w1.x; w[k][5] = w1.y; w[k][6] = w1.z; w[k][7] = w1.w; }
    { const f32x4 b0 = *(const f32x4*)(cb + c8), b1 = *(const f32x4*)(cb + c8 + 4); bias[0] = b0.x; bias[1] = b0.y; bias[2] = b0.z; bias[3] = b0.w; bias[4] = b1.x; bias[5] = b1.y; bias[6] = b1.z; bias[7] = b1.w; }
    const v4u zero4 = {0u, 0u, 0u, 0u};
    v4u win[4];
#pragma unroll
    for (int q = 0; q < 4; ++q) { const int tt = t0 - 2 + q; win[q] = (tt >= 0 && tt < len) ? *(const v4u*)(XBC + (size_t)(row0 - 2 + q) * 1536 + c8) : zero4; }
#pragma unroll 4
    for (int i = 0; i < 32; ++i) {
      const int tt = t0 + i + 2; const v4u nx = (tt < len) ? *(const v4u*)(XBC + (size_t)(row0 + i + 2) * 1536 + c8) : zero4;
      float acc[8];
#pragma unroll
      for (int e = 0; e < 8; ++e) acc[e] = bias[e];
#define CONV_TAP(k, xv) do { acc[0] += w[k][0] * __uint_as_float((xv).x << 16); acc[1] += w[k][1] * __uint_as_float((xv).x & 0xffff0000u); acc[2] += w[k][2] * __uint_as_float((xv).y << 16); acc[3] += w[k][3] * __uint_as_float((xv).y & 0xffff0000u); \
        acc[4] += w[k][4] * __uint_as_float((xv).z << 16); acc[5] += w[k][5] * __uint_as_float((xv).z & 0xffff0000u); acc[6] += w[k][6] * __uint_as_float((xv).w << 16); acc[7] += w[k][7] * __uint_as_float((xv).w & 0xffff0000u); } while (0)
      CONV_TAP(0, win[0]); CONV_TAP(1, win[1]); CONV_TAP(2, win[2]); CONV_TAP(3, win[3]); CONV_TAP(4, nx);
#undef CONV_TAP
      v4u o; o.x = pk2(silu_fast(acc[0]), silu_fast(acc[1])); o.y = pk2(silu_fast(acc[2]), silu_fast(acc[3])); o.z = pk2(silu_fast(acc[4]), silu_fast(acc[5])); o.w = pk2(silu_fast(acc[6]), silu_fast(acc[7]));
      *(v4u*)(XC + (size_t)(row0 + i) * 1536 + c8) = o;
      win[0] = win[1]; win[1] = win[2]; win[2] = win[3]; win[3] = nx;
    }
  }
  {
    const int lane = threadIdx.x & 63, wave = threadIdx.x >> 6, cl = lane & 7, seg = lane >> 3;
    for (int wt = blockIdx.x * NWAVES + wave; wt < NCH * 4; wt += gridDim.x * NWAVES) {
      const int gc = wt >> 2, col = (wt & 3) * 8 + cl, dir = col >> 4, h = col & 15;
      const float a = -fexp(a_log[col]), bias = dt_bias[col];
      float dtv[16], v[16]; float run = 0.f;
#pragma unroll
      for (int u = 0; u < 16; ++u) { const int s = seg * 16 + u, t = dir ? 127 - s : s; dtv[u] = softplusf(DTLR[((size_t)gc * 128 + t) * 64 + col] + bias); }
#pragma unroll
      for (int u = 0; u < 16; ++u) { run += dtv[u] * a; v[u] = run; }
      float off = 0.f;
#pragma unroll
      for (int sgi = 0; sgi < 7; ++sgi) { const float tot = __shfl(run, cl + 8 * sgi); off += (sgi < seg) ? tot : 0.f; }
#pragma unroll
      for (int u = 0; u < 16; ++u) { const int s = seg * 16 + u, t = dir ? 127 - s : s; const size_t row = (size_t)gc * 128 + t; SDT[row * 32 + col] = dtv[u]; SCS[row * 32 + col] = v[u] + off; }
      if (seg == 7) SDEC[(gc * 16 + h) * 2 + dir] = fexp(run + off);
    }
  }
}
DEV void ssd_u_phase(const bf16_t* XC, const float* SDT, const float* SCS, bf16_t* ST, LAS unsigned char* lds) {
  constexpr int XP = 272, BP = 144;
  LAS bf16_t* Xs = (LAS bf16_t*)lds; LAS bf16_t* Bs = (LAS bf16_t*)(lds + 128 * XP * 2); LAS float* wtab = (LAS float*)(lds + 128 * XP * 2 + 128 * BP * 2);
  const int tid = threadIdx.x, lane = tid & 63, wid = tid >> 6, r = lane & 15, Qd = lane >> 4, hl = wid >> 1, dir = wid & 1;
  for (int task = virt_block(); task < NCH * 4; task += gridDim.x) {
    const int gc = task >> 2, g = (task >> 1) & 1, hh = task & 1; const size_t r0 = (size_t)gc * 128; const int h0 = g * 8 + hh * 4;
    __syncthreads();
#pragma unroll
    for (int i = 0; i < 8; ++i) { const int cid = tid + 512 * i, row = cid >> 5, ch = cid & 31; *(LAS v4u*)(Xs + row * XP + ch * 8) = *(const v4u*)(XC + (r0 + row) * 1536 + h0 * 64 + ch * 8); }
#pragma unroll
    for (int i = 0; i < 4; ++i) { const int cid = tid + 512 * i, row = cid >> 4, ch = cid & 15; *(LAS v4u*)(Bs + row * BP + ch * 8) = *(const v4u*)(XC + (r0 + row) * 1536 + 1024 + g * 128 + ch * 8); }
    if (tid < 256) { const int d_ = tid >> 7, t = tid & 127;
      const f32x4 ce = *(const f32x4*)(SCS + (r0 + (d_ ? 0 : 127)) * 32 + d_ * 16 + h0), ct = *(const f32x4*)(SCS + (r0 + t) * 32 + d_ * 16 + h0), dt = *(const f32x4*)(SDT + (r0 + t) * 32 + d_ * 16 + h0);
      wtab[(0 * 2 + d_) * 128 + t] = fexp(ce.x - ct.x) * dt.x; wtab[(1 * 2 + d_) * 128 + t] = fexp(ce.y - ct.y) * dt.y; wtab[(2 * 2 + d_) * 128 + t] = fexp(ce.z - ct.z) * dt.z; wtab[(3 * 2 + d_) * 128 + t] = fexp(ce.w - ct.w) * dt.w; }
    __syncthreads();
    const LAS float* wt = wtab + wid * 128;
    bf16_t* Sp = ST + ((((size_t)gc * 16 + h0 + hl) * 2 + dir) * 64) * 128;
#pragma unroll 1
    for (int pp = 0; pp < 2; ++pp) {
      f32x4 acc[8][2];
#pragma unroll
      for (int nt = 0; nt < 8; ++nt) { acc[nt][0] = (f32x4){0.f, 0.f, 0.f, 0.f}; acc[nt][1] = (f32x4){0.f, 0.f, 0.f, 0.f}; }
#pragma unroll 1
      for (int k = 0; k < 4; ++k) {
        const f32x4 wlo = *(const LAS f32x4*)(wt + 32 * k + 4 * Qd), whi = *(const LAS f32x4*)(wt + 32 * k + 16 + 4 * Qd);
        bf16x8 xf[2];
#pragma unroll
        for (int pt = 0; pt < 2; ++pt) {
          const s16x4 lo = tr_read(Xs + (32 * k + 4 * Qd + (r >> 2)) * XP + hl * 64 + 32 * pp + 16 * pt + 4 * (r & 3));
          const s16x4 hi = tr_read(Xs + (32 * k + 16 + 4 * Qd + (r >> 2)) * XP + hl * 64 + 32 * pp + 16 * pt + 4 * (r & 3));
          const unsigned w0 = pk2(bf2f((bf16_t)lo[0]) * wlo[0], bf2f((bf16_t)lo[1]) * wlo[1]), w1 = pk2(bf2f((bf16_t)lo[2]) * wlo[2], bf2f((bf16_t)lo[3]) * wlo[3]);
          const unsigned w2 = pk2(bf2f((bf16_t)hi[0]) * whi[0], bf2f((bf16_t)hi[1]) * whi[1]), w3 = pk2(bf2f((bf16_t)hi[2]) * whi[2], bf2f((bf16_t)hi[3]) * whi[3]);
          xf[pt] = (bf16x8){(short)(w0 & 0xffff), (short)(w0 >> 16), (short)(w1 & 0xffff), (short)(w1 >> 16), (short)(w2 & 0xffff), (short)(w2 >> 16), (short)(w3 & 0xffff), (short)(w3 >> 16)};
        }
#pragma unroll
        for (int nt = 0; nt < 8; ++nt) {
          const s16x4 lo = tr_read(Bs + (32 * k + 4 * Qd + (r >> 2)) * BP + 16 * nt + 4 * (r & 3));
          const s16x4 hi = tr_read(Bs + (32 * k + 16 + 4 * Qd + (r >> 2)) * BP + 16 * nt + 4 * (r & 3));
          const bf16x8 bfr = (bf16x8){lo[0], lo[1], lo[2], lo[3], hi[0], hi[1], hi[2], hi[3]};
          acc[nt][0] = __builtin_amdgcn_mfma_f32_16x16x32_bf16(bfr, xf[0], acc[nt][0], 0, 0, 0);
          acc[nt][1] = __builtin_amdgcn_mfma_f32_16x16x32_bf16(bfr, xf[1], acc[nt][1], 0, 0, 0);
        }
      }
#pragma unroll
      for (int nt = 0; nt < 8; ++nt)
#pragma unroll
        for (int pt = 0; pt < 2; ++pt) { const f32x4 v = acc[nt][pt];
          *(unsigned long long*)(Sp + ((((2 * pp + pt) * 4 + (nt >> 1)) * 64 + ((nt & 1) * 2 + (Qd >> 1)) * 16 + r) * 8 + 4 * (Qd & 1))) = (unsigned long long)pk2(v[0], v[1]) | ((unsigned long long)pk2(v[2], v[3]) << 32); }
    }
  }
}
DEV void ssd_scan_phase(bf16_t* ST, const float* SDEC, bool wr) {
  for (int item = blockIdx.x * 512 + threadIdx.x; item < 2 * 16 * 2 * 2048; item += gridDim.x * 512) {
    const int e4 = item & 2047, dir = (item >> 11) & 1, h = (item >> 12) & 15, b = item >> 16;
    float S0 = 0.f, S1 = 0.f, S2 = 0.f, S3 = 0.f;
#define SCAN_GC(s) (!dir ? ((s) < 2 ? 128 + 2 * b + (s) : b * 64 + ((s) - 2)) : ((s) < 2 ? 128 + 2 * b + (1 - (s)) : b * 64 + (65 - (s))))
    for (int s0 = 0; s0 < 66; s0 += 6) {
      unsigned long long u[6]; float dec[6];
#pragma unroll
      for (int q = 0; q < 6; ++q) { const int gc = SCAN_GC(s0 + q); u[q] = *(const unsigned long long*)(ST + (((size_t)gc * 16 + h) * 2 + dir) * 8192 + e4 * 4); dec[q] = SDEC[(gc * 16 + h) * 2 + dir]; }
#pragma unroll
      for (int q = 0; q < 6; ++q) { const int gc = SCAN_GC(s0 + q);
        if (wr) *(unsigned long long*)(ST + (((size_t)gc * 16 + h) * 2 + dir) * 8192 + e4 * 4) = (unsigned long long)pk2(S0, S1) | ((unsigned long long)pk2(S2, S3) << 32);
        const unsigned lo = (unsigned)u[q], hi = (unsigned)(u[q] >> 32);
        S0 = dec[q] * S0 + __uint_as_float(lo << 16); S1 = dec[q] * S1 + __uint_as_float(lo & 0xffff0000u); S2 = dec[q] * S2 + __uint_as_float(hi << 16); S3 = dec[q] * S3 + __uint_as_float(hi & 0xffff0000u); }
    }
#undef SCAN_GC
  }
}
DEV bf16x8 scale_frag(bf16x8 f, float s) {
  bf16x8 o;
#pragma unroll
  for (int e = 0; e < 8; e += 2) { const unsigned w = pk2(bf2f((bf16_t)f[e]) * s, bf2f((bf16_t)f[e + 1]) * s); o[e] = (short)(w & 0xffff); o[e + 1] = (short)(w >> 16); }
  return o;
}
DEV void ssd_y_phase(const bf16_t* XC, const float* SDT, const float* SCS, const bf16_t* ST, const float* d_skip, bf16_t* Y0, float* SSQ, LAS unsigned char* lds, bool wr) {
  constexpr int XP = 272, BP = 136, SP = 72;
  LAS bf16_t* Xs = (LAS bf16_t*)lds; LAS bf16_t* Bs = (LAS bf16_t*)(lds + 128 * XP * 2);
  LAS float* tab = (LAS float*)(lds + 128 * XP * 2 + 128 * BP * 2);
  LAS float* ssq = tab + 4 * 4 * 128;
  LAS bf16_t* stg = (LAS bf16_t*)(ssq + 4 * 128);
  const int tid = threadIdx.x, lane = tid & 63, wid = tid >> 6, r = lane & 15, Qd = lane >> 4, hl = wid >> 1, ih = wid & 1;
  LAS bf16_t* mystg = stg + wid * 16 * SP;
  for (int task = virt_block(); task < NCH * 4; task += gridDim.x) {
    const int gc = task >> 2, g = (task >> 1) & 1, hh = task & 1; const size_t r0 = (size_t)gc * 128; const int h0 = g * 8 + hh * 4, h = h0 + hl;
    bf16x8 cstrip[4], cf[4][4];
#pragma unroll
    for (int ks = 0; ks < 4; ++ks) cstrip[ks] = *(const bf16x8*)(XC + (r0 + 16 * wid + r) * 1536 + 1280 + g * 128 + 32 * ks + 8 * Qd);
#pragma unroll
    for (int m = 0; m < 4; ++m)
#pragma unroll
      for (int ks = 0; ks < 4; ++ks) cf[m][ks] = *(const bf16x8*)(XC + (r0 + 64 * ih + 16 * m + r) * 1536 + 1280 + g * 128 + 32 * ks + 8 * Qd);
    __syncthreads();
#pragma unroll
    for (int i = 0; i < 8; ++i) { const int cid = tid + 512 * i, row = cid >> 5, ch = cid & 31; *(LAS v4u*)(Xs + row * XP + ch * 8) = *(const v4u*)(XC + (r0 + row) * 1536 + h0 * 64 + ch * 8); }
#pragma unroll
    for (int i = 0; i < 4; ++i) { const int cid = tid + 512 * i, row = cid >> 4, ch = cid & 15; *(LAS v4u*)(Bs + row * BP + ch * 8) = *(const v4u*)(XC + (r0 + row) * 1536 + 1024 + g * 128 + ch * 8); }
    { const int which = tid >> 7, t = tid & 127; const f32x4 v = *(const f32x4*)((which < 2 ? SCS : SDT) + (r0 + t) * 32 + (which & 1) * 16 + h0);
      tab[0 * 512 + which * 128 + t] = v.x; tab[1 * 512 + which * 128 + t] = v.y; tab[2 * 512 + which * 128 + t] = v.z; tab[3 * 512 + which * 128 + t] = v.w; }
    __syncthreads();
    {
      f32x4 cb[8];
#pragma unroll
      for (int t = 0; t < 8; ++t) { f32x4 c = {0.f, 0.f, 0.f, 0.f};
#pragma unroll
        for (int ks = 0; ks < 4; ++ks) { const bf16x8 bfr = *(const LAS bf16x8*)(Bs + (16 * t + r) * BP + 32 * ks + 8 * Qd); c = __builtin_amdgcn_mfma_f32_16x16x32_bf16(bfr, cstrip[ks], c, 0, 0, 0); }
        cb[t] = c; }
      __syncthreads();
#pragma unroll
      for (int t = 0; t < 8; ++t) *(LAS unsigned long long*)(Bs + (16 * wid + r) * BP + 16 * t + 4 * Qd) = (unsigned long long)pk2(cb[t][0], cb[t][1]) | ((unsigned long long)pk2(cb[t][2], cb[t][3]) << 32);
      __syncthreads();
    }
    const LAS float* csf = tab + hl * 512; const LAS float* csb = csf + 128; const LAS float* dtf = csf + 256; const LAS float* dtb = csf + 384;
    const float dsk = d_skip[h];
    f32x4 y[4][4];
#pragma unroll
    for (int m = 0; m < 4; ++m)
#pragma unroll
      for (int pt = 0; pt < 4; ++pt) y[m][pt] = (f32x4){0.f, 0.f, 0.f, 0.f};
    if (wr || !(PROBE_SKIP & 1))
#pragma unroll 1
    for (int dir = 0; dir < 2; ++dir) {
      const LAS float* csd = dir ? csb : csf; float sc[4];
#pragma unroll
      for (int m = 0; m < 4; ++m)
#pragma unroll
        for (int ks = 0; ks < 4; ++ks) asm volatile("" : "+v"(cf[m][ks]));
#pragma unroll
      for (int m = 0; m < 4; ++m) sc[m] = fexp(csd[64 * ih + 16 * m + r]);
      const bf16_t* Sp = ST + (((size_t)gc * 16 + h) * 2 + dir) * 8192 + lane * 8;
#pragma unroll
      for (int ks = 0; ks < 4; ++ks) {
        bf16x8 sf[4];
#pragma unroll
        for (int pt = 0; pt < 4; ++pt) sf[pt] = *(const bf16x8*)(Sp + (pt * 4 + ks) * 512);
#pragma unroll
        for (int m = 0; m < 4; ++m) { const bf16x8 a = scale_frag(cf[m][ks], sc[m]);
#pragma unroll
          for (int pt = 0; pt < 4; ++pt) y[m][pt] = __builtin_amdgcn_mfma_f32_16x16x32_bf16(a, sf[pt], y[m][pt], 0, 0, 0);
          __builtin_amdgcn_sched_barrier(0); }
      }
    }
#pragma unroll 1
    for (int m = 0; m < 4; ++m) {
      const int i0 = 64 * ih + 16 * m, i = i0 + r;
      const float cfi = csf[i], cbi = csb[i];
      v4u zpre[2];
#pragma unroll
      for (int q = 0; q < 2; ++q) { const int c = lane + 64 * q; zpre[q] = *(const v4u*)(Y0 + (r0 + i0 + (c >> 3)) * 2048 + h * 64 + (c & 7) * 8); }
      if (wr || !(PROBE_SKIP & 2))
#pragma unroll 1
      for (int k2 = 0; k2 < 4; ++k2) {
        const int j0 = 32 * k2 + 8 * Qd;
        const v4u cbv = *(const LAS v4u*)(Bs + i * BP + j0);
        const float cbe[8] = {__uint_as_float(cbv.x << 16), __uint_as_float(cbv.x & 0xffff0000u), __uint_as_float(cbv.y << 16), __uint_as_float(cbv.y & 0xffff0000u), __uint_as_float(cbv.z << 16), __uint_as_float(cbv.z & 0xffff0000u), __uint_as_float(cbv.w << 16), __uint_as_float(cbv.w & 0xffff0000u)};
        float pv[8];
        const bool dofwd = (32 * k2 <= i0 + 15), dobwd = (32 * k2 + 31 >= i0);
#pragma unroll
        for (int e = 0; e < 8; ++e) pv[e] = (j0 + e == i) ? dsk : 0.f;
        if (dofwd) { const f32x4 a0 = *(const LAS f32x4*)(csf + j0), a1 = *(const LAS f32x4*)(csf + j0 + 4), d0 = *(const LAS f32x4*)(dtf + j0), d1 = *(const LAS f32x4*)(dtf + j0 + 4);
          const float jc[8] = {a0.x, a0.y, a0.z, a0.w, a1.x, a1.y, a1.z, a1.w}; const float jd[8] = {d0.x, d0.y, d0.z, d0.w, d1.x, d1.y, d1.z, d1.w};
#pragma unroll
          for (int e = 0; e < 8; ++e) pv[e] += cbe[e] * fexp(j0 + e <= i ? cfi - jc[e] : -INFINITY) * jd[e]; }
        if (dobwd) { const f32x4 a0 = *(const LAS f32x4*)(csb + j0), a1 = *(const LAS f32x4*)(csb + j0 + 4), d0 = *(const LAS f32x4*)(dtb + j0), d1 = *(const LAS f32x4*)(dtb + j0 + 4);
          const float jc[8] = {a0.x, a0.y, a0.z, a0.w, a1.x, a1.y, a1.z, a1.w}; const float jd[8] = {d0.x, d0.y, d0.z, d0.w, d1.x, d1.y, d1.z, d1.w};
#pragma unroll
          for (int e = 0; e < 8; ++e) pv[e] += cbe[e] * fexp(j0 + e >= i ? cbi - jc[e] : -INFINITY) * jd[e]; }
        const unsigned w0 = pk2(pv[0], pv[1]), w1 = pk2(pv[2], pv[3]), w2 = pk2(pv[4], pv[5]), w3 = pk2(pv[6], pv[7]);
        const bf16x8 pa = (bf16x8){(short)(w0 & 0xffff), (short)(w0 >> 16), (short)(w1 & 0xffff), (short)(w1 >> 16), (short)(w2 & 0xffff), (short)(w2 >> 16), (short)(w3 & 0xffff), (short)(w3 >> 16)};
#pragma unroll
        for (int pt = 0; pt < 4; ++pt) {
          const s16x4 lo = tr_read(Xs + (32 * k2 + 8 * Qd + (r >> 2)) * XP + hl * 64 + 16 * pt + 4 * (r & 3));
          const s16x4 hi = tr_read(Xs + (32 * k2 + 8 * Qd + 4 + (r >> 2)) * XP + hl * 64 + 16 * pt + 4 * (r & 3));
          const bf16x8 xf = (bf16x8){lo[0], lo[1], lo[2], lo[3], hi[0], hi[1], hi[2], hi[3]};
          y[0][pt] = __builtin_amdgcn_mfma_f32_16x16x32_bf16(pa, xf, y[0][pt], 0, 0, 0);
        }
      }
      if (wr || !(PROBE_SKIP & 4)) {
#pragma unroll
      for (int pt = 0; pt < 4; ++pt)
#pragma unroll
        for (int jj = 0; jj < 4; ++jj) mystg[(4 * Qd + jj) * SP + 16 * pt + r] = f2bf(y[0][pt][jj]);
      LDS_WAIT(); asm volatile("" ::: "memory");
#pragma unroll
      for (int q = 0; q < 2; ++q) { const int c = lane + 64 * q, rowl = c >> 3, ch = c & 7; const int il = 64 * ih + 16 * m + rowl;
        const v4u yv = *(const LAS v4u*)(mystg + rowl * SP + ch * 8); bf16_t* zp = Y0 + (r0 + il) * 2048 + h * 64 + ch * 8; const v4u zv = zpre[q];
        const float v0 = __uint_as_float(yv.x << 16) * __uint_as_float(zv.x << 16), v1 = __uint_as_float(yv.x & 0xffff0000u) * __uint_as_float(zv.x & 0xffff0000u);
        const float v2 = __uint_as_float(yv.y << 16) * __uint_as_float(zv.y << 16), v3 = __uint_as_float(yv.y & 0xffff0000u) * __uint_as_float(zv.y & 0xffff0000u);
        const float v4 = __uint_as_float(yv.z << 16) * __uint_as_float(zv.z << 16), v5 = __uint_as_float(yv.z & 0xffff0000u) * __uint_as_float(zv.z & 0xffff0000u);
        const float v6 = __uint_as_float(yv.w << 16) * __uint_as_float(zv.w << 16), v7 = __uint_as_float(yv.w & 0xffff0000u) * __uint_as_float(zv.w & 0xffff0000u);
        float ss = (v0 * v0 + v1 * v1) + (v2 * v2 + v3 * v3) + (v4 * v4 + v5 * v5) + (v6 * v6 + v7 * v7);
        ss += __shfl_xor(ss, 1); ss += __shfl_xor(ss, 2); ss += __shfl_xor(ss, 4);
        v4u ov; ov.x = pk2(v0, v1); ov.y = pk2(v2, v3); ov.z = pk2(v4, v5); ov.w = pk2(v6, v7);
        if (wr) *(v4u*)zp = ov;
        if (ch == 0) ssq[hl * 128 + il] = ss; }
      LDS_WAIT(); asm volatile("" ::: "memory");
      }
#pragma unroll
      for (int pt = 0; pt < 4; ++pt) { y[0][pt] = y[1][pt]; y[1][pt] = y[2][pt]; y[2][pt] = y[3][pt]; }
    }
    __syncthreads();
    if (tid < 128) SSQ[((r0 + tid) * 2 + g) * 2 + hh] = (ssq[tid] + ssq[128 + tid]) + (ssq[256 + tid] + ssq[384 + tid]);
  }
}

typedef _Float16 h16_t;
typedef _Float16 h16x8 __attribute__((ext_vector_type(8)));
DEV const h16_t* gcs_row(const h16_t* wsb, const h16_t* outb, size_t row) {
  return row < 9472 ? (const h16_t*)((const char*)wsb + 237 * MiB + 512 * 1024) + row * 1024 : (row < 13824 ? (const h16_t*)((const char*)outb + 55 * MiB + 512 * 1024) + (row - 9472) * 1024 : (const h16_t*)((const char*)wsb + 2 * MiB) + (row - 13824) * 1024); }
DEV h16_t* gcs_row_w(h16_t* wsb, h16_t* outb, size_t row) { return (h16_t*)gcs_row(wsb, outb, row); }
DEV float logsig_fast(float x) { return fminf(x, 0.f) - 0.6931471805599453f * __builtin_amdgcn_logf(1.f + __builtin_amdgcn_exp2f(-1.4426950408889634f * fabsf(x))); }
DEV void gla_cs_phase(const float* DTLR, const float* gw, const float* gb, h16_t* GCSL, h16_t* GCSC, float* GDEC, LAS unsigned char* lds, unsigned* queue) {
  const int lane = threadIdx.x & 63, wave = threadIdx.x >> 6;
  LAS float* lrs = (LAS float*)(lds + wave * 8192);
  LAS h16_t* tile = (LAS h16_t*)(lds + 65536 + wave * 1024);
  for (;;) {
    unsigned wt_ = 0u; if (lane == 0) wt_ = __hip_atomic_fetch_add(queue, 1u, __ATOMIC_RELAXED, __HIP_MEMORY_SCOPE_AGENT);
    wt_ = (unsigned)__builtin_amdgcn_readfirstlane((int)wt_); if (wt_ >= (unsigned)(NCH * 2 * 8)) break;
    const int wt = (int)wt_;
    const int gc = wt >> 4, dir = (wt >> 3) & 1, k = (wt & 7) * 64 + lane;
#pragma unroll
    for (int q = 0; q < 8; ++q) { const int c = lane + 64 * q, row = c >> 2, part = c & 3;
      *(LAS f32x4*)(lrs + row * 16 + part * 4) = *(const f32x4*)(DTLR + ((size_t)gc * 128 + row) * 64 + 32 + dir * 16 + part * 4); }
    float wv[16];
#pragma unroll
    for (int q = 0; q < 16; ++q) wv[q] = gw[(dir * 16 + q) * 512 + k];
    const float bias = gb[dir * 512 + k];
    LDS_WAIT(); asm volatile("" ::: "memory");
    float run = 0.f;
#pragma unroll 1
    for (int s0 = 0; s0 < 128; s0 += 8) {
      float lg[8];
#pragma unroll
      for (int u = 0; u < 8; ++u) { const int s = s0 + u, t = dir ? 127 - s : s; const LAS float* lr = lrs + t * 16;
        const f32x4 l0 = *(const LAS f32x4*)lr, l1 = *(const LAS f32x4*)(lr + 4), l2 = *(const LAS f32x4*)(lr + 8), l3 = *(const LAS f32x4*)(lr + 12);
        const float x = bias + l0.x * wv[0] + l0.y * wv[1] + l0.z * wv[2] + l0.w * wv[3] + l1.x * wv[4] + l1.y * wv[5] + l1.z * wv[6] + l1.w * wv[7]
                        + l2.x * wv[8] + l2.y * wv[9] + l2.z * wv[10] + l2.w * wv[11] + l3.x * wv[12] + l3.y * wv[13] + l3.z * wv[14] + l3.w * wv[15];
        lg[u] = logsig_fast(x) * (1.f / 16.f); }
#pragma unroll
      for (int u = 0; u < 8; ++u) { run += lg[u]; tile[u * 64 + lane] = (h16_t)run; }
      LDS_WAIT(); asm volatile("" ::: "memory");
      { const int u = lane >> 3, ch = lane & 7, s = s0 + u, t = dir ? 127 - s : s;
        *(v4u*)(gcs_row_w(GCSL, GCSC, (size_t)gc * 128 + t) + dir * 512 + (k - lane) + ch * 8) = *(const LAS v4u*)(tile + u * 64 + ch * 8); }
      LDS_WAIT(); asm volatile("" ::: "memory");
    }
    GDEC[((gc * 4 + (k >> 7)) * 2 + dir) * 128 + (k & 127)] = fexp(run);
    LDS_WAIT(); asm volatile("" ::: "memory");
  }
}
DEV void gla_u_phase(const bf16_t* K0, const bf16_t* V0, const h16_t* GCSL, const h16_t* GCSC, bf16_t* ST, LAS unsigned char* lds) {
  constexpr int VP = 272, KP = 144;
  LAS bf16_t* Vs = (LAS bf16_t*)lds; LAS bf16_t* Kd = (LAS bf16_t*)(lds + 128 * VP * 2);
  const int tid = threadIdx.x, lane = tid & 63, wid = tid >> 6, r = lane & 15, Qd = lane >> 4;
  for (int task = virt_block(); task < NCH * 4; task += gridDim.x) {
    const int gc = task >> 2, h = task & 3; const size_t r0 = (size_t)gc * 128;
    __syncthreads();
#pragma unroll
    for (int i = 0; i < 8; ++i) { const int cid = tid + 512 * i, row = cid >> 5, ch = cid & 31; *(LAS v4u*)(Vs + row * VP + ch * 8) = *(const v4u*)(V0 + (r0 + row) * 1024 + h * 256 + ch * 8); }
#pragma unroll
    for (int i = 0; i < 4; ++i) { const int cid = tid + 512 * i, t = cid >> 4, ch = cid & 15;
      const v4u kv = *(const v4u*)(K0 + (r0 + t) * 512 + h * 128 + ch * 8);
      const float kf[8] = {__uint_as_float(kv.x << 16), __uint_as_float(kv.x & 0xffff0000u), __uint_as_float(kv.y << 16), __uint_as_float(kv.y & 0xffff0000u), __uint_as_float(kv.z << 16), __uint_as_float(kv.z & 0xffff0000u), __uint_as_float(kv.w << 16), __uint_as_float(kv.w & 0xffff0000u)};
#pragma unroll
      for (int dir = 0; dir < 2; ++dir) {
        const h16x8 ce = *(const h16x8*)(gcs_row(GCSL, GCSC, r0 + (dir ? 0 : 127)) + dir * 512 + h * 128 + ch * 8), ct = *(const h16x8*)(gcs_row(GCSL, GCSC, r0 + t) + dir * 512 + h * 128 + ch * 8);
        v4u o; o.x = pk2(kf[0] * fexp((float)ce[0] - (float)ct[0]), kf[1] * fexp((float)ce[1] - (float)ct[1])); o.y = pk2(kf[2] * fexp((float)ce[2] - (float)ct[2]), kf[3] * fexp((float)ce[3] - (float)ct[3]));
        o.z = pk2(kf[4] * fexp((float)ce[4] - (float)ct[4]), kf[5] * fexp((float)ce[5] - (float)ct[5])); o.w = pk2(kf[6] * fexp((float)ce[6] - (float)ct[6]), kf[7] * fexp((float)ce[7] - (float)ct[7]));
        *(LAS v4u*)(Kd + dir * 128 * KP + t * KP + ch * 8) = o; } }
    __syncthreads();
#pragma unroll 1
    for (int dir = 0; dir < 2; ++dir) {
      const LAS bf16_t* Kb = Kd + dir * 128 * KP;
      f32x4 acc[8][2];
#pragma unroll
      for (int dt = 0; dt < 8; ++dt) { acc[dt][0] = (f32x4){0.f, 0.f, 0.f, 0.f}; acc[dt][1] = (f32x4){0.f, 0.f, 0.f, 0.f}; }
#pragma unroll 1
      for (int k = 0; k < 4; ++k) {
        bf16x8 vf[2];
#pragma unroll
        for (int et = 0; et < 2; ++et) {
          const s16x4 lo = tr_read(Vs + (32 * k + 4 * Qd + (r >> 2)) * VP + 32 * wid + 16 * et + 4 * (r & 3));
          const s16x4 hi = tr_read(Vs + (32 * k + 16 + 4 * Qd + (r >> 2)) * VP + 32 * wid + 16 * et + 4 * (r & 3));
          vf[et] = (bf16x8){lo[0], lo[1], lo[2], lo[3], hi[0], hi[1], hi[2], hi[3]}; }
#pragma unroll
        for (int dt = 0; dt < 8; ++dt) {
          const s16x4 lo = tr_read(Kb + (32 * k + 4 * Qd + (r >> 2)) * KP + 16 * dt + 4 * (r & 3));
          const s16x4 hi = tr_read(Kb + (32 * k + 16 + 4 * Qd + (r >> 2)) * KP + 16 * dt + 4 * (r & 3));
          const bf16x8 kfr = (bf16x8){lo[0], lo[1], lo[2], lo[3], hi[0], hi[1], hi[2], hi[3]};
          acc[dt][0] = __builtin_amdgcn_mfma_f32_16x16x32_bf16(kfr, vf[0], acc[dt][0], 0, 0, 0);
          acc[dt][1] = __builtin_amdgcn_mfma_f32_16x16x32_bf16(kfr, vf[1], acc[dt][1], 0, 0, 0); }
      }
      bf16_t* Sp = ST + (((size_t)gc * 4 + h) * 2 + dir) * 32768;
#pragma unroll
      for (int dt = 0; dt < 8; ++dt)
#pragma unroll
        for (int et = 0; et < 2; ++et) { const f32x4 v = acc[dt][et];
          *(unsigned long long*)(Sp + ((((2 * wid + et) * 4 + (dt >> 1)) * 64 + ((dt & 1) * 2 + (Qd >> 1)) * 16 + r) * 8 + 4 * (Qd & 1))) = (unsigned long long)pk2(v[0], v[1]) | ((unsigned long long)pk2(v[2], v[3]) << 32); }
    }
  }
}
DEV void gla_scan_phase(bf16_t* ST, const float* GDEC, bool wr) {
  for (int item = blockIdx.x * 512 + threadIdx.x; item < 2 * 4 * 2 * 8192; item += gridDim.x * 512) {
    const int e4 = item & 8191, dir = (item >> 13) & 1, h = (item >> 14) & 3, b = item >> 16; const int d0 = 32 * ((e4 >> 7) & 3) + 8 * ((e4 >> 5) & 3) + 4 * (e4 & 1);
    float S0 = 0.f, S1 = 0.f, S2 = 0.f, S3 = 0.f;
#define SCAN_GC(s) (!dir ? ((s) < 2 ? 128 + 2 * b + (s) : b * 64 + ((s) - 2)) : ((s) < 2 ? 128 + 2 * b + (1 - (s)) : b * 64 + (65 - (s))))
    for (int s0 = 0; s0 < 66; s0 += 6) {
      unsigned long long u[6]; f32x4 dec[6];
#pragma unroll
      for (int q = 0; q < 6; ++q) { const int gc = SCAN_GC(s0 + q); u[q] = *(const unsigned long long*)(ST + (((size_t)gc * 4 + h) * 2 + dir) * 32768 + e4 * 4); dec[q] = *(const f32x4*)(GDEC + ((gc * 4 + h) * 2 + dir) * 128 + d0); }
#pragma unroll
      for (int q = 0; q < 6; ++q) { const int gc = SCAN_GC(s0 + q);
        if (wr) *(unsigned long long*)(ST + (((size_t)gc * 4 + h) * 2 + dir) * 32768 + e4 * 4) = (unsigned long long)pk2(S0, S1) | ((unsigned long long)pk2(S2, S3) << 32);
        const unsigned lo = (unsigned)u[q], hi = (unsigned)(u[q] >> 32);
        S0 = dec[q].x * S0 + __uint_as_float(lo << 16); S1 = dec[q].y * S1 + __uint_as_float(lo & 0xffff0000u); S2 = dec[q].z * S2 + __uint_as_float(hi << 16); S3 = dec[q].w * S3 + __uint_as_float(hi & 0xffff0000u); }
    }
#undef SCAN_GC
  }
}
DEV void gla_o_phase(const bf16_t* Q0, const bf16_t* K0, const bf16_t* V0, const h16_t* GCSL, const h16_t* GCSC, const bf16_t* ST, const float* gla_norm, bf16_t* Y0, LAS unsigned char* lds, bool wr) {
  constexpr int VP = 272, KP = 136;
  LAS bf16_t* Vs = (LAS bf16_t*)lds; LAS bf16_t* Kd = (LAS bf16_t*)(lds + 128 * VP * 2);
  const int tid = threadIdx.x, lane = tid & 63, wid = tid >> 6, r = lane & 15, Qd = lane >> 4;
  const float scale = 0.08838834764831845f;
  for (int task = virt_block(); task < NCH * 4; task += gridDim.x) {
    const int gc = task >> 2, h = task & 3; const size_t r0 = (size_t)gc * 128;
    __syncthreads();
#pragma unroll
    for (int i = 0; i < 8; ++i) { const int cid = tid + 512 * i, row = cid >> 5, ch = cid & 31; *(LAS v4u*)(Vs + row * VP + ch * 8) = *(const v4u*)(V0 + (r0 + row) * 1024 + h * 256 + ch * 8); }
#pragma unroll
    for (int i = 0; i < 4; ++i) { const int cid = tid + 512 * i, t = cid >> 4, ch = cid & 15;
      const v4u kv = *(const v4u*)(K0 + (r0 + t) * 512 + h * 128 + ch * 8);
      const float kf[8] = {__uint_as_float(kv.x << 16), __uint_as_float(kv.x & 0xffff0000u), __uint_as_float(kv.y << 16), __uint_as_float(kv.y & 0xffff0000u), __uint_as_float(kv.z << 16), __uint_as_float(kv.z & 0xffff0000u), __uint_as_float(kv.w << 16), __uint_as_float(kv.w & 0xffff0000u)};
#pragma unroll
      for (int dir = 0; dir < 2; ++dir) {
        const h16x8 ct = *(const h16x8*)(gcs_row(GCSL, GCSC, r0 + t) + dir * 512 + h * 128 + ch * 8);
        v4u o; o.x = pk2(kf[0] * fexp(-(float)ct[0]), kf[1] * fexp(-(float)ct[1])); o.y = pk2(kf[2] * fexp(-(float)ct[2]), kf[3] * fexp(-(float)ct[3]));
        o.z = pk2(kf[4] * fexp(-(float)ct[4]), kf[5] * fexp(-(float)ct[5])); o.w = pk2(kf[6] * fexp(-(float)ct[6]), kf[7] * fexp(-(float)ct[7]));
        *(LAS v4u*)(Kd + dir * 128 * KP + t * KP + ch * 8) = o; } }
    __syncthreads();
    const int i = 16 * wid + r;
    f32x4 o[16];
#pragma unroll
    for (int et = 0; et < 16; ++et) o[et] = (f32x4){0.f, 0.f, 0.f, 0.f};
#pragma unroll 1
    for (int dir = 0; dir < 2; ++dir) {
      bf16x8 qd[4];
      { const h16_t* ci = gcs_row(GCSL, GCSC, r0 + i) + dir * 512 + h * 128; const bf16_t* qp = Q0 + (r0 + i) * 512 + h * 128;
#pragma unroll
        for (int ks = 0; ks < 4; ++ks) { const v4u qv = *(const v4u*)(qp + 32 * ks + 8 * Qd); const h16x8 cc = *(const h16x8*)(ci + 32 * ks + 8 * Qd);
          const f32x4 c0 = {(float)cc[0], (float)cc[1], (float)cc[2], (float)cc[3]}, c1 = {(float)cc[4], (float)cc[5], (float)cc[6], (float)cc[7]};
          const unsigned w0 = pk2(__uint_as_float(qv.x << 16) * scale * fexp(c0.x), __uint_as_float(qv.x & 0xffff0000u) * scale * fexp(c0.y));
          const unsigned w1 = pk2(__uint_as_float(qv.y << 16) * scale * fexp(c0.z), __uint_as_float(qv.y & 0xffff0000u) * scale * fexp(c0.w));
          const unsigned w2 = pk2(__uint_as_float(qv.z << 16) * scale * fexp(c1.x), __uint_as_float(qv.z & 0xffff0000u) * scale * fexp(c1.y));
          const unsigned w3 = pk2(__uint_as_float(qv.w << 16) * scale * fexp(c1.z), __uint_as_float(qv.w & 0xffff0000u) * scale * fexp(c1.w));
          qd[ks] = (bf16x8){(short)(w0 & 0xffff), (short)(w0 >> 16), (short)(w1 & 0xffff), (short)(w1 >> 16), (short)(w2 & 0xffff), (short)(w2 >> 16), (short)(w3 & 0xffff), (short)(w3 >> 16)}; } }
      const bf16_t* Sp = ST + (((size_t)gc * 4 + h) * 2 + dir) * 32768 + lane * 8;
      {
        bf16x8 sA[4], sB[4];
#pragma unroll
        for (int q = 0; q < 4; ++q) sA[q] = *(const bf16x8*)(Sp + (q * 4 + 0) * 512);
#pragma unroll
        for (int bi = 0; bi < 16; ++bi) {
          const int ks = bi >> 2, e0 = 4 * (bi & 3);
          if (bi + 1 < 16) { const int ks2 = (bi + 1) >> 2, e2 = 4 * ((bi + 1) & 3);
#pragma unroll
            for (int q = 0; q < 4; ++q) { if (bi & 1) sA[q] = *(const bf16x8*)(Sp + ((e2 + q) * 4 + ks2) * 512); else sB[q] = *(const bf16x8*)(Sp + ((e2 + q) * 4 + ks2) * 512); } }
#pragma unroll
          for (int q = 0; q < 4; ++q) o[e0 + q] = __builtin_amdgcn_mfma_f32_16x16x32_bf16(qd[ks], (bi & 1) ? sB[q] : sA[q], o[e0 + q], 0, 0, 0);
          __builtin_amdgcn_sched_barrier(0);
        }
      }
      const LAS bf16_t* Kb = Kd + dir * 128 * KP;
#pragma unroll 1
      for (int k2 = 0; k2 < 4; ++k2) {
        const bool need = dir ? (2 * k2 + 1 >= wid) : (2 * k2 <= wid);
        if (!need) continue;
        bf16x8 pa;
#pragma unroll
        for (int tt = 0; tt < 2; ++tt) { const int t = 2 * k2 + tt;
          f32x4 c = {0.f, 0.f, 0.f, 0.f};
#pragma unroll
          for (int ks = 0; ks < 4; ++ks) { const bf16x8 kfr = *(const LAS bf16x8*)(Kb + (16 * t + r) * KP + 32 * ks + 8 * Qd); c = __builtin_amdgcn_mfma_f32_16x16x32_bf16(kfr, qd[ks], c, 0, 0, 0); }
          float pv[4];
#pragma unroll
          for (int jj = 0; jj < 4; ++jj) { const int j = 16 * t + 4 * Qd + jj; const bool ok = dir ? (j >= i) : (j <= i); pv[jj] = ok ? c[jj] : 0.f; }
          const unsigned w0 = pk2(pv[0], pv[1]), w1 = pk2(pv[2], pv[3]);
          pa[tt * 4 + 0] = (short)(w0 & 0xffff); pa[tt * 4 + 1] = (short)(w0 >> 16); pa[tt * 4 + 2] = (short)(w1 & 0xffff); pa[tt * 4 + 3] = (short)(w1 >> 16); }
#pragma unroll
        for (int et = 0; et < 16; ++et) {
          const s16x4 lo = tr_read(Vs + (32 * k2 + 4 * Qd + (r >> 2)) * VP + 16 * et + 4 * (r & 3));
          const s16x4 hi = tr_read(Vs + (32 * k2 + 16 + 4 * Qd + (r >> 2)) * VP + 16 * et + 4 * (r & 3));
          const bf16x8 vf = (bf16x8){lo[0], lo[1], lo[2], lo[3], hi[0], hi[1], hi[2], hi[3]};
          o[et] = __builtin_amdgcn_mfma_f32_16x16x32_bf16(pa, vf, o[et], 0, 0, 0); }
      }
    }
    asm volatile("s_nop 15\n\ts_nop 15\n\ts_nop 15\n\ts_nop 15" ::: "memory");
    __syncthreads();
    { constexpr int GP = 264;
      LAS bf16_t* stg = (LAS bf16_t*)lds + wid * (16 * GP);
      float gn_[16];
#pragma unroll
      for (int et = 0; et < 16; ++et) gn_[et] = gla_norm[h * 256 + 16 * et + r];
#pragma unroll
      for (int jj = 0; jj < 4; ++jj) { float ss = 0.f;
#pragma unroll
        for (int et = 0; et < 16; ++et) ss += o[et][jj] * o[et][jj];
        ss += __shfl_xor(ss, 1); ss += __shfl_xor(ss, 2); ss += __shfl_xor(ss, 4); ss += __shfl_xor(ss, 8);
        const float rstd = rsqrtf(ss * (1.f / 256.f) + EPS);
        LAS bf16_t* srow = stg + (4 * Qd + jj) * GP;
#pragma unroll
        for (int e = 0; e < 8; ++e) { const float a0 = o[2 * e][jj] * rstd * gn_[2 * e], a1 = o[2 * e + 1][jj] * rstd * gn_[2 * e + 1];
          const float p0 = __shfl_xor(a0, 1), p1 = __shfl_xor(a1, 1);
          const unsigned w = (r & 1) ? pk2(p1, a1) : pk2(a0, p0); const int col = (r & 1) ? 16 * (2 * e + 1) + r - 1 : 16 * (2 * e) + r;
          *(LAS unsigned*)(srow + col) = w; } }
      LDS_WAIT(); asm volatile("" ::: "memory");
#pragma unroll
      for (int q = 0; q < 8; ++q) { const int c = lane + 64 * q, rowl = c >> 5, ch = c & 31;
        bf16_t* gp = Y0 + (r0 + 16 * wid + rowl) * 2048 + 1024 + h * 256 + ch * 8;
        const v4u ov = *(const LAS v4u*)(stg + rowl * GP + ch * 8), gv = *(const v4u*)gp;
        v4u w; w.x = pk2(__uint_as_float(ov.x << 16) * __uint_as_float(gv.x << 16), __uint_as_float(ov.x & 0xffff0000u) * __uint_as_float(gv.x & 0xffff0000u));
        w.y = pk2(__uint_as_float(ov.y << 16) * __uint_as_float(gv.y << 16), __uint_as_float(ov.y & 0xffff0000u) * __uint_as_float(gv.y & 0xffff0000u));
        w.z = pk2(__uint_as_float(ov.z << 16) * __uint_as_float(gv.z << 16), __uint_as_float(ov.z & 0xffff0000u) * __uint_as_float(gv.z & 0xffff0000u));
        w.w = pk2(__uint_as_float(ov.w << 16) * __uint_as_float(gv.w << 16), __uint_as_float(ov.w & 0xffff0000u) * __uint_as_float(gv.w & 0xffff0000u));
        if (wr) *(v4u*)gp = w; }
      LDS_WAIT(); asm volatile("" ::: "memory"); }
  }
}

typedef __attribute__((address_space(1))) unsigned gu32;
#define RLX_AGENT __ATOMIC_RELAXED, __HIP_MEMORY_SCOPE_AGENT
#define XB_TMO      128
#define XB_XCNT(j)  (256  + 64 * (j))
#define XB_XSUB(j)  (1280 + 64 * (j))
#define XB_XGEN(j)  (2304 + 64 * (j))
#define XB_TOP      3328
#define XB_TOPGEN   3392
#define XCD_BAR_WORDS 3456
#define XB_SPIN_CAP (1u << 18)

__device__ __forceinline__ unsigned xb_ld(unsigned* p)              { return __hip_atomic_load(p, __ATOMIC_RELAXED, __HIP_MEMORY_SCOPE_AGENT); }
__device__ __forceinline__ unsigned xb_add(unsigned* p, unsigned v) { return __hip_atomic_fetch_add(p, v, __ATOMIC_RELAXED, __HIP_MEMORY_SCOPE_AGENT); }
__device__ __forceinline__ unsigned xb_xcc_id() { return (unsigned)__builtin_amdgcn_s_getreg((3 << 11) | 20) & 0xFu; }
#define XB_SPIN(cond, bar) do { unsigned _sp = 0; while (cond) { __builtin_amdgcn_s_sleep(1); \
    if ((++_sp & 255u) == 0u) { if (xb_ld(&(bar)[XB_TMO])) break; if (_sp > XB_SPIN_CAP) { atomicAdd(&(bar)[XB_TMO], 1u); break; } } } } while (0)

struct XcdBarrier {
    unsigned* bar; unsigned x;
    volatile LAS unsigned* st;
};

__device__ __forceinline__ XcdBarrier xcd_barrier_post(unsigned* bar, volatile LAS unsigned* st) {
    XcdBarrier b; b.bar = bar; b.x = xb_xcc_id(); b.st = st;
    if (threadIdx.x == 0) (void)xb_add(&bar[XB_XCNT(b.x)], 1u);
    return b;
}
__device__ __forceinline__ void xcd_barrier_complete(unsigned* bar, unsigned x, unsigned& nloc, unsigned& nx) {
    const unsigned G = gridDim.x * gridDim.y * gridDim.z;
    unsigned sum, cnt, mine, sp = 0u;
    for (;;) {
        sum = 0u; cnt = 0u; mine = 0u;
#pragma unroll
        for (unsigned j = 0; j < 16; ++j) { const unsigned c = xb_ld(&bar[XB_XCNT(j)]); sum += c; cnt += (c > 0u) ? 1u : 0u; mine = (j == x) ? c : mine; }
        if (sum == G) break;
        __builtin_amdgcn_s_sleep(1);
        if ((++sp & 255u) == 0u) { if (xb_ld(&bar[XB_TMO])) break; if (sp > XB_SPIN_CAP) { atomicAdd(&bar[XB_TMO], 1u); break; } }
    }
    nloc = mine > 0u ? mine : 1u; nx = cnt > 0u ? cnt : 1u;
}

__device__ __forceinline__ void xcd_barrier(const XcdBarrier& b) {
    asm volatile("s_waitcnt vmcnt(0)" ::: "memory");
    __syncthreads();
    if (threadIdx.x == 0) {
        unsigned* bar = b.bar;
        __builtin_amdgcn_s_waitcnt(0);
        unsigned nloc = b.st[0], nx = b.st[1];
        if (nloc == 0u) { xcd_barrier_complete(bar, b.x, nloc, nx); b.st[0] = nloc; b.st[1] = nx; }
        const unsigned old = xb_add(&bar[XB_XSUB(b.x)], 1u);
        const unsigned gen = old / nloc;
        if (old + 1u == (gen + 1u) * nloc) {
            __builtin_amdgcn_fence(__ATOMIC_RELEASE, "agent");
            asm volatile("s_waitcnt vmcnt(0)" ::: "memory");
            const unsigned og = xb_add(&bar[XB_TOP], 1u);
            const unsigned tg = og / nx;
            if (og + 1u == (tg + 1u) * nx) xb_add(&bar[XB_TOPGEN], 1u);
            else XB_SPIN(xb_ld(&bar[XB_TOPGEN]) == tg, bar);
            __builtin_amdgcn_fence(__ATOMIC_ACQUIRE, "agent");
            xb_add(&bar[XB_XGEN(b.x)], 1u);
            asm volatile("s_waitcnt vmcnt(0)" ::: "memory");
        } else {
            XB_SPIN(xb_ld(&bar[XB_XGEN(b.x)]) == gen, bar);
            __builtin_amdgcn_fence(__ATOMIC_ACQUIRE, "agent");
            asm volatile("s_waitcnt vmcnt(0)" ::: "memory");
        }
    }
    __syncthreads();
}

__global__ void __launch_bounds__(NWAVES * 64, 2) __attribute__((amdgpu_num_sgpr(92))) mega(Params p) {
  extern __shared__ __attribute__((aligned(16))) unsigned char lds_raw[];
  LAS unsigned char* lds = (LAS unsigned char*)lds_raw;
  volatile LAS unsigned* MISC = (volatile LAS unsigned*)(lds + MISC_OFF);
  if (threadIdx.x < 16) MISC[threadIdx.x] = 0u;
  __syncthreads();
  XcdBarrier bar = xcd_barrier_post((unsigned*)(p.ws + WS_CTL), MISC + 8);
  unsigned char* ws = p.ws;
  float* MOD = (float*)(ws + WS_MOD);
  bf16_t* H0 = (bf16_t*)p.out; float* X1 = p.out;
  const int lo = p.ph_lo, hi = p.ph_hi;
#define IN(k) (lo <= (k) && (k) < hi)
#define SEAM(k) do { if ((k) + 1 < hi) xcd_barrier(bar); } while (0)
#define PH(k, ...) if (IN(k)) { if ((PROBE_MASK >> (k)) & 1u) { const bool wr = (p.rep < 0); (void)wr; __VA_ARGS__; xcd_barrier(bar); } { const bool wr = true; (void)wr; __VA_ARGS__; } SEAM(k); }
  PH(0, prologue_phase(p, lds))
  PH(1, prep_phase(p.in[0], p.in[2], p.in[4], MOD, H0))
  PH(2, {
    pg8::Gemm g{H0, (const bf16_t*)(ws + WS_W1T), MA, E_INP, D}; pg8::StaticOrder S; S.init(MA, E_INP, gridDim.x, (int)blockIdx.x);
    pg8::EpiProj0 E{(bf16_t*)(ws + WS_Y0), (bf16_t*)(ws + WS_XBC), (bf16_t*)(ws + WS_Q0), (bf16_t*)(ws + WS_K0), (bf16_t*)(ws + WS_V0), (float*)(ws + WS_DTLR)};
    pg8::gemm_phase<pg8::EpiProj0, pg8::StaticOrder, true, true>(lds, g, S, E); })
  PH(3, ssd_prep_phase((const bf16_t*)(ws + WS_XBC), p.in[8], p.in[9], (bf16_t*)p.out, (const float*)(ws + WS_DTLR), p.in[10], p.in[11], (float*)((char*)p.out + DO_SDT), (float*)((char*)p.out + DO_SCS), (float*)(ws + WS_SDEC)))
  PH(4, { ssd_u_phase((const bf16_t*)p.out, (const float*)((char*)p.out + DO_SDT), (const float*)((char*)p.out + DO_SCS), (bf16_t*)(ws + WS_STATE), lds);
    { const int nbusy = (NCH * 4) % (int)gridDim.x, nfree = (int)gridDim.x - nbusy;
      const int vb_ = virt_block(); if (vb_ >= nbusy || nfree <= 0) { __syncthreads(); late_weights(p, lds, nfree > 0 ? vb_ - nbusy : vb_, nfree > 0 ? nfree : (int)gridDim.x); } } })
  PH(5, ssd_scan_phase((bf16_t*)(ws + WS_STATE), (const float*)(ws + WS_SDEC), wr))
  PH(6, { ssd_y_phase((const bf16_t*)p.out, (const float*)((char*)p.out + DO_SDT), (const float*)((char*)p.out + DO_SCS), (const bf16_t*)(ws + WS_STATE), p.in[12], (bf16_t*)(ws + WS_Y0), (float*)(ws + WS_SSQ), lds, wr);
    if (wr) gla_cs_phase((const float*)(ws + WS_DTLR), p.in[14], p.in[15], (h16_t*)ws, (h16_t*)p.out, (float*)(ws + WS_GDEC), lds, (unsigned*)(ws + WS_CTL) + CW_CSQ); })
  PH(8, gla_u_phase((const bf16_t*)(ws + WS_K0), (const bf16_t*)(ws + WS_V0), (const h16_t*)ws, (const h16_t*)p.out, (bf16_t*)(ws + WS_STATE), lds))
  PH(9, gla_scan_phase((bf16_t*)(ws + WS_STATE), (const float*)(ws + WS_GDEC), wr))
  PH(10, gla_o_phase((const bf16_t*)(ws + WS_Q0), (const bf16_t*)(ws + WS_K0), (const bf16_t*)(ws + WS_V0), (const h16_t*)ws, (const h16_t*)p.out, (const bf16_t*)(ws + WS_STATE), p.in[16], (bf16_t*)(ws + WS_Y0), lds, wr))
  PH(11, {
    pg8::Gemm g{(const bf16_t*)(ws + WS_Y0), (const bf16_t*)(ws + WS_W2T), ML, D, 2048}; pg8::StaticOrder S; S.init(ML, D, gridDim.x, (int)blockIdx.x);
    const float* SSQ = (const float*)(ws + WS_SSQ);
    LAS float* rs = (LAS float*)(lds + 131072);
    { pg8::Unit u0; if (S.next(0, u0) && threadIdx.x < 256) { const size_t row = (size_t)u0.pm * 256 + threadIdx.x;
        const float r0 = rsqrtf((SSQ[(row * 2 + 0) * 2] + SSQ[(row * 2 + 0) * 2 + 1]) * (1.f / 512.f) + EPS), r1 = rsqrtf((SSQ[(row * 2 + 1) * 2] + SSQ[(row * 2 + 1) * 2 + 1]) * (1.f / 512.f) + EPS);
        rs[threadIdx.x * 2] = r0 / r1; rs[threadIdx.x * 2 + 1] = r1; } }
    __syncthreads();
    pg8::EpiResid E{p.in[0], X1, MOD, true};
    pg8::gemm_phase<pg8::EpiResid, pg8::StaticOrder, true, true, true>(lds, g, S, E, rs);
    const float* ctx = p.in[2]; float* XC1 = (float*)(ws + WS_XC1); const float* gate = MOD + 2 * 3072 + 2048;
    small_gemm_splitk((const bf16_t*)(ws + WS_Y0) + (size_t)ML * 2048, 2048, (const bf16_t*)(ws + WS_W2T), 2048, 2048, MC, D, lds, SSQ + (size_t)ML * 4,
               [=](int m, int n, float v, float) { XC1[(size_t)m * D + n] = ctx[(size_t)m * D + n] + gate[n] * v; }); })
  PH(12, prep_phase(X1, (const float*)(ws + WS_XC1), p.in[18], MOD + 3 * 3072, (bf16_t*)(ws + WS_H1)))
  PH(13, {
    pg8::Gemm g{(const bf16_t*)(ws + WS_H1), (const bf16_t*)(ws + WS_W3T), ML, O_IN, D}; pg8::StaticOrder S; S.init(ML, O_IN, gridDim.x, (int)blockIdx.x);
    pg8::EpiProj1 E{(bf16_t*)(ws + WS_K1), (bf16_t*)(ws + WS_V1), (bf16_t*)(ws + WS_Q1), (bf16_t*)(ws + WS_G1), p.in[22], p.in[23], (const float*)(ws + WS_ROPE), (LAS float*)(lds + 131072)};
    pg8::gemm_phase<pg8::EpiProj1, pg8::StaticOrder, true, true>(lds, g, S, E);
    bf16_t* K1 = (bf16_t*)(ws + WS_K1); bf16_t* V1 = (bf16_t*)(ws + WS_V1);
    small_gemm_splitk((const bf16_t*)(ws + WS_H1) + (size_t)ML * D, D, (const bf16_t*)(ws + WS_W3T), D, D, MC, 1024, lds, nullptr,
               [=](int m, int n, float v, float vn) { if (n & 1) return; const unsigned w = pk2(v, vn);
                 if (n < 512) *(unsigned*)(K1 + (size_t)(ML + m) * 512 + n) = w; else *(unsigned*)(V1 + (size_t)(ML + m) * 512 + (n - 512)) = w; }); })
  PH(15, attn_phase((bf16_t*)(ws + WS_Q1), (const bf16_t*)(ws + WS_K1), (const bf16_t*)(ws + WS_V1), (const bf16_t*)(ws + WS_G1), p.in[24], p.in[22], p.in[23], lds, wr))
  PH(16, {
    pg8::Gemm g{(const bf16_t*)(ws + WS_Q1), (const bf16_t*)(ws + WS_W4T), ML, D, 2048}; pg8::StaticOrder S; S.init(ML, D, gridDim.x, (int)blockIdx.x);
    pg8::EpiResid E{X1, p.out, MOD + 3 * 3072, wr};
    pg8::gemm_phase<pg8::EpiResid, pg8::StaticOrder, true, true>(lds, g, S, E); })
#undef PH
#undef IN
#undef SEAM
}
extern "C" void kernel_launch(void* const* d_in, const int* in_sizes, int n_in, void* d_out, int out_size, void* d_ws, size_t ws_size, hipStream_t stream) {
  static int grid_blocks = 0;
  if (!grid_blocks) {
    int dev = 0, cus = 0, per_cu = 0;
    hipGetDevice(&dev);
    hipDeviceGetAttribute(&cus, hipDeviceAttributeMultiprocessorCount, dev);
    hipFuncSetAttribute((const void*)mega, hipFuncAttributeMaxDynamicSharedMemorySize, LDS_BYTES);
    hipOccupancyMaxActiveBlocksPerMultiprocessor(&per_cu, (const void*)mega, NWAVES * 64, LDS_BYTES);
    if (per_cu < 1) { fprintf(stderr, "kernel_launch: occupancy query says %d blocks per CU\n", per_cu); per_cu = 1; }
    if (per_cu > 1) per_cu = 1;
    grid_blocks = cus * per_cu;
  }
  hipMemsetAsync((char*)d_ws + WS_CTL, 0, 64 * 1024, stream);
  Params base{};
  for (int i = 0; i < 26; ++i) base.in[i] = (const float*)d_in[i];
  base.out = (float*)d_out; base.ws = (unsigned char*)d_ws;
  auto launch = [&](int lo, int hi) {
    Params p = base; p.ph_lo = lo; p.ph_hi = hi; p.rep = (int)PROBE_MASK; void* args[] = {&p};
    hipError_t e = hipLaunchCooperativeKernel((const void*)mega, dim3(grid_blocks), dim3(NWAVES * 64), args, LDS_BYTES, stream);
    if (e != hipSuccess) fprintf(stderr, "cooperative launch failed: %s (grid %d)\n", hipGetErrorString(e), grid_blocks);
  };
  launch(0, 17);
}
```

```cpp
#include <hip/hip_runtime.h>
#include <hip/hip_cooperative_groups.h>
#include <stdint.h>
#include <math.h>
#include <cstdio>
namespace cg = cooperative_groups;
#ifndef PROBE_SKIP
#define PROBE_SKIP 0
#endif
#ifndef PROBE_MASK
#define PROBE_MASK 0u
#endif

typedef unsigned short bf16_t;
#define DEV __device__ __forceinline__

DEV float bf2f(bf16_t v) { return __uint_as_float(((unsigned)v) << 16); }
typedef float f32x2_t __attribute__((ext_vector_type(2))); typedef __bf16 bf16x2_t __attribute__((ext_vector_type(2)));
DEV unsigned pk2(float lo, float hi) { const f32x2_t v = {lo, hi}; const bf16x2_t b = __builtin_convertvector(v, bf16x2_t); return __builtin_bit_cast(unsigned, b); }
DEV bf16_t f2bf(float f) { return (bf16_t)(pk2(f, 0.f) & 0xffffu); }
DEV float fexp(float x) { return __builtin_amdgcn_exp2f(x * 1.4426950408889634f); }
DEV float siluf(float x) { return x / (1.f + fexp(-x)); }
DEV float silu_fast(float x) { return x * __builtin_amdgcn_rcpf(1.f + fexp(-x)); }
DEV float softplusf(float x) { return x > 20.f ? x : log1pf(fexp(x)); }
DEV float logsigmoidf(float x) { return fminf(x, 0.f) - log1pf(fexp(-fabsf(x))); }

constexpr int D = 1024, NB = 2, SEQ = 8192, CTXL = 256;
constexpr int ML = NB * SEQ;
constexpr int MC = NB * CTXL;
constexpr int MA = ML + MC;
constexpr int NCH = MA / 128;
constexpr int E_IN = 5696, O_IN = 5120, E_INP = 5888;
constexpr float EPS = 1e-6f;

constexpr size_t MiB = 1u << 20;
constexpr int CW_CSQ = 8192;
constexpr size_t WS_CTL = 0;
constexpr size_t WS_SSQ1 = 64 * 1024;
constexpr size_t WS_CB = 160 * 1024;
constexpr size_t WS_MOD = 1 * MiB;
constexpr size_t WS_ROPE = 1 * MiB + 128 * 1024;
constexpr size_t WS_SDEC = 1 * MiB + 256 * 1024;
constexpr size_t WS_GDEC = 1 * MiB + 384 * 1024;
constexpr size_t WS_W1T = 2 * MiB;
constexpr size_t WS_W2T = 14 * MiB;
constexpr size_t WS_W3T = 18 * MiB;
constexpr size_t WS_W4T = 28 * MiB;
constexpr size_t WS_Y0 = 32 * MiB;
constexpr size_t WS_Q0 = 98 * MiB;
constexpr size_t WS_K0 = WS_Q0 + 16 * MiB + 512 * 1024;
constexpr size_t WS_V0 = 131 * MiB;
constexpr size_t WS_DTLR = 164 * MiB;
constexpr size_t WS_XC1 = 168 * MiB + 512 * 1024;
constexpr size_t WS_XBC = 171 * MiB;
constexpr size_t WS_STATE = 171 * MiB;
constexpr size_t WS_TAIL = 237 * MiB;
constexpr size_t WS_H1 = 98 * MiB;
constexpr size_t WS_K1 = 131 * MiB;
constexpr size_t WS_V1 = 147 * MiB + 512 * 1024;
constexpr size_t WS_Q1 = 32 * MiB;
constexpr size_t WS_G1 = 171 * MiB;

DEV int row_vec(int row) { return row < ML ? (row / SEQ) : 2; }

namespace pg8 {
constexpr int O_IN_ = 5120;
#define PG8_LAS __attribute__((address_space(3)))
typedef unsigned short bf16_t;
typedef short bf16x8 __attribute__((ext_vector_type(8)));
typedef float f32x4 __attribute__((ext_vector_type(4)));
typedef unsigned u32x4 __attribute__((ext_vector_type(4)));
constexpr int BM = 256, BK = 64, HALF = 128, HTB = HALF * BK * 2  , STAGE_BYTES = 8 * HTB, NXCD = 8, WGM = 8;

__host__ __device__ __forceinline__ int lds_byte(int r, int c) { const int st = (r >> 4) * 2 + (c >> 5), rr = r & 15, cc = c & 31, ob = rr * 64 + cc * 2; return st * 1024 + (ob ^ (((ob >> 9) & 1) << 5)); }
__host__ __device__ __forceinline__ void stage_rc(int b, int& R, int& C) { const int st = b / 1024, sb = b % 1024, swz = sb ^ (((sb >> 9) & 1) << 5); R = (st >> 1) * 16 + swz / 64; C = (st & 1) * 32 + (swz % 64) / 2; }
__host__ __device__ __forceinline__ int perm32(int rho) { const int n = rho >> 4, i = rho & 15; return 8 * (i >> 2) + 4 * n + (i & 3); }

struct Unit { int pm, pn; };
struct Gemm { const bf16_t* A; const bf16_t* Bt; int M, N, K; };

struct StaticOrder {
    int nM, nN, nwg, G, c;
    __host__ __device__ __forceinline__ void init(int M, int N, int G_, int c_) { nM = M / BM; nN = N / BM; nwg = nM * nN; G = G_; c = c_; }
    __host__ __device__ __forceinline__ bool next(int i, Unit& u) const {
        const long L = (long)i * G + c; if (L >= nwg) return false;
        int wgid = (int)L; { const int q = nwg / NXCD, r = nwg % NXCD, xcd = wgid % NXCD, off = wgid / NXCD; wgid = (xcd < r ? xcd * (q + 1) : r * (q + 1) + (xcd - r) * q) + off; }
        const int nig = WGM * nN, gid = wgid / nig, fm = gid * WGM, gsz = (nM - fm) < WGM ? (nM - fm) : WGM;
        u.pm = fm + ((wgid % nig) % gsz); u.pn = (wgid % nig) / gsz; return true;
    }
    __device__ __forceinline__ void a_ready(const Unit&) const {}
    __device__ __forceinline__ void done(const Unit&) const {}
};
__device__ __forceinline__ unsigned cvt_pk_bf16(float lo, float hi) { unsigned r; asm volatile("v_cvt_pk_bf16_f32 %0, %1, %2" : "=v"(r) : "v"(lo), "v"(hi)); return r; }
__device__ __forceinline__ float silu_e(float x) { return x * __builtin_amdgcn_rcpf(1.f + fexp(-x)); }

__device__ __forceinline__ void store_unit_bf16(const f32x4 (&acc)[2][2][4][2], bf16_t* base, int ld, int colt, bool act, const Unit& u, int wr, int wc, int fr, int fq) {
    const int row0 = u.pm * BM + wr * 64 + fr; const int col0 = colt + wc * 32 + 8 * fq;
#pragma unroll
    for (int ai = 0; ai < 2; ++ai)
#pragma unroll
        for (int m = 0; m < 4; ++m) { bf16_t* rowp = base + (size_t)(row0 + ai * HALF + m * 16) * ld + col0;
#pragma unroll
            for (int bj = 0; bj < 2; ++bj) { f32x4 v0 = acc[ai][bj][m][0], v1 = acc[ai][bj][m][1];
                if (act) { v0 = (f32x4){silu_e(v0[0]), silu_e(v0[1]), silu_e(v0[2]), silu_e(v0[3])}; v1 = (f32x4){silu_e(v1[0]), silu_e(v1[1]), silu_e(v1[2]), silu_e(v1[3])}; }
                u32x4 w; w.x = cvt_pk_bf16(v0[0], v0[1]); w.y = cvt_pk_bf16(v0[2], v0[3]); w.z = cvt_pk_bf16(v1[0], v1[1]); w.w = cvt_pk_bf16(v1[2], v1[3]);
                *(u32x4*)(rowp + bj * HALF) = w; } }
}
struct EpiProj0 {
    static constexpr bool PERM = true, AFTER_DRAIN = false;
    bf16_t *Y0, *XBC, *Q0, *K0, *V0; float* DTLR;
    __device__ __forceinline__ void operator()(const f32x4 (&acc)[2][2][4][2], const Unit& u, int wr, int wc, int fr, int fq) const {
        const int pn = u.pn;
        if (pn == 22) {
            if (wc < 2) { const int row0 = u.pm * BM + wr * 64 + fr;
#pragma unroll
                for (int ai = 0; ai < 2; ++ai)
#pragma unroll
                    for (int m = 0; m < 4; ++m) { float* rp = DTLR + (size_t)(row0 + ai * HALF + m * 16) * 64 + wc * 32 + 8 * fq; *(f32x4*)rp = acc[ai][0][m][0]; *(f32x4*)(rp + 4) = acc[ai][0][m][1]; } }
            return;
        }
        bf16_t* base; int ld, colt; bool act = false;
        if (pn < 8) { base = Y0; ld = 2048; colt = pn * 256; act = true; }
        else if (pn < 14) { base = XBC; ld = 1536; colt = (pn - 8) * 256; }
        else if (pn < 16) { base = Q0; ld = 512; colt = (pn - 14) * 256; }
        else if (pn < 18) { base = K0; ld = 512; colt = (pn - 16) * 256; }
        else { base = V0; ld = 1024; colt = (pn - 18) * 256; }
        store_unit_bf16(acc, base, ld, colt, act, u, wr, wc, fr, fq);
    }
};
struct EpiProj1 {
    static constexpr bool PERM = true, AFTER_DRAIN = false;
    bf16_t *K1, *V1, *Q1, *G1; const float *qn, *kn, *rope; PG8_LAS float* part; const float *ssq1, *cb;
    __device__ __forceinline__ void operator()(const f32x4 (&acc_)[2][2][4][2], const Unit& u, int wr, int wc, int fr, int fq) const {
        const int pn = u.pn; bf16_t* base; int ld, colt; bool act = false;
        f32x4 acc[2][2][4][2];
        { const float* cbp = cb + ((u.pm * BM) / 8192) * O_IN_ + pn * BM + wc * 32 + 8 * fq; f32x4 cbv[2][2];
#pragma unroll
          for (int bj = 0; bj < 2; ++bj)
#pragma unroll
              for (int n = 0; n < 2; ++n) cbv[bj][n] = *(const f32x4*)(cbp + bj * HALF + 4 * n);
#pragma unroll
          for (int ai = 0; ai < 2; ++ai)
#pragma unroll
              for (int m = 0; m < 4; ++m) { const float rs_ = __builtin_amdgcn_rsqf(ssq1[u.pm * BM + ai * HALF + wr * 64 + m * 16 + fr] * (1.f / 1024.f) + 1e-6f);
#pragma unroll
                  for (int bj = 0; bj < 2; ++bj)
#pragma unroll
                      for (int n = 0; n < 2; ++n) acc[ai][bj][m][n] = acc_[ai][bj][m][n] * rs_ + cbv[bj][n]; } }
        if (pn < 2) { base = K1; ld = 512; colt = pn * 256; }
        else if (pn < 4) { base = V1; ld = 512; colt = (pn - 2) * 256; }
        else if (pn < 12) { base = Q1; ld = 2048; colt = (pn - 4) * 256; }
        else { base = G1; ld = 2048; colt = (pn - 12) * 256; act = true; }
        const bool isk = pn < 2, isq = pn >= 4 && pn < 12;
        if (!(isk || isq)) { store_unit_bf16(acc, base, ld, colt, act, u, wr, wc, fr, fq); return; }
#pragma unroll
        for (int ai = 0; ai < 2; ++ai)
#pragma unroll
            for (int m = 0; m < 4; ++m)
#pragma unroll
                for (int bj = 0; bj < 2; ++bj) { const f32x4 x0 = acc[ai][bj][m][0], x1 = acc[ai][bj][m][1];
                    float s = (x0[0] * x0[0] + x0[1] * x0[1]) + (x0[2] * x0[2] + x0[3] * x0[3]) + (x1[0] * x1[0] + x1[1] * x1[1]) + (x1[2] * x1[2] + x1[3] * x1[3]);
                    s += __shfl_xor(s, 16); s += __shfl_xor(s, 32);
                    if (fq == 0) part[(ai * HALF + wr * 64 + m * 16 + fr) * 8 + bj * 4 + wc] = s; }
        asm volatile("s_waitcnt lgkmcnt(0)" ::: "memory"); __builtin_amdgcn_s_barrier(); asm volatile("" ::: "memory");
        const int a = wc >> 1, f0 = 16 * (wc & 1) + 4 * fq;
        const float* gn = (isq ? qn : kn) + a * 64 + f0;
        const f32x4 g0 = *(const f32x4*)gn, g1 = *(const f32x4*)(gn + 32);
        const float osc = isq ? 0.08838834764831845f * 1.4426950408889634f : 1.f;
        const int col0 = colt + wc * 32 + 8 * fq;
        f32x4 w_[2][2][4][2];
#pragma unroll
        for (int ai = 0; ai < 2; ++ai)
#pragma unroll
            for (int bj = 0; bj < 2; ++bj)
#pragma unroll
                for (int m = 0; m < 4; ++m) { w_[ai][bj][m][0] = acc[ai][bj][m][0]; w_[ai][bj][m][1] = acc[ai][bj][m][1]; }
#pragma unroll 1
        for (int m = 0; m < 4; ++m) {
#pragma unroll
            for (int ai = 0; ai < 2; ++ai) { const int rowl = ai * HALF + wr * 64 + m * 16 + fr, row = u.pm * BM + rowl, t = row & 8191, pos = a ? (t & 63) : (t >> 6);
                const f32x4 cs = *(const f32x4*)(rope + pos * 32 + f0), sn = *(const f32x4*)(rope + 4096 + pos * 32 + f0);
                bf16_t* rowp = base + (size_t)row * ld + col0;
#pragma unroll
                for (int bj = 0; bj < 2; ++bj) { const f32x4 p4 = *(const PG8_LAS f32x4*)(part + rowl * 8 + bj * 4);
                    const float rstd = __builtin_amdgcn_rsqf(((p4[0] + p4[1]) + (p4[2] + p4[3])) * (1.f / 128.f) + 1e-6f) * osc;
                    const f32x4 t1 = w_[ai][bj][0][0] * g0 * rstd, t2 = w_[ai][bj][0][1] * g1 * rstd;
                    const f32x4 o1 = t1 * cs - t2 * sn, o2 = t2 * cs + t1 * sn;
                    u32x4 w; w.x = cvt_pk_bf16(o1[0], o1[1]); w.y = cvt_pk_bf16(o1[2], o1[3]); w.z = cvt_pk_bf16(o2[0], o2[1]); w.w = cvt_pk_bf16(o2[2], o2[3]);
                    *(u32x4*)(rowp + bj * HALF) = w; } }
#pragma unroll
            for (int ai = 0; ai < 2; ++ai)
#pragma unroll
                for (int bj = 0; bj < 2; ++bj)
#pragma unroll
                    for (int n = 0; n < 2; ++n) { w_[ai][bj][0][n] = w_[ai][bj][1][n]; w_[ai][bj][1][n] = w_[ai][bj][2][n]; w_[ai][bj][2][n] = w_[ai][bj][3][n]; }
        }
    }
};
struct EpiResid {
    static constexpr bool PERM = false, AFTER_DRAIN = false;
    const float* res; float* out; const float* mod; bool do_store;
    __device__ __forceinline__ void operator()(const f32x4 (&acc)[2][2][4][2], const Unit& u, int wr, int wc, int fr, int fq) const {
        const int b = (u.pm * BM) / 8192; const float* gate = mod + b * 3072 + 2048;
        const int col0 = u.pn * BM + wc * 32 + 4 * fq;
        f32x4 gv[2][2];
#pragma unroll
        for (int bj = 0; bj < 2; ++bj)
#pragma unroll
            for (int n = 0; n < 2; ++n) gv[bj][n] = *(const f32x4*)(gate + col0 + bj * HALF + n * 16);
#pragma unroll
        for (int ai = 0; ai < 2; ++ai)
#pragma unroll
            for (int m = 0; m < 4; ++m) { const size_t off = (size_t)(u.pm * BM + ai * HALF + wr * 64 + m * 16 + fr) * 1024 + col0;
#pragma unroll
                for (int bj = 0; bj < 2; ++bj)
#pragma unroll
                    for (int n = 0; n < 2; ++n) { const f32x4 r = *(const f32x4*)(res + off + bj * HALF + n * 16); const f32x4 ov_ = r + gv[bj][n] * acc[ai][bj][m][n]; if (do_store) *(f32x4*)(out + off + bj * HALF + n * 16) = ov_; } }
    }
};
struct EpiResidH {
    static constexpr bool PERM = true, AFTER_DRAIN = false;
    const float* res; float* out; const float* mod0; const float* g1; const float* mod1; bf16_t* H; float* ssq1;
    __device__ __forceinline__ void operator()(const f32x4 (&acc)[2][2][4][2], const Unit& u, int wr, int wc, int fr, int fq) const {
        const int b = (u.pm * BM) / 8192; const float* gate = mod0 + b * 3072 + 2048; const float* sc1 = mod1 + b * 3072 + 1024;
        const int col0 = u.pn * BM + wc * 32 + 8 * fq;
        f32x4 gv[2][2], gs[2][2];
#pragma unroll
        for (int bj = 0; bj < 2; ++bj)
#pragma unroll
            for (int n = 0; n < 2; ++n) { const int c = col0 + bj * HALF + 4 * n; gv[bj][n] = *(const f32x4*)(gate + c); gs[bj][n] = *(const f32x4*)(g1 + c) * (*(const f32x4*)(sc1 + c) + 1.f); }
#pragma unroll
        for (int ai = 0; ai < 2; ++ai)
#pragma unroll
            for (int m = 0; m < 4; ++m) { const int row = u.pm * BM + ai * HALF + wr * 64 + m * 16 + fr; const size_t off = (size_t)row * 1024 + col0; float ss = 0.f;
#pragma unroll
                for (int bj = 0; bj < 2; ++bj) { const f32x4 x0 = *(const f32x4*)(res + off + bj * HALF) + gv[bj][0] * acc[ai][bj][m][0], x1 = *(const f32x4*)(res + off + bj * HALF + 4) + gv[bj][1] * acc[ai][bj][m][1];
                    *(f32x4*)(out + off + bj * HALF) = x0; *(f32x4*)(out + off + bj * HALF + 4) = x1;
                    ss += (x0[0] * x0[0] + x0[1] * x0[1]) + (x0[2] * x0[2] + x0[3] * x0[3]) + (x1[0] * x1[0] + x1[1] * x1[1]) + (x1[2] * x1[2] + x1[3] * x1[3]);
                    const f32x4 h0 = x0 * gs[bj][0], h1 = x1 * gs[bj][1];
                    u32x4 w; w.x = cvt_pk_bf16(h0[0], h0[1]); w.y = cvt_pk_bf16(h0[2], h0[3]); w.z = cvt_pk_bf16(h1[0], h1[1]); w.w = cvt_pk_bf16(h1[2], h1[3]);
                    *(u32x4*)(H + off + bj * HALF) = w; }
                ss += __shfl_xor(ss, 16); ss += __shfl_xor(ss, 32);
                if (fq == 0) atomicAdd(ssq1 + row, ss); }
    }
};
template <class Epi, class Sched, bool ALIGN_EPI = false, bool SP2 = false, bool RS = false>
__device__ __forceinline__ void gemm_phase(PG8_LAS unsigned char* lds, const Gemm g, const Sched& S, const Epi& E, const PG8_LAS float* rs = nullptr) {
    const int tid = threadIdx.x, wid = __builtin_amdgcn_readfirstlane(tid >> 6), lane = tid & 63, wr = wid >> 2, wc = wid & 3, fr = lane & 15, fq = lane >> 4;
    const int K = g.K, nt = K / BK;
    unsigned voffA[2], voffB[2];
#pragma unroll
    for (int i = 0; i < 2; ++i) { int R, C; stage_rc(tid * 16 + i * 8192, R, C); const int Rb = Epi::PERM ? ((R & ~31) + perm32(R & 31)) : R;
        voffA[i] = (unsigned)(R * K + C) * 2u; voffB[i] = (unsigned)(Rb * K + C) * 2u; }
    const size_t kstep = (size_t)(BK * 2);
    const size_t hstep = (size_t)HALF * K * 2;
    const size_t tstep = 2 * hstep;
    const unsigned ldsw = (unsigned)wid * 1024u;
    const int aoff = lds_byte(wr * 64 + fr, fq * 8), boff = lds_byte(wc * 32 + fr, fq * 8);
#define PG8_SA(b, h) (((b) * 2 + (h)) * HTB)
#define PG8_SB(b, h) ((4 + (b) * 2 + (h)) * HTB)
#define PG8_STAGE(bufoff, gbase, voff) do { _Pragma("unroll") for (int _i = 0; _i < 2; ++_i) \
        __builtin_amdgcn_global_load_lds((const unsigned*)((const char*)(gbase) + (voff)[_i]), (PG8_LAS unsigned*)(lds + (bufoff) + ldsw + _i * 8192), 16, 0, 0); } while (0)
#define PG8_LDA(dst, b, h) do { _Pragma("unroll") for (int m = 0; m < 4; ++m) _Pragma("unroll") for (int k = 0; k < 2; ++k) dst[m][k] = *(const PG8_LAS bf16x8*)(lds + PG8_SA(b, h) + aoff + m * 2048 + k * 1024); } while (0)
#define PG8_LDB(dst, b, h) do { _Pragma("unroll") for (int n = 0; n < 2; ++n) _Pragma("unroll") for (int k = 0; k < 2; ++k) dst[n][k] = *(const PG8_LAS bf16x8*)(lds + PG8_SB(b, h) + boff + n * 2048 + k * 1024); } while (0)
#define PG8_MMA(ai, bj, At, Bt) do { __builtin_amdgcn_s_setprio(1); _Pragma("unroll") for (int m = 0; m < 4; ++m) _Pragma("unroll") for (int n = 0; n < 2; ++n) _Pragma("unroll") for (int k = 0; k < 2; ++k) \
        acc[ai][bj][m][n] = __builtin_amdgcn_mfma_f32_16x16x32_bf16(Bt[n][k], At[m][k], acc[ai][bj][m][n], 0, 0, 0); __builtin_amdgcn_s_setprio(0); } while (0)
#define PG8_WAIT_V(n) asm volatile("s_waitcnt vmcnt(" #n ")" ::: "memory")
#define PG8_WAIT_L(n) asm volatile("s_waitcnt lgkmcnt(" #n ")" ::: "memory")
#define PG8_BAR __builtin_amdgcn_s_barrier()
#define PG8_SCHED __builtin_amdgcn_sched_barrier(0)
    Unit cur, nxt; int ui = 0;
    if (!S.next(0, cur)) return;
    f32x4 acc[2][2][4][2];
#pragma unroll
    for (int a = 0; a < 2; ++a)
#pragma unroll
        for (int b = 0; b < 2; ++b)
#pragma unroll
            for (int m = 0; m < 4; ++m)
#pragma unroll
                for (int n = 0; n < 2; ++n) acc[a][b][m][n] = (f32x4){0.f, 0.f, 0.f, 0.f};
    bf16x8 At[4][2], B0[2][2], B1[2][2];
    const char* cA = (const char*)g.A + (size_t)cur.pm * tstep; const char* cB = (const char*)g.Bt + (size_t)cur.pn * tstep;
    S.a_ready(cur);
    if constexpr (SP2) {
        PG8_STAGE(PG8_SB(0, 0), cB, voffB); PG8_STAGE(PG8_SB(0, 1), cB + hstep, voffB); PG8_STAGE(PG8_SA(0, 0), cA, voffA); PG8_STAGE(PG8_SA(0, 1), cA + hstep, voffA);
        if (wr == 1) PG8_BAR;
        PG8_WAIT_V(2); PG8_BAR;
        PG8_STAGE(PG8_SB(1, 0), cB + kstep, voffB); PG8_STAGE(PG8_SA(1, 0), cA + kstep, voffA); PG8_STAGE(PG8_SB(1, 1), cB + hstep + kstep, voffB);
        PG8_WAIT_V(6); PG8_BAR;
    } else {
        PG8_STAGE(PG8_SB(0, 0), cB, voffB); PG8_STAGE(PG8_SA(0, 0), cA, voffA); PG8_STAGE(PG8_SB(0, 1), cB + hstep, voffB); PG8_STAGE(PG8_SA(0, 1), cA + hstep, voffA);
        if (wr == 1) PG8_BAR;
        PG8_WAIT_V(4); PG8_BAR;
        PG8_STAGE(PG8_SB(1, 0), cB + kstep, voffB); PG8_STAGE(PG8_SA(1, 0), cA + kstep, voffA); PG8_STAGE(PG8_SB(1, 1), cB + hstep + kstep, voffB);
        PG8_WAIT_V(6); PG8_BAR;
    }
    for (;;) {
        const bool has_next = S.next(ui + 1, nxt);
        const char* nA = has_next ? (const char*)g.A + (size_t)nxt.pm * tstep : cA; const char* nB = has_next ? (const char*)g.Bt + (size_t)nxt.pn * tstep : cB;
        for (int t = 0; t < nt; t += 2) {
            if constexpr (RS) { if (t == 8 || t == 16) { const int sel = (t == 16);
#pragma unroll
                for (int ai = 0; ai < 2; ++ai)
#pragma unroll
                    for (int m = 0; m < 4; ++m) { const float sc = rs[(ai * HALF + wr * 64 + m * 16 + fr) * 2 + sel];
#pragma unroll
                        for (int bj = 0; bj < 2; ++bj)
#pragma unroll
                            for (int n = 0; n < 2; ++n) acc[ai][bj][m][n] = acc[ai][bj][m][n] * sc; } } }
            const bool last = (t == nt - 2);
            const char* a1 = cA + (size_t)(t + 1) * kstep;
            const char* a2 = last ? nA : cA + (size_t)(t + 2) * kstep; const char* b2 = last ? nB : cB + (size_t)(t + 2) * kstep;
            const char* a3 = a2 + kstep; const char* b3 = b2 + kstep;
            if (last && has_next) S.a_ready(nxt);
            if constexpr (SP2) {
            PG8_LDB(B0, 0, 0); PG8_LDB(B1, 0, 1); PG8_SCHED; PG8_LDA(At, 0, 0); PG8_STAGE(PG8_SA(1, 1), a1 + hstep, voffA);
            PG8_WAIT_V(8); PG8_WAIT_L(0); PG8_BAR; PG8_MMA(0, 0, At, B0); PG8_MMA(0, 1, At, B1); PG8_BAR; PG8_SCHED;
            PG8_LDA(At, 0, 1); PG8_STAGE(PG8_SB(0, 0), b2, voffB); PG8_STAGE(PG8_SB(0, 1), b2 + hstep, voffB); PG8_STAGE(PG8_SA(0, 0), a2, voffA);
            PG8_WAIT_V(8); PG8_WAIT_L(0); PG8_BAR; PG8_MMA(1, 0, At, B0); PG8_MMA(1, 1, At, B1); PG8_BAR; PG8_SCHED;
            PG8_LDB(B0, 1, 0); PG8_LDB(B1, 1, 1); PG8_SCHED; PG8_LDA(At, 1, 0); PG8_STAGE(PG8_SA(0, 1), a2 + hstep, voffA);
            PG8_WAIT_V(8); PG8_WAIT_L(0); PG8_BAR; PG8_MMA(0, 0, At, B0); PG8_MMA(0, 1, At, B1); PG8_BAR; PG8_SCHED;
            PG8_LDA(At, 1, 1); PG8_STAGE(PG8_SB(1, 0), b3, voffB); PG8_STAGE(PG8_SB(1, 1), b3 + hstep, voffB); PG8_STAGE(PG8_SA(1, 0), a3, voffA);
            PG8_WAIT_V(8); PG8_WAIT_L(0); PG8_BAR; PG8_MMA(1, 0, At, B0); PG8_MMA(1, 1, At, B1); PG8_BAR; PG8_SCHED;
            } else {
            PG8_LDB(B0, 0, 0); PG8_SCHED; PG8_LDA(At, 0, 0); PG8_STAGE(PG8_SA(1, 1), a1 + hstep, voffA);
            PG8_WAIT_L(8); PG8_BAR; PG8_WAIT_L(0); PG8_MMA(0, 0, At, B0); PG8_BAR; PG8_SCHED;
            PG8_LDB(B1, 0, 1); PG8_STAGE(PG8_SB(0, 0), b2, voffB);
            PG8_BAR; PG8_WAIT_L(0); PG8_MMA(0, 1, At, B1); PG8_BAR;
            PG8_LDA(At, 0, 1); PG8_STAGE(PG8_SA(0, 0), a2, voffA);
            PG8_BAR; PG8_WAIT_L(0); PG8_MMA(1, 0, At, B0); PG8_BAR; PG8_SCHED;
            PG8_STAGE(PG8_SB(0, 1), b2 + hstep, voffB);
            PG8_WAIT_V(6); PG8_BAR; PG8_MMA(1, 1, At, B1); PG8_BAR;
            PG8_LDB(B0, 1, 0); PG8_SCHED; PG8_LDA(At, 1, 0); PG8_STAGE(PG8_SA(0, 1), a2 + hstep, voffA);
            PG8_WAIT_L(8); PG8_BAR; PG8_WAIT_L(0); PG8_MMA(0, 0, At, B0); PG8_BAR; PG8_SCHED;
            PG8_LDB(B1, 1, 1); PG8_STAGE(PG8_SB(1, 0), b3, voffB);
            PG8_BAR; PG8_WAIT_L(0); PG8_MMA(0, 1, At, B1); PG8_BAR;
            PG8_LDA(At, 1, 1); PG8_STAGE(PG8_SA(1, 0), a3, voffA);
            PG8_BAR; PG8_WAIT_L(0); PG8_MMA(1, 0, At, B0); PG8_BAR; PG8_SCHED;
            PG8_STAGE(PG8_SB(1, 1), b3 + hstep, voffB);
            PG8_WAIT_V(6); PG8_BAR; PG8_MMA(1, 1, At, B1); PG8_BAR;
            }
        }
        if constexpr (ALIGN_EPI) { if (wr == 0) PG8_BAR; }
        if constexpr (!Epi::AFTER_DRAIN) { E(acc, cur, wr, wc, fr, fq); S.done(cur); }
        if (!has_next) break;
#pragma unroll
        for (int a = 0; a < 2; ++a)
#pragma unroll
            for (int b = 0; b < 2; ++b)
#pragma unroll
                for (int m = 0; m < 4; ++m)
#pragma unroll
                    for (int n = 0; n < 2; ++n) acc[a][b][m][n] = (f32x4){0.f, 0.f, 0.f, 0.f};
        cur = nxt; cA = nA; cB = nB; ++ui;
        if constexpr (ALIGN_EPI) { if (wr == 1) PG8_BAR; }
    }
    PG8_WAIT_V(0);
    if constexpr (!ALIGN_EPI) { if (wr == 0) PG8_BAR; }
    PG8_BAR;
    if constexpr (Epi::AFTER_DRAIN) { E.fused(acc, cur, wr, wc, fr, fq, lds, wid, lane); S.done(cur); }
#undef PG8_SA
#undef PG8_SB
#undef PG8_STAGE
#undef PG8_LDA
#undef PG8_LDB
#undef PG8_MMA
#undef PG8_WAIT_V
#undef PG8_WAIT_L
#undef PG8_BAR
#undef PG8_SCHED
}
}
#define LAS __attribute__((address_space(3)))
typedef unsigned v4u __attribute__((ext_vector_type(4)));
typedef float f32x4 __attribute__((ext_vector_type(4)));
typedef short bf16x8 __attribute__((ext_vector_type(8)));
#define LDS_WAIT() asm volatile("s_waitcnt lgkmcnt(0)" ::: "memory")
constexpr int NWAVES = 8;
constexpr int LDS_BYTES = 147456;
constexpr int MISC_OFF = 147456 - 128;

struct Params { const float* in[26]; float* out; unsigned char* ws; int ph_lo, ph_hi, rep, pad; };

DEV int virt_block() { const int G = (int)gridDim.x, b = (int)blockIdx.x; return (G % 8 == 0) ? (b % 8) * (G / 8) + b / 8 : b; }
DEV float wave_sum(float v) {
#pragma unroll
  for (int o = 1; o < 64; o <<= 1) v += __shfl_xor(v, o);
  return v;
}

DEV int w1_dest_row(int n) {
  if (n < 1024) return n;
  if (n < 2560) return 2048 + (n - 1024);
  if (n < 2592) return 5632 + (n - 2560);
  if (n < 3104) return 3584 + (n - 2592);
  if (n < 3616) return 4096 + (n - 3104);
  if (n < 4640) return 4608 + (n - 3616);
  if (n < 5664) return 1024 + (n - 4640);
  return n;
}
DEV int qk_pos(int d) { const int a = d >> 6, s = (d >> 5) & 1, f = d & 31; return 32 * (2 * a + (f >> 4)) + 8 * ((f >> 2) & 3) + 4 * s + (f & 3); }
DEV void transpose_item(const float* W, int K, int N, int k0, int n0, bf16_t* WT, int drow0, LAS float* scr, int lane, int headbase = -1, const float* kscale = nullptr, const float* shv = nullptr, float* cb = nullptr) {
#pragma unroll 8
  for (int i = 0; i < 32; ++i) { const int kk = 2 * i + (lane >> 5); scr[kk * 33 + (lane & 31)] = W[(size_t)(k0 + kk) * N + n0 + (lane & 31)]; }
  LDS_WAIT(); asm volatile("" ::: "memory");
  if (cb) {
    const int nn = lane & 31, hf = lane >> 5; float s0 = 0.f, s1 = 0.f, s2 = 0.f;
#pragma unroll 8
    for (int i = 0; i < 32; ++i) { const float w = scr[(hf * 32 + i) * 33 + nn]; const int k = k0 + hf * 32 + i; s0 += shv[k] * w; s1 += shv[3072 + k] * w; s2 += shv[6144 + k] * w; }
    s0 += __shfl_xor(s0, 32); s1 += __shfl_xor(s1, 32); s2 += __shfl_xor(s2, 32);
    if (hf == 0) { const int drow = headbase >= 0 ? headbase + qk_pos((n0 & 127) + nn) : drow0 + nn; atomicAdd(cb + drow, s0); atomicAdd(cb + N + drow, s1); atomicAdd(cb + 2 * N + drow, s2); } }
  const int c = lane & 7;
#pragma unroll
  for (int j = 0; j < 4; ++j) { const int n = (lane >> 3) + 8 * j; const LAS float* s = scr + (8 * c) * 33 + n;
    f32x4 k0s = {1.f, 1.f, 1.f, 1.f}, k1s = k0s; if (kscale) { k0s = *(const f32x4*)(kscale + k0 + 8 * c); k1s = *(const f32x4*)(kscale + k0 + 8 * c + 4); }
    v4u o; o.x = pk2(s[0 * 33] * k0s.x, s[1 * 33] * k0s.y); o.y = pk2(s[2 * 33] * k0s.z, s[3 * 33] * k0s.w); o.z = pk2(s[4 * 33] * k1s.x, s[5 * 33] * k1s.y); o.w = pk2(s[6 * 33] * k1s.z, s[7 * 33] * k1s.w);
    const int drow = headbase >= 0 ? headbase + qk_pos((n0 & 127) + n) : drow0 + n;
    *(v4u*)(WT + (size_t)drow * K + k0 + 8 * c) = o; }
  LDS_WAIT(); asm volatile("" ::: "memory");
}
DEV void prologue_phase(const Params& p, LAS unsigned char* lds) {
  const int tid = threadIdx.x, lane = tid & 63, wave = tid >> 6;
  unsigned char* ws = p.ws;
  float* MOD = (float*)(ws + WS_MOD);
  {
    LAS float* sc = (LAS float*)lds;
    LAS float* part = (LAS float*)(lds + 12288);
    for (int i = tid; i < 3072; i += 512) { const int v = i >> 10, k = i & 1023; const float cv = v < 2 ? p.in[1][v * 1024 + k] : p.in[3][k]; sc[i] = siluf(cv); }
    __syncthreads();
    for (int task = blockIdx.x; task < 192; task += gridDim.x) {
      const int l = task / 96, n0 = (task % 96) * 32; const float* w = l ? p.in[19] : p.in[5]; const float* bb = l ? p.in[20] : p.in[6];
      const int col = tid & 31, ks = tid >> 5;
      float a0 = 0.f, a1 = 0.f, a2 = 0.f;
#pragma unroll 16
      for (int k = ks * 64; k < ks * 64 + 64; ++k) { const float wv = w[(size_t)k * 3072 + n0 + col]; a0 += sc[k] * wv; a1 += sc[1024 + k] * wv; a2 += sc[2048 + k] * wv; }
      part[(ks * 3 + 0) * 32 + col] = a0; part[(ks * 3 + 1) * 32 + col] = a1; part[(ks * 3 + 2) * 32 + col] = a2;
      __syncthreads();
      if (tid < 96) { const int v = tid >> 5; float s = bb[n0 + col];
#pragma unroll
        for (int q = 0; q < 16; ++q) s += part[(q * 3 + v) * 32 + col];
        MOD[(l * 3 + v) * 3072 + n0 + col] = s; }
      __syncthreads();
    }
  }
  if (blockIdx.x == gridDim.x - 1) { float* rope = (float*)(ws + WS_ROPE);
    for (int idx = tid; idx < 4096; idx += 512) { const int pos = idx >> 5, f = idx & 31; const float inv = 1.0f / powf(10000.f, (float)f / 32.f); const float ang = (float)pos * inv; rope[idx] = cosf(ang); rope[4096 + idx] = sinf(ang); } }
  { v4u* z = (v4u*)(ws + WS_W1T + (size_t)E_IN * 1024 * 2); const v4u zero = {0u, 0u, 0u, 0u};
    for (int i = blockIdx.x * 512 + tid; i < (E_INP - E_IN) * 1024 * 2 / 16; i += gridDim.x * 512) z[i] = zero; }
  __syncthreads();
  {
    LAS float* scr = (LAS float*)(lds + wave * 16384);
    const int gw = blockIdx.x * NWAVES + wave, NGW = gridDim.x * NWAVES;
    constexpr int I1 = 16 * 178;
    for (int it = gw; it < I1; it += NGW) { const int kb = it / 178, nb = it % 178; transpose_item(p.in[7], 1024, E_IN, 64 * kb, 32 * nb, (bf16_t*)(ws + WS_W1T), w1_dest_row(32 * nb), scr, lane); }
  }
}
DEV void late_weights(const Params& p, LAS unsigned char* lds, int vblock, int nvblocks) {
  const int lane = threadIdx.x & 63, wave = threadIdx.x >> 6; unsigned char* ws = p.ws;
  LAS float* scr = (LAS float*)(lds + wave * 16384);
  constexpr int I2 = 32 * 32, I3 = 16 * 160, I4 = 32 * 32;
  for (int it = vblock * NWAVES + wave; it < I2 + I3 + I4; it += nvblocks * NWAVES) {
    int r = it;
    if (r < I2) { const int kb = r / 32, nb = r % 32; transpose_item(p.in[17], 2048, 1024, 64 * kb, 32 * nb, (bf16_t*)(ws + WS_W2T), 32 * nb, scr, lane, -1, kb < 16 ? p.in[13] : nullptr); continue; }
    r -= I2;
    if (r < I3) { const int kb = r / 160, nb = r % 160, n0 = 32 * nb; const bool qk = n0 < 512 || (n0 >= 1024 && n0 < 3072);
      transpose_item(p.in[21], 1024, O_IN, 64 * kb, n0, (bf16_t*)(ws + WS_W3T), n0, scr, lane, qk ? (n0 & ~127) : -1, nullptr, (const float*)(ws + WS_MOD) + 3 * 3072, (float*)(ws + WS_CB)); continue; } r -= I3;
    { const int kb = r / 32, nb = r % 32; transpose_item(p.in[25], 2048, 1024, 64 * kb, 32 * nb, (bf16_t*)(ws + WS_W4T), 32 * nb, scr, lane); }
  }
}
DEV void prep_phase(const float* xlat, const float* xctx, const float* g, const float* mod, bf16_t* H) {
  const int lane = threadIdx.x & 63, wave = threadIdx.x >> 6, NW = gridDim.x * NWAVES;
  for (int row = blockIdx.x * NWAVES + wave; row < MA; row += 2 * NW) {
    const int row2 = row + NW; const bool has2 = row2 < MA;
    const float* s0 = row < ML ? xlat + (size_t)row * D : xctx + (size_t)(row - ML) * D;
    const float* s1 = has2 ? (row2 < ML ? xlat + (size_t)row2 * D : xctx + (size_t)(row2 - ML) * D) : s0;
    f32x4 v0[4], v1[4]; float ss0 = 0.f, ss1 = 0.f;
#pragma unroll
    for (int j = 0; j < 4; ++j) { v0[j] = *(const f32x4*)(s0 + 4 * lane + 256 * j); v1[j] = *(const f32x4*)(s1 + 4 * lane + 256 * j); }
#pragma unroll
    for (int j = 0; j < 4; ++j) { ss0 += (v0[j].x * v0[j].x + v0[j].y * v0[j].y) + (v0[j].z * v0[j].z + v0[j].w * v0[j].w); ss1 += (v1[j].x * v1[j].x + v1[j].y * v1[j].y) + (v1[j].z * v1[j].z + v1[j].w * v1[j].w); }
#pragma unroll
    for (int o = 1; o < 64; o <<= 1) { ss0 += __shfl_xor(ss0, o); ss1 += __shfl_xor(ss1, o); }
    const float r0 = rsqrtf(ss0 * (1.f / D) + EPS), r1 = rsqrtf(ss1 * (1.f / D) + EPS);
    const float* m0 = mod + row_vec(row) * 3072; const float* m1 = mod + row_vec(has2 ? row2 : row) * 3072;
#pragma unroll
    for (int j = 0; j < 4; ++j) { const int k = 4 * lane + 256 * j; const f32x4 gg = *(const f32x4*)(g + k);
      { const f32x4 sc = *(const f32x4*)(m0 + 1024 + k), sh = *(const f32x4*)(m0 + k); const f32x4 o = v0[j] * r0 * gg * (sc + 1.f) + sh;
        *(unsigned long long*)(H + (size_t)row * D + k) = (unsigned long long)pk2(o.x, o.y) | ((unsigned long long)pk2(o.z, o.w) << 32); }
      if (has2) { const f32x4 sc = *(const f32x4*)(m1 + 1024 + k), sh = *(const f32x4*)(m1 + k); const f32x4 o = v1[j] * r1 * gg * (sc + 1.f) + sh;
        *(unsigned long long*)(H + (size_t)row2 * D + k) = (unsigned long long)pk2(o.x, o.y) | ((unsigned long long)pk2(o.z, o.w) << 32); } }
  }
}
template <class F> DEV void small_gemm(const bf16_t* A, int lda, const bf16_t* Bt, int ldb, int K, int Mrows, int Ncols, F f) {
  const int lane = threadIdx.x & 63, wid = threadIdx.x >> 6, mt = wid >> 2, nt = wid & 3, r = lane & 15, q = lane >> 4;
  const int ntn = Ncols / 64, ntasks = (Mrows / 32) * ntn;
  for (int task = blockIdx.x; task < ntasks; task += gridDim.x) {
    const int row0 = (task / ntn) * 32 + mt * 16, col0 = (task % ntn) * 64 + nt * 16;
    const bf16_t* ap = A + (size_t)(row0 + r) * lda + 8 * q; const bf16_t* bp = Bt + (size_t)(col0 + r) * ldb + 8 * q;
    f32x4 acc = {0.f, 0.f, 0.f, 0.f};
#pragma unroll 8
    for (int k = 0; k < K; k += 32) { const bf16x8 a = *(const bf16x8*)(ap + k), b = *(const bf16x8*)(bp + k); acc = __builtin_amdgcn_mfma_f32_16x16x32_bf16(a, b, acc, 0, 0, 0); }
#pragma unroll
    for (int j = 0; j < 4; ++j) f(row0 + q * 4 + j, col0 + r, acc[j]);
  }
}

template <class F> DEV void small_gemm_splitk(const bf16_t* A, int lda, const bf16_t* Bt, int ldb, int K, int Mrows, int Ncols, LAS unsigned char* lds, float* rowsum  , const float* ssq  , F f) {
  const int tid = threadIdx.x, lane = tid & 63, wid = tid >> 6, r = lane & 15, q = lane >> 4;
  LAS float* red = (LAS float*)lds;
  const int ntn = Ncols / 64, ntasks = (Mrows / 32) * ntn, kw = K / 8;
  for (int task = virt_block(); task < ntasks; task += gridDim.x) {
    const int row0 = (task / ntn) * 32, col0 = (task % ntn) * 64;
    asm volatile("s_waitcnt vmcnt(0)" ::: "memory");
    const bf16_t* ap = A + (size_t)(row0 + r) * lda + wid * kw + 8 * q; const bf16_t* bp = Bt + (size_t)(col0 + r) * ldb + wid * kw + 8 * q;
    f32x4 acc[2][4];
#pragma unroll
    for (int mt = 0; mt < 2; ++mt)
#pragma unroll
      for (int nt = 0; nt < 4; ++nt) acc[mt][nt] = (f32x4){0.f, 0.f, 0.f, 0.f};
#pragma unroll 4
    for (int k = 0; k < kw; k += 32) {
      bf16x8 a[2], b[4];
#pragma unroll
      for (int mt = 0; mt < 2; ++mt) a[mt] = *(const bf16x8*)(ap + (size_t)(16 * mt) * lda + k);
#pragma unroll
      for (int nt = 0; nt < 4; ++nt) b[nt] = *(const bf16x8*)(bp + (size_t)(16 * nt) * ldb + k);
#pragma unroll
      for (int mt = 0; mt < 2; ++mt)
#pragma unroll
        for (int nt = 0; nt < 4; ++nt) acc[mt][nt] = __builtin_amdgcn_mfma_f32_16x16x32_bf16(a[mt], b[nt], acc[mt][nt], 0, 0, 0);
    }
    __syncthreads();
#pragma unroll
    for (int mt = 0; mt < 2; ++mt)
#pragma unroll
      for (int nt = 0; nt < 4; ++nt)
#pragma unroll
        for (int j = 0; j < 4; ++j) { const int rl = 16 * mt + 4 * q + j; float sc = 1.f;
          if (ssq && wid < 4) { const float* sp = ssq + ((size_t)(row0 + rl) * 2 + (wid >> 1)) * 2; sc = rsqrtf((sp[0] + sp[1]) * (1.f / 512.f) + EPS); }
          red[wid * 2048 + rl * 64 + 16 * nt + r] = acc[mt][nt][j] * sc; }
    __syncthreads();
#pragma unroll
    for (int o = 0; o < 4; ++o) { const int e = tid + 512 * o; float s = 0.f;
#pragma unroll
      for (int w = 0; w < 8; ++w) s += red[w * 2048 + e];
      float rv = f(row0 + (e >> 6), col0 + (e & 63), s, __shfl_xor(s, 1));
      if (rowsum) { rv = wave_sum(rv); if (lane == 0) atomicAdd(rowsum + row0 + (e >> 6), rv); } }
  }
}

DEV void qknorm_phase(bf16_t* Q1, bf16_t* K1, const float* qn, const float* kn, const float* rope, bool wr) {
  const int lane = threadIdx.x & 63, wave = threadIdx.x >> 6, hl = lane >> 4, d0 = (lane & 15) * 8;
  const float scale = 0.08838834764831845f * 1.4426950408889634f;
  float gq[8], gk[8];
#pragma unroll
  for (int e = 0; e < 8; ++e) { gq[e] = qn[d0 + e] * scale; gk[e] = kn[d0 + e]; }
  const int ax = d0 >> 6, sgn = (d0 >> 5) & 1, f0 = d0 & 31;
  for (int row = blockIdx.x * NWAVES + wave; row < MA; row += gridDim.x * NWAVES) {
    const bool lat = row < ML;
    v4u raw[5];
    raw[0] = *(const v4u*)(K1 + (size_t)row * 512 + hl * 128 + d0);
    if (lat) {
#pragma unroll
      for (int g = 0; g < 4; ++g) raw[1 + g] = *(const v4u*)(Q1 + (size_t)row * 2048 + (g * 4 + hl) * 128 + d0);
    }
    float cs[8], sn[8];
    if (lat) { const int t = row % SEQ, pos = ax ? (t & 63) : (t >> 6);
      const f32x4 c0 = *(const f32x4*)(rope + pos * 32 + f0), c1 = *(const f32x4*)(rope + pos * 32 + f0 + 4), s0 = *(const f32x4*)(rope + 4096 + pos * 32 + f0), s1 = *(const f32x4*)(rope + 4096 + pos * 32 + f0 + 4);
      cs[0] = c0.x; cs[1] = c0.y; cs[2] = c0.z; cs[3] = c0.w; cs[4] = c1.x; cs[5] = c1.y; cs[6] = c1.z; cs[7] = c1.w;
      sn[0] = s0.x; sn[1] = s0.y; sn[2] = s0.z; sn[3] = s0.w; sn[4] = s1.x; sn[5] = s1.y; sn[6] = s1.z; sn[7] = s1.w; }
    const int ng = lat ? 5 : 1;
#pragma unroll
    for (int g = 0; g < 5; ++g) {
      if (g < ng) {
        const v4u rv = raw[g];
        float v[8] = {__uint_as_float(rv.x << 16), __uint_as_float(rv.x & 0xffff0000u), __uint_as_float(rv.y << 16), __uint_as_float(rv.y & 0xffff0000u), __uint_as_float(rv.z << 16), __uint_as_float(rv.z & 0xffff0000u), __uint_as_float(rv.w << 16), __uint_as_float(rv.w & 0xffff0000u)};
        float ss = 0.f;
#pragma unroll
        for (int e = 0; e < 8; ++e) ss += v[e] * v[e];
        ss += __shfl_xor(ss, 1); ss += __shfl_xor(ss, 2); ss += __shfl_xor(ss, 4); ss += __shfl_xor(ss, 8);
        const float rstd = rsqrtf(ss * (1.f / 128.f) + EPS);
#pragma unroll
        for (int e = 0; e < 8; ++e) v[e] *= rstd * (g == 0 ? gk[e] : gq[e]);
        if (lat) {
#pragma unroll
          for (int e = 0; e < 8; ++e) { const float o = __shfl_xor(v[e], 4); v[e] = sgn ? (v[e] * cs[e] + o * sn[e]) : (v[e] * cs[e] - o * sn[e]); }
        }
        v4u ov; ov.x = pk2(v[0], v[1]); ov.y = pk2(v[2], v[3]); ov.z = pk2(v[4], v[5]); ov.w = pk2(v[6], v[7]);
        if (wr) { if (g == 0) *(v4u*)(K1 + (size_t)row * 512 + hl * 128 + d0) = ov; else *(v4u*)(Q1 + (size_t)row * 2048 + ((g - 1) * 4 + hl) * 128 + d0) = ov; }
      }
    }
  }
}
typedef short s16x4 __attribute__((ext_vector_type(4)));
DEV s16x4 tr_read(const LAS bf16_t* p) { return __builtin_bit_cast(s16x4, __builtin_amdgcn_ds_read_tr16_b64_v4i16((LAS s16x4*)p)); }
DEV void attn_phase(bf16_t* Q1, const bf16_t* K1, const bf16_t* V1, const bf16_t* G1, const float* sink, const float* qn, const float* kn, LAS unsigned char* lds, bool wr) {
  constexpr int KP = 136, VP = 144;
  LAS bf16_t* Ks = (LAS bf16_t*)lds;
  LAS bf16_t* Vs = (LAS bf16_t*)(lds + 2 * 64 * KP * 2);
  LAS float* dsc = (LAS float*)(lds + 2 * 64 * KP * 2 + 2 * 64 * VP * 2);
  const int tid = threadIdx.x, lane = tid & 63, wid = tid >> 6, r = lane & 15, Qd = lane >> 4;
  float mb;
  { float a = fmaxf(fabsf(qn[lane]), fabsf(qn[64 + lane])), b = fmaxf(fabsf(kn[lane]), fabsf(kn[64 + lane]));
#pragma unroll
    for (int o = 1; o < 64; o <<= 1) { a = fmaxf(a, __shfl_xor(a, o)); b = fmaxf(b, __shfl_xor(b, o)); }
    mb = a * b * 11.313708498984761f * 1.4426950408889634f; }
  for (int task = virt_block(); task < 1024; task += gridDim.x) {
    const int b = task >> 9, kvh = (task >> 7) & 3, qt = task & 127;
    const int hq = kvh * 4 + (wid >> 1), qoff = (wid & 1) * 32;
    const size_t qrow0 = (size_t)b * SEQ + qt * 64 + qoff;
    bf16x8 qf[2][4];
#pragma unroll
    for (int m = 0; m < 2; ++m)
#pragma unroll
      for (int ks = 0; ks < 4; ++ks) qf[m][ks] = *(const bf16x8*)(Q1 + (qrow0 + 16 * m + r) * 2048 + hq * 128 + ks * 32 + 8 * Qd);
    const int tlo = (2 - qt) > 0 ? (2 - qt) : 0, thi = (129 - qt) < 4 ? (129 - qt) : 4, nband = thi - tlo + 1, ntile = nband + 4;
    const int skey = tid >> 4, sch = tid & 15;
    float gk[8];
    { const int dA = ((sch >> 2) >> 1) * 64 + 16 * ((sch >> 2) & 1) + 4 * (sch & 3); const f32x4 ga = *(const f32x4*)(kn + dA), gb_ = *(const f32x4*)(kn + dA + 32);
      gk[0] = ga.x; gk[1] = ga.y; gk[2] = ga.z; gk[3] = ga.w; gk[4] = gb_.x; gk[5] = gb_.y; gk[6] = gb_.z; gk[7] = gb_.w; }
    v4u kreg[2], vreg[2];
#define TILE_ROW0(i) ((i) < nband ? (size_t)b * SEQ + (size_t)(qt - 2 + tlo + (i)) * 64 : (size_t)ML + b * CTXL + ((i) - nband) * 64)
#define LOAD_TILE(i) do { const size_t r0_ = TILE_ROW0(i); _Pragma("unroll") for (int h_ = 0; h_ < 2; ++h_) { const size_t go_ = (r0_ + skey + 32 * h_) * 512 + kvh * 128 + sch * 8; kreg[h_] = *(const v4u*)(K1 + go_); vreg[h_] = *(const v4u*)(V1 + go_); } } while (0)
#define STORE_TILE(buf, ti) do { const bool ctx_ = (ti) >= nband; _Pragma("unroll") for (int h_ = 0; h_ < 2; ++h_) { v4u kw_ = kreg[h_]; \
      if (ctx_) { float v_[8] = {__uint_as_float(kw_.x << 16), __uint_as_float(kw_.x & 0xffff0000u), __uint_as_float(kw_.y << 16), __uint_as_float(kw_.y & 0xffff0000u), __uint_as_float(kw_.z << 16), __uint_as_float(kw_.z & 0xffff0000u), __uint_as_float(kw_.w << 16), __uint_as_float(kw_.w & 0xffff0000u)}; \
        float ss_ = 0.f; _Pragma("unroll") for (int e_ = 0; e_ < 8; ++e_) ss_ += v_[e_] * v_[e_]; \
        ss_ += __shfl_xor(ss_, 1); ss_ += __shfl_xor(ss_, 2); ss_ += __shfl_xor(ss_, 4); ss_ += __shfl_xor(ss_, 8); \
        const float rs_ = rsqrtf(ss_ * (1.f / 128.f) + EPS); _Pragma("unroll") for (int e_ = 0; e_ < 8; ++e_) v_[e_] *= rs_ * gk[e_]; \
        kw_.x = pk2(v_[0], v_[1]); kw_.y = pk2(v_[2], v_[3]); kw_.z = pk2(v_[4], v_[5]); kw_.w = pk2(v_[6], v_[7]); } \
      *(LAS v4u*)(Ks + (buf) * 64 * KP + (skey + 32 * h_) * KP + sch * 8) = kw_; *(LAS v4u*)(Vs + (buf) * 64 * VP + (skey + 32 * h_) * VP + sch * 8) = vreg[h_]; } } while (0)
    LOAD_TILE(0);
    __syncthreads();
    STORE_TILE(0, 0);
    __syncthreads();
    f32x4 o[2][8];
#pragma unroll
    for (int m = 0; m < 2; ++m)
#pragma unroll
      for (int n = 0; n < 8; ++n) o[m][n] = (f32x4){0.f, 0.f, 0.f, 0.f};
    float lsum[2] = {0.f, 0.f};
    for (int i = 0; i < ntile; ++i) {
      const int buf = i & 1;
      if (i + 1 < ntile) LOAD_TILE(i + 1);
      const int mtype = (i < nband) ? ((tlo + i) == 0 ? 1 : ((tlo + i) == 4 ? 2 : 0)) : 0;
      const LAS bf16_t* Kb = Ks + buf * 64 * KP; const LAS bf16_t* Vb = Vs + buf * 64 * VP;
      f32x4 s[4][2];
#pragma unroll
      for (int t = 0; t < 4; ++t) { s[t][0] = (f32x4){-mb, -mb, -mb, -mb}; s[t][1] = (f32x4){-mb, -mb, -mb, -mb}; }
#pragma unroll
      for (int ks = 0; ks < 4; ++ks)
#pragma unroll
        for (int t = 0; t < 4; ++t) { const bf16x8 kf = *(const LAS bf16x8*)(Kb + (16 * t + r) * KP + ks * 32 + 8 * Qd);
          s[t][0] = __builtin_amdgcn_mfma_f32_16x16x32_bf16(kf, qf[0][ks], s[t][0], 0, 0, 0);
          s[t][1] = __builtin_amdgcn_mfma_f32_16x16x32_bf16(kf, qf[1][ks], s[t][1], 0, 0, 0); }
      bf16x8 pa[2][2];
#pragma unroll
      for (int m = 0; m < 2; ++m) { const int qi = qoff + 16 * m + r;
#pragma unroll
        for (int t = 0; t < 4; ++t) {
          float pv[4];
#pragma unroll
          for (int j = 0; j < 4; ++j) { const int kj = 16 * t + 4 * Qd + j; float pj = __builtin_amdgcn_exp2f(s[t][m][j]);
            if (mtype != 0) { if (mtype == 1) pj = (kj >= qi) ? pj : 0.f; else pj = (kj <= qi) ? pj : 0.f; }
            pv[j] = pj; lsum[m] += pj; }
          const unsigned w0 = pk2(pv[0], pv[1]), w1 = pk2(pv[2], pv[3]);
          pa[m][t >> 1][(t & 1) * 4 + 0] = (short)(w0 & 0xffff); pa[m][t >> 1][(t & 1) * 4 + 1] = (short)(w0 >> 16);
          pa[m][t >> 1][(t & 1) * 4 + 2] = (short)(w1 & 0xffff); pa[m][t >> 1][(t & 1) * 4 + 3] = (short)(w1 >> 16); } }
#pragma unroll
      for (int k2 = 0; k2 < 2; ++k2)
#pragma unroll
        for (int n = 0; n < 8; ++n) {
          const s16x4 lo = tr_read(Vb + (32 * k2 + 4 * Qd + (r >> 2)) * VP + 16 * n + 4 * (r & 3));
          const s16x4 hi = tr_read(Vb + (32 * k2 + 16 + 4 * Qd + (r >> 2)) * VP + 16 * n + 4 * (r & 3));
          const bf16x8 vf = (bf16x8){lo[0], lo[1], lo[2], lo[3], hi[0], hi[1], hi[2], hi[3]};
          o[0][n] = __builtin_amdgcn_mfma_f32_16x16x32_bf16(pa[0][k2], vf, o[0][n], 0, 0, 0);
          o[1][n] = __builtin_amdgcn_mfma_f32_16x16x32_bf16(pa[1][k2], vf, o[1][n], 0, 0, 0); }
      if (i + 1 < ntile) STORE_TILE(buf ^ 1, i + 1);
      __syncthreads();
    }
#undef TILE_ROW0
#undef LOAD_TILE
#undef STORE_TILE
    const float sk = __builtin_amdgcn_exp2f(sink[hq] * 1.4426950408889634f - mb);
#pragma unroll
    for (int m = 0; m < 2; ++m) { float l = lsum[m]; l += __shfl_xor(l, 16); l += __shfl_xor(l, 32); if (Qd == 0) dsc[wid * 32 + 16 * m + r] = 1.f / (l + sk); }
    LDS_WAIT(); asm volatile("" ::: "memory");
    { LAS bf16_t* stg = (LAS bf16_t*)lds + wid * 32 * 136;
#pragma unroll
      for (int m = 0; m < 2; ++m)
#pragma unroll
        for (int j = 0; j < 4; ++j) { const float inv = dsc[wid * 32 + 16 * m + 4 * Qd + j];
#pragma unroll
          for (int n = 0; n < 8; ++n) stg[(16 * m + 4 * Qd + j) * 136 + 16 * n + r] = f2bf(o[m][n][j] * inv); }
      LDS_WAIT(); asm volatile("" ::: "memory");
#pragma unroll
      for (int q = 0; q < 8; ++q) { const int c = lane + 64 * q, rowl = c >> 4, ch = c & 15; const size_t go = (qrow0 + rowl) * 2048 + hq * 128 + ch * 8;
        const v4u ov = *(const LAS v4u*)(stg + rowl * 136 + ch * 8), gv = *(const v4u*)(G1 + go);
        v4u w; w.x = pk2(__uint_as_float(ov.x << 16) * __uint_as_float(gv.x << 16), __uint_as_float(ov.x & 0xffff0000u) * __uint_as_float(gv.x & 0xffff0000u));
        w.y = pk2(__uint_as_float(ov.y << 16) * __uint_as_float(gv.y << 16), __uint_as_float(ov.y & 0xffff0000u) * __uint_as_float(gv.y & 0xffff0000u));
        w.z = pk2(__uint_as_float(ov.z << 16) * __uint_as_float(gv.z << 16), __uint_as_float(ov.z & 0xffff0000u) * __uint_as_float(gv.z & 0xffff0000u));
        w.w = pk2(__uint_as_float(ov.w << 16) * __uint_as_float(gv.w << 16), __uint_as_float(ov.w & 0xffff0000u) * __uint_as_float(gv.w & 0xffff0000u));
        if (wr) *(v4u*)(Q1 + go) = w; }
      LDS_WAIT(); asm volatile("" ::: "memory"); }
  }
}

constexpr size_t DO_SDT = 50 * MiB, DO_SCS = 53 * MiB;
constexpr size_t WS_SSQ = 237 * MiB;
DEV unsigned short bfbits(float f) { return f2bf(f); }
DEV void ssd_prep_phase(const bf16_t* XBC, const float* cw, const float* cb, bf16_t* XC, const float* DTLR, const float* dt_bias, const float* a_log, float* SDT, float* SCS, float* SDEC) {
  const int gtid = blockIdx.x * 512 + threadIdx.x, gth = gridDim.x * 512;
  for (int it = gtid; it < (MA / 32) * 192; it += gth) {
    const int rg = it / 192, c8 = (it % 192) * 8, row0 = rg * 32;
    int t0, len;
    if (row0 < ML) { t0 = row0 % SEQ; len = SEQ; } else { t0 = (row0 - ML) % CTXL; len = CTXL; }
    float w[5][8], bias[8];
#pragma unroll
    for (int k = 0; k < 5; ++k) { const f32x4 w0 = *(const f32x4*)(cw + k * 1536 + c8), w1 = *(const f32x4*)(cw + k * 1536 + c8 + 4);
      w[k][0] = w0.x; w[k][1] = w0.y; w[k][2] = w0.z; w[k][3] = w0.w; w[k][4] = w1.x; w[k][5] = w1.y; w[k][6] = w1.z; w[k][7] = w1.w; }
    { const f32x4 b0 = *(const f32x4*)(cb + c8), b1 = *(const f32x4*)(cb + c8 + 4); bias[0] = b0.x; bias[1] = b0.y; bias[2] = b0.z; bias[3] = b0.w; bias[4] = b1.x; bias[5] = b1.y; bias[6] = b1.z; bias[7] = b1.w; }
    const v4u zero4 = {0u, 0u, 0u, 0u};
    v4u win[4];
#pragma unroll
    for (int q = 0; q < 4; ++q) { const int tt = t0 - 2 + q; win[q] = (tt >= 0 && tt < len) ? *(const v4u*)(XBC + (size_t)(row0 - 2 + q) * 1536 + c8) : zero4; }
#pragma unroll 4
    for (int i = 0; i < 32; ++i) {
      const int tt = t0 + i + 2; const v4u nx = (tt < len) ? *(const v4u*)(XBC + (size_t)(row0 + i + 2) * 1536 + c8) : zero4;
      float acc[8];
#pragma unroll
      for (int e = 0; e < 8; ++e) acc[e] = bias[e];
#define CONV_TAP(k, xv) do { acc[0] += w[k][0] * __uint_as_float((xv).x << 16); acc[1] += w[k][1] * __uint_as_float((xv).x & 0xffff0000u); acc[2] += w[k][2] * __uint_as_float((xv).y << 16); acc[3] += w[k][3] * __uint_as_float((xv).y & 0xffff0000u); \
        acc[4] += w[k][4] * __uint_as_float((xv).z << 16); acc[5] += w[k][5] * __uint_as_float((xv).z & 0xffff0000u); acc[6] += w[k][6] * __uint_as_float((xv).w << 16); acc[7] += w[k][7] * __uint_as_float((xv).w & 0xffff0000u); } while (0)
      CONV_TAP(0, win[0]); CONV_TAP(1, win[1]); CONV_TAP(2, win[2]); CONV_TAP(3, win[3]); CONV_TAP(4, nx);
#undef CONV_TAP
      v4u o; o.x = pk2(silu_fast(acc[0]), silu_fast(acc[1])); o.y = pk2(silu_fast(acc[2]), silu_fast(acc[3])); o.z = pk2(silu_fast(acc[4]), silu_fast(acc[5])); o.w = pk2(silu_fast(acc[6]), silu_fast(acc[7]));
      *(v4u*)(XC + (size_t)(row0 + i) * 1536 + c8) = o;
      win[0] = win[1]; win[1] = win[2]; win[2] = win[3]; win[3] = nx;
    }
  }
  {
    const int lane = threadIdx.x & 63, wave = threadIdx.x >> 6, cl = lane & 7, seg = lane >> 3;
    for (int wt = blockIdx.x * NWAVES + wave; wt < NCH * 4; wt += gridDim.x * NWAVES) {
      const int gc = wt >> 2, col = (wt & 3) * 8 + cl, dir = col >> 4, h = col & 15;
      const float a = -fexp(a_log[col]), bias = dt_bias[col];
      float dtv[16], v[16]; float run = 0.f;
#pragma unroll
      for (int u = 0; u < 16; ++u) { const int s = seg * 16 + u, t = dir ? 127 - s : s; dtv[u] = softplusf(DTLR[((size_t)gc * 128 + t) * 64 + col] + bias); }
#pragma unroll
      for (int u = 0; u < 16; ++u) { run += dtv[u] * a; v[u] = run; }
      float off = 0.f;
#pragma unroll
      for (int sgi = 0; sgi < 7; ++sgi) { const float tot = __shfl(run, cl + 8 * sgi); off += (sgi < seg) ? tot : 0.f; }
#pragma unroll
      for (int u = 0; u < 16; ++u) { const int s = seg * 16 + u, t = dir ? 127 - s : s; const size_t row = (size_t)gc * 128 + t; SDT[row * 32 + col] = dtv[u]; SCS[row * 32 + col] = v[u] + off; }
      if (seg == 7) SDEC[(gc * 16 + h) * 2 + dir] = fexp(run + off);
    }
  }
}
DEV void ssd_u_phase(const bf16_t* XC, const float* SDT, const float* SCS, bf16_t* ST, LAS unsigned char* lds) {
  constexpr int XP = 272, BP = 144;
  LAS bf16_t* Xs = (LAS bf16_t*)lds; LAS bf16_t* Bs = (LAS bf16_t*)(lds + 128 * XP * 2); LAS float* wtab = (LAS float*)(lds + 128 * XP * 2 + 128 * BP * 2);
  const int tid = threadIdx.x, lane = tid & 63, wid = tid >> 6, r = lane & 15, Qd = lane >> 4, hl = wid >> 1, dir = wid & 1;
  for (int task = virt_block(); task < NCH * 4; task += gridDim.x) {
    const int gc = task >> 2, g = (task >> 1) & 1, hh = task & 1; const size_t r0 = (size_t)gc * 128; const int h0 = g * 8 + hh * 4;
    __syncthreads();
#pragma unroll
    for (int i = 0; i < 8; ++i) { const int cid = tid + 512 * i, row = cid >> 5, ch = cid & 31; *(LAS v4u*)(Xs + row * XP + ch * 8) = *(const v4u*)(XC + (r0 + row) * 1536 + h0 * 64 + ch * 8); }
#pragma unroll
    for (int i = 0; i < 4; ++i) { const int cid = tid + 512 * i, row = cid >> 4, ch = cid & 15; *(LAS v4u*)(Bs + row * BP + ch * 8) = *(const v4u*)(XC + (r0 + row) * 1536 + 1024 + g * 128 + ch * 8); }
    if (tid < 256) { const int d_ = tid >> 7, t = tid & 127;
      const f32x4 ce = *(const f32x4*)(SCS + (r0 + (d_ ? 0 : 127)) * 32 + d_ * 16 + h0), ct = *(const f32x4*)(SCS + (r0 + t) * 32 + d_ * 16 + h0), dt = *(const f32x4*)(SDT + (r0 + t) * 32 + d_ * 16 + h0);
      wtab[(0 * 2 + d_) * 128 + t] = fexp(ce.x - ct.x) * dt.x; wtab[(1 * 2 + d_) * 128 + t] = fexp(ce.y - ct.y) * dt.y; wtab[(2 * 2 + d_) * 128 + t] = fexp(ce.z - ct.z) * dt.z; wtab[(3 * 2 + d_) * 128 + t] = fexp(ce.w - ct.w) * dt.w; }
    __syncthreads();
    const LAS float* wt = wtab + wid * 128;
    bf16_t* Sp = ST + ((((size_t)gc * 16 + h0 + hl) * 2 + dir) * 64) * 128;
#pragma unroll 1
    for (int pp = 0; pp < 2; ++pp) {
      f32x4 acc[8][2];
#pragma unroll
      for (int nt = 0; nt < 8; ++nt) { acc[nt][0] = (f32x4){0.f, 0.f, 0.f, 0.f}; acc[nt][1] = (f32x4){0.f, 0.f, 0.f, 0.f}; }
#pragma unroll 1
      for (int k = 0; k < 4; ++k) {
        const f32x4 wlo = *(const LAS f32x4*)(wt + 32 * k + 4 * Qd), whi = *(const LAS f32x4*)(wt + 32 * k + 16 + 4 * Qd);
        bf16x8 xf[2];
#pragma unroll
        for (int pt = 0; pt < 2; ++pt) {
          const s16x4 lo = tr_read(Xs + (32 * k + 4 * Qd + (r >> 2)) * XP + hl * 64 + 32 * pp + 16 * pt + 4 * (r & 3));
          const s16x4 hi = tr_read(Xs + (32 * k + 16 + 4 * Qd + (r >> 2)) * XP + hl * 64 + 32 * pp + 16 * pt + 4 * (r & 3));
          const unsigned w0 = pk2(bf2f((bf16_t)lo[0]) * wlo[0], bf2f((bf16_t)lo[1]) * wlo[1]), w1 = pk2(bf2f((bf16_t)lo[2]) * wlo[2], bf2f((bf16_t)lo[3]) * wlo[3]);
          const unsigned w2 = pk2(bf2f((bf16_t)hi[0]) * whi[0], bf2f((bf16_t)hi[1]) * whi[1]), w3 = pk2(bf2f((bf16_t)hi[2]) * whi[2], bf2f((bf16_t)hi[3]) * whi[3]);
          xf[pt] = (bf16x8){(short)(w0 & 0xffff), (short)(w0 >> 16), (short)(w1 & 0xffff), (short)(w1 >> 16), (short)(w2 & 0xffff), (short)(w2 >> 16), (short)(w3 & 0xffff), (short)(w3 >> 16)};
        }
#pragma unroll
        for (int nt = 0; nt < 8; ++nt) {
          const s16x4 lo = tr_read(Bs + (32 * k + 4 * Qd + (r >> 2)) * BP + 16 * nt + 4 * (r & 3));
          const s16x4 hi = tr_read(Bs + (32 * k + 16 + 4 * Qd + (r >> 2)) * BP + 16 * nt + 4 * (r & 3));
          const bf16x8 bfr = (bf16x8){lo[0], lo[1], lo[2], lo[3], hi[0], hi[1], hi[2], hi[3]};
          acc[nt][0] = __builtin_amdgcn_mfma_f32_16x16x32_bf16(bfr, xf[0], acc[nt][0], 0, 0, 0);
          acc[nt][1] = __builtin_amdgcn_mfma_f32_16x16x32_bf16(bfr, xf[1], acc[nt][1], 0, 0, 0);
        }
      }
#pragma unroll
      for (int nt = 0; nt < 8; ++nt)
#pragma unroll
        for (int pt = 0; pt < 2; ++pt) { const f32x4 v = acc[nt][pt];
          *(unsigned long long*)(Sp + ((((2 * pp + pt) * 4 + (nt >> 1)) * 64 + ((nt & 1) * 2 + (Qd >> 1)) * 16 + r) * 8 + 4 * (Qd & 1))) = (unsigned long long)pk2(v[0], v[1]) | ((unsigned long long)pk2(v[2], v[3]) << 32); }
    }
  }
}
DEV void ssd_scan_phase(bf16_t* ST, const float* SDEC, bool wr) {
  for (int item = blockIdx.x * 512 + threadIdx.x; item < 2 * 16 * 2 * 2048; item += gridDim.x * 512) {
    const int e4 = item & 2047, dir = (item >> 11) & 1, h = (item >> 12) & 15, b = item >> 16;
    float S0 = 0.f, S1 = 0.f, S2 = 0.f, S3 = 0.f;
#define SCAN_GC(s) (!dir ? ((s) < 2 ? 128 + 2 * b + (s) : b * 64 + ((s) - 2)) : ((s) < 2 ? 128 + 2 * b + (1 - (s)) : b * 64 + (65 - (s))))
    for (int s0 = 0; s0 < 66; s0 += 6) {
      unsigned long long u[6]; float dec[6];
#pragma unroll
      for (int q = 0; q < 6; ++q) { const int gc = SCAN_GC(s0 + q); u[q] = *(const unsigned long long*)(ST + (((size_t)gc * 16 + h) * 2 + dir) * 8192 + e4 * 4); dec[q] = SDEC[(gc * 16 + h) * 2 + dir]; }
#pragma unroll
      for (int q = 0; q < 6; ++q) { const int gc = SCAN_GC(s0 + q);
        if (wr) *(unsigned long long*)(ST + (((size_t)gc * 16 + h) * 2 + dir) * 8192 + e4 * 4) = (unsigned long long)pk2(S0, S1) | ((unsigned long long)pk2(S2, S3) << 32);
        const unsigned lo = (unsigned)u[q], hi = (unsigned)(u[q] >> 32);
        S0 = dec[q] * S0 + __uint_as_float(lo << 16); S1 = dec[q] * S1 + __uint_as_float(lo & 0xffff0000u); S2 = dec[q] * S2 + __uint_as_float(hi << 16); S3 = dec[q] * S3 + __uint_as_float(hi & 0xffff0000u); }
    }
#undef SCAN_GC
  }
}
DEV bf16x8 scale_frag(bf16x8 f, float s) {
  bf16x8 o;
#pragma unroll
  for (int e = 0; e < 8; e += 2) { const unsigned w = pk2(bf2f((bf16_t)f[e]) * s, bf2f((bf16_t)f[e + 1]) * s); o[e] = (short)(w & 0xffff); o[e + 1] = (short)(w >> 16); }
  return o;
}
DEV void ssd_y_phase(const bf16_t* XC, const float* SDT, const float* SCS, const bf16_t* ST, const float* d_skip, bf16_t* Y0, float* SSQ, LAS unsigned char* lds, bool wr) {
  constexpr int XP = 272, BP = 136, SP = 72;
  LAS bf16_t* Xs = (LAS bf16_t*)lds; LAS bf16_t* Bs = (LAS bf16_t*)(lds + 128 * XP * 2);
  LAS float* tab = (LAS float*)(lds + 128 * XP * 2 + 128 * BP * 2);
  LAS float* ssq = tab + 4 * 4 * 128;
  LAS bf16_t* stg = (LAS bf16_t*)(ssq + 4 * 128);
  const int tid = threadIdx.x, lane = tid & 63, wid = tid >> 6, r = lane & 15, Qd = lane >> 4, hl = wid >> 1, ih = wid & 1;
  LAS bf16_t* mystg = stg + wid * 16 * SP;
  for (int task = virt_block(); task < NCH * 4; task += gridDim.x) {
    const int gc = task >> 2, g = (task >> 1) & 1, hh = task & 1; const size_t r0 = (size_t)gc * 128; const int h0 = g * 8 + hh * 4, h = h0 + hl;
    bf16x8 cstrip[4], cf[4][4];
#pragma unroll
    for (int ks = 0; ks < 4; ++ks) cstrip[ks] = *(const bf16x8*)(XC + (r0 + 16 * wid + r) * 1536 + 1280 + g * 128 + 32 * ks + 8 * Qd);
#pragma unroll
    for (int m = 0; m < 4; ++m)
#pragma unroll
      for (int ks = 0; ks < 4; ++ks) cf[m][ks] = *(const bf16x8*)(XC + (r0 + 64 * ih + 16 * m + r) * 1536 + 1280 + g * 128 + 32 * ks + 8 * Qd);
    __syncthreads();
#pragma unroll
    for (int i = 0; i < 8; ++i) { const int cid = tid + 512 * i, row = cid >> 5, ch = cid & 31; *(LAS v4u*)(Xs + row * XP + ch * 8) = *(const v4u*)(XC + (r0 + row) * 1536 + h0 * 64 + ch * 8); }
#pragma unroll
    for (int i = 0; i < 4; ++i) { const int cid = tid + 512 * i, row = cid >> 4, ch = cid & 15; *(LAS v4u*)(Bs + row * BP + ch * 8) = *(const v4u*)(XC + (r0 + row) * 1536 + 1024 + g * 128 + ch * 8); }
    { const int which = tid >> 7, t = tid & 127; const f32x4 v = *(const f32x4*)((which < 2 ? SCS : SDT) + (r0 + t) * 32 + (which & 1) * 16 + h0);
      tab[0 * 512 + which * 128 + t] = v.x; tab[1 * 512 + which * 128 + t] = v.y; tab[2 * 512 + which * 128 + t] = v.z; tab[3 * 512 + which * 128 + t] = v.w; }
    __syncthreads();
    {
      f32x4 cb[8];
#pragma unroll
      for (int t = 0; t < 8; ++t) { f32x4 c = {0.f, 0.f, 0.f, 0.f};
#pragma unroll
        for (int ks = 0; ks < 4; ++ks) { const bf16x8 bfr = *(const LAS bf16x8*)(Bs + (16 * t + r) * BP + 32 * ks + 8 * Qd); c = __builtin_amdgcn_mfma_f32_16x16x32_bf16(bfr, cstrip[ks], c, 0, 0, 0); }
        cb[t] = c; }
      __syncthreads();
#pragma unroll
      for (int t = 0; t < 8; ++t) *(LAS unsigned long long*)(Bs + (16 * wid + r) * BP + 16 * t + 4 * Qd) = (unsigned long long)pk2(cb[t][0], cb[t][1]) | ((unsigned long long)pk2(cb[t][2], cb[t][3]) << 32);
      __syncthreads();
    }
    const LAS float* csf = tab + hl * 512; const LAS float* csb = csf + 128; const LAS float* dtf = csf + 256; const LAS float* dtb = csf + 384;
    const float dsk = d_skip[h];
    f32x4 y[4][4];
#pragma unroll
    for (int m = 0; m < 4; ++m)
#pragma unroll
      for (int pt = 0; pt < 4; ++pt) y[m][pt] = (f32x4){0.f, 0.f, 0.f, 0.f};
    if (wr || !(PROBE_SKIP & 1))
#pragma unroll 1
    for (int dir = 0; dir < 2; ++dir) {
      const LAS float* csd = dir ? csb : csf; float sc[4];
#pragma unroll
      for (int m = 0; m < 4; ++m)
#pragma unroll
        for (int ks = 0; ks < 4; ++ks) asm volatile("" : "+v"(cf[m][ks]));
#pragma unroll
      for (int m = 0; m < 4; ++m) sc[m] = fexp(csd[64 * ih + 16 * m + r]);
      const bf16_t* Sp = ST + (((size_t)gc * 16 + h) * 2 + dir) * 8192 + lane * 8;
#pragma unroll
      for (int ks = 0; ks < 4; ++ks) {
        bf16x8 sf[4];
#pragma unroll
        for (int pt = 0; pt < 4; ++pt) sf[pt] = *(const bf16x8*)(Sp + (pt * 4 + ks) * 512);
#pragma unroll
        for (int m = 0; m < 4; ++m) { const bf16x8 a = scale_frag(cf[m][ks], sc[m]);
#pragma unroll
          for (int pt = 0; pt < 4; ++pt) y[m][pt] = __builtin_amdgcn_mfma_f32_16x16x32_bf16(a, sf[pt], y[m][pt], 0, 0, 0);
          __builtin_amdgcn_sched_barrier(0); }
      }
    }
#pragma unroll 1
    for (int m = 0; m < 4; ++m) {
      const int i0 = 64 * ih + 16 * m, i = i0 + r;
      const float cfi = csf[i], cbi = csb[i];
      v4u zpre[2];
#pragma unroll
      for (int q = 0; q < 2; ++q) { const int c = lane + 64 * q; zpre[q] = *(const v4u*)(Y0 + (r0 + i0 + (c >> 3)) * 2048 + h * 64 + (c & 7) * 8); }
      if (wr || !(PROBE_SKIP & 2))
#pragma unroll 1
      for (int k2 = 0; k2 < 4; ++k2) {
        const int j0 = 32 * k2 + 8 * Qd;
        const v4u cbv = *(const LAS v4u*)(Bs + i * BP + j0);
        const float cbe[8] = {__uint_as_float(cbv.x << 16), __uint_as_float(cbv.x & 0xffff0000u), __uint_as_float(cbv.y << 16), __uint_as_float(cbv.y & 0xffff0000u), __uint_as_float(cbv.z << 16), __uint_as_float(cbv.z & 0xffff0000u), __uint_as_float(cbv.w << 16), __uint_as_float(cbv.w & 0xffff0000u)};
        float pv[8];
        const bool dofwd = (32 * k2 <= i0 + 15), dobwd = (32 * k2 + 31 >= i0);
#pragma unroll
        for (int e = 0; e < 8; ++e) pv[e] = (j0 + e == i) ? dsk : 0.f;
        if (dofwd) { const f32x4 a0 = *(const LAS f32x4*)(csf + j0), a1 = *(const LAS f32x4*)(csf + j0 + 4), d0 = *(const LAS f32x4*)(dtf + j0), d1 = *(const LAS f32x4*)(dtf + j0 + 4);
          const float jc[8] = {a0.x, a0.y, a0.z, a0.w, a1.x, a1.y, a1.z, a1.w}; const float jd[8] = {d0.x, d0.y, d0.z, d0.w, d1.x, d1.y, d1.z, d1.w};
#pragma unroll
          for (int e = 0; e < 8; ++e) pv[e] += cbe[e] * fexp(j0 + e <= i ? cfi - jc[e] : -INFINITY) * jd[e]; }
        if (dobwd) { const f32x4 a0 = *(const LAS f32x4*)(csb + j0), a1 = *(const LAS f32x4*)(csb + j0 + 4), d0 = *(const LAS f32x4*)(dtb + j0), d1 = *(const LAS f32x4*)(dtb + j0 + 4);
          const float jc[8] = {a0.x, a0.y, a0.z, a0.w, a1.x, a1.y, a1.z, a1.w}; const float jd[8] = {d0.x, d0.y, d0.z, d0.w, d1.x, d1.y, d1.z, d1.w};
#pragma unroll
          for (int e = 0; e < 8; ++e) pv[e] += cbe[e] * fexp(j0 + e >= i ? cbi - jc[e] : -INFINITY) * jd[e]; }
        const unsigned w0 = pk2(pv[0], pv[1]), w1 = pk2(pv[2], pv[3]), w2 = pk2(pv[4], pv[5]), w3 = pk2(pv[6], pv[7]);
        const bf16x8 pa = (bf16x8){(short)(w0 & 0xffff), (short)(w0 >> 16), (short)(w1 & 0xffff), (short)(w1 >> 16), (short)(w2 & 0xffff), (short)(w2 >> 16), (short)(w3 & 0xffff), (short)(w3 >> 16)};
#pragma unroll
        for (int pt = 0; pt < 4; ++pt) {
          const s16x4 lo = tr_read(Xs + (32 * k2 + 8 * Qd + (r >> 2)) * XP + hl * 64 + 16 * pt + 4 * (r & 3));
          const s16x4 hi = tr_read(Xs + (32 * k2 + 8 * Qd + 4 + (r >> 2)) * XP + hl * 64 + 16 * pt + 4 * (r & 3));
          const bf16x8 xf = (bf16x8){lo[0], lo[1], lo[2], lo[3], hi[0], hi[1], hi[2], hi[3]};
          y[0][pt] = __builtin_amdgcn_mfma_f32_16x16x32_bf16(pa, xf, y[0][pt], 0, 0, 0);
        }
      }
      if (wr || !(PROBE_SKIP & 4)) {
#pragma unroll
      for (int pt = 0; pt < 4; ++pt)
#pragma unroll
        for (int jj = 0; jj < 4; ++jj) mystg[(4 * Qd + jj) * SP + 16 * pt + r] = f2bf(y[0][pt][jj]);
      LDS_WAIT(); asm volatile("" ::: "memory");
#pragma unroll
      for (int q = 0; q < 2; ++q) { const int c = lane + 64 * q, rowl = c >> 3, ch = c & 7; const int il = 64 * ih + 16 * m + rowl;
        const v4u yv = *(const LAS v4u*)(mystg + rowl * SP + ch * 8); bf16_t* zp = Y0 + (r0 + il) * 2048 + h * 64 + ch * 8; const v4u zv = zpre[q];
        const float v0 = __uint_as_float(yv.x << 16) * __uint_as_float(zv.x << 16), v1 = __uint_as_float(yv.x & 0xffff0000u) * __uint_as_float(zv.x & 0xffff0000u);
        const float v2 = __uint_as_float(yv.y << 16) * __uint_as_float(zv.y << 16), v3 = __uint_as_float(yv.y & 0xffff0000u) * __uint_as_float(zv.y & 0xffff0000u);
        const float v4 = __uint_as_float(yv.z << 16) * __uint_as_float(zv.z << 16), v5 = __uint_as_float(yv.z & 0xffff0000u) * __uint_as_float(zv.z & 0xffff0000u);
        const float v6 = __uint_as_float(yv.w << 16) * __uint_as_float(zv.w << 16), v7 = __uint_as_float(yv.w & 0xffff0000u) * __uint_as_float(zv.w & 0xffff0000u);
        float ss = (v0 * v0 + v1 * v1) + (v2 * v2 + v3 * v3) + (v4 * v4 + v5 * v5) + (v6 * v6 + v7 * v7);
        ss += __shfl_xor(ss, 1); ss += __shfl_xor(ss, 2); ss += __shfl_xor(ss, 4);
        v4u ov; ov.x = pk2(v0, v1); ov.y = pk2(v2, v3); ov.z = pk2(v4, v5); ov.w = pk2(v6, v7);
        if (wr) *(v4u*)zp = ov;
        if (ch == 0) ssq[hl * 128 + il] = ss; }
      LDS_WAIT(); asm volatile("" ::: "memory");
      }
#pragma unroll
      for (int pt = 0; pt < 4; ++pt) { y[0][pt] = y[1][pt]; y[1][pt] = y[2][pt]; y[2][pt] = y[3][pt]; }
    }
    __syncthreads();
    if (tid < 128) SSQ[((r0 + tid) * 2 + g) * 2 + hh] = (ssq[tid] + ssq[128 + tid]) + (ssq[256 + tid] + ssq[384 + tid]);
  }
}

typedef _Float16 h16_t;
typedef _Float16 h16x8 __attribute__((ext_vector_type(8)));
DEV const h16_t* gcs_row(const h16_t* wsb, const h16_t* outb, size_t row) {
  return row < 9472 ? (const h16_t*)((const char*)wsb + 237 * MiB + 512 * 1024) + row * 1024 : (row < 13824 ? (const h16_t*)((const char*)outb + 55 * MiB + 512 * 1024) + (row - 9472) * 1024 : (const h16_t*)((const char*)wsb + 2 * MiB) + (row - 13824) * 1024); }
DEV h16_t* gcs_row_w(h16_t* wsb, h16_t* outb, size_t row) { return (h16_t*)gcs_row(wsb, outb, row); }
DEV float logsig_fast(float x) { return fminf(x, 0.f) - 0.6931471805599453f * __builtin_amdgcn_logf(1.f + __builtin_amdgcn_exp2f(-1.4426950408889634f * fabsf(x))); }
DEV void gla_cs_phase(const float* DTLR, const float* gw, const float* gb, h16_t* GCSL, h16_t* GCSC, float* GDEC, LAS unsigned char* lds, unsigned* queue) {
  const int lane = threadIdx.x & 63, wave = threadIdx.x >> 6;
  LAS float* lrs = (LAS float*)(lds + wave * 8192);
  LAS h16_t* tile = (LAS h16_t*)(lds + 65536 + wave * 1024);
  for (;;) {
    unsigned wt_ = 0u; if (lane == 0) wt_ = __hip_atomic_fetch_add(queue, 1u, __ATOMIC_RELAXED, __HIP_MEMORY_SCOPE_AGENT);
    wt_ = (unsigned)__builtin_amdgcn_readfirstlane((int)wt_); if (wt_ >= (unsigned)(NCH * 2 * 8)) break;
    const int wt = (int)wt_;
    const int gc = wt >> 4, dir = (wt >> 3) & 1, k = (wt & 7) * 64 + lane;
#pragma unroll
    for (int q = 0; q < 8; ++q) { const int c = lane + 64 * q, row = c >> 2, part = c & 3;
      *(LAS f32x4*)(lrs + row * 16 + part * 4) = *(const f32x4*)(DTLR + ((size_t)gc * 128 + row) * 64 + 32 + dir * 16 + part * 4); }
    float wv[16];
#pragma unroll
    for (int q = 0; q < 16; ++q) wv[q] = gw[(dir * 16 + q) * 512 + k];
    const float bias = gb[dir * 512 + k];
    LDS_WAIT(); asm volatile("" ::: "memory");
    float run = 0.f;
#pragma unroll 1
    for (int s0 = 0; s0 < 128; s0 += 8) {
      float lg[8];
#pragma unroll
      for (int u = 0; u < 8; ++u) { const int s = s0 + u, t = dir ? 127 - s : s; const LAS float* lr = lrs + t * 16;
        const f32x4 l0 = *(const LAS f32x4*)lr, l1 = *(const LAS f32x4*)(lr + 4), l2 = *(const LAS f32x4*)(lr + 8), l3 = *(const LAS f32x4*)(lr + 12);
        const float x = bias + l0.x * wv[0] + l0.y * wv[1] + l0.z * wv[2] + l0.w * wv[3] + l1.x * wv[4] + l1.y * wv[5] + l1.z * wv[6] + l1.w * wv[7]
                        + l2.x * wv[8] + l2.y * wv[9] + l2.z * wv[10] + l2.w * wv[11] + l3.x * wv[12] + l3.y * wv[13] + l3.z * wv[14] + l3.w * wv[15];
        lg[u] = logsig_fast(x) * (1.f / 16.f); }
#pragma unroll
      for (int u = 0; u < 8; ++u) { run += lg[u]; tile[u * 64 + lane] = (h16_t)run; }
      LDS_WAIT(); asm volatile("" ::: "memory");
      { const int u = lane >> 3, ch = lane & 7, s = s0 + u, t = dir ? 127 - s : s;
        *(v4u*)(gcs_row_w(GCSL, GCSC, (size_t)gc * 128 + t) + dir * 512 + (k - lane) + ch * 8) = *(const LAS v4u*)(tile + u * 64 + ch * 8); }
      LDS_WAIT(); asm volatile("" ::: "memory");
    }
    GDEC[((gc * 4 + (k >> 7)) * 2 + dir) * 128 + (k & 127)] = fexp(run);
    LDS_WAIT(); asm volatile("" ::: "memory");
  }
}
DEV void gla_u_phase(const bf16_t* K0, const bf16_t* V0, const h16_t* GCSL, const h16_t* GCSC, bf16_t* ST, LAS unsigned char* lds) {
  constexpr int VP = 272, KP = 144;
  LAS bf16_t* Vs = (LAS bf16_t*)lds; LAS bf16_t* Kd = (LAS bf16_t*)(lds + 128 * VP * 2);
  const int tid = threadIdx.x, lane = tid & 63, wid = tid >> 6, r = lane & 15, Qd = lane >> 4;
  for (int task = virt_block(); task < NCH * 4; task += gridDim.x) {
    const int gc = task >> 2, h = task & 3; const size_t r0 = (size_t)gc * 128;
    __syncthreads();
#pragma unroll
    for (int i = 0; i < 8; ++i) { const int cid = tid + 512 * i, row = cid >> 5, ch = cid & 31; *(LAS v4u*)(Vs + row * VP + ch * 8) = *(const v4u*)(V0 + (r0 + row) * 1024 + h * 256 + ch * 8); }
#pragma unroll
    for (int i = 0; i < 4; ++i) { const int cid = tid + 512 * i, t = cid >> 4, ch = cid & 15;
      const v4u kv = *(const v4u*)(K0 + (r0 + t) * 512 + h * 128 + ch * 8);
      const float kf[8] = {__uint_as_float(kv.x << 16), __uint_as_float(kv.x & 0xffff0000u), __uint_as_float(kv.y << 16), __uint_as_float(kv.y & 0xffff0000u), __uint_as_float(kv.z << 16), __uint_as_float(kv.z & 0xffff0000u), __uint_as_float(kv.w << 16), __uint_as_float(kv.w & 0xffff0000u)};
#pragma unroll
      for (int dir = 0; dir < 2; ++dir) {
        const h16x8 ce = *(const h16x8*)(gcs_row(GCSL, GCSC, r0 + (dir ? 0 : 127)) + dir * 512 + h * 128 + ch * 8), ct = *(const h16x8*)(gcs_row(GCSL, GCSC, r0 + t) + dir * 512 + h * 128 + ch * 8);
        v4u o; o.x = pk2(kf[0] * fexp((float)ce[0] - (float)ct[0]), kf[1] * fexp((float)ce[1] - (float)ct[1])); o.y = pk2(kf[2] * fexp((float)ce[2] - (float)ct[2]), kf[3] * fexp((float)ce[3] - (float)ct[3]));
        o.z = pk2(kf[4] * fexp((float)ce[4] - (float)ct[4]), kf[5] * fexp((float)ce[5] - (float)ct[5])); o.w = pk2(kf[6] * fexp((float)ce[6] - (float)ct[6]), kf[7] * fexp((float)ce[7] - (float)ct[7]));
        *(LAS v4u*)(Kd + dir * 128 * KP + t * KP + ch * 8) = o; } }
    __syncthreads();
#pragma unroll 1
    for (int dir = 0; dir < 2; ++dir) {
      const LAS bf16_t* Kb = Kd + dir * 128 * KP;
      f32x4 acc[8][2];
#pragma unroll
      for (int dt = 0; dt < 8; ++dt) { acc[dt][0] = (f32x4){0.f, 0.f, 0.f, 0.f}; acc[dt][1] = (f32x4){0.f, 0.f, 0.f, 0.f}; }
#pragma unroll 1
      for (int k = 0; k < 4; ++k) {
        bf16x8 vf[2];
#pragma unroll
        for (int et = 0; et < 2; ++et) {
          const s16x4 lo = tr_read(Vs + (32 * k + 4 * Qd + (r >> 2)) * VP + 32 * wid + 16 * et + 4 * (r & 3));
          const s16x4 hi = tr_read(Vs + (32 * k + 16 + 4 * Qd + (r >> 2)) * VP + 32 * wid + 16 * et + 4 * (r & 3));
          vf[et] = (bf16x8){lo[0], lo[1], lo[2], lo[3], hi[0], hi[1], hi[2], hi[3]}; }
#pragma unroll
        for (int dt = 0; dt < 8; ++dt) {
          const s16x4 lo = tr_read(Kb + (32 * k + 4 * Qd + (r >> 2)) * KP + 16 * dt + 4 * (r & 3));
          const s16x4 hi = tr_read(Kb + (32 * k + 16 + 4 * Qd + (r >> 2)) * KP + 16 * dt + 4 * (r & 3));
          const bf16x8 kfr = (bf16x8){lo[0], lo[1], lo[2], lo[3], hi[0], hi[1], hi[2], hi[3]};
          acc[dt][0] = __builtin_amdgcn_mfma_f32_16x16x32_bf16(kfr, vf[0], acc[dt][0], 0, 0, 0);
          acc[dt][1] = __builtin_amdgcn_mfma_f32_16x16x32_bf16(kfr, vf[1], acc[dt][1], 0, 0, 0); }
      }
      bf16_t* Sp = ST + (((size_t)gc * 4 + h) * 2 + dir) * 32768;
#pragma unroll
      for (int dt = 0; dt < 8; ++dt)
#pragma unroll
        for (int et = 0; et < 2; ++et) { const f32x4 v = acc[dt][et];
          *(unsigned long long*)(Sp + ((((2 * wid + et) * 4 + (dt >> 1)) * 64 + ((dt & 1) * 2 + (Qd >> 1)) * 16 + r) * 8 + 4 * (Qd & 1))) = (unsigned long long)pk2(v[0], v[1]) | ((unsigned long long)pk2(v[2], v[3]) << 32); }
    }
  }
}
DEV void gla_scan_phase(bf16_t* ST, const float* GDEC, bool wr) {
  for (int item = blockIdx.x * 512 + threadIdx.x; item < 2 * 4 * 2 * 8192; item += gridDim.x * 512) {
    const int e4 = item & 8191, dir = (item >> 13) & 1, h = (item >> 14) & 3, b = item >> 16; const int d0 = 32 * ((e4 >> 7) & 3) + 8 * ((e4 >> 5) & 3) + 4 * (e4 & 1);
    float S0 = 0.f, S1 = 0.f, S2 = 0.f, S3 = 0.f;
#define SCAN_GC(s) (!dir ? ((s) < 2 ? 128 + 2 * b + (s) : b * 64 + ((s) - 2)) : ((s) < 2 ? 128 + 2 * b + (1 - (s)) : b * 64 + (65 - (s))))
    for (int s0 = 0; s0 < 66; s0 += 6) {
      unsigned long long u[6]; f32x4 dec[6];
#pragma unroll
      for (int q = 0; q < 6; ++q) { const int gc = SCAN_GC(s0 + q); u[q] = *(const unsigned long long*)(ST + (((size_t)gc * 4 + h) * 2 + dir) * 32768 + e4 * 4); dec[q] = *(const f32x4*)(GDEC + ((gc * 4 + h) * 2 + dir) * 128 + d0); }
#pragma unroll
      for (int q = 0; q < 6; ++q) { const int gc = SCAN_GC(s0 + q);
        if (wr) *(unsigned long long*)(ST + (((size_t)gc * 4 + h) * 2 + dir) * 32768 + e4 * 4) = (unsigned long long)pk2(S0, S1) | ((unsigned long long)pk2(S2, S3) << 32);
        const unsigned lo = (unsigned)u[q], hi = (unsigned)(u[q] >> 32);
        S0 = dec[q].x * S0 + __uint_as_float(lo << 16); S1 = dec[q].y * S1 + __uint_as_float(lo & 0xffff0000u); S2 = dec[q].z * S2 + __uint_as_float(hi << 16); S3 = dec[q].w * S3 + __uint_as_float(hi & 0xffff0000u); }
    }
#undef SCAN_GC
  }
}
DEV void gla_o_phase(const bf16_t* Q0, const bf16_t* K0, const bf16_t* V0, const h16_t* GCSL, const h16_t* GCSC, const bf16_t* ST, const float* gla_norm, bf16_t* Y0, LAS unsigned char* lds, bool wr) {
  constexpr int VP = 272, KP = 136;
  LAS bf16_t* Vs = (LAS bf16_t*)lds; LAS bf16_t* Kd = (LAS bf16_t*)(lds + 128 * VP * 2);
  const int tid = threadIdx.x, lane = tid & 63, wid = tid >> 6, r = lane & 15, Qd = lane >> 4;
  const float scale = 0.08838834764831845f;
  for (int task = virt_block(); task < NCH * 4; task += gridDim.x) {
    const int gc = task >> 2, h = task & 3; const size_t r0 = (size_t)gc * 128;
    __syncthreads();
#pragma unroll
    for (int i = 0; i < 8; ++i) { const int cid = tid + 512 * i, row = cid >> 5, ch = cid & 31; *(LAS v4u*)(Vs + row * VP + ch * 8) = *(const v4u*)(V0 + (r0 + row) * 1024 + h * 256 + ch * 8); }
#pragma unroll
    for (int i = 0; i < 4; ++i) { const int cid = tid + 512 * i, t = cid >> 4, ch = cid & 15;
      const v4u kv = *(const v4u*)(K0 + (r0 + t) * 512 + h * 128 + ch * 8);
      const float kf[8] = {__uint_as_float(kv.x << 16), __uint_as_float(kv.x & 0xffff0000u), __uint_as_float(kv.y << 16), __uint_as_float(kv.y & 0xffff0000u), __uint_as_float(kv.z << 16), __uint_as_float(kv.z & 0xffff0000u), __uint_as_float(kv.w << 16), __uint_as_float(kv.w & 0xffff0000u)};
#pragma unroll
      for (int dir = 0; dir < 2; ++dir) {
        const h16x8 ct = *(const h16x8*)(gcs_row(GCSL, GCSC, r0 + t) + dir * 512 + h * 128 + ch * 8);
        v4u o; o.x = pk2(kf[0] * fexp(-(float)ct[0]), kf[1] * fexp(-(float)ct[1])); o.y = pk2(kf[2] * fexp(-(float)ct[2]), kf[3] * fexp(-(float)ct[3]));
        o.z = pk2(kf[4] * fexp(-(float)ct[4]), kf[5] * fexp(-(float)ct[5])); o.w = pk2(kf[6] * fexp(-(float)ct[6]), kf[7] * fexp(-(float)ct[7]));
        *(LAS v4u*)(Kd + dir * 128 * KP + t * KP + ch * 8) = o; } }
    __syncthreads();
    const int i = 16 * wid + r;
    f32x4 o[16];
#pragma unroll
    for (int et = 0; et < 16; ++et) o[et] = (f32x4){0.f, 0.f, 0.f, 0.f};
#pragma unroll 1
    for (int dir = 0; dir < 2; ++dir) {
      bf16x8 qd[4];
      { const h16_t* ci = gcs_row(GCSL, GCSC, r0 + i) + dir * 512 + h * 128; const bf16_t* qp = Q0 + (r0 + i) * 512 + h * 128;
#pragma unroll
        for (int ks = 0; ks < 4; ++ks) { const v4u qv = *(const v4u*)(qp + 32 * ks + 8 * Qd); const h16x8 cc = *(const h16x8*)(ci + 32 * ks + 8 * Qd);
          const f32x4 c0 = {(float)cc[0], (float)cc[1], (float)cc[2], (float)cc[3]}, c1 = {(float)cc[4], (float)cc[5], (float)cc[6], (float)cc[7]};
          const unsigned w0 = pk2(__uint_as_float(qv.x << 16) * scale * fexp(c0.x), __uint_as_float(qv.x & 0xffff0000u) * scale * fexp(c0.y));
          const unsigned w1 = pk2(__uint_as_float(qv.y << 16) * scale * fexp(c0.z), __uint_as_float(qv.y & 0xffff0000u) * scale * fexp(c0.w));
          const unsigned w2 = pk2(__uint_as_float(qv.z << 16) * scale * fexp(c1.x), __uint_as_float(qv.z & 0xffff0000u) * scale * fexp(c1.y));
          const unsigned w3 = pk2(__uint_as_float(qv.w << 16) * scale * fexp(c1.z), __uint_as_float(qv.w & 0xffff0000u) * scale * fexp(c1.w));
          qd[ks] = (bf16x8){(short)(w0 & 0xffff), (short)(w0 >> 16), (short)(w1 & 0xffff), (short)(w1 >> 16), (short)(w2 & 0xffff), (short)(w2 >> 16), (short)(w3 & 0xffff), (short)(w3 >> 16)}; } }
      const bf16_t* Sp = ST + (((size_t)gc * 4 + h) * 2 + dir) * 32768 + lane * 8;
      {
        bf16x8 sA[4], sB[4];
#pragma unroll
        for (int q = 0; q < 4; ++q) sA[q] = *(const bf16x8*)(Sp + (q * 4 + 0) * 512);
#pragma unroll
        for (int bi = 0; bi < 16; ++bi) {
          const int ks = bi >> 2, e0 = 4 * (bi & 3);
          if (bi + 1 < 16) { const int ks2 = (bi + 1) >> 2, e2 = 4 * ((bi + 1) & 3);
#pragma unroll
            for (int q = 0; q < 4; ++q) { if (bi & 1) sA[q] = *(const bf16x8*)(Sp + ((e2 + q) * 4 + ks2) * 512); else sB[q] = *(const bf16x8*)(Sp + ((e2 + q) * 4 + ks2) * 512); } }
#pragma unroll
          for (int q = 0; q < 4; ++q) o[e0 + q] = __builtin_amdgcn_mfma_f32_16x16x32_bf16(qd[ks], (bi & 1) ? sB[q] : sA[q], o[e0 + q], 0, 0, 0);
          __builtin_amdgcn_sched_barrier(0);
        }
      }
      const LAS bf16_t* Kb = Kd + dir * 128 * KP;
#pragma unroll 1
      for (int k2 = 0; k2 < 4; ++k2) {
        const bool need = dir ? (2 * k2 + 1 >= wid) : (2 * k2 <= wid);
        if (!need) continue;
        bf16x8 pa;
#pragma unroll
        for (int tt = 0; tt < 2; ++tt) { const int t = 2 * k2 + tt;
          f32x4 c = {0.f, 0.f, 0.f, 0.f};
#pragma unroll
          for (int ks = 0; ks < 4; ++ks) { const bf16x8 kfr = *(const LAS bf16x8*)(Kb + (16 * t + r) * KP + 32 * ks + 8 * Qd); c = __builtin_amdgcn_mfma_f32_16x16x32_bf16(kfr, qd[ks], c, 0, 0, 0); }
          float pv[4];
#pragma unroll
          for (int jj = 0; jj < 4; ++jj) { const int j = 16 * t + 4 * Qd + jj; const bool ok = dir ? (j >= i) : (j <= i); pv[jj] = ok ? c[jj] : 0.f; }
          const unsigned w0 = pk2(pv[0], pv[1]), w1 = pk2(pv[2], pv[3]);
          pa[tt * 4 + 0] = (short)(w0 & 0xffff); pa[tt * 4 + 1] = (short)(w0 >> 16); pa[tt * 4 + 2] = (short)(w1 & 0xffff); pa[tt * 4 + 3] = (short)(w1 >> 16); }
#pragma unroll
        for (int et = 0; et < 16; ++et) {
          const s16x4 lo = tr_read(Vs + (32 * k2 + 4 * Qd + (r >> 2)) * VP + 16 * et + 4 * (r & 3));
          const s16x4 hi = tr_read(Vs + (32 * k2 + 16 + 4 * Qd + (r >> 2)) * VP + 16 * et + 4 * (r & 3));
          const bf16x8 vf = (bf16x8){lo[0], lo[1], lo[2], lo[3], hi[0], hi[1], hi[2], hi[3]};
          o[et] = __builtin_amdgcn_mfma_f32_16x16x32_bf16(pa, vf, o[et], 0, 0, 0); }
      }
    }
    asm volatile("s_nop 15\n\ts_nop 15\n\ts_nop 15\n\ts_nop 15" ::: "memory");
    __syncthreads();
    { constexpr int GP = 264;
      LAS bf16_t* stg = (LAS bf16_t*)lds + wid * (16 * GP);
      float gn_[16];
#pragma unroll
      for (int et = 0; et < 16; ++et) gn_[et] = gla_norm[h * 256 + 16 * et + r];
#pragma unroll
      for (int jj = 0; jj < 4; ++jj) { float ss = 0.f;
#pragma unroll
        for (int et = 0; et < 16; ++et) ss += o[et][jj] * o[et][jj];
        ss += __shfl_xor(ss, 1); ss += __shfl_xor(ss, 2); ss += __shfl_xor(ss, 4); ss += __shfl_xor(ss, 8);
        const float rstd = rsqrtf(ss * (1.f / 256.f) + EPS);
        LAS bf16_t* srow = stg + (4 * Qd + jj) * GP;
#pragma unroll
        for (int e = 0; e < 8; ++e) { const float a0 = o[2 * e][jj] * rstd * gn_[2 * e], a1 = o[2 * e + 1][jj] * rstd * gn_[2 * e + 1];
          const float p0 = __shfl_xor(a0, 1), p1 = __shfl_xor(a1, 1);
          const unsigned w = (r & 1) ? pk2(p1, a1) : pk2(a0, p0); const int col = (r & 1) ? 16 * (2 * e + 1) + r - 1 : 16 * (2 * e) + r;
          *(LAS unsigned*)(srow + col) = w; } }
      LDS_WAIT(); asm volatile("" ::: "memory");
#pragma unroll
      for (int q = 0; q < 8; ++q) { const int c = lane + 64 * q, rowl = c >> 5, ch = c & 31;
        bf16_t* gp = Y0 + (r0 + 16 * wid + rowl) * 2048 + 1024 + h * 256 + ch * 8;
        const v4u ov = *(const LAS v4u*)(stg + rowl * GP + ch * 8), gv = *(const v4u*)gp;
        v4u w; w.x = pk2(__uint_as_float(ov.x << 16) * __uint_as_float(gv.x << 16), __uint_as_float(ov.x & 0xffff0000u) * __uint_as_float(gv.x & 0xffff0000u));
        w.y = pk2(__uint_as_float(ov.y << 16) * __uint_as_float(gv.y << 16), __uint_as_float(ov.y & 0xffff0000u) * __uint_as_float(gv.y & 0xffff0000u));
        w.z = pk2(__uint_as_float(ov.z << 16) * __uint_as_float(gv.z << 16), __uint_as_float(ov.z & 0xffff0000u) * __uint_as_float(gv.z & 0xffff0000u));
        w.w = pk2(__uint_as_float(ov.w << 16) * __uint_as_float(gv.w << 16), __uint_as_float(ov.w & 0xffff0000u) * __uint_as_float(gv.w & 0xffff0000u));
        if (wr) *(v4u*)gp = w; }
      LDS_WAIT(); asm volatile("" ::: "memory"); }
  }
}

typedef __attribute__((address_space(1))) unsigned gu32;
#define RLX_AGENT __ATOMIC_RELAXED, __HIP_MEMORY_SCOPE_AGENT
#define XB_TMO      128
#define XB_XCNT(j)  (256  + 64 * (j))
#define XB_XSUB(j)  (1280 + 64 * (j))
#define XB_XGEN(j)  (2304 + 64 * (j))
#define XB_TOP      3328
#define XB_TOPGEN   3392
#define XCD_BAR_WORDS 3456
#define XB_SPIN_CAP (1u << 18)

__device__ __forceinline__ unsigned xb_ld(unsigned* p)              { return __hip_atomic_load(p, __ATOMIC_RELAXED, __HIP_MEMORY_SCOPE_AGENT); }
__device__ __forceinline__ unsigned xb_add(unsigned* p, unsigned v) { return __hip_atomic_fetch_add(p, v, __ATOMIC_RELAXED, __HIP_MEMORY_SCOPE_AGENT); }
__device__ __forceinline__ unsigned xb_xcc_id() { return (unsigned)__builtin_amdgcn_s_getreg((3 << 11) | 20) & 0xFu; }
#define XB_SPIN(cond, bar) do { unsigned _sp = 0; while (cond) { __builtin_amdgcn_s_sleep(1); \
    if ((++_sp & 255u) == 0u) { if (xb_ld(&(bar)[XB_TMO])) break; if (_sp > XB_SPIN_CAP) { atomicAdd(&(bar)[XB_TMO], 1u); break; } } } } while (0)

struct XcdBarrier {
    unsigned* bar; unsigned x;
    volatile LAS unsigned* st;
};

__device__ __forceinline__ XcdBarrier xcd_barrier_post(unsigned* bar, volatile LAS unsigned* st) {
    XcdBarrier b; b.bar = bar; b.x = xb_xcc_id(); b.st = st;
    if (threadIdx.x == 0) (void)xb_add(&bar[XB_XCNT(b.x)], 1u);
    return b;
}
__device__ __forceinline__ void xcd_barrier_complete(unsigned* bar, unsigned x, unsigned& nloc, unsigned& nx) {
    const unsigned G = gridDim.x * gridDim.y * gridDim.z;
    unsigned sum, cnt, mine, sp = 0u;
    for (;;) {
        sum = 0u; cnt = 0u; mine = 0u;
#pragma unroll
        for (unsigned j = 0; j < 16; ++j) { const unsigned c = xb_ld(&bar[XB_XCNT(j)]); sum += c; cnt += (c > 0u) ? 1u : 0u; mine = (j == x) ? c : mine; }
        if (sum == G) break;
        __builtin_amdgcn_s_sleep(1);
        if ((++sp & 255u) == 0u) { if (xb_ld(&bar[XB_TMO])) break; if (sp > XB_SPIN_CAP) { atomicAdd(&bar[XB_TMO], 1u); break; } }
    }
    nloc = mine > 0u ? mine : 1u; nx = cnt > 0u ? cnt : 1u;
}

__device__ __forceinline__ void xcd_barrier(const XcdBarrier& b) {
    asm volatile("s_waitcnt vmcnt(0)" ::: "memory");
    __syncthreads();
    if (threadIdx.x == 0) {
        unsigned* bar = b.bar;
        __builtin_amdgcn_s_waitcnt(0);
        unsigned nloc = b.st[0], nx = b.st[1];
        if (nloc == 0u) { xcd_barrier_complete(bar, b.x, nloc, nx); b.st[0] = nloc; b.st[1] = nx; }
        const unsigned old = xb_add(&bar[XB_XSUB(b.x)], 1u);
        const unsigned gen = old / nloc;
        if (old + 1u == (gen + 1u) * nloc) {
            __builtin_amdgcn_fence(__ATOMIC_RELEASE, "agent");
            asm volatile("s_waitcnt vmcnt(0)" ::: "memory");
            const unsigned og = xb_add(&bar[XB_TOP], 1u);
            const unsigned tg = og / nx;
            if (og + 1u == (tg + 1u) * nx) xb_add(&bar[XB_TOPGEN], 1u);
            else XB_SPIN(xb_ld(&bar[XB_TOPGEN]) == tg, bar);
            __builtin_amdgcn_fence(__ATOMIC_ACQUIRE, "agent");
            xb_add(&bar[XB_XGEN(b.x)], 1u);
            asm volatile("s_waitcnt vmcnt(0)" ::: "memory");
        } else {
            XB_SPIN(xb_ld(&bar[XB_XGEN(b.x)]) == gen, bar);
            __builtin_amdgcn_fence(__ATOMIC_ACQUIRE, "agent");
            asm volatile("s_waitcnt vmcnt(0)" ::: "memory");
        }
    }
    __syncthreads();
}

__global__ void __launch_bounds__(NWAVES * 64, 2) __attribute__((amdgpu_num_sgpr(92))) mega(Params p) {
  extern __shared__ __attribute__((aligned(16))) unsigned char lds_raw[];
  LAS unsigned char* lds = (LAS unsigned char*)lds_raw;
  volatile LAS unsigned* MISC = (volatile LAS unsigned*)(lds + MISC_OFF);
  if (threadIdx.x < 16) MISC[threadIdx.x] = 0u;
  __syncthreads();
  XcdBarrier bar = xcd_barrier_post((unsigned*)(p.ws + WS_CTL), MISC + 8);
  unsigned char* ws = p.ws;
  float* MOD = (float*)(ws + WS_MOD);
  bf16_t* H0 = (bf16_t*)p.out; float* X1 = p.out;
  const int lo = p.ph_lo, hi = p.ph_hi;
#define IN(k) (lo <= (k) && (k) < hi)
#define SEAM(k) do { if ((k) + 1 < hi) xcd_barrier(bar); } while (0)
#define PH(k, ...) if (IN(k)) { if ((PROBE_MASK >> (k)) & 1u) { const bool wr = (p.rep < 0); (void)wr; __VA_ARGS__; xcd_barrier(bar); } { const bool wr = true; (void)wr; __VA_ARGS__; } SEAM(k); }
  PH(0, prologue_phase(p, lds))
  PH(1, prep_phase(p.in[0], p.in[2], p.in[4], MOD, H0))
  PH(2, {
    pg8::Gemm g{H0, (const bf16_t*)(ws + WS_W1T), MA, E_INP, D}; pg8::StaticOrder S; S.init(MA, E_INP, gridDim.x, (int)blockIdx.x);
    pg8::EpiProj0 E{(bf16_t*)(ws + WS_Y0), (bf16_t*)(ws + WS_XBC), (bf16_t*)(ws + WS_Q0), (bf16_t*)(ws + WS_K0), (bf16_t*)(ws + WS_V0), (float*)(ws + WS_DTLR)};
    pg8::gemm_phase<pg8::EpiProj0, pg8::StaticOrder, true, true>(lds, g, S, E); })
  PH(3, ssd_prep_phase((const bf16_t*)(ws + WS_XBC), p.in[8], p.in[9], (bf16_t*)p.out, (const float*)(ws + WS_DTLR), p.in[10], p.in[11], (float*)((char*)p.out + DO_SDT), (float*)((char*)p.out + DO_SCS), (float*)(ws + WS_SDEC)))
  PH(4, { ssd_u_phase((const bf16_t*)p.out, (const float*)((char*)p.out + DO_SDT), (const float*)((char*)p.out + DO_SCS), (bf16_t*)(ws + WS_STATE), lds);
    { const int nbusy = (NCH * 4) % (int)gridDim.x, nfree = (int)gridDim.x - nbusy;
      const int vb_ = virt_block(); if (vb_ >= nbusy || nfree <= 0) { __syncthreads(); late_weights(p, lds, nfree > 0 ? vb_ - nbusy : vb_, nfree > 0 ? nfree : (int)gridDim.x); } } })
  PH(5, ssd_scan_phase((bf16_t*)(ws + WS_STATE), (const float*)(ws + WS_SDEC), wr))
  PH(6, { ssd_y_phase((const bf16_t*)p.out, (const float*)((char*)p.out + DO_SDT), (const float*)((char*)p.out + DO_SCS), (const bf16_t*)(ws + WS_STATE), p.in[12], (bf16_t*)(ws + WS_Y0), (float*)(ws + WS_SSQ), lds, wr);
    if (wr) gla_cs_phase((const float*)(ws + WS_DTLR), p.in[14], p.in[15], (h16_t*)ws, (h16_t*)p.out, (float*)(ws + WS_GDEC), lds, (unsigned*)(ws + WS_CTL) + CW_CSQ); })
  PH(8, gla_u_phase((const bf16_t*)(ws + WS_K0), (const bf16_t*)(ws + WS_V0), (const h16_t*)ws, (const h16_t*)p.out, (bf16_t*)(ws + WS_STATE), lds))
  PH(9, gla_scan_phase((bf16_t*)(ws + WS_STATE), (const float*)(ws + WS_GDEC), wr))
  PH(10, gla_o_phase((const bf16_t*)(ws + WS_Q0), (const bf16_t*)(ws + WS_K0), (const bf16_t*)(ws + WS_V0), (const h16_t*)ws, (const h16_t*)p.out, (const bf16_t*)(ws + WS_STATE), p.in[16], (bf16_t*)(ws + WS_Y0), lds, wr))
  PH(11, {
    pg8::Gemm g{(const bf16_t*)(ws + WS_Y0), (const bf16_t*)(ws + WS_W2T), ML, D, 2048}; pg8::StaticOrder S; S.init(ML, D, gridDim.x, (int)blockIdx.x);
    const float* SSQ = (const float*)(ws + WS_SSQ);
    LAS float* rs = (LAS float*)(lds + 131072);
    { pg8::Unit u0; if (S.next(0, u0) && threadIdx.x < 256) { const size_t row = (size_t)u0.pm * 256 + threadIdx.x;
        const float r0 = rsqrtf((SSQ[(row * 2 + 0) * 2] + SSQ[(row * 2 + 0) * 2 + 1]) * (1.f / 512.f) + EPS), r1 = rsqrtf((SSQ[(row * 2 + 1) * 2] + SSQ[(row * 2 + 1) * 2 + 1]) * (1.f / 512.f) + EPS);
        rs[threadIdx.x * 2] = r0 / r1; rs[threadIdx.x * 2 + 1] = r1; } }
    __syncthreads();
    float* SSQ1 = (float*)(ws + WS_SSQ1); bf16_t* H1 = (bf16_t*)(ws + WS_H1); const float* g1 = p.in[18]; const float* MOD1 = MOD + 3 * 3072;
    pg8::EpiResidH E{p.in[0], X1, MOD, g1, MOD1, H1, SSQ1};
    pg8::gemm_phase<pg8::EpiResidH, pg8::StaticOrder, true, true, true>(lds, g, S, E, rs);
    const float* ctx = p.in[2]; const float* gate = MOD + 2 * 3072 + 2048; const float* sc1c = MOD1 + 2 * 3072 + 1024;
    small_gemm_splitk((const bf16_t*)(ws + WS_Y0) + (size_t)ML * 2048, 2048, (const bf16_t*)(ws + WS_W2T), 2048, 2048, MC, D, lds, SSQ1 + ML, SSQ + (size_t)ML * 4,
               [=](int m, int n, float v, float vn) { const float x1 = ctx[(size_t)m * D + n] + gate[n] * v, x1n = ctx[(size_t)m * D + (n ^ 1)] + gate[n ^ 1] * vn;
                 if (!(n & 1)) *(unsigned*)(H1 + (size_t)(ML + m) * D + n) = pk2(x1 * g1[n] * (1.f + sc1c[n]), x1n * g1[n + 1] * (1.f + sc1c[n + 1])); return x1 * x1; }); })
  PH(13, {
    pg8::Gemm g{(const bf16_t*)(ws + WS_H1), (const bf16_t*)(ws + WS_W3T), ML, O_IN, D}; pg8::StaticOrder S; S.init(ML, O_IN, gridDim.x, (int)blockIdx.x);
    pg8::EpiProj1 E{(bf16_t*)(ws + WS_K1), (bf16_t*)(ws + WS_V1), (bf16_t*)(ws + WS_Q1), (bf16_t*)(ws + WS_G1), p.in[22], p.in[23], (const float*)(ws + WS_ROPE), (LAS float*)(lds + 131072), (const float*)(ws + WS_SSQ1), (const float*)(ws + WS_CB)};
    pg8::gemm_phase<pg8::EpiProj1, pg8::StaticOrder, true, true>(lds, g, S, E);
    bf16_t* K1 = (bf16_t*)(ws + WS_K1); bf16_t* V1 = (bf16_t*)(ws + WS_V1);
    small_gemm_splitk((const bf16_t*)(ws + WS_H1) + (size_t)ML * D, D, (const bf16_t*)(ws + WS_W3T), D, D, MC, 1024, lds, nullptr, nullptr,
               [=](int m, int n, float v, float vn) { if (n & 1) return 0.f; const float* CB = (const float*)(ws + WS_CB) + 2 * O_IN; const float rs1 = rsqrtf(((const float*)(ws + WS_SSQ1))[ML + m] * (1.f / 1024.f) + EPS);
                 const unsigned w = pk2(v * rs1 + CB[n], vn * rs1 + CB[n + 1]);
                 if (n < 512) *(unsigned*)(K1 + (size_t)(ML + m) * 512 + n) = w; else *(unsigned*)(V1 + (size_t)(ML + m) * 512 + (n - 512)) = w; return 0.f; }); })
  PH(15, attn_phase((bf16_t*)(ws + WS_Q1), (const bf16_t*)(ws + WS_K1), (const bf16_t*)(ws + WS_V1), (const bf16_t*)(ws + WS_G1), p.in[24], p.in[22], p.in[23], lds, wr))
  PH(16, {
    pg8::Gemm g{(const bf16_t*)(ws + WS_Q1), (const bf16_t*)(ws + WS_W4T), ML, D, 2048}; pg8::StaticOrder S; S.init(ML, D, gridDim.x, (int)blockIdx.x);
    pg8::EpiResid E{X1, p.out, MOD + 3 * 3072, wr};
    pg8::gemm_phase<pg8::EpiResid, pg8::StaticOrder, true, true>(lds, g, S, E); })
#undef PH
#undef IN
#undef SEAM
}
extern "C" void kernel_launch(void* const* d_in, const int* in_sizes, int n_in, void* d_out, int out_size, void* d_ws, size_t ws_size, hipStream_t stream) {
  static int grid_blocks = 0;
  if (!grid_blocks) {
    int dev = 0, cus = 0, per_cu = 0;
    hipGetDevice(&dev);
    hipDeviceGetAttribute(&cus, hipDeviceAttributeMultiprocessorCount, dev);
    hipFuncSetAttribute((const void*)mega, hipFuncAttributeMaxDynamicSharedMemorySize, LDS_BYTES);
    hipOccupancyMaxActiveBlocksPerMultiprocessor(&per_cu, (const void*)mega, NWAVES * 64, LDS_BYTES);
    if (per_cu < 1) { fprintf(stderr, "kernel_launch: occupancy query says %d blocks per CU\n", per_cu); per_cu = 1; }
    if (per_cu > 1) per_cu = 1;
    grid_blocks = cus * per_cu;
  }
  hipMemsetAsync((char*)d_ws + WS_CTL, 0, 256 * 1024, stream);
  Params base{};
  for (int i = 0; i < 26; ++i) base.in[i] = (const float*)d_in[i];
  base.out = (float*)d_out; base.ws = (unsigned char*)d_ws;
  auto launch = [&](int lo, int hi) {
    Params p = base; p.ph_lo = lo; p.ph_hi = hi; p.rep = (int)PROBE_MASK; void* args[] = {&p};
    hipError_t e = hipLaunchCooperativeKernel((const void*)mega, dim3(grid_blocks), dim3(NWAVES * 64), args, LDS_BYTES, stream);
    if (e != hipSuccess) fprintf(stderr, "cooperative launch failed: %s (grid %d)\n", hipGetErrorString(e), grid_blocks);
  };
  launch(0, 17);
}
```

```cpp
#include <hip/hip_runtime.h>
#include <hip/hip_cooperative_groups.h>
#include <stdint.h>
#include <math.h>
#include <cstdio>
namespace cg = cooperative_groups;
#ifndef PROBE_SKIP
#define PROBE_SKIP 0
#endif
#ifndef PROBE_MASK
#define PROBE_MASK 0u
#endif

typedef unsigned short bf16_t;
#define DEV __device__ __forceinline__

DEV float bf2f(bf16_t v) { return __uint_as_float(((unsigned)v) << 16); }
typedef float f32x2_t __attribute__((ext_vector_type(2))); typedef __bf16 bf16x2_t __attribute__((ext_vector_type(2)));
DEV unsigned pk2(float lo, float hi) { const f32x2_t v = {lo, hi}; const bf16x2_t b = __builtin_convertvector(v, bf16x2_t); return __builtin_bit_cast(unsigned, b); }
DEV bf16_t f2bf(float f) { return (bf16_t)(pk2(f, 0.f) & 0xffffu); }
DEV float fexp(float x) { return __builtin_amdgcn_exp2f(x * 1.4426950408889634f); }
DEV float siluf(float x) { return x / (1.f + fexp(-x)); }
DEV float silu_fast(float x) { return x * __builtin_amdgcn_rcpf(1.f + fexp(-x)); }
DEV float softplusf(float x) { return x > 20.f ? x : log1pf(fexp(x)); }
DEV float logsigmoidf(float x) { return fminf(x, 0.f) - log1pf(fexp(-fabsf(x))); }

constexpr int D = 1024, NB = 2, SEQ = 8192, CTXL = 256;
constexpr int ML = NB * SEQ;
constexpr int MC = NB * CTXL;
constexpr int MA = ML + MC;
constexpr int NCH = MA / 128;
constexpr int E_IN = 5696, O_IN = 5120, E_INP = 5888;
constexpr float EPS = 1e-6f;

constexpr size_t MiB = 1u << 20;
constexpr int CW_CSQ = 8192;
constexpr size_t WS_CTL = 0;
constexpr size_t WS_SSQ1 = 64 * 1024;
constexpr size_t WS_CB = 160 * 1024;
constexpr size_t WS_MOD = 1 * MiB;
constexpr size_t WS_ROPE = 1 * MiB + 128 * 1024;
constexpr size_t WS_SDEC = 1 * MiB + 256 * 1024;
constexpr size_t WS_GDEC = 1 * MiB + 384 * 1024;
constexpr size_t WS_W1T = 2 * MiB;
constexpr size_t WS_W2T = 14 * MiB;
constexpr size_t WS_W3T = 18 * MiB;
constexpr size_t WS_W4T = 28 * MiB;
constexpr size_t WS_Y0 = 32 * MiB;
constexpr size_t WS_Q0 = 98 * MiB;
constexpr size_t WS_K0 = WS_Q0 + 16 * MiB + 512 * 1024;
constexpr size_t WS_V0 = 131 * MiB;
constexpr size_t WS_DTLR = 164 * MiB;
constexpr size_t WS_XC1 = 168 * MiB + 512 * 1024;
constexpr size_t WS_XBC = 171 * MiB;
constexpr size_t WS_STATE = 171 * MiB;
constexpr size_t WS_TAIL = 237 * MiB;
constexpr size_t WS_H1 = 98 * MiB;
constexpr size_t WS_K1 = 131 * MiB;
constexpr size_t WS_V1 = 147 * MiB + 512 * 1024;
constexpr size_t WS_Q1 = 32 * MiB;
constexpr size_t WS_G1 = 171 * MiB;

DEV int row_vec(int row) { return row < ML ? (row / SEQ) : 2; }

namespace pg8 {
constexpr int O_IN_ = 5120;
#define PG8_LAS __attribute__((address_space(3)))
typedef unsigned short bf16_t;
typedef short bf16x8 __attribute__((ext_vector_type(8)));
typedef float f32x4 __attribute__((ext_vector_type(4)));
typedef unsigned u32x4 __attribute__((ext_vector_type(4)));
constexpr int BM = 256, BK = 64, HALF = 128, HTB = HALF * BK * 2  , STAGE_BYTES = 8 * HTB, NXCD = 8, WGM = 8;

__host__ __device__ __forceinline__ int lds_byte(int r, int c) { const int st = (r >> 4) * 2 + (c >> 5), rr = r & 15, cc = c & 31, ob = rr * 64 + cc * 2; return st * 1024 + (ob ^ (((ob >> 9) & 1) << 5)); }
__host__ __device__ __forceinline__ void stage_rc(int b, int& R, int& C) { const int st = b / 1024, sb = b % 1024, swz = sb ^ (((sb >> 9) & 1) << 5); R = (st >> 1) * 16 + swz / 64; C = (st & 1) * 32 + (swz % 64) / 2; }
__host__ __device__ __forceinline__ int perm32(int rho) { const int n = rho >> 4, i = rho & 15; return 8 * (i >> 2) + 4 * n + (i & 3); }

struct Unit { int pm, pn; };
struct Gemm { const bf16_t* A; const bf16_t* Bt; int M, N, K; };

struct StaticOrder {
    int nM, nN, nwg, G, c;
    __host__ __device__ __forceinline__ void init(int M, int N, int G_, int c_) { nM = M / BM; nN = N / BM; nwg = nM * nN; G = G_; c = c_; }
    __host__ __device__ __forceinline__ bool next(int i, Unit& u) const {
        const long L = (long)i * G + c; if (L >= nwg) return false;
        int wgid = (int)L; { const int q = nwg / NXCD, r = nwg % NXCD, xcd = wgid % NXCD, off = wgid / NXCD; wgid = (xcd < r ? xcd * (q + 1) : r * (q + 1) + (xcd - r) * q) + off; }
        const int nig = WGM * nN, gid = wgid / nig, fm = gid * WGM, gsz = (nM - fm) < WGM ? (nM - fm) : WGM;
        u.pm = fm + ((wgid % nig) % gsz); u.pn = (wgid % nig) / gsz; return true;
    }
    __device__ __forceinline__ void a_ready(const Unit&) const {}
    __device__ __forceinline__ void done(const Unit&) const {}
};
__device__ __forceinline__ unsigned cvt_pk_bf16(float lo, float hi) { unsigned r; asm volatile("v_cvt_pk_bf16_f32 %0, %1, %2" : "=v"(r) : "v"(lo), "v"(hi)); return r; }
__device__ __forceinline__ float silu_e(float x) { return x * __builtin_amdgcn_rcpf(1.f + fexp(-x)); }

__device__ __forceinline__ void store_unit_bf16(const f32x4 (&acc)[2][2][4][2], bf16_t* base, int ld, int colt, bool act, const Unit& u, int wr, int wc, int fr, int fq) {
    const int row0 = u.pm * BM + wr * 64 + fr; const int col0 = colt + wc * 32 + 8 * fq;
#pragma unroll
    for (int ai = 0; ai < 2; ++ai)
#pragma unroll
        for (int m = 0; m < 4; ++m) { bf16_t* rowp = base + (size_t)(row0 + ai * HALF + m * 16) * ld + col0;
#pragma unroll
            for (int bj = 0; bj < 2; ++bj) { f32x4 v0 = acc[ai][bj][m][0], v1 = acc[ai][bj][m][1];
                if (act) { v0 = (f32x4){silu_e(v0[0]), silu_e(v0[1]), silu_e(v0[2]), silu_e(v0[3])}; v1 = (f32x4){silu_e(v1[0]), silu_e(v1[1]), silu_e(v1[2]), silu_e(v1[3])}; }
                u32x4 w; w.x = cvt_pk_bf16(v0[0], v0[1]); w.y = cvt_pk_bf16(v0[2], v0[3]); w.z = cvt_pk_bf16(v1[0], v1[1]); w.w = cvt_pk_bf16(v1[2], v1[3]);
                *(u32x4*)(rowp + bj * HALF) = w; } }
}
struct EpiProj0 {
    static constexpr bool PERM = true, AFTER_DRAIN = false;
    bf16_t *Y0, *XBC, *Q0, *K0, *V0; float* DTLR;
    __device__ __forceinline__ void operator()(const f32x4 (&acc)[2][2][4][2], const Unit& u, int wr, int wc, int fr, int fq) const {
        const int pn = u.pn;
        if (pn == 22) {
            if (wc < 2) { const int row0 = u.pm * BM + wr * 64 + fr;
#pragma unroll
                for (int ai = 0; ai < 2; ++ai)
#pragma unroll
                    for (int m = 0; m < 4; ++m) { float* rp = DTLR + (size_t)(row0 + ai * HALF + m * 16) * 64 + wc * 32 + 8 * fq; *(f32x4*)rp = acc[ai][0][m][0]; *(f32x4*)(rp + 4) = acc[ai][0][m][1]; } }
            return;
        }
        bf16_t* base; int ld, colt; bool act = false;
        if (pn < 8) { base = Y0; ld = 2048; colt = pn * 256; act = true; }
        else if (pn < 14) { base = XBC; ld = 1536; colt = (pn - 8) * 256; }
        else if (pn < 16) { base = Q0; ld = 512; colt = (pn - 14) * 256; }
        else if (pn < 18) { base = K0; ld = 512; colt = (pn - 16) * 256; }
        else { base = V0; ld = 1024; colt = (pn - 18) * 256; }
        store_unit_bf16(acc, base, ld, colt, act, u, wr, wc, fr, fq);
    }
};
struct EpiProj1 {
    static constexpr bool PERM = true, AFTER_DRAIN = false;
    bf16_t *K1, *V1, *Q1, *G1; const float *qn, *kn, *rope; PG8_LAS float* part; const float *ssq1, *cb;
    __device__ __forceinline__ void operator()(const f32x4 (&acc_)[2][2][4][2], const Unit& u, int wr, int wc, int fr, int fq) const {
        const int pn = u.pn; bf16_t* base; int ld, colt; bool act = false;
        f32x4 acc[2][2][4][2];
        { const float* cbp = cb + ((u.pm * BM) / 8192) * O_IN_ + pn * BM + wc * 32 + 8 * fq; f32x4 cbv[2][2];
#pragma unroll
          for (int bj = 0; bj < 2; ++bj)
#pragma unroll
              for (int n = 0; n < 2; ++n) cbv[bj][n] = *(const f32x4*)(cbp + bj * HALF + 4 * n);
#pragma unroll
          for (int ai = 0; ai < 2; ++ai)
#pragma unroll
              for (int m = 0; m < 4; ++m) { const float rs_ = __builtin_amdgcn_rsqf(ssq1[u.pm * BM + ai * HALF + wr * 64 + m * 16 + fr] * (1.f / 1024.f) + 1e-6f);
#pragma unroll
                  for (int bj = 0; bj < 2; ++bj)
#pragma unroll
                      for (int n = 0; n < 2; ++n) acc[ai][bj][m][n] = acc_[ai][bj][m][n] * rs_ + cbv[bj][n]; } }
        if (pn < 2) { base = K1; ld = 512; colt = pn * 256; }
        else if (pn < 4) { base = V1; ld = 512; colt = (pn - 2) * 256; }
        else if (pn < 12) { base = Q1; ld = 2048; colt = (pn - 4) * 256; }
        else { base = G1; ld = 2048; colt = (pn - 12) * 256; act = true; }
        const bool isk = pn < 2, isq = pn >= 4 && pn < 12;
        if (!(isk || isq)) { store_unit_bf16(acc, base, ld, colt, act, u, wr, wc, fr, fq); return; }
#pragma unroll
        for (int ai = 0; ai < 2; ++ai)
#pragma unroll
            for (int m = 0; m < 4; ++m)
#pragma unroll
                for (int bj = 0; bj < 2; ++bj) { const f32x4 x0 = acc[ai][bj][m][0], x1 = acc[ai][bj][m][1];
                    float s = (x0[0] * x0[0] + x0[1] * x0[1]) + (x0[2] * x0[2] + x0[3] * x0[3]) + (x1[0] * x1[0] + x1[1] * x1[1]) + (x1[2] * x1[2] + x1[3] * x1[3]);
                    s += __shfl_xor(s, 16); s += __shfl_xor(s, 32);
                    if (fq == 0) part[(ai * HALF + wr * 64 + m * 16 + fr) * 8 + bj * 4 + wc] = s; }
        asm volatile("s_waitcnt lgkmcnt(0)" ::: "memory"); __builtin_amdgcn_s_barrier(); asm volatile("" ::: "memory");
        const int a = wc >> 1, f0 = 16 * (wc & 1) + 4 * fq;
        const float* gn = (isq ? qn : kn) + a * 64 + f0;
        const f32x4 g0 = *(const f32x4*)gn, g1 = *(const f32x4*)(gn + 32);
        const float osc = isq ? 0.08838834764831845f * 1.4426950408889634f : 1.f;
        const int col0 = colt + wc * 32 + 8 * fq;
        f32x4 w_[2][2][4][2];
#pragma unroll
        for (int ai = 0; ai < 2; ++ai)
#pragma unroll
            for (int bj = 0; bj < 2; ++bj)
#pragma unroll
                for (int m = 0; m < 4; ++m) { w_[ai][bj][m][0] = acc[ai][bj][m][0]; w_[ai][bj][m][1] = acc[ai][bj][m][1]; }
#pragma unroll 1
        for (int m = 0; m < 4; ++m) {
#pragma unroll
            for (int ai = 0; ai < 2; ++ai) { const int rowl = ai * HALF + wr * 64 + m * 16 + fr, row = u.pm * BM + rowl, t = row & 8191, pos = a ? (t & 63) : (t >> 6);
                const f32x4 cs = *(const f32x4*)(rope + pos * 32 + f0), sn = *(const f32x4*)(rope + 4096 + pos * 32 + f0);
                bf16_t* rowp = base + (size_t)row * ld + col0;
#pragma unroll
                for (int bj = 0; bj < 2; ++bj) { const f32x4 p4 = *(const PG8_LAS f32x4*)(part + rowl * 8 + bj * 4);
                    const float rstd = __builtin_amdgcn_rsqf(((p4[0] + p4[1]) + (p4[2] + p4[3])) * (1.f / 128.f) + 1e-6f) * osc;
                    const f32x4 t1 = w_[ai][bj][0][0] * g0 * rstd, t2 = w_[ai][bj][0][1] * g1 * rstd;
                    const f32x4 o1 = t1 * cs - t2 * sn, o2 = t2 * cs + t1 * sn;
                    u32x4 w; w.x = cvt_pk_bf16(o1[0], o1[1]); w.y = cvt_pk_bf16(o1[2], o1[3]); w.z = cvt_pk_bf16(o2[0], o2[1]); w.w = cvt_pk_bf16(o2[2], o2[3]);
                    *(u32x4*)(rowp + bj * HALF) = w; } }
#pragma unroll
            for (int ai = 0; ai < 2; ++ai)
#pragma unroll
                for (int bj = 0; bj < 2; ++bj)
#pragma unroll
                    for (int n = 0; n < 2; ++n) { w_[ai][bj][0][n] = w_[ai][bj][1][n]; w_[ai][bj][1][n] = w_[ai][bj][2][n]; w_[ai][bj][2][n] = w_[ai][bj][3][n]; }
        }
    }
};
struct EpiResid {
    static constexpr bool PERM = false, AFTER_DRAIN = false;
    const float* res; float* out; const float* mod; bool do_store;
    __device__ __forceinline__ void operator()(const f32x4 (&acc)[2][2][4][2], const Unit& u, int wr, int wc, int fr, int fq) const {
        const int b = (u.pm * BM) / 8192; const float* gate = mod + b * 3072 + 2048;
        const int col0 = u.pn * BM + wc * 32 + 4 * fq;
        f32x4 gv[2][2];
#pragma unroll
        for (int bj = 0; bj < 2; ++bj)
#pragma unroll
            for (int n = 0; n < 2; ++n) gv[bj][n] = *(const f32x4*)(gate + col0 + bj * HALF + n * 16);
#pragma unroll
        for (int ai = 0; ai < 2; ++ai)
#pragma unroll
            for (int m = 0; m < 4; ++m) { const size_t off = (size_t)(u.pm * BM + ai * HALF + wr * 64 + m * 16 + fr) * 1024 + col0;
#pragma unroll
                for (int bj = 0; bj < 2; ++bj)
#pragma unroll
                    for (int n = 0; n < 2; ++n) { const f32x4 r = *(const f32x4*)(res + off + bj * HALF + n * 16); const f32x4 ov_ = r + gv[bj][n] * acc[ai][bj][m][n]; if (do_store) *(f32x4*)(out + off + bj * HALF + n * 16) = ov_; } }
    }
};
struct EpiResidH {
    static constexpr bool PERM = true, AFTER_DRAIN = false;
    const float* res; float* out; const float* mod0; const float* g1; const float* mod1; bf16_t* H; float* ssq1;
    __device__ __forceinline__ void operator()(const f32x4 (&acc)[2][2][4][2], const Unit& u, int wr, int wc, int fr, int fq) const {
        const int b = (u.pm * BM) / 8192; const float* gate = mod0 + b * 3072 + 2048; const float* sc1 = mod1 + b * 3072 + 1024;
        const int col0 = u.pn * BM + wc * 32 + 8 * fq;
        f32x4 gv[2][2], gs[2][2];
#pragma unroll
        for (int bj = 0; bj < 2; ++bj)
#pragma unroll
            for (int n = 0; n < 2; ++n) { const int c = col0 + bj * HALF + 4 * n; gv[bj][n] = *(const f32x4*)(gate + c); gs[bj][n] = *(const f32x4*)(g1 + c) * (*(const f32x4*)(sc1 + c) + 1.f); }
#pragma unroll
        for (int ai = 0; ai < 2; ++ai)
#pragma unroll
            for (int m = 0; m < 4; ++m) { const int row = u.pm * BM + ai * HALF + wr * 64 + m * 16 + fr; const size_t off = (size_t)row * 1024 + col0; float ss = 0.f;
#pragma unroll
                for (int bj = 0; bj < 2; ++bj) { const f32x4 x0 = *(const f32x4*)(res + off + bj * HALF) + gv[bj][0] * acc[ai][bj][m][0], x1 = *(const f32x4*)(res + off + bj * HALF + 4) + gv[bj][1] * acc[ai][bj][m][1];
                    *(f32x4*)(out + off + bj * HALF) = x0; *(f32x4*)(out + off + bj * HALF + 4) = x1;
                    ss += (x0[0] * x0[0] + x0[1] * x0[1]) + (x0[2] * x0[2] + x0[3] * x0[3]) + (x1[0] * x1[0] + x1[1] * x1[1]) + (x1[2] * x1[2] + x1[3] * x1[3]);
                    const f32x4 h0 = x0 * gs[bj][0], h1 = x1 * gs[bj][1];
                    u32x4 w; w.x = cvt_pk_bf16(h0[0], h0[1]); w.y = cvt_pk_bf16(h0[2], h0[3]); w.z = cvt_pk_bf16(h1[0], h1[1]); w.w = cvt_pk_bf16(h1[2], h1[3]);
                    *(u32x4*)(H + off + bj * HALF) = w; }
                ss += __shfl_xor(ss, 16); ss += __shfl_xor(ss, 32);
                if (fq == 0) atomicAdd(ssq1 + row, ss); }
    }
};
template <class Epi, class Sched, bool ALIGN_EPI = false, bool SP2 = false, bool RS = false>
__device__ __forceinline__ void gemm_phase(PG8_LAS unsigned char* lds, const Gemm g, const Sched& S, const Epi& E, const PG8_LAS float* rs = nullptr) {
    const int tid = threadIdx.x, wid = __builtin_amdgcn_readfirstlane(tid >> 6), lane = tid & 63, wr = wid >> 2, wc = wid & 3, fr = lane & 15, fq = lane >> 4;
    const int K = g.K, nt = K / BK;
    unsigned voffA[2], voffB[2];
#pragma unroll
    for (int i = 0; i < 2; ++i) { int R, C; stage_rc(tid * 16 + i * 8192, R, C); const int Rb = Epi::PERM ? ((R & ~31) + perm32(R & 31)) : R;
        voffA[i] = (unsigned)(R * K + C) * 2u; voffB[i] = (unsigned)(Rb * K + C) * 2u; }
    const size_t kstep = (size_t)(BK * 2);
    const size_t hstep = (size_t)HALF * K * 2;
    const size_t tstep = 2 * hstep;
    const unsigned ldsw = (unsigned)wid * 1024u;
    const int aoff = lds_byte(wr * 64 + fr, fq * 8), boff = lds_byte(wc * 32 + fr, fq * 8);
#define PG8_SA(b, h) (((b) * 2 + (h)) * HTB)
#define PG8_SB(b, h) ((4 + (b) * 2 + (h)) * HTB)
#define PG8_STAGE(bufoff, gbase, voff) do { _Pragma("unroll") for (int _i = 0; _i < 2; ++_i) \
        __builtin_amdgcn_global_load_lds((const unsigned*)((const char*)(gbase) + (voff)[_i]), (PG8_LAS unsigned*)(lds + (bufoff) + ldsw + _i * 8192), 16, 0, 0); } while (0)
#define PG8_LDA(dst, b, h) do { _Pragma("unroll") for (int m = 0; m < 4; ++m) _Pragma("unroll") for (int k = 0; k < 2; ++k) dst[m][k] = *(const PG8_LAS bf16x8*)(lds + PG8_SA(b, h) + aoff + m * 2048 + k * 1024); } while (0)
#define PG8_LDB(dst, b, h) do { _Pragma("unroll") for (int n = 0; n < 2; ++n) _Pragma("unroll") for (int k = 0; k < 2; ++k) dst[n][k] = *(const PG8_LAS bf16x8*)(lds + PG8_SB(b, h) + boff + n * 2048 + k * 1024); } while (0)
#define PG8_MMA(ai, bj, At, Bt) do { __builtin_amdgcn_s_setprio(1); _Pragma("unroll") for (int m = 0; m < 4; ++m) _Pragma("unroll") for (int n = 0; n < 2; ++n) _Pragma("unroll") for (int k = 0; k < 2; ++k) \
        acc[ai][bj][m][n] = __builtin_amdgcn_mfma_f32_16x16x32_bf16(Bt[n][k], At[m][k], acc[ai][bj][m][n], 0, 0, 0); __builtin_amdgcn_s_setprio(0); } while (0)
#define PG8_WAIT_V(n) asm volatile("s_waitcnt vmcnt(" #n ")" ::: "memory")
#define PG8_WAIT_L(n) asm volatile("s_waitcnt lgkmcnt(" #n ")" ::: "memory")
#define PG8_BAR __builtin_amdgcn_s_barrier()
#define PG8_SCHED __builtin_amdgcn_sched_barrier(0)
    Unit cur, nxt; int ui = 0;
    if (!S.next(0, cur)) return;
    f32x4 acc[2][2][4][2];
#pragma unroll
    for (int a = 0; a < 2; ++a)
#pragma unroll
        for (int b = 0; b < 2; ++b)
#pragma unroll
            for (int m = 0; m < 4; ++m)
#pragma unroll
                for (int n = 0; n < 2; ++n) acc[a][b][m][n] = (f32x4){0.f, 0.f, 0.f, 0.f};
    bf16x8 At[4][2], B0[2][2], B1[2][2];
    const char* cA = (const char*)g.A + (size_t)cur.pm * tstep; const char* cB = (const char*)g.Bt + (size_t)cur.pn * tstep;
    S.a_ready(cur);
    if constexpr (SP2) {
        PG8_STAGE(PG8_SB(0, 0), cB, voffB); PG8_STAGE(PG8_SB(0, 1), cB + hstep, voffB); PG8_STAGE(PG8_SA(0, 0), cA, voffA); PG8_STAGE(PG8_SA(0, 1), cA + hstep, voffA);
        if (wr == 1) PG8_BAR;
        PG8_WAIT_V(2); PG8_BAR;
        PG8_STAGE(PG8_SB(1, 0), cB + kstep, voffB); PG8_STAGE(PG8_SA(1, 0), cA + kstep, voffA); PG8_STAGE(PG8_SB(1, 1), cB + hstep + kstep, voffB);
        PG8_WAIT_V(6); PG8_BAR;
    } else {
        PG8_STAGE(PG8_SB(0, 0), cB, voffB); PG8_STAGE(PG8_SA(0, 0), cA, voffA); PG8_STAGE(PG8_SB(0, 1), cB + hstep, voffB); PG8_STAGE(PG8_SA(0, 1), cA + hstep, voffA);
        if (wr == 1) PG8_BAR;
        PG8_WAIT_V(4); PG8_BAR;
        PG8_STAGE(PG8_SB(1, 0), cB + kstep, voffB); PG8_STAGE(PG8_SA(1, 0), cA + kstep, voffA); PG8_STAGE(PG8_SB(1, 1), cB + hstep + kstep, voffB);
        PG8_WAIT_V(6); PG8_BAR;
    }
    for (;;) {
        const bool has_next = S.next(ui + 1, nxt);
        const char* nA = has_next ? (const char*)g.A + (size_t)nxt.pm * tstep : cA; const char* nB = has_next ? (const char*)g.Bt + (size_t)nxt.pn * tstep : cB;
        for (int t = 0; t < nt; t += 2) {
            if constexpr (RS) { if (t == 8 || t == 16) { const int sel = (t == 16);
#pragma unroll
                for (int ai = 0; ai < 2; ++ai)
#pragma unroll
                    for (int m = 0; m < 4; ++m) { const float sc = rs[(ai * HALF + wr * 64 + m * 16 + fr) * 2 + sel];
#pragma unroll
                        for (int bj = 0; bj < 2; ++bj)
#pragma unroll
                            for (int n = 0; n < 2; ++n) acc[ai][bj][m][n] = acc[ai][bj][m][n] * sc; } } }
            const bool last = (t == nt - 2);
            const char* a1 = cA + (size_t)(t + 1) * kstep;
            const char* a2 = last ? nA : cA + (size_t)(t + 2) * kstep; const char* b2 = last ? nB : cB + (size_t)(t + 2) * kstep;
            const char* a3 = a2 + kstep; const char* b3 = b2 + kstep;
            if (last && has_next) S.a_ready(nxt);
            if constexpr (SP2) {
            PG8_LDB(B0, 0, 0); PG8_LDB(B1, 0, 1); PG8_SCHED; PG8_LDA(At, 0, 0); PG8_STAGE(PG8_SA(1, 1), a1 + hstep, voffA);
            PG8_WAIT_V(8); PG8_WAIT_L(0); PG8_BAR; PG8_MMA(0, 0, At, B0); PG8_MMA(0, 1, At, B1); PG8_BAR; PG8_SCHED;
            PG8_LDA(At, 0, 1); PG8_STAGE(PG8_SB(0, 0), b2, voffB); PG8_STAGE(PG8_SB(0, 1), b2 + hstep, voffB); PG8_STAGE(PG8_SA(0, 0), a2, voffA);
            PG8_WAIT_V(8); PG8_WAIT_L(0); PG8_BAR; PG8_MMA(1, 0, At, B0); PG8_MMA(1, 1, At, B1); PG8_BAR; PG8_SCHED;
            PG8_LDB(B0, 1, 0); PG8_LDB(B1, 1, 1); PG8_SCHED; PG8_LDA(At, 1, 0); PG8_STAGE(PG8_SA(0, 1), a2 + hstep, voffA);
            PG8_WAIT_V(8); PG8_WAIT_L(0); PG8_BAR; PG8_MMA(0, 0, At, B0); PG8_MMA(0, 1, At, B1); PG8_BAR; PG8_SCHED;
            PG8_LDA(At, 1, 1); PG8_STAGE(PG8_SB(1, 0), b3, voffB); PG8_STAGE(PG8_SB(1, 1), b3 + hstep, voffB); PG8_STAGE(PG8_SA(1, 0), a3, voffA);
            PG8_WAIT_V(8); PG8_WAIT_L(0); PG8_BAR; PG8_MMA(1, 0, At, B0); PG8_MMA(1, 1, At, B1); PG8_BAR; PG8_SCHED;
            } else {
            PG8_LDB(B0, 0, 0); PG8_SCHED; PG8_LDA(At, 0, 0); PG8_STAGE(PG8_SA(1, 1), a1 + hstep, voffA);
            PG8_WAIT_L(8); PG8_BAR; PG8_WAIT_L(0); PG8_MMA(0, 0, At, B0); PG8_BAR; PG8_SCHED;
            PG8_LDB(B1, 0, 1); PG8_STAGE(PG8_SB(0, 0), b2, voffB);
            PG8_BAR; PG8_WAIT_L(0); PG8_MMA(0, 1, At, B1); PG8_BAR;
            PG8_LDA(At, 0, 1); PG8_STAGE(PG8_SA(0, 0), a2, voffA);
            PG8_BAR; PG8_WAIT_L(0); PG8_MMA(1, 0, At, B0); PG8_BAR; PG8_SCHED;
            PG8_STAGE(PG8_SB(0, 1), b2 + hstep, voffB);
            PG8_WAIT_V(6); PG8_BAR; PG8_MMA(1, 1, At, B1); PG8_BAR;
            PG8_LDB(B0, 1, 0); PG8_SCHED; PG8_LDA(At, 1, 0); PG8_STAGE(PG8_SA(0, 1), a2 + hstep, voffA);
            PG8_WAIT_L(8); PG8_BAR; PG8_WAIT_L(0); PG8_MMA(0, 0, At, B0); PG8_BAR; PG8_SCHED;
            PG8_LDB(B1, 1, 1); PG8_STAGE(PG8_SB(1, 0), b3, voffB);
            PG8_BAR; PG8_WAIT_L(0); PG8_MMA(0, 1, At, B1); PG8_BAR;
            PG8_LDA(At, 1, 1); PG8_STAGE(PG8_SA(1, 0), a3, voffA);
            PG8_BAR; PG8_WAIT_L(0); PG8_MMA(1, 0, At, B0); PG8_BAR; PG8_SCHED;
            PG8_STAGE(PG8_SB(1, 1), b3 + hstep, voffB);
            PG8_WAIT_V(6); PG8_BAR; PG8_MMA(1, 1, At, B1); PG8_BAR;
            }
        }
        if constexpr (ALIGN_EPI) { if (wr == 0) PG8_BAR; }
        if constexpr (!Epi::AFTER_DRAIN) { E(acc, cur, wr, wc, fr, fq); S.done(cur); }
        if (!has_next) break;
#pragma unroll
        for (int a = 0; a < 2; ++a)
#pragma unroll
            for (int b = 0; b < 2; ++b)
#pragma unroll
                for (int m = 0; m < 4; ++m)
#pragma unroll
                    for (int n = 0; n < 2; ++n) acc[a][b][m][n] = (f32x4){0.f, 0.f, 0.f, 0.f};
        cur = nxt; cA = nA; cB = nB; ++ui;
        if constexpr (ALIGN_EPI) { if (wr == 1) PG8_BAR; }
    }
    PG8_WAIT_V(0);
    if constexpr (!ALIGN_EPI) { if (wr == 0) PG8_BAR; }
    PG8_BAR;
    if constexpr (Epi::AFTER_DRAIN) { E.fused(acc, cur, wr, wc, fr, fq, lds, wid, lane); S.done(cur); }
#undef PG8_SA
#undef PG8_SB
#undef PG8_STAGE
#undef PG8_LDA
#undef PG8_LDB
#undef PG8_MMA
#undef PG8_WAIT_V
#undef PG8_WAIT_L
#undef PG8_BAR
#undef PG8_SCHED
}
}
#define LAS __attribute__((address_space(3)))
typedef unsigned v4u __attribute__((ext_vector_type(4)));
typedef float f32x4 __attribute__((ext_vector_type(4)));
typedef short bf16x8 __attribute__((ext_vector_type(8)));
#define LDS_WAIT() asm volatile("s_waitcnt lgkmcnt(0)" ::: "memory")
constexpr int NWAVES = 8;
constexpr int LDS_BYTES = 147456;
constexpr int MISC_OFF = 147456 - 128;

struct Params { const float* in[26]; float* out; unsigned char* ws; int ph_lo, ph_hi, rep, pad; };

DEV int virt_block() { const int G = (int)gridDim.x, b = (int)blockIdx.x; return (G % 8 == 0) ? (b % 8) * (G / 8) + b / 8 : b; }
DEV float wave_sum(float v) {
#pragma unroll
  for (int o = 1; o < 64; o <<= 1) v += __shfl_xor(v, o);
  return v;
}

DEV int w1_dest_row(int n) {
  if (n < 1024) return n;
  if (n < 2560) return 2048 + (n - 1024);
  if (n < 2592) return 5632 + (n - 2560);
  if (n < 3104) return 3584 + (n - 2592);
  if (n < 3616) return 4096 + (n - 3104);
  if (n < 4640) return 4608 + (n - 3616);
  if (n < 5664) return 1024 + (n - 4640);
  return n;
}
DEV int qk_pos(int d) { const int a = d >> 6, s = (d >> 5) & 1, f = d & 31; return 32 * (2 * a + (f >> 4)) + 8 * ((f >> 2) & 3) + 4 * s + (f & 3); }
DEV void transpose_item(const float* W, int K, int N, int k0, int n0, bf16_t* WT, int drow0, LAS float* scr, int lane, int headbase = -1, const float* kscale = nullptr, const float* shv = nullptr, float* cb = nullptr) {
  { float wv_[32];
#pragma unroll
    for (int i = 0; i < 32; ++i) { const int kk = 2 * i + (lane >> 5); wv_[i] = W[(size_t)(k0 + kk) * N + n0 + (lane & 31)]; }
#pragma unroll
    for (int i = 0; i < 32; ++i) { const int kk = 2 * i + (lane >> 5); scr[kk * 33 + (lane & 31)] = wv_[i]; } }
  LDS_WAIT(); asm volatile("" ::: "memory");
  if (cb) {
    const int nn = lane & 31, hf = lane >> 5; float s0 = 0.f, s1 = 0.f, s2 = 0.f;
#pragma unroll 8
    for (int i = 0; i < 32; ++i) { const float w = scr[(hf * 32 + i) * 33 + nn]; const int k = k0 + hf * 32 + i; s0 += shv[k] * w; s1 += shv[3072 + k] * w; s2 += shv[6144 + k] * w; }
    s0 += __shfl_xor(s0, 32); s1 += __shfl_xor(s1, 32); s2 += __shfl_xor(s2, 32);
    if (hf == 0) { const int drow = headbase >= 0 ? headbase + qk_pos((n0 & 127) + nn) : drow0 + nn; atomicAdd(cb + drow, s0); atomicAdd(cb + N + drow, s1); atomicAdd(cb + 2 * N + drow, s2); } }
  const int c = lane & 7;
#pragma unroll
  for (int j = 0; j < 4; ++j) { const int n = (lane >> 3) + 8 * j; const LAS float* s = scr + (8 * c) * 33 + n;
    f32x4 k0s = {1.f, 1.f, 1.f, 1.f}, k1s = k0s; if (kscale) { k0s = *(const f32x4*)(kscale + k0 + 8 * c); k1s = *(const f32x4*)(kscale + k0 + 8 * c + 4); }
    v4u o; o.x = pk2(s[0 * 33] * k0s.x, s[1 * 33] * k0s.y); o.y = pk2(s[2 * 33] * k0s.z, s[3 * 33] * k0s.w); o.z = pk2(s[4 * 33] * k1s.x, s[5 * 33] * k1s.y); o.w = pk2(s[6 * 33] * k1s.z, s[7 * 33] * k1s.w);
    const int drow = headbase >= 0 ? headbase + qk_pos((n0 & 127) + n) : drow0 + n;
    *(v4u*)(WT + (size_t)drow * K + k0 + 8 * c) = o; }
  LDS_WAIT(); asm volatile("" ::: "memory");
}
DEV void prologue_phase(const Params& p, LAS unsigned char* lds) {
  const int tid = threadIdx.x, lane = tid & 63, wave = tid >> 6;
  unsigned char* ws = p.ws;
  float* MOD = (float*)(ws + WS_MOD);
  {
    LAS float* sc = (LAS float*)lds;
    LAS float* part = (LAS float*)(lds + 12288);
    for (int i = tid; i < 3072; i += 512) { const int v = i >> 10, k = i & 1023; const float cv = v < 2 ? p.in[1][v * 1024 + k] : p.in[3][k]; sc[i] = siluf(cv); }
    __syncthreads();
    for (int task = blockIdx.x; task < 192; task += gridDim.x) {
      const int l = task / 96, n0 = (task % 96) * 32; const float* w = l ? p.in[19] : p.in[5]; const float* bb = l ? p.in[20] : p.in[6];
      const int col = tid & 31, ks = tid >> 5;
      float a0 = 0.f, a1 = 0.f, a2 = 0.f;
#pragma unroll 64
      for (int k = ks * 64; k < ks * 64 + 64; ++k) { const float wv = w[(size_t)k * 3072 + n0 + col]; a0 += sc[k] * wv; a1 += sc[1024 + k] * wv; a2 += sc[2048 + k] * wv; }
      part[(ks * 3 + 0) * 32 + col] = a0; part[(ks * 3 + 1) * 32 + col] = a1; part[(ks * 3 + 2) * 32 + col] = a2;
      __syncthreads();
      if (tid < 96) { const int v = tid >> 5; float s = bb[n0 + col];
#pragma unroll
        for (int q = 0; q < 16; ++q) s += part[(q * 3 + v) * 32 + col];
        MOD[(l * 3 + v) * 3072 + n0 + col] = s; }
      __syncthreads();
    }
  }
  if (blockIdx.x == gridDim.x - 1) { float* rope = (float*)(ws + WS_ROPE);
    for (int idx = tid; idx < 4096; idx += 512) { const int pos = idx >> 5, f = idx & 31; const float inv = 1.0f / powf(10000.f, (float)f / 32.f); const float ang = (float)pos * inv; rope[idx] = cosf(ang); rope[4096 + idx] = sinf(ang); } }
  { v4u* z = (v4u*)(ws + WS_W1T + (size_t)E_IN * 1024 * 2); const v4u zero = {0u, 0u, 0u, 0u};
    for (int i = blockIdx.x * 512 + tid; i < (E_INP - E_IN) * 1024 * 2 / 16; i += gridDim.x * 512) z[i] = zero; }
  __syncthreads();
  {
    LAS float* scr = (LAS float*)(lds + wave * 16384);
    const int gw = blockIdx.x * NWAVES + wave, NGW = gridDim.x * NWAVES;
    constexpr int I1 = 16 * 178;
    const int nfree = (NGW > 192 * NWAVES) ? NGW - 192 * NWAVES : 0;
    for (int it = gw; it < I1; it = (it < NGW && nfree > 0 && gw >= 192 * NWAVES) ? NGW + (gw - 192 * NWAVES) : ((nfree > 0 && gw >= 192 * NWAVES) ? it + nfree : (nfree > 0 ? I1 : it + NGW))) {
      const int kb = it / 178, nb = it % 178; transpose_item(p.in[7], 1024, E_IN, 64 * kb, 32 * nb, (bf16_t*)(ws + WS_W1T), w1_dest_row(32 * nb), scr, lane); }
  }
}
DEV void late_weights(const Params& p, LAS unsigned char* lds, int vblock, int nvblocks) {
  const int lane = threadIdx.x & 63, wave = threadIdx.x >> 6; unsigned char* ws = p.ws;
  LAS float* scr = (LAS float*)(lds + wave * 16384);
  constexpr int I2 = 32 * 32, I3 = 16 * 160, I4 = 32 * 32;
  for (int it = vblock * NWAVES + wave; it < I2 + I3 + I4; it += nvblocks * NWAVES) {
    int r = it;
    if (r < I2) { const int kb = r / 32, nb = r % 32; transpose_item(p.in[17], 2048, 1024, 64 * kb, 32 * nb, (bf16_t*)(ws + WS_W2T), 32 * nb, scr, lane, -1, kb < 16 ? p.in[13] : nullptr); continue; }
    r -= I2;
    if (r < I3) { const int kb = r / 160, nb = r % 160, n0 = 32 * nb; const bool qk = n0 < 512 || (n0 >= 1024 && n0 < 3072);
      transpose_item(p.in[21], 1024, O_IN, 64 * kb, n0, (bf16_t*)(ws + WS_W3T), n0, scr, lane, qk ? (n0 & ~127) : -1, nullptr, (const float*)(ws + WS_MOD) + 3 * 3072, (float*)(ws + WS_CB)); continue; } r -= I3;
    { const int kb = r / 32, nb = r % 32; transpose_item(p.in[25], 2048, 1024, 64 * kb, 32 * nb, (bf16_t*)(ws + WS_W4T), 32 * nb, scr, lane); }
  }
}
DEV void prep_phase(const float* xlat, const float* xctx, const float* g, const float* mod, bf16_t* H) {
  const int lane = threadIdx.x & 63, wave = threadIdx.x >> 6, NW = gridDim.x * NWAVES;
  for (int row = blockIdx.x * NWAVES + wave; row < MA; row += 2 * NW) {
    const int row2 = row + NW; const bool has2 = row2 < MA;
    const float* s0 = row < ML ? xlat + (size_t)row * D : xctx + (size_t)(row - ML) * D;
    const float* s1 = has2 ? (row2 < ML ? xlat + (size_t)row2 * D : xctx + (size_t)(row2 - ML) * D) : s0;
    f32x4 v0[4], v1[4]; float ss0 = 0.f, ss1 = 0.f;
#pragma unroll
    for (int j = 0; j < 4; ++j) { v0[j] = *(const f32x4*)(s0 + 4 * lane + 256 * j); v1[j] = *(const f32x4*)(s1 + 4 * lane + 256 * j); }
#pragma unroll
    for (int j = 0; j < 4; ++j) { ss0 += (v0[j].x * v0[j].x + v0[j].y * v0[j].y) + (v0[j].z * v0[j].z + v0[j].w * v0[j].w); ss1 += (v1[j].x * v1[j].x + v1[j].y * v1[j].y) + (v1[j].z * v1[j].z + v1[j].w * v1[j].w); }
#pragma unroll
    for (int o = 1; o < 64; o <<= 1) { ss0 += __shfl_xor(ss0, o); ss1 += __shfl_xor(ss1, o); }
    const float r0 = rsqrtf(ss0 * (1.f / D) + EPS), r1 = rsqrtf(ss1 * (1.f / D) + EPS);
    const float* m0 = mod + row_vec(row) * 3072; const float* m1 = mod + row_vec(has2 ? row2 : row) * 3072;
#pragma unroll
    for (int j = 0; j < 4; ++j) { const int k = 4 * lane + 256 * j; const f32x4 gg = *(const f32x4*)(g + k);
      { const f32x4 sc = *(const f32x4*)(m0 + 1024 + k), sh = *(const f32x4*)(m0 + k); const f32x4 o = v0[j] * r0 * gg * (sc + 1.f) + sh;
        *(unsigned long long*)(H + (size_t)row * D + k) = (unsigned long long)pk2(o.x, o.y) | ((unsigned long long)pk2(o.z, o.w) << 32); }
      if (has2) { const f32x4 sc = *(const f32x4*)(m1 + 1024 + k), sh = *(const f32x4*)(m1 + k); const f32x4 o = v1[j] * r1 * gg * (sc + 1.f) + sh;
        *(unsigned long long*)(H + (size_t)row2 * D + k) = (unsigned long long)pk2(o.x, o.y) | ((unsigned long long)pk2(o.z, o.w) << 32); } }
  }
}
template <class F> DEV void small_gemm(const bf16_t* A, int lda, const bf16_t* Bt, int ldb, int K, int Mrows, int Ncols, F f) {
  const int lane = threadIdx.x & 63, wid = threadIdx.x >> 6, mt = wid >> 2, nt = wid & 3, r = lane & 15, q = lane >> 4;
  const int ntn = Ncols / 64, ntasks = (Mrows / 32) * ntn;
  for (int task = blockIdx.x; task < ntasks; task += gridDim.x) {
    const int row0 = (task / ntn) * 32 + mt * 16, col0 = (task % ntn) * 64 + nt * 16;
    const bf16_t* ap = A + (size_t)(row0 + r) * lda + 8 * q; const bf16_t* bp = Bt + (size_t)(col0 + r) * ldb + 8 * q;
    f32x4 acc = {0.f, 0.f, 0.f, 0.f};
#pragma unroll 8
    for (int k = 0; k < K; k += 32) { const bf16x8 a = *(const bf16x8*)(ap + k), b = *(const bf16x8*)(bp + k); acc = __builtin_amdgcn_mfma_f32_16x16x32_bf16(a, b, acc, 0, 0, 0); }
#pragma unroll
    for (int j = 0; j < 4; ++j) f(row0 + q * 4 + j, col0 + r, acc[j]);
  }
}

template <class F> DEV void small_gemm_splitk(const bf16_t* A, int lda, const bf16_t* Bt, int ldb, int K, int Mrows, int Ncols, LAS unsigned char* lds, float* rowsum  , const float* ssq  , F f) {
  const int tid = threadIdx.x, lane = tid & 63, wid = tid >> 6, r = lane & 15, q = lane >> 4;
  LAS float* red = (LAS float*)lds;
  const int ntn = Ncols / 64, ntasks = (Mrows / 32) * ntn, kw = K / 8;
  for (int task = virt_block(); task < ntasks; task += gridDim.x) {
    const int row0 = (task / ntn) * 32, col0 = (task % ntn) * 64;
    asm volatile("s_waitcnt vmcnt(0)" ::: "memory");
    const bf16_t* ap = A + (size_t)(row0 + r) * lda + wid * kw + 8 * q; const bf16_t* bp = Bt + (size_t)(col0 + r) * ldb + wid * kw + 8 * q;
    f32x4 acc[2][4];
#pragma unroll
    for (int mt = 0; mt < 2; ++mt)
#pragma unroll
      for (int nt = 0; nt < 4; ++nt) acc[mt][nt] = (f32x4){0.f, 0.f, 0.f, 0.f};
#pragma unroll 4
    for (int k = 0; k < kw; k += 32) {
      bf16x8 a[2], b[4];
#pragma unroll
      for (int mt = 0; mt < 2; ++mt) a[mt] = *(const bf16x8*)(ap + (size_t)(16 * mt) * lda + k);
#pragma unroll
      for (int nt = 0; nt < 4; ++nt) b[nt] = *(const bf16x8*)(bp + (size_t)(16 * nt) * ldb + k);
#pragma unroll
      for (int mt = 0; mt < 2; ++mt)
#pragma unroll
        for (int nt = 0; nt < 4; ++nt) acc[mt][nt] = __builtin_amdgcn_mfma_f32_16x16x32_bf16(a[mt], b[nt], acc[mt][nt], 0, 0, 0);
    }
    __syncthreads();
#pragma unroll
    for (int mt = 0; mt < 2; ++mt)
#pragma unroll
      for (int nt = 0; nt < 4; ++nt)
#pragma unroll
        for (int j = 0; j < 4; ++j) { const int rl = 16 * mt + 4 * q + j; float sc = 1.f;
          if (ssq && wid < 4) { const float* sp = ssq + ((size_t)(row0 + rl) * 2 + (wid >> 1)) * 2; sc = rsqrtf((sp[0] + sp[1]) * (1.f / 512.f) + EPS); }
          red[wid * 2048 + rl * 64 + 16 * nt + r] = acc[mt][nt][j] * sc; }
    __syncthreads();
#pragma unroll
    for (int o = 0; o < 4; ++o) { const int e = tid + 512 * o; float s = 0.f;
#pragma unroll
      for (int w = 0; w < 8; ++w) s += red[w * 2048 + e];
      float rv = f(row0 + (e >> 6), col0 + (e & 63), s, __shfl_xor(s, 1));
      if (rowsum) { rv = wave_sum(rv); if (lane == 0) atomicAdd(rowsum + row0 + (e >> 6), rv); } }
  }
}

DEV void qknorm_phase(bf16_t* Q1, bf16_t* K1, const float* qn, const float* kn, const float* rope, bool wr) {
  const int lane = threadIdx.x & 63, wave = threadIdx.x >> 6, hl = lane >> 4, d0 = (lane & 15) * 8;
  const float scale = 0.08838834764831845f * 1.4426950408889634f;
  float gq[8], gk[8];
#pragma unroll
  for (int e = 0; e < 8; ++e) { gq[e] = qn[d0 + e] * scale; gk[e] = kn[d0 + e]; }
  const int ax = d0 >> 6, sgn = (d0 >> 5) & 1, f0 = d0 & 31;
  for (int row = blockIdx.x * NWAVES + wave; row < MA; row += gridDim.x * NWAVES) {
    const bool lat = row < ML;
    v4u raw[5];
    raw[0] = *(const v4u*)(K1 + (size_t)row * 512 + hl * 128 + d0);
    if (lat) {
#pragma unroll
      for (int g = 0; g < 4; ++g) raw[1 + g] = *(const v4u*)(Q1 + (size_t)row * 2048 + (g * 4 + hl) * 128 + d0);
    }
    float cs[8], sn[8];
    if (lat) { const int t = row % SEQ, pos = ax ? (t & 63) : (t >> 6);
      const f32x4 c0 = *(const f32x4*)(rope + pos * 32 + f0), c1 = *(const f32x4*)(rope + pos * 32 + f0 + 4), s0 = *(const f32x4*)(rope + 4096 + pos * 32 + f0), s1 = *(const f32x4*)(rope + 4096 + pos * 32 + f0 + 4);
      cs[0] = c0.x; cs[1] = c0.y; cs[2] = c0.z; cs[3] = c0.w; cs[4] = c1.x; cs[5] = c1.y; cs[6] = c1.z; cs[7] = c1.w;
      sn[0] = s0.x; sn[1] = s0.y; sn[2] = s0.z; sn[3] = s0.w; sn[4] = s1.x; sn[5] = s1.y; sn[6] = s1.z; sn[7] = s1.w; }
    const int ng = lat ? 5 : 1;
#pragma unroll
    for (int g = 0; g < 5; ++g) {
      if (g < ng) {
        const v4u rv = raw[g];
        float v[8] = {__uint_as_float(rv.x << 16), __uint_as_float(rv.x & 0xffff0000u), __uint_as_float(rv.y << 16), __uint_as_float(rv.y & 0xffff0000u), __uint_as_float(rv.z << 16), __uint_as_float(rv.z & 0xffff0000u), __uint_as_float(rv.w << 16), __uint_as_float(rv.w & 0xffff0000u)};
        float ss = 0.f;
#pragma unroll
        for (int e = 0; e < 8; ++e) ss += v[e] * v[e];
        ss += __shfl_xor(ss, 1); ss += __shfl_xor(ss, 2); ss += __shfl_xor(ss, 4); ss += __shfl_xor(ss, 8);
        const float rstd = rsqrtf(ss * (1.f / 128.f) + EPS);
#pragma unroll
        for (int e = 0; e < 8; ++e) v[e] *= rstd * (g == 0 ? gk[e] : gq[e]);
        if (lat) {
#pragma unroll
          for (int e = 0; e < 8; ++e) { const float o = __shfl_xor(v[e], 4); v[e] = sgn ? (v[e] * cs[e] + o * sn[e]) : (v[e] * cs[e] - o * sn[e]); }
        }
        v4u ov; ov.x = pk2(v[0], v[1]); ov.y = pk2(v[2], v[3]); ov.z = pk2(v[4], v[5]); ov.w = pk2(v[6], v[7]);
        if (wr) { if (g == 0) *(v4u*)(K1 + (size_t)row * 512 + hl * 128 + d0) = ov; else *(v4u*)(Q1 + (size_t)row * 2048 + ((g - 1) * 4 + hl) * 128 + d0) = ov; }
      }
    }
  }
}
typedef short s16x4 __attribute__((ext_vector_type(4)));
DEV s16x4 tr_read(const LAS bf16_t* p) { return __builtin_bit_cast(s16x4, __builtin_amdgcn_ds_read_tr16_b64_v4i16((LAS s16x4*)p)); }
DEV void attn_phase(bf16_t* Q1, const bf16_t* K1, const bf16_t* V1, const bf16_t* G1, const float* sink, const float* qn, const float* kn, LAS unsigned char* lds, bool wr) {
  constexpr int KP = 136, VP = 144;
  LAS bf16_t* Ks = (LAS bf16_t*)lds;
  LAS bf16_t* Vs = (LAS bf16_t*)(lds + 2 * 64 * KP * 2);
  LAS float* dsc = (LAS float*)(lds + 2 * 64 * KP * 2 + 2 * 64 * VP * 2);
  const int tid = threadIdx.x, lane = tid & 63, wid = tid >> 6, r = lane & 15, Qd = lane >> 4;
  float mb;
  { float a = fmaxf(fabsf(qn[lane]), fabsf(qn[64 + lane])), b = fmaxf(fabsf(kn[lane]), fabsf(kn[64 + lane]));
#pragma unroll
    for (int o = 1; o < 64; o <<= 1) { a = fmaxf(a, __shfl_xor(a, o)); b = fmaxf(b, __shfl_xor(b, o)); }
    mb = a * b * 11.313708498984761f * 1.4426950408889634f; }
  const int skey = tid >> 4, sch = tid & 15;
  float gk[8];
  { const int dA = ((sch >> 2) >> 1) * 64 + 16 * ((sch >> 2) & 1) + 4 * (sch & 3); const f32x4 ga = *(const f32x4*)(kn + dA), gb_ = *(const f32x4*)(kn + dA + 32);
    gk[0] = ga.x; gk[1] = ga.y; gk[2] = ga.z; gk[3] = ga.w; gk[4] = gb_.x; gk[5] = gb_.y; gk[6] = gb_.z; gk[7] = gb_.w; }
  int task = virt_block(); if (task >= 1024) return;
  int b, kvh, qt, hq, qoff, tlo, nband, ntile; size_t qrow0;
  bf16x8 qf[2][4]; v4u kreg[2], vreg[2];
#define SET_TASK(tk) do { b = (tk) >> 9; kvh = ((tk) >> 7) & 3; qt = (tk) & 127; hq = kvh * 4 + (wid >> 1); qoff = (wid & 1) * 32; qrow0 = (size_t)b * SEQ + qt * 64 + qoff; \
    tlo = (2 - qt) > 0 ? (2 - qt) : 0; { const int thi_ = (129 - qt) < 4 ? (129 - qt) : 4; nband = thi_ - tlo + 1; } ntile = nband + 4; } while (0)
#define LOAD_Q() do { _Pragma("unroll") for (int m_ = 0; m_ < 2; ++m_) _Pragma("unroll") for (int ks_ = 0; ks_ < 4; ++ks_) qf[m_][ks_] = *(const bf16x8*)(Q1 + (qrow0 + 16 * m_ + r) * 2048 + hq * 128 + ks_ * 32 + 8 * Qd); } while (0)
#define TILE_ROW0(i) ((i) < nband ? (size_t)b * SEQ + (size_t)(qt - 2 + tlo + (i)) * 64 : (size_t)ML + b * CTXL + ((i) - nband) * 64)
#define LOAD_TILE(i) do { const size_t r0_ = TILE_ROW0(i); _Pragma("unroll") for (int h_ = 0; h_ < 2; ++h_) { const size_t go_ = (r0_ + skey + 32 * h_) * 512 + kvh * 128 + sch * 8; kreg[h_] = *(const v4u*)(K1 + go_); vreg[h_] = *(const v4u*)(V1 + go_); } } while (0)
#define STORE_TILE(buf, ti) do { const bool ctx_ = (ti) >= nband; _Pragma("unroll") for (int h_ = 0; h_ < 2; ++h_) { v4u kw_ = kreg[h_]; \
      if (ctx_) { float v_[8] = {__uint_as_float(kw_.x << 16), __uint_as_float(kw_.x & 0xffff0000u), __uint_as_float(kw_.y << 16), __uint_as_float(kw_.y & 0xffff0000u), __uint_as_float(kw_.z << 16), __uint_as_float(kw_.z & 0xffff0000u), __uint_as_float(kw_.w << 16), __uint_as_float(kw_.w & 0xffff0000u)}; \
        float ss_ = 0.f; _Pragma("unroll") for (int e_ = 0; e_ < 8; ++e_) ss_ += v_[e_] * v_[e_]; \
        ss_ += __shfl_xor(ss_, 1); ss_ += __shfl_xor(ss_, 2); ss_ += __shfl_xor(ss_, 4); ss_ += __shfl_xor(ss_, 8); \
        const float rs_ = rsqrtf(ss_ * (1.f / 128.f) + EPS); _Pragma("unroll") for (int e_ = 0; e_ < 8; ++e_) v_[e_] *= rs_ * gk[e_]; \
        kw_.x = pk2(v_[0], v_[1]); kw_.y = pk2(v_[2], v_[3]); kw_.z = pk2(v_[4], v_[5]); kw_.w = pk2(v_[6], v_[7]); } \
      *(LAS v4u*)(Ks + (buf) * 64 * KP + (skey + 32 * h_) * KP + sch * 8) = kw_; *(LAS v4u*)(Vs + (buf) * 64 * VP + (skey + 32 * h_) * VP + sch * 8) = vreg[h_]; } } while (0)
  SET_TASK(task); LOAD_Q(); LOAD_TILE(0);
  for (;;) {
    __syncthreads();
    STORE_TILE(0, 0);
    __syncthreads();
    f32x4 o[2][8];
#pragma unroll
    for (int m = 0; m < 2; ++m)
#pragma unroll
      for (int n = 0; n < 8; ++n) o[m][n] = (f32x4){0.f, 0.f, 0.f, 0.f};
    float lsum[2] = {0.f, 0.f};
    for (int i = 0; i < ntile; ++i) {
      const int buf = i & 1;
      if (i + 1 < ntile) LOAD_TILE(i + 1);
      const int mtype = (i < nband) ? ((tlo + i) == 0 ? 1 : ((tlo + i) == 4 ? 2 : 0)) : 0;
      const LAS bf16_t* Kb = Ks + buf * 64 * KP; const LAS bf16_t* Vb = Vs + buf * 64 * VP;
      f32x4 s[4][2];
#pragma unroll
      for (int t = 0; t < 4; ++t) { s[t][0] = (f32x4){-mb, -mb, -mb, -mb}; s[t][1] = (f32x4){-mb, -mb, -mb, -mb}; }
      {
        bf16x8 kA[2], kB[2];
#define LDK(dst, g_) do { _Pragma("unroll") for (int q_ = 0; q_ < 2; ++q_) dst[q_] = *(const LAS bf16x8*)(Kb + (16 * (((g_) & 1) * 2 + q_) + r) * KP + ((g_) >> 1) * 32 + 8 * Qd); } while (0)
#define MMK(src_, g_) do { _Pragma("unroll") for (int q_ = 0; q_ < 2; ++q_) { const int t_ = ((g_) & 1) * 2 + q_, ks_ = (g_) >> 1; s[t_][0] = __builtin_amdgcn_mfma_f32_16x16x32_bf16(src_[q_], qf[0][ks_], s[t_][0], 0, 0, 0); s[t_][1] = __builtin_amdgcn_mfma_f32_16x16x32_bf16(src_[q_], qf[1][ks_], s[t_][1], 0, 0, 0); } } while (0)
        LDK(kA, 0); LDK(kB, 1); __builtin_amdgcn_sched_barrier(0);
        MMK(kA, 0); __builtin_amdgcn_sched_barrier(0); LDK(kA, 2); __builtin_amdgcn_sched_barrier(0);
        MMK(kB, 1); __builtin_amdgcn_sched_barrier(0); LDK(kB, 3); __builtin_amdgcn_sched_barrier(0);
        MMK(kA, 2); __builtin_amdgcn_sched_barrier(0); LDK(kA, 4); __builtin_amdgcn_sched_barrier(0);
        MMK(kB, 3); __builtin_amdgcn_sched_barrier(0); LDK(kB, 5); __builtin_amdgcn_sched_barrier(0);
        MMK(kA, 4); __builtin_amdgcn_sched_barrier(0); LDK(kA, 6); __builtin_amdgcn_sched_barrier(0);
        MMK(kB, 5); __builtin_amdgcn_sched_barrier(0); LDK(kB, 7); __builtin_amdgcn_sched_barrier(0);
        MMK(kA, 6); __builtin_amdgcn_sched_barrier(0);
        MMK(kB, 7); __builtin_amdgcn_sched_barrier(0);
#undef LDK
#undef MMK
      }
      bf16x8 pa[2][2];
#define EXP_BLOCK(MT) do { _Pragma("unroll") for (int m = 0; m < 2; ++m) { const int qi = qoff + 16 * m + r; \
        _Pragma("unroll") for (int t = 0; t < 4; ++t) { float pv[4]; \
          _Pragma("unroll") for (int j = 0; j < 4; ++j) { const int kj = 16 * t + 4 * Qd + j; float pj = __builtin_amdgcn_exp2f(s[t][m][j]); \
            if (MT == 1) pj = (kj >= qi) ? pj : 0.f; else if (MT == 2) pj = (kj <= qi) ? pj : 0.f; \
            pv[j] = pj; lsum[m] += pj; } \
          const unsigned w0 = pk2(pv[0], pv[1]), w1 = pk2(pv[2], pv[3]); \
          pa[m][t >> 1][(t & 1) * 4 + 0] = (short)(w0 & 0xffff); pa[m][t >> 1][(t & 1) * 4 + 1] = (short)(w0 >> 16); \
          pa[m][t >> 1][(t & 1) * 4 + 2] = (short)(w1 & 0xffff); pa[m][t >> 1][(t & 1) * 4 + 3] = (short)(w1 >> 16); } } } while (0)
      if (mtype == 0) EXP_BLOCK(0); else if (mtype == 1) EXP_BLOCK(1); else EXP_BLOCK(2);
#undef EXP_BLOCK
      {
        bf16x8 vA[4], vB[4];
#define LDV(dst, g_) do { _Pragma("unroll") for (int q_ = 0; q_ < 4; ++q_) { const int k2_ = (g_) >> 1, n_ = ((g_) & 1) * 4 + q_; \
          const s16x4 lo = tr_read(Vb + (32 * k2_ + 4 * Qd + (r >> 2)) * VP + 16 * n_ + 4 * (r & 3)); const s16x4 hi = tr_read(Vb + (32 * k2_ + 16 + 4 * Qd + (r >> 2)) * VP + 16 * n_ + 4 * (r & 3)); \
          dst[q_] = (bf16x8){lo[0], lo[1], lo[2], lo[3], hi[0], hi[1], hi[2], hi[3]}; } } while (0)
#define MMV(src_, g_) do { _Pragma("unroll") for (int q_ = 0; q_ < 4; ++q_) { const int k2_ = (g_) >> 1, n_ = ((g_) & 1) * 4 + q_; \
          o[0][n_] = __builtin_amdgcn_mfma_f32_16x16x32_bf16(pa[0][k2_], src_[q_], o[0][n_], 0, 0, 0); o[1][n_] = __builtin_amdgcn_mfma_f32_16x16x32_bf16(pa[1][k2_], src_[q_], o[1][n_], 0, 0, 0); } } while (0)
        LDV(vA, 0); LDV(vB, 1); __builtin_amdgcn_sched_barrier(0);
        MMV(vA, 0); __builtin_amdgcn_sched_barrier(0); LDV(vA, 2); __builtin_amdgcn_sched_barrier(0);
        MMV(vB, 1); __builtin_amdgcn_sched_barrier(0); LDV(vB, 3); __builtin_amdgcn_sched_barrier(0);
        MMV(vA, 2); __builtin_amdgcn_sched_barrier(0);
        MMV(vB, 3); __builtin_amdgcn_sched_barrier(0);
#undef LDV
#undef MMV
      }
      if (i + 1 < ntile) STORE_TILE(buf ^ 1, i + 1);
      __syncthreads();
    }
    const int hq_c = hq; const size_t qrow0_c = qrow0;
    const int ntask = task + (int)gridDim.x; const bool more = ntask < 1024;
    if (more) { SET_TASK(ntask); LOAD_Q(); LOAD_TILE(0); }
    const float sk = __builtin_amdgcn_exp2f(sink[hq_c] * 1.4426950408889634f - mb);
#pragma unroll
    for (int m = 0; m < 2; ++m) { float l = lsum[m]; l += __shfl_xor(l, 16); l += __shfl_xor(l, 32); if (Qd == 0) dsc[wid * 32 + 16 * m + r] = 1.f / (l + sk); }
    LDS_WAIT(); asm volatile("" ::: "memory");
    { LAS bf16_t* stg = (LAS bf16_t*)lds + wid * 32 * 136;
#pragma unroll
      for (int m = 0; m < 2; ++m)
#pragma unroll
        for (int j = 0; j < 4; ++j) { const float inv = dsc[wid * 32 + 16 * m + 4 * Qd + j];
#pragma unroll
          for (int n = 0; n < 8; ++n) stg[(16 * m + 4 * Qd + j) * 136 + 16 * n + r] = f2bf(o[m][n][j] * inv); }
      LDS_WAIT(); asm volatile("" ::: "memory");
#pragma unroll
      for (int q = 0; q < 8; ++q) { const int c = lane + 64 * q, rowl = c >> 4, ch = c & 15; const size_t go = (qrow0_c + rowl) * 2048 + hq_c * 128 + ch * 8;
        const v4u ov = *(const LAS v4u*)(stg + rowl * 136 + ch * 8), gv = *(const v4u*)(G1 + go);
        v4u w; w.x = pk2(__uint_as_float(ov.x << 16) * __uint_as_float(gv.x << 16), __uint_as_float(ov.x & 0xffff0000u) * __uint_as_float(gv.x & 0xffff0000u));
        w.y = pk2(__uint_as_float(ov.y << 16) * __uint_as_float(gv.y << 16), __uint_as_float(ov.y & 0xffff0000u) * __uint_as_float(gv.y & 0xffff0000u));
        w.z = pk2(__uint_as_float(ov.z << 16) * __uint_as_float(gv.z << 16), __uint_as_float(ov.z & 0xffff0000u) * __uint_as_float(gv.z & 0xffff0000u));
        w.w = pk2(__uint_as_float(ov.w << 16) * __uint_as_float(gv.w << 16), __uint_as_float(ov.w & 0xffff0000u) * __uint_as_float(gv.w & 0xffff0000u));
        if (wr) *(v4u*)(Q1 + go) = w; }
      LDS_WAIT(); asm volatile("" ::: "memory"); }
    if (!more) break;
    task = ntask;
  }
#undef TILE_ROW0
#undef LOAD_TILE
#undef STORE_TILE
#undef SET_TASK
#undef LOAD_Q
}

constexpr size_t DO_SDT = 50 * MiB, DO_SCS = 53 * MiB;
constexpr size_t WS_SSQ = 237 * MiB;
DEV unsigned short bfbits(float f) { return f2bf(f); }
DEV void ssd_prep_phase(const bf16_t* XBC, const float* cw, const float* cb, bf16_t* XC, const float* DTLR, const float* dt_bias, const float* a_log, float* SDT, float* SCS, float* SDEC) {
  const int gtid = blockIdx.x * 512 + threadIdx.x, gth = gridDim.x * 512;
  for (int it = gtid; it < (MA / 32) * 192; it += gth) {
    const int rg = it / 192, c8 = (it % 192) * 8, row0 = rg * 32;
    int t0, len;
    if (row0 < ML) { t0 = row0 % SEQ; len = SEQ; } else { t0 = (row0 - ML) % CTXL; len = CTXL; }
    float w[5][8], bias[8];
#pragma unroll
    for (int k = 0; k < 5; ++k) { const f32x4 w0 = *(const f32x4*)(cw + k * 1536 + c8), w1 = *(const f32x4*)(cw + k * 1536 + c8 + 4);
      w[k][0] = w0.x; w[k][1] = w0.y; w[k][2] = w0.z; w[k][3] = w0.w; w[k][4] = w1.x; w[k][5] = w1.y; w[k][6] = w1.z; w[k][7] = w1.w; }
    { const f32x4 b0 = *(const f32x4*)(cb + c8), b1 = *(const f32x4*)(cb + c8 + 4); bias[0] = b0.x; bias[1] = b0.y; bias[2] = b0.z; bias[3] = b0.w; bias[4] = b1.x; bias[5] = b1.y; bias[6] = b1.z; bias[7] = b1.w; }
    const v4u zero4 = {0u, 0u, 0u, 0u};
#pragma unroll 1
    for (int hf = 0; hf < 2; ++hf) {
    v4u xr[20];
#pragma unroll
    for (int q = 0; q < 20; ++q) { const int tt = t0 + 16 * hf - 2 + q; xr[q] = (tt >= 0 && tt < len) ? *(const v4u*)(XBC + (size_t)(row0 + 16 * hf - 2 + q) * 1536 + c8) : zero4; }
    v4u win[4] = {xr[0], xr[1], xr[2], xr[3]};
#pragma unroll
    for (int i0 = 0; i0 < 16; ++i0) { const int i = 16 * hf + i0;
      const v4u nx = xr[i0 + 4];
      float acc[8];
#pragma unroll
      for (int e = 0; e < 8; ++e) acc[e] = bias[e];
#define CONV_TAP(k, xv) do { acc[0] += w[k][0] * __uint_as_float((xv).x << 16); acc[1] += w[k][1] * __uint_as_float((xv).x & 0xffff0000u); acc[2] += w[k][2] * __uint_as_float((xv).y << 16); acc[3] += w[k][3] * __uint_as_float((xv).y & 0xffff0000u); \
        acc[4] += w[k][4] * __uint_as_float((xv).z << 16); acc[5] += w[k][5] * __uint_as_float((xv).z & 0xffff0000u); acc[6] += w[k][6] * __uint_as_float((xv).w << 16); acc[7] += w[k][7] * __uint_as_float((xv).w & 0xffff0000u); } while (0)
      CONV_TAP(0, win[0]); CONV_TAP(1, win[1]); CONV_TAP(2, win[2]); CONV_TAP(3, win[3]); CONV_TAP(4, nx);
#undef CONV_TAP
      v4u o; o.x = pk2(silu_fast(acc[0]), silu_fast(acc[1])); o.y = pk2(silu_fast(acc[2]), silu_fast(acc[3])); o.z = pk2(silu_fast(acc[4]), silu_fast(acc[5])); o.w = pk2(silu_fast(acc[6]), silu_fast(acc[7]));
      *(v4u*)(XC + (size_t)(row0 + i) * 1536 + c8) = o;
      win[0] = win[1]; win[1] = win[2]; win[2] = win[3]; win[3] = nx;
    } }
  }
  {
    const int lane = threadIdx.x & 63, wave = threadIdx.x >> 6, cl = lane & 7, seg = lane >> 3;
    for (int wt = blockIdx.x * NWAVES + wave; wt < NCH * 4; wt += gridDim.x * NWAVES) {
      const int gc = wt >> 2, col = (wt & 3) * 8 + cl, dir = col >> 4, h = col & 15;
      const float a = -fexp(a_log[col]), bias = dt_bias[col];
      float dtv[16], v[16]; float run = 0.f;
#pragma unroll
      for (int u = 0; u < 16; ++u) { const int s = seg * 16 + u, t = dir ? 127 - s : s; dtv[u] = softplusf(DTLR[((size_t)gc * 128 + t) * 64 + col] + bias); }
#pragma unroll
      for (int u = 0; u < 16; ++u) { run += dtv[u] * a; v[u] = run; }
      float off = 0.f;
#pragma unroll
      for (int sgi = 0; sgi < 7; ++sgi) { const float tot = __shfl(run, cl + 8 * sgi); off += (sgi < seg) ? tot : 0.f; }
#pragma unroll
      for (int u = 0; u < 16; ++u) { const int s = seg * 16 + u, t = dir ? 127 - s : s; const size_t row = (size_t)gc * 128 + t; SDT[row * 32 + col] = dtv[u]; SCS[row * 32 + col] = v[u] + off; }
      if (seg == 7) SDEC[(gc * 16 + h) * 2 + dir] = fexp(run + off);
    }
  }
}
DEV void ssd_u_phase(const bf16_t* XC, const float* SDT, const float* SCS, bf16_t* ST, LAS unsigned char* lds) {
  constexpr int XP = 272, BP = 144;
  LAS bf16_t* Xs = (LAS bf16_t*)lds; LAS bf16_t* Bs = (LAS bf16_t*)(lds + 128 * XP * 2); LAS float* wtab = (LAS float*)(lds + 128 * XP * 2 + 128 * BP * 2);
  const int tid = threadIdx.x, lane = tid & 63, wid = tid >> 6, r = lane & 15, Qd = lane >> 4, hl = wid >> 1, dir = wid & 1;
  for (int task = virt_block(); task < NCH * 4; task += gridDim.x) {
    const int gc = task >> 2, g = (task >> 1) & 1, hh = task & 1; const size_t r0 = (size_t)gc * 128; const int h0 = g * 8 + hh * 4;
    __syncthreads();
#pragma unroll
    for (int i = 0; i < 8; ++i) { const int cid = tid + 512 * i, row = cid >> 5, ch = cid & 31; *(LAS v4u*)(Xs + row * XP + ch * 8) = *(const v4u*)(XC + (r0 + row) * 1536 + h0 * 64 + ch * 8); }
#pragma unroll
    for (int i = 0; i < 4; ++i) { const int cid = tid + 512 * i, row = cid >> 4, ch = cid & 15; *(LAS v4u*)(Bs + row * BP + ch * 8) = *(const v4u*)(XC + (r0 + row) * 1536 + 1024 + g * 128 + ch * 8); }
    if (tid < 256) { const int d_ = tid >> 7, t = tid & 127;
      const f32x4 ce = *(const f32x4*)(SCS + (r0 + (d_ ? 0 : 127)) * 32 + d_ * 16 + h0), ct = *(const f32x4*)(SCS + (r0 + t) * 32 + d_ * 16 + h0), dt = *(const f32x4*)(SDT + (r0 + t) * 32 + d_ * 16 + h0);
      wtab[(0 * 2 + d_) * 128 + t] = fexp(ce.x - ct.x) * dt.x; wtab[(1 * 2 + d_) * 128 + t] = fexp(ce.y - ct.y) * dt.y; wtab[(2 * 2 + d_) * 128 + t] = fexp(ce.z - ct.z) * dt.z; wtab[(3 * 2 + d_) * 128 + t] = fexp(ce.w - ct.w) * dt.w; }
    __syncthreads();
    const LAS float* wt = wtab + wid * 128;
    bf16_t* Sp = ST + ((((size_t)gc * 16 + h0 + hl) * 2 + dir) * 64) * 128;
#pragma unroll 1
    for (int pp = 0; pp < 2; ++pp) {
      f32x4 acc[8][2];
#pragma unroll
      for (int nt = 0; nt < 8; ++nt) { acc[nt][0] = (f32x4){0.f, 0.f, 0.f, 0.f}; acc[nt][1] = (f32x4){0.f, 0.f, 0.f, 0.f}; }
#pragma unroll
      for (int k = 0; k < 4; ++k) {
        const f32x4 wlo = *(const LAS f32x4*)(wt + 32 * k + 4 * Qd), whi = *(const LAS f32x4*)(wt + 32 * k + 16 + 4 * Qd);
        bf16x8 xf[2];
#pragma unroll
        for (int pt = 0; pt < 2; ++pt) {
          const s16x4 lo = tr_read(Xs + (32 * k + 4 * Qd + (r >> 2)) * XP + hl * 64 + 32 * pp + 16 * pt + 4 * (r & 3));
          const s16x4 hi = tr_read(Xs + (32 * k + 16 + 4 * Qd + (r >> 2)) * XP + hl * 64 + 32 * pp + 16 * pt + 4 * (r & 3));
          const unsigned w0 = pk2(bf2f((bf16_t)lo[0]) * wlo[0], bf2f((bf16_t)lo[1]) * wlo[1]), w1 = pk2(bf2f((bf16_t)lo[2]) * wlo[2], bf2f((bf16_t)lo[3]) * wlo[3]);
          const unsigned w2 = pk2(bf2f((bf16_t)hi[0]) * whi[0], bf2f((bf16_t)hi[1]) * whi[1]), w3 = pk2(bf2f((bf16_t)hi[2]) * whi[2], bf2f((bf16_t)hi[3]) * whi[3]);
          xf[pt] = (bf16x8){(short)(w0 & 0xffff), (short)(w0 >> 16), (short)(w1 & 0xffff), (short)(w1 >> 16), (short)(w2 & 0xffff), (short)(w2 >> 16), (short)(w3 & 0xffff), (short)(w3 >> 16)};
        }
#pragma unroll
        for (int nt = 0; nt < 8; ++nt) {
          const s16x4 lo = tr_read(Bs + (32 * k + 4 * Qd + (r >> 2)) * BP + 16 * nt + 4 * (r & 3));
          const s16x4 hi = tr_read(Bs + (32 * k + 16 + 4 * Qd + (r >> 2)) * BP + 16 * nt + 4 * (r & 3));
          const bf16x8 bfr = (bf16x8){lo[0], lo[1], lo[2], lo[3], hi[0], hi[1], hi[2], hi[3]};
          acc[nt][0] = __builtin_amdgcn_mfma_f32_16x16x32_bf16(bfr, xf[0], acc[nt][0], 0, 0, 0);
          acc[nt][1] = __builtin_amdgcn_mfma_f32_16x16x32_bf16(bfr, xf[1], acc[nt][1], 0, 0, 0);
        }
      }
#pragma unroll
      for (int nt = 0; nt < 8; ++nt)
#pragma unroll
        for (int pt = 0; pt < 2; ++pt) { const f32x4 v = acc[nt][pt];
          *(unsigned long long*)(Sp + ((((2 * pp + pt) * 4 + (nt >> 1)) * 64 + ((nt & 1) * 2 + (Qd >> 1)) * 16 + r) * 8 + 4 * (Qd & 1))) = (unsigned long long)pk2(v[0], v[1]) | ((unsigned long long)pk2(v[2], v[3]) << 32); }
    }
  }
}
DEV void ssd_scan_phase(bf16_t* ST, const float* SDEC, bool wr) {
  for (int item = blockIdx.x * 512 + threadIdx.x; item < 2 * 16 * 2 * 2048; item += gridDim.x * 512) {
    const int e4 = item & 2047, dir = (item >> 11) & 1, h = (item >> 12) & 15, b = item >> 16;
    float S0 = 0.f, S1 = 0.f, S2 = 0.f, S3 = 0.f;
#define SCAN_GC(s) (!dir ? ((s) < 2 ? 128 + 2 * b + (s) : b * 64 + ((s) - 2)) : ((s) < 2 ? 128 + 2 * b + (1 - (s)) : b * 64 + (65 - (s))))
    for (int s0 = 0; s0 < 66; s0 += 6) {
      unsigned long long u[6]; float dec[6];
#pragma unroll
      for (int q = 0; q < 6; ++q) { const int gc = SCAN_GC(s0 + q); u[q] = *(const unsigned long long*)(ST + (((size_t)gc * 16 + h) * 2 + dir) * 8192 + e4 * 4); dec[q] = SDEC[(gc * 16 + h) * 2 + dir]; }
#pragma unroll
      for (int q = 0; q < 6; ++q) { const int gc = SCAN_GC(s0 + q);
        if (wr) *(unsigned long long*)(ST + (((size_t)gc * 16 + h) * 2 + dir) * 8192 + e4 * 4) = (unsigned long long)pk2(S0, S1) | ((unsigned long long)pk2(S2, S3) << 32);
        const unsigned lo = (unsigned)u[q], hi = (unsigned)(u[q] >> 32);
        S0 = dec[q] * S0 + __uint_as_float(lo << 16); S1 = dec[q] * S1 + __uint_as_float(lo & 0xffff0000u); S2 = dec[q] * S2 + __uint_as_float(hi << 16); S3 = dec[q] * S3 + __uint_as_float(hi & 0xffff0000u); }
    }
#undef SCAN_GC
  }
}
DEV bf16x8 scale_frag(bf16x8 f, float s) {
  bf16x8 o;
#pragma unroll
  for (int e = 0; e < 8; e += 2) { const unsigned w = pk2(bf2f((bf16_t)f[e]) * s, bf2f((bf16_t)f[e + 1]) * s); o[e] = (short)(w & 0xffff); o[e + 1] = (short)(w >> 16); }
  return o;
}
DEV void ssd_y_phase(const bf16_t* XC, const float* SDT, const float* SCS, const bf16_t* ST, const float* d_skip, bf16_t* Y0, float* SSQ, LAS unsigned char* lds, bool wr) {
  constexpr int XP = 272, BP = 136, SP = 72;
  LAS bf16_t* Xs = (LAS bf16_t*)lds; LAS bf16_t* Bs = (LAS bf16_t*)(lds + 128 * XP * 2);
  LAS float* tab = (LAS float*)(lds + 128 * XP * 2 + 128 * BP * 2);
  LAS float* ssq = tab + 4 * 4 * 128;
  LAS bf16_t* stg = (LAS bf16_t*)(ssq + 4 * 128);
  const int tid = threadIdx.x, lane = tid & 63, wid = tid >> 6, r = lane & 15, Qd = lane >> 4, hl = wid >> 1, ih = wid & 1;
  LAS bf16_t* mystg = stg + wid * 16 * SP;
  for (int task = virt_block(); task < NCH * 4; task += gridDim.x) {
    const int gc = task >> 2, g = (task >> 1) & 1, hh = task & 1; const size_t r0 = (size_t)gc * 128; const int h0 = g * 8 + hh * 4, h = h0 + hl;
    bf16x8 cstrip[4], cf[4][4];
#pragma unroll
    for (int ks = 0; ks < 4; ++ks) cstrip[ks] = *(const bf16x8*)(XC + (r0 + 16 * wid + r) * 1536 + 1280 + g * 128 + 32 * ks + 8 * Qd);
#pragma unroll
    for (int m = 0; m < 4; ++m)
#pragma unroll
      for (int ks = 0; ks < 4; ++ks) cf[m][ks] = *(const bf16x8*)(XC + (r0 + 64 * ih + 16 * m + r) * 1536 + 1280 + g * 128 + 32 * ks + 8 * Qd);
    __syncthreads();
#pragma unroll
    for (int i = 0; i < 8; ++i) { const int cid = tid + 512 * i, row = cid >> 5, ch = cid & 31; *(LAS v4u*)(Xs + row * XP + ch * 8) = *(const v4u*)(XC + (r0 + row) * 1536 + h0 * 64 + ch * 8); }
#pragma unroll
    for (int i = 0; i < 4; ++i) { const int cid = tid + 512 * i, row = cid >> 4, ch = cid & 15; *(LAS v4u*)(Bs + row * BP + ch * 8) = *(const v4u*)(XC + (r0 + row) * 1536 + 1024 + g * 128 + ch * 8); }
    { const int which = tid >> 7, t = tid & 127; const f32x4 v = *(const f32x4*)((which < 2 ? SCS : SDT) + (r0 + t) * 32 + (which & 1) * 16 + h0);
      tab[0 * 512 + which * 128 + t] = v.x; tab[1 * 512 + which * 128 + t] = v.y; tab[2 * 512 + which * 128 + t] = v.z; tab[3 * 512 + which * 128 + t] = v.w; }
    __syncthreads();
    {
      f32x4 cb[8];
#pragma unroll
      for (int t = 0; t < 8; ++t) { f32x4 c = {0.f, 0.f, 0.f, 0.f};
#pragma unroll
        for (int ks = 0; ks < 4; ++ks) { const bf16x8 bfr = *(const LAS bf16x8*)(Bs + (16 * t + r) * BP + 32 * ks + 8 * Qd); c = __builtin_amdgcn_mfma_f32_16x16x32_bf16(bfr, cstrip[ks], c, 0, 0, 0); }
        cb[t] = c; }
      __syncthreads();
#pragma unroll
      for (int t = 0; t < 8; ++t) *(LAS unsigned long long*)(Bs + (16 * wid + r) * BP + 16 * t + 4 * Qd) = (unsigned long long)pk2(cb[t][0], cb[t][1]) | ((unsigned long long)pk2(cb[t][2], cb[t][3]) << 32);
      __syncthreads();
    }
    const LAS float* csf = tab + hl * 512; const LAS float* csb = csf + 128; const LAS float* dtf = csf + 256; const LAS float* dtb = csf + 384;
    const float dsk = d_skip[h];
    f32x4 y[4][4];
#pragma unroll
    for (int m = 0; m < 4; ++m)
#pragma unroll
      for (int pt = 0; pt < 4; ++pt) y[m][pt] = (f32x4){0.f, 0.f, 0.f, 0.f};
    if (wr || !(PROBE_SKIP & 1))
#pragma unroll 1
    for (int dir = 0; dir < 2; ++dir) {
      const LAS float* csd = dir ? csb : csf; float sc[4];
#pragma unroll
      for (int m = 0; m < 4; ++m)
#pragma unroll
        for (int ks = 0; ks < 4; ++ks) asm volatile("" : "+v"(cf[m][ks]));
#pragma unroll
      for (int m = 0; m < 4; ++m) sc[m] = fexp(csd[64 * ih + 16 * m + r]);
      const bf16_t* Sp = ST + (((size_t)gc * 16 + h) * 2 + dir) * 8192 + lane * 8;
#pragma unroll
      for (int ks = 0; ks < 4; ++ks) {
        bf16x8 sf[4];
#pragma unroll
        for (int pt = 0; pt < 4; ++pt) sf[pt] = *(const bf16x8*)(Sp + (pt * 4 + ks) * 512);
#pragma unroll
        for (int m = 0; m < 4; ++m) { const bf16x8 a = scale_frag(cf[m][ks], sc[m]);
#pragma unroll
          for (int pt = 0; pt < 4; ++pt) y[m][pt] = __builtin_amdgcn_mfma_f32_16x16x32_bf16(a, sf[pt], y[m][pt], 0, 0, 0);
          __builtin_amdgcn_sched_barrier(0); }
      }
    }
#pragma unroll 1
    for (int m = 0; m < 4; ++m) {
      const int i0 = 64 * ih + 16 * m, i = i0 + r;
      const float cfi = csf[i], cbi = csb[i];
      v4u zpre[2];
#pragma unroll
      for (int q = 0; q < 2; ++q) { const int c = lane + 64 * q; zpre[q] = *(const v4u*)(Y0 + (r0 + i0 + (c >> 3)) * 2048 + h * 64 + (c & 7) * 8); }
      if (wr || !(PROBE_SKIP & 2))
#pragma unroll 1
      for (int k2 = 0; k2 < 4; ++k2) {
        const int j0 = 32 * k2 + 8 * Qd;
        const v4u cbv = *(const LAS v4u*)(Bs + i * BP + j0);
        const float cbe[8] = {__uint_as_float(cbv.x << 16), __uint_as_float(cbv.x & 0xffff0000u), __uint_as_float(cbv.y << 16), __uint_as_float(cbv.y & 0xffff0000u), __uint_as_float(cbv.z << 16), __uint_as_float(cbv.z & 0xffff0000u), __uint_as_float(cbv.w << 16), __uint_as_float(cbv.w & 0xffff0000u)};
        float pv[8];
        const bool dofwd = (32 * k2 <= i0 + 15), dobwd = (32 * k2 + 31 >= i0);
#pragma unroll
        for (int e = 0; e < 8; ++e) pv[e] = (j0 + e == i) ? dsk : 0.f;
        if (dofwd) { const f32x4 a0 = *(const LAS f32x4*)(csf + j0), a1 = *(const LAS f32x4*)(csf + j0 + 4), d0 = *(const LAS f32x4*)(dtf + j0), d1 = *(const LAS f32x4*)(dtf + j0 + 4);
          const float jc[8] = {a0.x, a0.y, a0.z, a0.w, a1.x, a1.y, a1.z, a1.w}; const float jd[8] = {d0.x, d0.y, d0.z, d0.w, d1.x, d1.y, d1.z, d1.w};
#pragma unroll
          for (int e = 0; e < 8; ++e) pv[e] += cbe[e] * fexp(j0 + e <= i ? cfi - jc[e] : -INFINITY) * jd[e]; }
        if (dobwd) { const f32x4 a0 = *(const LAS f32x4*)(csb + j0), a1 = *(const LAS f32x4*)(csb + j0 + 4), d0 = *(const LAS f32x4*)(dtb + j0), d1 = *(const LAS f32x4*)(dtb + j0 + 4);
          const float jc[8] = {a0.x, a0.y, a0.z, a0.w, a1.x, a1.y, a1.z, a1.w}; const float jd[8] = {d0.x, d0.y, d0.z, d0.w, d1.x, d1.y, d1.z, d1.w};
#pragma unroll
          for (int e = 0; e < 8; ++e) pv[e] += cbe[e] * fexp(j0 + e >= i ? cbi - jc[e] : -INFINITY) * jd[e]; }
        const unsigned w0 = pk2(pv[0], pv[1]), w1 = pk2(pv[2], pv[3]), w2 = pk2(pv[4], pv[5]), w3 = pk2(pv[6], pv[7]);
        const bf16x8 pa = (bf16x8){(short)(w0 & 0xffff), (short)(w0 >> 16), (short)(w1 & 0xffff), (short)(w1 >> 16), (short)(w2 & 0xffff), (short)(w2 >> 16), (short)(w3 & 0xffff), (short)(w3 >> 16)};
#pragma unroll
        for (int pt = 0; pt < 4; ++pt) {
          const s16x4 lo = tr_read(Xs + (32 * k2 + 8 * Qd + (r >> 2)) * XP + hl * 64 + 16 * pt + 4 * (r & 3));
          const s16x4 hi = tr_read(Xs + (32 * k2 + 8 * Qd + 4 + (r >> 2)) * XP + hl * 64 + 16 * pt + 4 * (r & 3));
          const bf16x8 xf = (bf16x8){lo[0], lo[1], lo[2], lo[3], hi[0], hi[1], hi[2], hi[3]};
          y[0][pt] = __builtin_amdgcn_mfma_f32_16x16x32_bf16(pa, xf, y[0][pt], 0, 0, 0);
        }
      }
      if (wr || !(PROBE_SKIP & 4)) {
#pragma unroll
      for (int pt = 0; pt < 4; ++pt)
#pragma unroll
        for (int jj = 0; jj < 4; ++jj) mystg[(4 * Qd + jj) * SP + 16 * pt + r] = f2bf(y[0][pt][jj]);
      LDS_WAIT(); asm volatile("" ::: "memory");
#pragma unroll
      for (int q = 0; q < 2; ++q) { const int c = lane + 64 * q, rowl = c >> 3, ch = c & 7; const int il = 64 * ih + 16 * m + rowl;
        const v4u yv = *(const LAS v4u*)(mystg + rowl * SP + ch * 8); bf16_t* zp = Y0 + (r0 + il) * 2048 + h * 64 + ch * 8; const v4u zv = zpre[q];
        const float v0 = __uint_as_float(yv.x << 16) * __uint_as_float(zv.x << 16), v1 = __uint_as_float(yv.x & 0xffff0000u) * __uint_as_float(zv.x & 0xffff0000u);
        const float v2 = __uint_as_float(yv.y << 16) * __uint_as_float(zv.y << 16), v3 = __uint_as_float(yv.y & 0xffff0000u) * __uint_as_float(zv.y & 0xffff0000u);
        const float v4 = __uint_as_float(yv.z << 16) * __uint_as_float(zv.z << 16), v5 = __uint_as_float(yv.z & 0xffff0000u) * __uint_as_float(zv.z & 0xffff0000u);
        const float v6 = __uint_as_float(yv.w << 16) * __uint_as_float(zv.w << 16), v7 = __uint_as_float(yv.w & 0xffff0000u) * __uint_as_float(zv.w & 0xffff0000u);
        float ss = (v0 * v0 + v1 * v1) + (v2 * v2 + v3 * v3) + (v4 * v4 + v5 * v5) + (v6 * v6 + v7 * v7);
        ss += __shfl_xor(ss, 1); ss += __shfl_xor(ss, 2); ss += __shfl_xor(ss, 4);
        v4u ov; ov.x = pk2(v0, v1); ov.y = pk2(v2, v3); ov.z = pk2(v4, v5); ov.w = pk2(v6, v7);
        if (wr) *(v4u*)zp = ov;
        if (ch == 0) ssq[hl * 128 + il] = ss; }
      LDS_WAIT(); asm volatile("" ::: "memory");
      }
#pragma unroll
      for (int pt = 0; pt < 4; ++pt) { y[0][pt] = y[1][pt]; y[1][pt] = y[2][pt]; y[2][pt] = y[3][pt]; }
    }
    __syncthreads();
    if (tid < 128) SSQ[((r0 + tid) * 2 + g) * 2 + hh] = (ssq[tid] + ssq[128 + tid]) + (ssq[256 + tid] + ssq[384 + tid]);
  }
}

typedef _Float16 h16_t;
typedef _Float16 h16x8 __attribute__((ext_vector_type(8)));
DEV const h16_t* gcs_row(const h16_t* wsb, const h16_t* outb, size_t row) {
  return row < 9472 ? (const h16_t*)((const char*)wsb + 237 * MiB + 512 * 1024) + row * 1024 : (row < 13824 ? (const h16_t*)((const char*)outb + 55 * MiB + 512 * 1024) + (row - 9472) * 1024 : (const h16_t*)((const char*)wsb + 2 * MiB) + (row - 13824) * 1024); }
DEV h16_t* gcs_row_w(h16_t* wsb, h16_t* outb, size_t row) { return (h16_t*)gcs_row(wsb, outb, row); }
DEV float logsig_fast(float x) { return fminf(x, 0.f) - 0.6931471805599453f * __builtin_amdgcn_logf(1.f + __builtin_amdgcn_exp2f(-1.4426950408889634f * fabsf(x))); }
DEV void gla_cs_phase(const float* DTLR, const float* gw, const float* gb, h16_t* GCSL, h16_t* GCSC, float* GDEC, LAS unsigned char* lds, unsigned* queue) {
  const int lane = threadIdx.x & 63, wave = threadIdx.x >> 6;
  LAS float* lrs = (LAS float*)(lds + wave * 8192);
  LAS h16_t* tile = (LAS h16_t*)(lds + 65536 + wave * 1024);
  for (;;) {
    unsigned wt_ = 0u; if (lane == 0) wt_ = __hip_atomic_fetch_add(queue, 1u, __ATOMIC_RELAXED, __HIP_MEMORY_SCOPE_AGENT);
    wt_ = (unsigned)__builtin_amdgcn_readfirstlane((int)wt_); if (wt_ >= (unsigned)(NCH * 2 * 8)) break;
    const int wt = (int)wt_;
    const int gc = wt >> 4, dir = (wt >> 3) & 1, k = (wt & 7) * 64 + lane;
#pragma unroll
    for (int q = 0; q < 8; ++q) { const int c = lane + 64 * q, row = c >> 2, part = c & 3;
      *(LAS f32x4*)(lrs + row * 16 + part * 4) = *(const f32x4*)(DTLR + ((size_t)gc * 128 + row) * 64 + 32 + dir * 16 + part * 4); }
    float wv[16];
#pragma unroll
    for (int q = 0; q < 16; ++q) wv[q] = gw[(dir * 16 + q) * 512 + k];
    const float bias = gb[dir * 512 + k];
    LDS_WAIT(); asm volatile("" ::: "memory");
    float run = 0.f;
#pragma unroll 1
    for (int s0 = 0; s0 < 128; s0 += 8) {
      float lg[8];
#pragma unroll
      for (int u = 0; u < 8; ++u) { const int s = s0 + u, t = dir ? 127 - s : s; const LAS float* lr = lrs + t * 16;
        const f32x4 l0 = *(const LAS f32x4*)lr, l1 = *(const LAS f32x4*)(lr + 4), l2 = *(const LAS f32x4*)(lr + 8), l3 = *(const LAS f32x4*)(lr + 12);
        const float x = bias + l0.x * wv[0] + l0.y * wv[1] + l0.z * wv[2] + l0.w * wv[3] + l1.x * wv[4] + l1.y * wv[5] + l1.z * wv[6] + l1.w * wv[7]
                        + l2.x * wv[8] + l2.y * wv[9] + l2.z * wv[10] + l2.w * wv[11] + l3.x * wv[12] + l3.y * wv[13] + l3.z * wv[14] + l3.w * wv[15];
        lg[u] = logsig_fast(x) * (1.f / 16.f); }
#pragma unroll
      for (int u = 0; u < 8; ++u) { run += lg[u]; tile[u * 64 + lane] = (h16_t)run; }
      LDS_WAIT(); asm volatile("" ::: "memory");
      { const int u = lane >> 3, ch = lane & 7, s = s0 + u, t = dir ? 127 - s : s;
        *(v4u*)(gcs_row_w(GCSL, GCSC, (size_t)gc * 128 + t) + dir * 512 + (k - lane) + ch * 8) = *(const LAS v4u*)(tile + u * 64 + ch * 8); }
      LDS_WAIT(); asm volatile("" ::: "memory");
    }
    GDEC[((gc * 4 + (k >> 7)) * 2 + dir) * 128 + (k & 127)] = fexp(run);
    LDS_WAIT(); asm volatile("" ::: "memory");
  }
}
DEV void gla_u_phase(const bf16_t* K0, const bf16_t* V0, const h16_t* GCSL, const h16_t* GCSC, bf16_t* ST, LAS unsigned char* lds) {
  constexpr int VP = 272, KP = 144;
  LAS bf16_t* Vs = (LAS bf16_t*)lds; LAS bf16_t* Kd = (LAS bf16_t*)(lds + 128 * VP * 2);
  const int tid = threadIdx.x, lane = tid & 63, wid = tid >> 6, r = lane & 15, Qd = lane >> 4;
  for (int task = virt_block(); task < NCH * 4; task += gridDim.x) {
    const int gc = task >> 2, h = task & 3; const size_t r0 = (size_t)gc * 128;
    __syncthreads();
#pragma unroll
    for (int i = 0; i < 8; ++i) { const int cid = tid + 512 * i, row = cid >> 5, ch = cid & 31; *(LAS v4u*)(Vs + row * VP + ch * 8) = *(const v4u*)(V0 + (r0 + row) * 1024 + h * 256 + ch * 8); }
#pragma unroll
    for (int i = 0; i < 4; ++i) { const int cid = tid + 512 * i, t = cid >> 4, ch = cid & 15;
      const v4u kv = *(const v4u*)(K0 + (r0 + t) * 512 + h * 128 + ch * 8);
      const float kf[8] = {__uint_as_float(kv.x << 16), __uint_as_float(kv.x & 0xffff0000u), __uint_as_float(kv.y << 16), __uint_as_float(kv.y & 0xffff0000u), __uint_as_float(kv.z << 16), __uint_as_float(kv.z & 0xffff0000u), __uint_as_float(kv.w << 16), __uint_as_float(kv.w & 0xffff0000u)};
#pragma unroll
      for (int dir = 0; dir < 2; ++dir) {
        const h16x8 ce = *(const h16x8*)(gcs_row(GCSL, GCSC, r0 + (dir ? 0 : 127)) + dir * 512 + h * 128 + ch * 8), ct = *(const h16x8*)(gcs_row(GCSL, GCSC, r0 + t) + dir * 512 + h * 128 + ch * 8);
        v4u o; o.x = pk2(kf[0] * fexp((float)ce[0] - (float)ct[0]), kf[1] * fexp((float)ce[1] - (float)ct[1])); o.y = pk2(kf[2] * fexp((float)ce[2] - (float)ct[2]), kf[3] * fexp((float)ce[3] - (float)ct[3]));
        o.z = pk2(kf[4] * fexp((float)ce[4] - (float)ct[4]), kf[5] * fexp((float)ce[5] - (float)ct[5])); o.w = pk2(kf[6] * fexp((float)ce[6] - (float)ct[6]), kf[7] * fexp((float)ce[7] - (float)ct[7]));
        *(LAS v4u*)(Kd + dir * 128 * KP + t * KP + ch * 8) = o; } }
    __syncthreads();
#pragma unroll 1
    for (int dir = 0; dir < 2; ++dir) {
      const LAS bf16_t* Kb = Kd + dir * 128 * KP;
      f32x4 acc[8][2];
#pragma unroll
      for (int dt = 0; dt < 8; ++dt) { acc[dt][0] = (f32x4){0.f, 0.f, 0.f, 0.f}; acc[dt][1] = (f32x4){0.f, 0.f, 0.f, 0.f}; }
      {
        bf16x8 vfA[2], vfB[2], kA[2], kB[2], kC[2];
#define LDVF(dst, k_) do { _Pragma("unroll") for (int et = 0; et < 2; ++et) { const s16x4 lo = tr_read(Vs + (32 * (k_) + 4 * Qd + (r >> 2)) * VP + 32 * wid + 16 * et + 4 * (r & 3)); const s16x4 hi = tr_read(Vs + (32 * (k_) + 16 + 4 * Qd + (r >> 2)) * VP + 32 * wid + 16 * et + 4 * (r & 3)); \
          dst[et] = (bf16x8){lo[0], lo[1], lo[2], lo[3], hi[0], hi[1], hi[2], hi[3]}; } } while (0)
#define LDKF(dst, g_) do { _Pragma("unroll") for (int q_ = 0; q_ < 2; ++q_) { const int k_ = (g_) >> 2, dt_ = ((g_) & 3) * 2 + q_; const s16x4 lo = tr_read(Kb + (32 * k_ + 4 * Qd + (r >> 2)) * KP + 16 * dt_ + 4 * (r & 3)); const s16x4 hi = tr_read(Kb + (32 * k_ + 16 + 4 * Qd + (r >> 2)) * KP + 16 * dt_ + 4 * (r & 3)); \
          dst[q_] = (bf16x8){lo[0], lo[1], lo[2], lo[3], hi[0], hi[1], hi[2], hi[3]}; } } while (0)
#define MMKF(src_, g_) do { _Pragma("unroll") for (int q_ = 0; q_ < 2; ++q_) { const int dt_ = ((g_) & 3) * 2 + q_; \
          if ((((g_) >> 2) & 1) == 0) { acc[dt_][0] = __builtin_amdgcn_mfma_f32_16x16x32_bf16(src_[q_], vfA[0], acc[dt_][0], 0, 0, 0); acc[dt_][1] = __builtin_amdgcn_mfma_f32_16x16x32_bf16(src_[q_], vfA[1], acc[dt_][1], 0, 0, 0); } \
          else { acc[dt_][0] = __builtin_amdgcn_mfma_f32_16x16x32_bf16(src_[q_], vfB[0], acc[dt_][0], 0, 0, 0); acc[dt_][1] = __builtin_amdgcn_mfma_f32_16x16x32_bf16(src_[q_], vfB[1], acc[dt_][1], 0, 0, 0); } } } while (0)
        LDVF(vfA, 0); LDVF(vfB, 1);
        LDKF(kA, 0);
        LDKF(kB, 1);
        LDKF(kC, 2);
        __builtin_amdgcn_sched_barrier(0);
        MMKF(kA, 0); __builtin_amdgcn_sched_barrier(0);
        LDKF(kA, 3); __builtin_amdgcn_sched_barrier(0);
        MMKF(kB, 1); __builtin_amdgcn_sched_barrier(0);
        LDKF(kB, 4); __builtin_amdgcn_sched_barrier(0);
        MMKF(kC, 2); __builtin_amdgcn_sched_barrier(0);
        LDKF(kC, 5); __builtin_amdgcn_sched_barrier(0);
        MMKF(kA, 3); __builtin_amdgcn_sched_barrier(0); LDVF(vfA, 2); __builtin_amdgcn_sched_barrier(0);
        LDKF(kA, 6); __builtin_amdgcn_sched_barrier(0);
        MMKF(kB, 4); __builtin_amdgcn_sched_barrier(0);
        LDKF(kB, 7); __builtin_amdgcn_sched_barrier(0);
        MMKF(kC, 5); __builtin_amdgcn_sched_barrier(0);
        LDKF(kC, 8); __builtin_amdgcn_sched_barrier(0);
        MMKF(kA, 6); __builtin_amdgcn_sched_barrier(0);
        LDKF(kA, 9); __builtin_amdgcn_sched_barrier(0);
        MMKF(kB, 7); __builtin_amdgcn_sched_barrier(0); LDVF(vfB, 3); __builtin_amdgcn_sched_barrier(0);
        LDKF(kB, 10); __builtin_amdgcn_sched_barrier(0);
        MMKF(kC, 8); __builtin_amdgcn_sched_barrier(0);
        LDKF(kC, 11); __builtin_amdgcn_sched_barrier(0);
        MMKF(kA, 9); __builtin_amdgcn_sched_barrier(0);
        LDKF(kA, 12); __builtin_amdgcn_sched_barrier(0);
        MMKF(kB, 10); __builtin_amdgcn_sched_barrier(0);
        LDKF(kB, 13); __builtin_amdgcn_sched_barrier(0);
        MMKF(kC, 11); __builtin_amdgcn_sched_barrier(0);
        LDKF(kC, 14); __builtin_amdgcn_sched_barrier(0);
        MMKF(kA, 12); __builtin_amdgcn_sched_barrier(0);
        LDKF(kA, 15); __builtin_amdgcn_sched_barrier(0);
        MMKF(kB, 13); __builtin_amdgcn_sched_barrier(0);
        MMKF(kC, 14); __builtin_amdgcn_sched_barrier(0);
        MMKF(kA, 15); __builtin_amdgcn_sched_barrier(0);
#undef LDVF
#undef LDKF
#undef MMKF
      }
      bf16_t* Sp = ST + (((size_t)gc * 4 + h) * 2 + dir) * 32768;
#pragma unroll
      for (int dt = 0; dt < 8; ++dt)
#pragma unroll
        for (int et = 0; et < 2; ++et) { const f32x4 v = acc[dt][et];
          *(unsigned long long*)(Sp + ((((2 * wid + et) * 4 + (dt >> 1)) * 64 + ((dt & 1) * 2 + (Qd >> 1)) * 16 + r) * 8 + 4 * (Qd & 1))) = (unsigned long long)pk2(v[0], v[1]) | ((unsigned long long)pk2(v[2], v[3]) << 32); }
    }
  }
}
DEV void gla_scan_phase(bf16_t* ST, const float* GDEC, bool wr) {
  for (int item = blockIdx.x * 512 + threadIdx.x; item < 2 * 4 * 2 * 8192; item += gridDim.x * 512) {
    const int e4 = item & 8191, dir = (item >> 13) & 1, h = (item >> 14) & 3, b = item >> 16; const int d0 = 32 * ((e4 >> 7) & 3) + 8 * ((e4 >> 5) & 3) + 4 * (e4 & 1);
    float S0 = 0.f, S1 = 0.f, S2 = 0.f, S3 = 0.f;
#define SCAN_GC(s) (!dir ? ((s) < 2 ? 128 + 2 * b + (s) : b * 64 + ((s) - 2)) : ((s) < 2 ? 128 + 2 * b + (1 - (s)) : b * 64 + (65 - (s))))
    for (int s0 = 0; s0 < 66; s0 += 6) {
      unsigned long long u[6]; f32x4 dec[6];
#pragma unroll
      for (int q = 0; q < 6; ++q) { const int gc = SCAN_GC(s0 + q); u[q] = *(const unsigned long long*)(ST + (((size_t)gc * 4 + h) * 2 + dir) * 32768 + e4 * 4); dec[q] = *(const f32x4*)(GDEC + ((gc * 4 + h) * 2 + dir) * 128 + d0); }
#pragma unroll
      for (int q = 0; q < 6; ++q) { const int gc = SCAN_GC(s0 + q);
        if (wr) *(unsigned long long*)(ST + (((size_t)gc * 4 + h) * 2 + dir) * 32768 + e4 * 4) = (unsigned long long)pk2(S0, S1) | ((unsigned long long)pk2(S2, S3) << 32);
        const unsigned lo = (unsigned)u[q], hi = (unsigned)(u[q] >> 32);
        S0 = dec[q].x * S0 + __uint_as_float(lo << 16); S1 = dec[q].y * S1 + __uint_as_float(lo & 0xffff0000u); S2 = dec[q].z * S2 + __uint_as_float(hi << 16); S3 = dec[q].w * S3 + __uint_as_float(hi & 0xffff0000u); }
    }
#undef SCAN_GC
  }
}
DEV void gla_o_phase(const bf16_t* Q0, const bf16_t* K0, const bf16_t* V0, const h16_t* GCSL, const h16_t* GCSC, const bf16_t* ST, const float* gla_norm, bf16_t* Y0, LAS unsigned char* lds, bool wr) {
  constexpr int VP = 272, KP = 136;
  LAS bf16_t* Vs = (LAS bf16_t*)lds; LAS bf16_t* Kd = (LAS bf16_t*)(lds + 128 * VP * 2);
  const int tid = threadIdx.x, lane = tid & 63, wid = tid >> 6, r = lane & 15, Qd = lane >> 4;
  const float scale = 0.08838834764831845f;
  for (int task = virt_block(); task < NCH * 4; task += gridDim.x) {
    const int gc = task >> 2, h = task & 3; const size_t r0 = (size_t)gc * 128;
    __syncthreads();
#pragma unroll
    for (int i = 0; i < 8; ++i) { const int cid = tid + 512 * i, row = cid >> 5, ch = cid & 31; *(LAS v4u*)(Vs + row * VP + ch * 8) = *(const v4u*)(V0 + (r0 + row) * 1024 + h * 256 + ch * 8); }
#pragma unroll
    for (int i = 0; i < 4; ++i) { const int cid = tid + 512 * i, t = cid >> 4, ch = cid & 15;
      const v4u kv = *(const v4u*)(K0 + (r0 + t) * 512 + h * 128 + ch * 8);
      const float kf[8] = {__uint_as_float(kv.x << 16), __uint_as_float(kv.x & 0xffff0000u), __uint_as_float(kv.y << 16), __uint_as_float(kv.y & 0xffff0000u), __uint_as_float(kv.z << 16), __uint_as_float(kv.z & 0xffff0000u), __uint_as_float(kv.w << 16), __uint_as_float(kv.w & 0xffff0000u)};
#pragma unroll
      for (int dir = 0; dir < 2; ++dir) {
        const h16x8 ct = *(const h16x8*)(gcs_row(GCSL, GCSC, r0 + t) + dir * 512 + h * 128 + ch * 8);
        v4u o; o.x = pk2(kf[0] * fexp(-(float)ct[0]), kf[1] * fexp(-(float)ct[1])); o.y = pk2(kf[2] * fexp(-(float)ct[2]), kf[3] * fexp(-(float)ct[3]));
        o.z = pk2(kf[4] * fexp(-(float)ct[4]), kf[5] * fexp(-(float)ct[5])); o.w = pk2(kf[6] * fexp(-(float)ct[6]), kf[7] * fexp(-(float)ct[7]));
        *(LAS v4u*)(Kd + dir * 128 * KP + t * KP + ch * 8) = o; } }
    __syncthreads();
    const int i = 16 * wid + r;
    f32x4 o[16];
#pragma unroll
    for (int et = 0; et < 16; ++et) o[et] = (f32x4){0.f, 0.f, 0.f, 0.f};
#pragma unroll 1
    for (int dir = 0; dir < 2; ++dir) {
      bf16x8 qd[4];
      { const h16_t* ci = gcs_row(GCSL, GCSC, r0 + i) + dir * 512 + h * 128; const bf16_t* qp = Q0 + (r0 + i) * 512 + h * 128;
#pragma unroll
        for (int ks = 0; ks < 4; ++ks) { const v4u qv = *(const v4u*)(qp + 32 * ks + 8 * Qd); const h16x8 cc = *(const h16x8*)(ci + 32 * ks + 8 * Qd);
          const f32x4 c0 = {(float)cc[0], (float)cc[1], (float)cc[2], (float)cc[3]}, c1 = {(float)cc[4], (float)cc[5], (float)cc[6], (float)cc[7]};
          const unsigned w0 = pk2(__uint_as_float(qv.x << 16) * scale * fexp(c0.x), __uint_as_float(qv.x & 0xffff0000u) * scale * fexp(c0.y));
          const unsigned w1 = pk2(__uint_as_float(qv.y << 16) * scale * fexp(c0.z), __uint_as_float(qv.y & 0xffff0000u) * scale * fexp(c0.w));
          const unsigned w2 = pk2(__uint_as_float(qv.z << 16) * scale * fexp(c1.x), __uint_as_float(qv.z & 0xffff0000u) * scale * fexp(c1.y));
          const unsigned w3 = pk2(__uint_as_float(qv.w << 16) * scale * fexp(c1.z), __uint_as_float(qv.w & 0xffff0000u) * scale * fexp(c1.w));
          qd[ks] = (bf16x8){(short)(w0 & 0xffff), (short)(w0 >> 16), (short)(w1 & 0xffff), (short)(w1 >> 16), (short)(w2 & 0xffff), (short)(w2 >> 16), (short)(w3 & 0xffff), (short)(w3 >> 16)}; } }
      const bf16_t* Sp = ST + (((size_t)gc * 4 + h) * 2 + dir) * 32768 + lane * 8;
      {
        bf16x8 sA[4], sB[4];
#pragma unroll
        for (int q = 0; q < 4; ++q) sA[q] = *(const bf16x8*)(Sp + (q * 4 + 0) * 512);
#pragma unroll
        for (int bi = 0; bi < 16; ++bi) {
          const int ks = bi >> 2, e0 = 4 * (bi & 3);
          if (bi + 1 < 16) { const int ks2 = (bi + 1) >> 2, e2 = 4 * ((bi + 1) & 3);
#pragma unroll
            for (int q = 0; q < 4; ++q) { if (bi & 1) sA[q] = *(const bf16x8*)(Sp + ((e2 + q) * 4 + ks2) * 512); else sB[q] = *(const bf16x8*)(Sp + ((e2 + q) * 4 + ks2) * 512); } }
#pragma unroll
          for (int q = 0; q < 4; ++q) o[e0 + q] = __builtin_amdgcn_mfma_f32_16x16x32_bf16(qd[ks], (bi & 1) ? sB[q] : sA[q], o[e0 + q], 0, 0, 0);
          __builtin_amdgcn_sched_barrier(0);
        }
      }
      const LAS bf16_t* Kb = Kd + dir * 128 * KP;
#pragma unroll 1
      for (int k2 = 0; k2 < 4; ++k2) {
        const bool need = dir ? (2 * k2 + 1 >= wid) : (2 * k2 <= wid);
        if (!need) continue;
        bf16x8 pa;
#pragma unroll
        for (int tt = 0; tt < 2; ++tt) { const int t = 2 * k2 + tt;
          f32x4 c = {0.f, 0.f, 0.f, 0.f};
#pragma unroll
          for (int ks = 0; ks < 4; ++ks) { const bf16x8 kfr = *(const LAS bf16x8*)(Kb + (16 * t + r) * KP + 32 * ks + 8 * Qd); c = __builtin_amdgcn_mfma_f32_16x16x32_bf16(kfr, qd[ks], c, 0, 0, 0); }
          float pv[4];
#pragma unroll
          for (int jj = 0; jj < 4; ++jj) { const int j = 16 * t + 4 * Qd + jj; const bool ok = dir ? (j >= i) : (j <= i); pv[jj] = ok ? c[jj] : 0.f; }
          const unsigned w0 = pk2(pv[0], pv[1]), w1 = pk2(pv[2], pv[3]);
          pa[tt * 4 + 0] = (short)(w0 & 0xffff); pa[tt * 4 + 1] = (short)(w0 >> 16); pa[tt * 4 + 2] = (short)(w1 & 0xffff); pa[tt * 4 + 3] = (short)(w1 >> 16); }
#pragma unroll
        for (int et = 0; et < 16; ++et) {
          const s16x4 lo = tr_read(Vs + (32 * k2 + 4 * Qd + (r >> 2)) * VP + 16 * et + 4 * (r & 3));
          const s16x4 hi = tr_read(Vs + (32 * k2 + 16 + 4 * Qd + (r >> 2)) * VP + 16 * et + 4 * (r & 3));
          const bf16x8 vf = (bf16x8){lo[0], lo[1], lo[2], lo[3], hi[0], hi[1], hi[2], hi[3]};
          o[et] = __builtin_amdgcn_mfma_f32_16x16x32_bf16(pa, vf, o[et], 0, 0, 0); }
      }
    }
    asm volatile("s_nop 15\n\ts_nop 15\n\ts_nop 15\n\ts_nop 15" ::: "memory");
    __syncthreads();
    { constexpr int GP = 264;
      LAS bf16_t* stg = (LAS bf16_t*)lds + wid * (16 * GP);
      float gn_[16];
#pragma unroll
      for (int et = 0; et < 16; ++et) gn_[et] = gla_norm[h * 256 + 16 * et + r];
#pragma unroll
      for (int jj = 0; jj < 4; ++jj) { float ss = 0.f;
#pragma unroll
        for (int et = 0; et < 16; ++et) ss += o[et][jj] * o[et][jj];
        ss += __shfl_xor(ss, 1); ss += __shfl_xor(ss, 2); ss += __shfl_xor(ss, 4); ss += __shfl_xor(ss, 8);
        const float rstd = rsqrtf(ss * (1.f / 256.f) + EPS);
        LAS bf16_t* srow = stg + (4 * Qd + jj) * GP;
#pragma unroll
        for (int e = 0; e < 8; ++e) { const float a0 = o[2 * e][jj] * rstd * gn_[2 * e], a1 = o[2 * e + 1][jj] * rstd * gn_[2 * e + 1];
          const float p0 = __shfl_xor(a0, 1), p1 = __shfl_xor(a1, 1);
          const unsigned w = (r & 1) ? pk2(p1, a1) : pk2(a0, p0); const int col = (r & 1) ? 16 * (2 * e + 1) + r - 1 : 16 * (2 * e) + r;
          *(LAS unsigned*)(srow + col) = w; } }
      LDS_WAIT(); asm volatile("" ::: "memory");
#pragma unroll
      for (int q = 0; q < 8; ++q) { const int c = lane + 64 * q, rowl = c >> 5, ch = c & 31;
        bf16_t* gp = Y0 + (r0 + 16 * wid + rowl) * 2048 + 1024 + h * 256 + ch * 8;
        const v4u ov = *(const LAS v4u*)(stg + rowl * GP + ch * 8), gv = *(const v4u*)gp;
        v4u w; w.x = pk2(__uint_as_float(ov.x << 16) * __uint_as_float(gv.x << 16), __uint_as_float(ov.x & 0xffff0000u) * __uint_as_float(gv.x & 0xffff0000u));
        w.y = pk2(__uint_as_float(ov.y << 16) * __uint_as_float(gv.y << 16), __uint_as_float(ov.y & 0xffff0000u) * __uint_as_float(gv.y & 0xffff0000u));
        w.z = pk2(__uint_as_float(ov.z << 16) * __uint_as_float(gv.z << 16), __uint_as_float(ov.z & 0xffff0000u) * __uint_as_float(gv.z & 0xffff0000u));
        w.w = pk2(__uint_as_float(ov.w << 16) * __uint_as_float(gv.w << 16), __uint_as_float(ov.w & 0xffff0000u) * __uint_as_float(gv.w & 0xffff0000u));
        if (wr) *(v4u*)gp = w; }
      LDS_WAIT(); asm volatile("" ::: "memory"); }
  }
}

typedef __attribute__((address_space(1))) unsigned gu32;
#define RLX_AGENT __ATOMIC_RELAXED, __HIP_MEMORY_SCOPE_AGENT
#define XB_TMO      128
#define XB_XCNT(j)  (256  + 64 * (j))
#define XB_XSUB(j)  (1280 + 64 * (j))
#define XB_XGEN(j)  (2304 + 64 * (j))
#define XB_TOP      3328
#define XB_TOPGEN   3392
#define XCD_BAR_WORDS 3456
#define XB_SPIN_CAP (1u << 18)

__device__ __forceinline__ unsigned xb_ld(unsigned* p)              { return __hip_atomic_load(p, __ATOMIC_RELAXED, __HIP_MEMORY_SCOPE_AGENT); }
__device__ __forceinline__ unsigned xb_add(unsigned* p, unsigned v) { return __hip_atomic_fetch_add(p, v, __ATOMIC_RELAXED, __HIP_MEMORY_SCOPE_AGENT); }
__device__ __forceinline__ unsigned xb_xcc_id() { return (unsigned)__builtin_amdgcn_s_getreg((3 << 11) | 20) & 0xFu; }
#define XB_SPIN(cond, bar) do { unsigned _sp = 0; while (cond) { __builtin_amdgcn_s_sleep(1); \
    if ((++_sp & 255u) == 0u) { if (xb_ld(&(bar)[XB_TMO])) break; if (_sp > XB_SPIN_CAP) { atomicAdd(&(bar)[XB_TMO], 1u); break; } } } } while (0)

struct XcdBarrier {
    unsigned* bar; unsigned x;
    volatile LAS unsigned* st;
};

__device__ __forceinline__ XcdBarrier xcd_barrier_post(unsigned* bar, volatile LAS unsigned* st) {
    XcdBarrier b; b.bar = bar; b.x = xb_xcc_id(); b.st = st;
    if (threadIdx.x == 0) (void)xb_add(&bar[XB_XCNT(b.x)], 1u);
    return b;
}
__device__ __forceinline__ void xcd_barrier_complete(unsigned* bar, unsigned x, unsigned& nloc, unsigned& nx) {
    const unsigned G = gridDim.x * gridDim.y * gridDim.z;
    unsigned sum, cnt, mine, sp = 0u;
    for (;;) {
        sum = 0u; cnt = 0u; mine = 0u;
#pragma unroll
        for (unsigned j = 0; j < 16; ++j) { const unsigned c = xb_ld(&bar[XB_XCNT(j)]); sum += c; cnt += (c > 0u) ? 1u : 0u; mine = (j == x) ? c : mine; }
        if (sum == G) break;
        __builtin_amdgcn_s_sleep(1);
        if ((++sp & 255u) == 0u) { if (xb_ld(&bar[XB_TMO])) break; if (sp > XB_SPIN_CAP) { atomicAdd(&bar[XB_TMO], 1u); break; } }
    }
    nloc = mine > 0u ? mine : 1u; nx = cnt > 0u ? cnt : 1u;
}

__device__ __forceinline__ void xcd_barrier(const XcdBarrier& b) {
    asm volatile("s_waitcnt vmcnt(0)" ::: "memory");
    __syncthreads();
    if (threadIdx.x == 0) {
        unsigned* bar = b.bar;
        __builtin_amdgcn_s_waitcnt(0);
        unsigned nloc = b.st[0], nx = b.st[1];
        if (nloc == 0u) { xcd_barrier_complete(bar, b.x, nloc, nx); b.st[0] = nloc; b.st[1] = nx; }
        const unsigned old = xb_add(&bar[XB_XSUB(b.x)], 1u);
        const unsigned gen = old / nloc;
        if (old + 1u == (gen + 1u) * nloc) {
            __builtin_amdgcn_fence(__ATOMIC_RELEASE, "agent");
            asm volatile("s_waitcnt vmcnt(0)" ::: "memory");
            const unsigned og = xb_add(&bar[XB_TOP], 1u);
            const unsigned tg = og / nx;
            if (og + 1u == (tg + 1u) * nx) xb_add(&bar[XB_TOPGEN], 1u);
            else XB_SPIN(xb_ld(&bar[XB_TOPGEN]) == tg, bar);
            __builtin_amdgcn_fence(__ATOMIC_ACQUIRE, "agent");
            xb_add(&bar[XB_XGEN(b.x)], 1u);
            asm volatile("s_waitcnt vmcnt(0)" ::: "memory");
        } else {
            XB_SPIN(xb_ld(&bar[XB_XGEN(b.x)]) == gen, bar);
            __builtin_amdgcn_fence(__ATOMIC_ACQUIRE, "agent");
            asm volatile("s_waitcnt vmcnt(0)" ::: "memory");
        }
    }
    __syncthreads();
}

__global__ void __launch_bounds__(NWAVES * 64, 2) __attribute__((amdgpu_num_sgpr(92))) mega(Params p) {
  extern __shared__ __attribute__((aligned(16))) unsigned char lds_raw[];
  LAS unsigned char* lds = (LAS unsigned char*)lds_raw;
  volatile LAS unsigned* MISC = (volatile LAS unsigned*)(lds + MISC_OFF);
  if (threadIdx.x < 16) MISC[threadIdx.x] = 0u;
  __syncthreads();
  XcdBarrier bar = xcd_barrier_post((unsigned*)(p.ws + WS_CTL), MISC + 8);
  unsigned char* ws = p.ws;
  float* MOD = (float*)(ws + WS_MOD);
  bf16_t* H0 = (bf16_t*)p.out; float* X1 = p.out;
  const int lo = p.ph_lo, hi = p.ph_hi;
#define IN(k) (lo <= (k) && (k) < hi)
#define SEAM(k) do { if ((k) + 1 < hi) xcd_barrier(bar); } while (0)
#define PH(k, ...) if (IN(k)) { if ((PROBE_MASK >> (k)) & 1u) { const bool wr = (p.rep < 0); (void)wr; __VA_ARGS__; xcd_barrier(bar); } { const bool wr = true; (void)wr; __VA_ARGS__; } SEAM(k); }
  PH(0, prologue_phase(p, lds))
  PH(1, prep_phase(p.in[0], p.in[2], p.in[4], MOD, H0))
  PH(2, {
    pg8::Gemm g{H0, (const bf16_t*)(ws + WS_W1T), MA, E_INP, D}; pg8::StaticOrder S; S.init(MA, E_INP, gridDim.x, (int)blockIdx.x);
    pg8::EpiProj0 E{(bf16_t*)(ws + WS_Y0), (bf16_t*)(ws + WS_XBC), (bf16_t*)(ws + WS_Q0), (bf16_t*)(ws + WS_K0), (bf16_t*)(ws + WS_V0), (float*)(ws + WS_DTLR)};
    pg8::gemm_phase<pg8::EpiProj0, pg8::StaticOrder, true, true>(lds, g, S, E); })
  PH(3, ssd_prep_phase((const bf16_t*)(ws + WS_XBC), p.in[8], p.in[9], (bf16_t*)p.out, (const float*)(ws + WS_DTLR), p.in[10], p.in[11], (float*)((char*)p.out + DO_SDT), (float*)((char*)p.out + DO_SCS), (float*)(ws + WS_SDEC)))
  PH(4, { ssd_u_phase((const bf16_t*)p.out, (const float*)((char*)p.out + DO_SDT), (const float*)((char*)p.out + DO_SCS), (bf16_t*)(ws + WS_STATE), lds);
    { const int nbusy = (NCH * 4) % (int)gridDim.x, nfree = (int)gridDim.x - nbusy;
      const int vb_ = virt_block(); if (vb_ >= nbusy || nfree <= 0) { __syncthreads(); late_weights(p, lds, nfree > 0 ? vb_ - nbusy : vb_, nfree > 0 ? nfree : (int)gridDim.x); } } })
  PH(5, ssd_scan_phase((bf16_t*)(ws + WS_STATE), (const float*)(ws + WS_SDEC), wr))
  PH(6, { ssd_y_phase((const bf16_t*)p.out, (const float*)((char*)p.out + DO_SDT), (const float*)((char*)p.out + DO_SCS), (const bf16_t*)(ws + WS_STATE), p.in[12], (bf16_t*)(ws + WS_Y0), (float*)(ws + WS_SSQ), lds, wr);
    if (wr) gla_cs_phase((const float*)(ws + WS_DTLR), p.in[14], p.in[15], (h16_t*)ws, (h16_t*)p.out, (float*)(ws + WS_GDEC), lds, (unsigned*)(ws + WS_CTL) + CW_CSQ); })
  PH(8, gla_u_phase((const bf16_t*)(ws + WS_K0), (const bf16_t*)(ws + WS_V0), (const h16_t*)ws, (const h16_t*)p.out, (bf16_t*)(ws + WS_STATE), lds))
  PH(9, gla_scan_phase((bf16_t*)(ws + WS_STATE), (const float*)(ws + WS_GDEC), wr))
  PH(10, gla_o_phase((const bf16_t*)(ws + WS_Q0), (const bf16_t*)(ws + WS_K0), (const bf16_t*)(ws + WS_V0), (const h16_t*)ws, (const h16_t*)p.out, (const bf16_t*)(ws + WS_STATE), p.in[16], (bf16_t*)(ws + WS_Y0), lds, wr))
  PH(11, {
    pg8::Gemm g{(const bf16_t*)(ws + WS_Y0), (const bf16_t*)(ws + WS_W2T), ML, D, 2048}; pg8::StaticOrder S; S.init(ML, D, gridDim.x, (int)blockIdx.x);
    const float* SSQ = (const float*)(ws + WS_SSQ);
    LAS float* rs = (LAS float*)(lds + 131072);
    { pg8::Unit u0; if (S.next(0, u0) && threadIdx.x < 256) { const size_t row = (size_t)u0.pm * 256 + threadIdx.x;
        const float r0 = rsqrtf((SSQ[(row * 2 + 0) * 2] + SSQ[(row * 2 + 0) * 2 + 1]) * (1.f / 512.f) + EPS), r1 = rsqrtf((SSQ[(row * 2 + 1) * 2] + SSQ[(row * 2 + 1) * 2 + 1]) * (1.f / 512.f) + EPS);
        rs[threadIdx.x * 2] = r0 / r1; rs[threadIdx.x * 2 + 1] = r1; } }
    __syncthreads();
    float* SSQ1 = (float*)(ws + WS_SSQ1); bf16_t* H1 = (bf16_t*)(ws + WS_H1); const float* g1 = p.in[18]; const float* MOD1 = MOD + 3 * 3072;
    pg8::EpiResidH E{p.in[0], X1, MOD, g1, MOD1, H1, SSQ1};
    pg8::gemm_phase<pg8::EpiResidH, pg8::StaticOrder, true, true, true>(lds, g, S, E, rs);
    const float* ctx = p.in[2]; const float* gate = MOD + 2 * 3072 + 2048; const float* sc1c = MOD1 + 2 * 3072 + 1024;
    small_gemm_splitk((const bf16_t*)(ws + WS_Y0) + (size_t)ML * 2048, 2048, (const bf16_t*)(ws + WS_W2T), 2048, 2048, MC, D, lds, SSQ1 + ML, SSQ + (size_t)ML * 4,
               [=](int m, int n, float v, float vn) { const float x1 = ctx[(size_t)m * D + n] + gate[n] * v, x1n = ctx[(size_t)m * D + (n ^ 1)] + gate[n ^ 1] * vn;
                 if (!(n & 1)) *(unsigned*)(H1 + (size_t)(ML + m) * D + n) = pk2(x1 * g1[n] * (1.f + sc1c[n]), x1n * g1[n + 1] * (1.f + sc1c[n + 1])); return x1 * x1; }); })
  PH(13, {
    pg8::Gemm g{(const bf16_t*)(ws + WS_H1), (const bf16_t*)(ws + WS_W3T), ML, O_IN, D}; pg8::StaticOrder S; S.init(ML, O_IN, gridDim.x, (int)blockIdx.x);
    pg8::EpiProj1 E{(bf16_t*)(ws + WS_K1), (bf16_t*)(ws + WS_V1), (bf16_t*)(ws + WS_Q1), (bf16_t*)(ws + WS_G1), p.in[22], p.in[23], (const float*)(ws + WS_ROPE), (LAS float*)(lds + 131072), (const float*)(ws + WS_SSQ1), (const float*)(ws + WS_CB)};
    pg8::gemm_phase<pg8::EpiProj1, pg8::StaticOrder, true, true>(lds, g, S, E);
    bf16_t* K1 = (bf16_t*)(ws + WS_K1); bf16_t* V1 = (bf16_t*)(ws + WS_V1);
    small_gemm_splitk((const bf16_t*)(ws + WS_H1) + (size_t)ML * D, D, (const bf16_t*)(ws + WS_W3T), D, D, MC, 1024, lds, nullptr, nullptr,
               [=](int m, int n, float v, float vn) { if (n & 1) return 0.f; const float* CB = (const float*)(ws + WS_CB) + 2 * O_IN; const float rs1 = rsqrtf(((const float*)(ws + WS_SSQ1))[ML + m] * (1.f / 1024.f) + EPS);
                 const unsigned w = pk2(v * rs1 + CB[n], vn * rs1 + CB[n + 1]);
                 if (n < 512) *(unsigned*)(K1 + (size_t)(ML + m) * 512 + n) = w; else *(unsigned*)(V1 + (size_t)(ML + m) * 512 + (n - 512)) = w; return 0.f; }); })
  PH(15, attn_phase((bf16_t*)(ws + WS_Q1), (const bf16_t*)(ws + WS_K1), (const bf16_t*)(ws + WS_V1), (const bf16_t*)(ws + WS_G1), p.in[24], p.in[22], p.in[23], lds, wr))
  PH(16, {
    pg8::Gemm g{(const bf16_t*)(ws + WS_Q1), (const bf16_t*)(ws + WS_W4T), ML, D, 2048}; pg8::StaticOrder S; S.init(ML, D, gridDim.x, (int)blockIdx.x);
    pg8::EpiResid E{X1, p.out, MOD + 3 * 3072, wr};
    pg8::gemm_phase<pg8::EpiResid, pg8::StaticOrder, true, true>(lds, g, S, E); })
#undef PH
#undef IN
#undef SEAM
}
extern "C" void kernel_launch(void* const* d_in, const int* in_sizes, int n_in, void* d_out, int out_size, void* d_ws, size_t ws_size, hipStream_t stream) {
  static int grid_blocks = 0;
  if (!grid_blocks) {
    int dev = 0, cus = 0, per_cu = 0;
    hipGetDevice(&dev);
    hipDeviceGetAttribute(&cus, hipDeviceAttributeMultiprocessorCount, dev);
    hipFuncSetAttribute((const void*)mega, hipFuncAttributeMaxDynamicSharedMemorySize, LDS_BYTES);
    hipOccupancyMaxActiveBlocksPerMultiprocessor(&per_cu, (const void*)mega, NWAVES * 64, LDS_BYTES);
    if (per_cu < 1) { fprintf(stderr, "kernel_launch: occupancy query says %d blocks per CU\n", per_cu); per_cu = 1; }
    if (per_cu > 1) per_cu = 1;
    grid_blocks = cus * per_cu;
  }
  hipMemsetAsync((char*)d_ws + WS_CTL, 0, 256 * 1024, stream);
  Params base{};
  for (int i = 0; i < 26; ++i) base.in[i] = (const float*)d_in[i];
  base.out = (float*)d_out; base.ws = (unsigned char*)d_ws;
  auto launch = [&](int lo, int hi) {
    Params p = base; p.ph_lo = lo; p.ph_hi = hi; p.rep = (int)PROBE_MASK; void* args[] = {&p};
    hipError_t e = hipLaunchCooperativeKernel((const void*)mega, dim3(grid_blocks), dim3(NWAVES * 64), args, LDS_BYTES, stream);
    if (e != hipSuccess) fprintf(stderr, "cooperative launch failed: %s (grid %d)\n", hipGetErrorString(e), grid_blocks);
  };
  launch(0, 17);
}
```

```cpp
#include <hip/hip_runtime.h>
#include <hip/hip_cooperative_groups.h>
#include <stdint.h>
#include <math.h>
#include <cstdio>
namespace cg = cooperative_groups;
#ifndef PROBE_SKIP
#define PROBE_SKIP 0
#endif
#ifndef PROBE_MASK
#define PROBE_MASK 0u
#endif

typedef unsigned short bf16_t;
#define DEV __device__ __forceinline__

DEV float bf2f(bf16_t v) { return __uint_as_float(((unsigned)v) << 16); }
typedef float f32x2_t __attribute__((ext_vector_type(2))); typedef __bf16 bf16x2_t __attribute__((ext_vector_type(2)));
DEV unsigned pk2(float lo, float hi) { const f32x2_t v = {lo, hi}; const bf16x2_t b = __builtin_convertvector(v, bf16x2_t); return __builtin_bit_cast(unsigned, b); }
DEV bf16_t f2bf(float f) { return (bf16_t)(pk2(f, 0.f) & 0xffffu); }
DEV float fexp(float x) { return __builtin_amdgcn_exp2f(x * 1.4426950408889634f); }
DEV float siluf(float x) { return x / (1.f + fexp(-x)); }
DEV float silu_fast(float x) { return x * __builtin_amdgcn_rcpf(1.f + fexp(-x)); }
DEV float softplusf(float x) { return x > 20.f ? x : log1pf(fexp(x)); }
DEV float logsigmoidf(float x) { return fminf(x, 0.f) - log1pf(fexp(-fabsf(x))); }

constexpr int D = 1024, NB = 2, SEQ = 8192, CTXL = 256;
constexpr int ML = NB * SEQ;
constexpr int MC = NB * CTXL;
constexpr int MA = ML + MC;
constexpr int NCH = MA / 128;
constexpr int E_IN = 5696, O_IN = 5120, E_INP = 5888;
constexpr float EPS = 1e-6f;

constexpr size_t MiB = 1u << 20;
constexpr int CW_CSQ = 8192;
constexpr size_t WS_CTL = 0;
constexpr size_t WS_SSQ1 = 64 * 1024;
constexpr size_t WS_CB = 160 * 1024;
constexpr size_t WS_MOD = 1 * MiB;
constexpr size_t WS_ROPE = 1 * MiB + 128 * 1024;
constexpr size_t WS_SDEC = 1 * MiB + 256 * 1024;
constexpr size_t WS_GDEC = 1 * MiB + 384 * 1024;
constexpr size_t WS_W1T = 2 * MiB;
constexpr size_t WS_W2T = 14 * MiB;
constexpr size_t WS_W3T = 18 * MiB;
constexpr size_t WS_W4T = 28 * MiB;
constexpr size_t WS_Y0 = 32 * MiB;
constexpr size_t WS_Q0 = 98 * MiB;
constexpr size_t WS_K0 = WS_Q0 + 16 * MiB + 512 * 1024;
constexpr size_t WS_V0 = 131 * MiB;
constexpr size_t WS_DTLR = 164 * MiB;
constexpr size_t WS_XC1 = 168 * MiB + 512 * 1024;
constexpr size_t WS_XBC = 171 * MiB;
constexpr size_t WS_STATE = 171 * MiB;
constexpr size_t WS_TAIL = 237 * MiB;
constexpr size_t WS_H1 = 98 * MiB;
constexpr size_t WS_K1 = 131 * MiB;
constexpr size_t WS_V1 = 147 * MiB + 512 * 1024;
constexpr size_t WS_Q1 = 32 * MiB;
constexpr size_t WS_G1 = 171 * MiB;

DEV int row_vec(int row) { return row < ML ? (row / SEQ) : 2; }

namespace pg8 {
constexpr int O_IN_ = 5120;
#define PG8_LAS __attribute__((address_space(3)))
typedef unsigned short bf16_t;
typedef short bf16x8 __attribute__((ext_vector_type(8)));
typedef float f32x4 __attribute__((ext_vector_type(4)));
typedef unsigned u32x4 __attribute__((ext_vector_type(4)));
constexpr int BM = 256, BK = 64, HALF = 128, HTB = HALF * BK * 2  , STAGE_BYTES = 8 * HTB, NXCD = 8, WGM = 8;

__host__ __device__ __forceinline__ int lds_byte(int r, int c) { const int st = (r >> 4) * 2 + (c >> 5), rr = r & 15, cc = c & 31, ob = rr * 64 + cc * 2; return st * 1024 + (ob ^ (((ob >> 9) & 1) << 5)); }
__host__ __device__ __forceinline__ void stage_rc(int b, int& R, int& C) { const int st = b / 1024, sb = b % 1024, swz = sb ^ (((sb >> 9) & 1) << 5); R = (st >> 1) * 16 + swz / 64; C = (st & 1) * 32 + (swz % 64) / 2; }
__host__ __device__ __forceinline__ int perm32(int rho) { const int n = rho >> 4, i = rho & 15; return 8 * (i >> 2) + 4 * n + (i & 3); }

struct Unit { int pm, pn; };
struct Gemm { const bf16_t* A; const bf16_t* Bt; int M, N, K; };

struct StaticOrder {
    int nM, nN, nwg, G, c;
    __host__ __device__ __forceinline__ void init(int M, int N, int G_, int c_) { nM = M / BM; nN = N / BM; nwg = nM * nN; G = G_; c = c_; }
    __host__ __device__ __forceinline__ bool next(int i, Unit& u) const {
        const long L = (long)i * G + c; if (L >= nwg) return false;
        int wgid = (int)L; { const int q = nwg / NXCD, r = nwg % NXCD, xcd = wgid % NXCD, off = wgid / NXCD; wgid = (xcd < r ? xcd * (q + 1) : r * (q + 1) + (xcd - r) * q) + off; }
        const int nig = WGM * nN, gid = wgid / nig, fm = gid * WGM, gsz = (nM - fm) < WGM ? (nM - fm) : WGM;
        u.pm = fm + ((wgid % nig) % gsz); u.pn = (wgid % nig) / gsz; return true;
    }
    __device__ __forceinline__ void a_ready(const Unit&) const {}
    __device__ __forceinline__ void done(const Unit&) const {}
};
__device__ __forceinline__ unsigned cvt_pk_bf16(float lo, float hi) { unsigned r; asm volatile("v_cvt_pk_bf16_f32 %0, %1, %2" : "=v"(r) : "v"(lo), "v"(hi)); return r; }
__device__ __forceinline__ float silu_e(float x) { return x * __builtin_amdgcn_rcpf(1.f + fexp(-x)); }

__device__ __forceinline__ void store_unit_bf16(const f32x4 (&acc)[2][2][4][2], bf16_t* base, int ld, int colt, bool act, const Unit& u, int wr, int wc, int fr, int fq) {
    const int row0 = u.pm * BM + wr * 64 + fr; const int col0 = colt + wc * 32 + 8 * fq;
#pragma unroll
    for (int ai = 0; ai < 2; ++ai)
#pragma unroll
        for (int m = 0; m < 4; ++m) { bf16_t* rowp = base + (size_t)(row0 + ai * HALF + m * 16) * ld + col0;
#pragma unroll
            for (int bj = 0; bj < 2; ++bj) { f32x4 v0 = acc[ai][bj][m][0], v1 = acc[ai][bj][m][1];
                if (act) { v0 = (f32x4){silu_e(v0[0]), silu_e(v0[1]), silu_e(v0[2]), silu_e(v0[3])}; v1 = (f32x4){silu_e(v1[0]), silu_e(v1[1]), silu_e(v1[2]), silu_e(v1[3])}; }
                u32x4 w; w.x = cvt_pk_bf16(v0[0], v0[1]); w.y = cvt_pk_bf16(v0[2], v0[3]); w.z = cvt_pk_bf16(v1[0], v1[1]); w.w = cvt_pk_bf16(v1[2], v1[3]);
                *(u32x4*)(rowp + bj * HALF) = w; } }
}
struct EpiProj0 {
    static constexpr bool PERM = true, AFTER_DRAIN = false;
    bf16_t *Y0, *XBC, *Q0, *K0, *V0; float* DTLR;
    __device__ __forceinline__ void operator()(const f32x4 (&acc)[2][2][4][2], const Unit& u, int wr, int wc, int fr, int fq) const {
        const int pn = u.pn;
        if (pn == 22) {
            if (wc < 2) { const int row0 = u.pm * BM + wr * 64 + fr;
#pragma unroll
                for (int ai = 0; ai < 2; ++ai)
#pragma unroll
                    for (int m = 0; m < 4; ++m) { float* rp = DTLR + (size_t)(row0 + ai * HALF + m * 16) * 64 + wc * 32 + 8 * fq; *(f32x4*)rp = acc[ai][0][m][0]; *(f32x4*)(rp + 4) = acc[ai][0][m][1]; } }
            return;
        }
        bf16_t* base; int ld, colt; bool act = false;
        if (pn < 8) { base = Y0; ld = 2048; colt = pn * 256; act = true; }
        else if (pn < 14) { base = XBC; ld = 1536; colt = (pn - 8) * 256; }
        else if (pn < 16) { base = Q0; ld = 512; colt = (pn - 14) * 256; }
        else if (pn < 18) { base = K0; ld = 512; colt = (pn - 16) * 256; }
        else { base = V0; ld = 1024; colt = (pn - 18) * 256; }
        store_unit_bf16(acc, base, ld, colt, act, u, wr, wc, fr, fq);
    }
};
struct EpiProj1 {
    static constexpr bool PERM = true, AFTER_DRAIN = false;
    bf16_t *K1, *V1, *Q1, *G1; const float *qn, *kn, *rope; PG8_LAS float* part; const float *ssq1, *cb;
    __device__ __forceinline__ void operator()(const f32x4 (&acc_)[2][2][4][2], const Unit& u, int wr, int wc, int fr, int fq) const {
        const int pn = u.pn; bf16_t* base; int ld, colt; bool act = false;
        f32x4 acc[2][2][4][2];
        { const float* cbp = cb + ((u.pm * BM) / 8192) * O_IN_ + pn * BM + wc * 32 + 8 * fq; f32x4 cbv[2][2];
#pragma unroll
          for (int bj = 0; bj < 2; ++bj)
#pragma unroll
              for (int n = 0; n < 2; ++n) cbv[bj][n] = *(const f32x4*)(cbp + bj * HALF + 4 * n);
#pragma unroll
          for (int ai = 0; ai < 2; ++ai)
#pragma unroll
              for (int m = 0; m < 4; ++m) { const float rs_ = __builtin_amdgcn_rsqf(ssq1[u.pm * BM + ai * HALF + wr * 64 + m * 16 + fr] * (1.f / 1024.f) + 1e-6f);
#pragma unroll
                  for (int bj = 0; bj < 2; ++bj)
#pragma unroll
                      for (int n = 0; n < 2; ++n) acc[ai][bj][m][n] = acc_[ai][bj][m][n] * rs_ + cbv[bj][n]; } }
        if (pn < 2) { base = K1; ld = 512; colt = pn * 256; }
        else if (pn < 4) { base = V1; ld = 512; colt = (pn - 2) * 256; }
        else if (pn < 12) { base = Q1; ld = 2048; colt = (pn - 4) * 256; }
        else { base = G1; ld = 2048; colt = (pn - 12) * 256; act = true; }
        const bool isk = pn < 2, isq = pn >= 4 && pn < 12;
        if (!(isk || isq)) { store_unit_bf16(acc, base, ld, colt, act, u, wr, wc, fr, fq); return; }
#pragma unroll
        for (int ai = 0; ai < 2; ++ai)
#pragma unroll
            for (int m = 0; m < 4; ++m)
#pragma unroll
                for (int bj = 0; bj < 2; ++bj) { const f32x4 x0 = acc[ai][bj][m][0], x1 = acc[ai][bj][m][1];
                    float s = (x0[0] * x0[0] + x0[1] * x0[1]) + (x0[2] * x0[2] + x0[3] * x0[3]) + (x1[0] * x1[0] + x1[1] * x1[1]) + (x1[2] * x1[2] + x1[3] * x1[3]);
                    s += __shfl_xor(s, 16); s += __shfl_xor(s, 32);
                    if (fq == 0) part[(ai * HALF + wr * 64 + m * 16 + fr) * 8 + bj * 4 + wc] = s; }
        asm volatile("s_waitcnt lgkmcnt(0)" ::: "memory"); __builtin_amdgcn_s_barrier(); asm volatile("" ::: "memory");
        const int a = wc >> 1, f0 = 16 * (wc & 1) + 4 * fq;
        const float* gn = (isq ? qn : kn) + a * 64 + f0;
        const f32x4 g0 = *(const f32x4*)gn, g1 = *(const f32x4*)(gn + 32);
        const float osc = isq ? 0.08838834764831845f * 1.4426950408889634f : 1.f;
        const int col0 = colt + wc * 32 + 8 * fq;
        f32x4 w_[2][2][4][2];
#pragma unroll
        for (int ai = 0; ai < 2; ++ai)
#pragma unroll
            for (int bj = 0; bj < 2; ++bj)
#pragma unroll
                for (int m = 0; m < 4; ++m) { w_[ai][bj][m][0] = acc[ai][bj][m][0]; w_[ai][bj][m][1] = acc[ai][bj][m][1]; }
#pragma unroll 1
        for (int m = 0; m < 4; ++m) {
#pragma unroll
            for (int ai = 0; ai < 2; ++ai) { const int rowl = ai * HALF + wr * 64 + m * 16 + fr, row = u.pm * BM + rowl, t = row & 8191, pos = a ? (t & 63) : (t >> 6);
                const f32x4 cs = *(const f32x4*)(rope + pos * 32 + f0), sn = *(const f32x4*)(rope + 4096 + pos * 32 + f0);
                bf16_t* rowp = base + (size_t)row * ld + col0;
#pragma unroll
                for (int bj = 0; bj < 2; ++bj) { const f32x4 p4 = *(const PG8_LAS f32x4*)(part + rowl * 8 + bj * 4);
                    const float rstd = __builtin_amdgcn_rsqf(((p4[0] + p4[1]) + (p4[2] + p4[3])) * (1.f / 128.f) + 1e-6f) * osc;
                    const f32x4 t1 = w_[ai][bj][0][0] * g0 * rstd, t2 = w_[ai][bj][0][1] * g1 * rstd;
                    const f32x4 o1 = t1 * cs - t2 * sn, o2 = t2 * cs + t1 * sn;
                    u32x4 w; w.x = cvt_pk_bf16(o1[0], o1[1]); w.y = cvt_pk_bf16(o1[2], o1[3]); w.z = cvt_pk_bf16(o2[0], o2[1]); w.w = cvt_pk_bf16(o2[2], o2[3]);
                    *(u32x4*)(rowp + bj * HALF) = w; } }
#pragma unroll
            for (int ai = 0; ai < 2; ++ai)
#pragma unroll
                for (int bj = 0; bj < 2; ++bj)
#pragma unroll
                    for (int n = 0; n < 2; ++n) { w_[ai][bj][0][n] = w_[ai][bj][1][n]; w_[ai][bj][1][n] = w_[ai][bj][2][n]; w_[ai][bj][2][n] = w_[ai][bj][3][n]; }
        }
    }
};
struct EpiResid {
    static constexpr bool PERM = false, AFTER_DRAIN = false;
    const float* res; float* out; const float* mod; bool do_store;
    __device__ __forceinline__ void operator()(const f32x4 (&acc)[2][2][4][2], const Unit& u, int wr, int wc, int fr, int fq) const {
        const int b = (u.pm * BM) / 8192; const float* gate = mod + b * 3072 + 2048;
        const int col0 = u.pn * BM + wc * 32 + 4 * fq;
        f32x4 gv[2][2];
#pragma unroll
        for (int bj = 0; bj < 2; ++bj)
#pragma unroll
            for (int n = 0; n < 2; ++n) gv[bj][n] = *(const f32x4*)(gate + col0 + bj * HALF + n * 16);
#pragma unroll
        for (int ai = 0; ai < 2; ++ai)
#pragma unroll
            for (int m = 0; m < 4; ++m) { const size_t off = (size_t)(u.pm * BM + ai * HALF + wr * 64 + m * 16 + fr) * 1024 + col0;
#pragma unroll
                for (int bj = 0; bj < 2; ++bj)
#pragma unroll
                    for (int n = 0; n < 2; ++n) { const f32x4 r = *(const f32x4*)(res + off + bj * HALF + n * 16); const f32x4 ov_ = r + gv[bj][n] * acc[ai][bj][m][n]; if (do_store) *(f32x4*)(out + off + bj * HALF + n * 16) = ov_; } }
    }
};
struct EpiResidH {
    static constexpr bool PERM = true, AFTER_DRAIN = false;
    const float* res; float* out; const float* mod0; const float* g1; const float* mod1; bf16_t* H; float* ssq1;
    __device__ __forceinline__ void operator()(const f32x4 (&acc)[2][2][4][2], const Unit& u, int wr, int wc, int fr, int fq) const {
        const int b = (u.pm * BM) / 8192; const float* gate = mod0 + b * 3072 + 2048; const float* sc1 = mod1 + b * 3072 + 1024;
        const int col0 = u.pn * BM + wc * 32 + 8 * fq;
        f32x4 gv[2][2], gs[2][2];
#pragma unroll
        for (int bj = 0; bj < 2; ++bj)
#pragma unroll
            for (int n = 0; n < 2; ++n) { const int c = col0 + bj * HALF + 4 * n; gv[bj][n] = *(const f32x4*)(gate + c); gs[bj][n] = *(const f32x4*)(g1 + c) * (*(const f32x4*)(sc1 + c) + 1.f); }
#pragma unroll
        for (int ai = 0; ai < 2; ++ai)
#pragma unroll
            for (int m = 0; m < 4; ++m) { const int row = u.pm * BM + ai * HALF + wr * 64 + m * 16 + fr; const size_t off = (size_t)row * 1024 + col0; float ss = 0.f;
#pragma unroll
                for (int bj = 0; bj < 2; ++bj) { const f32x4 x0 = *(const f32x4*)(res + off + bj * HALF) + gv[bj][0] * acc[ai][bj][m][0], x1 = *(const f32x4*)(res + off + bj * HALF + 4) + gv[bj][1] * acc[ai][bj][m][1];
                    *(f32x4*)(out + off + bj * HALF) = x0; *(f32x4*)(out + off + bj * HALF + 4) = x1;
                    ss += (x0[0] * x0[0] + x0[1] * x0[1]) + (x0[2] * x0[2] + x0[3] * x0[3]) + (x1[0] * x1[0] + x1[1] * x1[1]) + (x1[2] * x1[2] + x1[3] * x1[3]);
                    const f32x4 h0 = x0 * gs[bj][0], h1 = x1 * gs[bj][1];
                    u32x4 w; w.x = cvt_pk_bf16(h0[0], h0[1]); w.y = cvt_pk_bf16(h0[2], h0[3]); w.z = cvt_pk_bf16(h1[0], h1[1]); w.w = cvt_pk_bf16(h1[2], h1[3]);
                    *(u32x4*)(H + off + bj * HALF) = w; }
                ss += __shfl_xor(ss, 16); ss += __shfl_xor(ss, 32);
                if (fq == 0) atomicAdd(ssq1 + row, ss); }
    }
};
template <class Epi, class Sched, bool ALIGN_EPI = false, bool SP2 = false, bool RS = false>
__device__ __forceinline__ void gemm_phase(PG8_LAS unsigned char* lds, const Gemm g, const Sched& S, const Epi& E, const PG8_LAS float* rs = nullptr) {
    const int tid = threadIdx.x, wid = __builtin_amdgcn_readfirstlane(tid >> 6), lane = tid & 63, wr = wid >> 2, wc = wid & 3, fr = lane & 15, fq = lane >> 4;
    const int K = g.K, nt = K / BK;
    unsigned voffA[2], voffB[2];
#pragma unroll
    for (int i = 0; i < 2; ++i) { int R, C; stage_rc(tid * 16 + i * 8192, R, C); const int Rb = Epi::PERM ? ((R & ~31) + perm32(R & 31)) : R;
        voffA[i] = (unsigned)(R * K + C) * 2u; voffB[i] = (unsigned)(Rb * K + C) * 2u; }
    const size_t kstep = (size_t)(BK * 2);
    const size_t hstep = (size_t)HALF * K * 2;
    const size_t tstep = 2 * hstep;
    const unsigned ldsw = (unsigned)wid * 1024u;
    const int aoff = lds_byte(wr * 64 + fr, fq * 8), boff = lds_byte(wc * 32 + fr, fq * 8);
#define PG8_SA(b, h) (((b) * 2 + (h)) * HTB)
#define PG8_SB(b, h) ((4 + (b) * 2 + (h)) * HTB)
#define PG8_STAGE(bufoff, gbase, voff) do { _Pragma("unroll") for (int _i = 0; _i < 2; ++_i) \
        __builtin_amdgcn_global_load_lds((const unsigned*)((const char*)(gbase) + (voff)[_i]), (PG8_LAS unsigned*)(lds + (bufoff) + ldsw + _i * 8192), 16, 0, 0); } while (0)
#define PG8_LDA(dst, b, h) do { _Pragma("unroll") for (int m = 0; m < 4; ++m) _Pragma("unroll") for (int k = 0; k < 2; ++k) dst[m][k] = *(const PG8_LAS bf16x8*)(lds + PG8_SA(b, h) + aoff + m * 2048 + k * 1024); } while (0)
#define PG8_LDB(dst, b, h) do { _Pragma("unroll") for (int n = 0; n < 2; ++n) _Pragma("unroll") for (int k = 0; k < 2; ++k) dst[n][k] = *(const PG8_LAS bf16x8*)(lds + PG8_SB(b, h) + boff + n * 2048 + k * 1024); } while (0)
#define PG8_MMA(ai, bj, At, Bt) do { __builtin_amdgcn_s_setprio(1); _Pragma("unroll") for (int m = 0; m < 4; ++m) _Pragma("unroll") for (int n = 0; n < 2; ++n) _Pragma("unroll") for (int k = 0; k < 2; ++k) \
        acc[ai][bj][m][n] = __builtin_amdgcn_mfma_f32_16x16x32_bf16(Bt[n][k], At[m][k], acc[ai][bj][m][n], 0, 0, 0); __builtin_amdgcn_s_setprio(0); } while (0)
#define PG8_WAIT_V(n) asm volatile("s_waitcnt vmcnt(" #n ")" ::: "memory")
#define PG8_WAIT_L(n) asm volatile("s_waitcnt lgkmcnt(" #n ")" ::: "memory")
#define PG8_BAR __builtin_amdgcn_s_barrier()
#define PG8_SCHED __builtin_amdgcn_sched_barrier(0)
    Unit cur, nxt; int ui = 0;
    if (!S.next(0, cur)) return;
    f32x4 acc[2][2][4][2];
#pragma unroll
    for (int a = 0; a < 2; ++a)
#pragma unroll
        for (int b = 0; b < 2; ++b)
#pragma unroll
            for (int m = 0; m < 4; ++m)
#pragma unroll
                for (int n = 0; n < 2; ++n) acc[a][b][m][n] = (f32x4){0.f, 0.f, 0.f, 0.f};
    bf16x8 At[4][2], B0[2][2], B1[2][2];
    const char* cA = (const char*)g.A + (size_t)cur.pm * tstep; const char* cB = (const char*)g.Bt + (size_t)cur.pn * tstep;
    S.a_ready(cur);
    if constexpr (SP2) {
        PG8_STAGE(PG8_SB(0, 0), cB, voffB); PG8_STAGE(PG8_SB(0, 1), cB + hstep, voffB); PG8_STAGE(PG8_SA(0, 0), cA, voffA); PG8_STAGE(PG8_SA(0, 1), cA + hstep, voffA);
        if (wr == 1) PG8_BAR;
        PG8_WAIT_V(2); PG8_BAR;
        PG8_STAGE(PG8_SB(1, 0), cB + kstep, voffB); PG8_STAGE(PG8_SA(1, 0), cA + kstep, voffA); PG8_STAGE(PG8_SB(1, 1), cB + hstep + kstep, voffB);
        PG8_WAIT_V(6); PG8_BAR;
    } else {
        PG8_STAGE(PG8_SB(0, 0), cB, voffB); PG8_STAGE(PG8_SA(0, 0), cA, voffA); PG8_STAGE(PG8_SB(0, 1), cB + hstep, voffB); PG8_STAGE(PG8_SA(0, 1), cA + hstep, voffA);
        if (wr == 1) PG8_BAR;
        PG8_WAIT_V(4); PG8_BAR;
        PG8_STAGE(PG8_SB(1, 0), cB + kstep, voffB); PG8_STAGE(PG8_SA(1, 0), cA + kstep, voffA); PG8_STAGE(PG8_SB(1, 1), cB + hstep + kstep, voffB);
        PG8_WAIT_V(6); PG8_BAR;
    }
    for (;;) {
        const bool has_next = S.next(ui + 1, nxt);
        const char* nA = has_next ? (const char*)g.A + (size_t)nxt.pm * tstep : cA; const char* nB = has_next ? (const char*)g.Bt + (size_t)nxt.pn * tstep : cB;
        for (int t = 0; t < nt; t += 2) {
            if constexpr (RS) { if (t == 8 || t == 16) { const int sel = (t == 16);
#pragma unroll
                for (int ai = 0; ai < 2; ++ai)
#pragma unroll
                    for (int m = 0; m < 4; ++m) { const float sc = rs[(ai * HALF + wr * 64 + m * 16 + fr) * 2 + sel];
#pragma unroll
                        for (int bj = 0; bj < 2; ++bj)
#pragma unroll
                            for (int n = 0; n < 2; ++n) acc[ai][bj][m][n] = acc[ai][bj][m][n] * sc; } } }
            const bool last = (t == nt - 2);
            const char* a1 = cA + (size_t)(t + 1) * kstep;
            const char* a2 = last ? nA : cA + (size_t)(t + 2) * kstep; const char* b2 = last ? nB : cB + (size_t)(t + 2) * kstep;
            const char* a3 = a2 + kstep; const char* b3 = b2 + kstep;
            if (last && has_next) S.a_ready(nxt);
            if constexpr (SP2) {
            PG8_LDB(B0, 0, 0); PG8_LDB(B1, 0, 1); PG8_SCHED; PG8_LDA(At, 0, 0); PG8_STAGE(PG8_SA(1, 1), a1 + hstep, voffA);
            PG8_WAIT_V(8); PG8_WAIT_L(0); PG8_BAR; PG8_MMA(0, 0, At, B0); PG8_MMA(0, 1, At, B1); PG8_BAR; PG8_SCHED;
            PG8_LDA(At, 0, 1); PG8_STAGE(PG8_SB(0, 0), b2, voffB); PG8_STAGE(PG8_SB(0, 1), b2 + hstep, voffB); PG8_STAGE(PG8_SA(0, 0), a2, voffA);
            PG8_WAIT_V(8); PG8_WAIT_L(0); PG8_BAR; PG8_MMA(1, 0, At, B0); PG8_MMA(1, 1, At, B1); PG8_BAR; PG8_SCHED;
            PG8_LDB(B0, 1, 0); PG8_LDB(B1, 1, 1); PG8_SCHED; PG8_LDA(At, 1, 0); PG8_STAGE(PG8_SA(0, 1), a2 + hstep, voffA);
            PG8_WAIT_V(8); PG8_WAIT_L(0); PG8_BAR; PG8_MMA(0, 0, At, B0); PG8_MMA(0, 1, At, B1); PG8_BAR; PG8_SCHED;
            PG8_LDA(At, 1, 1); PG8_STAGE(PG8_SB(1, 0), b3, voffB); PG8_STAGE(PG8_SB(1, 1), b3 + hstep, voffB); PG8_STAGE(PG8_SA(1, 0), a3, voffA);
            PG8_WAIT_V(8); PG8_WAIT_L(0); PG8_BAR; PG8_MMA(1, 0, At, B0); PG8_MMA(1, 1, At, B1); PG8_BAR; PG8_SCHED;
            } else {
            PG8_LDB(B0, 0, 0); PG8_SCHED; PG8_LDA(At, 0, 0); PG8_STAGE(PG8_SA(1, 1), a1 + hstep, voffA);
            PG8_WAIT_L(8); PG8_BAR; PG8_WAIT_L(0); PG8_MMA(0, 0, At, B0); PG8_BAR; PG8_SCHED;
            PG8_LDB(B1, 0, 1); PG8_STAGE(PG8_SB(0, 0), b2, voffB);
            PG8_BAR; PG8_WAIT_L(0); PG8_MMA(0, 1, At, B1); PG8_BAR;
            PG8_LDA(At, 0, 1); PG8_STAGE(PG8_SA(0, 0), a2, voffA);
            PG8_BAR; PG8_WAIT_L(0); PG8_MMA(1, 0, At, B0); PG8_BAR; PG8_SCHED;
            PG8_STAGE(PG8_SB(0, 1), b2 + hstep, voffB);
            PG8_WAIT_V(6); PG8_BAR; PG8_MMA(1, 1, At, B1); PG8_BAR;
            PG8_LDB(B0, 1, 0); PG8_SCHED; PG8_LDA(At, 1, 0); PG8_STAGE(PG8_SA(0, 1), a2 + hstep, voffA);
            PG8_WAIT_L(8); PG8_BAR; PG8_WAIT_L(0); PG8_MMA(0, 0, At, B0); PG8_BAR; PG8_SCHED;
            PG8_LDB(B1, 1, 1); PG8_STAGE(PG8_SB(1, 0), b3, voffB);
            PG8_BAR; PG8_WAIT_L(0); PG8_MMA(0, 1, At, B1); PG8_BAR;
            PG8_LDA(At, 1, 1); PG8_STAGE(PG8_SA(1, 0), a3, voffA);
            PG8_BAR; PG8_WAIT_L(0); PG8_MMA(1, 0, At, B0); PG8_BAR; PG8_SCHED;
            PG8_STAGE(PG8_SB(1, 1), b3 + hstep, voffB);
            PG8_WAIT_V(6); PG8_BAR; PG8_MMA(1, 1, At, B1); PG8_BAR;
            }
        }
        if constexpr (ALIGN_EPI) { if (wr == 0) PG8_BAR; }
        if constexpr (!Epi::AFTER_DRAIN) { E(acc, cur, wr, wc, fr, fq); S.done(cur); }
        if (!has_next) break;
#pragma unroll
        for (int a = 0; a < 2; ++a)
#pragma unroll
            for (int b = 0; b < 2; ++b)
#pragma unroll
                for (int m = 0; m < 4; ++m)
#pragma unroll
                    for (int n = 0; n < 2; ++n) acc[a][b][m][n] = (f32x4){0.f, 0.f, 0.f, 0.f};
        cur = nxt; cA = nA; cB = nB; ++ui;
        if constexpr (ALIGN_EPI) { if (wr == 1) PG8_BAR; }
    }
    PG8_WAIT_V(0);
    if constexpr (!ALIGN_EPI) { if (wr == 0) PG8_BAR; }
    PG8_BAR;
    if constexpr (Epi::AFTER_DRAIN) { E.fused(acc, cur, wr, wc, fr, fq, lds, wid, lane); S.done(cur); }
#undef PG8_SA
#undef PG8_SB
#undef PG8_STAGE
#undef PG8_LDA
#undef PG8_LDB
#undef PG8_MMA
#undef PG8_WAIT_V
#undef PG8_WAIT_L
#undef PG8_BAR
#undef PG8_SCHED
}
}
#define LAS __attribute__((address_space(3)))
typedef unsigned v4u __attribute__((ext_vector_type(4)));
typedef float f32x4 __attribute__((ext_vector_type(4)));
typedef short bf16x8 __attribute__((ext_vector_type(8)));
#define LDS_WAIT() asm volatile("s_waitcnt lgkmcnt(0)" ::: "memory")
constexpr int NWAVES = 8;
constexpr int LDS_BYTES = 147456;
constexpr int MISC_OFF = 147456 - 128;

struct Params { const float* in[26]; float* out; unsigned char* ws; int ph_lo, ph_hi, rep, pad; };

DEV int virt_block() { const int G = (int)gridDim.x, b = (int)blockIdx.x; return (G % 8 == 0) ? (b % 8) * (G / 8) + b / 8 : b; }
DEV float wave_sum(float v) {
#pragma unroll
  for (int o = 1; o < 64; o <<= 1) v += __shfl_xor(v, o);
  return v;
}

DEV int w1_dest_row(int n) {
  if (n < 1024) return n;
  if (n < 2560) return 2048 + (n - 1024);
  if (n < 2592) return 5632 + (n - 2560);
  if (n < 3104) return 3584 + (n - 2592);
  if (n < 3616) return 4096 + (n - 3104);
  if (n < 4640) return 4608 + (n - 3616);
  if (n < 5664) return 1024 + (n - 4640);
  return n;
}
DEV int qk_pos(int d) { const int a = d >> 6, s = (d >> 5) & 1, f = d & 31; return 32 * (2 * a + (f >> 4)) + 8 * ((f >> 2) & 3) + 4 * s + (f & 3); }
DEV void transpose_item(const float* W, int K, int N, int k0, int n0, bf16_t* WT, int drow0, LAS float* scr, int lane, int headbase = -1, const float* kscale = nullptr, const float* shv = nullptr, float* cb = nullptr) {
  { float wv_[32];
#pragma unroll
    for (int i = 0; i < 32; ++i) { const int kk = 2 * i + (lane >> 5); wv_[i] = W[(size_t)(k0 + kk) * N + n0 + (lane & 31)]; }
#pragma unroll
    for (int i = 0; i < 32; ++i) { const int kk = 2 * i + (lane >> 5); scr[kk * 33 + (lane & 31)] = wv_[i]; } }
  LDS_WAIT(); asm volatile("" ::: "memory");
  if (cb) {
    const int nn = lane & 31, hf = lane >> 5; float s0 = 0.f, s1 = 0.f, s2 = 0.f;
#pragma unroll 8
    for (int i = 0; i < 32; ++i) { const float w = scr[(hf * 32 + i) * 33 + nn]; const int k = k0 + hf * 32 + i; s0 += shv[k] * w; s1 += shv[3072 + k] * w; s2 += shv[6144 + k] * w; }
    s0 += __shfl_xor(s0, 32); s1 += __shfl_xor(s1, 32); s2 += __shfl_xor(s2, 32);
    if (hf == 0) { const int drow = headbase >= 0 ? headbase + qk_pos((n0 & 127) + nn) : drow0 + nn; atomicAdd(cb + drow, s0); atomicAdd(cb + N + drow, s1); atomicAdd(cb + 2 * N + drow, s2); } }
  const int c = lane & 7;
#pragma unroll
  for (int j = 0; j < 4; ++j) { const int n = (lane >> 3) + 8 * j; const LAS float* s = scr + (8 * c) * 33 + n;
    f32x4 k0s = {1.f, 1.f, 1.f, 1.f}, k1s = k0s; if (kscale) { k0s = *(const f32x4*)(kscale + k0 + 8 * c); k1s = *(const f32x4*)(kscale + k0 + 8 * c + 4); }
    v4u o; o.x = pk2(s[0 * 33] * k0s.x, s[1 * 33] * k0s.y); o.y = pk2(s[2 * 33] * k0s.z, s[3 * 33] * k0s.w); o.z = pk2(s[4 * 33] * k1s.x, s[5 * 33] * k1s.y); o.w = pk2(s[6 * 33] * k1s.z, s[7 * 33] * k1s.w);
    const int drow = headbase >= 0 ? headbase + qk_pos((n0 & 127) + n) : drow0 + n;
    *(v4u*)(WT + (size_t)drow * K + k0 + 8 * c) = o; }
  LDS_WAIT(); asm volatile("" ::: "memory");
}
DEV void prologue_phase(const Params& p, LAS unsigned char* lds) {
  const int tid = threadIdx.x, lane = tid & 63, wave = tid >> 6;
  unsigned char* ws = p.ws;
  float* MOD = (float*)(ws + WS_MOD);
  {
    LAS float* sc = (LAS float*)lds;
    LAS float* part = (LAS float*)(lds + 12288);
    for (int i = tid; i < 3072; i += 512) { const int v = i >> 10, k = i & 1023; const float cv = v < 2 ? p.in[1][v * 1024 + k] : p.in[3][k]; sc[i] = siluf(cv); }
    __syncthreads();
    for (int task = blockIdx.x; task < 192; task += gridDim.x) {
      const int l = task / 96, n0 = (task % 96) * 32; const float* w = l ? p.in[19] : p.in[5]; const float* bb = l ? p.in[20] : p.in[6];
      const int col = tid & 31, ks = tid >> 5;
      float a0 = 0.f, a1 = 0.f, a2 = 0.f;
#pragma unroll 64
      for (int k = ks * 64; k < ks * 64 + 64; ++k) { const float wv = w[(size_t)k * 3072 + n0 + col]; a0 += sc[k] * wv; a1 += sc[1024 + k] * wv; a2 += sc[2048 + k] * wv; }
      part[(ks * 3 + 0) * 32 + col] = a0; part[(ks * 3 + 1) * 32 + col] = a1; part[(ks * 3 + 2) * 32 + col] = a2;
      __syncthreads();
      if (tid < 96) { const int v = tid >> 5; float s = bb[n0 + col];
#pragma unroll
        for (int q = 0; q < 16; ++q) s += part[(q * 3 + v) * 32 + col];
        MOD[(l * 3 + v) * 3072 + n0 + col] = s; }
      __syncthreads();
    }
  }
  if (blockIdx.x == gridDim.x - 1) { float* rope = (float*)(ws + WS_ROPE);
    for (int idx = tid; idx < 4096; idx += 512) { const int pos = idx >> 5, f = idx & 31; const float inv = 1.0f / powf(10000.f, (float)f / 32.f); const float ang = (float)pos * inv; rope[idx] = cosf(ang); rope[4096 + idx] = sinf(ang); } }
  { v4u* z = (v4u*)(ws + WS_W1T + (size_t)E_IN * 1024 * 2); const v4u zero = {0u, 0u, 0u, 0u};
    for (int i = blockIdx.x * 512 + tid; i < (E_INP - E_IN) * 1024 * 2 / 16; i += gridDim.x * 512) z[i] = zero; }
  __syncthreads();
  {
    LAS float* scr = (LAS float*)(lds + wave * 16384);
    const int gw = blockIdx.x * NWAVES + wave, NGW = gridDim.x * NWAVES;
    constexpr int I1 = 16 * 178;
    const int nfree = (NGW > 192 * NWAVES) ? NGW - 192 * NWAVES : 0;
    for (int it = gw; it < I1; it = (it < NGW && nfree > 0 && gw >= 192 * NWAVES) ? NGW + (gw - 192 * NWAVES) : ((nfree > 0 && gw >= 192 * NWAVES) ? it + nfree : (nfree > 0 ? I1 : it + NGW))) {
      const int kb = it / 178, nb = it % 178; transpose_item(p.in[7], 1024, E_IN, 64 * kb, 32 * nb, (bf16_t*)(ws + WS_W1T), w1_dest_row(32 * nb), scr, lane); }
  }
}
DEV void late_weights(const Params& p, LAS unsigned char* lds, int vblock, int nvblocks) {
  const int lane = threadIdx.x & 63, wave = threadIdx.x >> 6; unsigned char* ws = p.ws;
  LAS float* scr = (LAS float*)(lds + wave * 16384);
  constexpr int I2 = 32 * 32, I3 = 16 * 160, I4 = 32 * 32;
  for (int it = vblock * NWAVES + wave; it < I2 + I3 + I4; it += nvblocks * NWAVES) {
    int r = it;
    if (r < I2) { const int kb = r / 32, nb = r % 32; transpose_item(p.in[17], 2048, 1024, 64 * kb, 32 * nb, (bf16_t*)(ws + WS_W2T), 32 * nb, scr, lane, -1, kb < 16 ? p.in[13] : nullptr); continue; }
    r -= I2;
    if (r < I3) { const int kb = r / 160, nb = r % 160, n0 = 32 * nb; const bool qk = n0 < 512 || (n0 >= 1024 && n0 < 3072);
      transpose_item(p.in[21], 1024, O_IN, 64 * kb, n0, (bf16_t*)(ws + WS_W3T), n0, scr, lane, qk ? (n0 & ~127) : -1, nullptr, (const float*)(ws + WS_MOD) + 3 * 3072, (float*)(ws + WS_CB)); continue; } r -= I3;
    { const int kb = r / 32, nb = r % 32; transpose_item(p.in[25], 2048, 1024, 64 * kb, 32 * nb, (bf16_t*)(ws + WS_W4T), 32 * nb, scr, lane); }
  }
}
DEV void prep_phase(const float* xlat, const float* xctx, const float* g, const float* mod, bf16_t* H) {
  const int lane = threadIdx.x & 63, wave = threadIdx.x >> 6, NW = gridDim.x * NWAVES;
  for (int row = blockIdx.x * NWAVES + wave; row < MA; row += 2 * NW) {
    const int row2 = row + NW; const bool has2 = row2 < MA;
    const float* s0 = row < ML ? xlat + (size_t)row * D : xctx + (size_t)(row - ML) * D;
    const float* s1 = has2 ? (row2 < ML ? xlat + (size_t)row2 * D : xctx + (size_t)(row2 - ML) * D) : s0;
    f32x4 v0[4], v1[4]; float ss0 = 0.f, ss1 = 0.f;
#pragma unroll
    for (int j = 0; j < 4; ++j) { v0[j] = *(const f32x4*)(s0 + 4 * lane + 256 * j); v1[j] = *(const f32x4*)(s1 + 4 * lane + 256 * j); }
#pragma unroll
    for (int j = 0; j < 4; ++j) { ss0 += (v0[j].x * v0[j].x + v0[j].y * v0[j].y) + (v0[j].z * v0[j].z + v0[j].w * v0[j].w); ss1 += (v1[j].x * v1[j].x + v1[j].y * v1[j].y) + (v1[j].z * v1[j].z + v1[j].w * v1[j].w); }
#pragma unroll
    for (int o = 1; o < 64; o <<= 1) { ss0 += __shfl_xor(ss0, o); ss1 += __shfl_xor(ss1, o); }
    const float r0 = rsqrtf(ss0 * (1.f / D) + EPS), r1 = rsqrtf(ss1 * (1.f / D) + EPS);
    const float* m0 = mod + row_vec(row) * 3072; const float* m1 = mod + row_vec(has2 ? row2 : row) * 3072;
#pragma unroll
    for (int j = 0; j < 4; ++j) { const int k = 4 * lane + 256 * j; const f32x4 gg = *(const f32x4*)(g + k);
      { const f32x4 sc = *(const f32x4*)(m0 + 1024 + k), sh = *(const f32x4*)(m0 + k); const f32x4 o = v0[j] * r0 * gg * (sc + 1.f) + sh;
        *(unsigned long long*)(H + (size_t)row * D + k) = (unsigned long long)pk2(o.x, o.y) | ((unsigned long long)pk2(o.z, o.w) << 32); }
      if (has2) { const f32x4 sc = *(const f32x4*)(m1 + 1024 + k), sh = *(const f32x4*)(m1 + k); const f32x4 o = v1[j] * r1 * gg * (sc + 1.f) + sh;
        *(unsigned long long*)(H + (size_t)row2 * D + k) = (unsigned long long)pk2(o.x, o.y) | ((unsigned long long)pk2(o.z, o.w) << 32); } }
  }
}
template <class F> DEV void small_gemm(const bf16_t* A, int lda, const bf16_t* Bt, int ldb, int K, int Mrows, int Ncols, F f) {
  const int lane = threadIdx.x & 63, wid = threadIdx.x >> 6, mt = wid >> 2, nt = wid & 3, r = lane & 15, q = lane >> 4;
  const int ntn = Ncols / 64, ntasks = (Mrows / 32) * ntn;
  for (int task = blockIdx.x; task < ntasks; task += gridDim.x) {
    const int row0 = (task / ntn) * 32 + mt * 16, col0 = (task % ntn) * 64 + nt * 16;
    const bf16_t* ap = A + (size_t)(row0 + r) * lda + 8 * q; const bf16_t* bp = Bt + (size_t)(col0 + r) * ldb + 8 * q;
    f32x4 acc = {0.f, 0.f, 0.f, 0.f};
#pragma unroll 8
    for (int k = 0; k < K; k += 32) { const bf16x8 a = *(const bf16x8*)(ap + k), b = *(const bf16x8*)(bp + k); acc = __builtin_amdgcn_mfma_f32_16x16x32_bf16(a, b, acc, 0, 0, 0); }
#pragma unroll
    for (int j = 0; j < 4; ++j) f(row0 + q * 4 + j, col0 + r, acc[j]);
  }
}

template <class F> DEV void small_gemm_splitk(const bf16_t* A, int lda, const bf16_t* Bt, int ldb, int K, int Mrows, int Ncols, LAS unsigned char* lds, float* rowsum  , const float* ssq  , F f) {
  const int tid = threadIdx.x, lane = tid & 63, wid = tid >> 6, r = lane & 15, q = lane >> 4;
  LAS float* red = (LAS float*)lds;
  const int ntn = Ncols / 64, ntasks = (Mrows / 32) * ntn, kw = K / 8;
  for (int task = virt_block(); task < ntasks; task += gridDim.x) {
    const int row0 = (task / ntn) * 32, col0 = (task % ntn) * 64;
    asm volatile("s_waitcnt vmcnt(0)" ::: "memory");
    const bf16_t* ap = A + (size_t)(row0 + r) * lda + wid * kw + 8 * q; const bf16_t* bp = Bt + (size_t)(col0 + r) * ldb + wid * kw + 8 * q;
    f32x4 acc[2][4];
#pragma unroll
    for (int mt = 0; mt < 2; ++mt)
#pragma unroll
      for (int nt = 0; nt < 4; ++nt) acc[mt][nt] = (f32x4){0.f, 0.f, 0.f, 0.f};
#pragma unroll 4
    for (int k = 0; k < kw; k += 32) {
      bf16x8 a[2], b[4];
#pragma unroll
      for (int mt = 0; mt < 2; ++mt) a[mt] = *(const bf16x8*)(ap + (size_t)(16 * mt) * lda + k);
#pragma unroll
      for (int nt = 0; nt < 4; ++nt) b[nt] = *(const bf16x8*)(bp + (size_t)(16 * nt) * ldb + k);
#pragma unroll
      for (int mt = 0; mt < 2; ++mt)
#pragma unroll
        for (int nt = 0; nt < 4; ++nt) acc[mt][nt] = __builtin_amdgcn_mfma_f32_16x16x32_bf16(a[mt], b[nt], acc[mt][nt], 0, 0, 0);
    }
    __syncthreads();
#pragma unroll
    for (int mt = 0; mt < 2; ++mt)
#pragma unroll
      for (int nt = 0; nt < 4; ++nt)
#pragma unroll
        for (int j = 0; j < 4; ++j) { const int rl = 16 * mt + 4 * q + j; float sc = 1.f;
          if (ssq && wid < 4) { const float* sp = ssq + ((size_t)(row0 + rl) * 2 + (wid >> 1)) * 2; sc = rsqrtf((sp[0] + sp[1]) * (1.f / 512.f) + EPS); }
          red[wid * 2048 + rl * 64 + 16 * nt + r] = acc[mt][nt][j] * sc; }
    __syncthreads();
#pragma unroll
    for (int o = 0; o < 4; ++o) { const int e = tid + 512 * o; float s = 0.f;
#pragma unroll
      for (int w = 0; w < 8; ++w) s += red[w * 2048 + e];
      float rv = f(row0 + (e >> 6), col0 + (e & 63), s, __shfl_xor(s, 1));
      if (rowsum) { rv = wave_sum(rv); if (lane == 0) atomicAdd(rowsum + row0 + (e >> 6), rv); } }
  }
}

DEV void qknorm_phase(bf16_t* Q1, bf16_t* K1, const float* qn, const float* kn, const float* rope, bool wr) {
  const int lane = threadIdx.x & 63, wave = threadIdx.x >> 6, hl = lane >> 4, d0 = (lane & 15) * 8;
  const float scale = 0.08838834764831845f * 1.4426950408889634f;
  float gq[8], gk[8];
#pragma unroll
  for (int e = 0; e < 8; ++e) { gq[e] = qn[d0 + e] * scale; gk[e] = kn[d0 + e]; }
  const int ax = d0 >> 6, sgn = (d0 >> 5) & 1, f0 = d0 & 31;
  for (int row = blockIdx.x * NWAVES + wave; row < MA; row += gridDim.x * NWAVES) {
    const bool lat = row < ML;
    v4u raw[5];
    raw[0] = *(const v4u*)(K1 + (size_t)row * 512 + hl * 128 + d0);
    if (lat) {
#pragma unroll
      for (int g = 0; g < 4; ++g) raw[1 + g] = *(const v4u*)(Q1 + (size_t)row * 2048 + (g * 4 + hl) * 128 + d0);
    }
    float cs[8], sn[8];
    if (lat) { const int t = row % SEQ, pos = ax ? (t & 63) : (t >> 6);
      const f32x4 c0 = *(const f32x4*)(rope + pos * 32 + f0), c1 = *(const f32x4*)(rope + pos * 32 + f0 + 4), s0 = *(const f32x4*)(rope + 4096 + pos * 32 + f0), s1 = *(const f32x4*)(rope + 4096 + pos * 32 + f0 + 4);
      cs[0] = c0.x; cs[1] = c0.y; cs[2] = c0.z; cs[3] = c0.w; cs[4] = c1.x; cs[5] = c1.y; cs[6] = c1.z; cs[7] = c1.w;
      sn[0] = s0.x; sn[1] = s0.y; sn[2] = s0.z; sn[3] = s0.w; sn[4] = s1.x; sn[5] = s1.y; sn[6] = s1.z; sn[7] = s1.w; }
    const int ng = lat ? 5 : 1;
#pragma unroll
    for (int g = 0; g < 5; ++g) {
      if (g < ng) {
        const v4u rv = raw[g];
        float v[8] = {__uint_as_float(rv.x << 16), __uint_as_float(rv.x & 0xffff0000u), __uint_as_float(rv.y << 16), __uint_as_float(rv.y & 0xffff0000u), __uint_as_float(rv.z << 16), __uint_as_float(rv.z & 0xffff0000u), __uint_as_float(rv.w << 16), __uint_as_float(rv.w & 0xffff0000u)};
        float ss = 0.f;
#pragma unroll
        for (int e = 0; e < 8; ++e) ss += v[e] * v[e];
        ss += __shfl_xor(ss, 1); ss += __shfl_xor(ss, 2); ss += __shfl_xor(ss, 4); ss += __shfl_xor(ss, 8);
        const float rstd = rsqrtf(ss * (1.f / 128.f) + EPS);
#pragma unroll
        for (int e = 0; e < 8; ++e) v[e] *= rstd * (g == 0 ? gk[e] : gq[e]);
        if (lat) {
#pragma unroll
          for (int e = 0; e < 8; ++e) { const float o = __shfl_xor(v[e], 4); v[e] = sgn ? (v[e] * cs[e] + o * sn[e]) : (v[e] * cs[e] - o * sn[e]); }
        }
        v4u ov; ov.x = pk2(v[0], v[1]); ov.y = pk2(v[2], v[3]); ov.z = pk2(v[4], v[5]); ov.w = pk2(v[6], v[7]);
        if (wr) { if (g == 0) *(v4u*)(K1 + (size_t)row * 512 + hl * 128 + d0) = ov; else *(v4u*)(Q1 + (size_t)row * 2048 + ((g - 1) * 4 + hl) * 128 + d0) = ov; }
      }
    }
  }
}
typedef short s16x4 __attribute__((ext_vector_type(4)));
DEV s16x4 tr_read(const LAS bf16_t* p) { return __builtin_bit_cast(s16x4, __builtin_amdgcn_ds_read_tr16_b64_v4i16((LAS s16x4*)p)); }
DEV void attn_phase(bf16_t* Q1, const bf16_t* K1, const bf16_t* V1, const bf16_t* G1, const float* sink, const float* qn, const float* kn, LAS unsigned char* lds, bool wr) {
  constexpr int KP = 136, VP = 144;
  LAS bf16_t* Ks = (LAS bf16_t*)lds;
  LAS bf16_t* Vs = (LAS bf16_t*)(lds + 2 * 64 * KP * 2);
  LAS float* dsc = (LAS float*)(lds + 2 * 64 * KP * 2 + 2 * 64 * VP * 2);
  const int tid = threadIdx.x, lane = tid & 63, wid = tid >> 6, r = lane & 15, Qd = lane >> 4;
  float mb;
  { float a = fmaxf(fabsf(qn[lane]), fabsf(qn[64 + lane])), b = fmaxf(fabsf(kn[lane]), fabsf(kn[64 + lane]));
#pragma unroll
    for (int o = 1; o < 64; o <<= 1) { a = fmaxf(a, __shfl_xor(a, o)); b = fmaxf(b, __shfl_xor(b, o)); }
    mb = a * b * 11.313708498984761f * 1.4426950408889634f; }
  const int skey = tid >> 4, sch = tid & 15;
  float gk[8];
  { const int dA = ((sch >> 2) >> 1) * 64 + 16 * ((sch >> 2) & 1) + 4 * (sch & 3); const f32x4 ga = *(const f32x4*)(kn + dA), gb_ = *(const f32x4*)(kn + dA + 32);
    gk[0] = ga.x; gk[1] = ga.y; gk[2] = ga.z; gk[3] = ga.w; gk[4] = gb_.x; gk[5] = gb_.y; gk[6] = gb_.z; gk[7] = gb_.w; }
  int task = virt_block(); if (task >= 1024) return;
  int b, kvh, qt, hq, qoff, tlo, nband, ntile; size_t qrow0;
  bf16x8 qf[2][4]; v4u kreg[2], vreg[2];
#define SET_TASK(tk) do { b = (tk) >> 9; kvh = ((tk) >> 7) & 3; qt = (tk) & 127; hq = kvh * 4 + (wid >> 1); qoff = (wid & 1) * 32; qrow0 = (size_t)b * SEQ + qt * 64 + qoff; \
    tlo = (2 - qt) > 0 ? (2 - qt) : 0; { const int thi_ = (129 - qt) < 4 ? (129 - qt) : 4; nband = thi_ - tlo + 1; } ntile = nband + 4; } while (0)
#define LOAD_Q() do { _Pragma("unroll") for (int m_ = 0; m_ < 2; ++m_) _Pragma("unroll") for (int ks_ = 0; ks_ < 4; ++ks_) qf[m_][ks_] = *(const bf16x8*)(Q1 + (qrow0 + 16 * m_ + r) * 2048 + hq * 128 + ks_ * 32 + 8 * Qd); } while (0)
#define TILE_ROW0(i) ((i) < nband ? (size_t)b * SEQ + (size_t)(qt - 2 + tlo + (i)) * 64 : (size_t)ML + b * CTXL + ((i) - nband) * 64)
#define LOAD_TILE(i) do { const size_t r0_ = TILE_ROW0(i); _Pragma("unroll") for (int h_ = 0; h_ < 2; ++h_) { const size_t go_ = (r0_ + skey + 32 * h_) * 512 + kvh * 128 + sch * 8; kreg[h_] = *(const v4u*)(K1 + go_); vreg[h_] = *(const v4u*)(V1 + go_); } } while (0)
#define STORE_TILE(buf, ti) do { const bool ctx_ = (ti) >= nband; _Pragma("unroll") for (int h_ = 0; h_ < 2; ++h_) { v4u kw_ = kreg[h_]; \
      if (ctx_) { float v_[8] = {__uint_as_float(kw_.x << 16), __uint_as_float(kw_.x & 0xffff0000u), __uint_as_float(kw_.y << 16), __uint_as_float(kw_.y & 0xffff0000u), __uint_as_float(kw_.z << 16), __uint_as_float(kw_.z & 0xffff0000u), __uint_as_float(kw_.w << 16), __uint_as_float(kw_.w & 0xffff0000u)}; \
        float ss_ = 0.f; _Pragma("unroll") for (int e_ = 0; e_ < 8; ++e_) ss_ += v_[e_] * v_[e_]; \
        ss_ += __shfl_xor(ss_, 1); ss_ += __shfl_xor(ss_, 2); ss_ += __shfl_xor(ss_, 4); ss_ += __shfl_xor(ss_, 8); \
        const float rs_ = rsqrtf(ss_ * (1.f / 128.f) + EPS); _Pragma("unroll") for (int e_ = 0; e_ < 8; ++e_) v_[e_] *= rs_ * gk[e_]; \
        kw_.x = pk2(v_[0], v_[1]); kw_.y = pk2(v_[2], v_[3]); kw_.z = pk2(v_[4], v_[5]); kw_.w = pk2(v_[6], v_[7]); } \
      *(LAS v4u*)(Ks + (buf) * 64 * KP + (skey + 32 * h_) * KP + sch * 8) = kw_; *(LAS v4u*)(Vs + (buf) * 64 * VP + (skey + 32 * h_) * VP + sch * 8) = vreg[h_]; } } while (0)
  SET_TASK(task); LOAD_Q(); LOAD_TILE(0);
  for (;;) {
    __syncthreads();
    STORE_TILE(0, 0);
    __syncthreads();
    f32x4 o[2][8];
#pragma unroll
    for (int m = 0; m < 2; ++m)
#pragma unroll
      for (int n = 0; n < 8; ++n) o[m][n] = (f32x4){0.f, 0.f, 0.f, 0.f};
    f32x4 osum[2] = {{0.f, 0.f, 0.f, 0.f}, {0.f, 0.f, 0.f, 0.f}};
    const bf16x8 ones8 = {(short)0x3f80, (short)0x3f80, (short)0x3f80, (short)0x3f80, (short)0x3f80, (short)0x3f80, (short)0x3f80, (short)0x3f80};
    for (int i = 0; i < ntile; ++i) {
      const int buf = i & 1;
      if (i + 1 < ntile) LOAD_TILE(i + 1);
      const int mtype = (i < nband) ? ((tlo + i) == 0 ? 1 : ((tlo + i) == 4 ? 2 : 0)) : 0;
      const LAS bf16_t* Kb = Ks + buf * 64 * KP; const LAS bf16_t* Vb = Vs + buf * 64 * VP;
      f32x4 s[4][2];
#pragma unroll
      for (int t = 0; t < 4; ++t) { s[t][0] = (f32x4){-mb, -mb, -mb, -mb}; s[t][1] = (f32x4){-mb, -mb, -mb, -mb}; }
      {
        bf16x8 kA[2], kB[2];
#define LDK(dst, g_) do { _Pragma("unroll") for (int q_ = 0; q_ < 2; ++q_) dst[q_] = *(const LAS bf16x8*)(Kb + (16 * (((g_) & 1) * 2 + q_) + r) * KP + ((g_) >> 1) * 32 + 8 * Qd); } while (0)
#define MMK(src_, g_) do { _Pragma("unroll") for (int q_ = 0; q_ < 2; ++q_) { const int t_ = ((g_) & 1) * 2 + q_, ks_ = (g_) >> 1; s[t_][0] = __builtin_amdgcn_mfma_f32_16x16x32_bf16(src_[q_], qf[0][ks_], s[t_][0], 0, 0, 0); s[t_][1] = __builtin_amdgcn_mfma_f32_16x16x32_bf16(src_[q_], qf[1][ks_], s[t_][1], 0, 0, 0); } } while (0)
        LDK(kA, 0); LDK(kB, 1); __builtin_amdgcn_sched_barrier(0);
        __builtin_amdgcn_s_setprio(1);
        MMK(kA, 0); __builtin_amdgcn_sched_barrier(0); LDK(kA, 2); __builtin_amdgcn_sched_barrier(0);
        MMK(kB, 1); __builtin_amdgcn_sched_barrier(0); LDK(kB, 3); __builtin_amdgcn_sched_barrier(0);
        MMK(kA, 2); __builtin_amdgcn_sched_barrier(0); LDK(kA, 4); __builtin_amdgcn_sched_barrier(0);
        MMK(kB, 3); __builtin_amdgcn_sched_barrier(0); LDK(kB, 5); __builtin_amdgcn_sched_barrier(0);
        MMK(kA, 4); __builtin_amdgcn_sched_barrier(0); LDK(kA, 6); __builtin_amdgcn_sched_barrier(0);
        MMK(kB, 5); __builtin_amdgcn_sched_barrier(0); LDK(kB, 7); __builtin_amdgcn_sched_barrier(0);
        MMK(kA, 6); __builtin_amdgcn_sched_barrier(0);
        MMK(kB, 7); __builtin_amdgcn_sched_barrier(0);
        __builtin_amdgcn_s_setprio(0);
#undef LDK
#undef MMK
      }
      bf16x8 pa[2][2];
#define EXP_BLOCK(MT) do { _Pragma("unroll") for (int m = 0; m < 2; ++m) { const int qi = qoff + 16 * m + r; \
        _Pragma("unroll") for (int t = 0; t < 4; ++t) { float pv[4]; \
          _Pragma("unroll") for (int j = 0; j < 4; ++j) { const int kj = 16 * t + 4 * Qd + j; float pj = __builtin_amdgcn_exp2f(s[t][m][j]); \
            if (MT == 1) pj = (kj >= qi) ? pj : 0.f; else if (MT == 2) pj = (kj <= qi) ? pj : 0.f; \
            pv[j] = pj; } \
          const unsigned w0 = pk2(pv[0], pv[1]), w1 = pk2(pv[2], pv[3]); \
          pa[m][t >> 1][(t & 1) * 4 + 0] = (short)(w0 & 0xffff); pa[m][t >> 1][(t & 1) * 4 + 1] = (short)(w0 >> 16); \
          pa[m][t >> 1][(t & 1) * 4 + 2] = (short)(w1 & 0xffff); pa[m][t >> 1][(t & 1) * 4 + 3] = (short)(w1 >> 16); } } } while (0)
      if (mtype == 0) EXP_BLOCK(0); else if (mtype == 1) EXP_BLOCK(1); else EXP_BLOCK(2);
#undef EXP_BLOCK
      {
        bf16x8 vA[4], vB[4];
#define LDV(dst, g_) do { _Pragma("unroll") for (int q_ = 0; q_ < 4; ++q_) { const int k2_ = (g_) >> 1, n_ = ((g_) & 1) * 4 + q_; \
          const s16x4 lo = tr_read(Vb + (32 * k2_ + 4 * Qd + (r >> 2)) * VP + 16 * n_ + 4 * (r & 3)); const s16x4 hi = tr_read(Vb + (32 * k2_ + 16 + 4 * Qd + (r >> 2)) * VP + 16 * n_ + 4 * (r & 3)); \
          dst[q_] = (bf16x8){lo[0], lo[1], lo[2], lo[3], hi[0], hi[1], hi[2], hi[3]}; } } while (0)
#define MMV(src_, g_) do { _Pragma("unroll") for (int q_ = 0; q_ < 4; ++q_) { const int k2_ = (g_) >> 1, n_ = ((g_) & 1) * 4 + q_; \
          o[0][n_] = __builtin_amdgcn_mfma_f32_16x16x32_bf16(pa[0][k2_], src_[q_], o[0][n_], 0, 0, 0); o[1][n_] = __builtin_amdgcn_mfma_f32_16x16x32_bf16(pa[1][k2_], src_[q_], o[1][n_], 0, 0, 0); } } while (0)
        LDV(vA, 0); LDV(vB, 1); __builtin_amdgcn_sched_barrier(0);
        __builtin_amdgcn_s_setprio(1);
        MMV(vA, 0); __builtin_amdgcn_sched_barrier(0); LDV(vA, 2); __builtin_amdgcn_sched_barrier(0);
        MMV(vB, 1); __builtin_amdgcn_sched_barrier(0); LDV(vB, 3); __builtin_amdgcn_sched_barrier(0);
        MMV(vA, 2); __builtin_amdgcn_sched_barrier(0);
        MMV(vB, 3); __builtin_amdgcn_sched_barrier(0);
#undef LDV
#undef MMV
        _Pragma("unroll") for (int m = 0; m < 2; ++m) _Pragma("unroll") for (int k2 = 0; k2 < 2; ++k2) osum[m] = __builtin_amdgcn_mfma_f32_16x16x32_bf16(pa[m][k2], ones8, osum[m], 0, 0, 0);
        __builtin_amdgcn_s_setprio(0);
      }
      if (i + 1 < ntile) STORE_TILE(buf ^ 1, i + 1);
      __syncthreads();
    }
    const int hq_c = hq; const size_t qrow0_c = qrow0;
    const int ntask = task + (int)gridDim.x; const bool more = ntask < 1024;
    if (more) { SET_TASK(ntask); LOAD_Q(); LOAD_TILE(0); }
    const float sk = __builtin_amdgcn_exp2f(sink[hq_c] * 1.4426950408889634f - mb);
    { LAS bf16_t* stg = (LAS bf16_t*)lds + wid * 32 * 136;
#pragma unroll
      for (int m = 0; m < 2; ++m)
#pragma unroll
        for (int j = 0; j < 4; ++j) { const float inv = __builtin_amdgcn_rcpf(osum[m][j] + sk);
#pragma unroll
          for (int n = 0; n < 8; ++n) stg[(16 * m + 4 * Qd + j) * 136 + 16 * n + r] = f2bf(o[m][n][j] * inv); }
      LDS_WAIT(); asm volatile("" ::: "memory");
#pragma unroll
      for (int q = 0; q < 8; ++q) { const int c = lane + 64 * q, rowl = c >> 4, ch = c & 15; const size_t go = (qrow0_c + rowl) * 2048 + hq_c * 128 + ch * 8;
        const v4u ov = *(const LAS v4u*)(stg + rowl * 136 + ch * 8), gv = *(const v4u*)(G1 + go);
        v4u w; w.x = pk2(__uint_as_float(ov.x << 16) * __uint_as_float(gv.x << 16), __uint_as_float(ov.x & 0xffff0000u) * __uint_as_float(gv.x & 0xffff0000u));
        w.y = pk2(__uint_as_float(ov.y << 16) * __uint_as_float(gv.y << 16), __uint_as_float(ov.y & 0xffff0000u) * __uint_as_float(gv.y & 0xffff0000u));
        w.z = pk2(__uint_as_float(ov.z << 16) * __uint_as_float(gv.z << 16), __uint_as_float(ov.z & 0xffff0000u) * __uint_as_float(gv.z & 0xffff0000u));
        w.w = pk2(__uint_as_float(ov.w << 16) * __uint_as_float(gv.w << 16), __uint_as_float(ov.w & 0xffff0000u) * __uint_as_float(gv.w & 0xffff0000u));
        if (wr) *(v4u*)(Q1 + go) = w; }
      LDS_WAIT(); asm volatile("" ::: "memory"); }
    if (!more) break;
    task = ntask;
  }
#undef TILE_ROW0
#undef LOAD_TILE
#undef STORE_TILE
#undef SET_TASK
#undef LOAD_Q
}

constexpr size_t DO_SDT = 50 * MiB, DO_SCS = 53 * MiB;
constexpr size_t WS_SSQ = 237 * MiB;
DEV unsigned short bfbits(float f) { return f2bf(f); }
DEV void ssd_prep_phase(const bf16_t* XBC, const float* cw, const float* cb, bf16_t* XC, const float* DTLR, const float* dt_bias, const float* a_log, float* SDT, float* SCS, float* SDEC) {
  const int gtid = blockIdx.x * 512 + threadIdx.x, gth = gridDim.x * 512;
  for (int it = gtid; it < (MA / 32) * 192; it += gth) {
    const int rg = it / 192, c8 = (it % 192) * 8, row0 = rg * 32;
    int t0, len;
    if (row0 < ML) { t0 = row0 % SEQ; len = SEQ; } else { t0 = (row0 - ML) % CTXL; len = CTXL; }
    float w[5][8], bias[8];
#pragma unroll
    for (int k = 0; k < 5; ++k) { const f32x4 w0 = *(const f32x4*)(cw + k * 1536 + c8), w1 = *(const f32x4*)(cw + k * 1536 + c8 + 4);
      w[k][0] = w0.x; w[k][1] = w0.y; w[k][2] = w0.z; w[k][3] = w0.w; w[k][4] = w1.x; w[k][5] = w1.y; w[k][6] = w1.z; w[k][7] = w1.w; }
    { const f32x4 b0 = *(const f32x4*)(cb + c8), b1 = *(const f32x4*)(cb + c8 + 4); bias[0] = b0.x; bias[1] = b0.y; bias[2] = b0.z; bias[3] = b0.w; bias[4] = b1.x; bias[5] = b1.y; bias[6] = b1.z; bias[7] = b1.w; }
    const v4u zero4 = {0u, 0u, 0u, 0u};
#pragma unroll 1
    for (int hf = 0; hf < 2; ++hf) {
    v4u xr[20];
#pragma unroll
    for (int q = 0; q < 20; ++q) { const int tt = t0 + 16 * hf - 2 + q; xr[q] = (tt >= 0 && tt < len) ? *(const v4u*)(XBC + (size_t)(row0 + 16 * hf - 2 + q) * 1536 + c8) : zero4; }
    v4u win[4] = {xr[0], xr[1], xr[2], xr[3]};
#pragma unroll
    for (int i0 = 0; i0 < 16; ++i0) { const int i = 16 * hf + i0;
      const v4u nx = xr[i0 + 4];
      float acc[8];
#pragma unroll
      for (int e = 0; e < 8; ++e) acc[e] = bias[e];
#define CONV_TAP(k, xv) do { acc[0] += w[k][0] * __uint_as_float((xv).x << 16); acc[1] += w[k][1] * __uint_as_float((xv).x & 0xffff0000u); acc[2] += w[k][2] * __uint_as_float((xv).y << 16); acc[3] += w[k][3] * __uint_as_float((xv).y & 0xffff0000u); \
        acc[4] += w[k][4] * __uint_as_float((xv).z << 16); acc[5] += w[k][5] * __uint_as_float((xv).z & 0xffff0000u); acc[6] += w[k][6] * __uint_as_float((xv).w << 16); acc[7] += w[k][7] * __uint_as_float((xv).w & 0xffff0000u); } while (0)
      CONV_TAP(0, win[0]); CONV_TAP(1, win[1]); CONV_TAP(2, win[2]); CONV_TAP(3, win[3]); CONV_TAP(4, nx);
#undef CONV_TAP
      v4u o; o.x = pk2(silu_fast(acc[0]), silu_fast(acc[1])); o.y = pk2(silu_fast(acc[2]), silu_fast(acc[3])); o.z = pk2(silu_fast(acc[4]), silu_fast(acc[5])); o.w = pk2(silu_fast(acc[6]), silu_fast(acc[7]));
      *(v4u*)(XC + (size_t)(row0 + i) * 1536 + c8) = o;
      win[0] = win[1]; win[1] = win[2]; win[2] = win[3]; win[3] = nx;
    } }
  }
  {
    const int lane = threadIdx.x & 63, wave = threadIdx.x >> 6, cl = lane & 7, seg = lane >> 3;
    for (int wt = blockIdx.x * NWAVES + wave; wt < NCH * 4; wt += gridDim.x * NWAVES) {
      const int gc = wt >> 2, col = (wt & 3) * 8 + cl, dir = col >> 4, h = col & 15;
      const float a = -fexp(a_log[col]), bias = dt_bias[col];
      float dtv[16], v[16]; float run = 0.f;
#pragma unroll
      for (int u = 0; u < 16; ++u) { const int s = seg * 16 + u, t = dir ? 127 - s : s; dtv[u] = softplusf(DTLR[((size_t)gc * 128 + t) * 64 + col] + bias); }
#pragma unroll
      for (int u = 0; u < 16; ++u) { run += dtv[u] * a; v[u] = run; }
      float off = 0.f;
#pragma unroll
      for (int sgi = 0; sgi < 7; ++sgi) { const float tot = __shfl(run, cl + 8 * sgi); off += (sgi < seg) ? tot : 0.f; }
#pragma unroll
      for (int u = 0; u < 16; ++u) { const int s = seg * 16 + u, t = dir ? 127 - s : s; const size_t row = (size_t)gc * 128 + t; SDT[row * 32 + col] = dtv[u]; SCS[row * 32 + col] = v[u] + off; }
      if (seg == 7) SDEC[(gc * 16 + h) * 2 + dir] = fexp(run + off);
    }
  }
}
DEV void ssd_u_phase(const bf16_t* XC, const float* SDT, const float* SCS, bf16_t* ST, LAS unsigned char* lds) {
  constexpr int XP = 272, BP = 144;
  LAS bf16_t* Xs = (LAS bf16_t*)lds; LAS bf16_t* Bs = (LAS bf16_t*)(lds + 128 * XP * 2); LAS float* wtab = (LAS float*)(lds + 128 * XP * 2 + 128 * BP * 2);
  const int tid = threadIdx.x, lane = tid & 63, wid = tid >> 6, r = lane & 15, Qd = lane >> 4, hl = wid >> 1, dir = wid & 1;
  for (int task = virt_block(); task < NCH * 4; task += gridDim.x) {
    const int gc = task >> 2, g = (task >> 1) & 1, hh = task & 1; const size_t r0 = (size_t)gc * 128; const int h0 = g * 8 + hh * 4;
    __syncthreads();
#pragma unroll
    for (int i = 0; i < 8; ++i) { const int cid = tid + 512 * i, row = cid >> 5, ch = cid & 31; *(LAS v4u*)(Xs + row * XP + ch * 8) = *(const v4u*)(XC + (r0 + row) * 1536 + h0 * 64 + ch * 8); }
#pragma unroll
    for (int i = 0; i < 4; ++i) { const int cid = tid + 512 * i, row = cid >> 4, ch = cid & 15; *(LAS v4u*)(Bs + row * BP + ch * 8) = *(const v4u*)(XC + (r0 + row) * 1536 + 1024 + g * 128 + ch * 8); }
    if (tid < 256) { const int d_ = tid >> 7, t = tid & 127;
      const f32x4 ce = *(const f32x4*)(SCS + (r0 + (d_ ? 0 : 127)) * 32 + d_ * 16 + h0), ct = *(const f32x4*)(SCS + (r0 + t) * 32 + d_ * 16 + h0), dt = *(const f32x4*)(SDT + (r0 + t) * 32 + d_ * 16 + h0);
      wtab[(0 * 2 + d_) * 128 + t] = fexp(ce.x - ct.x) * dt.x; wtab[(1 * 2 + d_) * 128 + t] = fexp(ce.y - ct.y) * dt.y; wtab[(2 * 2 + d_) * 128 + t] = fexp(ce.z - ct.z) * dt.z; wtab[(3 * 2 + d_) * 128 + t] = fexp(ce.w - ct.w) * dt.w; }
    __syncthreads();
    const LAS float* wt = wtab + wid * 128;
    bf16_t* Sp = ST + ((((size_t)gc * 16 + h0 + hl) * 2 + dir) * 64) * 128;
#pragma unroll 1
    for (int pp = 0; pp < 2; ++pp) {
      f32x4 acc[8][2];
#pragma unroll
      for (int nt = 0; nt < 8; ++nt) { acc[nt][0] = (f32x4){0.f, 0.f, 0.f, 0.f}; acc[nt][1] = (f32x4){0.f, 0.f, 0.f, 0.f}; }
#pragma unroll
      for (int k = 0; k < 4; ++k) {
        const f32x4 wlo = *(const LAS f32x4*)(wt + 32 * k + 4 * Qd), whi = *(const LAS f32x4*)(wt + 32 * k + 16 + 4 * Qd);
        bf16x8 xf[2];
#pragma unroll
        for (int pt = 0; pt < 2; ++pt) {
          const s16x4 lo = tr_read(Xs + (32 * k + 4 * Qd + (r >> 2)) * XP + hl * 64 + 32 * pp + 16 * pt + 4 * (r & 3));
          const s16x4 hi = tr_read(Xs + (32 * k + 16 + 4 * Qd + (r >> 2)) * XP + hl * 64 + 32 * pp + 16 * pt + 4 * (r & 3));
          const unsigned w0 = pk2(bf2f((bf16_t)lo[0]) * wlo[0], bf2f((bf16_t)lo[1]) * wlo[1]), w1 = pk2(bf2f((bf16_t)lo[2]) * wlo[2], bf2f((bf16_t)lo[3]) * wlo[3]);
          const unsigned w2 = pk2(bf2f((bf16_t)hi[0]) * whi[0], bf2f((bf16_t)hi[1]) * whi[1]), w3 = pk2(bf2f((bf16_t)hi[2]) * whi[2], bf2f((bf16_t)hi[3]) * whi[3]);
          xf[pt] = (bf16x8){(short)(w0 & 0xffff), (short)(w0 >> 16), (short)(w1 & 0xffff), (short)(w1 >> 16), (short)(w2 & 0xffff), (short)(w2 >> 16), (short)(w3 & 0xffff), (short)(w3 >> 16)};
        }
        __builtin_amdgcn_s_setprio(1);
#pragma unroll
        for (int nt = 0; nt < 8; ++nt) {
          const s16x4 lo = tr_read(Bs + (32 * k + 4 * Qd + (r >> 2)) * BP + 16 * nt + 4 * (r & 3));
          const s16x4 hi = tr_read(Bs + (32 * k + 16 + 4 * Qd + (r >> 2)) * BP + 16 * nt + 4 * (r & 3));
          const bf16x8 bfr = (bf16x8){lo[0], lo[1], lo[2], lo[3], hi[0], hi[1], hi[2], hi[3]};
          acc[nt][0] = __builtin_amdgcn_mfma_f32_16x16x32_bf16(bfr, xf[0], acc[nt][0], 0, 0, 0);
          acc[nt][1] = __builtin_amdgcn_mfma_f32_16x16x32_bf16(bfr, xf[1], acc[nt][1], 0, 0, 0);
        }
        __builtin_amdgcn_s_setprio(0);
      }
#pragma unroll
      for (int nt = 0; nt < 8; ++nt)
#pragma unroll
        for (int pt = 0; pt < 2; ++pt) { const f32x4 v = acc[nt][pt];
          *(unsigned long long*)(Sp + ((((2 * pp + pt) * 4 + (nt >> 1)) * 64 + ((nt & 1) * 2 + (Qd >> 1)) * 16 + r) * 8 + 4 * (Qd & 1))) = (unsigned long long)pk2(v[0], v[1]) | ((unsigned long long)pk2(v[2], v[3]) << 32); }
    }
  }
}
DEV void ssd_scan_phase(bf16_t* ST, const float* SDEC, bool wr) {
  for (int item = blockIdx.x * 512 + threadIdx.x; item < 2 * 16 * 2 * 2048; item += gridDim.x * 512) {
    const int e4 = item & 2047, dir = (item >> 11) & 1, h = (item >> 12) & 15, b = item >> 16;
    float S0 = 0.f, S1 = 0.f, S2 = 0.f, S3 = 0.f;
#define SCAN_GC(s) (!dir ? ((s) < 2 ? 128 + 2 * b + (s) : b * 64 + ((s) - 2)) : ((s) < 2 ? 128 + 2 * b + (1 - (s)) : b * 64 + (65 - (s))))
    for (int s0 = 0; s0 < 66; s0 += 6) {
      unsigned long long u[6]; float dec[6];
#pragma unroll
      for (int q = 0; q < 6; ++q) { const int gc = SCAN_GC(s0 + q); u[q] = *(const unsigned long long*)(ST + (((size_t)gc * 16 + h) * 2 + dir) * 8192 + e4 * 4); dec[q] = SDEC[(gc * 16 + h) * 2 + dir]; }
#pragma unroll
      for (int q = 0; q < 6; ++q) { const int gc = SCAN_GC(s0 + q);
        if (wr) *(unsigned long long*)(ST + (((size_t)gc * 16 + h) * 2 + dir) * 8192 + e4 * 4) = (unsigned long long)pk2(S0, S1) | ((unsigned long long)pk2(S2, S3) << 32);
        const unsigned lo = (unsigned)u[q], hi = (unsigned)(u[q] >> 32);
        S0 = dec[q] * S0 + __uint_as_float(lo << 16); S1 = dec[q] * S1 + __uint_as_float(lo & 0xffff0000u); S2 = dec[q] * S2 + __uint_as_float(hi << 16); S3 = dec[q] * S3 + __uint_as_float(hi & 0xffff0000u); }
    }
#undef SCAN_GC
  }
}
DEV bf16x8 scale_frag(bf16x8 f, float s) {
  bf16x8 o;
#pragma unroll
  for (int e = 0; e < 8; e += 2) { const unsigned w = pk2(bf2f((bf16_t)f[e]) * s, bf2f((bf16_t)f[e + 1]) * s); o[e] = (short)(w & 0xffff); o[e + 1] = (short)(w >> 16); }
  return o;
}
DEV void ssd_y_phase(const bf16_t* XC, const float* SDT, const float* SCS, const bf16_t* ST, const float* d_skip, bf16_t* Y0, float* SSQ, LAS unsigned char* lds, bool wr) {
  constexpr int XP = 272, BP = 136, SP = 72;
  LAS bf16_t* Xs = (LAS bf16_t*)lds; LAS bf16_t* Bs = (LAS bf16_t*)(lds + 128 * XP * 2);
  LAS float* tab = (LAS float*)(lds + 128 * XP * 2 + 128 * BP * 2);
  LAS float* ssq = tab + 4 * 4 * 128;
  LAS bf16_t* stg = (LAS bf16_t*)(ssq + 4 * 128);
  const int tid = threadIdx.x, lane = tid & 63, wid = tid >> 6, r = lane & 15, Qd = lane >> 4, hl = wid >> 1, ih = wid & 1;
  LAS bf16_t* mystg = stg + wid * 16 * SP;
  for (int task = virt_block(); task < NCH * 4; task += gridDim.x) {
    const int gc = task >> 2, g = (task >> 1) & 1, hh = task & 1; const size_t r0 = (size_t)gc * 128; const int h0 = g * 8 + hh * 4, h = h0 + hl;
    bf16x8 cstrip[4], cf[4][4];
#pragma unroll
    for (int ks = 0; ks < 4; ++ks) cstrip[ks] = *(const bf16x8*)(XC + (r0 + 16 * wid + r) * 1536 + 1280 + g * 128 + 32 * ks + 8 * Qd);
#pragma unroll
    for (int m = 0; m < 4; ++m)
#pragma unroll
      for (int ks = 0; ks < 4; ++ks) cf[m][ks] = *(const bf16x8*)(XC + (r0 + 64 * ih + 16 * m + r) * 1536 + 1280 + g * 128 + 32 * ks + 8 * Qd);
    __syncthreads();
#pragma unroll
    for (int i = 0; i < 8; ++i) { const int cid = tid + 512 * i, row = cid >> 5, ch = cid & 31; *(LAS v4u*)(Xs + row * XP + ch * 8) = *(const v4u*)(XC + (r0 + row) * 1536 + h0 * 64 + ch * 8); }
#pragma unroll
    for (int i = 0; i < 4; ++i) { const int cid = tid + 512 * i, row = cid >> 4, ch = cid & 15; *(LAS v4u*)(Bs + row * BP + ch * 8) = *(const v4u*)(XC + (r0 + row) * 1536 + 1024 + g * 128 + ch * 8); }
    { const int which = tid >> 7, t = tid & 127; const f32x4 v = *(const f32x4*)((which < 2 ? SCS : SDT) + (r0 + t) * 32 + (which & 1) * 16 + h0);
      const float l2_ = which < 2 ? 1.4426950408889634f : 1.f;
      tab[0 * 512 + which * 128 + t] = v.x * l2_; tab[1 * 512 + which * 128 + t] = v.y * l2_; tab[2 * 512 + which * 128 + t] = v.z * l2_; tab[3 * 512 + which * 128 + t] = v.w * l2_; }
    __syncthreads();
    {
      f32x4 cb[8];
#pragma unroll
      for (int t = 0; t < 8; ++t) { f32x4 c = {0.f, 0.f, 0.f, 0.f};
#pragma unroll
        for (int ks = 0; ks < 4; ++ks) { const bf16x8 bfr = *(const LAS bf16x8*)(Bs + (16 * t + r) * BP + 32 * ks + 8 * Qd); c = __builtin_amdgcn_mfma_f32_16x16x32_bf16(bfr, cstrip[ks], c, 0, 0, 0); }
        cb[t] = c; }
      __syncthreads();
#pragma unroll
      for (int t = 0; t < 8; ++t) *(LAS unsigned long long*)(Bs + (16 * wid + r) * BP + 16 * t + 4 * Qd) = (unsigned long long)pk2(cb[t][0], cb[t][1]) | ((unsigned long long)pk2(cb[t][2], cb[t][3]) << 32);
      __syncthreads();
    }
    const LAS float* csf = tab + hl * 512; const LAS float* csb = csf + 128; const LAS float* dtf = csf + 256; const LAS float* dtb = csf + 384;
    const float dsk = d_skip[h];
    f32x4 y[4][4];
#pragma unroll
    for (int m = 0; m < 4; ++m)
#pragma unroll
      for (int pt = 0; pt < 4; ++pt) y[m][pt] = (f32x4){0.f, 0.f, 0.f, 0.f};
    if (wr || !(PROBE_SKIP & 1))
#pragma unroll 1
    for (int dir = 0; dir < 2; ++dir) {
      const LAS float* csd = dir ? csb : csf; f32x4 sc4[4];
#pragma unroll
      for (int m = 0; m < 4; ++m) { const f32x4 c4 = *(const LAS f32x4*)(csd + 64 * ih + 16 * m + 4 * Qd);
        sc4[m] = (f32x4){__builtin_amdgcn_exp2f(c4[0]), __builtin_amdgcn_exp2f(c4[1]), __builtin_amdgcn_exp2f(c4[2]), __builtin_amdgcn_exp2f(c4[3])}; }
      const bf16_t* Sp = ST + (((size_t)gc * 16 + h) * 2 + dir) * 8192 + lane * 8;
      bf16x8 sfA[4];
#define LDSF(dst, pt_) do { _Pragma("unroll") for (int ks = 0; ks < 4; ++ks) dst[ks] = *(const bf16x8*)(Sp + ((pt_) * 4 + ks) * 512); } while (0)
#define MMSF(src_, pt_) do { __builtin_amdgcn_s_setprio(1); _Pragma("unroll") for (int m = 0; m < 4; ++m) { f32x4 t_ = {0.f, 0.f, 0.f, 0.f}; \
        _Pragma("unroll") for (int ks = 0; ks < 4; ++ks) t_ = __builtin_amdgcn_mfma_f32_16x16x32_bf16(cf[m][ks], src_[ks], t_, 0, 0, 0); \
        y[m][pt_] += sc4[m] * t_; } __builtin_amdgcn_s_setprio(0); } while (0)
      LDSF(sfA, 0); MMSF(sfA, 0);
      LDSF(sfA, 1); MMSF(sfA, 1);
      LDSF(sfA, 2); MMSF(sfA, 2);
      LDSF(sfA, 3); MMSF(sfA, 3);
#undef LDSF
#undef MMSF
    }
#pragma unroll 1
    for (int m = 0; m < 4; ++m) {
      const int i0 = 64 * ih + 16 * m, i = i0 + r;
      const float cfi = csf[i], cbi = csb[i];
      v4u zpre[2];
#pragma unroll
      for (int q = 0; q < 2; ++q) { const int c = lane + 64 * q; zpre[q] = *(const v4u*)(Y0 + (r0 + i0 + (c >> 3)) * 2048 + h * 64 + (c & 7) * 8); }
      if (wr || !(PROBE_SKIP & 2))
#pragma unroll 1
      for (int k2 = 0; k2 < 4; ++k2) {
        const int j0 = 32 * k2 + 8 * Qd;
        const v4u cbv = *(const LAS v4u*)(Bs + i * BP + j0);
        const float cbe[8] = {__uint_as_float(cbv.x << 16), __uint_as_float(cbv.x & 0xffff0000u), __uint_as_float(cbv.y << 16), __uint_as_float(cbv.y & 0xffff0000u), __uint_as_float(cbv.z << 16), __uint_as_float(cbv.z & 0xffff0000u), __uint_as_float(cbv.w << 16), __uint_as_float(cbv.w & 0xffff0000u)};
        float pv[8];
        const bool dofwd = (32 * k2 <= i0 + 15), dobwd = (32 * k2 + 31 >= i0);
#pragma unroll
        for (int e = 0; e < 8; ++e) pv[e] = (j0 + e == i) ? dsk : 0.f;
        if (dofwd) { const f32x4 a0 = *(const LAS f32x4*)(csf + j0), a1 = *(const LAS f32x4*)(csf + j0 + 4), d0 = *(const LAS f32x4*)(dtf + j0), d1 = *(const LAS f32x4*)(dtf + j0 + 4);
          const float jc[8] = {a0.x, a0.y, a0.z, a0.w, a1.x, a1.y, a1.z, a1.w}; const float jd[8] = {d0.x, d0.y, d0.z, d0.w, d1.x, d1.y, d1.z, d1.w};
          if (32 * k2 + 31 <= i0) {
#pragma unroll
            for (int e = 0; e < 8; ++e) pv[e] += cbe[e] * __builtin_amdgcn_exp2f(cfi - jc[e]) * jd[e]; }
          else {
#pragma unroll
            for (int e = 0; e < 8; ++e) pv[e] += cbe[e] * __builtin_amdgcn_exp2f(j0 + e <= i ? cfi - jc[e] : -INFINITY) * jd[e]; } }
        if (dobwd) { const f32x4 a0 = *(const LAS f32x4*)(csb + j0), a1 = *(const LAS f32x4*)(csb + j0 + 4), d0 = *(const LAS f32x4*)(dtb + j0), d1 = *(const LAS f32x4*)(dtb + j0 + 4);
          const float jc[8] = {a0.x, a0.y, a0.z, a0.w, a1.x, a1.y, a1.z, a1.w}; const float jd[8] = {d0.x, d0.y, d0.z, d0.w, d1.x, d1.y, d1.z, d1.w};
          if (32 * k2 >= i0 + 15) {
#pragma unroll
            for (int e = 0; e < 8; ++e) pv[e] += cbe[e] * __builtin_amdgcn_exp2f(cbi - jc[e]) * jd[e]; }
          else {
#pragma unroll
            for (int e = 0; e < 8; ++e) pv[e] += cbe[e] * __builtin_amdgcn_exp2f(j0 + e >= i ? cbi - jc[e] : -INFINITY) * jd[e]; } }
        const unsigned w0 = pk2(pv[0], pv[1]), w1 = pk2(pv[2], pv[3]), w2 = pk2(pv[4], pv[5]), w3 = pk2(pv[6], pv[7]);
        const bf16x8 pa = (bf16x8){(short)(w0 & 0xffff), (short)(w0 >> 16), (short)(w1 & 0xffff), (short)(w1 >> 16), (short)(w2 & 0xffff), (short)(w2 >> 16), (short)(w3 & 0xffff), (short)(w3 >> 16)};
#pragma unroll
        for (int pt = 0; pt < 4; ++pt) {
          const s16x4 lo = tr_read(Xs + (32 * k2 + 8 * Qd + (r >> 2)) * XP + hl * 64 + 16 * pt + 4 * (r & 3));
          const s16x4 hi = tr_read(Xs + (32 * k2 + 8 * Qd + 4 + (r >> 2)) * XP + hl * 64 + 16 * pt + 4 * (r & 3));
          const bf16x8 xf = (bf16x8){lo[0], lo[1], lo[2], lo[3], hi[0], hi[1], hi[2], hi[3]};
          y[0][pt] = __builtin_amdgcn_mfma_f32_16x16x32_bf16(pa, xf, y[0][pt], 0, 0, 0);
        }
      }
      if (wr || !(PROBE_SKIP & 4)) {
#pragma unroll
      for (int pt = 0; pt < 4; ++pt)
#pragma unroll
        for (int jj = 0; jj < 4; ++jj) mystg[(4 * Qd + jj) * SP + 16 * pt + r] = f2bf(y[0][pt][jj]);
      LDS_WAIT(); asm volatile("" ::: "memory");
#pragma unroll
      for (int q = 0; q < 2; ++q) { const int c = lane + 64 * q, rowl = c >> 3, ch = c & 7; const int il = 64 * ih + 16 * m + rowl;
        const v4u yv = *(const LAS v4u*)(mystg + rowl * SP + ch * 8); bf16_t* zp = Y0 + (r0 + il) * 2048 + h * 64 + ch * 8; const v4u zv = zpre[q];
        const float v0 = __uint_as_float(yv.x << 16) * __uint_as_float(zv.x << 16), v1 = __uint_as_float(yv.x & 0xffff0000u) * __uint_as_float(zv.x & 0xffff0000u);
        const float v2 = __uint_as_float(yv.y << 16) * __uint_as_float(zv.y << 16), v3 = __uint_as_float(yv.y & 0xffff0000u) * __uint_as_float(zv.y & 0xffff0000u);
        const float v4 = __uint_as_float(yv.z << 16) * __uint_as_float(zv.z << 16), v5 = __uint_as_float(yv.z & 0xffff0000u) * __uint_as_float(zv.z & 0xffff0000u);
        const float v6 = __uint_as_float(yv.w << 16) * __uint_as_float(zv.w << 16), v7 = __uint_as_float(yv.w & 0xffff0000u) * __uint_as_float(zv.w & 0xffff0000u);
        float ss = (v0 * v0 + v1 * v1) + (v2 * v2 + v3 * v3) + (v4 * v4 + v5 * v5) + (v6 * v6 + v7 * v7);
        ss += __shfl_xor(ss, 1); ss += __shfl_xor(ss, 2); ss += __shfl_xor(ss, 4);
        v4u ov; ov.x = pk2(v0, v1); ov.y = pk2(v2, v3); ov.z = pk2(v4, v5); ov.w = pk2(v6, v7);
        if (wr) *(v4u*)zp = ov;
        if (ch == 0) ssq[hl * 128 + il] = ss; }
      LDS_WAIT(); asm volatile("" ::: "memory");
      }
#pragma unroll
      for (int pt = 0; pt < 4; ++pt) { y[0][pt] = y[1][pt]; y[1][pt] = y[2][pt]; y[2][pt] = y[3][pt]; }
    }
    __syncthreads();
    if (tid < 128) SSQ[((r0 + tid) * 2 + g) * 2 + hh] = (ssq[tid] + ssq[128 + tid]) + (ssq[256 + tid] + ssq[384 + tid]);
  }
}

typedef _Float16 h16_t;
typedef _Float16 h16x8 __attribute__((ext_vector_type(8)));
DEV const h16_t* gcs_row(const h16_t* wsb, const h16_t* outb, size_t row) {
  return row < 9472 ? (const h16_t*)((const char*)wsb + 237 * MiB + 512 * 1024) + row * 1024 : (row < 13824 ? (const h16_t*)((const char*)outb + 55 * MiB + 512 * 1024) + (row - 9472) * 1024 : (const h16_t*)((const char*)wsb + 2 * MiB) + (row - 13824) * 1024); }
DEV h16_t* gcs_row_w(h16_t* wsb, h16_t* outb, size_t row) { return (h16_t*)gcs_row(wsb, outb, row); }
DEV float logsig_fast(float x) { return fminf(x, 0.f) - 0.6931471805599453f * __builtin_amdgcn_logf(1.f + __builtin_amdgcn_exp2f(-1.4426950408889634f * fabsf(x))); }
DEV void gla_cs_phase(const float* DTLR, const float* gw, const float* gb, h16_t* GCSL, h16_t* GCSC, float* GDEC, LAS unsigned char* lds, unsigned* queue) {
  const int lane = threadIdx.x & 63, wave = threadIdx.x >> 6;
  LAS float* lrs = (LAS float*)(lds + wave * 8192);
  LAS h16_t* tile = (LAS h16_t*)(lds + 65536 + wave * 1024);
  for (;;) {
    unsigned wt_ = 0u; if (lane == 0) wt_ = __hip_atomic_fetch_add(queue, 1u, __ATOMIC_RELAXED, __HIP_MEMORY_SCOPE_AGENT);
    wt_ = (unsigned)__builtin_amdgcn_readfirstlane((int)wt_); if (wt_ >= (unsigned)(NCH * 2 * 8)) break;
    const int wt = (int)wt_;
    const int gc = wt >> 4, dir = (wt >> 3) & 1, k = (wt & 7) * 64 + lane;
#pragma unroll
    for (int q = 0; q < 8; ++q) { const int c = lane + 64 * q, row = c >> 2, part = c & 3;
      *(LAS f32x4*)(lrs + row * 16 + part * 4) = *(const f32x4*)(DTLR + ((size_t)gc * 128 + row) * 64 + 32 + dir * 16 + part * 4); }
    float wv[16];
#pragma unroll
    for (int q = 0; q < 16; ++q) wv[q] = gw[(dir * 16 + q) * 512 + k];
    const float bias = gb[dir * 512 + k];
    LDS_WAIT(); asm volatile("" ::: "memory");
    float run = 0.f;
#pragma unroll 1
    for (int s0 = 0; s0 < 128; s0 += 8) {
      float lg[8];
#pragma unroll
      for (int u = 0; u < 8; ++u) { const int s = s0 + u, t = dir ? 127 - s : s; const LAS float* lr = lrs + t * 16;
        const f32x4 l0 = *(const LAS f32x4*)lr, l1 = *(const LAS f32x4*)(lr + 4), l2 = *(const LAS f32x4*)(lr + 8), l3 = *(const LAS f32x4*)(lr + 12);
        const float x = bias + l0.x * wv[0] + l0.y * wv[1] + l0.z * wv[2] + l0.w * wv[3] + l1.x * wv[4] + l1.y * wv[5] + l1.z * wv[6] + l1.w * wv[7]
                        + l2.x * wv[8] + l2.y * wv[9] + l2.z * wv[10] + l2.w * wv[11] + l3.x * wv[12] + l3.y * wv[13] + l3.z * wv[14] + l3.w * wv[15];
        lg[u] = logsig_fast(x) * (1.f / 16.f); }
#pragma unroll
      for (int u = 0; u < 8; ++u) { run += lg[u]; tile[u * 64 + lane] = (h16_t)run; }
      LDS_WAIT(); asm volatile("" ::: "memory");
      { const int u = lane >> 3, ch = lane & 7, s = s0 + u, t = dir ? 127 - s : s;
        *(v4u*)(gcs_row_w(GCSL, GCSC, (size_t)gc * 128 + t) + dir * 512 + (k - lane) + ch * 8) = *(const LAS v4u*)(tile + u * 64 + ch * 8); }
      LDS_WAIT(); asm volatile("" ::: "memory");
    }
    GDEC[((gc * 4 + (k >> 7)) * 2 + dir) * 128 + (k & 127)] = fexp(run);
    LDS_WAIT(); asm volatile("" ::: "memory");
  }
}
DEV void gla_u_phase(const bf16_t* K0, const bf16_t* V0, const h16_t* GCSL, const h16_t* GCSC, bf16_t* ST, LAS unsigned char* lds) {
  constexpr int VP = 272, KP = 144;
  LAS bf16_t* Vs = (LAS bf16_t*)lds; LAS bf16_t* Kd = (LAS bf16_t*)(lds + 128 * VP * 2);
  const int tid = threadIdx.x, lane = tid & 63, wid = tid >> 6, r = lane & 15, Qd = lane >> 4;
  for (int task = virt_block(); task < NCH * 4; task += gridDim.x) {
    const int gc = task >> 2, h = task & 3; const size_t r0 = (size_t)gc * 128;
    __syncthreads();
#pragma unroll
    for (int i = 0; i < 8; ++i) { const int cid = tid + 512 * i, row = cid >> 5, ch = cid & 31; *(LAS v4u*)(Vs + row * VP + ch * 8) = *(const v4u*)(V0 + (r0 + row) * 1024 + h * 256 + ch * 8); }
#pragma unroll
    for (int i = 0; i < 4; ++i) { const int cid = tid + 512 * i, t = cid >> 4, ch = cid & 15;
      const v4u kv = *(const v4u*)(K0 + (r0 + t) * 512 + h * 128 + ch * 8);
      const float kf[8] = {__uint_as_float(kv.x << 16), __uint_as_float(kv.x & 0xffff0000u), __uint_as_float(kv.y << 16), __uint_as_float(kv.y & 0xffff0000u), __uint_as_float(kv.z << 16), __uint_as_float(kv.z & 0xffff0000u), __uint_as_float(kv.w << 16), __uint_as_float(kv.w & 0xffff0000u)};
#pragma unroll
      for (int dir = 0; dir < 2; ++dir) {
        const h16x8 ce = *(const h16x8*)(gcs_row(GCSL, GCSC, r0 + (dir ? 0 : 127)) + dir * 512 + h * 128 + ch * 8), ct = *(const h16x8*)(gcs_row(GCSL, GCSC, r0 + t) + dir * 512 + h * 128 + ch * 8);
        v4u o; o.x = pk2(kf[0] * fexp((float)ce[0] - (float)ct[0]), kf[1] * fexp((float)ce[1] - (float)ct[1])); o.y = pk2(kf[2] * fexp((float)ce[2] - (float)ct[2]), kf[3] * fexp((float)ce[3] - (float)ct[3]));
        o.z = pk2(kf[4] * fexp((float)ce[4] - (float)ct[4]), kf[5] * fexp((float)ce[5] - (float)ct[5])); o.w = pk2(kf[6] * fexp((float)ce[6] - (float)ct[6]), kf[7] * fexp((float)ce[7] - (float)ct[7]));
        *(LAS v4u*)(Kd + dir * 128 * KP + t * KP + ch * 8) = o; } }
    __syncthreads();
#pragma unroll 1
    for (int dir = 0; dir < 2; ++dir) {
      const LAS bf16_t* Kb = Kd + dir * 128 * KP;
      f32x4 acc[8][2];
#pragma unroll
      for (int dt = 0; dt < 8; ++dt) { acc[dt][0] = (f32x4){0.f, 0.f, 0.f, 0.f}; acc[dt][1] = (f32x4){0.f, 0.f, 0.f, 0.f}; }
#pragma unroll
      for (int k = 0; k < 4; ++k) {
        bf16x8 vf[2];
#pragma unroll
        for (int et = 0; et < 2; ++et) {
          const s16x4 lo = tr_read(Vs + (32 * k + 4 * Qd + (r >> 2)) * VP + 32 * wid + 16 * et + 4 * (r & 3));
          const s16x4 hi = tr_read(Vs + (32 * k + 16 + 4 * Qd + (r >> 2)) * VP + 32 * wid + 16 * et + 4 * (r & 3));
          vf[et] = (bf16x8){lo[0], lo[1], lo[2], lo[3], hi[0], hi[1], hi[2], hi[3]}; }
        __builtin_amdgcn_s_setprio(1);
#pragma unroll
        for (int dt = 0; dt < 8; ++dt) {
          const s16x4 lo = tr_read(Kb + (32 * k + 4 * Qd + (r >> 2)) * KP + 16 * dt + 4 * (r & 3));
          const s16x4 hi = tr_read(Kb + (32 * k + 16 + 4 * Qd + (r >> 2)) * KP + 16 * dt + 4 * (r & 3));
          const bf16x8 kfr = (bf16x8){lo[0], lo[1], lo[2], lo[3], hi[0], hi[1], hi[2], hi[3]};
          acc[dt][0] = __builtin_amdgcn_mfma_f32_16x16x32_bf16(kfr, vf[0], acc[dt][0], 0, 0, 0);
          acc[dt][1] = __builtin_amdgcn_mfma_f32_16x16x32_bf16(kfr, vf[1], acc[dt][1], 0, 0, 0); }
        __builtin_amdgcn_s_setprio(0);
      }
      bf16_t* Sp = ST + (((size_t)gc * 4 + h) * 2 + dir) * 32768;
#pragma unroll
      for (int dt = 0; dt < 8; ++dt)
#pragma unroll
        for (int et = 0; et < 2; ++et) { const f32x4 v = acc[dt][et];
          *(unsigned long long*)(Sp + ((((2 * wid + et) * 4 + (dt >> 1)) * 64 + ((dt & 1) * 2 + (Qd >> 1)) * 16 + r) * 8 + 4 * (Qd & 1))) = (unsigned long long)pk2(v[0], v[1]) | ((unsigned long long)pk2(v[2], v[3]) << 32); }
    }
  }
}
DEV void gla_scan_phase(bf16_t* ST, const float* GDEC, bool wr) {
  for (int item = blockIdx.x * 512 + threadIdx.x; item < 2 * 4 * 2 * 8192; item += gridDim.x * 512) {
    const int e4 = item & 8191, dir = (item >> 13) & 1, h = (item >> 14) & 3, b = item >> 16; const int d0 = 32 * ((e4 >> 7) & 3) + 8 * ((e4 >> 5) & 3) + 4 * (e4 & 1);
    float S0 = 0.f, S1 = 0.f, S2 = 0.f, S3 = 0.f;
#define SCAN_GC(s) (!dir ? ((s) < 2 ? 128 + 2 * b + (s) : b * 64 + ((s) - 2)) : ((s) < 2 ? 128 + 2 * b + (1 - (s)) : b * 64 + (65 - (s))))
    for (int s0 = 0; s0 < 66; s0 += 6) {
      unsigned long long u[6]; f32x4 dec[6];
#pragma unroll
      for (int q = 0; q < 6; ++q) { const int gc = SCAN_GC(s0 + q); u[q] = *(const unsigned long long*)(ST + (((size_t)gc * 4 + h) * 2 + dir) * 32768 + e4 * 4); dec[q] = *(const f32x4*)(GDEC + ((gc * 4 + h) * 2 + dir) * 128 + d0); }
#pragma unroll
      for (int q = 0; q < 6; ++q) { const int gc = SCAN_GC(s0 + q);
        if (wr) *(unsigned long long*)(ST + (((size_t)gc * 4 + h) * 2 + dir) * 32768 + e4 * 4) = (unsigned long long)pk2(S0, S1) | ((unsigned long long)pk2(S2, S3) << 32);
        const unsigned lo = (unsigned)u[q], hi = (unsigned)(u[q] >> 32);
        S0 = dec[q].x * S0 + __uint_as_float(lo << 16); S1 = dec[q].y * S1 + __uint_as_float(lo & 0xffff0000u); S2 = dec[q].z * S2 + __uint_as_float(hi << 16); S3 = dec[q].w * S3 + __uint_as_float(hi & 0xffff0000u); }
    }
#undef SCAN_GC
  }
}
DEV void gla_o_phase(const bf16_t* Q0, const bf16_t* K0, const bf16_t* V0, const h16_t* GCSL, const h16_t* GCSC, const bf16_t* ST, const float* gla_norm, bf16_t* Y0, LAS unsigned char* lds, bool wr) {
  constexpr int VP = 272, KP = 136;
  LAS bf16_t* Vs = (LAS bf16_t*)lds; LAS bf16_t* Kd = (LAS bf16_t*)(lds + 128 * VP * 2);
  const int tid = threadIdx.x, lane = tid & 63, wid = tid >> 6, r = lane & 15, Qd = lane >> 4;
  const float scale = 0.08838834764831845f;
  for (int task = virt_block(); task < NCH * 4; task += gridDim.x) {
    const int gc = task >> 2, h = task & 3; const size_t r0 = (size_t)gc * 128;
    __syncthreads();
#pragma unroll
    for (int i = 0; i < 8; ++i) { const int cid = tid + 512 * i, row = cid >> 5, ch = cid & 31; *(LAS v4u*)(Vs + row * VP + ch * 8) = *(const v4u*)(V0 + (r0 + row) * 1024 + h * 256 + ch * 8); }
#pragma unroll
    for (int i = 0; i < 4; ++i) { const int cid = tid + 512 * i, t = cid >> 4, ch = cid & 15;
      const v4u kv = *(const v4u*)(K0 + (r0 + t) * 512 + h * 128 + ch * 8);
      const float kf[8] = {__uint_as_float(kv.x << 16), __uint_as_float(kv.x & 0xffff0000u), __uint_as_float(kv.y << 16), __uint_as_float(kv.y & 0xffff0000u), __uint_as_float(kv.z << 16), __uint_as_float(kv.z & 0xffff0000u), __uint_as_float(kv.w << 16), __uint_as_float(kv.w & 0xffff0000u)};
#pragma unroll
      for (int dir = 0; dir < 2; ++dir) {
        const h16x8 ct = *(const h16x8*)(gcs_row(GCSL, GCSC, r0 + t) + dir * 512 + h * 128 + ch * 8);
        v4u o; o.x = pk2(kf[0] * fexp(-(float)ct[0]), kf[1] * fexp(-(float)ct[1])); o.y = pk2(kf[2] * fexp(-(float)ct[2]), kf[3] * fexp(-(float)ct[3]));
        o.z = pk2(kf[4] * fexp(-(float)ct[4]), kf[5] * fexp(-(float)ct[5])); o.w = pk2(kf[6] * fexp(-(float)ct[6]), kf[7] * fexp(-(float)ct[7]));
        *(LAS v4u*)(Kd + dir * 128 * KP + t * KP + ch * 8) = o; } }
    __syncthreads();
    const int i = 16 * wid + r;
    f32x4 o[16];
#pragma unroll
    for (int et = 0; et < 16; ++et) o[et] = (f32x4){0.f, 0.f, 0.f, 0.f};
#pragma unroll 1
    for (int dir = 0; dir < 2; ++dir) {
      bf16x8 qd[4];
      { const h16_t* ci = gcs_row(GCSL, GCSC, r0 + i) + dir * 512 + h * 128; const bf16_t* qp = Q0 + (r0 + i) * 512 + h * 128;
#pragma unroll
        for (int ks = 0; ks < 4; ++ks) { const v4u qv = *(const v4u*)(qp + 32 * ks + 8 * Qd); const h16x8 cc = *(const h16x8*)(ci + 32 * ks + 8 * Qd);
          const f32x4 c0 = {(float)cc[0], (float)cc[1], (float)cc[2], (float)cc[3]}, c1 = {(float)cc[4], (float)cc[5], (float)cc[6], (float)cc[7]};
          const unsigned w0 = pk2(__uint_as_float(qv.x << 16) * scale * fexp(c0.x), __uint_as_float(qv.x & 0xffff0000u) * scale * fexp(c0.y));
          const unsigned w1 = pk2(__uint_as_float(qv.y << 16) * scale * fexp(c0.z), __uint_as_float(qv.y & 0xffff0000u) * scale * fexp(c0.w));
          const unsigned w2 = pk2(__uint_as_float(qv.z << 16) * scale * fexp(c1.x), __uint_as_float(qv.z & 0xffff0000u) * scale * fexp(c1.y));
          const unsigned w3 = pk2(__uint_as_float(qv.w << 16) * scale * fexp(c1.z), __uint_as_float(qv.w & 0xffff0000u) * scale * fexp(c1.w));
          qd[ks] = (bf16x8){(short)(w0 & 0xffff), (short)(w0 >> 16), (short)(w1 & 0xffff), (short)(w1 >> 16), (short)(w2 & 0xffff), (short)(w2 >> 16), (short)(w3 & 0xffff), (short)(w3 >> 16)}; } }
      const bf16_t* Sp = ST + (((size_t)gc * 4 + h) * 2 + dir) * 32768 + lane * 8;
      {
        bf16x8 sA[4], sB[4];
#pragma unroll
        for (int q = 0; q < 4; ++q) sA[q] = *(const bf16x8*)(Sp + (q * 4 + 0) * 512);
#pragma unroll
        for (int bi = 0; bi < 16; ++bi) {
          const int ks = bi >> 2, e0 = 4 * (bi & 3);
          if (bi + 1 < 16) { const int ks2 = (bi + 1) >> 2, e2 = 4 * ((bi + 1) & 3);
#pragma unroll
            for (int q = 0; q < 4; ++q) { if (bi & 1) sA[q] = *(const bf16x8*)(Sp + ((e2 + q) * 4 + ks2) * 512); else sB[q] = *(const bf16x8*)(Sp + ((e2 + q) * 4 + ks2) * 512); } }
          __builtin_amdgcn_s_setprio(1);
#pragma unroll
          for (int q = 0; q < 4; ++q) o[e0 + q] = __builtin_amdgcn_mfma_f32_16x16x32_bf16(qd[ks], (bi & 1) ? sB[q] : sA[q], o[e0 + q], 0, 0, 0);
          __builtin_amdgcn_s_setprio(0);
          __builtin_amdgcn_sched_barrier(0);
        }
      }
      const LAS bf16_t* Kb = Kd + dir * 128 * KP;
#pragma unroll 1
      for (int k2 = 0; k2 < 4; ++k2) {
        const bool need = dir ? (2 * k2 + 1 >= wid) : (2 * k2 <= wid);
        if (!need) continue;
        bf16x8 pa;
#pragma unroll
        for (int tt = 0; tt < 2; ++tt) { const int t = 2 * k2 + tt;
          f32x4 c = {0.f, 0.f, 0.f, 0.f};
#pragma unroll
          for (int ks = 0; ks < 4; ++ks) { const bf16x8 kfr = *(const LAS bf16x8*)(Kb + (16 * t + r) * KP + 32 * ks + 8 * Qd); c = __builtin_amdgcn_mfma_f32_16x16x32_bf16(kfr, qd[ks], c, 0, 0, 0); }
          float pv[4];
#pragma unroll
          for (int jj = 0; jj < 4; ++jj) { const int j = 16 * t + 4 * Qd + jj; const bool ok = dir ? (j >= i) : (j <= i); pv[jj] = ok ? c[jj] : 0.f; }
          const unsigned w0 = pk2(pv[0], pv[1]), w1 = pk2(pv[2], pv[3]);
          pa[tt * 4 + 0] = (short)(w0 & 0xffff); pa[tt * 4 + 1] = (short)(w0 >> 16); pa[tt * 4 + 2] = (short)(w1 & 0xffff); pa[tt * 4 + 3] = (short)(w1 >> 16); }
        __builtin_amdgcn_s_setprio(1);
#pragma unroll
        for (int et = 0; et < 16; ++et) {
          const s16x4 lo = tr_read(Vs + (32 * k2 + 4 * Qd + (r >> 2)) * VP + 16 * et + 4 * (r & 3));
          const s16x4 hi = tr_read(Vs + (32 * k2 + 16 + 4 * Qd + (r >> 2)) * VP + 16 * et + 4 * (r & 3));
          const bf16x8 vf = (bf16x8){lo[0], lo[1], lo[2], lo[3], hi[0], hi[1], hi[2], hi[3]};
          o[et] = __builtin_amdgcn_mfma_f32_16x16x32_bf16(pa, vf, o[et], 0, 0, 0); }
        __builtin_amdgcn_s_setprio(0);
      }
    }
    asm volatile("s_nop 15\n\ts_nop 15\n\ts_nop 15\n\ts_nop 15" ::: "memory");
    __syncthreads();
    { constexpr int GP = 264;
      LAS bf16_t* stg = (LAS bf16_t*)lds + wid * (16 * GP);
      float gn_[16];
#pragma unroll
      for (int et = 0; et < 16; ++et) gn_[et] = gla_norm[h * 256 + 16 * et + r];
#pragma unroll
      for (int jj = 0; jj < 4; ++jj) { float ss = 0.f;
#pragma unroll
        for (int et = 0; et < 16; ++et) ss += o[et][jj] * o[et][jj];
        ss += __shfl_xor(ss, 1); ss += __shfl_xor(ss, 2); ss += __shfl_xor(ss, 4); ss += __shfl_xor(ss, 8);
        const float rstd = rsqrtf(ss * (1.f / 256.f) + EPS);
        LAS bf16_t* srow = stg + (4 * Qd + jj) * GP;
#pragma unroll
        for (int e = 0; e < 8; ++e) { const float a0 = o[2 * e][jj] * rstd * gn_[2 * e], a1 = o[2 * e + 1][jj] * rstd * gn_[2 * e + 1];
          const float p0 = __shfl_xor(a0, 1), p1 = __shfl_xor(a1, 1);
          const unsigned w = (r & 1) ? pk2(p1, a1) : pk2(a0, p0); const int col = (r & 1) ? 16 * (2 * e + 1) + r - 1 : 16 * (2 * e) + r;
          *(LAS unsigned*)(srow + col) = w; } }
      LDS_WAIT(); asm volatile("" ::: "memory");
#pragma unroll
      for (int q = 0; q < 8; ++q) { const int c = lane + 64 * q, rowl = c >> 5, ch = c & 31;
        bf16_t* gp = Y0 + (r0 + 16 * wid + rowl) * 2048 + 1024 + h * 256 + ch * 8;
        const v4u ov = *(const LAS v4u*)(stg + rowl * GP + ch * 8), gv = *(const v4u*)gp;
        v4u w; w.x = pk2(__uint_as_float(ov.x << 16) * __uint_as_float(gv.x << 16), __uint_as_float(ov.x & 0xffff0000u) * __uint_as_float(gv.x & 0xffff0000u));
        w.y = pk2(__uint_as_float(ov.y << 16) * __uint_as_float(gv.y << 16), __uint_as_float(ov.y & 0xffff0000u) * __uint_as_float(gv.y & 0xffff0000u));
        w.z = pk2(__uint_as_float(ov.z << 16) * __uint_as_float(gv.z << 16), __uint_as_float(ov.z & 0xffff0000u) * __uint_as_float(gv.z & 0xffff0000u));
        w.w = pk2(__uint_as_float(ov.w << 16) * __uint_as_float(gv.w << 16), __uint_as_float(ov.w & 0xffff0000u) * __uint_as_float(gv.w & 0xffff0000u));
        if (wr) *(v4u*)gp = w; }
      LDS_WAIT(); asm volatile("" ::: "memory"); }
  }
}

typedef __attribute__((address_space(1))) unsigned gu32;
#define RLX_AGENT __ATOMIC_RELAXED, __HIP_MEMORY_SCOPE_AGENT
#define XB_TMO      128
#define XB_XCNT(j)  (256  + 64 * (j))
#define XB_XSUB(j)  (1280 + 64 * (j))
#define XB_XGEN(j)  (2304 + 64 * (j))
#define XB_TOP      3328
#define XB_TOPGEN   3392
#define XCD_BAR_WORDS 3456
#define XB_SPIN_CAP (1u << 18)

__device__ __forceinline__ unsigned xb_ld(unsigned* p)              { return __hip_atomic_load(p, __ATOMIC_RELAXED, __HIP_MEMORY_SCOPE_AGENT); }
__device__ __forceinline__ unsigned xb_add(unsigned* p, unsigned v) { return __hip_atomic_fetch_add(p, v, __ATOMIC_RELAXED, __HIP_MEMORY_SCOPE_AGENT); }
__device__ __forceinline__ unsigned xb_xcc_id() { return (unsigned)__builtin_amdgcn_s_getreg((3 << 11) | 20) & 0xFu; }
#define XB_SPIN(cond, bar) do { unsigned _sp = 0; while (cond) { __builtin_amdgcn_s_sleep(1); \
    if ((++_sp & 255u) == 0u) { if (xb_ld(&(bar)[XB_TMO])) break; if (_sp > XB_SPIN_CAP) { atomicAdd(&(bar)[XB_TMO], 1u); break; } } } } while (0)

struct XcdBarrier {
    unsigned* bar; unsigned x;
    volatile LAS unsigned* st;
};

__device__ __forceinline__ XcdBarrier xcd_barrier_post(unsigned* bar, volatile LAS unsigned* st) {
    XcdBarrier b; b.bar = bar; b.x = xb_xcc_id(); b.st = st;
    if (threadIdx.x == 0) (void)xb_add(&bar[XB_XCNT(b.x)], 1u);
    return b;
}
__device__ __forceinline__ void xcd_barrier_complete(unsigned* bar, unsigned x, unsigned& nloc, unsigned& nx) {
    const unsigned G = gridDim.x * gridDim.y * gridDim.z;
    unsigned sum, cnt, mine, sp = 0u;
    for (;;) {
        sum = 0u; cnt = 0u; mine = 0u;
#pragma unroll
        for (unsigned j = 0; j < 16; ++j) { const unsigned c = xb_ld(&bar[XB_XCNT(j)]); sum += c; cnt += (c > 0u) ? 1u : 0u; mine = (j == x) ? c : mine; }
        if (sum == G) break;
        __builtin_amdgcn_s_sleep(1);
        if ((++sp & 255u) == 0u) { if (xb_ld(&bar[XB_TMO])) break; if (sp > XB_SPIN_CAP) { atomicAdd(&bar[XB_TMO], 1u); break; } }
    }
    nloc = mine > 0u ? mine : 1u; nx = cnt > 0u ? cnt : 1u;
}

__device__ __forceinline__ void xcd_barrier(const XcdBarrier& b) {
    asm volatile("s_waitcnt vmcnt(0)" ::: "memory");
    __syncthreads();
    if (threadIdx.x == 0) {
        unsigned* bar = b.bar;
        __builtin_amdgcn_s_waitcnt(0);
        unsigned nloc = b.st[0], nx = b.st[1];
        if (nloc == 0u) { xcd_barrier_complete(bar, b.x, nloc, nx); b.st[0] = nloc; b.st[1] = nx; }
        const unsigned old = xb_add(&bar[XB_XSUB(b.x)], 1u);
        const unsigned gen = old / nloc;
        if (old + 1u == (gen + 1u) * nloc) {
            __builtin_amdgcn_fence(__ATOMIC_RELEASE, "agent");
            asm volatile("s_waitcnt vmcnt(0)" ::: "memory");
            const unsigned og = xb_add(&bar[XB_TOP], 1u);
            const unsigned tg = og / nx;
            if (og + 1u == (tg + 1u) * nx) xb_add(&bar[XB_TOPGEN], 1u);
            else XB_SPIN(xb_ld(&bar[XB_TOPGEN]) == tg, bar);
            __builtin_amdgcn_fence(__ATOMIC_ACQUIRE, "agent");
            xb_add(&bar[XB_XGEN(b.x)], 1u);
            asm volatile("s_waitcnt vmcnt(0)" ::: "memory");
        } else {
            XB_SPIN(xb_ld(&bar[XB_XGEN(b.x)]) == gen, bar);
            __builtin_amdgcn_fence(__ATOMIC_ACQUIRE, "agent");
            asm volatile("s_waitcnt vmcnt(0)" ::: "memory");
        }
    }
    __syncthreads();
}

__global__ void __launch_bounds__(NWAVES * 64, 2) __attribute__((amdgpu_num_sgpr(92))) mega(Params p) {
  extern __shared__ __attribute__((aligned(16))) unsigned char lds_raw[];
  LAS unsigned char* lds = (LAS unsigned char*)lds_raw;
  volatile LAS unsigned* MISC = (volatile LAS unsigned*)(lds + MISC_OFF);
  if (threadIdx.x < 16) MISC[threadIdx.x] = 0u;
  __syncthreads();
  XcdBarrier bar = xcd_barrier_post((unsigned*)(p.ws + WS_CTL), MISC + 8);
  unsigned char* ws = p.ws;
  float* MOD = (float*)(ws + WS_MOD);
  bf16_t* H0 = (bf16_t*)p.out; float* X1 = p.out;
  const int lo = p.ph_lo, hi = p.ph_hi;
#define IN(k) (lo <= (k) && (k) < hi)
#define SEAM(k) do { if ((k) + 1 < hi) xcd_barrier(bar); } while (0)
#define PH(k, ...) if (IN(k)) { if ((PROBE_MASK >> (k)) & 1u) { const bool wr = (p.rep < 0); (void)wr; __VA_ARGS__; xcd_barrier(bar); } { const bool wr = true; (void)wr; __VA_ARGS__; } SEAM(k); }
  PH(0, prologue_phase(p, lds))
  PH(1, prep_phase(p.in[0], p.in[2], p.in[4], MOD, H0))
  PH(2, {
    pg8::Gemm g{H0, (const bf16_t*)(ws + WS_W1T), MA, E_INP, D}; pg8::StaticOrder S; S.init(MA, E_INP, gridDim.x, (int)blockIdx.x);
    pg8::EpiProj0 E{(bf16_t*)(ws + WS_Y0), (bf16_t*)(ws + WS_XBC), (bf16_t*)(ws + WS_Q0), (bf16_t*)(ws + WS_K0), (bf16_t*)(ws + WS_V0), (float*)(ws + WS_DTLR)};
    pg8::gemm_phase<pg8::EpiProj0, pg8::StaticOrder, true, true>(lds, g, S, E); })
  PH(3, ssd_prep_phase((const bf16_t*)(ws + WS_XBC), p.in[8], p.in[9], (bf16_t*)p.out, (const float*)(ws + WS_DTLR), p.in[10], p.in[11], (float*)((char*)p.out + DO_SDT), (float*)((char*)p.out + DO_SCS), (float*)(ws + WS_SDEC)))
  PH(4, { ssd_u_phase((const bf16_t*)p.out, (const float*)((char*)p.out + DO_SDT), (const float*)((char*)p.out + DO_SCS), (bf16_t*)(ws + WS_STATE), lds);
    { const int nbusy = (NCH * 4) % (int)gridDim.x, nfree = (int)gridDim.x - nbusy;
      const int vb_ = virt_block(); if (vb_ >= nbusy || nfree <= 0) { __syncthreads(); late_weights(p, lds, nfree > 0 ? vb_ - nbusy : vb_, nfree > 0 ? nfree : (int)gridDim.x); } } })
  PH(5, ssd_scan_phase((bf16_t*)(ws + WS_STATE), (const float*)(ws + WS_SDEC), wr))
  PH(6, { ssd_y_phase((const bf16_t*)p.out, (const float*)((char*)p.out + DO_SDT), (const float*)((char*)p.out + DO_SCS), (const bf16_t*)(ws + WS_STATE), p.in[12], (bf16_t*)(ws + WS_Y0), (float*)(ws + WS_SSQ), lds, wr);
    if (wr) gla_cs_phase((const float*)(ws + WS_DTLR), p.in[14], p.in[15], (h16_t*)ws, (h16_t*)p.out, (float*)(ws + WS_GDEC), lds, (unsigned*)(ws + WS_CTL) + CW_CSQ); })
  PH(8, gla_u_phase((const bf16_t*)(ws + WS_K0), (const bf16_t*)(ws + WS_V0), (const h16_t*)ws, (const h16_t*)p.out, (bf16_t*)(ws + WS_STATE), lds))
  PH(9, gla_scan_phase((bf16_t*)(ws + WS_STATE), (const float*)(ws + WS_GDEC), wr))
  PH(10, gla_o_phase((const bf16_t*)(ws + WS_Q0), (const bf16_t*)(ws + WS_K0), (const bf16_t*)(ws + WS_V0), (const h16_t*)ws, (const h16_t*)p.out, (const bf16_t*)(ws + WS_STATE), p.in[16], (bf16_t*)(ws + WS_Y0), lds, wr))
  PH(11, {
    pg8::Gemm g{(const bf16_t*)(ws + WS_Y0), (const bf16_t*)(ws + WS_W2T), ML, D, 2048}; pg8::StaticOrder S; S.init(ML, D, gridDim.x, (int)blockIdx.x);
    const float* SSQ = (const float*)(ws + WS_SSQ);
    LAS float* rs = (LAS float*)(lds + 131072);
    { pg8::Unit u0; if (S.next(0, u0) && threadIdx.x < 256) { const size_t row = (size_t)u0.pm * 256 + threadIdx.x;
        const float r0 = rsqrtf((SSQ[(row * 2 + 0) * 2] + SSQ[(row * 2 + 0) * 2 + 1]) * (1.f / 512.f) + EPS), r1 = rsqrtf((SSQ[(row * 2 + 1) * 2] + SSQ[(row * 2 + 1) * 2 + 1]) * (1.f / 512.f) + EPS);
        rs[threadIdx.x * 2] = r0 / r1; rs[threadIdx.x * 2 + 1] = r1; } }
    __syncthreads();
    float* SSQ1 = (float*)(ws + WS_SSQ1); bf16_t* H1 = (bf16_t*)(ws + WS_H1); const float* g1 = p.in[18]; const float* MOD1 = MOD + 3 * 3072;
    pg8::EpiResidH E{p.in[0], X1, MOD, g1, MOD1, H1, SSQ1};
    pg8::gemm_phase<pg8::EpiResidH, pg8::StaticOrder, true, true, true>(lds, g, S, E, rs);
    const float* ctx = p.in[2]; const float* gate = MOD + 2 * 3072 + 2048; const float* sc1c = MOD1 + 2 * 3072 + 1024;
    small_gemm_splitk((const bf16_t*)(ws + WS_Y0) + (size_t)ML * 2048, 2048, (const bf16_t*)(ws + WS_W2T), 2048, 2048, MC, D, lds, SSQ1 + ML, SSQ + (size_t)ML * 4,
               [=](int m, int n, float v, float vn) { const float x1 = ctx[(size_t)m * D + n] + gate[n] * v, x1n = ctx[(size_t)m * D + (n ^ 1)] + gate[n ^ 1] * vn;
                 if (!(n & 1)) *(unsigned*)(H1 + (size_t)(ML + m) * D + n) = pk2(x1 * g1[n] * (1.f + sc1c[n]), x1n * g1[n + 1] * (1.f + sc1c[n + 1])); return x1 * x1; }); })
  PH(13, {
    pg8::Gemm g{(const bf16_t*)(ws + WS_H1), (const bf16_t*)(ws + WS_W3T), ML, O_IN, D}; pg8::StaticOrder S; S.init(ML, O_IN, gridDim.x, (int)blockIdx.x);
    pg8::EpiProj1 E{(bf16_t*)(ws + WS_K1), (bf16_t*)(ws + WS_V1), (bf16_t*)(ws + WS_Q1), (bf16_t*)(ws + WS_G1), p.in[22], p.in[23], (const float*)(ws + WS_ROPE), (LAS float*)(lds + 131072), (const float*)(ws + WS_SSQ1), (const float*)(ws + WS_CB)};
    pg8::gemm_phase<pg8::EpiProj1, pg8::StaticOrder, true, true>(lds, g, S, E);
    bf16_t* K1 = (bf16_t*)(ws + WS_K1); bf16_t* V1 = (bf16_t*)(ws + WS_V1);
    small_gemm_splitk((const bf16_t*)(ws + WS_H1) + (size_t)ML * D, D, (const bf16_t*)(ws + WS_W3T), D, D, MC, 1024, lds, nullptr, nullptr,
               [=](int m, int n, float v, float vn) { if (n & 1) return 0.f; const float* CB = (const float*)(ws + WS_CB) + 2 * O_IN; const float rs1 = rsqrtf(((const float*)(ws + WS_SSQ1))[ML + m] * (1.f / 1024.f) + EPS);
                 const unsigned w = pk2(v * rs1 + CB[n], vn * rs1 + CB[n + 1]);
                 if (n < 512) *(unsigned*)(K1 + (size_t)(ML + m) * 512 + n) = w; else *(unsigned*)(V1 + (size_t)(ML + m) * 512 + (n - 512)) = w; return 0.f; }); })
  PH(15, attn_phase((bf16_t*)(ws + WS_Q1), (const bf16_t*)(ws + WS_K1), (const bf16_t*)(ws + WS_V1), (const bf16_t*)(ws + WS_G1), p.in[24], p.in[22], p.in[23], lds, wr))
  PH(16, {
    pg8::Gemm g{(const bf16_t*)(ws + WS_Q1), (const bf16_t*)(ws + WS_W4T), ML, D, 2048}; pg8::StaticOrder S; S.init(ML, D, gridDim.x, (int)blockIdx.x);
    pg8::EpiResid E{X1, p.out, MOD + 3 * 3072, wr};
    pg8::gemm_phase<pg8::EpiResid, pg8::StaticOrder, true, true>(lds, g, S, E); })
#undef PH
#undef IN
#undef SEAM
}
extern "C" void kernel_launch(void* const* d_in, const int* in_sizes, int n_in, void* d_out, int out_size, void* d_ws, size_t ws_size, hipStream_t stream) {
  static int grid_blocks = 0;
  if (!grid_blocks) {
    int dev = 0, cus = 0, per_cu = 0;
    hipGetDevice(&dev);
    hipDeviceGetAttribute(&cus, hipDeviceAttributeMultiprocessorCount, dev);
    hipFuncSetAttribute((const void*)mega, hipFuncAttributeMaxDynamicSharedMemorySize, LDS_BYTES);
    hipOccupancyMaxActiveBlocksPerMultiprocessor(&per_cu, (const void*)mega, NWAVES * 64, LDS_BYTES);
    if (per_cu < 1) { fprintf(stderr, "kernel_launch: occupancy query says %d blocks per CU\n", per_cu); per_cu = 1; }
    if (per_cu > 1) per_cu = 1;
    grid_blocks = cus * per_cu;
  }
  hipMemsetAsync((char*)d_ws + WS_CTL, 0, 256 * 1024, stream);
  Params base{};
  for (int i = 0; i < 26; ++i) base.in[i] = (const float*)d_in[i];
  base.out = (float*)d_out; base.ws = (unsigned char*)d_ws;
  auto launch = [&](int lo, int hi) {
    Params p = base; p.ph_lo = lo; p.ph_hi = hi; p.rep = (int)PROBE_MASK; void* args[] = {&p};
    hipError_t e = hipLaunchCooperativeKernel((const void*)mega, dim3(grid_blocks), dim3(NWAVES * 64), args, LDS_BYTES, stream);
    if (e != hipSuccess) fprintf(stderr, "cooperative launch failed: %s (grid %d)\n", hipGetErrorString(e), grid_blocks);
  };
  launch(0, 17);
}
```
